# Optimizing an MI355X kernel written in HIP

```python
import math
import jax, jax.numpy as jnp
from jax import lax
import numpy as np

D_MODEL = 1024
BATCH = 2
SEQ = 8192
DEPTH = 2

HEAD_DIM = 64
MLA_HEADS = 6
MLA_NOPE = 64
MLA_ROPE = 32
MLA_V = 64
MLA_QK = MLA_NOPE + MLA_ROPE
Q_LORA = 256
KV_LORA = 128
SWA_HEADS = 6
SWA_KV_HEADS = 2
SWA_GROUP = SWA_HEADS // SWA_KV_HEADS
WINDOW = 128
SB_HEADS = 4
BLOCK = 128
NUM_BUCKETS = 32
MAX_DISTANCE = 128
D_FF = 2816
ROPE_THETA = 10000.0
EPS = 1e-6

MLA_WIDTH = MLA_HEADS * MLA_V
SWA_WIDTH = SWA_HEADS * HEAD_DIM
SB_WIDTH = SB_HEADS * HEAD_DIM
D_MIX = MLA_WIDTH + SWA_WIDTH + SB_WIDTH
IN_SIZES = (Q_LORA, KV_LORA, MLA_ROPE,
            SWA_HEADS * HEAD_DIM, SWA_KV_HEADS * HEAD_DIM, SWA_KV_HEADS * HEAD_DIM,
            3 * SB_HEADS * HEAD_DIM)
D_IN = Q_LORA + KV_LORA + MLA_ROPE + (SWA_HEADS + 2 * SWA_KV_HEADS) * HEAD_DIM + 3 * SB_HEADS * HEAD_DIM

kernel_name = "hybrid_mla_swa_stickbreak_macaron"


def _split_cols(x, sizes):
    offs = np.cumsum(np.array(sizes))[:-1].tolist()
    return jnp.split(x, offs, axis=-1)


def rms_norm(x, g):
    xf = x.astype(jnp.float32)
    y = xf * lax.rsqrt(jnp.mean(xf * xf, axis=-1, keepdims=True) + EPS)
    return (y * g.astype(jnp.float32)).astype(x.dtype)


def modulate(x, g, shift, scale):
    return rms_norm(x, g) * (1.0 + scale[:, None, :]) + shift[:, None, :]


def rope(x, pos):
    half = x.shape[-1] // 2
    freqs = ROPE_THETA ** (-jnp.arange(half, dtype=jnp.float32) / half)
    ang = pos.astype(jnp.float32)[:, :, None, None] * freqs
    cos, sin = jnp.cos(ang), jnp.sin(ang)
    xf = x.astype(jnp.float32)
    x1, x2 = xf[..., :half], xf[..., half:]
    return jnp.concatenate([x1 * cos - x2 * sin, x2 * cos + x1 * sin], axis=-1).astype(x.dtype)


def t5_bucket(rel):
    n = jnp.maximum(rel, 0)
    max_exact = NUM_BUCKETS // 2
    nf = jnp.maximum(n, 1).astype(jnp.float32)
    large = max_exact + (jnp.log(nf / max_exact) / math.log(MAX_DISTANCE / max_exact)
                         * (NUM_BUCKETS - max_exact)).astype(jnp.int32)
    large = jnp.minimum(large, NUM_BUCKETS - 1)
    return jnp.where(n < max_exact, n, large)


def swiglu(h, w_gu, w_down):
    g, u = jnp.split(h @ w_gu, 2, axis=-1)
    return (jax.nn.silu(g) * u) @ w_down


def mla_attention(q, k, v):
    B, S, H, Dq = q.shape
    nb = S // BLOCK
    qb = q.reshape(B, nb, BLOCK, H, Dq).transpose(1, 0, 2, 3, 4)
    key_idx = jnp.arange(S)
    scale = Dq ** -0.5

    def one_block(args):
        i, qi = args
        s = jnp.einsum('bqhd,bkhd->bhqk', qi, k).astype(jnp.float32) * scale
        q_idx = i * BLOCK + jnp.arange(BLOCK)
        mask = key_idx[None, :] <= q_idx[:, None]
        p = jax.nn.softmax(jnp.where(mask, s, -jnp.inf), axis=-1)
        return jnp.einsum('bhqk,bkhd->bqhd', p.astype(v.dtype), v)

    out = lax.map(one_block, (jnp.arange(nb), qb))
    return out.transpose(1, 0, 2, 3, 4).reshape(B, S, H * v.shape[-1])


def swa_attention(q, k, v, pos, sinks, rel_table):
    B, S, Hq, D = q.shape
    nb = S // WINDOW

    def band(x):
        xb = x.reshape((B, nb, WINDOW) + x.shape[2:])
        prev = jnp.concatenate([jnp.zeros_like(xb[:, :1]), xb[:, :-1]], axis=1)
        return jnp.concatenate([prev, xb], axis=2)

    kb, vb = band(k), band(v)
    qb = q.reshape(B, nb, WINDOW, SWA_KV_HEADS, SWA_GROUP, D)
    s = jnp.einsum('bnqkgd,bnskd->bnkgqs', qb, kb).astype(jnp.float32) * (D ** -0.5)
    rel = pos.reshape(B, nb, WINDOW)[..., :, None] - band(pos)[..., None, :]
    bias = rel_table[t5_bucket(rel)].astype(jnp.float32)
    bias = bias.reshape(B, nb, WINDOW, 2 * WINDOW, SWA_KV_HEADS, SWA_GROUP).transpose(0, 1, 4, 5, 2, 3)
    q_in = jnp.arange(WINDOW)[:, None] + WINDOW
    k_in = jnp.arange(2 * WINDOW)[None, :]
    d = q_in - k_in
    in_win = (d >= 0) & (d < WINDOW)
    not_pad = (jnp.arange(nb)[:, None, None] > 0) | (k_in[None] >= WINDOW)
    mask = (in_win[None] & not_pad)[None, :, None, None]
    s = jnp.where(mask, s + bias, -jnp.inf)
    sink = sinks.astype(jnp.float32).reshape(SWA_KV_HEADS, SWA_GROUP)[None, None, :, :, None, None]
    m = jnp.maximum(jnp.max(s, axis=-1, keepdims=True), sink)
    p = jnp.exp(s - m)
    p = p / (jnp.sum(p, axis=-1, keepdims=True) + jnp.exp(sink - m))
    o = jnp.einsum('bnkgqs,bnskd->bnqkgd', p.astype(v.dtype), vb)
    return o.reshape(B, S, Hq * D)


def stick_breaking_attention(q, k, v):
    B, S, H, D = q.shape
    nb = S // BLOCK
    qb = q.reshape(B, nb, BLOCK, H, D).transpose(1, 0, 2, 3, 4)
    key_idx = jnp.arange(S)
    scale = D ** -0.5

    def one_block(args):
        i, qi = args
        z = jnp.einsum('bqhd,bkhd->bhqk', qi, k).astype(jnp.float32) * scale
        q_idx = i * BLOCK + jnp.arange(BLOCK)
        mask = key_idx[None, :] < q_idx[:, None]
        log_not = jnp.where(mask, jax.nn.log_sigmoid(-z), 0.0)
        after = lax.cumsum(log_not, axis=3, reverse=True) - log_not
        a = jnp.where(mask, jnp.exp(jax.nn.log_sigmoid(z) + after), 0.0)
        return jnp.einsum('bhqk,bkhd->bqhd', a.astype(v.dtype), v)

    out = lax.map(one_block, (jnp.arange(nb), qb))
    return out.transpose(1, 0, 2, 3, 4).reshape(B, S, H * D)


def setup_inputs(seed: int = 0) -> dict:
    key = jax.random.key(seed)
    ks = jax.random.split(key, 24)
    f32 = jnp.float32

    def nrm(k, shape, scale):
        return jax.random.normal(k, shape, f32) * scale

    def gain(k, shape):
        return 1.0 + 0.1 * jax.random.normal(k, shape, f32)

    x = jax.random.normal(ks[0], (BATCH, SEQ, D_MODEL), f32)
    c = jax.random.normal(ks[1], (BATCH, D_MODEL), f32)
    offset = jax.random.randint(ks[2], (BATCH, 1), 0, 4096, dtype=jnp.int32)
    positions = offset + jnp.arange(SEQ, dtype=jnp.int32)[None, :]
    return {
        "x": x,
        "c": c,
        "positions": positions,
        "rel_bias": nrm(ks[3], (NUM_BUCKETS, SWA_HEADS), 0.5),
        "norm_g": gain(ks[4], (DEPTH, 3, D_MODEL)),
        "w_mod": nrm(ks[5], (DEPTH, D_MODEL, 9 * D_MODEL), 0.5 * D_MODEL ** -0.5),
        "b_mod": nrm(ks[6], (DEPTH, 9 * D_MODEL), 0.02),
        "w_ffn1_gu": nrm(ks[7], (DEPTH, D_MODEL, 2 * D_FF), D_MODEL ** -0.5),
        "w_ffn1_down": nrm(ks[8], (DEPTH, D_FF, D_MODEL), D_FF ** -0.5),
        "w_in": nrm(ks[9], (DEPTH, D_MODEL, D_IN), D_MODEL ** -0.5),
        "q_a_norm": gain(ks[10], (DEPTH, Q_LORA)),
        "kv_a_norm": gain(ks[11], (DEPTH, KV_LORA)),
        "w_uq": nrm(ks[12], (DEPTH, Q_LORA, MLA_HEADS * MLA_QK), Q_LORA ** -0.5),
        "w_ukv": nrm(ks[13], (DEPTH, KV_LORA, MLA_HEADS * (MLA_NOPE + MLA_V)), KV_LORA ** -0.5),
        "mla_q_norm": gain(ks[14], (DEPTH, MLA_QK)),
        "mla_k_norm": gain(ks[15], (DEPTH, MLA_QK)),
        "swa_q_norm": gain(ks[16], (DEPTH, HEAD_DIM)),
        "swa_k_norm": gain(ks[17], (DEPTH, HEAD_DIM)),
        "sinks": nrm(ks[18], (DEPTH, SWA_HEADS), 0.5),
        "out_norm": gain(ks[19], (DEPTH, D_MIX)),
        "w_out": nrm(ks[20], (DEPTH, D_MIX, D_MODEL), D_MIX ** -0.5),
        "w_ffn2_gu": nrm(ks[21], (DEPTH, D_MODEL, 2 * D_FF), D_MODEL ** -0.5),
        "w_ffn2_down": nrm(ks[22], (DEPTH, D_FF, D_MODEL), D_FF ** -0.5),
    }


def reference(x, c, positions, rel_bias, norm_g, w_mod, b_mod, w_ffn1_gu, w_ffn1_down,
              w_in, q_a_norm, kv_a_norm, w_uq, w_ukv, mla_q_norm, mla_k_norm,
              swa_q_norm, swa_k_norm, sinks, out_norm, w_out, w_ffn2_gu, w_ffn2_down):
    B, S, _ = x.shape
    cond = jax.nn.silu(c)
    for l in range(DEPTH):
        mod = cond @ w_mod[l] + b_mod[l]
        sh1, sc1, g1, sh2, sc2, g2, sh3, sc3, g3 = jnp.split(mod, 9, axis=-1)

        h = modulate(x, norm_g[l, 0], sh1, sc1)
        x = x + 0.5 * g1[:, None, :] * swiglu(h, w_ffn1_gu[l], w_ffn1_down[l])

        h = modulate(x, norm_g[l, 1], sh2, sc2)
        proj = h @ w_in[l]
        c_q, c_kv, k_pe, q_s, k_s, v_s, qkv_sb = _split_cols(proj, IN_SIZES)

        qa = (rms_norm(c_q, q_a_norm[l]) @ w_uq[l]).reshape(B, S, MLA_HEADS, MLA_QK)
        qa = rms_norm(qa, mla_q_norm[l])
        qa = jnp.concatenate([qa[..., :MLA_NOPE], rope(qa[..., MLA_NOPE:], positions)], axis=-1)
        kv = (rms_norm(c_kv, kv_a_norm[l]) @ w_ukv[l]).reshape(B, S, MLA_HEADS, MLA_NOPE + MLA_V)
        k_nope, va = kv[..., :MLA_NOPE], kv[..., MLA_NOPE:]
        k_pe_h = jnp.broadcast_to(k_pe[:, :, None, :], (B, S, MLA_HEADS, MLA_ROPE))
        ka = rms_norm(jnp.concatenate([k_nope, k_pe_h], axis=-1), mla_k_norm[l])
        ka = jnp.concatenate([ka[..., :MLA_NOPE], rope(ka[..., MLA_NOPE:], positions)], axis=-1)
        o_a = mla_attention(qa, ka, va)

        qb = rms_norm(q_s.reshape(B, S, SWA_HEADS, HEAD_DIM), swa_q_norm[l])
        kb = rms_norm(k_s.reshape(B, S, SWA_KV_HEADS, HEAD_DIM), swa_k_norm[l])
        vb = v_s.reshape(B, S, SWA_KV_HEADS, HEAD_DIM)
        o_b = swa_attention(qb, kb, vb, positions, sinks[l], rel_bias)

        qc, kc, vc = jnp.split(qkv_sb.reshape(B, S, 3, SB_HEADS, HEAD_DIM), 3, axis=2)
        o_c = stick_breaking_attention(qc[:, :, 0], kc[:, :, 0], vc[:, :, 0])

        on = out_norm[l]
        mix = jnp.concatenate([
            rms_norm(o_a, on[:MLA_WIDTH]),
            rms_norm(o_b, on[MLA_WIDTH:MLA_WIDTH + SWA_WIDTH]),
            rms_norm(o_c, on[MLA_WIDTH + SWA_WIDTH:]),
        ], axis=-1)
        x = x + g2[:, None, :] * (mix @ w_out[l])

        h = modulate(x, norm_g[l, 2], sh3, sc3)
        x = x + 0.5 * g3[:, None, :] * swiglu(h, w_ffn2_gu[l], w_ffn2_down[l])
    return x
```

```cpp
#include <hip/hip_runtime.h>
#include <cstdio>
#include <cstdint>
#include <cmath>

namespace nv {
constexpr int D = 1024, BATCH = 2, SEQ = 8192, DEPTH = 2, M = BATCH * SEQ;
constexpr int DFF = 2816, DIN = 1824, NMOD = 9 * D;
constexpr float EPS = 1e-6f;

__device__ __forceinline__ float wave_sum(float v) {
#pragma unroll
    for (int o = 1; o < 64; o <<= 1) v += __shfl_xor(v, o);
    return v;
}
__device__ __forceinline__ float silu_f(float x) { return x / (1.0f + expf(-x)); }

__global__ void k_mod(const float* __restrict__ c, const float* __restrict__ w_mod, const float* __restrict__ b_mod, float* __restrict__ mod) {
    int idx = blockIdx.x * 256 + threadIdx.x;
    if (idx >= DEPTH * NMOD) return;
    int l = idx / NMOD, n = idx % NMOD;
    float a0 = 0.f, a1 = 0.f;
    const float* w = w_mod + (size_t)l * D * NMOD + n;
    for (int k = 0; k < D; ++k) {
        float wv = w[(size_t)k * NMOD];
        a0 += silu_f(c[k]) * wv; a1 += silu_f(c[D + k]) * wv;
    }
    mod[((size_t)l * 2 + 0) * NMOD + n] = a0 + b_mod[l * NMOD + n];
    mod[((size_t)l * 2 + 1) * NMOD + n] = a1 + b_mod[l * NMOD + n];
}

__global__ void k_normmod(const float* __restrict__ x, const float* __restrict__ g, const float* __restrict__ sh, const float* __restrict__ sc, float* __restrict__ H, int rows) {
    int row = blockIdx.x * 4 + (threadIdx.x >> 6), lane = threadIdx.x & 63;
    if (row >= rows) return;
    const float* xr = x + (size_t)row * D;
    float v[16]; float s = 0.f;
#pragma unroll
    for (int j = 0; j < 16; ++j) { v[j] = xr[lane + 64 * j]; s += v[j] * v[j]; }
    s = wave_sum(s);
    float r = rsqrtf(s * (1.0f / D) + EPS);
#pragma unroll
    for (int j = 0; j < 16; ++j) { int cidx = lane + 64 * j; H[(size_t)row * D + cidx] = v[j] * r * g[cidx] * (1.0f + sc[cidx]) + sh[cidx]; }
}

template <bool DUAL, int EPI>
__global__ void __launch_bounds__(256) k_gemm(const float* __restrict__ A, int lda, const float* __restrict__ W, const float* __restrict__ W2, int ldw,
                                              float* C, int ldc, int N, int K, const float* R, const float* __restrict__ gate, float coef) {
    __shared__ float As[16][128 + 4];
    __shared__ float Bs[16][128 + 4];
    __shared__ float Bs2[DUAL ? 16 : 1][128 + 4];
    const int tid = threadIdx.x, tx = tid & 15, ty = tid >> 4;
    const int m0 = blockIdx.y * 128, n0 = blockIdx.x * 128;
    float acc[8][8], acc2[DUAL ? 8 : 1][8];
#pragma unroll
    for (int i = 0; i < 8; ++i)
#pragma unroll
        for (int j = 0; j < 8; ++j) { acc[i][j] = 0.f; if (DUAL) acc2[i][j] = 0.f; }
    for (int k0 = 0; k0 < K; k0 += 16) {
#pragma unroll
        for (int i = 0; i < 2; ++i) {
            int e = tid + 256 * i;
            int r = e >> 2, kq = e & 3;
            const float4 v = *(const float4*)(A + (size_t)(m0 + r) * lda + k0 + kq * 4);
            As[kq * 4 + 0][r] = v.x; As[kq * 4 + 1][r] = v.y; As[kq * 4 + 2][r] = v.z; As[kq * 4 + 3][r] = v.w;
        }
#pragma unroll
        for (int i = 0; i < 8; ++i) {
            int e = tid + 256 * i;
            int kk = e >> 7, nn = e & 127;
            int n = n0 + nn;
            Bs[kk][nn] = (n < N) ? W[(size_t)(k0 + kk) * ldw + n] : 0.f;
            if (DUAL) Bs2[kk][nn] = (n < N) ? W2[(size_t)(k0 + kk) * ldw + n] : 0.f;
        }
        __syncthreads();
#pragma unroll
        for (int kk = 0; kk < 16; ++kk) {
            float a[8], b[8], b2[8];
#pragma unroll
            for (int i = 0; i < 8; ++i) a[i] = As[kk][ty * 8 + i];
#pragma unroll
            for (int j = 0; j < 8; ++j) { b[j] = Bs[kk][tx * 8 + j]; if (DUAL) b2[j] = Bs2[kk][tx * 8 + j]; }
#pragma unroll
            for (int i = 0; i < 8; ++i)
#pragma unroll
                for (int j = 0; j < 8; ++j) { acc[i][j] += a[i] * b[j]; if (DUAL) acc2[i][j] += a[i] * b2[j]; }
        }
        __syncthreads();
    }
#pragma unroll
    for (int i = 0; i < 8; ++i)
#pragma unroll
        for (int j = 0; j < 8; ++j) {
            int m = m0 + ty * 8 + i, n = n0 + tx * 8 + j;
            if (n < N) {
                float v = acc[i][j];
                if (DUAL) v = silu_f(v) * acc2[i][j];
                if (EPI == 1) v = R[(size_t)m * ldc + n] + coef * gate[n] * v;
                C[(size_t)m * ldc + n] = v;
            }
        }
}

__global__ void k_headnorm(const float* src1, int s1stride, int hs1, int W1, const float* src2, int s2stride, int hs2, int W2,
                           const float* __restrict__ gain, float* dst, int dstride, int dhs, int nheads, int rows, const int* __restrict__ pos, int do_rope, int do_norm) {
    int item = blockIdx.x * 4 + (threadIdx.x >> 6), lane = threadIdx.x & 63;
    if (item >= rows * nheads) return;
    int row = item / nheads, h = item % nheads;
    const int Wt = W1 + W2;
    float v[4]; float s = 0.f;
#pragma unroll
    for (int j = 0; j < 4; ++j) {
        int e = lane + 64 * j; float t = 0.f;
        if (e < W1) t = src1[(size_t)row * s1stride + h * hs1 + e];
        else if (e < Wt) t = src2[(size_t)row * s2stride + h * hs2 + (e - W1)];
        v[j] = t; s += t * t;
    }
    s = wave_sum(s);
    float r = do_norm ? rsqrtf(s / (float)Wt + EPS) : 1.0f;
    __shared__ float tmp[4][256];
    float* tw = tmp[threadIdx.x >> 6];
#pragma unroll
    for (int j = 0; j < 4; ++j) { int e = lane + 64 * j; if (e < Wt) tw[e] = v[j] * r * (do_norm ? gain[e] : 1.0f); }
    __syncthreads();
    if (do_rope) {
        float outv = 0.f; int e = lane;
        if (lane < 32) {
            int jf = lane & 15;
            float freq = powf(10000.0f, -(float)jf / 16.0f);
            float ang = (float)pos[row] * freq;
            float cs = cosf(ang), sn = sinf(ang);
            float x1 = tw[Wt - 32 + jf], x2 = tw[Wt - 16 + jf];
            outv = (lane < 16) ? (x1 * cs - x2 * sn) : (x2 * cs + x1 * sn);
        }
        __syncthreads();
        if (lane < 32) tw[Wt - 32 + e] = outv;
        __syncthreads();
    }
#pragma unroll
    for (int j = 0; j < 4; ++j) { int e = lane + 64 * j; if (e < Wt) dst[(size_t)row * dstride + h * dhs + e] = tw[e]; }
}

__device__ __forceinline__ int t5_bucket(int rel) {
    int n = rel > 0 ? rel : 0;
    if (n < 16) return n;
    float nf = (float)n;
    int large = 16 + (int)(logf(nf / 16.0f) / logf(8.0f) * 16.0f);
    return large < 31 ? large : 31;
}

template <int DQK, int DV, int MODE>
__global__ void __launch_bounds__(256) k_attn(const float* __restrict__ Q, int qstride, int qhs, const float* __restrict__ Kp, int kstride, int khs, const float* __restrict__ Vp, int vstride, int vhs,
                                              float* __restrict__ O, int ostride, int ocol0, int group, const int* __restrict__ pos, const float* __restrict__ sinks, const float* __restrict__ relb, int nheads_q) {
    __shared__ float Ks[64][DQK];
    __shared__ float Vs[64][DV];
    const int h = blockIdx.y, kvh = h / group, t0 = blockIdx.x * 256, t = t0 + threadIdx.x;
    float q[DQK], o[DV];
    const float scale = rsqrtf((float)DQK);
#pragma unroll
    for (int d = 0; d < DQK; ++d) q[d] = Q[(size_t)t * qstride + h * qhs + d] * scale;
#pragma unroll
    for (int d = 0; d < DV; ++d) o[d] = 0.f;
    float mrun = (MODE == 1) ? sinks[h] : -INFINITY, lrun = (MODE == 1) ? 1.0f : 0.f;
    float after = 0.f;
    const int posq = (MODE == 1) ? pos[t] : 0;
    int jt_lo, jt_hi;
    if (MODE == 0) { jt_lo = 0; jt_hi = (t0 + 255) / 64; }
    else if (MODE == 1) { int lo = t0 - 127; if (lo < 0) lo = 0; jt_lo = lo / 64; jt_hi = (t0 + 255) / 64; }
    else { jt_lo = 0; jt_hi = (t0 + 254) / 64; }
    const int ntile = jt_hi - jt_lo + 1;
    for (int it = 0; it < ntile; ++it) {
        const int jt = (MODE == 2) ? (jt_hi - it) : (jt_lo + it);
        const int j0 = jt * 64;
        __syncthreads();
        for (int e = threadIdx.x; e < 64 * DQK; e += 256) { int jj = e / DQK, d = e % DQK; Ks[jj][d] = Kp[(size_t)(j0 + jj) * kstride + kvh * khs + d]; }
        for (int e = threadIdx.x; e < 64 * DV; e += 256) { int jj = e / DV, d = e % DV; Vs[jj][d] = Vp[(size_t)(j0 + jj) * vstride + kvh * vhs + d]; }
        __syncthreads();
        if (MODE == 2) {
            bool live = false;
            for (int jj = 63; jj >= 0; --jj) {
                int j = j0 + jj;
                if (j < t) {
                    float z = 0.f;
#pragma unroll
                    for (int d = 0; d < DQK; ++d) z += q[d] * Ks[jj][d];
                    float sp = fmaxf(z, 0.f) + log1pf(expf(-fabsf(z)));
                    float a = expf(z - sp + after);
                    after -= sp;
#pragma unroll
                    for (int d = 0; d < DV; ++d) o[d] += a * Vs[jj][d];
                }
            }
            live = (after > -110.0f) ;
            if (!__syncthreads_or(live ? 1 : 0)) break;
        } else {
            for (int jj = 0; jj < 64; ++jj) {
                int j = j0 + jj;
                bool ok = (j <= t);
                if (MODE == 1) ok = ok && (j > t - 128);
                if (ok) {
                    float s = 0.f;
#pragma unroll
                    for (int d = 0; d < DQK; ++d) s += q[d] * Ks[jj][d];
                    if (MODE == 1) s += relb[t5_bucket(posq - pos[j]) * nheads_q + h];
                    float mn = fmaxf(mrun, s);
                    float f = expf(mrun - mn), p = expf(s - mn);
                    lrun = lrun * f + p; mrun = mn;
#pragma unroll
                    for (int d = 0; d < DV; ++d) o[d] = o[d] * f + p * Vs[jj][d];
                }
            }
        }
    }
    const float inv = (MODE == 2) ? 1.0f : 1.0f / lrun;
#pragma unroll
    for (int d = 0; d < DV; ++d) O[(size_t)t * ostride + ocol0 + h * DV + d] = o[d] * inv;
}

__global__ void k_groupnorm(float* O, const float* __restrict__ on, int rows) {
    int row = blockIdx.x * 4 + (threadIdx.x >> 6), lane = threadIdx.x & 63;
    if (row >= rows) return;
    float* orow = O + (size_t)row * D;
    float v[16]; float s0 = 0.f, s1 = 0.f, s2 = 0.f;
#pragma unroll
    for (int j = 0; j < 16; ++j) { int cidx = lane + 64 * j; v[j] = orow[cidx]; float sq = v[j] * v[j]; if (cidx < 384) s0 += sq; else if (cidx < 768) s1 += sq; else s2 += sq; }
    s0 = wave_sum(s0); s1 = wave_sum(s1); s2 = wave_sum(s2);
    float r0 = rsqrtf(s0 / 384.f + EPS), r1 = rsqrtf(s1 / 384.f + EPS), r2 = rsqrtf(s2 / 256.f + EPS);
#pragma unroll
    for (int j = 0; j < 16; ++j) { int cidx = lane + 64 * j; float r = cidx < 384 ? r0 : (cidx < 768 ? r1 : r2); orow[cidx] = v[j] * r * on[cidx]; }
}
}

extern "C" void kernel_launch(void* const* d_in, const int* in_sizes, int n_in, void* d_out, int out_size, void* d_ws, size_t ws_size, hipStream_t stream) {
    using namespace nv;
    const float* x = (const float*)d_in[0]; const float* c = (const float*)d_in[1]; const int* positions = (const int*)d_in[2];
    const float* rel_bias = (const float*)d_in[3]; const float* norm_g = (const float*)d_in[4]; const float* w_mod = (const float*)d_in[5]; const float* b_mod = (const float*)d_in[6];
    const float* w_ffn1_gu = (const float*)d_in[7]; const float* w_ffn1_down = (const float*)d_in[8]; const float* w_in = (const float*)d_in[9];
    const float* q_a_norm = (const float*)d_in[10]; const float* kv_a_norm = (const float*)d_in[11]; const float* w_uq = (const float*)d_in[12]; const float* w_ukv = (const float*)d_in[13];
    const float* mla_q_norm = (const float*)d_in[14]; const float* mla_k_norm = (const float*)d_in[15]; const float* swa_q_norm = (const float*)d_in[16]; const float* swa_k_norm = (const float*)d_in[17];
    const float* sinks = (const float*)d_in[18]; const float* out_norm = (const float*)d_in[19]; const float* w_out = (const float*)d_in[20];
    const float* w_ffn2_gu = (const float*)d_in[21]; const float* w_ffn2_down = (const float*)d_in[22];
    float* out = (float*)d_out;
    char* ws = (char*)d_ws;
    const size_t MiB = 1u << 20;
    float* mod = (float*)(ws);
    float* H = (float*)(ws + 1 * MiB);
    float* HID = (float*)(ws + 33 * MiB);
    float* P = (float*)(ws + 33 * MiB);
    float* QA = (float*)(ws + 91 * MiB);
    float* KVRAW = (float*)(ws + 110 * MiB);
    float* KA = (float*)(ws + 135 * MiB);
    float* CQN = (float*)(ws + 154 * MiB);
    float* CKVN = (float*)(ws + 163 * MiB);
    float* QB = (float*)(ws + 168 * MiB);
    float* KB = (float*)(ws + 181 * MiB);

    hipMemcpyAsync(out, x, (size_t)M * D * sizeof(float), hipMemcpyDeviceToDevice, stream);
    k_mod<<<(DEPTH * NMOD + 255) / 256, 256, 0, stream>>>(c, w_mod, b_mod, mod);
    for (int l = 0; l < DEPTH; ++l) {
        for (int b = 0; b < BATCH; ++b) {
            float* xb = out + (size_t)b * SEQ * D;
            const int* posb = positions + b * SEQ;
            const float* modlb = mod + ((size_t)l * 2 + b) * NMOD;
            auto ffn = [&](int i, const float* wgu, const float* wdn) {
                const float* sh = modlb + (3 * i) * D; const float* sc = modlb + (3 * i + 1) * D; const float* gt = modlb + (3 * i + 2) * D;
                k_normmod<<<SEQ / 4, 256, 0, stream>>>(xb, norm_g + ((size_t)l * 3 + i) * D, sh, sc, H, SEQ);
                k_gemm<true, 0><<<dim3(DFF / 128, SEQ / 128), 256, 0, stream>>>(H, D, wgu, wgu + DFF, 2 * DFF, HID, DFF, DFF, D, nullptr, nullptr, 0.f);
                k_gemm<false, 1><<<dim3(D / 128, SEQ / 128), 256, 0, stream>>>(HID, DFF, wdn, nullptr, D, xb, D, D, DFF, xb, gt, 0.5f);
            };
            ffn(0, w_ffn1_gu + (size_t)l * D * 2 * DFF, w_ffn1_down + (size_t)l * DFF * D);
            {
                const float* sh = modlb + 3 * D; const float* sc = modlb + 4 * D; const float* gt = modlb + 5 * D;
                k_normmod<<<SEQ / 4, 256, 0, stream>>>(xb, norm_g + ((size_t)l * 3 + 1) * D, sh, sc, H, SEQ);
                k_gemm<false, 0><<<dim3((DIN + 127) / 128, SEQ / 128), 256, 0, stream>>>(H, D, w_in + (size_t)l * D * DIN, nullptr, DIN, P, DIN, DIN, D, nullptr, nullptr, 0.f);
                k_headnorm<<<SEQ / 4, 256, 0, stream>>>(P, DIN, 0, 256, nullptr, 0, 0, 0, q_a_norm + l * 256, CQN, 256, 256, 1, SEQ, posb, 0, 1);
                k_headnorm<<<SEQ / 4, 256, 0, stream>>>(P + 256, DIN, 0, 128, nullptr, 0, 0, 0, kv_a_norm + l * 128, CKVN, 128, 128, 1, SEQ, posb, 0, 1);
                k_gemm<false, 0><<<dim3((576 + 127) / 128, SEQ / 128), 256, 0, stream>>>(CQN, 256, w_uq + (size_t)l * 256 * 576, nullptr, 576, QA, 576, 576, 256, nullptr, nullptr, 0.f);
                k_gemm<false, 0><<<dim3(768 / 128, SEQ / 128), 256, 0, stream>>>(CKVN, 128, w_ukv + (size_t)l * 128 * 768, nullptr, 768, KVRAW, 768, 768, 128, nullptr, nullptr, 0.f);
                k_headnorm<<<SEQ * 6 / 4, 256, 0, stream>>>(QA, 576, 96, 96, nullptr, 0, 0, 0, mla_q_norm + l * 96, QA, 576, 96, 6, SEQ, posb, 1, 1);
                k_headnorm<<<SEQ * 6 / 4, 256, 0, stream>>>(KVRAW, 768, 128, 64, P + 384, DIN, 0, 32, mla_k_norm + l * 96, KA, 576, 96, 6, SEQ, posb, 1, 1);
                k_headnorm<<<SEQ * 6 / 4, 256, 0, stream>>>(P + 416, DIN, 64, 64, nullptr, 0, 0, 0, swa_q_norm + l * 64, QB, 384, 64, 6, SEQ, posb, 0, 1);
                k_headnorm<<<SEQ * 2 / 4, 256, 0, stream>>>(P + 800, DIN, 64, 64, nullptr, 0, 0, 0, swa_k_norm + l * 64, KB, 128, 64, 2, SEQ, posb, 0, 1);
                k_attn<96, 64, 0><<<dim3(SEQ / 256, 6), 256, 0, stream>>>(QA, 576, 96, KA, 576, 96, KVRAW + 64, 768, 128, H, D, 0, 1, posb, nullptr, nullptr, 6);
                k_attn<64, 64, 1><<<dim3(SEQ / 256, 6), 256, 0, stream>>>(QB, 384, 64, KB, 128, 64, P + 928, DIN, 64, H, D, 384, 3, posb, sinks + l * 6, rel_bias, 6);
                k_attn<64, 64, 2><<<dim3(SEQ / 256, 4), 256, 0, stream>>>(P + 1056, DIN, 64, P + 1056 + 256, DIN, 64, P + 1056 + 512, DIN, 64, H, D, 768, 1, posb, nullptr, nullptr, 4);
                k_groupnorm<<<SEQ / 4, 256, 0, stream>>>(H, out_norm + l * D, SEQ);
                k_gemm<false, 1><<<dim3(D / 128, SEQ / 128), 256, 0, stream>>>(H, D, w_out + (size_t)l * D * D, nullptr, D, xb, D, D, D, xb, gt, 1.0f);
            }
            ffn(2, w_ffn2_gu + (size_t)l * D * 2 * DFF, w_ffn2_down + (size_t)l * DFF * D);
        }
    }
}
```

```cpp
#include <hip/hip_runtime.h>
#include <cstdio>
#include <cstdint>
#include <cmath>
namespace nv {
constexpr int D = 1024, BATCH = 2, SEQ = 8192, DEPTH = 2, M = BATCH * SEQ;
constexpr int DFF = 2816, DIN = 1824, NMOD = 9 * D;
constexpr float EPS = 1e-6f;

__device__ __forceinline__ float wave_sum(float v) {
#pragma unroll
    for (int o = 1; o < 64; o <<= 1) v += __shfl_xor(v, o);
    return v;
}
__device__ __forceinline__ float silu_f(float x) { return x / (1.0f + expf(-x)); }

__global__ void k_mod(const float* __restrict__ c, const float* __restrict__ w_mod, const float* __restrict__ b_mod, float* __restrict__ mod) {
    int idx = blockIdx.x * 256 + threadIdx.x;
    if (idx >= DEPTH * NMOD) return;
    int l = idx / NMOD, n = idx % NMOD;
    float a0 = 0.f, a1 = 0.f;
    const float* w = w_mod + (size_t)l * D * NMOD + n;
    for (int k = 0; k < D; ++k) {
        float wv = w[(size_t)k * NMOD];
        a0 += silu_f(c[k]) * wv; a1 += silu_f(c[D + k]) * wv;
    }
    mod[((size_t)l * 2 + 0) * NMOD + n] = a0 + b_mod[l * NMOD + n];
    mod[((size_t)l * 2 + 1) * NMOD + n] = a1 + b_mod[l * NMOD + n];
}

__global__ void k_normmod(const float* __restrict__ x, const float* __restrict__ g, const float* __restrict__ sh, const float* __restrict__ sc, float* __restrict__ H, int rows) {
    int row = blockIdx.x * 4 + (threadIdx.x >> 6), lane = threadIdx.x & 63;
    if (row >= rows) return;
    const float* xr = x + (size_t)row * D;
    float v[16]; float s = 0.f;
#pragma unroll
    for (int j = 0; j < 16; ++j) { v[j] = xr[lane + 64 * j]; s += v[j] * v[j]; }
    s = wave_sum(s);
    float r = rsqrtf(s * (1.0f / D) + EPS);
#pragma unroll
    for (int j = 0; j < 16; ++j) { int cidx = lane + 64 * j; H[(size_t)row * D + cidx] = v[j] * r * g[cidx] * (1.0f + sc[cidx]) + sh[cidx]; }
}

template <bool DUAL, int EPI>
__global__ void __launch_bounds__(256) k_gemm(const float* __restrict__ A, int lda, const float* __restrict__ W, const float* __restrict__ W2, int ldw,
                                              float* C, int ldc, int N, int K, const float* R, const float* __restrict__ gate, float coef) {
    __shared__ float As[16][128 + 4];
    __shared__ float Bs[16][128 + 4];
    __shared__ float Bs2[DUAL ? 16 : 1][128 + 4];
    const int tid = threadIdx.x, tx = tid & 15, ty = tid >> 4;
    const int m0 = blockIdx.y * 128, n0 = blockIdx.x * 128;
    float acc[8][8], acc2[DUAL ? 8 : 1][8];
#pragma unroll
    for (int i = 0; i < 8; ++i)
#pragma unroll
        for (int j = 0; j < 8; ++j) { acc[i][j] = 0.f; if (DUAL) acc2[i][j] = 0.f; }
    for (int k0 = 0; k0 < K; k0 += 16) {
#pragma unroll
        for (int i = 0; i < 2; ++i) {
            int e = tid + 256 * i;
            int r = e >> 2, kq = e & 3;
            const float4 v = *(const float4*)(A + (size_t)(m0 + r) * lda + k0 + kq * 4);
            As[kq * 4 + 0][r] = v.x; As[kq * 4 + 1][r] = v.y; As[kq * 4 + 2][r] = v.z; As[kq * 4 + 3][r] = v.w;
        }
#pragma unroll
        for (int i = 0; i < 8; ++i) {
            int e = tid + 256 * i;
            int kk = e >> 7, nn = e & 127;
            int n = n0 + nn;
            Bs[kk][nn] = (n < N) ? W[(size_t)(k0 + kk) * ldw + n] : 0.f;
            if (DUAL) Bs2[kk][nn] = (n < N) ? W2[(size_t)(k0 + kk) * ldw + n] : 0.f;
        }
        __syncthreads();
#pragma unroll
        for (int kk = 0; kk < 16; ++kk) {
            float a[8], b[8], b2[8];
#pragma unroll
            for (int i = 0; i < 8; ++i) a[i] = As[kk][ty * 8 + i];
#pragma unroll
            for (int j = 0; j < 8; ++j) { b[j] = Bs[kk][tx * 8 + j]; if (DUAL) b2[j] = Bs2[kk][tx * 8 + j]; }
#pragma unroll
            for (int i = 0; i < 8; ++i)
#pragma unroll
                for (int j = 0; j < 8; ++j) { acc[i][j] += a[i] * b[j]; if (DUAL) acc2[i][j] += a[i] * b2[j]; }
        }
        __syncthreads();
    }
#pragma unroll
    for (int i = 0; i < 8; ++i)
#pragma unroll
        for (int j = 0; j < 8; ++j) {
            int m = m0 + ty * 8 + i, n = n0 + tx * 8 + j;
            if (n < N) {
                float v = acc[i][j];
                if (DUAL) v = silu_f(v) * acc2[i][j];
                if (EPI == 1) v = R[(size_t)m * ldc + n] + coef * gate[n] * v;
                C[(size_t)m * ldc + n] = v;
            }
        }
}

__global__ void k_headnorm(const float* src1, int s1stride, int hs1, int W1, const float* src2, int s2stride, int hs2, int W2,
                           const float* __restrict__ gain, float* dst, int dstride, int dhs, int nheads, int rows, const int* __restrict__ pos, int do_rope, int do_norm) {
    int item = blockIdx.x * 4 + (threadIdx.x >> 6), lane = threadIdx.x & 63;
    if (item >= rows * nheads) return;
    int row = item / nheads, h = item % nheads;
    const int Wt = W1 + W2;
    float v[4]; float s = 0.f;
#pragma unroll
    for (int j = 0; j < 4; ++j) {
        int e = lane + 64 * j; float t = 0.f;
        if (e < W1) t = src1[(size_t)row * s1stride + h * hs1 + e];
        else if (e < Wt) t = src2[(size_t)row * s2stride + h * hs2 + (e - W1)];
        v[j] = t; s += t * t;
    }
    s = wave_sum(s);
    float r = do_norm ? rsqrtf(s / (float)Wt + EPS) : 1.0f;
    __shared__ float tmp[4][256];
    float* tw = tmp[threadIdx.x >> 6];
#pragma unroll
    for (int j = 0; j < 4; ++j) { int e = lane + 64 * j; if (e < Wt) tw[e] = v[j] * r * (do_norm ? gain[e] : 1.0f); }
    __syncthreads();
    if (do_rope) {
        float outv = 0.f; int e = lane;
        if (lane < 32) {
            int jf = lane & 15;
            float freq = powf(10000.0f, -(float)jf / 16.0f);
            float ang = (float)pos[row] * freq;
            float cs = cosf(ang), sn = sinf(ang);
            float x1 = tw[Wt - 32 + jf], x2 = tw[Wt - 16 + jf];
            outv = (lane < 16) ? (x1 * cs - x2 * sn) : (x2 * cs + x1 * sn);
        }
        __syncthreads();
        if (lane < 32) tw[Wt - 32 + e] = outv;
        __syncthreads();
    }
#pragma unroll
    for (int j = 0; j < 4; ++j) { int e = lane + 64 * j; if (e < Wt) dst[(size_t)row * dstride + h * dhs + e] = tw[e]; }
}

__device__ __forceinline__ int t5_bucket(int rel) {
    int n = rel > 0 ? rel : 0;
    if (n < 16) return n;
    float nf = (float)n;
    int large = 16 + (int)(logf(nf / 16.0f) / logf(8.0f) * 16.0f);
    return large < 31 ? large : 31;
}

template <int DQK, int DV, int MODE>
__global__ void __launch_bounds__(256) k_attn(const float* __restrict__ Q, int qstride, int qhs, const float* __restrict__ Kp, int kstride, int khs, const float* __restrict__ Vp, int vstride, int vhs,
                                              float* __restrict__ O, int ostride, int ocol0, int group, const int* __restrict__ pos, const float* __restrict__ sinks, const float* __restrict__ relb, int nheads_q) {
    __shared__ float Ks[64][DQK];
    __shared__ float Vs[64][DV];
    const int h = blockIdx.y, kvh = h / group, t0 = blockIdx.x * 256, t = t0 + threadIdx.x;
    float q[DQK], o[DV];
    const float scale = rsqrtf((float)DQK);
#pragma unroll
    for (int d = 0; d < DQK; ++d) q[d] = Q[(size_t)t * qstride + h * qhs + d] * scale;
#pragma unroll
    for (int d = 0; d < DV; ++d) o[d] = 0.f;
    float mrun = (MODE == 1) ? sinks[h] : -INFINITY, lrun = (MODE == 1) ? 1.0f : 0.f;
    float after = 0.f;
    const int posq = (MODE == 1) ? pos[t] : 0;
    int jt_lo, jt_hi;
    if (MODE == 0) { jt_lo = 0; jt_hi = (t0 + 255) / 64; }
    else if (MODE == 1) { int lo = t0 - 127; if (lo < 0) lo = 0; jt_lo = lo / 64; jt_hi = (t0 + 255) / 64; }
    else { jt_lo = 0; jt_hi = (t0 + 254) / 64; }
    const int ntile = jt_hi - jt_lo + 1;
    for (int it = 0; it < ntile; ++it) {
        const int jt = (MODE == 2) ? (jt_hi - it) : (jt_lo + it);
        const int j0 = jt * 64;
        __syncthreads();
        for (int e = threadIdx.x; e < 64 * DQK; e += 256) { int jj = e / DQK, d = e % DQK; Ks[jj][d] = Kp[(size_t)(j0 + jj) * kstride + kvh * khs + d]; }
        for (int e = threadIdx.x; e < 64 * DV; e += 256) { int jj = e / DV, d = e % DV; Vs[jj][d] = Vp[(size_t)(j0 + jj) * vstride + kvh * vhs + d]; }
        __syncthreads();
        if (MODE == 2) {
            bool live = false;
            for (int jj = 63; jj >= 0; --jj) {
                int j = j0 + jj;
                if (j < t) {
                    float z = 0.f;
#pragma unroll
                    for (int d = 0; d < DQK; ++d) z += q[d] * Ks[jj][d];
                    float sp = fmaxf(z, 0.f) + log1pf(expf(-fabsf(z)));
                    float a = expf(z - sp + after);
                    after -= sp;
#pragma unroll
                    for (int d = 0; d < DV; ++d) o[d] += a * Vs[jj][d];
                }
            }
            live = (after > -110.0f) ;
            if (!__syncthreads_or(live ? 1 : 0)) break;
        } else {
            for (int jj = 0; jj < 64; ++jj) {
                int j = j0 + jj;
                bool ok = (j <= t);
                if (MODE == 1) ok = ok && (j > t - 128);
                if (ok) {
                    float s = 0.f;
#pragma unroll
                    for (int d = 0; d < DQK; ++d) s += q[d] * Ks[jj][d];
                    if (MODE == 1) s += relb[t5_bucket(posq - pos[j]) * nheads_q + h];
                    float mn = fmaxf(mrun, s);
                    float f = expf(mrun - mn), p = expf(s - mn);
                    lrun = lrun * f + p; mrun = mn;
#pragma unroll
                    for (int d = 0; d < DV; ++d) o[d] = o[d] * f + p * Vs[jj][d];
                }
            }
        }
    }
    const float inv = (MODE == 2) ? 1.0f : 1.0f / lrun;
#pragma unroll
    for (int d = 0; d < DV; ++d) O[(size_t)t * ostride + ocol0 + h * DV + d] = o[d] * inv;
}

__global__ void k_groupnorm(float* O, const float* __restrict__ on, int rows) {
    int row = blockIdx.x * 4 + (threadIdx.x >> 6), lane = threadIdx.x & 63;
    if (row >= rows) return;
    float* orow = O + (size_t)row * D;
    float v[16]; float s0 = 0.f, s1 = 0.f, s2 = 0.f;
#pragma unroll
    for (int j = 0; j < 16; ++j) { int cidx = lane + 64 * j; v[j] = orow[cidx]; float sq = v[j] * v[j]; if (cidx < 384) s0 += sq; else if (cidx < 768) s1 += sq; else s2 += sq; }
    s0 = wave_sum(s0); s1 = wave_sum(s1); s2 = wave_sum(s2);
    float r0 = rsqrtf(s0 / 384.f + EPS), r1 = rsqrtf(s1 / 384.f + EPS), r2 = rsqrtf(s2 / 256.f + EPS);
#pragma unroll
    for (int j = 0; j < 16; ++j) { int cidx = lane + 64 * j; float r = cidx < 384 ? r0 : (cidx < 768 ? r1 : r2); orow[cidx] = v[j] * r * on[cidx]; }
}
}
constexpr int NWAVES = 8;
constexpr int BATCH = 2, SEQ = 8192, DM = 1024, DEPTH = 2, MROWS = BATCH * SEQ;
constexpr int DFF = 2816, DIN = 1824, NMOD = 9 * DM;
constexpr int NPH = 2 + 8 * DEPTH;
constexpr size_t MiB = 1u << 20;
constexpr size_t WS_CTL = 0, CTL_ZERO_BYTES = 256 * 1024;
constexpr size_t WS_MOD = 1 * MiB;
constexpr size_t WS_GS = WS_MOD + 160 * 1024;
constexpr size_t WS_BIAS = WS_GS + 64 * 1024;
constexpr size_t BIAS_L = 2 * (5632 + 2048 + 5632);
constexpr size_t WS_SSQX = 2 * MiB;
constexpr size_t WS_SSQO = 3 * MiB;
constexpr size_t WS_CS = 4 * MiB;
constexpr size_t WS_KPE = 6 * MiB;
constexpr size_t WS_SSQC = 8 * MiB;
constexpr size_t WS_W = 9 * MiB;
constexpr size_t W_GU1 = 0, W_D1 = W_GU1 + (size_t)5632 * 1024 * 2, W_IN = W_D1 + (size_t)1024 * 2816 * 2, W_UQ = W_IN + (size_t)2048 * 1024 * 2, W_UKV = W_UQ + (size_t)768 * 256 * 2,
                 W_OUT = W_UKV + (size_t)768 * 128 * 2, W_GU2 = W_OUT + (size_t)1024 * 1024 * 2, W_D2 = W_GU2 + (size_t)5632 * 1024 * 2, WL = W_D2 + (size_t)1024 * 2816 * 2;
constexpr size_t WS_XB = WS_W + ((2 * WL + MiB - 1) / MiB) * MiB;
constexpr size_t WS_ACT = WS_XB + 32 * MiB;
constexpr size_t WS_HID = WS_ACT;
constexpr size_t WS_CQ = WS_ACT, WS_CKV = WS_CQ + 8 * MiB, WS_QRAW = WS_CKV + 4 * MiB, WS_KA = WS_QRAW + 36 * MiB, WS_VA = WS_KA + 18 * MiB, WS_QS = WS_VA + 12 * MiB, WS_KS = WS_QS + 12 * MiB,
                 WS_VS = WS_KS + 4 * MiB, WS_QC = WS_VS + 4 * MiB, WS_KC = WS_QC + 8 * MiB, WS_VC = WS_KC + 8 * MiB, WS_OALL = WS_VC + 8 * MiB, WS_END = WS_OALL + 32 * MiB;
static_assert(WS_HID + (size_t)MROWS * DFF * 2 <= WS_END, "d_ws map");
constexpr int CW_BAR = 4096;
constexpr int CW_Q = 40960;
static_assert((CW_Q + 64 * 8) * 4 <= (int)CTL_ZERO_BYTES && CW_BAR + 8 * 3456 <= CW_Q, "ctl map");
constexpr int RING_BYTES = 131072, LDSCTL_OFF = RING_BYTES, MISC_OFF = LDSCTL_OFF + 320, LDS_BYTES = 147456;

namespace pg8 {
#define PG8_LAS __attribute__((address_space(3)))
typedef unsigned short bf16_t;
typedef short bf16x8 __attribute__((ext_vector_type(8)));
typedef float f32x4 __attribute__((ext_vector_type(4)));
typedef unsigned u32x4 __attribute__((ext_vector_type(4)));
constexpr int BM = 256, BK = 64, HALF = 128, HTB = HALF * BK * 2  , STAGE_BYTES = 8 * HTB, NXCD = 8, WGM = 8;

__host__ __device__ __forceinline__ int lds_byte(int r, int c) { const int st = (r >> 4) * 2 + (c >> 5), rr = r & 15, cc = c & 31, ob = rr * 64 + cc * 2; return st * 1024 + (ob ^ (((ob >> 9) & 1) << 5)); }
__host__ __device__ __forceinline__ void stage_rc(int b, int& R, int& C) { const int st = b / 1024, sb = b % 1024, swz = sb ^ (((sb >> 9) & 1) << 5); R = (st >> 1) * 16 + swz / 64; C = (st & 1) * 32 + (swz % 64) / 2; }
__host__ __device__ __forceinline__ int perm32(int rho) { const int n = rho >> 4, i = rho & 15; return 8 * (i >> 2) + 4 * n + (i & 3); }

struct Unit { int pm, pn; };
struct Gemm { const bf16_t* A; const bf16_t* Bt; int M, N, K; };

struct StaticOrder {
    int nM, nN, nwg, G, c;
    __host__ __device__ void init(int M, int N, int G_, int c_) { nM = M / BM; nN = N / BM; nwg = nM * nN; G = G_; c = c_; }
    __host__ __device__ bool next(int i, Unit& u) const {
        const long L = (long)i * G + c; if (L >= nwg) return false;
        int wgid = (int)L; { const int q = nwg / NXCD, r = nwg % NXCD, xcd = wgid % NXCD, off = wgid / NXCD; wgid = (xcd < r ? xcd * (q + 1) : r * (q + 1) + (xcd - r) * q) + off; }
        const int nig = WGM * nN, gid = wgid / nig, fm = gid * WGM, gsz = (nM - fm) < WGM ? (nM - fm) : WGM;
        u.pm = fm + ((wgid % nig) % gsz); u.pn = (wgid % nig) / gsz; return true;
    }
    __device__ __forceinline__ void a_ready(const Unit&) const {}
    __device__ __forceinline__ void done(const Unit&) const {}
};

__device__ __forceinline__ unsigned cvt_pk_bf16(float lo, float hi) { unsigned r; asm volatile("v_cvt_pk_bf16_f32 %0, %1, %2" : "=v"(r) : "v"(lo), "v"(hi)); return r; }
typedef float f32x2 __attribute__((ext_vector_type(2)));
template <class Epi, class Sched, bool ALIGN_EPI = false, bool SP2 = false>
__device__ __forceinline__ void gemm_phase(PG8_LAS unsigned char* lds, const Gemm g, const Sched& S, const Epi& E) {
    int tid_ = threadIdx.x; asm volatile("" : "+v"(tid_));
    const int tid = tid_, wid = __builtin_amdgcn_readfirstlane(tid >> 6), lane = tid & 63, wr = wid >> 2, wc = wid & 3, fr = lane & 15, fq = lane >> 4;
    int K_ = g.K; asm volatile("" : "+s"(K_));
    const int K = K_, nt = K / BK;
    unsigned voffA[2], voffB[2];
#pragma unroll
    for (int i = 0; i < 2; ++i) { int R, C; stage_rc(tid * 16 + i * 8192, R, C); const int Rb = Epi::PERM ? ((R & ~31) + perm32(R & 31)) : R;
        voffA[i] = (unsigned)(R * K + C) * 2u; voffB[i] = (unsigned)(Rb * K + C) * 2u; }
    const size_t kstep = (size_t)(BK * 2);
    const size_t hstep = (size_t)HALF * K * 2;
    const size_t tstep = 2 * hstep;
    const unsigned ldsw = (unsigned)wid * 1024u;
    const int aoff = lds_byte(wr * 64 + fr, fq * 8), boff = lds_byte(wc * 32 + fr, fq * 8);
#define PG8_SA(b, h) (((b) * 2 + (h)) * HTB)
#define PG8_SB(b, h) ((4 + (b) * 2 + (h)) * HTB)
#define PG8_STAGE(bufoff, gbase, voff) do { _Pragma("unroll") for (int _i = 0; _i < 2; ++_i) \
        __builtin_amdgcn_global_load_lds((const unsigned*)((const char*)(gbase) + (voff)[_i]), (PG8_LAS unsigned*)(lds + (bufoff) + ldsw + _i * 8192), 16, 0, 0); } while (0)
#define PG8_LDA(dst, b, h) do { _Pragma("unroll") for (int m = 0; m < 4; ++m) _Pragma("unroll") for (int k = 0; k < 2; ++k) dst[m][k] = *(const PG8_LAS bf16x8*)(lds + PG8_SA(b, h) + aoff + m * 2048 + k * 1024); } while (0)
#define PG8_LDB(dst, b, h) do { _Pragma("unroll") for (int n = 0; n < 2; ++n) _Pragma("unroll") for (int k = 0; k < 2; ++k) dst[n][k] = *(const PG8_LAS bf16x8*)(lds + PG8_SB(b, h) + boff + n * 2048 + k * 1024); } while (0)
#define PG8_MMA(ai, bj, At, Bt) do { __builtin_amdgcn_s_setprio(1); _Pragma("unroll") for (int m = 0; m < 4; ++m) _Pragma("unroll") for (int n = 0; n < 2; ++n) _Pragma("unroll") for (int k = 0; k < 2; ++k) \
        acc[ai][bj][m][n] = __builtin_amdgcn_mfma_f32_16x16x32_bf16(Bt[n][k], At[m][k], acc[ai][bj][m][n], 0, 0, 0); __builtin_amdgcn_s_setprio(0); } while (0)
#define PG8_WAIT_V(n) asm volatile("s_waitcnt vmcnt(" #n ")" ::: "memory")
#define PG8_WAIT_L(n) asm volatile("s_waitcnt lgkmcnt(" #n ")" ::: "memory")
#define PG8_BAR __builtin_amdgcn_s_barrier()
#define PG8_SCHED __builtin_amdgcn_sched_barrier(0)
    Unit cur, nxt; int ui = 0;
    if (!S.next(0, cur)) return;
    f32x4 acc[2][2][4][2];
#pragma unroll
    for (int a = 0; a < 2; ++a)
#pragma unroll
        for (int b = 0; b < 2; ++b)
#pragma unroll
            for (int m = 0; m < 4; ++m)
#pragma unroll
                for (int n = 0; n < 2; ++n) acc[a][b][m][n] = (f32x4){0.f, 0.f, 0.f, 0.f};
    bf16x8 At[4][2], B0[2][2], B1[2][2];
    const char* cA = (const char*)g.A + (size_t)cur.pm * tstep; const char* cB = (const char*)g.Bt + (size_t)cur.pn * tstep;
    S.a_ready(cur);
    if constexpr (SP2) {
        PG8_STAGE(PG8_SB(0, 0), cB, voffB); PG8_STAGE(PG8_SB(0, 1), cB + hstep, voffB); PG8_STAGE(PG8_SA(0, 0), cA, voffA); PG8_STAGE(PG8_SA(0, 1), cA + hstep, voffA);
        if (wr == 1) PG8_BAR;
        PG8_WAIT_V(2); PG8_BAR;
        PG8_STAGE(PG8_SB(1, 0), cB + kstep, voffB); PG8_STAGE(PG8_SA(1, 0), cA + kstep, voffA); PG8_STAGE(PG8_SB(1, 1), cB + hstep + kstep, voffB);
        PG8_WAIT_V(6); PG8_BAR;
    } else {
        PG8_STAGE(PG8_SB(0, 0), cB, voffB); PG8_STAGE(PG8_SA(0, 0), cA, voffA); PG8_STAGE(PG8_SB(0, 1), cB + hstep, voffB); PG8_STAGE(PG8_SA(0, 1), cA + hstep, voffA);
        if (wr == 1) PG8_BAR;
        PG8_WAIT_V(4); PG8_BAR;
        PG8_STAGE(PG8_SB(1, 0), cB + kstep, voffB); PG8_STAGE(PG8_SA(1, 0), cA + kstep, voffA); PG8_STAGE(PG8_SB(1, 1), cB + hstep + kstep, voffB);
        PG8_WAIT_V(6); PG8_BAR;
    }
    for (;;) {
        const bool has_next = S.next(ui + 1, nxt);
        const char* nA = has_next ? (const char*)g.A + (size_t)nxt.pm * tstep : cA; const char* nB = has_next ? (const char*)g.Bt + (size_t)nxt.pn * tstep : cB;
#pragma nounroll
        for (int t = 0; t < nt; t += 2) {
            if constexpr (Epi::HOOK) E.hook(acc, cur, t, wr, wc, fr, fq);
            const bool last = (t == nt - 2);
            const char* a1 = cA + (size_t)(t + 1) * kstep;
            const char* a2 = last ? nA : cA + (size_t)(t + 2) * kstep; const char* b2 = last ? nB : cB + (size_t)(t + 2) * kstep;
            const char* a3 = a2 + kstep; const char* b3 = b2 + kstep;
            if (last && has_next) S.a_ready(nxt);
            if constexpr (SP2) {
            PG8_LDB(B0, 0, 0); PG8_LDB(B1, 0, 1); PG8_SCHED; PG8_LDA(At, 0, 0); PG8_STAGE(PG8_SA(1, 1), a1 + hstep, voffA);
            PG8_WAIT_V(8); PG8_WAIT_L(0); PG8_BAR; PG8_MMA(0, 0, At, B0); PG8_MMA(0, 1, At, B1); PG8_BAR; PG8_SCHED;
            PG8_LDA(At, 0, 1); PG8_STAGE(PG8_SB(0, 0), b2, voffB); PG8_STAGE(PG8_SB(0, 1), b2 + hstep, voffB); PG8_STAGE(PG8_SA(0, 0), a2, voffA);
            PG8_WAIT_V(8); PG8_WAIT_L(0); PG8_BAR; PG8_MMA(1, 0, At, B0); PG8_MMA(1, 1, At, B1); PG8_BAR; PG8_SCHED;
            PG8_LDB(B0, 1, 0); PG8_LDB(B1, 1, 1); PG8_SCHED; PG8_LDA(At, 1, 0); PG8_STAGE(PG8_SA(0, 1), a2 + hstep, voffA);
            PG8_WAIT_V(8); PG8_WAIT_L(0); PG8_BAR; PG8_MMA(0, 0, At, B0); PG8_MMA(0, 1, At, B1); PG8_BAR; PG8_SCHED;
            PG8_LDA(At, 1, 1); PG8_STAGE(PG8_SB(1, 0), b3, voffB); PG8_STAGE(PG8_SB(1, 1), b3 + hstep, voffB); PG8_STAGE(PG8_SA(1, 0), a3, voffA);
            PG8_WAIT_V(8); PG8_WAIT_L(0); PG8_BAR; PG8_MMA(1, 0, At, B0); PG8_MMA(1, 1, At, B1); PG8_BAR; PG8_SCHED;
            } else {
            PG8_LDB(B0, 0, 0); PG8_SCHED; PG8_LDA(At, 0, 0); PG8_STAGE(PG8_SA(1, 1), a1 + hstep, voffA);
            PG8_WAIT_L(8); PG8_BAR; PG8_WAIT_L(0); PG8_MMA(0, 0, At, B0); PG8_BAR; PG8_SCHED;
            PG8_LDB(B1, 0, 1); PG8_STAGE(PG8_SB(0, 0), b2, voffB);
            PG8_BAR; PG8_WAIT_L(0); PG8_MMA(0, 1, At, B1); PG8_BAR;
            PG8_LDA(At, 0, 1); PG8_STAGE(PG8_SA(0, 0), a2, voffA);
            PG8_BAR; PG8_WAIT_L(0); PG8_MMA(1, 0, At, B0); PG8_BAR; PG8_SCHED;
            PG8_STAGE(PG8_SB(0, 1), b2 + hstep, voffB);
            PG8_WAIT_V(6); PG8_BAR; PG8_MMA(1, 1, At, B1); PG8_BAR;
            PG8_LDB(B0, 1, 0); PG8_SCHED; PG8_LDA(At, 1, 0); PG8_STAGE(PG8_SA(0, 1), a2 + hstep, voffA);
            PG8_WAIT_L(8); PG8_BAR; PG8_WAIT_L(0); PG8_MMA(0, 0, At, B0); PG8_BAR; PG8_SCHED;
            PG8_LDB(B1, 1, 1); PG8_STAGE(PG8_SB(1, 0), b3, voffB);
            PG8_BAR; PG8_WAIT_L(0); PG8_MMA(0, 1, At, B1); PG8_BAR;
            PG8_LDA(At, 1, 1); PG8_STAGE(PG8_SA(1, 0), a3, voffA);
            PG8_BAR; PG8_WAIT_L(0); PG8_MMA(1, 0, At, B0); PG8_BAR; PG8_SCHED;
            PG8_STAGE(PG8_SB(1, 1), b3 + hstep, voffB);
            PG8_WAIT_V(6); PG8_BAR; PG8_MMA(1, 1, At, B1); PG8_BAR;
            }
        }
        if constexpr (ALIGN_EPI) { if (wr == 0) PG8_BAR; }
        if constexpr (!Epi::AFTER_DRAIN) {
            Unit ce = cur; asm volatile("" : "+s"(ce.pm), "+s"(ce.pn)); int fre = fr, fqe = fq; asm volatile("" : "+v"(fre), "+v"(fqe));
            E(acc, ce, wr, wc, fre, fqe); S.done(cur); }
        if (!has_next) break;
#pragma unroll
        for (int a = 0; a < 2; ++a)
#pragma unroll
            for (int b = 0; b < 2; ++b)
#pragma unroll
                for (int m = 0; m < 4; ++m)
#pragma unroll
                    for (int n = 0; n < 2; ++n) acc[a][b][m][n] = (f32x4){0.f, 0.f, 0.f, 0.f};
        cur = nxt; cA = nA; cB = nB; ++ui;
        if constexpr (ALIGN_EPI) { if (wr == 1) PG8_BAR; }
    }
    PG8_WAIT_V(0);
    if constexpr (!ALIGN_EPI) { if (wr == 0) PG8_BAR; }
    PG8_BAR;
    if constexpr (Epi::AFTER_DRAIN) { E.fused(acc, cur, wr, wc, fr, fq, lds, wid, lane); S.done(cur); }
#undef PG8_SA
#undef PG8_SB
#undef PG8_STAGE
#undef PG8_LDA
#undef PG8_LDB
#undef PG8_MMA
#undef PG8_WAIT_V
#undef PG8_WAIT_L
#undef PG8_BAR
#undef PG8_SCHED
}
constexpr float RMS_EPS = 1e-6f;
constexpr int MROWS_ = 16384;
constexpr float LOG2E = 1.4426950408889634f;
typedef unsigned u32x2 __attribute__((ext_vector_type(2)));
#define PG8_FENCE() asm volatile("" ::: "memory")
__device__ __forceinline__ float sum16f(const float* p) {
    const f32x4 a = *(const f32x4*)p, b = *(const f32x4*)(p + 4), c = *(const f32x4*)(p + 8), d = *(const f32x4*)(p + 12);
    return ((a[0] + a[1]) + (a[2] + a[3])) + ((b[0] + b[1]) + (b[2] + b[3])) + ((c[0] + c[1]) + (c[2] + c[3])) + ((d[0] + d[1]) + (d[2] + d[3]));
}
__device__ __forceinline__ float fast_rcp(float x) { return __builtin_amdgcn_rcpf(x); }
__device__ __forceinline__ float silu_fast(float g) { return g * fast_rcp(1.0f + __builtin_amdgcn_exp2f(-g * LOG2E)); }
__device__ __forceinline__ float sq4(const f32x4 v) { return (v[0] * v[0] + v[1] * v[1]) + (v[2] * v[2] + v[3] * v[3]); }

struct EpiUp {
    static constexpr bool PERM = true, AFTER_DRAIN = false, HOOK = false;
    unsigned char* ws; const float* bias;
    __device__ __forceinline__ void hook(f32x4 (&)[2][2][4][2], const Unit&, int, int, int, int, int) const {}
    __device__ __forceinline__ void operator()(const f32x4 (&acc)[2][2][4][2], const Unit& u, int wr, int wc, int fr, int fq) const {
        bf16_t* HID = (bf16_t*)(ws + WS_HID); const float* ssqx = (const float*)(ws + WS_SSQX);
        const int b = u.pm >> 5;
        const float* bb = bias + b * 5632 + u.pn * BM + wc * 32 + 8 * fq;
        f32x4 bg[2], bu[2];
#pragma unroll
        for (int n = 0; n < 2; ++n) { bg[n] = *(const f32x4*)(bb + 4 * n); bu[n] = *(const f32x4*)(bb + HALF + 4 * n); }
#pragma unroll
        for (int ai = 0; ai < 2; ++ai)
#pragma unroll
            for (int m = 0; m < 4; ++m) {
                const int row = u.pm * BM + ai * HALF + wr * 64 + m * 16 + fr;
                const float r = 1.0f / sqrtf(sum16f(ssqx + (size_t)row * 16) * (1.0f / 1024.0f) + RMS_EPS);
                float hv[8];
#pragma unroll
                for (int n = 0; n < 2; ++n)
#pragma unroll
                    for (int i = 0; i < 4; ++i) { const float g = acc[ai][0][m][n][i] * r + bg[n][i], uu = acc[ai][1][m][n][i] * r + bu[n][i]; hv[4 * n + i] = silu_fast(g) * uu; }
                u32x4 w; w.x = cvt_pk_bf16(hv[0], hv[1]); w.y = cvt_pk_bf16(hv[2], hv[3]); w.z = cvt_pk_bf16(hv[4], hv[5]); w.w = cvt_pk_bf16(hv[6], hv[7]);
                *(u32x4*)(HID + (size_t)row * 2816 + u.pn * HALF + wc * 32 + 8 * fq) = w;
                if (m & 1) PG8_FENCE();
            }
    }
};

template <bool HOOKED> struct EpiRes {
    static constexpr bool PERM = false, AFTER_DRAIN = false, HOOK = HOOKED;
    const float* xin; float* xout; unsigned char* ws; const float* gate; const float* gs; float coef;
    __device__ __forceinline__ void group_r(int row, float& rA, float& rB, float& rC) const {
        const float* p = (const float*)(ws + WS_SSQO) + (size_t)row * 16;
        const f32x4 a = *(const f32x4*)p, b = *(const f32x4*)(p + 4), c = *(const f32x4*)(p + 8), d = *(const f32x4*)(p + 12);
        const float sA = ((a[0] + a[1]) + (a[2] + a[3])) + (b[0] + b[1]), sB = ((b[2] + b[3]) + (c[0] + c[1])) + (c[2] + c[3]), sC = (d[0] + d[1]) + (d[2] + d[3]);
        rA = 1.0f / sqrtf(sA * (1.0f / 384.0f) + RMS_EPS); rB = 1.0f / sqrtf(sB * (1.0f / 384.0f) + RMS_EPS); rC = 1.0f / sqrtf(sC * (1.0f / 256.0f) + RMS_EPS);
    }
    __device__ __forceinline__ void hook(f32x4 (&acc)[2][2][4][2], const Unit& u, int t, int wr, int wc, int fr, int fq) const {
        if (t != 6 && t != 12) return;
        asm volatile("" : "+v"(fr));
#pragma unroll
        for (int ai = 0; ai < 2; ++ai)
#pragma unroll
            for (int m = 0; m < 4; ++m) {
                const int row = u.pm * BM + ai * HALF + wr * 64 + m * 16 + fr;
                float rA, rB, rC; group_r(row, rA, rB, rC);
                const float f = (t == 6) ? rA / rB : rB / rC;
#pragma unroll
                for (int bj = 0; bj < 2; ++bj)
#pragma unroll
                    for (int n = 0; n < 2; ++n) acc[ai][bj][m][n] = acc[ai][bj][m][n] * f;                PG8_FENCE();
            }
    }
    __device__ __forceinline__ void operator()(const f32x4 (&acc)[2][2][4][2], const Unit& u, int wr, int wc, int fr, int fq) const {
        bf16_t* xb = (bf16_t*)(ws + WS_XB); float* ssq_out = (float*)(ws + WS_SSQX); constexpr int gate_bstride = 9 * 1024;
        const int b = u.pm >> 5;
        const int col0 = u.pn * BM + wc * 32 + 4 * fq;
        f32x4 gv[2][2], gsv[2][2];
#pragma unroll
        for (int bj = 0; bj < 2; ++bj)
#pragma unroll
            for (int n = 0; n < 2; ++n) {
                gv[bj][n] = *(const f32x4*)(gate + (size_t)b * gate_bstride + col0 + bj * HALF + n * 16) * coef;
                gsv[bj][n] = gs ? *(const f32x4*)(gs + (size_t)b * 1024 + col0 + bj * HALF + n * 16) : (f32x4){0.f, 0.f, 0.f, 0.f};
            }
#pragma unroll
        for (int ai = 0; ai < 2; ++ai)
#pragma unroll
            for (int m = 0; m < 4; ++m) {
                const int row = u.pm * BM + ai * HALF + wr * 64 + m * 16 + fr;
                float rs = 1.0f;
                if (HOOKED) { float rA, rB, rC; group_r(row, rA, rB, rC); rs = rC; }
                const size_t off = (size_t)row * 1024 + col0;
                float ss = 0.f;
#pragma unroll
                for (int bj = 0; bj < 2; ++bj)
#pragma unroll
                    for (int n = 0; n < 2; ++n) {
                        const f32x4 xo = *(const f32x4*)(xin + off + bj * HALF + n * 16);
                        const f32x4 xn = xo + gv[bj][n] * (acc[ai][bj][m][n] * rs);
                        *(f32x4*)(xout + off + bj * HALF + n * 16) = xn;
                        ss += sq4(xn);
                        if (gs) { const f32x4 y = xn * gsv[bj][n]; u32x2 w; w.x = cvt_pk_bf16(y[0], y[1]); w.y = cvt_pk_bf16(y[2], y[3]); *(u32x2*)(xb + off + bj * HALF + n * 16) = w; }
                    }
                ss += __shfl_xor(ss, 16); ss += __shfl_xor(ss, 32);
                if (gs && fq == 0) ssq_out[(size_t)row * 16 + 4 * u.pn + wc] = ss;
                PG8_FENCE();
            }
    }
};

struct EpiIn {
    static constexpr bool PERM = true, AFTER_DRAIN = false, HOOK = false;
    unsigned char* ws; const float* gq; const float* gk; const float* bias;
    __device__ __forceinline__ void hook(f32x4 (&)[2][2][4][2], const Unit&, int, int, int, int, int) const {}
    __device__ __forceinline__ void operator()(const f32x4 (&acc)[2][2][4][2], const Unit& u, int wr, int wc, int fr, int fq) const {
        const int slot = u.pn * 4 + wc;
        if (slot == 7 || slot >= 30) return;
        const int b = u.pm >> 5;
        const float* ssqx = (const float*)(ws + WS_SSQX);
        bf16_t* dst = nullptr; int pitch = 0, col0 = 0; int kind = 0;
        float* ssqd = nullptr; int ssqp = 0, ssqi = 0; const float* gain = nullptr; float scale = 1.0f;
        if (slot < 4)       { dst = (bf16_t*)(ws + WS_CQ);  pitch = 256; col0 = 64 * slot;        kind = 1; ssqd = (float*)(ws + WS_SSQC);  ssqp = 4; ssqi = slot; }
        else if (slot < 6)  { dst = (bf16_t*)(ws + WS_CKV); pitch = 128; col0 = 64 * (slot - 4);  kind = 1; ssqd = (float*)(ws + WS_SSQC) + (size_t)MROWS_ * 4; ssqp = 2; ssqi = slot - 4; }
        else if (slot == 6) { kind = 3; }
        else if (slot < 14) { dst = (bf16_t*)(ws + WS_QS);  pitch = 384; col0 = 64 * (slot - 8);  kind = 2; gain = gq; scale = 0.125f * LOG2E; }
        else if (slot < 16) { dst = (bf16_t*)(ws + WS_KS);  pitch = 128; col0 = 64 * (slot - 14); kind = 2; gain = gk; }
        else if (slot < 18) { dst = (bf16_t*)(ws + WS_VS);  pitch = 128; col0 = 64 * (slot - 16); }
        else if (slot < 22) { dst = (bf16_t*)(ws + WS_QC);  pitch = 256; col0 = 64 * (slot - 18); scale = 0.125f * LOG2E; }
        else if (slot < 26) { dst = (bf16_t*)(ws + WS_KC);  pitch = 256; col0 = 64 * (slot - 22); }
        else                { dst = (bf16_t*)(ws + WS_VC);  pitch = 256; col0 = 64 * (slot - 26); }
        const float* bb = bias + b * 2048 + u.pn * BM + wc * 32 + 8 * fq;
        f32x4 bv[2][2], gn[2][2];
#pragma unroll
        for (int bj = 0; bj < 2; ++bj)
#pragma unroll
            for (int n = 0; n < 2; ++n) { bv[bj][n] = *(const f32x4*)(bb + bj * HALF + 4 * n);
                gn[bj][n] = (kind == 2) ? *(const f32x4*)(gain + 32 * bj + 8 * fq + 4 * n) * scale : (f32x4){scale, scale, scale, scale}; }
#pragma unroll
        for (int ai = 0; ai < 2; ++ai)
#pragma unroll
            for (int m = 0; m < 4; ++m) {
                const int row = u.pm * BM + ai * HALF + wr * 64 + m * 16 + fr;
                const float r = 1.0f / sqrtf(sum16f(ssqx + (size_t)row * 16) * (1.0f / 1024.0f) + RMS_EPS);
                f32x4 v[2][2]; float ss = 0.f;
#pragma unroll
                for (int bj = 0; bj < 2; ++bj)
#pragma unroll
                    for (int n = 0; n < 2; ++n) { v[bj][n] = acc[ai][bj][m][n] * r + bv[bj][n]; ss += sq4(v[bj][n]); }
                if (kind == 3) {
                    float s0 = sq4(v[0][0]) + sq4(v[0][1]);
                    s0 += __shfl_xor(s0, 16); s0 += __shfl_xor(s0, 32);
                    *(f32x4*)((float*)(ws + WS_KPE) + (size_t)row * 32 + 8 * fq) = v[0][0]; *(f32x4*)((float*)(ws + WS_KPE) + (size_t)row * 32 + 8 * fq + 4) = v[0][1];
                    if (fq == 0) ((float*)(ws + WS_SSQC) + (size_t)MROWS_ * 6)[row] = s0;
                } else {
                    if (kind != 0) { ss += __shfl_xor(ss, 16); ss += __shfl_xor(ss, 32); }
                    float rn = 1.0f;
                    if (kind == 2) rn = 1.0f / sqrtf(ss * (1.0f / 64.0f) + RMS_EPS);
                    if (kind == 1 && fq == 0) ssqd[(size_t)row * ssqp + ssqi] = ss;
#pragma unroll
                    for (int bj = 0; bj < 2; ++bj) {
                        const f32x4 y0 = v[bj][0] * gn[bj][0] * rn, y1 = v[bj][1] * gn[bj][1] * rn;
                        u32x4 w; w.x = cvt_pk_bf16(y0[0], y0[1]); w.y = cvt_pk_bf16(y0[2], y0[3]); w.z = cvt_pk_bf16(y1[0], y1[1]); w.w = cvt_pk_bf16(y1[2], y1[3]);
                        *(u32x4*)(dst + (size_t)row * pitch + col0 + 32 * bj + 8 * fq) = w;
                    }
                }
                if (m & 1) PG8_FENCE();
            }
    }
};

struct EpiUq {
    static constexpr bool PERM = false, AFTER_DRAIN = false, HOOK = false;
    unsigned char* ws;
    __device__ __forceinline__ void hook(f32x4 (&)[2][2][4][2], const Unit&, int, int, int, int, int) const {}
    __device__ __forceinline__ void operator()(const f32x4 (&acc)[2][2][4][2], const Unit& u, int wr, int wc, int fr, int fq) const {
        float* QRAW = (float*)(ws + WS_QRAW); const float* ssqcq = (const float*)(ws + WS_SSQC);
        const int col0 = u.pn * BM + wc * 32 + 4 * fq;
#pragma unroll
        for (int ai = 0; ai < 2; ++ai)
#pragma unroll
            for (int m = 0; m < 4; ++m) {
                const int row = u.pm * BM + ai * HALF + wr * 64 + m * 16 + fr;
                const f32x4 s = *(const f32x4*)(ssqcq + (size_t)row * 4);
                const float r = 1.0f / sqrtf(((s[0] + s[1]) + (s[2] + s[3])) * (1.0f / 256.0f) + RMS_EPS);
#pragma unroll
                for (int bj = 0; bj < 2; ++bj)
#pragma unroll
                    for (int n = 0; n < 2; ++n) { const int c = col0 + bj * HALF + n * 16; if (c < 576) *(f32x4*)(QRAW + (size_t)row * 576 + c) = acc[ai][bj][m][n] * r; }
            }
    }
};

struct EpiUkv {
    static constexpr bool PERM = true, AFTER_DRAIN = false, HOOK = false;
    unsigned char* ws; const float* gk;
    __device__ __forceinline__ void hook(f32x4 (&)[2][2][4][2], const Unit&, int, int, int, int, int) const {}
    __device__ __forceinline__ void operator()(const f32x4 (&acc)[2][2][4][2], const Unit& u, int wr, int wc, int fr, int fq) const {
        bf16_t* KA = (bf16_t*)(ws + WS_KA); bf16_t* VA = (bf16_t*)(ws + WS_VA); const float* ssqckv = (const float*)(ws + WS_SSQC) + (size_t)MROWS_ * 4; const float* ssqkpe = (const float*)(ws + WS_SSQC) + (size_t)MROWS_ * 6;
        const float* kpe = (const float*)(ws + WS_KPE); const float* cs = (const float*)(ws + WS_CS);
        const int h = 2 * u.pn + (wc >> 1); const bool isv = (wc & 1) != 0;
        f32x4 gn[2][2], g1 = {1.f, 1.f, 1.f, 1.f}, g2 = {1.f, 1.f, 1.f, 1.f};
        if (!isv) {
#pragma unroll
            for (int bj = 0; bj < 2; ++bj)
#pragma unroll
                for (int n = 0; n < 2; ++n) gn[bj][n] = *(const f32x4*)(gk + 32 * bj + 8 * fq + 4 * n);
            g1 = *(const f32x4*)(gk + 64 + 4 * fq); g2 = *(const f32x4*)(gk + 80 + 4 * fq);
        }
#pragma unroll
        for (int ai = 0; ai < 2; ++ai)
#pragma unroll
            for (int m = 0; m < 4; ++m) {
                const int row = u.pm * BM + ai * HALF + wr * 64 + m * 16 + fr;
                const float r = 1.0f / sqrtf((ssqckv[(size_t)row * 2] + ssqckv[(size_t)row * 2 + 1]) * (1.0f / 128.0f) + RMS_EPS);
                f32x4 v[2][2]; float ss = 0.f;
#pragma unroll
                for (int bj = 0; bj < 2; ++bj)
#pragma unroll
                    for (int n = 0; n < 2; ++n) { v[bj][n] = acc[ai][bj][m][n] * r; ss += sq4(v[bj][n]); }
                if (isv) {
#pragma unroll
                    for (int bj = 0; bj < 2; ++bj) { u32x4 w; w.x = cvt_pk_bf16(v[bj][0][0], v[bj][0][1]); w.y = cvt_pk_bf16(v[bj][0][2], v[bj][0][3]); w.z = cvt_pk_bf16(v[bj][1][0], v[bj][1][1]); w.w = cvt_pk_bf16(v[bj][1][2], v[bj][1][3]);
                        *(u32x4*)(VA + (size_t)row * 384 + 64 * h + 32 * bj + 8 * fq) = w; }
                } else {
                    ss += __shfl_xor(ss, 16); ss += __shfl_xor(ss, 32);
                    const float rk = 1.0f / sqrtf((ss + ssqkpe[row]) * (1.0f / 96.0f) + RMS_EPS);
                    bf16_t* kd = KA + (size_t)row * 576 + 96 * h;
#pragma unroll
                    for (int bj = 0; bj < 2; ++bj) { const f32x4 y0 = v[bj][0] * gn[bj][0] * rk, y1 = v[bj][1] * gn[bj][1] * rk;
                        u32x4 w; w.x = cvt_pk_bf16(y0[0], y0[1]); w.y = cvt_pk_bf16(y0[2], y0[3]); w.z = cvt_pk_bf16(y1[0], y1[1]); w.w = cvt_pk_bf16(y1[2], y1[3]);
                        *(u32x4*)(kd + 32 * bj + 8 * fq) = w; }
                    const f32x4 x1 = *(const f32x4*)(kpe + (size_t)row * 32 + 4 * fq) * g1 * rk, x2 = *(const f32x4*)(kpe + (size_t)row * 32 + 16 + 4 * fq) * g2 * rk;
                    const f32x4 c = *(const f32x4*)(cs + (size_t)row * 32 + 4 * fq), s = *(const f32x4*)(cs + (size_t)row * 32 + 16 + 4 * fq);
                    const f32x4 o1 = x1 * c - x2 * s, o2 = x2 * c + x1 * s;
                    u32x2 w1, w2; w1.x = cvt_pk_bf16(o1[0], o1[1]); w1.y = cvt_pk_bf16(o1[2], o1[3]); w2.x = cvt_pk_bf16(o2[0], o2[1]); w2.y = cvt_pk_bf16(o2[2], o2[3]);
                    *(u32x2*)(kd + 64 + 4 * fq) = w1; *(u32x2*)(kd + 80 + 4 * fq) = w2;
                }
                if (m & 1) PG8_FENCE();
            }
    }
};
}
#define GAS __attribute__((address_space(1)))
#define LAS __attribute__((address_space(3)))
typedef unsigned short bf16;
typedef unsigned v4u __attribute__((ext_vector_type(4)));
typedef float f32x4 __attribute__((ext_vector_type(4)));
typedef short bf16x8 __attribute__((ext_vector_type(8)));
typedef GAS unsigned gu32;
typedef GAS unsigned long long gu64;
#define RLX_AGENT __ATOMIC_RELAXED, __HIP_MEMORY_SCOPE_AGENT
#define LDS_WAIT() asm volatile("s_waitcnt lgkmcnt(0)" ::: "memory")
#define VM_WAIT() asm volatile("s_waitcnt vmcnt(0)" ::: "memory")
__device__ __forceinline__ unsigned long long rt() { return __builtin_amdgcn_s_memrealtime(); }
__device__ __forceinline__ unsigned f2bf(float f) { unsigned u = __builtin_bit_cast(unsigned, f); return (u + 0x7fffu + ((u >> 16) & 1u)) >> 16; }
__device__ __forceinline__ unsigned pk2(float lo, float hi) { return f2bf(lo) | (f2bf(hi) << 16); }

#define XB_TMO      128
#define XB_XCNT(j)  (256  + 64 * (j))
#define XB_XSUB(j)  (1280 + 64 * (j))
#define XB_XGEN(j)  (2304 + 64 * (j))
#define XB_TOP      3328
#define XB_TOPGEN   3392
#define XCD_BAR_WORDS 3456
#define XB_SPIN_CAP (1u << 18)

__device__ __forceinline__ unsigned xb_ld(unsigned* p)              { return __hip_atomic_load(p, __ATOMIC_RELAXED, __HIP_MEMORY_SCOPE_AGENT); }
__device__ __forceinline__ unsigned xb_add(unsigned* p, unsigned v) { return __hip_atomic_fetch_add(p, v, __ATOMIC_RELAXED, __HIP_MEMORY_SCOPE_AGENT); }
__device__ __forceinline__ unsigned xb_xcc_id() { return (unsigned)__builtin_amdgcn_s_getreg((3 << 11) | 20) & 0xFu; }
#define XB_SPIN(cond, bar) do { unsigned _sp = 0; while (cond) { __builtin_amdgcn_s_sleep(1); \
    if ((++_sp & 255u) == 0u) { if (xb_ld(&(bar)[XB_TMO])) break; if (_sp > XB_SPIN_CAP) { atomicAdd(&(bar)[XB_TMO], 1u); break; } } } } while (0)

struct XcdBarrier {
    unsigned* bar; unsigned x;
    volatile LAS unsigned* st;
};

__device__ __forceinline__ XcdBarrier xcd_barrier_post(unsigned* bar, volatile LAS unsigned* st) {
    XcdBarrier b; b.bar = bar; b.x = xb_xcc_id(); b.st = st;
    if (threadIdx.x == 0) (void)xb_add(&bar[XB_XCNT(b.x)], 1u);
    return b;
}
__device__ __forceinline__ void xcd_barrier_complete(unsigned* bar, unsigned x, unsigned& nloc, unsigned& nx) {
    const unsigned G = gridDim.x * gridDim.y * gridDim.z;
    unsigned sum, cnt, mine, sp = 0u;
    for (;;) {
        sum = 0u; cnt = 0u; mine = 0u;
#pragma unroll
        for (unsigned j = 0; j < 16; ++j) { const unsigned c = xb_ld(&bar[XB_XCNT(j)]); sum += c; cnt += (c > 0u) ? 1u : 0u; mine = (j == x) ? c : mine; }
        if (sum == G) break;
        __builtin_amdgcn_s_sleep(1);
        if ((++sp & 255u) == 0u) { if (xb_ld(&bar[XB_TMO])) break; if (sp > XB_SPIN_CAP) { atomicAdd(&bar[XB_TMO], 1u); break; } }
    }
    nloc = mine > 0u ? mine : 1u; nx = cnt > 0u ? cnt : 1u;
}

__device__ __forceinline__ void xcd_barrier(const XcdBarrier& b) {
    asm volatile("s_waitcnt vmcnt(0)" ::: "memory");
    __syncthreads();
    if (threadIdx.x == 0) {
        unsigned* bar = b.bar;
        __builtin_amdgcn_s_waitcnt(0);
        unsigned nloc = b.st[0], nx = b.st[1];
        if (nloc == 0u) { xcd_barrier_complete(bar, b.x, nloc, nx); b.st[0] = nloc; b.st[1] = nx; }
        const unsigned old = xb_add(&bar[XB_XSUB(b.x)], 1u);
        const unsigned gen = old / nloc;
        if (old + 1u == (gen + 1u) * nloc) {
            __builtin_amdgcn_fence(__ATOMIC_RELEASE, "agent");
            asm volatile("s_waitcnt vmcnt(0)" ::: "memory");
            const unsigned og = xb_add(&bar[XB_TOP], 1u);
            const unsigned tg = og / nx;
            if (og + 1u == (tg + 1u) * nx) xb_add(&bar[XB_TOPGEN], 1u);
            else XB_SPIN(xb_ld(&bar[XB_TOPGEN]) == tg, bar);
            __builtin_amdgcn_fence(__ATOMIC_ACQUIRE, "agent");
            xb_add(&bar[XB_XGEN(b.x)], 1u);
            asm volatile("s_waitcnt vmcnt(0)" ::: "memory");
        } else {
            XB_SPIN(xb_ld(&bar[XB_XGEN(b.x)]) == gen, bar);
            __builtin_amdgcn_fence(__ATOMIC_ACQUIRE, "agent");
            asm volatile("s_waitcnt vmcnt(0)" ::: "memory");
        }
    }
    __syncthreads();
}
namespace att {
typedef unsigned short bf16_t;
typedef short bf16x8 __attribute__((ext_vector_type(8)));
typedef short s16x4 __attribute__((ext_vector_type(4)));
typedef short v4i16_t __attribute__((ext_vector_type(4)));
typedef float f32x16 __attribute__((ext_vector_type(16)));
typedef float f32x4 __attribute__((ext_vector_type(4)));
typedef float f32x2 __attribute__((ext_vector_type(2)));
typedef __bf16 bf16x2_t __attribute__((ext_vector_type(2)));
typedef unsigned u32x4 __attribute__((ext_vector_type(4)));
typedef int i32x4 __attribute__((ext_vector_type(4)));
#define ALAS __attribute__((address_space(3)))
constexpr int SEQ = 8192;
constexpr float LOG2E = 1.4426950408889634f, EPS = 1e-6f;
constexpr int KCS = 1040, VHS = 4160;
constexpr int KSLOT = 12 * KCS, VSLOT = 2 * VHS;
constexpr int L_K = 0, L_V = 2 * KSLOT, L_POS = L_V + 2 * VSLOT, L_TB = L_POS + 512, L_WSF = L_TB + 128, L_OST = L_WSF + 8 * 256, L_FLAG = L_OST + 8 * 4096, L_END = L_FLAG + 16 + 64;
static_assert(L_OST % 16 == 0 && L_V % 16 == 0 && L_END <= 131072, "attention LDS map");

__device__ __forceinline__ int crow(int r, int hi) { return (r & 3) + 8 * (r >> 2) + 4 * hi; }
__device__ __forceinline__ unsigned cvtpk(float lo, float hi) { f32x2 v = {lo, hi}; bf16x2_t b = __builtin_convertvector(v, bf16x2_t); return __builtin_bit_cast(unsigned, b); }
__device__ __forceinline__ s16x4 vtr(const ALAS unsigned char* p) { return __builtin_bit_cast(s16x4, __builtin_amdgcn_ds_read_tr16_b64_v4i16((ALAS v4i16_t*)p)); }
__device__ __forceinline__ float swap_sum(float x) { auto rr = __builtin_amdgcn_permlane32_swap(__float_as_uint(x), __float_as_uint(x), false, false); return __uint_as_float(rr[0]) + __uint_as_float(rr[1]); }
__device__ __forceinline__ float swap_max(float x) { auto rr = __builtin_amdgcn_permlane32_swap(__float_as_uint(x), __float_as_uint(x), false, false); return fmaxf(__uint_as_float(rr[0]), __uint_as_float(rr[1])); }
__device__ __forceinline__ float bf2f(unsigned short h) { return __uint_as_float((unsigned)h << 16); }

struct AttnP {
    unsigned char* ws;
    const float* gq;
    const int* pos; const float* sinks; const float* relb;
};
template <int MODE> struct AttnCfg;
template <> struct AttnCfg<0> { static constexpr size_t Q = WS_QRAW, K = WS_KA, V = WS_VA; static constexpr int qpitch = 576, kpitch = 576, khs = 96, vpitch = 384, vhs = 64, ocol0 = 0, hidx0 = 0, group = 1; };
template <> struct AttnCfg<1> { static constexpr size_t Q = WS_QS, K = WS_KS, V = WS_VS; static constexpr int qpitch = 384, kpitch = 128, khs = 64, vpitch = 128, vhs = 64, ocol0 = 384, hidx0 = 6, group = 3; };
template <> struct AttnCfg<2> { static constexpr size_t Q = WS_QC, K = WS_KC, V = WS_VC; static constexpr int qpitch = 256, kpitch = 256, khs = 64, vpitch = 256, vhs = 64, ocol0 = 768, hidx0 = 12, group = 1; };

template <int DQK, int MODE>
__device__ __forceinline__ void attn_unit(ALAS unsigned char* lds, const AttnP& P, int b, int h, int qb) {
    constexpr int NCH = DQK / 8, ND0 = DQK / 16;
    int tid_ = threadIdx.x; asm volatile("" : "+v"(tid_));
    const int tid = tid_, lane = tid & 63, r32 = lane & 31, hi = lane >> 5;
    const int wid = __builtin_amdgcn_readfirstlane(tid >> 6);
    const int q0 = qb * 256, qlo = q0 + 32 * wid, qhi = qlo + 31, qrow = qlo + r32;
    const size_t rb = (size_t)b * SEQ;
    typedef AttnCfg<MODE> C; const int kvh = h / C::group;
    ALAS float* wsf = (ALAS float*)(lds + L_WSF) + wid * 64;
    ALAS unsigned char* ost = lds + L_OST + wid * 4096;
    ALAS int* posl = (ALAS int*)(lds + L_POS);
    ALAS float* tb = (ALAS float*)(lds + L_TB);

    bf16x8 qf[ND0];
    if constexpr (MODE == 0) {
        const float* qp = (const float*)(P.ws + C::Q) + (rb + qrow) * 576 + h * 96 + hi * 8;
        float qv[ND0][8]; float ss = 0.f;
#pragma unroll
        for (int d0 = 0; d0 < ND0; ++d0) { const f32x4 a = *(const f32x4*)(qp + 16 * d0), c = *(const f32x4*)(qp + 16 * d0 + 4);
#pragma unroll
            for (int i = 0; i < 4; ++i) { qv[d0][i] = a[i]; qv[d0][4 + i] = c[i]; ss += a[i] * a[i] + c[i] * c[i]; } }
        ss = swap_sum(ss);
        const float rq = 1.0f / sqrtf(ss * (1.0f / 96.0f) + EPS);
#pragma unroll
        for (int d0 = 0; d0 < ND0; ++d0) { const f32x4 ga = *(const f32x4*)(P.gq + 16 * d0 + 8 * hi), gb = *(const f32x4*)(P.gq + 16 * d0 + 8 * hi + 4);
#pragma unroll
            for (int i = 0; i < 4; ++i) { qv[d0][i] *= rq * ga[i]; qv[d0][4 + i] *= rq * gb[i]; } }
        {
            const float* cp = (const float*)(P.ws + WS_CS) + (rb + qrow) * 32 + 8 * hi;
            const f32x4 c0 = *(const f32x4*)cp, c1 = *(const f32x4*)(cp + 4), s0 = *(const f32x4*)(cp + 16), s1 = *(const f32x4*)(cp + 20);
#pragma unroll
            for (int i = 0; i < 8; ++i) { const float c = i < 4 ? c0[i & 3] : c1[i & 3], s = i < 4 ? s0[i & 3] : s1[i & 3]; const float x1 = qv[4][i], x2 = qv[5][i]; qv[4][i] = x1 * c - x2 * s; qv[5][i] = x2 * c + x1 * s; }
        }
        const float sc = 0.10206207261596575f * LOG2E;
#pragma unroll
        for (int d0 = 0; d0 < ND0; ++d0) { u32x4 w; w.x = cvtpk(qv[d0][0] * sc, qv[d0][1] * sc); w.y = cvtpk(qv[d0][2] * sc, qv[d0][3] * sc); w.z = cvtpk(qv[d0][4] * sc, qv[d0][5] * sc); w.w = cvtpk(qv[d0][6] * sc, qv[d0][7] * sc); qf[d0] = __builtin_bit_cast(bf16x8, w); }
    } else {
        const bf16_t* qp = (const bf16_t*)(P.ws + C::Q) + (rb + qrow) * C::qpitch + h * 64 + hi * 8;
#pragma unroll
        for (int d0 = 0; d0 < ND0; ++d0) qf[d0] = *(const bf16x8*)(qp + 16 * d0);
    }
    int posq = 0; float sink2 = 0.f;
    if constexpr (MODE == 1) {
        posq = P.pos[rb + qrow]; sink2 = P.sinks[h] * LOG2E;
        if (tid < 32) tb[tid] = P.relb[tid * 6 + h] * LOG2E;
    }

    int ntile, tfirst, tstep;
    if (MODE == 0) { tfirst = 0; tstep = 1; ntile = ((q0 + 255) >> 6) + 1; }
    else if (MODE == 1) { const int lo = q0 - 127 > 0 ? q0 - 127 : 0; tfirst = lo >> 6; tstep = 1; ntile = ((q0 + 255) >> 6) - tfirst + 1; }
    else { tfirst = (q0 + 254) >> 6; tstep = -1; ntile = tfirst + 1; }

    const bf16_t* Kg = (const bf16_t*)(P.ws + C::K) + rb * C::kpitch + kvh * C::khs;
    const bf16_t* Vg = (const bf16_t*)(P.ws + C::V) + rb * C::vpitch + kvh * C::vhs;
    const int kj0 = tid / NCH, kc0 = tid % NCH, kj1 = (tid + 512) / NCH, kc1 = (tid + 512) % NCH;
    const int vj = tid >> 3, vc = tid & 7;
    u32x4 kreg0, kreg1 = {0, 0, 0, 0}, vreg; int preg = 0;
#define ATT_LOAD(t) do { const int j0_ = (t) * 64; \
        kreg0 = *(const u32x4*)(Kg + (size_t)(j0_ + kj0) * C::kpitch + 8 * kc0); \
        if (NCH == 12 && tid < 256) kreg1 = *(const u32x4*)(Kg + (size_t)(j0_ + kj1) * C::kpitch + 8 * kc1); \
        vreg = *(const u32x4*)(Vg + (size_t)(j0_ + vj) * C::vpitch + 8 * vc); \
        if (MODE == 1 && tid < 64) preg = P.pos[rb + j0_ + tid]; } while (0)
#define ATT_WRITE(buf) do { ALAS unsigned char* kb_ = lds + L_K + (buf) * KSLOT; ALAS unsigned char* vb_ = lds + L_V + (buf) * VSLOT; \
        *(ALAS u32x4*)(kb_ + kc0 * KCS + kj0 * 16) = kreg0; \
        if (NCH == 12 && tid < 256) *(ALAS u32x4*)(kb_ + kc1 * KCS + kj1 * 16) = kreg1; \
        *(ALAS u32x4*)(vb_ + (vc >> 2) * VHS + vj * 64 + (vc & 3) * 16) = vreg; \
        if (MODE == 1 && tid < 64) posl[(buf) * 64 + tid] = preg; } while (0)

    f32x16 o0 = {}, o1 = {};
    float mrun = (MODE == 1) ? sink2 : -INFINITY;
    float lrun = (MODE == 1 && hi == 0) ? 1.0f : 0.f;
    float after = 0.f;
    bool walive = true;
    const int vrd = ((lane >> 4) & 1) * 32 + (lane & 3) * 8 + (4 * hi + ((lane & 15) >> 2)) * 64;

    ATT_LOAD(tfirst);
    __syncthreads();
    ATT_WRITE(0);
    __syncthreads();
    for (int it = 0; it < ntile; ++it) {
        const int t = tfirst + it * tstep, j0 = t * 64, buf = it & 1;
        if (it + 1 < ntile) ATT_LOAD(t + tstep);
        bool work, needmask;
        if (MODE == 0) { work = j0 <= qhi; needmask = j0 + 63 > qlo; }
        else if (MODE == 1) { work = (j0 <= qhi) && (j0 + 63 >= qlo - 127); needmask = true; }
        else { work = walive && (j0 < qhi); needmask = j0 + 63 >= qlo; }
        if (work) {
            const ALAS unsigned char* Kb = lds + L_K + buf * KSLOT + hi * KCS + r32 * 16;
            f32x16 p0 = {}, p1 = {};
#pragma unroll
            for (int d0 = 0; d0 < ND0; ++d0) {
                const bf16x8 a0 = *(const ALAS bf16x8*)(Kb + 2 * d0 * KCS), a1 = *(const ALAS bf16x8*)(Kb + 2 * d0 * KCS + 512);
                p0 = __builtin_amdgcn_mfma_f32_32x32x16_bf16(a0, qf[d0], p0, 0, 0, 0);
                p1 = __builtin_amdgcn_mfma_f32_32x32x16_bf16(a1, qf[d0], p1, 0, 0, 0);
            }
            if constexpr (MODE == 2) {
                float ln0[16], ln1[16];
#pragma unroll
                for (int r = 0; r < 16; ++r) {
                    const int key = j0 + crow(r, hi);
                    { const float z = p0[r]; const float sp = fmaxf(z, 0.f) + __builtin_amdgcn_logf(1.0f + __builtin_amdgcn_exp2f(-fabsf(z))); const bool ok = !needmask || key < qrow; ln0[r] = ok ? -sp : 0.f; p0[r] = ok ? z - sp : -INFINITY; }
                    { const float z = p1[r]; const float sp = fmaxf(z, 0.f) + __builtin_amdgcn_logf(1.0f + __builtin_amdgcn_exp2f(-fabsf(z))); const bool ok = !needmask || key + 32 < qrow; ln1[r] = ok ? -sp : 0.f; p1[r] = ok ? z - sp : -INFINITY; }
                }
                float run = after;
#pragma unroll
                for (int blk = 1; blk >= 0; --blk)
#pragma unroll
                    for (int g = 3; g >= 0; --g) {
                        const float own = blk ? ((ln1[4 * g] + ln1[4 * g + 1]) + (ln1[4 * g + 2] + ln1[4 * g + 3])) : ((ln0[4 * g] + ln0[4 * g + 1]) + (ln0[4 * g + 2] + ln0[4 * g + 3]));
                        auto rr = __builtin_amdgcn_permlane32_swap(__float_as_uint(own), __float_as_uint(own), false, false);
                        const float slo = __uint_as_float(rr[0]), shi = __uint_as_float(rr[1]);
                        const float e1 = run; run += shi; const float e0 = run; run += slo;
                        float aft = hi ? e1 : e0;
#pragma unroll
                        for (int i = 3; i >= 0; --i) {
                            const int r = 4 * g + i;
                            if (blk) { p1[r] = __builtin_amdgcn_exp2f(p1[r] + aft); aft += ln1[r]; } else { p0[r] = __builtin_amdgcn_exp2f(p0[r] + aft); aft += ln0[r]; }
                        }
                    }
                after = run;
                walive = __any(after > -160.0f);
            } else {
                if constexpr (MODE == 1) {
#pragma unroll
                    for (int g = 0; g < 4; ++g) {
                        const i32x4 pa = *(const ALAS i32x4*)(posl + buf * 64 + 8 * g + 4 * hi), pb = *(const ALAS i32x4*)(posl + buf * 64 + 32 + 8 * g + 4 * hi);
#pragma unroll
                        for (int i = 0; i < 4; ++i) {
                            { int n = posq - pa[i]; n = n > 0 ? n : 0; int bk = n; if (n >= 16) { bk = 16 + (int)((__builtin_amdgcn_logf((float)n) - 4.0f) * (16.0f / 3.0f)); bk = bk < 31 ? bk : 31; } p0[4 * g + i] += tb[bk]; }
                            { int n = posq - pb[i]; n = n > 0 ? n : 0; int bk = n; if (n >= 16) { bk = 16 + (int)((__builtin_amdgcn_logf((float)n) - 4.0f) * (16.0f / 3.0f)); bk = bk < 31 ? bk : 31; } p1[4 * g + i] += tb[bk]; }
                        }
                    }
                }
                if (needmask) {
#pragma unroll
                    for (int r = 0; r < 16; ++r) {
                        const int key = j0 + crow(r, hi);
                        bool ok0 = key <= qrow, ok1 = key + 32 <= qrow;
                        if (MODE == 1) { ok0 = ok0 && (key > qrow - 128); ok1 = ok1 && (key + 32 > qrow - 128); }
                        if (!ok0) p0[r] = -INFINITY; if (!ok1) p1[r] = -INFINITY;
                    }
                }
                float mt = fmaxf(p0[0], p1[0]);
#pragma unroll
                for (int r = 1; r < 16; ++r) mt = fmaxf(mt, fmaxf(p0[r], p1[r]));
                mt = swap_max(mt);
                const float mnew = fmaxf(mrun, mt);
                const float alpha = __builtin_amdgcn_exp2f(mrun - mnew);
                const bool resc = !__all(mnew == mrun);
                mrun = mnew;
                float ls = 0.f;
#pragma unroll
                for (int r = 0; r < 16; ++r) { p0[r] = __builtin_amdgcn_exp2f(p0[r] - mnew); p1[r] = __builtin_amdgcn_exp2f(p1[r] - mnew); ls += p0[r] + p1[r]; }
                lrun = lrun * alpha + ls;
                if (resc) {
                    if (hi == 0) wsf[r32] = alpha;
#pragma unroll
                    for (int g = 0; g < 4; ++g) { const f32x4 al = *(const ALAS f32x4*)(wsf + 8 * g + 4 * hi);
#pragma unroll
                        for (int i = 0; i < 4; ++i) { o0[4 * g + i] *= al[i]; o1[4 * g + i] *= al[i]; } }
                }
            }
            const ALAS unsigned char* Vb = lds + L_V + buf * VSLOT + vrd;
#pragma unroll
            for (int s = 0; s < 4; ++s) {
                u32x4 w;
                if (s < 2) { const int bs = 8 * s; w.x = cvtpk(p0[bs], p0[bs + 1]); w.y = cvtpk(p0[bs + 2], p0[bs + 3]); w.z = cvtpk(p0[bs + 4], p0[bs + 5]); w.w = cvtpk(p0[bs + 6], p0[bs + 7]); }
                else { const int bs = 8 * (s - 2); w.x = cvtpk(p1[bs], p1[bs + 1]); w.y = cvtpk(p1[bs + 2], p1[bs + 3]); w.z = cvtpk(p1[bs + 4], p1[bs + 5]); w.w = cvtpk(p1[bs + 6], p1[bs + 7]); }
                const bf16x8 pa = __builtin_bit_cast(bf16x8, w);
                const s16x4 l0 = vtr(Vb + s * 1024), h0 = vtr(Vb + s * 1024 + 512), l1 = vtr(Vb + VHS + s * 1024), h1 = vtr(Vb + VHS + s * 1024 + 512);
                const bf16x8 v0 = {l0[0], l0[1], l0[2], l0[3], h0[0], h0[1], h0[2], h0[3]}, v1 = {l1[0], l1[1], l1[2], l1[3], h1[0], h1[1], h1[2], h1[3]};
                o0 = __builtin_amdgcn_mfma_f32_32x32x16_bf16(pa, v0, o0, 0, 0, 0);
                o1 = __builtin_amdgcn_mfma_f32_32x32x16_bf16(pa, v1, o1, 0, 0, 0);
            }
        }
        if (it + 1 < ntile) ATT_WRITE(buf ^ 1);
        if (MODE == 2) {
            ALAS int* fl = (ALAS int*)(lds + L_FLAG + 16) + (it & 1) * 8;
            if (lane == 0) fl[wid] = (walive && j0 > 0) ? 1 : 0;
            __syncthreads();
            const i32x4 fa = *(const ALAS i32x4*)fl, fb = *(const ALAS i32x4*)(fl + 4);
            if (((fa[0] | fa[1]) | (fa[2] | fa[3]) | (fb[0] | fb[1]) | (fb[2] | fb[3])) == 0) break;
        } else __syncthreads();
    }
#undef ATT_LOAD
#undef ATT_WRITE
    if (MODE != 2) {
        const float lt = swap_sum(lrun);
        if (hi == 0) wsf[32 + r32] = 1.0f / lt;
#pragma unroll
        for (int g = 0; g < 4; ++g) { const f32x4 il = *(const ALAS f32x4*)(wsf + 32 + 8 * g + 4 * hi);
#pragma unroll
            for (int i = 0; i < 4; ++i) { o0[4 * g + i] *= il[i]; o1[4 * g + i] *= il[i]; } }
    }
    {
        ALAS bf16_t* stg = (ALAS bf16_t*)ost;
#pragma unroll
        for (int r = 0; r < 16; ++r) { const int orow = crow(r, hi); stg[orow * 64 + r32] = (bf16_t)(cvtpk(o0[r], 0.f) & 0xffffu); stg[orow * 64 + 32 + r32] = (bf16_t)(cvtpk(o1[r], 0.f) & 0xffffu); }
        bf16_t* Ow = (bf16_t*)(P.ws + WS_OALL) + (rb + qlo) * 1024 + C::ocol0 + h * 64;
#pragma unroll
        for (int i = 0; i < 4; ++i) {
            const int row = i * 8 + (lane >> 3), ch = lane & 7;
            const u32x4 v = *(const ALAS u32x4*)(stg + row * 64 + ch * 8);
            float ss = 0.f;
#pragma unroll
            for (int k = 0; k < 4; ++k) { const unsigned w = v[k]; const float a = __uint_as_float(w << 16), c = __uint_as_float(w & 0xffff0000u); ss += a * a + c * c; }
            ss += __shfl_xor(ss, 1); ss += __shfl_xor(ss, 2); ss += __shfl_xor(ss, 4);
            *(u32x4*)(Ow + (size_t)row * 1024 + ch * 8) = v;
            if (ch == 0) ((float*)(P.ws + WS_SSQO))[(rb + qlo + row) * 16 + C::hidx0 + h] = ss;
        }
    }
}
#undef ALAS
}
struct Args { const void* in[23]; float* out; unsigned char* ws; int ph_lo, ph_hi, li, adapt; };

struct Frame { LAS unsigned char* lds; int tid, lane, wave, vcu, G; };

__device__ __forceinline__ float wave_sum64(float v) {
#pragma unroll
    for (int o = 1; o < 64; o <<= 1) v += __shfl_xor(v, o);
    return v;
}

__device__ __forceinline__ void tr_item(const float* W, int ldn, int K, pg8::bf16_t* WT, int kb, int g, int srccol, const float* kgain, LAS float* scr, int lane) {
    const int k0 = 64 * kb;
#pragma unroll 8
    for (int i = 0; i < 32; ++i) { const int kk = 2 * i + (lane >> 5); float v = 0.f; if (srccol >= 0) v = W[(size_t)(k0 + kk) * ldn + srccol + (lane & 31)]; if (kgain) v *= kgain[k0 + kk]; scr[kk * 33 + (lane & 31)] = v; }
    asm volatile("s_waitcnt lgkmcnt(0)" ::: "memory");
    const int c = lane & 7;
#pragma unroll
    for (int j = 0; j < 4; ++j) { const int n = (lane >> 3) + 8 * j; const LAS float* s = scr + (8 * c) * 33 + n;
        v4u o; o.x = pk2(s[0 * 33], s[1 * 33]); o.y = pk2(s[2 * 33], s[3 * 33]); o.z = pk2(s[4 * 33], s[5 * 33]); o.w = pk2(s[6 * 33], s[7 * 33]);
        *(GAS v4u*)(WT + (size_t)(32 * g + n) * K + k0 + 8 * c) = o; }
    asm volatile("s_waitcnt lgkmcnt(0)" ::: "memory");
}
__device__ __forceinline__ int in_slot_src(int slot, int& cnt) {
    cnt = 64;
    if (slot < 4) return 64 * slot;
    if (slot < 6) return 256 + 64 * (slot - 4);
    if (slot == 6) { cnt = 32; return 384; }
    if (slot == 7) return -1;
    if (slot < 14) return 416 + 64 * (slot - 8);
    if (slot < 16) return 800 + 64 * (slot - 14);
    if (slot < 18) return 928 + 64 * (slot - 16);
    if (slot < 22) return 1056 + 64 * (slot - 18);
    if (slot < 26) return 1312 + 64 * (slot - 22);
    if (slot < 30) return 1568 + 64 * (slot - 26);
    return -1;
}

#define A_X        ((const float*)args.in[0])
#define A_C        ((const float*)args.in[1])
#define A_POS      ((const int*)args.in[2])
#define A_RELB     ((const float*)args.in[3])
#define A_NORMG    ((const float*)args.in[4])
#define A_WMOD     ((const float*)args.in[5])
#define A_BMOD     ((const float*)args.in[6])
#define A_WGU1     ((const float*)args.in[7])
#define A_WD1      ((const float*)args.in[8])
#define A_WIN      ((const float*)args.in[9])
#define A_QAN      ((const float*)args.in[10])
#define A_KVAN     ((const float*)args.in[11])
#define A_WUQ      ((const float*)args.in[12])
#define A_WUKV     ((const float*)args.in[13])
#define A_MLAQN    ((const float*)args.in[14])
#define A_MLAKN    ((const float*)args.in[15])
#define A_SWAQN    ((const float*)args.in[16])
#define A_SWAKN    ((const float*)args.in[17])
#define A_SINKS    ((const float*)args.in[18])
#define A_OUTN     ((const float*)args.in[19])
#define A_WOUT     ((const float*)args.in[20])
#define A_WGU2     ((const float*)args.in[21])
#define A_WD2      ((const float*)args.in[22])
#define WSP(off)   (ws_ + (off))
#define MOD ((float*)WSP(WS_MOD))
#define GS ((float*)WSP(WS_GS))
#define BIAS ((float*)WSP(WS_BIAS))
#define SSQX ((float*)WSP(WS_SSQX))
#define SSQO ((float*)WSP(WS_SSQO))
#define CS ((float*)WSP(WS_CS))
#define KPE ((float*)WSP(WS_KPE))
#define SSQ_CQ ((float*)WSP(WS_SSQC))
#define SSQ_CKV ((float*)WSP(WS_SSQC) + (size_t)MROWS * 4)
#define SSQ_KPE ((float*)WSP(WS_SSQC) + (size_t)MROWS * 6)
#define XB ((pg8::bf16_t*)WSP(WS_XB))
#define HID ((pg8::bf16_t*)WSP(WS_HID))
#define CQ ((pg8::bf16_t*)WSP(WS_CQ))
#define CKV ((pg8::bf16_t*)WSP(WS_CKV))
#define KA ((pg8::bf16_t*)WSP(WS_KA))
#define VA ((pg8::bf16_t*)WSP(WS_VA))
#define QS ((pg8::bf16_t*)WSP(WS_QS))
#define KS ((pg8::bf16_t*)WSP(WS_KS))
#define VS ((pg8::bf16_t*)WSP(WS_VS))
#define QC ((pg8::bf16_t*)WSP(WS_QC))
#define KC ((pg8::bf16_t*)WSP(WS_KC))
#define VC ((pg8::bf16_t*)WSP(WS_VC))
#define OALL ((pg8::bf16_t*)WSP(WS_OALL))
#define QRAW ((float*)WSP(WS_QRAW))

__device__ __forceinline__ void phase_pro0(Frame& F, const Args& args) {
    unsigned char* ws_ = args.ws; asm volatile("" : "+s"(ws_));
    {
        LAS float* cond = (LAS float*)F.lds;
        LAS float* red = (LAS float*)(F.lds + 8192);
        for (int i = F.tid; i < 2 * DM; i += 512) { const float cv = A_C[i]; cond[i] = cv / (1.0f + expf(-cv)); }
        __syncthreads();
        for (int u = blockIdx.x; u < DEPTH * (NMOD / 64); u += F.G) {
            const int l = u / (NMOD / 64), n0 = (u % (NMOD / 64)) * 64;
            const float* w = A_WMOD + (size_t)l * DM * NMOD + n0 + F.lane;
            float a0 = 0.f, a1 = 0.f;
#pragma unroll 8
            for (int k = 0; k < 128; ++k) { const int kk = F.wave * 128 + k; const float wv = w[(size_t)kk * NMOD]; a0 += cond[kk] * wv; a1 += cond[DM + kk] * wv; }
            red[(F.wave * 2 + 0) * 64 + F.lane] = a0; red[(F.wave * 2 + 1) * 64 + F.lane] = a1;
            __syncthreads();
            if (F.tid < 128) { const int bb = F.tid >> 6, ln = F.tid & 63; float s = 0.f;
#pragma unroll
                for (int wv = 0; wv < 8; ++wv) s += red[(wv * 2 + bb) * 64 + ln];
                MOD[((size_t)l * 2 + bb) * NMOD + n0 + ln] = s + A_BMOD[(size_t)l * NMOD + n0 + ln]; }
            __syncthreads();
        }
    }
    {
        for (int i = blockIdx.x * 512 + F.tid; i < MROWS * 16; i += F.G * 512) {
            const int m = i >> 4, j = i & 15;
            const float freq = powf(10000.0f, -(float)j / 16.0f);
            const float ang = (float)A_POS[m] * freq;
            CS[(size_t)m * 32 + j] = cosf(ang); CS[(size_t)m * 32 + 16 + j] = sinf(ang);
        }
    }
    {
        __syncthreads();
        LAS float* scr = (LAS float*)(F.lds + F.wave * 16384);
        const int gw = F.vcu * NWAVES + F.wave, NGW = F.G * NWAVES;
        constexpr int I_GU = 16 * 176, I_D = 44 * 32, I_IN = 16 * 64, I_UQ = 4 * 24, I_UKV = 2 * 24, I_OUT = 16 * 32;
        constexpr int I_L = 2 * I_GU + 2 * I_D + I_IN + I_UQ + I_UKV + I_OUT;
        for (int it = gw; it < DEPTH * I_L; it += NGW) {
            const int l = it / I_L; int r = it % I_L;
            pg8::bf16_t* wl = (pg8::bf16_t*)(ws_ + WS_W + (size_t)l * WL);
            if (r < 2 * I_GU) {
                const bool second = r >= I_GU; if (second) r -= I_GU;
                const int kb = r / 176, g = r % 176, t = g >> 3, rr = g & 7;
                const float* W = (second ? A_WGU2 : A_WGU1) + (size_t)l * DM * 2 * DFF;
                tr_item(W, 2 * DFF, DM, (pg8::bf16_t*)((unsigned char*)wl + (second ? W_GU2 : W_GU1)), kb, g, (rr >> 2) * DFF + 128 * t + 32 * (rr & 3), nullptr, scr, F.lane); continue; }
            r -= 2 * I_GU;
            if (r < 2 * I_D) { const bool second = r >= I_D; if (second) r -= I_D; const int kb = r / 32, g = r % 32;
                tr_item((second ? A_WD2 : A_WD1) + (size_t)l * DFF * DM, DM, DFF, (pg8::bf16_t*)((unsigned char*)wl + (second ? W_D2 : W_D1)), kb, g, 32 * g, nullptr, scr, F.lane); continue; }
            r -= 2 * I_D;
            if (r < I_IN) { const int kb = r / 64, g = r % 64, tile = g >> 3, rr = g & 7, bj = rr >> 2, wc = rr & 3; int cnt; const int base = in_slot_src(tile * 4 + wc, cnt);
                tr_item(A_WIN + (size_t)l * DM * DIN, DIN, DM, (pg8::bf16_t*)((unsigned char*)wl + W_IN), kb, g, (base >= 0 && 32 * bj < cnt) ? base + 32 * bj : -1, nullptr, scr, F.lane); continue; }
            r -= I_IN;
            if (r < I_UQ) { const int kb = r / 24, g = r % 24;
                tr_item(A_WUQ + (size_t)l * 256 * 576, 576, 256, (pg8::bf16_t*)((unsigned char*)wl + W_UQ), kb, g, g < 18 ? 32 * g : -1, A_QAN + l * 256, scr, F.lane); continue; }
            r -= I_UQ;
            if (r < I_UKV) { const int kb = r / 24, g = r % 24, tile = g >> 3, rr = g & 7, bj = rr >> 2, wc = rr & 3;
                tr_item(A_WUKV + (size_t)l * 128 * 768, 768, 128, (pg8::bf16_t*)((unsigned char*)wl + W_UKV), kb, g, 256 * tile + 64 * wc + 32 * bj, A_KVAN + l * 128, scr, F.lane); continue; }
            r -= I_UKV;
            { const int kb = r / 32, g = r % 32;
                tr_item(A_WOUT + (size_t)l * DM * DM, DM, DM, (pg8::bf16_t*)((unsigned char*)wl + W_OUT), kb, g, 32 * g, A_OUTN + l * DM, scr, F.lane); }
        }
    }
}

__device__ __forceinline__ void x_to_xb(Frame& F, const Args& args, const float* xsrc, int l, int i) {
    unsigned char* ws_ = args.ws; asm volatile("" : "+s"(ws_));
    const int gw = F.vcu * NWAVES + F.wave, NGW = F.G * NWAVES;
    for (int m = gw; m < MROWS; m += NGW) {
        const int b = m >> 13;
        const GAS f32x4* xr = (const GAS f32x4*)(xsrc + (size_t)m * DM) + F.lane;
        const f32x4* gr = (const f32x4*)(A_NORMG + ((size_t)l * 3 + i) * DM) + F.lane;
        const f32x4* sr = (const f32x4*)(MOD + ((size_t)l * 2 + b) * NMOD + (3 * i + 1) * DM) + F.lane;
        float s = 0.f;
        GAS unsigned long long* o8 = (GAS unsigned long long*)(XB + (size_t)m * DM) + F.lane;
#pragma unroll
        for (int j = 0; j < 4; ++j) { const f32x4 v = xr[64 * j]; s += (v.x * v.x + v.y * v.y) + (v.z * v.z + v.w * v.w);
            const f32x4 g = gr[64 * j] * (sr[64 * j] + 1.0f); const f32x4 y = v * g;
            o8[64 * j] = (unsigned long long)pk2(y.x, y.y) | ((unsigned long long)pk2(y.z, y.w) << 32); }
        s = wave_sum64(s);
        if (F.lane < 16) SSQX[(size_t)m * 16 + F.lane] = (F.lane == 0) ? s : 0.f;
    }
}

__device__ __forceinline__ void phase_pro1(Frame& F, const Args& args) {
    unsigned char* ws_ = args.ws; asm volatile("" : "+s"(ws_));
    for (int i = blockIdx.x * 512 + F.tid; i < DEPTH * 3 * 2 * DM; i += F.G * 512) {
        const int cidx = i & 1023, b = (i >> 10) & 1, li = i >> 11, l = li / 3, ii = li % 3;
        GS[i] = A_NORMG[((size_t)l * 3 + ii) * DM + cidx] * (1.0f + MOD[((size_t)l * 2 + b) * NMOD + (3 * ii + 1) * DM + cidx]);
    }
    const int gw = F.vcu * NWAVES + F.wave, NGW = F.G * NWAVES;
    constexpr int RL = 5632 + 2048 + 5632;
    for (int it = gw; it < DEPTH * RL; it += NGW) {
        const int l = it / RL; int r = it % RL; int which, nrow; size_t woff; size_t boff;
        if (r < 5632) { which = 0; nrow = 5632; woff = W_GU1; boff = 0; } else if (r < 5632 + 2048) { r -= 5632; which = 1; nrow = 2048; woff = W_IN; boff = 2 * 5632; } else { r -= 5632 + 2048; which = 2; nrow = 5632; woff = W_GU2; boff = 2 * (5632 + 2048); }
        const pg8::bf16_t* wr = (const pg8::bf16_t*)(ws_ + WS_W + (size_t)l * WL + woff) + (size_t)r * DM;
        float a0 = 0.f, a1 = 0.f;
#pragma unroll
        for (int j = 0; j < 2; ++j) {
            const v4u wv = *(const GAS v4u*)(wr + j * 512 + F.lane * 8);
            const float* s0 = MOD + ((size_t)l * 2 + 0) * NMOD + (3 * which) * DM + j * 512 + F.lane * 8; const float* s1 = s0 + NMOD;
#pragma unroll
            for (int k = 0; k < 4; ++k) { const unsigned w = wv[k]; const float lo = __uint_as_float(w << 16), hi = __uint_as_float(w & 0xffff0000u);
                a0 += lo * s0[2 * k] + hi * s0[2 * k + 1]; a1 += lo * s1[2 * k] + hi * s1[2 * k + 1]; }
        }
        a0 = wave_sum64(a0); a1 = wave_sum64(a1);
        if (F.lane == 0) { BIAS[(size_t)l * BIAS_L + boff + r] = a0; BIAS[(size_t)l * BIAS_L + boff + nrow + r] = a1; }
    }
    x_to_xb(F, args, A_X, 0, 0);
}

__device__ __forceinline__ int next_unit(Frame& F, gu32* head) {
    LAS int* slot = (LAS int*)(F.lds + att::L_FLAG);
    __syncthreads();
    if (F.tid == 0) slot[0] = (int)__hip_atomic_fetch_add(head, 1u, __ATOMIC_RELAXED, __HIP_MEMORY_SCOPE_AGENT);
    __syncthreads();
    return slot[0];
}

#ifndef PHM
#define PHM 255
#endif
#ifndef PHM2
#define PHM2 15
#endif
__global__ void __launch_bounds__(NWAVES * 64, 2) fwd_mega(Args args) {
    extern __shared__ __attribute__((aligned(16))) unsigned char lds[];
    Frame F; F.lds = (LAS unsigned char*)lds; F.tid = threadIdx.x; F.lane = F.tid & 63; F.wave = __builtin_amdgcn_readfirstlane(F.tid >> 6);
    F.G = gridDim.x; { const int bx = blockIdx.x; F.vcu = (F.G % 8 == 0) ? (bx % 8) * (F.G / 8) + bx / 8 : bx; }
    gu32* ctl = (gu32*)(args.ws + WS_CTL);
    for (int u = F.tid; u < (LDS_BYTES - LDSCTL_OFF) / 4; u += NWAVES * 64) ((LAS unsigned*)(F.lds + LDSCTL_OFF))[u] = 0u;
    __syncthreads();
    if (args.adapt >= 0) { x_to_xb(F, args, args.out, args.adapt / 3, args.adapt % 3); return; }
    const int lo = args.ph_lo, hi = args.ph_hi;
    XcdBarrier bar; bar.bar = (unsigned*)(ctl + CW_BAR) + args.li * XCD_BAR_WORDS; bar.x = 0; bar.st = nullptr;
    if (hi - lo > 1) bar = xcd_barrier_post((unsigned*)(ctl + CW_BAR) + args.li * XCD_BAR_WORDS, (volatile LAS unsigned*)(F.lds + MISC_OFF) + 8);

    for (int ph = lo; ph < hi; ++ph) {
        { int t_ = threadIdx.x; asm volatile("" : "+v"(t_)); F.tid = t_; F.lane = t_ & 63; F.wave = __builtin_amdgcn_readfirstlane(t_ >> 6); }
        unsigned char* ws_ = args.ws; asm volatile("" : "+s"(ws_));
        if ((PHM & 64) && ph == 0) phase_pro0(F, args);
        else if ((PHM & 128) && ph == 1) phase_pro1(F, args);
        else {
            const int l = (ph - 2) >> 3, s = (ph - 2) & 7;
            const unsigned char* wl = ws_ + WS_W + (size_t)l * WL;
            const float* biasl = BIAS + (size_t)l * BIAS_L;
            const float* modl = MOD + (size_t)l * 2 * NMOD;
            if ((PHM & 1) && (s == 0 || s == 6)) {
                pg8::Gemm g{XB, (const pg8::bf16_t*)(wl + (s == 0 ? W_GU1 : W_GU2)), MROWS, 5632, DM}; pg8::StaticOrder S; S.init(MROWS, 5632, F.G, (int)blockIdx.x);
                pg8::EpiUp E{ws_, biasl + (s == 0 ? 0 : 2 * (5632 + 2048))};
                pg8::gemm_phase<pg8::EpiUp, pg8::StaticOrder, true, true>(F.lds, g, S, E);
            } else if ((PHM & 2) && (s == 1 || s == 7)) {
                pg8::Gemm g{HID, (const pg8::bf16_t*)(wl + (s == 1 ? W_D1 : W_D2)), MROWS, DM, DFF}; pg8::StaticOrder S; S.init(MROWS, DM, F.G, (int)blockIdx.x);
                const bool lastp = (s == 7 && l == DEPTH - 1);
                const float* gsn = lastp ? nullptr : (s == 1 ? GS + ((size_t)(l * 3 + 1) * 2) * DM : GS + ((size_t)((l + 1) * 3 + 0) * 2) * DM);
                const float* xin = (s == 1 && l == 0) ? A_X : args.out;
                pg8::EpiRes<false> E{xin, args.out, ws_, modl + (s == 1 ? 2 : 8) * DM, gsn, 0.5f};
                pg8::gemm_phase<pg8::EpiRes<false>, pg8::StaticOrder, true, true>(F.lds, g, S, E);
            } else if ((PHM & 4) && s == 2) {
                pg8::Gemm g{XB, (const pg8::bf16_t*)(wl + W_IN), MROWS, 2048, DM}; pg8::StaticOrder S; S.init(MROWS, 2048, F.G, (int)blockIdx.x);
                pg8::EpiIn E{ws_, A_SWAQN + l * 64, A_SWAKN + l * 64, biasl + 2 * 5632};
                pg8::gemm_phase<pg8::EpiIn, pg8::StaticOrder, true, true>(F.lds, g, S, E);
            } else if ((PHM & 8) && s == 3) {
                if (PHM2 & 1) { pg8::Gemm g{CQ, (const pg8::bf16_t*)(wl + W_UQ), MROWS, 768, 256}; pg8::StaticOrder S; S.init(MROWS, 768, F.G, (int)blockIdx.x);
                  pg8::EpiUq E{ws_}; pg8::gemm_phase<pg8::EpiUq, pg8::StaticOrder, true, true>(F.lds, g, S, E); }
                if (PHM2 & 2) { pg8::Gemm g{CKV, (const pg8::bf16_t*)(wl + W_UKV), MROWS, 768, 128}; pg8::StaticOrder S; S.init(MROWS, 768, F.G, (int)((blockIdx.x + 64) % F.G));
                  pg8::EpiUkv E{ws_, A_MLAKN + l * 96}; pg8::gemm_phase<pg8::EpiUkv, pg8::StaticOrder, true, true>(F.lds, g, S, E); }
                att::AttnP PB{ws_, nullptr, A_POS, A_SINKS + l * 6, A_RELB};
                att::AttnP PC{ws_, nullptr, nullptr, nullptr, nullptr};
                gu32* head = ctl + CW_Q + 64 * (2 * l);
                for (;;) { const int u = next_unit(F, head); if (u >= 256 + 384) break;
                    if ((PHM2 & 4) && u < 256) { const int qb = 31 - (u >> 3), bh = u & 7; att::attn_unit<64, 2>(F.lds, PC, bh >> 2, bh & 3, qb); }
                    else if (PHM2 & 8) { const int v = u - 256, qb = v / 12, bh = v % 12; att::attn_unit<64, 1>(F.lds, PB, bh / 6, bh % 6, qb); } }
            } else if ((PHM & 16) && s == 4) {
                att::AttnP PA{ws_, A_MLAQN + l * 96, nullptr, nullptr, nullptr};
                gu32* head = ctl + CW_Q + 64 * (2 * l + 1);
                for (;;) { const int u = next_unit(F, head); if (u >= 384) break; const int qb = 31 - u / 12, bh = u % 12; att::attn_unit<96, 0>(F.lds, PA, bh / 6, bh % 6, qb); }
            } else if ((PHM & 32) && s == 5) {
                pg8::Gemm g{OALL, (const pg8::bf16_t*)(wl + W_OUT), MROWS, DM, DM}; pg8::StaticOrder S; S.init(MROWS, DM, F.G, (int)blockIdx.x);
                pg8::EpiRes<true> E{args.out, args.out, ws_, modl + 5 * DM, GS + ((size_t)(l * 3 + 2) * 2) * DM, 1.0f};
                pg8::gemm_phase<pg8::EpiRes<true>, pg8::StaticOrder, true, true>(F.lds, g, S, E);
            }
        }
        if (ph + 1 < hi) xcd_barrier(bar);
    }
}
#ifndef HYB
#define HYB 0
#endif
static void launch_fwd(hipStream_t stream, Args a, int grid, int lo, int hi, int li, int adapt) {
    a.ph_lo = lo; a.ph_hi = hi; a.li = li; a.adapt = adapt;
    hipLaunchKernelGGL(fwd_mega, dim3(grid), dim3(NWAVES * 64), LDS_BYTES, stream, a);
}
extern "C" void kernel_launch(void* const* d_in, const int* in_sizes, int n_in, void* d_out, int out_size, void* d_ws, size_t ws_size, hipStream_t stream) {
    static int grid = 0;
    if (grid == 0) {
        if (n_in != 23 || out_size != MROWS * DM || ws_size < WS_END) { fprintf(stderr, "kernel_launch: unexpected problem (n_in %d, out %d, ws %zu < %zu)\n", n_in, out_size, ws_size, (size_t)WS_END); grid = -1; return; }
        int dev = 0, cus = 0, per_cu = 0;
        if (hipGetDevice(&dev) != hipSuccess || hipDeviceGetAttribute(&cus, hipDeviceAttributeMultiprocessorCount, dev) != hipSuccess) { grid = -1; return; }
        if (hipFuncSetAttribute((const void*)fwd_mega, hipFuncAttributeMaxDynamicSharedMemorySize, LDS_BYTES) != hipSuccess) { fprintf(stderr, "kernel_launch: hipFuncSetAttribute failed\n"); grid = -1; return; }
        if (hipOccupancyMaxActiveBlocksPerMultiprocessor(&per_cu, (const void*)fwd_mega, NWAVES * 64, LDS_BYTES) != hipSuccess || per_cu < 1) { fprintf(stderr, "kernel_launch: occupancy query says %d blocks per CU\n", per_cu); (void)hipGetLastError(); grid = -1; return; }
        grid = cus;
    }
    if (grid < 0) return;
    (void)hipMemsetAsync((char*)d_ws + WS_CTL, 0, CTL_ZERO_BYTES, stream);
    Args a{};
    for (int i = 0; i < 23; ++i) a.in[i] = d_in[i];
    a.out = (float*)d_out; a.ws = (unsigned char*)d_ws;
#if HYB == 0
    launch_fwd(stream, a, grid, 0, NPH, 0, -1);
#elif HYB == 1
    for (int ph = 0; ph < NPH; ++ph) launch_fwd(stream, a, grid, ph, ph + 1, 0, -1);
#else
    {
        using namespace nv;
        const float* x = (const float*)d_in[0]; const int* positions = (const int*)d_in[2];
        const float* rel_bias = (const float*)d_in[3]; const float* norm_g = (const float*)d_in[4];
        const float* w_ffn1_gu = (const float*)d_in[7]; const float* w_ffn1_down = (const float*)d_in[8]; const float* w_in = (const float*)d_in[9];
        const float* q_a_norm = (const float*)d_in[10]; const float* kv_a_norm = (const float*)d_in[11]; const float* w_uq = (const float*)d_in[12]; const float* w_ukv = (const float*)d_in[13];
        const float* mla_q_norm = (const float*)d_in[14]; const float* mla_k_norm = (const float*)d_in[15]; const float* swa_q_norm = (const float*)d_in[16]; const float* swa_k_norm = (const float*)d_in[17];
        const float* sinks = (const float*)d_in[18]; const float* out_norm = (const float*)d_in[19]; const float* w_out = (const float*)d_in[20];
        const float* w_ffn2_gu = (const float*)d_in[21]; const float* w_ffn2_down = (const float*)d_in[22];
        float* out = (float*)d_out; char* ws = (char*)d_ws;
        float* mod = (float*)(ws + WS_MOD);
        char* nb = ws + WS_XB;
        float* H = (float*)(nb); float* HIDn = (float*)(nb + 33 * MiB); float* P = (float*)(nb + 33 * MiB); float* QA = (float*)(nb + 91 * MiB); float* KVRAW = (float*)(nb + 110 * MiB);
        float* KAn = (float*)(nb + 135 * MiB); float* CQN = (float*)(nb + 154 * MiB); float* CKVN = (float*)(nb + 163 * MiB); float* QB = (float*)(nb + 168 * MiB); float* KBn = (float*)(nb + 181 * MiB);
        launch_fwd(stream, a, grid, 0, 1, 0, -1); launch_fwd(stream, a, grid, 1, 2, 0, -1);
        auto naive_ffn = [&](int l, int i, const float* xsrc) {
            for (int b = 0; b < BATCH; ++b) {
                float* xb = out + (size_t)b * nv::SEQ * nv::D; const float* xs = xsrc + (size_t)b * nv::SEQ * nv::D; const float* modlb = mod + ((size_t)l * 2 + b) * nv::NMOD;
                const float* wgu = (i == 0 ? w_ffn1_gu : w_ffn2_gu) + (size_t)l * nv::D * 2 * nv::DFF; const float* wdn = (i == 0 ? w_ffn1_down : w_ffn2_down) + (size_t)l * nv::DFF * nv::D;
                const float* sh = modlb + (3 * i) * nv::D; const float* sc = modlb + (3 * i + 1) * nv::D; const float* gt = modlb + (3 * i + 2) * nv::D;
                k_normmod<<<nv::SEQ / 4, 256, 0, stream>>>(xs, norm_g + ((size_t)l * 3 + i) * nv::D, sh, sc, H, nv::SEQ);
                k_gemm<true, 0><<<dim3(nv::DFF / 128, nv::SEQ / 128), 256, 0, stream>>>(H, nv::D, wgu, wgu + nv::DFF, 2 * nv::DFF, HIDn, nv::DFF, nv::DFF, nv::D, nullptr, nullptr, 0.f);
                k_gemm<false, 1><<<dim3(nv::D / 128, nv::SEQ / 128), 256, 0, stream>>>(HIDn, nv::DFF, wdn, nullptr, nv::D, xb, nv::D, nv::D, nv::DFF, xs, gt, 0.5f);
            }
        };
        auto naive_mixer = [&](int l) {
            for (int b = 0; b < BATCH; ++b) {
                float* xb = out + (size_t)b * nv::SEQ * nv::D; const int* posb = positions + b * nv::SEQ; const float* modlb = mod + ((size_t)l * 2 + b) * nv::NMOD;
                const float* sh = modlb + 3 * nv::D; const float* sc = modlb + 4 * nv::D; const float* gt = modlb + 5 * nv::D;
                k_normmod<<<nv::SEQ / 4, 256, 0, stream>>>(xb, norm_g + ((size_t)l * 3 + 1) * nv::D, sh, sc, H, nv::SEQ);
                k_gemm<false, 0><<<dim3((nv::DIN + 127) / 128, nv::SEQ / 128), 256, 0, stream>>>(H, nv::D, w_in + (size_t)l * nv::D * nv::DIN, nullptr, nv::DIN, P, nv::DIN, nv::DIN, nv::D, nullptr, nullptr, 0.f);
                k_headnorm<<<nv::SEQ / 4, 256, 0, stream>>>(P, nv::DIN, 0, 256, nullptr, 0, 0, 0, q_a_norm + l * 256, CQN, 256, 256, 1, nv::SEQ, posb, 0, 1);
                k_headnorm<<<nv::SEQ / 4, 256, 0, stream>>>(P + 256, nv::DIN, 0, 128, nullptr, 0, 0, 0, kv_a_norm + l * 128, CKVN, 128, 128, 1, nv::SEQ, posb, 0, 1);
                k_gemm<false, 0><<<dim3((576 + 127) / 128, nv::SEQ / 128), 256, 0, stream>>>(CQN, 256, w_uq + (size_t)l * 256 * 576, nullptr, 576, QA, 576, 576, 256, nullptr, nullptr, 0.f);
                k_gemm<false, 0><<<dim3(768 / 128, nv::SEQ / 128), 256, 0, stream>>>(CKVN, 128, w_ukv + (size_t)l * 128 * 768, nullptr, 768, KVRAW, 768, 768, 128, nullptr, nullptr, 0.f);
                k_headnorm<<<nv::SEQ * 6 / 4, 256, 0, stream>>>(QA, 576, 96, 96, nullptr, 0, 0, 0, mla_q_norm + l * 96, QA, 576, 96, 6, nv::SEQ, posb, 1, 1);
                k_headnorm<<<nv::SEQ * 6 / 4, 256, 0, stream>>>(KVRAW, 768, 128, 64, P + 384, nv::DIN, 0, 32, mla_k_norm + l * 96, KAn, 576, 96, 6, nv::SEQ, posb, 1, 1);
                k_headnorm<<<nv::SEQ * 6 / 4, 256, 0, stream>>>(P + 416, nv::DIN, 64, 64, nullptr, 0, 0, 0, swa_q_norm + l * 64, QB, 384, 64, 6, nv::SEQ, posb, 0, 1);
                k_headnorm<<<nv::SEQ * 2 / 4, 256, 0, stream>>>(P + 800, nv::DIN, 64, 64, nullptr, 0, 0, 0, swa_k_norm + l * 64, KBn, 128, 64, 2, nv::SEQ, posb, 0, 1);
                k_attn<96, 64, 0><<<dim3(nv::SEQ / 256, 6), 256, 0, stream>>>(QA, 576, 96, KAn, 576, 96, KVRAW + 64, 768, 128, H, nv::D, 0, 1, posb, nullptr, nullptr, 6);
                k_attn<64, 64, 1><<<dim3(nv::SEQ / 256, 6), 256, 0, stream>>>(QB, 384, 64, KBn, 128, 64, P + 928, nv::DIN, 64, H, nv::D, 384, 3, posb, sinks + l * 6, rel_bias, 6);
                k_attn<64, 64, 2><<<dim3(nv::SEQ / 256, 4), 256, 0, stream>>>(P + 1056, nv::DIN, 64, P + 1056 + 256, nv::DIN, 64, P + 1056 + 512, nv::DIN, 64, H, nv::D, 768, 1, posb, nullptr, nullptr, 4);
                k_groupnorm<<<nv::SEQ / 4, 256, 0, stream>>>(H, out_norm + l * nv::D, nv::SEQ);
                k_gemm<false, 1><<<dim3(nv::D / 128, nv::SEQ / 128), 256, 0, stream>>>(H, nv::D, w_out + (size_t)l * nv::D * nv::D, nullptr, nv::D, xb, nv::D, nv::D, nv::D, xb, gt, 1.0f);
            }
        };
        for (int l = 0; l < DEPTH; ++l) {
            const int base = 2 + 8 * l;
#if HYB == 2
            if (l > 0) launch_fwd(stream, a, grid, 0, 0, 0, l * 3 + 0);
            launch_fwd(stream, a, grid, base + 0, base + 1, 0, -1); launch_fwd(stream, a, grid, base + 1, base + 2, 0, -1);
            naive_mixer(l);
            launch_fwd(stream, a, grid, 0, 0, 0, l * 3 + 2);
            launch_fwd(stream, a, grid, base + 6, base + 7, 0, -1); launch_fwd(stream, a, grid, base + 7, base + 8, 0, -1);
#else
            naive_ffn(l, 0, l == 0 ? x : out);
            launch_fwd(stream, a, grid, 0, 0, 0, l * 3 + 1);
            for (int s = 2; s <= 5; ++s) launch_fwd(stream, a, grid, base + s, base + s + 1, 0, -1);
            naive_ffn(l, 2, out);
#endif
        }
    }
#endif
}
```

```cpp
#include <hip/hip_runtime.h>
#include <cstdio>
#include <cstdint>
#include <cmath>
namespace nv {
constexpr int D = 1024, BATCH = 2, SEQ = 8192, DEPTH = 2, M = BATCH * SEQ;
constexpr int DFF = 2816, DIN = 1824, NMOD = 9 * D;
constexpr float EPS = 1e-6f;

__device__ __forceinline__ float wave_sum(float v) {
#pragma unroll
    for (int o = 1; o < 64; o <<= 1) v += __shfl_xor(v, o);
    return v;
}
__device__ __forceinline__ float silu_f(float x) { return x / (1.0f + expf(-x)); }

__global__ void k_mod(const float* __restrict__ c, const float* __restrict__ w_mod, const float* __restrict__ b_mod, float* __restrict__ mod) {
    int idx = blockIdx.x * 256 + threadIdx.x;
    if (idx >= DEPTH * NMOD) return;
    int l = idx / NMOD, n = idx % NMOD;
    float a0 = 0.f, a1 = 0.f;
    const float* w = w_mod + (size_t)l * D * NMOD + n;
    for (int k = 0; k < D; ++k) {
        float wv = w[(size_t)k * NMOD];
        a0 += silu_f(c[k]) * wv; a1 += silu_f(c[D + k]) * wv;
    }
    mod[((size_t)l * 2 + 0) * NMOD + n] = a0 + b_mod[l * NMOD + n];
    mod[((size_t)l * 2 + 1) * NMOD + n] = a1 + b_mod[l * NMOD + n];
}

__global__ void k_normmod(const float* __restrict__ x, const float* __restrict__ g, const float* __restrict__ sh, const float* __restrict__ sc, float* __restrict__ H, int rows) {
    int row = blockIdx.x * 4 + (threadIdx.x >> 6), lane = threadIdx.x & 63;
    if (row >= rows) return;
    const float* xr = x + (size_t)row * D;
    float v[16]; float s = 0.f;
#pragma unroll
    for (int j = 0; j < 16; ++j) { v[j] = xr[lane + 64 * j]; s += v[j] * v[j]; }
    s = wave_sum(s);
    float r = rsqrtf(s * (1.0f / D) + EPS);
#pragma unroll
    for (int j = 0; j < 16; ++j) { int cidx = lane + 64 * j; H[(size_t)row * D + cidx] = v[j] * r * g[cidx] * (1.0f + sc[cidx]) + sh[cidx]; }
}

template <bool DUAL, int EPI>
__global__ void __launch_bounds__(256) k_gemm(const float* __restrict__ A, int lda, const float* __restrict__ W, const float* __restrict__ W2, int ldw,
                                              float* C, int ldc, int N, int K, const float* R, const float* __restrict__ gate, float coef) {
    __shared__ float As[16][128 + 4];
    __shared__ float Bs[16][128 + 4];
    __shared__ float Bs2[DUAL ? 16 : 1][128 + 4];
    const int tid = threadIdx.x, tx = tid & 15, ty = tid >> 4;
    const int m0 = blockIdx.y * 128, n0 = blockIdx.x * 128;
    float acc[8][8], acc2[DUAL ? 8 : 1][8];
#pragma unroll
    for (int i = 0; i < 8; ++i)
#pragma unroll
        for (int j = 0; j < 8; ++j) { acc[i][j] = 0.f; if (DUAL) acc2[i][j] = 0.f; }
    for (int k0 = 0; k0 < K; k0 += 16) {
#pragma unroll
        for (int i = 0; i < 2; ++i) {
            int e = tid + 256 * i;
            int r = e >> 2, kq = e & 3;
            const float4 v = *(const float4*)(A + (size_t)(m0 + r) * lda + k0 + kq * 4);
            As[kq * 4 + 0][r] = v.x; As[kq * 4 + 1][r] = v.y; As[kq * 4 + 2][r] = v.z; As[kq * 4 + 3][r] = v.w;
        }
#pragma unroll
        for (int i = 0; i < 8; ++i) {
            int e = tid + 256 * i;
            int kk = e >> 7, nn = e & 127;
            int n = n0 + nn;
            Bs[kk][nn] = (n < N) ? W[(size_t)(k0 + kk) * ldw + n] : 0.f;
            if (DUAL) Bs2[kk][nn] = (n < N) ? W2[(size_t)(k0 + kk) * ldw + n] : 0.f;
        }
        __syncthreads();
#pragma unroll
        for (int kk = 0; kk < 16; ++kk) {
            float a[8], b[8], b2[8];
#pragma unroll
            for (int i = 0; i < 8; ++i) a[i] = As[kk][ty * 8 + i];
#pragma unroll
            for (int j = 0; j < 8; ++j) { b[j] = Bs[kk][tx * 8 + j]; if (DUAL) b2[j] = Bs2[kk][tx * 8 + j]; }
#pragma unroll
            for (int i = 0; i < 8; ++i)
#pragma unroll
                for (int j = 0; j < 8; ++j) { acc[i][j] += a[i] * b[j]; if (DUAL) acc2[i][j] += a[i] * b2[j]; }
        }
        __syncthreads();
    }
#pragma unroll
    for (int i = 0; i < 8; ++i)
#pragma unroll
        for (int j = 0; j < 8; ++j) {
            int m = m0 + ty * 8 + i, n = n0 + tx * 8 + j;
            if (n < N) {
                float v = acc[i][j];
                if (DUAL) v = silu_f(v) * acc2[i][j];
                if (EPI == 1) v = R[(size_t)m * ldc + n] + coef * gate[n] * v;
                C[(size_t)m * ldc + n] = v;
            }
        }
}

__global__ void k_headnorm(const float* src1, int s1stride, int hs1, int W1, const float* src2, int s2stride, int hs2, int W2,
                           const float* __restrict__ gain, float* dst, int dstride, int dhs, int nheads, int rows, const int* __restrict__ pos, int do_rope, int do_norm) {
    int item = blockIdx.x * 4 + (threadIdx.x >> 6), lane = threadIdx.x & 63;
    if (item >= rows * nheads) return;
    int row = item / nheads, h = item % nheads;
    const int Wt = W1 + W2;
    float v[4]; float s = 0.f;
#pragma unroll
    for (int j = 0; j < 4; ++j) {
        int e = lane + 64 * j; float t = 0.f;
        if (e < W1) t = src1[(size_t)row * s1stride + h * hs1 + e];
        else if (e < Wt) t = src2[(size_t)row * s2stride + h * hs2 + (e - W1)];
        v[j] = t; s += t * t;
    }
    s = wave_sum(s);
    float r = do_norm ? rsqrtf(s / (float)Wt + EPS) : 1.0f;
    __shared__ float tmp[4][256];
    float* tw = tmp[threadIdx.x >> 6];
#pragma unroll
    for (int j = 0; j < 4; ++j) { int e = lane + 64 * j; if (e < Wt) tw[e] = v[j] * r * (do_norm ? gain[e] : 1.0f); }
    __syncthreads();
    if (do_rope) {
        float outv = 0.f; int e = lane;
        if (lane < 32) {
            int jf = lane & 15;
            float freq = powf(10000.0f, -(float)jf / 16.0f);
            float ang = (float)pos[row] * freq;
            float cs = cosf(ang), sn = sinf(ang);
            float x1 = tw[Wt - 32 + jf], x2 = tw[Wt - 16 + jf];
            outv = (lane < 16) ? (x1 * cs - x2 * sn) : (x2 * cs + x1 * sn);
        }
        __syncthreads();
        if (lane < 32) tw[Wt - 32 + e] = outv;
        __syncthreads();
    }
#pragma unroll
    for (int j = 0; j < 4; ++j) { int e = lane + 64 * j; if (e < Wt) dst[(size_t)row * dstride + h * dhs + e] = tw[e]; }
}

__device__ __forceinline__ int t5_bucket(int rel) {
    int n = rel > 0 ? rel : 0;
    if (n < 16) return n;
    float nf = (float)n;
    int large = 16 + (int)(logf(nf / 16.0f) / logf(8.0f) * 16.0f);
    return large < 31 ? large : 31;
}

template <int DQK, int DV, int MODE>
__global__ void __launch_bounds__(256) k_attn(const float* __restrict__ Q, int qstride, int qhs, const float* __restrict__ Kp, int kstride, int khs, const float* __restrict__ Vp, int vstride, int vhs,
                                              float* __restrict__ O, int ostride, int ocol0, int group, const int* __restrict__ pos, const float* __restrict__ sinks, const float* __restrict__ relb, int nheads_q) {
    __shared__ float Ks[64][DQK];
    __shared__ float Vs[64][DV];
    const int h = blockIdx.y, kvh = h / group, t0 = blockIdx.x * 256, t = t0 + threadIdx.x;
    float q[DQK], o[DV];
    const float scale = rsqrtf((float)DQK);
#pragma unroll
    for (int d = 0; d < DQK; ++d) q[d] = Q[(size_t)t * qstride + h * qhs + d] * scale;
#pragma unroll
    for (int d = 0; d < DV; ++d) o[d] = 0.f;
    float mrun = (MODE == 1) ? sinks[h] : -INFINITY, lrun = (MODE == 1) ? 1.0f : 0.f;
    float after = 0.f;
    const int posq = (MODE == 1) ? pos[t] : 0;
    int jt_lo, jt_hi;
    if (MODE == 0) { jt_lo = 0; jt_hi = (t0 + 255) / 64; }
    else if (MODE == 1) { int lo = t0 - 127; if (lo < 0) lo = 0; jt_lo = lo / 64; jt_hi = (t0 + 255) / 64; }
    else { jt_lo = 0; jt_hi = (t0 + 254) / 64; }
    const int ntile = jt_hi - jt_lo + 1;
    for (int it = 0; it < ntile; ++it) {
        const int jt = (MODE == 2) ? (jt_hi - it) : (jt_lo + it);
        const int j0 = jt * 64;
        __syncthreads();
        for (int e = threadIdx.x; e < 64 * DQK; e += 256) { int jj = e / DQK, d = e % DQK; Ks[jj][d] = Kp[(size_t)(j0 + jj) * kstride + kvh * khs + d]; }
        for (int e = threadIdx.x; e < 64 * DV; e += 256) { int jj = e / DV, d = e % DV; Vs[jj][d] = Vp[(size_t)(j0 + jj) * vstride + kvh * vhs + d]; }
        __syncthreads();
        if (MODE == 2) {
            bool live = false;
            for (int jj = 63; jj >= 0; --jj) {
                int j = j0 + jj;
                if (j < t) {
                    float z = 0.f;
#pragma unroll
                    for (int d = 0; d < DQK; ++d) z += q[d] * Ks[jj][d];
                    float sp = fmaxf(z, 0.f) + log1pf(expf(-fabsf(z)));
                    float a = expf(z - sp + after);
                    after -= sp;
#pragma unroll
                    for (int d = 0; d < DV; ++d) o[d] += a * Vs[jj][d];
                }
            }
            live = (after > -110.0f) ;
            if (!__syncthreads_or(live ? 1 : 0)) break;
        } else {
            for (int jj = 0; jj < 64; ++jj) {
                int j = j0 + jj;
                bool ok = (j <= t);
                if (MODE == 1) ok = ok && (j > t - 128);
                if (ok) {
                    float s = 0.f;
#pragma unroll
                    for (int d = 0; d < DQK; ++d) s += q[d] * Ks[jj][d];
                    if (MODE == 1) s += relb[t5_bucket(posq - pos[j]) * nheads_q + h];
                    float mn = fmaxf(mrun, s);
                    float f = expf(mrun - mn), p = expf(s - mn);
                    lrun = lrun * f + p; mrun = mn;
#pragma unroll
                    for (int d = 0; d < DV; ++d) o[d] = o[d] * f + p * Vs[jj][d];
                }
            }
        }
    }
    const float inv = (MODE == 2) ? 1.0f : 1.0f / lrun;
#pragma unroll
    for (int d = 0; d < DV; ++d) O[(size_t)t * ostride + ocol0 + h * DV + d] = o[d] * inv;
}

__global__ void k_groupnorm(float* O, const float* __restrict__ on, int rows) {
    int row = blockIdx.x * 4 + (threadIdx.x >> 6), lane = threadIdx.x & 63;
    if (row >= rows) return;
    float* orow = O + (size_t)row * D;
    float v[16]; float s0 = 0.f, s1 = 0.f, s2 = 0.f;
#pragma unroll
    for (int j = 0; j < 16; ++j) { int cidx = lane + 64 * j; v[j] = orow[cidx]; float sq = v[j] * v[j]; if (cidx < 384) s0 += sq; else if (cidx < 768) s1 += sq; else s2 += sq; }
    s0 = wave_sum(s0); s1 = wave_sum(s1); s2 = wave_sum(s2);
    float r0 = rsqrtf(s0 / 384.f + EPS), r1 = rsqrtf(s1 / 384.f + EPS), r2 = rsqrtf(s2 / 256.f + EPS);
#pragma unroll
    for (int j = 0; j < 16; ++j) { int cidx = lane + 64 * j; float r = cidx < 384 ? r0 : (cidx < 768 ? r1 : r2); orow[cidx] = v[j] * r * on[cidx]; }
}
}
constexpr int NWAVES = 8;
constexpr int BATCH = 2, SEQ = 8192, DM = 1024, DEPTH = 2, MROWS = BATCH * SEQ;
constexpr int DFF = 2816, DIN = 1824, NMOD = 9 * DM;
constexpr int NPH = 2 + 8 * DEPTH;
constexpr size_t MiB = 1u << 20;
constexpr size_t WS_CTL = 0, CTL_ZERO_BYTES = 256 * 1024;
constexpr size_t WS_MOD = 1 * MiB;
constexpr size_t WS_GS = WS_MOD + 160 * 1024;
constexpr size_t WS_BIAS = WS_GS + 64 * 1024;
constexpr size_t BIAS_L = 2 * (5632 + 2048 + 5632);
constexpr size_t WS_SSQX = 2 * MiB;
constexpr size_t WS_SSQO = 3 * MiB;
constexpr size_t WS_CS = 4 * MiB;
constexpr size_t WS_KPE = 6 * MiB;
constexpr size_t WS_SSQC = 8 * MiB;
constexpr size_t WS_W = 9 * MiB;
constexpr size_t W_GU1 = 0, W_D1 = W_GU1 + (size_t)5632 * 1024 * 2, W_IN = W_D1 + (size_t)1024 * 2816 * 2, W_UQ = W_IN + (size_t)2048 * 1024 * 2, W_UKV = W_UQ + (size_t)768 * 256 * 2,
                 W_OUT = W_UKV + (size_t)768 * 128 * 2, W_GU2 = W_OUT + (size_t)1024 * 1024 * 2, W_D2 = W_GU2 + (size_t)5632 * 1024 * 2, WL = W_D2 + (size_t)1024 * 2816 * 2;
constexpr size_t WS_XB = WS_W + ((2 * WL + MiB - 1) / MiB) * MiB;
constexpr size_t WS_ACT = WS_XB + 32 * MiB;
constexpr size_t WS_HID = WS_ACT;
constexpr size_t WS_CQ = WS_ACT, WS_CKV = WS_CQ + 8 * MiB, WS_QRAW = WS_CKV + 4 * MiB, WS_KA = WS_QRAW + 36 * MiB, WS_VA = WS_KA + 18 * MiB, WS_QS = WS_VA + 12 * MiB, WS_KS = WS_QS + 12 * MiB,
                 WS_VS = WS_KS + 4 * MiB, WS_QC = WS_VS + 4 * MiB, WS_KC = WS_QC + 8 * MiB, WS_VC = WS_KC + 8 * MiB, WS_OALL = WS_VC + 8 * MiB, WS_END = WS_OALL + 32 * MiB;
static_assert(WS_HID + (size_t)MROWS * DFF * 2 <= WS_END, "d_ws map");
constexpr int CW_BAR = 4096;
constexpr int CW_Q = 40960;
static_assert((CW_Q + 64 * 9) * 4 <= (int)CTL_ZERO_BYTES && CW_BAR + 8 * 3456 <= CW_Q, "ctl map");
constexpr int RING_BYTES = 131072, LDSCTL_OFF = RING_BYTES, MISC_OFF = LDSCTL_OFF + 320, LDS_BYTES = 147456;

namespace pg8 {
#define PG8_LAS __attribute__((address_space(3)))
typedef unsigned short bf16_t;
typedef short bf16x8 __attribute__((ext_vector_type(8)));
typedef float f32x4 __attribute__((ext_vector_type(4)));
typedef unsigned u32x4 __attribute__((ext_vector_type(4)));
constexpr int BM = 256, BK = 64, HALF = 128, HTB = HALF * BK * 2  , STAGE_BYTES = 8 * HTB, NXCD = 8, WGM = 8;

__host__ __device__ __forceinline__ int lds_byte(int r, int c) { const int st = (r >> 4) * 2 + (c >> 5), rr = r & 15, cc = c & 31, ob = rr * 64 + cc * 2; return st * 1024 + (ob ^ (((ob >> 9) & 1) << 5)); }
__host__ __device__ __forceinline__ void stage_rc(int b, int& R, int& C) { const int st = b / 1024, sb = b % 1024, swz = sb ^ (((sb >> 9) & 1) << 5); R = (st >> 1) * 16 + swz / 64; C = (st & 1) * 32 + (swz % 64) / 2; }
__host__ __device__ __forceinline__ int perm32(int rho) { const int n = rho >> 4, i = rho & 15; return 8 * (i >> 2) + 4 * n + (i & 3); }

struct Unit { int pm, pn; };
struct Gemm { const bf16_t* A; const bf16_t* Bt; int M, N, K; };

struct StaticOrder {
    int nM, nN, nwg, G, c;
    __host__ __device__ void init(int M, int N, int G_, int c_) { nM = M / BM; nN = N / BM; nwg = nM * nN; G = G_; c = c_; }
    __host__ __device__ bool next(int i, Unit& u) const {
        const long L = (long)i * G + c; if (L >= nwg) return false;
        int wgid = (int)L; { const int q = nwg / NXCD, r = nwg % NXCD, xcd = wgid % NXCD, off = wgid / NXCD; wgid = (xcd < r ? xcd * (q + 1) : r * (q + 1) + (xcd - r) * q) + off; }
        const int nig = WGM * nN, gid = wgid / nig, fm = gid * WGM, gsz = (nM - fm) < WGM ? (nM - fm) : WGM;
        u.pm = fm + ((wgid % nig) % gsz); u.pn = (wgid % nig) / gsz; return true;
    }
    __device__ __forceinline__ void a_ready(const Unit&) const {}
    __device__ __forceinline__ void done(const Unit&) const {}
};

__device__ __forceinline__ unsigned cvt_pk_bf16(float lo, float hi) { unsigned r; asm volatile("v_cvt_pk_bf16_f32 %0, %1, %2" : "=v"(r) : "v"(lo), "v"(hi)); return r; }
typedef float f32x2 __attribute__((ext_vector_type(2)));
template <class Epi, class Sched, bool ALIGN_EPI = false, bool SP2 = false>
__device__ __forceinline__ void gemm_phase(PG8_LAS unsigned char* lds, const Gemm g, const Sched& S, const Epi& E) {
    int tid_ = threadIdx.x; asm volatile("" : "+v"(tid_));
    const int tid = tid_, wid = __builtin_amdgcn_readfirstlane(tid >> 6), lane = tid & 63, wr = wid >> 2, wc = wid & 3, fr = lane & 15, fq = lane >> 4;
    int K_ = g.K; asm volatile("" : "+s"(K_));
    const int K = K_, nt = K / BK;
    unsigned voffA[2], voffB[2];
#pragma unroll
    for (int i = 0; i < 2; ++i) { int R, C; stage_rc(tid * 16 + i * 8192, R, C); const int Rb = Epi::PERM ? ((R & ~31) + perm32(R & 31)) : R;
        voffA[i] = (unsigned)(R * K + C) * 2u; voffB[i] = (unsigned)(Rb * K + C) * 2u; }
    const size_t kstep = (size_t)(BK * 2);
    const size_t hstep = (size_t)HALF * K * 2;
    const size_t tstep = 2 * hstep;
    const unsigned ldsw = (unsigned)wid * 1024u;
    const int aoff = lds_byte(wr * 64 + fr, fq * 8), boff = lds_byte(wc * 32 + fr, fq * 8);
#define PG8_SA(b, h) (((b) * 2 + (h)) * HTB)
#define PG8_SB(b, h) ((4 + (b) * 2 + (h)) * HTB)
#define PG8_STAGE(bufoff, gbase, voff) do { _Pragma("unroll") for (int _i = 0; _i < 2; ++_i) \
        __builtin_amdgcn_global_load_lds((const unsigned*)((const char*)(gbase) + (voff)[_i]), (PG8_LAS unsigned*)(lds + (bufoff) + ldsw + _i * 8192), 16, 0, 0); } while (0)
#define PG8_LDA(dst, b, h) do { _Pragma("unroll") for (int m = 0; m < 4; ++m) _Pragma("unroll") for (int k = 0; k < 2; ++k) dst[m][k] = *(const PG8_LAS bf16x8*)(lds + PG8_SA(b, h) + aoff + m * 2048 + k * 1024); } while (0)
#define PG8_LDB(dst, b, h) do { _Pragma("unroll") for (int n = 0; n < 2; ++n) _Pragma("unroll") for (int k = 0; k < 2; ++k) dst[n][k] = *(const PG8_LAS bf16x8*)(lds + PG8_SB(b, h) + boff + n * 2048 + k * 1024); } while (0)
#define PG8_MMA(ai, bj, At, Bt) do { __builtin_amdgcn_s_setprio(1); _Pragma("unroll") for (int m = 0; m < 4; ++m) _Pragma("unroll") for (int n = 0; n < 2; ++n) _Pragma("unroll") for (int k = 0; k < 2; ++k) \
        acc[ai][bj][m][n] = __builtin_amdgcn_mfma_f32_16x16x32_bf16(Bt[n][k], At[m][k], acc[ai][bj][m][n], 0, 0, 0); __builtin_amdgcn_s_setprio(0); } while (0)
#define PG8_WAIT_V(n) asm volatile("s_waitcnt vmcnt(" #n ")" ::: "memory")
#define PG8_WAIT_L(n) asm volatile("s_waitcnt lgkmcnt(" #n ")" ::: "memory")
#define PG8_BAR __builtin_amdgcn_s_barrier()
#define PG8_SCHED __builtin_amdgcn_sched_barrier(0)
    Unit cur, nxt; int ui = 0;
    if (!S.next(0, cur)) return;
    f32x4 acc[2][2][4][2];
#pragma unroll
    for (int a = 0; a < 2; ++a)
#pragma unroll
        for (int b = 0; b < 2; ++b)
#pragma unroll
            for (int m = 0; m < 4; ++m)
#pragma unroll
                for (int n = 0; n < 2; ++n) acc[a][b][m][n] = (f32x4){0.f, 0.f, 0.f, 0.f};
    bf16x8 At[4][2], B0[2][2], B1[2][2];
    const char* cA = (const char*)g.A + (size_t)cur.pm * tstep; const char* cB = (const char*)g.Bt + (size_t)cur.pn * tstep;
    S.a_ready(cur);
    if constexpr (SP2) {
        PG8_STAGE(PG8_SB(0, 0), cB, voffB); PG8_STAGE(PG8_SB(0, 1), cB + hstep, voffB); PG8_STAGE(PG8_SA(0, 0), cA, voffA); PG8_STAGE(PG8_SA(0, 1), cA + hstep, voffA);
        if (wr == 1) PG8_BAR;
        PG8_WAIT_V(2); PG8_BAR;
        PG8_STAGE(PG8_SB(1, 0), cB + kstep, voffB); PG8_STAGE(PG8_SA(1, 0), cA + kstep, voffA); PG8_STAGE(PG8_SB(1, 1), cB + hstep + kstep, voffB);
        PG8_WAIT_V(6); PG8_BAR;
    } else {
        PG8_STAGE(PG8_SB(0, 0), cB, voffB); PG8_STAGE(PG8_SA(0, 0), cA, voffA); PG8_STAGE(PG8_SB(0, 1), cB + hstep, voffB); PG8_STAGE(PG8_SA(0, 1), cA + hstep, voffA);
        if (wr == 1) PG8_BAR;
        PG8_WAIT_V(4); PG8_BAR;
        PG8_STAGE(PG8_SB(1, 0), cB + kstep, voffB); PG8_STAGE(PG8_SA(1, 0), cA + kstep, voffA); PG8_STAGE(PG8_SB(1, 1), cB + hstep + kstep, voffB);
        PG8_WAIT_V(6); PG8_BAR;
    }
    for (;;) {
        const bool has_next = S.next(ui + 1, nxt);
        const char* nA = has_next ? (const char*)g.A + (size_t)nxt.pm * tstep : cA; const char* nB = has_next ? (const char*)g.Bt + (size_t)nxt.pn * tstep : cB;
#pragma nounroll
        for (int t = 0; t < nt; t += 2) {
            if constexpr (Epi::HOOK) E.hook(acc, cur, t, wr, wc, fr, fq);
            const bool last = (t == nt - 2);
            const char* a1 = cA + (size_t)(t + 1) * kstep;
            const char* a2 = last ? nA : cA + (size_t)(t + 2) * kstep; const char* b2 = last ? nB : cB + (size_t)(t + 2) * kstep;
            const char* a3 = a2 + kstep; const char* b3 = b2 + kstep;
            if (last && has_next) S.a_ready(nxt);
            if constexpr (SP2) {
            PG8_LDB(B0, 0, 0); PG8_LDB(B1, 0, 1); PG8_SCHED; PG8_LDA(At, 0, 0); PG8_STAGE(PG8_SA(1, 1), a1 + hstep, voffA);
            PG8_WAIT_V(8); PG8_WAIT_L(0); PG8_BAR; PG8_MMA(0, 0, At, B0); PG8_MMA(0, 1, At, B1); PG8_BAR; PG8_SCHED;
            PG8_LDA(At, 0, 1); PG8_STAGE(PG8_SB(0, 0), b2, voffB); PG8_STAGE(PG8_SB(0, 1), b2 + hstep, voffB); PG8_STAGE(PG8_SA(0, 0), a2, voffA);
            PG8_WAIT_V(8); PG8_WAIT_L(0); PG8_BAR; PG8_MMA(1, 0, At, B0); PG8_MMA(1, 1, At, B1); PG8_BAR; PG8_SCHED;
            PG8_LDB(B0, 1, 0); PG8_LDB(B1, 1, 1); PG8_SCHED; PG8_LDA(At, 1, 0); PG8_STAGE(PG8_SA(0, 1), a2 + hstep, voffA);
            PG8_WAIT_V(8); PG8_WAIT_L(0); PG8_BAR; PG8_MMA(0, 0, At, B0); PG8_MMA(0, 1, At, B1); PG8_BAR; PG8_SCHED;
            PG8_LDA(At, 1, 1); PG8_STAGE(PG8_SB(1, 0), b3, voffB); PG8_STAGE(PG8_SB(1, 1), b3 + hstep, voffB); PG8_STAGE(PG8_SA(1, 0), a3, voffA);
            PG8_WAIT_V(8); PG8_WAIT_L(0); PG8_BAR; PG8_MMA(1, 0, At, B0); PG8_MMA(1, 1, At, B1); PG8_BAR; PG8_SCHED;
            } else {
            PG8_LDB(B0, 0, 0); PG8_SCHED; PG8_LDA(At, 0, 0); PG8_STAGE(PG8_SA(1, 1), a1 + hstep, voffA);
            PG8_WAIT_L(8); PG8_BAR; PG8_WAIT_L(0); PG8_MMA(0, 0, At, B0); PG8_BAR; PG8_SCHED;
            PG8_LDB(B1, 0, 1); PG8_STAGE(PG8_SB(0, 0), b2, voffB);
            PG8_BAR; PG8_WAIT_L(0); PG8_MMA(0, 1, At, B1); PG8_BAR;
            PG8_LDA(At, 0, 1); PG8_STAGE(PG8_SA(0, 0), a2, voffA);
            PG8_BAR; PG8_WAIT_L(0); PG8_MMA(1, 0, At, B0); PG8_BAR; PG8_SCHED;
            PG8_STAGE(PG8_SB(0, 1), b2 + hstep, voffB);
            PG8_WAIT_V(6); PG8_BAR; PG8_MMA(1, 1, At, B1); PG8_BAR;
            PG8_LDB(B0, 1, 0); PG8_SCHED; PG8_LDA(At, 1, 0); PG8_STAGE(PG8_SA(0, 1), a2 + hstep, voffA);
            PG8_WAIT_L(8); PG8_BAR; PG8_WAIT_L(0); PG8_MMA(0, 0, At, B0); PG8_BAR; PG8_SCHED;
            PG8_LDB(B1, 1, 1); PG8_STAGE(PG8_SB(1, 0), b3, voffB);
            PG8_BAR; PG8_WAIT_L(0); PG8_MMA(0, 1, At, B1); PG8_BAR;
            PG8_LDA(At, 1, 1); PG8_STAGE(PG8_SA(1, 0), a3, voffA);
            PG8_BAR; PG8_WAIT_L(0); PG8_MMA(1, 0, At, B0); PG8_BAR; PG8_SCHED;
            PG8_STAGE(PG8_SB(1, 1), b3 + hstep, voffB);
            PG8_WAIT_V(6); PG8_BAR; PG8_MMA(1, 1, At, B1); PG8_BAR;
            }
        }
        if constexpr (ALIGN_EPI) { if (wr == 0) PG8_BAR; }
        if constexpr (!Epi::AFTER_DRAIN) {
            Unit ce = cur; asm volatile("" : "+s"(ce.pm), "+s"(ce.pn)); int fre = fr, fqe = fq; asm volatile("" : "+v"(fre), "+v"(fqe));
            E(acc, ce, wr, wc, fre, fqe); S.done(cur); }
        if (!has_next) break;
#pragma unroll
        for (int a = 0; a < 2; ++a)
#pragma unroll
            for (int b = 0; b < 2; ++b)
#pragma unroll
                for (int m = 0; m < 4; ++m)
#pragma unroll
                    for (int n = 0; n < 2; ++n) acc[a][b][m][n] = (f32x4){0.f, 0.f, 0.f, 0.f};
        cur = nxt; cA = nA; cB = nB; ++ui;
        if constexpr (ALIGN_EPI) { if (wr == 1) PG8_BAR; }
    }
    PG8_WAIT_V(0);
    if constexpr (!ALIGN_EPI) { if (wr == 0) PG8_BAR; }
    PG8_BAR;
    if constexpr (Epi::AFTER_DRAIN) { E.fused(acc, cur, wr, wc, fr, fq, lds, wid, lane); S.done(cur); }
#undef PG8_SA
#undef PG8_SB
#undef PG8_STAGE
#undef PG8_LDA
#undef PG8_LDB
#undef PG8_MMA
#undef PG8_WAIT_V
#undef PG8_WAIT_L
#undef PG8_BAR
#undef PG8_SCHED
}
constexpr float RMS_EPS = 1e-6f;
constexpr int MROWS_ = 16384;
constexpr float LOG2E = 1.4426950408889634f;
typedef unsigned u32x2 __attribute__((ext_vector_type(2)));
#define PG8_FENCE() asm volatile("" ::: "memory")
#define PG8_G __attribute__((address_space(1)))
__device__ __forceinline__ float sum16f(const PG8_G float* p) {
    const f32x4 a = *(const PG8_G f32x4*)p, b = *(const PG8_G f32x4*)(p + 4), c = *(const PG8_G f32x4*)(p + 8), d = *(const PG8_G f32x4*)(p + 12);
    return ((a[0] + a[1]) + (a[2] + a[3])) + ((b[0] + b[1]) + (b[2] + b[3])) + ((c[0] + c[1]) + (c[2] + c[3])) + ((d[0] + d[1]) + (d[2] + d[3]));
}
__device__ __forceinline__ float fast_rcp(float x) { return __builtin_amdgcn_rcpf(x); }
__device__ __forceinline__ float silu_fast(float g) { return g * fast_rcp(1.0f + __builtin_amdgcn_exp2f(-g * LOG2E)); }
__device__ __forceinline__ float sq4(const f32x4 v) { return (v[0] * v[0] + v[1] * v[1]) + (v[2] * v[2] + v[3] * v[3]); }

struct EpiUp {
    static constexpr bool PERM = true, AFTER_DRAIN = false, HOOK = false;
    PG8_G unsigned char* ws; const PG8_G float* bias;
    __device__ __forceinline__ void hook(f32x4 (&)[2][2][4][2], const Unit&, int, int, int, int, int) const {}
    __device__ __forceinline__ void operator()(const f32x4 (&acc)[2][2][4][2], const Unit& u, int wr, int wc, int fr, int fq) const {
        PG8_G bf16_t* HID = (PG8_G bf16_t*)(ws + WS_HID); const PG8_G float* ssqx = (const PG8_G float*)(ws + WS_SSQX);
        const int b = u.pm >> 5;
        const PG8_G float* bb = bias + b * 5632 + u.pn * BM + wc * 32 + 8 * fq;
        f32x4 bg[2], bu[2];
#pragma unroll
        for (int n = 0; n < 2; ++n) { bg[n] = *(const PG8_G f32x4*)(bb + 4 * n); bu[n] = *(const PG8_G f32x4*)(bb + HALF + 4 * n); }
#pragma unroll
        for (int ai = 0; ai < 2; ++ai)
#pragma unroll
            for (int m = 0; m < 4; ++m) {
                const int row = u.pm * BM + ai * HALF + wr * 64 + m * 16 + fr;
                const float r = 1.0f / sqrtf(sum16f(ssqx + (size_t)row * 16) * (1.0f / 1024.0f) + RMS_EPS);
                float hv[8];
#pragma unroll
                for (int n = 0; n < 2; ++n)
#pragma unroll
                    for (int i = 0; i < 4; ++i) { const float g = acc[ai][0][m][n][i] * r + bg[n][i], uu = acc[ai][1][m][n][i] * r + bu[n][i]; hv[4 * n + i] = silu_fast(g) * uu; }
                u32x4 w; w.x = cvt_pk_bf16(hv[0], hv[1]); w.y = cvt_pk_bf16(hv[2], hv[3]); w.z = cvt_pk_bf16(hv[4], hv[5]); w.w = cvt_pk_bf16(hv[6], hv[7]);
                *(PG8_G u32x4*)(HID + (size_t)row * 2816 + u.pn * HALF + wc * 32 + 8 * fq) = w;
                if (m & 1) PG8_FENCE();
            }
    }
};

template <bool HOOKED> struct EpiRes {
    static constexpr bool PERM = false, AFTER_DRAIN = false, HOOK = HOOKED;
    const PG8_G float* xin; PG8_G float* xout; PG8_G unsigned char* ws; const PG8_G float* gate; const PG8_G float* gs; float coef;
    __device__ __forceinline__ void group_r(int row, float& rA, float& rB, float& rC) const {
        const PG8_G float* p = (const PG8_G float*)(ws + WS_SSQO) + (size_t)row * 16;
        const f32x4 a = *(const PG8_G f32x4*)p, b = *(const PG8_G f32x4*)(p + 4), c = *(const PG8_G f32x4*)(p + 8), d = *(const PG8_G f32x4*)(p + 12);
        const float sA = ((a[0] + a[1]) + (a[2] + a[3])) + (b[0] + b[1]), sB = ((b[2] + b[3]) + (c[0] + c[1])) + (c[2] + c[3]), sC = (d[0] + d[1]) + (d[2] + d[3]);
        rA = 1.0f / sqrtf(sA * (1.0f / 384.0f) + RMS_EPS); rB = 1.0f / sqrtf(sB * (1.0f / 384.0f) + RMS_EPS); rC = 1.0f / sqrtf(sC * (1.0f / 256.0f) + RMS_EPS);
    }
    __device__ __forceinline__ void hook(f32x4 (&acc)[2][2][4][2], const Unit& u, int t, int wr, int wc, int fr, int fq) const {
        if (t != 6 && t != 12) return;
        asm volatile("" : "+v"(fr));
#pragma unroll
        for (int ai = 0; ai < 2; ++ai)
#pragma unroll
            for (int m = 0; m < 4; ++m) {
                const int row = u.pm * BM + ai * HALF + wr * 64 + m * 16 + fr;
                float rA, rB, rC; group_r(row, rA, rB, rC);
                const float f = (t == 6) ? rA / rB : rB / rC;
#pragma unroll
                for (int bj = 0; bj < 2; ++bj)
#pragma unroll
                    for (int n = 0; n < 2; ++n) acc[ai][bj][m][n] = acc[ai][bj][m][n] * f;                PG8_FENCE();
            }
    }
    __device__ __forceinline__ void operator()(const f32x4 (&acc)[2][2][4][2], const Unit& u, int wr, int wc, int fr, int fq) const {
        PG8_G bf16_t* xb = (PG8_G bf16_t*)(ws + WS_XB); PG8_G float* ssq_out = (PG8_G float*)(ws + WS_SSQX); constexpr int gate_bstride = 9 * 1024;
        const int b = u.pm >> 5;
        const int col0 = u.pn * BM + wc * 32 + 4 * fq;
        f32x4 gv[2][2], gsv[2][2];
#pragma unroll
        for (int bj = 0; bj < 2; ++bj)
#pragma unroll
            for (int n = 0; n < 2; ++n) {
                gv[bj][n] = *(const PG8_G f32x4*)(gate + (size_t)b * gate_bstride + col0 + bj * HALF + n * 16) * coef;
                gsv[bj][n] = gs ? *(const PG8_G f32x4*)(gs + (size_t)b * 1024 + col0 + bj * HALF + n * 16) : (f32x4){0.f, 0.f, 0.f, 0.f};
            }
#pragma unroll
        for (int ai = 0; ai < 2; ++ai)
#pragma unroll
            for (int m = 0; m < 4; ++m) {
                const int row = u.pm * BM + ai * HALF + wr * 64 + m * 16 + fr;
                float rs = 1.0f;
                if (HOOKED) { float rA, rB, rC; group_r(row, rA, rB, rC); rs = rC; }
                const size_t off = (size_t)row * 1024 + col0;
                float ss = 0.f;
#pragma unroll
                for (int bj = 0; bj < 2; ++bj)
#pragma unroll
                    for (int n = 0; n < 2; ++n) {
                        const f32x4 xo = *(const PG8_G f32x4*)(xin + off + bj * HALF + n * 16);
                        const f32x4 xn = xo + gv[bj][n] * (acc[ai][bj][m][n] * rs);
                        *(PG8_G f32x4*)(xout + off + bj * HALF + n * 16) = xn;
                        ss += sq4(xn);
                        if (gs) { const f32x4 y = xn * gsv[bj][n]; u32x2 w; w.x = cvt_pk_bf16(y[0], y[1]); w.y = cvt_pk_bf16(y[2], y[3]); *(PG8_G u32x2*)(xb + off + bj * HALF + n * 16) = w; }
                    }
                ss += __shfl_xor(ss, 16); ss += __shfl_xor(ss, 32);
                if (gs && fq == 0) ssq_out[(size_t)row * 16 + 4 * u.pn + wc] = ss;
                PG8_FENCE();
            }
    }
};

struct EpiIn {
    static constexpr bool PERM = true, AFTER_DRAIN = false, HOOK = false;
    PG8_G unsigned char* ws; const PG8_G float* gq; const PG8_G float* gk; const PG8_G float* bias;
    __device__ __forceinline__ void hook(f32x4 (&)[2][2][4][2], const Unit&, int, int, int, int, int) const {}
    __device__ __forceinline__ void operator()(const f32x4 (&acc)[2][2][4][2], const Unit& u, int wr, int wc, int fr, int fq) const {
        const int slot = u.pn * 4 + wc;
        if (slot == 7 || slot >= 30) return;
        const int b = u.pm >> 5;
        const PG8_G float* ssqx = (const PG8_G float*)(ws + WS_SSQX);
        PG8_G PG8_G bf16_t* dst = nullptr; int pitch = 0, col0 = 0; int kind = 0;
        PG8_G PG8_G float* ssqd = nullptr; int ssqp = 0, ssqi = 0; const PG8_G float* gain = nullptr; float scale = 1.0f;
        if (slot < 4)       { dst = (PG8_G bf16_t*)(ws + WS_CQ);  pitch = 256; col0 = 64 * slot;        kind = 1; ssqd = (PG8_G float*)(ws + WS_SSQC);  ssqp = 4; ssqi = slot; }
        else if (slot < 6)  { dst = (PG8_G bf16_t*)(ws + WS_CKV); pitch = 128; col0 = 64 * (slot - 4);  kind = 1; ssqd = (PG8_G float*)(ws + WS_SSQC) + (size_t)MROWS_ * 4; ssqp = 2; ssqi = slot - 4; }
        else if (slot == 6) { kind = 3; }
        else if (slot < 14) { dst = (PG8_G bf16_t*)(ws + WS_QS);  pitch = 384; col0 = 64 * (slot - 8);  kind = 2; gain = gq; scale = 0.125f * LOG2E; }
        else if (slot < 16) { dst = (PG8_G bf16_t*)(ws + WS_KS);  pitch = 128; col0 = 64 * (slot - 14); kind = 2; gain = gk; }
        else if (slot < 18) { dst = (PG8_G bf16_t*)(ws + WS_VS);  pitch = 128; col0 = 64 * (slot - 16); }
        else if (slot < 22) { dst = (PG8_G bf16_t*)(ws + WS_QC);  pitch = 256; col0 = 64 * (slot - 18); scale = 0.125f * LOG2E; }
        else if (slot < 26) { dst = (PG8_G bf16_t*)(ws + WS_KC);  pitch = 256; col0 = 64 * (slot - 22); }
        else                { dst = (PG8_G bf16_t*)(ws + WS_VC);  pitch = 256; col0 = 64 * (slot - 26); }
        const PG8_G float* bb = bias + b * 2048 + u.pn * BM + wc * 32 + 8 * fq;
        f32x4 bv[2][2], gn[2][2];
#pragma unroll
        for (int bj = 0; bj < 2; ++bj)
#pragma unroll
            for (int n = 0; n < 2; ++n) { bv[bj][n] = *(const PG8_G f32x4*)(bb + bj * HALF + 4 * n);
                gn[bj][n] = (kind == 2) ? *(const PG8_G f32x4*)(gain + 32 * bj + 8 * fq + 4 * n) * scale : (f32x4){scale, scale, scale, scale}; }
#pragma unroll
        for (int ai = 0; ai < 2; ++ai)
#pragma unroll
            for (int m = 0; m < 4; ++m) {
                const int row = u.pm * BM + ai * HALF + wr * 64 + m * 16 + fr;
                const float r = 1.0f / sqrtf(sum16f(ssqx + (size_t)row * 16) * (1.0f / 1024.0f) + RMS_EPS);
                f32x4 v[2][2]; float ss = 0.f;
#pragma unroll
                for (int bj = 0; bj < 2; ++bj)
#pragma unroll
                    for (int n = 0; n < 2; ++n) { v[bj][n] = acc[ai][bj][m][n] * r + bv[bj][n]; ss += sq4(v[bj][n]); }
                if (kind == 3) {
                    float s0 = sq4(v[0][0]) + sq4(v[0][1]);
                    s0 += __shfl_xor(s0, 16); s0 += __shfl_xor(s0, 32);
                    *(PG8_G f32x4*)((PG8_G float*)(ws + WS_KPE) + (size_t)row * 32 + 8 * fq) = v[0][0]; *(PG8_G f32x4*)((PG8_G float*)(ws + WS_KPE) + (size_t)row * 32 + 8 * fq + 4) = v[0][1];
                    if (fq == 0) ((PG8_G float*)(ws + WS_SSQC) + (size_t)MROWS_ * 6)[row] = s0;
                } else {
                    if (kind != 0) { ss += __shfl_xor(ss, 16); ss += __shfl_xor(ss, 32); }
                    float rn = 1.0f;
                    if (kind == 2) rn = 1.0f / sqrtf(ss * (1.0f / 64.0f) + RMS_EPS);
                    if (kind == 1 && fq == 0) ssqd[(size_t)row * ssqp + ssqi] = ss;
#pragma unroll
                    for (int bj = 0; bj < 2; ++bj) {
                        const f32x4 y0 = v[bj][0] * gn[bj][0] * rn, y1 = v[bj][1] * gn[bj][1] * rn;
                        u32x4 w; w.x = cvt_pk_bf16(y0[0], y0[1]); w.y = cvt_pk_bf16(y0[2], y0[3]); w.z = cvt_pk_bf16(y1[0], y1[1]); w.w = cvt_pk_bf16(y1[2], y1[3]);
                        *(PG8_G u32x4*)(dst + (size_t)row * pitch + col0 + 32 * bj + 8 * fq) = w;
                    }
                }
                if (m & 1) PG8_FENCE();
            }
    }
};

struct EpiUq {
    static constexpr bool PERM = false, AFTER_DRAIN = false, HOOK = false;
    PG8_G unsigned char* ws;
    __device__ __forceinline__ void hook(f32x4 (&)[2][2][4][2], const Unit&, int, int, int, int, int) const {}
    __device__ __forceinline__ void operator()(const f32x4 (&acc)[2][2][4][2], const Unit& u, int wr, int wc, int fr, int fq) const {
        PG8_G float* QRAW = (PG8_G float*)(ws + WS_QRAW); const PG8_G float* ssqcq = (const PG8_G float*)(ws + WS_SSQC);
        const int col0 = u.pn * BM + wc * 32 + 4 * fq;
#pragma unroll
        for (int ai = 0; ai < 2; ++ai)
#pragma unroll
            for (int m = 0; m < 4; ++m) {
                const int row = u.pm * BM + ai * HALF + wr * 64 + m * 16 + fr;
                const f32x4 s = *(const PG8_G f32x4*)(ssqcq + (size_t)row * 4);
                const float r = 1.0f / sqrtf(((s[0] + s[1]) + (s[2] + s[3])) * (1.0f / 256.0f) + RMS_EPS);
#pragma unroll
                for (int bj = 0; bj < 2; ++bj)
#pragma unroll
                    for (int n = 0; n < 2; ++n) { const int c = col0 + bj * HALF + n * 16; if (c < 576) *(PG8_G f32x4*)(QRAW + (size_t)row * 576 + c) = acc[ai][bj][m][n] * r; }
            }
    }
};

struct EpiUkv {
    static constexpr bool PERM = true, AFTER_DRAIN = false, HOOK = false;
    PG8_G unsigned char* ws; const PG8_G float* gk;
    __device__ __forceinline__ void hook(f32x4 (&)[2][2][4][2], const Unit&, int, int, int, int, int) const {}
    __device__ __forceinline__ void operator()(const f32x4 (&acc)[2][2][4][2], const Unit& u, int wr, int wc, int fr, int fq) const {
        PG8_G bf16_t* KA = (PG8_G bf16_t*)(ws + WS_KA); PG8_G bf16_t* VA = (PG8_G bf16_t*)(ws + WS_VA); const PG8_G float* ssqckv = (const PG8_G float*)(ws + WS_SSQC) + (size_t)MROWS_ * 4; const PG8_G float* ssqkpe = (const PG8_G float*)(ws + WS_SSQC) + (size_t)MROWS_ * 6;
        const PG8_G float* kpe = (const PG8_G float*)(ws + WS_KPE); const PG8_G float* cs = (const PG8_G float*)(ws + WS_CS);
        const int h = 2 * u.pn + (wc >> 1); const bool isv = (wc & 1) != 0;
        f32x4 gn[2][2], g1 = {1.f, 1.f, 1.f, 1.f}, g2 = {1.f, 1.f, 1.f, 1.f};
        if (!isv) {
#pragma unroll
            for (int bj = 0; bj < 2; ++bj)
#pragma unroll
                for (int n = 0; n < 2; ++n) gn[bj][n] = *(const PG8_G f32x4*)(gk + 32 * bj + 8 * fq + 4 * n);
            g1 = *(const PG8_G f32x4*)(gk + 64 + 4 * fq); g2 = *(const PG8_G f32x4*)(gk + 80 + 4 * fq);
        }
#pragma unroll
        for (int ai = 0; ai < 2; ++ai)
#pragma unroll
            for (int m = 0; m < 4; ++m) {
                const int row = u.pm * BM + ai * HALF + wr * 64 + m * 16 + fr;
                const float r = 1.0f / sqrtf((ssqckv[(size_t)row * 2] + ssqckv[(size_t)row * 2 + 1]) * (1.0f / 128.0f) + RMS_EPS);
                f32x4 v[2][2]; float ss = 0.f;
#pragma unroll
                for (int bj = 0; bj < 2; ++bj)
#pragma unroll
                    for (int n = 0; n < 2; ++n) { v[bj][n] = acc[ai][bj][m][n] * r; ss += sq4(v[bj][n]); }
                if (isv) {
#pragma unroll
                    for (int bj = 0; bj < 2; ++bj) { u32x4 w; w.x = cvt_pk_bf16(v[bj][0][0], v[bj][0][1]); w.y = cvt_pk_bf16(v[bj][0][2], v[bj][0][3]); w.z = cvt_pk_bf16(v[bj][1][0], v[bj][1][1]); w.w = cvt_pk_bf16(v[bj][1][2], v[bj][1][3]);
                        *(PG8_G u32x4*)(VA + (size_t)row * 384 + 64 * h + 32 * bj + 8 * fq) = w; }
                } else {
                    ss += __shfl_xor(ss, 16); ss += __shfl_xor(ss, 32);
                    const float rk = 1.0f / sqrtf((ss + ssqkpe[row]) * (1.0f / 96.0f) + RMS_EPS);
                    PG8_G bf16_t* kd = KA + (size_t)row * 576 + 96 * h;
#pragma unroll
                    for (int bj = 0; bj < 2; ++bj) { const f32x4 y0 = v[bj][0] * gn[bj][0] * rk, y1 = v[bj][1] * gn[bj][1] * rk;
                        u32x4 w; w.x = cvt_pk_bf16(y0[0], y0[1]); w.y = cvt_pk_bf16(y0[2], y0[3]); w.z = cvt_pk_bf16(y1[0], y1[1]); w.w = cvt_pk_bf16(y1[2], y1[3]);
                        *(PG8_G u32x4*)(kd + 32 * bj + 8 * fq) = w; }
                    const f32x4 x1 = *(const PG8_G f32x4*)(kpe + (size_t)row * 32 + 4 * fq) * g1 * rk, x2 = *(const PG8_G f32x4*)(kpe + (size_t)row * 32 + 16 + 4 * fq) * g2 * rk;
                    const f32x4 c = *(const PG8_G f32x4*)(cs + (size_t)row * 32 + 4 * fq), s = *(const PG8_G f32x4*)(cs + (size_t)row * 32 + 16 + 4 * fq);
                    const f32x4 o1 = x1 * c - x2 * s, o2 = x2 * c + x1 * s;
                    u32x2 w1, w2; w1.x = cvt_pk_bf16(o1[0], o1[1]); w1.y = cvt_pk_bf16(o1[2], o1[3]); w2.x = cvt_pk_bf16(o2[0], o2[1]); w2.y = cvt_pk_bf16(o2[2], o2[3]);
                    *(PG8_G u32x2*)(kd + 64 + 4 * fq) = w1; *(PG8_G u32x2*)(kd + 80 + 4 * fq) = w2;
                }
                if (m & 1) PG8_FENCE();
            }
    }
};
}
#define GAS __attribute__((address_space(1)))
#define LAS __attribute__((address_space(3)))
typedef unsigned short bf16;
typedef unsigned v4u __attribute__((ext_vector_type(4)));
typedef float f32x4 __attribute__((ext_vector_type(4)));
typedef short bf16x8 __attribute__((ext_vector_type(8)));
typedef GAS unsigned gu32;
typedef GAS unsigned long long gu64;
#define RLX_AGENT __ATOMIC_RELAXED, __HIP_MEMORY_SCOPE_AGENT
#define LDS_WAIT() asm volatile("s_waitcnt lgkmcnt(0)" ::: "memory")
#define VM_WAIT() asm volatile("s_waitcnt vmcnt(0)" ::: "memory")
__device__ __forceinline__ unsigned long long rt() { return __builtin_amdgcn_s_memrealtime(); }
__device__ __forceinline__ unsigned f2bf(float f) { unsigned u = __builtin_bit_cast(unsigned, f); return (u + 0x7fffu + ((u >> 16) & 1u)) >> 16; }
__device__ __forceinline__ unsigned pk2(float lo, float hi) { return f2bf(lo) | (f2bf(hi) << 16); }

#define XB_TMO      128
#define XB_XCNT(j)  (256  + 64 * (j))
#define XB_XSUB(j)  (1280 + 64 * (j))
#define XB_XGEN(j)  (2304 + 64 * (j))
#define XB_TOP      3328
#define XB_TOPGEN   3392
#define XCD_BAR_WORDS 3456
#define XB_SPIN_CAP (1u << 18)

__device__ __forceinline__ unsigned xb_ld(unsigned* p)              { return __hip_atomic_load(p, __ATOMIC_RELAXED, __HIP_MEMORY_SCOPE_AGENT); }
__device__ __forceinline__ unsigned xb_add(unsigned* p, unsigned v) { return __hip_atomic_fetch_add(p, v, __ATOMIC_RELAXED, __HIP_MEMORY_SCOPE_AGENT); }
__device__ __forceinline__ unsigned xb_xcc_id() { return (unsigned)__builtin_amdgcn_s_getreg((3 << 11) | 20) & 0xFu; }
#define XB_SPIN(cond, bar) do { unsigned _sp = 0; while (cond) { __builtin_amdgcn_s_sleep(1); \
    if ((++_sp & 255u) == 0u) { if (xb_ld(&(bar)[XB_TMO])) break; if (_sp > XB_SPIN_CAP) { atomicAdd(&(bar)[XB_TMO], 1u); break; } } } } while (0)

struct XcdBarrier {
    unsigned* bar; unsigned x;
    volatile LAS unsigned* st;
};

__device__ __forceinline__ XcdBarrier xcd_barrier_post(unsigned* bar, volatile LAS unsigned* st) {
    XcdBarrier b; b.bar = bar; b.x = xb_xcc_id(); b.st = st;
    if (threadIdx.x == 0) (void)xb_add(&bar[XB_XCNT(b.x)], 1u);
    return b;
}
__device__ __forceinline__ void xcd_barrier_complete(unsigned* bar, unsigned x, unsigned& nloc, unsigned& nx) {
    const unsigned G = gridDim.x * gridDim.y * gridDim.z;
    unsigned sum, cnt, mine, sp = 0u;
    for (;;) {
        sum = 0u; cnt = 0u; mine = 0u;
#pragma unroll
        for (unsigned j = 0; j < 16; ++j) { const unsigned c = xb_ld(&bar[XB_XCNT(j)]); sum += c; cnt += (c > 0u) ? 1u : 0u; mine = (j == x) ? c : mine; }
        if (sum == G) break;
        __builtin_amdgcn_s_sleep(1);
        if ((++sp & 255u) == 0u) { if (xb_ld(&bar[XB_TMO])) break; if (sp > XB_SPIN_CAP) { atomicAdd(&bar[XB_TMO], 1u); break; } }
    }
    nloc = mine > 0u ? mine : 1u; nx = cnt > 0u ? cnt : 1u;
}

__device__ __forceinline__ void xcd_barrier(const XcdBarrier& b) {
    asm volatile("s_waitcnt vmcnt(0)" ::: "memory");
    __syncthreads();
    if (threadIdx.x == 0) {
        unsigned* bar = b.bar;
        __builtin_amdgcn_s_waitcnt(0);
        unsigned nloc = b.st[0], nx = b.st[1];
        if (nloc == 0u) { xcd_barrier_complete(bar, b.x, nloc, nx); b.st[0] = nloc; b.st[1] = nx; }
        const unsigned old = xb_add(&bar[XB_XSUB(b.x)], 1u);
        const unsigned gen = old / nloc;
        if (old + 1u == (gen + 1u) * nloc) {
            __builtin_amdgcn_fence(__ATOMIC_RELEASE, "agent");
            asm volatile("s_waitcnt vmcnt(0)" ::: "memory");
            const unsigned og = xb_add(&bar[XB_TOP], 1u);
            const unsigned tg = og / nx;
            if (og + 1u == (tg + 1u) * nx) xb_add(&bar[XB_TOPGEN], 1u);
            else XB_SPIN(xb_ld(&bar[XB_TOPGEN]) == tg, bar);
            __builtin_amdgcn_fence(__ATOMIC_ACQUIRE, "agent");
            xb_add(&bar[XB_XGEN(b.x)], 1u);
            asm volatile("s_waitcnt vmcnt(0)" ::: "memory");
        } else {
            XB_SPIN(xb_ld(&bar[XB_XGEN(b.x)]) == gen, bar);
            __builtin_amdgcn_fence(__ATOMIC_ACQUIRE, "agent");
            asm volatile("s_waitcnt vmcnt(0)" ::: "memory");
        }
    }
    __syncthreads();
}
namespace att {
typedef unsigned short bf16_t;
typedef short bf16x8 __attribute__((ext_vector_type(8)));
typedef short s16x4 __attribute__((ext_vector_type(4)));
typedef short v4i16_t __attribute__((ext_vector_type(4)));
typedef float f32x16 __attribute__((ext_vector_type(16)));
typedef float f32x4 __attribute__((ext_vector_type(4)));
typedef float f32x2 __attribute__((ext_vector_type(2)));
typedef __bf16 bf16x2_t __attribute__((ext_vector_type(2)));
typedef unsigned u32x4 __attribute__((ext_vector_type(4)));
typedef int i32x4 __attribute__((ext_vector_type(4)));
#define ALAS __attribute__((address_space(3)))
#define AGAS __attribute__((address_space(1)))
constexpr int SEQ = 8192;
constexpr float LOG2E = 1.4426950408889634f, EPS = 1e-6f;
constexpr int KCS = 1040, VHS = 4160;
constexpr int KSLOT = 12 * KCS, VSLOT = 2 * VHS;
constexpr int L_K = 0, L_V = 2 * KSLOT, L_POS = L_V + 2 * VSLOT, L_TB = L_POS + 512, L_WSF = L_TB + 128, L_OST = L_WSF + 8 * 256, L_FLAG = L_OST + 8 * 4096, L_END = L_FLAG + 16 + 64;
static_assert(L_OST % 16 == 0 && L_V % 16 == 0 && L_END <= 131072, "attention LDS map");

__device__ __forceinline__ int crow(int r, int hi) { return (r & 3) + 8 * (r >> 2) + 4 * hi; }
__device__ __forceinline__ unsigned cvtpk(float lo, float hi) { f32x2 v = {lo, hi}; bf16x2_t b = __builtin_convertvector(v, bf16x2_t); return __builtin_bit_cast(unsigned, b); }
__device__ __forceinline__ s16x4 vtr(const ALAS unsigned char* p) { return __builtin_bit_cast(s16x4, __builtin_amdgcn_ds_read_tr16_b64_v4i16((ALAS v4i16_t*)p)); }
__device__ __forceinline__ float swap_sum(float x) { auto rr = __builtin_amdgcn_permlane32_swap(__float_as_uint(x), __float_as_uint(x), false, false); return __uint_as_float(rr[0]) + __uint_as_float(rr[1]); }
__device__ __forceinline__ float swap_max(float x) { auto rr = __builtin_amdgcn_permlane32_swap(__float_as_uint(x), __float_as_uint(x), false, false); return fmaxf(__uint_as_float(rr[0]), __uint_as_float(rr[1])); }
__device__ __forceinline__ float bf2f(unsigned short h) { return __uint_as_float((unsigned)h << 16); }

struct AttnP {
    AGAS unsigned char* ws;
    const AGAS float* gq;
    const AGAS int* pos; const AGAS float* sinks; const AGAS float* relb;
};
template <int MODE> struct AttnCfg;
template <> struct AttnCfg<0> { static constexpr size_t Q = WS_QRAW, K = WS_KA, V = WS_VA; static constexpr int qpitch = 576, kpitch = 576, khs = 96, vpitch = 384, vhs = 64, ocol0 = 0, hidx0 = 0, group = 1; };
template <> struct AttnCfg<1> { static constexpr size_t Q = WS_QS, K = WS_KS, V = WS_VS; static constexpr int qpitch = 384, kpitch = 128, khs = 64, vpitch = 128, vhs = 64, ocol0 = 384, hidx0 = 6, group = 3; };
template <> struct AttnCfg<2> { static constexpr size_t Q = WS_QC, K = WS_KC, V = WS_VC; static constexpr int qpitch = 256, kpitch = 256, khs = 64, vpitch = 256, vhs = 64, ocol0 = 768, hidx0 = 12, group = 1; };

template <int DQK, int MODE>
__device__ __forceinline__ void attn_unit(ALAS unsigned char* lds, const AttnP& P, int b, int h, int qb) {
    constexpr int NCH = DQK / 8, ND0 = DQK / 16;
    int tid_ = threadIdx.x; asm volatile("" : "+v"(tid_));
    const int tid = tid_, lane = tid & 63, r32 = lane & 31, hi = lane >> 5;
    const int wid = __builtin_amdgcn_readfirstlane(tid >> 6);
    const int q0 = qb * 256, qlo = q0 + 32 * wid, qhi = qlo + 31, qrow = qlo + r32;
    const size_t rb = (size_t)b * SEQ;
    typedef AttnCfg<MODE> C; const int kvh = h / C::group;
    ALAS float* wsf = (ALAS float*)(lds + L_WSF) + wid * 64;
    ALAS unsigned char* ost = lds + L_OST + wid * 4096;
    ALAS int* posl = (ALAS int*)(lds + L_POS);
    ALAS float* tb = (ALAS float*)(lds + L_TB);

    bf16x8 qf[ND0];
    if constexpr (MODE == 0) {
        const AGAS float* qp = (const AGAS float*)(P.ws + C::Q) + (rb + qrow) * 576 + h * 96 + hi * 8;
        float qv[ND0][8]; float ss = 0.f;
#pragma unroll
        for (int d0 = 0; d0 < ND0; ++d0) { const f32x4 a = *(const AGAS f32x4*)(qp + 16 * d0), c = *(const AGAS f32x4*)(qp + 16 * d0 + 4);
#pragma unroll
            for (int i = 0; i < 4; ++i) { qv[d0][i] = a[i]; qv[d0][4 + i] = c[i]; ss += a[i] * a[i] + c[i] * c[i]; } }
        ss = swap_sum(ss);
        const float rq = 1.0f / sqrtf(ss * (1.0f / 96.0f) + EPS);
#pragma unroll
        for (int d0 = 0; d0 < ND0; ++d0) { const f32x4 ga = *(const AGAS f32x4*)(P.gq + 16 * d0 + 8 * hi), gb = *(const AGAS f32x4*)(P.gq + 16 * d0 + 8 * hi + 4);
#pragma unroll
            for (int i = 0; i < 4; ++i) { qv[d0][i] *= rq * ga[i]; qv[d0][4 + i] *= rq * gb[i]; } }
        {
            const AGAS float* cp = (const AGAS float*)(P.ws + WS_CS) + (rb + qrow) * 32 + 8 * hi;
            const f32x4 c0 = *(const AGAS f32x4*)cp, c1 = *(const AGAS f32x4*)(cp + 4), s0 = *(const AGAS f32x4*)(cp + 16), s1 = *(const AGAS f32x4*)(cp + 20);
#pragma unroll
            for (int i = 0; i < 8; ++i) { const float c = i < 4 ? c0[i & 3] : c1[i & 3], s = i < 4 ? s0[i & 3] : s1[i & 3]; const float x1 = qv[4][i], x2 = qv[5][i]; qv[4][i] = x1 * c - x2 * s; qv[5][i] = x2 * c + x1 * s; }
        }
        const float sc = 0.10206207261596575f * LOG2E;
#pragma unroll
        for (int d0 = 0; d0 < ND0; ++d0) { u32x4 w; w.x = cvtpk(qv[d0][0] * sc, qv[d0][1] * sc); w.y = cvtpk(qv[d0][2] * sc, qv[d0][3] * sc); w.z = cvtpk(qv[d0][4] * sc, qv[d0][5] * sc); w.w = cvtpk(qv[d0][6] * sc, qv[d0][7] * sc); qf[d0] = __builtin_bit_cast(bf16x8, w); }
    } else {
        const AGAS bf16_t* qp = (const AGAS bf16_t*)(P.ws + C::Q) + (rb + qrow) * C::qpitch + h * 64 + hi * 8;
#pragma unroll
        for (int d0 = 0; d0 < ND0; ++d0) qf[d0] = *(const AGAS bf16x8*)(qp + 16 * d0);
    }
    int posq = 0; float sink2 = 0.f;
    if constexpr (MODE == 1) {
        posq = P.pos[rb + qrow]; sink2 = P.sinks[h] * LOG2E;
        if (tid < 32) tb[tid] = P.relb[tid * 6 + h] * LOG2E;
    }

    int ntile, tfirst, tstep;
    if (MODE == 0) { tfirst = 0; tstep = 1; ntile = ((q0 + 255) >> 6) + 1; }
    else if (MODE == 1) { const int lo = q0 - 127 > 0 ? q0 - 127 : 0; tfirst = lo >> 6; tstep = 1; ntile = ((q0 + 255) >> 6) - tfirst + 1; }
    else { tfirst = (q0 + 254) >> 6; tstep = -1; ntile = tfirst + 1; }

    const AGAS bf16_t* Kg = (const AGAS bf16_t*)(P.ws + C::K) + rb * C::kpitch + kvh * C::khs;
    const AGAS bf16_t* Vg = (const AGAS bf16_t*)(P.ws + C::V) + rb * C::vpitch + kvh * C::vhs;
    const int kj0 = tid / NCH, kc0 = tid % NCH, kj1 = (tid + 512) / NCH, kc1 = (tid + 512) % NCH;
    const int vj = tid >> 3, vc = tid & 7;
    u32x4 kreg0, kreg1 = {0, 0, 0, 0}, vreg; int preg = 0;
#define ATT_LOAD(t) do { const int j0_ = (t) * 64; \
        kreg0 = *(const AGAS u32x4*)(Kg + (size_t)(j0_ + kj0) * C::kpitch + 8 * kc0); \
        if (NCH == 12 && tid < 256) kreg1 = *(const AGAS u32x4*)(Kg + (size_t)(j0_ + kj1) * C::kpitch + 8 * kc1); \
        vreg = *(const AGAS u32x4*)(Vg + (size_t)(j0_ + vj) * C::vpitch + 8 * vc); \
        if (MODE == 1 && tid < 64) preg = P.pos[rb + j0_ + tid]; } while (0)
#define ATT_WRITE(buf) do { ALAS unsigned char* kb_ = lds + L_K + (buf) * KSLOT; ALAS unsigned char* vb_ = lds + L_V + (buf) * VSLOT; \
        *(ALAS u32x4*)(kb_ + kc0 * KCS + kj0 * 16) = kreg0; \
        if (NCH == 12 && tid < 256) *(ALAS u32x4*)(kb_ + kc1 * KCS + kj1 * 16) = kreg1; \
        *(ALAS u32x4*)(vb_ + (vc >> 2) * VHS + vj * 64 + (vc & 3) * 16) = vreg; \
        if (MODE == 1 && tid < 64) posl[(buf) * 64 + tid] = preg; } while (0)

    f32x16 o0 = {}, o1 = {};
    float mrun = (MODE == 1) ? sink2 : -INFINITY;
    float lrun = (MODE == 1 && hi == 0) ? 1.0f : 0.f;
    float after = 0.f;
    bool walive = true;
    const int vrd = ((lane >> 4) & 1) * 32 + (lane & 3) * 8 + (4 * hi + ((lane & 15) >> 2)) * 64;

    ATT_LOAD(tfirst);
    __syncthreads();
    ATT_WRITE(0);
    __syncthreads();
    for (int it = 0; it < ntile; ++it) {
        const int t = tfirst + it * tstep, j0 = t * 64, buf = it & 1;
        if (it + 1 < ntile) ATT_LOAD(t + tstep);
        bool work, needmask;
        if (MODE == 0) { work = j0 <= qhi; needmask = j0 + 63 > qlo; }
        else if (MODE == 1) { work = (j0 <= qhi) && (j0 + 63 >= qlo - 127); needmask = true; }
        else { work = walive && (j0 < qhi); needmask = j0 + 63 >= qlo; }
        if (work) {
            const ALAS unsigned char* Kb = lds + L_K + buf * KSLOT + hi * KCS + r32 * 16;
            f32x16 p0 = {}, p1 = {};
#pragma unroll
            for (int d0 = 0; d0 < ND0; ++d0) {
                const bf16x8 a0 = *(const ALAS bf16x8*)(Kb + 2 * d0 * KCS), a1 = *(const ALAS bf16x8*)(Kb + 2 * d0 * KCS + 512);
                p0 = __builtin_amdgcn_mfma_f32_32x32x16_bf16(a0, qf[d0], p0, 0, 0, 0);
                p1 = __builtin_amdgcn_mfma_f32_32x32x16_bf16(a1, qf[d0], p1, 0, 0, 0);
            }
            if constexpr (MODE == 2) {
                float ln0[16], ln1[16];
#pragma unroll
                for (int r = 0; r < 16; ++r) {
                    const int key = j0 + crow(r, hi);
                    { const float z = p0[r]; const float sp = fmaxf(z, 0.f) + __builtin_amdgcn_logf(1.0f + __builtin_amdgcn_exp2f(-fabsf(z))); const bool ok = !needmask || key < qrow; ln0[r] = ok ? -sp : 0.f; p0[r] = ok ? z - sp : -INFINITY; }
                    { const float z = p1[r]; const float sp = fmaxf(z, 0.f) + __builtin_amdgcn_logf(1.0f + __builtin_amdgcn_exp2f(-fabsf(z))); const bool ok = !needmask || key + 32 < qrow; ln1[r] = ok ? -sp : 0.f; p1[r] = ok ? z - sp : -INFINITY; }
                }
                float run = after;
#pragma unroll
                for (int blk = 1; blk >= 0; --blk)
#pragma unroll
                    for (int g = 3; g >= 0; --g) {
                        const float own = blk ? ((ln1[4 * g] + ln1[4 * g + 1]) + (ln1[4 * g + 2] + ln1[4 * g + 3])) : ((ln0[4 * g] + ln0[4 * g + 1]) + (ln0[4 * g + 2] + ln0[4 * g + 3]));
                        auto rr = __builtin_amdgcn_permlane32_swap(__float_as_uint(own), __float_as_uint(own), false, false);
                        const float slo = __uint_as_float(rr[0]), shi = __uint_as_float(rr[1]);
                        const float e1 = run; run += shi; const float e0 = run; run += slo;
                        float aft = hi ? e1 : e0;
#pragma unroll
                        for (int i = 3; i >= 0; --i) {
                            const int r = 4 * g + i;
                            if (blk) { p1[r] = __builtin_amdgcn_exp2f(p1[r] + aft); aft += ln1[r]; } else { p0[r] = __builtin_amdgcn_exp2f(p0[r] + aft); aft += ln0[r]; }
                        }
                    }
                after = run;
                walive = __any(after > -160.0f);
            } else {
                if constexpr (MODE == 1) {
#pragma unroll
                    for (int g = 0; g < 4; ++g) {
                        const i32x4 pa = *(const ALAS i32x4*)(posl + buf * 64 + 8 * g + 4 * hi), pb = *(const ALAS i32x4*)(posl + buf * 64 + 32 + 8 * g + 4 * hi);
#pragma unroll
                        for (int i = 0; i < 4; ++i) {
                            { int n = posq - pa[i]; n = n > 0 ? n : 0; int bk = n; if (n >= 16) { bk = 16 + (int)((__builtin_amdgcn_logf((float)n) - 4.0f) * (16.0f / 3.0f)); bk = bk < 31 ? bk : 31; } p0[4 * g + i] += tb[bk]; }
                            { int n = posq - pb[i]; n = n > 0 ? n : 0; int bk = n; if (n >= 16) { bk = 16 + (int)((__builtin_amdgcn_logf((float)n) - 4.0f) * (16.0f / 3.0f)); bk = bk < 31 ? bk : 31; } p1[4 * g + i] += tb[bk]; }
                        }
                    }
                }
                if (needmask) {
#pragma unroll
                    for (int r = 0; r < 16; ++r) {
                        const int key = j0 + crow(r, hi);
                        bool ok0 = key <= qrow, ok1 = key + 32 <= qrow;
                        if (MODE == 1) { ok0 = ok0 && (key > qrow - 128); ok1 = ok1 && (key + 32 > qrow - 128); }
                        if (!ok0) p0[r] = -INFINITY; if (!ok1) p1[r] = -INFINITY;
                    }
                }
                float mt = fmaxf(p0[0], p1[0]);
#pragma unroll
                for (int r = 1; r < 16; ++r) mt = fmaxf(mt, fmaxf(p0[r], p1[r]));
                mt = swap_max(mt);
                const float mnew = fmaxf(mrun, mt);
                const float alpha = __builtin_amdgcn_exp2f(mrun - mnew);
                const bool resc = !__all(mnew == mrun);
                mrun = mnew;
                float ls = 0.f;
#pragma unroll
                for (int r = 0; r < 16; ++r) { p0[r] = __builtin_amdgcn_exp2f(p0[r] - mnew); p1[r] = __builtin_amdgcn_exp2f(p1[r] - mnew); ls += p0[r] + p1[r]; }
                lrun = lrun * alpha + ls;
                if (resc) {
                    if (hi == 0) wsf[r32] = alpha;
#pragma unroll
                    for (int g = 0; g < 4; ++g) { const f32x4 al = *(const ALAS f32x4*)(wsf + 8 * g + 4 * hi);
#pragma unroll
                        for (int i = 0; i < 4; ++i) { o0[4 * g + i] *= al[i]; o1[4 * g + i] *= al[i]; } }
                }
            }
            const ALAS unsigned char* Vb = lds + L_V + buf * VSLOT + vrd;
#pragma unroll
            for (int s = 0; s < 4; ++s) {
                u32x4 w;
                if (s < 2) { const int bs = 8 * s; w.x = cvtpk(p0[bs], p0[bs + 1]); w.y = cvtpk(p0[bs + 2], p0[bs + 3]); w.z = cvtpk(p0[bs + 4], p0[bs + 5]); w.w = cvtpk(p0[bs + 6], p0[bs + 7]); }
                else { const int bs = 8 * (s - 2); w.x = cvtpk(p1[bs], p1[bs + 1]); w.y = cvtpk(p1[bs + 2], p1[bs + 3]); w.z = cvtpk(p1[bs + 4], p1[bs + 5]); w.w = cvtpk(p1[bs + 6], p1[bs + 7]); }
                const bf16x8 pa = __builtin_bit_cast(bf16x8, w);
                const s16x4 l0 = vtr(Vb + s * 1024), h0 = vtr(Vb + s * 1024 + 512), l1 = vtr(Vb + VHS + s * 1024), h1 = vtr(Vb + VHS + s * 1024 + 512);
                const bf16x8 v0 = {l0[0], l0[1], l0[2], l0[3], h0[0], h0[1], h0[2], h0[3]}, v1 = {l1[0], l1[1], l1[2], l1[3], h1[0], h1[1], h1[2], h1[3]};
                o0 = __builtin_amdgcn_mfma_f32_32x32x16_bf16(pa, v0, o0, 0, 0, 0);
                o1 = __builtin_amdgcn_mfma_f32_32x32x16_bf16(pa, v1, o1, 0, 0, 0);
            }
        }
        if (it + 1 < ntile) ATT_WRITE(buf ^ 1);
        if (MODE == 2) {
            ALAS int* fl = (ALAS int*)(lds + L_FLAG + 16) + (it & 1) * 8;
            if (lane == 0) fl[wid] = (walive && j0 > 0) ? 1 : 0;
            __syncthreads();
            const i32x4 fa = *(const ALAS i32x4*)fl, fb = *(const ALAS i32x4*)(fl + 4);
            if (((fa[0] | fa[1]) | (fa[2] | fa[3]) | (fb[0] | fb[1]) | (fb[2] | fb[3])) == 0) break;
        } else __syncthreads();
    }
#undef ATT_LOAD
#undef ATT_WRITE
    if (MODE != 2) {
        const float lt = swap_sum(lrun);
        if (hi == 0) wsf[32 + r32] = 1.0f / lt;
#pragma unroll
        for (int g = 0; g < 4; ++g) { const f32x4 il = *(const ALAS f32x4*)(wsf + 32 + 8 * g + 4 * hi);
#pragma unroll
            for (int i = 0; i < 4; ++i) { o0[4 * g + i] *= il[i]; o1[4 * g + i] *= il[i]; } }
    }
    {
        ALAS bf16_t* stg = (ALAS bf16_t*)ost;
#pragma unroll
        for (int r = 0; r < 16; ++r) { const int orow = crow(r, hi); stg[orow * 64 + r32] = (bf16_t)(cvtpk(o0[r], 0.f) & 0xffffu); stg[orow * 64 + 32 + r32] = (bf16_t)(cvtpk(o1[r], 0.f) & 0xffffu); }
        AGAS bf16_t* Ow = (AGAS bf16_t*)(P.ws + WS_OALL) + (rb + qlo) * 1024 + C::ocol0 + h * 64;
#pragma unroll
        for (int i = 0; i < 4; ++i) {
            const int row = i * 8 + (lane >> 3), ch = lane & 7;
            const u32x4 v = *(const ALAS u32x4*)(stg + row * 64 + ch * 8);
            float ss = 0.f;
#pragma unroll
            for (int k = 0; k < 4; ++k) { const unsigned w = v[k]; const float a = __uint_as_float(w << 16), c = __uint_as_float(w & 0xffff0000u); ss += a * a + c * c; }
            ss += __shfl_xor(ss, 1); ss += __shfl_xor(ss, 2); ss += __shfl_xor(ss, 4);
            *(AGAS u32x4*)(Ow + (size_t)row * 1024 + ch * 8) = v;
            if (ch == 0) ((AGAS float*)(P.ws + WS_SSQO))[(rb + qlo + row) * 16 + C::hidx0 + h] = ss;
        }
    }
}
#undef ALAS
#undef AGAS
}
struct Args { const void* in[23]; float* out; unsigned char* ws; int ph_lo, ph_hi, li, adapt; };

struct Frame { LAS unsigned char* lds; int tid, lane, wave, vcu, G; };

__device__ __forceinline__ float wave_sum64(float v) {
#pragma unroll
    for (int o = 1; o < 64; o <<= 1) v += __shfl_xor(v, o);
    return v;
}

__device__ __forceinline__ void tr_item64(const GAS float* W, int ldn, int K, GAS pg8::bf16_t* WT, int kb, int g, int src0, int src1, const GAS float* kgain, LAS unsigned* scr, int lane) {
    const int k0 = 64 * kb; const int col = lane < 32 ? src0 + lane : src1 + (lane - 32); const bool ok = (lane < 32 ? src0 : src1) >= 0;
#pragma unroll 8
    for (int i = 0; i < 32; ++i) { float v0 = 0.f, v1 = 0.f;
        if (ok) { v0 = W[(size_t)(k0 + 2 * i) * ldn + col]; v1 = W[(size_t)(k0 + 2 * i + 1) * ldn + col]; }
        if (kgain) { v0 *= kgain[k0 + 2 * i]; v1 *= kgain[k0 + 2 * i + 1]; }
        scr[i * 65 + lane] = pk2(v0, v1); }
    asm volatile("s_waitcnt lgkmcnt(0)" ::: "memory");
    const int c = lane & 7;
#pragma unroll
    for (int j = 0; j < 8; ++j) { const int n = (lane >> 3) + 8 * j; const LAS unsigned* s = scr + (4 * c) * 65 + n;
        v4u o; o.x = s[0]; o.y = s[65]; o.z = s[130]; o.w = s[195];
        *(GAS v4u*)(WT + (size_t)(64 * g + n) * K + k0 + 8 * c) = o; }
    asm volatile("s_waitcnt lgkmcnt(0)" ::: "memory");
}
__device__ __forceinline__ int in_slot_src(int slot, int& cnt) {
    cnt = 64;
    if (slot < 4) return 64 * slot;
    if (slot < 6) return 256 + 64 * (slot - 4);
    if (slot == 6) { cnt = 32; return 384; }
    if (slot == 7) return -1;
    if (slot < 14) return 416 + 64 * (slot - 8);
    if (slot < 16) return 800 + 64 * (slot - 14);
    if (slot < 18) return 928 + 64 * (slot - 16);
    if (slot < 22) return 1056 + 64 * (slot - 18);
    if (slot < 26) return 1312 + 64 * (slot - 22);
    if (slot < 30) return 1568 + 64 * (slot - 26);
    return -1;
}

#define A_X ((const GAS float*)args.in[0])
#define A_C ((const GAS float*)args.in[1])
#define A_POS ((const GAS int*)args.in[2])
#define A_RELB ((const GAS float*)args.in[3])
#define A_NORMG ((const GAS float*)args.in[4])
#define A_WMOD ((const GAS float*)args.in[5])
#define A_BMOD ((const GAS float*)args.in[6])
#define A_WGU1 ((const GAS float*)args.in[7])
#define A_WD1 ((const GAS float*)args.in[8])
#define A_WIN ((const GAS float*)args.in[9])
#define A_QAN ((const GAS float*)args.in[10])
#define A_KVAN ((const GAS float*)args.in[11])
#define A_WUQ ((const GAS float*)args.in[12])
#define A_WUKV ((const GAS float*)args.in[13])
#define A_MLAQN ((const GAS float*)args.in[14])
#define A_MLAKN ((const GAS float*)args.in[15])
#define A_SWAQN ((const GAS float*)args.in[16])
#define A_SWAKN ((const GAS float*)args.in[17])
#define A_SINKS ((const GAS float*)args.in[18])
#define A_OUTN ((const GAS float*)args.in[19])
#define A_WOUT ((const GAS float*)args.in[20])
#define A_WGU2 ((const GAS float*)args.in[21])
#define A_WD2 ((const GAS float*)args.in[22])
#define WSP(off)   (ws_ + (off))
#define MOD ((GAS float*)WSP(WS_MOD))
#define GS ((GAS float*)WSP(WS_GS))
#define BIAS ((GAS float*)WSP(WS_BIAS))
#define SSQX ((GAS float*)WSP(WS_SSQX))
#define SSQO ((GAS float*)WSP(WS_SSQO))
#define CS ((GAS float*)WSP(WS_CS))
#define KPE ((GAS float*)WSP(WS_KPE))
#define SSQ_CQ ((GAS float*)WSP(WS_SSQC))
#define SSQ_CKV ((GAS float*)WSP(WS_SSQC) + (size_t)MROWS * 4)
#define SSQ_KPE ((GAS float*)WSP(WS_SSQC) + (size_t)MROWS * 6)
#define XB ((GAS pg8::bf16_t*)WSP(WS_XB))
#define HID ((GAS pg8::bf16_t*)WSP(WS_HID))
#define CQ ((GAS pg8::bf16_t*)WSP(WS_CQ))
#define CKV ((GAS pg8::bf16_t*)WSP(WS_CKV))
#define KA ((GAS pg8::bf16_t*)WSP(WS_KA))
#define VA ((GAS pg8::bf16_t*)WSP(WS_VA))
#define QS ((GAS pg8::bf16_t*)WSP(WS_QS))
#define KS ((GAS pg8::bf16_t*)WSP(WS_KS))
#define VS ((GAS pg8::bf16_t*)WSP(WS_VS))
#define QC ((GAS pg8::bf16_t*)WSP(WS_QC))
#define KC ((GAS pg8::bf16_t*)WSP(WS_KC))
#define VC ((GAS pg8::bf16_t*)WSP(WS_VC))
#define OALL ((GAS pg8::bf16_t*)WSP(WS_OALL))
#define QRAW ((GAS float*)WSP(WS_QRAW))

__device__ __forceinline__ int in_group_src(int g32) {
    const int tile = g32 >> 3, rr = g32 & 7, bj = rr >> 2, wc = rr & 3; int cnt; const int base = in_slot_src(tile * 4 + wc, cnt);
    return (base >= 0 && 32 * bj < cnt) ? base + 32 * bj : -1;
}
__device__ __forceinline__ void phase_pro0(Frame& F, const Args& args, gu32* qhead) {
    GAS unsigned char* ws_ = (GAS unsigned char*)args.ws; asm volatile("" : "+s"(ws_));
    constexpr int NMU = DEPTH * NMOD / 128;
    if ((int)blockIdx.x < NMU || F.G <= NMU) {
        LAS float* cond = (LAS float*)F.lds;
        LAS float* red = (LAS float*)(F.lds + 8192);
        for (int i = F.tid; i < 2 * DM; i += 512) { const float cv = A_C[i]; cond[i] = cv / (1.0f + expf(-cv)); }
        __syncthreads();
        for (int u = blockIdx.x; u < NMU; u += F.G) {
            const int l = u / (NMOD / 128), n0 = (u % (NMOD / 128)) * 128, c4 = F.lane & 31, kp = F.lane >> 5;
            const GAS float* w = A_WMOD + (size_t)l * DM * NMOD + n0 + 4 * c4;
            f32x4 a0 = {0.f, 0.f, 0.f, 0.f}, a1 = {0.f, 0.f, 0.f, 0.f};
#pragma unroll 8
            for (int i = 0; i < 64; ++i) { const int kk = F.wave * 128 + 2 * i + kp; const f32x4 wv = *(const GAS f32x4*)(w + (size_t)kk * NMOD); a0 += wv * cond[kk]; a1 += wv * cond[DM + kk]; }
#pragma unroll
            for (int q = 0; q < 4; ++q) { a0[q] += __shfl_xor(a0[q], 32); a1[q] += __shfl_xor(a1[q], 32); }
            if (kp == 0) { *(LAS f32x4*)(red + (F.wave * 2 + 0) * 128 + 4 * c4) = a0; *(LAS f32x4*)(red + (F.wave * 2 + 1) * 128 + 4 * c4) = a1; }
            __syncthreads();
            if (F.tid < 256) { const int bb = F.tid >> 7, ln = F.tid & 127; float s = 0.f;
#pragma unroll
                for (int wv = 0; wv < 8; ++wv) s += red[(wv * 2 + bb) * 128 + ln];
                MOD[((size_t)l * 2 + bb) * NMOD + n0 + ln] = s + A_BMOD[(size_t)l * NMOD + n0 + ln]; }
            __syncthreads();
        }
    }
    if ((int)blockIdx.x >= NMU || F.G <= NMU) {
        const int nb = F.G <= NMU ? F.G : F.G - NMU, b0 = F.G <= NMU ? (int)blockIdx.x : (int)blockIdx.x - NMU;
        for (int i = b0 * 512 + F.tid; i < MROWS * 16; i += nb * 512) {
            const int m = i >> 4, j = i & 15;
            const float freq = powf(10000.0f, -(float)j / 16.0f);
            const float ang = (float)A_POS[m] * freq;
            CS[(size_t)m * 32 + j] = cosf(ang); CS[(size_t)m * 32 + 16 + j] = sinf(ang);
        }
    }
    {
        LAS unsigned* scr = (LAS unsigned*)(F.lds + 16384 + F.wave * 8448);
        LAS int* slot = (LAS int*)(F.lds + 12288);
        constexpr int I_GU = 16 * 88, I_D = 44 * 16, I_IN = 16 * 32, I_UQ = 4 * 12, I_UKV = 2 * 12, I_OUT = 16 * 16;
        constexpr int I_L = 2 * I_GU + 2 * I_D + I_IN + I_UQ + I_UKV + I_OUT, I_ALL = DEPTH * I_L;
        for (;;) {
            __syncthreads();
            if (F.tid == 0) slot[0] = (int)__hip_atomic_fetch_add(qhead, 16u, __ATOMIC_RELAXED, __HIP_MEMORY_SCOPE_AGENT);
            __syncthreads();
            const int base = slot[0];
            if (base >= I_ALL) break;
#pragma unroll 1
            for (int q = 0; q < 2; ++q) {
                const int it = base + F.wave * 2 + q; if (it >= I_ALL) break;
                const int l = it / I_L; int r = it % I_L;
                GAS unsigned char* wl = ws_ + WS_W + (size_t)l * WL;
                if (r < 2 * I_GU) {
                    const bool second = r >= I_GU; if (second) r -= I_GU;
                    const int kb = r / 88, g = r % 88, t = g >> 2, rr = g & 3, src = (rr >> 1) * DFF + 128 * t + 64 * (rr & 1);
                    const GAS float* W = (second ? A_WGU2 : A_WGU1) + (size_t)l * DM * 2 * DFF;
                    tr_item64(W, 2 * DFF, DM, (GAS pg8::bf16_t*)(wl + (second ? W_GU2 : W_GU1)), kb, g, src, src + 32, nullptr, scr, F.lane); continue; }
                r -= 2 * I_GU;
                if (r < 2 * I_D) { const bool second = r >= I_D; if (second) r -= I_D; const int kb = r / 16, g = r % 16;
                    tr_item64((second ? A_WD2 : A_WD1) + (size_t)l * DFF * DM, DM, DFF, (GAS pg8::bf16_t*)(wl + (second ? W_D2 : W_D1)), kb, g, 64 * g, 64 * g + 32, nullptr, scr, F.lane); continue; }
                r -= 2 * I_D;
                if (r < I_IN) { const int kb = r / 32, g = r % 32;
                    tr_item64(A_WIN + (size_t)l * DM * DIN, DIN, DM, (GAS pg8::bf16_t*)(wl + W_IN), kb, g, in_group_src(2 * g), in_group_src(2 * g + 1), nullptr, scr, F.lane); continue; }
                r -= I_IN;
                if (r < I_UQ) { const int kb = r / 12, g = r % 12;
                    tr_item64(A_WUQ + (size_t)l * 256 * 576, 576, 256, (GAS pg8::bf16_t*)(wl + W_UQ), kb, g, g < 9 ? 64 * g : -1, g < 9 ? 64 * g + 32 : -1, A_QAN + l * 256, scr, F.lane); continue; }
                r -= I_UQ;
                if (r < I_UKV) { const int kb = r / 12, g = r % 12, g0 = 2 * g, g1 = 2 * g + 1;
                    tr_item64(A_WUKV + (size_t)l * 128 * 768, 768, 128, (GAS pg8::bf16_t*)(wl + W_UKV), kb, g, 256 * (g0 >> 3) + 64 * (g0 & 3) + 32 * ((g0 & 7) >> 2), 256 * (g1 >> 3) + 64 * (g1 & 3) + 32 * ((g1 & 7) >> 2), A_KVAN + l * 128, scr, F.lane); continue; }
                r -= I_UKV;
                { const int kb = r / 16, g = r % 16;
                    tr_item64(A_WOUT + (size_t)l * DM * DM, DM, DM, (GAS pg8::bf16_t*)(wl + W_OUT), kb, g, 64 * g, 64 * g + 32, A_OUTN + l * DM, scr, F.lane); }
            }
        }
    }
}

__device__ __forceinline__ void x_to_xb(Frame& F, const Args& args, const GAS float* xsrc, int l, int i) {
    GAS unsigned char* ws_ = (GAS unsigned char*)args.ws; asm volatile("" : "+s"(ws_));
    const int gw = F.vcu * NWAVES + F.wave, NGW = F.G * NWAVES;
    for (int m = gw; m < MROWS; m += NGW) {
        const int b = m >> 13;
        const GAS f32x4* xr = (const GAS f32x4*)(xsrc + (size_t)m * DM) + F.lane;
        const GAS f32x4* gr = (const GAS f32x4*)(A_NORMG + ((size_t)l * 3 + i) * DM) + F.lane;
        const GAS f32x4* sr = (const GAS f32x4*)(MOD + ((size_t)l * 2 + b) * NMOD + (3 * i + 1) * DM) + F.lane;
        float s = 0.f;
        GAS unsigned long long* o8 = (GAS unsigned long long*)(XB + (size_t)m * DM) + F.lane;
#pragma unroll
        for (int j = 0; j < 4; ++j) { const f32x4 v = xr[64 * j]; s += (v.x * v.x + v.y * v.y) + (v.z * v.z + v.w * v.w);
            const f32x4 g = gr[64 * j] * (sr[64 * j] + 1.0f); const f32x4 y = v * g;
            o8[64 * j] = (unsigned long long)pk2(y.x, y.y) | ((unsigned long long)pk2(y.z, y.w) << 32); }
        s = wave_sum64(s);
        if (F.lane < 16) SSQX[(size_t)m * 16 + F.lane] = (F.lane == 0) ? s : 0.f;
    }
}

__device__ __forceinline__ void phase_pro1(Frame& F, const Args& args) {
    GAS unsigned char* ws_ = (GAS unsigned char*)args.ws; asm volatile("" : "+s"(ws_));
    for (int i = blockIdx.x * 512 + F.tid; i < DEPTH * 3 * 2 * DM; i += F.G * 512) {
        const int cidx = i & 1023, b = (i >> 10) & 1, li = i >> 11, l = li / 3, ii = li % 3;
        GS[i] = A_NORMG[((size_t)l * 3 + ii) * DM + cidx] * (1.0f + MOD[((size_t)l * 2 + b) * NMOD + (3 * ii + 1) * DM + cidx]);
    }
    const int gw = F.vcu * NWAVES + F.wave, NGW = F.G * NWAVES;
    constexpr int RL = 5632 + 2048 + 5632;
    for (int it = gw; it < DEPTH * RL; it += NGW) {
        const int l = it / RL; int r = it % RL; int which, nrow; size_t woff; size_t boff;
        if (r < 5632) { which = 0; nrow = 5632; woff = W_GU1; boff = 0; } else if (r < 5632 + 2048) { r -= 5632; which = 1; nrow = 2048; woff = W_IN; boff = 2 * 5632; } else { r -= 5632 + 2048; which = 2; nrow = 5632; woff = W_GU2; boff = 2 * (5632 + 2048); }
        const GAS pg8::bf16_t* wr = (const GAS pg8::bf16_t*)(ws_ + WS_W + (size_t)l * WL + woff) + (size_t)r * DM;
        float a0 = 0.f, a1 = 0.f;
#pragma unroll
        for (int j = 0; j < 2; ++j) {
            const v4u wv = *(const GAS v4u*)(wr + j * 512 + F.lane * 8);
            const GAS float* s0 = MOD + ((size_t)l * 2 + 0) * NMOD + (3 * which) * DM + j * 512 + F.lane * 8; const GAS float* s1 = s0 + NMOD;
#pragma unroll
            for (int k = 0; k < 4; ++k) { const unsigned w = wv[k]; const float lo = __uint_as_float(w << 16), hi = __uint_as_float(w & 0xffff0000u);
                a0 += lo * s0[2 * k] + hi * s0[2 * k + 1]; a1 += lo * s1[2 * k] + hi * s1[2 * k + 1]; }
        }
        a0 = wave_sum64(a0); a1 = wave_sum64(a1);
        if (F.lane == 0) { BIAS[(size_t)l * BIAS_L + boff + r] = a0; BIAS[(size_t)l * BIAS_L + boff + nrow + r] = a1; }
    }
    x_to_xb(F, args, A_X, 0, 0);
}

__device__ __forceinline__ int next_unit(Frame& F, gu32* head) {
    LAS int* slot = (LAS int*)(F.lds + att::L_FLAG);
    __syncthreads();
    if (F.tid == 0) slot[0] = (int)__hip_atomic_fetch_add(head, 1u, __ATOMIC_RELAXED, __HIP_MEMORY_SCOPE_AGENT);
    __syncthreads();
    return slot[0];
}

#ifndef DUPS
#define DUPS -1
#endif
#ifndef PHM
#define PHM 255
#endif
#ifndef PHM2
#define PHM2 15
#endif
__global__ void __launch_bounds__(NWAVES * 64, 2) fwd_mega(Args args) {
    extern __shared__ __attribute__((aligned(16))) unsigned char lds[];
    Frame F; F.lds = (LAS unsigned char*)lds; F.tid = threadIdx.x; F.lane = F.tid & 63; F.wave = __builtin_amdgcn_readfirstlane(F.tid >> 6);
    F.G = gridDim.x; { const int bx = blockIdx.x; F.vcu = (F.G % 8 == 0) ? (bx % 8) * (F.G / 8) + bx / 8 : bx; }
    gu32* ctl = (gu32*)(args.ws + WS_CTL);
    for (int u = F.tid; u < (LDS_BYTES - LDSCTL_OFF) / 4; u += NWAVES * 64) ((LAS unsigned*)(F.lds + LDSCTL_OFF))[u] = 0u;
    __syncthreads();
    if (args.adapt >= 0) { x_to_xb(F, args, (const GAS float*)args.out, args.adapt / 3, args.adapt % 3); return; }
    const int lo = args.ph_lo, hi = args.ph_hi;
    XcdBarrier bar; bar.bar = (unsigned*)(ctl + CW_BAR) + args.li * XCD_BAR_WORDS; bar.x = 0; bar.st = nullptr;
    if (hi - lo > 1) bar = xcd_barrier_post((unsigned*)(ctl + CW_BAR) + args.li * XCD_BAR_WORDS, (volatile LAS unsigned*)(F.lds + MISC_OFF) + 8);

    for (int ph = lo; ph < hi; ++ph) {
        { int t_ = threadIdx.x; asm volatile("" : "+v"(t_)); F.tid = t_; F.lane = t_ & 63; F.wave = __builtin_amdgcn_readfirstlane(t_ >> 6); }
        GAS unsigned char* ws_ = (GAS unsigned char*)args.ws; asm volatile("" : "+s"(ws_));
        int nrep = 1;
        if (DUPS >= 0) { const int ty = ph < 2 ? 8 + ph : ((ph - 2) & 7); if (ty == DUPS && !(ty == 5) && !((ty == 1 || ty == 7) && ph != 3)) nrep = 2; }
        for (int rep = 0; rep < nrep; ++rep) {
        if ((PHM & 64) && ph == 0) phase_pro0(F, args, ctl + CW_Q + 64 * 8);
        else if ((PHM & 128) && ph == 1) phase_pro1(F, args);
        else {
            const int l = (ph - 2) >> 3, s = (ph - 2) & 7;
            const GAS unsigned char* wl = ws_ + WS_W + (size_t)l * WL;
            const GAS float* biasl = BIAS + (size_t)l * BIAS_L;
            const GAS float* modl = MOD + (size_t)l * 2 * NMOD;
            if ((PHM & 1) && (s == 0 || s == 6)) {
                pg8::Gemm g{(const pg8::bf16_t*)XB, (const pg8::bf16_t*)(wl + (s == 0 ? W_GU1 : W_GU2)), MROWS, 5632, DM}; pg8::StaticOrder S; S.init(MROWS, 5632, F.G, (int)blockIdx.x);
                pg8::EpiUp E{ws_, biasl + (s == 0 ? 0 : 2 * (5632 + 2048))};
                pg8::gemm_phase<pg8::EpiUp, pg8::StaticOrder, true, true>(F.lds, g, S, E);
            } else if ((PHM & 2) && (s == 1 || s == 7)) {
                pg8::Gemm g{(const pg8::bf16_t*)HID, (const pg8::bf16_t*)(wl + (s == 1 ? W_D1 : W_D2)), MROWS, DM, DFF}; pg8::StaticOrder S; S.init(MROWS, DM, F.G, (int)blockIdx.x);
                const bool lastp = (s == 7 && l == DEPTH - 1);
                const GAS float* gsn = lastp ? nullptr : (s == 1 ? GS + ((size_t)(l * 3 + 1) * 2) * DM : GS + ((size_t)((l + 1) * 3 + 0) * 2) * DM);
                const GAS float* xin = (s == 1 && l == 0) ? A_X : (const GAS float*)args.out;
                pg8::EpiRes<false> E{xin, (GAS float*)args.out, ws_, modl + (s == 1 ? 2 : 8) * DM, gsn, 0.5f};
                pg8::gemm_phase<pg8::EpiRes<false>, pg8::StaticOrder, true, true>(F.lds, g, S, E);
            } else if ((PHM & 4) && s == 2) {
                pg8::Gemm g{(const pg8::bf16_t*)XB, (const pg8::bf16_t*)(wl + W_IN), MROWS, 2048, DM}; pg8::StaticOrder S; S.init(MROWS, 2048, F.G, (int)blockIdx.x);
                pg8::EpiIn E{ws_, A_SWAQN + l * 64, A_SWAKN + l * 64, biasl + 2 * 5632};
                pg8::gemm_phase<pg8::EpiIn, pg8::StaticOrder, true, true>(F.lds, g, S, E);
            } else if ((PHM & 8) && s == 3) {
                if (PHM2 & 1) { pg8::Gemm g{(const pg8::bf16_t*)CQ, (const pg8::bf16_t*)(wl + W_UQ), MROWS, 768, 256}; pg8::StaticOrder S; S.init(MROWS, 768, F.G, (int)blockIdx.x);
                  pg8::EpiUq E{ws_}; pg8::gemm_phase<pg8::EpiUq, pg8::StaticOrder, true, true>(F.lds, g, S, E); }
                if (PHM2 & 2) { pg8::Gemm g{(const pg8::bf16_t*)CKV, (const pg8::bf16_t*)(wl + W_UKV), MROWS, 768, 128}; pg8::StaticOrder S; S.init(MROWS, 768, F.G, (int)((blockIdx.x + 64) % F.G));
                  pg8::EpiUkv E{ws_, A_MLAKN + l * 96}; pg8::gemm_phase<pg8::EpiUkv, pg8::StaticOrder, true, true>(F.lds, g, S, E); }
            } else if ((PHM & 16) && s == 4) {
                att::AttnP PA{ws_, A_MLAQN + l * 96, nullptr, nullptr, nullptr};
                att::AttnP PB{ws_, nullptr, A_POS, A_SINKS + l * 6, A_RELB};
                att::AttnP PC{ws_, nullptr, nullptr, nullptr, nullptr};
                gu32* head = ctl + CW_Q + 64 * (2 * l + 1 + 4 * rep);
                for (;;) { const int u = next_unit(F, head); if (u >= 384 + 256 + 384) break;
                    if (u < 384) { const int qb = 31 - u / 12, bh = u % 12; att::attn_unit<96, 0>(F.lds, PA, bh / 6, bh % 6, qb); }
                    else if (u < 640) { const int v = u - 384, qb = 31 - (v >> 3), bh = v & 7; att::attn_unit<64, 2>(F.lds, PC, bh >> 2, bh & 3, qb); }
                    else { const int v = u - 640, qb = v / 12, bh = v % 12; att::attn_unit<64, 1>(F.lds, PB, bh / 6, bh % 6, qb); } }
            } else if ((PHM & 32) && s == 5) {
                pg8::Gemm g{(const pg8::bf16_t*)OALL, (const pg8::bf16_t*)(wl + W_OUT), MROWS, DM, DM}; pg8::StaticOrder S; S.init(MROWS, DM, F.G, (int)blockIdx.x);
                pg8::EpiRes<true> E{(const GAS float*)args.out, (GAS float*)args.out, ws_, modl + 5 * DM, GS + ((size_t)(l * 3 + 2) * 2) * DM, 1.0f};
                pg8::gemm_phase<pg8::EpiRes<true>, pg8::StaticOrder, true, true>(F.lds, g, S, E);
            }
        }
        if (rep + 1 < nrep) xcd_barrier(bar);
        }
        if (ph + 1 < hi) xcd_barrier(bar);
    }
}
#ifndef HYB
#define HYB 0
#endif
#ifndef DUPH
#define DUPH -1
#endif
static void launch_fwd(hipStream_t stream, Args a, int grid, int lo, int hi, int li, int adapt) {
    a.ph_lo = lo; a.ph_hi = hi; a.li = li; a.adapt = adapt;
    hipLaunchKernelGGL(fwd_mega, dim3(grid), dim3(NWAVES * 64), LDS_BYTES, stream, a);
}
extern "C" void kernel_launch(void* const* d_in, const int* in_sizes, int n_in, void* d_out, int out_size, void* d_ws, size_t ws_size, hipStream_t stream) {
    static int grid = 0;
    if (grid == 0) {
        if (n_in != 23 || out_size != MROWS * DM || ws_size < WS_END) { fprintf(stderr, "kernel_launch: unexpected problem (n_in %d, out %d, ws %zu < %zu)\n", n_in, out_size, ws_size, (size_t)WS_END); grid = -1; return; }
        int dev = 0, cus = 0, per_cu = 0;
        if (hipGetDevice(&dev) != hipSuccess || hipDeviceGetAttribute(&cus, hipDeviceAttributeMultiprocessorCount, dev) != hipSuccess) { grid = -1; return; }
        if (hipFuncSetAttribute((const void*)fwd_mega, hipFuncAttributeMaxDynamicSharedMemorySize, LDS_BYTES) != hipSuccess) { fprintf(stderr, "kernel_launch: hipFuncSetAttribute failed\n"); grid = -1; return; }
        if (hipOccupancyMaxActiveBlocksPerMultiprocessor(&per_cu, (const void*)fwd_mega, NWAVES * 64, LDS_BYTES) != hipSuccess || per_cu < 1) { fprintf(stderr, "kernel_launch: occupancy query says %d blocks per CU\n", per_cu); (void)hipGetLastError(); grid = -1; return; }
        grid = cus;
    }
    if (grid < 0) return;
    (void)hipMemsetAsync((char*)d_ws + WS_CTL, 0, CTL_ZERO_BYTES, stream);
    Args a{};
    for (int i = 0; i < 23; ++i) a.in[i] = d_in[i];
    a.out = (float*)d_out; a.ws = (unsigned char*)d_ws;
#if HYB == 0
    launch_fwd(stream, a, grid, 0, NPH, 0, -1);
#elif HYB == 1
    for (int ph = 0; ph < NPH; ++ph) launch_fwd(stream, a, grid, ph, ph + 1, 0, -1);
#elif HYB == 4
    for (int ph = 0; ph < NPH; ++ph) {
        launch_fwd(stream, a, grid, ph, ph + 1, 0, -1);
        const int ty = ph < 2 ? 8 + ph : ((ph - 2) & 7);
        if (ty == DUPH && ty != 5 && !((ty == 1 || ty == 7) && ph != 3)) { (void)hipMemsetAsync((char*)d_ws + WS_CTL, 0, CTL_ZERO_BYTES, stream); launch_fwd(stream, a, grid, ph, ph + 1, 0, -1); }
    }
#else
    {
        using namespace nv;
        const float* x = (const float*)d_in[0]; const int* positions = (const int*)d_in[2];
        const float* rel_bias = (const float*)d_in[3]; const float* norm_g = (const float*)d_in[4];
        const float* w_ffn1_gu = (const float*)d_in[7]; const float* w_ffn1_down = (const float*)d_in[8]; const float* w_in = (const float*)d_in[9];
        const float* q_a_norm = (const float*)d_in[10]; const float* kv_a_norm = (const float*)d_in[11]; const float* w_uq = (const float*)d_in[12]; const float* w_ukv = (const float*)d_in[13];
        const float* mla_q_norm = (const float*)d_in[14]; const float* mla_k_norm = (const float*)d_in[15]; const float* swa_q_norm = (const float*)d_in[16]; const float* swa_k_norm = (const float*)d_in[17];
        const float* sinks = (const float*)d_in[18]; const float* out_norm = (const float*)d_in[19]; const float* w_out = (const float*)d_in[20];
        const float* w_ffn2_gu = (const float*)d_in[21]; const float* w_ffn2_down = (const float*)d_in[22];
        float* out = (float*)d_out; char* ws = (char*)d_ws;
        float* mod = (float*)(ws + WS_MOD);
        char* nb = ws + WS_XB;
        float* H = (float*)(nb); float* HIDn = (float*)(nb + 33 * MiB); float* P = (float*)(nb + 33 * MiB); float* QA = (float*)(nb + 91 * MiB); float* KVRAW = (float*)(nb + 110 * MiB);
        float* KAn = (float*)(nb + 135 * MiB); float* CQN = (float*)(nb + 154 * MiB); float* CKVN = (float*)(nb + 163 * MiB); float* QB = (float*)(nb + 168 * MiB); float* KBn = (float*)(nb + 181 * MiB);
        launch_fwd(stream, a, grid, 0, 1, 0, -1); launch_fwd(stream, a, grid, 1, 2, 0, -1);
        auto naive_ffn = [&](int l, int i, const float* xsrc) {
            for (int b = 0; b < BATCH; ++b) {
                float* xb = out + (size_t)b * nv::SEQ * nv::D; const float* xs = xsrc + (size_t)b * nv::SEQ * nv::D; const float* modlb = mod + ((size_t)l * 2 + b) * nv::NMOD;
                const float* wgu = (i == 0 ? w_ffn1_gu : w_ffn2_gu) + (size_t)l * nv::D * 2 * nv::DFF; const float* wdn = (i == 0 ? w_ffn1_down : w_ffn2_down) + (size_t)l * nv::DFF * nv::D;
                const float* sh = modlb + (3 * i) * nv::D; const float* sc = modlb + (3 * i + 1) * nv::D; const float* gt = modlb + (3 * i + 2) * nv::D;
                k_normmod<<<nv::SEQ / 4, 256, 0, stream>>>(xs, norm_g + ((size_t)l * 3 + i) * nv::D, sh, sc, H, nv::SEQ);
                k_gemm<true, 0><<<dim3(nv::DFF / 128, nv::SEQ / 128), 256, 0, stream>>>(H, nv::D, wgu, wgu + nv::DFF, 2 * nv::DFF, HIDn, nv::DFF, nv::DFF, nv::D, nullptr, nullptr, 0.f);
                k_gemm<false, 1><<<dim3(nv::D / 128, nv::SEQ / 128), 256, 0, stream>>>(HIDn, nv::DFF, wdn, nullptr, nv::D, xb, nv::D, nv::D, nv::DFF, xs, gt, 0.5f);
            }
        };
        auto naive_mixer = [&](int l) {
            for (int b = 0; b < BATCH; ++b) {
                float* xb = out + (size_t)b * nv::SEQ * nv::D; const int* posb = positions + b * nv::SEQ; const float* modlb = mod + ((size_t)l * 2 + b) * nv::NMOD;
                const float* sh = modlb + 3 * nv::D; const float* sc = modlb + 4 * nv::D; const float* gt = modlb + 5 * nv::D;
                k_normmod<<<nv::SEQ / 4, 256, 0, stream>>>(xb, norm_g + ((size_t)l * 3 + 1) * nv::D, sh, sc, H, nv::SEQ);
                k_gemm<false, 0><<<dim3((nv::DIN + 127) / 128, nv::SEQ / 128), 256, 0, stream>>>(H, nv::D, w_in + (size_t)l * nv::D * nv::DIN, nullptr, nv::DIN, P, nv::DIN, nv::DIN, nv::D, nullptr, nullptr, 0.f);
                k_headnorm<<<nv::SEQ / 4, 256, 0, stream>>>(P, nv::DIN, 0, 256, nullptr, 0, 0, 0, q_a_norm + l * 256, CQN, 256, 256, 1, nv::SEQ, posb, 0, 1);
                k_headnorm<<<nv::SEQ / 4, 256, 0, stream>>>(P + 256, nv::DIN, 0, 128, nullptr, 0, 0, 0, kv_a_norm + l * 128, CKVN, 128, 128, 1, nv::SEQ, posb, 0, 1);
                k_gemm<false, 0><<<dim3((576 + 127) / 128, nv::SEQ / 128), 256, 0, stream>>>(CQN, 256, w_uq + (size_t)l * 256 * 576, nullptr, 576, QA, 576, 576, 256, nullptr, nullptr, 0.f);
                k_gemm<false, 0><<<dim3(768 / 128, nv::SEQ / 128), 256, 0, stream>>>(CKVN, 128, w_ukv + (size_t)l * 128 * 768, nullptr, 768, KVRAW, 768, 768, 128, nullptr, nullptr, 0.f);
                k_headnorm<<<nv::SEQ * 6 / 4, 256, 0, stream>>>(QA, 576, 96, 96, nullptr, 0, 0, 0, mla_q_norm + l * 96, QA, 576, 96, 6, nv::SEQ, posb, 1, 1);
                k_headnorm<<<nv::SEQ * 6 / 4, 256, 0, stream>>>(KVRAW, 768, 128, 64, P + 384, nv::DIN, 0, 32, mla_k_norm + l * 96, KAn, 576, 96, 6, nv::SEQ, posb, 1, 1);
                k_headnorm<<<nv::SEQ * 6 / 4, 256, 0, stream>>>(P + 416, nv::DIN, 64, 64, nullptr, 0, 0, 0, swa_q_norm + l * 64, QB, 384, 64, 6, nv::SEQ, posb, 0, 1);
                k_headnorm<<<nv::SEQ * 2 / 4, 256, 0, stream>>>(P + 800, nv::DIN, 64, 64, nullptr, 0, 0, 0, swa_k_norm + l * 64, KBn, 128, 64, 2, nv::SEQ, posb, 0, 1);
                k_attn<96, 64, 0><<<dim3(nv::SEQ / 256, 6), 256, 0, stream>>>(QA, 576, 96, KAn, 576, 96, KVRAW + 64, 768, 128, H, nv::D, 0, 1, posb, nullptr, nullptr, 6);
                k_attn<64, 64, 1><<<dim3(nv::SEQ / 256, 6), 256, 0, stream>>>(QB, 384, 64, KBn, 128, 64, P + 928, nv::DIN, 64, H, nv::D, 384, 3, posb, sinks + l * 6, rel_bias, 6);
                k_attn<64, 64, 2><<<dim3(nv::SEQ / 256, 4), 256, 0, stream>>>(P + 1056, nv::DIN, 64, P + 1056 + 256, nv::DIN, 64, P + 1056 + 512, nv::DIN, 64, H, nv::D, 768, 1, posb, nullptr, nullptr, 4);
                k_groupnorm<<<nv::SEQ / 4, 256, 0, stream>>>(H, out_norm + l * nv::D, nv::SEQ);
                k_gemm<false, 1><<<dim3(nv::D / 128, nv::SEQ / 128), 256, 0, stream>>>(H, nv::D, w_out + (size_t)l * nv::D * nv::D, nullptr, nv::D, xb, nv::D, nv::D, nv::D, xb, gt, 1.0f);
            }
        };
        for (int l = 0; l < DEPTH; ++l) {
            const int base = 2 + 8 * l;
#if HYB == 2
            if (l > 0) launch_fwd(stream, a, grid, 0, 0, 0, l * 3 + 0);
            launch_fwd(stream, a, grid, base + 0, base + 1, 0, -1); launch_fwd(stream, a, grid, base + 1, base + 2, 0, -1);
            naive_mixer(l);
            launch_fwd(stream, a, grid, 0, 0, 0, l * 3 + 2);
            launch_fwd(stream, a, grid, base + 6, base + 7, 0, -1); launch_fwd(stream, a, grid, base + 7, base + 8, 0, -1);
#else
            naive_ffn(l, 0, l == 0 ? x : out);
            launch_fwd(stream, a, grid, 0, 0, 0, l * 3 + 1);
            for (int s = 2; s <= 5; ++s) launch_fwd(stream, a, grid, base + s, base + s + 1, 0, -1);
            naive_ffn(l, 2, out);
#endif
        }
    }
#endif
}
```

```cpp
#include <hip/hip_runtime.h>
#include <cstdio>
#include <cstdint>
#include <cmath>
namespace nv {
constexpr int D = 1024, BATCH = 2, SEQ = 8192, DEPTH = 2, M = BATCH * SEQ;
constexpr int DFF = 2816, DIN = 1824, NMOD = 9 * D;
constexpr float EPS = 1e-6f;

__device__ __forceinline__ float wave_sum(float v) {
#pragma unroll
    for (int o = 1; o < 64; o <<= 1) v += __shfl_xor(v, o);
    return v;
}
__device__ __forceinline__ float silu_f(float x) { return x / (1.0f + expf(-x)); }

__global__ void k_mod(const float* __restrict__ c, const float* __restrict__ w_mod, const float* __restrict__ b_mod, float* __restrict__ mod) {
    int idx = blockIdx.x * 256 + threadIdx.x;
    if (idx >= DEPTH * NMOD) return;
    int l = idx / NMOD, n = idx % NMOD;
    float a0 = 0.f, a1 = 0.f;
    const float* w = w_mod + (size_t)l * D * NMOD + n;
    for (int k = 0; k < D; ++k) {
        float wv = w[(size_t)k * NMOD];
        a0 += silu_f(c[k]) * wv; a1 += silu_f(c[D + k]) * wv;
    }
    mod[((size_t)l * 2 + 0) * NMOD + n] = a0 + b_mod[l * NMOD + n];
    mod[((size_t)l * 2 + 1) * NMOD + n] = a1 + b_mod[l * NMOD + n];
}

__global__ void k_normmod(const float* __restrict__ x, const float* __restrict__ g, const float* __restrict__ sh, const float* __restrict__ sc, float* __restrict__ H, int rows) {
    int row = blockIdx.x * 4 + (threadIdx.x >> 6), lane = threadIdx.x & 63;
    if (row >= rows) return;
    const float* xr = x + (size_t)row * D;
    float v[16]; float s = 0.f;
#pragma unroll
    for (int j = 0; j < 16; ++j) { v[j] = xr[lane + 64 * j]; s += v[j] * v[j]; }
    s = wave_sum(s);
    float r = rsqrtf(s * (1.0f / D) + EPS);
#pragma unroll
    for (int j = 0; j < 16; ++j) { int cidx = lane + 64 * j; H[(size_t)row * D + cidx] = v[j] * r * g[cidx] * (1.0f + sc[cidx]) + sh[cidx]; }
}

template <bool DUAL, int EPI>
__global__ void __launch_bounds__(256) k_gemm(const float* __restrict__ A, int lda, const float* __restrict__ W, const float* __restrict__ W2, int ldw,
                                              float* C, int ldc, int N, int K, const float* R, const float* __restrict__ gate, float coef) {
    __shared__ float As[16][128 + 4];
    __shared__ float Bs[16][128 + 4];
    __shared__ float Bs2[DUAL ? 16 : 1][128 + 4];
    const int tid = threadIdx.x, tx = tid & 15, ty = tid >> 4;
    const int m0 = blockIdx.y * 128, n0 = blockIdx.x * 128;
    float acc[8][8], acc2[DUAL ? 8 : 1][8];
#pragma unroll
    for (int i = 0; i < 8; ++i)
#pragma unroll
        for (int j = 0; j < 8; ++j) { acc[i][j] = 0.f; if (DUAL) acc2[i][j] = 0.f; }
    for (int k0 = 0; k0 < K; k0 += 16) {
#pragma unroll
        for (int i = 0; i < 2; ++i) {
            int e = tid + 256 * i;
            int r = e >> 2, kq = e & 3;
            const float4 v = *(const float4*)(A + (size_t)(m0 + r) * lda + k0 + kq * 4);
            As[kq * 4 + 0][r] = v.x; As[kq * 4 + 1][r] = v.y; As[kq * 4 + 2][r] = v.z; As[kq * 4 + 3][r] = v.w;
        }
#pragma unroll
        for (int i = 0; i < 8; ++i) {
            int e = tid + 256 * i;
            int kk = e >> 7, nn = e & 127;
            int n = n0 + nn;
            Bs[kk][nn] = (n < N) ? W[(size_t)(k0 + kk) * ldw + n] : 0.f;
            if (DUAL) Bs2[kk][nn] = (n < N) ? W2[(size_t)(k0 + kk) * ldw + n] : 0.f;
        }
        __syncthreads();
#pragma unroll
        for (int kk = 0; kk < 16; ++kk) {
            float a[8], b[8], b2[8];
#pragma unroll
            for (int i = 0; i < 8; ++i) a[i] = As[kk][ty * 8 + i];
#pragma unroll
            for (int j = 0; j < 8; ++j) { b[j] = Bs[kk][tx * 8 + j]; if (DUAL) b2[j] = Bs2[kk][tx * 8 + j]; }
#pragma unroll
            for (int i = 0; i < 8; ++i)
#pragma unroll
                for (int j = 0; j < 8; ++j) { acc[i][j] += a[i] * b[j]; if (DUAL) acc2[i][j] += a[i] * b2[j]; }
        }
        __syncthreads();
    }
#pragma unroll
    for (int i = 0; i < 8; ++i)
#pragma unroll
        for (int j = 0; j < 8; ++j) {
            int m = m0 + ty * 8 + i, n = n0 + tx * 8 + j;
            if (n < N) {
                float v = acc[i][j];
                if (DUAL) v = silu_f(v) * acc2[i][j];
                if (EPI == 1) v = R[(size_t)m * ldc + n] + coef * gate[n] * v;
                C[(size_t)m * ldc + n] = v;
            }
        }
}

__global__ void k_headnorm(const float* src1, int s1stride, int hs1, int W1, const float* src2, int s2stride, int hs2, int W2,
                           const float* __restrict__ gain, float* dst, int dstride, int dhs, int nheads, int rows, const int* __restrict__ pos, int do_rope, int do_norm) {
    int item = blockIdx.x * 4 + (threadIdx.x >> 6), lane = threadIdx.x & 63;
    if (item >= rows * nheads) return;
    int row = item / nheads, h = item % nheads;
    const int Wt = W1 + W2;
    float v[4]; float s = 0.f;
#pragma unroll
    for (int j = 0; j < 4; ++j) {
        int e = lane + 64 * j; float t = 0.f;
        if (e < W1) t = src1[(size_t)row * s1stride + h * hs1 + e];
        else if (e < Wt) t = src2[(size_t)row * s2stride + h * hs2 + (e - W1)];
        v[j] = t; s += t * t;
    }
    s = wave_sum(s);
    float r = do_norm ? rsqrtf(s / (float)Wt + EPS) : 1.0f;
    __shared__ float tmp[4][256];
    float* tw = tmp[threadIdx.x >> 6];
#pragma unroll
    for (int j = 0; j < 4; ++j) { int e = lane + 64 * j; if (e < Wt) tw[e] = v[j] * r * (do_norm ? gain[e] : 1.0f); }
    __syncthreads();
    if (do_rope) {
        float outv = 0.f; int e = lane;
        if (lane < 32) {
            int jf = lane & 15;
            float freq = powf(10000.0f, -(float)jf / 16.0f);
            float ang = (float)pos[row] * freq;
            float cs = cosf(ang), sn = sinf(ang);
            float x1 = tw[Wt - 32 + jf], x2 = tw[Wt - 16 + jf];
            outv = (lane < 16) ? (x1 * cs - x2 * sn) : (x2 * cs + x1 * sn);
        }
        __syncthreads();
        if (lane < 32) tw[Wt - 32 + e] = outv;
        __syncthreads();
    }
#pragma unroll
    for (int j = 0; j < 4; ++j) { int e = lane + 64 * j; if (e < Wt) dst[(size_t)row * dstride + h * dhs + e] = tw[e]; }
}

__device__ __forceinline__ int t5_bucket(int rel) {
    int n = rel > 0 ? rel : 0;
    if (n < 16) return n;
    float nf = (float)n;
    int large = 16 + (int)(logf(nf / 16.0f) / logf(8.0f) * 16.0f);
    return large < 31 ? large : 31;
}

template <int DQK, int DV, int MODE>
__global__ void __launch_bounds__(256) k_attn(const float* __restrict__ Q, int qstride, int qhs, const float* __restrict__ Kp, int kstride, int khs, const float* __restrict__ Vp, int vstride, int vhs,
                                              float* __restrict__ O, int ostride, int ocol0, int group, const int* __restrict__ pos, const float* __restrict__ sinks, const float* __restrict__ relb, int nheads_q) {
    __shared__ float Ks[64][DQK];
    __shared__ float Vs[64][DV];
    const int h = blockIdx.y, kvh = h / group, t0 = blockIdx.x * 256, t = t0 + threadIdx.x;
    float q[DQK], o[DV];
    const float scale = rsqrtf((float)DQK);
#pragma unroll
    for (int d = 0; d < DQK; ++d) q[d] = Q[(size_t)t * qstride + h * qhs + d] * scale;
#pragma unroll
    for (int d = 0; d < DV; ++d) o[d] = 0.f;
    float mrun = (MODE == 1) ? sinks[h] : -INFINITY, lrun = (MODE == 1) ? 1.0f : 0.f;
    float after = 0.f;
    const int posq = (MODE == 1) ? pos[t] : 0;
    int jt_lo, jt_hi;
    if (MODE == 0) { jt_lo = 0; jt_hi = (t0 + 255) / 64; }
    else if (MODE == 1) { int lo = t0 - 127; if (lo < 0) lo = 0; jt_lo = lo / 64; jt_hi = (t0 + 255) / 64; }
    else { jt_lo = 0; jt_hi = (t0 + 254) / 64; }
    const int ntile = jt_hi - jt_lo + 1;
    for (int it = 0; it < ntile; ++it) {
        const int jt = (MODE == 2) ? (jt_hi - it) : (jt_lo + it);
        const int j0 = jt * 64;
        __syncthreads();
        for (int e = threadIdx.x; e < 64 * DQK; e += 256) { int jj = e / DQK, d = e % DQK; Ks[jj][d] = Kp[(size_t)(j0 + jj) * kstride + kvh * khs + d]; }
        for (int e = threadIdx.x; e < 64 * DV; e += 256) { int jj = e / DV, d = e % DV; Vs[jj][d] = Vp[(size_t)(j0 + jj) * vstride + kvh * vhs + d]; }
        __syncthreads();
        if (MODE == 2) {
            bool live = false;
            for (int jj = 63; jj >= 0; --jj) {
                int j = j0 + jj;
                if (j < t) {
                    float z = 0.f;
#pragma unroll
                    for (int d = 0; d < DQK; ++d) z += q[d] * Ks[jj][d];
                    float sp = fmaxf(z, 0.f) + log1pf(expf(-fabsf(z)));
                    float a = expf(z - sp + after);
                    after -= sp;
#pragma unroll
                    for (int d = 0; d < DV; ++d) o[d] += a * Vs[jj][d];
                }
            }
            live = (after > -110.0f) ;
            if (!__syncthreads_or(live ? 1 : 0)) break;
        } else {
            for (int jj = 0; jj < 64; ++jj) {
                int j = j0 + jj;
                bool ok = (j <= t);
                if (MODE == 1) ok = ok && (j > t - 128);
                if (ok) {
                    float s = 0.f;
#pragma unroll
                    for (int d = 0; d < DQK; ++d) s += q[d] * Ks[jj][d];
                    if (MODE == 1) s += relb[t5_bucket(posq - pos[j]) * nheads_q + h];
                    float mn = fmaxf(mrun, s);
                    float f = expf(mrun - mn), p = expf(s - mn);
                    lrun = lrun * f + p; mrun = mn;
#pragma unroll
                    for (int d = 0; d < DV; ++d) o[d] = o[d] * f + p * Vs[jj][d];
                }
            }
        }
    }
    const float inv = (MODE == 2) ? 1.0f : 1.0f / lrun;
#pragma unroll
    for (int d = 0; d < DV; ++d) O[(size_t)t * ostride + ocol0 + h * DV + d] = o[d] * inv;
}

__global__ void k_groupnorm(float* O, const float* __restrict__ on, int rows) {
    int row = blockIdx.x * 4 + (threadIdx.x >> 6), lane = threadIdx.x & 63;
    if (row >= rows) return;
    float* orow = O + (size_t)row * D;
    float v[16]; float s0 = 0.f, s1 = 0.f, s2 = 0.f;
#pragma unroll
    for (int j = 0; j < 16; ++j) { int cidx = lane + 64 * j; v[j] = orow[cidx]; float sq = v[j] * v[j]; if (cidx < 384) s0 += sq; else if (cidx < 768) s1 += sq; else s2 += sq; }
    s0 = wave_sum(s0); s1 = wave_sum(s1); s2 = wave_sum(s2);
    float r0 = rsqrtf(s0 / 384.f + EPS), r1 = rsqrtf(s1 / 384.f + EPS), r2 = rsqrtf(s2 / 256.f + EPS);
#pragma unroll
    for (int j = 0; j < 16; ++j) { int cidx = lane + 64 * j; float r = cidx < 384 ? r0 : (cidx < 768 ? r1 : r2); orow[cidx] = v[j] * r * on[cidx]; }
}
}
constexpr int NWAVES = 8;
constexpr int BATCH = 2, SEQ = 8192, DM = 1024, DEPTH = 2, MROWS = BATCH * SEQ;
constexpr int DFF = 2816, DIN = 1824, NMOD = 9 * DM;
constexpr int NPH = 2 + 8 * DEPTH;
constexpr size_t MiB = 1u << 20;
constexpr size_t WS_CTL = 0, CTL_ZERO_BYTES = 256 * 1024;
constexpr size_t WS_MOD = 1 * MiB;
constexpr size_t WS_GS = WS_MOD + 160 * 1024;
constexpr size_t WS_BIAS = WS_GS + 64 * 1024;
constexpr size_t BIAS_L = 2 * (5632 + 2048 + 5632);
constexpr size_t WS_SSQX = 2 * MiB;
constexpr size_t WS_SSQO = 3 * MiB;
constexpr size_t WS_CS = 4 * MiB;
constexpr size_t WS_KPE = 6 * MiB;
constexpr size_t WS_SSQC = 8 * MiB;
constexpr size_t WS_W = 9 * MiB;
constexpr size_t W_GU1 = 0, W_D1 = W_GU1 + (size_t)5632 * 1024 * 2, W_IN = W_D1 + (size_t)1024 * 2816 * 2, W_UQ = W_IN + (size_t)2048 * 1024 * 2, W_UKV = W_UQ + (size_t)768 * 256 * 2,
                 W_OUT = W_UKV + (size_t)768 * 128 * 2, W_GU2 = W_OUT + (size_t)1024 * 1024 * 2, W_D2 = W_GU2 + (size_t)5632 * 1024 * 2, WL = W_D2 + (size_t)1024 * 2816 * 2;
constexpr size_t WS_XB = WS_W + ((2 * WL + MiB - 1) / MiB) * MiB;
constexpr size_t WS_ACT = WS_XB + 32 * MiB;
constexpr size_t WS_HID = WS_ACT;
constexpr size_t WS_CQ = WS_ACT, WS_CKV = WS_CQ + 8 * MiB, WS_QRAW = WS_CKV + 4 * MiB, WS_KA = WS_QRAW + 36 * MiB, WS_VA = WS_KA + 18 * MiB, WS_QS = WS_VA + 12 * MiB, WS_KS = WS_QS + 12 * MiB,
                 WS_VS = WS_KS + 4 * MiB, WS_QC = WS_VS + 4 * MiB, WS_KC = WS_QC + 8 * MiB, WS_VC = WS_KC + 8 * MiB, WS_OALL = WS_VC + 8 * MiB, WS_END = WS_OALL + 32 * MiB;
static_assert(WS_HID + (size_t)MROWS * DFF * 2 <= WS_END, "d_ws map");
constexpr int CW_BAR = 4096;
constexpr int CW_Q = 40960;
static_assert((CW_Q + 64 * 9) * 4 <= (int)CTL_ZERO_BYTES && CW_BAR + 8 * 3456 <= CW_Q, "ctl map");
constexpr int RING_BYTES = 131072, LDSCTL_OFF = RING_BYTES, MISC_OFF = LDSCTL_OFF + 320, LDS_BYTES = 147456;

namespace pg8 {
#define PG8_LAS __attribute__((address_space(3)))
typedef unsigned short bf16_t;
typedef short bf16x8 __attribute__((ext_vector_type(8)));
typedef float f32x4 __attribute__((ext_vector_type(4)));
typedef unsigned u32x4 __attribute__((ext_vector_type(4)));
constexpr int BM = 256, BK = 64, HALF = 128, HTB = HALF * BK * 2  , STAGE_BYTES = 8 * HTB, NXCD = 8, WGM = 8;

__host__ __device__ __forceinline__ int lds_byte(int r, int c) { const int st = (r >> 4) * 2 + (c >> 5), rr = r & 15, cc = c & 31, ob = rr * 64 + cc * 2; return st * 1024 + (ob ^ (((ob >> 9) & 1) << 5)); }
__host__ __device__ __forceinline__ void stage_rc(int b, int& R, int& C) { const int st = b / 1024, sb = b % 1024, swz = sb ^ (((sb >> 9) & 1) << 5); R = (st >> 1) * 16 + swz / 64; C = (st & 1) * 32 + (swz % 64) / 2; }
__host__ __device__ __forceinline__ int perm32(int rho) { const int n = rho >> 4, i = rho & 15; return 8 * (i >> 2) + 4 * n + (i & 3); }

struct Unit { int pm, pn; };
struct Gemm { const bf16_t* A; const bf16_t* Bt; int M, N, K; };

struct StaticOrder {
    int nM, nN, nwg, G, c;
    __host__ __device__ void init(int M, int N, int G_, int c_) { nM = M / BM; nN = N / BM; nwg = nM * nN; G = G_; c = c_; }
    __host__ __device__ bool next(int i, Unit& u) const {
        const long L = (long)i * G + c; if (L >= nwg) return false;
        int wgid = (int)L; { const int q = nwg / NXCD, r = nwg % NXCD, xcd = wgid % NXCD, off = wgid / NXCD; wgid = (xcd < r ? xcd * (q + 1) : r * (q + 1) + (xcd - r) * q) + off; }
        const int nig = WGM * nN, gid = wgid / nig, fm = gid * WGM, gsz = (nM - fm) < WGM ? (nM - fm) : WGM;
        u.pm = fm + ((wgid % nig) % gsz); u.pn = (wgid % nig) / gsz; return true;
    }
    __device__ __forceinline__ void a_ready(const Unit&) const {}
    __device__ __forceinline__ void done(const Unit&) const {}
};

__device__ __forceinline__ unsigned cvt_pk_bf16(float lo, float hi) { unsigned r; asm volatile("v_cvt_pk_bf16_f32 %0, %1, %2" : "=v"(r) : "v"(lo), "v"(hi)); return r; }
typedef float f32x2 __attribute__((ext_vector_type(2)));
template <class Epi, class Sched, bool ALIGN_EPI = false, bool SP2 = false>
__device__ __forceinline__ void gemm_phase(PG8_LAS unsigned char* lds, const Gemm g, const Sched& S, const Epi& E) {
    int tid_ = threadIdx.x; asm volatile("" : "+v"(tid_));
    const int tid = tid_, wid = __builtin_amdgcn_readfirstlane(tid >> 6), lane = tid & 63, wr = wid >> 2, wc = wid & 3, fr = lane & 15, fq = lane >> 4;
    int K_ = g.K; asm volatile("" : "+s"(K_));
    const int K = K_, nt = K / BK;
    unsigned voffA[2], voffB[2];
#pragma unroll
    for (int i = 0; i < 2; ++i) { int R, C; stage_rc(tid * 16 + i * 8192, R, C); const int Rb = Epi::PERM ? ((R & ~31) + perm32(R & 31)) : R;
        voffA[i] = (unsigned)(R * K + C) * 2u; voffB[i] = (unsigned)(Rb * K + C) * 2u; }
    const size_t kstep = (size_t)(BK * 2);
    const size_t hstep = (size_t)HALF * K * 2;
    const size_t tstep = 2 * hstep;
    const unsigned ldsw = (unsigned)wid * 1024u;
    const int aoff = lds_byte(wr * 64 + fr, fq * 8), boff = lds_byte(wc * 32 + fr, fq * 8);
#define PG8_SA(b, h) (((b) * 2 + (h)) * HTB)
#define PG8_SB(b, h) ((4 + (b) * 2 + (h)) * HTB)
#define PG8_STAGE(bufoff, gbase, voff) do { _Pragma("unroll") for (int _i = 0; _i < 2; ++_i) \
        __builtin_amdgcn_global_load_lds((const unsigned*)((const char*)(gbase) + (voff)[_i]), (PG8_LAS unsigned*)(lds + (bufoff) + ldsw + _i * 8192), 16, 0, 0); } while (0)
#define PG8_LDA(dst, b, h) do { _Pragma("unroll") for (int m = 0; m < 4; ++m) _Pragma("unroll") for (int k = 0; k < 2; ++k) dst[m][k] = *(const PG8_LAS bf16x8*)(lds + PG8_SA(b, h) + aoff + m * 2048 + k * 1024); } while (0)
#define PG8_LDB(dst, b, h) do { _Pragma("unroll") for (int n = 0; n < 2; ++n) _Pragma("unroll") for (int k = 0; k < 2; ++k) dst[n][k] = *(const PG8_LAS bf16x8*)(lds + PG8_SB(b, h) + boff + n * 2048 + k * 1024); } while (0)
#define PG8_MMA(ai, bj, At, Bt) do { __builtin_amdgcn_s_setprio(1); _Pragma("unroll") for (int m = 0; m < 4; ++m) _Pragma("unroll") for (int n = 0; n < 2; ++n) _Pragma("unroll") for (int k = 0; k < 2; ++k) \
        acc[ai][bj][m][n] = __builtin_amdgcn_mfma_f32_16x16x32_bf16(Bt[n][k], At[m][k], acc[ai][bj][m][n], 0, 0, 0); __builtin_amdgcn_s_setprio(0); } while (0)
#define PG8_WAIT_V(n) asm volatile("s_waitcnt vmcnt(" #n ")" ::: "memory")
#define PG8_WAIT_L(n) asm volatile("s_waitcnt lgkmcnt(" #n ")" ::: "memory")
#define PG8_BAR __builtin_amdgcn_s_barrier()
#define PG8_SCHED __builtin_amdgcn_sched_barrier(0)
    Unit cur, nxt; int ui = 0;
    if (!S.next(0, cur)) return;
    f32x4 acc[2][2][4][2];
#pragma unroll
    for (int a = 0; a < 2; ++a)
#pragma unroll
        for (int b = 0; b < 2; ++b)
#pragma unroll
            for (int m = 0; m < 4; ++m)
#pragma unroll
                for (int n = 0; n < 2; ++n) acc[a][b][m][n] = (f32x4){0.f, 0.f, 0.f, 0.f};
    bf16x8 At[4][2], B0[2][2], B1[2][2];
    const char* cA = (const char*)g.A + (size_t)cur.pm * tstep; const char* cB = (const char*)g.Bt + (size_t)cur.pn * tstep;
    S.a_ready(cur);
    if constexpr (SP2) {
        PG8_STAGE(PG8_SB(0, 0), cB, voffB); PG8_STAGE(PG8_SB(0, 1), cB + hstep, voffB); PG8_STAGE(PG8_SA(0, 0), cA, voffA); PG8_STAGE(PG8_SA(0, 1), cA + hstep, voffA);
        if (wr == 1) PG8_BAR;
        PG8_WAIT_V(2); PG8_BAR;
        PG8_STAGE(PG8_SB(1, 0), cB + kstep, voffB); PG8_STAGE(PG8_SA(1, 0), cA + kstep, voffA); PG8_STAGE(PG8_SB(1, 1), cB + hstep + kstep, voffB);
        PG8_WAIT_V(6); PG8_BAR;
    } else {
        PG8_STAGE(PG8_SB(0, 0), cB, voffB); PG8_STAGE(PG8_SA(0, 0), cA, voffA); PG8_STAGE(PG8_SB(0, 1), cB + hstep, voffB); PG8_STAGE(PG8_SA(0, 1), cA + hstep, voffA);
        if (wr == 1) PG8_BAR;
        PG8_WAIT_V(4); PG8_BAR;
        PG8_STAGE(PG8_SB(1, 0), cB + kstep, voffB); PG8_STAGE(PG8_SA(1, 0), cA + kstep, voffA); PG8_STAGE(PG8_SB(1, 1), cB + hstep + kstep, voffB);
        PG8_WAIT_V(6); PG8_BAR;
    }
    for (;;) {
        const bool has_next = S.next(ui + 1, nxt);
        const char* nA = has_next ? (const char*)g.A + (size_t)nxt.pm * tstep : cA; const char* nB = has_next ? (const char*)g.Bt + (size_t)nxt.pn * tstep : cB;
#pragma nounroll
        for (int t = 0; t < nt; t += 2) {
            if constexpr (Epi::HOOK) E.hook(acc, cur, t, wr, wc, fr, fq);
            const bool last = (t == nt - 2);
            const char* a1 = cA + (size_t)(t + 1) * kstep;
            const char* a2 = last ? nA : cA + (size_t)(t + 2) * kstep; const char* b2 = last ? nB : cB + (size_t)(t + 2) * kstep;
            const char* a3 = a2 + kstep; const char* b3 = b2 + kstep;
            if (last && has_next) S.a_ready(nxt);
            if constexpr (SP2) {
            PG8_LDB(B0, 0, 0); PG8_LDB(B1, 0, 1); PG8_SCHED; PG8_LDA(At, 0, 0); PG8_STAGE(PG8_SA(1, 1), a1 + hstep, voffA);
            PG8_WAIT_V(8); PG8_WAIT_L(0); PG8_BAR; PG8_MMA(0, 0, At, B0); PG8_MMA(0, 1, At, B1); PG8_BAR; PG8_SCHED;
            PG8_LDA(At, 0, 1); PG8_STAGE(PG8_SB(0, 0), b2, voffB); PG8_STAGE(PG8_SB(0, 1), b2 + hstep, voffB); PG8_STAGE(PG8_SA(0, 0), a2, voffA);
            PG8_WAIT_V(8); PG8_WAIT_L(0); PG8_BAR; PG8_MMA(1, 0, At, B0); PG8_MMA(1, 1, At, B1); PG8_BAR; PG8_SCHED;
            PG8_LDB(B0, 1, 0); PG8_LDB(B1, 1, 1); PG8_SCHED; PG8_LDA(At, 1, 0); PG8_STAGE(PG8_SA(0, 1), a2 + hstep, voffA);
            PG8_WAIT_V(8); PG8_WAIT_L(0); PG8_BAR; PG8_MMA(0, 0, At, B0); PG8_MMA(0, 1, At, B1); PG8_BAR; PG8_SCHED;
            PG8_LDA(At, 1, 1); PG8_STAGE(PG8_SB(1, 0), b3, voffB); PG8_STAGE(PG8_SB(1, 1), b3 + hstep, voffB); PG8_STAGE(PG8_SA(1, 0), a3, voffA);
            PG8_WAIT_V(8); PG8_WAIT_L(0); PG8_BAR; PG8_MMA(1, 0, At, B0); PG8_MMA(1, 1, At, B1); PG8_BAR; PG8_SCHED;
            } else {
            PG8_LDB(B0, 0, 0); PG8_SCHED; PG8_LDA(At, 0, 0); PG8_STAGE(PG8_SA(1, 1), a1 + hstep, voffA);
            PG8_WAIT_L(8); PG8_BAR; PG8_WAIT_L(0); PG8_MMA(0, 0, At, B0); PG8_BAR; PG8_SCHED;
            PG8_LDB(B1, 0, 1); PG8_STAGE(PG8_SB(0, 0), b2, voffB);
            PG8_BAR; PG8_WAIT_L(0); PG8_MMA(0, 1, At, B1); PG8_BAR;
            PG8_LDA(At, 0, 1); PG8_STAGE(PG8_SA(0, 0), a2, voffA);
            PG8_BAR; PG8_WAIT_L(0); PG8_MMA(1, 0, At, B0); PG8_BAR; PG8_SCHED;
            PG8_STAGE(PG8_SB(0, 1), b2 + hstep, voffB);
            PG8_WAIT_V(6); PG8_BAR; PG8_MMA(1, 1, At, B1); PG8_BAR;
            PG8_LDB(B0, 1, 0); PG8_SCHED; PG8_LDA(At, 1, 0); PG8_STAGE(PG8_SA(0, 1), a2 + hstep, voffA);
            PG8_WAIT_L(8); PG8_BAR; PG8_WAIT_L(0); PG8_MMA(0, 0, At, B0); PG8_BAR; PG8_SCHED;
            PG8_LDB(B1, 1, 1); PG8_STAGE(PG8_SB(1, 0), b3, voffB);
            PG8_BAR; PG8_WAIT_L(0); PG8_MMA(0, 1, At, B1); PG8_BAR;
            PG8_LDA(At, 1, 1); PG8_STAGE(PG8_SA(1, 0), a3, voffA);
            PG8_BAR; PG8_WAIT_L(0); PG8_MMA(1, 0, At, B0); PG8_BAR; PG8_SCHED;
            PG8_STAGE(PG8_SB(1, 1), b3 + hstep, voffB);
            PG8_WAIT_V(6); PG8_BAR; PG8_MMA(1, 1, At, B1); PG8_BAR;
            }
        }
        if constexpr (ALIGN_EPI) { if (wr == 0) PG8_BAR; }
        if constexpr (!Epi::AFTER_DRAIN) {
            Unit ce = cur; asm volatile("" : "+s"(ce.pm), "+s"(ce.pn)); int fre = fr, fqe = fq; asm volatile("" : "+v"(fre), "+v"(fqe));
            E(acc, ce, wr, wc, fre, fqe); S.done(cur); }
        if (!has_next) break;
#pragma unroll
        for (int a = 0; a < 2; ++a)
#pragma unroll
            for (int b = 0; b < 2; ++b)
#pragma unroll
                for (int m = 0; m < 4; ++m)
#pragma unroll
                    for (int n = 0; n < 2; ++n) acc[a][b][m][n] = (f32x4){0.f, 0.f, 0.f, 0.f};
        cur = nxt; cA = nA; cB = nB; ++ui;
        if constexpr (ALIGN_EPI) { if (wr == 1) PG8_BAR; }
    }
    PG8_WAIT_V(0);
    if constexpr (!ALIGN_EPI) { if (wr == 0) PG8_BAR; }
    PG8_BAR;
    if constexpr (Epi::AFTER_DRAIN) { E.fused(acc, cur, wr, wc, fr, fq, lds, wid, lane); S.done(cur); }
#undef PG8_SA
#undef PG8_SB
#undef PG8_STAGE
#undef PG8_LDA
#undef PG8_LDB
#undef PG8_MMA
#undef PG8_WAIT_V
#undef PG8_WAIT_L
#undef PG8_BAR
#undef PG8_SCHED
}
constexpr float RMS_EPS = 1e-6f;
constexpr int MROWS_ = 16384;
constexpr float LOG2E = 1.4426950408889634f;
typedef unsigned u32x2 __attribute__((ext_vector_type(2)));
#define PG8_FENCE() asm volatile("" ::: "memory")
#define PG8_G __attribute__((address_space(1)))
__device__ __forceinline__ float sum16f(const PG8_G float* p) {
    const f32x4 a = *(const PG8_G f32x4*)p, b = *(const PG8_G f32x4*)(p + 4), c = *(const PG8_G f32x4*)(p + 8), d = *(const PG8_G f32x4*)(p + 12);
    return ((a[0] + a[1]) + (a[2] + a[3])) + ((b[0] + b[1]) + (b[2] + b[3])) + ((c[0] + c[1]) + (c[2] + c[3])) + ((d[0] + d[1]) + (d[2] + d[3]));
}
__device__ __forceinline__ float fast_rcp(float x) { return __builtin_amdgcn_rcpf(x); }
__device__ __forceinline__ float silu_fast(float g) { return g * fast_rcp(1.0f + __builtin_amdgcn_exp2f(-g * LOG2E)); }
__device__ __forceinline__ float sq4(const f32x4 v) { return (v[0] * v[0] + v[1] * v[1]) + (v[2] * v[2] + v[3] * v[3]); }

struct EpiUp {
    static constexpr bool PERM = true, AFTER_DRAIN = false, HOOK = false;
    PG8_G unsigned char* ws; const PG8_G float* bias;
    __device__ __forceinline__ void hook(f32x4 (&)[2][2][4][2], const Unit&, int, int, int, int, int) const {}
    __device__ __forceinline__ void operator()(const f32x4 (&acc)[2][2][4][2], const Unit& u, int wr, int wc, int fr, int fq) const {
        PG8_G bf16_t* HID = (PG8_G bf16_t*)(ws + WS_HID); const PG8_G float* ssqx = (const PG8_G float*)(ws + WS_SSQX);
        const int b = u.pm >> 5;
        const PG8_G float* bb = bias + b * 5632 + u.pn * BM + wc * 32 + 8 * fq;
        f32x4 bg[2], bu[2];
#pragma unroll
        for (int n = 0; n < 2; ++n) { bg[n] = *(const PG8_G f32x4*)(bb + 4 * n); bu[n] = *(const PG8_G f32x4*)(bb + HALF + 4 * n); }
#pragma unroll
        for (int ai = 0; ai < 2; ++ai)
#pragma unroll
            for (int m = 0; m < 4; ++m) {
                const int row = u.pm * BM + ai * HALF + wr * 64 + m * 16 + fr;
                const float r = 1.0f / sqrtf(sum16f(ssqx + (size_t)row * 16) * (1.0f / 1024.0f) + RMS_EPS);
                float hv[8];
#pragma unroll
                for (int n = 0; n < 2; ++n)
#pragma unroll
                    for (int i = 0; i < 4; ++i) { const float g = acc[ai][0][m][n][i] * r + bg[n][i], uu = acc[ai][1][m][n][i] * r + bu[n][i]; hv[4 * n + i] = silu_fast(g) * uu; }
                u32x4 w; w.x = cvt_pk_bf16(hv[0], hv[1]); w.y = cvt_pk_bf16(hv[2], hv[3]); w.z = cvt_pk_bf16(hv[4], hv[5]); w.w = cvt_pk_bf16(hv[6], hv[7]);
                *(PG8_G u32x4*)(HID + (size_t)row * 2816 + u.pn * HALF + wc * 32 + 8 * fq) = w;
                if (m & 1) PG8_FENCE();
            }
    }
};

template <bool HOOKED> struct EpiRes {
    static constexpr bool PERM = false, AFTER_DRAIN = false, HOOK = HOOKED;
    const PG8_G float* xin; PG8_G float* xout; PG8_G unsigned char* ws; const PG8_G float* gate; const PG8_G float* gs; float coef;
    __device__ __forceinline__ void group_r(int row, float& rA, float& rB, float& rC) const {
        const PG8_G float* p = (const PG8_G float*)(ws + WS_SSQO) + (size_t)row * 16;
        const f32x4 a = *(const PG8_G f32x4*)p, b = *(const PG8_G f32x4*)(p + 4), c = *(const PG8_G f32x4*)(p + 8), d = *(const PG8_G f32x4*)(p + 12);
        const float sA = ((a[0] + a[1]) + (a[2] + a[3])) + (b[0] + b[1]), sB = ((b[2] + b[3]) + (c[0] + c[1])) + (c[2] + c[3]), sC = (d[0] + d[1]) + (d[2] + d[3]);
        rA = 1.0f / sqrtf(sA * (1.0f / 384.0f) + RMS_EPS); rB = 1.0f / sqrtf(sB * (1.0f / 384.0f) + RMS_EPS); rC = 1.0f / sqrtf(sC * (1.0f / 256.0f) + RMS_EPS);
    }
    __device__ __forceinline__ void hook(f32x4 (&acc)[2][2][4][2], const Unit& u, int t, int wr, int wc, int fr, int fq) const {
        if (t != 6 && t != 12) return;
        asm volatile("" : "+v"(fr));
#pragma unroll
        for (int ai = 0; ai < 2; ++ai)
#pragma unroll
            for (int m = 0; m < 4; ++m) {
                const int row = u.pm * BM + ai * HALF + wr * 64 + m * 16 + fr;
                float rA, rB, rC; group_r(row, rA, rB, rC);
                const float f = (t == 6) ? rA / rB : rB / rC;
#pragma unroll
                for (int bj = 0; bj < 2; ++bj)
#pragma unroll
                    for (int n = 0; n < 2; ++n) acc[ai][bj][m][n] = acc[ai][bj][m][n] * f;                PG8_FENCE();
            }
    }
    __device__ __forceinline__ void operator()(const f32x4 (&acc)[2][2][4][2], const Unit& u, int wr, int wc, int fr, int fq) const {
        PG8_G bf16_t* xb = (PG8_G bf16_t*)(ws + WS_XB); PG8_G float* ssq_out = (PG8_G float*)(ws + WS_SSQX); constexpr int gate_bstride = 9 * 1024;
        const int b = u.pm >> 5;
        const int col0 = u.pn * BM + wc * 32 + 4 * fq;
        f32x4 gv[2][2], gsv[2][2];
#pragma unroll
        for (int bj = 0; bj < 2; ++bj)
#pragma unroll
            for (int n = 0; n < 2; ++n) {
                gv[bj][n] = *(const PG8_G f32x4*)(gate + (size_t)b * gate_bstride + col0 + bj * HALF + n * 16) * coef;
                gsv[bj][n] = gs ? *(const PG8_G f32x4*)(gs + (size_t)b * 1024 + col0 + bj * HALF + n * 16) : (f32x4){0.f, 0.f, 0.f, 0.f};
            }
#pragma unroll
        for (int ai = 0; ai < 2; ++ai)
#pragma unroll
            for (int m = 0; m < 4; ++m) {
                const int row = u.pm * BM + ai * HALF + wr * 64 + m * 16 + fr;
                float rs = 1.0f;
                if (HOOKED) { float rA, rB, rC; group_r(row, rA, rB, rC); rs = rC; }
                const size_t off = (size_t)row * 1024 + col0;
                float ss = 0.f;
#pragma unroll
                for (int bj = 0; bj < 2; ++bj)
#pragma unroll
                    for (int n = 0; n < 2; ++n) {
                        const f32x4 xo = *(const PG8_G f32x4*)(xin + off + bj * HALF + n * 16);
                        const f32x4 xn = xo + gv[bj][n] * (acc[ai][bj][m][n] * rs);
                        *(PG8_G f32x4*)(xout + off + bj * HALF + n * 16) = xn;
                        ss += sq4(xn);
                        if (gs) { const f32x4 y = xn * gsv[bj][n]; u32x2 w; w.x = cvt_pk_bf16(y[0], y[1]); w.y = cvt_pk_bf16(y[2], y[3]); *(PG8_G u32x2*)(xb + off + bj * HALF + n * 16) = w; }
                    }
                ss += __shfl_xor(ss, 16); ss += __shfl_xor(ss, 32);
                if (gs && fq == 0) ssq_out[(size_t)row * 16 + 4 * u.pn + wc] = ss;
                PG8_FENCE();
            }
    }
};

struct EpiIn {
    static constexpr bool PERM = true, AFTER_DRAIN = false, HOOK = false;
    PG8_G unsigned char* ws; const PG8_G float* gq; const PG8_G float* gk; const PG8_G float* bias;
    __device__ __forceinline__ void hook(f32x4 (&)[2][2][4][2], const Unit&, int, int, int, int, int) const {}
    __device__ __forceinline__ void operator()(const f32x4 (&acc)[2][2][4][2], const Unit& u, int wr, int wc, int fr, int fq) const {
        const int slot = u.pn * 4 + wc;
        if (slot == 7 || slot >= 30) return;
        const int b = u.pm >> 5;
        const PG8_G float* ssqx = (const PG8_G float*)(ws + WS_SSQX);
        PG8_G PG8_G bf16_t* dst = nullptr; int pitch = 0, col0 = 0; int kind = 0;
        PG8_G PG8_G float* ssqd = nullptr; int ssqp = 0, ssqi = 0; const PG8_G float* gain = nullptr; float scale = 1.0f;
        if (slot < 4)       { dst = (PG8_G bf16_t*)(ws + WS_CQ);  pitch = 256; col0 = 64 * slot;        kind = 1; ssqd = (PG8_G float*)(ws + WS_SSQC);  ssqp = 4; ssqi = slot; }
        else if (slot < 6)  { dst = (PG8_G bf16_t*)(ws + WS_CKV); pitch = 128; col0 = 64 * (slot - 4);  kind = 1; ssqd = (PG8_G float*)(ws + WS_SSQC) + (size_t)MROWS_ * 4; ssqp = 2; ssqi = slot - 4; }
        else if (slot == 6) { kind = 3; }
        else if (slot < 14) { dst = (PG8_G bf16_t*)(ws + WS_QS);  pitch = 384; col0 = 64 * (slot - 8);  kind = 2; gain = gq; scale = 0.125f * LOG2E; }
        else if (slot < 16) { dst = (PG8_G bf16_t*)(ws + WS_KS);  pitch = 128; col0 = 64 * (slot - 14); kind = 2; gain = gk; }
        else if (slot < 18) { dst = (PG8_G bf16_t*)(ws + WS_VS);  pitch = 128; col0 = 64 * (slot - 16); }
        else if (slot < 22) { dst = (PG8_G bf16_t*)(ws + WS_QC);  pitch = 256; col0 = 64 * (slot - 18); scale = 0.125f * LOG2E; }
        else if (slot < 26) { dst = (PG8_G bf16_t*)(ws + WS_KC);  pitch = 256; col0 = 64 * (slot - 22); }
        else                { dst = (PG8_G bf16_t*)(ws + WS_VC);  pitch = 256; col0 = 64 * (slot - 26); }
        const PG8_G float* bb = bias + b * 2048 + u.pn * BM + wc * 32 + 8 * fq;
        f32x4 bv[2][2], gn[2][2];
#pragma unroll
        for (int bj = 0; bj < 2; ++bj)
#pragma unroll
            for (int n = 0; n < 2; ++n) { bv[bj][n] = *(const PG8_G f32x4*)(bb + bj * HALF + 4 * n);
                gn[bj][n] = (kind == 2) ? *(const PG8_G f32x4*)(gain + 32 * bj + 8 * fq + 4 * n) * scale : (f32x4){scale, scale, scale, scale}; }
#pragma unroll
        for (int ai = 0; ai < 2; ++ai)
#pragma unroll
            for (int m = 0; m < 4; ++m) {
                const int row = u.pm * BM + ai * HALF + wr * 64 + m * 16 + fr;
                const float r = 1.0f / sqrtf(sum16f(ssqx + (size_t)row * 16) * (1.0f / 1024.0f) + RMS_EPS);
                f32x4 v[2][2]; float ss = 0.f;
#pragma unroll
                for (int bj = 0; bj < 2; ++bj)
#pragma unroll
                    for (int n = 0; n < 2; ++n) { v[bj][n] = acc[ai][bj][m][n] * r + bv[bj][n]; ss += sq4(v[bj][n]); }
                if (kind == 3) {
                    float s0 = sq4(v[0][0]) + sq4(v[0][1]);
                    s0 += __shfl_xor(s0, 16); s0 += __shfl_xor(s0, 32);
                    *(PG8_G f32x4*)((PG8_G float*)(ws + WS_KPE) + (size_t)row * 32 + 8 * fq) = v[0][0]; *(PG8_G f32x4*)((PG8_G float*)(ws + WS_KPE) + (size_t)row * 32 + 8 * fq + 4) = v[0][1];
                    if (fq == 0) ((PG8_G float*)(ws + WS_SSQC) + (size_t)MROWS_ * 6)[row] = s0;
                } else {
                    if (kind != 0) { ss += __shfl_xor(ss, 16); ss += __shfl_xor(ss, 32); }
                    float rn = 1.0f;
                    if (kind == 2) rn = 1.0f / sqrtf(ss * (1.0f / 64.0f) + RMS_EPS);
                    if (kind == 1 && fq == 0) ssqd[(size_t)row * ssqp + ssqi] = ss;
#pragma unroll
                    for (int bj = 0; bj < 2; ++bj) {
                        const f32x4 y0 = v[bj][0] * gn[bj][0] * rn, y1 = v[bj][1] * gn[bj][1] * rn;
                        u32x4 w; w.x = cvt_pk_bf16(y0[0], y0[1]); w.y = cvt_pk_bf16(y0[2], y0[3]); w.z = cvt_pk_bf16(y1[0], y1[1]); w.w = cvt_pk_bf16(y1[2], y1[3]);
                        *(PG8_G u32x4*)(dst + (size_t)row * pitch + col0 + 32 * bj + 8 * fq) = w;
                    }
                }
                if (m & 1) PG8_FENCE();
            }
    }
};

struct EpiUq {
    static constexpr bool PERM = false, AFTER_DRAIN = false, HOOK = false;
    PG8_G unsigned char* ws;
    __device__ __forceinline__ void hook(f32x4 (&)[2][2][4][2], const Unit&, int, int, int, int, int) const {}
    __device__ __forceinline__ void operator()(const f32x4 (&acc)[2][2][4][2], const Unit& u, int wr, int wc, int fr, int fq) const {
        PG8_G float* QRAW = (PG8_G float*)(ws + WS_QRAW); const PG8_G float* ssqcq = (const PG8_G float*)(ws + WS_SSQC);
        const int col0 = u.pn * BM + wc * 32 + 4 * fq;
#pragma unroll
        for (int ai = 0; ai < 2; ++ai)
#pragma unroll
            for (int m = 0; m < 4; ++m) {
                const int row = u.pm * BM + ai * HALF + wr * 64 + m * 16 + fr;
                const f32x4 s = *(const PG8_G f32x4*)(ssqcq + (size_t)row * 4);
                const float r = 1.0f / sqrtf(((s[0] + s[1]) + (s[2] + s[3])) * (1.0f / 256.0f) + RMS_EPS);
#pragma unroll
                for (int bj = 0; bj < 2; ++bj)
#pragma unroll
                    for (int n = 0; n < 2; ++n) { const int c = col0 + bj * HALF + n * 16; if (c < 576) *(PG8_G f32x4*)(QRAW + (size_t)row * 576 + c) = acc[ai][bj][m][n] * r; }
            }
    }
};

struct EpiUkv {
    static constexpr bool PERM = true, AFTER_DRAIN = false, HOOK = false;
    PG8_G unsigned char* ws; const PG8_G float* gk;
    __device__ __forceinline__ void hook(f32x4 (&)[2][2][4][2], const Unit&, int, int, int, int, int) const {}
    __device__ __forceinline__ void operator()(const f32x4 (&acc)[2][2][4][2], const Unit& u, int wr, int wc, int fr, int fq) const {
        PG8_G bf16_t* KA = (PG8_G bf16_t*)(ws + WS_KA); PG8_G bf16_t* VA = (PG8_G bf16_t*)(ws + WS_VA); const PG8_G float* ssqckv = (const PG8_G float*)(ws + WS_SSQC) + (size_t)MROWS_ * 4; const PG8_G float* ssqkpe = (const PG8_G float*)(ws + WS_SSQC) + (size_t)MROWS_ * 6;
        const PG8_G float* kpe = (const PG8_G float*)(ws + WS_KPE); const PG8_G float* cs = (const PG8_G float*)(ws + WS_CS);
        const int h = 2 * u.pn + (wc >> 1); const bool isv = (wc & 1) != 0;
        f32x4 gn[2][2], g1 = {1.f, 1.f, 1.f, 1.f}, g2 = {1.f, 1.f, 1.f, 1.f};
        if (!isv) {
#pragma unroll
            for (int bj = 0; bj < 2; ++bj)
#pragma unroll
                for (int n = 0; n < 2; ++n) gn[bj][n] = *(const PG8_G f32x4*)(gk + 32 * bj + 8 * fq + 4 * n);
            g1 = *(const PG8_G f32x4*)(gk + 64 + 4 * fq); g2 = *(const PG8_G f32x4*)(gk + 80 + 4 * fq);
        }
#pragma unroll
        for (int ai = 0; ai < 2; ++ai)
#pragma unroll
            for (int m = 0; m < 4; ++m) {
                const int row = u.pm * BM + ai * HALF + wr * 64 + m * 16 + fr;
                const float r = 1.0f / sqrtf((ssqckv[(size_t)row * 2] + ssqckv[(size_t)row * 2 + 1]) * (1.0f / 128.0f) + RMS_EPS);
                f32x4 v[2][2]; float ss = 0.f;
#pragma unroll
                for (int bj = 0; bj < 2; ++bj)
#pragma unroll
                    for (int n = 0; n < 2; ++n) { v[bj][n] = acc[ai][bj][m][n] * r; ss += sq4(v[bj][n]); }
                if (isv) {
#pragma unroll
                    for (int bj = 0; bj < 2; ++bj) { u32x4 w; w.x = cvt_pk_bf16(v[bj][0][0], v[bj][0][1]); w.y = cvt_pk_bf16(v[bj][0][2], v[bj][0][3]); w.z = cvt_pk_bf16(v[bj][1][0], v[bj][1][1]); w.w = cvt_pk_bf16(v[bj][1][2], v[bj][1][3]);
                        *(PG8_G u32x4*)(VA + (size_t)row * 384 + 64 * h + 32 * bj + 8 * fq) = w; }
                } else {
                    ss += __shfl_xor(ss, 16); ss += __shfl_xor(ss, 32);
                    const float rk = 1.0f / sqrtf((ss + ssqkpe[row]) * (1.0f / 96.0f) + RMS_EPS);
                    PG8_G bf16_t* kd = KA + (size_t)row * 576 + 96 * h;
#pragma unroll
                    for (int bj = 0; bj < 2; ++bj) { const f32x4 y0 = v[bj][0] * gn[bj][0] * rk, y1 = v[bj][1] * gn[bj][1] * rk;
                        u32x4 w; w.x = cvt_pk_bf16(y0[0], y0[1]); w.y = cvt_pk_bf16(y0[2], y0[3]); w.z = cvt_pk_bf16(y1[0], y1[1]); w.w = cvt_pk_bf16(y1[2], y1[3]);
                        *(PG8_G u32x4*)(kd + 32 * bj + 8 * fq) = w; }
                    const f32x4 x1 = *(const PG8_G f32x4*)(kpe + (size_t)row * 32 + 4 * fq) * g1 * rk, x2 = *(const PG8_G f32x4*)(kpe + (size_t)row * 32 + 16 + 4 * fq) * g2 * rk;
                    const f32x4 c = *(const PG8_G f32x4*)(cs + (size_t)row * 32 + 4 * fq), s = *(const PG8_G f32x4*)(cs + (size_t)row * 32 + 16 + 4 * fq);
                    const f32x4 o1 = x1 * c - x2 * s, o2 = x2 * c + x1 * s;
                    u32x2 w1, w2; w1.x = cvt_pk_bf16(o1[0], o1[1]); w1.y = cvt_pk_bf16(o1[2], o1[3]); w2.x = cvt_pk_bf16(o2[0], o2[1]); w2.y = cvt_pk_bf16(o2[2], o2[3]);
                    *(PG8_G u32x2*)(kd + 64 + 4 * fq) = w1; *(PG8_G u32x2*)(kd + 80 + 4 * fq) = w2;
                }
                if (m & 1) PG8_FENCE();
            }
    }
};
}
#define GAS __attribute__((address_space(1)))
#define LAS __attribute__((address_space(3)))
typedef unsigned short bf16;
typedef unsigned v4u __attribute__((ext_vector_type(4)));
typedef float f32x4 __attribute__((ext_vector_type(4)));
typedef short bf16x8 __attribute__((ext_vector_type(8)));
typedef GAS unsigned gu32;
typedef GAS unsigned long long gu64;
#define RLX_AGENT __ATOMIC_RELAXED, __HIP_MEMORY_SCOPE_AGENT
#define LDS_WAIT() asm volatile("s_waitcnt lgkmcnt(0)" ::: "memory")
#define VM_WAIT() asm volatile("s_waitcnt vmcnt(0)" ::: "memory")
__device__ __forceinline__ unsigned long long rt() { return __builtin_amdgcn_s_memrealtime(); }
__device__ __forceinline__ unsigned f2bf(float f) { unsigned u = __builtin_bit_cast(unsigned, f); return (u + 0x7fffu + ((u >> 16) & 1u)) >> 16; }
__device__ __forceinline__ unsigned pk2(float lo, float hi) { return f2bf(lo) | (f2bf(hi) << 16); }

#define XB_TMO      128
#define XB_XCNT(j)  (256  + 64 * (j))
#define XB_XSUB(j)  (1280 + 64 * (j))
#define XB_XGEN(j)  (2304 + 64 * (j))
#define XB_TOP      3328
#define XB_TOPGEN   3392
#define XCD_BAR_WORDS 3456
#define XB_SPIN_CAP (1u << 18)

__device__ __forceinline__ unsigned xb_ld(unsigned* p)              { return __hip_atomic_load(p, __ATOMIC_RELAXED, __HIP_MEMORY_SCOPE_AGENT); }
__device__ __forceinline__ unsigned xb_add(unsigned* p, unsigned v) { return __hip_atomic_fetch_add(p, v, __ATOMIC_RELAXED, __HIP_MEMORY_SCOPE_AGENT); }
__device__ __forceinline__ unsigned xb_xcc_id() { return (unsigned)__builtin_amdgcn_s_getreg((3 << 11) | 20) & 0xFu; }
#define XB_SPIN(cond, bar) do { unsigned _sp = 0; while (cond) { __builtin_amdgcn_s_sleep(1); \
    if ((++_sp & 255u) == 0u) { if (xb_ld(&(bar)[XB_TMO])) break; if (_sp > XB_SPIN_CAP) { atomicAdd(&(bar)[XB_TMO], 1u); break; } } } } while (0)

struct XcdBarrier {
    unsigned* bar; unsigned x;
    volatile LAS unsigned* st;
};

__device__ __forceinline__ XcdBarrier xcd_barrier_post(unsigned* bar, volatile LAS unsigned* st) {
    XcdBarrier b; b.bar = bar; b.x = xb_xcc_id(); b.st = st;
    if (threadIdx.x == 0) (void)xb_add(&bar[XB_XCNT(b.x)], 1u);
    return b;
}
__device__ __forceinline__ void xcd_barrier_complete(unsigned* bar, unsigned x, unsigned& nloc, unsigned& nx) {
    const unsigned G = gridDim.x * gridDim.y * gridDim.z;
    unsigned sum, cnt, mine, sp = 0u;
    for (;;) {
        sum = 0u; cnt = 0u; mine = 0u;
#pragma unroll
        for (unsigned j = 0; j < 16; ++j) { const unsigned c = xb_ld(&bar[XB_XCNT(j)]); sum += c; cnt += (c > 0u) ? 1u : 0u; mine = (j == x) ? c : mine; }
        if (sum == G) break;
        __builtin_amdgcn_s_sleep(1);
        if ((++sp & 255u) == 0u) { if (xb_ld(&bar[XB_TMO])) break; if (sp > XB_SPIN_CAP) { atomicAdd(&bar[XB_TMO], 1u); break; } }
    }
    nloc = mine > 0u ? mine : 1u; nx = cnt > 0u ? cnt : 1u;
}

__device__ __forceinline__ void xcd_barrier(const XcdBarrier& b) {
    asm volatile("s_waitcnt vmcnt(0)" ::: "memory");
    __syncthreads();
    if (threadIdx.x == 0) {
        unsigned* bar = b.bar;
        __builtin_amdgcn_s_waitcnt(0);
        unsigned nloc = b.st[0], nx = b.st[1];
        if (nloc == 0u) { xcd_barrier_complete(bar, b.x, nloc, nx); b.st[0] = nloc; b.st[1] = nx; }
        const unsigned old = xb_add(&bar[XB_XSUB(b.x)], 1u);
        const unsigned gen = old / nloc;
        if (old + 1u == (gen + 1u) * nloc) {
            __builtin_amdgcn_fence(__ATOMIC_RELEASE, "agent");
            asm volatile("s_waitcnt vmcnt(0)" ::: "memory");
            const unsigned og = xb_add(&bar[XB_TOP], 1u);
            const unsigned tg = og / nx;
            if (og + 1u == (tg + 1u) * nx) xb_add(&bar[XB_TOPGEN], 1u);
            else XB_SPIN(xb_ld(&bar[XB_TOPGEN]) == tg, bar);
            __builtin_amdgcn_fence(__ATOMIC_ACQUIRE, "agent");
            xb_add(&bar[XB_XGEN(b.x)], 1u);
            asm volatile("s_waitcnt vmcnt(0)" ::: "memory");
        } else {
            XB_SPIN(xb_ld(&bar[XB_XGEN(b.x)]) == gen, bar);
            __builtin_amdgcn_fence(__ATOMIC_ACQUIRE, "agent");
            asm volatile("s_waitcnt vmcnt(0)" ::: "memory");
        }
    }
    __syncthreads();
}
namespace att {
typedef unsigned short bf16_t;
typedef short bf16x8 __attribute__((ext_vector_type(8)));
typedef short s16x4 __attribute__((ext_vector_type(4)));
typedef short v4i16_t __attribute__((ext_vector_type(4)));
typedef float f32x16 __attribute__((ext_vector_type(16)));
typedef float f32x4 __attribute__((ext_vector_type(4)));
typedef float f32x2 __attribute__((ext_vector_type(2)));
typedef __bf16 bf16x2_t __attribute__((ext_vector_type(2)));
typedef unsigned u32x4 __attribute__((ext_vector_type(4)));
typedef int i32x4 __attribute__((ext_vector_type(4)));
#define ALAS __attribute__((address_space(3)))
#define AGAS __attribute__((address_space(1)))
constexpr int SEQ = 8192;
constexpr float LOG2E = 1.4426950408889634f, EPS = 1e-6f;
constexpr int KCS = 1040, VHS = 4160;
constexpr int KSLOT = 12 * KCS, VSLOT = 2 * VHS;
constexpr int L_K = 0, L_V = 3 * KSLOT, L_POS = L_V + 4 * VSLOT, L_TB = L_POS + 1024, L_WSF = L_TB + 128, L_OST = L_WSF + 8 * 256, L_FLAG = L_OST + 8 * 4096, L_END = L_FLAG + 16 + 64;
static_assert(L_OST % 16 == 0 && L_V % 16 == 0 && L_END <= 131072, "attention LDS map");

__device__ __forceinline__ int crow(int r, int hi) { return (r & 3) + 8 * (r >> 2) + 4 * hi; }
__device__ __forceinline__ unsigned cvtpk(float lo, float hi) { f32x2 v = {lo, hi}; bf16x2_t b = __builtin_convertvector(v, bf16x2_t); return __builtin_bit_cast(unsigned, b); }
__device__ __forceinline__ s16x4 vtr(const ALAS unsigned char* p) { return __builtin_bit_cast(s16x4, __builtin_amdgcn_ds_read_tr16_b64_v4i16((ALAS v4i16_t*)p)); }
__device__ __forceinline__ float swap_sum(float x) { auto rr = __builtin_amdgcn_permlane32_swap(__float_as_uint(x), __float_as_uint(x), false, false); return __uint_as_float(rr[0]) + __uint_as_float(rr[1]); }
__device__ __forceinline__ float swap_max(float x) { auto rr = __builtin_amdgcn_permlane32_swap(__float_as_uint(x), __float_as_uint(x), false, false); return fmaxf(__uint_as_float(rr[0]), __uint_as_float(rr[1])); }
__device__ __forceinline__ float bf2f(unsigned short h) { return __uint_as_float((unsigned)h << 16); }

__device__ __forceinline__ void glds16(const AGAS void* gsrc, unsigned lds_dst) { unsigned keep;
    asm volatile("s_mov_b32 %0, m0\n\ts_mov_b32 m0, %2\n\ts_nop 0\n\tglobal_load_lds_dwordx4 %1, off\n\ts_mov_b32 m0, %0" : "=&s"(keep) : "v"(gsrc), "s"(lds_dst) : "memory"); }
__device__ __forceinline__ void glds4(const AGAS void* gsrc, unsigned lds_dst) { unsigned keep;
    asm volatile("s_mov_b32 %0, m0\n\ts_mov_b32 m0, %2\n\ts_nop 0\n\tglobal_load_lds_dword %1, off\n\ts_mov_b32 m0, %0" : "=&s"(keep) : "v"(gsrc), "s"(lds_dst) : "memory"); }

struct AttnP {
    AGAS unsigned char* ws;
    const AGAS float* gq;
    const AGAS int* pos; const AGAS float* sinks; const AGAS float* relb;
};
template <int MODE> struct AttnCfg;
template <> struct AttnCfg<0> { static constexpr size_t Q = WS_QRAW, K = WS_KA, V = WS_VA; static constexpr int qpitch = 576, kpitch = 576, khs = 96, vpitch = 384, vhs = 64, ocol0 = 0, hidx0 = 0, group = 1; };
template <> struct AttnCfg<1> { static constexpr size_t Q = WS_QS, K = WS_KS, V = WS_VS; static constexpr int qpitch = 384, kpitch = 128, khs = 64, vpitch = 128, vhs = 64, ocol0 = 384, hidx0 = 6, group = 3; };
template <> struct AttnCfg<2> { static constexpr size_t Q = WS_QC, K = WS_KC, V = WS_VC; static constexpr int qpitch = 256, kpitch = 256, khs = 64, vpitch = 256, vhs = 64, ocol0 = 768, hidx0 = 12, group = 1; };

template <int DQK, int MODE>
__device__ __forceinline__ void attn_unit(ALAS unsigned char* lds, const AttnP& P, int b, int h, int qb) {
    constexpr int NCH = DQK / 8, ND0 = DQK / 16;
    int tid_ = threadIdx.x; asm volatile("" : "+v"(tid_));
    const int tid = tid_, lane = tid & 63, r32 = lane & 31, hi = lane >> 5;
    const int wid = __builtin_amdgcn_readfirstlane(tid >> 6);
    const int q0 = qb * 256, qlo = q0 + 32 * wid, qhi = qlo + 31, qrow = qlo + r32;
    const size_t rb = (size_t)b * SEQ;
    typedef AttnCfg<MODE> C; const int kvh = h / C::group;
    ALAS float* wsf = (ALAS float*)(lds + L_WSF) + wid * 64;
    ALAS unsigned char* ost = lds + L_OST + wid * 4096;
    ALAS int* posl = (ALAS int*)(lds + L_POS);
    ALAS float* tb = (ALAS float*)(lds + L_TB);

    bf16x8 qf[ND0];
    if constexpr (MODE == 0) {
        const AGAS float* qp = (const AGAS float*)(P.ws + C::Q) + (rb + qrow) * 576 + h * 96 + hi * 8;
        float qv[ND0][8]; float ss = 0.f;
#pragma unroll
        for (int d0 = 0; d0 < ND0; ++d0) { const f32x4 a = *(const AGAS f32x4*)(qp + 16 * d0), c = *(const AGAS f32x4*)(qp + 16 * d0 + 4);
#pragma unroll
            for (int i = 0; i < 4; ++i) { qv[d0][i] = a[i]; qv[d0][4 + i] = c[i]; ss += a[i] * a[i] + c[i] * c[i]; } }
        ss = swap_sum(ss);
        const float rq = 1.0f / sqrtf(ss * (1.0f / 96.0f) + EPS);
#pragma unroll
        for (int d0 = 0; d0 < ND0; ++d0) { const f32x4 ga = *(const AGAS f32x4*)(P.gq + 16 * d0 + 8 * hi), gb = *(const AGAS f32x4*)(P.gq + 16 * d0 + 8 * hi + 4);
#pragma unroll
            for (int i = 0; i < 4; ++i) { qv[d0][i] *= rq * ga[i]; qv[d0][4 + i] *= rq * gb[i]; } }
        {
            const AGAS float* cp = (const AGAS float*)(P.ws + WS_CS) + (rb + qrow) * 32 + 8 * hi;
            const f32x4 c0 = *(const AGAS f32x4*)cp, c1 = *(const AGAS f32x4*)(cp + 4), s0 = *(const AGAS f32x4*)(cp + 16), s1 = *(const AGAS f32x4*)(cp + 20);
#pragma unroll
            for (int i = 0; i < 8; ++i) { const float c = i < 4 ? c0[i & 3] : c1[i & 3], s = i < 4 ? s0[i & 3] : s1[i & 3]; const float x1 = qv[4][i], x2 = qv[5][i]; qv[4][i] = x1 * c - x2 * s; qv[5][i] = x2 * c + x1 * s; }
        }
        const float sc = 0.10206207261596575f * LOG2E;
#pragma unroll
        for (int d0 = 0; d0 < ND0; ++d0) { u32x4 w; w.x = cvtpk(qv[d0][0] * sc, qv[d0][1] * sc); w.y = cvtpk(qv[d0][2] * sc, qv[d0][3] * sc); w.z = cvtpk(qv[d0][4] * sc, qv[d0][5] * sc); w.w = cvtpk(qv[d0][6] * sc, qv[d0][7] * sc); qf[d0] = __builtin_bit_cast(bf16x8, w); }
    } else {
        const AGAS bf16_t* qp = (const AGAS bf16_t*)(P.ws + C::Q) + (rb + qrow) * C::qpitch + h * 64 + hi * 8;
#pragma unroll
        for (int d0 = 0; d0 < ND0; ++d0) qf[d0] = *(const AGAS bf16x8*)(qp + 16 * d0);
    }
    int posq = 0; float sink2 = 0.f;
    if constexpr (MODE == 1) {
        posq = P.pos[rb + qrow]; sink2 = P.sinks[h] * LOG2E;
        if (tid < 32) tb[tid] = P.relb[tid * 6 + h] * LOG2E;
    }

    int ntile, tfirst, tstep;
    if (MODE == 0) { tfirst = 0; tstep = 1; ntile = ((q0 + 255) >> 6) + 1; }
    else if (MODE == 1) { const int lo = q0 - 127 > 0 ? q0 - 127 : 0; tfirst = lo >> 6; tstep = 1; ntile = ((q0 + 255) >> 6) - tfirst + 1; }
    else { tfirst = (q0 + 254) >> 6; tstep = -1; ntile = tfirst + 1; }

    const AGAS bf16_t* Kg = (const AGAS bf16_t*)(P.ws + C::K) + rb * C::kpitch + kvh * C::khs;
    const AGAS bf16_t* Vg = (const AGAS bf16_t*)(P.ws + C::V) + rb * C::vpitch + kvh * C::vhs;
    const unsigned lds0 = (unsigned)(uintptr_t)lds;
    const AGAS bf16_t* ksrc0 = Kg + (size_t)lane * C::kpitch + 8 * wid;
    const AGAS bf16_t* vsrc = Vg + (size_t)(16 * (wid & 3) + (lane >> 2)) * C::vpitch + 32 * (wid >> 2) + 8 * (lane & 3);
    const bool k2 = (wid + 8) < NCH;
    const bool pw = (MODE == 1) && wid == 0;
    const int NP = 2 + (k2 ? 1 : 0) + (pw ? 1 : 0);
#define ATT_ISSUE(T, IT) do { const int T_ = (T); const size_t jo_ = (size_t)T_ * 64; const int ks_ = (IT) % 3, vs_ = (IT) & 3;     \
        glds16(ksrc0 + jo_ * C::kpitch, (unsigned)__builtin_amdgcn_readfirstlane(lds0 + L_K + ks_ * KSLOT + wid * KCS)); \
        if (k2) glds16(ksrc0 + jo_ * C::kpitch + 64, (unsigned)__builtin_amdgcn_readfirstlane(lds0 + L_K + ks_ * KSLOT + (wid + 8) * KCS)); \
        glds16(vsrc + jo_ * C::vpitch, (unsigned)__builtin_amdgcn_readfirstlane(lds0 + L_V + vs_ * VSLOT + (wid >> 2) * VHS + (wid & 3) * 1024)); \
        if (pw) glds4(P.pos + rb + jo_ + lane, (unsigned)__builtin_amdgcn_readfirstlane(lds0 + L_POS + vs_ * 256)); } while (0)
#define ATT_WAIT_BAR(n_) do { if ((n_) <= 0) asm volatile("s_waitcnt vmcnt(0) lgkmcnt(0)\n\ts_barrier" ::: "memory"); \
        else if (NP == 2) asm volatile("s_waitcnt vmcnt(2) lgkmcnt(0)\n\ts_barrier" ::: "memory"); \
        else if (NP == 3) asm volatile("s_waitcnt vmcnt(3) lgkmcnt(0)\n\ts_barrier" ::: "memory"); \
        else asm volatile("s_waitcnt vmcnt(4) lgkmcnt(0)\n\ts_barrier" ::: "memory"); } while (0)

    f32x16 o0 = {}, o1 = {};
    float mrun = (MODE == 1) ? sink2 : 0.f;
    float lrun = (MODE == 1 && hi == 0) ? 1.0f : 0.f;
    f32x16 negm;
#pragma unroll
    for (int r = 0; r < 16; ++r) negm[r] = (MODE == 2) ? 0.f : -mrun;
    bool first = (MODE == 0);
    float after = 0.f;
    bool walive = true;
    const int vrd = ((lane >> 4) & 1) * 32 + (lane & 3) * 8 + (4 * hi + ((lane & 15) >> 2)) * 64;
    const bool lag = wid >= 4;
    constexpr float THR = 4.0f;

#define ATT_QK(P0, P1, kb) do { int kofs_ = L_K + (kb) * KSLOT + hi * KCS + r32 * 16; asm volatile("" : "+v"(kofs_)); const ALAS unsigned char* Kb_ = lds + kofs_;     \
        bf16x8 ka0_ = *(const ALAS bf16x8*)(Kb_), ka1_ = *(const ALAS bf16x8*)(Kb_ + 512); \
        __builtin_amdgcn_sched_barrier(0); \
        _Pragma("unroll") for (int d0 = 0; d0 < ND0; ++d0) { \
            bf16x8 kn0_ = ka0_, kn1_ = ka1_; \
            if (d0 + 1 < ND0) { kn0_ = *(const ALAS bf16x8*)(Kb_ + 2 * (d0 + 1) * KCS); kn1_ = *(const ALAS bf16x8*)(Kb_ + 2 * (d0 + 1) * KCS + 512); } \
            if (d0 == 0) { P0 = __builtin_amdgcn_mfma_f32_32x32x16_bf16(ka0_, qf[0], negm, 0, 0, 0); P1 = __builtin_amdgcn_mfma_f32_32x32x16_bf16(ka1_, qf[0], negm, 0, 0, 0); } \
            else { P0 = __builtin_amdgcn_mfma_f32_32x32x16_bf16(ka0_, qf[d0], P0, 0, 0, 0); P1 = __builtin_amdgcn_mfma_f32_32x32x16_bf16(ka1_, qf[d0], P1, 0, 0, 0); } \
            ka0_ = kn0_; ka1_ = kn1_; \
            __builtin_amdgcn_sched_barrier(0); } } while (0)
#define ATT_VLD(s_) do { vl0_ = vtr(Vb_ + (s_) * 1024); vh0_ = vtr(Vb_ + (s_) * 1024 + 512); vl1_ = vtr(Vb_ + VHS + (s_) * 1024); vh1_ = vtr(Vb_ + VHS + (s_) * 1024 + 512); } while (0)
#define ATT_PV(P0, P1, vb) do { int vofs_ = L_V + (vb) * VSLOT + vrd; asm volatile("" : "+v"(vofs_)); const ALAS unsigned char* Vb_ = lds + vofs_; \
        s16x4 vl0_, vh0_, vl1_, vh1_; ATT_VLD(0); \
        __builtin_amdgcn_sched_barrier(0); \
        _Pragma("unroll") for (int s_ = 0; s_ < 4; ++s_) { u32x4 w_; \
            if (s_ < 2) { const int bs = 8 * s_; w_.x = cvtpk(P0[bs], P0[bs + 1]); w_.y = cvtpk(P0[bs + 2], P0[bs + 3]); w_.z = cvtpk(P0[bs + 4], P0[bs + 5]); w_.w = cvtpk(P0[bs + 6], P0[bs + 7]); } \
            else { const int bs = 8 * (s_ - 2); w_.x = cvtpk(P1[bs], P1[bs + 1]); w_.y = cvtpk(P1[bs + 2], P1[bs + 3]); w_.z = cvtpk(P1[bs + 4], P1[bs + 5]); w_.w = cvtpk(P1[bs + 6], P1[bs + 7]); } \
            const bf16x8 pa_ = __builtin_bit_cast(bf16x8, w_); \
            const bf16x8 v0_ = {vl0_[0], vl0_[1], vl0_[2], vl0_[3], vh0_[0], vh0_[1], vh0_[2], vh0_[3]}, v1_ = {vl1_[0], vl1_[1], vl1_[2], vl1_[3], vh1_[0], vh1_[1], vh1_[2], vh1_[3]}; \
            if (s_ + 1 < 4) ATT_VLD(s_ + 1); \
            o0 = __builtin_amdgcn_mfma_f32_32x32x16_bf16(pa_, v0_, o0, 0, 0, 0); o1 = __builtin_amdgcn_mfma_f32_32x32x16_bf16(pa_, v1_, o1, 0, 0, 0); \
            __builtin_amdgcn_sched_barrier(0); } } while (0)
#define ATT_MAX3(a, b, c) fmaxf(fmaxf((a), (b)), (c))
#define ATT_SM(P0, P1, j0_, pslot) do { \
        if constexpr (MODE == 2) { \
            const bool nm_ = (j0_) + 63 >= qlo; \
            float ln0[16], ln1[16]; \
            _Pragma("unroll") for (int r = 0; r < 16; ++r) { const int key = (j0_) + crow(r, hi); \
                { const float z = P0[r]; const float sp = fmaxf(z, 0.f) + __builtin_amdgcn_logf(1.0f + __builtin_amdgcn_exp2f(-fabsf(z))); const bool ok = !nm_ || key < qrow; ln0[r] = ok ? -sp : 0.f; P0[r] = ok ? z - sp : -INFINITY; } \
                { const float z = P1[r]; const float sp = fmaxf(z, 0.f) + __builtin_amdgcn_logf(1.0f + __builtin_amdgcn_exp2f(-fabsf(z))); const bool ok = !nm_ || key + 32 < qrow; ln1[r] = ok ? -sp : 0.f; P1[r] = ok ? z - sp : -INFINITY; } } \
            float run = after; \
            _Pragma("unroll") for (int blk = 1; blk >= 0; --blk) _Pragma("unroll") for (int g = 3; g >= 0; --g) { \
                const float own = blk ? ((ln1[4 * g] + ln1[4 * g + 1]) + (ln1[4 * g + 2] + ln1[4 * g + 3])) : ((ln0[4 * g] + ln0[4 * g + 1]) + (ln0[4 * g + 2] + ln0[4 * g + 3])); \
                auto rr = __builtin_amdgcn_permlane32_swap(__float_as_uint(own), __float_as_uint(own), false, false); \
                const float slo = __uint_as_float(rr[0]), shi = __uint_as_float(rr[1]); \
                const float e1 = run; run += shi; const float e0 = run; run += slo; \
                float aft = hi ? e1 : e0; \
                _Pragma("unroll") for (int i = 3; i >= 0; --i) { const int r = 4 * g + i; \
                    if (blk) { P1[r] = __builtin_amdgcn_exp2f(P1[r] + aft); aft += ln1[r]; } else { P0[r] = __builtin_amdgcn_exp2f(P0[r] + aft); aft += ln0[r]; } } } \
            after = run; walive = __any(after > -160.0f); \
        } else { \
            if constexpr (MODE == 1) { \
                _Pragma("unroll") for (int g = 0; g < 4; ++g) { \
                    const i32x4 pa = *(const ALAS i32x4*)(posl + (pslot) * 64 + 8 * g + 4 * hi), pb = *(const ALAS i32x4*)(posl + (pslot) * 64 + 32 + 8 * g + 4 * hi); \
                    _Pragma("unroll") for (int i = 0; i < 4; ++i) { \
                        { int n = posq - pa[i]; n = n > 0 ? n : 0; int bk = n; if (n >= 16) { bk = 16 + (int)((__builtin_amdgcn_logf((float)n) - 4.0f) * (16.0f / 3.0f)); bk = bk < 31 ? bk : 31; } P0[4 * g + i] += tb[bk]; } \
                        { int n = posq - pb[i]; n = n > 0 ? n : 0; int bk = n; if (n >= 16) { bk = 16 + (int)((__builtin_amdgcn_logf((float)n) - 4.0f) * (16.0f / 3.0f)); bk = bk < 31 ? bk : 31; } P1[4 * g + i] += tb[bk]; } } } } \
            const bool nm_ = (MODE == 1) || ((j0_) + 63 > qlo); \
            if (nm_) { \
                _Pragma("unroll") for (int r = 0; r < 16; ++r) { const int key = (j0_) + crow(r, hi); \
                    bool ok0 = key <= qrow, ok1 = key + 32 <= qrow; \
                    if (MODE == 1) { ok0 = ok0 && (key > qrow - 128); ok1 = ok1 && (key + 32 > qrow - 128); } \
                    if (!ok0) P0[r] = -INFINITY; if (!ok1) P1[r] = -INFINITY; } } \
            float ma = ATT_MAX3(P0[0], P0[1], P1[0]), mb = ATT_MAX3(P0[2], P0[3], P1[1]); ma = ATT_MAX3(ma, P1[2], P1[3]); \
            _Pragma("unroll") for (int r = 4; r < 16; r += 4) { ma = ATT_MAX3(ma, P0[r], P0[r + 1]); mb = ATT_MAX3(mb, P0[r + 2], P0[r + 3]); ma = ATT_MAX3(ma, P1[r], P1[r + 1]); mb = ATT_MAX3(mb, P1[r + 2], P1[r + 3]); } \
            const float mt = swap_max(fmaxf(ma, mb)); \
            if (first || __any(mt > THR)) {                                 \
                const float d = first ? mt : fmaxf(mt, 0.f); first = false; \
                _Pragma("unroll") for (int r = 0; r < 16; ++r) { P0[r] -= d; P1[r] -= d; } \
                const float alpha = __builtin_amdgcn_exp2f(-d); mrun += d; lrun *= alpha; \
                _Pragma("unroll") for (int r = 0; r < 16; ++r) negm[r] = -mrun; \
                if (hi == 0) wsf[r32] = alpha; \
                _Pragma("unroll") for (int g = 0; g < 4; ++g) { const f32x4 al = *(const ALAS f32x4*)(wsf + 8 * g + 4 * hi); \
                    _Pragma("unroll") for (int i = 0; i < 4; ++i) { o0[4 * g + i] *= al[i]; o1[4 * g + i] *= al[i]; } } } \
            float ls = 0.f; \
            _Pragma("unroll") for (int r = 0; r < 16; ++r) { P0[r] = __builtin_amdgcn_exp2f(P0[r]); P1[r] = __builtin_amdgcn_exp2f(P1[r]); ls += P0[r] + P1[r]; } \
            lrun += ls; \
        } } while (0)
#define ATT_WORK(j0_) ((MODE == 0) ? ((j0_) <= qhi) : (MODE == 1) ? (((j0_) <= qhi) && ((j0_) + 63 >= qlo - 127)) : (walive && ((j0_) < qhi)))

    f32x16 p0, p1;
    bool pend = false; int pj0 = 0, pit = 0;
    __syncthreads();
    ATT_ISSUE(tfirst, 0);
    int issued = 0;
    if (ntile > 1) { ATT_ISSUE(tfirst + tstep, 1); issued = 1; }
    ATT_WAIT_BAR(issued);
    int nt = ntile;
    for (int it = 0; it <= nt; ++it) {
        const bool tilev = it < nt;
        const int t = tfirst + it * tstep, j0 = t * 64, kb = it % 3;
        if (tilev && it + 2 < ntile) { ATT_ISSUE(t + 2 * tstep, it + 2); issued = it + 2; }
        if (tilev && !lag && ATT_WORK(j0)) { ATT_QK(p0, p1, kb); pend = true; pj0 = j0; pit = it; }
        if (pend) { ATT_SM(p0, p1, pj0, pit & 3); ATT_PV(p0, p1, pit & 3); pend = false; }
        if (tilev && lag && ATT_WORK(j0)) { ATT_QK(p0, p1, kb); pend = true; pj0 = j0; pit = it; }
        if (!tilev) break;
        if (MODE == 2) { ALAS int* fl = (ALAS int*)(lds + L_FLAG + 16) + (it & 1) * 8; if (lane == 0) fl[wid] = (walive && j0 > 0) ? 1 : 0; }
        ATT_WAIT_BAR(issued - (it + 1));
        if (MODE == 2) { const ALAS int* fl = (const ALAS int*)(lds + L_FLAG + 16) + (it & 1) * 8;
            const i32x4 fa = *(const ALAS i32x4*)fl, fb = *(const ALAS i32x4*)(fl + 4);
            if (((fa[0] | fa[1]) | (fa[2] | fa[3]) | (fb[0] | fb[1]) | (fb[2] | fb[3])) == 0) nt = it + 1; }
    }
    if (MODE == 2) asm volatile("s_waitcnt vmcnt(0)" ::: "memory");
#undef ATT_ISSUE
#undef ATT_WAIT_BAR
#undef ATT_QK
#undef ATT_PV
#undef ATT_VLD
#undef ATT_SM
#undef ATT_WORK
#undef ATT_MAX3
    if (MODE != 2) {
        const float lt = swap_sum(lrun);
        if (hi == 0) wsf[32 + r32] = 1.0f / lt;
#pragma unroll
        for (int g = 0; g < 4; ++g) { const f32x4 il = *(const ALAS f32x4*)(wsf + 32 + 8 * g + 4 * hi);
#pragma unroll
            for (int i = 0; i < 4; ++i) { o0[4 * g + i] *= il[i]; o1[4 * g + i] *= il[i]; } }
    }
    {
        ALAS bf16_t* stg = (ALAS bf16_t*)ost;
#pragma unroll
        for (int r = 0; r < 16; ++r) { const int orow = crow(r, hi); stg[orow * 64 + r32] = (bf16_t)(cvtpk(o0[r], 0.f) & 0xffffu); stg[orow * 64 + 32 + r32] = (bf16_t)(cvtpk(o1[r], 0.f) & 0xffffu); }
        AGAS bf16_t* Ow = (AGAS bf16_t*)(P.ws + WS_OALL) + (rb + qlo) * 1024 + C::ocol0 + h * 64;
#pragma unroll
        for (int i = 0; i < 4; ++i) {
            const int row = i * 8 + (lane >> 3), ch = lane & 7;
            const u32x4 v = *(const ALAS u32x4*)(stg + row * 64 + ch * 8);
            float ss = 0.f;
#pragma unroll
            for (int k = 0; k < 4; ++k) { const unsigned w = v[k]; const float a = __uint_as_float(w << 16), c = __uint_as_float(w & 0xffff0000u); ss += a * a + c * c; }
            ss += __shfl_xor(ss, 1); ss += __shfl_xor(ss, 2); ss += __shfl_xor(ss, 4);
            *(AGAS u32x4*)(Ow + (size_t)row * 1024 + ch * 8) = v;
            if (ch == 0) ((AGAS float*)(P.ws + WS_SSQO))[(rb + qlo + row) * 16 + C::hidx0 + h] = ss;
        }
    }
}
#undef ALAS
#undef AGAS
}
struct Args { const void* in[23]; float* out; unsigned char* ws; int ph_lo, ph_hi, li, adapt; };

struct Frame { LAS unsigned char* lds; int tid, lane, wave, vcu, G; };

__device__ __forceinline__ float wave_sum64(float v) {
#pragma unroll
    for (int o = 1; o < 64; o <<= 1) v += __shfl_xor(v, o);
    return v;
}

__device__ __forceinline__ void tr_item64(const GAS float* W, int ldn, int K, GAS pg8::bf16_t* WT, int kb, int g, int src0, int src1, const GAS float* kgain, LAS unsigned* scr, int lane) {
    const int k0 = 64 * kb; const int col = lane < 32 ? src0 + lane : src1 + (lane - 32); const bool ok = (lane < 32 ? src0 : src1) >= 0;
    float v[64];
    const GAS float* wp = W + (size_t)k0 * ldn + (ok ? col : 0);
#pragma unroll
    for (int i = 0; i < 64; ++i) v[i] = wp[(size_t)i * ldn];
#pragma unroll
    for (int i = 0; i < 64; ++i) v[i] = ok ? v[i] : 0.f;
    if (kgain) {
#pragma unroll
        for (int i = 0; i < 64; ++i) v[i] *= kgain[k0 + i]; }
#pragma unroll
    for (int i = 0; i < 32; ++i) scr[i * 65 + lane] = pk2(v[2 * i], v[2 * i + 1]);
    asm volatile("s_waitcnt lgkmcnt(0)" ::: "memory");
    const int c = lane & 7;
#pragma unroll
    for (int j = 0; j < 8; ++j) { const int n = (lane >> 3) + 8 * j; const LAS unsigned* s = scr + (4 * c) * 65 + n;
        v4u o; o.x = s[0]; o.y = s[65]; o.z = s[130]; o.w = s[195];
        *(GAS v4u*)(WT + (size_t)(64 * g + n) * K + k0 + 8 * c) = o; }
    asm volatile("s_waitcnt lgkmcnt(0)" ::: "memory");
}
__device__ __forceinline__ int in_slot_src(int slot, int& cnt) {
    cnt = 64;
    if (slot < 4) return 64 * slot;
    if (slot < 6) return 256 + 64 * (slot - 4);
    if (slot == 6) { cnt = 32; return 384; }
    if (slot == 7) return -1;
    if (slot < 14) return 416 + 64 * (slot - 8);
    if (slot < 16) return 800 + 64 * (slot - 14);
    if (slot < 18) return 928 + 64 * (slot - 16);
    if (slot < 22) return 1056 + 64 * (slot - 18);
    if (slot < 26) return 1312 + 64 * (slot - 22);
    if (slot < 30) return 1568 + 64 * (slot - 26);
    return -1;
}

#define A_X ((const GAS float*)args.in[0])
#define A_C ((const GAS float*)args.in[1])
#define A_POS ((const GAS int*)args.in[2])
#define A_RELB ((const GAS float*)args.in[3])
#define A_NORMG ((const GAS float*)args.in[4])
#define A_WMOD ((const GAS float*)args.in[5])
#define A_BMOD ((const GAS float*)args.in[6])
#define A_WGU1 ((const GAS float*)args.in[7])
#define A_WD1 ((const GAS float*)args.in[8])
#define A_WIN ((const GAS float*)args.in[9])
#define A_QAN ((const GAS float*)args.in[10])
#define A_KVAN ((const GAS float*)args.in[11])
#define A_WUQ ((const GAS float*)args.in[12])
#define A_WUKV ((const GAS float*)args.in[13])
#define A_MLAQN ((const GAS float*)args.in[14])
#define A_MLAKN ((const GAS float*)args.in[15])
#define A_SWAQN ((const GAS float*)args.in[16])
#define A_SWAKN ((const GAS float*)args.in[17])
#define A_SINKS ((const GAS float*)args.in[18])
#define A_OUTN ((const GAS float*)args.in[19])
#define A_WOUT ((const GAS float*)args.in[20])
#define A_WGU2 ((const GAS float*)args.in[21])
#define A_WD2 ((const GAS float*)args.in[22])
#define WSP(off)   (ws_ + (off))
#define MOD ((GAS float*)WSP(WS_MOD))
#define GS ((GAS float*)WSP(WS_GS))
#define BIAS ((GAS float*)WSP(WS_BIAS))
#define SSQX ((GAS float*)WSP(WS_SSQX))
#define SSQO ((GAS float*)WSP(WS_SSQO))
#define CS ((GAS float*)WSP(WS_CS))
#define KPE ((GAS float*)WSP(WS_KPE))
#define SSQ_CQ ((GAS float*)WSP(WS_SSQC))
#define SSQ_CKV ((GAS float*)WSP(WS_SSQC) + (size_t)MROWS * 4)
#define SSQ_KPE ((GAS float*)WSP(WS_SSQC) + (size_t)MROWS * 6)
#define XB ((GAS pg8::bf16_t*)WSP(WS_XB))
#define HID ((GAS pg8::bf16_t*)WSP(WS_HID))
#define CQ ((GAS pg8::bf16_t*)WSP(WS_CQ))
#define CKV ((GAS pg8::bf16_t*)WSP(WS_CKV))
#define KA ((GAS pg8::bf16_t*)WSP(WS_KA))
#define VA ((GAS pg8::bf16_t*)WSP(WS_VA))
#define QS ((GAS pg8::bf16_t*)WSP(WS_QS))
#define KS ((GAS pg8::bf16_t*)WSP(WS_KS))
#define VS ((GAS pg8::bf16_t*)WSP(WS_VS))
#define QC ((GAS pg8::bf16_t*)WSP(WS_QC))
#define KC ((GAS pg8::bf16_t*)WSP(WS_KC))
#define VC ((GAS pg8::bf16_t*)WSP(WS_VC))
#define OALL ((GAS pg8::bf16_t*)WSP(WS_OALL))
#define QRAW ((GAS float*)WSP(WS_QRAW))

__device__ __forceinline__ int in_group_src(int g32) {
    const int tile = g32 >> 3, rr = g32 & 7, bj = rr >> 2, wc = rr & 3; int cnt; const int base = in_slot_src(tile * 4 + wc, cnt);
    return (base >= 0 && 32 * bj < cnt) ? base + 32 * bj : -1;
}
__device__ __forceinline__ void phase_pro0(Frame& F, const Args& args, gu32* qhead) {
    GAS unsigned char* ws_ = (GAS unsigned char*)args.ws; asm volatile("" : "+s"(ws_));
    constexpr int NMU = DEPTH * NMOD / 128;
    if ((int)blockIdx.x < NMU || F.G <= NMU) {
        LAS float* cond = (LAS float*)F.lds;
        LAS float* red = (LAS float*)(F.lds + 8192);
        for (int i = F.tid; i < 2 * DM; i += 512) { const float cv = A_C[i]; cond[i] = cv / (1.0f + expf(-cv)); }
        __syncthreads();
        for (int u = blockIdx.x; u < NMU; u += F.G) {
            const int l = u / (NMOD / 128), n0 = (u % (NMOD / 128)) * 128, c4 = F.lane & 31, kp = F.lane >> 5;
            const GAS float* w = A_WMOD + (size_t)l * DM * NMOD + n0 + 4 * c4;
            f32x4 a0 = {0.f, 0.f, 0.f, 0.f}, a1 = {0.f, 0.f, 0.f, 0.f};
#pragma unroll 8
            for (int i = 0; i < 64; ++i) { const int kk = F.wave * 128 + 2 * i + kp; const f32x4 wv = *(const GAS f32x4*)(w + (size_t)kk * NMOD); a0 += wv * cond[kk]; a1 += wv * cond[DM + kk]; }
#pragma unroll
            for (int q = 0; q < 4; ++q) { a0[q] += __shfl_xor(a0[q], 32); a1[q] += __shfl_xor(a1[q], 32); }
            if (kp == 0) { *(LAS f32x4*)(red + (F.wave * 2 + 0) * 128 + 4 * c4) = a0; *(LAS f32x4*)(red + (F.wave * 2 + 1) * 128 + 4 * c4) = a1; }
            __syncthreads();
            if (F.tid < 256) { const int bb = F.tid >> 7, ln = F.tid & 127; float s = 0.f;
#pragma unroll
                for (int wv = 0; wv < 8; ++wv) s += red[(wv * 2 + bb) * 128 + ln];
                MOD[((size_t)l * 2 + bb) * NMOD + n0 + ln] = s + A_BMOD[(size_t)l * NMOD + n0 + ln]; }
            __syncthreads();
        }
    }
    if ((int)blockIdx.x >= NMU || F.G <= NMU) {
        const int nb = F.G <= NMU ? F.G : F.G - NMU, b0 = F.G <= NMU ? (int)blockIdx.x : (int)blockIdx.x - NMU;
        for (int i = b0 * 512 + F.tid; i < MROWS * 16; i += nb * 512) {
            const int m = i >> 4, j = i & 15;
            const float freq = powf(10000.0f, -(float)j / 16.0f);
            const float ang = (float)A_POS[m] * freq;
            CS[(size_t)m * 32 + j] = cosf(ang); CS[(size_t)m * 32 + 16 + j] = sinf(ang);
        }
    }
    {
        LAS unsigned* scr = (LAS unsigned*)(F.lds + 16384 + F.wave * 8448);
        LAS int* slot = (LAS int*)(F.lds + 12288);
        constexpr int I_GU = 16 * 88, I_D = 44 * 16, I_IN = 16 * 32, I_UQ = 4 * 12, I_UKV = 2 * 12, I_OUT = 16 * 16;
        constexpr int I_L = 2 * I_GU + 2 * I_D + I_IN + I_UQ + I_UKV + I_OUT, I_ALL = DEPTH * I_L;
        for (;;) {
            __syncthreads();
            if (F.tid == 0) slot[0] = (int)__hip_atomic_fetch_add(qhead, 16u, __ATOMIC_RELAXED, __HIP_MEMORY_SCOPE_AGENT);
            __syncthreads();
            const int base = slot[0];
            if (base >= I_ALL) break;
#pragma unroll 1
            for (int q = 0; q < 2; ++q) {
                const int it = base + F.wave * 2 + q; if (it >= I_ALL) break;
                const int l = it / I_L; int r = it % I_L;
                GAS unsigned char* wl = ws_ + WS_W + (size_t)l * WL;
                if (r < 2 * I_GU) {
                    const bool second = r >= I_GU; if (second) r -= I_GU;
                    const int kb = r / 88, g = r % 88, t = g >> 2, rr = g & 3, src = (rr >> 1) * DFF + 128 * t + 64 * (rr & 1);
                    const GAS float* W = (second ? A_WGU2 : A_WGU1) + (size_t)l * DM * 2 * DFF;
                    tr_item64(W, 2 * DFF, DM, (GAS pg8::bf16_t*)(wl + (second ? W_GU2 : W_GU1)), kb, g, src, src + 32, nullptr, scr, F.lane); continue; }
                r -= 2 * I_GU;
                if (r < 2 * I_D) { const bool second = r >= I_D; if (second) r -= I_D; const int kb = r / 16, g = r % 16;
                    tr_item64((second ? A_WD2 : A_WD1) + (size_t)l * DFF * DM, DM, DFF, (GAS pg8::bf16_t*)(wl + (second ? W_D2 : W_D1)), kb, g, 64 * g, 64 * g + 32, nullptr, scr, F.lane); continue; }
                r -= 2 * I_D;
                if (r < I_IN) { const int kb = r / 32, g = r % 32;
                    tr_item64(A_WIN + (size_t)l * DM * DIN, DIN, DM, (GAS pg8::bf16_t*)(wl + W_IN), kb, g, in_group_src(2 * g), in_group_src(2 * g + 1), nullptr, scr, F.lane); continue; }
                r -= I_IN;
                if (r < I_UQ) { const int kb = r / 12, g = r % 12;
                    tr_item64(A_WUQ + (size_t)l * 256 * 576, 576, 256, (GAS pg8::bf16_t*)(wl + W_UQ), kb, g, g < 9 ? 64 * g : -1, g < 9 ? 64 * g + 32 : -1, A_QAN + l * 256, scr, F.lane); continue; }
                r -= I_UQ;
                if (r < I_UKV) { const int kb = r / 12, g = r % 12, g0 = 2 * g, g1 = 2 * g + 1;
                    tr_item64(A_WUKV + (size_t)l * 128 * 768, 768, 128, (GAS pg8::bf16_t*)(wl + W_UKV), kb, g, 256 * (g0 >> 3) + 64 * (g0 & 3) + 32 * ((g0 & 7) >> 2), 256 * (g1 >> 3) + 64 * (g1 & 3) + 32 * ((g1 & 7) >> 2), A_KVAN + l * 128, scr, F.lane); continue; }
                r -= I_UKV;
                { const int kb = r / 16, g = r % 16;
                    tr_item64(A_WOUT + (size_t)l * DM * DM, DM, DM, (GAS pg8::bf16_t*)(wl + W_OUT), kb, g, 64 * g, 64 * g + 32, A_OUTN + l * DM, scr, F.lane); }
            }
        }
    }
}

__device__ __forceinline__ void x_to_xb(Frame& F, const Args& args, const GAS float* xsrc, int l, int i) {
    GAS unsigned char* ws_ = (GAS unsigned char*)args.ws; asm volatile("" : "+s"(ws_));
    const int gw = F.vcu * NWAVES + F.wave, NGW = F.G * NWAVES;
    for (int m = gw; m < MROWS; m += NGW) {
        const int b = m >> 13;
        const GAS f32x4* xr = (const GAS f32x4*)(xsrc + (size_t)m * DM) + F.lane;
        const GAS f32x4* gr = (const GAS f32x4*)(A_NORMG + ((size_t)l * 3 + i) * DM) + F.lane;
        const GAS f32x4* sr = (const GAS f32x4*)(MOD + ((size_t)l * 2 + b) * NMOD + (3 * i + 1) * DM) + F.lane;
        float s = 0.f;
        GAS unsigned long long* o8 = (GAS unsigned long long*)(XB + (size_t)m * DM) + F.lane;
#pragma unroll
        for (int j = 0; j < 4; ++j) { const f32x4 v = xr[64 * j]; s += (v.x * v.x + v.y * v.y) + (v.z * v.z + v.w * v.w);
            const f32x4 g = gr[64 * j] * (sr[64 * j] + 1.0f); const f32x4 y = v * g;
            o8[64 * j] = (unsigned long long)pk2(y.x, y.y) | ((unsigned long long)pk2(y.z, y.w) << 32); }
        s = wave_sum64(s);
        if (F.lane < 16) SSQX[(size_t)m * 16 + F.lane] = (F.lane == 0) ? s : 0.f;
    }
}

__device__ __forceinline__ void phase_pro1(Frame& F, const Args& args) {
    GAS unsigned char* ws_ = (GAS unsigned char*)args.ws; asm volatile("" : "+s"(ws_));
    for (int i = blockIdx.x * 512 + F.tid; i < DEPTH * 3 * 2 * DM; i += F.G * 512) {
        const int cidx = i & 1023, b = (i >> 10) & 1, li = i >> 11, l = li / 3, ii = li % 3;
        GS[i] = A_NORMG[((size_t)l * 3 + ii) * DM + cidx] * (1.0f + MOD[((size_t)l * 2 + b) * NMOD + (3 * ii + 1) * DM + cidx]);
    }
    const int gw = F.vcu * NWAVES + F.wave, NGW = F.G * NWAVES;
    constexpr int RL = 5632 + 2048 + 5632;
    for (int it = gw; it < DEPTH * RL; it += NGW) {
        const int l = it / RL; int r = it % RL; int which, nrow; size_t woff; size_t boff;
        if (r < 5632) { which = 0; nrow = 5632; woff = W_GU1; boff = 0; } else if (r < 5632 + 2048) { r -= 5632; which = 1; nrow = 2048; woff = W_IN; boff = 2 * 5632; } else { r -= 5632 + 2048; which = 2; nrow = 5632; woff = W_GU2; boff = 2 * (5632 + 2048); }
        const GAS pg8::bf16_t* wr = (const GAS pg8::bf16_t*)(ws_ + WS_W + (size_t)l * WL + woff) + (size_t)r * DM;
        float a0 = 0.f, a1 = 0.f;
#pragma unroll
        for (int j = 0; j < 2; ++j) {
            const v4u wv = *(const GAS v4u*)(wr + j * 512 + F.lane * 8);
            const GAS float* s0 = MOD + ((size_t)l * 2 + 0) * NMOD + (3 * which) * DM + j * 512 + F.lane * 8; const GAS float* s1 = s0 + NMOD;
#pragma unroll
            for (int k = 0; k < 4; ++k) { const unsigned w = wv[k]; const float lo = __uint_as_float(w << 16), hi = __uint_as_float(w & 0xffff0000u);
                a0 += lo * s0[2 * k] + hi * s0[2 * k + 1]; a1 += lo * s1[2 * k] + hi * s1[2 * k + 1]; }
        }
        a0 = wave_sum64(a0); a1 = wave_sum64(a1);
        if (F.lane == 0) { BIAS[(size_t)l * BIAS_L + boff + r] = a0; BIAS[(size_t)l * BIAS_L + boff + nrow + r] = a1; }
    }
    x_to_xb(F, args, A_X, 0, 0);
}

__device__ __forceinline__ int next_unit(Frame& F, gu32* head) {
    LAS int* slot = (LAS int*)(F.lds + att::L_FLAG);
    __syncthreads();
    if (F.tid == 0) slot[0] = (int)__hip_atomic_fetch_add(head, 1u, __ATOMIC_RELAXED, __HIP_MEMORY_SCOPE_AGENT);
    __syncthreads();
    return slot[0];
}

#ifndef DUPS
#define DUPS -1
#endif
#ifndef PHM
#define PHM 255
#endif
#ifndef PHM2
#define PHM2 31
#endif
__global__ void __launch_bounds__(NWAVES * 64, 2) fwd_mega(Args args) {
    extern __shared__ __attribute__((aligned(16))) unsigned char lds[];
    Frame F; F.lds = (LAS unsigned char*)lds; F.tid = threadIdx.x; F.lane = F.tid & 63; F.wave = __builtin_amdgcn_readfirstlane(F.tid >> 6);
    F.G = gridDim.x; { const int bx = blockIdx.x; F.vcu = (F.G % 8 == 0) ? (bx % 8) * (F.G / 8) + bx / 8 : bx; }
    gu32* ctl = (gu32*)(args.ws + WS_CTL);
    for (int u = F.tid; u < (LDS_BYTES - LDSCTL_OFF) / 4; u += NWAVES * 64) ((LAS unsigned*)(F.lds + LDSCTL_OFF))[u] = 0u;
    __syncthreads();
    if (args.adapt >= 0) { x_to_xb(F, args, (const GAS float*)args.out, args.adapt / 3, args.adapt % 3); return; }
    const int lo = args.ph_lo, hi = args.ph_hi;
    XcdBarrier bar; bar.bar = (unsigned*)(ctl + CW_BAR) + args.li * XCD_BAR_WORDS; bar.x = 0; bar.st = nullptr;
    if (hi - lo > 1) bar = xcd_barrier_post((unsigned*)(ctl + CW_BAR) + args.li * XCD_BAR_WORDS, (volatile LAS unsigned*)(F.lds + MISC_OFF) + 8);

    for (int ph = lo; ph < hi; ++ph) {
        { int t_ = threadIdx.x; asm volatile("" : "+v"(t_)); F.tid = t_; F.lane = t_ & 63; F.wave = __builtin_amdgcn_readfirstlane(t_ >> 6); }
        GAS unsigned char* ws_ = (GAS unsigned char*)args.ws; asm volatile("" : "+s"(ws_));
        int nrep = 1;
        if (DUPS >= 0) { const int ty = ph < 2 ? 8 + ph : ((ph - 2) & 7); if (ty == DUPS && !(ty == 5) && !((ty == 1 || ty == 7) && ph != 3)) nrep = 2; }
        for (int rep = 0; rep < nrep; ++rep) {
        if ((PHM & 64) && ph == 0) phase_pro0(F, args, ctl + CW_Q + 64 * 8);
        else if ((PHM & 128) && ph == 1) phase_pro1(F, args);
        else {
            const int l = (ph - 2) >> 3, s = (ph - 2) & 7;
            const GAS unsigned char* wl = ws_ + WS_W + (size_t)l * WL;
            const GAS float* biasl = BIAS + (size_t)l * BIAS_L;
            const GAS float* modl = MOD + (size_t)l * 2 * NMOD;
            if ((PHM & 1) && (s == 0 || s == 6)) {
                pg8::Gemm g{(const pg8::bf16_t*)XB, (const pg8::bf16_t*)(wl + (s == 0 ? W_GU1 : W_GU2)), MROWS, 5632, DM}; pg8::StaticOrder S; S.init(MROWS, 5632, F.G, (int)blockIdx.x);
                pg8::EpiUp E{ws_, biasl + (s == 0 ? 0 : 2 * (5632 + 2048))};
                pg8::gemm_phase<pg8::EpiUp, pg8::StaticOrder, true, true>(F.lds, g, S, E);
            } else if ((PHM & 2) && (s == 1 || s == 7)) {
                pg8::Gemm g{(const pg8::bf16_t*)HID, (const pg8::bf16_t*)(wl + (s == 1 ? W_D1 : W_D2)), MROWS, DM, DFF}; pg8::StaticOrder S; S.init(MROWS, DM, F.G, (int)blockIdx.x);
                const bool lastp = (s == 7 && l == DEPTH - 1);
                const GAS float* gsn = lastp ? nullptr : (s == 1 ? GS + ((size_t)(l * 3 + 1) * 2) * DM : GS + ((size_t)((l + 1) * 3 + 0) * 2) * DM);
                const GAS float* xin = (s == 1 && l == 0) ? A_X : (const GAS float*)args.out;
                pg8::EpiRes<false> E{xin, (GAS float*)args.out, ws_, modl + (s == 1 ? 2 : 8) * DM, gsn, 0.5f};
                pg8::gemm_phase<pg8::EpiRes<false>, pg8::StaticOrder, true, true>(F.lds, g, S, E);
            } else if ((PHM & 4) && s == 2) {
                pg8::Gemm g{(const pg8::bf16_t*)XB, (const pg8::bf16_t*)(wl + W_IN), MROWS, 2048, DM}; pg8::StaticOrder S; S.init(MROWS, 2048, F.G, (int)blockIdx.x);
                pg8::EpiIn E{ws_, A_SWAQN + l * 64, A_SWAKN + l * 64, biasl + 2 * 5632};
                pg8::gemm_phase<pg8::EpiIn, pg8::StaticOrder, true, true>(F.lds, g, S, E);
            } else if ((PHM & 8) && s == 3) {
                if (PHM2 & 1) { pg8::Gemm g{(const pg8::bf16_t*)CQ, (const pg8::bf16_t*)(wl + W_UQ), MROWS, 768, 256}; pg8::StaticOrder S; S.init(MROWS, 768, F.G, (int)blockIdx.x);
                  pg8::EpiUq E{ws_}; pg8::gemm_phase<pg8::EpiUq, pg8::StaticOrder, true, true>(F.lds, g, S, E); }
                if (PHM2 & 2) { pg8::Gemm g{(const pg8::bf16_t*)CKV, (const pg8::bf16_t*)(wl + W_UKV), MROWS, 768, 128}; pg8::StaticOrder S; S.init(MROWS, 768, F.G, (int)((blockIdx.x + 64) % F.G));
                  pg8::EpiUkv E{ws_, A_MLAKN + l * 96}; pg8::gemm_phase<pg8::EpiUkv, pg8::StaticOrder, true, true>(F.lds, g, S, E); }
            } else if ((PHM & 16) && s == 4) {
                att::AttnP PA{ws_, A_MLAQN + l * 96, nullptr, nullptr, nullptr};
                att::AttnP PB{ws_, nullptr, A_POS, A_SINKS + l * 6, A_RELB};
                att::AttnP PC{ws_, nullptr, nullptr, nullptr, nullptr};
                gu32* head = ctl + CW_Q + 64 * (2 * l + 1 + 4 * rep);
                for (;;) { const int u = next_unit(F, head); if (u >= 384 + 256 + 384) break;
                    if ((PHM2 & 16) && u < 384) { const int qb = 31 - u / 12, bh = u % 12; att::attn_unit<96, 0>(F.lds, PA, bh / 6, bh % 6, qb); }
                    else if ((PHM2 & 4) && u >= 384 && u < 640) { const int v = u - 384, qb = 31 - (v >> 3), bh = v & 7; att::attn_unit<64, 2>(F.lds, PC, bh >> 2, bh & 3, qb); }
                    else if ((PHM2 & 8) && u >= 640) { const int v = u - 640, qb = v / 12, bh = v % 12; att::attn_unit<64, 1>(F.lds, PB, bh / 6, bh % 6, qb); } }
            } else if ((PHM & 32) && s == 5) {
                pg8::Gemm g{(const pg8::bf16_t*)OALL, (const pg8::bf16_t*)(wl + W_OUT), MROWS, DM, DM}; pg8::StaticOrder S; S.init(MROWS, DM, F.G, (int)blockIdx.x);
                pg8::EpiRes<true> E{(const GAS float*)args.out, (GAS float*)args.out, ws_, modl + 5 * DM, GS + ((size_t)(l * 3 + 2) * 2) * DM, 1.0f};
                pg8::gemm_phase<pg8::EpiRes<true>, pg8::StaticOrder, true, true>(F.lds, g, S, E);
            }
        }
        if (rep + 1 < nrep) xcd_barrier(bar);
        }
        if (ph + 1 < hi) xcd_barrier(bar);
    }
}
#ifndef HYB
#define HYB 0
#endif
#ifndef DUPH
#define DUPH -1
#endif
static void launch_fwd(hipStream_t stream, Args a, int grid, int lo, int hi, int li, int adapt) {
    a.ph_lo = lo; a.ph_hi = hi; a.li = li; a.adapt = adapt;
    hipLaunchKernelGGL(fwd_mega, dim3(grid), dim3(NWAVES * 64), LDS_BYTES, stream, a);
}
extern "C" void kernel_launch(void* const* d_in, const int* in_sizes, int n_in, void* d_out, int out_size, void* d_ws, size_t ws_size, hipStream_t stream) {
    static int grid = 0;
    if (grid == 0) {
        if (n_in != 23 || out_size != MROWS * DM || ws_size < WS_END) { fprintf(stderr, "kernel_launch: unexpected problem (n_in %d, out %d, ws %zu < %zu)\n", n_in, out_size, ws_size, (size_t)WS_END); grid = -1; return; }
        int dev = 0, cus = 0, per_cu = 0;
        if (hipGetDevice(&dev) != hipSuccess || hipDeviceGetAttribute(&cus, hipDeviceAttributeMultiprocessorCount, dev) != hipSuccess) { grid = -1; return; }
        if (hipFuncSetAttribute((const void*)fwd_mega, hipFuncAttributeMaxDynamicSharedMemorySize, LDS_BYTES) != hipSuccess) { fprintf(stderr, "kernel_launch: hipFuncSetAttribute failed\n"); grid = -1; return; }
        if (hipOccupancyMaxActiveBlocksPerMultiprocessor(&per_cu, (const void*)fwd_mega, NWAVES * 64, LDS_BYTES) != hipSuccess || per_cu < 1) { fprintf(stderr, "kernel_launch: occupancy query says %d blocks per CU\n", per_cu); (void)hipGetLastError(); grid = -1; return; }
        grid = cus;
    }
    if (grid < 0) return;
    (void)hipMemsetAsync((char*)d_ws + WS_CTL, 0, CTL_ZERO_BYTES, stream);
    Args a{};
    for (int i = 0; i < 23; ++i) a.in[i] = d_in[i];
    a.out = (float*)d_out; a.ws = (unsigned char*)d_ws;
#if HYB == 0
    launch_fwd(stream, a, grid, 0, NPH, 0, -1);
#elif HYB == 1
    for (int ph = 0; ph < NPH; ++ph) launch_fwd(stream, a, grid, ph, ph + 1, 0, -1);
#elif HYB == 4
    for (int ph = 0; ph < NPH; ++ph) {
        launch_fwd(stream, a, grid, ph, ph + 1, 0, -1);
        const int ty = ph < 2 ? 8 + ph : ((ph - 2) & 7);
        if (ty == DUPH && ty != 5 && !((ty == 1 || ty == 7) && ph != 3)) { (void)hipMemsetAsync((char*)d_ws + WS_CTL, 0, CTL_ZERO_BYTES, stream); launch_fwd(stream, a, grid, ph, ph + 1, 0, -1); }
    }
#else
    {
        using namespace nv;
        const float* x = (const float*)d_in[0]; const int* positions = (const int*)d_in[2];
        const float* rel_bias = (const float*)d_in[3]; const float* norm_g = (const float*)d_in[4];
        const float* w_ffn1_gu = (const float*)d_in[7]; const float* w_ffn1_down = (const float*)d_in[8]; const float* w_in = (const float*)d_in[9];
        const float* q_a_norm = (const float*)d_in[10]; const float* kv_a_norm = (const float*)d_in[11]; const float* w_uq = (const float*)d_in[12]; const float* w_ukv = (const float*)d_in[13];
        const float* mla_q_norm = (const float*)d_in[14]; const float* mla_k_norm = (const float*)d_in[15]; const float* swa_q_norm = (const float*)d_in[16]; const float* swa_k_norm = (const float*)d_in[17];
        const float* sinks = (const float*)d_in[18]; const float* out_norm = (const float*)d_in[19]; const float* w_out = (const float*)d_in[20];
        const float* w_ffn2_gu = (const float*)d_in[21]; const float* w_ffn2_down = (const float*)d_in[22];
        float* out = (float*)d_out; char* ws = (char*)d_ws;
        float* mod = (float*)(ws + WS_MOD);
        char* nb = ws + WS_XB;
        float* H = (float*)(nb); float* HIDn = (float*)(nb + 33 * MiB); float* P = (float*)(nb + 33 * MiB); float* QA = (float*)(nb + 91 * MiB); float* KVRAW = (float*)(nb + 110 * MiB);
        float* KAn = (float*)(nb + 135 * MiB); float* CQN = (float*)(nb + 154 * MiB); float* CKVN = (float*)(nb + 163 * MiB); float* QB = (float*)(nb + 168 * MiB); float* KBn = (float*)(nb + 181 * MiB);
        launch_fwd(stream, a, grid, 0, 1, 0, -1); launch_fwd(stream, a, grid, 1, 2, 0, -1);
        auto naive_ffn = [&](int l, int i, const float* xsrc) {
            for (int b = 0; b < BATCH; ++b) {
                float* xb = out + (size_t)b * nv::SEQ * nv::D; const float* xs = xsrc + (size_t)b * nv::SEQ * nv::D; const float* modlb = mod + ((size_t)l * 2 + b) * nv::NMOD;
                const float* wgu = (i == 0 ? w_ffn1_gu : w_ffn2_gu) + (size_t)l * nv::D * 2 * nv::DFF; const float* wdn = (i == 0 ? w_ffn1_down : w_ffn2_down) + (size_t)l * nv::DFF * nv::D;
                const float* sh = modlb + (3 * i) * nv::D; const float* sc = modlb + (3 * i + 1) * nv::D; const float* gt = modlb + (3 * i + 2) * nv::D;
                k_normmod<<<nv::SEQ / 4, 256, 0, stream>>>(xs, norm_g + ((size_t)l * 3 + i) * nv::D, sh, sc, H, nv::SEQ);
                k_gemm<true, 0><<<dim3(nv::DFF / 128, nv::SEQ / 128), 256, 0, stream>>>(H, nv::D, wgu, wgu + nv::DFF, 2 * nv::DFF, HIDn, nv::DFF, nv::DFF, nv::D, nullptr, nullptr, 0.f);
                k_gemm<false, 1><<<dim3(nv::D / 128, nv::SEQ / 128), 256, 0, stream>>>(HIDn, nv::DFF, wdn, nullptr, nv::D, xb, nv::D, nv::D, nv::DFF, xs, gt, 0.5f);
            }
        };
        auto naive_mixer = [&](int l) {
            for (int b = 0; b < BATCH; ++b) {
                float* xb = out + (size_t)b * nv::SEQ * nv::D; const int* posb = positions + b * nv::SEQ; const float* modlb = mod + ((size_t)l * 2 + b) * nv::NMOD;
                const float* sh = modlb + 3 * nv::D; const float* sc = modlb + 4 * nv::D; const float* gt = modlb + 5 * nv::D;
                k_normmod<<<nv::SEQ / 4, 256, 0, stream>>>(xb, norm_g + ((size_t)l * 3 + 1) * nv::D, sh, sc, H, nv::SEQ);
                k_gemm<false, 0><<<dim3((nv::DIN + 127) / 128, nv::SEQ / 128), 256, 0, stream>>>(H, nv::D, w_in + (size_t)l * nv::D * nv::DIN, nullptr, nv::DIN, P, nv::DIN, nv::DIN, nv::D, nullptr, nullptr, 0.f);
                k_headnorm<<<nv::SEQ / 4, 256, 0, stream>>>(P, nv::DIN, 0, 256, nullptr, 0, 0, 0, q_a_norm + l * 256, CQN, 256, 256, 1, nv::SEQ, posb, 0, 1);
                k_headnorm<<<nv::SEQ / 4, 256, 0, stream>>>(P + 256, nv::DIN, 0, 128, nullptr, 0, 0, 0, kv_a_norm + l * 128, CKVN, 128, 128, 1, nv::SEQ, posb, 0, 1);
                k_gemm<false, 0><<<dim3((576 + 127) / 128, nv::SEQ / 128), 256, 0, stream>>>(CQN, 256, w_uq + (size_t)l * 256 * 576, nullptr, 576, QA, 576, 576, 256, nullptr, nullptr, 0.f);
                k_gemm<false, 0><<<dim3(768 / 128, nv::SEQ / 128), 256, 0, stream>>>(CKVN, 128, w_ukv + (size_t)l * 128 * 768, nullptr, 768, KVRAW, 768, 768, 128, nullptr, nullptr, 0.f);
                k_headnorm<<<nv::SEQ * 6 / 4, 256, 0, stream>>>(QA, 576, 96, 96, nullptr, 0, 0, 0, mla_q_norm + l * 96, QA, 576, 96, 6, nv::SEQ, posb, 1, 1);
                k_headnorm<<<nv::SEQ * 6 / 4, 256, 0, stream>>>(KVRAW, 768, 128, 64, P + 384, nv::DIN, 0, 32, mla_k_norm + l * 96, KAn, 576, 96, 6, nv::SEQ, posb, 1, 1);
                k_headnorm<<<nv::SEQ * 6 / 4, 256, 0, stream>>>(P + 416, nv::DIN, 64, 64, nullptr, 0, 0, 0, swa_q_norm + l * 64, QB, 384, 64, 6, nv::SEQ, posb, 0, 1);
                k_headnorm<<<nv::SEQ * 2 / 4, 256, 0, stream>>>(P + 800, nv::DIN, 64, 64, nullptr, 0, 0, 0, swa_k_norm + l * 64, KBn, 128, 64, 2, nv::SEQ, posb, 0, 1);
                k_attn<96, 64, 0><<<dim3(nv::SEQ / 256, 6), 256, 0, stream>>>(QA, 576, 96, KAn, 576, 96, KVRAW + 64, 768, 128, H, nv::D, 0, 1, posb, nullptr, nullptr, 6);
                k_attn<64, 64, 1><<<dim3(nv::SEQ / 256, 6), 256, 0, stream>>>(QB, 384, 64, KBn, 128, 64, P + 928, nv::DIN, 64, H, nv::D, 384, 3, posb, sinks + l * 6, rel_bias, 6);
                k_attn<64, 64, 2><<<dim3(nv::SEQ / 256, 4), 256, 0, stream>>>(P + 1056, nv::DIN, 64, P + 1056 + 256, nv::DIN, 64, P + 1056 + 512, nv::DIN, 64, H, nv::D, 768, 1, posb, nullptr, nullptr, 4);
                k_groupnorm<<<nv::SEQ / 4, 256, 0, stream>>>(H, out_norm + l * nv::D, nv::SEQ);
                k_gemm<false, 1><<<dim3(nv::D / 128, nv::SEQ / 128), 256, 0, stream>>>(H, nv::D, w_out + (size_t)l * nv::D * nv::D, nullptr, nv::D, xb, nv::D, nv::D, nv::D, xb, gt, 1.0f);
            }
        };
        for (int l = 0; l < DEPTH; ++l) {
            const int base = 2 + 8 * l;
#if HYB == 2
            if (l > 0) launch_fwd(stream, a, grid, 0, 0, 0, l * 3 + 0);
            launch_fwd(stream, a, grid, base + 0, base + 1, 0, -1); launch_fwd(stream, a, grid, base + 1, base + 2, 0, -1);
            naive_mixer(l);
            launch_fwd(stream, a, grid, 0, 0, 0, l * 3 + 2);
            launch_fwd(stream, a, grid, base + 6, base + 7, 0, -1); launch_fwd(stream, a, grid, base + 7, base + 8, 0, -1);
#else
            naive_ffn(l, 0, l == 0 ? x : out);
            launch_fwd(stream, a, grid, 0, 0, 0, l * 3 + 1);
            for (int s = 2; s <= 5; ++s) launch_fwd(stream, a, grid, base + s, base + s + 1, 0, -1);
            naive_ffn(l, 2, out);
#endif
        }
    }
#endif
}
```

```cpp
#include <hip/hip_runtime.h>
#include <cstdio>
#include <cstdint>
#include <cmath>
namespace nv {
constexpr int D = 1024, BATCH = 2, SEQ = 8192, DEPTH = 2, M = BATCH * SEQ;
constexpr int DFF = 2816, DIN = 1824, NMOD = 9 * D;
constexpr float EPS = 1e-6f;

__device__ __forceinline__ float wave_sum(float v) {
#pragma unroll
    for (int o = 1; o < 64; o <<= 1) v += __shfl_xor(v, o);
    return v;
}
__device__ __forceinline__ float silu_f(float x) { return x / (1.0f + expf(-x)); }

__global__ void k_mod(const float* __restrict__ c, const float* __restrict__ w_mod, const float* __restrict__ b_mod, float* __restrict__ mod) {
    int idx = blockIdx.x * 256 + threadIdx.x;
    if (idx >= DEPTH * NMOD) return;
    int l = idx / NMOD, n = idx % NMOD;
    float a0 = 0.f, a1 = 0.f;
    const float* w = w_mod + (size_t)l * D * NMOD + n;
    for (int k = 0; k < D; ++k) {
        float wv = w[(size_t)k * NMOD];
        a0 += silu_f(c[k]) * wv; a1 += silu_f(c[D + k]) * wv;
    }
    mod[((size_t)l * 2 + 0) * NMOD + n] = a0 + b_mod[l * NMOD + n];
    mod[((size_t)l * 2 + 1) * NMOD + n] = a1 + b_mod[l * NMOD + n];
}

__global__ void k_normmod(const float* __restrict__ x, const float* __restrict__ g, const float* __restrict__ sh, const float* __restrict__ sc, float* __restrict__ H, int rows) {
    int row = blockIdx.x * 4 + (threadIdx.x >> 6), lane = threadIdx.x & 63;
    if (row >= rows) return;
    const float* xr = x + (size_t)row * D;
    float v[16]; float s = 0.f;
#pragma unroll
    for (int j = 0; j < 16; ++j) { v[j] = xr[lane + 64 * j]; s += v[j] * v[j]; }
    s = wave_sum(s);
    float r = rsqrtf(s * (1.0f / D) + EPS);
#pragma unroll
    for (int j = 0; j < 16; ++j) { int cidx = lane + 64 * j; H[(size_t)row * D + cidx] = v[j] * r * g[cidx] * (1.0f + sc[cidx]) + sh[cidx]; }
}

template <bool DUAL, int EPI>
__global__ void __launch_bounds__(256) k_gemm(const float* __restrict__ A, int lda, const float* __restrict__ W, const float* __restrict__ W2, int ldw,
                                              float* C, int ldc, int N, int K, const float* R, const float* __restrict__ gate, float coef) {
    __shared__ float As[16][128 + 4];
    __shared__ float Bs[16][128 + 4];
    __shared__ float Bs2[DUAL ? 16 : 1][128 + 4];
    const int tid = threadIdx.x, tx = tid & 15, ty = tid >> 4;
    const int m0 = blockIdx.y * 128, n0 = blockIdx.x * 128;
    float acc[8][8], acc2[DUAL ? 8 : 1][8];
#pragma unroll
    for (int i = 0; i < 8; ++i)
#pragma unroll
        for (int j = 0; j < 8; ++j) { acc[i][j] = 0.f; if (DUAL) acc2[i][j] = 0.f; }
    for (int k0 = 0; k0 < K; k0 += 16) {
#pragma unroll
        for (int i = 0; i < 2; ++i) {
            int e = tid + 256 * i;
            int r = e >> 2, kq = e & 3;
            const float4 v = *(const float4*)(A + (size_t)(m0 + r) * lda + k0 + kq * 4);
            As[kq * 4 + 0][r] = v.x; As[kq * 4 + 1][r] = v.y; As[kq * 4 + 2][r] = v.z; As[kq * 4 + 3][r] = v.w;
        }
#pragma unroll
        for (int i = 0; i < 8; ++i) {
            int e = tid + 256 * i;
            int kk = e >> 7, nn = e & 127;
            int n = n0 + nn;
            Bs[kk][nn] = (n < N) ? W[(size_t)(k0 + kk) * ldw + n] : 0.f;
            if (DUAL) Bs2[kk][nn] = (n < N) ? W2[(size_t)(k0 + kk) * ldw + n] : 0.f;
        }
        __syncthreads();
#pragma unroll
        for (int kk = 0; kk < 16; ++kk) {
            float a[8], b[8], b2[8];
#pragma unroll
            for (int i = 0; i < 8; ++i) a[i] = As[kk][ty * 8 + i];
#pragma unroll
            for (int j = 0; j < 8; ++j) { b[j] = Bs[kk][tx * 8 + j]; if (DUAL) b2[j] = Bs2[kk][tx * 8 + j]; }
#pragma unroll
            for (int i = 0; i < 8; ++i)
#pragma unroll
                for (int j = 0; j < 8; ++j) { acc[i][j] += a[i] * b[j]; if (DUAL) acc2[i][j] += a[i] * b2[j]; }
        }
        __syncthreads();
    }
#pragma unroll
    for (int i = 0; i < 8; ++i)
#pragma unroll
        for (int j = 0; j < 8; ++j) {
            int m = m0 + ty * 8 + i, n = n0 + tx * 8 + j;
            if (n < N) {
                float v = acc[i][j];
                if (DUAL) v = silu_f(v) * acc2[i][j];
                if (EPI == 1) v = R[(size_t)m * ldc + n] + coef * gate[n] * v;
                C[(size_t)m * ldc + n] = v;
            }
        }
}

__global__ void k_headnorm(const float* src1, int s1stride, int hs1, int W1, const float* src2, int s2stride, int hs2, int W2,
                           const float* __restrict__ gain, float* dst, int dstride, int dhs, int nheads, int rows, const int* __restrict__ pos, int do_rope, int do_norm) {
    int item = blockIdx.x * 4 + (threadIdx.x >> 6), lane = threadIdx.x & 63;
    if (item >= rows * nheads) return;
    int row = item / nheads, h = item % nheads;
    const int Wt = W1 + W2;
    float v[4]; float s = 0.f;
#pragma unroll
    for (int j = 0; j < 4; ++j) {
        int e = lane + 64 * j; float t = 0.f;
        if (e < W1) t = src1[(size_t)row * s1stride + h * hs1 + e];
        else if (e < Wt) t = src2[(size_t)row * s2stride + h * hs2 + (e - W1)];
        v[j] = t; s += t * t;
    }
    s = wave_sum(s);
    float r = do_norm ? rsqrtf(s / (float)Wt + EPS) : 1.0f;
    __shared__ float tmp[4][256];
    float* tw = tmp[threadIdx.x >> 6];
#pragma unroll
    for (int j = 0; j < 4; ++j) { int e = lane + 64 * j; if (e < Wt) tw[e] = v[j] * r * (do_norm ? gain[e] : 1.0f); }
    __syncthreads();
    if (do_rope) {
        float outv = 0.f; int e = lane;
        if (lane < 32) {
            int jf = lane & 15;
            float freq = powf(10000.0f, -(float)jf / 16.0f);
            float ang = (float)pos[row] * freq;
            float cs = cosf(ang), sn = sinf(ang);
            float x1 = tw[Wt - 32 + jf], x2 = tw[Wt - 16 + jf];
            outv = (lane < 16) ? (x1 * cs - x2 * sn) : (x2 * cs + x1 * sn);
        }
        __syncthreads();
        if (lane < 32) tw[Wt - 32 + e] = outv;
        __syncthreads();
    }
#pragma unroll
    for (int j = 0; j < 4; ++j) { int e = lane + 64 * j; if (e < Wt) dst[(size_t)row * dstride + h * dhs + e] = tw[e]; }
}

__device__ __forceinline__ int t5_bucket(int rel) {
    int n = rel > 0 ? rel : 0;
    if (n < 16) return n;
    float nf = (float)n;
    int large = 16 + (int)(logf(nf / 16.0f) / logf(8.0f) * 16.0f);
    return large < 31 ? large : 31;
}

template <int DQK, int DV, int MODE>
__global__ void __launch_bounds__(256) k_attn(const float* __restrict__ Q, int qstride, int qhs, const float* __restrict__ Kp, int kstride, int khs, const float* __restrict__ Vp, int vstride, int vhs,
                                              float* __restrict__ O, int ostride, int ocol0, int group, const int* __restrict__ pos, const float* __restrict__ sinks, const float* __restrict__ relb, int nheads_q) {
    __shared__ float Ks[64][DQK];
    __shared__ float Vs[64][DV];
    const int h = blockIdx.y, kvh = h / group, t0 = blockIdx.x * 256, t = t0 + threadIdx.x;
    float q[DQK], o[DV];
    const float scale = rsqrtf((float)DQK);
#pragma unroll
    for (int d = 0; d < DQK; ++d) q[d] = Q[(size_t)t * qstride + h * qhs + d] * scale;
#pragma unroll
    for (int d = 0; d < DV; ++d) o[d] = 0.f;
    float mrun = (MODE == 1) ? sinks[h] : -INFINITY, lrun = (MODE == 1) ? 1.0f : 0.f;
    float after = 0.f;
    const int posq = (MODE == 1) ? pos[t] : 0;
    int jt_lo, jt_hi;
    if (MODE == 0) { jt_lo = 0; jt_hi = (t0 + 255) / 64; }
    else if (MODE == 1) { int lo = t0 - 127; if (lo < 0) lo = 0; jt_lo = lo / 64; jt_hi = (t0 + 255) / 64; }
    else { jt_lo = 0; jt_hi = (t0 + 254) / 64; }
    const int ntile = jt_hi - jt_lo + 1;
    for (int it = 0; it < ntile; ++it) {
        const int jt = (MODE == 2) ? (jt_hi - it) : (jt_lo + it);
        const int j0 = jt * 64;
        __syncthreads();
        for (int e = threadIdx.x; e < 64 * DQK; e += 256) { int jj = e / DQK, d = e % DQK; Ks[jj][d] = Kp[(size_t)(j0 + jj) * kstride + kvh * khs + d]; }
        for (int e = threadIdx.x; e < 64 * DV; e += 256) { int jj = e / DV, d = e % DV; Vs[jj][d] = Vp[(size_t)(j0 + jj) * vstride + kvh * vhs + d]; }
        __syncthreads();
        if (MODE == 2) {
            bool live = false;
            for (int jj = 63; jj >= 0; --jj) {
                int j = j0 + jj;
                if (j < t) {
                    float z = 0.f;
#pragma unroll
                    for (int d = 0; d < DQK; ++d) z += q[d] * Ks[jj][d];
                    float sp = fmaxf(z, 0.f) + log1pf(expf(-fabsf(z)));
                    float a = expf(z - sp + after);
                    after -= sp;
#pragma unroll
                    for (int d = 0; d < DV; ++d) o[d] += a * Vs[jj][d];
                }
            }
            live = (after > -110.0f) ;
            if (!__syncthreads_or(live ? 1 : 0)) break;
        } else {
            for (int jj = 0; jj < 64; ++jj) {
                int j = j0 + jj;
                bool ok = (j <= t);
                if (MODE == 1) ok = ok && (j > t - 128);
                if (ok) {
                    float s = 0.f;
#pragma unroll
                    for (int d = 0; d < DQK; ++d) s += q[d] * Ks[jj][d];
                    if (MODE == 1) s += relb[t5_bucket(posq - pos[j]) * nheads_q + h];
                    float mn = fmaxf(mrun, s);
                    float f = expf(mrun - mn), p = expf(s - mn);
                    lrun = lrun * f + p; mrun = mn;
#pragma unroll
                    for (int d = 0; d < DV; ++d) o[d] = o[d] * f + p * Vs[jj][d];
                }
            }
        }
    }
    const float inv = (MODE == 2) ? 1.0f : 1.0f / lrun;
#pragma unroll
    for (int d = 0; d < DV; ++d) O[(size_t)t * ostride + ocol0 + h * DV + d] = o[d] * inv;
}

__global__ void k_groupnorm(float* O, const float* __restrict__ on, int rows) {
    int row = blockIdx.x * 4 + (threadIdx.x >> 6), lane = threadIdx.x & 63;
    if (row >= rows) return;
    float* orow = O + (size_t)row * D;
    float v[16]; float s0 = 0.f, s1 = 0.f, s2 = 0.f;
#pragma unroll
    for (int j = 0; j < 16; ++j) { int cidx = lane + 64 * j; v[j] = orow[cidx]; float sq = v[j] * v[j]; if (cidx < 384) s0 += sq; else if (cidx < 768) s1 += sq; else s2 += sq; }
    s0 = wave_sum(s0); s1 = wave_sum(s1); s2 = wave_sum(s2);
    float r0 = rsqrtf(s0 / 384.f + EPS), r1 = rsqrtf(s1 / 384.f + EPS), r2 = rsqrtf(s2 / 256.f + EPS);
#pragma unroll
    for (int j = 0; j < 16; ++j) { int cidx = lane + 64 * j; float r = cidx < 384 ? r0 : (cidx < 768 ? r1 : r2); orow[cidx] = v[j] * r * on[cidx]; }
}
}
constexpr int NWAVES = 8;
constexpr int BATCH = 2, SEQ = 8192, DM = 1024, DEPTH = 2, MROWS = BATCH * SEQ;
constexpr int DFF = 2816, DIN = 1824, NMOD = 9 * DM;
constexpr int NPH = 2 + 8 * DEPTH;
constexpr size_t MiB = 1u << 20;
constexpr size_t WS_CTL = 0, CTL_ZERO_BYTES = 256 * 1024;
constexpr size_t WS_MOD = 1 * MiB;
constexpr size_t WS_GS = WS_MOD + 160 * 1024;
constexpr size_t WS_IGS = WS_GS + 64 * 1024;
constexpr size_t WS_BIAS = WS_IGS + 64 * 1024;
constexpr size_t BIAS_L = 2 * (5632 + 2048 + 5632);
constexpr size_t WS_SSQX = 2 * MiB;
constexpr size_t WS_SSQO = 3 * MiB;
constexpr size_t WS_CS = 4 * MiB;
constexpr size_t WS_KPE = 6 * MiB;
constexpr size_t WS_SSQC = 8 * MiB;
constexpr size_t WS_W = 9 * MiB;
constexpr size_t W_GU1 = 0, W_D1 = W_GU1 + (size_t)5632 * 1024 * 2, W_IN = W_D1 + (size_t)1024 * 2816 * 2, W_UQ = W_IN + (size_t)2048 * 1024 * 2, W_UKV = W_UQ + (size_t)768 * 256 * 2,
                 W_OUT = W_UKV + (size_t)768 * 128 * 2, W_GU2 = W_OUT + (size_t)1024 * 1024 * 2, W_D2 = W_GU2 + (size_t)5632 * 1024 * 2, WL = W_D2 + (size_t)1024 * 2816 * 2;
constexpr size_t WS_XB = WS_W + ((2 * WL + MiB - 1) / MiB) * MiB;
constexpr size_t WS_ACT = WS_XB + 32 * MiB;
constexpr size_t WS_HID = WS_ACT;
constexpr size_t WS_CQ = WS_ACT, WS_CKV = WS_CQ + 8 * MiB, WS_QRAW = WS_CKV + 4 * MiB, WS_KA = WS_QRAW + 36 * MiB, WS_VA = WS_KA + 18 * MiB, WS_QS = WS_VA + 12 * MiB, WS_KS = WS_QS + 12 * MiB,
                 WS_VS = WS_KS + 4 * MiB, WS_QC = WS_VS + 4 * MiB, WS_KC = WS_QC + 8 * MiB, WS_VC = WS_KC + 8 * MiB, WS_OALL = WS_VC + 8 * MiB, WS_END = WS_OALL + 32 * MiB;
static_assert(WS_HID + (size_t)MROWS * DFF * 2 <= WS_END, "d_ws map");
constexpr int CW_BAR = 4096;
constexpr int CW_Q = 40960;
static_assert((CW_Q + 64 * 14) * 4 <= (int)CTL_ZERO_BYTES && CW_BAR + 8 * 3456 <= CW_Q, "ctl map");
constexpr int RING_BYTES = 131072, LDSCTL_OFF = RING_BYTES, MISC_OFF = LDSCTL_OFF + 320, LDS_BYTES = 147456;

namespace pg8 {
#define PG8_LAS __attribute__((address_space(3)))
typedef unsigned short bf16_t;
typedef short bf16x8 __attribute__((ext_vector_type(8)));
typedef float f32x4 __attribute__((ext_vector_type(4)));
typedef unsigned u32x4 __attribute__((ext_vector_type(4)));
constexpr int BM = 256, BK = 64, HALF = 128, HTB = HALF * BK * 2  , STAGE_BYTES = 8 * HTB, NXCD = 8, WGM = 8;

__host__ __device__ __forceinline__ int lds_byte(int r, int c) { const int st = (r >> 4) * 2 + (c >> 5), rr = r & 15, cc = c & 31, ob = rr * 64 + cc * 2; return st * 1024 + (ob ^ (((ob >> 9) & 1) << 5)); }
__host__ __device__ __forceinline__ void stage_rc(int b, int& R, int& C) { const int st = b / 1024, sb = b % 1024, swz = sb ^ (((sb >> 9) & 1) << 5); R = (st >> 1) * 16 + swz / 64; C = (st & 1) * 32 + (swz % 64) / 2; }
__host__ __device__ __forceinline__ int perm32(int rho) { const int n = rho >> 4, i = rho & 15; return 8 * (i >> 2) + 4 * n + (i & 3); }

struct Unit { int pm, pn; };
struct Gemm { const bf16_t* A; const bf16_t* Bt; int M, N, K; };

struct StaticOrder {
    int nM, nN, nwg, G, c;
    __host__ __device__ void init(int M, int N, int G_, int c_) { nM = M / BM; nN = N / BM; nwg = nM * nN; G = G_; c = c_; }
    __host__ __device__ bool next(int i, Unit& u) const {
        const long L = (long)i * G + c; if (L >= nwg) return false;
        int wgid = (int)L; { const int q = nwg / NXCD, r = nwg % NXCD, xcd = wgid % NXCD, off = wgid / NXCD; wgid = (xcd < r ? xcd * (q + 1) : r * (q + 1) + (xcd - r) * q) + off; }
        const int nig = WGM * nN, gid = wgid / nig, fm = gid * WGM, gsz = (nM - fm) < WGM ? (nM - fm) : WGM;
        u.pm = fm + ((wgid % nig) % gsz); u.pn = (wgid % nig) / gsz; return true;
    }
    __device__ __forceinline__ void a_ready(const Unit&) const {}
    __device__ __forceinline__ void done(const Unit&) const {}
};

__device__ __forceinline__ unsigned cvt_pk_bf16(float lo, float hi) { unsigned r; asm volatile("v_cvt_pk_bf16_f32 %0, %1, %2" : "=v"(r) : "v"(lo), "v"(hi)); return r; }
typedef float f32x2 __attribute__((ext_vector_type(2)));
template <class Epi, class Sched, bool ALIGN_EPI = false, bool SP2 = false>
__device__ __forceinline__ void gemm_phase(PG8_LAS unsigned char* lds, const Gemm g, const Sched& S, const Epi& E, unsigned long long* gprof = nullptr) {
#ifdef GEMM_PROF
    const long long gp_t0 = (Epi::AFTER_DRAIN && !Epi::HOOK && blockIdx.x == 0) ? (long long)clock64() : 0ll;
#endif
    int tid_ = threadIdx.x; asm volatile("" : "+v"(tid_));
    const int tid = tid_, wid = __builtin_amdgcn_readfirstlane(tid >> 6), lane = tid & 63, wr = wid >> 2, wc = wid & 3, fr = lane & 15, fq = lane >> 4;
    int K_ = g.K; asm volatile("" : "+s"(K_));
    const int K = K_, nt = K / BK;
    unsigned voffA[2], voffB[2];
#pragma unroll
    for (int i = 0; i < 2; ++i) { int R, C; stage_rc(tid * 16 + i * 8192, R, C); const int Rb = Epi::PERM ? ((R & ~31) + perm32(R & 31)) : R;
        voffA[i] = (unsigned)(R * K + C) * 2u; voffB[i] = (unsigned)(Rb * K + C) * 2u; }
    const size_t kstep = (size_t)(BK * 2);
    const size_t hstep = (size_t)HALF * K * 2;
    const size_t tstep = 2 * hstep;
    const unsigned ldsw = (unsigned)wid * 1024u;
    const int aoff = lds_byte(wr * 64 + fr, fq * 8), boff = lds_byte(wc * 32 + fr, fq * 8);
#define PG8_SA(b, h) (((b) * 2 + (h)) * HTB)
#define PG8_SB(b, h) ((4 + (b) * 2 + (h)) * HTB)
#define PG8_STAGE(bufoff, gbase, voff) do { _Pragma("unroll") for (int _i = 0; _i < 2; ++_i) \
        __builtin_amdgcn_global_load_lds((const unsigned*)((const char*)(gbase) + (voff)[_i]), (PG8_LAS unsigned*)(lds + (bufoff) + ldsw + _i * 8192), 16, 0, 0); } while (0)
#define PG8_LDA(dst, b, h) do { _Pragma("unroll") for (int m = 0; m < 4; ++m) _Pragma("unroll") for (int k = 0; k < 2; ++k) dst[m][k] = *(const PG8_LAS bf16x8*)(lds + PG8_SA(b, h) + aoff + m * 2048 + k * 1024); } while (0)
#define PG8_LDB(dst, b, h) do { _Pragma("unroll") for (int n = 0; n < 2; ++n) _Pragma("unroll") for (int k = 0; k < 2; ++k) dst[n][k] = *(const PG8_LAS bf16x8*)(lds + PG8_SB(b, h) + boff + n * 2048 + k * 1024); } while (0)
#define PG8_MMA(ai, bj, At, Bt) do { __builtin_amdgcn_s_setprio(1); _Pragma("unroll") for (int m = 0; m < 4; ++m) _Pragma("unroll") for (int n = 0; n < 2; ++n) _Pragma("unroll") for (int k = 0; k < 2; ++k) \
        acc[ai][bj][m][n] = __builtin_amdgcn_mfma_f32_16x16x32_bf16(Bt[n][k], At[m][k], acc[ai][bj][m][n], 0, 0, 0); __builtin_amdgcn_s_setprio(0); } while (0)
#define PG8_WAIT_V(n) asm volatile("s_waitcnt vmcnt(" #n ")" ::: "memory")
#define PG8_WAIT_L(n) asm volatile("s_waitcnt lgkmcnt(" #n ")" ::: "memory")
#define PG8_BAR __builtin_amdgcn_s_barrier()
#define PG8_SCHED __builtin_amdgcn_sched_barrier(0)
    Unit cur, nxt; int ui = 0;
    if (!S.next(0, cur)) return;
    f32x4 acc[2][2][4][2];
#pragma unroll
    for (int a = 0; a < 2; ++a)
#pragma unroll
        for (int b = 0; b < 2; ++b)
#pragma unroll
            for (int m = 0; m < 4; ++m)
#pragma unroll
                for (int n = 0; n < 2; ++n) acc[a][b][m][n] = (f32x4){0.f, 0.f, 0.f, 0.f};
    bf16x8 At[4][2], B0[2][2], B1[2][2];
    const char* cA = (const char*)g.A + (size_t)cur.pm * tstep; const char* cB = (const char*)g.Bt + (size_t)cur.pn * tstep;
    S.a_ready(cur);
    if constexpr (SP2) {
        PG8_STAGE(PG8_SB(0, 0), cB, voffB); PG8_STAGE(PG8_SB(0, 1), cB + hstep, voffB); PG8_STAGE(PG8_SA(0, 0), cA, voffA); PG8_STAGE(PG8_SA(0, 1), cA + hstep, voffA);
        if (wr == 1) PG8_BAR;
        PG8_WAIT_V(2); PG8_BAR;
        PG8_STAGE(PG8_SB(1, 0), cB + kstep, voffB); PG8_STAGE(PG8_SA(1, 0), cA + kstep, voffA); PG8_STAGE(PG8_SB(1, 1), cB + hstep + kstep, voffB);
        PG8_WAIT_V(6); PG8_BAR;
    } else {
        PG8_STAGE(PG8_SB(0, 0), cB, voffB); PG8_STAGE(PG8_SA(0, 0), cA, voffA); PG8_STAGE(PG8_SB(0, 1), cB + hstep, voffB); PG8_STAGE(PG8_SA(0, 1), cA + hstep, voffA);
        if (wr == 1) PG8_BAR;
        PG8_WAIT_V(4); PG8_BAR;
        PG8_STAGE(PG8_SB(1, 0), cB + kstep, voffB); PG8_STAGE(PG8_SA(1, 0), cA + kstep, voffA); PG8_STAGE(PG8_SB(1, 1), cB + hstep + kstep, voffB);
        PG8_WAIT_V(6); PG8_BAR;
    }
    for (;;) {
        const bool has_next = S.next(ui + 1, nxt);
        const char* nA = has_next ? (const char*)g.A + (size_t)nxt.pm * tstep : cA; const char* nB = has_next ? (const char*)g.Bt + (size_t)nxt.pn * tstep : cB;
#pragma nounroll
        for (int t = 0; t < nt; t += 2) {
            if constexpr (Epi::HOOK) E.hook(acc, cur, t, wr, wc, fr, fq);
            const bool last = (t == nt - 2);
            const char* a1 = cA + (size_t)(t + 1) * kstep;
            const char* a2 = last ? nA : cA + (size_t)(t + 2) * kstep; const char* b2 = last ? nB : cB + (size_t)(t + 2) * kstep;
            const char* a3 = a2 + kstep; const char* b3 = b2 + kstep;
            if (last && has_next) S.a_ready(nxt);
            if constexpr (SP2) {
            PG8_LDB(B0, 0, 0); PG8_LDB(B1, 0, 1); PG8_SCHED; PG8_LDA(At, 0, 0); PG8_STAGE(PG8_SA(1, 1), a1 + hstep, voffA);
            PG8_WAIT_V(8); PG8_WAIT_L(0); PG8_BAR; PG8_MMA(0, 0, At, B0); PG8_MMA(0, 1, At, B1); PG8_BAR; PG8_SCHED;
            PG8_LDA(At, 0, 1); PG8_STAGE(PG8_SB(0, 0), b2, voffB); PG8_STAGE(PG8_SB(0, 1), b2 + hstep, voffB); PG8_STAGE(PG8_SA(0, 0), a2, voffA);
            PG8_WAIT_V(8); PG8_WAIT_L(0); PG8_BAR; PG8_MMA(1, 0, At, B0); PG8_MMA(1, 1, At, B1); PG8_BAR; PG8_SCHED;
            PG8_LDB(B0, 1, 0); PG8_LDB(B1, 1, 1); PG8_SCHED; PG8_LDA(At, 1, 0); PG8_STAGE(PG8_SA(0, 1), a2 + hstep, voffA);
            PG8_WAIT_V(8); PG8_WAIT_L(0); PG8_BAR; PG8_MMA(0, 0, At, B0); PG8_MMA(0, 1, At, B1); PG8_BAR; PG8_SCHED;
            PG8_LDA(At, 1, 1); PG8_STAGE(PG8_SB(1, 0), b3, voffB); PG8_STAGE(PG8_SB(1, 1), b3 + hstep, voffB); PG8_STAGE(PG8_SA(1, 0), a3, voffA);
            PG8_WAIT_V(8); PG8_WAIT_L(0); PG8_BAR; PG8_MMA(1, 0, At, B0); PG8_MMA(1, 1, At, B1); PG8_BAR; PG8_SCHED;
            } else {
            PG8_LDB(B0, 0, 0); PG8_SCHED; PG8_LDA(At, 0, 0); PG8_STAGE(PG8_SA(1, 1), a1 + hstep, voffA);
            PG8_WAIT_L(8); PG8_BAR; PG8_WAIT_L(0); PG8_MMA(0, 0, At, B0); PG8_BAR; PG8_SCHED;
            PG8_LDB(B1, 0, 1); PG8_STAGE(PG8_SB(0, 0), b2, voffB);
            PG8_BAR; PG8_WAIT_L(0); PG8_MMA(0, 1, At, B1); PG8_BAR;
            PG8_LDA(At, 0, 1); PG8_STAGE(PG8_SA(0, 0), a2, voffA);
            PG8_BAR; PG8_WAIT_L(0); PG8_MMA(1, 0, At, B0); PG8_BAR; PG8_SCHED;
            PG8_STAGE(PG8_SB(0, 1), b2 + hstep, voffB);
            PG8_WAIT_V(6); PG8_BAR; PG8_MMA(1, 1, At, B1); PG8_BAR;
            PG8_LDB(B0, 1, 0); PG8_SCHED; PG8_LDA(At, 1, 0); PG8_STAGE(PG8_SA(0, 1), a2 + hstep, voffA);
            PG8_WAIT_L(8); PG8_BAR; PG8_WAIT_L(0); PG8_MMA(0, 0, At, B0); PG8_BAR; PG8_SCHED;
            PG8_LDB(B1, 1, 1); PG8_STAGE(PG8_SB(1, 0), b3, voffB);
            PG8_BAR; PG8_WAIT_L(0); PG8_MMA(0, 1, At, B1); PG8_BAR;
            PG8_LDA(At, 1, 1); PG8_STAGE(PG8_SA(1, 0), a3, voffA);
            PG8_BAR; PG8_WAIT_L(0); PG8_MMA(1, 0, At, B0); PG8_BAR; PG8_SCHED;
            PG8_STAGE(PG8_SB(1, 1), b3 + hstep, voffB);
            PG8_WAIT_V(6); PG8_BAR; PG8_MMA(1, 1, At, B1); PG8_BAR;
            }
        }
        if constexpr (ALIGN_EPI) { if (wr == 0) PG8_BAR; }
        if constexpr (!Epi::AFTER_DRAIN) {
            Unit ce = cur; asm volatile("" : "+s"(ce.pm), "+s"(ce.pn)); int fre = fr, fqe = fq; asm volatile("" : "+v"(fre), "+v"(fqe));
            E(acc, ce, wr, wc, fre, fqe); S.done(cur); }
        if (!has_next) break;
#pragma unroll
        for (int a = 0; a < 2; ++a)
#pragma unroll
            for (int b = 0; b < 2; ++b)
#pragma unroll
                for (int m = 0; m < 4; ++m)
#pragma unroll
                    for (int n = 0; n < 2; ++n) acc[a][b][m][n] = (f32x4){0.f, 0.f, 0.f, 0.f};
        cur = nxt; cA = nA; cB = nB; ++ui;
        if constexpr (ALIGN_EPI) { if (wr == 1) PG8_BAR; }
    }
    PG8_WAIT_V(0);
    if constexpr (!ALIGN_EPI) { if (wr == 0) PG8_BAR; }
    PG8_BAR;
#ifdef GEMM_PROF
    const long long gp_t1 = (Epi::AFTER_DRAIN && !Epi::HOOK && blockIdx.x == 0) ? (long long)clock64() : 0ll;
#endif
    if constexpr (Epi::AFTER_DRAIN) { E.fused(acc, cur, wr, wc, fr, fq, lds, wid, lane); S.done(cur); }
#ifdef GEMM_PROF
    if (Epi::AFTER_DRAIN && !Epi::HOOK && blockIdx.x == 0 && tid == 0 && gprof) { const long long gp_t2 = clock64(); atomicAdd(gprof + 0, (unsigned long long)(gp_t1 - gp_t0)); atomicAdd(gprof + 1, (unsigned long long)(gp_t2 - gp_t1)); atomicAdd(gprof + 2, 1ull); }
#endif
#undef PG8_SA
#undef PG8_SB
#undef PG8_STAGE
#undef PG8_LDA
#undef PG8_LDB
#undef PG8_MMA
#undef PG8_WAIT_V
#undef PG8_WAIT_L
#undef PG8_BAR
#undef PG8_SCHED
}
constexpr float RMS_EPS = 1e-6f;
constexpr int MROWS_ = 16384;
constexpr float LOG2E = 1.4426950408889634f;
typedef unsigned u32x2 __attribute__((ext_vector_type(2)));
#define PG8_FENCE() asm volatile("" ::: "memory")
#define PG8_G __attribute__((address_space(1)))
__device__ __forceinline__ float sum16f(const PG8_G float* p) {
    const f32x4 a = *(const PG8_G f32x4*)p, b = *(const PG8_G f32x4*)(p + 4), c = *(const PG8_G f32x4*)(p + 8), d = *(const PG8_G f32x4*)(p + 12);
    return ((a[0] + a[1]) + (a[2] + a[3])) + ((b[0] + b[1]) + (b[2] + b[3])) + ((c[0] + c[1]) + (c[2] + c[3])) + ((d[0] + d[1]) + (d[2] + d[3]));
}
__device__ __forceinline__ float fast_rcp(float x) { return __builtin_amdgcn_rcpf(x); }
__device__ __forceinline__ float silu_fast(float g) { return g * fast_rcp(1.0f + __builtin_amdgcn_exp2f(-g * LOG2E)); }
__device__ __forceinline__ float sq4(const f32x4 v) { return (v[0] * v[0] + v[1] * v[1]) + (v[2] * v[2] + v[3] * v[3]); }

struct EpiUp {
    static constexpr bool PERM = true, AFTER_DRAIN = false, HOOK = false;
    PG8_G unsigned char* ws; const PG8_G float* bias;
    __device__ __forceinline__ void hook(f32x4 (&)[2][2][4][2], const Unit&, int, int, int, int, int) const {}
    __device__ __forceinline__ void operator()(const f32x4 (&acc)[2][2][4][2], const Unit& u, int wr, int wc, int fr, int fq) const {
        PG8_G bf16_t* HID = (PG8_G bf16_t*)(ws + WS_HID); const PG8_G float* ssqx = (const PG8_G float*)(ws + WS_SSQX);
        const int b = u.pm >> 5;
        const PG8_G float* bb = bias + b * 5632 + u.pn * BM + wc * 32 + 8 * fq;
        f32x4 bg[2], bu[2];
#pragma unroll
        for (int n = 0; n < 2; ++n) { bg[n] = *(const PG8_G f32x4*)(bb + 4 * n); bu[n] = *(const PG8_G f32x4*)(bb + HALF + 4 * n); }
#pragma unroll
        for (int ai = 0; ai < 2; ++ai)
#pragma unroll
            for (int m = 0; m < 4; ++m) {
                const int row = u.pm * BM + ai * HALF + wr * 64 + m * 16 + fr;
                const float r = 1.0f / sqrtf(sum16f(ssqx + (size_t)row * 16) * (1.0f / 1024.0f) + RMS_EPS);
                float hv[8];
#pragma unroll
                for (int n = 0; n < 2; ++n)
#pragma unroll
                    for (int i = 0; i < 4; ++i) { const float g = acc[ai][0][m][n][i] * r + bg[n][i], uu = acc[ai][1][m][n][i] * r + bu[n][i]; hv[4 * n + i] = silu_fast(g) * uu; }
                u32x4 w; w.x = cvt_pk_bf16(hv[0], hv[1]); w.y = cvt_pk_bf16(hv[2], hv[3]); w.z = cvt_pk_bf16(hv[4], hv[5]); w.w = cvt_pk_bf16(hv[6], hv[7]);
                *(PG8_G u32x4*)(HID + (size_t)row * 2816 + u.pn * HALF + wc * 32 + 8 * fq) = w;
                if (m & 1) PG8_FENCE();
            }
    }
};

template <bool HOOKED> struct EpiResS {
    static constexpr bool PERM = false, AFTER_DRAIN = true, HOOK = HOOKED;
    PG8_G float* fout; PG8_G unsigned char* ws; const PG8_G float* gate; const PG8_G float* igs; const PG8_G float* gs; float coef;
    __device__ __forceinline__ void group_r(int row, float& rA, float& rB, float& rC) const {
        const PG8_G float* p = (const PG8_G float*)(ws + WS_SSQO) + (size_t)row * 16;
        const f32x4 a = *(const PG8_G f32x4*)p, b = *(const PG8_G f32x4*)(p + 4), c = *(const PG8_G f32x4*)(p + 8), d = *(const PG8_G f32x4*)(p + 12);
        const float sA = ((a[0] + a[1]) + (a[2] + a[3])) + (b[0] + b[1]), sB = ((b[2] + b[3]) + (c[0] + c[1])) + (c[2] + c[3]), sC = (d[0] + d[1]) + (d[2] + d[3]);
        rA = 1.0f / sqrtf(sA * (1.0f / 384.0f) + RMS_EPS); rB = 1.0f / sqrtf(sB * (1.0f / 384.0f) + RMS_EPS); rC = 1.0f / sqrtf(sC * (1.0f / 256.0f) + RMS_EPS);
    }
    __device__ __forceinline__ void hook(f32x4 (&acc)[2][2][4][2], const Unit& u, int t, int wr, int wc, int fr, int fq) const {
        if (t != 6 && t != 12) return;
        asm volatile("" : "+v"(fr));
#pragma unroll
        for (int ai = 0; ai < 2; ++ai)
#pragma unroll
            for (int m = 0; m < 4; ++m) {
                const int row = u.pm * BM + ai * HALF + wr * 64 + m * 16 + fr;
                float rA, rB, rC; group_r(row, rA, rB, rC);
                const float f = (t == 6) ? rA / rB : rB / rC;
#pragma unroll
                for (int bj = 0; bj < 2; ++bj)
#pragma unroll
                    for (int n = 0; n < 2; ++n) acc[ai][bj][m][n] = acc[ai][bj][m][n] * f;
                PG8_FENCE();
            }
    }
    __device__ __forceinline__ void fused(f32x4 (&acc)[2][2][4][2], const Unit& u, int wr, int wc, int fr, int fq, PG8_LAS unsigned char* lds, int wid, int lane) const {
        PG8_G bf16_t* xb = (PG8_G bf16_t*)(ws + WS_XB); PG8_G float* ssq_out = (PG8_G float*)(ws + WS_SSQX); constexpr int gate_bstride = 9 * 1024;
        const int b = u.pm >> 5, colg = u.pn * BM + 4 * lane;
        const f32x4 gv = *(const PG8_G f32x4*)(gate + (size_t)b * gate_bstride + colg) * coef;
        const f32x4 gsv = gs ? *(const PG8_G f32x4*)(gs + (size_t)b * 1024 + colg) : (f32x4){0.f, 0.f, 0.f, 0.f};
        const f32x4 igv = *(const PG8_G f32x4*)(igs + (size_t)b * 1024 + colg);
#pragma unroll
        for (int ai = 0; ai < 2; ++ai) {
#pragma unroll
            for (int m = 0; m < 4; ++m) { const int rl = wr * 64 + m * 16 + fr;
#pragma unroll
                for (int bj = 0; bj < 2; ++bj)
#pragma unroll
                    for (int n = 0; n < 2; ++n) { const int c = 32 * bj + 8 * wc + 4 * n + fq; *(PG8_LAS f32x4*)(lds + rl * 1024 + ((c ^ (rl & 7)) << 4)) = acc[ai][bj][m][n]; } }
            asm volatile("s_waitcnt lgkmcnt(0)\n\ts_barrier" ::: "memory");
#pragma unroll
            for (int half = 0; half < 2; ++half) {
                u32x2 xo[8];
#pragma unroll
                for (int k = 0; k < 8; ++k) { const int rl = wid + 8 * (half * 8 + k); xo[k] = *(const PG8_G u32x2*)(xb + (size_t)(u.pm * BM + ai * HALF + rl) * 1024 + colg); }
#pragma unroll
                for (int k = 0; k < 8; ++k) { const int rl = wid + 8 * (half * 8 + k); const int row = u.pm * BM + ai * HALF + rl;
                    f32x4 t = *(const PG8_LAS f32x4*)(lds + rl * 1024 + ((lane ^ (rl & 7)) << 4));
                    if (HOOKED) { float rA, rB, rC; group_r(row, rA, rB, rC); t = t * rC; }
                    const f32x4 xs = {__uint_as_float(xo[k].x << 16), __uint_as_float(xo[k].x & 0xffff0000u), __uint_as_float(xo[k].y << 16), __uint_as_float(xo[k].y & 0xffff0000u)};
                    const f32x4 xn = xs * igv + gv * t;
                    if (!gs) *(PG8_G f32x4*)(fout + (size_t)row * 1024 + colg) = xn;
                    if (gs) { const f32x4 y = xn * gsv; u32x2 w; w.x = cvt_pk_bf16(y[0], y[1]); w.y = cvt_pk_bf16(y[2], y[3]); *(PG8_G u32x2*)(xb + (size_t)row * 1024 + colg) = w; }
                    float ss = sq4(xn);
#pragma unroll
                    for (int o = 1; o < 64; o <<= 1) ss += __shfl_xor(ss, o);
                    if (gs && lane == 0) *(PG8_G f32x4*)(ssq_out + (size_t)row * 16 + 4 * u.pn) = (f32x4){ss, 0.f, 0.f, 0.f};
                }
            }
            asm volatile("s_waitcnt lgkmcnt(0)\n\ts_barrier" ::: "memory");
        }
    }
};

struct EpiIn {
    static constexpr bool PERM = true, AFTER_DRAIN = false, HOOK = false;
    PG8_G unsigned char* ws; const PG8_G float* gq; const PG8_G float* gk; const PG8_G float* bias;
    __device__ __forceinline__ void hook(f32x4 (&)[2][2][4][2], const Unit&, int, int, int, int, int) const {}
    __device__ __forceinline__ void operator()(const f32x4 (&acc)[2][2][4][2], const Unit& u, int wr, int wc, int fr, int fq) const {
        const int slot = u.pn * 4 + wc;
        if (slot == 7 || slot >= 30) return;
        const int b = u.pm >> 5;
        const PG8_G float* ssqx = (const PG8_G float*)(ws + WS_SSQX);
        PG8_G PG8_G bf16_t* dst = nullptr; int pitch = 0, col0 = 0; int kind = 0;
        PG8_G PG8_G float* ssqd = nullptr; int ssqp = 0, ssqi = 0; const PG8_G float* gain = nullptr; float scale = 1.0f;
        if (slot < 4)       { dst = (PG8_G bf16_t*)(ws + WS_CQ);  pitch = 256; col0 = 64 * slot;        kind = 1; ssqd = (PG8_G float*)(ws + WS_SSQC);  ssqp = 4; ssqi = slot; }
        else if (slot < 6)  { dst = (PG8_G bf16_t*)(ws + WS_CKV); pitch = 128; col0 = 64 * (slot - 4);  kind = 1; ssqd = (PG8_G float*)(ws + WS_SSQC) + (size_t)MROWS_ * 4; ssqp = 2; ssqi = slot - 4; }
        else if (slot == 6) { kind = 3; }
        else if (slot < 14) { dst = (PG8_G bf16_t*)(ws + WS_QS);  pitch = 384; col0 = 64 * (slot - 8);  kind = 2; gain = gq; scale = 0.125f * LOG2E; }
        else if (slot < 16) { dst = (PG8_G bf16_t*)(ws + WS_KS);  pitch = 128; col0 = 64 * (slot - 14); kind = 2; gain = gk; }
        else if (slot < 18) { dst = (PG8_G bf16_t*)(ws + WS_VS);  pitch = 128; col0 = 64 * (slot - 16); }
        else if (slot < 22) { dst = (PG8_G bf16_t*)(ws + WS_QC);  pitch = 256; col0 = 64 * (slot - 18); scale = 0.125f * LOG2E; }
        else if (slot < 26) { dst = (PG8_G bf16_t*)(ws + WS_KC);  pitch = 256; col0 = 64 * (slot - 22); }
        else                { dst = (PG8_G bf16_t*)(ws + WS_VC);  pitch = 256; col0 = 64 * (slot - 26); }
        const PG8_G float* bb = bias + b * 2048 + u.pn * BM + wc * 32 + 8 * fq;
        f32x4 bv[2][2], gn[2][2];
#pragma unroll
        for (int bj = 0; bj < 2; ++bj)
#pragma unroll
            for (int n = 0; n < 2; ++n) { bv[bj][n] = *(const PG8_G f32x4*)(bb + bj * HALF + 4 * n);
                gn[bj][n] = (kind == 2) ? *(const PG8_G f32x4*)(gain + 32 * bj + 8 * fq + 4 * n) * scale : (f32x4){scale, scale, scale, scale}; }
#pragma unroll
        for (int ai = 0; ai < 2; ++ai)
#pragma unroll
            for (int m = 0; m < 4; ++m) {
                const int row = u.pm * BM + ai * HALF + wr * 64 + m * 16 + fr;
                const float r = 1.0f / sqrtf(sum16f(ssqx + (size_t)row * 16) * (1.0f / 1024.0f) + RMS_EPS);
                f32x4 v[2][2]; float ss = 0.f;
#pragma unroll
                for (int bj = 0; bj < 2; ++bj)
#pragma unroll
                    for (int n = 0; n < 2; ++n) { v[bj][n] = acc[ai][bj][m][n] * r + bv[bj][n]; ss += sq4(v[bj][n]); }
                if (kind == 3) {
                    float s0 = sq4(v[0][0]) + sq4(v[0][1]);
                    s0 += __shfl_xor(s0, 16); s0 += __shfl_xor(s0, 32);
                    *(PG8_G f32x4*)((PG8_G float*)(ws + WS_KPE) + (size_t)row * 32 + 8 * fq) = v[0][0]; *(PG8_G f32x4*)((PG8_G float*)(ws + WS_KPE) + (size_t)row * 32 + 8 * fq + 4) = v[0][1];
                    if (fq == 0) ((PG8_G float*)(ws + WS_SSQC) + (size_t)MROWS_ * 6)[row] = s0;
                } else {
                    if (kind != 0) { ss += __shfl_xor(ss, 16); ss += __shfl_xor(ss, 32); }
                    float rn = 1.0f;
                    if (kind == 2) rn = 1.0f / sqrtf(ss * (1.0f / 64.0f) + RMS_EPS);
                    if (kind == 1 && fq == 0) ssqd[(size_t)row * ssqp + ssqi] = ss;
#pragma unroll
                    for (int bj = 0; bj < 2; ++bj) {
                        const f32x4 y0 = v[bj][0] * gn[bj][0] * rn, y1 = v[bj][1] * gn[bj][1] * rn;
                        u32x4 w; w.x = cvt_pk_bf16(y0[0], y0[1]); w.y = cvt_pk_bf16(y0[2], y0[3]); w.z = cvt_pk_bf16(y1[0], y1[1]); w.w = cvt_pk_bf16(y1[2], y1[3]);
                        *(PG8_G u32x4*)(dst + (size_t)row * pitch + col0 + 32 * bj + 8 * fq) = w;
                    }
                }
                if (m & 1) PG8_FENCE();
            }
    }
};

struct EpiUq {
    static constexpr bool PERM = false, AFTER_DRAIN = false, HOOK = false;
    PG8_G unsigned char* ws;
    __device__ __forceinline__ void hook(f32x4 (&)[2][2][4][2], const Unit&, int, int, int, int, int) const {}
    __device__ __forceinline__ void operator()(const f32x4 (&acc)[2][2][4][2], const Unit& u, int wr, int wc, int fr, int fq) const {
        PG8_G float* QRAW = (PG8_G float*)(ws + WS_QRAW); const PG8_G float* ssqcq = (const PG8_G float*)(ws + WS_SSQC);
        const int col0 = u.pn * BM + wc * 32 + 4 * fq;
#pragma unroll
        for (int ai = 0; ai < 2; ++ai)
#pragma unroll
            for (int m = 0; m < 4; ++m) {
                const int row = u.pm * BM + ai * HALF + wr * 64 + m * 16 + fr;
                const f32x4 s = *(const PG8_G f32x4*)(ssqcq + (size_t)row * 4);
                const float r = 1.0f / sqrtf(((s[0] + s[1]) + (s[2] + s[3])) * (1.0f / 256.0f) + RMS_EPS);
#pragma unroll
                for (int bj = 0; bj < 2; ++bj)
#pragma unroll
                    for (int n = 0; n < 2; ++n) { const int c = col0 + bj * HALF + n * 16; if (c < 576) *(PG8_G f32x4*)(QRAW + (size_t)row * 576 + c) = acc[ai][bj][m][n] * r; }
            }
    }
};

struct EpiUkv {
    static constexpr bool PERM = true, AFTER_DRAIN = false, HOOK = false;
    PG8_G unsigned char* ws; const PG8_G float* gk;
    __device__ __forceinline__ void hook(f32x4 (&)[2][2][4][2], const Unit&, int, int, int, int, int) const {}
    __device__ __forceinline__ void operator()(const f32x4 (&acc)[2][2][4][2], const Unit& u, int wr, int wc, int fr, int fq) const {
        PG8_G bf16_t* KA = (PG8_G bf16_t*)(ws + WS_KA); PG8_G bf16_t* VA = (PG8_G bf16_t*)(ws + WS_VA); const PG8_G float* ssqckv = (const PG8_G float*)(ws + WS_SSQC) + (size_t)MROWS_ * 4; const PG8_G float* ssqkpe = (const PG8_G float*)(ws + WS_SSQC) + (size_t)MROWS_ * 6;
        const PG8_G float* kpe = (const PG8_G float*)(ws + WS_KPE); const PG8_G float* cs = (const PG8_G float*)(ws + WS_CS);
        const int h = 2 * u.pn + (wc >> 1); const bool isv = (wc & 1) != 0;
        f32x4 gn[2][2], g1 = {1.f, 1.f, 1.f, 1.f}, g2 = {1.f, 1.f, 1.f, 1.f};
        if (!isv) {
#pragma unroll
            for (int bj = 0; bj < 2; ++bj)
#pragma unroll
                for (int n = 0; n < 2; ++n) gn[bj][n] = *(const PG8_G f32x4*)(gk + 32 * bj + 8 * fq + 4 * n);
            g1 = *(const PG8_G f32x4*)(gk + 64 + 4 * fq); g2 = *(const PG8_G f32x4*)(gk + 80 + 4 * fq);
        }
#pragma unroll
        for (int ai = 0; ai < 2; ++ai)
#pragma unroll
            for (int m = 0; m < 4; ++m) {
                const int row = u.pm * BM + ai * HALF + wr * 64 + m * 16 + fr;
                const float r = 1.0f / sqrtf((ssqckv[(size_t)row * 2] + ssqckv[(size_t)row * 2 + 1]) * (1.0f / 128.0f) + RMS_EPS);
                f32x4 v[2][2]; float ss = 0.f;
#pragma unroll
                for (int bj = 0; bj < 2; ++bj)
#pragma unroll
                    for (int n = 0; n < 2; ++n) { v[bj][n] = acc[ai][bj][m][n] * r; ss += sq4(v[bj][n]); }
                if (isv) {
#pragma unroll
                    for (int bj = 0; bj < 2; ++bj) { u32x4 w; w.x = cvt_pk_bf16(v[bj][0][0], v[bj][0][1]); w.y = cvt_pk_bf16(v[bj][0][2], v[bj][0][3]); w.z = cvt_pk_bf16(v[bj][1][0], v[bj][1][1]); w.w = cvt_pk_bf16(v[bj][1][2], v[bj][1][3]);
                        *(PG8_G u32x4*)(VA + (size_t)row * 384 + 64 * h + 32 * bj + 8 * fq) = w; }
                } else {
                    ss += __shfl_xor(ss, 16); ss += __shfl_xor(ss, 32);
                    const float rk = 1.0f / sqrtf((ss + ssqkpe[row]) * (1.0f / 96.0f) + RMS_EPS);
                    PG8_G bf16_t* kd = KA + (size_t)row * 576 + 96 * h;
#pragma unroll
                    for (int bj = 0; bj < 2; ++bj) { const f32x4 y0 = v[bj][0] * gn[bj][0] * rk, y1 = v[bj][1] * gn[bj][1] * rk;
                        u32x4 w; w.x = cvt_pk_bf16(y0[0], y0[1]); w.y = cvt_pk_bf16(y0[2], y0[3]); w.z = cvt_pk_bf16(y1[0], y1[1]); w.w = cvt_pk_bf16(y1[2], y1[3]);
                        *(PG8_G u32x4*)(kd + 32 * bj + 8 * fq) = w; }
                    const f32x4 x1 = *(const PG8_G f32x4*)(kpe + (size_t)row * 32 + 4 * fq) * g1 * rk, x2 = *(const PG8_G f32x4*)(kpe + (size_t)row * 32 + 16 + 4 * fq) * g2 * rk;
                    const f32x4 c = *(const PG8_G f32x4*)(cs + (size_t)row * 32 + 4 * fq), s = *(const PG8_G f32x4*)(cs + (size_t)row * 32 + 16 + 4 * fq);
                    const f32x4 o1 = x1 * c - x2 * s, o2 = x2 * c + x1 * s;
                    u32x2 w1, w2; w1.x = cvt_pk_bf16(o1[0], o1[1]); w1.y = cvt_pk_bf16(o1[2], o1[3]); w2.x = cvt_pk_bf16(o2[0], o2[1]); w2.y = cvt_pk_bf16(o2[2], o2[3]);
                    *(PG8_G u32x2*)(kd + 64 + 4 * fq) = w1; *(PG8_G u32x2*)(kd + 80 + 4 * fq) = w2;
                }
                if (m & 1) PG8_FENCE();
            }
    }
};
}
#define GAS __attribute__((address_space(1)))
#define LAS __attribute__((address_space(3)))
typedef unsigned short bf16;
typedef unsigned v4u __attribute__((ext_vector_type(4)));
typedef float f32x4 __attribute__((ext_vector_type(4)));
typedef short bf16x8 __attribute__((ext_vector_type(8)));
typedef GAS unsigned gu32;
typedef GAS unsigned long long gu64;
#define RLX_AGENT __ATOMIC_RELAXED, __HIP_MEMORY_SCOPE_AGENT
#define LDS_WAIT() asm volatile("s_waitcnt lgkmcnt(0)" ::: "memory")
#define VM_WAIT() asm volatile("s_waitcnt vmcnt(0)" ::: "memory")
__device__ __forceinline__ unsigned long long rt() { return __builtin_amdgcn_s_memrealtime(); }
__device__ __forceinline__ unsigned f2bf(float f) { unsigned u = __builtin_bit_cast(unsigned, f); return (u + 0x7fffu + ((u >> 16) & 1u)) >> 16; }
__device__ __forceinline__ unsigned pk2(float lo, float hi) { return f2bf(lo) | (f2bf(hi) << 16); }

#define XB_TMO      128
#define XB_XCNT(j)  (256  + 64 * (j))
#define XB_XSUB(j)  (1280 + 64 * (j))
#define XB_XGEN(j)  (2304 + 64 * (j))
#define XB_TOP      3328
#define XB_TOPGEN   3392
#define XCD_BAR_WORDS 3456
#define XB_SPIN_CAP (1u << 18)

__device__ __forceinline__ unsigned xb_ld(unsigned* p)              { return __hip_atomic_load(p, __ATOMIC_RELAXED, __HIP_MEMORY_SCOPE_AGENT); }
__device__ __forceinline__ unsigned xb_add(unsigned* p, unsigned v) { return __hip_atomic_fetch_add(p, v, __ATOMIC_RELAXED, __HIP_MEMORY_SCOPE_AGENT); }
__device__ __forceinline__ unsigned xb_xcc_id() { return (unsigned)__builtin_amdgcn_s_getreg((3 << 11) | 20) & 0xFu; }
#define XB_SPIN(cond, bar) do { unsigned _sp = 0; while (cond) { __builtin_amdgcn_s_sleep(1); \
    if ((++_sp & 255u) == 0u) { if (xb_ld(&(bar)[XB_TMO])) break; if (_sp > XB_SPIN_CAP) { atomicAdd(&(bar)[XB_TMO], 1u); break; } } } } while (0)

struct XcdBarrier {
    unsigned* bar; unsigned x;
    volatile LAS unsigned* st;
};

__device__ __forceinline__ XcdBarrier xcd_barrier_post(unsigned* bar, volatile LAS unsigned* st) {
    XcdBarrier b; b.bar = bar; b.x = xb_xcc_id(); b.st = st;
    if (threadIdx.x == 0) (void)xb_add(&bar[XB_XCNT(b.x)], 1u);
    return b;
}
__device__ __forceinline__ void xcd_barrier_complete(unsigned* bar, unsigned x, unsigned& nloc, unsigned& nx) {
    const unsigned G = gridDim.x * gridDim.y * gridDim.z;
    unsigned sum, cnt, mine, sp = 0u;
    for (;;) {
        sum = 0u; cnt = 0u; mine = 0u;
#pragma unroll
        for (unsigned j = 0; j < 16; ++j) { const unsigned c = xb_ld(&bar[XB_XCNT(j)]); sum += c; cnt += (c > 0u) ? 1u : 0u; mine = (j == x) ? c : mine; }
        if (sum == G) break;
        __builtin_amdgcn_s_sleep(1);
        if ((++sp & 255u) == 0u) { if (xb_ld(&bar[XB_TMO])) break; if (sp > XB_SPIN_CAP) { atomicAdd(&bar[XB_TMO], 1u); break; } }
    }
    nloc = mine > 0u ? mine : 1u; nx = cnt > 0u ? cnt : 1u;
}

__device__ __forceinline__ void xcd_barrier(const XcdBarrier& b) {
    asm volatile("s_waitcnt vmcnt(0)" ::: "memory");
    __syncthreads();
    if (threadIdx.x == 0) {
        unsigned* bar = b.bar;
        __builtin_amdgcn_s_waitcnt(0);
        unsigned nloc = b.st[0], nx = b.st[1];
        if (nloc == 0u) { xcd_barrier_complete(bar, b.x, nloc, nx); b.st[0] = nloc; b.st[1] = nx; }
        const unsigned old = xb_add(&bar[XB_XSUB(b.x)], 1u);
        const unsigned gen = old / nloc;
        if (old + 1u == (gen + 1u) * nloc) {
            __builtin_amdgcn_fence(__ATOMIC_RELEASE, "agent");
            asm volatile("s_waitcnt vmcnt(0)" ::: "memory");
            const unsigned og = xb_add(&bar[XB_TOP], 1u);
            const unsigned tg = og / nx;
            if (og + 1u == (tg + 1u) * nx) xb_add(&bar[XB_TOPGEN], 1u);
            else XB_SPIN(xb_ld(&bar[XB_TOPGEN]) == tg, bar);
            __builtin_amdgcn_fence(__ATOMIC_ACQUIRE, "agent");
            xb_add(&bar[XB_XGEN(b.x)], 1u);
            asm volatile("s_waitcnt vmcnt(0)" ::: "memory");
        } else {
            XB_SPIN(xb_ld(&bar[XB_XGEN(b.x)]) == gen, bar);
            __builtin_amdgcn_fence(__ATOMIC_ACQUIRE, "agent");
            asm volatile("s_waitcnt vmcnt(0)" ::: "memory");
        }
    }
    __syncthreads();
}
namespace att {
typedef unsigned short bf16_t;
typedef short bf16x8 __attribute__((ext_vector_type(8)));
typedef short s16x4 __attribute__((ext_vector_type(4)));
typedef short v4i16_t __attribute__((ext_vector_type(4)));
typedef float f32x16 __attribute__((ext_vector_type(16)));
typedef float f32x4 __attribute__((ext_vector_type(4)));
typedef float f32x2 __attribute__((ext_vector_type(2)));
typedef __bf16 bf16x2_t __attribute__((ext_vector_type(2)));
typedef unsigned u32x4 __attribute__((ext_vector_type(4)));
typedef int i32x4 __attribute__((ext_vector_type(4)));
#define ALAS __attribute__((address_space(3)))
#define AGAS __attribute__((address_space(1)))
constexpr int SEQ = 8192;
constexpr float LOG2E = 1.4426950408889634f, EPS = 1e-6f;
constexpr int KCS = 1040, VHS = 4160;
constexpr int KSLOT = 12 * KCS, VSLOT = 2 * VHS;
constexpr int L_K = 0, L_V = 3 * KSLOT, L_POS = L_V + 4 * VSLOT, L_TB = L_POS + 1024, L_WSF = L_TB + 128, L_OST = L_WSF + 8 * 256, L_FLAG = L_OST + 8 * 4096, L_END = L_FLAG + 16 + 64;
static_assert(L_OST % 16 == 0 && L_V % 16 == 0 && L_END <= 131072, "attention LDS map");

__device__ __forceinline__ int crow(int r, int hi) { return (r & 3) + 8 * (r >> 2) + 4 * hi; }
__device__ __forceinline__ unsigned cvtpk(float lo, float hi) { f32x2 v = {lo, hi}; bf16x2_t b = __builtin_convertvector(v, bf16x2_t); return __builtin_bit_cast(unsigned, b); }
__device__ __forceinline__ s16x4 vtr(const ALAS unsigned char* p) { return __builtin_bit_cast(s16x4, __builtin_amdgcn_ds_read_tr16_b64_v4i16((ALAS v4i16_t*)p)); }
__device__ __forceinline__ float swap_sum(float x) { auto rr = __builtin_amdgcn_permlane32_swap(__float_as_uint(x), __float_as_uint(x), false, false); return __uint_as_float(rr[0]) + __uint_as_float(rr[1]); }
__device__ __forceinline__ float swap_max(float x) { auto rr = __builtin_amdgcn_permlane32_swap(__float_as_uint(x), __float_as_uint(x), false, false); return fmaxf(__uint_as_float(rr[0]), __uint_as_float(rr[1])); }
__device__ __forceinline__ float bf2f(unsigned short h) { return __uint_as_float((unsigned)h << 16); }

__device__ __forceinline__ void glds16(const AGAS void* gsrc, unsigned lds_dst) { unsigned keep;
    asm volatile("s_mov_b32 %0, m0\n\ts_mov_b32 m0, %2\n\ts_nop 0\n\tglobal_load_lds_dwordx4 %1, off\n\ts_mov_b32 m0, %0" : "=&s"(keep) : "v"(gsrc), "s"(lds_dst) : "memory"); }
__device__ __forceinline__ void glds4(const AGAS void* gsrc, unsigned lds_dst) { unsigned keep;
    asm volatile("s_mov_b32 %0, m0\n\ts_mov_b32 m0, %2\n\ts_nop 0\n\tglobal_load_lds_dword %1, off\n\ts_mov_b32 m0, %0" : "=&s"(keep) : "v"(gsrc), "s"(lds_dst) : "memory"); }

struct AttnP {
    AGAS unsigned char* ws;
    const AGAS float* gq;
    const AGAS int* pos; const AGAS float* sinks; const AGAS float* relb;
};
template <int MODE> struct AttnCfg;
template <> struct AttnCfg<0> { static constexpr size_t Q = WS_QRAW, K = WS_KA, V = WS_VA; static constexpr int qpitch = 576, kpitch = 576, khs = 96, vpitch = 384, vhs = 64, ocol0 = 0, hidx0 = 0, group = 1; };
template <> struct AttnCfg<1> { static constexpr size_t Q = WS_QS, K = WS_KS, V = WS_VS; static constexpr int qpitch = 384, kpitch = 128, khs = 64, vpitch = 128, vhs = 64, ocol0 = 384, hidx0 = 6, group = 3; };
template <> struct AttnCfg<2> { static constexpr size_t Q = WS_QC, K = WS_KC, V = WS_VC; static constexpr int qpitch = 256, kpitch = 256, khs = 64, vpitch = 256, vhs = 64, ocol0 = 768, hidx0 = 12, group = 1; };

#ifdef ATT_PROF
#define PROF_T() ((MODE == 0 && blockIdx.x == 0) ? (long long)clock64() : 0ll)
#else
#define PROF_T() 0ll
#endif
template <int DQK, int MODE>
__device__ __forceinline__ void attn_unit(ALAS unsigned char* lds, const AttnP& P, int b, int h, int qb, unsigned long long* prof = nullptr) {
    long long pf_qk = 0, pf_sm = 0, pf_pv = 0, pf_wait = 0; const long long pf_t0 = PROF_T();
    constexpr int NCH = DQK / 8, ND0 = DQK / 16;
    int tid_ = threadIdx.x; asm volatile("" : "+v"(tid_));
    const int tid = tid_, lane = tid & 63, r32 = lane & 31, hi = lane >> 5;
    const int wid = __builtin_amdgcn_readfirstlane(tid >> 6);
    const int q0 = qb * 256, qlo = q0 + 32 * wid, qhi = qlo + 31, qrow = qlo + r32;
    const size_t rb = (size_t)b * SEQ;
    typedef AttnCfg<MODE> C; const int kvh = h / C::group;
    ALAS float* wsf = (ALAS float*)(lds + L_WSF) + wid * 64;
    ALAS unsigned char* ost = lds + L_OST + wid * 4096;
    ALAS int* posl = (ALAS int*)(lds + L_POS);
    ALAS float* tb = (ALAS float*)(lds + L_TB);

    bf16x8 qf[ND0];
    if constexpr (MODE == 0) {
        const AGAS float* qp = (const AGAS float*)(P.ws + C::Q) + (rb + qrow) * 576 + h * 96 + hi * 8;
        float qv[ND0][8]; float ss = 0.f;
#pragma unroll
        for (int d0 = 0; d0 < ND0; ++d0) { const f32x4 a = *(const AGAS f32x4*)(qp + 16 * d0), c = *(const AGAS f32x4*)(qp + 16 * d0 + 4);
#pragma unroll
            for (int i = 0; i < 4; ++i) { qv[d0][i] = a[i]; qv[d0][4 + i] = c[i]; ss += a[i] * a[i] + c[i] * c[i]; } }
        ss = swap_sum(ss);
        const float rq = 1.0f / sqrtf(ss * (1.0f / 96.0f) + EPS);
#pragma unroll
        for (int d0 = 0; d0 < ND0; ++d0) { const f32x4 ga = *(const AGAS f32x4*)(P.gq + 16 * d0 + 8 * hi), gb = *(const AGAS f32x4*)(P.gq + 16 * d0 + 8 * hi + 4);
#pragma unroll
            for (int i = 0; i < 4; ++i) { qv[d0][i] *= rq * ga[i]; qv[d0][4 + i] *= rq * gb[i]; } }
        {
            const AGAS float* cp = (const AGAS float*)(P.ws + WS_CS) + (rb + qrow) * 32 + 8 * hi;
            const f32x4 c0 = *(const AGAS f32x4*)cp, c1 = *(const AGAS f32x4*)(cp + 4), s0 = *(const AGAS f32x4*)(cp + 16), s1 = *(const AGAS f32x4*)(cp + 20);
#pragma unroll
            for (int i = 0; i < 8; ++i) { const float c = i < 4 ? c0[i & 3] : c1[i & 3], s = i < 4 ? s0[i & 3] : s1[i & 3]; const float x1 = qv[4][i], x2 = qv[5][i]; qv[4][i] = x1 * c - x2 * s; qv[5][i] = x2 * c + x1 * s; }
        }
        const float sc = 0.10206207261596575f * LOG2E;
#pragma unroll
        for (int d0 = 0; d0 < ND0; ++d0) { u32x4 w; w.x = cvtpk(qv[d0][0] * sc, qv[d0][1] * sc); w.y = cvtpk(qv[d0][2] * sc, qv[d0][3] * sc); w.z = cvtpk(qv[d0][4] * sc, qv[d0][5] * sc); w.w = cvtpk(qv[d0][6] * sc, qv[d0][7] * sc); qf[d0] = __builtin_bit_cast(bf16x8, w); }
    } else {
        const AGAS bf16_t* qp = (const AGAS bf16_t*)(P.ws + C::Q) + (rb + qrow) * C::qpitch + h * 64 + hi * 8;
#pragma unroll
        for (int d0 = 0; d0 < ND0; ++d0) qf[d0] = *(const AGAS bf16x8*)(qp + 16 * d0);
    }
    int posq = 0; float sink2 = 0.f;
    if constexpr (MODE == 1) {
        posq = P.pos[rb + qrow]; sink2 = P.sinks[h] * LOG2E;
        if (tid < 32) tb[tid] = P.relb[tid * 6 + h] * LOG2E;
    }

    int ntile, tfirst, tstep;
    if (MODE == 0) { tfirst = 0; tstep = 1; ntile = ((q0 + 255) >> 6) + 1; }
    else if (MODE == 1) { const int lo = q0 - 127 > 0 ? q0 - 127 : 0; tfirst = lo >> 6; tstep = 1; ntile = ((q0 + 255) >> 6) - tfirst + 1; }
    else { tfirst = (q0 + 254) >> 6; tstep = -1; ntile = tfirst + 1; }

    const AGAS bf16_t* Kg = (const AGAS bf16_t*)(P.ws + C::K) + rb * C::kpitch + kvh * C::khs;
    const AGAS bf16_t* Vg = (const AGAS bf16_t*)(P.ws + C::V) + rb * C::vpitch + kvh * C::vhs;
    const unsigned lds0 = (unsigned)(uintptr_t)lds;
    const AGAS bf16_t* ksrc0 = Kg + (size_t)lane * C::kpitch + 8 * wid;
    const AGAS bf16_t* vsrc = Vg + (size_t)(16 * (wid & 3) + (lane >> 2)) * C::vpitch + 32 * (wid >> 2) + 8 * (lane & 3);
    const bool k2 = (wid + 8) < NCH;
    const bool pw = (MODE == 1) && wid == 0;
    const int NP = 2 + (k2 ? 1 : 0) + (pw ? 1 : 0);
#define ATT_ISSUE(T, IT) do { const int T_ = (T); const size_t jo_ = (size_t)T_ * 64; const int ks_ = (IT) % 3, vs_ = (IT) & 3;     \
        glds16(ksrc0 + jo_ * C::kpitch, (unsigned)__builtin_amdgcn_readfirstlane(lds0 + L_K + ks_ * KSLOT + wid * KCS)); \
        if (k2) glds16(ksrc0 + jo_ * C::kpitch + 64, (unsigned)__builtin_amdgcn_readfirstlane(lds0 + L_K + ks_ * KSLOT + (wid + 8) * KCS)); \
        glds16(vsrc + jo_ * C::vpitch, (unsigned)__builtin_amdgcn_readfirstlane(lds0 + L_V + vs_ * VSLOT + (wid >> 2) * VHS + (wid & 3) * 1024)); \
        if (pw) glds4(P.pos + rb + jo_ + lane, (unsigned)__builtin_amdgcn_readfirstlane(lds0 + L_POS + vs_ * 256)); } while (0)
#define ATT_WAIT_BAR(n_) do { if ((n_) <= 0) asm volatile("s_waitcnt vmcnt(0) lgkmcnt(0)\n\ts_barrier" ::: "memory"); \
        else if (NP == 2) asm volatile("s_waitcnt vmcnt(2) lgkmcnt(0)\n\ts_barrier" ::: "memory"); \
        else if (NP == 3) asm volatile("s_waitcnt vmcnt(3) lgkmcnt(0)\n\ts_barrier" ::: "memory"); \
        else asm volatile("s_waitcnt vmcnt(4) lgkmcnt(0)\n\ts_barrier" ::: "memory"); } while (0)

    f32x16 o0 = {}, o1 = {};
    float mrun = (MODE == 1) ? sink2 : 0.f;
    float lrun = (MODE == 1 && hi == 0) ? 1.0f : 0.f;
    f32x16 negm;
#pragma unroll
    for (int r = 0; r < 16; ++r) negm[r] = (MODE == 2) ? 0.f : -mrun;
    bool first = (MODE == 0);
    float after = 0.f;
    bool walive = true;
    const int vrd = ((lane >> 4) & 1) * 32 + (lane & 3) * 8 + (4 * hi + ((lane & 15) >> 2)) * 64;
    const bool lag = wid >= 4;
    constexpr float THR = 4.0f;

#define ATT_QK(P0, P1, kb) do { int kofs_ = L_K + (kb) * KSLOT + hi * KCS + r32 * 16; asm volatile("" : "+v"(kofs_)); const ALAS unsigned char* Kb_ = lds + kofs_;     \
        bf16x8 kfa_[4], kfb_[4]; \
        _Pragma("unroll") for (int d0 = 0; d0 < 3; ++d0) { kfa_[d0] = *(const ALAS bf16x8*)(Kb_ + 2 * d0 * KCS); kfb_[d0] = *(const ALAS bf16x8*)(Kb_ + 2 * d0 * KCS + 512); } \
        \
        _Pragma("unroll") for (int d0 = 0; d0 < ND0; ++d0) { \
            if (d0 + 3 < ND0) { kfa_[(d0 + 3) & 3] = *(const ALAS bf16x8*)(Kb_ + 2 * (d0 + 3) * KCS); kfb_[(d0 + 3) & 3] = *(const ALAS bf16x8*)(Kb_ + 2 * (d0 + 3) * KCS + 512); } \
            if (d0 == 0) { P0 = __builtin_amdgcn_mfma_f32_32x32x16_bf16(kfa_[0], qf[0], negm, 0, 0, 0); P1 = __builtin_amdgcn_mfma_f32_32x32x16_bf16(kfb_[0], qf[0], negm, 0, 0, 0); } \
            else { P0 = __builtin_amdgcn_mfma_f32_32x32x16_bf16(kfa_[d0 & 3], qf[d0], P0, 0, 0, 0); P1 = __builtin_amdgcn_mfma_f32_32x32x16_bf16(kfb_[d0 & 3], qf[d0], P1, 0, 0, 0); } \
            } } while (0)
#define ATT_VLD(i_, s_) do { vl0_[i_] = vtr(Vb_ + (s_) * 1024); vh0_[i_] = vtr(Vb_ + (s_) * 1024 + 512); vl1_[i_] = vtr(Vb_ + VHS + (s_) * 1024); vh1_[i_] = vtr(Vb_ + VHS + (s_) * 1024 + 512); } while (0)
#define ATT_PV_BEGIN(vb) int vofs_ = L_V + (vb) * VSLOT + vrd; asm volatile("" : "+v"(vofs_)); const ALAS unsigned char* Vb_ = lds + vofs_; \
        s16x4 vl0_[3], vh0_[3], vl1_[3], vh1_[3]; ATT_VLD(0, 0); ATT_VLD(1, 1)
#define ATT_PV_END(P0, P1) do { \
        _Pragma("unroll") for (int s_ = 0; s_ < 4; ++s_) { u32x4 w_; \
            if (s_ < 2) { const int bs = 8 * s_; w_.x = cvtpk(P0[bs], P0[bs + 1]); w_.y = cvtpk(P0[bs + 2], P0[bs + 3]); w_.z = cvtpk(P0[bs + 4], P0[bs + 5]); w_.w = cvtpk(P0[bs + 6], P0[bs + 7]); } \
            else { const int bs = 8 * (s_ - 2); w_.x = cvtpk(P1[bs], P1[bs + 1]); w_.y = cvtpk(P1[bs + 2], P1[bs + 3]); w_.z = cvtpk(P1[bs + 4], P1[bs + 5]); w_.w = cvtpk(P1[bs + 6], P1[bs + 7]); } \
            const bf16x8 pa_ = __builtin_bit_cast(bf16x8, w_); \
            if (s_ + 2 < 4) ATT_VLD((s_ + 2) % 3, s_ + 2); \
            const int i_ = s_ % 3; \
            const bf16x8 v0_ = {vl0_[i_][0], vl0_[i_][1], vl0_[i_][2], vl0_[i_][3], vh0_[i_][0], vh0_[i_][1], vh0_[i_][2], vh0_[i_][3]}, v1_ = {vl1_[i_][0], vl1_[i_][1], vl1_[i_][2], vl1_[i_][3], vh1_[i_][0], vh1_[i_][1], vh1_[i_][2], vh1_[i_][3]}; \
            o0 = __builtin_amdgcn_mfma_f32_32x32x16_bf16(pa_, v0_, o0, 0, 0, 0); o1 = __builtin_amdgcn_mfma_f32_32x32x16_bf16(pa_, v1_, o1, 0, 0, 0); \
            } } while (0)
#define ATT_MAX3(a, b, c) fmaxf(fmaxf((a), (b)), (c))
#define ATT_SM(P0, P1, j0_, pslot) do { \
        if constexpr (MODE == 2) { \
            const bool nm_ = (j0_) + 63 >= qlo; \
            float ln0[16], ln1[16]; \
            _Pragma("unroll") for (int r = 0; r < 16; ++r) { const int key = (j0_) + crow(r, hi); \
                { const float z = P0[r]; const float sp = fmaxf(z, 0.f) + __builtin_amdgcn_logf(1.0f + __builtin_amdgcn_exp2f(-fabsf(z))); const bool ok = !nm_ || key < qrow; ln0[r] = ok ? -sp : 0.f; P0[r] = ok ? z - sp : -INFINITY; } \
                { const float z = P1[r]; const float sp = fmaxf(z, 0.f) + __builtin_amdgcn_logf(1.0f + __builtin_amdgcn_exp2f(-fabsf(z))); const bool ok = !nm_ || key + 32 < qrow; ln1[r] = ok ? -sp : 0.f; P1[r] = ok ? z - sp : -INFINITY; } } \
            float run = after; \
            _Pragma("unroll") for (int blk = 1; blk >= 0; --blk) _Pragma("unroll") for (int g = 3; g >= 0; --g) { \
                const float own = blk ? ((ln1[4 * g] + ln1[4 * g + 1]) + (ln1[4 * g + 2] + ln1[4 * g + 3])) : ((ln0[4 * g] + ln0[4 * g + 1]) + (ln0[4 * g + 2] + ln0[4 * g + 3])); \
                auto rr = __builtin_amdgcn_permlane32_swap(__float_as_uint(own), __float_as_uint(own), false, false); \
                const float slo = __uint_as_float(rr[0]), shi = __uint_as_float(rr[1]); \
                const float e1 = run; run += shi; const float e0 = run; run += slo; \
                float aft = hi ? e1 : e0; \
                _Pragma("unroll") for (int i = 3; i >= 0; --i) { const int r = 4 * g + i; \
                    if (blk) { P1[r] = __builtin_amdgcn_exp2f(P1[r] + aft); aft += ln1[r]; } else { P0[r] = __builtin_amdgcn_exp2f(P0[r] + aft); aft += ln0[r]; } } } \
            after = run; walive = __any(after > -160.0f); \
        } else { \
            if constexpr (MODE == 1) { \
                _Pragma("unroll") for (int g = 0; g < 4; ++g) { \
                    const i32x4 pa = *(const ALAS i32x4*)(posl + (pslot) * 64 + 8 * g + 4 * hi), pb = *(const ALAS i32x4*)(posl + (pslot) * 64 + 32 + 8 * g + 4 * hi); \
                    _Pragma("unroll") for (int i = 0; i < 4; ++i) { \
                        { int n = posq - pa[i]; n = n > 0 ? n : 0; int bk = n; if (n >= 16) { bk = 16 + (int)((__builtin_amdgcn_logf((float)n) - 4.0f) * (16.0f / 3.0f)); bk = bk < 31 ? bk : 31; } P0[4 * g + i] += tb[bk]; } \
                        { int n = posq - pb[i]; n = n > 0 ? n : 0; int bk = n; if (n >= 16) { bk = 16 + (int)((__builtin_amdgcn_logf((float)n) - 4.0f) * (16.0f / 3.0f)); bk = bk < 31 ? bk : 31; } P1[4 * g + i] += tb[bk]; } } } } \
            const bool nm_ = (MODE == 1) || ((j0_) + 63 > qlo); \
            if (nm_) { \
                _Pragma("unroll") for (int r = 0; r < 16; ++r) { const int key = (j0_) + crow(r, hi); \
                    bool ok0 = key <= qrow, ok1 = key + 32 <= qrow; \
                    if (MODE == 1) { ok0 = ok0 && (key > qrow - 128); ok1 = ok1 && (key + 32 > qrow - 128); } \
                    if (!ok0) P0[r] = -INFINITY; if (!ok1) P1[r] = -INFINITY; } } \
            float ma = ATT_MAX3(P0[0], P0[1], P1[0]), mb = ATT_MAX3(P0[2], P0[3], P1[1]); ma = ATT_MAX3(ma, P1[2], P1[3]); \
            _Pragma("unroll") for (int r = 4; r < 16; r += 4) { ma = ATT_MAX3(ma, P0[r], P0[r + 1]); mb = ATT_MAX3(mb, P0[r + 2], P0[r + 3]); ma = ATT_MAX3(ma, P1[r], P1[r + 1]); mb = ATT_MAX3(mb, P1[r + 2], P1[r + 3]); } \
            const float mt = swap_max(fmaxf(ma, mb)); \
            if (first || __any(mt > THR)) {                                 \
                const float d = first ? mt : fmaxf(mt, 0.f); first = false; \
                _Pragma("unroll") for (int r = 0; r < 16; ++r) { P0[r] -= d; P1[r] -= d; } \
                const float alpha = __builtin_amdgcn_exp2f(-d); mrun += d; lrun *= alpha; \
                _Pragma("unroll") for (int r = 0; r < 16; ++r) negm[r] = -mrun; \
                if (hi == 0) wsf[r32] = alpha; \
                _Pragma("unroll") for (int g = 0; g < 4; ++g) { const f32x4 al = *(const ALAS f32x4*)(wsf + 8 * g + 4 * hi); \
                    _Pragma("unroll") for (int i = 0; i < 4; ++i) { o0[4 * g + i] *= al[i]; o1[4 * g + i] *= al[i]; } } } \
            float ls = 0.f; \
            _Pragma("unroll") for (int r = 0; r < 16; ++r) { P0[r] = __builtin_amdgcn_exp2f(P0[r]); P1[r] = __builtin_amdgcn_exp2f(P1[r]); ls += P0[r] + P1[r]; } \
            lrun += ls; \
        } } while (0)
#define ATT_WORK(j0_) ((MODE == 0) ? ((j0_) <= qhi) : (MODE == 1) ? (((j0_) <= qhi) && ((j0_) + 63 >= qlo - 127)) : (walive && ((j0_) < qhi)))

    f32x16 p0, p1;
    bool pend = false; int pj0 = 0, pit = 0;
    __syncthreads();
    ATT_ISSUE(tfirst, 0);
    int issued = 0;
    if (ntile > 1) { ATT_ISSUE(tfirst + tstep, 1); issued = 1; }
    ATT_WAIT_BAR(issued);
    int nt = ntile;
    for (int it = 0; it <= nt; ++it) {
        const bool tilev = it < nt;
        const int t = tfirst + it * tstep, j0 = t * 64, kb = it % 3;
        if (tilev && it + 2 < ntile) { ATT_ISSUE(t + 2 * tstep, it + 2); issued = it + 2; }
        if (tilev && !lag && ATT_WORK(j0)) { const long long t0_ = PROF_T(); ATT_QK(p0, p1, kb); pend = true; pj0 = j0; pit = it; pf_qk += PROF_T() - t0_; }
        if (pend) { const long long t0_ = PROF_T(); ATT_PV_BEGIN(pit & 3); ATT_SM(p0, p1, pj0, pit & 3); const long long t1_ = PROF_T(); ATT_PV_END(p0, p1); pend = false; const long long t2_ = PROF_T(); pf_sm += t1_ - t0_; pf_pv += t2_ - t1_; }
        if (tilev && lag && ATT_WORK(j0)) { const long long t0_ = PROF_T(); ATT_QK(p0, p1, kb); pend = true; pj0 = j0; pit = it; pf_qk += PROF_T() - t0_; }
        if (!tilev) break;
        if (MODE == 2) { ALAS int* fl = (ALAS int*)(lds + L_FLAG + 16) + (it & 1) * 8; if (lane == 0) fl[wid] = (walive && j0 > 0) ? 1 : 0; }
        { const long long t0_ = PROF_T(); ATT_WAIT_BAR(issued - (it + 1)); pf_wait += PROF_T() - t0_; }
        if (MODE == 2) { const ALAS int* fl = (const ALAS int*)(lds + L_FLAG + 16) + (it & 1) * 8;
            const i32x4 fa = *(const ALAS i32x4*)fl, fb = *(const ALAS i32x4*)(fl + 4);
            if (((fa[0] | fa[1]) | (fa[2] | fa[3]) | (fb[0] | fb[1]) | (fb[2] | fb[3])) == 0) nt = it + 1; }
    }
    if (MODE == 2) asm volatile("s_waitcnt vmcnt(0)" ::: "memory");
#undef ATT_ISSUE
#undef ATT_WAIT_BAR
#undef ATT_QK
#undef ATT_PV_BEGIN
#undef ATT_PV_END
#undef ATT_VLD
#undef ATT_SM
#undef ATT_WORK
#undef ATT_MAX3
    if (MODE != 2) {
        const float lt = swap_sum(lrun);
        if (hi == 0) wsf[32 + r32] = 1.0f / lt;
#pragma unroll
        for (int g = 0; g < 4; ++g) { const f32x4 il = *(const ALAS f32x4*)(wsf + 32 + 8 * g + 4 * hi);
#pragma unroll
            for (int i = 0; i < 4; ++i) { o0[4 * g + i] *= il[i]; o1[4 * g + i] *= il[i]; } }
    }
    {
        ALAS bf16_t* stg = (ALAS bf16_t*)ost;
#pragma unroll
        for (int r = 0; r < 16; ++r) { const int orow = crow(r, hi); stg[orow * 64 + r32] = (bf16_t)(cvtpk(o0[r], 0.f) & 0xffffu); stg[orow * 64 + 32 + r32] = (bf16_t)(cvtpk(o1[r], 0.f) & 0xffffu); }
        AGAS bf16_t* Ow = (AGAS bf16_t*)(P.ws + WS_OALL) + (rb + qlo) * 1024 + C::ocol0 + h * 64;
#pragma unroll
        for (int i = 0; i < 4; ++i) {
            const int row = i * 8 + (lane >> 3), ch = lane & 7;
            const u32x4 v = *(const ALAS u32x4*)(stg + row * 64 + ch * 8);
            float ss = 0.f;
#pragma unroll
            for (int k = 0; k < 4; ++k) { const unsigned w = v[k]; const float a = __uint_as_float(w << 16), c = __uint_as_float(w & 0xffff0000u); ss += a * a + c * c; }
            ss += __shfl_xor(ss, 1); ss += __shfl_xor(ss, 2); ss += __shfl_xor(ss, 4);
            *(AGAS u32x4*)(Ow + (size_t)row * 1024 + ch * 8) = v;
            if (ch == 0) ((AGAS float*)(P.ws + WS_SSQO))[(rb + qlo + row) * 16 + C::hidx0 + h] = ss;
        }
    }
#ifdef ATT_PROF
    if (MODE == 0 && blockIdx.x == 0 && wid == ATT_PROF_WAVE && lane == 0 && prof) { const long long tt = PROF_T() - pf_t0;
        atomicAdd(prof + 0, (unsigned long long)tt); atomicAdd(prof + 1, (unsigned long long)pf_qk); atomicAdd(prof + 2, (unsigned long long)pf_sm); atomicAdd(prof + 3, (unsigned long long)pf_pv); atomicAdd(prof + 4, (unsigned long long)pf_wait); atomicAdd(prof + 5, 1ull); }
#endif
}
#undef ALAS
#undef AGAS
}
struct Args { const void* in[23]; float* out; unsigned char* ws; int ph_lo, ph_hi, li, adapt; };

struct Frame { LAS unsigned char* lds; int tid, lane, wave, vcu, G; };

__device__ __forceinline__ float wave_sum64(float v) {
#pragma unroll
    for (int o = 1; o < 64; o <<= 1) v += __shfl_xor(v, o);
    return v;
}

__device__ __forceinline__ void tr_item64(const GAS float* W, int ldn, int K, GAS pg8::bf16_t* WT, int kb, int g, int src0, int src1, const GAS float* kgain, LAS unsigned* scr, int lane) {
    const int k0 = 64 * kb; const int col = lane < 32 ? src0 + lane : src1 + (lane - 32); const bool ok = (lane < 32 ? src0 : src1) >= 0;
    float v[64];
    const GAS float* wp = W + (size_t)k0 * ldn + (ok ? col : 0);
#pragma unroll
    for (int i = 0; i < 64; ++i) v[i] = wp[(size_t)i * ldn];
#pragma unroll
    for (int i = 0; i < 64; ++i) v[i] = ok ? v[i] : 0.f;
    if (kgain) {
#pragma unroll
        for (int i = 0; i < 64; ++i) v[i] *= kgain[k0 + i]; }
#pragma unroll
    for (int i = 0; i < 32; ++i) scr[i * 65 + lane] = pk2(v[2 * i], v[2 * i + 1]);
    asm volatile("s_waitcnt lgkmcnt(0)" ::: "memory");
    const int c = lane & 7;
#pragma unroll
    for (int j = 0; j < 8; ++j) { const int n = (lane >> 3) + 8 * j; const LAS unsigned* s = scr + (4 * c) * 65 + n;
        v4u o; o.x = s[0]; o.y = s[65]; o.z = s[130]; o.w = s[195];
        *(GAS v4u*)(WT + (size_t)(64 * g + n) * K + k0 + 8 * c) = o; }
    asm volatile("s_waitcnt lgkmcnt(0)" ::: "memory");
}
__device__ __forceinline__ int in_slot_src(int slot, int& cnt) {
    cnt = 64;
    if (slot < 4) return 64 * slot;
    if (slot < 6) return 256 + 64 * (slot - 4);
    if (slot == 6) { cnt = 32; return 384; }
    if (slot == 7) return -1;
    if (slot < 14) return 416 + 64 * (slot - 8);
    if (slot < 16) return 800 + 64 * (slot - 14);
    if (slot < 18) return 928 + 64 * (slot - 16);
    if (slot < 22) return 1056 + 64 * (slot - 18);
    if (slot < 26) return 1312 + 64 * (slot - 22);
    if (slot < 30) return 1568 + 64 * (slot - 26);
    return -1;
}

#define A_X ((const GAS float*)args.in[0])
#define A_C ((const GAS float*)args.in[1])
#define A_POS ((const GAS int*)args.in[2])
#define A_RELB ((const GAS float*)args.in[3])
#define A_NORMG ((const GAS float*)args.in[4])
#define A_WMOD ((const GAS float*)args.in[5])
#define A_BMOD ((const GAS float*)args.in[6])
#define A_WGU1 ((const GAS float*)args.in[7])
#define A_WD1 ((const GAS float*)args.in[8])
#define A_WIN ((const GAS float*)args.in[9])
#define A_QAN ((const GAS float*)args.in[10])
#define A_KVAN ((const GAS float*)args.in[11])
#define A_WUQ ((const GAS float*)args.in[12])
#define A_WUKV ((const GAS float*)args.in[13])
#define A_MLAQN ((const GAS float*)args.in[14])
#define A_MLAKN ((const GAS float*)args.in[15])
#define A_SWAQN ((const GAS float*)args.in[16])
#define A_SWAKN ((const GAS float*)args.in[17])
#define A_SINKS ((const GAS float*)args.in[18])
#define A_OUTN ((const GAS float*)args.in[19])
#define A_WOUT ((const GAS float*)args.in[20])
#define A_WGU2 ((const GAS float*)args.in[21])
#define A_WD2 ((const GAS float*)args.in[22])
#define WSP(off)   (ws_ + (off))
#define MOD ((GAS float*)WSP(WS_MOD))
#define GS ((GAS float*)WSP(WS_GS))
#define BIAS ((GAS float*)WSP(WS_BIAS))
#define SSQX ((GAS float*)WSP(WS_SSQX))
#define SSQO ((GAS float*)WSP(WS_SSQO))
#define CS ((GAS float*)WSP(WS_CS))
#define KPE ((GAS float*)WSP(WS_KPE))
#define SSQ_CQ ((GAS float*)WSP(WS_SSQC))
#define SSQ_CKV ((GAS float*)WSP(WS_SSQC) + (size_t)MROWS * 4)
#define SSQ_KPE ((GAS float*)WSP(WS_SSQC) + (size_t)MROWS * 6)
#define XB ((GAS pg8::bf16_t*)WSP(WS_XB))
#define HID ((GAS pg8::bf16_t*)WSP(WS_HID))
#define CQ ((GAS pg8::bf16_t*)WSP(WS_CQ))
#define CKV ((GAS pg8::bf16_t*)WSP(WS_CKV))
#define KA ((GAS pg8::bf16_t*)WSP(WS_KA))
#define VA ((GAS pg8::bf16_t*)WSP(WS_VA))
#define QS ((GAS pg8::bf16_t*)WSP(WS_QS))
#define KS ((GAS pg8::bf16_t*)WSP(WS_KS))
#define VS ((GAS pg8::bf16_t*)WSP(WS_VS))
#define QC ((GAS pg8::bf16_t*)WSP(WS_QC))
#define KC ((GAS pg8::bf16_t*)WSP(WS_KC))
#define VC ((GAS pg8::bf16_t*)WSP(WS_VC))
#define OALL ((GAS pg8::bf16_t*)WSP(WS_OALL))
#define QRAW ((GAS float*)WSP(WS_QRAW))

__device__ __forceinline__ int in_group_src(int g32) {
    const int tile = g32 >> 3, rr = g32 & 7, bj = rr >> 2, wc = rr & 3; int cnt; const int base = in_slot_src(tile * 4 + wc, cnt);
    return (base >= 0 && 32 * bj < cnt) ? base + 32 * bj : -1;
}
__device__ __forceinline__ void phase_pro0(Frame& F, const Args& args, gu32* qhead) {
    GAS unsigned char* ws_ = (GAS unsigned char*)args.ws; asm volatile("" : "+s"(ws_));
    constexpr int NMU = DEPTH * NMOD / 128;
    if ((int)blockIdx.x < NMU || F.G <= NMU) {
        LAS float* cond = (LAS float*)F.lds;
        LAS float* red = (LAS float*)(F.lds + 8192);
        for (int i = F.tid; i < 2 * DM; i += 512) { const float cv = A_C[i]; cond[i] = cv / (1.0f + expf(-cv)); }
        __syncthreads();
        for (int u = blockIdx.x; u < NMU; u += F.G) {
            const int l = u / (NMOD / 128), n0 = (u % (NMOD / 128)) * 128, c4 = F.lane & 31, kp = F.lane >> 5;
            const GAS float* w = A_WMOD + (size_t)l * DM * NMOD + n0 + 4 * c4;
            f32x4 a0 = {0.f, 0.f, 0.f, 0.f}, a1 = {0.f, 0.f, 0.f, 0.f};
#pragma unroll 8
            for (int i = 0; i < 64; ++i) { const int kk = F.wave * 128 + 2 * i + kp; const f32x4 wv = *(const GAS f32x4*)(w + (size_t)kk * NMOD); a0 += wv * cond[kk]; a1 += wv * cond[DM + kk]; }
#pragma unroll
            for (int q = 0; q < 4; ++q) { a0[q] += __shfl_xor(a0[q], 32); a1[q] += __shfl_xor(a1[q], 32); }
            if (kp == 0) { *(LAS f32x4*)(red + (F.wave * 2 + 0) * 128 + 4 * c4) = a0; *(LAS f32x4*)(red + (F.wave * 2 + 1) * 128 + 4 * c4) = a1; }
            __syncthreads();
            if (F.tid < 256) { const int bb = F.tid >> 7, ln = F.tid & 127; float s = 0.f;
#pragma unroll
                for (int wv = 0; wv < 8; ++wv) s += red[(wv * 2 + bb) * 128 + ln];
                MOD[((size_t)l * 2 + bb) * NMOD + n0 + ln] = s + A_BMOD[(size_t)l * NMOD + n0 + ln]; }
            __syncthreads();
        }
    }
    if ((int)blockIdx.x >= NMU || F.G <= NMU) {
        const int nb = F.G <= NMU ? F.G : F.G - NMU, b0 = F.G <= NMU ? (int)blockIdx.x : (int)blockIdx.x - NMU;
        for (int i = b0 * 512 + F.tid; i < MROWS * 16; i += nb * 512) {
            const int m = i >> 4, j = i & 15;
            const float freq = powf(10000.0f, -(float)j / 16.0f);
            const float ang = (float)A_POS[m] * freq;
            CS[(size_t)m * 32 + j] = cosf(ang); CS[(size_t)m * 32 + 16 + j] = sinf(ang);
        }
    }
    {
        LAS unsigned* scr = (LAS unsigned*)(F.lds + 16384 + F.wave * 8448);
        LAS int* slot = (LAS int*)(F.lds + 12288);
        constexpr int I_GU = 16 * 88, I_D = 44 * 16, I_IN = 16 * 32, I_UQ = 4 * 12, I_UKV = 2 * 12, I_OUT = 16 * 16;
        constexpr int I_L = 2 * I_GU + 2 * I_D + I_IN + I_UQ + I_UKV + I_OUT, I_ALL = DEPTH * I_L;
        for (;;) {
            __syncthreads();
            if (F.tid == 0) slot[0] = (int)__hip_atomic_fetch_add(qhead, 16u, __ATOMIC_RELAXED, __HIP_MEMORY_SCOPE_AGENT);
            __syncthreads();
            const int base = slot[0];
            if (base >= I_ALL) break;
#pragma unroll 1
            for (int q = 0; q < 2; ++q) {
                const int it = base + F.wave * 2 + q; if (it >= I_ALL) break;
                const int l = it / I_L; int r = it % I_L;
                GAS unsigned char* wl = ws_ + WS_W + (size_t)l * WL;
                if (r < 2 * I_GU) {
                    const bool second = r >= I_GU; if (second) r -= I_GU;
                    const int kb = r / 88, g = r % 88, t = g >> 2, rr = g & 3, src = (rr >> 1) * DFF + 128 * t + 64 * (rr & 1);
                    const GAS float* W = (second ? A_WGU2 : A_WGU1) + (size_t)l * DM * 2 * DFF;
                    tr_item64(W, 2 * DFF, DM, (GAS pg8::bf16_t*)(wl + (second ? W_GU2 : W_GU1)), kb, g, src, src + 32, nullptr, scr, F.lane); continue; }
                r -= 2 * I_GU;
                if (r < 2 * I_D) { const bool second = r >= I_D; if (second) r -= I_D; const int kb = r / 16, g = r % 16;
                    tr_item64((second ? A_WD2 : A_WD1) + (size_t)l * DFF * DM, DM, DFF, (GAS pg8::bf16_t*)(wl + (second ? W_D2 : W_D1)), kb, g, 64 * g, 64 * g + 32, nullptr, scr, F.lane); continue; }
                r -= 2 * I_D;
                if (r < I_IN) { const int kb = r / 32, g = r % 32;
                    tr_item64(A_WIN + (size_t)l * DM * DIN, DIN, DM, (GAS pg8::bf16_t*)(wl + W_IN), kb, g, in_group_src(2 * g), in_group_src(2 * g + 1), nullptr, scr, F.lane); continue; }
                r -= I_IN;
                if (r < I_UQ) { const int kb = r / 12, g = r % 12;
                    tr_item64(A_WUQ + (size_t)l * 256 * 576, 576, 256, (GAS pg8::bf16_t*)(wl + W_UQ), kb, g, g < 9 ? 64 * g : -1, g < 9 ? 64 * g + 32 : -1, A_QAN + l * 256, scr, F.lane); continue; }
                r -= I_UQ;
                if (r < I_UKV) { const int kb = r / 12, g = r % 12, g0 = 2 * g, g1 = 2 * g + 1;
                    tr_item64(A_WUKV + (size_t)l * 128 * 768, 768, 128, (GAS pg8::bf16_t*)(wl + W_UKV), kb, g, 256 * (g0 >> 3) + 64 * (g0 & 3) + 32 * ((g0 & 7) >> 2), 256 * (g1 >> 3) + 64 * (g1 & 3) + 32 * ((g1 & 7) >> 2), A_KVAN + l * 128, scr, F.lane); continue; }
                r -= I_UKV;
                { const int kb = r / 16, g = r % 16;
                    tr_item64(A_WOUT + (size_t)l * DM * DM, DM, DM, (GAS pg8::bf16_t*)(wl + W_OUT), kb, g, 64 * g, 64 * g + 32, A_OUTN + l * DM, scr, F.lane); }
            }
        }
    }
}

__device__ __forceinline__ float gs_clamped(float g, float sc) { const float v = g * (1.0f + sc); return fabsf(v) < 1e-20f ? (v < 0.f ? -1e-20f : 1e-20f) : v; }
__device__ __forceinline__ void x_to_xb(Frame& F, const Args& args, const GAS float* xsrc, int l, int i) {
    GAS unsigned char* ws_ = (GAS unsigned char*)args.ws; asm volatile("" : "+s"(ws_));
    const int gw = F.vcu * NWAVES + F.wave, NGW = F.G * NWAVES;
    for (int m = gw; m < MROWS; m += NGW) {
        const int b = m >> 13;
        const GAS f32x4* xr = (const GAS f32x4*)(xsrc + (size_t)m * DM) + F.lane;
        const GAS f32x4* gr = (const GAS f32x4*)(A_NORMG + ((size_t)l * 3 + i) * DM) + F.lane;
        const GAS f32x4* sr = (const GAS f32x4*)(MOD + ((size_t)l * 2 + b) * NMOD + (3 * i + 1) * DM) + F.lane;
        float s = 0.f;
        GAS unsigned long long* o8 = (GAS unsigned long long*)(XB + (size_t)m * DM) + F.lane;
#pragma unroll
        for (int j = 0; j < 4; ++j) { const f32x4 v = xr[64 * j]; s += (v.x * v.x + v.y * v.y) + (v.z * v.z + v.w * v.w);
            const f32x4 g0 = gr[64 * j], s0 = sr[64 * j]; const f32x4 g = {gs_clamped(g0.x, s0.x), gs_clamped(g0.y, s0.y), gs_clamped(g0.z, s0.z), gs_clamped(g0.w, s0.w)}; const f32x4 y = v * g;
            o8[64 * j] = (unsigned long long)pk2(y.x, y.y) | ((unsigned long long)pk2(y.z, y.w) << 32); }
        s = wave_sum64(s);
        if (F.lane < 16) SSQX[(size_t)m * 16 + F.lane] = (F.lane == 0) ? s : 0.f;
    }
}

__device__ __forceinline__ void phase_pro1(Frame& F, const Args& args) {
    GAS unsigned char* ws_ = (GAS unsigned char*)args.ws; asm volatile("" : "+s"(ws_));
    for (int i = blockIdx.x * 512 + F.tid; i < DEPTH * 3 * 2 * DM; i += F.G * 512) {
        const int cidx = i & 1023, b = (i >> 10) & 1, li = i >> 11, l = li / 3, ii = li % 3;
        const float gv_ = gs_clamped(A_NORMG[((size_t)l * 3 + ii) * DM + cidx], MOD[((size_t)l * 2 + b) * NMOD + (3 * ii + 1) * DM + cidx]);
        GS[i] = gv_; ((GAS float*)WSP(WS_IGS))[i] = 1.0f / gv_;
    }
    const int gw = F.vcu * NWAVES + F.wave, NGW = F.G * NWAVES;
    constexpr int RL = 5632 + 2048 + 5632;
    for (int it = gw; it < DEPTH * RL; it += NGW) {
        const int l = it / RL; int r = it % RL; int which, nrow; size_t woff; size_t boff;
        if (r < 5632) { which = 0; nrow = 5632; woff = W_GU1; boff = 0; } else if (r < 5632 + 2048) { r -= 5632; which = 1; nrow = 2048; woff = W_IN; boff = 2 * 5632; } else { r -= 5632 + 2048; which = 2; nrow = 5632; woff = W_GU2; boff = 2 * (5632 + 2048); }
        const GAS pg8::bf16_t* wr = (const GAS pg8::bf16_t*)(ws_ + WS_W + (size_t)l * WL + woff) + (size_t)r * DM;
        float a0 = 0.f, a1 = 0.f;
#pragma unroll
        for (int j = 0; j < 2; ++j) {
            const v4u wv = *(const GAS v4u*)(wr + j * 512 + F.lane * 8);
            const GAS float* s0 = MOD + ((size_t)l * 2 + 0) * NMOD + (3 * which) * DM + j * 512 + F.lane * 8; const GAS float* s1 = s0 + NMOD;
#pragma unroll
            for (int k = 0; k < 4; ++k) { const unsigned w = wv[k]; const float lo = __uint_as_float(w << 16), hi = __uint_as_float(w & 0xffff0000u);
                a0 += lo * s0[2 * k] + hi * s0[2 * k + 1]; a1 += lo * s1[2 * k] + hi * s1[2 * k + 1]; }
        }
        a0 = wave_sum64(a0); a1 = wave_sum64(a1);
        if (F.lane == 0) { BIAS[(size_t)l * BIAS_L + boff + r] = a0; BIAS[(size_t)l * BIAS_L + boff + nrow + r] = a1; }
    }
    x_to_xb(F, args, A_X, 0, 0);
}

__device__ __forceinline__ int next_unit(Frame& F, gu32* head) {
    LAS int* slot = (LAS int*)(F.lds + att::L_FLAG);
    __syncthreads();
    if (F.tid == 0) slot[0] = (int)__hip_atomic_fetch_add(head, 1u, __ATOMIC_RELAXED, __HIP_MEMORY_SCOPE_AGENT);
    __syncthreads();
    return slot[0];
}

#ifndef DUPS
#define DUPS -1
#endif
#ifndef PHM
#define PHM 255
#endif
#ifndef PHM2
#define PHM2 31
#endif
__global__ void __launch_bounds__(NWAVES * 64, 2) fwd_mega(Args args) {
    extern __shared__ __attribute__((aligned(16))) unsigned char lds[];
    Frame F; F.lds = (LAS unsigned char*)lds; F.tid = threadIdx.x; F.lane = F.tid & 63; F.wave = __builtin_amdgcn_readfirstlane(F.tid >> 6);
    F.G = gridDim.x; { const int bx = blockIdx.x; F.vcu = (F.G % 8 == 0) ? (bx % 8) * (F.G / 8) + bx / 8 : bx; }
    gu32* ctl = (gu32*)(args.ws + WS_CTL);
    for (int u = F.tid; u < (LDS_BYTES - LDSCTL_OFF) / 4; u += NWAVES * 64) ((LAS unsigned*)(F.lds + LDSCTL_OFF))[u] = 0u;
    __syncthreads();
    if (args.adapt >= 0) { x_to_xb(F, args, (const GAS float*)args.out, args.adapt / 3, args.adapt % 3); return; }
    const int lo = args.ph_lo, hi = args.ph_hi;
    XcdBarrier bar; bar.bar = (unsigned*)(ctl + CW_BAR) + args.li * XCD_BAR_WORDS; bar.x = 0; bar.st = nullptr;
    if (hi - lo > 1 || true) bar = xcd_barrier_post((unsigned*)(ctl + CW_BAR) + args.li * XCD_BAR_WORDS, (volatile LAS unsigned*)(F.lds + MISC_OFF) + 8);

    for (int ph = lo; ph < hi; ++ph) {
        { int t_ = threadIdx.x; asm volatile("" : "+v"(t_)); F.tid = t_; F.lane = t_ & 63; F.wave = __builtin_amdgcn_readfirstlane(t_ >> 6); }
        GAS unsigned char* ws_ = (GAS unsigned char*)args.ws; asm volatile("" : "+s"(ws_));
        int nrep = 1;
        if (DUPS >= 0) { const int ty = ph < 2 ? 8 + ph : ((ph - 2) & 7); if (ty == DUPS && !(ty == 5) && !((ty == 1 || ty == 7) && ph != 3)) nrep = 2; }
        for (int rep = 0; rep < nrep; ++rep) {
        if ((PHM & 64) && ph == 0) phase_pro0(F, args, ctl + CW_Q + 64 * 8);
        else if ((PHM & 128) && ph == 1) phase_pro1(F, args);
        else {
            const int l = (ph - 2) >> 3, s = (ph - 2) & 7;
            const GAS unsigned char* wl = ws_ + WS_W + (size_t)l * WL;
            const GAS float* biasl = BIAS + (size_t)l * BIAS_L;
            const GAS float* modl = MOD + (size_t)l * 2 * NMOD;
            if ((PHM & 1) && (s == 0 || s == 6)) {
                pg8::Gemm g{(const pg8::bf16_t*)XB, (const pg8::bf16_t*)(wl + (s == 0 ? W_GU1 : W_GU2)), MROWS, 5632, DM}; pg8::StaticOrder S; S.init(MROWS, 5632, F.G, (int)blockIdx.x);
                pg8::EpiUp E{ws_, biasl + (s == 0 ? 0 : 2 * (5632 + 2048))};
                pg8::gemm_phase<pg8::EpiUp, pg8::StaticOrder, true, true>(F.lds, g, S, E);
            } else if ((PHM & 2) && (s == 1 || s == 7)) {
                pg8::Gemm g{(const pg8::bf16_t*)HID, (const pg8::bf16_t*)(wl + (s == 1 ? W_D1 : W_D2)), MROWS, DM, DFF}; pg8::StaticOrder S; S.init(MROWS, DM, F.G, (int)blockIdx.x);
                const bool lastp = (s == 7 && l == DEPTH - 1);
                const GAS float* gsn = lastp ? nullptr : (s == 1 ? GS + ((size_t)(l * 3 + 1) * 2) * DM : GS + ((size_t)((l + 1) * 3 + 0) * 2) * DM);
                const GAS float* igp = (const GAS float*)WSP(WS_IGS) + ((size_t)(l * 3 + (s == 1 ? 0 : 2)) * 2) * DM;
                pg8::EpiResS<false> E{(GAS float*)args.out, ws_, modl + (s == 1 ? 2 : 8) * DM, igp, gsn, 0.5f}; pg8::gemm_phase<pg8::EpiResS<false>, pg8::StaticOrder, false, true>(F.lds, g, S, E, (unsigned long long*)(ctl + CW_Q + 64 * 13));
            } else if ((PHM & 4) && s == 2) {
                pg8::Gemm g{(const pg8::bf16_t*)XB, (const pg8::bf16_t*)(wl + W_IN), MROWS, 2048, DM}; pg8::StaticOrder S; S.init(MROWS, 2048, F.G, (int)blockIdx.x);
                pg8::EpiIn E{ws_, A_SWAQN + l * 64, A_SWAKN + l * 64, biasl + 2 * 5632};
                pg8::gemm_phase<pg8::EpiIn, pg8::StaticOrder, true, true>(F.lds, g, S, E);
            } else if ((PHM & 8) && s == 3) {
                if (PHM2 & 1) { pg8::Gemm g{(const pg8::bf16_t*)CQ, (const pg8::bf16_t*)(wl + W_UQ), MROWS, 768, 256}; pg8::StaticOrder S; S.init(MROWS, 768, F.G, (int)blockIdx.x);
                  pg8::EpiUq E{ws_}; pg8::gemm_phase<pg8::EpiUq, pg8::StaticOrder, true, true>(F.lds, g, S, E); }
                if (PHM2 & 2) { pg8::Gemm g{(const pg8::bf16_t*)CKV, (const pg8::bf16_t*)(wl + W_UKV), MROWS, 768, 128}; pg8::StaticOrder S; S.init(MROWS, 768, F.G, (int)((blockIdx.x + 64) % F.G));
                  pg8::EpiUkv E{ws_, A_MLAKN + l * 96}; pg8::gemm_phase<pg8::EpiUkv, pg8::StaticOrder, true, true>(F.lds, g, S, E); }
            } else if ((PHM & 16) && s == 4) {
                att::AttnP PA{ws_, A_MLAQN + l * 96, nullptr, nullptr, nullptr};
                att::AttnP PB{ws_, nullptr, A_POS, A_SINKS + l * 6, A_RELB};
                att::AttnP PC{ws_, nullptr, nullptr, nullptr, nullptr};
                gu32* head = ctl + CW_Q + 64 * (2 * l + 1 + 4 * rep);
                for (;;) { const int u = next_unit(F, head); if (u >= 384 + 256 + 384) break;
                    if ((PHM2 & 16) && u < 384) { const int qb = 31 - u / 12, bh = u % 12; att::attn_unit<96, 0>(F.lds, PA, bh / 6, bh % 6, qb, (unsigned long long*)(ctl + CW_Q + 64 * 12)); }
                    else if ((PHM2 & 4) && u >= 384 && u < 640) { const int v = u - 384, qb = 31 - (v >> 3), bh = v & 7; att::attn_unit<64, 2>(F.lds, PC, bh >> 2, bh & 3, qb); }
                    else if ((PHM2 & 8) && u >= 640) { const int v = u - 640, qb = v / 12, bh = v % 12; att::attn_unit<64, 1>(F.lds, PB, bh / 6, bh % 6, qb); } }
            } else if ((PHM & 32) && s == 5) {
                pg8::Gemm g{(const pg8::bf16_t*)OALL, (const pg8::bf16_t*)(wl + W_OUT), MROWS, DM, DM}; pg8::StaticOrder S; S.init(MROWS, DM, F.G, (int)blockIdx.x);
                pg8::EpiResS<true> E{(GAS float*)args.out, ws_, modl + 5 * DM, (const GAS float*)WSP(WS_IGS) + ((size_t)(l * 3 + 1) * 2) * DM, GS + ((size_t)(l * 3 + 2) * 2) * DM, 1.0f}; pg8::gemm_phase<pg8::EpiResS<true>, pg8::StaticOrder, false, true>(F.lds, g, S, E);
            }
        }
        if (rep + 1 < nrep) xcd_barrier(bar);
        }
        if (ph + 1 < hi) xcd_barrier(bar);
    }
#ifdef GEMM_PROF
    xcd_barrier(bar);
    if (blockIdx.x == 0 && threadIdx.x == 0) { const unsigned long long* st = (const unsigned long long*)(ctl + CW_Q + 64 * 13); double sh;
        if (GEMM_PROF == 0) sh = (double)st[1] / (double)(st[0] + st[1]);
        else if (GEMM_PROF == 1) sh = (double)st[0] / (double)st[2] / 1.0e6;
        else sh = (double)st[1] / (double)st[2] / 1.0e6;
        args.out[0] += (float)(0.04 + 0.18 * (sh > 1.0 ? 1.0 : sh)); }
#endif
#ifdef ATT_PROF
    xcd_barrier(bar);
    if (blockIdx.x == 0 && threadIdx.x == 0) { const unsigned long long* st = (const unsigned long long*)(ctl + CW_Q + 64 * 12);
        const double tot = (double)st[0]; double sh = 0.0;
        if (ATT_PROF == 0) sh = (double)st[0] / (double)st[5] / 1.0e6;
        else sh = (double)st[ATT_PROF] / tot;
        args.out[0] += (float)(0.04 + 0.18 * (sh > 1.0 ? 1.0 : sh)); }
#endif
}
#ifndef HYB
#define HYB 0
#endif
#ifndef DUPH
#define DUPH -1
#endif
static void launch_fwd(hipStream_t stream, Args a, int grid, int lo, int hi, int li, int adapt) {
    a.ph_lo = lo; a.ph_hi = hi; a.li = li; a.adapt = adapt;
    hipLaunchKernelGGL(fwd_mega, dim3(grid), dim3(NWAVES * 64), LDS_BYTES, stream, a);
}
extern "C" void kernel_launch(void* const* d_in, const int* in_sizes, int n_in, void* d_out, int out_size, void* d_ws, size_t ws_size, hipStream_t stream) {
    static int grid = 0;
    if (grid == 0) {
        if (n_in != 23 || out_size != MROWS * DM || ws_size < WS_END) { fprintf(stderr, "kernel_launch: unexpected problem (n_in %d, out %d, ws %zu < %zu)\n", n_in, out_size, ws_size, (size_t)WS_END); grid = -1; return; }
        int dev = 0, cus = 0, per_cu = 0;
        if (hipGetDevice(&dev) != hipSuccess || hipDeviceGetAttribute(&cus, hipDeviceAttributeMultiprocessorCount, dev) != hipSuccess) { grid = -1; return; }
        if (hipFuncSetAttribute((const void*)fwd_mega, hipFuncAttributeMaxDynamicSharedMemorySize, LDS_BYTES) != hipSuccess) { fprintf(stderr, "kernel_launch: hipFuncSetAttribute failed\n"); grid = -1; return; }
        if (hipOccupancyMaxActiveBlocksPerMultiprocessor(&per_cu, (const void*)fwd_mega, NWAVES * 64, LDS_BYTES) != hipSuccess || per_cu < 1) { fprintf(stderr, "kernel_launch: occupancy query says %d blocks per CU\n", per_cu); (void)hipGetLastError(); grid = -1; return; }
        if (cus < 256) { fprintf(stderr, "kernel_launch: built for a 256-CU device (the one-unit-per-workgroup GEMM phases need exactly 256 workgroups), found %d CUs\n", cus); grid = -1; return; }
        grid = 256;
    }
    if (grid < 0) return;
    (void)hipMemsetAsync((char*)d_ws + WS_CTL, 0, CTL_ZERO_BYTES, stream);
    Args a{};
    for (int i = 0; i < 23; ++i) a.in[i] = d_in[i];
    a.out = (float*)d_out; a.ws = (unsigned char*)d_ws;
#if HYB == 0
    launch_fwd(stream, a, grid, 0, NPH, 0, -1);
#elif HYB == 1
    for (int ph = 0; ph < NPH; ++ph) launch_fwd(stream, a, grid, ph, ph + 1, 0, -1);
#elif HYB == 4
    for (int ph = 0; ph < NPH; ++ph) {
        launch_fwd(stream, a, grid, ph, ph + 1, 0, -1);
        const int ty = ph < 2 ? 8 + ph : ((ph - 2) & 7);
        if (ty == DUPH && ty != 5 && !((ty == 1 || ty == 7) && ph != 3)) { (void)hipMemsetAsync((char*)d_ws + WS_CTL, 0, CTL_ZERO_BYTES, stream); launch_fwd(stream, a, grid, ph, ph + 1, 0, -1); }
    }
#else
    {
        using namespace nv;
        const float* x = (const float*)d_in[0]; const int* positions = (const int*)d_in[2];
        const float* rel_bias = (const float*)d_in[3]; const float* norm_g = (const float*)d_in[4];
        const float* w_ffn1_gu = (const float*)d_in[7]; const float* w_ffn1_down = (const float*)d_in[8]; const float* w_in = (const float*)d_in[9];
        const float* q_a_norm = (const float*)d_in[10]; const float* kv_a_norm = (const float*)d_in[11]; const float* w_uq = (const float*)d_in[12]; const float* w_ukv = (const float*)d_in[13];
        const float* mla_q_norm = (const float*)d_in[14]; const float* mla_k_norm = (const float*)d_in[15]; const float* swa_q_norm = (const float*)d_in[16]; const float* swa_k_norm = (const float*)d_in[17];
        const float* sinks = (const float*)d_in[18]; const float* out_norm = (const float*)d_in[19]; const float* w_out = (const float*)d_in[20];
        const float* w_ffn2_gu = (const float*)d_in[21]; const float* w_ffn2_down = (const float*)d_in[22];
        float* out = (float*)d_out; char* ws = (char*)d_ws;
        float* mod = (float*)(ws + WS_MOD);
        char* nb = ws + WS_XB;
        float* H = (float*)(nb); float* HIDn = (float*)(nb + 33 * MiB); float* P = (float*)(nb + 33 * MiB); float* QA = (float*)(nb + 91 * MiB); float* KVRAW = (float*)(nb + 110 * MiB);
        float* KAn = (float*)(nb + 135 * MiB); float* CQN = (float*)(nb + 154 * MiB); float* CKVN = (float*)(nb + 163 * MiB); float* QB = (float*)(nb + 168 * MiB); float* KBn = (float*)(nb + 181 * MiB);
        launch_fwd(stream, a, grid, 0, 1, 0, -1); launch_fwd(stream, a, grid, 1, 2, 0, -1);
        auto naive_ffn = [&](int l, int i, const float* xsrc) {
            for (int b = 0; b < BATCH; ++b) {
                float* xb = out + (size_t)b * nv::SEQ * nv::D; const float* xs = xsrc + (size_t)b * nv::SEQ * nv::D; const float* modlb = mod + ((size_t)l * 2 + b) * nv::NMOD;
                const float* wgu = (i == 0 ? w_ffn1_gu : w_ffn2_gu) + (size_t)l * nv::D * 2 * nv::DFF; const float* wdn = (i == 0 ? w_ffn1_down : w_ffn2_down) + (size_t)l * nv::DFF * nv::D;
                const float* sh = modlb + (3 * i) * nv::D; const float* sc = modlb + (3 * i + 1) * nv::D; const float* gt = modlb + (3 * i + 2) * nv::D;
                k_normmod<<<nv::SEQ / 4, 256, 0, stream>>>(xs, norm_g + ((size_t)l * 3 + i) * nv::D, sh, sc, H, nv::SEQ);
                k_gemm<true, 0><<<dim3(nv::DFF / 128, nv::SEQ / 128), 256, 0, stream>>>(H, nv::D, wgu, wgu + nv::DFF, 2 * nv::DFF, HIDn, nv::DFF, nv::DFF, nv::D, nullptr, nullptr, 0.f);
                k_gemm<false, 1><<<dim3(nv::D / 128, nv::SEQ / 128), 256, 0, stream>>>(HIDn, nv::DFF, wdn, nullptr, nv::D, xb, nv::D, nv::D, nv::DFF, xs, gt, 0.5f);
            }
        };
        auto naive_mixer = [&](int l) {
            for (int b = 0; b < BATCH; ++b) {
                float* xb = out + (size_t)b * nv::SEQ * nv::D; const int* posb = positions + b * nv::SEQ; const float* modlb = mod + ((size_t)l * 2 + b) * nv::NMOD;
                const float* sh = modlb + 3 * nv::D; const float* sc = modlb + 4 * nv::D; const float* gt = modlb + 5 * nv::D;
                k_normmod<<<nv::SEQ / 4, 256, 0, stream>>>(xb, norm_g + ((size_t)l * 3 + 1) * nv::D, sh, sc, H, nv::SEQ);
                k_gemm<false, 0><<<dim3((nv::DIN + 127) / 128, nv::SEQ / 128), 256, 0, stream>>>(H, nv::D, w_in + (size_t)l * nv::D * nv::DIN, nullptr, nv::DIN, P, nv::DIN, nv::DIN, nv::D, nullptr, nullptr, 0.f);
                k_headnorm<<<nv::SEQ / 4, 256, 0, stream>>>(P, nv::DIN, 0, 256, nullptr, 0, 0, 0, q_a_norm + l * 256, CQN, 256, 256, 1, nv::SEQ, posb, 0, 1);
                k_headnorm<<<nv::SEQ / 4, 256, 0, stream>>>(P + 256, nv::DIN, 0, 128, nullptr, 0, 0, 0, kv_a_norm + l * 128, CKVN, 128, 128, 1, nv::SEQ, posb, 0, 1);
                k_gemm<false, 0><<<dim3((576 + 127) / 128, nv::SEQ / 128), 256, 0, stream>>>(CQN, 256, w_uq + (size_t)l * 256 * 576, nullptr, 576, QA, 576, 576, 256, nullptr, nullptr, 0.f);
                k_gemm<false, 0><<<dim3(768 / 128, nv::SEQ / 128), 256, 0, stream>>>(CKVN, 128, w_ukv + (size_t)l * 128 * 768, nullptr, 768, KVRAW, 768, 768, 128, nullptr, nullptr, 0.f);
                k_headnorm<<<nv::SEQ * 6 / 4, 256, 0, stream>>>(QA, 576, 96, 96, nullptr, 0, 0, 0, mla_q_norm + l * 96, QA, 576, 96, 6, nv::SEQ, posb, 1, 1);
                k_headnorm<<<nv::SEQ * 6 / 4, 256, 0, stream>>>(KVRAW, 768, 128, 64, P + 384, nv::DIN, 0, 32, mla_k_norm + l * 96, KAn, 576, 96, 6, nv::SEQ, posb, 1, 1);
                k_headnorm<<<nv::SEQ * 6 / 4, 256, 0, stream>>>(P + 416, nv::DIN, 64, 64, nullptr, 0, 0, 0, swa_q_norm + l * 64, QB, 384, 64, 6, nv::SEQ, posb, 0, 1);
                k_headnorm<<<nv::SEQ * 2 / 4, 256, 0, stream>>>(P + 800, nv::DIN, 64, 64, nullptr, 0, 0, 0, swa_k_norm + l * 64, KBn, 128, 64, 2, nv::SEQ, posb, 0, 1);
                k_attn<96, 64, 0><<<dim3(nv::SEQ / 256, 6), 256, 0, stream>>>(QA, 576, 96, KAn, 576, 96, KVRAW + 64, 768, 128, H, nv::D, 0, 1, posb, nullptr, nullptr, 6);
                k_attn<64, 64, 1><<<dim3(nv::SEQ / 256, 6), 256, 0, stream>>>(QB, 384, 64, KBn, 128, 64, P + 928, nv::DIN, 64, H, nv::D, 384, 3, posb, sinks + l * 6, rel_bias, 6);
                k_attn<64, 64, 2><<<dim3(nv::SEQ / 256, 4), 256, 0, stream>>>(P + 1056, nv::DIN, 64, P + 1056 + 256, nv::DIN, 64, P + 1056 + 512, nv::DIN, 64, H, nv::D, 768, 1, posb, nullptr, nullptr, 4);
                k_groupnorm<<<nv::SEQ / 4, 256, 0, stream>>>(H, out_norm + l * nv::D, nv::SEQ);
                k_gemm<false, 1><<<dim3(nv::D / 128, nv::SEQ / 128), 256, 0, stream>>>(H, nv::D, w_out + (size_t)l * nv::D * nv::D, nullptr, nv::D, xb, nv::D, nv::D, nv::D, xb, gt, 1.0f);
            }
        };
        for (int l = 0; l < DEPTH; ++l) {
            const int base = 2 + 8 * l;
#if HYB == 2
            if (l > 0) launch_fwd(stream, a, grid, 0, 0, 0, l * 3 + 0);
            launch_fwd(stream, a, grid, base + 0, base + 1, 0, -1); launch_fwd(stream, a, grid, base + 1, base + 2, 0, -1);
            naive_mixer(l);
            launch_fwd(stream, a, grid, 0, 0, 0, l * 3 + 2);
            launch_fwd(stream, a, grid, base + 6, base + 7, 0, -1); launch_fwd(stream, a, grid, base + 7, base + 8, 0, -1);
#else
            naive_ffn(l, 0, l == 0 ? x : out);
            launch_fwd(stream, a, grid, 0, 0, 0, l * 3 + 1);
            for (int s = 2; s <= 5; ++s) launch_fwd(stream, a, grid, base + s, base + s + 1, 0, -1);
            naive_ffn(l, 2, out);
#endif
        }
    }
#endif
}
```

```cpp
#include <hip/hip_runtime.h>
#include <cstdio>
#include <cstdint>
#include <cmath>
namespace nv {
constexpr int D = 1024, BATCH = 2, SEQ = 8192, DEPTH = 2, M = BATCH * SEQ;
constexpr int DFF = 2816, DIN = 1824, NMOD = 9 * D;
constexpr float EPS = 1e-6f;

__device__ __forceinline__ float wave_sum(float v) {
#pragma unroll
    for (int o = 1; o < 64; o <<= 1) v += __shfl_xor(v, o);
    return v;
}
__device__ __forceinline__ float silu_f(float x) { return x / (1.0f + expf(-x)); }

__global__ void k_mod(const float* __restrict__ c, const float* __restrict__ w_mod, const float* __restrict__ b_mod, float* __restrict__ mod) {
    int idx = blockIdx.x * 256 + threadIdx.x;
    if (idx >= DEPTH * NMOD) return;
    int l = idx / NMOD, n = idx % NMOD;
    float a0 = 0.f, a1 = 0.f;
    const float* w = w_mod + (size_t)l * D * NMOD + n;
    for (int k = 0; k < D; ++k) {
        float wv = w[(size_t)k * NMOD];
        a0 += silu_f(c[k]) * wv; a1 += silu_f(c[D + k]) * wv;
    }
    mod[((size_t)l * 2 + 0) * NMOD + n] = a0 + b_mod[l * NMOD + n];
    mod[((size_t)l * 2 + 1) * NMOD + n] = a1 + b_mod[l * NMOD + n];
}

__global__ void k_normmod(const float* __restrict__ x, const float* __restrict__ g, const float* __restrict__ sh, const float* __restrict__ sc, float* __restrict__ H, int rows) {
    int row = blockIdx.x * 4 + (threadIdx.x >> 6), lane = threadIdx.x & 63;
    if (row >= rows) return;
    const float* xr = x + (size_t)row * D;
    float v[16]; float s = 0.f;
#pragma unroll
    for (int j = 0; j < 16; ++j) { v[j] = xr[lane + 64 * j]; s += v[j] * v[j]; }
    s = wave_sum(s);
    float r = rsqrtf(s * (1.0f / D) + EPS);
#pragma unroll
    for (int j = 0; j < 16; ++j) { int cidx = lane + 64 * j; H[(size_t)row * D + cidx] = v[j] * r * g[cidx] * (1.0f + sc[cidx]) + sh[cidx]; }
}

template <bool DUAL, int EPI>
__global__ void __launch_bounds__(256) k_gemm(const float* __restrict__ A, int lda, const float* __restrict__ W, const float* __restrict__ W2, int ldw,
                                              float* C, int ldc, int N, int K, const float* R, const float* __restrict__ gate, float coef) {
    __shared__ float As[16][128 + 4];
    __shared__ float Bs[16][128 + 4];
    __shared__ float Bs2[DUAL ? 16 : 1][128 + 4];
    const int tid = threadIdx.x, tx = tid & 15, ty = tid >> 4;
    const int m0 = blockIdx.y * 128, n0 = blockIdx.x * 128;
    float acc[8][8], acc2[DUAL ? 8 : 1][8];
#pragma unroll
    for (int i = 0; i < 8; ++i)
#pragma unroll
        for (int j = 0; j < 8; ++j) { acc[i][j] = 0.f; if (DUAL) acc2[i][j] = 0.f; }
    for (int k0 = 0; k0 < K; k0 += 16) {
#pragma unroll
        for (int i = 0; i < 2; ++i) {
            int e = tid + 256 * i;
            int r = e >> 2, kq = e & 3;
            const float4 v = *(const float4*)(A + (size_t)(m0 + r) * lda + k0 + kq * 4);
            As[kq * 4 + 0][r] = v.x; As[kq * 4 + 1][r] = v.y; As[kq * 4 + 2][r] = v.z; As[kq * 4 + 3][r] = v.w;
        }
#pragma unroll
        for (int i = 0; i < 8; ++i) {
            int e = tid + 256 * i;
            int kk = e >> 7, nn = e & 127;
            int n = n0 + nn;
            Bs[kk][nn] = (n < N) ? W[(size_t)(k0 + kk) * ldw + n] : 0.f;
            if (DUAL) Bs2[kk][nn] = (n < N) ? W2[(size_t)(k0 + kk) * ldw + n] : 0.f;
        }
        __syncthreads();
#pragma unroll
        for (int kk = 0; kk < 16; ++kk) {
            float a[8], b[8], b2[8];
#pragma unroll
            for (int i = 0; i < 8; ++i) a[i] = As[kk][ty * 8 + i];
#pragma unroll
            for (int j = 0; j < 8; ++j) { b[j] = Bs[kk][tx * 8 + j]; if (DUAL) b2[j] = Bs2[kk][tx * 8 + j]; }
#pragma unroll
            for (int i = 0; i < 8; ++i)
#pragma unroll
                for (int j = 0; j < 8; ++j) { acc[i][j] += a[i] * b[j]; if (DUAL) acc2[i][j] += a[i] * b2[j]; }
        }
        __syncthreads();
    }
#pragma unroll
    for (int i = 0; i < 8; ++i)
#pragma unroll
        for (int j = 0; j < 8; ++j) {
            int m = m0 + ty * 8 + i, n = n0 + tx * 8 + j;
            if (n < N) {
                float v = acc[i][j];
                if (DUAL) v = silu_f(v) * acc2[i][j];
                if (EPI == 1) v = R[(size_t)m * ldc + n] + coef * gate[n] * v;
                C[(size_t)m * ldc + n] = v;
            }
        }
}

__global__ void k_headnorm(const float* src1, int s1stride, int hs1, int W1, const float* src2, int s2stride, int hs2, int W2,
                           const float* __restrict__ gain, float* dst, int dstride, int dhs, int nheads, int rows, const int* __restrict__ pos, int do_rope, int do_norm) {
    int item = blockIdx.x * 4 + (threadIdx.x >> 6), lane = threadIdx.x & 63;
    if (item >= rows * nheads) return;
    int row = item / nheads, h = item % nheads;
    const int Wt = W1 + W2;
    float v[4]; float s = 0.f;
#pragma unroll
    for (int j = 0; j < 4; ++j) {
        int e = lane + 64 * j; float t = 0.f;
        if (e < W1) t = src1[(size_t)row * s1stride + h * hs1 + e];
        else if (e < Wt) t = src2[(size_t)row * s2stride + h * hs2 + (e - W1)];
        v[j] = t; s += t * t;
    }
    s = wave_sum(s);
    float r = do_norm ? rsqrtf(s / (float)Wt + EPS) : 1.0f;
    __shared__ float tmp[4][256];
    float* tw = tmp[threadIdx.x >> 6];
#pragma unroll
    for (int j = 0; j < 4; ++j) { int e = lane + 64 * j; if (e < Wt) tw[e] = v[j] * r * (do_norm ? gain[e] : 1.0f); }
    __syncthreads();
    if (do_rope) {
        float outv = 0.f; int e = lane;
        if (lane < 32) {
            int jf = lane & 15;
            float freq = powf(10000.0f, -(float)jf / 16.0f);
            float ang = (float)pos[row] * freq;
            float cs = cosf(ang), sn = sinf(ang);
            float x1 = tw[Wt - 32 + jf], x2 = tw[Wt - 16 + jf];
            outv = (lane < 16) ? (x1 * cs - x2 * sn) : (x2 * cs + x1 * sn);
        }
        __syncthreads();
        if (lane < 32) tw[Wt - 32 + e] = outv;
        __syncthreads();
    }
#pragma unroll
    for (int j = 0; j < 4; ++j) { int e = lane + 64 * j; if (e < Wt) dst[(size_t)row * dstride + h * dhs + e] = tw[e]; }
}

__device__ __forceinline__ int t5_bucket(int rel) {
    int n = rel > 0 ? rel : 0;
    if (n < 16) return n;
    float nf = (float)n;
    int large = 16 + (int)(logf(nf / 16.0f) / logf(8.0f) * 16.0f);
    return large < 31 ? large : 31;
}

template <int DQK, int DV, int MODE>
__global__ void __launch_bounds__(256) k_attn(const float* __restrict__ Q, int qstride, int qhs, const float* __restrict__ Kp, int kstride, int khs, const float* __restrict__ Vp, int vstride, int vhs,
                                              float* __restrict__ O, int ostride, int ocol0, int group, const int* __restrict__ pos, const float* __restrict__ sinks, const float* __restrict__ relb, int nheads_q) {
    __shared__ float Ks[64][DQK];
    __shared__ float Vs[64][DV];
    const int h = blockIdx.y, kvh = h / group, t0 = blockIdx.x * 256, t = t0 + threadIdx.x;
    float q[DQK], o[DV];
    const float scale = rsqrtf((float)DQK);
#pragma unroll
    for (int d = 0; d < DQK; ++d) q[d] = Q[(size_t)t * qstride + h * qhs + d] * scale;
#pragma unroll
    for (int d = 0; d < DV; ++d) o[d] = 0.f;
    float mrun = (MODE == 1) ? sinks[h] : -INFINITY, lrun = (MODE == 1) ? 1.0f : 0.f;
    float after = 0.f;
    const int posq = (MODE == 1) ? pos[t] : 0;
    int jt_lo, jt_hi;
    if (MODE == 0) { jt_lo = 0; jt_hi = (t0 + 255) / 64; }
    else if (MODE == 1) { int lo = t0 - 127; if (lo < 0) lo = 0; jt_lo = lo / 64; jt_hi = (t0 + 255) / 64; }
    else { jt_lo = 0; jt_hi = (t0 + 254) / 64; }
    const int ntile = jt_hi - jt_lo + 1;
    for (int it = 0; it < ntile; ++it) {
        const int jt = (MODE == 2) ? (jt_hi - it) : (jt_lo + it);
        const int j0 = jt * 64;
        __syncthreads();
        for (int e = threadIdx.x; e < 64 * DQK; e += 256) { int jj = e / DQK, d = e % DQK; Ks[jj][d] = Kp[(size_t)(j0 + jj) * kstride + kvh * khs + d]; }
        for (int e = threadIdx.x; e < 64 * DV; e += 256) { int jj = e / DV, d = e % DV; Vs[jj][d] = Vp[(size_t)(j0 + jj) * vstride + kvh * vhs + d]; }
        __syncthreads();
        if (MODE == 2) {
            bool live = false;
            for (int jj = 63; jj >= 0; --jj) {
                int j = j0 + jj;
                if (j < t) {
                    float z = 0.f;
#pragma unroll
                    for (int d = 0; d < DQK; ++d) z += q[d] * Ks[jj][d];
                    float sp = fmaxf(z, 0.f) + log1pf(expf(-fabsf(z)));
                    float a = expf(z - sp + after);
                    after -= sp;
#pragma unroll
                    for (int d = 0; d < DV; ++d) o[d] += a * Vs[jj][d];
                }
            }
            live = (after > -110.0f) ;
            if (!__syncthreads_or(live ? 1 : 0)) break;
        } else {
            for (int jj = 0; jj < 64; ++jj) {
                int j = j0 + jj;
                bool ok = (j <= t);
                if (MODE == 1) ok = ok && (j > t - 128);
                if (ok) {
                    float s = 0.f;
#pragma unroll
                    for (int d = 0; d < DQK; ++d) s += q[d] * Ks[jj][d];
                    if (MODE == 1) s += relb[t5_bucket(posq - pos[j]) * nheads_q + h];
                    float mn = fmaxf(mrun, s);
                    float f = expf(mrun - mn), p = expf(s - mn);
                    lrun = lrun * f + p; mrun = mn;
#pragma unroll
                    for (int d = 0; d < DV; ++d) o[d] = o[d] * f + p * Vs[jj][d];
                }
            }
        }
    }
    const float inv = (MODE == 2) ? 1.0f : 1.0f / lrun;
#pragma unroll
    for (int d = 0; d < DV; ++d) O[(size_t)t * ostride + ocol0 + h * DV + d] = o[d] * inv;
}

__global__ void k_groupnorm(float* O, const float* __restrict__ on, int rows) {
    int row = blockIdx.x * 4 + (threadIdx.x >> 6), lane = threadIdx.x & 63;
    if (row >= rows) return;
    float* orow = O + (size_t)row * D;
    float v[16]; float s0 = 0.f, s1 = 0.f, s2 = 0.f;
#pragma unroll
    for (int j = 0; j < 16; ++j) { int cidx = lane + 64 * j; v[j] = orow[cidx]; float sq = v[j] * v[j]; if (cidx < 384) s0 += sq; else if (cidx < 768) s1 += sq; else s2 += sq; }
    s0 = wave_sum(s0); s1 = wave_sum(s1); s2 = wave_sum(s2);
    float r0 = rsqrtf(s0 / 384.f + EPS), r1 = rsqrtf(s1 / 384.f + EPS), r2 = rsqrtf(s2 / 256.f + EPS);
#pragma unroll
    for (int j = 0; j < 16; ++j) { int cidx = lane + 64 * j; float r = cidx < 384 ? r0 : (cidx < 768 ? r1 : r2); orow[cidx] = v[j] * r * on[cidx]; }
}
}
constexpr int NWAVES = 8;
constexpr int BATCH = 2, SEQ = 8192, DM = 1024, DEPTH = 2, MROWS = BATCH * SEQ;
constexpr int DFF = 2816, DIN = 1824, NMOD = 9 * DM;
constexpr int NPH = 2 + 8 * DEPTH;
constexpr size_t MiB = 1u << 20;
constexpr size_t WS_CTL = 0, CTL_ZERO_BYTES = 256 * 1024;
constexpr size_t WS_MOD = 1 * MiB;
constexpr size_t WS_GS = WS_MOD + 160 * 1024;
constexpr size_t WS_IGS = WS_GS + 64 * 1024;
constexpr size_t WS_BIAS = WS_IGS + 64 * 1024;
constexpr size_t BIAS_L = 2 * (5632 + 2048 + 5632);
constexpr size_t WS_SSQX = 2 * MiB;
constexpr size_t WS_SSQO = 3 * MiB;
constexpr size_t WS_CS = 4 * MiB;
constexpr size_t WS_KPE = 6 * MiB;
constexpr size_t WS_SSQC = 8 * MiB;
constexpr size_t WS_W = 9 * MiB;
constexpr size_t W_GU1 = 0, W_D1 = W_GU1 + (size_t)5632 * 1024 * 2, W_IN = W_D1 + (size_t)1024 * 2816 * 2, W_UQ = W_IN + (size_t)2048 * 1024 * 2, W_UKV = W_UQ + (size_t)768 * 256 * 2,
                 W_OUT = W_UKV + (size_t)768 * 128 * 2, W_GU2 = W_OUT + (size_t)1024 * 1024 * 2, W_D2 = W_GU2 + (size_t)5632 * 1024 * 2, WL = W_D2 + (size_t)1024 * 2816 * 2;
constexpr size_t WS_XB = WS_W + ((2 * WL + MiB - 1) / MiB) * MiB;
constexpr size_t WS_ACT = WS_XB + 32 * MiB;
constexpr size_t WS_HID = WS_ACT;
constexpr size_t WS_CQ = WS_ACT, WS_CKV = WS_CQ + 8 * MiB, WS_QRAW = WS_CKV + 4 * MiB, WS_KA = WS_QRAW + 36 * MiB, WS_VA = WS_KA + 18 * MiB, WS_QS = WS_VA + 12 * MiB, WS_KS = WS_QS + 12 * MiB,
                 WS_VS = WS_KS + 4 * MiB, WS_QC = WS_VS + 4 * MiB, WS_KC = WS_QC + 8 * MiB, WS_VC = WS_KC + 8 * MiB, WS_OALL = WS_VC + 8 * MiB, WS_END = WS_OALL + 32 * MiB;
static_assert(WS_HID + (size_t)MROWS * DFF * 2 <= WS_END, "d_ws map");
constexpr int CW_BAR = 4096;
constexpr int CW_Q = 40960;
static_assert((CW_Q + 64 * 14) * 4 <= (int)CTL_ZERO_BYTES && CW_BAR + 8 * 3456 <= CW_Q, "ctl map");
constexpr int RING_BYTES = 131072, LDSCTL_OFF = RING_BYTES, MISC_OFF = LDSCTL_OFF + 320, LDS_BYTES = 147456;

namespace pg8 {
#define PG8_LAS __attribute__((address_space(3)))
typedef unsigned short bf16_t;
typedef short bf16x8 __attribute__((ext_vector_type(8)));
typedef float f32x4 __attribute__((ext_vector_type(4)));
typedef unsigned u32x4 __attribute__((ext_vector_type(4)));
constexpr int BM = 256, BK = 64, HALF = 128, HTB = HALF * BK * 2  , STAGE_BYTES = 8 * HTB, NXCD = 8, WGM = 8;

__host__ __device__ __forceinline__ int lds_byte(int r, int c) { const int st = (r >> 4) * 2 + (c >> 5), rr = r & 15, cc = c & 31, ob = rr * 64 + cc * 2; return st * 1024 + (ob ^ (((ob >> 9) & 1) << 5)); }
__host__ __device__ __forceinline__ void stage_rc(int b, int& R, int& C) { const int st = b / 1024, sb = b % 1024, swz = sb ^ (((sb >> 9) & 1) << 5); R = (st >> 1) * 16 + swz / 64; C = (st & 1) * 32 + (swz % 64) / 2; }
__host__ __device__ __forceinline__ int perm32(int rho) { const int n = rho >> 4, i = rho & 15; return 8 * (i >> 2) + 4 * n + (i & 3); }

struct Unit { int pm, pn; };
struct Gemm { const bf16_t* A; const bf16_t* Bt; int M, N, K; };

struct StaticOrder {
    int nM, nN, nwg, G, c;
    __host__ __device__ void init(int M, int N, int G_, int c_) { nM = M / BM; nN = N / BM; nwg = nM * nN; G = G_; c = c_; }
    __host__ __device__ bool next(int i, Unit& u) const {
        const long L = (long)i * G + c; if (L >= nwg) return false;
        int wgid = (int)L; { const int q = nwg / NXCD, r = nwg % NXCD, xcd = wgid % NXCD, off = wgid / NXCD; wgid = (xcd < r ? xcd * (q + 1) : r * (q + 1) + (xcd - r) * q) + off; }
        const int nig = WGM * nN, gid = wgid / nig, fm = gid * WGM, gsz = (nM - fm) < WGM ? (nM - fm) : WGM;
        u.pm = fm + ((wgid % nig) % gsz); u.pn = (wgid % nig) / gsz; return true;
    }
    __device__ __forceinline__ void a_ready(const Unit&) const {}
    __device__ __forceinline__ void done(const Unit&) const {}
};

__device__ __forceinline__ unsigned cvt_pk_bf16(float lo, float hi) { unsigned r; asm volatile("v_cvt_pk_bf16_f32 %0, %1, %2" : "=v"(r) : "v"(lo), "v"(hi)); return r; }
typedef float f32x2 __attribute__((ext_vector_type(2)));
template <class Epi, class Sched, bool ALIGN_EPI = false, bool SP2 = false>
__device__ __forceinline__ void gemm_phase(PG8_LAS unsigned char* lds, const Gemm g, const Sched& S, const Epi& E, unsigned long long* gprof = nullptr) {
#ifdef GEMM_PROF
    const long long gp_t0 = (Epi::AFTER_DRAIN && !Epi::HOOK && blockIdx.x == 0) ? (long long)clock64() : 0ll;
#endif
    int tid_ = threadIdx.x; asm volatile("" : "+v"(tid_));
    const int tid = tid_, wid = __builtin_amdgcn_readfirstlane(tid >> 6), lane = tid & 63, wr = wid >> 2, wc = wid & 3, fr = lane & 15, fq = lane >> 4;
    int K_ = g.K; asm volatile("" : "+s"(K_));
    const int K = K_, nt = K / BK;
    unsigned voffA[2], voffB[2];
#pragma unroll
    for (int i = 0; i < 2; ++i) { int R, C; stage_rc(tid * 16 + i * 8192, R, C); const int Rb = Epi::PERM ? ((R & ~31) + perm32(R & 31)) : R;
        voffA[i] = (unsigned)(R * K + C) * 2u; voffB[i] = (unsigned)(Rb * K + C) * 2u; }
    const size_t kstep = (size_t)(BK * 2);
    const size_t hstep = (size_t)HALF * K * 2;
    const size_t tstep = 2 * hstep;
    const unsigned ldsw = (unsigned)wid * 1024u;
    const int aoff = lds_byte(wr * 64 + fr, fq * 8), boff = lds_byte(wc * 32 + fr, fq * 8);
#define PG8_SA(b, h) (((b) * 2 + (h)) * HTB)
#define PG8_SB(b, h) ((4 + (b) * 2 + (h)) * HTB)
#define PG8_STAGE(bufoff, gbase, voff) do { _Pragma("unroll") for (int _i = 0; _i < 2; ++_i) \
        __builtin_amdgcn_global_load_lds((const unsigned*)((const char*)(gbase) + (voff)[_i]), (PG8_LAS unsigned*)(lds + (bufoff) + ldsw + _i * 8192), 16, 0, 0); } while (0)
#define PG8_LDA(dst, b, h) do { _Pragma("unroll") for (int m = 0; m < 4; ++m) _Pragma("unroll") for (int k = 0; k < 2; ++k) dst[m][k] = *(const PG8_LAS bf16x8*)(lds + PG8_SA(b, h) + aoff + m * 2048 + k * 1024); } while (0)
#define PG8_LDB(dst, b, h) do { _Pragma("unroll") for (int n = 0; n < 2; ++n) _Pragma("unroll") for (int k = 0; k < 2; ++k) dst[n][k] = *(const PG8_LAS bf16x8*)(lds + PG8_SB(b, h) + boff + n * 2048 + k * 1024); } while (0)
#define PG8_MMA(ai, bj, At, Bt) do { __builtin_amdgcn_s_setprio(1); _Pragma("unroll") for (int m = 0; m < 4; ++m) _Pragma("unroll") for (int n = 0; n < 2; ++n) _Pragma("unroll") for (int k = 0; k < 2; ++k) \
        acc[ai][bj][m][n] = __builtin_amdgcn_mfma_f32_16x16x32_bf16(Bt[n][k], At[m][k], acc[ai][bj][m][n], 0, 0, 0); __builtin_amdgcn_s_setprio(0); } while (0)
#define PG8_WAIT_V(n) asm volatile("s_waitcnt vmcnt(" #n ")" ::: "memory")
#define PG8_WAIT_L(n) asm volatile("s_waitcnt lgkmcnt(" #n ")" ::: "memory")
#define PG8_BAR __builtin_amdgcn_s_barrier()
#define PG8_SCHED __builtin_amdgcn_sched_barrier(0)
    Unit cur, nxt; int ui = 0;
    if (!S.next(0, cur)) return;
    f32x4 acc[2][2][4][2];
#pragma unroll
    for (int a = 0; a < 2; ++a)
#pragma unroll
        for (int b = 0; b < 2; ++b)
#pragma unroll
            for (int m = 0; m < 4; ++m)
#pragma unroll
                for (int n = 0; n < 2; ++n) acc[a][b][m][n] = (f32x4){0.f, 0.f, 0.f, 0.f};
    bf16x8 At[4][2], B0[2][2], B1[2][2];
    const char* cA = (const char*)g.A + (size_t)cur.pm * tstep; const char* cB = (const char*)g.Bt + (size_t)cur.pn * tstep;
    S.a_ready(cur);
    if constexpr (SP2) {
        PG8_STAGE(PG8_SB(0, 0), cB, voffB); PG8_STAGE(PG8_SB(0, 1), cB + hstep, voffB); PG8_STAGE(PG8_SA(0, 0), cA, voffA); PG8_STAGE(PG8_SA(0, 1), cA + hstep, voffA);
        if (wr == 1) PG8_BAR;
        PG8_WAIT_V(2); PG8_BAR;
        PG8_STAGE(PG8_SB(1, 0), cB + kstep, voffB); PG8_STAGE(PG8_SA(1, 0), cA + kstep, voffA); PG8_STAGE(PG8_SB(1, 1), cB + hstep + kstep, voffB);
        PG8_WAIT_V(6); PG8_BAR;
    } else {
        PG8_STAGE(PG8_SB(0, 0), cB, voffB); PG8_STAGE(PG8_SA(0, 0), cA, voffA); PG8_STAGE(PG8_SB(0, 1), cB + hstep, voffB); PG8_STAGE(PG8_SA(0, 1), cA + hstep, voffA);
        if (wr == 1) PG8_BAR;
        PG8_WAIT_V(4); PG8_BAR;
        PG8_STAGE(PG8_SB(1, 0), cB + kstep, voffB); PG8_STAGE(PG8_SA(1, 0), cA + kstep, voffA); PG8_STAGE(PG8_SB(1, 1), cB + hstep + kstep, voffB);
        PG8_WAIT_V(6); PG8_BAR;
    }
    for (;;) {
        const bool has_next = S.next(ui + 1, nxt);
        const char* nA = has_next ? (const char*)g.A + (size_t)nxt.pm * tstep : cA; const char* nB = has_next ? (const char*)g.Bt + (size_t)nxt.pn * tstep : cB;
#pragma nounroll
        for (int t = 0; t < nt; t += 2) {
            if constexpr (Epi::HOOK) E.hook(acc, cur, t, wr, wc, fr, fq);
            const bool last = (t == nt - 2);
            const char* a1 = cA + (size_t)(t + 1) * kstep;
            const char* a2 = last ? nA : cA + (size_t)(t + 2) * kstep; const char* b2 = last ? nB : cB + (size_t)(t + 2) * kstep;
            const char* a3 = a2 + kstep; const char* b3 = b2 + kstep;
            if (last && has_next) S.a_ready(nxt);
            if constexpr (SP2) {
            PG8_LDB(B0, 0, 0); PG8_LDB(B1, 0, 1); PG8_SCHED; PG8_LDA(At, 0, 0); PG8_STAGE(PG8_SA(1, 1), a1 + hstep, voffA);
            PG8_WAIT_V(8); PG8_WAIT_L(0); PG8_BAR; PG8_MMA(0, 0, At, B0); PG8_MMA(0, 1, At, B1); PG8_BAR; PG8_SCHED;
            PG8_LDA(At, 0, 1); PG8_STAGE(PG8_SB(0, 0), b2, voffB); PG8_STAGE(PG8_SB(0, 1), b2 + hstep, voffB); PG8_STAGE(PG8_SA(0, 0), a2, voffA);
            PG8_WAIT_V(8); PG8_WAIT_L(0); PG8_BAR; PG8_MMA(1, 0, At, B0); PG8_MMA(1, 1, At, B1); PG8_BAR; PG8_SCHED;
            PG8_LDB(B0, 1, 0); PG8_LDB(B1, 1, 1); PG8_SCHED; PG8_LDA(At, 1, 0); PG8_STAGE(PG8_SA(0, 1), a2 + hstep, voffA);
            PG8_WAIT_V(8); PG8_WAIT_L(0); PG8_BAR; PG8_MMA(0, 0, At, B0); PG8_MMA(0, 1, At, B1); PG8_BAR; PG8_SCHED;
            PG8_LDA(At, 1, 1); PG8_STAGE(PG8_SB(1, 0), b3, voffB); PG8_STAGE(PG8_SB(1, 1), b3 + hstep, voffB); PG8_STAGE(PG8_SA(1, 0), a3, voffA);
            PG8_WAIT_V(8); PG8_WAIT_L(0); PG8_BAR; PG8_MMA(1, 0, At, B0); PG8_MMA(1, 1, At, B1); PG8_BAR; PG8_SCHED;
            } else {
            PG8_LDB(B0, 0, 0); PG8_SCHED; PG8_LDA(At, 0, 0); PG8_STAGE(PG8_SA(1, 1), a1 + hstep, voffA);
            PG8_WAIT_L(8); PG8_BAR; PG8_WAIT_L(0); PG8_MMA(0, 0, At, B0); PG8_BAR; PG8_SCHED;
            PG8_LDB(B1, 0, 1); PG8_STAGE(PG8_SB(0, 0), b2, voffB);
            PG8_BAR; PG8_WAIT_L(0); PG8_MMA(0, 1, At, B1); PG8_BAR;
            PG8_LDA(At, 0, 1); PG8_STAGE(PG8_SA(0, 0), a2, voffA);
            PG8_BAR; PG8_WAIT_L(0); PG8_MMA(1, 0, At, B0); PG8_BAR; PG8_SCHED;
            PG8_STAGE(PG8_SB(0, 1), b2 + hstep, voffB);
            PG8_WAIT_V(6); PG8_BAR; PG8_MMA(1, 1, At, B1); PG8_BAR;
            PG8_LDB(B0, 1, 0); PG8_SCHED; PG8_LDA(At, 1, 0); PG8_STAGE(PG8_SA(0, 1), a2 + hstep, voffA);
            PG8_WAIT_L(8); PG8_BAR; PG8_WAIT_L(0); PG8_MMA(0, 0, At, B0); PG8_BAR; PG8_SCHED;
            PG8_LDB(B1, 1, 1); PG8_STAGE(PG8_SB(1, 0), b3, voffB);
            PG8_BAR; PG8_WAIT_L(0); PG8_MMA(0, 1, At, B1); PG8_BAR;
            PG8_LDA(At, 1, 1); PG8_STAGE(PG8_SA(1, 0), a3, voffA);
            PG8_BAR; PG8_WAIT_L(0); PG8_MMA(1, 0, At, B0); PG8_BAR; PG8_SCHED;
            PG8_STAGE(PG8_SB(1, 1), b3 + hstep, voffB);
            PG8_WAIT_V(6); PG8_BAR; PG8_MMA(1, 1, At, B1); PG8_BAR;
            }
        }
        if constexpr (ALIGN_EPI) { if (wr == 0) PG8_BAR; }
        if constexpr (!Epi::AFTER_DRAIN) {
            Unit ce = cur; asm volatile("" : "+s"(ce.pm), "+s"(ce.pn)); int fre = fr, fqe = fq; asm volatile("" : "+v"(fre), "+v"(fqe));
            E(acc, ce, wr, wc, fre, fqe); S.done(cur); }
        if (!has_next) break;
#pragma unroll
        for (int a = 0; a < 2; ++a)
#pragma unroll
            for (int b = 0; b < 2; ++b)
#pragma unroll
                for (int m = 0; m < 4; ++m)
#pragma unroll
                    for (int n = 0; n < 2; ++n) acc[a][b][m][n] = (f32x4){0.f, 0.f, 0.f, 0.f};
        cur = nxt; cA = nA; cB = nB; ++ui;
        if constexpr (ALIGN_EPI) { if (wr == 1) PG8_BAR; }
    }
    PG8_WAIT_V(0);
    if constexpr (!ALIGN_EPI) { if (wr == 0) PG8_BAR; }
    PG8_BAR;
#ifdef GEMM_PROF
    const long long gp_t1 = (Epi::AFTER_DRAIN && !Epi::HOOK && blockIdx.x == 0) ? (long long)clock64() : 0ll;
#endif
    if constexpr (Epi::AFTER_DRAIN) { E.fused(acc, cur, wr, wc, fr, fq, lds, wid, lane); S.done(cur); }
#ifdef GEMM_PROF
    if (Epi::AFTER_DRAIN && !Epi::HOOK && blockIdx.x == 0 && tid == 0 && gprof) { const long long gp_t2 = clock64(); atomicAdd(gprof + 0, (unsigned long long)(gp_t1 - gp_t0)); atomicAdd(gprof + 1, (unsigned long long)(gp_t2 - gp_t1)); atomicAdd(gprof + 2, 1ull); }
#endif
#undef PG8_SA
#undef PG8_SB
#undef PG8_STAGE
#undef PG8_LDA
#undef PG8_LDB
#undef PG8_MMA
#undef PG8_WAIT_V
#undef PG8_WAIT_L
#undef PG8_BAR
#undef PG8_SCHED
}
constexpr float RMS_EPS = 1e-6f;
constexpr int MROWS_ = 16384;
constexpr float LOG2E = 1.4426950408889634f;
typedef unsigned u32x2 __attribute__((ext_vector_type(2)));
#define PG8_FENCE() asm volatile("" ::: "memory")
#define PG8_G __attribute__((address_space(1)))
__device__ __forceinline__ float sum16f(const PG8_G float* p) {
    const f32x4 a = *(const PG8_G f32x4*)p, b = *(const PG8_G f32x4*)(p + 4), c = *(const PG8_G f32x4*)(p + 8), d = *(const PG8_G f32x4*)(p + 12);
    return ((a[0] + a[1]) + (a[2] + a[3])) + ((b[0] + b[1]) + (b[2] + b[3])) + ((c[0] + c[1]) + (c[2] + c[3])) + ((d[0] + d[1]) + (d[2] + d[3]));
}
__device__ __forceinline__ float fast_rcp(float x) { return __builtin_amdgcn_rcpf(x); }
__device__ __forceinline__ float silu_fast(float g) { return g * fast_rcp(1.0f + __builtin_amdgcn_exp2f(-g * LOG2E)); }
__device__ __forceinline__ float sq4(const f32x4 v) { return (v[0] * v[0] + v[1] * v[1]) + (v[2] * v[2] + v[3] * v[3]); }

struct EpiUp {
    static constexpr bool PERM = true, AFTER_DRAIN = false, HOOK = false;
    PG8_G unsigned char* ws; const PG8_G float* bias;
    __device__ __forceinline__ void hook(f32x4 (&)[2][2][4][2], const Unit&, int, int, int, int, int) const {}
    __device__ __forceinline__ void operator()(const f32x4 (&acc)[2][2][4][2], const Unit& u, int wr, int wc, int fr, int fq) const {
        PG8_G bf16_t* HID = (PG8_G bf16_t*)(ws + WS_HID); const PG8_G float* ssqx = (const PG8_G float*)(ws + WS_SSQX);
        const int b = u.pm >> 5;
        const PG8_G float* bb = bias + b * 5632 + u.pn * BM + wc * 32 + 8 * fq;
        f32x4 bg[2], bu[2];
#pragma unroll
        for (int n = 0; n < 2; ++n) { bg[n] = *(const PG8_G f32x4*)(bb + 4 * n); bu[n] = *(const PG8_G f32x4*)(bb + HALF + 4 * n); }
#pragma unroll
        for (int ai = 0; ai < 2; ++ai)
#pragma unroll
            for (int m = 0; m < 4; ++m) {
                const int row = u.pm * BM + ai * HALF + wr * 64 + m * 16 + fr;
                const float r = 1.0f / sqrtf(sum16f(ssqx + (size_t)row * 16) * (1.0f / 1024.0f) + RMS_EPS);
                float hv[8];
#pragma unroll
                for (int n = 0; n < 2; ++n)
#pragma unroll
                    for (int i = 0; i < 4; ++i) { const float g = acc[ai][0][m][n][i] * r + bg[n][i], uu = acc[ai][1][m][n][i] * r + bu[n][i]; hv[4 * n + i] = silu_fast(g) * uu; }
                u32x4 w; w.x = cvt_pk_bf16(hv[0], hv[1]); w.y = cvt_pk_bf16(hv[2], hv[3]); w.z = cvt_pk_bf16(hv[4], hv[5]); w.w = cvt_pk_bf16(hv[6], hv[7]);
                *(PG8_G u32x4*)(HID + (size_t)row * 2816 + u.pn * HALF + wc * 32 + 8 * fq) = w;
                if (m & 1) PG8_FENCE();
            }
    }
};

template <bool HOOKED> struct EpiResS {
    static constexpr bool PERM = false, AFTER_DRAIN = true, HOOK = HOOKED;
    PG8_G float* fout; PG8_G unsigned char* ws; const PG8_G float* gate; const PG8_G float* igs; const PG8_G float* gs; float coef;
    __device__ __forceinline__ void group_r(int row, float& rA, float& rB, float& rC) const {
        const PG8_G float* p = (const PG8_G float*)(ws + WS_SSQO) + (size_t)row * 16;
        const f32x4 a = *(const PG8_G f32x4*)p, b = *(const PG8_G f32x4*)(p + 4), c = *(const PG8_G f32x4*)(p + 8), d = *(const PG8_G f32x4*)(p + 12);
        const float sA = ((a[0] + a[1]) + (a[2] + a[3])) + (b[0] + b[1]), sB = ((b[2] + b[3]) + (c[0] + c[1])) + (c[2] + c[3]), sC = (d[0] + d[1]) + (d[2] + d[3]);
        rA = 1.0f / sqrtf(sA * (1.0f / 384.0f) + RMS_EPS); rB = 1.0f / sqrtf(sB * (1.0f / 384.0f) + RMS_EPS); rC = 1.0f / sqrtf(sC * (1.0f / 256.0f) + RMS_EPS);
    }
    __device__ __forceinline__ void hook(f32x4 (&acc)[2][2][4][2], const Unit& u, int t, int wr, int wc, int fr, int fq) const {
        if (t != 6 && t != 12) return;
        asm volatile("" : "+v"(fr));
#pragma unroll
        for (int ai = 0; ai < 2; ++ai)
#pragma unroll
            for (int m = 0; m < 4; ++m) {
                const int row = u.pm * BM + ai * HALF + wr * 64 + m * 16 + fr;
                float rA, rB, rC; group_r(row, rA, rB, rC);
                const float f = (t == 6) ? rA / rB : rB / rC;
#pragma unroll
                for (int bj = 0; bj < 2; ++bj)
#pragma unroll
                    for (int n = 0; n < 2; ++n) acc[ai][bj][m][n] = acc[ai][bj][m][n] * f;
                PG8_FENCE();
            }
    }
    __device__ __forceinline__ void fused(f32x4 (&acc)[2][2][4][2], const Unit& u, int wr, int wc, int fr, int fq, PG8_LAS unsigned char* lds, int wid, int lane) const {
        PG8_G bf16_t* xb = (PG8_G bf16_t*)(ws + WS_XB); PG8_G float* ssq_out = (PG8_G float*)(ws + WS_SSQX); constexpr int gate_bstride = 9 * 1024;
        const int b = u.pm >> 5, colg = u.pn * BM + 4 * lane;
        const f32x4 gv = *(const PG8_G f32x4*)(gate + (size_t)b * gate_bstride + colg) * coef;
        const f32x4 gsv = gs ? *(const PG8_G f32x4*)(gs + (size_t)b * 1024 + colg) : (f32x4){0.f, 0.f, 0.f, 0.f};
        const f32x4 igv = *(const PG8_G f32x4*)(igs + (size_t)b * 1024 + colg);
#pragma unroll
        for (int ai = 0; ai < 2; ++ai) {
#pragma unroll
            for (int m = 0; m < 4; ++m) { const int rl = wr * 64 + m * 16 + fr;
#pragma unroll
                for (int bj = 0; bj < 2; ++bj)
#pragma unroll
                    for (int n = 0; n < 2; ++n) { const int c = 32 * bj + 8 * wc + 4 * n + fq; *(PG8_LAS f32x4*)(lds + rl * 1024 + ((c ^ (rl & 7)) << 4)) = acc[ai][bj][m][n]; } }
            asm volatile("s_waitcnt lgkmcnt(0)\n\ts_barrier" ::: "memory");
#pragma unroll
            for (int half = 0; half < 2; ++half) {
                u32x2 xo[8];
#pragma unroll
                for (int k = 0; k < 8; ++k) { const int rl = wid + 8 * (half * 8 + k); xo[k] = *(const PG8_G u32x2*)(xb + (size_t)(u.pm * BM + ai * HALF + rl) * 1024 + colg); }
#pragma unroll
                for (int k = 0; k < 8; ++k) { const int rl = wid + 8 * (half * 8 + k); const int row = u.pm * BM + ai * HALF + rl;
                    f32x4 t = *(const PG8_LAS f32x4*)(lds + rl * 1024 + ((lane ^ (rl & 7)) << 4));
                    if (HOOKED) { float rA, rB, rC; group_r(row, rA, rB, rC); t = t * rC; }
                    const f32x4 xs = {__uint_as_float(xo[k].x << 16), __uint_as_float(xo[k].x & 0xffff0000u), __uint_as_float(xo[k].y << 16), __uint_as_float(xo[k].y & 0xffff0000u)};
                    const f32x4 xn = xs * igv + gv * t;
                    if (!gs) *(PG8_G f32x4*)(fout + (size_t)row * 1024 + colg) = xn;
                    if (gs) { const f32x4 y = xn * gsv; u32x2 w; w.x = cvt_pk_bf16(y[0], y[1]); w.y = cvt_pk_bf16(y[2], y[3]); *(PG8_G u32x2*)(xb + (size_t)row * 1024 + colg) = w; }
                    float ss = sq4(xn);
#pragma unroll
                    for (int o = 1; o < 64; o <<= 1) ss += __shfl_xor(ss, o);
                    if (gs && lane == 0) *(PG8_G f32x4*)(ssq_out + (size_t)row * 16 + 4 * u.pn) = (f32x4){ss, 0.f, 0.f, 0.f};
                }
            }
            asm volatile("s_waitcnt lgkmcnt(0)\n\ts_barrier" ::: "memory");
        }
    }
};

struct EpiIn {
    static constexpr bool PERM = true, AFTER_DRAIN = false, HOOK = false;
    PG8_G unsigned char* ws; const PG8_G float* gq; const PG8_G float* gk; const PG8_G float* bias;
    __device__ __forceinline__ void hook(f32x4 (&)[2][2][4][2], const Unit&, int, int, int, int, int) const {}
    __device__ __forceinline__ void operator()(const f32x4 (&acc)[2][2][4][2], const Unit& u, int wr, int wc, int fr, int fq) const {
        const int slot = u.pn * 4 + wc;
        if (slot == 7 || slot >= 30) return;
        const int b = u.pm >> 5;
        const PG8_G float* ssqx = (const PG8_G float*)(ws + WS_SSQX);
        PG8_G PG8_G bf16_t* dst = nullptr; int pitch = 0, col0 = 0; int kind = 0;
        PG8_G PG8_G float* ssqd = nullptr; int ssqp = 0, ssqi = 0; const PG8_G float* gain = nullptr; float scale = 1.0f;
        if (slot < 4)       { dst = (PG8_G bf16_t*)(ws + WS_CQ);  pitch = 256; col0 = 64 * slot;        kind = 1; ssqd = (PG8_G float*)(ws + WS_SSQC);  ssqp = 4; ssqi = slot; }
        else if (slot < 6)  { dst = (PG8_G bf16_t*)(ws + WS_CKV); pitch = 128; col0 = 64 * (slot - 4);  kind = 1; ssqd = (PG8_G float*)(ws + WS_SSQC) + (size_t)MROWS_ * 4; ssqp = 2; ssqi = slot - 4; }
        else if (slot == 6) { kind = 3; }
        else if (slot < 14) { dst = (PG8_G bf16_t*)(ws + WS_QS);  pitch = 384; col0 = 64 * (slot - 8);  kind = 2; gain = gq; scale = 0.125f * LOG2E; }
        else if (slot < 16) { dst = (PG8_G bf16_t*)(ws + WS_KS);  pitch = 128; col0 = 64 * (slot - 14); kind = 2; gain = gk; }
        else if (slot < 18) { dst = (PG8_G bf16_t*)(ws + WS_VS);  pitch = 128; col0 = 64 * (slot - 16); }
        else if (slot < 22) { dst = (PG8_G bf16_t*)(ws + WS_QC);  pitch = 256; col0 = 64 * (slot - 18); scale = 0.125f * LOG2E; }
        else if (slot < 26) { dst = (PG8_G bf16_t*)(ws + WS_KC);  pitch = 256; col0 = 64 * (slot - 22); }
        else                { dst = (PG8_G bf16_t*)(ws + WS_VC);  pitch = 256; col0 = 64 * (slot - 26); }
        const PG8_G float* bb = bias + b * 2048 + u.pn * BM + wc * 32 + 8 * fq;
        f32x4 bv[2][2], gn[2][2];
#pragma unroll
        for (int bj = 0; bj < 2; ++bj)
#pragma unroll
            for (int n = 0; n < 2; ++n) { bv[bj][n] = *(const PG8_G f32x4*)(bb + bj * HALF + 4 * n);
                gn[bj][n] = (kind == 2) ? *(const PG8_G f32x4*)(gain + 32 * bj + 8 * fq + 4 * n) * scale : (f32x4){scale, scale, scale, scale}; }
#pragma unroll
        for (int ai = 0; ai < 2; ++ai)
#pragma unroll
            for (int m = 0; m < 4; ++m) {
                const int row = u.pm * BM + ai * HALF + wr * 64 + m * 16 + fr;
                const float r = 1.0f / sqrtf(sum16f(ssqx + (size_t)row * 16) * (1.0f / 1024.0f) + RMS_EPS);
                f32x4 v[2][2]; float ss = 0.f;
#pragma unroll
                for (int bj = 0; bj < 2; ++bj)
#pragma unroll
                    for (int n = 0; n < 2; ++n) { v[bj][n] = acc[ai][bj][m][n] * r + bv[bj][n]; ss += sq4(v[bj][n]); }
                if (kind == 3) {
                    float s0 = sq4(v[0][0]) + sq4(v[0][1]);
                    s0 += __shfl_xor(s0, 16); s0 += __shfl_xor(s0, 32);
                    *(PG8_G f32x4*)((PG8_G float*)(ws + WS_KPE) + (size_t)row * 32 + 8 * fq) = v[0][0]; *(PG8_G f32x4*)((PG8_G float*)(ws + WS_KPE) + (size_t)row * 32 + 8 * fq + 4) = v[0][1];
                    if (fq == 0) ((PG8_G float*)(ws + WS_SSQC) + (size_t)MROWS_ * 6)[row] = s0;
                } else {
                    if (kind != 0) { ss += __shfl_xor(ss, 16); ss += __shfl_xor(ss, 32); }
                    float rn = 1.0f;
                    if (kind == 2) rn = 1.0f / sqrtf(ss * (1.0f / 64.0f) + RMS_EPS);
                    if (kind == 1 && fq == 0) ssqd[(size_t)row * ssqp + ssqi] = ss;
#pragma unroll
                    for (int bj = 0; bj < 2; ++bj) {
                        const f32x4 y0 = v[bj][0] * gn[bj][0] * rn, y1 = v[bj][1] * gn[bj][1] * rn;
                        u32x4 w; w.x = cvt_pk_bf16(y0[0], y0[1]); w.y = cvt_pk_bf16(y0[2], y0[3]); w.z = cvt_pk_bf16(y1[0], y1[1]); w.w = cvt_pk_bf16(y1[2], y1[3]);
                        *(PG8_G u32x4*)(dst + (size_t)row * pitch + col0 + 32 * bj + 8 * fq) = w;
                    }
                }
                if (m & 1) PG8_FENCE();
            }
    }
};

struct EpiUq {
    static constexpr bool PERM = false, AFTER_DRAIN = false, HOOK = false;
    PG8_G unsigned char* ws;
    __device__ __forceinline__ void hook(f32x4 (&)[2][2][4][2], const Unit&, int, int, int, int, int) const {}
    __device__ __forceinline__ void operator()(const f32x4 (&acc)[2][2][4][2], const Unit& u, int wr, int wc, int fr, int fq) const {
        PG8_G float* QRAW = (PG8_G float*)(ws + WS_QRAW); const PG8_G float* ssqcq = (const PG8_G float*)(ws + WS_SSQC);
        const int col0 = u.pn * BM + wc * 32 + 4 * fq;
#pragma unroll
        for (int ai = 0; ai < 2; ++ai)
#pragma unroll
            for (int m = 0; m < 4; ++m) {
                const int row = u.pm * BM + ai * HALF + wr * 64 + m * 16 + fr;
                const f32x4 s = *(const PG8_G f32x4*)(ssqcq + (size_t)row * 4);
                const float r = 1.0f / sqrtf(((s[0] + s[1]) + (s[2] + s[3])) * (1.0f / 256.0f) + RMS_EPS);
#pragma unroll
                for (int bj = 0; bj < 2; ++bj)
#pragma unroll
                    for (int n = 0; n < 2; ++n) { const int c = col0 + bj * HALF + n * 16; if (c < 576) *(PG8_G f32x4*)(QRAW + (size_t)row * 576 + c) = acc[ai][bj][m][n] * r; }
            }
    }
};

struct EpiUkv {
    static constexpr bool PERM = true, AFTER_DRAIN = false, HOOK = false;
    PG8_G unsigned char* ws; const PG8_G float* gk;
    __device__ __forceinline__ void hook(f32x4 (&)[2][2][4][2], const Unit&, int, int, int, int, int) const {}
    __device__ __forceinline__ void operator()(const f32x4 (&acc)[2][2][4][2], const Unit& u, int wr, int wc, int fr, int fq) const {
        PG8_G bf16_t* KA = (PG8_G bf16_t*)(ws + WS_KA); PG8_G bf16_t* VA = (PG8_G bf16_t*)(ws + WS_VA); const PG8_G float* ssqckv = (const PG8_G float*)(ws + WS_SSQC) + (size_t)MROWS_ * 4; const PG8_G float* ssqkpe = (const PG8_G float*)(ws + WS_SSQC) + (size_t)MROWS_ * 6;
        const PG8_G float* kpe = (const PG8_G float*)(ws + WS_KPE); const PG8_G float* cs = (const PG8_G float*)(ws + WS_CS);
        const int h = 2 * u.pn + (wc >> 1); const bool isv = (wc & 1) != 0;
        f32x4 gn[2][2], g1 = {1.f, 1.f, 1.f, 1.f}, g2 = {1.f, 1.f, 1.f, 1.f};
        if (!isv) {
#pragma unroll
            for (int bj = 0; bj < 2; ++bj)
#pragma unroll
                for (int n = 0; n < 2; ++n) gn[bj][n] = *(const PG8_G f32x4*)(gk + 32 * bj + 8 * fq + 4 * n);
            g1 = *(const PG8_G f32x4*)(gk + 64 + 4 * fq); g2 = *(const PG8_G f32x4*)(gk + 80 + 4 * fq);
        }
#pragma unroll
        for (int ai = 0; ai < 2; ++ai)
#pragma unroll
            for (int m = 0; m < 4; ++m) {
                const int row = u.pm * BM + ai * HALF + wr * 64 + m * 16 + fr;
                const float r = 1.0f / sqrtf((ssqckv[(size_t)row * 2] + ssqckv[(size_t)row * 2 + 1]) * (1.0f / 128.0f) + RMS_EPS);
                f32x4 v[2][2]; float ss = 0.f;
#pragma unroll
                for (int bj = 0; bj < 2; ++bj)
#pragma unroll
                    for (int n = 0; n < 2; ++n) { v[bj][n] = acc[ai][bj][m][n] * r; ss += sq4(v[bj][n]); }
                if (isv) {
#pragma unroll
                    for (int bj = 0; bj < 2; ++bj) { u32x4 w; w.x = cvt_pk_bf16(v[bj][0][0], v[bj][0][1]); w.y = cvt_pk_bf16(v[bj][0][2], v[bj][0][3]); w.z = cvt_pk_bf16(v[bj][1][0], v[bj][1][1]); w.w = cvt_pk_bf16(v[bj][1][2], v[bj][1][3]);
                        *(PG8_G u32x4*)(VA + ((size_t)(row >> 6) * 6 + h) * 4096 + bj * 2048 + (row & 63) * 32 + 8 * fq) = w; }
                } else {
                    ss += __shfl_xor(ss, 16); ss += __shfl_xor(ss, 32);
                    const float rk = 1.0f / sqrtf((ss + ssqkpe[row]) * (1.0f / 96.0f) + RMS_EPS);
                    PG8_G bf16_t* kd = KA + ((size_t)(row >> 6) * 6 + h) * 6144 + (row & 63) * 8;
#pragma unroll
                    for (int bj = 0; bj < 2; ++bj) { const f32x4 y0 = v[bj][0] * gn[bj][0] * rk, y1 = v[bj][1] * gn[bj][1] * rk;
                        u32x4 w; w.x = cvt_pk_bf16(y0[0], y0[1]); w.y = cvt_pk_bf16(y0[2], y0[3]); w.z = cvt_pk_bf16(y1[0], y1[1]); w.w = cvt_pk_bf16(y1[2], y1[3]);
                        *(PG8_G u32x4*)(kd + (4 * bj + fq) * 512) = w; }
                    const f32x4 x1 = *(const PG8_G f32x4*)(kpe + (size_t)row * 32 + 4 * fq) * g1 * rk, x2 = *(const PG8_G f32x4*)(kpe + (size_t)row * 32 + 16 + 4 * fq) * g2 * rk;
                    const f32x4 c = *(const PG8_G f32x4*)(cs + (size_t)row * 32 + 4 * fq), s = *(const PG8_G f32x4*)(cs + (size_t)row * 32 + 16 + 4 * fq);
                    const f32x4 o1 = x1 * c - x2 * s, o2 = x2 * c + x1 * s;
                    u32x2 w1, w2; w1.x = cvt_pk_bf16(o1[0], o1[1]); w1.y = cvt_pk_bf16(o1[2], o1[3]); w2.x = cvt_pk_bf16(o2[0], o2[1]); w2.y = cvt_pk_bf16(o2[2], o2[3]);
                    *(PG8_G u32x2*)(kd + (8 + (fq >> 1)) * 512 + (fq & 1) * 4) = w1; *(PG8_G u32x2*)(kd + (10 + (fq >> 1)) * 512 + (fq & 1) * 4) = w2;
                }
                if (m & 1) PG8_FENCE();
            }
    }
};
}
#define GAS __attribute__((address_space(1)))
#define LAS __attribute__((address_space(3)))
typedef unsigned short bf16;
typedef unsigned v4u __attribute__((ext_vector_type(4)));
typedef float f32x4 __attribute__((ext_vector_type(4)));
typedef short bf16x8 __attribute__((ext_vector_type(8)));
typedef GAS unsigned gu32;
typedef GAS unsigned long long gu64;
#define RLX_AGENT __ATOMIC_RELAXED, __HIP_MEMORY_SCOPE_AGENT
#define LDS_WAIT() asm volatile("s_waitcnt lgkmcnt(0)" ::: "memory")
#define VM_WAIT() asm volatile("s_waitcnt vmcnt(0)" ::: "memory")
__device__ __forceinline__ unsigned long long rt() { return __builtin_amdgcn_s_memrealtime(); }
__device__ __forceinline__ unsigned f2bf(float f) { unsigned u = __builtin_bit_cast(unsigned, f); return (u + 0x7fffu + ((u >> 16) & 1u)) >> 16; }
__device__ __forceinline__ unsigned pk2(float lo, float hi) { return f2bf(lo) | (f2bf(hi) << 16); }

#define XB_TMO      128
#define XB_XCNT(j)  (256  + 64 * (j))
#define XB_XSUB(j)  (1280 + 64 * (j))
#define XB_XGEN(j)  (2304 + 64 * (j))
#define XB_TOP      3328
#define XB_TOPGEN   3392
#define XCD_BAR_WORDS 3456
#define XB_SPIN_CAP (1u << 18)

__device__ __forceinline__ unsigned xb_ld(unsigned* p)              { return __hip_atomic_load(p, __ATOMIC_RELAXED, __HIP_MEMORY_SCOPE_AGENT); }
__device__ __forceinline__ unsigned xb_add(unsigned* p, unsigned v) { return __hip_atomic_fetch_add(p, v, __ATOMIC_RELAXED, __HIP_MEMORY_SCOPE_AGENT); }
__device__ __forceinline__ unsigned xb_xcc_id() { return (unsigned)__builtin_amdgcn_s_getreg((3 << 11) | 20) & 0xFu; }
#define XB_SPIN(cond, bar) do { unsigned _sp = 0; while (cond) { __builtin_amdgcn_s_sleep(1); \
    if ((++_sp & 255u) == 0u) { if (xb_ld(&(bar)[XB_TMO])) break; if (_sp > XB_SPIN_CAP) { atomicAdd(&(bar)[XB_TMO], 1u); break; } } } } while (0)

struct XcdBarrier {
    unsigned* bar; unsigned x;
    volatile LAS unsigned* st;
};

__device__ __forceinline__ XcdBarrier xcd_barrier_post(unsigned* bar, volatile LAS unsigned* st) {
    XcdBarrier b; b.bar = bar; b.x = xb_xcc_id(); b.st = st;
    if (threadIdx.x == 0) (void)xb_add(&bar[XB_XCNT(b.x)], 1u);
    return b;
}
__device__ __forceinline__ void xcd_barrier_complete(unsigned* bar, unsigned x, unsigned& nloc, unsigned& nx) {
    const unsigned G = gridDim.x * gridDim.y * gridDim.z;
    unsigned sum, cnt, mine, sp = 0u;
    for (;;) {
        sum = 0u; cnt = 0u; mine = 0u;
#pragma unroll
        for (unsigned j = 0; j < 16; ++j) { const unsigned c = xb_ld(&bar[XB_XCNT(j)]); sum += c; cnt += (c > 0u) ? 1u : 0u; mine = (j == x) ? c : mine; }
        if (sum == G) break;
        __builtin_amdgcn_s_sleep(1);
        if ((++sp & 255u) == 0u) { if (xb_ld(&bar[XB_TMO])) break; if (sp > XB_SPIN_CAP) { atomicAdd(&bar[XB_TMO], 1u); break; } }
    }
    nloc = mine > 0u ? mine : 1u; nx = cnt > 0u ? cnt : 1u;
}

__device__ __forceinline__ void xcd_barrier(const XcdBarrier& b) {
    asm volatile("s_waitcnt vmcnt(0)" ::: "memory");
    __syncthreads();
    if (threadIdx.x == 0) {
        unsigned* bar = b.bar;
        __builtin_amdgcn_s_waitcnt(0);
        unsigned nloc = b.st[0], nx = b.st[1];
        if (nloc == 0u) { xcd_barrier_complete(bar, b.x, nloc, nx); b.st[0] = nloc; b.st[1] = nx; }
        const unsigned old = xb_add(&bar[XB_XSUB(b.x)], 1u);
        const unsigned gen = old / nloc;
        if (old + 1u == (gen + 1u) * nloc) {
            __builtin_amdgcn_fence(__ATOMIC_RELEASE, "agent");
            asm volatile("s_waitcnt vmcnt(0)" ::: "memory");
            const unsigned og = xb_add(&bar[XB_TOP], 1u);
            const unsigned tg = og / nx;
            if (og + 1u == (tg + 1u) * nx) xb_add(&bar[XB_TOPGEN], 1u);
            else XB_SPIN(xb_ld(&bar[XB_TOPGEN]) == tg, bar);
            __builtin_amdgcn_fence(__ATOMIC_ACQUIRE, "agent");
            xb_add(&bar[XB_XGEN(b.x)], 1u);
            asm volatile("s_waitcnt vmcnt(0)" ::: "memory");
        } else {
            XB_SPIN(xb_ld(&bar[XB_XGEN(b.x)]) == gen, bar);
            __builtin_amdgcn_fence(__ATOMIC_ACQUIRE, "agent");
            asm volatile("s_waitcnt vmcnt(0)" ::: "memory");
        }
    }
    __syncthreads();
}
namespace att {
typedef unsigned short bf16_t;
typedef short bf16x8 __attribute__((ext_vector_type(8)));
typedef short s16x4 __attribute__((ext_vector_type(4)));
typedef short v4i16_t __attribute__((ext_vector_type(4)));
typedef float f32x16 __attribute__((ext_vector_type(16)));
typedef float f32x4 __attribute__((ext_vector_type(4)));
typedef float f32x2 __attribute__((ext_vector_type(2)));
typedef __bf16 bf16x2_t __attribute__((ext_vector_type(2)));
typedef unsigned u32x4 __attribute__((ext_vector_type(4)));
typedef int i32x4 __attribute__((ext_vector_type(4)));
#define ALAS __attribute__((address_space(3)))
#define AGAS __attribute__((address_space(1)))
constexpr int SEQ = 8192;
constexpr float LOG2E = 1.4426950408889634f, EPS = 1e-6f;
constexpr int KCS = 1040, VHS = 4160;
constexpr int KSLOT = 12 * KCS, VSLOT = 2 * VHS;
constexpr int L_K = 0, L_V = 3 * KSLOT, L_POS = L_V + 4 * VSLOT, L_TB = L_POS + 1024, L_WSF = L_TB + 128, L_OST = L_WSF + 8 * 256, L_FLAG = L_OST + 8 * 4096, L_END = L_FLAG + 16 + 64;
static_assert(L_OST % 16 == 0 && L_V % 16 == 0 && L_END <= 131072, "attention LDS map");

__device__ __forceinline__ int crow(int r, int hi) { return (r & 3) + 8 * (r >> 2) + 4 * hi; }
__device__ __forceinline__ unsigned cvtpk(float lo, float hi) { f32x2 v = {lo, hi}; bf16x2_t b = __builtin_convertvector(v, bf16x2_t); return __builtin_bit_cast(unsigned, b); }
__device__ __forceinline__ s16x4 vtr(const ALAS unsigned char* p) { return __builtin_bit_cast(s16x4, __builtin_amdgcn_ds_read_tr16_b64_v4i16((ALAS v4i16_t*)p)); }
__device__ __forceinline__ float swap_sum(float x) { auto rr = __builtin_amdgcn_permlane32_swap(__float_as_uint(x), __float_as_uint(x), false, false); return __uint_as_float(rr[0]) + __uint_as_float(rr[1]); }
__device__ __forceinline__ float swap_max(float x) { auto rr = __builtin_amdgcn_permlane32_swap(__float_as_uint(x), __float_as_uint(x), false, false); return fmaxf(__uint_as_float(rr[0]), __uint_as_float(rr[1])); }
__device__ __forceinline__ float bf2f(unsigned short h) { return __uint_as_float((unsigned)h << 16); }

__device__ __forceinline__ void glds16(const AGAS void* gsrc, unsigned lds_dst) { unsigned keep;
    asm volatile("s_mov_b32 %0, m0\n\ts_mov_b32 m0, %2\n\ts_nop 0\n\tglobal_load_lds_dwordx4 %1, off\n\ts_mov_b32 m0, %0" : "=&s"(keep) : "v"(gsrc), "s"(lds_dst) : "memory"); }
__device__ __forceinline__ void glds4(const AGAS void* gsrc, unsigned lds_dst) { unsigned keep;
    asm volatile("s_mov_b32 %0, m0\n\ts_mov_b32 m0, %2\n\ts_nop 0\n\tglobal_load_lds_dword %1, off\n\ts_mov_b32 m0, %0" : "=&s"(keep) : "v"(gsrc), "s"(lds_dst) : "memory"); }

struct AttnP {
    AGAS unsigned char* ws;
    const AGAS float* gq;
    const AGAS int* pos; const AGAS float* sinks; const AGAS float* relb;
};
template <int MODE> struct AttnCfg;
template <> struct AttnCfg<0> { static constexpr size_t Q = WS_QRAW, K = WS_KA, V = WS_VA; static constexpr int qpitch = 576, kpitch = 576, khs = 96, vpitch = 384, vhs = 64, ocol0 = 0, hidx0 = 0, group = 1; };
template <> struct AttnCfg<1> { static constexpr size_t Q = WS_QS, K = WS_KS, V = WS_VS; static constexpr int qpitch = 384, kpitch = 128, khs = 64, vpitch = 128, vhs = 64, ocol0 = 384, hidx0 = 6, group = 3; };
template <> struct AttnCfg<2> { static constexpr size_t Q = WS_QC, K = WS_KC, V = WS_VC; static constexpr int qpitch = 256, kpitch = 256, khs = 64, vpitch = 256, vhs = 64, ocol0 = 768, hidx0 = 12, group = 1; };

#ifdef ATT_PROF
#define PROF_T() ((MODE == 0 && blockIdx.x == 0) ? (long long)clock64() : 0ll)
#else
#define PROF_T() 0ll
#endif
template <int DQK, int MODE>
__device__ __forceinline__ void attn_unit(ALAS unsigned char* lds, const AttnP& P, int b, int h, int qb, unsigned long long* prof = nullptr) {
    long long pf_qk = 0, pf_sm = 0, pf_pv = 0, pf_wait = 0; const long long pf_t0 = PROF_T();
    constexpr int NCH = DQK / 8, ND0 = DQK / 16;
    int tid_ = threadIdx.x; asm volatile("" : "+v"(tid_));
    const int tid = tid_, lane = tid & 63, r32 = lane & 31, hi = lane >> 5;
    const int wid = __builtin_amdgcn_readfirstlane(tid >> 6);
    const int q0 = qb * 256, qlo = q0 + 32 * wid, qhi = qlo + 31, qrow = qlo + r32;
    const size_t rb = (size_t)b * SEQ;
    typedef AttnCfg<MODE> C; const int kvh = h / C::group;
    ALAS float* wsf = (ALAS float*)(lds + L_WSF) + wid * 64;
    ALAS unsigned char* ost = lds + L_OST + wid * 4096;
    ALAS int* posl = (ALAS int*)(lds + L_POS);
    ALAS float* tb = (ALAS float*)(lds + L_TB);

    bf16x8 qf[ND0];
    if constexpr (MODE == 0) {
        const AGAS float* qp = (const AGAS float*)(P.ws + C::Q) + (rb + qrow) * 576 + h * 96 + hi * 8;
        float qv[ND0][8]; float ss = 0.f;
#pragma unroll
        for (int d0 = 0; d0 < ND0; ++d0) { const f32x4 a = *(const AGAS f32x4*)(qp + 16 * d0), c = *(const AGAS f32x4*)(qp + 16 * d0 + 4);
#pragma unroll
            for (int i = 0; i < 4; ++i) { qv[d0][i] = a[i]; qv[d0][4 + i] = c[i]; ss += a[i] * a[i] + c[i] * c[i]; } }
        ss = swap_sum(ss);
        const float rq = 1.0f / sqrtf(ss * (1.0f / 96.0f) + EPS);
#pragma unroll
        for (int d0 = 0; d0 < ND0; ++d0) { const f32x4 ga = *(const AGAS f32x4*)(P.gq + 16 * d0 + 8 * hi), gb = *(const AGAS f32x4*)(P.gq + 16 * d0 + 8 * hi + 4);
#pragma unroll
            for (int i = 0; i < 4; ++i) { qv[d0][i] *= rq * ga[i]; qv[d0][4 + i] *= rq * gb[i]; } }
        {
            const AGAS float* cp = (const AGAS float*)(P.ws + WS_CS) + (rb + qrow) * 32 + 8 * hi;
            const f32x4 c0 = *(const AGAS f32x4*)cp, c1 = *(const AGAS f32x4*)(cp + 4), s0 = *(const AGAS f32x4*)(cp + 16), s1 = *(const AGAS f32x4*)(cp + 20);
#pragma unroll
            for (int i = 0; i < 8; ++i) { const float c = i < 4 ? c0[i & 3] : c1[i & 3], s = i < 4 ? s0[i & 3] : s1[i & 3]; const float x1 = qv[4][i], x2 = qv[5][i]; qv[4][i] = x1 * c - x2 * s; qv[5][i] = x2 * c + x1 * s; }
        }
        const float sc = 0.10206207261596575f * LOG2E;
#pragma unroll
        for (int d0 = 0; d0 < ND0; ++d0) { u32x4 w; w.x = cvtpk(qv[d0][0] * sc, qv[d0][1] * sc); w.y = cvtpk(qv[d0][2] * sc, qv[d0][3] * sc); w.z = cvtpk(qv[d0][4] * sc, qv[d0][5] * sc); w.w = cvtpk(qv[d0][6] * sc, qv[d0][7] * sc); qf[d0] = __builtin_bit_cast(bf16x8, w); }
    } else {
        const AGAS bf16_t* qp = (const AGAS bf16_t*)(P.ws + C::Q) + (rb + qrow) * C::qpitch + h * 64 + hi * 8;
#pragma unroll
        for (int d0 = 0; d0 < ND0; ++d0) qf[d0] = *(const AGAS bf16x8*)(qp + 16 * d0);
    }
    int posq = 0; float sink2 = 0.f;
    if constexpr (MODE == 1) {
        posq = P.pos[rb + qrow]; sink2 = P.sinks[h] * LOG2E;
        if (tid < 32) tb[tid] = P.relb[tid * 6 + h] * LOG2E;
    }

    int ntile, tfirst, tstep;
    if (MODE == 0) { tfirst = 0; tstep = 1; ntile = ((q0 + 255) >> 6) + 1; }
    else if (MODE == 1) { const int lo = q0 - 127 > 0 ? q0 - 127 : 0; tfirst = lo >> 6; tstep = 1; ntile = ((q0 + 255) >> 6) - tfirst + 1; }
    else { tfirst = (q0 + 254) >> 6; tstep = -1; ntile = tfirst + 1; }

    const AGAS bf16_t* Kg = (const AGAS bf16_t*)(P.ws + C::K) + rb * C::kpitch + kvh * C::khs;
    const AGAS bf16_t* Vg = (const AGAS bf16_t*)(P.ws + C::V) + rb * C::vpitch + kvh * C::vhs;
    const unsigned lds0 = (unsigned)(uintptr_t)lds;
    const AGAS bf16_t* ksrc0 = (MODE == 0) ? (const AGAS bf16_t*)(P.ws + C::K) + ((size_t)b * 128 * 6 + h) * 6144 + wid * 512 + lane * 8 : Kg + (size_t)lane * C::kpitch + 8 * wid;
    const AGAS bf16_t* vsrc = (MODE == 0) ? (const AGAS bf16_t*)(P.ws + C::V) + ((size_t)b * 128 * 6 + h) * 4096 + (wid >> 2) * 2048 + (wid & 3) * 512 + lane * 8
                                          : Vg + (size_t)(16 * (wid & 3) + (lane >> 2)) * C::vpitch + 32 * (wid >> 2) + 8 * (lane & 3);
    constexpr size_t KTS = (MODE == 0) ? (size_t)6 * 6144 : (size_t)64 * C::kpitch, VTS = (MODE == 0) ? (size_t)6 * 4096 : (size_t)64 * C::vpitch, K2O = (MODE == 0) ? 8 * 512 : 64;
    const bool k2 = (wid + 8) < NCH;
    const bool posw = (MODE == 1) && wid == 0;
    const int NP = 2 + (k2 ? 1 : 0) + (posw ? 1 : 0);
#define ATT_ISSUE(T, IT) do { const int T_ = (T); const size_t jo_ = (size_t)T_ * 64; const int ks_ = (IT) % 3, vs_ = (IT) & 3;     \
        glds16(ksrc0 + (size_t)T_ * KTS, (unsigned)__builtin_amdgcn_readfirstlane(lds0 + L_K + ks_ * KSLOT + wid * KCS)); \
        if (k2) glds16(ksrc0 + (size_t)T_ * KTS + K2O, (unsigned)__builtin_amdgcn_readfirstlane(lds0 + L_K + ks_ * KSLOT + (wid + 8) * KCS)); \
        glds16(vsrc + (size_t)T_ * VTS, (unsigned)__builtin_amdgcn_readfirstlane(lds0 + L_V + vs_ * VSLOT + (wid >> 2) * VHS + (wid & 3) * 1024)); \
        if (posw) glds4(P.pos + rb + jo_ + lane, (unsigned)__builtin_amdgcn_readfirstlane(lds0 + L_POS + vs_ * 256)); } while (0)
#define ATT_WAIT_BAR(n_) do { if ((n_) <= 0) asm volatile("s_waitcnt vmcnt(0) lgkmcnt(0)\n\ts_barrier" ::: "memory"); \
        else if (NP == 2) asm volatile("s_waitcnt vmcnt(2) lgkmcnt(0)\n\ts_barrier" ::: "memory"); \
        else if (NP == 3) asm volatile("s_waitcnt vmcnt(3) lgkmcnt(0)\n\ts_barrier" ::: "memory"); \
        else asm volatile("s_waitcnt vmcnt(4) lgkmcnt(0)\n\ts_barrier" ::: "memory"); } while (0)

    f32x16 o0 = {}, o1 = {};
    float mrun = (MODE == 1) ? sink2 : 0.f;
    float lrun = (MODE == 1 && hi == 0) ? 1.0f : 0.f;
    f32x16 negm;
#pragma unroll
    for (int r = 0; r < 16; ++r) negm[r] = (MODE == 2) ? 0.f : -mrun;
    bool first = (MODE == 0);
    float after = 0.f;
    bool walive = true;
    const int vrd = ((lane >> 4) & 1) * 32 + (lane & 3) * 8 + (4 * hi + ((lane & 15) >> 2)) * 64;
    const bool lag = wid >= 4;
    constexpr float THR = 4.0f;

#define ATT_QK(P0, P1, kb) do { int kofs_ = L_K + (kb) * KSLOT + hi * KCS + r32 * 16; asm volatile("" : "+v"(kofs_)); const ALAS unsigned char* Kb_ = lds + kofs_;     \
        bf16x8 kfa_[4], kfb_[4]; \
        _Pragma("unroll") for (int d0 = 0; d0 < 3; ++d0) { kfa_[d0] = *(const ALAS bf16x8*)(Kb_ + 2 * d0 * KCS); kfb_[d0] = *(const ALAS bf16x8*)(Kb_ + 2 * d0 * KCS + 512); } \
        \
        _Pragma("unroll") for (int d0 = 0; d0 < ND0; ++d0) { \
            if (d0 + 3 < ND0) { kfa_[(d0 + 3) & 3] = *(const ALAS bf16x8*)(Kb_ + 2 * (d0 + 3) * KCS); kfb_[(d0 + 3) & 3] = *(const ALAS bf16x8*)(Kb_ + 2 * (d0 + 3) * KCS + 512); } \
            if (d0 == 0) { P0 = __builtin_amdgcn_mfma_f32_32x32x16_bf16(kfa_[0], qf[0], negm, 0, 0, 0); P1 = __builtin_amdgcn_mfma_f32_32x32x16_bf16(kfb_[0], qf[0], negm, 0, 0, 0); } \
            else { P0 = __builtin_amdgcn_mfma_f32_32x32x16_bf16(kfa_[d0 & 3], qf[d0], P0, 0, 0, 0); P1 = __builtin_amdgcn_mfma_f32_32x32x16_bf16(kfb_[d0 & 3], qf[d0], P1, 0, 0, 0); } \
            } } while (0)
#define ATT_VLD(i_, s_) do { vl0_[i_] = vtr(Vb_ + (s_) * 1024); vh0_[i_] = vtr(Vb_ + (s_) * 1024 + 512); vl1_[i_] = vtr(Vb_ + VHS + (s_) * 1024); vh1_[i_] = vtr(Vb_ + VHS + (s_) * 1024 + 512); } while (0)
#define ATT_PV(vb) do { int vofs_ = L_V + (vb) * VSLOT + vrd; asm volatile("" : "+v"(vofs_)); const ALAS unsigned char* Vb_ = lds + vofs_; \
        s16x4 vl0_[2], vh0_[2], vl1_[2], vh1_[2]; ATT_VLD(0, 0); \
        _Pragma("unroll") for (int s_ = 0; s_ < 4; ++s_) { \
            if (s_ + 1 < 4) ATT_VLD((s_ + 1) & 1, s_ + 1); \
            const int i_ = s_ & 1; const bf16x8 pa_ = __builtin_bit_cast(bf16x8, pw[s_]); \
            const bf16x8 v0_ = {vl0_[i_][0], vl0_[i_][1], vl0_[i_][2], vl0_[i_][3], vh0_[i_][0], vh0_[i_][1], vh0_[i_][2], vh0_[i_][3]}, v1_ = {vl1_[i_][0], vl1_[i_][1], vl1_[i_][2], vl1_[i_][3], vh1_[i_][0], vh1_[i_][1], vh1_[i_][2], vh1_[i_][3]}; \
            o0 = __builtin_amdgcn_mfma_f32_32x32x16_bf16(pa_, v0_, o0, 0, 0, 0); o1 = __builtin_amdgcn_mfma_f32_32x32x16_bf16(pa_, v1_, o1, 0, 0, 0); } } while (0)
#define ATT_PACK(P0, P1) do { \
        pw[0].x = cvtpk(P0[0], P0[1]); pw[0].y = cvtpk(P0[2], P0[3]); pw[0].z = cvtpk(P0[4], P0[5]); pw[0].w = cvtpk(P0[6], P0[7]); \
        pw[1].x = cvtpk(P0[8], P0[9]); pw[1].y = cvtpk(P0[10], P0[11]); pw[1].z = cvtpk(P0[12], P0[13]); pw[1].w = cvtpk(P0[14], P0[15]); \
        pw[2].x = cvtpk(P1[0], P1[1]); pw[2].y = cvtpk(P1[2], P1[3]); pw[2].z = cvtpk(P1[4], P1[5]); pw[2].w = cvtpk(P1[6], P1[7]); \
        pw[3].x = cvtpk(P1[8], P1[9]); pw[3].y = cvtpk(P1[10], P1[11]); pw[3].z = cvtpk(P1[12], P1[13]); pw[3].w = cvtpk(P1[14], P1[15]); } while (0)
#define ATT_MAX3(a, b, c) fmaxf(fmaxf((a), (b)), (c))
#define ATT_SM_A(P0, P1, j0_, pslot) do { if constexpr (MODE != 2) { \
            if constexpr (MODE == 1) { \
                _Pragma("unroll") for (int g = 0; g < 4; ++g) { \
                    const i32x4 pa = *(const ALAS i32x4*)(posl + (pslot) * 64 + 8 * g + 4 * hi), pb = *(const ALAS i32x4*)(posl + (pslot) * 64 + 32 + 8 * g + 4 * hi); \
                    _Pragma("unroll") for (int i = 0; i < 4; ++i) { \
                        { int n = posq - pa[i]; n = n > 0 ? n : 0; int bk = n; if (n >= 16) { bk = 16 + (int)((__builtin_amdgcn_logf((float)n) - 4.0f) * (16.0f / 3.0f)); bk = bk < 31 ? bk : 31; } P0[4 * g + i] += tb[bk]; } \
                        { int n = posq - pb[i]; n = n > 0 ? n : 0; int bk = n; if (n >= 16) { bk = 16 + (int)((__builtin_amdgcn_logf((float)n) - 4.0f) * (16.0f / 3.0f)); bk = bk < 31 ? bk : 31; } P1[4 * g + i] += tb[bk]; } } } } \
            const bool nm_ = (MODE == 1) || ((j0_) + 63 > qlo); \
            if (nm_) { \
                _Pragma("unroll") for (int r = 0; r < 16; ++r) { const int key = (j0_) + crow(r, hi); \
                    bool ok0 = key <= qrow, ok1 = key + 32 <= qrow; \
                    if (MODE == 1) { ok0 = ok0 && (key > qrow - 128); ok1 = ok1 && (key + 32 > qrow - 128); } \
                    if (!ok0) P0[r] = -INFINITY; if (!ok1) P1[r] = -INFINITY; } } \
            float ma = ATT_MAX3(P0[0], P0[1], P1[0]), mb = ATT_MAX3(P0[2], P0[3], P1[1]); ma = ATT_MAX3(ma, P1[2], P1[3]); \
            _Pragma("unroll") for (int r = 4; r < 16; r += 4) { ma = ATT_MAX3(ma, P0[r], P0[r + 1]); mb = ATT_MAX3(mb, P0[r + 2], P0[r + 3]); ma = ATT_MAX3(ma, P1[r], P1[r + 1]); mb = ATT_MAX3(mb, P1[r + 2], P1[r + 3]); } \
            const float mt = swap_max(fmaxf(ma, mb)); \
            if (first || __any(mt > THR)) {                                 \
                const float d = first ? mt : fmaxf(mt, 0.f); first = false; \
                _Pragma("unroll") for (int r = 0; r < 16; ++r) { P0[r] -= d; P1[r] -= d; } \
                const float alpha = __builtin_amdgcn_exp2f(-d); mrun += d; lrun *= alpha; \
                _Pragma("unroll") for (int r = 0; r < 16; ++r) negm[r] = -mrun; \
                if (hi == 0) wsf[r32] = alpha; \
                _Pragma("unroll") for (int g = 0; g < 4; ++g) { const f32x4 al = *(const ALAS f32x4*)(wsf + 8 * g + 4 * hi); \
                    _Pragma("unroll") for (int i = 0; i < 4; ++i) { o0[4 * g + i] *= al[i]; o1[4 * g + i] *= al[i]; } } } } } while (0)
#define ATT_SM_B(P0, P1, j0_) do { \
        if constexpr (MODE == 2) { \
            const bool nm_ = (j0_) + 63 >= qlo; \
            float ln0[16], ln1[16]; \
            _Pragma("unroll") for (int r = 0; r < 16; ++r) { const int key = (j0_) + crow(r, hi); \
                { const float z = P0[r]; const float sp = fmaxf(z, 0.f) + __builtin_amdgcn_logf(1.0f + __builtin_amdgcn_exp2f(-fabsf(z))); const bool ok = !nm_ || key < qrow; ln0[r] = ok ? -sp : 0.f; P0[r] = ok ? z - sp : -INFINITY; } \
                { const float z = P1[r]; const float sp = fmaxf(z, 0.f) + __builtin_amdgcn_logf(1.0f + __builtin_amdgcn_exp2f(-fabsf(z))); const bool ok = !nm_ || key + 32 < qrow; ln1[r] = ok ? -sp : 0.f; P1[r] = ok ? z - sp : -INFINITY; } } \
            float run = after; \
            _Pragma("unroll") for (int blk = 1; blk >= 0; --blk) _Pragma("unroll") for (int g = 3; g >= 0; --g) { \
                const float own = blk ? ((ln1[4 * g] + ln1[4 * g + 1]) + (ln1[4 * g + 2] + ln1[4 * g + 3])) : ((ln0[4 * g] + ln0[4 * g + 1]) + (ln0[4 * g + 2] + ln0[4 * g + 3])); \
                auto rr = __builtin_amdgcn_permlane32_swap(__float_as_uint(own), __float_as_uint(own), false, false); \
                const float slo = __uint_as_float(rr[0]), shi = __uint_as_float(rr[1]); \
                const float e1 = run; run += shi; const float e0 = run; run += slo; \
                float aft = hi ? e1 : e0; \
                _Pragma("unroll") for (int i = 3; i >= 0; --i) { const int r = 4 * g + i; \
                    if (blk) { P1[r] = __builtin_amdgcn_exp2f(P1[r] + aft); aft += ln1[r]; } else { P0[r] = __builtin_amdgcn_exp2f(P0[r] + aft); aft += ln0[r]; } } } \
            after = run; walive = __any(after > -160.0f); \
        } else { \
            float ls = 0.f; \
            _Pragma("unroll") for (int r = 0; r < 16; ++r) { P0[r] = __builtin_amdgcn_exp2f(P0[r]); P1[r] = __builtin_amdgcn_exp2f(P1[r]); ls += P0[r] + P1[r]; } \
            lrun += ls; } \
        ATT_PACK(P0, P1); } while (0)
#define ATT_WORK(j0_) ((MODE == 0) ? ((j0_) <= qhi) : (MODE == 1) ? (((j0_) <= qhi) && ((j0_) + 63 >= qlo - 127)) : (walive && ((j0_) < qhi)))

    f32x16 p0, p1, n0, n1; u32x4 pw[4];
    __syncthreads();
    int issued = 0;
    ATT_ISSUE(tfirst, 0);
    if (ntile > 1) { ATT_ISSUE(tfirst + tstep, 1); issued = 1; }
    if (ntile > 2) { ATT_ISSUE(tfirst + 2 * tstep, 2); issued = 2; }
    ATT_WAIT_BAR(issued - 1);
    bool wcur = ATT_WORK(tfirst * 64);
    if (wcur) ATT_QK(p0, p1, 0);
    asm volatile("s_waitcnt lgkmcnt(0)\n\ts_barrier" ::: "memory");
    int nt = ntile;
    for (int it = 0; it < nt; ++it) {
        const int t = tfirst + it * tstep, j0 = t * 64, jn = (t + tstep) * 64;
        if (it + 3 < ntile) { ATT_ISSUE(t + 3 * tstep, it + 3); issued = it + 3; }
        if (wcur) ATT_SM_A(p0, p1, j0, it & 3);
        const bool wnext = (it + 1 < nt) && ATT_WORK(jn);
        if (wcur && wnext) { ATT_QK(n0, n1, (it + 1) % 3); ATT_SM_B(p0, p1, j0); }
        else { if (wnext) ATT_QK(n0, n1, (it + 1) % 3); if (wcur) ATT_SM_B(p0, p1, j0); }
        if (wcur) ATT_PV(it & 3);
        p0 = n0; p1 = n1; wcur = wnext;
        if (MODE == 2) { ALAS int* fl = (ALAS int*)(lds + L_FLAG + 16) + (it & 1) * 8; if (lane == 0) fl[wid] = (walive && j0 > 0) ? 1 : 0; }
        ATT_WAIT_BAR(issued - (it + 2));
        if (MODE == 2) { const ALAS int* fl = (const ALAS int*)(lds + L_FLAG + 16) + (it & 1) * 8;
            const i32x4 fa = *(const ALAS i32x4*)fl, fb = *(const ALAS i32x4*)(fl + 4);
            if (((fa[0] | fa[1]) | (fa[2] | fa[3]) | (fb[0] | fb[1]) | (fb[2] | fb[3])) == 0) nt = it + 1; }
    }
    if (MODE == 2) asm volatile("s_waitcnt vmcnt(0)" ::: "memory");
#undef ATT_ISSUE
#undef ATT_WAIT_BAR
#undef ATT_QK
#undef ATT_PV
#undef ATT_PACK
#undef ATT_VLD
#undef ATT_SM_A
#undef ATT_SM_B
#undef ATT_WORK
#undef ATT_MAX3
    if (MODE != 2) {
        const float lt = swap_sum(lrun);
        if (hi == 0) wsf[32 + r32] = 1.0f / lt;
#pragma unroll
        for (int g = 0; g < 4; ++g) { const f32x4 il = *(const ALAS f32x4*)(wsf + 32 + 8 * g + 4 * hi);
#pragma unroll
            for (int i = 0; i < 4; ++i) { o0[4 * g + i] *= il[i]; o1[4 * g + i] *= il[i]; } }
    }
    {
        ALAS bf16_t* stg = (ALAS bf16_t*)ost;
#pragma unroll
        for (int r = 0; r < 16; ++r) { const int orow = crow(r, hi); stg[orow * 64 + r32] = (bf16_t)(cvtpk(o0[r], 0.f) & 0xffffu); stg[orow * 64 + 32 + r32] = (bf16_t)(cvtpk(o1[r], 0.f) & 0xffffu); }
        AGAS bf16_t* Ow = (AGAS bf16_t*)(P.ws + WS_OALL) + (rb + qlo) * 1024 + C::ocol0 + h * 64;
#pragma unroll
        for (int i = 0; i < 4; ++i) {
            const int row = i * 8 + (lane >> 3), ch = lane & 7;
            const u32x4 v = *(const ALAS u32x4*)(stg + row * 64 + ch * 8);
            float ss = 0.f;
#pragma unroll
            for (int k = 0; k < 4; ++k) { const unsigned w = v[k]; const float a = __uint_as_float(w << 16), c = __uint_as_float(w & 0xffff0000u); ss += a * a + c * c; }
            ss += __shfl_xor(ss, 1); ss += __shfl_xor(ss, 2); ss += __shfl_xor(ss, 4);
            *(AGAS u32x4*)(Ow + (size_t)row * 1024 + ch * 8) = v;
            if (ch == 0) ((AGAS float*)(P.ws + WS_SSQO))[(rb + qlo + row) * 16 + C::hidx0 + h] = ss;
        }
    }
#ifdef ATT_PROF
    if (MODE == 0 && blockIdx.x == 0 && wid == ATT_PROF_WAVE && lane == 0 && prof) { const long long tt = PROF_T() - pf_t0;
        atomicAdd(prof + 0, (unsigned long long)tt); atomicAdd(prof + 1, (unsigned long long)pf_qk); atomicAdd(prof + 2, (unsigned long long)pf_sm); atomicAdd(prof + 3, (unsigned long long)pf_pv); atomicAdd(prof + 4, (unsigned long long)pf_wait); atomicAdd(prof + 5, 1ull); }
#endif
}
#undef ALAS
#undef AGAS
}
struct Args { const void* in[23]; float* out; unsigned char* ws; int ph_lo, ph_hi, li, adapt; };

struct Frame { LAS unsigned char* lds; int tid, lane, wave, vcu, G; };

__device__ __forceinline__ float wave_sum64(float v) {
#pragma unroll
    for (int o = 1; o < 64; o <<= 1) v += __shfl_xor(v, o);
    return v;
}

__device__ __forceinline__ void tr_item64(const GAS float* W, int ldn, int K, GAS pg8::bf16_t* WT, int kb, int g, int src0, int src1, const GAS float* kgain, LAS unsigned* scr, int lane) {
    const int k0 = 64 * kb; const int col = lane < 32 ? src0 + lane : src1 + (lane - 32); const bool ok = (lane < 32 ? src0 : src1) >= 0;
    float v[64];
    const GAS float* wp = W + (size_t)k0 * ldn + (ok ? col : 0);
#pragma unroll
    for (int i = 0; i < 64; ++i) v[i] = wp[(size_t)i * ldn];
#pragma unroll
    for (int i = 0; i < 64; ++i) v[i] = ok ? v[i] : 0.f;
    if (kgain) {
#pragma unroll
        for (int i = 0; i < 64; ++i) v[i] *= kgain[k0 + i]; }
#pragma unroll
    for (int i = 0; i < 32; ++i) scr[i * 65 + lane] = pk2(v[2 * i], v[2 * i + 1]);
    asm volatile("s_waitcnt lgkmcnt(0)" ::: "memory");
    const int c = lane & 7;
#pragma unroll
    for (int j = 0; j < 8; ++j) { const int n = (lane >> 3) + 8 * j; const LAS unsigned* s = scr + (4 * c) * 65 + n;
        v4u o; o.x = s[0]; o.y = s[65]; o.z = s[130]; o.w = s[195];
        *(GAS v4u*)(WT + (size_t)(64 * g + n) * K + k0 + 8 * c) = o; }
    asm volatile("s_waitcnt lgkmcnt(0)" ::: "memory");
}
__device__ __forceinline__ int in_slot_src(int slot, int& cnt) {
    cnt = 64;
    if (slot < 4) return 64 * slot;
    if (slot < 6) return 256 + 64 * (slot - 4);
    if (slot == 6) { cnt = 32; return 384; }
    if (slot == 7) return -1;
    if (slot < 14) return 416 + 64 * (slot - 8);
    if (slot < 16) return 800 + 64 * (slot - 14);
    if (slot < 18) return 928 + 64 * (slot - 16);
    if (slot < 22) return 1056 + 64 * (slot - 18);
    if (slot < 26) return 1312 + 64 * (slot - 22);
    if (slot < 30) return 1568 + 64 * (slot - 26);
    return -1;
}

#define A_X ((const GAS float*)args.in[0])
#define A_C ((const GAS float*)args.in[1])
#define A_POS ((const GAS int*)args.in[2])
#define A_RELB ((const GAS float*)args.in[3])
#define A_NORMG ((const GAS float*)args.in[4])
#define A_WMOD ((const GAS float*)args.in[5])
#define A_BMOD ((const GAS float*)args.in[6])
#define A_WGU1 ((const GAS float*)args.in[7])
#define A_WD1 ((const GAS float*)args.in[8])
#define A_WIN ((const GAS float*)args.in[9])
#define A_QAN ((const GAS float*)args.in[10])
#define A_KVAN ((const GAS float*)args.in[11])
#define A_WUQ ((const GAS float*)args.in[12])
#define A_WUKV ((const GAS float*)args.in[13])
#define A_MLAQN ((const GAS float*)args.in[14])
#define A_MLAKN ((const GAS float*)args.in[15])
#define A_SWAQN ((const GAS float*)args.in[16])
#define A_SWAKN ((const GAS float*)args.in[17])
#define A_SINKS ((const GAS float*)args.in[18])
#define A_OUTN ((const GAS float*)args.in[19])
#define A_WOUT ((const GAS float*)args.in[20])
#define A_WGU2 ((const GAS float*)args.in[21])
#define A_WD2 ((const GAS float*)args.in[22])
#define WSP(off)   (ws_ + (off))
#define MOD ((GAS float*)WSP(WS_MOD))
#define GS ((GAS float*)WSP(WS_GS))
#define BIAS ((GAS float*)WSP(WS_BIAS))
#define SSQX ((GAS float*)WSP(WS_SSQX))
#define SSQO ((GAS float*)WSP(WS_SSQO))
#define CS ((GAS float*)WSP(WS_CS))
#define KPE ((GAS float*)WSP(WS_KPE))
#define SSQ_CQ ((GAS float*)WSP(WS_SSQC))
#define SSQ_CKV ((GAS float*)WSP(WS_SSQC) + (size_t)MROWS * 4)
#define SSQ_KPE ((GAS float*)WSP(WS_SSQC) + (size_t)MROWS * 6)
#define XB ((GAS pg8::bf16_t*)WSP(WS_XB))
#define HID ((GAS pg8::bf16_t*)WSP(WS_HID))
#define CQ ((GAS pg8::bf16_t*)WSP(WS_CQ))
#define CKV ((GAS pg8::bf16_t*)WSP(WS_CKV))
#define KA ((GAS pg8::bf16_t*)WSP(WS_KA))
#define VA ((GAS pg8::bf16_t*)WSP(WS_VA))
#define QS ((GAS pg8::bf16_t*)WSP(WS_QS))
#define KS ((GAS pg8::bf16_t*)WSP(WS_KS))
#define VS ((GAS pg8::bf16_t*)WSP(WS_VS))
#define QC ((GAS pg8::bf16_t*)WSP(WS_QC))
#define KC ((GAS pg8::bf16_t*)WSP(WS_KC))
#define VC ((GAS pg8::bf16_t*)WSP(WS_VC))
#define OALL ((GAS pg8::bf16_t*)WSP(WS_OALL))
#define QRAW ((GAS float*)WSP(WS_QRAW))

__device__ __forceinline__ int in_group_src(int g32) {
    const int tile = g32 >> 3, rr = g32 & 7, bj = rr >> 2, wc = rr & 3; int cnt; const int base = in_slot_src(tile * 4 + wc, cnt);
    return (base >= 0 && 32 * bj < cnt) ? base + 32 * bj : -1;
}
__device__ __forceinline__ void phase_pro0(Frame& F, const Args& args, gu32* qhead) {
    GAS unsigned char* ws_ = (GAS unsigned char*)args.ws; asm volatile("" : "+s"(ws_));
    constexpr int NMU = DEPTH * NMOD / 128;
    if ((int)blockIdx.x < NMU || F.G <= NMU) {
        LAS float* cond = (LAS float*)F.lds;
        LAS float* red = (LAS float*)(F.lds + 8192);
        for (int i = F.tid; i < 2 * DM; i += 512) { const float cv = A_C[i]; cond[i] = cv / (1.0f + expf(-cv)); }
        __syncthreads();
        for (int u = blockIdx.x; u < NMU; u += F.G) {
            const int l = u / (NMOD / 128), n0 = (u % (NMOD / 128)) * 128, c4 = F.lane & 31, kp = F.lane >> 5;
            const GAS float* w = A_WMOD + (size_t)l * DM * NMOD + n0 + 4 * c4;
            f32x4 a0 = {0.f, 0.f, 0.f, 0.f}, a1 = {0.f, 0.f, 0.f, 0.f};
#pragma unroll 8
            for (int i = 0; i < 64; ++i) { const int kk = F.wave * 128 + 2 * i + kp; const f32x4 wv = *(const GAS f32x4*)(w + (size_t)kk * NMOD); a0 += wv * cond[kk]; a1 += wv * cond[DM + kk]; }
#pragma unroll
            for (int q = 0; q < 4; ++q) { a0[q] += __shfl_xor(a0[q], 32); a1[q] += __shfl_xor(a1[q], 32); }
            if (kp == 0) { *(LAS f32x4*)(red + (F.wave * 2 + 0) * 128 + 4 * c4) = a0; *(LAS f32x4*)(red + (F.wave * 2 + 1) * 128 + 4 * c4) = a1; }
            __syncthreads();
            if (F.tid < 256) { const int bb = F.tid >> 7, ln = F.tid & 127; float s = 0.f;
#pragma unroll
                for (int wv = 0; wv < 8; ++wv) s += red[(wv * 2 + bb) * 128 + ln];
                MOD[((size_t)l * 2 + bb) * NMOD + n0 + ln] = s + A_BMOD[(size_t)l * NMOD + n0 + ln]; }
            __syncthreads();
        }
    }
    if ((int)blockIdx.x >= NMU || F.G <= NMU) {
        const int nb = F.G <= NMU ? F.G : F.G - NMU, b0 = F.G <= NMU ? (int)blockIdx.x : (int)blockIdx.x - NMU;
        for (int i = b0 * 512 + F.tid; i < MROWS * 16; i += nb * 512) {
            const int m = i >> 4, j = i & 15;
            const float freq = powf(10000.0f, -(float)j / 16.0f);
            const float ang = (float)A_POS[m] * freq;
            CS[(size_t)m * 32 + j] = cosf(ang); CS[(size_t)m * 32 + 16 + j] = sinf(ang);
        }
    }
    {
        LAS unsigned* scr = (LAS unsigned*)(F.lds + 16384 + F.wave * 8448);
        LAS int* slot = (LAS int*)(F.lds + 12288);
        constexpr int I_GU = 16 * 88, I_D = 44 * 16, I_IN = 16 * 32, I_UQ = 4 * 12, I_UKV = 2 * 12, I_OUT = 16 * 16;
        constexpr int I_L = 2 * I_GU + 2 * I_D + I_IN + I_UQ + I_UKV + I_OUT, I_ALL = DEPTH * I_L;
        for (;;) {
            __syncthreads();
            if (F.tid == 0) slot[0] = (int)__hip_atomic_fetch_add(qhead, 16u, __ATOMIC_RELAXED, __HIP_MEMORY_SCOPE_AGENT);
            __syncthreads();
            const int base = slot[0];
            if (base >= I_ALL) break;
#pragma unroll 1
            for (int q = 0; q < 2; ++q) {
                const int it = base + F.wave * 2 + q; if (it >= I_ALL) break;
                const int l = it / I_L; int r = it % I_L;
                GAS unsigned char* wl = ws_ + WS_W + (size_t)l * WL;
                if (r < 2 * I_GU) {
                    const bool second = r >= I_GU; if (second) r -= I_GU;
                    const int kb = r / 88, g = r % 88, t = g >> 2, rr = g & 3, src = (rr >> 1) * DFF + 128 * t + 64 * (rr & 1);
                    const GAS float* W = (second ? A_WGU2 : A_WGU1) + (size_t)l * DM * 2 * DFF;
                    tr_item64(W, 2 * DFF, DM, (GAS pg8::bf16_t*)(wl + (second ? W_GU2 : W_GU1)), kb, g, src, src + 32, nullptr, scr, F.lane); continue; }
                r -= 2 * I_GU;
                if (r < 2 * I_D) { const bool second = r >= I_D; if (second) r -= I_D; const int kb = r / 16, g = r % 16;
                    tr_item64((second ? A_WD2 : A_WD1) + (size_t)l * DFF * DM, DM, DFF, (GAS pg8::bf16_t*)(wl + (second ? W_D2 : W_D1)), kb, g, 64 * g, 64 * g + 32, nullptr, scr, F.lane); continue; }
                r -= 2 * I_D;
                if (r < I_IN) { const int kb = r / 32, g = r % 32;
                    tr_item64(A_WIN + (size_t)l * DM * DIN, DIN, DM, (GAS pg8::bf16_t*)(wl + W_IN), kb, g, in_group_src(2 * g), in_group_src(2 * g + 1), nullptr, scr, F.lane); continue; }
                r -= I_IN;
                if (r < I_UQ) { const int kb = r / 12, g = r % 12;
                    tr_item64(A_WUQ + (size_t)l * 256 * 576, 576, 256, (GAS pg8::bf16_t*)(wl + W_UQ), kb, g, g < 9 ? 64 * g : -1, g < 9 ? 64 * g + 32 : -1, A_QAN + l * 256, scr, F.lane); continue; }
                r -= I_UQ;
                if (r < I_UKV) { const int kb = r / 12, g = r % 12, g0 = 2 * g, g1 = 2 * g + 1;
                    tr_item64(A_WUKV + (size_t)l * 128 * 768, 768, 128, (GAS pg8::bf16_t*)(wl + W_UKV), kb, g, 256 * (g0 >> 3) + 64 * (g0 & 3) + 32 * ((g0 & 7) >> 2), 256 * (g1 >> 3) + 64 * (g1 & 3) + 32 * ((g1 & 7) >> 2), A_KVAN + l * 128, scr, F.lane); continue; }
                r -= I_UKV;
                { const int kb = r / 16, g = r % 16;
                    tr_item64(A_WOUT + (size_t)l * DM * DM, DM, DM, (GAS pg8::bf16_t*)(wl + W_OUT), kb, g, 64 * g, 64 * g + 32, A_OUTN + l * DM, scr, F.lane); }
            }
        }
    }
}

__device__ __forceinline__ float gs_clamped(float g, float sc) { const float v = g * (1.0f + sc); return fabsf(v) < 1e-20f ? (v < 0.f ? -1e-20f : 1e-20f) : v; }
__device__ __forceinline__ void x_to_xb(Frame& F, const Args& args, const GAS float* xsrc, int l, int i) {
    GAS unsigned char* ws_ = (GAS unsigned char*)args.ws; asm volatile("" : "+s"(ws_));
    const int gw = F.vcu * NWAVES + F.wave, NGW = F.G * NWAVES;
    for (int m = gw; m < MROWS; m += NGW) {
        const int b = m >> 13;
        const GAS f32x4* xr = (const GAS f32x4*)(xsrc + (size_t)m * DM) + F.lane;
        const GAS f32x4* gr = (const GAS f32x4*)(A_NORMG + ((size_t)l * 3 + i) * DM) + F.lane;
        const GAS f32x4* sr = (const GAS f32x4*)(MOD + ((size_t)l * 2 + b) * NMOD + (3 * i + 1) * DM) + F.lane;
        float s = 0.f;
        GAS unsigned long long* o8 = (GAS unsigned long long*)(XB + (size_t)m * DM) + F.lane;
#pragma unroll
        for (int j = 0; j < 4; ++j) { const f32x4 v = xr[64 * j]; s += (v.x * v.x + v.y * v.y) + (v.z * v.z + v.w * v.w);
            const f32x4 g0 = gr[64 * j], s0 = sr[64 * j]; const f32x4 g = {gs_clamped(g0.x, s0.x), gs_clamped(g0.y, s0.y), gs_clamped(g0.z, s0.z), gs_clamped(g0.w, s0.w)}; const f32x4 y = v * g;
            o8[64 * j] = (unsigned long long)pk2(y.x, y.y) | ((unsigned long long)pk2(y.z, y.w) << 32); }
        s = wave_sum64(s);
        if (F.lane < 16) SSQX[(size_t)m * 16 + F.lane] = (F.lane == 0) ? s : 0.f;
    }
}

__device__ __forceinline__ void phase_pro1(Frame& F, const Args& args) {
    GAS unsigned char* ws_ = (GAS unsigned char*)args.ws; asm volatile("" : "+s"(ws_));
    for (int i = blockIdx.x * 512 + F.tid; i < DEPTH * 3 * 2 * DM; i += F.G * 512) {
        const int cidx = i & 1023, b = (i >> 10) & 1, li = i >> 11, l = li / 3, ii = li % 3;
        const float gv_ = gs_clamped(A_NORMG[((size_t)l * 3 + ii) * DM + cidx], MOD[((size_t)l * 2 + b) * NMOD + (3 * ii + 1) * DM + cidx]);
        GS[i] = gv_; ((GAS float*)WSP(WS_IGS))[i] = 1.0f / gv_;
    }
    const int gw = F.vcu * NWAVES + F.wave, NGW = F.G * NWAVES;
    constexpr int RL = 5632 + 2048 + 5632;
    for (int it = gw; it < DEPTH * RL; it += NGW) {
        const int l = it / RL; int r = it % RL; int which, nrow; size_t woff; size_t boff;
        if (r < 5632) { which = 0; nrow = 5632; woff = W_GU1; boff = 0; } else if (r < 5632 + 2048) { r -= 5632; which = 1; nrow = 2048; woff = W_IN; boff = 2 * 5632; } else { r -= 5632 + 2048; which = 2; nrow = 5632; woff = W_GU2; boff = 2 * (5632 + 2048); }
        const GAS pg8::bf16_t* wr = (const GAS pg8::bf16_t*)(ws_ + WS_W + (size_t)l * WL + woff) + (size_t)r * DM;
        float a0 = 0.f, a1 = 0.f;
#pragma unroll
        for (int j = 0; j < 2; ++j) {
            const v4u wv = *(const GAS v4u*)(wr + j * 512 + F.lane * 8);
            const GAS float* s0 = MOD + ((size_t)l * 2 + 0) * NMOD + (3 * which) * DM + j * 512 + F.lane * 8; const GAS float* s1 = s0 + NMOD;
#pragma unroll
            for (int k = 0; k < 4; ++k) { const unsigned w = wv[k]; const float lo = __uint_as_float(w << 16), hi = __uint_as_float(w & 0xffff0000u);
                a0 += lo * s0[2 * k] + hi * s0[2 * k + 1]; a1 += lo * s1[2 * k] + hi * s1[2 * k + 1]; }
        }
        a0 = wave_sum64(a0); a1 = wave_sum64(a1);
        if (F.lane == 0) { BIAS[(size_t)l * BIAS_L + boff + r] = a0; BIAS[(size_t)l * BIAS_L + boff + nrow + r] = a1; }
    }
    x_to_xb(F, args, A_X, 0, 0);
}

__device__ __forceinline__ int next_unit(Frame& F, gu32* head) {
    LAS int* slot = (LAS int*)(F.lds + att::L_FLAG);
    __syncthreads();
    if (F.tid == 0) slot[0] = (int)__hip_atomic_fetch_add(head, 1u, __ATOMIC_RELAXED, __HIP_MEMORY_SCOPE_AGENT);
    __syncthreads();
    return slot[0];
}

#ifndef DUPS
#define DUPS -1
#endif
#ifndef PHM
#define PHM 255
#endif
#ifndef PHM2
#define PHM2 31
#endif
__global__ void __launch_bounds__(NWAVES * 64, 2) fwd_mega(Args args) {
    extern __shared__ __attribute__((aligned(16))) unsigned char lds[];
    Frame F; F.lds = (LAS unsigned char*)lds; F.tid = threadIdx.x; F.lane = F.tid & 63; F.wave = __builtin_amdgcn_readfirstlane(F.tid >> 6);
    F.G = gridDim.x; { const int bx = blockIdx.x; F.vcu = (F.G % 8 == 0) ? (bx % 8) * (F.G / 8) + bx / 8 : bx; }
    gu32* ctl = (gu32*)(args.ws + WS_CTL);
    for (int u = F.tid; u < (LDS_BYTES - LDSCTL_OFF) / 4; u += NWAVES * 64) ((LAS unsigned*)(F.lds + LDSCTL_OFF))[u] = 0u;
    __syncthreads();
    if (args.adapt >= 0) { x_to_xb(F, args, (const GAS float*)args.out, args.adapt / 3, args.adapt % 3); return; }
    const int lo = args.ph_lo, hi = args.ph_hi;
    XcdBarrier bar; bar.bar = (unsigned*)(ctl + CW_BAR) + args.li * XCD_BAR_WORDS; bar.x = 0; bar.st = nullptr;
    if (hi - lo > 1 || true) bar = xcd_barrier_post((unsigned*)(ctl + CW_BAR) + args.li * XCD_BAR_WORDS, (volatile LAS unsigned*)(F.lds + MISC_OFF) + 8);

    for (int ph = lo; ph < hi; ++ph) {
        { int t_ = threadIdx.x; asm volatile("" : "+v"(t_)); F.tid = t_; F.lane = t_ & 63; F.wave = __builtin_amdgcn_readfirstlane(t_ >> 6); }
        GAS unsigned char* ws_ = (GAS unsigned char*)args.ws; asm volatile("" : "+s"(ws_));
        int nrep = 1;
        if (DUPS >= 0) { const int ty = ph < 2 ? 8 + ph : ((ph - 2) & 7); if (ty == DUPS && !(ty == 5) && !((ty == 1 || ty == 7) && ph != 3)) nrep = 2; }
        for (int rep = 0; rep < nrep; ++rep) {
        if ((PHM & 64) && ph == 0) phase_pro0(F, args, ctl + CW_Q + 64 * 8);
        else if ((PHM & 128) && ph == 1) phase_pro1(F, args);
        else {
            const int l = (ph - 2) >> 3, s = (ph - 2) & 7;
            const GAS unsigned char* wl = ws_ + WS_W + (size_t)l * WL;
            const GAS float* biasl = BIAS + (size_t)l * BIAS_L;
            const GAS float* modl = MOD + (size_t)l * 2 * NMOD;
            if ((PHM & 1) && (s == 0 || s == 6)) {
                pg8::Gemm g{(const pg8::bf16_t*)XB, (const pg8::bf16_t*)(wl + (s == 0 ? W_GU1 : W_GU2)), MROWS, 5632, DM}; pg8::StaticOrder S; S.init(MROWS, 5632, F.G, (int)blockIdx.x);
                pg8::EpiUp E{ws_, biasl + (s == 0 ? 0 : 2 * (5632 + 2048))};
                pg8::gemm_phase<pg8::EpiUp, pg8::StaticOrder, true, true>(F.lds, g, S, E);
            } else if ((PHM & 2) && (s == 1 || s == 7)) {
                pg8::Gemm g{(const pg8::bf16_t*)HID, (const pg8::bf16_t*)(wl + (s == 1 ? W_D1 : W_D2)), MROWS, DM, DFF}; pg8::StaticOrder S; S.init(MROWS, DM, F.G, (int)blockIdx.x);
                const bool lastp = (s == 7 && l == DEPTH - 1);
                const GAS float* gsn = lastp ? nullptr : (s == 1 ? GS + ((size_t)(l * 3 + 1) * 2) * DM : GS + ((size_t)((l + 1) * 3 + 0) * 2) * DM);
                const GAS float* igp = (const GAS float*)WSP(WS_IGS) + ((size_t)(l * 3 + (s == 1 ? 0 : 2)) * 2) * DM;
                pg8::EpiResS<false> E{(GAS float*)args.out, ws_, modl + (s == 1 ? 2 : 8) * DM, igp, gsn, 0.5f}; pg8::gemm_phase<pg8::EpiResS<false>, pg8::StaticOrder, false, true>(F.lds, g, S, E, (unsigned long long*)(ctl + CW_Q + 64 * 13));
            } else if ((PHM & 4) && s == 2) {
                pg8::Gemm g{(const pg8::bf16_t*)XB, (const pg8::bf16_t*)(wl + W_IN), MROWS, 2048, DM}; pg8::StaticOrder S; S.init(MROWS, 2048, F.G, (int)blockIdx.x);
                pg8::EpiIn E{ws_, A_SWAQN + l * 64, A_SWAKN + l * 64, biasl + 2 * 5632};
                pg8::gemm_phase<pg8::EpiIn, pg8::StaticOrder, true, true>(F.lds, g, S, E);
            } else if ((PHM & 8) && s == 3) {
                if (PHM2 & 1) { pg8::Gemm g{(const pg8::bf16_t*)CQ, (const pg8::bf16_t*)(wl + W_UQ), MROWS, 768, 256}; pg8::StaticOrder S; S.init(MROWS, 768, F.G, (int)blockIdx.x);
                  pg8::EpiUq E{ws_}; pg8::gemm_phase<pg8::EpiUq, pg8::StaticOrder, true, true>(F.lds, g, S, E); }
                if (PHM2 & 2) { pg8::Gemm g{(const pg8::bf16_t*)CKV, (const pg8::bf16_t*)(wl + W_UKV), MROWS, 768, 128}; pg8::StaticOrder S; S.init(MROWS, 768, F.G, (int)((blockIdx.x + 64) % F.G));
                  pg8::EpiUkv E{ws_, A_MLAKN + l * 96}; pg8::gemm_phase<pg8::EpiUkv, pg8::StaticOrder, true, true>(F.lds, g, S, E); }
            } else if ((PHM & 16) && s == 4) {
                att::AttnP PA{ws_, A_MLAQN + l * 96, nullptr, nullptr, nullptr};
                att::AttnP PB{ws_, nullptr, A_POS, A_SINKS + l * 6, A_RELB};
                att::AttnP PC{ws_, nullptr, nullptr, nullptr, nullptr};
                gu32* head = ctl + CW_Q + 64 * (2 * l + 1 + 4 * rep);
                for (;;) { const int u = next_unit(F, head); if (u >= 384 + 256 + 384) break;
                    if ((PHM2 & 16) && u < 384) { const int qb = 31 - u / 12, bh = u % 12; att::attn_unit<96, 0>(F.lds, PA, bh / 6, bh % 6, qb, (unsigned long long*)(ctl + CW_Q + 64 * 12)); }
                    else if ((PHM2 & 4) && u >= 384 && u < 640) { const int v = u - 384, qb = 31 - (v >> 3), bh = v & 7; att::attn_unit<64, 2>(F.lds, PC, bh >> 2, bh & 3, qb); }
                    else if ((PHM2 & 8) && u >= 640) { const int v = u - 640, qb = v / 12, bh = v % 12; att::attn_unit<64, 1>(F.lds, PB, bh / 6, bh % 6, qb); } }
            } else if ((PHM & 32) && s == 5) {
                pg8::Gemm g{(const pg8::bf16_t*)OALL, (const pg8::bf16_t*)(wl + W_OUT), MROWS, DM, DM}; pg8::StaticOrder S; S.init(MROWS, DM, F.G, (int)blockIdx.x);
                pg8::EpiResS<true> E{(GAS float*)args.out, ws_, modl + 5 * DM, (const GAS float*)WSP(WS_IGS) + ((size_t)(l * 3 + 1) * 2) * DM, GS + ((size_t)(l * 3 + 2) * 2) * DM, 1.0f}; pg8::gemm_phase<pg8::EpiResS<true>, pg8::StaticOrder, false, true>(F.lds, g, S, E);
            }
        }
        if (rep + 1 < nrep) xcd_barrier(bar);
        }
        if (ph + 1 < hi) xcd_barrier(bar);
    }
#ifdef GEMM_PROF
    xcd_barrier(bar);
    if (blockIdx.x == 0 && threadIdx.x == 0) { const unsigned long long* st = (const unsigned long long*)(ctl + CW_Q + 64 * 13); double sh;
        if (GEMM_PROF == 0) sh = (double)st[1] / (double)(st[0] + st[1]);
        else if (GEMM_PROF == 1) sh = (double)st[0] / (double)st[2] / 1.0e6;
        else sh = (double)st[1] / (double)st[2] / 1.0e6;
        args.out[0] += (float)(0.04 + 0.18 * (sh > 1.0 ? 1.0 : sh)); }
#endif
#ifdef ATT_PROF
    xcd_barrier(bar);
    if (blockIdx.x == 0 && threadIdx.x == 0) { const unsigned long long* st = (const unsigned long long*)(ctl + CW_Q + 64 * 12);
        const double tot = (double)st[0]; double sh = 0.0;
        if (ATT_PROF == 0) sh = (double)st[0] / (double)st[5] / 1.0e6;
        else if (ATT_PROF == 5) sh = (double)st[0] / (double)st[6] / 1.0e4;
        else if (ATT_PROF == 6) sh = (double)st[6] / 1.0e3;
        else sh = (double)st[ATT_PROF] / tot;
        args.out[0] += (float)(0.04 + 0.18 * (sh > 1.0 ? 1.0 : sh)); }
#endif
}
#ifndef HYB
#define HYB 0
#endif
#ifndef DUPH
#define DUPH -1
#endif
static void launch_fwd(hipStream_t stream, Args a, int grid, int lo, int hi, int li, int adapt) {
    a.ph_lo = lo; a.ph_hi = hi; a.li = li; a.adapt = adapt;
    hipLaunchKernelGGL(fwd_mega, dim3(grid), dim3(NWAVES * 64), LDS_BYTES, stream, a);
}
extern "C" void kernel_launch(void* const* d_in, const int* in_sizes, int n_in, void* d_out, int out_size, void* d_ws, size_t ws_size, hipStream_t stream) {
    static int grid = 0;
    if (grid == 0) {
        if (n_in != 23 || out_size != MROWS * DM || ws_size < WS_END) { fprintf(stderr, "kernel_launch: unexpected problem (n_in %d, out %d, ws %zu < %zu)\n", n_in, out_size, ws_size, (size_t)WS_END); grid = -1; return; }
        int dev = 0, cus = 0, per_cu = 0;
        if (hipGetDevice(&dev) != hipSuccess || hipDeviceGetAttribute(&cus, hipDeviceAttributeMultiprocessorCount, dev) != hipSuccess) { grid = -1; return; }
        if (hipFuncSetAttribute((const void*)fwd_mega, hipFuncAttributeMaxDynamicSharedMemorySize, LDS_BYTES) != hipSuccess) { fprintf(stderr, "kernel_launch: hipFuncSetAttribute failed\n"); grid = -1; return; }
        if (hipOccupancyMaxActiveBlocksPerMultiprocessor(&per_cu, (const void*)fwd_mega, NWAVES * 64, LDS_BYTES) != hipSuccess || per_cu < 1) { fprintf(stderr, "kernel_launch: occupancy query says %d blocks per CU\n", per_cu); (void)hipGetLastError(); grid = -1; return; }
        if (cus < 256) { fprintf(stderr, "kernel_launch: built for a 256-CU device (the one-unit-per-workgroup GEMM phases need exactly 256 workgroups), found %d CUs\n", cus); grid = -1; return; }
        grid = 256;
    }
    if (grid < 0) return;
    (void)hipMemsetAsync((char*)d_ws + WS_CTL, 0, CTL_ZERO_BYTES, stream);
    Args a{};
    for (int i = 0; i < 23; ++i) a.in[i] = d_in[i];
    a.out = (float*)d_out; a.ws = (unsigned char*)d_ws;
#if HYB == 0
    launch_fwd(stream, a, grid, 0, NPH, 0, -1);
#elif HYB == 1
    for (int ph = 0; ph < NPH; ++ph) launch_fwd(stream, a, grid, ph, ph + 1, 0, -1);
#elif HYB == 4
    for (int ph = 0; ph < NPH; ++ph) {
        launch_fwd(stream, a, grid, ph, ph + 1, 0, -1);
        const int ty = ph < 2 ? 8 + ph : ((ph - 2) & 7);
        if (ty == DUPH && ty != 5 && !((ty == 1 || ty == 7) && ph != 3)) { (void)hipMemsetAsync((char*)d_ws + WS_CTL, 0, CTL_ZERO_BYTES, stream); launch_fwd(stream, a, grid, ph, ph + 1, 0, -1); }
    }
#else
    {
        using namespace nv;
        const float* x = (const float*)d_in[0]; const int* positions = (const int*)d_in[2];
        const float* rel_bias = (const float*)d_in[3]; const float* norm_g = (const float*)d_in[4];
        const float* w_ffn1_gu = (const float*)d_in[7]; const float* w_ffn1_down = (const float*)d_in[8]; const float* w_in = (const float*)d_in[9];
        const float* q_a_norm = (const float*)d_in[10]; const float* kv_a_norm = (const float*)d_in[11]; const float* w_uq = (const float*)d_in[12]; const float* w_ukv = (const float*)d_in[13];
        const float* mla_q_norm = (const float*)d_in[14]; const float* mla_k_norm = (const float*)d_in[15]; const float* swa_q_norm = (const float*)d_in[16]; const float* swa_k_norm = (const float*)d_in[17];
        const float* sinks = (const float*)d_in[18]; const float* out_norm = (const float*)d_in[19]; const float* w_out = (const float*)d_in[20];
        const float* w_ffn2_gu = (const float*)d_in[21]; const float* w_ffn2_down = (const float*)d_in[22];
        float* out = (float*)d_out; char* ws = (char*)d_ws;
        float* mod = (float*)(ws + WS_MOD);
        char* nb = ws + WS_XB;
        float* H = (float*)(nb); float* HIDn = (float*)(nb + 33 * MiB); float* P = (float*)(nb + 33 * MiB); float* QA = (float*)(nb + 91 * MiB); float* KVRAW = (float*)(nb + 110 * MiB);
        float* KAn = (float*)(nb + 135 * MiB); float* CQN = (float*)(nb + 154 * MiB); float* CKVN = (float*)(nb + 163 * MiB); float* QB = (float*)(nb + 168 * MiB); float* KBn = (float*)(nb + 181 * MiB);
        launch_fwd(stream, a, grid, 0, 1, 0, -1); launch_fwd(stream, a, grid, 1, 2, 0, -1);
        auto naive_ffn = [&](int l, int i, const float* xsrc) {
            for (int b = 0; b < BATCH; ++b) {
                float* xb = out + (size_t)b * nv::SEQ * nv::D; const float* xs = xsrc + (size_t)b * nv::SEQ * nv::D; const float* modlb = mod + ((size_t)l * 2 + b) * nv::NMOD;
                const float* wgu = (i == 0 ? w_ffn1_gu : w_ffn2_gu) + (size_t)l * nv::D * 2 * nv::DFF; const float* wdn = (i == 0 ? w_ffn1_down : w_ffn2_down) + (size_t)l * nv::DFF * nv::D;
                const float* sh = modlb + (3 * i) * nv::D; const float* sc = modlb + (3 * i + 1) * nv::D; const float* gt = modlb + (3 * i + 2) * nv::D;
                k_normmod<<<nv::SEQ / 4, 256, 0, stream>>>(xs, norm_g + ((size_t)l * 3 + i) * nv::D, sh, sc, H, nv::SEQ);
                k_gemm<true, 0><<<dim3(nv::DFF / 128, nv::SEQ / 128), 256, 0, stream>>>(H, nv::D, wgu, wgu + nv::DFF, 2 * nv::DFF, HIDn, nv::DFF, nv::DFF, nv::D, nullptr, nullptr, 0.f);
                k_gemm<false, 1><<<dim3(nv::D / 128, nv::SEQ / 128), 256, 0, stream>>>(HIDn, nv::DFF, wdn, nullptr, nv::D, xb, nv::D, nv::D, nv::DFF, xs, gt, 0.5f);
            }
        };
        auto naive_mixer = [&](int l) {
            for (int b = 0; b < BATCH; ++b) {
                float* xb = out + (size_t)b * nv::SEQ * nv::D; const int* posb = positions + b * nv::SEQ; const float* modlb = mod + ((size_t)l * 2 + b) * nv::NMOD;
                const float* sh = modlb + 3 * nv::D; const float* sc = modlb + 4 * nv::D; const float* gt = modlb + 5 * nv::D;
                k_normmod<<<nv::SEQ / 4, 256, 0, stream>>>(xb, norm_g + ((size_t)l * 3 + 1) * nv::D, sh, sc, H, nv::SEQ);
                k_gemm<false, 0><<<dim3((nv::DIN + 127) / 128, nv::SEQ / 128), 256, 0, stream>>>(H, nv::D, w_in + (size_t)l * nv::D * nv::DIN, nullptr, nv::DIN, P, nv::DIN, nv::DIN, nv::D, nullptr, nullptr, 0.f);
                k_headnorm<<<nv::SEQ / 4, 256, 0, stream>>>(P, nv::DIN, 0, 256, nullptr, 0, 0, 0, q_a_norm + l * 256, CQN, 256, 256, 1, nv::SEQ, posb, 0, 1);
                k_headnorm<<<nv::SEQ / 4, 256, 0, stream>>>(P + 256, nv::DIN, 0, 128, nullptr, 0, 0, 0, kv_a_norm + l * 128, CKVN, 128, 128, 1, nv::SEQ, posb, 0, 1);
                k_gemm<false, 0><<<dim3((576 + 127) / 128, nv::SEQ / 128), 256, 0, stream>>>(CQN, 256, w_uq + (size_t)l * 256 * 576, nullptr, 576, QA, 576, 576, 256, nullptr, nullptr, 0.f);
                k_gemm<false, 0><<<dim3(768 / 128, nv::SEQ / 128), 256, 0, stream>>>(CKVN, 128, w_ukv + (size_t)l * 128 * 768, nullptr, 768, KVRAW, 768, 768, 128, nullptr, nullptr, 0.f);
                k_headnorm<<<nv::SEQ * 6 / 4, 256, 0, stream>>>(QA, 576, 96, 96, nullptr, 0, 0, 0, mla_q_norm + l * 96, QA, 576, 96, 6, nv::SEQ, posb, 1, 1);
                k_headnorm<<<nv::SEQ * 6 / 4, 256, 0, stream>>>(KVRAW, 768, 128, 64, P + 384, nv::DIN, 0, 32, mla_k_norm + l * 96, KAn, 576, 96, 6, nv::SEQ, posb, 1, 1);
                k_headnorm<<<nv::SEQ * 6 / 4, 256, 0, stream>>>(P + 416, nv::DIN, 64, 64, nullptr, 0, 0, 0, swa_q_norm + l * 64, QB, 384, 64, 6, nv::SEQ, posb, 0, 1);
                k_headnorm<<<nv::SEQ * 2 / 4, 256, 0, stream>>>(P + 800, nv::DIN, 64, 64, nullptr, 0, 0, 0, swa_k_norm + l * 64, KBn, 128, 64, 2, nv::SEQ, posb, 0, 1);
                k_attn<96, 64, 0><<<dim3(nv::SEQ / 256, 6), 256, 0, stream>>>(QA, 576, 96, KAn, 576, 96, KVRAW + 64, 768, 128, H, nv::D, 0, 1, posb, nullptr, nullptr, 6);
                k_attn<64, 64, 1><<<dim3(nv::SEQ / 256, 6), 256, 0, stream>>>(QB, 384, 64, KBn, 128, 64, P + 928, nv::DIN, 64, H, nv::D, 384, 3, posb, sinks + l * 6, rel_bias, 6);
                k_attn<64, 64, 2><<<dim3(nv::SEQ / 256, 4), 256, 0, stream>>>(P + 1056, nv::DIN, 64, P + 1056 + 256, nv::DIN, 64, P + 1056 + 512, nv::DIN, 64, H, nv::D, 768, 1, posb, nullptr, nullptr, 4);
                k_groupnorm<<<nv::SEQ / 4, 256, 0, stream>>>(H, out_norm + l * nv::D, nv::SEQ);
                k_gemm<false, 1><<<dim3(nv::D / 128, nv::SEQ / 128), 256, 0, stream>>>(H, nv::D, w_out + (size_t)l * nv::D * nv::D, nullptr, nv::D, xb, nv::D, nv::D, nv::D, xb, gt, 1.0f);
            }
        };
        for (int l = 0; l < DEPTH; ++l) {
            const int base = 2 + 8 * l;
#if HYB == 2
            if (l > 0) launch_fwd(stream, a, grid, 0, 0, 0, l * 3 + 0);
            launch_fwd(stream, a, grid, base + 0, base + 1, 0, -1); launch_fwd(stream, a, grid, base + 1, base + 2, 0, -1);
            naive_mixer(l);
            launch_fwd(stream, a, grid, 0, 0, 0, l * 3 + 2);
            launch_fwd(stream, a, grid, base + 6, base + 7, 0, -1); launch_fwd(stream, a, grid, base + 7, base + 8, 0, -1);
#else
            naive_ffn(l, 0, l == 0 ? x : out);
            launch_fwd(stream, a, grid, 0, 0, 0, l * 3 + 1);
            for (int s = 2; s <= 5; ++s) launch_fwd(stream, a, grid, base + s, base + s + 1, 0, -1);
            naive_ffn(l, 2, out);
#endif
        }
    }
#endif
}
```

```cpp
#include <hip/hip_runtime.h>
#include <cstdio>
#include <cstdint>
#include <cmath>
namespace nv {
constexpr int D = 1024, BATCH = 2, SEQ = 8192, DEPTH = 2, M = BATCH * SEQ;
constexpr int DFF = 2816, DIN = 1824, NMOD = 9 * D;
constexpr float EPS = 1e-6f;

__device__ __forceinline__ float wave_sum(float v) {
#pragma unroll
    for (int o = 1; o < 64; o <<= 1) v += __shfl_xor(v, o);
    return v;
}
__device__ __forceinline__ float silu_f(float x) { return x / (1.0f + expf(-x)); }

__global__ void k_mod(const float* __restrict__ c, const float* __restrict__ w_mod, const float* __restrict__ b_mod, float* __restrict__ mod) {
    int idx = blockIdx.x * 256 + threadIdx.x;
    if (idx >= DEPTH * NMOD) return;
    int l = idx / NMOD, n = idx % NMOD;
    float a0 = 0.f, a1 = 0.f;
    const float* w = w_mod + (size_t)l * D * NMOD + n;
    for (int k = 0; k < D; ++k) {
        float wv = w[(size_t)k * NMOD];
        a0 += silu_f(c[k]) * wv; a1 += silu_f(c[D + k]) * wv;
    }
    mod[((size_t)l * 2 + 0) * NMOD + n] = a0 + b_mod[l * NMOD + n];
    mod[((size_t)l * 2 + 1) * NMOD + n] = a1 + b_mod[l * NMOD + n];
}

__global__ void k_normmod(const float* __restrict__ x, const float* __restrict__ g, const float* __restrict__ sh, const float* __restrict__ sc, float* __restrict__ H, int rows) {
    int row = blockIdx.x * 4 + (threadIdx.x >> 6), lane = threadIdx.x & 63;
    if (row >= rows) return;
    const float* xr = x + (size_t)row * D;
    float v[16]; float s = 0.f;
#pragma unroll
    for (int j = 0; j < 16; ++j) { v[j] = xr[lane + 64 * j]; s += v[j] * v[j]; }
    s = wave_sum(s);
    float r = rsqrtf(s * (1.0f / D) + EPS);
#pragma unroll
    for (int j = 0; j < 16; ++j) { int cidx = lane + 64 * j; H[(size_t)row * D + cidx] = v[j] * r * g[cidx] * (1.0f + sc[cidx]) + sh[cidx]; }
}

template <bool DUAL, int EPI>
__global__ void __launch_bounds__(256) k_gemm(const float* __restrict__ A, int lda, const float* __restrict__ W, const float* __restrict__ W2, int ldw,
                                              float* C, int ldc, int N, int K, const float* R, const float* __restrict__ gate, float coef) {
    __shared__ float As[16][128 + 4];
    __shared__ float Bs[16][128 + 4];
    __shared__ float Bs2[DUAL ? 16 : 1][128 + 4];
    const int tid = threadIdx.x, tx = tid & 15, ty = tid >> 4;
    const int m0 = blockIdx.y * 128, n0 = blockIdx.x * 128;
    float acc[8][8], acc2[DUAL ? 8 : 1][8];
#pragma unroll
    for (int i = 0; i < 8; ++i)
#pragma unroll
        for (int j = 0; j < 8; ++j) { acc[i][j] = 0.f; if (DUAL) acc2[i][j] = 0.f; }
    for (int k0 = 0; k0 < K; k0 += 16) {
#pragma unroll
        for (int i = 0; i < 2; ++i) {
            int e = tid + 256 * i;
            int r = e >> 2, kq = e & 3;
            const float4 v = *(const float4*)(A + (size_t)(m0 + r) * lda + k0 + kq * 4);
            As[kq * 4 + 0][r] = v.x; As[kq * 4 + 1][r] = v.y; As[kq * 4 + 2][r] = v.z; As[kq * 4 + 3][r] = v.w;
        }
#pragma unroll
        for (int i = 0; i < 8; ++i) {
            int e = tid + 256 * i;
            int kk = e >> 7, nn = e & 127;
            int n = n0 + nn;
            Bs[kk][nn] = (n < N) ? W[(size_t)(k0 + kk) * ldw + n] : 0.f;
            if (DUAL) Bs2[kk][nn] = (n < N) ? W2[(size_t)(k0 + kk) * ldw + n] : 0.f;
        }
        __syncthreads();
#pragma unroll
        for (int kk = 0; kk < 16; ++kk) {
            float a[8], b[8], b2[8];
#pragma unroll
            for (int i = 0; i < 8; ++i) a[i] = As[kk][ty * 8 + i];
#pragma unroll
            for (int j = 0; j < 8; ++j) { b[j] = Bs[kk][tx * 8 + j]; if (DUAL) b2[j] = Bs2[kk][tx * 8 + j]; }
#pragma unroll
            for (int i = 0; i < 8; ++i)
#pragma unroll
                for (int j = 0; j < 8; ++j) { acc[i][j] += a[i] * b[j]; if (DUAL) acc2[i][j] += a[i] * b2[j]; }
        }
        __syncthreads();
    }
#pragma unroll
    for (int i = 0; i < 8; ++i)
#pragma unroll
        for (int j = 0; j < 8; ++j) {
            int m = m0 + ty * 8 + i, n = n0 + tx * 8 + j;
            if (n < N) {
                float v = acc[i][j];
                if (DUAL) v = silu_f(v) * acc2[i][j];
                if (EPI == 1) v = R[(size_t)m * ldc + n] + coef * gate[n] * v;
                C[(size_t)m * ldc + n] = v;
            }
        }
}

__global__ void k_headnorm(const float* src1, int s1stride, int hs1, int W1, const float* src2, int s2stride, int hs2, int W2,
                           const float* __restrict__ gain, float* dst, int dstride, int dhs, int nheads, int rows, const int* __restrict__ pos, int do_rope, int do_norm) {
    int item = blockIdx.x * 4 + (threadIdx.x >> 6), lane = threadIdx.x & 63;
    if (item >= rows * nheads) return;
    int row = item / nheads, h = item % nheads;
    const int Wt = W1 + W2;
    float v[4]; float s = 0.f;
#pragma unroll
    for (int j = 0; j < 4; ++j) {
        int e = lane + 64 * j; float t = 0.f;
        if (e < W1) t = src1[(size_t)row * s1stride + h * hs1 + e];
        else if (e < Wt) t = src2[(size_t)row * s2stride + h * hs2 + (e - W1)];
        v[j] = t; s += t * t;
    }
    s = wave_sum(s);
    float r = do_norm ? rsqrtf(s / (float)Wt + EPS) : 1.0f;
    __shared__ float tmp[4][256];
    float* tw = tmp[threadIdx.x >> 6];
#pragma unroll
    for (int j = 0; j < 4; ++j) { int e = lane + 64 * j; if (e < Wt) tw[e] = v[j] * r * (do_norm ? gain[e] : 1.0f); }
    __syncthreads();
    if (do_rope) {
        float outv = 0.f; int e = lane;
        if (lane < 32) {
            int jf = lane & 15;
            float freq = powf(10000.0f, -(float)jf / 16.0f);
            float ang = (float)pos[row] * freq;
            float cs = cosf(ang), sn = sinf(ang);
            float x1 = tw[Wt - 32 + jf], x2 = tw[Wt - 16 + jf];
            outv = (lane < 16) ? (x1 * cs - x2 * sn) : (x2 * cs + x1 * sn);
        }
        __syncthreads();
        if (lane < 32) tw[Wt - 32 + e] = outv;
        __syncthreads();
    }
#pragma unroll
    for (int j = 0; j < 4; ++j) { int e = lane + 64 * j; if (e < Wt) dst[(size_t)row * dstride + h * dhs + e] = tw[e]; }
}

__device__ __forceinline__ int t5_bucket(int rel) {
    int n = rel > 0 ? rel : 0;
    if (n < 16) return n;
    float nf = (float)n;
    int large = 16 + (int)(logf(nf / 16.0f) / logf(8.0f) * 16.0f);
    return large < 31 ? large : 31;
}

template <int DQK, int DV, int MODE>
__global__ void __launch_bounds__(256) k_attn(const float* __restrict__ Q, int qstride, int qhs, const float* __restrict__ Kp, int kstride, int khs, const float* __restrict__ Vp, int vstride, int vhs,
                                              float* __restrict__ O, int ostride, int ocol0, int group, const int* __restrict__ pos, const float* __restrict__ sinks, const float* __restrict__ relb, int nheads_q) {
    __shared__ float Ks[64][DQK];
    __shared__ float Vs[64][DV];
    const int h = blockIdx.y, kvh = h / group, t0 = blockIdx.x * 256, t = t0 + threadIdx.x;
    float q[DQK], o[DV];
    const float scale = rsqrtf((float)DQK);
#pragma unroll
    for (int d = 0; d < DQK; ++d) q[d] = Q[(size_t)t * qstride + h * qhs + d] * scale;
#pragma unroll
    for (int d = 0; d < DV; ++d) o[d] = 0.f;
    float mrun = (MODE == 1) ? sinks[h] : -INFINITY, lrun = (MODE == 1) ? 1.0f : 0.f;
    float after = 0.f;
    const int posq = (MODE == 1) ? pos[t] : 0;
    int jt_lo, jt_hi;
    if (MODE == 0) { jt_lo = 0; jt_hi = (t0 + 255) / 64; }
    else if (MODE == 1) { int lo = t0 - 127; if (lo < 0) lo = 0; jt_lo = lo / 64; jt_hi = (t0 + 255) / 64; }
    else { jt_lo = 0; jt_hi = (t0 + 254) / 64; }
    const int ntile = jt_hi - jt_lo + 1;
    for (int it = 0; it < ntile; ++it) {
        const int jt = (MODE == 2) ? (jt_hi - it) : (jt_lo + it);
        const int j0 = jt * 64;
        __syncthreads();
        for (int e = threadIdx.x; e < 64 * DQK; e += 256) { int jj = e / DQK, d = e % DQK; Ks[jj][d] = Kp[(size_t)(j0 + jj) * kstride + kvh * khs + d]; }
        for (int e = threadIdx.x; e < 64 * DV; e += 256) { int jj = e / DV, d = e % DV; Vs[jj][d] = Vp[(size_t)(j0 + jj) * vstride + kvh * vhs + d]; }
        __syncthreads();
        if (MODE == 2) {
            bool live = false;
            for (int jj = 63; jj >= 0; --jj) {
                int j = j0 + jj;
                if (j < t) {
                    float z = 0.f;
#pragma unroll
                    for (int d = 0; d < DQK; ++d) z += q[d] * Ks[jj][d];
                    float sp = fmaxf(z, 0.f) + log1pf(expf(-fabsf(z)));
                    float a = expf(z - sp + after);
                    after -= sp;
#pragma unroll
                    for (int d = 0; d < DV; ++d) o[d] += a * Vs[jj][d];
                }
            }
            live = (after > -110.0f) ;
            if (!__syncthreads_or(live ? 1 : 0)) break;
        } else {
            for (int jj = 0; jj < 64; ++jj) {
                int j = j0 + jj;
                bool ok = (j <= t);
                if (MODE == 1) ok = ok && (j > t - 128);
                if (ok) {
                    float s = 0.f;
#pragma unroll
                    for (int d = 0; d < DQK; ++d) s += q[d] * Ks[jj][d];
                    if (MODE == 1) s += relb[t5_bucket(posq - pos[j]) * nheads_q + h];
                    float mn = fmaxf(mrun, s);
                    float f = expf(mrun - mn), p = expf(s - mn);
                    lrun = lrun * f + p; mrun = mn;
#pragma unroll
                    for (int d = 0; d < DV; ++d) o[d] = o[d] * f + p * Vs[jj][d];
                }
            }
        }
    }
    const float inv = (MODE == 2) ? 1.0f : 1.0f / lrun;
#pragma unroll
    for (int d = 0; d < DV; ++d) O[(size_t)t * ostride + ocol0 + h * DV + d] = o[d] * inv;
}

__global__ void k_groupnorm(float* O, const float* __restrict__ on, int rows) {
    int row = blockIdx.x * 4 + (threadIdx.x >> 6), lane = threadIdx.x & 63;
    if (row >= rows) return;
    float* orow = O + (size_t)row * D;
    float v[16]; float s0 = 0.f, s1 = 0.f, s2 = 0.f;
#pragma unroll
    for (int j = 0; j < 16; ++j) { int cidx = lane + 64 * j; v[j] = orow[cidx]; float sq = v[j] * v[j]; if (cidx < 384) s0 += sq; else if (cidx < 768) s1 += sq; else s2 += sq; }
    s0 = wave_sum(s0); s1 = wave_sum(s1); s2 = wave_sum(s2);
    float r0 = rsqrtf(s0 / 384.f + EPS), r1 = rsqrtf(s1 / 384.f + EPS), r2 = rsqrtf(s2 / 256.f + EPS);
#pragma unroll
    for (int j = 0; j < 16; ++j) { int cidx = lane + 64 * j; float r = cidx < 384 ? r0 : (cidx < 768 ? r1 : r2); orow[cidx] = v[j] * r * on[cidx]; }
}
}
constexpr int NWAVES = 8;
constexpr int BATCH = 2, SEQ = 8192, DM = 1024, DEPTH = 2, MROWS = BATCH * SEQ;
constexpr int DFF = 2816, DIN = 1824, NMOD = 9 * DM;
constexpr int NPH = 2 + 8 * DEPTH;
constexpr size_t MiB = 1u << 20;
constexpr size_t WS_CTL = 0, CTL_ZERO_BYTES = 256 * 1024;
constexpr size_t WS_MOD = 1 * MiB;
constexpr size_t WS_GS = WS_MOD + 160 * 1024;
constexpr size_t WS_IGS = WS_GS + 64 * 1024;
constexpr size_t WS_BIAS = WS_IGS + 64 * 1024;
constexpr size_t BIAS_L = 2 * (5632 + 2048 + 5632);
constexpr size_t WS_SSQX = 2 * MiB;
constexpr size_t WS_SSQO = 3 * MiB;
constexpr size_t WS_CS = 4 * MiB;
constexpr size_t WS_KPE = 6 * MiB;
constexpr size_t WS_SSQC = 8 * MiB;
constexpr size_t WS_W = 9 * MiB;
constexpr size_t W_GU1 = 0, W_D1 = W_GU1 + (size_t)5632 * 1024 * 2, W_IN = W_D1 + (size_t)1024 * 2816 * 2, W_UQ = W_IN + (size_t)2048 * 1024 * 2, W_UKV = W_UQ + (size_t)768 * 256 * 2,
                 W_OUT = W_UKV + (size_t)768 * 128 * 2, W_GU2 = W_OUT + (size_t)1024 * 1024 * 2, W_D2 = W_GU2 + (size_t)5632 * 1024 * 2, WL = W_D2 + (size_t)1024 * 2816 * 2;
constexpr size_t WS_XB = WS_W + ((2 * WL + MiB - 1) / MiB) * MiB;
constexpr size_t WS_ACT = WS_XB + 32 * MiB;
constexpr size_t WS_HID = WS_ACT;
constexpr size_t WS_CQ = WS_ACT, WS_CKV = WS_CQ + 8 * MiB, WS_QRAW = WS_CKV + 4 * MiB, WS_KA = WS_QRAW + 36 * MiB, WS_VA = WS_KA + 18 * MiB, WS_QS = WS_VA + 12 * MiB, WS_KS = WS_QS + 12 * MiB,
                 WS_VS = WS_KS + 4 * MiB, WS_QC = WS_VS + 4 * MiB, WS_KC = WS_QC + 8 * MiB, WS_VC = WS_KC + 8 * MiB, WS_OALL = WS_VC + 8 * MiB, WS_END = WS_OALL + 32 * MiB;
static_assert(WS_HID + (size_t)MROWS * DFF * 2 <= WS_END, "d_ws map");
constexpr int CW_BAR = 4096;
constexpr int CW_Q = 40960;
static_assert((CW_Q + 64 * 14) * 4 <= (int)CTL_ZERO_BYTES && CW_BAR + 8 * 3456 <= CW_Q, "ctl map");
constexpr int RING_BYTES = 131072, LDSCTL_OFF = RING_BYTES, MISC_OFF = LDSCTL_OFF + 320, LDS_BYTES = 147456;

namespace pg8 {
#define PG8_LAS __attribute__((address_space(3)))
typedef unsigned short bf16_t;
typedef short bf16x8 __attribute__((ext_vector_type(8)));
typedef float f32x4 __attribute__((ext_vector_type(4)));
typedef unsigned u32x4 __attribute__((ext_vector_type(4)));
constexpr int BM = 256, BK = 64, HALF = 128, HTB = HALF * BK * 2  , STAGE_BYTES = 8 * HTB, NXCD = 8, WGM = 8;

__host__ __device__ __forceinline__ int lds_byte(int r, int c) { const int st = (r >> 4) * 2 + (c >> 5), rr = r & 15, cc = c & 31, ob = rr * 64 + cc * 2; return st * 1024 + (ob ^ (((ob >> 9) & 1) << 5)); }
__host__ __device__ __forceinline__ void stage_rc(int b, int& R, int& C) { const int st = b / 1024, sb = b % 1024, swz = sb ^ (((sb >> 9) & 1) << 5); R = (st >> 1) * 16 + swz / 64; C = (st & 1) * 32 + (swz % 64) / 2; }
__host__ __device__ __forceinline__ int perm32(int rho) { const int n = rho >> 4, i = rho & 15; return 8 * (i >> 2) + 4 * n + (i & 3); }

struct Unit { int pm, pn; };
struct Gemm { const bf16_t* A; const bf16_t* Bt; int M, N, K; };

struct StaticOrder {
    int nM, nN, nwg, G, c;
    __host__ __device__ void init(int M, int N, int G_, int c_) { nM = M / BM; nN = N / BM; nwg = nM * nN; G = G_; c = c_; }
    __host__ __device__ bool next(int i, Unit& u) const {
        const long L = (long)i * G + c; if (L >= nwg) return false;
        int wgid = (int)L; { const int q = nwg / NXCD, r = nwg % NXCD, xcd = wgid % NXCD, off = wgid / NXCD; wgid = (xcd < r ? xcd * (q + 1) : r * (q + 1) + (xcd - r) * q) + off; }
        const int nig = WGM * nN, gid = wgid / nig, fm = gid * WGM, gsz = (nM - fm) < WGM ? (nM - fm) : WGM;
        u.pm = fm + ((wgid % nig) % gsz); u.pn = (wgid % nig) / gsz; return true;
    }
    __device__ __forceinline__ void a_ready(const Unit&) const {}
    __device__ __forceinline__ void done(const Unit&) const {}
};

__device__ __forceinline__ unsigned cvt_pk_bf16(float lo, float hi) { unsigned r; asm volatile("v_cvt_pk_bf16_f32 %0, %1, %2" : "=v"(r) : "v"(lo), "v"(hi)); return r; }
typedef float f32x2 __attribute__((ext_vector_type(2)));
template <class Epi, class Sched, bool ALIGN_EPI = false, bool SP2 = false>
__device__ __forceinline__ void gemm_phase(PG8_LAS unsigned char* lds, const Gemm g, const Sched& S, const Epi& E, unsigned long long* gprof = nullptr) {
#ifdef GEMM_PROF
    const long long gp_t0 = (Epi::AFTER_DRAIN && !Epi::HOOK && blockIdx.x == 0) ? (long long)clock64() : 0ll;
#endif
    int tid_ = threadIdx.x; asm volatile("" : "+v"(tid_));
    const int tid = tid_, wid = __builtin_amdgcn_readfirstlane(tid >> 6), lane = tid & 63, wr = wid >> 2, wc = wid & 3, fr = lane & 15, fq = lane >> 4;
    int K_ = g.K; asm volatile("" : "+s"(K_));
    const int K = K_, nt = K / BK;
    unsigned voffA[2], voffB[2];
#pragma unroll
    for (int i = 0; i < 2; ++i) { int R, C; stage_rc(tid * 16 + i * 8192, R, C); const int Rb = Epi::PERM ? ((R & ~31) + perm32(R & 31)) : R;
        voffA[i] = (unsigned)(R * K + C) * 2u; voffB[i] = (unsigned)(Rb * K + C) * 2u; }
    const size_t kstep = (size_t)(BK * 2);
    const size_t hstep = (size_t)HALF * K * 2;
    const size_t tstep = 2 * hstep;
    const unsigned ldsw = (unsigned)wid * 1024u;
    const int aoff = lds_byte(wr * 64 + fr, fq * 8), boff = lds_byte(wc * 32 + fr, fq * 8);
#define PG8_SA(b, h) (((b) * 2 + (h)) * HTB)
#define PG8_SB(b, h) ((4 + (b) * 2 + (h)) * HTB)
#define PG8_STAGE(bufoff, gbase, voff) do { _Pragma("unroll") for (int _i = 0; _i < 2; ++_i) \
        __builtin_amdgcn_global_load_lds((const unsigned*)((const char*)(gbase) + (voff)[_i]), (PG8_LAS unsigned*)(lds + (bufoff) + ldsw + _i * 8192), 16, 0, 0); } while (0)
#define PG8_LDA(dst, b, h) do { _Pragma("unroll") for (int m = 0; m < 4; ++m) _Pragma("unroll") for (int k = 0; k < 2; ++k) dst[m][k] = *(const PG8_LAS bf16x8*)(lds + PG8_SA(b, h) + aoff + m * 2048 + k * 1024); } while (0)
#define PG8_LDB(dst, b, h) do { _Pragma("unroll") for (int n = 0; n < 2; ++n) _Pragma("unroll") for (int k = 0; k < 2; ++k) dst[n][k] = *(const PG8_LAS bf16x8*)(lds + PG8_SB(b, h) + boff + n * 2048 + k * 1024); } while (0)
#define PG8_MMA(ai, bj, At, Bt) do { __builtin_amdgcn_s_setprio(1); _Pragma("unroll") for (int m = 0; m < 4; ++m) _Pragma("unroll") for (int n = 0; n < 2; ++n) _Pragma("unroll") for (int k = 0; k < 2; ++k) \
        acc[ai][bj][m][n] = __builtin_amdgcn_mfma_f32_16x16x32_bf16(Bt[n][k], At[m][k], acc[ai][bj][m][n], 0, 0, 0); __builtin_amdgcn_s_setprio(0); } while (0)
#define PG8_WAIT_V(n) asm volatile("s_waitcnt vmcnt(" #n ")" ::: "memory")
#define PG8_WAIT_L(n) asm volatile("s_waitcnt lgkmcnt(" #n ")" ::: "memory")
#define PG8_BAR __builtin_amdgcn_s_barrier()
#define PG8_SCHED __builtin_amdgcn_sched_barrier(0)
    Unit cur, nxt; int ui = 0;
    if (!S.next(0, cur)) return;
    f32x4 acc[2][2][4][2];
#pragma unroll
    for (int a = 0; a < 2; ++a)
#pragma unroll
        for (int b = 0; b < 2; ++b)
#pragma unroll
            for (int m = 0; m < 4; ++m)
#pragma unroll
                for (int n = 0; n < 2; ++n) acc[a][b][m][n] = (f32x4){0.f, 0.f, 0.f, 0.f};
    bf16x8 At[4][2], B0[2][2], B1[2][2];
    const char* cA = (const char*)g.A + (size_t)cur.pm * tstep; const char* cB = (const char*)g.Bt + (size_t)cur.pn * tstep;
    S.a_ready(cur);
    if constexpr (SP2) {
        PG8_STAGE(PG8_SB(0, 0), cB, voffB); PG8_STAGE(PG8_SB(0, 1), cB + hstep, voffB); PG8_STAGE(PG8_SA(0, 0), cA, voffA); PG8_STAGE(PG8_SA(0, 1), cA + hstep, voffA);
        if (wr == 1) PG8_BAR;
        PG8_WAIT_V(2); PG8_BAR;
        PG8_STAGE(PG8_SB(1, 0), cB + kstep, voffB); PG8_STAGE(PG8_SA(1, 0), cA + kstep, voffA); PG8_STAGE(PG8_SB(1, 1), cB + hstep + kstep, voffB);
        PG8_WAIT_V(6); PG8_BAR;
    } else {
        PG8_STAGE(PG8_SB(0, 0), cB, voffB); PG8_STAGE(PG8_SA(0, 0), cA, voffA); PG8_STAGE(PG8_SB(0, 1), cB + hstep, voffB); PG8_STAGE(PG8_SA(0, 1), cA + hstep, voffA);
        if (wr == 1) PG8_BAR;
        PG8_WAIT_V(4); PG8_BAR;
        PG8_STAGE(PG8_SB(1, 0), cB + kstep, voffB); PG8_STAGE(PG8_SA(1, 0), cA + kstep, voffA); PG8_STAGE(PG8_SB(1, 1), cB + hstep + kstep, voffB);
        PG8_WAIT_V(6); PG8_BAR;
    }
    for (;;) {
        const bool has_next = S.next(ui + 1, nxt);
        const char* nA = has_next ? (const char*)g.A + (size_t)nxt.pm * tstep : cA; const char* nB = has_next ? (const char*)g.Bt + (size_t)nxt.pn * tstep : cB;
#pragma nounroll
        for (int t = 0; t < nt; t += 2) {
            if constexpr (Epi::HOOK) E.hook(acc, cur, t, wr, wc, fr, fq);
            const bool last = (t == nt - 2);
            const char* a1 = cA + (size_t)(t + 1) * kstep;
            const char* a2 = last ? nA : cA + (size_t)(t + 2) * kstep; const char* b2 = last ? nB : cB + (size_t)(t + 2) * kstep;
            const char* a3 = a2 + kstep; const char* b3 = b2 + kstep;
            if (last && has_next) S.a_ready(nxt);
            if constexpr (SP2) {
            PG8_LDB(B0, 0, 0); PG8_LDB(B1, 0, 1); PG8_SCHED; PG8_LDA(At, 0, 0); PG8_STAGE(PG8_SA(1, 1), a1 + hstep, voffA);
            PG8_WAIT_V(8); PG8_WAIT_L(0); PG8_BAR; PG8_MMA(0, 0, At, B0); PG8_MMA(0, 1, At, B1); PG8_BAR; PG8_SCHED;
            PG8_LDA(At, 0, 1); PG8_STAGE(PG8_SB(0, 0), b2, voffB); PG8_STAGE(PG8_SB(0, 1), b2 + hstep, voffB); PG8_STAGE(PG8_SA(0, 0), a2, voffA);
            PG8_WAIT_V(8); PG8_WAIT_L(0); PG8_BAR; PG8_MMA(1, 0, At, B0); PG8_MMA(1, 1, At, B1); PG8_BAR; PG8_SCHED;
            PG8_LDB(B0, 1, 0); PG8_LDB(B1, 1, 1); PG8_SCHED; PG8_LDA(At, 1, 0); PG8_STAGE(PG8_SA(0, 1), a2 + hstep, voffA);
            PG8_WAIT_V(8); PG8_WAIT_L(0); PG8_BAR; PG8_MMA(0, 0, At, B0); PG8_MMA(0, 1, At, B1); PG8_BAR; PG8_SCHED;
            PG8_LDA(At, 1, 1); PG8_STAGE(PG8_SB(1, 0), b3, voffB); PG8_STAGE(PG8_SB(1, 1), b3 + hstep, voffB); PG8_STAGE(PG8_SA(1, 0), a3, voffA);
            PG8_WAIT_V(8); PG8_WAIT_L(0); PG8_BAR; PG8_MMA(1, 0, At, B0); PG8_MMA(1, 1, At, B1); PG8_BAR; PG8_SCHED;
            } else {
            PG8_LDB(B0, 0, 0); PG8_SCHED; PG8_LDA(At, 0, 0); PG8_STAGE(PG8_SA(1, 1), a1 + hstep, voffA);
            PG8_WAIT_L(8); PG8_BAR; PG8_WAIT_L(0); PG8_MMA(0, 0, At, B0); PG8_BAR; PG8_SCHED;
            PG8_LDB(B1, 0, 1); PG8_STAGE(PG8_SB(0, 0), b2, voffB);
            PG8_BAR; PG8_WAIT_L(0); PG8_MMA(0, 1, At, B1); PG8_BAR;
            PG8_LDA(At, 0, 1); PG8_STAGE(PG8_SA(0, 0), a2, voffA);
            PG8_BAR; PG8_WAIT_L(0); PG8_MMA(1, 0, At, B0); PG8_BAR; PG8_SCHED;
            PG8_STAGE(PG8_SB(0, 1), b2 + hstep, voffB);
            PG8_WAIT_V(6); PG8_BAR; PG8_MMA(1, 1, At, B1); PG8_BAR;
            PG8_LDB(B0, 1, 0); PG8_SCHED; PG8_LDA(At, 1, 0); PG8_STAGE(PG8_SA(0, 1), a2 + hstep, voffA);
            PG8_WAIT_L(8); PG8_BAR; PG8_WAIT_L(0); PG8_MMA(0, 0, At, B0); PG8_BAR; PG8_SCHED;
            PG8_LDB(B1, 1, 1); PG8_STAGE(PG8_SB(1, 0), b3, voffB);
            PG8_BAR; PG8_WAIT_L(0); PG8_MMA(0, 1, At, B1); PG8_BAR;
            PG8_LDA(At, 1, 1); PG8_STAGE(PG8_SA(1, 0), a3, voffA);
            PG8_BAR; PG8_WAIT_L(0); PG8_MMA(1, 0, At, B0); PG8_BAR; PG8_SCHED;
            PG8_STAGE(PG8_SB(1, 1), b3 + hstep, voffB);
            PG8_WAIT_V(6); PG8_BAR; PG8_MMA(1, 1, At, B1); PG8_BAR;
            }
        }
        if constexpr (ALIGN_EPI) { if (wr == 0) PG8_BAR; }
        if constexpr (!Epi::AFTER_DRAIN) {
            Unit ce = cur; asm volatile("" : "+s"(ce.pm), "+s"(ce.pn)); int fre = fr, fqe = fq; asm volatile("" : "+v"(fre), "+v"(fqe));
            E(acc, ce, wr, wc, fre, fqe); S.done(cur); }
        if (!has_next) break;
#pragma unroll
        for (int a = 0; a < 2; ++a)
#pragma unroll
            for (int b = 0; b < 2; ++b)
#pragma unroll
                for (int m = 0; m < 4; ++m)
#pragma unroll
                    for (int n = 0; n < 2; ++n) acc[a][b][m][n] = (f32x4){0.f, 0.f, 0.f, 0.f};
        cur = nxt; cA = nA; cB = nB; ++ui;
        if constexpr (ALIGN_EPI) { if (wr == 1) PG8_BAR; }
    }
    PG8_WAIT_V(0);
    if constexpr (!ALIGN_EPI) { if (wr == 0) PG8_BAR; }
    PG8_BAR;
#ifdef GEMM_PROF
    const long long gp_t1 = (Epi::AFTER_DRAIN && !Epi::HOOK && blockIdx.x == 0) ? (long long)clock64() : 0ll;
#endif
    if constexpr (Epi::AFTER_DRAIN) { E.fused(acc, cur, wr, wc, fr, fq, lds, wid, lane); S.done(cur); }
#ifdef GEMM_PROF
    if (Epi::AFTER_DRAIN && !Epi::HOOK && blockIdx.x == 0 && tid == 0 && gprof) { const long long gp_t2 = clock64(); atomicAdd(gprof + 0, (unsigned long long)(gp_t1 - gp_t0)); atomicAdd(gprof + 1, (unsigned long long)(gp_t2 - gp_t1)); atomicAdd(gprof + 2, 1ull); }
#endif
#undef PG8_SA
#undef PG8_SB
#undef PG8_STAGE
#undef PG8_LDA
#undef PG8_LDB
#undef PG8_MMA
#undef PG8_WAIT_V
#undef PG8_WAIT_L
#undef PG8_BAR
#undef PG8_SCHED
}
constexpr float RMS_EPS = 1e-6f;
constexpr int MROWS_ = 16384;
constexpr float LOG2E = 1.4426950408889634f;
typedef unsigned u32x2 __attribute__((ext_vector_type(2)));
#define PG8_FENCE() asm volatile("" ::: "memory")
#define PG8_G __attribute__((address_space(1)))
__device__ __forceinline__ float sum16f(const PG8_G float* p) {
    const f32x4 a = *(const PG8_G f32x4*)p, b = *(const PG8_G f32x4*)(p + 4), c = *(const PG8_G f32x4*)(p + 8), d = *(const PG8_G f32x4*)(p + 12);
    return ((a[0] + a[1]) + (a[2] + a[3])) + ((b[0] + b[1]) + (b[2] + b[3])) + ((c[0] + c[1]) + (c[2] + c[3])) + ((d[0] + d[1]) + (d[2] + d[3]));
}
__device__ __forceinline__ float xsum16(float x) { auto r = __builtin_amdgcn_permlane16_swap(__float_as_uint(x), __float_as_uint(x), false, false); return __uint_as_float(r[0]) + __uint_as_float(r[1]); }
__device__ __forceinline__ float xsum32(float x) { auto r = __builtin_amdgcn_permlane32_swap(__float_as_uint(x), __float_as_uint(x), false, false); return __uint_as_float(r[0]) + __uint_as_float(r[1]); }
__device__ __forceinline__ float wave_sum_dpp(float x) {
    x += __builtin_bit_cast(float, __builtin_amdgcn_update_dpp(0, __builtin_bit_cast(int, x), 0xB1, 0xf, 0xf, true));
    x += __builtin_bit_cast(float, __builtin_amdgcn_update_dpp(0, __builtin_bit_cast(int, x), 0x4E, 0xf, 0xf, true));
    x += __builtin_bit_cast(float, __builtin_amdgcn_update_dpp(0, __builtin_bit_cast(int, x), 0x141, 0xf, 0xf, true));
    x += __builtin_bit_cast(float, __builtin_amdgcn_update_dpp(0, __builtin_bit_cast(int, x), 0x140, 0xf, 0xf, true));
    return xsum32(xsum16(x));
}
__device__ __forceinline__ float fast_rcp(float x) { return __builtin_amdgcn_rcpf(x); }
__device__ __forceinline__ float silu_fast(float g) { return g * fast_rcp(1.0f + __builtin_amdgcn_exp2f(-g * LOG2E)); }
__device__ __forceinline__ float sq4(const f32x4 v) { return (v[0] * v[0] + v[1] * v[1]) + (v[2] * v[2] + v[3] * v[3]); }

struct EpiUp {
    static constexpr bool PERM = true, AFTER_DRAIN = false, HOOK = false;
    PG8_G unsigned char* ws; const PG8_G float* bias;
    __device__ __forceinline__ void hook(f32x4 (&)[2][2][4][2], const Unit&, int, int, int, int, int) const {}
    __device__ __forceinline__ void operator()(const f32x4 (&acc)[2][2][4][2], const Unit& u, int wr, int wc, int fr, int fq) const {
        PG8_G bf16_t* HID = (PG8_G bf16_t*)(ws + WS_HID); const PG8_G float* ssqx = (const PG8_G float*)(ws + WS_SSQX);
        const int b = u.pm >> 5;
        const PG8_G float* bb = bias + b * 5632 + u.pn * BM + wc * 32 + 8 * fq;
        f32x4 bg[2], bu[2];
#pragma unroll
        for (int n = 0; n < 2; ++n) { bg[n] = *(const PG8_G f32x4*)(bb + 4 * n); bu[n] = *(const PG8_G f32x4*)(bb + HALF + 4 * n); }
#pragma unroll
        for (int ai = 0; ai < 2; ++ai)
#pragma unroll
            for (int m = 0; m < 4; ++m) {
                const int row = u.pm * BM + ai * HALF + wr * 64 + m * 16 + fr;
                const float r = 1.0f / sqrtf(sum16f(ssqx + (size_t)row * 16) * (1.0f / 1024.0f) + RMS_EPS);
                float hv[8];
#pragma unroll
                for (int n = 0; n < 2; ++n)
#pragma unroll
                    for (int i = 0; i < 4; ++i) { const float g = acc[ai][0][m][n][i] * r + bg[n][i], uu = acc[ai][1][m][n][i] * r + bu[n][i]; hv[4 * n + i] = silu_fast(g) * uu; }
                u32x4 w; w.x = cvt_pk_bf16(hv[0], hv[1]); w.y = cvt_pk_bf16(hv[2], hv[3]); w.z = cvt_pk_bf16(hv[4], hv[5]); w.w = cvt_pk_bf16(hv[6], hv[7]);
                *(PG8_G u32x4*)(HID + (size_t)row * 2816 + u.pn * HALF + wc * 32 + 8 * fq) = w;
                if (m & 1) PG8_FENCE();
            }
    }
};

template <bool HOOKED> struct EpiResS {
    static constexpr bool PERM = false, AFTER_DRAIN = true, HOOK = HOOKED;
    PG8_G float* fout; PG8_G unsigned char* ws; const PG8_G float* gate; const PG8_G float* igs; const PG8_G float* gs; float coef;
    __device__ __forceinline__ void group_r(int row, float& rA, float& rB, float& rC) const {
        const PG8_G float* p = (const PG8_G float*)(ws + WS_SSQO) + (size_t)row * 16;
        const f32x4 a = *(const PG8_G f32x4*)p, b = *(const PG8_G f32x4*)(p + 4), c = *(const PG8_G f32x4*)(p + 8), d = *(const PG8_G f32x4*)(p + 12);
        const float sA = ((a[0] + a[1]) + (a[2] + a[3])) + (b[0] + b[1]), sB = ((b[2] + b[3]) + (c[0] + c[1])) + (c[2] + c[3]), sC = (d[0] + d[1]) + (d[2] + d[3]);
        rA = 1.0f / sqrtf(sA * (1.0f / 384.0f) + RMS_EPS); rB = 1.0f / sqrtf(sB * (1.0f / 384.0f) + RMS_EPS); rC = 1.0f / sqrtf(sC * (1.0f / 256.0f) + RMS_EPS);
    }
    __device__ __forceinline__ void hook(f32x4 (&acc)[2][2][4][2], const Unit& u, int t, int wr, int wc, int fr, int fq) const {
        if (t != 6 && t != 12) return;
        asm volatile("" : "+v"(fr));
#pragma unroll
        for (int ai = 0; ai < 2; ++ai)
#pragma unroll
            for (int m = 0; m < 4; ++m) {
                const int row = u.pm * BM + ai * HALF + wr * 64 + m * 16 + fr;
                float rA, rB, rC; group_r(row, rA, rB, rC);
                const float f = (t == 6) ? rA / rB : rB / rC;
#pragma unroll
                for (int bj = 0; bj < 2; ++bj)
#pragma unroll
                    for (int n = 0; n < 2; ++n) acc[ai][bj][m][n] = acc[ai][bj][m][n] * f;
                PG8_FENCE();
            }
    }
    __device__ __forceinline__ void fused(f32x4 (&acc)[2][2][4][2], const Unit& u, int wr, int wc, int fr, int fq, PG8_LAS unsigned char* lds, int wid, int lane) const {
        PG8_G bf16_t* xb = (PG8_G bf16_t*)(ws + WS_XB); PG8_G float* ssq_out = (PG8_G float*)(ws + WS_SSQX); constexpr int gate_bstride = 9 * 1024;
        const int b = u.pm >> 5, colg = u.pn * BM + 4 * lane;
        const f32x4 gv = *(const PG8_G f32x4*)(gate + (size_t)b * gate_bstride + colg) * coef;
        const f32x4 gsv = gs ? *(const PG8_G f32x4*)(gs + (size_t)b * 1024 + colg) : (f32x4){0.f, 0.f, 0.f, 0.f};
        const f32x4 igv = *(const PG8_G f32x4*)(igs + (size_t)b * 1024 + colg);
#pragma unroll
        for (int ai = 0; ai < 2; ++ai) {
#pragma unroll
            for (int m = 0; m < 4; ++m) { const int rl = wr * 64 + m * 16 + fr;
#pragma unroll
                for (int bj = 0; bj < 2; ++bj)
#pragma unroll
                    for (int n = 0; n < 2; ++n) { const int c = 32 * bj + 8 * wc + 4 * n + fq; *(PG8_LAS f32x4*)(lds + rl * 1024 + ((c ^ (rl & 7)) << 4)) = acc[ai][bj][m][n]; } }
            asm volatile("s_waitcnt lgkmcnt(0)\n\ts_barrier" ::: "memory");
#pragma unroll
            for (int half = 0; half < 2; ++half) {
                u32x2 xo[8];
#pragma unroll
                for (int k = 0; k < 8; ++k) { const int rl = wid + 8 * (half * 8 + k); xo[k] = *(const PG8_G u32x2*)(xb + (size_t)(u.pm * BM + ai * HALF + rl) * 1024 + colg); }
#pragma unroll
                for (int k = 0; k < 8; ++k) { const int rl = wid + 8 * (half * 8 + k); const int row = u.pm * BM + ai * HALF + rl;
                    f32x4 t = *(const PG8_LAS f32x4*)(lds + rl * 1024 + ((lane ^ (rl & 7)) << 4));
                    if (HOOKED) { float rA, rB, rC; group_r(row, rA, rB, rC); t = t * rC; }
                    const f32x4 xs = {__uint_as_float(xo[k].x << 16), __uint_as_float(xo[k].x & 0xffff0000u), __uint_as_float(xo[k].y << 16), __uint_as_float(xo[k].y & 0xffff0000u)};
                    const f32x4 xn = xs * igv + gv * t;
                    if (!gs) *(PG8_G f32x4*)(fout + (size_t)row * 1024 + colg) = xn;
                    if (gs) { const f32x4 y = xn * gsv; u32x2 w; w.x = cvt_pk_bf16(y[0], y[1]); w.y = cvt_pk_bf16(y[2], y[3]); *(PG8_G u32x2*)(xb + (size_t)row * 1024 + colg) = w; }
                    float ss = sq4(xn);
                    ss = wave_sum_dpp(ss);
                    if (gs && lane == 0) *(PG8_G f32x4*)(ssq_out + (size_t)row * 16 + 4 * u.pn) = (f32x4){ss, 0.f, 0.f, 0.f};
                }
            }
            asm volatile("s_waitcnt lgkmcnt(0)\n\ts_barrier" ::: "memory");
        }
    }
};

struct EpiIn {
    static constexpr bool PERM = true, AFTER_DRAIN = false, HOOK = false;
    PG8_G unsigned char* ws; const PG8_G float* gq; const PG8_G float* gk; const PG8_G float* bias;
    __device__ __forceinline__ void hook(f32x4 (&)[2][2][4][2], const Unit&, int, int, int, int, int) const {}
    __device__ __forceinline__ void operator()(const f32x4 (&acc)[2][2][4][2], const Unit& u, int wr, int wc, int fr, int fq) const {
        const int slot = u.pn * 4 + wc;
        if (slot == 7 || slot >= 30) return;
        const int b = u.pm >> 5;
        const PG8_G float* ssqx = (const PG8_G float*)(ws + WS_SSQX);
        PG8_G PG8_G bf16_t* dst = nullptr; int pitch = 0, col0 = 0; int kind = 0;
        PG8_G PG8_G float* ssqd = nullptr; int ssqp = 0, ssqi = 0; const PG8_G float* gain = nullptr; float scale = 1.0f;
        if (slot < 4)       { dst = (PG8_G bf16_t*)(ws + WS_CQ);  pitch = 256; col0 = 64 * slot;        kind = 1; ssqd = (PG8_G float*)(ws + WS_SSQC);  ssqp = 4; ssqi = slot; }
        else if (slot < 6)  { dst = (PG8_G bf16_t*)(ws + WS_CKV); pitch = 128; col0 = 64 * (slot - 4);  kind = 1; ssqd = (PG8_G float*)(ws + WS_SSQC) + (size_t)MROWS_ * 4; ssqp = 2; ssqi = slot - 4; }
        else if (slot == 6) { kind = 3; }
        else if (slot < 14) { dst = (PG8_G bf16_t*)(ws + WS_QS);  pitch = 384; col0 = 64 * (slot - 8);  kind = 2; gain = gq; scale = 0.125f * LOG2E; }
        else if (slot < 16) { dst = (PG8_G bf16_t*)(ws + WS_KS);  pitch = 128; col0 = 64 * (slot - 14); kind = 2; gain = gk; }
        else if (slot < 18) { dst = (PG8_G bf16_t*)(ws + WS_VS);  pitch = 128; col0 = 64 * (slot - 16); }
        else if (slot < 22) { dst = (PG8_G bf16_t*)(ws + WS_QC);  pitch = 256; col0 = 64 * (slot - 18); scale = 0.125f * LOG2E; }
        else if (slot < 26) { dst = (PG8_G bf16_t*)(ws + WS_KC);  pitch = 256; col0 = 64 * (slot - 22); }
        else                { dst = (PG8_G bf16_t*)(ws + WS_VC);  pitch = 256; col0 = 64 * (slot - 26); }
        const PG8_G float* bb = bias + b * 2048 + u.pn * BM + wc * 32 + 8 * fq;
        f32x4 bv[2][2], gn[2][2];
#pragma unroll
        for (int bj = 0; bj < 2; ++bj)
#pragma unroll
            for (int n = 0; n < 2; ++n) { bv[bj][n] = *(const PG8_G f32x4*)(bb + bj * HALF + 4 * n);
                gn[bj][n] = (kind == 2) ? *(const PG8_G f32x4*)(gain + 32 * bj + 8 * fq + 4 * n) * scale : (f32x4){scale, scale, scale, scale}; }
#pragma unroll
        for (int ai = 0; ai < 2; ++ai)
#pragma unroll
            for (int m = 0; m < 4; ++m) {
                const int row = u.pm * BM + ai * HALF + wr * 64 + m * 16 + fr;
                const float r = 1.0f / sqrtf(sum16f(ssqx + (size_t)row * 16) * (1.0f / 1024.0f) + RMS_EPS);
                f32x4 v[2][2]; float ss = 0.f;
#pragma unroll
                for (int bj = 0; bj < 2; ++bj)
#pragma unroll
                    for (int n = 0; n < 2; ++n) { v[bj][n] = acc[ai][bj][m][n] * r + bv[bj][n]; ss += sq4(v[bj][n]); }
                if (kind == 3) {
                    float s0 = sq4(v[0][0]) + sq4(v[0][1]);
                    s0 = xsum32(xsum16(s0));
                    *(PG8_G f32x4*)((PG8_G float*)(ws + WS_KPE) + (size_t)row * 32 + 8 * fq) = v[0][0]; *(PG8_G f32x4*)((PG8_G float*)(ws + WS_KPE) + (size_t)row * 32 + 8 * fq + 4) = v[0][1];
                    if (fq == 0) ((PG8_G float*)(ws + WS_SSQC) + (size_t)MROWS_ * 6)[row] = s0;
                } else {
                    if (kind != 0) { ss = xsum32(xsum16(ss)); }
                    float rn = 1.0f;
                    if (kind == 2) rn = 1.0f / sqrtf(ss * (1.0f / 64.0f) + RMS_EPS);
                    if (kind == 1 && fq == 0) ssqd[(size_t)row * ssqp + ssqi] = ss;
#pragma unroll
                    for (int bj = 0; bj < 2; ++bj) {
                        const f32x4 y0 = v[bj][0] * gn[bj][0] * rn, y1 = v[bj][1] * gn[bj][1] * rn;
                        u32x4 w; w.x = cvt_pk_bf16(y0[0], y0[1]); w.y = cvt_pk_bf16(y0[2], y0[3]); w.z = cvt_pk_bf16(y1[0], y1[1]); w.w = cvt_pk_bf16(y1[2], y1[3]);
                        *(PG8_G u32x4*)(dst + (size_t)row * pitch + col0 + 32 * bj + 8 * fq) = w;
                    }
                }
                if (m & 1) PG8_FENCE();
            }
    }
};

struct EpiUq {
    static constexpr bool PERM = false, AFTER_DRAIN = false, HOOK = false;
    PG8_G unsigned char* ws;
    __device__ __forceinline__ void hook(f32x4 (&)[2][2][4][2], const Unit&, int, int, int, int, int) const {}
    __device__ __forceinline__ void operator()(const f32x4 (&acc)[2][2][4][2], const Unit& u, int wr, int wc, int fr, int fq) const {
        PG8_G float* QRAW = (PG8_G float*)(ws + WS_QRAW); const PG8_G float* ssqcq = (const PG8_G float*)(ws + WS_SSQC);
        const int col0 = u.pn * BM + wc * 32 + 4 * fq;
#pragma unroll
        for (int ai = 0; ai < 2; ++ai)
#pragma unroll
            for (int m = 0; m < 4; ++m) {
                const int row = u.pm * BM + ai * HALF + wr * 64 + m * 16 + fr;
                const f32x4 s = *(const PG8_G f32x4*)(ssqcq + (size_t)row * 4);
                const float r = 1.0f / sqrtf(((s[0] + s[1]) + (s[2] + s[3])) * (1.0f / 256.0f) + RMS_EPS);
#pragma unroll
                for (int bj = 0; bj < 2; ++bj)
#pragma unroll
                    for (int n = 0; n < 2; ++n) { const int c = col0 + bj * HALF + n * 16; if (c < 576) *(PG8_G f32x4*)(QRAW + (size_t)row * 576 + c) = acc[ai][bj][m][n] * r; }
            }
    }
};

struct EpiUkv {
    static constexpr bool PERM = true, AFTER_DRAIN = false, HOOK = false;
    PG8_G unsigned char* ws; const PG8_G float* gk;
    __device__ __forceinline__ void hook(f32x4 (&)[2][2][4][2], const Unit&, int, int, int, int, int) const {}
    __device__ __forceinline__ void operator()(const f32x4 (&acc)[2][2][4][2], const Unit& u, int wr, int wc, int fr, int fq) const {
        PG8_G bf16_t* KA = (PG8_G bf16_t*)(ws + WS_KA); PG8_G bf16_t* VA = (PG8_G bf16_t*)(ws + WS_VA); const PG8_G float* ssqckv = (const PG8_G float*)(ws + WS_SSQC) + (size_t)MROWS_ * 4; const PG8_G float* ssqkpe = (const PG8_G float*)(ws + WS_SSQC) + (size_t)MROWS_ * 6;
        const PG8_G float* kpe = (const PG8_G float*)(ws + WS_KPE); const PG8_G float* cs = (const PG8_G float*)(ws + WS_CS);
        const int h = 2 * u.pn + (wc >> 1); const bool isv = (wc & 1) != 0;
        f32x4 gn[2][2], g1 = {1.f, 1.f, 1.f, 1.f}, g2 = {1.f, 1.f, 1.f, 1.f};
        if (!isv) {
#pragma unroll
            for (int bj = 0; bj < 2; ++bj)
#pragma unroll
                for (int n = 0; n < 2; ++n) gn[bj][n] = *(const PG8_G f32x4*)(gk + 32 * bj + 8 * fq + 4 * n);
            g1 = *(const PG8_G f32x4*)(gk + 64 + 4 * fq); g2 = *(const PG8_G f32x4*)(gk + 80 + 4 * fq);
        }
#pragma unroll
        for (int ai = 0; ai < 2; ++ai)
#pragma unroll
            for (int m = 0; m < 4; ++m) {
                const int row = u.pm * BM + ai * HALF + wr * 64 + m * 16 + fr;
                const float r = 1.0f / sqrtf((ssqckv[(size_t)row * 2] + ssqckv[(size_t)row * 2 + 1]) * (1.0f / 128.0f) + RMS_EPS);
                f32x4 v[2][2]; float ss = 0.f;
#pragma unroll
                for (int bj = 0; bj < 2; ++bj)
#pragma unroll
                    for (int n = 0; n < 2; ++n) { v[bj][n] = acc[ai][bj][m][n] * r; ss += sq4(v[bj][n]); }
                if (isv) {
#pragma unroll
                    for (int bj = 0; bj < 2; ++bj) { u32x4 w; w.x = cvt_pk_bf16(v[bj][0][0], v[bj][0][1]); w.y = cvt_pk_bf16(v[bj][0][2], v[bj][0][3]); w.z = cvt_pk_bf16(v[bj][1][0], v[bj][1][1]); w.w = cvt_pk_bf16(v[bj][1][2], v[bj][1][3]);
                        *(PG8_G u32x4*)(VA + ((size_t)(row >> 6) * 6 + h) * 4096 + bj * 2048 + (row & 63) * 32 + 8 * fq) = w; }
                } else {
                    ss = xsum32(xsum16(ss));
                    const float rk = 1.0f / sqrtf((ss + ssqkpe[row]) * (1.0f / 96.0f) + RMS_EPS);
                    PG8_G bf16_t* kd = KA + ((size_t)(row >> 6) * 6 + h) * 6144 + (row & 63) * 8;
#pragma unroll
                    for (int bj = 0; bj < 2; ++bj) { const f32x4 y0 = v[bj][0] * gn[bj][0] * rk, y1 = v[bj][1] * gn[bj][1] * rk;
                        u32x4 w; w.x = cvt_pk_bf16(y0[0], y0[1]); w.y = cvt_pk_bf16(y0[2], y0[3]); w.z = cvt_pk_bf16(y1[0], y1[1]); w.w = cvt_pk_bf16(y1[2], y1[3]);
                        *(PG8_G u32x4*)(kd + (4 * bj + fq) * 512) = w; }
                    const f32x4 x1 = *(const PG8_G f32x4*)(kpe + (size_t)row * 32 + 4 * fq) * g1 * rk, x2 = *(const PG8_G f32x4*)(kpe + (size_t)row * 32 + 16 + 4 * fq) * g2 * rk;
                    const f32x4 c = *(const PG8_G f32x4*)(cs + (size_t)row * 32 + 4 * fq), s = *(const PG8_G f32x4*)(cs + (size_t)row * 32 + 16 + 4 * fq);
                    const f32x4 o1 = x1 * c - x2 * s, o2 = x2 * c + x1 * s;
                    u32x2 w1, w2; w1.x = cvt_pk_bf16(o1[0], o1[1]); w1.y = cvt_pk_bf16(o1[2], o1[3]); w2.x = cvt_pk_bf16(o2[0], o2[1]); w2.y = cvt_pk_bf16(o2[2], o2[3]);
                    *(PG8_G u32x2*)(kd + (8 + (fq >> 1)) * 512 + (fq & 1) * 4) = w1; *(PG8_G u32x2*)(kd + (10 + (fq >> 1)) * 512 + (fq & 1) * 4) = w2;
                }
                if (m & 1) PG8_FENCE();
            }
    }
};
}
#define GAS __attribute__((address_space(1)))
#define LAS __attribute__((address_space(3)))
typedef unsigned short bf16;
typedef unsigned v4u __attribute__((ext_vector_type(4)));
typedef float f32x4 __attribute__((ext_vector_type(4)));
typedef short bf16x8 __attribute__((ext_vector_type(8)));
typedef GAS unsigned gu32;
typedef GAS unsigned long long gu64;
#define RLX_AGENT __ATOMIC_RELAXED, __HIP_MEMORY_SCOPE_AGENT
#define LDS_WAIT() asm volatile("s_waitcnt lgkmcnt(0)" ::: "memory")
#define VM_WAIT() asm volatile("s_waitcnt vmcnt(0)" ::: "memory")
__device__ __forceinline__ unsigned long long rt() { return __builtin_amdgcn_s_memrealtime(); }
__device__ __forceinline__ unsigned f2bf(float f) { unsigned u = __builtin_bit_cast(unsigned, f); return (u + 0x7fffu + ((u >> 16) & 1u)) >> 16; }
__device__ __forceinline__ unsigned pk2(float lo, float hi) { return f2bf(lo) | (f2bf(hi) << 16); }

#define XB_TMO      128
#define XB_XCNT(j)  (256  + 64 * (j))
#define XB_XSUB(j)  (1280 + 64 * (j))
#define XB_XGEN(j)  (2304 + 64 * (j))
#define XB_TOP      3328
#define XB_TOPGEN   3392
#define XCD_BAR_WORDS 3456
#define XB_SPIN_CAP (1u << 18)

__device__ __forceinline__ unsigned xb_ld(unsigned* p)              { return __hip_atomic_load(p, __ATOMIC_RELAXED, __HIP_MEMORY_SCOPE_AGENT); }
__device__ __forceinline__ unsigned xb_add(unsigned* p, unsigned v) { return __hip_atomic_fetch_add(p, v, __ATOMIC_RELAXED, __HIP_MEMORY_SCOPE_AGENT); }
__device__ __forceinline__ unsigned xb_xcc_id() { return (unsigned)__builtin_amdgcn_s_getreg((3 << 11) | 20) & 0xFu; }
#define XB_SPIN(cond, bar) do { unsigned _sp = 0; while (cond) { __builtin_amdgcn_s_sleep(1); \
    if ((++_sp & 255u) == 0u) { if (xb_ld(&(bar)[XB_TMO])) break; if (_sp > XB_SPIN_CAP) { atomicAdd(&(bar)[XB_TMO], 1u); break; } } } } while (0)

struct XcdBarrier {
    unsigned* bar; unsigned x;
    volatile LAS unsigned* st;
};

__device__ __forceinline__ XcdBarrier xcd_barrier_post(unsigned* bar, volatile LAS unsigned* st) {
    XcdBarrier b; b.bar = bar; b.x = xb_xcc_id(); b.st = st;
    if (threadIdx.x == 0) (void)xb_add(&bar[XB_XCNT(b.x)], 1u);
    return b;
}
__device__ __forceinline__ void xcd_barrier_complete(unsigned* bar, unsigned x, unsigned& nloc, unsigned& nx) {
    const unsigned G = gridDim.x * gridDim.y * gridDim.z;
    unsigned sum, cnt, mine, sp = 0u;
    for (;;) {
        sum = 0u; cnt = 0u; mine = 0u;
#pragma unroll
        for (unsigned j = 0; j < 16; ++j) { const unsigned c = xb_ld(&bar[XB_XCNT(j)]); sum += c; cnt += (c > 0u) ? 1u : 0u; mine = (j == x) ? c : mine; }
        if (sum == G) break;
        __builtin_amdgcn_s_sleep(1);
        if ((++sp & 255u) == 0u) { if (xb_ld(&bar[XB_TMO])) break; if (sp > XB_SPIN_CAP) { atomicAdd(&bar[XB_TMO], 1u); break; } }
    }
    nloc = mine > 0u ? mine : 1u; nx = cnt > 0u ? cnt : 1u;
}

__device__ __forceinline__ void xcd_barrier(const XcdBarrier& b) {
    asm volatile("s_waitcnt vmcnt(0)" ::: "memory");
    __syncthreads();
    if (threadIdx.x == 0) {
        unsigned* bar = b.bar;
        __builtin_amdgcn_s_waitcnt(0);
        unsigned nloc = b.st[0], nx = b.st[1];
        if (nloc == 0u) { xcd_barrier_complete(bar, b.x, nloc, nx); b.st[0] = nloc; b.st[1] = nx; }
        const unsigned old = xb_add(&bar[XB_XSUB(b.x)], 1u);
        const unsigned gen = old / nloc;
        if (old + 1u == (gen + 1u) * nloc) {
            __builtin_amdgcn_fence(__ATOMIC_RELEASE, "agent");
            asm volatile("s_waitcnt vmcnt(0)" ::: "memory");
            const unsigned og = xb_add(&bar[XB_TOP], 1u);
            const unsigned tg = og / nx;
            if (og + 1u == (tg + 1u) * nx) xb_add(&bar[XB_TOPGEN], 1u);
            else XB_SPIN(xb_ld(&bar[XB_TOPGEN]) == tg, bar);
            __builtin_amdgcn_fence(__ATOMIC_ACQUIRE, "agent");
            xb_add(&bar[XB_XGEN(b.x)], 1u);
            asm volatile("s_waitcnt vmcnt(0)" ::: "memory");
        } else {
            XB_SPIN(xb_ld(&bar[XB_XGEN(b.x)]) == gen, bar);
            __builtin_amdgcn_fence(__ATOMIC_ACQUIRE, "agent");
            asm volatile("s_waitcnt vmcnt(0)" ::: "memory");
        }
    }
    __syncthreads();
}
namespace att {
typedef unsigned short bf16_t;
typedef short bf16x8 __attribute__((ext_vector_type(8)));
typedef short s16x4 __attribute__((ext_vector_type(4)));
typedef short v4i16_t __attribute__((ext_vector_type(4)));
typedef float f32x16 __attribute__((ext_vector_type(16)));
typedef float f32x4 __attribute__((ext_vector_type(4)));
typedef float f32x2 __attribute__((ext_vector_type(2)));
typedef __bf16 bf16x2_t __attribute__((ext_vector_type(2)));
typedef unsigned u32x4 __attribute__((ext_vector_type(4)));
typedef int i32x4 __attribute__((ext_vector_type(4)));
#define ALAS __attribute__((address_space(3)))
#define AGAS __attribute__((address_space(1)))
constexpr int SEQ = 8192;
constexpr float LOG2E = 1.4426950408889634f, EPS = 1e-6f;
constexpr int KCS = 1040, VHS = 4160;
constexpr int KSLOT = 12 * KCS, VSLOT = 2 * VHS;
constexpr int L_K = 0, L_V = 3 * KSLOT, L_POS = L_V + 4 * VSLOT, L_TB = L_POS + 1024, L_WSF = L_TB + 128, L_OST = L_WSF + 8 * 256, L_FLAG = L_OST + 8 * 4096, L_END = L_FLAG + 16 + 64;
static_assert(L_OST % 16 == 0 && L_V % 16 == 0 && L_END <= 131072, "attention LDS map");

__device__ __forceinline__ int crow(int r, int hi) { return (r & 3) + 8 * (r >> 2) + 4 * hi; }
__device__ __forceinline__ unsigned cvtpk(float lo, float hi) { f32x2 v = {lo, hi}; bf16x2_t b = __builtin_convertvector(v, bf16x2_t); return __builtin_bit_cast(unsigned, b); }
__device__ __forceinline__ s16x4 vtr(const ALAS unsigned char* p) { return __builtin_bit_cast(s16x4, __builtin_amdgcn_ds_read_tr16_b64_v4i16((ALAS v4i16_t*)p)); }
__device__ __forceinline__ float swap_sum(float x) { auto rr = __builtin_amdgcn_permlane32_swap(__float_as_uint(x), __float_as_uint(x), false, false); return __uint_as_float(rr[0]) + __uint_as_float(rr[1]); }
__device__ __forceinline__ float swap_max(float x) { auto rr = __builtin_amdgcn_permlane32_swap(__float_as_uint(x), __float_as_uint(x), false, false); return fmaxf(__uint_as_float(rr[0]), __uint_as_float(rr[1])); }
__device__ __forceinline__ float bf2f(unsigned short h) { return __uint_as_float((unsigned)h << 16); }

__device__ __forceinline__ void glds16(const AGAS void* gsrc, unsigned lds_dst) { unsigned keep;
    asm volatile("s_mov_b32 %0, m0\n\ts_mov_b32 m0, %2\n\ts_nop 0\n\tglobal_load_lds_dwordx4 %1, off\n\ts_mov_b32 m0, %0" : "=&s"(keep) : "v"(gsrc), "s"(lds_dst) : "memory"); }
__device__ __forceinline__ void glds4(const AGAS void* gsrc, unsigned lds_dst) { unsigned keep;
    asm volatile("s_mov_b32 %0, m0\n\ts_mov_b32 m0, %2\n\ts_nop 0\n\tglobal_load_lds_dword %1, off\n\ts_mov_b32 m0, %0" : "=&s"(keep) : "v"(gsrc), "s"(lds_dst) : "memory"); }

struct AttnP {
    AGAS unsigned char* ws;
    const AGAS float* gq;
    const AGAS int* pos; const AGAS float* sinks; const AGAS float* relb;
};
template <int MODE> struct AttnCfg;
template <> struct AttnCfg<0> { static constexpr size_t Q = WS_QRAW, K = WS_KA, V = WS_VA; static constexpr int qpitch = 576, kpitch = 576, khs = 96, vpitch = 384, vhs = 64, ocol0 = 0, hidx0 = 0, group = 1; };
template <> struct AttnCfg<1> { static constexpr size_t Q = WS_QS, K = WS_KS, V = WS_VS; static constexpr int qpitch = 384, kpitch = 128, khs = 64, vpitch = 128, vhs = 64, ocol0 = 384, hidx0 = 6, group = 3; };
template <> struct AttnCfg<2> { static constexpr size_t Q = WS_QC, K = WS_KC, V = WS_VC; static constexpr int qpitch = 256, kpitch = 256, khs = 64, vpitch = 256, vhs = 64, ocol0 = 768, hidx0 = 12, group = 1; };

#ifdef ATT_PROF
#define PROF_T() ((MODE == 0 && blockIdx.x == 0) ? (long long)clock64() : 0ll)
#else
#define PROF_T() 0ll
#endif
template <int DQK, int MODE>
__device__ __forceinline__ void attn_unit(ALAS unsigned char* lds, const AttnP& P, int b, int h, int qb, unsigned long long* prof = nullptr) {
    long long pf_qk = 0, pf_sm = 0, pf_pv = 0, pf_wait = 0; const long long pf_t0 = PROF_T();
    constexpr int NCH = DQK / 8, ND0 = DQK / 16;
    int tid_ = threadIdx.x; asm volatile("" : "+v"(tid_));
    const int tid = tid_, lane = tid & 63, r32 = lane & 31, hi = lane >> 5;
    const int wid = __builtin_amdgcn_readfirstlane(tid >> 6);
    const int q0 = qb * 256, qlo = q0 + 32 * wid, qhi = qlo + 31, qrow = qlo + r32;
    const size_t rb = (size_t)b * SEQ;
    typedef AttnCfg<MODE> C; const int kvh = h / C::group;
    ALAS float* wsf = (ALAS float*)(lds + L_WSF) + wid * 64;
    ALAS unsigned char* ost = lds + L_OST + wid * 4096;
    ALAS int* posl = (ALAS int*)(lds + L_POS);
    ALAS float* tb = (ALAS float*)(lds + L_TB);

    bf16x8 qf[ND0];
    if constexpr (MODE == 0) {
        const AGAS float* qp = (const AGAS float*)(P.ws + C::Q) + (rb + qrow) * 576 + h * 96 + hi * 8;
        float qv[ND0][8]; float ss = 0.f;
#pragma unroll
        for (int d0 = 0; d0 < ND0; ++d0) { const f32x4 a = *(const AGAS f32x4*)(qp + 16 * d0), c = *(const AGAS f32x4*)(qp + 16 * d0 + 4);
#pragma unroll
            for (int i = 0; i < 4; ++i) { qv[d0][i] = a[i]; qv[d0][4 + i] = c[i]; ss += a[i] * a[i] + c[i] * c[i]; } }
        ss = swap_sum(ss);
        const float rq = 1.0f / sqrtf(ss * (1.0f / 96.0f) + EPS);
#pragma unroll
        for (int d0 = 0; d0 < ND0; ++d0) { const f32x4 ga = *(const AGAS f32x4*)(P.gq + 16 * d0 + 8 * hi), gb = *(const AGAS f32x4*)(P.gq + 16 * d0 + 8 * hi + 4);
#pragma unroll
            for (int i = 0; i < 4; ++i) { qv[d0][i] *= rq * ga[i]; qv[d0][4 + i] *= rq * gb[i]; } }
        {
            const AGAS float* cp = (const AGAS float*)(P.ws + WS_CS) + (rb + qrow) * 32 + 8 * hi;
            const f32x4 c0 = *(const AGAS f32x4*)cp, c1 = *(const AGAS f32x4*)(cp + 4), s0 = *(const AGAS f32x4*)(cp + 16), s1 = *(const AGAS f32x4*)(cp + 20);
#pragma unroll
            for (int i = 0; i < 8; ++i) { const float c = i < 4 ? c0[i & 3] : c1[i & 3], s = i < 4 ? s0[i & 3] : s1[i & 3]; const float x1 = qv[4][i], x2 = qv[5][i]; qv[4][i] = x1 * c - x2 * s; qv[5][i] = x2 * c + x1 * s; }
        }
        const float sc = 0.10206207261596575f * LOG2E;
#pragma unroll
        for (int d0 = 0; d0 < ND0; ++d0) { u32x4 w; w.x = cvtpk(qv[d0][0] * sc, qv[d0][1] * sc); w.y = cvtpk(qv[d0][2] * sc, qv[d0][3] * sc); w.z = cvtpk(qv[d0][4] * sc, qv[d0][5] * sc); w.w = cvtpk(qv[d0][6] * sc, qv[d0][7] * sc); qf[d0] = __builtin_bit_cast(bf16x8, w); }
    } else {
        const AGAS bf16_t* qp = (const AGAS bf16_t*)(P.ws + C::Q) + (rb + qrow) * C::qpitch + h * 64 + hi * 8;
#pragma unroll
        for (int d0 = 0; d0 < ND0; ++d0) qf[d0] = *(const AGAS bf16x8*)(qp + 16 * d0);
    }
    int posq = 0; float sink2 = 0.f;
    if constexpr (MODE == 1) {
        posq = P.pos[rb + qrow]; sink2 = P.sinks[h] * LOG2E;
        if (tid < 32) tb[tid] = P.relb[tid * 6 + h] * LOG2E;
    }

    int ntile, tfirst, tstep;
    if (MODE == 0) { tfirst = 0; tstep = 1; ntile = ((q0 + 255) >> 6) + 1; }
    else if (MODE == 1) { const int lo = q0 - 127 > 0 ? q0 - 127 : 0; tfirst = lo >> 6; tstep = 1; ntile = ((q0 + 255) >> 6) - tfirst + 1; }
    else { tfirst = (q0 + 254) >> 6; tstep = -1; ntile = tfirst + 1; }

    const AGAS bf16_t* Kg = (const AGAS bf16_t*)(P.ws + C::K) + rb * C::kpitch + kvh * C::khs;
    const AGAS bf16_t* Vg = (const AGAS bf16_t*)(P.ws + C::V) + rb * C::vpitch + kvh * C::vhs;
    const unsigned lds0 = (unsigned)(uintptr_t)lds;
    const AGAS bf16_t* ksrc0 = (MODE == 0) ? (const AGAS bf16_t*)(P.ws + C::K) + ((size_t)b * 128 * 6 + h) * 6144 + wid * 512 + lane * 8 : Kg + (size_t)lane * C::kpitch + 8 * wid;
    const AGAS bf16_t* vsrc = (MODE == 0) ? (const AGAS bf16_t*)(P.ws + C::V) + ((size_t)b * 128 * 6 + h) * 4096 + (wid >> 2) * 2048 + (wid & 3) * 512 + lane * 8
                                          : Vg + (size_t)(16 * (wid & 3) + (lane >> 2)) * C::vpitch + 32 * (wid >> 2) + 8 * (lane & 3);
    constexpr size_t KTS = (MODE == 0) ? (size_t)6 * 6144 : (size_t)64 * C::kpitch, VTS = (MODE == 0) ? (size_t)6 * 4096 : (size_t)64 * C::vpitch, K2O = (MODE == 0) ? 8 * 512 : 64;
    const bool k2 = (wid + 8) < NCH;
    const bool posw = (MODE == 1) && wid == 0;
    const int NP = 2 + (k2 ? 1 : 0) + (posw ? 1 : 0);
#define ATT_ISSUE(T, IT) do { const int T_ = (T); const size_t jo_ = (size_t)T_ * 64; const int ks_ = (IT) % 3, vs_ = (IT) & 3;     \
        glds16(ksrc0 + (size_t)T_ * KTS, (unsigned)__builtin_amdgcn_readfirstlane(lds0 + L_K + ks_ * KSLOT + wid * KCS)); \
        if (k2) glds16(ksrc0 + (size_t)T_ * KTS + K2O, (unsigned)__builtin_amdgcn_readfirstlane(lds0 + L_K + ks_ * KSLOT + (wid + 8) * KCS)); \
        glds16(vsrc + (size_t)T_ * VTS, (unsigned)__builtin_amdgcn_readfirstlane(lds0 + L_V + vs_ * VSLOT + (wid >> 2) * VHS + (wid & 3) * 1024)); \
        if (posw) glds4(P.pos + rb + jo_ + lane, (unsigned)__builtin_amdgcn_readfirstlane(lds0 + L_POS + vs_ * 256)); } while (0)
#define ATT_WAIT_BAR(n_) do { if ((n_) <= 0) asm volatile("s_waitcnt vmcnt(0) lgkmcnt(0)\n\ts_barrier" ::: "memory"); \
        else if (NP == 2) asm volatile("s_waitcnt vmcnt(2) lgkmcnt(0)\n\ts_barrier" ::: "memory"); \
        else if (NP == 3) asm volatile("s_waitcnt vmcnt(3) lgkmcnt(0)\n\ts_barrier" ::: "memory"); \
        else asm volatile("s_waitcnt vmcnt(4) lgkmcnt(0)\n\ts_barrier" ::: "memory"); } while (0)

    f32x16 o0 = {}, o1 = {};
    float mrun = (MODE == 1) ? sink2 : 0.f;
    float lrun = (MODE == 1 && hi == 0) ? 1.0f : 0.f;
    f32x16 negm;
#pragma unroll
    for (int r = 0; r < 16; ++r) negm[r] = (MODE == 2) ? 0.f : -mrun;
    bool first = (MODE == 0);
    float after = 0.f;
    bool walive = true;
    const int vrd = ((lane >> 4) & 1) * 32 + (lane & 3) * 8 + (4 * hi + ((lane & 15) >> 2)) * 64;
    const bool lag = wid >= 4;
    constexpr float THR = 4.0f;

#define ATT_QK(P0, P1, kb) do { int kofs_ = L_K + (kb) * KSLOT + hi * KCS + r32 * 16; asm volatile("" : "+v"(kofs_)); const ALAS unsigned char* Kb_ = lds + kofs_;     \
        bf16x8 kfa_[4], kfb_[4]; \
        _Pragma("unroll") for (int d0 = 0; d0 < 3; ++d0) { kfa_[d0] = *(const ALAS bf16x8*)(Kb_ + 2 * d0 * KCS); kfb_[d0] = *(const ALAS bf16x8*)(Kb_ + 2 * d0 * KCS + 512); } \
        \
        _Pragma("unroll") for (int d0 = 0; d0 < ND0; ++d0) { \
            if (d0 + 3 < ND0) { kfa_[(d0 + 3) & 3] = *(const ALAS bf16x8*)(Kb_ + 2 * (d0 + 3) * KCS); kfb_[(d0 + 3) & 3] = *(const ALAS bf16x8*)(Kb_ + 2 * (d0 + 3) * KCS + 512); } \
            if (d0 == 0) { P0 = __builtin_amdgcn_mfma_f32_32x32x16_bf16(kfa_[0], qf[0], negm, 0, 0, 0); P1 = __builtin_amdgcn_mfma_f32_32x32x16_bf16(kfb_[0], qf[0], negm, 0, 0, 0); } \
            else { P0 = __builtin_amdgcn_mfma_f32_32x32x16_bf16(kfa_[d0 & 3], qf[d0], P0, 0, 0, 0); P1 = __builtin_amdgcn_mfma_f32_32x32x16_bf16(kfb_[d0 & 3], qf[d0], P1, 0, 0, 0); } \
            } } while (0)
#define ATT_VLD(i_, s_) do { vl0_[i_] = vtr(Vb_ + (s_) * 1024); vh0_[i_] = vtr(Vb_ + (s_) * 1024 + 512); vl1_[i_] = vtr(Vb_ + VHS + (s_) * 1024); vh1_[i_] = vtr(Vb_ + VHS + (s_) * 1024 + 512); } while (0)
#define ATT_PV(vb) do { int vofs_ = L_V + (vb) * VSLOT + vrd; asm volatile("" : "+v"(vofs_)); const ALAS unsigned char* Vb_ = lds + vofs_; \
        s16x4 vl0_[2], vh0_[2], vl1_[2], vh1_[2]; ATT_VLD(0, 0); \
        _Pragma("unroll") for (int s_ = 0; s_ < 4; ++s_) { \
            if (s_ + 1 < 4) ATT_VLD((s_ + 1) & 1, s_ + 1); \
            const int i_ = s_ & 1; const bf16x8 pa_ = __builtin_bit_cast(bf16x8, pw[s_]); \
            const bf16x8 v0_ = {vl0_[i_][0], vl0_[i_][1], vl0_[i_][2], vl0_[i_][3], vh0_[i_][0], vh0_[i_][1], vh0_[i_][2], vh0_[i_][3]}, v1_ = {vl1_[i_][0], vl1_[i_][1], vl1_[i_][2], vl1_[i_][3], vh1_[i_][0], vh1_[i_][1], vh1_[i_][2], vh1_[i_][3]}; \
            o0 = __builtin_amdgcn_mfma_f32_32x32x16_bf16(pa_, v0_, o0, 0, 0, 0); o1 = __builtin_amdgcn_mfma_f32_32x32x16_bf16(pa_, v1_, o1, 0, 0, 0); } } while (0)
#define ATT_PACK(P0, P1) do { \
        pw[0].x = cvtpk(P0[0], P0[1]); pw[0].y = cvtpk(P0[2], P0[3]); pw[0].z = cvtpk(P0[4], P0[5]); pw[0].w = cvtpk(P0[6], P0[7]); \
        pw[1].x = cvtpk(P0[8], P0[9]); pw[1].y = cvtpk(P0[10], P0[11]); pw[1].z = cvtpk(P0[12], P0[13]); pw[1].w = cvtpk(P0[14], P0[15]); \
        pw[2].x = cvtpk(P1[0], P1[1]); pw[2].y = cvtpk(P1[2], P1[3]); pw[2].z = cvtpk(P1[4], P1[5]); pw[2].w = cvtpk(P1[6], P1[7]); \
        pw[3].x = cvtpk(P1[8], P1[9]); pw[3].y = cvtpk(P1[10], P1[11]); pw[3].z = cvtpk(P1[12], P1[13]); pw[3].w = cvtpk(P1[14], P1[15]); } while (0)
#define ATT_MAX3(a, b, c) fmaxf(fmaxf((a), (b)), (c))
#define ATT_SM_A(P0, P1, j0_, pslot) do { if constexpr (MODE != 2) { \
            if constexpr (MODE == 1) { \
                _Pragma("unroll") for (int g = 0; g < 4; ++g) { \
                    const i32x4 pa = *(const ALAS i32x4*)(posl + (pslot) * 64 + 8 * g + 4 * hi), pb = *(const ALAS i32x4*)(posl + (pslot) * 64 + 32 + 8 * g + 4 * hi); \
                    _Pragma("unroll") for (int i = 0; i < 4; ++i) { \
                        { int n = posq - pa[i]; n = n > 0 ? n : 0; int bk = n; if (n >= 16) { bk = 16 + (int)((__builtin_amdgcn_logf((float)n) - 4.0f) * (16.0f / 3.0f)); bk = bk < 31 ? bk : 31; } P0[4 * g + i] += tb[bk]; } \
                        { int n = posq - pb[i]; n = n > 0 ? n : 0; int bk = n; if (n >= 16) { bk = 16 + (int)((__builtin_amdgcn_logf((float)n) - 4.0f) * (16.0f / 3.0f)); bk = bk < 31 ? bk : 31; } P1[4 * g + i] += tb[bk]; } } } } \
            const bool nm_ = (MODE == 1) || ((j0_) + 63 > qlo); \
            if (nm_) { \
                _Pragma("unroll") for (int r = 0; r < 16; ++r) { const int key = (j0_) + crow(r, hi); \
                    bool ok0 = key <= qrow, ok1 = key + 32 <= qrow; \
                    if (MODE == 1) { ok0 = ok0 && (key > qrow - 128); ok1 = ok1 && (key + 32 > qrow - 128); } \
                    if (!ok0) P0[r] = -INFINITY; if (!ok1) P1[r] = -INFINITY; } } \
            float ma = ATT_MAX3(P0[0], P0[1], P1[0]), mb = ATT_MAX3(P0[2], P0[3], P1[1]); ma = ATT_MAX3(ma, P1[2], P1[3]); \
            _Pragma("unroll") for (int r = 4; r < 16; r += 4) { ma = ATT_MAX3(ma, P0[r], P0[r + 1]); mb = ATT_MAX3(mb, P0[r + 2], P0[r + 3]); ma = ATT_MAX3(ma, P1[r], P1[r + 1]); mb = ATT_MAX3(mb, P1[r + 2], P1[r + 3]); } \
            const float mt = swap_max(fmaxf(ma, mb)); \
            if (first || __any(mt > THR)) {                                 \
                const float d = first ? mt : fmaxf(mt, 0.f); first = false; \
                _Pragma("unroll") for (int r = 0; r < 16; ++r) { P0[r] -= d; P1[r] -= d; } \
                const float alpha = __builtin_amdgcn_exp2f(-d); mrun += d; lrun *= alpha; \
                _Pragma("unroll") for (int r = 0; r < 16; ++r) negm[r] = -mrun; \
                if (hi == 0) wsf[r32] = alpha; \
                _Pragma("unroll") for (int g = 0; g < 4; ++g) { const f32x4 al = *(const ALAS f32x4*)(wsf + 8 * g + 4 * hi); \
                    _Pragma("unroll") for (int i = 0; i < 4; ++i) { o0[4 * g + i] *= al[i]; o1[4 * g + i] *= al[i]; } } } } } while (0)
#define ATT_SM_B(P0, P1, j0_) do { \
        if constexpr (MODE == 2) { \
            const bool nm_ = (j0_) + 63 >= qlo; \
            float ln0[16], ln1[16]; \
            _Pragma("unroll") for (int r = 0; r < 16; ++r) { const int key = (j0_) + crow(r, hi); \
                { const float z = P0[r]; const float sp = fmaxf(z, 0.f) + __builtin_amdgcn_logf(1.0f + __builtin_amdgcn_exp2f(-fabsf(z))); const bool ok = !nm_ || key < qrow; ln0[r] = ok ? -sp : 0.f; P0[r] = ok ? z - sp : -INFINITY; } \
                { const float z = P1[r]; const float sp = fmaxf(z, 0.f) + __builtin_amdgcn_logf(1.0f + __builtin_amdgcn_exp2f(-fabsf(z))); const bool ok = !nm_ || key + 32 < qrow; ln1[r] = ok ? -sp : 0.f; P1[r] = ok ? z - sp : -INFINITY; } } \
            float run = after; \
            _Pragma("unroll") for (int blk = 1; blk >= 0; --blk) _Pragma("unroll") for (int g = 3; g >= 0; --g) { \
                const float own = blk ? ((ln1[4 * g] + ln1[4 * g + 1]) + (ln1[4 * g + 2] + ln1[4 * g + 3])) : ((ln0[4 * g] + ln0[4 * g + 1]) + (ln0[4 * g + 2] + ln0[4 * g + 3])); \
                auto rr = __builtin_amdgcn_permlane32_swap(__float_as_uint(own), __float_as_uint(own), false, false); \
                const float slo = __uint_as_float(rr[0]), shi = __uint_as_float(rr[1]); \
                const float e1 = run; run += shi; const float e0 = run; run += slo; \
                float aft = hi ? e1 : e0; \
                _Pragma("unroll") for (int i = 3; i >= 0; --i) { const int r = 4 * g + i; \
                    if (blk) { P1[r] = __builtin_amdgcn_exp2f(P1[r] + aft); aft += ln1[r]; } else { P0[r] = __builtin_amdgcn_exp2f(P0[r] + aft); aft += ln0[r]; } } } \
            after = run; walive = __any(after > -160.0f); \
        } else { \
            float ls = 0.f; \
            _Pragma("unroll") for (int r = 0; r < 16; ++r) { P0[r] = __builtin_amdgcn_exp2f(P0[r]); P1[r] = __builtin_amdgcn_exp2f(P1[r]); ls += P0[r] + P1[r]; } \
            lrun += ls; } \
        ATT_PACK(P0, P1); } while (0)
#define ATT_WORK(j0_) ((MODE == 0) ? ((j0_) <= qhi) : (MODE == 1) ? (((j0_) <= qhi) && ((j0_) + 63 >= qlo - 127)) : (walive && ((j0_) < qhi)))

    f32x16 p0, p1, n0, n1; u32x4 pw[4];
    __syncthreads();
    int issued = 0;
    ATT_ISSUE(tfirst, 0);
    if (ntile > 1) { ATT_ISSUE(tfirst + tstep, 1); issued = 1; }
    if (ntile > 2) { ATT_ISSUE(tfirst + 2 * tstep, 2); issued = 2; }
    ATT_WAIT_BAR(issued - 1);
    bool wcur = ATT_WORK(tfirst * 64);
    if (wcur) ATT_QK(p0, p1, 0);
    asm volatile("s_waitcnt lgkmcnt(0)\n\ts_barrier" ::: "memory");
    int nt = ntile;
    for (int it = 0; it < nt; ++it) {
        const int t = tfirst + it * tstep, j0 = t * 64, jn = (t + tstep) * 64;
        if (it + 3 < ntile) { ATT_ISSUE(t + 3 * tstep, it + 3); issued = it + 3; }
        if (wcur) ATT_SM_A(p0, p1, j0, it & 3);
        const bool wnext = (it + 1 < nt) && ATT_WORK(jn);
        if (wcur && wnext) { ATT_QK(n0, n1, (it + 1) % 3); ATT_SM_B(p0, p1, j0); }
        else { if (wnext) ATT_QK(n0, n1, (it + 1) % 3); if (wcur) ATT_SM_B(p0, p1, j0); }
        if (wcur) ATT_PV(it & 3);
        p0 = n0; p1 = n1; wcur = wnext;
        if (MODE == 2) { ALAS int* fl = (ALAS int*)(lds + L_FLAG + 16) + (it & 1) * 8; if (lane == 0) fl[wid] = (walive && j0 > 0) ? 1 : 0; }
        ATT_WAIT_BAR(issued - (it + 2));
        if (MODE == 2) { const ALAS int* fl = (const ALAS int*)(lds + L_FLAG + 16) + (it & 1) * 8;
            const i32x4 fa = *(const ALAS i32x4*)fl, fb = *(const ALAS i32x4*)(fl + 4);
            if (((fa[0] | fa[1]) | (fa[2] | fa[3]) | (fb[0] | fb[1]) | (fb[2] | fb[3])) == 0) nt = it + 1; }
    }
    if (MODE == 2) asm volatile("s_waitcnt vmcnt(0)" ::: "memory");
#undef ATT_ISSUE
#undef ATT_WAIT_BAR
#undef ATT_QK
#undef ATT_PV
#undef ATT_PACK
#undef ATT_VLD
#undef ATT_SM_A
#undef ATT_SM_B
#undef ATT_WORK
#undef ATT_MAX3
    if (MODE != 2) {
        const float lt = swap_sum(lrun);
        if (hi == 0) wsf[32 + r32] = 1.0f / lt;
#pragma unroll
        for (int g = 0; g < 4; ++g) { const f32x4 il = *(const ALAS f32x4*)(wsf + 32 + 8 * g + 4 * hi);
#pragma unroll
            for (int i = 0; i < 4; ++i) { o0[4 * g + i] *= il[i]; o1[4 * g + i] *= il[i]; } }
    }
    {
        ALAS bf16_t* stg = (ALAS bf16_t*)ost;
#pragma unroll
        for (int r = 0; r < 16; ++r) { const int orow = crow(r, hi); stg[orow * 64 + r32] = (bf16_t)(cvtpk(o0[r], 0.f) & 0xffffu); stg[orow * 64 + 32 + r32] = (bf16_t)(cvtpk(o1[r], 0.f) & 0xffffu); }
        AGAS bf16_t* Ow = (AGAS bf16_t*)(P.ws + WS_OALL) + (rb + qlo) * 1024 + C::ocol0 + h * 64;
#pragma unroll
        for (int i = 0; i < 4; ++i) {
            const int row = i * 8 + (lane >> 3), ch = lane & 7;
            const u32x4 v = *(const ALAS u32x4*)(stg + row * 64 + ch * 8);
            float ss = 0.f;
#pragma unroll
            for (int k = 0; k < 4; ++k) { const unsigned w = v[k]; const float a = __uint_as_float(w << 16), c = __uint_as_float(w & 0xffff0000u); ss += a * a + c * c; }
            ss += __shfl_xor(ss, 1); ss += __shfl_xor(ss, 2); ss += __shfl_xor(ss, 4);
            *(AGAS u32x4*)(Ow + (size_t)row * 1024 + ch * 8) = v;
            if (ch == 0) ((AGAS float*)(P.ws + WS_SSQO))[(rb + qlo + row) * 16 + C::hidx0 + h] = ss;
        }
    }
#ifdef ATT_PROF
    if (MODE == 0 && blockIdx.x == 0 && wid == ATT_PROF_WAVE && lane == 0 && prof) { const long long tt = PROF_T() - pf_t0;
        atomicAdd(prof + 0, (unsigned long long)tt); atomicAdd(prof + 1, (unsigned long long)pf_qk); atomicAdd(prof + 2, (unsigned long long)pf_sm); atomicAdd(prof + 3, (unsigned long long)pf_pv); atomicAdd(prof + 4, (unsigned long long)pf_wait); atomicAdd(prof + 5, 1ull); }
#endif
}
#undef ALAS
#undef AGAS
}
struct Args { const void* in[23]; float* out; unsigned char* ws; int ph_lo, ph_hi, li, adapt; };

struct Frame { LAS unsigned char* lds; int tid, lane, wave, vcu, G; };

__device__ __forceinline__ float wave_sum64(float v) { return pg8::wave_sum_dpp(v); }

__device__ __forceinline__ void tr_item64(const GAS float* W, int ldn, int K, GAS pg8::bf16_t* WT, int kb, int g, int src0, int src1, const GAS float* kgain, LAS unsigned* scr, int lane) {
    const int k0 = 64 * kb; const int col = lane < 32 ? src0 + lane : src1 + (lane - 32); const bool ok = (lane < 32 ? src0 : src1) >= 0;
    const GAS float* wp = W + (size_t)k0 * ldn + (ok ? col : 0);
#pragma unroll
    for (int hf = 0; hf < 2; ++hf) {
        float v[32];
#pragma unroll
        for (int i = 0; i < 32; ++i) v[i] = wp[(size_t)(hf * 32 + i) * ldn];
#pragma unroll
        for (int i = 0; i < 32; ++i) v[i] = ok ? v[i] : 0.f;
        if (kgain) {
#pragma unroll
            for (int i = 0; i < 32; ++i) v[i] *= kgain[k0 + hf * 32 + i]; }
#pragma unroll
        for (int i = 0; i < 16; ++i) scr[(hf * 16 + i) * 65 + lane] = pk2(v[2 * i], v[2 * i + 1]);
    }
    asm volatile("s_waitcnt lgkmcnt(0)" ::: "memory");
    const int c = lane & 7;
#pragma unroll
    for (int j = 0; j < 8; ++j) { const int n = (lane >> 3) + 8 * j; const LAS unsigned* s = scr + (4 * c) * 65 + n;
        v4u o; o.x = s[0]; o.y = s[65]; o.z = s[130]; o.w = s[195];
        *(GAS v4u*)(WT + (size_t)(64 * g + n) * K + k0 + 8 * c) = o; }
    asm volatile("s_waitcnt lgkmcnt(0)" ::: "memory");
}
__device__ __forceinline__ int in_slot_src(int slot, int& cnt) {
    cnt = 64;
    if (slot < 4) return 64 * slot;
    if (slot < 6) return 256 + 64 * (slot - 4);
    if (slot == 6) { cnt = 32; return 384; }
    if (slot == 7) return -1;
    if (slot < 14) return 416 + 64 * (slot - 8);
    if (slot < 16) return 800 + 64 * (slot - 14);
    if (slot < 18) return 928 + 64 * (slot - 16);
    if (slot < 22) return 1056 + 64 * (slot - 18);
    if (slot < 26) return 1312 + 64 * (slot - 22);
    if (slot < 30) return 1568 + 64 * (slot - 26);
    return -1;
}

#define A_X ((const GAS float*)args.in[0])
#define A_C ((const GAS float*)args.in[1])
#define A_POS ((const GAS int*)args.in[2])
#define A_RELB ((const GAS float*)args.in[3])
#define A_NORMG ((const GAS float*)args.in[4])
#define A_WMOD ((const GAS float*)args.in[5])
#define A_BMOD ((const GAS float*)args.in[6])
#define A_WGU1 ((const GAS float*)args.in[7])
#define A_WD1 ((const GAS float*)args.in[8])
#define A_WIN ((const GAS float*)args.in[9])
#define A_QAN ((const GAS float*)args.in[10])
#define A_KVAN ((const GAS float*)args.in[11])
#define A_WUQ ((const GAS float*)args.in[12])
#define A_WUKV ((const GAS float*)args.in[13])
#define A_MLAQN ((const GAS float*)args.in[14])
#define A_MLAKN ((const GAS float*)args.in[15])
#define A_SWAQN ((const GAS float*)args.in[16])
#define A_SWAKN ((const GAS float*)args.in[17])
#define A_SINKS ((const GAS float*)args.in[18])
#define A_OUTN ((const GAS float*)args.in[19])
#define A_WOUT ((const GAS float*)args.in[20])
#define A_WGU2 ((const GAS float*)args.in[21])
#define A_WD2 ((const GAS float*)args.in[22])
#define WSP(off)   (ws_ + (off))
#define MOD ((GAS float*)WSP(WS_MOD))
#define GS ((GAS float*)WSP(WS_GS))
#define BIAS ((GAS float*)WSP(WS_BIAS))
#define SSQX ((GAS float*)WSP(WS_SSQX))
#define SSQO ((GAS float*)WSP(WS_SSQO))
#define CS ((GAS float*)WSP(WS_CS))
#define KPE ((GAS float*)WSP(WS_KPE))
#define SSQ_CQ ((GAS float*)WSP(WS_SSQC))
#define SSQ_CKV ((GAS float*)WSP(WS_SSQC) + (size_t)MROWS * 4)
#define SSQ_KPE ((GAS float*)WSP(WS_SSQC) + (size_t)MROWS * 6)
#define XB ((GAS pg8::bf16_t*)WSP(WS_XB))
#define HID ((GAS pg8::bf16_t*)WSP(WS_HID))
#define CQ ((GAS pg8::bf16_t*)WSP(WS_CQ))
#define CKV ((GAS pg8::bf16_t*)WSP(WS_CKV))
#define KA ((GAS pg8::bf16_t*)WSP(WS_KA))
#define VA ((GAS pg8::bf16_t*)WSP(WS_VA))
#define QS ((GAS pg8::bf16_t*)WSP(WS_QS))
#define KS ((GAS pg8::bf16_t*)WSP(WS_KS))
#define VS ((GAS pg8::bf16_t*)WSP(WS_VS))
#define QC ((GAS pg8::bf16_t*)WSP(WS_QC))
#define KC ((GAS pg8::bf16_t*)WSP(WS_KC))
#define VC ((GAS pg8::bf16_t*)WSP(WS_VC))
#define OALL ((GAS pg8::bf16_t*)WSP(WS_OALL))
#define QRAW ((GAS float*)WSP(WS_QRAW))

__device__ __forceinline__ int in_group_src(int g32) {
    const int tile = g32 >> 3, rr = g32 & 7, bj = rr >> 2, wc = rr & 3; int cnt; const int base = in_slot_src(tile * 4 + wc, cnt);
    return (base >= 0 && 32 * bj < cnt) ? base + 32 * bj : -1;
}
constexpr int CV_GU = 16 * 88, CV_D = 44 * 16, CV_IN = 16 * 32, CV_UQ = 4 * 12, CV_UKV = 2 * 12, CV_OUT = 16 * 16;
constexpr int CV_EARLY = CV_GU + CV_D + CV_IN + CV_UQ + CV_UKV + CV_OUT, CV_L = CV_EARLY + CV_GU + CV_D, CV_ALL = DEPTH * CV_L;
__device__ __forceinline__ void convert_chunk(Frame& F, const Args& args, int base, int limit) {
    GAS unsigned char* ws_ = (GAS unsigned char*)args.ws; asm volatile("" : "+s"(ws_));
    LAS unsigned* scr = (LAS unsigned*)(F.lds + 16384 + F.wave * 8448);
#pragma unroll 1
    for (int q = 0; q < 2; ++q) {
        const int it = base + F.wave * 2 + q; if (it >= limit) break;
        const int l = it / CV_L; int r = it % CV_L;
        GAS unsigned char* wl = ws_ + WS_W + (size_t)l * WL;
        int kind;
        if (r < CV_GU) kind = 0; else if ((r -= CV_GU) < CV_D) kind = 1; else if ((r -= CV_D) < CV_IN) kind = 2; else if ((r -= CV_IN) < CV_UQ) kind = 3;
        else if ((r -= CV_UQ) < CV_UKV) kind = 4; else if ((r -= CV_UKV) < CV_OUT) kind = 5; else if ((r -= CV_OUT) < CV_GU) kind = 6; else { r -= CV_GU; kind = 7; }
        if (kind == 0 || kind == 6) {
            const bool second = kind == 6; const int kb = r / 88, g = r % 88, t = g >> 2, rr = g & 3, src = (rr >> 1) * DFF + 128 * t + 64 * (rr & 1);
            const GAS float* W = (second ? A_WGU2 : A_WGU1) + (size_t)l * DM * 2 * DFF;
            tr_item64(W, 2 * DFF, DM, (GAS pg8::bf16_t*)(wl + (second ? W_GU2 : W_GU1)), kb, g, src, src + 32, nullptr, scr, F.lane);
        } else if (kind == 1 || kind == 7) { const bool second = kind == 7; const int kb = r / 16, g = r % 16;
            tr_item64((second ? A_WD2 : A_WD1) + (size_t)l * DFF * DM, DM, DFF, (GAS pg8::bf16_t*)(wl + (second ? W_D2 : W_D1)), kb, g, 64 * g, 64 * g + 32, nullptr, scr, F.lane);
        } else if (kind == 2) { const int kb = r / 32, g = r % 32;
            tr_item64(A_WIN + (size_t)l * DM * DIN, DIN, DM, (GAS pg8::bf16_t*)(wl + W_IN), kb, g, in_group_src(2 * g), in_group_src(2 * g + 1), nullptr, scr, F.lane);
        } else if (kind == 3) { const int kb = r / 12, g = r % 12;
            tr_item64(A_WUQ + (size_t)l * 256 * 576, 576, 256, (GAS pg8::bf16_t*)(wl + W_UQ), kb, g, g < 9 ? 64 * g : -1, g < 9 ? 64 * g + 32 : -1, A_QAN + l * 256, scr, F.lane);
        } else if (kind == 4) { const int kb = r / 12, g = r % 12, g0 = 2 * g, g1 = 2 * g + 1;
            tr_item64(A_WUKV + (size_t)l * 128 * 768, 768, 128, (GAS pg8::bf16_t*)(wl + W_UKV), kb, g, 256 * (g0 >> 3) + 64 * (g0 & 3) + 32 * ((g0 & 7) >> 2), 256 * (g1 >> 3) + 64 * (g1 & 3) + 32 * ((g1 & 7) >> 2), A_KVAN + l * 128, scr, F.lane);
        } else { const int kb = r / 16, g = r % 16;
            tr_item64(A_WOUT + (size_t)l * DM * DM, DM, DM, (GAS pg8::bf16_t*)(wl + W_OUT), kb, g, 64 * g, 64 * g + 32, A_OUTN + l * DM, scr, F.lane); }
    }
}

__device__ __forceinline__ void phase_pro0(Frame& F, const Args& args, gu32* qhead) {
    GAS unsigned char* ws_ = (GAS unsigned char*)args.ws; asm volatile("" : "+s"(ws_));
    constexpr int NMU = DEPTH * NMOD / 128;
    if ((int)blockIdx.x < NMU || F.G <= NMU) {
        LAS float* cond = (LAS float*)F.lds;
        LAS float* red = (LAS float*)(F.lds + 8192);
        for (int i = F.tid; i < 2 * DM; i += 512) { const float cv = A_C[i]; cond[i] = cv / (1.0f + expf(-cv)); }
        __syncthreads();
        for (int u = blockIdx.x; u < NMU; u += F.G) {
            const int l = u / (NMOD / 128), n0 = (u % (NMOD / 128)) * 128, c4 = F.lane & 31, kp = F.lane >> 5;
            const GAS float* w = A_WMOD + (size_t)l * DM * NMOD + n0 + 4 * c4;
            f32x4 a0 = {0.f, 0.f, 0.f, 0.f}, a1 = {0.f, 0.f, 0.f, 0.f};
#pragma unroll 8
            for (int i = 0; i < 64; ++i) { const int kk = F.wave * 128 + 2 * i + kp; const f32x4 wv = *(const GAS f32x4*)(w + (size_t)kk * NMOD); a0 += wv * cond[kk]; a1 += wv * cond[DM + kk]; }
#pragma unroll
            for (int q = 0; q < 4; ++q) { a0[q] = pg8::xsum32(a0[q]); a1[q] = pg8::xsum32(a1[q]); }
            if (kp == 0) { *(LAS f32x4*)(red + (F.wave * 2 + 0) * 128 + 4 * c4) = a0; *(LAS f32x4*)(red + (F.wave * 2 + 1) * 128 + 4 * c4) = a1; }
            __syncthreads();
            if (F.tid < 256) { const int bb = F.tid >> 7, ln = F.tid & 127; float s = 0.f;
#pragma unroll
                for (int wv = 0; wv < 8; ++wv) s += red[(wv * 2 + bb) * 128 + ln];
                MOD[((size_t)l * 2 + bb) * NMOD + n0 + ln] = s + A_BMOD[(size_t)l * NMOD + n0 + ln]; }
            __syncthreads();
        }
    }
    if ((int)blockIdx.x >= NMU || F.G <= NMU) {
        const int nb = F.G <= NMU ? F.G : F.G - NMU, b0 = F.G <= NMU ? (int)blockIdx.x : (int)blockIdx.x - NMU;
        for (int i = b0 * 512 + F.tid; i < MROWS * 16; i += nb * 512) {
            const int m = i >> 4, j = i & 15;
            const float freq = powf(10000.0f, -(float)j / 16.0f);
            const float ang = (float)A_POS[m] * freq;
            CS[(size_t)m * 32 + j] = cosf(ang); CS[(size_t)m * 32 + 16 + j] = sinf(ang);
        }
    }
    {
        LAS int* slot = (LAS int*)(F.lds + 12288);
        for (;;) {
            __syncthreads();
            if (F.tid == 0) slot[0] = (int)__hip_atomic_fetch_add(qhead, 16u, __ATOMIC_RELAXED, __HIP_MEMORY_SCOPE_AGENT);
            __syncthreads();
            const int base = slot[0];
            if (base >= CV_EARLY) break;
            convert_chunk(F, args, base, CV_EARLY);
        }
    }
}

__device__ __forceinline__ float gs_clamped(float g, float sc) { const float v = g * (1.0f + sc); return fabsf(v) < 1e-20f ? (v < 0.f ? -1e-20f : 1e-20f) : v; }
__device__ __forceinline__ void x_to_xb(Frame& F, const Args& args, const GAS float* xsrc, int l, int i) {
    GAS unsigned char* ws_ = (GAS unsigned char*)args.ws; asm volatile("" : "+s"(ws_));
    const int gw = F.vcu * NWAVES + F.wave, NGW = F.G * NWAVES;
    for (int m = gw; m < MROWS; m += NGW) {
        const int b = m >> 13;
        const GAS f32x4* xr = (const GAS f32x4*)(xsrc + (size_t)m * DM) + F.lane;
        const GAS f32x4* gr = (const GAS f32x4*)(A_NORMG + ((size_t)l * 3 + i) * DM) + F.lane;
        const GAS f32x4* sr = (const GAS f32x4*)(MOD + ((size_t)l * 2 + b) * NMOD + (3 * i + 1) * DM) + F.lane;
        float s = 0.f;
        GAS unsigned long long* o8 = (GAS unsigned long long*)(XB + (size_t)m * DM) + F.lane;
#pragma unroll
        for (int j = 0; j < 4; ++j) { const f32x4 v = xr[64 * j]; s += (v.x * v.x + v.y * v.y) + (v.z * v.z + v.w * v.w);
            const f32x4 g0 = gr[64 * j], s0 = sr[64 * j]; const f32x4 g = {gs_clamped(g0.x, s0.x), gs_clamped(g0.y, s0.y), gs_clamped(g0.z, s0.z), gs_clamped(g0.w, s0.w)}; const f32x4 y = v * g;
            o8[64 * j] = (unsigned long long)pk2(y.x, y.y) | ((unsigned long long)pk2(y.z, y.w) << 32); }
        s = wave_sum64(s);
        if (F.lane < 16) SSQX[(size_t)m * 16 + F.lane] = (F.lane == 0) ? s : 0.f;
    }
}

__device__ __forceinline__ void bias_rows(Frame& F, const Args& args, bool early) {
    GAS unsigned char* ws_ = (GAS unsigned char*)args.ws; asm volatile("" : "+s"(ws_));
    const int gw = F.vcu * NWAVES + F.wave, NGW = F.G * NWAVES;
    constexpr int RL = 5632 + 2048 + 5632, RE = 5632 + 2048;
    const int lo = early ? 0 : RE, hi = early ? RE : DEPTH * RL;
    for (int it = lo + gw; it < hi; it += NGW) {
        const int l = it / RL; int r = it % RL; int which, nrow; size_t woff; size_t boff;
        if (r < 5632) { which = 0; nrow = 5632; woff = W_GU1; boff = 0; } else if (r < 5632 + 2048) { r -= 5632; which = 1; nrow = 2048; woff = W_IN; boff = 2 * 5632; } else { r -= 5632 + 2048; which = 2; nrow = 5632; woff = W_GU2; boff = 2 * (5632 + 2048); }
        const GAS pg8::bf16_t* wr = (const GAS pg8::bf16_t*)(ws_ + WS_W + (size_t)l * WL + woff) + (size_t)r * DM;
        float a0 = 0.f, a1 = 0.f;
#pragma unroll
        for (int j = 0; j < 2; ++j) {
            const v4u wv = *(const GAS v4u*)(wr + j * 512 + F.lane * 8);
            const GAS float* s0 = MOD + ((size_t)l * 2 + 0) * NMOD + (3 * which) * DM + j * 512 + F.lane * 8; const GAS float* s1 = s0 + NMOD;
#pragma unroll
            for (int k = 0; k < 4; ++k) { const unsigned w = wv[k]; const float lo_ = __uint_as_float(w << 16), hi_ = __uint_as_float(w & 0xffff0000u);
                a0 += lo_ * s0[2 * k] + hi_ * s0[2 * k + 1]; a1 += lo_ * s1[2 * k] + hi_ * s1[2 * k + 1]; }
        }
        a0 = wave_sum64(a0); a1 = wave_sum64(a1);
        if (F.lane == 0) { BIAS[(size_t)l * BIAS_L + boff + r] = a0; BIAS[(size_t)l * BIAS_L + boff + nrow + r] = a1; }
    }
}
__device__ __forceinline__ void phase_pro1(Frame& F, const Args& args) {
    GAS unsigned char* ws_ = (GAS unsigned char*)args.ws; asm volatile("" : "+s"(ws_));
    for (int i = blockIdx.x * 512 + F.tid; i < DEPTH * 3 * 2 * DM; i += F.G * 512) {
        const int cidx = i & 1023, b = (i >> 10) & 1, li = i >> 11, l = li / 3, ii = li % 3;
        const float gv_ = gs_clamped(A_NORMG[((size_t)l * 3 + ii) * DM + cidx], MOD[((size_t)l * 2 + b) * NMOD + (3 * ii + 1) * DM + cidx]);
        GS[i] = gv_; ((GAS float*)WSP(WS_IGS))[i] = 1.0f / gv_;
    }
    bias_rows(F, args, true);
    x_to_xb(F, args, A_X, 0, 0);
}

__device__ __forceinline__ int next_unit(Frame& F, gu32* head) {
    LAS int* slot = (LAS int*)(F.lds + att::L_FLAG);
    __syncthreads();
    if (F.tid == 0) slot[0] = (int)__hip_atomic_fetch_add(head, 1u, __ATOMIC_RELAXED, __HIP_MEMORY_SCOPE_AGENT);
    __syncthreads();
    return slot[0];
}

#ifndef DUPS
#define DUPS -1
#endif
#ifndef PHM
#define PHM 255
#endif
#ifndef PHM2
#define PHM2 31
#endif
__global__ void __launch_bounds__(NWAVES * 64, 2) fwd_mega(Args args) {
    extern __shared__ __attribute__((aligned(16))) unsigned char lds[];
    Frame F; F.lds = (LAS unsigned char*)lds; F.tid = threadIdx.x; F.lane = F.tid & 63; F.wave = __builtin_amdgcn_readfirstlane(F.tid >> 6);
    F.G = gridDim.x; { const int bx = blockIdx.x; F.vcu = (F.G % 8 == 0) ? (bx % 8) * (F.G / 8) + bx / 8 : bx; }
    gu32* ctl = (gu32*)(args.ws + WS_CTL);
    for (int u = F.tid; u < (LDS_BYTES - LDSCTL_OFF) / 4; u += NWAVES * 64) ((LAS unsigned*)(F.lds + LDSCTL_OFF))[u] = 0u;
    __syncthreads();
    if (args.adapt >= 0) { x_to_xb(F, args, (const GAS float*)args.out, args.adapt / 3, args.adapt % 3); return; }
    const int lo = args.ph_lo, hi = args.ph_hi;
    XcdBarrier bar; bar.bar = (unsigned*)(ctl + CW_BAR) + args.li * XCD_BAR_WORDS; bar.x = 0; bar.st = nullptr;
    if (hi - lo > 1 || true) bar = xcd_barrier_post((unsigned*)(ctl + CW_BAR) + args.li * XCD_BAR_WORDS, (volatile LAS unsigned*)(F.lds + MISC_OFF) + 8);

    for (int ph = lo; ph < hi; ++ph) {
        { int t_ = threadIdx.x; asm volatile("" : "+v"(t_)); F.tid = t_; F.lane = t_ & 63; F.wave = __builtin_amdgcn_readfirstlane(t_ >> 6); }
        GAS unsigned char* ws_ = (GAS unsigned char*)args.ws; asm volatile("" : "+s"(ws_));
        int nrep = 1;
        if (DUPS >= 0) { const int ty = ph < 2 ? 8 + ph : ((ph - 2) & 7); if (ty == DUPS && !(ty == 5) && !((ty == 1 || ty == 7) && ph != 3)) nrep = 2; }
        for (int rep = 0; rep < nrep; ++rep) {
        if ((PHM & 64) && ph == 0) phase_pro0(F, args, ctl + CW_Q + 64 * 8);
        else if ((PHM & 128) && ph == 1) phase_pro1(F, args);
        else {
            const int l = (ph - 2) >> 3, s = (ph - 2) & 7;
            const GAS unsigned char* wl = ws_ + WS_W + (size_t)l * WL;
            const GAS float* biasl = BIAS + (size_t)l * BIAS_L;
            const GAS float* modl = MOD + (size_t)l * 2 * NMOD;
            if ((PHM & 1) && (s == 0 || s == 6)) {
                pg8::Gemm g{(const pg8::bf16_t*)XB, (const pg8::bf16_t*)(wl + (s == 0 ? W_GU1 : W_GU2)), MROWS, 5632, DM}; pg8::StaticOrder S; S.init(MROWS, 5632, F.G, (int)blockIdx.x);
                pg8::EpiUp E{ws_, biasl + (s == 0 ? 0 : 2 * (5632 + 2048))};
                pg8::gemm_phase<pg8::EpiUp, pg8::StaticOrder, true, true>(F.lds, g, S, E);
            } else if ((PHM & 2) && (s == 1 || s == 7)) {
                pg8::Gemm g{(const pg8::bf16_t*)HID, (const pg8::bf16_t*)(wl + (s == 1 ? W_D1 : W_D2)), MROWS, DM, DFF}; pg8::StaticOrder S; S.init(MROWS, DM, F.G, (int)blockIdx.x);
                const bool lastp = (s == 7 && l == DEPTH - 1);
                const GAS float* gsn = lastp ? nullptr : (s == 1 ? GS + ((size_t)(l * 3 + 1) * 2) * DM : GS + ((size_t)((l + 1) * 3 + 0) * 2) * DM);
                const GAS float* igp = (const GAS float*)WSP(WS_IGS) + ((size_t)(l * 3 + (s == 1 ? 0 : 2)) * 2) * DM;
                pg8::EpiResS<false> E{(GAS float*)args.out, ws_, modl + (s == 1 ? 2 : 8) * DM, igp, gsn, 0.5f}; pg8::gemm_phase<pg8::EpiResS<false>, pg8::StaticOrder, false, true>(F.lds, g, S, E, (unsigned long long*)(ctl + CW_Q + 64 * 13));
            } else if ((PHM & 4) && s == 2) {
                pg8::Gemm g{(const pg8::bf16_t*)XB, (const pg8::bf16_t*)(wl + W_IN), MROWS, 2048, DM}; pg8::StaticOrder S; S.init(MROWS, 2048, F.G, (int)blockIdx.x);
                pg8::EpiIn E{ws_, A_SWAQN + l * 64, A_SWAKN + l * 64, biasl + 2 * 5632};
                pg8::gemm_phase<pg8::EpiIn, pg8::StaticOrder, true, true>(F.lds, g, S, E);
            } else if ((PHM & 8) && s == 3) {
                if (PHM2 & 1) { pg8::Gemm g{(const pg8::bf16_t*)CQ, (const pg8::bf16_t*)(wl + W_UQ), MROWS, 768, 256}; pg8::StaticOrder S; S.init(MROWS, 768, F.G, (int)blockIdx.x);
                  pg8::EpiUq E{ws_}; pg8::gemm_phase<pg8::EpiUq, pg8::StaticOrder, true, true>(F.lds, g, S, E); }
                if (PHM2 & 2) { pg8::Gemm g{(const pg8::bf16_t*)CKV, (const pg8::bf16_t*)(wl + W_UKV), MROWS, 768, 128}; pg8::StaticOrder S; S.init(MROWS, 768, F.G, (int)((blockIdx.x + 64) % F.G));
                  pg8::EpiUkv E{ws_, A_MLAKN + l * 96}; pg8::gemm_phase<pg8::EpiUkv, pg8::StaticOrder, true, true>(F.lds, g, S, E); }
            } else if ((PHM & 16) && s == 4) {
                att::AttnP PA{ws_, A_MLAQN + l * 96, nullptr, nullptr, nullptr};
                att::AttnP PB{ws_, nullptr, A_POS, A_SINKS + l * 6, A_RELB};
                att::AttnP PC{ws_, nullptr, nullptr, nullptr, nullptr};
                gu32* head = ctl + CW_Q + 64 * (2 * l + 1 + 4 * rep);
                for (;;) { const int u = next_unit(F, head); if (u >= 384 + 256 + 384) break;
                    if ((PHM2 & 16) && u < 384) { const int qb = 31 - u / 12, bh = u % 12;
                        att::attn_unit<96, 0>(F.lds, PA, bh / 6, bh % 6, qb, (unsigned long long*)(ctl + CW_Q + 64 * 12)); }

                    else if ((PHM2 & 4) && u >= 384 && u < 640) { const int v = u - 384, qb = 31 - (v >> 3), bh = v & 7; att::attn_unit<64, 2>(F.lds, PC, bh >> 2, bh & 3, qb); }
                    else if ((PHM2 & 8) && u >= 640) { const int v = u - 640, qb = v / 12, bh = v % 12; att::attn_unit<64, 1>(F.lds, PB, bh / 6, bh % 6, qb); } }
                if (l == 0 && rep == 0) {
                    gu32* chead = ctl + CW_Q + 64 * 9; LAS int* cslot = (LAS int*)(F.lds + 12288);
                    for (;;) { __syncthreads(); if (F.tid == 0) cslot[0] = (int)__hip_atomic_fetch_add(chead, 16u, __ATOMIC_RELAXED, __HIP_MEMORY_SCOPE_AGENT); __syncthreads();
                        const int cb = CV_EARLY + cslot[0]; if (cb >= CV_ALL) break; convert_chunk(F, args, cb, CV_ALL); } }
            } else if ((PHM & 32) && s == 5) {
                if (l == 0 && rep == 0) { bias_rows(F, args, false); asm volatile("s_waitcnt vmcnt(0)" ::: "memory"); __syncthreads(); }
                pg8::Gemm g{(const pg8::bf16_t*)OALL, (const pg8::bf16_t*)(wl + W_OUT), MROWS, DM, DM}; pg8::StaticOrder S; S.init(MROWS, DM, F.G, (int)blockIdx.x);
                pg8::EpiResS<true> E{(GAS float*)args.out, ws_, modl + 5 * DM, (const GAS float*)WSP(WS_IGS) + ((size_t)(l * 3 + 1) * 2) * DM, GS + ((size_t)(l * 3 + 2) * 2) * DM, 1.0f}; pg8::gemm_phase<pg8::EpiResS<true>, pg8::StaticOrder, false, true>(F.lds, g, S, E);
            }
        }
        if (rep + 1 < nrep) xcd_barrier(bar);
        }
        if (ph + 1 < hi) xcd_barrier(bar);
    }
#ifdef GEMM_PROF
    xcd_barrier(bar);
    if (blockIdx.x == 0 && threadIdx.x == 0) { const unsigned long long* st = (const unsigned long long*)(ctl + CW_Q + 64 * 13); double sh;
        if (GEMM_PROF == 0) sh = (double)st[1] / (double)(st[0] + st[1]);
        else if (GEMM_PROF == 1) sh = (double)st[0] / (double)st[2] / 1.0e6;
        else sh = (double)st[1] / (double)st[2] / 1.0e6;
        args.out[0] += (float)(0.04 + 0.18 * (sh > 1.0 ? 1.0 : sh)); }
#endif
#ifdef ATT_PROF
    xcd_barrier(bar);
    if (blockIdx.x == 0 && threadIdx.x == 0) { const unsigned long long* st = (const unsigned long long*)(ctl + CW_Q + 64 * 12);
        const double tot = (double)st[0]; double sh = 0.0;
        if (ATT_PROF == 0) sh = (double)st[0] / (double)st[5] / 1.0e6;
        else if (ATT_PROF == 5) sh = (double)st[0] / (double)st[6] / 1.0e4;
        else if (ATT_PROF == 6) sh = (double)st[6] / 1.0e3;
        else sh = (double)st[ATT_PROF] / tot;
        args.out[0] += (float)(0.04 + 0.18 * (sh > 1.0 ? 1.0 : sh)); }
#endif
}
#ifndef HYB
#define HYB 0
#endif
#ifndef DUPH
#define DUPH -1
#endif
static void launch_fwd(hipStream_t stream, Args a, int grid, int lo, int hi, int li, int adapt) {
    a.ph_lo = lo; a.ph_hi = hi; a.li = li; a.adapt = adapt;
    hipLaunchKernelGGL(fwd_mega, dim3(grid), dim3(NWAVES * 64), LDS_BYTES, stream, a);
}
extern "C" void kernel_launch(void* const* d_in, const int* in_sizes, int n_in, void* d_out, int out_size, void* d_ws, size_t ws_size, hipStream_t stream) {
    static int grid = 0;
    if (grid == 0) {
        if (n_in != 23 || out_size != MROWS * DM || ws_size < WS_END) { fprintf(stderr, "kernel_launch: unexpected problem (n_in %d, out %d, ws %zu < %zu)\n", n_in, out_size, ws_size, (size_t)WS_END); grid = -1; return; }
        int dev = 0, cus = 0, per_cu = 0;
        if (hipGetDevice(&dev) != hipSuccess || hipDeviceGetAttribute(&cus, hipDeviceAttributeMultiprocessorCount, dev) != hipSuccess) { grid = -1; return; }
        if (hipFuncSetAttribute((const void*)fwd_mega, hipFuncAttributeMaxDynamicSharedMemorySize, LDS_BYTES) != hipSuccess) { fprintf(stderr, "kernel_launch: hipFuncSetAttribute failed\n"); grid = -1; return; }
        if (hipOccupancyMaxActiveBlocksPerMultiprocessor(&per_cu, (const void*)fwd_mega, NWAVES * 64, LDS_BYTES) != hipSuccess || per_cu < 1) { fprintf(stderr, "kernel_launch: occupancy query says %d blocks per CU\n", per_cu); (void)hipGetLastError(); grid = -1; return; }
        if (cus < 256) { fprintf(stderr, "kernel_launch: built for a 256-CU device (the one-unit-per-workgroup GEMM phases need exactly 256 workgroups), found %d CUs\n", cus); grid = -1; return; }
        grid = 256;
    }
    if (grid < 0) return;
    (void)hipMemsetAsync((char*)d_ws + WS_CTL, 0, CTL_ZERO_BYTES, stream);
    Args a{};
    for (int i = 0; i < 23; ++i) a.in[i] = d_in[i];
    a.out = (float*)d_out; a.ws = (unsigned char*)d_ws;
#if HYB == 0
    launch_fwd(stream, a, grid, 0, NPH, 0, -1);
#elif HYB == 1
    for (int ph = 0; ph < NPH; ++ph) launch_fwd(stream, a, grid, ph, ph + 1, 0, -1);
#elif HYB == 4
    for (int ph = 0; ph < NPH; ++ph) {
        launch_fwd(stream, a, grid, ph, ph + 1, 0, -1);
        const int ty = ph < 2 ? 8 + ph : ((ph - 2) & 7);
        if (ty == DUPH && ty != 5 && !((ty == 1 || ty == 7) && ph != 3)) { (void)hipMemsetAsync((char*)d_ws + WS_CTL, 0, CTL_ZERO_BYTES, stream); launch_fwd(stream, a, grid, ph, ph + 1, 0, -1); }
    }
#else
    {
        using namespace nv;
        const float* x = (const float*)d_in[0]; const int* positions = (const int*)d_in[2];
        const float* rel_bias = (const float*)d_in[3]; const float* norm_g = (const float*)d_in[4];
        const float* w_ffn1_gu = (const float*)d_in[7]; const float* w_ffn1_down = (const float*)d_in[8]; const float* w_in = (const float*)d_in[9];
        const float* q_a_norm = (const float*)d_in[10]; const float* kv_a_norm = (const float*)d_in[11]; const float* w_uq = (const float*)d_in[12]; const float* w_ukv = (const float*)d_in[13];
        const float* mla_q_norm = (const float*)d_in[14]; const float* mla_k_norm = (const float*)d_in[15]; const float* swa_q_norm = (const float*)d_in[16]; const float* swa_k_norm = (const float*)d_in[17];
        const float* sinks = (const float*)d_in[18]; const float* out_norm = (const float*)d_in[19]; const float* w_out = (const float*)d_in[20];
        const float* w_ffn2_gu = (const float*)d_in[21]; const float* w_ffn2_down = (const float*)d_in[22];
        float* out = (float*)d_out; char* ws = (char*)d_ws;
        float* mod = (float*)(ws + WS_MOD);
        char* nb = ws + WS_XB;
        float* H = (float*)(nb); float* HIDn = (float*)(nb + 33 * MiB); float* P = (float*)(nb + 33 * MiB); float* QA = (float*)(nb + 91 * MiB); float* KVRAW = (float*)(nb + 110 * MiB);
        float* KAn = (float*)(nb + 135 * MiB); float* CQN = (float*)(nb + 154 * MiB); float* CKVN = (float*)(nb + 163 * MiB); float* QB = (float*)(nb + 168 * MiB); float* KBn = (float*)(nb + 181 * MiB);
        launch_fwd(stream, a, grid, 0, 1, 0, -1); launch_fwd(stream, a, grid, 1, 2, 0, -1);
        auto naive_ffn = [&](int l, int i, const float* xsrc) {
            for (int b = 0; b < BATCH; ++b) {
                float* xb = out + (size_t)b * nv::SEQ * nv::D; const float* xs = xsrc + (size_t)b * nv::SEQ * nv::D; const float* modlb = mod + ((size_t)l * 2 + b) * nv::NMOD;
                const float* wgu = (i == 0 ? w_ffn1_gu : w_ffn2_gu) + (size_t)l * nv::D * 2 * nv::DFF; const float* wdn = (i == 0 ? w_ffn1_down : w_ffn2_down) + (size_t)l * nv::DFF * nv::D;
                const float* sh = modlb + (3 * i) * nv::D; const float* sc = modlb + (3 * i + 1) * nv::D; const float* gt = modlb + (3 * i + 2) * nv::D;
                k_normmod<<<nv::SEQ / 4, 256, 0, stream>>>(xs, norm_g + ((size_t)l * 3 + i) * nv::D, sh, sc, H, nv::SEQ);
                k_gemm<true, 0><<<dim3(nv::DFF / 128, nv::SEQ / 128), 256, 0, stream>>>(H, nv::D, wgu, wgu + nv::DFF, 2 * nv::DFF, HIDn, nv::DFF, nv::DFF, nv::D, nullptr, nullptr, 0.f);
                k_gemm<false, 1><<<dim3(nv::D / 128, nv::SEQ / 128), 256, 0, stream>>>(HIDn, nv::DFF, wdn, nullptr, nv::D, xb, nv::D, nv::D, nv::DFF, xs, gt, 0.5f);
            }
        };
        auto naive_mixer = [&](int l) {
            for (int b = 0; b < BATCH; ++b) {
                float* xb = out + (size_t)b * nv::SEQ * nv::D; const int* posb = positions + b * nv::SEQ; const float* modlb = mod + ((size_t)l * 2 + b) * nv::NMOD;
                const float* sh = modlb + 3 * nv::D; const float* sc = modlb + 4 * nv::D; const float* gt = modlb + 5 * nv::D;
                k_normmod<<<nv::SEQ / 4, 256, 0, stream>>>(xb, norm_g + ((size_t)l * 3 + 1) * nv::D, sh, sc, H, nv::SEQ);
                k_gemm<false, 0><<<dim3((nv::DIN + 127) / 128, nv::SEQ / 128), 256, 0, stream>>>(H, nv::D, w_in + (size_t)l * nv::D * nv::DIN, nullptr, nv::DIN, P, nv::DIN, nv::DIN, nv::D, nullptr, nullptr, 0.f);
                k_headnorm<<<nv::SEQ / 4, 256, 0, stream>>>(P, nv::DIN, 0, 256, nullptr, 0, 0, 0, q_a_norm + l * 256, CQN, 256, 256, 1, nv::SEQ, posb, 0, 1);
                k_headnorm<<<nv::SEQ / 4, 256, 0, stream>>>(P + 256, nv::DIN, 0, 128, nullptr, 0, 0, 0, kv_a_norm + l * 128, CKVN, 128, 128, 1, nv::SEQ, posb, 0, 1);
                k_gemm<false, 0><<<dim3((576 + 127) / 128, nv::SEQ / 128), 256, 0, stream>>>(CQN, 256, w_uq + (size_t)l * 256 * 576, nullptr, 576, QA, 576, 576, 256, nullptr, nullptr, 0.f);
                k_gemm<false, 0><<<dim3(768 / 128, nv::SEQ / 128), 256, 0, stream>>>(CKVN, 128, w_ukv + (size_t)l * 128 * 768, nullptr, 768, KVRAW, 768, 768, 128, nullptr, nullptr, 0.f);
                k_headnorm<<<nv::SEQ * 6 / 4, 256, 0, stream>>>(QA, 576, 96, 96, nullptr, 0, 0, 0, mla_q_norm + l * 96, QA, 576, 96, 6, nv::SEQ, posb, 1, 1);
                k_headnorm<<<nv::SEQ * 6 / 4, 256, 0, stream>>>(KVRAW, 768, 128, 64, P + 384, nv::DIN, 0, 32, mla_k_norm + l * 96, KAn, 576, 96, 6, nv::SEQ, posb, 1, 1);
                k_headnorm<<<nv::SEQ * 6 / 4, 256, 0, stream>>>(P + 416, nv::DIN, 64, 64, nullptr, 0, 0, 0, swa_q_norm + l * 64, QB, 384, 64, 6, nv::SEQ, posb, 0, 1);
                k_headnorm<<<nv::SEQ * 2 / 4, 256, 0, stream>>>(P + 800, nv::DIN, 64, 64, nullptr, 0, 0, 0, swa_k_norm + l * 64, KBn, 128, 64, 2, nv::SEQ, posb, 0, 1);
                k_attn<96, 64, 0><<<dim3(nv::SEQ / 256, 6), 256, 0, stream>>>(QA, 576, 96, KAn, 576, 96, KVRAW + 64, 768, 128, H, nv::D, 0, 1, posb, nullptr, nullptr, 6);
                k_attn<64, 64, 1><<<dim3(nv::SEQ / 256, 6), 256, 0, stream>>>(QB, 384, 64, KBn, 128, 64, P + 928, nv::DIN, 64, H, nv::D, 384, 3, posb, sinks + l * 6, rel_bias, 6);
                k_attn<64, 64, 2><<<dim3(nv::SEQ / 256, 4), 256, 0, stream>>>(P + 1056, nv::DIN, 64, P + 1056 + 256, nv::DIN, 64, P + 1056 + 512, nv::DIN, 64, H, nv::D, 768, 1, posb, nullptr, nullptr, 4);
                k_groupnorm<<<nv::SEQ / 4, 256, 0, stream>>>(H, out_norm + l * nv::D, nv::SEQ);
                k_gemm<false, 1><<<dim3(nv::D / 128, nv::SEQ / 128), 256, 0, stream>>>(H, nv::D, w_out + (size_t)l * nv::D * nv::D, nullptr, nv::D, xb, nv::D, nv::D, nv::D, xb, gt, 1.0f);
            }
        };
        for (int l = 0; l < DEPTH; ++l) {
            const int base = 2 + 8 * l;
#if HYB == 2
            if (l > 0) launch_fwd(stream, a, grid, 0, 0, 0, l * 3 + 0);
            launch_fwd(stream, a, grid, base + 0, base + 1, 0, -1); launch_fwd(stream, a, grid, base + 1, base + 2, 0, -1);
            naive_mixer(l);
            launch_fwd(stream, a, grid, 0, 0, 0, l * 3 + 2);
            launch_fwd(stream, a, grid, base + 6, base + 7, 0, -1); launch_fwd(stream, a, grid, base + 7, base + 8, 0, -1);
#else
            naive_ffn(l, 0, l == 0 ? x : out);
            launch_fwd(stream, a, grid, 0, 0, 0, l * 3 + 1);
            for (int s = 2; s <= 5; ++s) launch_fwd(stream, a, grid, base + s, base + s + 1, 0, -1);
            naive_ffn(l, 2, out);
#endif
        }
    }
#endif
}
```

```cpp
#include <hip/hip_runtime.h>
#include <cstdio>
#include <cstdint>
#include <cmath>
namespace nv {
constexpr int D = 1024, BATCH = 2, SEQ = 8192, DEPTH = 2, M = BATCH * SEQ;
constexpr int DFF = 2816, DIN = 1824, NMOD = 9 * D;
constexpr float EPS = 1e-6f;

__device__ __forceinline__ float wave_sum(float v) {
#pragma unroll
    for (int o = 1; o < 64; o <<= 1) v += __shfl_xor(v, o);
    return v;
}
__device__ __forceinline__ float silu_f(float x) { return x / (1.0f + expf(-x)); }

__global__ void k_mod(const float* __restrict__ c, const float* __restrict__ w_mod, const float* __restrict__ b_mod, float* __restrict__ mod) {
    int idx = blockIdx.x * 256 + threadIdx.x;
    if (idx >= DEPTH * NMOD) return;
    int l = idx / NMOD, n = idx % NMOD;
    float a0 = 0.f, a1 = 0.f;
    const float* w = w_mod + (size_t)l * D * NMOD + n;
    for (int k = 0; k < D; ++k) {
        float wv = w[(size_t)k * NMOD];
        a0 += silu_f(c[k]) * wv; a1 += silu_f(c[D + k]) * wv;
    }
    mod[((size_t)l * 2 + 0) * NMOD + n] = a0 + b_mod[l * NMOD + n];
    mod[((size_t)l * 2 + 1) * NMOD + n] = a1 + b_mod[l * NMOD + n];
}

__global__ void k_normmod(const float* __restrict__ x, const float* __restrict__ g, const float* __restrict__ sh, const float* __restrict__ sc, float* __restrict__ H, int rows) {
    int row = blockIdx.x * 4 + (threadIdx.x >> 6), lane = threadIdx.x & 63;
    if (row >= rows) return;
    const float* xr = x + (size_t)row * D;
    float v[16]; float s = 0.f;
#pragma unroll
    for (int j = 0; j < 16; ++j) { v[j] = xr[lane + 64 * j]; s += v[j] * v[j]; }
    s = wave_sum(s);
    float r = rsqrtf(s * (1.0f / D) + EPS);
#pragma unroll
    for (int j = 0; j < 16; ++j) { int cidx = lane + 64 * j; H[(size_t)row * D + cidx] = v[j] * r * g[cidx] * (1.0f + sc[cidx]) + sh[cidx]; }
}

template <bool DUAL, int EPI>
__global__ void __launch_bounds__(256) k_gemm(const float* __restrict__ A, int lda, const float* __restrict__ W, const float* __restrict__ W2, int ldw,
                                              float* C, int ldc, int N, int K, const float* R, const float* __restrict__ gate, float coef) {
    __shared__ float As[16][128 + 4];
    __shared__ float Bs[16][128 + 4];
    __shared__ float Bs2[DUAL ? 16 : 1][128 + 4];
    const int tid = threadIdx.x, tx = tid & 15, ty = tid >> 4;
    const int m0 = blockIdx.y * 128, n0 = blockIdx.x * 128;
    float acc[8][8], acc2[DUAL ? 8 : 1][8];
#pragma unroll
    for (int i = 0; i < 8; ++i)
#pragma unroll
        for (int j = 0; j < 8; ++j) { acc[i][j] = 0.f; if (DUAL) acc2[i][j] = 0.f; }
    for (int k0 = 0; k0 < K; k0 += 16) {
#pragma unroll
        for (int i = 0; i < 2; ++i) {
            int e = tid + 256 * i;
            int r = e >> 2, kq = e & 3;
            const float4 v = *(const float4*)(A + (size_t)(m0 + r) * lda + k0 + kq * 4);
            As[kq * 4 + 0][r] = v.x; As[kq * 4 + 1][r] = v.y; As[kq * 4 + 2][r] = v.z; As[kq * 4 + 3][r] = v.w;
        }
#pragma unroll
        for (int i = 0; i < 8; ++i) {
            int e = tid + 256 * i;
            int kk = e >> 7, nn = e & 127;
            int n = n0 + nn;
            Bs[kk][nn] = (n < N) ? W[(size_t)(k0 + kk) * ldw + n] : 0.f;
            if (DUAL) Bs2[kk][nn] = (n < N) ? W2[(size_t)(k0 + kk) * ldw + n] : 0.f;
        }
        __syncthreads();
#pragma unroll
        for (int kk = 0; kk < 16; ++kk) {
            float a[8], b[8], b2[8];
#pragma unroll
            for (int i = 0; i < 8; ++i) a[i] = As[kk][ty * 8 + i];
#pragma unroll
            for (int j = 0; j < 8; ++j) { b[j] = Bs[kk][tx * 8 + j]; if (DUAL) b2[j] = Bs2[kk][tx * 8 + j]; }
#pragma unroll
            for (int i = 0; i < 8; ++i)
#pragma unroll
                for (int j = 0; j < 8; ++j) { acc[i][j] += a[i] * b[j]; if (DUAL) acc2[i][j] += a[i] * b2[j]; }
        }
        __syncthreads();
    }
#pragma unroll
    for (int i = 0; i < 8; ++i)
#pragma unroll
        for (int j = 0; j < 8; ++j) {
            int m = m0 + ty * 8 + i, n = n0 + tx * 8 + j;
            if (n < N) {
                float v = acc[i][j];
                if (DUAL) v = silu_f(v) * acc2[i][j];
                if (EPI == 1) v = R[(size_t)m * ldc + n] + coef * gate[n] * v;
                C[(size_t)m * ldc + n] = v;
            }
        }
}

__global__ void k_headnorm(const float* src1, int s1stride, int hs1, int W1, const float* src2, int s2stride, int hs2, int W2,
                           const float* __restrict__ gain, float* dst, int dstride, int dhs, int nheads, int rows, const int* __restrict__ pos, int do_rope, int do_norm) {
    int item = blockIdx.x * 4 + (threadIdx.x >> 6), lane = threadIdx.x & 63;
    if (item >= rows * nheads) return;
    int row = item / nheads, h = item % nheads;
    const int Wt = W1 + W2;
    float v[4]; float s = 0.f;
#pragma unroll
    for (int j = 0; j < 4; ++j) {
        int e = lane + 64 * j; float t = 0.f;
        if (e < W1) t = src1[(size_t)row * s1stride + h * hs1 + e];
        else if (e < Wt) t = src2[(size_t)row * s2stride + h * hs2 + (e - W1)];
        v[j] = t; s += t * t;
    }
    s = wave_sum(s);
    float r = do_norm ? rsqrtf(s / (float)Wt + EPS) : 1.0f;
    __shared__ float tmp[4][256];
    float* tw = tmp[threadIdx.x >> 6];
#pragma unroll
    for (int j = 0; j < 4; ++j) { int e = lane + 64 * j; if (e < Wt) tw[e] = v[j] * r * (do_norm ? gain[e] : 1.0f); }
    __syncthreads();
    if (do_rope) {
        float outv = 0.f; int e = lane;
        if (lane < 32) {
            int jf = lane & 15;
            float freq = powf(10000.0f, -(float)jf / 16.0f);
            float ang = (float)pos[row] * freq;
            float cs = cosf(ang), sn = sinf(ang);
            float x1 = tw[Wt - 32 + jf], x2 = tw[Wt - 16 + jf];
            outv = (lane < 16) ? (x1 * cs - x2 * sn) : (x2 * cs + x1 * sn);
        }
        __syncthreads();
        if (lane < 32) tw[Wt - 32 + e] = outv;
        __syncthreads();
    }
#pragma unroll
    for (int j = 0; j < 4; ++j) { int e = lane + 64 * j; if (e < Wt) dst[(size_t)row * dstride + h * dhs + e] = tw[e]; }
}

__device__ __forceinline__ int t5_bucket(int rel) {
    int n = rel > 0 ? rel : 0;
    if (n < 16) return n;
    float nf = (float)n;
    int large = 16 + (int)(logf(nf / 16.0f) / logf(8.0f) * 16.0f);
    return large < 31 ? large : 31;
}

template <int DQK, int DV, int MODE>
__global__ void __launch_bounds__(256) k_attn(const float* __restrict__ Q, int qstride, int qhs, const float* __restrict__ Kp, int kstride, int khs, const float* __restrict__ Vp, int vstride, int vhs,
                                              float* __restrict__ O, int ostride, int ocol0, int group, const int* __restrict__ pos, const float* __restrict__ sinks, const float* __restrict__ relb, int nheads_q) {
    __shared__ float Ks[64][DQK];
    __shared__ float Vs[64][DV];
    const int h = blockIdx.y, kvh = h / group, t0 = blockIdx.x * 256, t = t0 + threadIdx.x;
    float q[DQK], o[DV];
    const float scale = rsqrtf((float)DQK);
#pragma unroll
    for (int d = 0; d < DQK; ++d) q[d] = Q[(size_t)t * qstride + h * qhs + d] * scale;
#pragma unroll
    for (int d = 0; d < DV; ++d) o[d] = 0.f;
    float mrun = (MODE == 1) ? sinks[h] : -INFINITY, lrun = (MODE == 1) ? 1.0f : 0.f;
    float after = 0.f;
    const int posq = (MODE == 1) ? pos[t] : 0;
    int jt_lo, jt_hi;
    if (MODE == 0) { jt_lo = 0; jt_hi = (t0 + 255) / 64; }
    else if (MODE == 1) { int lo = t0 - 127; if (lo < 0) lo = 0; jt_lo = lo / 64; jt_hi = (t0 + 255) / 64; }
    else { jt_lo = 0; jt_hi = (t0 + 254) / 64; }
    const int ntile = jt_hi - jt_lo + 1;
    for (int it = 0; it < ntile; ++it) {
        const int jt = (MODE == 2) ? (jt_hi - it) : (jt_lo + it);
        const int j0 = jt * 64;
        __syncthreads();
        for (int e = threadIdx.x; e < 64 * DQK; e += 256) { int jj = e / DQK, d = e % DQK; Ks[jj][d] = Kp[(size_t)(j0 + jj) * kstride + kvh * khs + d]; }
        for (int e = threadIdx.x; e < 64 * DV; e += 256) { int jj = e / DV, d = e % DV; Vs[jj][d] = Vp[(size_t)(j0 + jj) * vstride + kvh * vhs + d]; }
        __syncthreads();
        if (MODE == 2) {
            bool live = false;
            for (int jj = 63; jj >= 0; --jj) {
                int j = j0 + jj;
                if (j < t) {
                    float z = 0.f;
#pragma unroll
                    for (int d = 0; d < DQK; ++d) z += q[d] * Ks[jj][d];
                    float sp = fmaxf(z, 0.f) + log1pf(expf(-fabsf(z)));
                    float a = expf(z - sp + after);
                    after -= sp;
#pragma unroll
                    for (int d = 0; d < DV; ++d) o[d] += a * Vs[jj][d];
                }
            }
            live = (after > -110.0f) ;
            if (!__syncthreads_or(live ? 1 : 0)) break;
        } else {
            for (int jj = 0; jj < 64; ++jj) {
                int j = j0 + jj;
                bool ok = (j <= t);
                if (MODE == 1) ok = ok && (j > t - 128);
                if (ok) {
                    float s = 0.f;
#pragma unroll
                    for (int d = 0; d < DQK; ++d) s += q[d] * Ks[jj][d];
                    if (MODE == 1) s += relb[t5_bucket(posq - pos[j]) * nheads_q + h];
                    float mn = fmaxf(mrun, s);
                    float f = expf(mrun - mn), p = expf(s - mn);
                    lrun = lrun * f + p; mrun = mn;
#pragma unroll
                    for (int d = 0; d < DV; ++d) o[d] = o[d] * f + p * Vs[jj][d];
                }
            }
        }
    }
    const float inv = (MODE == 2) ? 1.0f : 1.0f / lrun;
#pragma unroll
    for (int d = 0; d < DV; ++d) O[(size_t)t * ostride + ocol0 + h * DV + d] = o[d] * inv;
}

__global__ void k_groupnorm(float* O, const float* __restrict__ on, int rows) {
    int row = blockIdx.x * 4 + (threadIdx.x >> 6), lane = threadIdx.x & 63;
    if (row >= rows) return;
    float* orow = O + (size_t)row * D;
    float v[16]; float s0 = 0.f, s1 = 0.f, s2 = 0.f;
#pragma unroll
    for (int j = 0; j < 16; ++j) { int cidx = lane + 64 * j; v[j] = orow[cidx]; float sq = v[j] * v[j]; if (cidx < 384) s0 += sq; else if (cidx < 768) s1 += sq; else s2 += sq; }
    s0 = wave_sum(s0); s1 = wave_sum(s1); s2 = wave_sum(s2);
    float r0 = rsqrtf(s0 / 384.f + EPS), r1 = rsqrtf(s1 / 384.f + EPS), r2 = rsqrtf(s2 / 256.f + EPS);
#pragma unroll
    for (int j = 0; j < 16; ++j) { int cidx = lane + 64 * j; float r = cidx < 384 ? r0 : (cidx < 768 ? r1 : r2); orow[cidx] = v[j] * r * on[cidx]; }
}
}
constexpr int NWAVES = 8;
constexpr int BATCH = 2, SEQ = 8192, DM = 1024, DEPTH = 2, MROWS = BATCH * SEQ;
constexpr int DFF = 2816, DIN = 1824, NMOD = 9 * DM;
constexpr int NPH = 2 + 8 * DEPTH;
constexpr size_t MiB = 1u << 20;
constexpr size_t WS_CTL = 0, CTL_ZERO_BYTES = 256 * 1024;
constexpr size_t WS_MOD = 1 * MiB;
constexpr size_t WS_GS = WS_MOD + 160 * 1024;
constexpr size_t WS_IGS = WS_GS + 64 * 1024;
constexpr size_t WS_BIAS = WS_IGS + 64 * 1024;
constexpr size_t BIAS_L = 2 * (5632 + 2048 + 5632);
constexpr size_t WS_SSQX = 2 * MiB;
constexpr size_t WS_SSQO = 3 * MiB;
constexpr size_t WS_CS = 4 * MiB;
constexpr size_t WS_KPE = 6 * MiB;
constexpr size_t WS_SSQC = 8 * MiB;
constexpr size_t WS_W = 9 * MiB;
constexpr size_t W_GU1 = 0, W_D1 = W_GU1 + (size_t)5632 * 1024 * 2, W_IN = W_D1 + (size_t)1024 * 2816 * 2, W_UQ = W_IN + (size_t)2048 * 1024 * 2, W_UKV = W_UQ + (size_t)768 * 256 * 2,
                 W_OUT = W_UKV + (size_t)768 * 128 * 2, W_GU2 = W_OUT + (size_t)1024 * 1024 * 2, W_D2 = W_GU2 + (size_t)5632 * 1024 * 2, WL = W_D2 + (size_t)1024 * 2816 * 2;
constexpr size_t WS_XB = WS_W + ((2 * WL + MiB - 1) / MiB) * MiB;
constexpr size_t WS_ACT = WS_XB + 32 * MiB;
constexpr size_t WS_HID = WS_ACT;
constexpr size_t WS_CQ = WS_ACT, WS_CKV = WS_CQ + 8 * MiB, WS_QRAW = WS_CKV + 4 * MiB, WS_KA = WS_QRAW + 36 * MiB, WS_VA = WS_KA + 18 * MiB, WS_QS = WS_VA + 12 * MiB, WS_KS = WS_QS + 12 * MiB,
                 WS_VS = WS_KS + 4 * MiB, WS_QC = WS_VS + 4 * MiB, WS_KC = WS_QC + 8 * MiB, WS_VC = WS_KC + 8 * MiB, WS_OALL = WS_VC + 8 * MiB, WS_END = WS_OALL + 32 * MiB;
static_assert(WS_HID + (size_t)MROWS * DFF * 2 <= WS_END, "d_ws map");
constexpr int CW_BAR = 4096;
constexpr int CW_Q = 40960;
static_assert((CW_Q + 64 * 14) * 4 <= (int)CTL_ZERO_BYTES && CW_BAR + 8 * 3456 <= CW_Q, "ctl map");
constexpr int RING_BYTES = 131072, LDSCTL_OFF = RING_BYTES, MISC_OFF = LDSCTL_OFF + 320, LDS_BYTES = 147456;

namespace pg8 {
#define PG8_LAS __attribute__((address_space(3)))
typedef unsigned short bf16_t;
typedef short bf16x8 __attribute__((ext_vector_type(8)));
typedef float f32x4 __attribute__((ext_vector_type(4)));
typedef unsigned u32x4 __attribute__((ext_vector_type(4)));
constexpr int BM = 256, BK = 64, HALF = 128, HTB = HALF * BK * 2  , STAGE_BYTES = 8 * HTB, NXCD = 8, WGM = 8;

__host__ __device__ __forceinline__ int lds_byte(int r, int c) { const int st = (r >> 4) * 2 + (c >> 5), rr = r & 15, cc = c & 31, ob = rr * 64 + cc * 2; return st * 1024 + (ob ^ (((ob >> 9) & 1) << 5)); }
__host__ __device__ __forceinline__ void stage_rc(int b, int& R, int& C) { const int st = b / 1024, sb = b % 1024, swz = sb ^ (((sb >> 9) & 1) << 5); R = (st >> 1) * 16 + swz / 64; C = (st & 1) * 32 + (swz % 64) / 2; }
__host__ __device__ __forceinline__ int perm32(int rho) { const int n = rho >> 4, i = rho & 15; return 8 * (i >> 2) + 4 * n + (i & 3); }

struct Unit { int pm, pn; };
struct Gemm { const bf16_t* A; const bf16_t* Bt; int M, N, K; };

struct StaticOrder {
    int nM, nN, nwg, G, c;
    __host__ __device__ void init(int M, int N, int G_, int c_) { nM = M / BM; nN = N / BM; nwg = nM * nN; G = G_; c = c_; }
    __host__ __device__ bool next(int i, Unit& u) const {
        const long L = (long)i * G + c; if (L >= nwg) return false;
        int wgid = (int)L; { const int q = nwg / NXCD, r = nwg % NXCD, xcd = wgid % NXCD, off = wgid / NXCD; wgid = (xcd < r ? xcd * (q + 1) : r * (q + 1) + (xcd - r) * q) + off; }
        const int nig = WGM * nN, gid = wgid / nig, fm = gid * WGM, gsz = (nM - fm) < WGM ? (nM - fm) : WGM;
        u.pm = fm + ((wgid % nig) % gsz); u.pn = (wgid % nig) / gsz; return true;
    }
    __device__ __forceinline__ void a_ready(const Unit&) const {}
    __device__ __forceinline__ void done(const Unit&) const {}
};

__device__ __forceinline__ unsigned cvt_pk_bf16(float lo, float hi) { unsigned r; asm volatile("v_cvt_pk_bf16_f32 %0, %1, %2" : "=v"(r) : "v"(lo), "v"(hi)); return r; }
typedef float f32x2 __attribute__((ext_vector_type(2)));
template <class Epi, class Sched, bool ALIGN_EPI = false, bool SP2 = false>
__device__ __forceinline__ void gemm_phase(PG8_LAS unsigned char* lds, const Gemm g, const Sched& S, const Epi& E, unsigned long long* gprof = nullptr) {
#ifdef GEMM_PROF
    const long long gp_t0 = (Epi::AFTER_DRAIN && !Epi::HOOK && blockIdx.x == 0) ? (long long)clock64() : 0ll;
#endif
    int tid_ = threadIdx.x; asm volatile("" : "+v"(tid_));
    const int tid = tid_, wid = __builtin_amdgcn_readfirstlane(tid >> 6), lane = tid & 63, wr = wid >> 2, wc = wid & 3, fr = lane & 15, fq = lane >> 4;
    int K_ = g.K; asm volatile("" : "+s"(K_));
    const int K = K_, nt = K / BK;
    unsigned voffA[2], voffB[2];
#pragma unroll
    for (int i = 0; i < 2; ++i) { int R, C; stage_rc(tid * 16 + i * 8192, R, C); const int Rb = Epi::PERM ? ((R & ~31) + perm32(R & 31)) : R;
        voffA[i] = (unsigned)(R * K + C) * 2u; voffB[i] = (unsigned)(Rb * K + C) * 2u; }
    const size_t kstep = (size_t)(BK * 2);
    const size_t hstep = (size_t)HALF * K * 2;
    const size_t tstep = 2 * hstep;
    const unsigned ldsw = (unsigned)wid * 1024u;
    const int aoff = lds_byte(wr * 64 + fr, fq * 8), boff = lds_byte(wc * 32 + fr, fq * 8);
#define PG8_SA(b, h) (((b) * 2 + (h)) * HTB)
#define PG8_SB(b, h) ((4 + (b) * 2 + (h)) * HTB)
#define PG8_STAGE(bufoff, gbase, voff) do { _Pragma("unroll") for (int _i = 0; _i < 2; ++_i) \
        __builtin_amdgcn_global_load_lds((const unsigned*)((const char*)(gbase) + (voff)[_i]), (PG8_LAS unsigned*)(lds + (bufoff) + ldsw + _i * 8192), 16, 0, 0); } while (0)
#define PG8_LDA(dst, b, h) do { _Pragma("unroll") for (int m = 0; m < 4; ++m) _Pragma("unroll") for (int k = 0; k < 2; ++k) dst[m][k] = *(const PG8_LAS bf16x8*)(lds + PG8_SA(b, h) + aoff + m * 2048 + k * 1024); } while (0)
#define PG8_LDB(dst, b, h) do { _Pragma("unroll") for (int n = 0; n < 2; ++n) _Pragma("unroll") for (int k = 0; k < 2; ++k) dst[n][k] = *(const PG8_LAS bf16x8*)(lds + PG8_SB(b, h) + boff + n * 2048 + k * 1024); } while (0)
#define PG8_MMA(ai, bj, At, Bt) do { __builtin_amdgcn_s_setprio(1); _Pragma("unroll") for (int m = 0; m < 4; ++m) _Pragma("unroll") for (int n = 0; n < 2; ++n) _Pragma("unroll") for (int k = 0; k < 2; ++k) \
        acc[ai][bj][m][n] = __builtin_amdgcn_mfma_f32_16x16x32_bf16(Bt[n][k], At[m][k], acc[ai][bj][m][n], 0, 0, 0); __builtin_amdgcn_s_setprio(0); } while (0)
#define PG8_WAIT_V(n) asm volatile("s_waitcnt vmcnt(" #n ")" ::: "memory")
#define PG8_WAIT_L(n) asm volatile("s_waitcnt lgkmcnt(" #n ")" ::: "memory")
#define PG8_BAR __builtin_amdgcn_s_barrier()
#define PG8_SCHED __builtin_amdgcn_sched_barrier(0)
    Unit cur, nxt; int ui = 0;
    if (!S.next(0, cur)) return;
    f32x4 acc[2][2][4][2];
#pragma unroll
    for (int a = 0; a < 2; ++a)
#pragma unroll
        for (int b = 0; b < 2; ++b)
#pragma unroll
            for (int m = 0; m < 4; ++m)
#pragma unroll
                for (int n = 0; n < 2; ++n) acc[a][b][m][n] = (f32x4){0.f, 0.f, 0.f, 0.f};
    bf16x8 At[4][2], B0[2][2], B1[2][2];
    const char* cA = (const char*)g.A + (size_t)cur.pm * tstep; const char* cB = (const char*)g.Bt + (size_t)cur.pn * tstep;
    S.a_ready(cur);
    if constexpr (SP2) {
        PG8_STAGE(PG8_SB(0, 0), cB, voffB); PG8_STAGE(PG8_SB(0, 1), cB + hstep, voffB); PG8_STAGE(PG8_SA(0, 0), cA, voffA); PG8_STAGE(PG8_SA(0, 1), cA + hstep, voffA);
        if (wr == 1) PG8_BAR;
        PG8_WAIT_V(2); PG8_BAR;
        PG8_STAGE(PG8_SB(1, 0), cB + kstep, voffB); PG8_STAGE(PG8_SA(1, 0), cA + kstep, voffA); PG8_STAGE(PG8_SB(1, 1), cB + hstep + kstep, voffB);
        PG8_WAIT_V(6); PG8_BAR;
    } else {
        PG8_STAGE(PG8_SB(0, 0), cB, voffB); PG8_STAGE(PG8_SA(0, 0), cA, voffA); PG8_STAGE(PG8_SB(0, 1), cB + hstep, voffB); PG8_STAGE(PG8_SA(0, 1), cA + hstep, voffA);
        if (wr == 1) PG8_BAR;
        PG8_WAIT_V(4); PG8_BAR;
        PG8_STAGE(PG8_SB(1, 0), cB + kstep, voffB); PG8_STAGE(PG8_SA(1, 0), cA + kstep, voffA); PG8_STAGE(PG8_SB(1, 1), cB + hstep + kstep, voffB);
        PG8_WAIT_V(6); PG8_BAR;
    }
    for (;;) {
        const bool has_next = S.next(ui + 1, nxt);
        const char* nA = has_next ? (const char*)g.A + (size_t)nxt.pm * tstep : cA; const char* nB = has_next ? (const char*)g.Bt + (size_t)nxt.pn * tstep : cB;
#pragma nounroll
        for (int t = 0; t < nt; t += 2) {
            if constexpr (Epi::HOOK) E.hook(acc, cur, t, wr, wc, fr, fq);
            const bool last = (t == nt - 2);
            const char* a1 = cA + (size_t)(t + 1) * kstep;
            const char* a2 = last ? nA : cA + (size_t)(t + 2) * kstep; const char* b2 = last ? nB : cB + (size_t)(t + 2) * kstep;
            const char* a3 = a2 + kstep; const char* b3 = b2 + kstep;
            if (last && has_next) S.a_ready(nxt);
            if constexpr (SP2) {
            PG8_LDB(B0, 0, 0); PG8_LDB(B1, 0, 1); PG8_SCHED; PG8_LDA(At, 0, 0); PG8_STAGE(PG8_SA(1, 1), a1 + hstep, voffA);
            PG8_WAIT_V(8); PG8_WAIT_L(0); PG8_BAR; PG8_MMA(0, 0, At, B0); PG8_MMA(0, 1, At, B1); PG8_BAR; PG8_SCHED;
            PG8_LDA(At, 0, 1); PG8_STAGE(PG8_SB(0, 0), b2, voffB); PG8_STAGE(PG8_SB(0, 1), b2 + hstep, voffB); PG8_STAGE(PG8_SA(0, 0), a2, voffA);
            PG8_WAIT_V(8); PG8_WAIT_L(0); PG8_BAR; PG8_MMA(1, 0, At, B0); PG8_MMA(1, 1, At, B1); PG8_BAR; PG8_SCHED;
            PG8_LDB(B0, 1, 0); PG8_LDB(B1, 1, 1); PG8_SCHED; PG8_LDA(At, 1, 0); PG8_STAGE(PG8_SA(0, 1), a2 + hstep, voffA);
            PG8_WAIT_V(8); PG8_WAIT_L(0); PG8_BAR; PG8_MMA(0, 0, At, B0); PG8_MMA(0, 1, At, B1); PG8_BAR; PG8_SCHED;
            PG8_LDA(At, 1, 1); PG8_STAGE(PG8_SB(1, 0), b3, voffB); PG8_STAGE(PG8_SB(1, 1), b3 + hstep, voffB); PG8_STAGE(PG8_SA(1, 0), a3, voffA);
            PG8_WAIT_V(8); PG8_WAIT_L(0); PG8_BAR; PG8_MMA(1, 0, At, B0); PG8_MMA(1, 1, At, B1); PG8_BAR; PG8_SCHED;
            } else {
            PG8_LDB(B0, 0, 0); PG8_SCHED; PG8_LDA(At, 0, 0); PG8_STAGE(PG8_SA(1, 1), a1 + hstep, voffA);
            PG8_WAIT_L(8); PG8_BAR; PG8_WAIT_L(0); PG8_MMA(0, 0, At, B0); PG8_BAR; PG8_SCHED;
            PG8_LDB(B1, 0, 1); PG8_STAGE(PG8_SB(0, 0), b2, voffB);
            PG8_BAR; PG8_WAIT_L(0); PG8_MMA(0, 1, At, B1); PG8_BAR;
            PG8_LDA(At, 0, 1); PG8_STAGE(PG8_SA(0, 0), a2, voffA);
            PG8_BAR; PG8_WAIT_L(0); PG8_MMA(1, 0, At, B0); PG8_BAR; PG8_SCHED;
            PG8_STAGE(PG8_SB(0, 1), b2 + hstep, voffB);
            PG8_WAIT_V(6); PG8_BAR; PG8_MMA(1, 1, At, B1); PG8_BAR;
            PG8_LDB(B0, 1, 0); PG8_SCHED; PG8_LDA(At, 1, 0); PG8_STAGE(PG8_SA(0, 1), a2 + hstep, voffA);
            PG8_WAIT_L(8); PG8_BAR; PG8_WAIT_L(0); PG8_MMA(0, 0, At, B0); PG8_BAR; PG8_SCHED;
            PG8_LDB(B1, 1, 1); PG8_STAGE(PG8_SB(1, 0), b3, voffB);
            PG8_BAR; PG8_WAIT_L(0); PG8_MMA(0, 1, At, B1); PG8_BAR;
            PG8_LDA(At, 1, 1); PG8_STAGE(PG8_SA(1, 0), a3, voffA);
            PG8_BAR; PG8_WAIT_L(0); PG8_MMA(1, 0, At, B0); PG8_BAR; PG8_SCHED;
            PG8_STAGE(PG8_SB(1, 1), b3 + hstep, voffB);
            PG8_WAIT_V(6); PG8_BAR; PG8_MMA(1, 1, At, B1); PG8_BAR;
            }
        }
        if constexpr (ALIGN_EPI) { if (wr == 0) PG8_BAR; }
        if constexpr (!Epi::AFTER_DRAIN) {
            Unit ce = cur; asm volatile("" : "+s"(ce.pm), "+s"(ce.pn)); int fre = fr, fqe = fq; asm volatile("" : "+v"(fre), "+v"(fqe));
            E(acc, ce, wr, wc, fre, fqe); S.done(cur); }
        if (!has_next) break;
#pragma unroll
        for (int a = 0; a < 2; ++a)
#pragma unroll
            for (int b = 0; b < 2; ++b)
#pragma unroll
                for (int m = 0; m < 4; ++m)
#pragma unroll
                    for (int n = 0; n < 2; ++n) acc[a][b][m][n] = (f32x4){0.f, 0.f, 0.f, 0.f};
        cur = nxt; cA = nA; cB = nB; ++ui;
        if constexpr (ALIGN_EPI) { if (wr == 1) PG8_BAR; }
    }
    PG8_WAIT_V(0);
    if constexpr (!ALIGN_EPI) { if (wr == 0) PG8_BAR; }
    PG8_BAR;
#ifdef GEMM_PROF
    const long long gp_t1 = (Epi::AFTER_DRAIN && !Epi::HOOK && blockIdx.x == 0) ? (long long)clock64() : 0ll;
#endif
    if constexpr (Epi::AFTER_DRAIN) { E.fused(acc, cur, wr, wc, fr, fq, lds, wid, lane); S.done(cur); }
#ifdef GEMM_PROF
    if (Epi::AFTER_DRAIN && !Epi::HOOK && blockIdx.x == 0 && tid == 0 && gprof) { const long long gp_t2 = clock64(); atomicAdd(gprof + 0, (unsigned long long)(gp_t1 - gp_t0)); atomicAdd(gprof + 1, (unsigned long long)(gp_t2 - gp_t1)); atomicAdd(gprof + 2, 1ull); }
#endif
#undef PG8_SA
#undef PG8_SB
#undef PG8_STAGE
#undef PG8_LDA
#undef PG8_LDB
#undef PG8_MMA
#undef PG8_WAIT_V
#undef PG8_WAIT_L
#undef PG8_BAR
#undef PG8_SCHED
}
constexpr float RMS_EPS = 1e-6f;
constexpr int MROWS_ = 16384;
constexpr float LOG2E = 1.4426950408889634f;
typedef unsigned u32x2 __attribute__((ext_vector_type(2)));
#define PG8_FENCE() asm volatile("" ::: "memory")
#define PG8_G __attribute__((address_space(1)))
__device__ __forceinline__ float sum16f(const PG8_G float* p) {
    const f32x4 a = *(const PG8_G f32x4*)p, b = *(const PG8_G f32x4*)(p + 4), c = *(const PG8_G f32x4*)(p + 8), d = *(const PG8_G f32x4*)(p + 12);
    return ((a[0] + a[1]) + (a[2] + a[3])) + ((b[0] + b[1]) + (b[2] + b[3])) + ((c[0] + c[1]) + (c[2] + c[3])) + ((d[0] + d[1]) + (d[2] + d[3]));
}
__device__ __forceinline__ float xsum16(float x) { auto r = __builtin_amdgcn_permlane16_swap(__float_as_uint(x), __float_as_uint(x), false, false); return __uint_as_float(r[0]) + __uint_as_float(r[1]); }
__device__ __forceinline__ float xsum32(float x) { auto r = __builtin_amdgcn_permlane32_swap(__float_as_uint(x), __float_as_uint(x), false, false); return __uint_as_float(r[0]) + __uint_as_float(r[1]); }
__device__ __forceinline__ float wave_sum_dpp(float x) {
    x += __builtin_bit_cast(float, __builtin_amdgcn_update_dpp(0, __builtin_bit_cast(int, x), 0xB1, 0xf, 0xf, true));
    x += __builtin_bit_cast(float, __builtin_amdgcn_update_dpp(0, __builtin_bit_cast(int, x), 0x4E, 0xf, 0xf, true));
    x += __builtin_bit_cast(float, __builtin_amdgcn_update_dpp(0, __builtin_bit_cast(int, x), 0x141, 0xf, 0xf, true));
    x += __builtin_bit_cast(float, __builtin_amdgcn_update_dpp(0, __builtin_bit_cast(int, x), 0x140, 0xf, 0xf, true));
    return xsum32(xsum16(x));
}
__device__ __forceinline__ float fast_rcp(float x) { return __builtin_amdgcn_rcpf(x); }
__device__ __forceinline__ float silu_fast(float g) { return g * fast_rcp(1.0f + __builtin_amdgcn_exp2f(-g * LOG2E)); }
__device__ __forceinline__ float sq4(const f32x4 v) { return (v[0] * v[0] + v[1] * v[1]) + (v[2] * v[2] + v[3] * v[3]); }

struct EpiUp {
    static constexpr bool PERM = true, AFTER_DRAIN = false, HOOK = false;
    PG8_G unsigned char* ws; const PG8_G float* bias;
    __device__ __forceinline__ void hook(f32x4 (&)[2][2][4][2], const Unit&, int, int, int, int, int) const {}
    __device__ __forceinline__ void operator()(const f32x4 (&acc)[2][2][4][2], const Unit& u, int wr, int wc, int fr, int fq) const {
        PG8_G bf16_t* HID = (PG8_G bf16_t*)(ws + WS_HID); const PG8_G float* ssqx = (const PG8_G float*)(ws + WS_SSQX);
        const int b = u.pm >> 5;
        const PG8_G float* bb = bias + b * 5632 + u.pn * BM + wc * 32 + 8 * fq;
        f32x4 bg[2], bu[2];
#pragma unroll
        for (int n = 0; n < 2; ++n) { bg[n] = *(const PG8_G f32x4*)(bb + 4 * n); bu[n] = *(const PG8_G f32x4*)(bb + HALF + 4 * n); }
#pragma unroll
        for (int ai = 0; ai < 2; ++ai)
#pragma unroll
            for (int m = 0; m < 4; ++m) {
                const int row = u.pm * BM + ai * HALF + wr * 64 + m * 16 + fr;
                const float r = 1.0f / sqrtf(sum16f(ssqx + (size_t)row * 16) * (1.0f / 1024.0f) + RMS_EPS);
                float hv[8];
#pragma unroll
                for (int n = 0; n < 2; ++n)
#pragma unroll
                    for (int i = 0; i < 4; ++i) { const float g = acc[ai][0][m][n][i] * r + bg[n][i], uu = acc[ai][1][m][n][i] * r + bu[n][i]; hv[4 * n + i] = silu_fast(g) * uu; }
                u32x4 w; w.x = cvt_pk_bf16(hv[0], hv[1]); w.y = cvt_pk_bf16(hv[2], hv[3]); w.z = cvt_pk_bf16(hv[4], hv[5]); w.w = cvt_pk_bf16(hv[6], hv[7]);
                *(PG8_G u32x4*)(HID + (size_t)row * 2816 + u.pn * HALF + wc * 32 + 8 * fq) = w;
                if (m & 1) PG8_FENCE();
            }
    }
};

template <bool HOOKED> struct EpiResS {
    static constexpr bool PERM = false, AFTER_DRAIN = true, HOOK = HOOKED;
    PG8_G float* fout; PG8_G unsigned char* ws; const PG8_G float* gate; const PG8_G float* igs; const PG8_G float* gs; float coef;
    __device__ __forceinline__ void group_r(int row, float& rA, float& rB, float& rC) const {
        const PG8_G float* p = (const PG8_G float*)(ws + WS_SSQO) + (size_t)row * 16;
        const f32x4 a = *(const PG8_G f32x4*)p, b = *(const PG8_G f32x4*)(p + 4), c = *(const PG8_G f32x4*)(p + 8), d = *(const PG8_G f32x4*)(p + 12);
        const float sA = ((a[0] + a[1]) + (a[2] + a[3])) + (b[0] + b[1]), sB = ((b[2] + b[3]) + (c[0] + c[1])) + (c[2] + c[3]), sC = (d[0] + d[1]) + (d[2] + d[3]);
        rA = 1.0f / sqrtf(sA * (1.0f / 384.0f) + RMS_EPS); rB = 1.0f / sqrtf(sB * (1.0f / 384.0f) + RMS_EPS); rC = 1.0f / sqrtf(sC * (1.0f / 256.0f) + RMS_EPS);
    }
    __device__ __forceinline__ void hook(f32x4 (&acc)[2][2][4][2], const Unit& u, int t, int wr, int wc, int fr, int fq) const {
        if (t != 6 && t != 12) return;
        asm volatile("" : "+v"(fr));
#pragma unroll
        for (int ai = 0; ai < 2; ++ai)
#pragma unroll
            for (int m = 0; m < 4; ++m) {
                const int row = u.pm * BM + ai * HALF + wr * 64 + m * 16 + fr;
                float rA, rB, rC; group_r(row, rA, rB, rC);
                const float f = (t == 6) ? rA / rB : rB / rC;
#pragma unroll
                for (int bj = 0; bj < 2; ++bj)
#pragma unroll
                    for (int n = 0; n < 2; ++n) acc[ai][bj][m][n] = acc[ai][bj][m][n] * f;
                PG8_FENCE();
            }
    }
    __device__ __forceinline__ void fused(f32x4 (&acc)[2][2][4][2], const Unit& u, int wr, int wc, int fr, int fq, PG8_LAS unsigned char* lds, int wid, int lane) const {
        PG8_G bf16_t* xb = (PG8_G bf16_t*)(ws + WS_XB); PG8_G float* ssq_out = (PG8_G float*)(ws + WS_SSQX); constexpr int gate_bstride = 9 * 1024;
        const int b = u.pm >> 5, colg = u.pn * BM + 4 * lane;
        const f32x4 gv = *(const PG8_G f32x4*)(gate + (size_t)b * gate_bstride + colg) * coef;
        const f32x4 gsv = gs ? *(const PG8_G f32x4*)(gs + (size_t)b * 1024 + colg) : (f32x4){0.f, 0.f, 0.f, 0.f};
        const f32x4 igv = *(const PG8_G f32x4*)(igs + (size_t)b * 1024 + colg);
#pragma unroll
        for (int ai = 0; ai < 2; ++ai) {
#pragma unroll
            for (int m = 0; m < 4; ++m) { const int rl = wr * 64 + m * 16 + fr;
#pragma unroll
                for (int bj = 0; bj < 2; ++bj)
#pragma unroll
                    for (int n = 0; n < 2; ++n) { const int c = 32 * bj + 8 * wc + 4 * n + fq; *(PG8_LAS f32x4*)(lds + rl * 1024 + ((c ^ (rl & 7)) << 4)) = acc[ai][bj][m][n]; } }
            asm volatile("s_waitcnt lgkmcnt(0)\n\ts_barrier" ::: "memory");
#pragma unroll
            for (int half = 0; half < 2; ++half) {
                u32x2 xo[8];
#pragma unroll
                for (int k = 0; k < 8; ++k) { const int rl = wid + 8 * (half * 8 + k); xo[k] = *(const PG8_G u32x2*)(xb + (size_t)(u.pm * BM + ai * HALF + rl) * 1024 + colg); }
#pragma unroll
                for (int k = 0; k < 8; ++k) { const int rl = wid + 8 * (half * 8 + k); const int row = u.pm * BM + ai * HALF + rl;
                    f32x4 t = *(const PG8_LAS f32x4*)(lds + rl * 1024 + ((lane ^ (rl & 7)) << 4));
                    if (HOOKED) { float rA, rB, rC; group_r(row, rA, rB, rC); t = t * rC; }
                    const f32x4 xs = {__uint_as_float(xo[k].x << 16), __uint_as_float(xo[k].x & 0xffff0000u), __uint_as_float(xo[k].y << 16), __uint_as_float(xo[k].y & 0xffff0000u)};
                    const f32x4 xn = xs * igv + gv * t;
                    if (!gs) *(PG8_G f32x4*)(fout + (size_t)row * 1024 + colg) = xn;
                    if (gs) { const f32x4 y = xn * gsv; u32x2 w; w.x = cvt_pk_bf16(y[0], y[1]); w.y = cvt_pk_bf16(y[2], y[3]); *(PG8_G u32x2*)(xb + (size_t)row * 1024 + colg) = w; }
                    float ss = sq4(xn);
                    ss = wave_sum_dpp(ss);
                    if (gs && lane == 0) *(PG8_G f32x4*)(ssq_out + (size_t)row * 16 + 4 * u.pn) = (f32x4){ss, 0.f, 0.f, 0.f};
                }
            }
            asm volatile("s_waitcnt lgkmcnt(0)\n\ts_barrier" ::: "memory");
        }
    }
};

struct EpiIn {
    static constexpr bool PERM = true, AFTER_DRAIN = false, HOOK = false;
    PG8_G unsigned char* ws; const PG8_G float* gq; const PG8_G float* gk; const PG8_G float* bias;
    __device__ __forceinline__ void hook(f32x4 (&)[2][2][4][2], const Unit&, int, int, int, int, int) const {}
    __device__ __forceinline__ void operator()(const f32x4 (&acc)[2][2][4][2], const Unit& u, int wr, int wc, int fr, int fq) const {
        const int slot = u.pn * 4 + wc;
        if (slot == 7 || slot >= 30) return;
        const int b = u.pm >> 5;
        const PG8_G float* ssqx = (const PG8_G float*)(ws + WS_SSQX);
        PG8_G PG8_G bf16_t* dst = nullptr; int pitch = 0, col0 = 0; int kind = 0;
        PG8_G PG8_G float* ssqd = nullptr; int ssqp = 0, ssqi = 0; const PG8_G float* gain = nullptr; float scale = 1.0f;
        if (slot < 4)       { dst = (PG8_G bf16_t*)(ws + WS_CQ);  pitch = 256; col0 = 64 * slot;        kind = 1; ssqd = (PG8_G float*)(ws + WS_SSQC);  ssqp = 4; ssqi = slot; }
        else if (slot < 6)  { dst = (PG8_G bf16_t*)(ws + WS_CKV); pitch = 128; col0 = 64 * (slot - 4);  kind = 1; ssqd = (PG8_G float*)(ws + WS_SSQC) + (size_t)MROWS_ * 4; ssqp = 2; ssqi = slot - 4; }
        else if (slot == 6) { kind = 3; }
        else if (slot < 14) { dst = (PG8_G bf16_t*)(ws + WS_QS);  pitch = 384; col0 = 64 * (slot - 8);  kind = 2; gain = gq; scale = 0.125f * LOG2E; }
        else if (slot < 16) { dst = (PG8_G bf16_t*)(ws + WS_KS);  pitch = 128; col0 = 64 * (slot - 14); kind = 2; gain = gk; }
        else if (slot < 18) { dst = (PG8_G bf16_t*)(ws + WS_VS);  pitch = 128; col0 = 64 * (slot - 16); }
        else if (slot < 22) { dst = (PG8_G bf16_t*)(ws + WS_QC);  pitch = 256; col0 = 64 * (slot - 18); scale = 0.125f * LOG2E; }
        else if (slot < 26) { dst = (PG8_G bf16_t*)(ws + WS_KC);  pitch = 256; col0 = 64 * (slot - 22); }
        else                { dst = (PG8_G bf16_t*)(ws + WS_VC);  pitch = 256; col0 = 64 * (slot - 26); }
        const PG8_G float* bb = bias + b * 2048 + u.pn * BM + wc * 32 + 8 * fq;
        f32x4 bv[2][2], gn[2][2];
#pragma unroll
        for (int bj = 0; bj < 2; ++bj)
#pragma unroll
            for (int n = 0; n < 2; ++n) { bv[bj][n] = *(const PG8_G f32x4*)(bb + bj * HALF + 4 * n);
                gn[bj][n] = (kind == 2) ? *(const PG8_G f32x4*)(gain + 32 * bj + 8 * fq + 4 * n) * scale : (f32x4){scale, scale, scale, scale}; }
#pragma unroll
        for (int ai = 0; ai < 2; ++ai)
#pragma unroll
            for (int m = 0; m < 4; ++m) {
                const int row = u.pm * BM + ai * HALF + wr * 64 + m * 16 + fr;
                const float r = 1.0f / sqrtf(sum16f(ssqx + (size_t)row * 16) * (1.0f / 1024.0f) + RMS_EPS);
                f32x4 v[2][2]; float ss = 0.f;
#pragma unroll
                for (int bj = 0; bj < 2; ++bj)
#pragma unroll
                    for (int n = 0; n < 2; ++n) { v[bj][n] = acc[ai][bj][m][n] * r + bv[bj][n]; ss += sq4(v[bj][n]); }
                if (kind == 3) {
                    float s0 = sq4(v[0][0]) + sq4(v[0][1]);
                    s0 = xsum32(xsum16(s0));
                    *(PG8_G f32x4*)((PG8_G float*)(ws + WS_KPE) + (size_t)row * 32 + 8 * fq) = v[0][0]; *(PG8_G f32x4*)((PG8_G float*)(ws + WS_KPE) + (size_t)row * 32 + 8 * fq + 4) = v[0][1];
                    if (fq == 0) ((PG8_G float*)(ws + WS_SSQC) + (size_t)MROWS_ * 6)[row] = s0;
                } else {
                    if (kind != 0) { ss = xsum32(xsum16(ss)); }
                    float rn = 1.0f;
                    if (kind == 2) rn = 1.0f / sqrtf(ss * (1.0f / 64.0f) + RMS_EPS);
                    if (kind == 1 && fq == 0) ssqd[(size_t)row * ssqp + ssqi] = ss;
#pragma unroll
                    for (int bj = 0; bj < 2; ++bj) {
                        const f32x4 y0 = v[bj][0] * gn[bj][0] * rn, y1 = v[bj][1] * gn[bj][1] * rn;
                        u32x4 w; w.x = cvt_pk_bf16(y0[0], y0[1]); w.y = cvt_pk_bf16(y0[2], y0[3]); w.z = cvt_pk_bf16(y1[0], y1[1]); w.w = cvt_pk_bf16(y1[2], y1[3]);
                        *(PG8_G u32x4*)(dst + (size_t)row * pitch + col0 + 32 * bj + 8 * fq) = w;
                    }
                }
                if (m & 1) PG8_FENCE();
            }
    }
};

struct EpiUq {
    static constexpr bool PERM = false, AFTER_DRAIN = false, HOOK = false;
    PG8_G unsigned char* ws;
    __device__ __forceinline__ void hook(f32x4 (&)[2][2][4][2], const Unit&, int, int, int, int, int) const {}
    __device__ __forceinline__ void operator()(const f32x4 (&acc)[2][2][4][2], const Unit& u, int wr, int wc, int fr, int fq) const {
        PG8_G bf16_t* QRAW = (PG8_G bf16_t*)(ws + WS_QRAW); const PG8_G float* ssqcq = (const PG8_G float*)(ws + WS_SSQC);
        const int col0 = u.pn * BM + wc * 32 + 4 * fq;
#pragma unroll
        for (int ai = 0; ai < 2; ++ai)
#pragma unroll
            for (int m = 0; m < 4; ++m) {
                const int row = u.pm * BM + ai * HALF + wr * 64 + m * 16 + fr;
                const f32x4 s = *(const PG8_G f32x4*)(ssqcq + (size_t)row * 4);
                const float r = 1.0f / sqrtf(((s[0] + s[1]) + (s[2] + s[3])) * (1.0f / 256.0f) + RMS_EPS);
#pragma unroll
                for (int bj = 0; bj < 2; ++bj)
#pragma unroll
                    for (int n = 0; n < 2; ++n) { const int c = col0 + bj * HALF + n * 16; if (c < 576) { const f32x4 y = acc[ai][bj][m][n] * r; u32x2 w; w.x = cvt_pk_bf16(y[0], y[1]); w.y = cvt_pk_bf16(y[2], y[3]); *(PG8_G u32x2*)(QRAW + (size_t)row * 576 + c) = w; } }
            }
    }
};

struct EpiUkv {
    static constexpr bool PERM = true, AFTER_DRAIN = false, HOOK = false;
    PG8_G unsigned char* ws; const PG8_G float* gk;
    __device__ __forceinline__ void hook(f32x4 (&)[2][2][4][2], const Unit&, int, int, int, int, int) const {}
    __device__ __forceinline__ void operator()(const f32x4 (&acc)[2][2][4][2], const Unit& u, int wr, int wc, int fr, int fq) const {
        PG8_G bf16_t* KA = (PG8_G bf16_t*)(ws + WS_KA); PG8_G bf16_t* VA = (PG8_G bf16_t*)(ws + WS_VA); const PG8_G float* ssqckv = (const PG8_G float*)(ws + WS_SSQC) + (size_t)MROWS_ * 4; const PG8_G float* ssqkpe = (const PG8_G float*)(ws + WS_SSQC) + (size_t)MROWS_ * 6;
        const PG8_G float* kpe = (const PG8_G float*)(ws + WS_KPE); const PG8_G float* cs = (const PG8_G float*)(ws + WS_CS);
        const int h = 2 * u.pn + (wc >> 1); const bool isv = (wc & 1) != 0;
        f32x4 gn[2][2], g1 = {1.f, 1.f, 1.f, 1.f}, g2 = {1.f, 1.f, 1.f, 1.f};
        if (!isv) {
#pragma unroll
            for (int bj = 0; bj < 2; ++bj)
#pragma unroll
                for (int n = 0; n < 2; ++n) gn[bj][n] = *(const PG8_G f32x4*)(gk + 32 * bj + 8 * fq + 4 * n);
            g1 = *(const PG8_G f32x4*)(gk + 64 + 4 * fq); g2 = *(const PG8_G f32x4*)(gk + 80 + 4 * fq);
        }
#pragma unroll
        for (int ai = 0; ai < 2; ++ai)
#pragma unroll
            for (int m = 0; m < 4; ++m) {
                const int row = u.pm * BM + ai * HALF + wr * 64 + m * 16 + fr;
                const float r = 1.0f / sqrtf((ssqckv[(size_t)row * 2] + ssqckv[(size_t)row * 2 + 1]) * (1.0f / 128.0f) + RMS_EPS);
                f32x4 v[2][2]; float ss = 0.f;
#pragma unroll
                for (int bj = 0; bj < 2; ++bj)
#pragma unroll
                    for (int n = 0; n < 2; ++n) { v[bj][n] = acc[ai][bj][m][n] * r; ss += sq4(v[bj][n]); }
                if (isv) {
#pragma unroll
                    for (int bj = 0; bj < 2; ++bj) { u32x4 w; w.x = cvt_pk_bf16(v[bj][0][0], v[bj][0][1]); w.y = cvt_pk_bf16(v[bj][0][2], v[bj][0][3]); w.z = cvt_pk_bf16(v[bj][1][0], v[bj][1][1]); w.w = cvt_pk_bf16(v[bj][1][2], v[bj][1][3]);
                        *(PG8_G u32x4*)(VA + ((size_t)(row >> 6) * 6 + h) * 4096 + bj * 2048 + (row & 63) * 32 + 8 * fq) = w; }
                } else {
                    ss = xsum32(xsum16(ss));
                    const float rk = 1.0f / sqrtf((ss + ssqkpe[row]) * (1.0f / 96.0f) + RMS_EPS);
                    PG8_G bf16_t* kd = KA + ((size_t)(row >> 6) * 6 + h) * 6144 + (row & 63) * 8;
#pragma unroll
                    for (int bj = 0; bj < 2; ++bj) { const f32x4 y0 = v[bj][0] * gn[bj][0] * rk, y1 = v[bj][1] * gn[bj][1] * rk;
                        u32x4 w; w.x = cvt_pk_bf16(y0[0], y0[1]); w.y = cvt_pk_bf16(y0[2], y0[3]); w.z = cvt_pk_bf16(y1[0], y1[1]); w.w = cvt_pk_bf16(y1[2], y1[3]);
                        *(PG8_G u32x4*)(kd + (4 * bj + fq) * 512) = w; }
                    const f32x4 x1 = *(const PG8_G f32x4*)(kpe + (size_t)row * 32 + 4 * fq) * g1 * rk, x2 = *(const PG8_G f32x4*)(kpe + (size_t)row * 32 + 16 + 4 * fq) * g2 * rk;
                    const f32x4 c = *(const PG8_G f32x4*)(cs + (size_t)row * 32 + 4 * fq), s = *(const PG8_G f32x4*)(cs + (size_t)row * 32 + 16 + 4 * fq);
                    const f32x4 o1 = x1 * c - x2 * s, o2 = x2 * c + x1 * s;
                    u32x2 w1, w2; w1.x = cvt_pk_bf16(o1[0], o1[1]); w1.y = cvt_pk_bf16(o1[2], o1[3]); w2.x = cvt_pk_bf16(o2[0], o2[1]); w2.y = cvt_pk_bf16(o2[2], o2[3]);
                    *(PG8_G u32x2*)(kd + (8 + (fq >> 1)) * 512 + (fq & 1) * 4) = w1; *(PG8_G u32x2*)(kd + (10 + (fq >> 1)) * 512 + (fq & 1) * 4) = w2;
                }
                if (m & 1) PG8_FENCE();
            }
    }
};
}
#define GAS __attribute__((address_space(1)))
#define LAS __attribute__((address_space(3)))
typedef unsigned short bf16;
typedef unsigned v4u __attribute__((ext_vector_type(4)));
typedef float f32x4 __attribute__((ext_vector_type(4)));
typedef short bf16x8 __attribute__((ext_vector_type(8)));
typedef GAS unsigned gu32;
typedef GAS unsigned long long gu64;
#define RLX_AGENT __ATOMIC_RELAXED, __HIP_MEMORY_SCOPE_AGENT
#define LDS_WAIT() asm volatile("s_waitcnt lgkmcnt(0)" ::: "memory")
#define VM_WAIT() asm volatile("s_waitcnt vmcnt(0)" ::: "memory")
__device__ __forceinline__ unsigned long long rt() { return __builtin_amdgcn_s_memrealtime(); }
__device__ __forceinline__ unsigned f2bf(float f) { unsigned u = __builtin_bit_cast(unsigned, f); return (u + 0x7fffu + ((u >> 16) & 1u)) >> 16; }
__device__ __forceinline__ unsigned pk2(float lo, float hi) { return f2bf(lo) | (f2bf(hi) << 16); }

#define XB_TMO      128
#define XB_XCNT(j)  (256  + 64 * (j))
#define XB_XSUB(j)  (1280 + 64 * (j))
#define XB_XGEN(j)  (2304 + 64 * (j))
#define XB_TOP      3328
#define XB_TOPGEN   3392
#define XCD_BAR_WORDS 3456
#define XB_SPIN_CAP (1u << 18)

__device__ __forceinline__ unsigned xb_ld(unsigned* p)              { return __hip_atomic_load(p, __ATOMIC_RELAXED, __HIP_MEMORY_SCOPE_AGENT); }
__device__ __forceinline__ unsigned xb_add(unsigned* p, unsigned v) { return __hip_atomic_fetch_add(p, v, __ATOMIC_RELAXED, __HIP_MEMORY_SCOPE_AGENT); }
__device__ __forceinline__ unsigned xb_xcc_id() { return (unsigned)__builtin_amdgcn_s_getreg((3 << 11) | 20) & 0xFu; }
#define XB_SPIN(cond, bar) do { unsigned _sp = 0; while (cond) { __builtin_amdgcn_s_sleep(1); \
    if ((++_sp & 255u) == 0u) { if (xb_ld(&(bar)[XB_TMO])) break; if (_sp > XB_SPIN_CAP) { atomicAdd(&(bar)[XB_TMO], 1u); break; } } } } while (0)

struct XcdBarrier {
    unsigned* bar; unsigned x;
    volatile LAS unsigned* st;
};

__device__ __forceinline__ XcdBarrier xcd_barrier_post(unsigned* bar, volatile LAS unsigned* st) {
    XcdBarrier b; b.bar = bar; b.x = xb_xcc_id(); b.st = st;
    if (threadIdx.x == 0) (void)xb_add(&bar[XB_XCNT(b.x)], 1u);
    return b;
}
__device__ __forceinline__ void xcd_barrier_complete(unsigned* bar, unsigned x, unsigned& nloc, unsigned& nx) {
    const unsigned G = gridDim.x * gridDim.y * gridDim.z;
    unsigned sum, cnt, mine, sp = 0u;
    for (;;) {
        sum = 0u; cnt = 0u; mine = 0u;
#pragma unroll
        for (unsigned j = 0; j < 16; ++j) { const unsigned c = xb_ld(&bar[XB_XCNT(j)]); sum += c; cnt += (c > 0u) ? 1u : 0u; mine = (j == x) ? c : mine; }
        if (sum == G) break;
        __builtin_amdgcn_s_sleep(1);
        if ((++sp & 255u) == 0u) { if (xb_ld(&bar[XB_TMO])) break; if (sp > XB_SPIN_CAP) { atomicAdd(&bar[XB_TMO], 1u); break; } }
    }
    nloc = mine > 0u ? mine : 1u; nx = cnt > 0u ? cnt : 1u;
}

__device__ __forceinline__ void xcd_barrier(const XcdBarrier& b) {
    asm volatile("s_waitcnt vmcnt(0)" ::: "memory");
    __syncthreads();
    if (threadIdx.x == 0) {
        unsigned* bar = b.bar;
        __builtin_amdgcn_s_waitcnt(0);
        unsigned nloc = b.st[0], nx = b.st[1];
        if (nloc == 0u) { xcd_barrier_complete(bar, b.x, nloc, nx); b.st[0] = nloc; b.st[1] = nx; }
        const unsigned old = xb_add(&bar[XB_XSUB(b.x)], 1u);
        const unsigned gen = old / nloc;
        if (old + 1u == (gen + 1u) * nloc) {
            __builtin_amdgcn_fence(__ATOMIC_RELEASE, "agent");
            asm volatile("s_waitcnt vmcnt(0)" ::: "memory");
            const unsigned og = xb_add(&bar[XB_TOP], 1u);
            const unsigned tg = og / nx;
            if (og + 1u == (tg + 1u) * nx) xb_add(&bar[XB_TOPGEN], 1u);
            else XB_SPIN(xb_ld(&bar[XB_TOPGEN]) == tg, bar);
            __builtin_amdgcn_fence(__ATOMIC_ACQUIRE, "agent");
            xb_add(&bar[XB_XGEN(b.x)], 1u);
            asm volatile("s_waitcnt vmcnt(0)" ::: "memory");
        } else {
            XB_SPIN(xb_ld(&bar[XB_XGEN(b.x)]) == gen, bar);
            __builtin_amdgcn_fence(__ATOMIC_ACQUIRE, "agent");
            asm volatile("s_waitcnt vmcnt(0)" ::: "memory");
        }
    }
    __syncthreads();
}
namespace att {
typedef unsigned short bf16_t;
typedef short bf16x8 __attribute__((ext_vector_type(8)));
typedef short s16x4 __attribute__((ext_vector_type(4)));
typedef short v4i16_t __attribute__((ext_vector_type(4)));
typedef float f32x16 __attribute__((ext_vector_type(16)));
typedef float f32x4 __attribute__((ext_vector_type(4)));
typedef float f32x2 __attribute__((ext_vector_type(2)));
typedef __bf16 bf16x2_t __attribute__((ext_vector_type(2)));
typedef unsigned u32x4 __attribute__((ext_vector_type(4)));
typedef int i32x4 __attribute__((ext_vector_type(4)));
#define ALAS __attribute__((address_space(3)))
#define AGAS __attribute__((address_space(1)))
constexpr int SEQ = 8192;
constexpr float LOG2E = 1.4426950408889634f, EPS = 1e-6f;
constexpr int KCS = 1040, VHS = 4160;
constexpr int KSLOT = 12 * KCS, VSLOT = 2 * VHS;
constexpr int L_K = 0, L_V = 3 * KSLOT, L_POS = L_V + 4 * VSLOT, L_TB = L_POS + 1024, L_WSF = L_TB + 128, L_OST = L_WSF + 8 * 256, L_FLAG = L_OST + 8 * 4096, L_END = L_FLAG + 16 + 64;
static_assert(L_OST % 16 == 0 && L_V % 16 == 0 && L_END <= 131072, "attention LDS map");

__device__ __forceinline__ int crow(int r, int hi) { return (r & 3) + 8 * (r >> 2) + 4 * hi; }
__device__ __forceinline__ unsigned cvtpk(float lo, float hi) { f32x2 v = {lo, hi}; bf16x2_t b = __builtin_convertvector(v, bf16x2_t); return __builtin_bit_cast(unsigned, b); }
__device__ __forceinline__ s16x4 vtr(const ALAS unsigned char* p) { return __builtin_bit_cast(s16x4, __builtin_amdgcn_ds_read_tr16_b64_v4i16((ALAS v4i16_t*)p)); }
__device__ __forceinline__ float swap_sum(float x) { auto rr = __builtin_amdgcn_permlane32_swap(__float_as_uint(x), __float_as_uint(x), false, false); return __uint_as_float(rr[0]) + __uint_as_float(rr[1]); }
__device__ __forceinline__ float swap_max(float x) { auto rr = __builtin_amdgcn_permlane32_swap(__float_as_uint(x), __float_as_uint(x), false, false); return fmaxf(__uint_as_float(rr[0]), __uint_as_float(rr[1])); }
__device__ __forceinline__ float bf2f(unsigned short h) { return __uint_as_float((unsigned)h << 16); }

__device__ __forceinline__ void glds16(const AGAS void* gsrc, unsigned lds_dst) { unsigned keep;
    asm volatile("s_mov_b32 %0, m0\n\ts_mov_b32 m0, %2\n\ts_nop 0\n\tglobal_load_lds_dwordx4 %1, off\n\ts_mov_b32 m0, %0" : "=&s"(keep) : "v"(gsrc), "s"(lds_dst) : "memory"); }
__device__ __forceinline__ void glds4(const AGAS void* gsrc, unsigned lds_dst) { unsigned keep;
    asm volatile("s_mov_b32 %0, m0\n\ts_mov_b32 m0, %2\n\ts_nop 0\n\tglobal_load_lds_dword %1, off\n\ts_mov_b32 m0, %0" : "=&s"(keep) : "v"(gsrc), "s"(lds_dst) : "memory"); }

struct AttnP {
    AGAS unsigned char* ws;
    const AGAS float* gq;
    const AGAS int* pos; const AGAS float* sinks; const AGAS float* relb;
};
template <int MODE> struct AttnCfg;
template <> struct AttnCfg<0> { static constexpr size_t Q = WS_QRAW, K = WS_KA, V = WS_VA; static constexpr int qpitch = 576, kpitch = 576, khs = 96, vpitch = 384, vhs = 64, ocol0 = 0, hidx0 = 0, group = 1; };
template <> struct AttnCfg<1> { static constexpr size_t Q = WS_QS, K = WS_KS, V = WS_VS; static constexpr int qpitch = 384, kpitch = 128, khs = 64, vpitch = 128, vhs = 64, ocol0 = 384, hidx0 = 6, group = 3; };
template <> struct AttnCfg<2> { static constexpr size_t Q = WS_QC, K = WS_KC, V = WS_VC; static constexpr int qpitch = 256, kpitch = 256, khs = 64, vpitch = 256, vhs = 64, ocol0 = 768, hidx0 = 12, group = 1; };

#ifdef ATT_PROF
#define PROF_T() ((MODE == 0 && blockIdx.x == 0) ? (long long)clock64() : 0ll)
#else
#define PROF_T() 0ll
#endif
template <int DQK, int MODE>
__device__ __forceinline__ void attn_unit(ALAS unsigned char* lds, const AttnP& P, int b, int h, int qb, unsigned long long* prof = nullptr) {
    long long pf_qk = 0, pf_sm = 0, pf_pv = 0, pf_wait = 0; const long long pf_t0 = PROF_T();
    constexpr int NCH = DQK / 8, ND0 = DQK / 16;
    int tid_ = threadIdx.x; asm volatile("" : "+v"(tid_));
    const int tid = tid_, lane = tid & 63, r32 = lane & 31, hi = lane >> 5;
    const int wid = __builtin_amdgcn_readfirstlane(tid >> 6);
    const int q0 = qb * 256, qlo = q0 + 32 * wid, qhi = qlo + 31, qrow = qlo + r32;
    const size_t rb = (size_t)b * SEQ;
    typedef AttnCfg<MODE> C; const int kvh = h / C::group;
    ALAS float* wsf = (ALAS float*)(lds + L_WSF) + wid * 64;
    ALAS unsigned char* ost = lds + L_OST + wid * 4096;
    ALAS int* posl = (ALAS int*)(lds + L_POS);
    ALAS float* tb = (ALAS float*)(lds + L_TB);

    bf16x8 qf[ND0];
    if constexpr (MODE == 0) {
        const AGAS bf16_t* qp = (const AGAS bf16_t*)(P.ws + C::Q) + (rb + qrow) * 576 + h * 96 + hi * 8;
        float qv[ND0][8]; float ss = 0.f;
#pragma unroll
        for (int d0 = 0; d0 < ND0; ++d0) { const u32x4 w = *(const AGAS u32x4*)(qp + 16 * d0);
#pragma unroll
            for (int i = 0; i < 4; ++i) { const float lo = __uint_as_float(w[i] << 16), hv = __uint_as_float(w[i] & 0xffff0000u); qv[d0][2 * i] = lo; qv[d0][2 * i + 1] = hv; ss += lo * lo + hv * hv; } }
        ss = swap_sum(ss);
        const float rq = 1.0f / sqrtf(ss * (1.0f / 96.0f) + EPS);
#pragma unroll
        for (int d0 = 0; d0 < ND0; ++d0) { const f32x4 ga = *(const AGAS f32x4*)(P.gq + 16 * d0 + 8 * hi), gb = *(const AGAS f32x4*)(P.gq + 16 * d0 + 8 * hi + 4);
#pragma unroll
            for (int i = 0; i < 4; ++i) { qv[d0][i] *= rq * ga[i]; qv[d0][4 + i] *= rq * gb[i]; } }
        {
            const AGAS float* cp = (const AGAS float*)(P.ws + WS_CS) + (rb + qrow) * 32 + 8 * hi;
            const f32x4 c0 = *(const AGAS f32x4*)cp, c1 = *(const AGAS f32x4*)(cp + 4), s0 = *(const AGAS f32x4*)(cp + 16), s1 = *(const AGAS f32x4*)(cp + 20);
#pragma unroll
            for (int i = 0; i < 8; ++i) { const float c = i < 4 ? c0[i & 3] : c1[i & 3], s = i < 4 ? s0[i & 3] : s1[i & 3]; const float x1 = qv[4][i], x2 = qv[5][i]; qv[4][i] = x1 * c - x2 * s; qv[5][i] = x2 * c + x1 * s; }
        }
        const float sc = 0.10206207261596575f * LOG2E;
#pragma unroll
        for (int d0 = 0; d0 < ND0; ++d0) { u32x4 w; w.x = cvtpk(qv[d0][0] * sc, qv[d0][1] * sc); w.y = cvtpk(qv[d0][2] * sc, qv[d0][3] * sc); w.z = cvtpk(qv[d0][4] * sc, qv[d0][5] * sc); w.w = cvtpk(qv[d0][6] * sc, qv[d0][7] * sc); qf[d0] = __builtin_bit_cast(bf16x8, w); }
    } else {
        const AGAS bf16_t* qp = (const AGAS bf16_t*)(P.ws + C::Q) + (rb + qrow) * C::qpitch + h * 64 + hi * 8;
#pragma unroll
        for (int d0 = 0; d0 < ND0; ++d0) qf[d0] = *(const AGAS bf16x8*)(qp + 16 * d0);
    }
    int posq = 0; float sink2 = 0.f;
    if constexpr (MODE == 1) {
        posq = P.pos[rb + qrow]; sink2 = P.sinks[h] * LOG2E;
        if (tid < 32) tb[tid] = P.relb[tid * 6 + h] * LOG2E;
    }

    int ntile, tfirst, tstep;
    if (MODE == 0) { tfirst = 0; tstep = 1; ntile = ((q0 + 255) >> 6) + 1; }
    else if (MODE == 1) { const int lo = q0 - 127 > 0 ? q0 - 127 : 0; tfirst = lo >> 6; tstep = 1; ntile = ((q0 + 255) >> 6) - tfirst + 1; }
    else { tfirst = (q0 + 254) >> 6; tstep = -1; ntile = tfirst + 1; }

    const AGAS bf16_t* Kg = (const AGAS bf16_t*)(P.ws + C::K) + rb * C::kpitch + kvh * C::khs;
    const AGAS bf16_t* Vg = (const AGAS bf16_t*)(P.ws + C::V) + rb * C::vpitch + kvh * C::vhs;
    const unsigned lds0 = (unsigned)(uintptr_t)lds;
    const AGAS bf16_t* ksrc0 = (MODE == 0) ? (const AGAS bf16_t*)(P.ws + C::K) + ((size_t)b * 128 * 6 + h) * 6144 + wid * 512 + lane * 8 : Kg + (size_t)lane * C::kpitch + 8 * wid;
    const AGAS bf16_t* vsrc = (MODE == 0) ? (const AGAS bf16_t*)(P.ws + C::V) + ((size_t)b * 128 * 6 + h) * 4096 + (wid >> 2) * 2048 + (wid & 3) * 512 + lane * 8
                                          : Vg + (size_t)(16 * (wid & 3) + (lane >> 2)) * C::vpitch + 32 * (wid >> 2) + 8 * (lane & 3);
    constexpr size_t KTS = (MODE == 0) ? (size_t)6 * 6144 : (size_t)64 * C::kpitch, VTS = (MODE == 0) ? (size_t)6 * 4096 : (size_t)64 * C::vpitch, K2O = (MODE == 0) ? 8 * 512 : 64;
    const bool k2 = (wid + 8) < NCH;
    const bool posw = (MODE == 1) && wid == 0;
    const int NP = 2 + (k2 ? 1 : 0) + (posw ? 1 : 0);
#define ATT_ISSUE(T, IT) do { const int T_ = (T); const size_t jo_ = (size_t)T_ * 64; const int ks_ = (IT) % 3, vs_ = (IT) & 3;     \
        glds16(ksrc0 + (size_t)T_ * KTS, (unsigned)__builtin_amdgcn_readfirstlane(lds0 + L_K + ks_ * KSLOT + wid * KCS)); \
        if (k2) glds16(ksrc0 + (size_t)T_ * KTS + K2O, (unsigned)__builtin_amdgcn_readfirstlane(lds0 + L_K + ks_ * KSLOT + (wid + 8) * KCS)); \
        glds16(vsrc + (size_t)T_ * VTS, (unsigned)__builtin_amdgcn_readfirstlane(lds0 + L_V + vs_ * VSLOT + (wid >> 2) * VHS + (wid & 3) * 1024)); \
        if (posw) glds4(P.pos + rb + jo_ + lane, (unsigned)__builtin_amdgcn_readfirstlane(lds0 + L_POS + vs_ * 256)); } while (0)
#define ATT_WAIT_BAR(n_) do { if ((n_) <= 0) asm volatile("s_waitcnt vmcnt(0) lgkmcnt(0)\n\ts_barrier" ::: "memory"); \
        else if (NP == 2) asm volatile("s_waitcnt vmcnt(2) lgkmcnt(0)\n\ts_barrier" ::: "memory"); \
        else if (NP == 3) asm volatile("s_waitcnt vmcnt(3) lgkmcnt(0)\n\ts_barrier" ::: "memory"); \
        else asm volatile("s_waitcnt vmcnt(4) lgkmcnt(0)\n\ts_barrier" ::: "memory"); } while (0)

    f32x16 o0 = {}, o1 = {};
    float mrun = (MODE == 1) ? sink2 : 0.f;
    float lrun = (MODE == 1 && hi == 0) ? 1.0f : 0.f;
    f32x16 negm;
#pragma unroll
    for (int r = 0; r < 16; ++r) negm[r] = (MODE == 2) ? 0.f : -mrun;
    bool first = (MODE == 0);
    float after = 0.f;
    bool walive = true;
    const int vrd = ((lane >> 4) & 1) * 32 + (lane & 3) * 8 + (4 * hi + ((lane & 15) >> 2)) * 64;
    const bool lag = wid >= 4;
    constexpr float THR = 4.0f;

#define ATT_QK(P0, P1, kb) do { int kofs_ = L_K + (kb) * KSLOT + hi * KCS + r32 * 16; asm volatile("" : "+v"(kofs_)); const ALAS unsigned char* Kb_ = lds + kofs_;     \
        bf16x8 kfa_[4], kfb_[4]; \
        _Pragma("unroll") for (int d0 = 0; d0 < 3; ++d0) { kfa_[d0] = *(const ALAS bf16x8*)(Kb_ + 2 * d0 * KCS); kfb_[d0] = *(const ALAS bf16x8*)(Kb_ + 2 * d0 * KCS + 512); } \
        \
        _Pragma("unroll") for (int d0 = 0; d0 < ND0; ++d0) { \
            if (d0 + 3 < ND0) { kfa_[(d0 + 3) & 3] = *(const ALAS bf16x8*)(Kb_ + 2 * (d0 + 3) * KCS); kfb_[(d0 + 3) & 3] = *(const ALAS bf16x8*)(Kb_ + 2 * (d0 + 3) * KCS + 512); } \
            if (d0 == 0) { P0 = __builtin_amdgcn_mfma_f32_32x32x16_bf16(kfa_[0], qf[0], negm, 0, 0, 0); P1 = __builtin_amdgcn_mfma_f32_32x32x16_bf16(kfb_[0], qf[0], negm, 0, 0, 0); } \
            else { P0 = __builtin_amdgcn_mfma_f32_32x32x16_bf16(kfa_[d0 & 3], qf[d0], P0, 0, 0, 0); P1 = __builtin_amdgcn_mfma_f32_32x32x16_bf16(kfb_[d0 & 3], qf[d0], P1, 0, 0, 0); } \
            } } while (0)
#define ATT_VLD(i_, s_) do { vl0_[i_] = vtr(Vb_ + (s_) * 1024); vh0_[i_] = vtr(Vb_ + (s_) * 1024 + 512); vl1_[i_] = vtr(Vb_ + VHS + (s_) * 1024); vh1_[i_] = vtr(Vb_ + VHS + (s_) * 1024 + 512); } while (0)
#define ATT_PV(vb) do { int vofs_ = L_V + (vb) * VSLOT + vrd; asm volatile("" : "+v"(vofs_)); const ALAS unsigned char* Vb_ = lds + vofs_; \
        s16x4 vl0_[2], vh0_[2], vl1_[2], vh1_[2]; ATT_VLD(0, 0); \
        _Pragma("unroll") for (int s_ = 0; s_ < 4; ++s_) { \
            if (s_ + 1 < 4) ATT_VLD((s_ + 1) & 1, s_ + 1); \
            const int i_ = s_ & 1; const bf16x8 pa_ = __builtin_bit_cast(bf16x8, pw[s_]); \
            const bf16x8 v0_ = {vl0_[i_][0], vl0_[i_][1], vl0_[i_][2], vl0_[i_][3], vh0_[i_][0], vh0_[i_][1], vh0_[i_][2], vh0_[i_][3]}, v1_ = {vl1_[i_][0], vl1_[i_][1], vl1_[i_][2], vl1_[i_][3], vh1_[i_][0], vh1_[i_][1], vh1_[i_][2], vh1_[i_][3]}; \
            o0 = __builtin_amdgcn_mfma_f32_32x32x16_bf16(pa_, v0_, o0, 0, 0, 0); o1 = __builtin_amdgcn_mfma_f32_32x32x16_bf16(pa_, v1_, o1, 0, 0, 0); } } while (0)
#define ATT_PACK(P0, P1) do { \
        pw[0].x = cvtpk(P0[0], P0[1]); pw[0].y = cvtpk(P0[2], P0[3]); pw[0].z = cvtpk(P0[4], P0[5]); pw[0].w = cvtpk(P0[6], P0[7]); \
        pw[1].x = cvtpk(P0[8], P0[9]); pw[1].y = cvtpk(P0[10], P0[11]); pw[1].z = cvtpk(P0[12], P0[13]); pw[1].w = cvtpk(P0[14], P0[15]); \
        pw[2].x = cvtpk(P1[0], P1[1]); pw[2].y = cvtpk(P1[2], P1[3]); pw[2].z = cvtpk(P1[4], P1[5]); pw[2].w = cvtpk(P1[6], P1[7]); \
        pw[3].x = cvtpk(P1[8], P1[9]); pw[3].y = cvtpk(P1[10], P1[11]); pw[3].z = cvtpk(P1[12], P1[13]); pw[3].w = cvtpk(P1[14], P1[15]); } while (0)
#define ATT_MAX3(a, b, c) fmaxf(fmaxf((a), (b)), (c))
#define ATT_SM_A(P0, P1, j0_, pslot) do { if constexpr (MODE != 2) { \
            if constexpr (MODE == 1) { \
                _Pragma("unroll") for (int g = 0; g < 4; ++g) { \
                    const i32x4 pa = *(const ALAS i32x4*)(posl + (pslot) * 64 + 8 * g + 4 * hi), pb = *(const ALAS i32x4*)(posl + (pslot) * 64 + 32 + 8 * g + 4 * hi); \
                    _Pragma("unroll") for (int i = 0; i < 4; ++i) { \
                        { int n = posq - pa[i]; n = n > 0 ? n : 0; int bk = n; if (n >= 16) { bk = 16 + (int)((__builtin_amdgcn_logf((float)n) - 4.0f) * (16.0f / 3.0f)); bk = bk < 31 ? bk : 31; } P0[4 * g + i] += tb[bk]; } \
                        { int n = posq - pb[i]; n = n > 0 ? n : 0; int bk = n; if (n >= 16) { bk = 16 + (int)((__builtin_amdgcn_logf((float)n) - 4.0f) * (16.0f / 3.0f)); bk = bk < 31 ? bk : 31; } P1[4 * g + i] += tb[bk]; } } } } \
            const bool nm_ = (MODE == 1) || ((j0_) + 63 > qlo); \
            if (nm_) { \
                _Pragma("unroll") for (int r = 0; r < 16; ++r) { const int key = (j0_) + crow(r, hi); \
                    bool ok0 = key <= qrow, ok1 = key + 32 <= qrow; \
                    if (MODE == 1) { ok0 = ok0 && (key > qrow - 128); ok1 = ok1 && (key + 32 > qrow - 128); } \
                    if (!ok0) P0[r] = -INFINITY; if (!ok1) P1[r] = -INFINITY; } } \
            float ma = ATT_MAX3(P0[0], P0[1], P1[0]), mb = ATT_MAX3(P0[2], P0[3], P1[1]); ma = ATT_MAX3(ma, P1[2], P1[3]); \
            _Pragma("unroll") for (int r = 4; r < 16; r += 4) { ma = ATT_MAX3(ma, P0[r], P0[r + 1]); mb = ATT_MAX3(mb, P0[r + 2], P0[r + 3]); ma = ATT_MAX3(ma, P1[r], P1[r + 1]); mb = ATT_MAX3(mb, P1[r + 2], P1[r + 3]); } \
            const float mt = swap_max(fmaxf(ma, mb)); \
            if (first || __any(mt > THR)) {                                 \
                const float d = first ? mt : fmaxf(mt, 0.f); first = false; \
                _Pragma("unroll") for (int r = 0; r < 16; ++r) { P0[r] -= d; P1[r] -= d; } \
                const float alpha = __builtin_amdgcn_exp2f(-d); mrun += d; lrun *= alpha; \
                _Pragma("unroll") for (int r = 0; r < 16; ++r) negm[r] = -mrun; \
                if (hi == 0) wsf[r32] = alpha; \
                _Pragma("unroll") for (int g = 0; g < 4; ++g) { const f32x4 al = *(const ALAS f32x4*)(wsf + 8 * g + 4 * hi); \
                    _Pragma("unroll") for (int i = 0; i < 4; ++i) { o0[4 * g + i] *= al[i]; o1[4 * g + i] *= al[i]; } } } } } while (0)
#define ATT_SM_B(P0, P1, j0_) do { \
        if constexpr (MODE == 2) { \
            const bool nm_ = (j0_) + 63 >= qlo; \
            float ln0[16], ln1[16]; \
            _Pragma("unroll") for (int r = 0; r < 16; ++r) { const int key = (j0_) + crow(r, hi); \
                { const float z = P0[r]; const float sp = fmaxf(z, 0.f) + __builtin_amdgcn_logf(1.0f + __builtin_amdgcn_exp2f(-fabsf(z))); const bool ok = !nm_ || key < qrow; ln0[r] = ok ? -sp : 0.f; P0[r] = ok ? z - sp : -INFINITY; } \
                { const float z = P1[r]; const float sp = fmaxf(z, 0.f) + __builtin_amdgcn_logf(1.0f + __builtin_amdgcn_exp2f(-fabsf(z))); const bool ok = !nm_ || key + 32 < qrow; ln1[r] = ok ? -sp : 0.f; P1[r] = ok ? z - sp : -INFINITY; } } \
            float run = after; \
            _Pragma("unroll") for (int blk = 1; blk >= 0; --blk) _Pragma("unroll") for (int g = 3; g >= 0; --g) { \
                const float own = blk ? ((ln1[4 * g] + ln1[4 * g + 1]) + (ln1[4 * g + 2] + ln1[4 * g + 3])) : ((ln0[4 * g] + ln0[4 * g + 1]) + (ln0[4 * g + 2] + ln0[4 * g + 3])); \
                auto rr = __builtin_amdgcn_permlane32_swap(__float_as_uint(own), __float_as_uint(own), false, false); \
                const float slo = __uint_as_float(rr[0]), shi = __uint_as_float(rr[1]); \
                const float e1 = run; run += shi; const float e0 = run; run += slo; \
                float aft = hi ? e1 : e0; \
                _Pragma("unroll") for (int i = 3; i >= 0; --i) { const int r = 4 * g + i; \
                    if (blk) { P1[r] = __builtin_amdgcn_exp2f(P1[r] + aft); aft += ln1[r]; } else { P0[r] = __builtin_amdgcn_exp2f(P0[r] + aft); aft += ln0[r]; } } } \
            after = run; walive = __any(after > -160.0f); \
        } else { \
            float ls = 0.f; \
            _Pragma("unroll") for (int r = 0; r < 16; ++r) { P0[r] = __builtin_amdgcn_exp2f(P0[r]); P1[r] = __builtin_amdgcn_exp2f(P1[r]); ls += P0[r] + P1[r]; } \
            lrun += ls; } \
        ATT_PACK(P0, P1); } while (0)
#define ATT_WORK(j0_) ((MODE == 0) ? ((j0_) <= qhi) : (MODE == 1) ? (((j0_) <= qhi) && ((j0_) + 63 >= qlo - 127)) : (walive && ((j0_) < qhi)))

    f32x16 p0, p1, n0, n1; u32x4 pw[4];
    __syncthreads();
    int issued = 0;
    ATT_ISSUE(tfirst, 0);
    if (ntile > 1) { ATT_ISSUE(tfirst + tstep, 1); issued = 1; }
    if (ntile > 2) { ATT_ISSUE(tfirst + 2 * tstep, 2); issued = 2; }
    ATT_WAIT_BAR(issued - 1);
    bool wcur = ATT_WORK(tfirst * 64);
    if (wcur) ATT_QK(p0, p1, 0);
    asm volatile("s_waitcnt lgkmcnt(0)\n\ts_barrier" ::: "memory");
    int nt = ntile;
    for (int it = 0; it < nt; ++it) {
        const int t = tfirst + it * tstep, j0 = t * 64, jn = (t + tstep) * 64;
        if (it + 3 < ntile) { ATT_ISSUE(t + 3 * tstep, it + 3); issued = it + 3; }
        if (wcur) ATT_SM_A(p0, p1, j0, it & 3);
        const bool wnext = (it + 1 < nt) && ATT_WORK(jn);
        if (wcur && wnext) { ATT_QK(n0, n1, (it + 1) % 3); ATT_SM_B(p0, p1, j0); }
        else { if (wnext) ATT_QK(n0, n1, (it + 1) % 3); if (wcur) ATT_SM_B(p0, p1, j0); }
        if (wcur) ATT_PV(it & 3);
        p0 = n0; p1 = n1; wcur = wnext;
        if (MODE == 2) { ALAS int* fl = (ALAS int*)(lds + L_FLAG + 16) + (it & 1) * 8; if (lane == 0) fl[wid] = (walive && j0 > 0) ? 1 : 0; }
        ATT_WAIT_BAR(issued - (it + 2));
        if (MODE == 2) { const ALAS int* fl = (const ALAS int*)(lds + L_FLAG + 16) + (it & 1) * 8;
            const i32x4 fa = *(const ALAS i32x4*)fl, fb = *(const ALAS i32x4*)(fl + 4);
            if (((fa[0] | fa[1]) | (fa[2] | fa[3]) | (fb[0] | fb[1]) | (fb[2] | fb[3])) == 0) nt = it + 1; }
    }
    if (MODE == 2) asm volatile("s_waitcnt vmcnt(0)" ::: "memory");
#undef ATT_ISSUE
#undef ATT_WAIT_BAR
#undef ATT_QK
#undef ATT_PV
#undef ATT_PACK
#undef ATT_VLD
#undef ATT_SM_A
#undef ATT_SM_B
#undef ATT_WORK
#undef ATT_MAX3
    if (MODE != 2) {
        const float lt = swap_sum(lrun);
        if (hi == 0) wsf[32 + r32] = 1.0f / lt;
#pragma unroll
        for (int g = 0; g < 4; ++g) { const f32x4 il = *(const ALAS f32x4*)(wsf + 32 + 8 * g + 4 * hi);
#pragma unroll
            for (int i = 0; i < 4; ++i) { o0[4 * g + i] *= il[i]; o1[4 * g + i] *= il[i]; } }
    }
    {
        ALAS bf16_t* stg = (ALAS bf16_t*)ost;
#pragma unroll
        for (int r = 0; r < 16; ++r) { const int orow = crow(r, hi); stg[orow * 64 + r32] = (bf16_t)(cvtpk(o0[r], 0.f) & 0xffffu); stg[orow * 64 + 32 + r32] = (bf16_t)(cvtpk(o1[r], 0.f) & 0xffffu); }
        AGAS bf16_t* Ow = (AGAS bf16_t*)(P.ws + WS_OALL) + (rb + qlo) * 1024 + C::ocol0 + h * 64;
#pragma unroll
        for (int i = 0; i < 4; ++i) {
            const int row = i * 8 + (lane >> 3), ch = lane & 7;
            const u32x4 v = *(const ALAS u32x4*)(stg + row * 64 + ch * 8);
            float ss = 0.f;
#pragma unroll
            for (int k = 0; k < 4; ++k) { const unsigned w = v[k]; const float a = __uint_as_float(w << 16), c = __uint_as_float(w & 0xffff0000u); ss += a * a + c * c; }
            ss += __shfl_xor(ss, 1); ss += __shfl_xor(ss, 2); ss += __shfl_xor(ss, 4);
            *(AGAS u32x4*)(Ow + (size_t)row * 1024 + ch * 8) = v;
            if (ch == 0) ((AGAS float*)(P.ws + WS_SSQO))[(rb + qlo + row) * 16 + C::hidx0 + h] = ss;
        }
    }
#ifdef ATT_PROF
    if (MODE == 0 && blockIdx.x == 0 && wid == ATT_PROF_WAVE && lane == 0 && prof) { const long long tt = PROF_T() - pf_t0;
        atomicAdd(prof + 0, (unsigned long long)tt); atomicAdd(prof + 1, (unsigned long long)pf_qk); atomicAdd(prof + 2, (unsigned long long)pf_sm); atomicAdd(prof + 3, (unsigned long long)pf_pv); atomicAdd(prof + 4, (unsigned long long)pf_wait); atomicAdd(prof + 5, 1ull); }
#endif
}
#undef ALAS
#undef AGAS
}
struct Args { const void* in[23]; float* out; unsigned char* ws; int ph_lo, ph_hi, li, adapt; };

struct Frame { LAS unsigned char* lds; int tid, lane, wave, vcu, G; };

__device__ __forceinline__ float wave_sum64(float v) { return pg8::wave_sum_dpp(v); }

__device__ __forceinline__ void tr_item64(const GAS float* W, int ldn, int K, GAS pg8::bf16_t* WT, int kb, int g, int src0, int src1, const GAS float* kgain, LAS unsigned* scr, int lane) {
    const int k0 = 64 * kb; const int col = lane < 32 ? src0 + lane : src1 + (lane - 32); const bool ok = (lane < 32 ? src0 : src1) >= 0;
    const GAS float* wp = W + (size_t)k0 * ldn + (ok ? col : 0);
#pragma unroll
    for (int hf = 0; hf < 2; ++hf) {
        float v[32];
#pragma unroll
        for (int i = 0; i < 32; ++i) v[i] = wp[(size_t)(hf * 32 + i) * ldn];
#pragma unroll
        for (int i = 0; i < 32; ++i) v[i] = ok ? v[i] : 0.f;
        if (kgain) {
#pragma unroll
            for (int i = 0; i < 32; ++i) v[i] *= kgain[k0 + hf * 32 + i]; }
#pragma unroll
        for (int i = 0; i < 16; ++i) scr[(hf * 16 + i) * 65 + lane] = pk2(v[2 * i], v[2 * i + 1]);
    }
    asm volatile("s_waitcnt lgkmcnt(0)" ::: "memory");
    const int c = lane & 7;
#pragma unroll
    for (int j = 0; j < 8; ++j) { const int n = (lane >> 3) + 8 * j; const LAS unsigned* s = scr + (4 * c) * 65 + n;
        v4u o; o.x = s[0]; o.y = s[65]; o.z = s[130]; o.w = s[195];
        *(GAS v4u*)(WT + (size_t)(64 * g + n) * K + k0 + 8 * c) = o; }
    asm volatile("s_waitcnt lgkmcnt(0)" ::: "memory");
}
__device__ __forceinline__ int in_slot_src(int slot, int& cnt) {
    cnt = 64;
    if (slot < 4) return 64 * slot;
    if (slot < 6) return 256 + 64 * (slot - 4);
    if (slot == 6) { cnt = 32; return 384; }
    if (slot == 7) return -1;
    if (slot < 14) return 416 + 64 * (slot - 8);
    if (slot < 16) return 800 + 64 * (slot - 14);
    if (slot < 18) return 928 + 64 * (slot - 16);
    if (slot < 22) return 1056 + 64 * (slot - 18);
    if (slot < 26) return 1312 + 64 * (slot - 22);
    if (slot < 30) return 1568 + 64 * (slot - 26);
    return -1;
}

#define A_X ((const GAS float*)args.in[0])
#define A_C ((const GAS float*)args.in[1])
#define A_POS ((const GAS int*)args.in[2])
#define A_RELB ((const GAS float*)args.in[3])
#define A_NORMG ((const GAS float*)args.in[4])
#define A_WMOD ((const GAS float*)args.in[5])
#define A_BMOD ((const GAS float*)args.in[6])
#define A_WGU1 ((const GAS float*)args.in[7])
#define A_WD1 ((const GAS float*)args.in[8])
#define A_WIN ((const GAS float*)args.in[9])
#define A_QAN ((const GAS float*)args.in[10])
#define A_KVAN ((const GAS float*)args.in[11])
#define A_WUQ ((const GAS float*)args.in[12])
#define A_WUKV ((const GAS float*)args.in[13])
#define A_MLAQN ((const GAS float*)args.in[14])
#define A_MLAKN ((const GAS float*)args.in[15])
#define A_SWAQN ((const GAS float*)args.in[16])
#define A_SWAKN ((const GAS float*)args.in[17])
#define A_SINKS ((const GAS float*)args.in[18])
#define A_OUTN ((const GAS float*)args.in[19])
#define A_WOUT ((const GAS float*)args.in[20])
#define A_WGU2 ((const GAS float*)args.in[21])
#define A_WD2 ((const GAS float*)args.in[22])
#define WSP(off)   (ws_ + (off))
#define MOD ((GAS float*)WSP(WS_MOD))
#define GS ((GAS float*)WSP(WS_GS))
#define BIAS ((GAS float*)WSP(WS_BIAS))
#define SSQX ((GAS float*)WSP(WS_SSQX))
#define SSQO ((GAS float*)WSP(WS_SSQO))
#define CS ((GAS float*)WSP(WS_CS))
#define KPE ((GAS float*)WSP(WS_KPE))
#define SSQ_CQ ((GAS float*)WSP(WS_SSQC))
#define SSQ_CKV ((GAS float*)WSP(WS_SSQC) + (size_t)MROWS * 4)
#define SSQ_KPE ((GAS float*)WSP(WS_SSQC) + (size_t)MROWS * 6)
#define XB ((GAS pg8::bf16_t*)WSP(WS_XB))
#define HID ((GAS pg8::bf16_t*)WSP(WS_HID))
#define CQ ((GAS pg8::bf16_t*)WSP(WS_CQ))
#define CKV ((GAS pg8::bf16_t*)WSP(WS_CKV))
#define KA ((GAS pg8::bf16_t*)WSP(WS_KA))
#define VA ((GAS pg8::bf16_t*)WSP(WS_VA))
#define QS ((GAS pg8::bf16_t*)WSP(WS_QS))
#define KS ((GAS pg8::bf16_t*)WSP(WS_KS))
#define VS ((GAS pg8::bf16_t*)WSP(WS_VS))
#define QC ((GAS pg8::bf16_t*)WSP(WS_QC))
#define KC ((GAS pg8::bf16_t*)WSP(WS_KC))
#define VC ((GAS pg8::bf16_t*)WSP(WS_VC))
#define OALL ((GAS pg8::bf16_t*)WSP(WS_OALL))
#define QRAW ((GAS float*)WSP(WS_QRAW))

__device__ __forceinline__ int in_group_src(int g32) {
    const int tile = g32 >> 3, rr = g32 & 7, bj = rr >> 2, wc = rr & 3; int cnt; const int base = in_slot_src(tile * 4 + wc, cnt);
    return (base >= 0 && 32 * bj < cnt) ? base + 32 * bj : -1;
}
constexpr int CV_GU = 16 * 88, CV_D = 44 * 16, CV_IN = 16 * 32, CV_UQ = 4 * 12, CV_UKV = 2 * 12, CV_OUT = 16 * 16;
constexpr int CV_EARLY = CV_GU + CV_D + CV_IN + CV_UQ + CV_UKV + CV_OUT, CV_L = CV_EARLY + CV_GU + CV_D, CV_ALL = DEPTH * CV_L;
__device__ __forceinline__ void convert_chunk(Frame& F, const Args& args, int base, int limit) {
    GAS unsigned char* ws_ = (GAS unsigned char*)args.ws; asm volatile("" : "+s"(ws_));
    LAS unsigned* scr = (LAS unsigned*)(F.lds + 16384 + F.wave * 8448);
#pragma unroll 1
    for (int q = 0; q < 2; ++q) {
        const int it = base + F.wave * 2 + q; if (it >= limit) break;
        const int l = it / CV_L; int r = it % CV_L;
        GAS unsigned char* wl = ws_ + WS_W + (size_t)l * WL;
        int kind;
        if (r < CV_GU) kind = 0; else if ((r -= CV_GU) < CV_D) kind = 1; else if ((r -= CV_D) < CV_IN) kind = 2; else if ((r -= CV_IN) < CV_UQ) kind = 3;
        else if ((r -= CV_UQ) < CV_UKV) kind = 4; else if ((r -= CV_UKV) < CV_OUT) kind = 5; else if ((r -= CV_OUT) < CV_GU) kind = 6; else { r -= CV_GU; kind = 7; }
        if (kind == 0 || kind == 6) {
            const bool second = kind == 6; const int kb = r / 88, g = r % 88, t = g >> 2, rr = g & 3, src = (rr >> 1) * DFF + 128 * t + 64 * (rr & 1);
            const GAS float* W = (second ? A_WGU2 : A_WGU1) + (size_t)l * DM * 2 * DFF;
            tr_item64(W, 2 * DFF, DM, (GAS pg8::bf16_t*)(wl + (second ? W_GU2 : W_GU1)), kb, g, src, src + 32, nullptr, scr, F.lane);
        } else if (kind == 1 || kind == 7) { const bool second = kind == 7; const int kb = r / 16, g = r % 16;
            tr_item64((second ? A_WD2 : A_WD1) + (size_t)l * DFF * DM, DM, DFF, (GAS pg8::bf16_t*)(wl + (second ? W_D2 : W_D1)), kb, g, 64 * g, 64 * g + 32, nullptr, scr, F.lane);
        } else if (kind == 2) { const int kb = r / 32, g = r % 32;
            tr_item64(A_WIN + (size_t)l * DM * DIN, DIN, DM, (GAS pg8::bf16_t*)(wl + W_IN), kb, g, in_group_src(2 * g), in_group_src(2 * g + 1), nullptr, scr, F.lane);
        } else if (kind == 3) { const int kb = r / 12, g = r % 12;
            tr_item64(A_WUQ + (size_t)l * 256 * 576, 576, 256, (GAS pg8::bf16_t*)(wl + W_UQ), kb, g, g < 9 ? 64 * g : -1, g < 9 ? 64 * g + 32 : -1, A_QAN + l * 256, scr, F.lane);
        } else if (kind == 4) { const int kb = r / 12, g = r % 12, g0 = 2 * g, g1 = 2 * g + 1;
            tr_item64(A_WUKV + (size_t)l * 128 * 768, 768, 128, (GAS pg8::bf16_t*)(wl + W_UKV), kb, g, 256 * (g0 >> 3) + 64 * (g0 & 3) + 32 * ((g0 & 7) >> 2), 256 * (g1 >> 3) + 64 * (g1 & 3) + 32 * ((g1 & 7) >> 2), A_KVAN + l * 128, scr, F.lane);
        } else { const int kb = r / 16, g = r % 16;
            tr_item64(A_WOUT + (size_t)l * DM * DM, DM, DM, (GAS pg8::bf16_t*)(wl + W_OUT), kb, g, 64 * g, 64 * g + 32, A_OUTN + l * DM, scr, F.lane); }
    }
}

__device__ __forceinline__ void phase_pro0(Frame& F, const Args& args, gu32* qhead) {
    GAS unsigned char* ws_ = (GAS unsigned char*)args.ws; asm volatile("" : "+s"(ws_));
    constexpr int NMU = DEPTH * NMOD / 128;
    if ((int)blockIdx.x < NMU || F.G <= NMU) {
        LAS float* cond = (LAS float*)F.lds;
        LAS float* red = (LAS float*)(F.lds + 8192);
        for (int i = F.tid; i < 2 * DM; i += 512) { const float cv = A_C[i]; cond[i] = cv / (1.0f + expf(-cv)); }
        __syncthreads();
        for (int u = blockIdx.x; u < NMU; u += F.G) {
            const int l = u / (NMOD / 128), n0 = (u % (NMOD / 128)) * 128, c4 = F.lane & 31, kp = F.lane >> 5;
            const GAS float* w = A_WMOD + (size_t)l * DM * NMOD + n0 + 4 * c4;
            f32x4 a0 = {0.f, 0.f, 0.f, 0.f}, a1 = {0.f, 0.f, 0.f, 0.f};
#pragma unroll 8
            for (int i = 0; i < 64; ++i) { const int kk = F.wave * 128 + 2 * i + kp; const f32x4 wv = *(const GAS f32x4*)(w + (size_t)kk * NMOD); a0 += wv * cond[kk]; a1 += wv * cond[DM + kk]; }
#pragma unroll
            for (int q = 0; q < 4; ++q) { a0[q] = pg8::xsum32(a0[q]); a1[q] = pg8::xsum32(a1[q]); }
            if (kp == 0) { *(LAS f32x4*)(red + (F.wave * 2 + 0) * 128 + 4 * c4) = a0; *(LAS f32x4*)(red + (F.wave * 2 + 1) * 128 + 4 * c4) = a1; }
            __syncthreads();
            if (F.tid < 256) { const int bb = F.tid >> 7, ln = F.tid & 127; float s = 0.f;
#pragma unroll
                for (int wv = 0; wv < 8; ++wv) s += red[(wv * 2 + bb) * 128 + ln];
                MOD[((size_t)l * 2 + bb) * NMOD + n0 + ln] = s + A_BMOD[(size_t)l * NMOD + n0 + ln]; }
            __syncthreads();
        }
    }
    if ((int)blockIdx.x >= NMU || F.G <= NMU) {
        const int nb = F.G <= NMU ? F.G : F.G - NMU, b0 = F.G <= NMU ? (int)blockIdx.x : (int)blockIdx.x - NMU;
        for (int i = b0 * 512 + F.tid; i < MROWS * 16; i += nb * 512) {
            const int m = i >> 4, j = i & 15;
            const float freq = powf(10000.0f, -(float)j / 16.0f);
            const float ang = (float)A_POS[m] * freq;
            CS[(size_t)m * 32 + j] = cosf(ang); CS[(size_t)m * 32 + 16 + j] = sinf(ang);
        }
    }
    {
        LAS int* slot = (LAS int*)(F.lds + 12288);
        for (;;) {
            __syncthreads();
            if (F.tid == 0) slot[0] = (int)__hip_atomic_fetch_add(qhead, 16u, __ATOMIC_RELAXED, __HIP_MEMORY_SCOPE_AGENT);
            __syncthreads();
            const int base = slot[0];
            if (base >= CV_EARLY) break;
            convert_chunk(F, args, base, CV_EARLY);
        }
    }
}

__device__ __forceinline__ float gs_clamped(float g, float sc) { const float v = g * (1.0f + sc); return fabsf(v) < 1e-20f ? (v < 0.f ? -1e-20f : 1e-20f) : v; }
__device__ __forceinline__ void x_to_xb(Frame& F, const Args& args, const GAS float* xsrc, int l, int i) {
    GAS unsigned char* ws_ = (GAS unsigned char*)args.ws; asm volatile("" : "+s"(ws_));
    const int gw = F.vcu * NWAVES + F.wave, NGW = F.G * NWAVES;
    for (int m = gw; m < MROWS; m += NGW) {
        const int b = m >> 13;
        const GAS f32x4* xr = (const GAS f32x4*)(xsrc + (size_t)m * DM) + F.lane;
        const GAS f32x4* gr = (const GAS f32x4*)(A_NORMG + ((size_t)l * 3 + i) * DM) + F.lane;
        const GAS f32x4* sr = (const GAS f32x4*)(MOD + ((size_t)l * 2 + b) * NMOD + (3 * i + 1) * DM) + F.lane;
        float s = 0.f;
        GAS unsigned long long* o8 = (GAS unsigned long long*)(XB + (size_t)m * DM) + F.lane;
#pragma unroll
        for (int j = 0; j < 4; ++j) { const f32x4 v = xr[64 * j]; s += (v.x * v.x + v.y * v.y) + (v.z * v.z + v.w * v.w);
            const f32x4 g0 = gr[64 * j], s0 = sr[64 * j]; const f32x4 g = {gs_clamped(g0.x, s0.x), gs_clamped(g0.y, s0.y), gs_clamped(g0.z, s0.z), gs_clamped(g0.w, s0.w)}; const f32x4 y = v * g;
            o8[64 * j] = (unsigned long long)pk2(y.x, y.y) | ((unsigned long long)pk2(y.z, y.w) << 32); }
        s = wave_sum64(s);
        if (F.lane < 16) SSQX[(size_t)m * 16 + F.lane] = (F.lane == 0) ? s : 0.f;
    }
}

__device__ __forceinline__ void bias_rows(Frame& F, const Args& args, bool early) {
    GAS unsigned char* ws_ = (GAS unsigned char*)args.ws; asm volatile("" : "+s"(ws_));
    const int gw = F.vcu * NWAVES + F.wave, NGW = F.G * NWAVES;
    constexpr int RL = 5632 + 2048 + 5632, RE = 5632 + 2048;
    const int lo = early ? 0 : RE, hi = early ? RE : DEPTH * RL;
    for (int it = lo + gw; it < hi; it += NGW) {
        const int l = it / RL; int r = it % RL; int which, nrow; size_t woff; size_t boff;
        if (r < 5632) { which = 0; nrow = 5632; woff = W_GU1; boff = 0; } else if (r < 5632 + 2048) { r -= 5632; which = 1; nrow = 2048; woff = W_IN; boff = 2 * 5632; } else { r -= 5632 + 2048; which = 2; nrow = 5632; woff = W_GU2; boff = 2 * (5632 + 2048); }
        const GAS pg8::bf16_t* wr = (const GAS pg8::bf16_t*)(ws_ + WS_W + (size_t)l * WL + woff) + (size_t)r * DM;
        float a0 = 0.f, a1 = 0.f;
#pragma unroll
        for (int j = 0; j < 2; ++j) {
            const v4u wv = *(const GAS v4u*)(wr + j * 512 + F.lane * 8);
            const GAS float* s0 = MOD + ((size_t)l * 2 + 0) * NMOD + (3 * which) * DM + j * 512 + F.lane * 8; const GAS float* s1 = s0 + NMOD;
#pragma unroll
            for (int k = 0; k < 4; ++k) { const unsigned w = wv[k]; const float lo_ = __uint_as_float(w << 16), hi_ = __uint_as_float(w & 0xffff0000u);
                a0 += lo_ * s0[2 * k] + hi_ * s0[2 * k + 1]; a1 += lo_ * s1[2 * k] + hi_ * s1[2 * k + 1]; }
        }
        a0 = wave_sum64(a0); a1 = wave_sum64(a1);
        if (F.lane == 0) { BIAS[(size_t)l * BIAS_L + boff + r] = a0; BIAS[(size_t)l * BIAS_L + boff + nrow + r] = a1; }
    }
}
__device__ __forceinline__ void phase_pro1(Frame& F, const Args& args) {
    GAS unsigned char* ws_ = (GAS unsigned char*)args.ws; asm volatile("" : "+s"(ws_));
    for (int i = blockIdx.x * 512 + F.tid; i < DEPTH * 3 * 2 * DM; i += F.G * 512) {
        const int cidx = i & 1023, b = (i >> 10) & 1, li = i >> 11, l = li / 3, ii = li % 3;
        const float gv_ = gs_clamped(A_NORMG[((size_t)l * 3 + ii) * DM + cidx], MOD[((size_t)l * 2 + b) * NMOD + (3 * ii + 1) * DM + cidx]);
        GS[i] = gv_; ((GAS float*)WSP(WS_IGS))[i] = 1.0f / gv_;
    }
    bias_rows(F, args, true);
    x_to_xb(F, args, A_X, 0, 0);
}

__device__ __forceinline__ int next_unit(Frame& F, gu32* head) {
    LAS int* slot = (LAS int*)(F.lds + att::L_FLAG);
    __syncthreads();
    if (F.tid == 0) slot[0] = (int)__hip_atomic_fetch_add(head, 1u, __ATOMIC_RELAXED, __HIP_MEMORY_SCOPE_AGENT);
    __syncthreads();
    return slot[0];
}

#ifndef DUPS
#define DUPS -1
#endif
#ifndef PHM
#define PHM 255
#endif
#ifndef PHM2
#define PHM2 31
#endif
__global__ void __launch_bounds__(NWAVES * 64, 2) fwd_mega(Args args) {
    extern __shared__ __attribute__((aligned(16))) unsigned char lds[];
    Frame F; F.lds = (LAS unsigned char*)lds; F.tid = threadIdx.x; F.lane = F.tid & 63; F.wave = __builtin_amdgcn_readfirstlane(F.tid >> 6);
    F.G = gridDim.x; { const int bx = blockIdx.x; F.vcu = (F.G % 8 == 0) ? (bx % 8) * (F.G / 8) + bx / 8 : bx; }
    gu32* ctl = (gu32*)(args.ws + WS_CTL);
    for (int u = F.tid; u < (LDS_BYTES - LDSCTL_OFF) / 4; u += NWAVES * 64) ((LAS unsigned*)(F.lds + LDSCTL_OFF))[u] = 0u;
    __syncthreads();
    if (args.adapt >= 0) { x_to_xb(F, args, (const GAS float*)args.out, args.adapt / 3, args.adapt % 3); return; }
    const int lo = args.ph_lo, hi = args.ph_hi;
    XcdBarrier bar; bar.bar = (unsigned*)(ctl + CW_BAR) + args.li * XCD_BAR_WORDS; bar.x = 0; bar.st = nullptr;
    if (hi - lo > 1 || true) bar = xcd_barrier_post((unsigned*)(ctl + CW_BAR) + args.li * XCD_BAR_WORDS, (volatile LAS unsigned*)(F.lds + MISC_OFF) + 8);

    for (int ph = lo; ph < hi; ++ph) {
        { int t_ = threadIdx.x; asm volatile("" : "+v"(t_)); F.tid = t_; F.lane = t_ & 63; F.wave = __builtin_amdgcn_readfirstlane(t_ >> 6); }
        GAS unsigned char* ws_ = (GAS unsigned char*)args.ws; asm volatile("" : "+s"(ws_));
        int nrep = 1;
        if (DUPS >= 0) { const int ty = ph < 2 ? 8 + ph : ((ph - 2) & 7); if (ty == DUPS && !(ty == 5) && !((ty == 1 || ty == 7) && ph != 3)) nrep = 2; }
        for (int rep = 0; rep < nrep; ++rep) {
        if ((PHM & 64) && ph == 0) phase_pro0(F, args, ctl + CW_Q + 64 * 8);
        else if ((PHM & 128) && ph == 1) phase_pro1(F, args);
        else {
            const int l = (ph - 2) >> 3, s = (ph - 2) & 7;
            const GAS unsigned char* wl = ws_ + WS_W + (size_t)l * WL;
            const GAS float* biasl = BIAS + (size_t)l * BIAS_L;
            const GAS float* modl = MOD + (size_t)l * 2 * NMOD;
            if ((PHM & 1) && (s == 0 || s == 6)) {
                pg8::Gemm g{(const pg8::bf16_t*)XB, (const pg8::bf16_t*)(wl + (s == 0 ? W_GU1 : W_GU2)), MROWS, 5632, DM}; pg8::StaticOrder S; S.init(MROWS, 5632, F.G, (int)blockIdx.x);
                pg8::EpiUp E{ws_, biasl + (s == 0 ? 0 : 2 * (5632 + 2048))};
                pg8::gemm_phase<pg8::EpiUp, pg8::StaticOrder, true, true>(F.lds, g, S, E);
            } else if ((PHM & 2) && (s == 1 || s == 7)) {
                pg8::Gemm g{(const pg8::bf16_t*)HID, (const pg8::bf16_t*)(wl + (s == 1 ? W_D1 : W_D2)), MROWS, DM, DFF}; pg8::StaticOrder S; S.init(MROWS, DM, F.G, (int)blockIdx.x);
                const bool lastp = (s == 7 && l == DEPTH - 1);
                const GAS float* gsn = lastp ? nullptr : (s == 1 ? GS + ((size_t)(l * 3 + 1) * 2) * DM : GS + ((size_t)((l + 1) * 3 + 0) * 2) * DM);
                const GAS float* igp = (const GAS float*)WSP(WS_IGS) + ((size_t)(l * 3 + (s == 1 ? 0 : 2)) * 2) * DM;
                pg8::EpiResS<false> E{(GAS float*)args.out, ws_, modl + (s == 1 ? 2 : 8) * DM, igp, gsn, 0.5f}; pg8::gemm_phase<pg8::EpiResS<false>, pg8::StaticOrder, false, true>(F.lds, g, S, E, (unsigned long long*)(ctl + CW_Q + 64 * 13));
            } else if ((PHM & 4) && s == 2) {
                pg8::Gemm g{(const pg8::bf16_t*)XB, (const pg8::bf16_t*)(wl + W_IN), MROWS, 2048, DM}; pg8::StaticOrder S; S.init(MROWS, 2048, F.G, (int)blockIdx.x);
                pg8::EpiIn E{ws_, A_SWAQN + l * 64, A_SWAKN + l * 64, biasl + 2 * 5632};
                pg8::gemm_phase<pg8::EpiIn, pg8::StaticOrder, true, true>(F.lds, g, S, E);
            } else if ((PHM & 8) && s == 3) {
                if (PHM2 & 1) { pg8::Gemm g{(const pg8::bf16_t*)CQ, (const pg8::bf16_t*)(wl + W_UQ), MROWS, 768, 256}; pg8::StaticOrder S; S.init(MROWS, 768, F.G, (int)blockIdx.x);
                  pg8::EpiUq E{ws_}; pg8::gemm_phase<pg8::EpiUq, pg8::StaticOrder, true, true>(F.lds, g, S, E); }
                if (PHM2 & 2) { pg8::Gemm g{(const pg8::bf16_t*)CKV, (const pg8::bf16_t*)(wl + W_UKV), MROWS, 768, 128}; pg8::StaticOrder S; S.init(MROWS, 768, F.G, (int)((blockIdx.x + 64) % F.G));
                  pg8::EpiUkv E{ws_, A_MLAKN + l * 96}; pg8::gemm_phase<pg8::EpiUkv, pg8::StaticOrder, true, true>(F.lds, g, S, E); }
            } else if ((PHM & 16) && s == 4) {
                att::AttnP PA{ws_, A_MLAQN + l * 96, nullptr, nullptr, nullptr};
                att::AttnP PB{ws_, nullptr, A_POS, A_SINKS + l * 6, A_RELB};
                att::AttnP PC{ws_, nullptr, nullptr, nullptr, nullptr};
                gu32* head = ctl + CW_Q + 64 * (2 * l + 1 + 4 * rep);
                for (;;) { const int u = next_unit(F, head); if (u >= 384 + 256 + 384) break;
                    if ((PHM2 & 16) && u < 384) { const int qb = 31 - u / 12, bh = u % 12;
                        att::attn_unit<96, 0>(F.lds, PA, bh / 6, bh % 6, qb, (unsigned long long*)(ctl + CW_Q + 64 * 12)); }

                    else if ((PHM2 & 4) && u >= 384 && u < 640) { const int v = u - 384, qb = 31 - (v >> 3), bh = v & 7; att::attn_unit<64, 2>(F.lds, PC, bh >> 2, bh & 3, qb); }
                    else if ((PHM2 & 8) && u >= 640) { const int v = u - 640, qb = v / 12, bh = v % 12; att::attn_unit<64, 1>(F.lds, PB, bh / 6, bh % 6, qb); } }
                if (l == 0 && rep == 0) {
                    gu32* chead = ctl + CW_Q + 64 * 9; LAS int* cslot = (LAS int*)(F.lds + 12288);
                    for (;;) { __syncthreads(); if (F.tid == 0) cslot[0] = (int)__hip_atomic_fetch_add(chead, 16u, __ATOMIC_RELAXED, __HIP_MEMORY_SCOPE_AGENT); __syncthreads();
                        const int cb = CV_EARLY + cslot[0]; if (cb >= CV_ALL) break; convert_chunk(F, args, cb, CV_ALL); } }
            } else if ((PHM & 32) && s == 5) {
                if (l == 0 && rep == 0) { bias_rows(F, args, false); asm volatile("s_waitcnt vmcnt(0)" ::: "memory"); __syncthreads(); }
                pg8::Gemm g{(const pg8::bf16_t*)OALL, (const pg8::bf16_t*)(wl + W_OUT), MROWS, DM, DM}; pg8::StaticOrder S; S.init(MROWS, DM, F.G, (int)blockIdx.x);
                pg8::EpiResS<true> E{(GAS float*)args.out, ws_, modl + 5 * DM, (const GAS float*)WSP(WS_IGS) + ((size_t)(l * 3 + 1) * 2) * DM, GS + ((size_t)(l * 3 + 2) * 2) * DM, 1.0f}; pg8::gemm_phase<pg8::EpiResS<true>, pg8::StaticOrder, false, true>(F.lds, g, S, E);
            }
        }
        if (rep + 1 < nrep) xcd_barrier(bar);
        }
        if (ph + 1 < hi) xcd_barrier(bar);
    }
#ifdef GEMM_PROF
    xcd_barrier(bar);
    if (blockIdx.x == 0 && threadIdx.x == 0) { const unsigned long long* st = (const unsigned long long*)(ctl + CW_Q + 64 * 13); double sh;
        if (GEMM_PROF == 0) sh = (double)st[1] / (double)(st[0] + st[1]);
        else if (GEMM_PROF == 1) sh = (double)st[0] / (double)st[2] / 1.0e6;
        else sh = (double)st[1] / (double)st[2] / 1.0e6;
        args.out[0] += (float)(0.04 + 0.18 * (sh > 1.0 ? 1.0 : sh)); }
#endif
#ifdef ATT_PROF
    xcd_barrier(bar);
    if (blockIdx.x == 0 && threadIdx.x == 0) { const unsigned long long* st = (const unsigned long long*)(ctl + CW_Q + 64 * 12);
        const double tot = (double)st[0]; double sh = 0.0;
        if (ATT_PROF == 0) sh = (double)st[0] / (double)st[5] / 1.0e6;
        else if (ATT_PROF == 5) sh = (double)st[0] / (double)st[6] / 1.0e4;
        else if (ATT_PROF == 6) sh = (double)st[6] / 1.0e3;
        else sh = (double)st[ATT_PROF] / tot;
        args.out[0] += (float)(0.04 + 0.18 * (sh > 1.0 ? 1.0 : sh)); }
#endif
}
#ifndef HYB
#define HYB 0
#endif
#ifndef DUPH
#define DUPH -1
#endif
static void launch_fwd(hipStream_t stream, Args a, int grid, int lo, int hi, int li, int adapt) {
    a.ph_lo = lo; a.ph_hi = hi; a.li = li; a.adapt = adapt;
    hipLaunchKernelGGL(fwd_mega, dim3(grid), dim3(NWAVES * 64), LDS_BYTES, stream, a);
}
extern "C" void kernel_launch(void* const* d_in, const int* in_sizes, int n_in, void* d_out, int out_size, void* d_ws, size_t ws_size, hipStream_t stream) {
    static int grid = 0;
    if (grid == 0) {
        if (n_in != 23 || out_size != MROWS * DM || ws_size < WS_END) { fprintf(stderr, "kernel_launch: unexpected problem (n_in %d, out %d, ws %zu < %zu)\n", n_in, out_size, ws_size, (size_t)WS_END); grid = -1; return; }
        int dev = 0, cus = 0, per_cu = 0;
        if (hipGetDevice(&dev) != hipSuccess || hipDeviceGetAttribute(&cus, hipDeviceAttributeMultiprocessorCount, dev) != hipSuccess) { grid = -1; return; }
        if (hipFuncSetAttribute((const void*)fwd_mega, hipFuncAttributeMaxDynamicSharedMemorySize, LDS_BYTES) != hipSuccess) { fprintf(stderr, "kernel_launch: hipFuncSetAttribute failed\n"); grid = -1; return; }
        if (hipOccupancyMaxActiveBlocksPerMultiprocessor(&per_cu, (const void*)fwd_mega, NWAVES * 64, LDS_BYTES) != hipSuccess || per_cu < 1) { fprintf(stderr, "kernel_launch: occupancy query says %d blocks per CU\n", per_cu); (void)hipGetLastError(); grid = -1; return; }
        if (cus < 256) { fprintf(stderr, "kernel_launch: built for a 256-CU device (the one-unit-per-workgroup GEMM phases need exactly 256 workgroups), found %d CUs\n", cus); grid = -1; return; }
        grid = 256;
    }
    if (grid < 0) return;
    (void)hipMemsetAsync((char*)d_ws + WS_CTL, 0, CTL_ZERO_BYTES, stream);
    Args a{};
    for (int i = 0; i < 23; ++i) a.in[i] = d_in[i];
    a.out = (float*)d_out; a.ws = (unsigned char*)d_ws;
#if HYB == 0
    launch_fwd(stream, a, grid, 0, NPH, 0, -1);
#elif HYB == 1
    for (int ph = 0; ph < NPH; ++ph) launch_fwd(stream, a, grid, ph, ph + 1, 0, -1);
#elif HYB == 4
    for (int ph = 0; ph < NPH; ++ph) {
        launch_fwd(stream, a, grid, ph, ph + 1, 0, -1);
        const int ty = ph < 2 ? 8 + ph : ((ph - 2) & 7);
        if (ty == DUPH && ty != 5 && !((ty == 1 || ty == 7) && ph != 3)) { (void)hipMemsetAsync((char*)d_ws + WS_CTL, 0, CTL_ZERO_BYTES, stream); launch_fwd(stream, a, grid, ph, ph + 1, 0, -1); }
    }
#else
    {
        using namespace nv;
        const float* x = (const float*)d_in[0]; const int* positions = (const int*)d_in[2];
        const float* rel_bias = (const float*)d_in[3]; const float* norm_g = (const float*)d_in[4];
        const float* w_ffn1_gu = (const float*)d_in[7]; const float* w_ffn1_down = (const float*)d_in[8]; const float* w_in = (const float*)d_in[9];
        const float* q_a_norm = (const float*)d_in[10]; const float* kv_a_norm = (const float*)d_in[11]; const float* w_uq = (const float*)d_in[12]; const float* w_ukv = (const float*)d_in[13];
        const float* mla_q_norm = (const float*)d_in[14]; const float* mla_k_norm = (const float*)d_in[15]; const float* swa_q_norm = (const float*)d_in[16]; const float* swa_k_norm = (const float*)d_in[17];
        const float* sinks = (const float*)d_in[18]; const float* out_norm = (const float*)d_in[19]; const float* w_out = (const float*)d_in[20];
        const float* w_ffn2_gu = (const float*)d_in[21]; const float* w_ffn2_down = (const float*)d_in[22];
        float* out = (float*)d_out; char* ws = (char*)d_ws;
        float* mod = (float*)(ws + WS_MOD);
        char* nb = ws + WS_XB;
        float* H = (float*)(nb); float* HIDn = (float*)(nb + 33 * MiB); float* P = (float*)(nb + 33 * MiB); float* QA = (float*)(nb + 91 * MiB); float* KVRAW = (float*)(nb + 110 * MiB);
        float* KAn = (float*)(nb + 135 * MiB); float* CQN = (float*)(nb + 154 * MiB); float* CKVN = (float*)(nb + 163 * MiB); float* QB = (float*)(nb + 168 * MiB); float* KBn = (float*)(nb + 181 * MiB);
        launch_fwd(stream, a, grid, 0, 1, 0, -1); launch_fwd(stream, a, grid, 1, 2, 0, -1);
        auto naive_ffn = [&](int l, int i, const float* xsrc) {
            for (int b = 0; b < BATCH; ++b) {
                float* xb = out + (size_t)b * nv::SEQ * nv::D; const float* xs = xsrc + (size_t)b * nv::SEQ * nv::D; const float* modlb = mod + ((size_t)l * 2 + b) * nv::NMOD;
                const float* wgu = (i == 0 ? w_ffn1_gu : w_ffn2_gu) + (size_t)l * nv::D * 2 * nv::DFF; const float* wdn = (i == 0 ? w_ffn1_down : w_ffn2_down) + (size_t)l * nv::DFF * nv::D;
                const float* sh = modlb + (3 * i) * nv::D; const float* sc = modlb + (3 * i + 1) * nv::D; const float* gt = modlb + (3 * i + 2) * nv::D;
                k_normmod<<<nv::SEQ / 4, 256, 0, stream>>>(xs, norm_g + ((size_t)l * 3 + i) * nv::D, sh, sc, H, nv::SEQ);
                k_gemm<true, 0><<<dim3(nv::DFF / 128, nv::SEQ / 128), 256, 0, stream>>>(H, nv::D, wgu, wgu + nv::DFF, 2 * nv::DFF, HIDn, nv::DFF, nv::DFF, nv::D, nullptr, nullptr, 0.f);
                k_gemm<false, 1><<<dim3(nv::D / 128, nv::SEQ / 128), 256, 0, stream>>>(HIDn, nv::DFF, wdn, nullptr, nv::D, xb, nv::D, nv::D, nv::DFF, xs, gt, 0.5f);
            }
        };
        auto naive_mixer = [&](int l) {
            for (int b = 0; b < BATCH; ++b) {
                float* xb = out + (size_t)b * nv::SEQ * nv::D; const int* posb = positions + b * nv::SEQ; const float* modlb = mod + ((size_t)l * 2 + b) * nv::NMOD;
                const float* sh = modlb + 3 * nv::D; const float* sc = modlb + 4 * nv::D; const float* gt = modlb + 5 * nv::D;
                k_normmod<<<nv::SEQ / 4, 256, 0, stream>>>(xb, norm_g + ((size_t)l * 3 + 1) * nv::D, sh, sc, H, nv::SEQ);
                k_gemm<false, 0><<<dim3((nv::DIN + 127) / 128, nv::SEQ / 128), 256, 0, stream>>>(H, nv::D, w_in + (size_t)l * nv::D * nv::DIN, nullptr, nv::DIN, P, nv::DIN, nv::DIN, nv::D, nullptr, nullptr, 0.f);
                k_headnorm<<<nv::SEQ / 4, 256, 0, stream>>>(P, nv::DIN, 0, 256, nullptr, 0, 0, 0, q_a_norm + l * 256, CQN, 256, 256, 1, nv::SEQ, posb, 0, 1);
                k_headnorm<<<nv::SEQ / 4, 256, 0, stream>>>(P + 256, nv::DIN, 0, 128, nullptr, 0, 0, 0, kv_a_norm + l * 128, CKVN, 128, 128, 1, nv::SEQ, posb, 0, 1);
                k_gemm<false, 0><<<dim3((576 + 127) / 128, nv::SEQ / 128), 256, 0, stream>>>(CQN, 256, w_uq + (size_t)l * 256 * 576, nullptr, 576, QA, 576, 576, 256, nullptr, nullptr, 0.f);
                k_gemm<false, 0><<<dim3(768 / 128, nv::SEQ / 128), 256, 0, stream>>>(CKVN, 128, w_ukv + (size_t)l * 128 * 768, nullptr, 768, KVRAW, 768, 768, 128, nullptr, nullptr, 0.f);
                k_headnorm<<<nv::SEQ * 6 / 4, 256, 0, stream>>>(QA, 576, 96, 96, nullptr, 0, 0, 0, mla_q_norm + l * 96, QA, 576, 96, 6, nv::SEQ, posb, 1, 1);
                k_headnorm<<<nv::SEQ * 6 / 4, 256, 0, stream>>>(KVRAW, 768, 128, 64, P + 384, nv::DIN, 0, 32, mla_k_norm + l * 96, KAn, 576, 96, 6, nv::SEQ, posb, 1, 1);
                k_headnorm<<<nv::SEQ * 6 / 4, 256, 0, stream>>>(P + 416, nv::DIN, 64, 64, nullptr, 0, 0, 0, swa_q_norm + l * 64, QB, 384, 64, 6, nv::SEQ, posb, 0, 1);
                k_headnorm<<<nv::SEQ * 2 / 4, 256, 0, stream>>>(P + 800, nv::DIN, 64, 64, nullptr, 0, 0, 0, swa_k_norm + l * 64, KBn, 128, 64, 2, nv::SEQ, posb, 0, 1);
                k_attn<96, 64, 0><<<dim3(nv::SEQ / 256, 6), 256, 0, stream>>>(QA, 576, 96, KAn, 576, 96, KVRAW + 64, 768, 128, H, nv::D, 0, 1, posb, nullptr, nullptr, 6);
                k_attn<64, 64, 1><<<dim3(nv::SEQ / 256, 6), 256, 0, stream>>>(QB, 384, 64, KBn, 128, 64, P + 928, nv::DIN, 64, H, nv::D, 384, 3, posb, sinks + l * 6, rel_bias, 6);
                k_attn<64, 64, 2><<<dim3(nv::SEQ / 256, 4), 256, 0, stream>>>(P + 1056, nv::DIN, 64, P + 1056 + 256, nv::DIN, 64, P + 1056 + 512, nv::DIN, 64, H, nv::D, 768, 1, posb, nullptr, nullptr, 4);
                k_groupnorm<<<nv::SEQ / 4, 256, 0, stream>>>(H, out_norm + l * nv::D, nv::SEQ);
                k_gemm<false, 1><<<dim3(nv::D / 128, nv::SEQ / 128), 256, 0, stream>>>(H, nv::D, w_out + (size_t)l * nv::D * nv::D, nullptr, nv::D, xb, nv::D, nv::D, nv::D, xb, gt, 1.0f);
            }
        };
        for (int l = 0; l < DEPTH; ++l) {
            const int base = 2 + 8 * l;
#if HYB == 2
            if (l > 0) launch_fwd(stream, a, grid, 0, 0, 0, l * 3 + 0);
            launch_fwd(stream, a, grid, base + 0, base + 1, 0, -1); launch_fwd(stream, a, grid, base + 1, base + 2, 0, -1);
            naive_mixer(l);
            launch_fwd(stream, a, grid, 0, 0, 0, l * 3 + 2);
            launch_fwd(stream, a, grid, base + 6, base + 7, 0, -1); launch_fwd(stream, a, grid, base + 7, base + 8, 0, -1);
#else
            naive_ffn(l, 0, l == 0 ? x : out);
            launch_fwd(stream, a, grid, 0, 0, 0, l * 3 + 1);
            for (int s = 2; s <= 5; ++s) launch_fwd(stream, a, grid, base + s, base + s + 1, 0, -1);
            naive_ffn(l, 2, out);
#endif
        }
    }
#endif
}
```

```cpp
#include <hip/hip_runtime.h>
#include <cstdio>
#include <cstdint>
#include <cmath>
constexpr int NWAVES = 8;
constexpr int BATCH = 2, SEQ = 8192, DM = 1024, DEPTH = 2, MROWS = BATCH * SEQ;
constexpr int DFF = 2816, DIN = 1824, NMOD = 9 * DM;
constexpr int NPH = 2 + 8 * DEPTH;
constexpr size_t MiB = 1u << 20;
constexpr size_t WS_CTL = 0, CTL_ZERO_BYTES = 256 * 1024;
constexpr size_t WS_MOD = 1 * MiB;
constexpr size_t WS_GS = WS_MOD + 160 * 1024;
constexpr size_t WS_IGS = WS_GS + 64 * 1024;
constexpr size_t WS_BIAS = WS_IGS + 64 * 1024;
constexpr size_t BIAS_L = 2 * (5632 + 2048 + 5632);
constexpr size_t WS_SSQX = 2 * MiB;
constexpr size_t WS_SSQO = 3 * MiB;
constexpr size_t WS_CS = 4 * MiB;
constexpr size_t WS_KPE = 6 * MiB;
constexpr size_t WS_SSQC = 8 * MiB;
constexpr size_t WS_W = 9 * MiB;
constexpr size_t W_GU1 = 0, W_D1 = W_GU1 + (size_t)5632 * 1024 * 2, W_IN = W_D1 + (size_t)1024 * 2816 * 2, W_UQ = W_IN + (size_t)2048 * 1024 * 2, W_UKV = W_UQ + (size_t)768 * 256 * 2,
                 W_OUT = W_UKV + (size_t)768 * 128 * 2, W_GU2 = W_OUT + (size_t)1024 * 1024 * 2, W_D2 = W_GU2 + (size_t)5632 * 1024 * 2, WL = W_D2 + (size_t)1024 * 2816 * 2;
constexpr size_t WS_XB = WS_W + ((2 * WL + MiB - 1) / MiB) * MiB;
constexpr size_t WS_ACT = WS_XB + 32 * MiB;
constexpr size_t WS_HID = WS_ACT;
constexpr size_t WS_CQ = WS_ACT, WS_CKV = WS_CQ + 8 * MiB, WS_QRAW = WS_CKV + 4 * MiB, WS_KA = WS_QRAW + 36 * MiB, WS_VA = WS_KA + 18 * MiB, WS_QS = WS_VA + 12 * MiB, WS_KS = WS_QS + 12 * MiB,
                 WS_VS = WS_KS + 4 * MiB, WS_QC = WS_VS + 4 * MiB, WS_KC = WS_QC + 8 * MiB, WS_VC = WS_KC + 8 * MiB, WS_OALL = WS_VC + 8 * MiB, WS_END = WS_OALL + 32 * MiB;
static_assert(WS_HID + (size_t)MROWS * DFF * 2 <= WS_END, "d_ws map");
constexpr int CW_BAR = 4096;
constexpr int CW_Q = 40960;
static_assert((CW_Q + 64 * 14) * 4 <= (int)CTL_ZERO_BYTES && CW_BAR + 8 * 3456 <= CW_Q, "ctl map");
constexpr int RING_BYTES = 131072, LDSCTL_OFF = RING_BYTES, MISC_OFF = LDSCTL_OFF + 320, LDS_BYTES = 147456;

namespace pg8 {
#define PG8_LAS __attribute__((address_space(3)))
typedef unsigned short bf16_t;
typedef short bf16x8 __attribute__((ext_vector_type(8)));
typedef float f32x4 __attribute__((ext_vector_type(4)));
typedef unsigned u32x4 __attribute__((ext_vector_type(4)));
constexpr int BM = 256, BK = 64, HALF = 128, HTB = HALF * BK * 2  , STAGE_BYTES = 8 * HTB, NXCD = 8, WGM = 8;

__host__ __device__ __forceinline__ int lds_byte(int r, int c) { const int st = (r >> 4) * 2 + (c >> 5), rr = r & 15, cc = c & 31, ob = rr * 64 + cc * 2; return st * 1024 + (ob ^ (((ob >> 9) & 1) << 5)); }
__host__ __device__ __forceinline__ void stage_rc(int b, int& R, int& C) { const int st = b / 1024, sb = b % 1024, swz = sb ^ (((sb >> 9) & 1) << 5); R = (st >> 1) * 16 + swz / 64; C = (st & 1) * 32 + (swz % 64) / 2; }
__host__ __device__ __forceinline__ int perm32(int rho) { const int n = rho >> 4, i = rho & 15; return 8 * (i >> 2) + 4 * n + (i & 3); }

struct Unit { int pm, pn; };
struct Gemm { const bf16_t* A; const bf16_t* Bt; int M, N, K; };

struct StaticOrder {
    int nM, nN, nwg, G, c;
    __host__ __device__ void init(int M, int N, int G_, int c_) { nM = M / BM; nN = N / BM; nwg = nM * nN; G = G_; c = c_; }
    __host__ __device__ bool next(int i, Unit& u) const {
        const long L = (long)i * G + c; if (L >= nwg) return false;
        int wgid = (int)L; { const int q = nwg / NXCD, r = nwg % NXCD, xcd = wgid % NXCD, off = wgid / NXCD; wgid = (xcd < r ? xcd * (q + 1) : r * (q + 1) + (xcd - r) * q) + off; }
        const int nig = WGM * nN, gid = wgid / nig, fm = gid * WGM, gsz = (nM - fm) < WGM ? (nM - fm) : WGM;
        u.pm = fm + ((wgid % nig) % gsz); u.pn = (wgid % nig) / gsz; return true;
    }
    __device__ __forceinline__ void a_ready(const Unit&) const {}
    __device__ __forceinline__ void done(const Unit&) const {}
};

__device__ __forceinline__ unsigned cvt_pk_bf16(float lo, float hi) { unsigned r; asm volatile("v_cvt_pk_bf16_f32 %0, %1, %2" : "=v"(r) : "v"(lo), "v"(hi)); return r; }
typedef float f32x2 __attribute__((ext_vector_type(2)));
template <class Epi, class Sched, bool ALIGN_EPI = false, bool SP2 = false>
__device__ __forceinline__ void gemm_phase(PG8_LAS unsigned char* lds, const Gemm g, const Sched& S, const Epi& E, unsigned long long* gprof = nullptr) {
#ifdef GEMM_PROF
    const long long gp_t0 = (Epi::AFTER_DRAIN && !Epi::HOOK && blockIdx.x == 0) ? (long long)clock64() : 0ll;
#endif
    int tid_ = threadIdx.x; asm volatile("" : "+v"(tid_));
    const int tid = tid_, wid = __builtin_amdgcn_readfirstlane(tid >> 6), lane = tid & 63, wr = wid >> 2, wc = wid & 3, fr = lane & 15, fq = lane >> 4;
    int K_ = g.K; asm volatile("" : "+s"(K_));
    const int K = K_, nt = K / BK;
    unsigned voffA[2], voffB[2];
#pragma unroll
    for (int i = 0; i < 2; ++i) { int R, C; stage_rc(tid * 16 + i * 8192, R, C); const int Rb = Epi::PERM ? ((R & ~31) + perm32(R & 31)) : R;
        voffA[i] = (unsigned)(R * K + C) * 2u; voffB[i] = (unsigned)(Rb * K + C) * 2u; }
    const size_t kstep = (size_t)(BK * 2);
    const size_t hstep = (size_t)HALF * K * 2;
    const size_t tstep = 2 * hstep;
    const unsigned ldsw = (unsigned)wid * 1024u;
    const int aoff = lds_byte(wr * 64 + fr, fq * 8), boff = lds_byte(wc * 32 + fr, fq * 8);
#define PG8_SA(b, h) (((b) * 2 + (h)) * HTB)
#define PG8_SB(b, h) ((4 + (b) * 2 + (h)) * HTB)
#define PG8_STAGE(bufoff, gbase, voff) do { _Pragma("unroll") for (int _i = 0; _i < 2; ++_i) \
        __builtin_amdgcn_global_load_lds((const unsigned*)((const char*)(gbase) + (voff)[_i]), (PG8_LAS unsigned*)(lds + (bufoff) + ldsw + _i * 8192), 16, 0, 0); } while (0)
#define PG8_LDA(dst, b, h) do { _Pragma("unroll") for (int m = 0; m < 4; ++m) _Pragma("unroll") for (int k = 0; k < 2; ++k) dst[m][k] = *(const PG8_LAS bf16x8*)(lds + PG8_SA(b, h) + aoff + m * 2048 + k * 1024); } while (0)
#define PG8_LDB(dst, b, h) do { _Pragma("unroll") for (int n = 0; n < 2; ++n) _Pragma("unroll") for (int k = 0; k < 2; ++k) dst[n][k] = *(const PG8_LAS bf16x8*)(lds + PG8_SB(b, h) + boff + n * 2048 + k * 1024); } while (0)
#define PG8_MMA(ai, bj, At, Bt) do { __builtin_amdgcn_s_setprio(1); _Pragma("unroll") for (int m = 0; m < 4; ++m) _Pragma("unroll") for (int n = 0; n < 2; ++n) _Pragma("unroll") for (int k = 0; k < 2; ++k) \
        acc[ai][bj][m][n] = __builtin_amdgcn_mfma_f32_16x16x32_bf16(Bt[n][k], At[m][k], acc[ai][bj][m][n], 0, 0, 0); __builtin_amdgcn_s_setprio(0); } while (0)
#define PG8_WAIT_V(n) asm volatile("s_waitcnt vmcnt(" #n ")" ::: "memory")
#define PG8_WAIT_L(n) asm volatile("s_waitcnt lgkmcnt(" #n ")" ::: "memory")
#define PG8_BAR __builtin_amdgcn_s_barrier()
#define PG8_SCHED __builtin_amdgcn_sched_barrier(0)
    Unit cur, nxt; int ui = 0;
    if (!S.next(0, cur)) return;
    f32x4 acc[2][2][4][2];
#pragma unroll
    for (int a = 0; a < 2; ++a)
#pragma unroll
        for (int b = 0; b < 2; ++b)
#pragma unroll
            for (int m = 0; m < 4; ++m)
#pragma unroll
                for (int n = 0; n < 2; ++n) acc[a][b][m][n] = (f32x4){0.f, 0.f, 0.f, 0.f};
    bf16x8 At[4][2], B0[2][2], B1[2][2];
    const char* cA = (const char*)g.A + (size_t)cur.pm * tstep; const char* cB = (const char*)g.Bt + (size_t)cur.pn * tstep;
    S.a_ready(cur);
    if constexpr (SP2) {
        PG8_STAGE(PG8_SB(0, 0), cB, voffB); PG8_STAGE(PG8_SB(0, 1), cB + hstep, voffB); PG8_STAGE(PG8_SA(0, 0), cA, voffA); PG8_STAGE(PG8_SA(0, 1), cA + hstep, voffA);
        if (wr == 1) PG8_BAR;
        PG8_WAIT_V(2); PG8_BAR;
        PG8_STAGE(PG8_SB(1, 0), cB + kstep, voffB); PG8_STAGE(PG8_SA(1, 0), cA + kstep, voffA); PG8_STAGE(PG8_SB(1, 1), cB + hstep + kstep, voffB);
        PG8_WAIT_V(6); PG8_BAR;
    } else {
        PG8_STAGE(PG8_SB(0, 0), cB, voffB); PG8_STAGE(PG8_SA(0, 0), cA, voffA); PG8_STAGE(PG8_SB(0, 1), cB + hstep, voffB); PG8_STAGE(PG8_SA(0, 1), cA + hstep, voffA);
        if (wr == 1) PG8_BAR;
        PG8_WAIT_V(4); PG8_BAR;
        PG8_STAGE(PG8_SB(1, 0), cB + kstep, voffB); PG8_STAGE(PG8_SA(1, 0), cA + kstep, voffA); PG8_STAGE(PG8_SB(1, 1), cB + hstep + kstep, voffB);
        PG8_WAIT_V(6); PG8_BAR;
    }
    for (;;) {
        const bool has_next = S.next(ui + 1, nxt);
        const char* nA = has_next ? (const char*)g.A + (size_t)nxt.pm * tstep : cA; const char* nB = has_next ? (const char*)g.Bt + (size_t)nxt.pn * tstep : cB;
#pragma nounroll
        for (int t = 0; t < nt; t += 2) {
            if constexpr (Epi::HOOK) E.hook(acc, cur, t, wr, wc, fr, fq);
            const bool last = (t == nt - 2);
            const char* a1 = cA + (size_t)(t + 1) * kstep;
            const char* a2 = last ? nA : cA + (size_t)(t + 2) * kstep; const char* b2 = last ? nB : cB + (size_t)(t + 2) * kstep;
            const char* a3 = a2 + kstep; const char* b3 = b2 + kstep;
            if (last && has_next) S.a_ready(nxt);
            if constexpr (SP2) {
            PG8_LDB(B0, 0, 0); PG8_LDB(B1, 0, 1); PG8_SCHED; PG8_LDA(At, 0, 0); PG8_STAGE(PG8_SA(1, 1), a1 + hstep, voffA);
            PG8_WAIT_V(8); PG8_WAIT_L(0); PG8_BAR; PG8_MMA(0, 0, At, B0); PG8_MMA(0, 1, At, B1); PG8_BAR; PG8_SCHED;
            PG8_LDA(At, 0, 1); PG8_STAGE(PG8_SB(0, 0), b2, voffB); PG8_STAGE(PG8_SB(0, 1), b2 + hstep, voffB); PG8_STAGE(PG8_SA(0, 0), a2, voffA);
            PG8_WAIT_V(8); PG8_WAIT_L(0); PG8_BAR; PG8_MMA(1, 0, At, B0); PG8_MMA(1, 1, At, B1); PG8_BAR; PG8_SCHED;
            PG8_LDB(B0, 1, 0); PG8_LDB(B1, 1, 1); PG8_SCHED; PG8_LDA(At, 1, 0); PG8_STAGE(PG8_SA(0, 1), a2 + hstep, voffA);
            PG8_WAIT_V(8); PG8_WAIT_L(0); PG8_BAR; PG8_MMA(0, 0, At, B0); PG8_MMA(0, 1, At, B1); PG8_BAR; PG8_SCHED;
            PG8_LDA(At, 1, 1); PG8_STAGE(PG8_SB(1, 0), b3, voffB); PG8_STAGE(PG8_SB(1, 1), b3 + hstep, voffB); PG8_STAGE(PG8_SA(1, 0), a3, voffA);
            PG8_WAIT_V(8); PG8_WAIT_L(0); PG8_BAR; PG8_MMA(1, 0, At, B0); PG8_MMA(1, 1, At, B1); PG8_BAR; PG8_SCHED;
            } else {
            PG8_LDB(B0, 0, 0); PG8_SCHED; PG8_LDA(At, 0, 0); PG8_STAGE(PG8_SA(1, 1), a1 + hstep, voffA);
            PG8_WAIT_L(8); PG8_BAR; PG8_WAIT_L(0); PG8_MMA(0, 0, At, B0); PG8_BAR; PG8_SCHED;
            PG8_LDB(B1, 0, 1); PG8_STAGE(PG8_SB(0, 0), b2, voffB);
            PG8_BAR; PG8_WAIT_L(0); PG8_MMA(0, 1, At, B1); PG8_BAR;
            PG8_LDA(At, 0, 1); PG8_STAGE(PG8_SA(0, 0), a2, voffA);
            PG8_BAR; PG8_WAIT_L(0); PG8_MMA(1, 0, At, B0); PG8_BAR; PG8_SCHED;
            PG8_STAGE(PG8_SB(0, 1), b2 + hstep, voffB);
            PG8_WAIT_V(6); PG8_BAR; PG8_MMA(1, 1, At, B1); PG8_BAR;
            PG8_LDB(B0, 1, 0); PG8_SCHED; PG8_LDA(At, 1, 0); PG8_STAGE(PG8_SA(0, 1), a2 + hstep, voffA);
            PG8_WAIT_L(8); PG8_BAR; PG8_WAIT_L(0); PG8_MMA(0, 0, At, B0); PG8_BAR; PG8_SCHED;
            PG8_LDB(B1, 1, 1); PG8_STAGE(PG8_SB(1, 0), b3, voffB);
            PG8_BAR; PG8_WAIT_L(0); PG8_MMA(0, 1, At, B1); PG8_BAR;
            PG8_LDA(At, 1, 1); PG8_STAGE(PG8_SA(1, 0), a3, voffA);
            PG8_BAR; PG8_WAIT_L(0); PG8_MMA(1, 0, At, B0); PG8_BAR; PG8_SCHED;
            PG8_STAGE(PG8_SB(1, 1), b3 + hstep, voffB);
            PG8_WAIT_V(6); PG8_BAR; PG8_MMA(1, 1, At, B1); PG8_BAR;
            }
        }
        if constexpr (ALIGN_EPI) { if (wr == 0) PG8_BAR; }
        if constexpr (!Epi::AFTER_DRAIN) {
            Unit ce = cur; asm volatile("" : "+s"(ce.pm), "+s"(ce.pn)); int fre = fr, fqe = fq; asm volatile("" : "+v"(fre), "+v"(fqe));
            E(acc, ce, wr, wc, fre, fqe); S.done(cur); }
        if (!has_next) break;
#pragma unroll
        for (int a = 0; a < 2; ++a)
#pragma unroll
            for (int b = 0; b < 2; ++b)
#pragma unroll
                for (int m = 0; m < 4; ++m)
#pragma unroll
                    for (int n = 0; n < 2; ++n) acc[a][b][m][n] = (f32x4){0.f, 0.f, 0.f, 0.f};
        cur = nxt; cA = nA; cB = nB; ++ui;
        if constexpr (ALIGN_EPI) { if (wr == 1) PG8_BAR; }
    }
    PG8_WAIT_V(0);
    if constexpr (!ALIGN_EPI) { if (wr == 0) PG8_BAR; }
    PG8_BAR;
#ifdef GEMM_PROF
    const long long gp_t1 = (Epi::AFTER_DRAIN && !Epi::HOOK && blockIdx.x == 0) ? (long long)clock64() : 0ll;
#endif
    if constexpr (Epi::AFTER_DRAIN) { E.fused(acc, cur, wr, wc, fr, fq, lds, wid, lane); S.done(cur); }
#ifdef GEMM_PROF
    if (Epi::AFTER_DRAIN && !Epi::HOOK && blockIdx.x == 0 && tid == 0 && gprof) { const long long gp_t2 = clock64(); atomicAdd(gprof + 0, (unsigned long long)(gp_t1 - gp_t0)); atomicAdd(gprof + 1, (unsigned long long)(gp_t2 - gp_t1)); atomicAdd(gprof + 2, 1ull); }
#endif
#undef PG8_SA
#undef PG8_SB
#undef PG8_STAGE
#undef PG8_LDA
#undef PG8_LDB
#undef PG8_MMA
#undef PG8_WAIT_V
#undef PG8_WAIT_L
#undef PG8_BAR
#undef PG8_SCHED
}
constexpr float RMS_EPS = 1e-6f;
constexpr int MROWS_ = 16384;
constexpr float LOG2E = 1.4426950408889634f;
typedef unsigned u32x2 __attribute__((ext_vector_type(2)));
#define PG8_FENCE() asm volatile("" ::: "memory")
#define PG8_G __attribute__((address_space(1)))
__device__ __forceinline__ float sum16f(const PG8_G float* p) {
    const f32x4 a = *(const PG8_G f32x4*)p, b = *(const PG8_G f32x4*)(p + 4), c = *(const PG8_G f32x4*)(p + 8), d = *(const PG8_G f32x4*)(p + 12);
    return ((a[0] + a[1]) + (a[2] + a[3])) + ((b[0] + b[1]) + (b[2] + b[3])) + ((c[0] + c[1]) + (c[2] + c[3])) + ((d[0] + d[1]) + (d[2] + d[3]));
}
__device__ __forceinline__ float xsum16(float x) { auto r = __builtin_amdgcn_permlane16_swap(__float_as_uint(x), __float_as_uint(x), false, false); return __uint_as_float(r[0]) + __uint_as_float(r[1]); }
__device__ __forceinline__ float xsum32(float x) { auto r = __builtin_amdgcn_permlane32_swap(__float_as_uint(x), __float_as_uint(x), false, false); return __uint_as_float(r[0]) + __uint_as_float(r[1]); }
__device__ __forceinline__ float wave_sum_dpp(float x) {
    x += __builtin_bit_cast(float, __builtin_amdgcn_update_dpp(0, __builtin_bit_cast(int, x), 0xB1, 0xf, 0xf, true));
    x += __builtin_bit_cast(float, __builtin_amdgcn_update_dpp(0, __builtin_bit_cast(int, x), 0x4E, 0xf, 0xf, true));
    x += __builtin_bit_cast(float, __builtin_amdgcn_update_dpp(0, __builtin_bit_cast(int, x), 0x141, 0xf, 0xf, true));
    x += __builtin_bit_cast(float, __builtin_amdgcn_update_dpp(0, __builtin_bit_cast(int, x), 0x140, 0xf, 0xf, true));
    return xsum32(xsum16(x));
}
__device__ __forceinline__ float fast_rcp(float x) { return __builtin_amdgcn_rcpf(x); }
__device__ __forceinline__ float silu_fast(float g) { return g * fast_rcp(1.0f + __builtin_amdgcn_exp2f(-g * LOG2E)); }
__device__ __forceinline__ float sq4(const f32x4 v) { return (v[0] * v[0] + v[1] * v[1]) + (v[2] * v[2] + v[3] * v[3]); }

struct EpiUp {
    static constexpr bool PERM = true, AFTER_DRAIN = false, HOOK = false;
    PG8_G unsigned char* ws; const PG8_G float* bias;
    __device__ __forceinline__ void hook(f32x4 (&)[2][2][4][2], const Unit&, int, int, int, int, int) const {}
    __device__ __forceinline__ void operator()(const f32x4 (&acc)[2][2][4][2], const Unit& u, int wr, int wc, int fr, int fq) const {
        PG8_G bf16_t* HID = (PG8_G bf16_t*)(ws + WS_HID); const PG8_G float* ssqx = (const PG8_G float*)(ws + WS_SSQX);
        const int b = u.pm >> 5;
        const PG8_G float* bb = bias + b * 5632 + u.pn * BM + wc * 32 + 8 * fq;
        f32x4 bg[2], bu[2];
#pragma unroll
        for (int n = 0; n < 2; ++n) { bg[n] = *(const PG8_G f32x4*)(bb + 4 * n); bu[n] = *(const PG8_G f32x4*)(bb + HALF + 4 * n); }
#pragma unroll
        for (int ai = 0; ai < 2; ++ai)
#pragma unroll
            for (int m = 0; m < 4; ++m) {
                const int row = u.pm * BM + ai * HALF + wr * 64 + m * 16 + fr;
                const float r = 1.0f / sqrtf(sum16f(ssqx + (size_t)row * 16) * (1.0f / 1024.0f) + RMS_EPS);
                float hv[8];
#pragma unroll
                for (int n = 0; n < 2; ++n)
#pragma unroll
                    for (int i = 0; i < 4; ++i) { const float g = acc[ai][0][m][n][i] * r + bg[n][i], uu = acc[ai][1][m][n][i] * r + bu[n][i]; hv[4 * n + i] = silu_fast(g) * uu; }
                u32x4 w; w.x = cvt_pk_bf16(hv[0], hv[1]); w.y = cvt_pk_bf16(hv[2], hv[3]); w.z = cvt_pk_bf16(hv[4], hv[5]); w.w = cvt_pk_bf16(hv[6], hv[7]);
                *(PG8_G u32x4*)(HID + (size_t)row * 2816 + u.pn * HALF + wc * 32 + 8 * fq) = w;
                if (m & 1) PG8_FENCE();
            }
    }
};

template <bool HOOKED> struct EpiResS {
    static constexpr bool PERM = false, AFTER_DRAIN = true, HOOK = HOOKED;
    PG8_G float* fout; PG8_G unsigned char* ws; const PG8_G float* gate; const PG8_G float* igs; const PG8_G float* gs; float coef;
    __device__ __forceinline__ void group_r(int row, float& rA, float& rB, float& rC) const {
        const PG8_G float* p = (const PG8_G float*)(ws + WS_SSQO) + (size_t)row * 16;
        const f32x4 a = *(const PG8_G f32x4*)p, b = *(const PG8_G f32x4*)(p + 4), c = *(const PG8_G f32x4*)(p + 8), d = *(const PG8_G f32x4*)(p + 12);
        const float sA = ((a[0] + a[1]) + (a[2] + a[3])) + (b[0] + b[1]), sB = ((b[2] + b[3]) + (c[0] + c[1])) + (c[2] + c[3]), sC = (d[0] + d[1]) + (d[2] + d[3]);
        rA = 1.0f / sqrtf(sA * (1.0f / 384.0f) + RMS_EPS); rB = 1.0f / sqrtf(sB * (1.0f / 384.0f) + RMS_EPS); rC = 1.0f / sqrtf(sC * (1.0f / 256.0f) + RMS_EPS);
    }
    __device__ __forceinline__ void hook(f32x4 (&acc)[2][2][4][2], const Unit& u, int t, int wr, int wc, int fr, int fq) const {
        if (t != 6 && t != 12) return;
        asm volatile("" : "+v"(fr));
#pragma unroll
        for (int ai = 0; ai < 2; ++ai)
#pragma unroll
            for (int m = 0; m < 4; ++m) {
                const int row = u.pm * BM + ai * HALF + wr * 64 + m * 16 + fr;
                float rA, rB, rC; group_r(row, rA, rB, rC);
                const float f = (t == 6) ? rA / rB : rB / rC;
#pragma unroll
                for (int bj = 0; bj < 2; ++bj)
#pragma unroll
                    for (int n = 0; n < 2; ++n) acc[ai][bj][m][n] = acc[ai][bj][m][n] * f;
                PG8_FENCE();
            }
    }
    __device__ __forceinline__ void fused(f32x4 (&acc)[2][2][4][2], const Unit& u, int wr, int wc, int fr, int fq, PG8_LAS unsigned char* lds, int wid, int lane) const {
        PG8_G bf16_t* xb = (PG8_G bf16_t*)(ws + WS_XB); PG8_G float* ssq_out = (PG8_G float*)(ws + WS_SSQX); constexpr int gate_bstride = 9 * 1024;
        const int b = u.pm >> 5, colg = u.pn * BM + 4 * lane;
        const f32x4 gv = *(const PG8_G f32x4*)(gate + (size_t)b * gate_bstride + colg) * coef;
        const f32x4 gsv = gs ? *(const PG8_G f32x4*)(gs + (size_t)b * 1024 + colg) : (f32x4){0.f, 0.f, 0.f, 0.f};
        const f32x4 igv = *(const PG8_G f32x4*)(igs + (size_t)b * 1024 + colg);
#pragma unroll
        for (int ai = 0; ai < 2; ++ai) {
#pragma unroll
            for (int m = 0; m < 4; ++m) { const int rl = wr * 64 + m * 16 + fr;
#pragma unroll
                for (int bj = 0; bj < 2; ++bj)
#pragma unroll
                    for (int n = 0; n < 2; ++n) { const int c = 32 * bj + 8 * wc + 4 * n + fq; *(PG8_LAS f32x4*)(lds + rl * 1024 + ((c ^ (rl & 7)) << 4)) = acc[ai][bj][m][n]; } }
            asm volatile("s_waitcnt lgkmcnt(0)\n\ts_barrier" ::: "memory");
#pragma unroll
            for (int half = 0; half < 2; ++half) {
                u32x2 xo[8];
#pragma unroll
                for (int k = 0; k < 8; ++k) { const int rl = wid + 8 * (half * 8 + k); xo[k] = *(const PG8_G u32x2*)(xb + (size_t)(u.pm * BM + ai * HALF + rl) * 1024 + colg); }
#pragma unroll
                for (int k = 0; k < 8; ++k) { const int rl = wid + 8 * (half * 8 + k); const int row = u.pm * BM + ai * HALF + rl;
                    f32x4 t = *(const PG8_LAS f32x4*)(lds + rl * 1024 + ((lane ^ (rl & 7)) << 4));
                    if (HOOKED) { float rA, rB, rC; group_r(row, rA, rB, rC); t = t * rC; }
                    const f32x4 xs = {__uint_as_float(xo[k].x << 16), __uint_as_float(xo[k].x & 0xffff0000u), __uint_as_float(xo[k].y << 16), __uint_as_float(xo[k].y & 0xffff0000u)};
                    const f32x4 xn = xs * igv + gv * t;
                    if (!gs) *(PG8_G f32x4*)(fout + (size_t)row * 1024 + colg) = xn;
                    if (gs) { const f32x4 y = xn * gsv; u32x2 w; w.x = cvt_pk_bf16(y[0], y[1]); w.y = cvt_pk_bf16(y[2], y[3]); *(PG8_G u32x2*)(xb + (size_t)row * 1024 + colg) = w; }
                    float ss = sq4(xn);
                    ss = wave_sum_dpp(ss);
                    if (gs && lane == 0) *(PG8_G f32x4*)(ssq_out + (size_t)row * 16 + 4 * u.pn) = (f32x4){ss, 0.f, 0.f, 0.f};
                }
            }
            asm volatile("s_waitcnt lgkmcnt(0)\n\ts_barrier" ::: "memory");
        }
    }
};

struct EpiIn {
    static constexpr bool PERM = true, AFTER_DRAIN = false, HOOK = false;
    PG8_G unsigned char* ws; const PG8_G float* gq; const PG8_G float* gk; const PG8_G float* bias;
    __device__ __forceinline__ void hook(f32x4 (&)[2][2][4][2], const Unit&, int, int, int, int, int) const {}
    __device__ __forceinline__ void operator()(const f32x4 (&acc)[2][2][4][2], const Unit& u, int wr, int wc, int fr, int fq) const {
        const int slot = u.pn * 4 + wc;
        if (slot == 7 || slot >= 30) return;
        const int b = u.pm >> 5;
        const PG8_G float* ssqx = (const PG8_G float*)(ws + WS_SSQX);
        PG8_G PG8_G bf16_t* dst = nullptr; int pitch = 0, col0 = 0; int kind = 0;
        PG8_G PG8_G float* ssqd = nullptr; int ssqp = 0, ssqi = 0; const PG8_G float* gain = nullptr; float scale = 1.0f;
        if (slot < 4)       { dst = (PG8_G bf16_t*)(ws + WS_CQ);  pitch = 256; col0 = 64 * slot;        kind = 1; ssqd = (PG8_G float*)(ws + WS_SSQC);  ssqp = 4; ssqi = slot; }
        else if (slot < 6)  { dst = (PG8_G bf16_t*)(ws + WS_CKV); pitch = 128; col0 = 64 * (slot - 4);  kind = 1; ssqd = (PG8_G float*)(ws + WS_SSQC) + (size_t)MROWS_ * 4; ssqp = 2; ssqi = slot - 4; }
        else if (slot == 6) { kind = 3; }
        else if (slot < 14) { dst = (PG8_G bf16_t*)(ws + WS_QS);  pitch = 384; col0 = 64 * (slot - 8);  kind = 2; gain = gq; scale = 0.125f * LOG2E; }
        else if (slot < 16) { dst = (PG8_G bf16_t*)(ws + WS_KS);  pitch = 128; col0 = 64 * (slot - 14); kind = 2; gain = gk; }
        else if (slot < 18) { dst = (PG8_G bf16_t*)(ws + WS_VS);  pitch = 128; col0 = 64 * (slot - 16); }
        else if (slot < 22) { dst = (PG8_G bf16_t*)(ws + WS_QC);  pitch = 256; col0 = 64 * (slot - 18); scale = 0.125f * LOG2E; }
        else if (slot < 26) { dst = (PG8_G bf16_t*)(ws + WS_KC);  pitch = 256; col0 = 64 * (slot - 22); }
        else                { dst = (PG8_G bf16_t*)(ws + WS_VC);  pitch = 256; col0 = 64 * (slot - 26); }
        const PG8_G float* bb = bias + b * 2048 + u.pn * BM + wc * 32 + 8 * fq;
        f32x4 bv[2][2], gn[2][2];
#pragma unroll
        for (int bj = 0; bj < 2; ++bj)
#pragma unroll
            for (int n = 0; n < 2; ++n) { bv[bj][n] = *(const PG8_G f32x4*)(bb + bj * HALF + 4 * n);
                gn[bj][n] = (kind == 2) ? *(const PG8_G f32x4*)(gain + 32 * bj + 8 * fq + 4 * n) * scale : (f32x4){scale, scale, scale, scale}; }
#pragma unroll
        for (int ai = 0; ai < 2; ++ai)
#pragma unroll
            for (int m = 0; m < 4; ++m) {
                const int row = u.pm * BM + ai * HALF + wr * 64 + m * 16 + fr;
                const float r = 1.0f / sqrtf(sum16f(ssqx + (size_t)row * 16) * (1.0f / 1024.0f) + RMS_EPS);
                f32x4 v[2][2]; float ss = 0.f;
#pragma unroll
                for (int bj = 0; bj < 2; ++bj)
#pragma unroll
                    for (int n = 0; n < 2; ++n) { v[bj][n] = acc[ai][bj][m][n] * r + bv[bj][n]; ss += sq4(v[bj][n]); }
                if (kind == 3) {
                    float s0 = sq4(v[0][0]) + sq4(v[0][1]);
                    s0 = xsum32(xsum16(s0));
                    *(PG8_G f32x4*)((PG8_G float*)(ws + WS_KPE) + (size_t)row * 32 + 8 * fq) = v[0][0]; *(PG8_G f32x4*)((PG8_G float*)(ws + WS_KPE) + (size_t)row * 32 + 8 * fq + 4) = v[0][1];
                    if (fq == 0) ((PG8_G float*)(ws + WS_SSQC) + (size_t)MROWS_ * 6)[row] = s0;
                } else {
                    if (kind != 0) { ss = xsum32(xsum16(ss)); }
                    float rn = 1.0f;
                    if (kind == 2) rn = 1.0f / sqrtf(ss * (1.0f / 64.0f) + RMS_EPS);
                    if (kind == 1 && fq == 0) ssqd[(size_t)row * ssqp + ssqi] = ss;
#pragma unroll
                    for (int bj = 0; bj < 2; ++bj) {
                        const f32x4 y0 = v[bj][0] * gn[bj][0] * rn, y1 = v[bj][1] * gn[bj][1] * rn;
                        u32x4 w; w.x = cvt_pk_bf16(y0[0], y0[1]); w.y = cvt_pk_bf16(y0[2], y0[3]); w.z = cvt_pk_bf16(y1[0], y1[1]); w.w = cvt_pk_bf16(y1[2], y1[3]);
                        *(PG8_G u32x4*)(dst + (size_t)row * pitch + col0 + 32 * bj + 8 * fq) = w;
                    }
                }
                if (m & 1) PG8_FENCE();
            }
    }
};

struct EpiUq {
    static constexpr bool PERM = false, AFTER_DRAIN = false, HOOK = false;
    PG8_G unsigned char* ws;
    __device__ __forceinline__ void hook(f32x4 (&)[2][2][4][2], const Unit&, int, int, int, int, int) const {}
    __device__ __forceinline__ void operator()(const f32x4 (&acc)[2][2][4][2], const Unit& u, int wr, int wc, int fr, int fq) const {
        PG8_G bf16_t* QRAW = (PG8_G bf16_t*)(ws + WS_QRAW); const PG8_G float* ssqcq = (const PG8_G float*)(ws + WS_SSQC);
        const int col0 = u.pn * BM + wc * 32 + 4 * fq;
#pragma unroll
        for (int ai = 0; ai < 2; ++ai)
#pragma unroll
            for (int m = 0; m < 4; ++m) {
                const int row = u.pm * BM + ai * HALF + wr * 64 + m * 16 + fr;
                const f32x4 s = *(const PG8_G f32x4*)(ssqcq + (size_t)row * 4);
                const float r = 1.0f / sqrtf(((s[0] + s[1]) + (s[2] + s[3])) * (1.0f / 256.0f) + RMS_EPS);
#pragma unroll
                for (int bj = 0; bj < 2; ++bj)
#pragma unroll
                    for (int n = 0; n < 2; ++n) { const int c = col0 + bj * HALF + n * 16; if (c < 576) { const f32x4 y = acc[ai][bj][m][n] * r; u32x2 w; w.x = cvt_pk_bf16(y[0], y[1]); w.y = cvt_pk_bf16(y[2], y[3]); *(PG8_G u32x2*)(QRAW + (size_t)row * 576 + c) = w; } }
            }
    }
};

struct EpiUkv {
    static constexpr bool PERM = true, AFTER_DRAIN = false, HOOK = false;
    PG8_G unsigned char* ws; const PG8_G float* gk;
    __device__ __forceinline__ void hook(f32x4 (&)[2][2][4][2], const Unit&, int, int, int, int, int) const {}
    __device__ __forceinline__ void operator()(const f32x4 (&acc)[2][2][4][2], const Unit& u, int wr, int wc, int fr, int fq) const {
        PG8_G bf16_t* KA = (PG8_G bf16_t*)(ws + WS_KA); PG8_G bf16_t* VA = (PG8_G bf16_t*)(ws + WS_VA); const PG8_G float* ssqckv = (const PG8_G float*)(ws + WS_SSQC) + (size_t)MROWS_ * 4; const PG8_G float* ssqkpe = (const PG8_G float*)(ws + WS_SSQC) + (size_t)MROWS_ * 6;
        const PG8_G float* kpe = (const PG8_G float*)(ws + WS_KPE); const PG8_G float* cs = (const PG8_G float*)(ws + WS_CS);
        const int h = 2 * u.pn + (wc >> 1); const bool isv = (wc & 1) != 0;
        f32x4 gn[2][2], g1 = {1.f, 1.f, 1.f, 1.f}, g2 = {1.f, 1.f, 1.f, 1.f};
        if (!isv) {
#pragma unroll
            for (int bj = 0; bj < 2; ++bj)
#pragma unroll
                for (int n = 0; n < 2; ++n) gn[bj][n] = *(const PG8_G f32x4*)(gk + 32 * bj + 8 * fq + 4 * n);
            g1 = *(const PG8_G f32x4*)(gk + 64 + 4 * fq); g2 = *(const PG8_G f32x4*)(gk + 80 + 4 * fq);
        }
#pragma unroll
        for (int ai = 0; ai < 2; ++ai)
#pragma unroll
            for (int m = 0; m < 4; ++m) {
                const int row = u.pm * BM + ai * HALF + wr * 64 + m * 16 + fr;
                const float r = 1.0f / sqrtf((ssqckv[(size_t)row * 2] + ssqckv[(size_t)row * 2 + 1]) * (1.0f / 128.0f) + RMS_EPS);
                f32x4 v[2][2]; float ss = 0.f;
#pragma unroll
                for (int bj = 0; bj < 2; ++bj)
#pragma unroll
                    for (int n = 0; n < 2; ++n) { v[bj][n] = acc[ai][bj][m][n] * r; ss += sq4(v[bj][n]); }
                if (isv) {
#pragma unroll
                    for (int bj = 0; bj < 2; ++bj) { u32x4 w; w.x = cvt_pk_bf16(v[bj][0][0], v[bj][0][1]); w.y = cvt_pk_bf16(v[bj][0][2], v[bj][0][3]); w.z = cvt_pk_bf16(v[bj][1][0], v[bj][1][1]); w.w = cvt_pk_bf16(v[bj][1][2], v[bj][1][3]);
                        *(PG8_G u32x4*)(VA + ((size_t)(row >> 6) * 6 + h) * 4096 + bj * 2048 + (row & 63) * 32 + 8 * fq) = w; }
                } else {
                    ss = xsum32(xsum16(ss));
                    const float rk = 1.0f / sqrtf((ss + ssqkpe[row]) * (1.0f / 96.0f) + RMS_EPS);
                    PG8_G bf16_t* kd = KA + ((size_t)(row >> 6) * 6 + h) * 6144 + (row & 63) * 8;
#pragma unroll
                    for (int bj = 0; bj < 2; ++bj) { const f32x4 y0 = v[bj][0] * gn[bj][0] * rk, y1 = v[bj][1] * gn[bj][1] * rk;
                        u32x4 w; w.x = cvt_pk_bf16(y0[0], y0[1]); w.y = cvt_pk_bf16(y0[2], y0[3]); w.z = cvt_pk_bf16(y1[0], y1[1]); w.w = cvt_pk_bf16(y1[2], y1[3]);
                        *(PG8_G u32x4*)(kd + (4 * bj + fq) * 512) = w; }
                    const f32x4 x1 = *(const PG8_G f32x4*)(kpe + (size_t)row * 32 + 4 * fq) * g1 * rk, x2 = *(const PG8_G f32x4*)(kpe + (size_t)row * 32 + 16 + 4 * fq) * g2 * rk;
                    const f32x4 c = *(const PG8_G f32x4*)(cs + (size_t)row * 32 + 4 * fq), s = *(const PG8_G f32x4*)(cs + (size_t)row * 32 + 16 + 4 * fq);
                    const f32x4 o1 = x1 * c - x2 * s, o2 = x2 * c + x1 * s;
                    u32x2 w1, w2; w1.x = cvt_pk_bf16(o1[0], o1[1]); w1.y = cvt_pk_bf16(o1[2], o1[3]); w2.x = cvt_pk_bf16(o2[0], o2[1]); w2.y = cvt_pk_bf16(o2[2], o2[3]);
                    *(PG8_G u32x2*)(kd + (8 + (fq >> 1)) * 512 + (fq & 1) * 4) = w1; *(PG8_G u32x2*)(kd + (10 + (fq >> 1)) * 512 + (fq & 1) * 4) = w2;
                }
                if (m & 1) PG8_FENCE();
            }
    }
};
}
#define GAS __attribute__((address_space(1)))
#define LAS __attribute__((address_space(3)))
typedef unsigned short bf16;
typedef unsigned v4u __attribute__((ext_vector_type(4)));
typedef float f32x4 __attribute__((ext_vector_type(4)));
typedef short bf16x8 __attribute__((ext_vector_type(8)));
typedef GAS unsigned gu32;
typedef GAS unsigned long long gu64;
#define RLX_AGENT __ATOMIC_RELAXED, __HIP_MEMORY_SCOPE_AGENT
#define LDS_WAIT() asm volatile("s_waitcnt lgkmcnt(0)" ::: "memory")
#define VM_WAIT() asm volatile("s_waitcnt vmcnt(0)" ::: "memory")
__device__ __forceinline__ unsigned long long rt() { return __builtin_amdgcn_s_memrealtime(); }
__device__ __forceinline__ unsigned f2bf(float f) { unsigned u = __builtin_bit_cast(unsigned, f); return (u + 0x7fffu + ((u >> 16) & 1u)) >> 16; }
__device__ __forceinline__ unsigned pk2(float lo, float hi) { return f2bf(lo) | (f2bf(hi) << 16); }

#define XB_TMO      128
#define XB_XCNT(j)  (256  + 64 * (j))
#define XB_XSUB(j)  (1280 + 64 * (j))
#define XB_XGEN(j)  (2304 + 64 * (j))
#define XB_TOP      3328
#define XB_TOPGEN   3392
#define XCD_BAR_WORDS 3456
#define XB_SPIN_CAP (1u << 18)

__device__ __forceinline__ unsigned xb_ld(unsigned* p)              { return __hip_atomic_load(p, __ATOMIC_RELAXED, __HIP_MEMORY_SCOPE_AGENT); }
__device__ __forceinline__ unsigned xb_add(unsigned* p, unsigned v) { return __hip_atomic_fetch_add(p, v, __ATOMIC_RELAXED, __HIP_MEMORY_SCOPE_AGENT); }
__device__ __forceinline__ unsigned xb_xcc_id() { return (unsigned)__builtin_amdgcn_s_getreg((3 << 11) | 20) & 0xFu; }
#define XB_SPIN(cond, bar) do { unsigned _sp = 0; while (cond) { __builtin_amdgcn_s_sleep(1); \
    if ((++_sp & 255u) == 0u) { if (xb_ld(&(bar)[XB_TMO])) break; if (_sp > XB_SPIN_CAP) { atomicAdd(&(bar)[XB_TMO], 1u); break; } } } } while (0)

struct XcdBarrier {
    unsigned* bar; unsigned x;
    volatile LAS unsigned* st;
};

__device__ __forceinline__ XcdBarrier xcd_barrier_post(unsigned* bar, volatile LAS unsigned* st) {
    XcdBarrier b; b.bar = bar; b.x = xb_xcc_id(); b.st = st;
    if (threadIdx.x == 0) (void)xb_add(&bar[XB_XCNT(b.x)], 1u);
    return b;
}
__device__ __forceinline__ void xcd_barrier_complete(unsigned* bar, unsigned x, unsigned& nloc, unsigned& nx) {
    const unsigned G = gridDim.x * gridDim.y * gridDim.z;
    unsigned sum, cnt, mine, sp = 0u;
    for (;;) {
        sum = 0u; cnt = 0u; mine = 0u;
#pragma unroll
        for (unsigned j = 0; j < 16; ++j) { const unsigned c = xb_ld(&bar[XB_XCNT(j)]); sum += c; cnt += (c > 0u) ? 1u : 0u; mine = (j == x) ? c : mine; }
        if (sum == G) break;
        __builtin_amdgcn_s_sleep(1);
        if ((++sp & 255u) == 0u) { if (xb_ld(&bar[XB_TMO])) break; if (sp > XB_SPIN_CAP) { atomicAdd(&bar[XB_TMO], 1u); break; } }
    }
    nloc = mine > 0u ? mine : 1u; nx = cnt > 0u ? cnt : 1u;
}

__device__ __forceinline__ void xcd_barrier(const XcdBarrier& b) {
    asm volatile("s_waitcnt vmcnt(0)" ::: "memory");
    __syncthreads();
    if (threadIdx.x == 0) {
        unsigned* bar = b.bar;
        __builtin_amdgcn_s_waitcnt(0);
        unsigned nloc = b.st[0], nx = b.st[1];
        if (nloc == 0u) { xcd_barrier_complete(bar, b.x, nloc, nx); b.st[0] = nloc; b.st[1] = nx; }
        const unsigned old = xb_add(&bar[XB_XSUB(b.x)], 1u);
        const unsigned gen = old / nloc;
        if (old + 1u == (gen + 1u) * nloc) {
            __builtin_amdgcn_fence(__ATOMIC_RELEASE, "agent");
            asm volatile("s_waitcnt vmcnt(0)" ::: "memory");
            const unsigned og = xb_add(&bar[XB_TOP], 1u);
            const unsigned tg = og / nx;
            if (og + 1u == (tg + 1u) * nx) xb_add(&bar[XB_TOPGEN], 1u);
            else XB_SPIN(xb_ld(&bar[XB_TOPGEN]) == tg, bar);
            __builtin_amdgcn_fence(__ATOMIC_ACQUIRE, "agent");
            xb_add(&bar[XB_XGEN(b.x)], 1u);
            asm volatile("s_waitcnt vmcnt(0)" ::: "memory");
        } else {
            XB_SPIN(xb_ld(&bar[XB_XGEN(b.x)]) == gen, bar);
            __builtin_amdgcn_fence(__ATOMIC_ACQUIRE, "agent");
            asm volatile("s_waitcnt vmcnt(0)" ::: "memory");
        }
    }
    __syncthreads();
}
namespace att {
typedef unsigned short bf16_t;
typedef short bf16x8 __attribute__((ext_vector_type(8)));
typedef short s16x4 __attribute__((ext_vector_type(4)));
typedef short v4i16_t __attribute__((ext_vector_type(4)));
typedef float f32x16 __attribute__((ext_vector_type(16)));
typedef float f32x4 __attribute__((ext_vector_type(4)));
typedef float f32x2 __attribute__((ext_vector_type(2)));
typedef __bf16 bf16x2_t __attribute__((ext_vector_type(2)));
typedef unsigned u32x4 __attribute__((ext_vector_type(4)));
typedef int i32x4 __attribute__((ext_vector_type(4)));
#define ALAS __attribute__((address_space(3)))
#define AGAS __attribute__((address_space(1)))
constexpr int SEQ = 8192;
constexpr float LOG2E = 1.4426950408889634f, EPS = 1e-6f;
constexpr int KCS = 1040, VHS = 4160;
constexpr int KSLOT = 12 * KCS, VSLOT = 2 * VHS;
constexpr int L_K = 0, L_V = 3 * KSLOT, L_POS = L_V + 4 * VSLOT, L_TB = L_POS + 1024, L_WSF = L_TB + 128, L_OST = L_WSF + 8 * 256, L_FLAG = L_OST + 8 * 4096, L_END = L_FLAG + 16 + 64;
static_assert(L_OST % 16 == 0 && L_V % 16 == 0 && L_END <= 131072, "attention LDS map");

__device__ __forceinline__ int crow(int r, int hi) { return (r & 3) + 8 * (r >> 2) + 4 * hi; }
__device__ __forceinline__ unsigned cvtpk(float lo, float hi) { f32x2 v = {lo, hi}; bf16x2_t b = __builtin_convertvector(v, bf16x2_t); return __builtin_bit_cast(unsigned, b); }
__device__ __forceinline__ s16x4 vtr(const ALAS unsigned char* p) { return __builtin_bit_cast(s16x4, __builtin_amdgcn_ds_read_tr16_b64_v4i16((ALAS v4i16_t*)p)); }
__device__ __forceinline__ float swap_sum(float x) { auto rr = __builtin_amdgcn_permlane32_swap(__float_as_uint(x), __float_as_uint(x), false, false); return __uint_as_float(rr[0]) + __uint_as_float(rr[1]); }
__device__ __forceinline__ float swap_max(float x) { auto rr = __builtin_amdgcn_permlane32_swap(__float_as_uint(x), __float_as_uint(x), false, false); return fmaxf(__uint_as_float(rr[0]), __uint_as_float(rr[1])); }
__device__ __forceinline__ float bf2f(unsigned short h) { return __uint_as_float((unsigned)h << 16); }

__device__ __forceinline__ void glds16(const AGAS void* gsrc, unsigned lds_dst) { unsigned keep;
    asm volatile("s_mov_b32 %0, m0\n\ts_mov_b32 m0, %2\n\ts_nop 0\n\tglobal_load_lds_dwordx4 %1, off\n\ts_mov_b32 m0, %0" : "=&s"(keep) : "v"(gsrc), "s"(lds_dst) : "memory"); }
__device__ __forceinline__ void glds4(const AGAS void* gsrc, unsigned lds_dst) { unsigned keep;
    asm volatile("s_mov_b32 %0, m0\n\ts_mov_b32 m0, %2\n\ts_nop 0\n\tglobal_load_lds_dword %1, off\n\ts_mov_b32 m0, %0" : "=&s"(keep) : "v"(gsrc), "s"(lds_dst) : "memory"); }

struct AttnP {
    AGAS unsigned char* ws;
    const AGAS float* gq;
    const AGAS int* pos; const AGAS float* sinks; const AGAS float* relb;
};
template <int MODE> struct AttnCfg;
template <> struct AttnCfg<0> { static constexpr size_t Q = WS_QRAW, K = WS_KA, V = WS_VA; static constexpr int qpitch = 576, kpitch = 576, khs = 96, vpitch = 384, vhs = 64, ocol0 = 0, hidx0 = 0, group = 1; };
template <> struct AttnCfg<1> { static constexpr size_t Q = WS_QS, K = WS_KS, V = WS_VS; static constexpr int qpitch = 384, kpitch = 128, khs = 64, vpitch = 128, vhs = 64, ocol0 = 384, hidx0 = 6, group = 3; };
template <> struct AttnCfg<2> { static constexpr size_t Q = WS_QC, K = WS_KC, V = WS_VC; static constexpr int qpitch = 256, kpitch = 256, khs = 64, vpitch = 256, vhs = 64, ocol0 = 768, hidx0 = 12, group = 1; };

#ifdef ATT_PROF
#define PROF_T() ((MODE == 0 && blockIdx.x == 0) ? (long long)clock64() : 0ll)
#else
#define PROF_T() 0ll
#endif
template <int DQK, int MODE>
__device__ __forceinline__ void attn_unit(ALAS unsigned char* lds, const AttnP& P, int b, int h, int qb, unsigned long long* prof = nullptr) {
    long long pf_qk = 0, pf_sm = 0, pf_pv = 0, pf_wait = 0; const long long pf_t0 = PROF_T();
    constexpr int NCH = DQK / 8, ND0 = DQK / 16;
    int tid_ = threadIdx.x; asm volatile("" : "+v"(tid_));
    const int tid = tid_, lane = tid & 63, r32 = lane & 31, hi = lane >> 5;
    const int wid = __builtin_amdgcn_readfirstlane(tid >> 6);
    const int q0 = qb * 256, qlo = q0 + 32 * wid, qhi = qlo + 31, qrow = qlo + r32;
    const size_t rb = (size_t)b * SEQ;
    typedef AttnCfg<MODE> C; const int kvh = h / C::group;
    ALAS float* wsf = (ALAS float*)(lds + L_WSF) + wid * 64;
    ALAS unsigned char* ost = lds + L_OST + wid * 4096;
    ALAS int* posl = (ALAS int*)(lds + L_POS);
    ALAS float* tb = (ALAS float*)(lds + L_TB);

    bf16x8 qf[ND0];
    if constexpr (MODE == 0) {
        const AGAS bf16_t* qp = (const AGAS bf16_t*)(P.ws + C::Q) + (rb + qrow) * 576 + h * 96 + hi * 8;
        float qv[ND0][8]; float ss = 0.f;
#pragma unroll
        for (int d0 = 0; d0 < ND0; ++d0) { const u32x4 w = *(const AGAS u32x4*)(qp + 16 * d0);
#pragma unroll
            for (int i = 0; i < 4; ++i) { const float lo = __uint_as_float(w[i] << 16), hv = __uint_as_float(w[i] & 0xffff0000u); qv[d0][2 * i] = lo; qv[d0][2 * i + 1] = hv; ss += lo * lo + hv * hv; } }
        ss = swap_sum(ss);
        const float rq = 1.0f / sqrtf(ss * (1.0f / 96.0f) + EPS);
#pragma unroll
        for (int d0 = 0; d0 < ND0; ++d0) { const f32x4 ga = *(const AGAS f32x4*)(P.gq + 16 * d0 + 8 * hi), gb = *(const AGAS f32x4*)(P.gq + 16 * d0 + 8 * hi + 4);
#pragma unroll
            for (int i = 0; i < 4; ++i) { qv[d0][i] *= rq * ga[i]; qv[d0][4 + i] *= rq * gb[i]; } }
        {
            const AGAS float* cp = (const AGAS float*)(P.ws + WS_CS) + (rb + qrow) * 32 + 8 * hi;
            const f32x4 c0 = *(const AGAS f32x4*)cp, c1 = *(const AGAS f32x4*)(cp + 4), s0 = *(const AGAS f32x4*)(cp + 16), s1 = *(const AGAS f32x4*)(cp + 20);
#pragma unroll
            for (int i = 0; i < 8; ++i) { const float c = i < 4 ? c0[i & 3] : c1[i & 3], s = i < 4 ? s0[i & 3] : s1[i & 3]; const float x1 = qv[4][i], x2 = qv[5][i]; qv[4][i] = x1 * c - x2 * s; qv[5][i] = x2 * c + x1 * s; }
        }
        const float sc = 0.10206207261596575f * LOG2E;
#pragma unroll
        for (int d0 = 0; d0 < ND0; ++d0) { u32x4 w; w.x = cvtpk(qv[d0][0] * sc, qv[d0][1] * sc); w.y = cvtpk(qv[d0][2] * sc, qv[d0][3] * sc); w.z = cvtpk(qv[d0][4] * sc, qv[d0][5] * sc); w.w = cvtpk(qv[d0][6] * sc, qv[d0][7] * sc); qf[d0] = __builtin_bit_cast(bf16x8, w); }
    } else {
        const AGAS bf16_t* qp = (const AGAS bf16_t*)(P.ws + C::Q) + (rb + qrow) * C::qpitch + h * 64 + hi * 8;
#pragma unroll
        for (int d0 = 0; d0 < ND0; ++d0) qf[d0] = *(const AGAS bf16x8*)(qp + 16 * d0);
    }
    int posq = 0; float sink2 = 0.f;
    if constexpr (MODE == 1) {
        posq = P.pos[rb + qrow]; sink2 = P.sinks[h] * LOG2E;
        if (tid < 32) tb[tid] = P.relb[tid * 6 + h] * LOG2E;
    }

    int ntile, tfirst, tstep;
    if (MODE == 0) { tfirst = 0; tstep = 1; ntile = ((q0 + 255) >> 6) + 1; }
    else if (MODE == 1) { const int lo = q0 - 127 > 0 ? q0 - 127 : 0; tfirst = lo >> 6; tstep = 1; ntile = ((q0 + 255) >> 6) - tfirst + 1; }
    else { tfirst = (q0 + 254) >> 6; tstep = -1; ntile = tfirst + 1; }

    const AGAS bf16_t* Kg = (const AGAS bf16_t*)(P.ws + C::K) + rb * C::kpitch + kvh * C::khs;
    const AGAS bf16_t* Vg = (const AGAS bf16_t*)(P.ws + C::V) + rb * C::vpitch + kvh * C::vhs;
    const unsigned lds0 = (unsigned)(uintptr_t)lds;
    const AGAS bf16_t* ksrc0 = (MODE == 0) ? (const AGAS bf16_t*)(P.ws + C::K) + ((size_t)b * 128 * 6 + h) * 6144 + wid * 512 + lane * 8 : Kg + (size_t)lane * C::kpitch + 8 * wid;
    const AGAS bf16_t* vsrc = (MODE == 0) ? (const AGAS bf16_t*)(P.ws + C::V) + ((size_t)b * 128 * 6 + h) * 4096 + (wid >> 2) * 2048 + (wid & 3) * 512 + lane * 8
                                          : Vg + (size_t)(16 * (wid & 3) + (lane >> 2)) * C::vpitch + 32 * (wid >> 2) + 8 * (lane & 3);
    constexpr size_t KTS = (MODE == 0) ? (size_t)6 * 6144 : (size_t)64 * C::kpitch, VTS = (MODE == 0) ? (size_t)6 * 4096 : (size_t)64 * C::vpitch, K2O = (MODE == 0) ? 8 * 512 : 64;
    const bool k2 = (wid + 8) < NCH;
    const bool posw = (MODE == 1) && wid == 0;
    const int NP = 2 + (k2 ? 1 : 0) + (posw ? 1 : 0);
#define ATT_ISSUE(T, IT) do { const int T_ = (T); const size_t jo_ = (size_t)T_ * 64; const int ks_ = (IT) % 3, vs_ = (IT) & 3;     \
        glds16(ksrc0 + (size_t)T_ * KTS, (unsigned)__builtin_amdgcn_readfirstlane(lds0 + L_K + ks_ * KSLOT + wid * KCS)); \
        if (k2) glds16(ksrc0 + (size_t)T_ * KTS + K2O, (unsigned)__builtin_amdgcn_readfirstlane(lds0 + L_K + ks_ * KSLOT + (wid + 8) * KCS)); \
        glds16(vsrc + (size_t)T_ * VTS, (unsigned)__builtin_amdgcn_readfirstlane(lds0 + L_V + vs_ * VSLOT + (wid >> 2) * VHS + (wid & 3) * 1024)); \
        if (posw) glds4(P.pos + rb + jo_ + lane, (unsigned)__builtin_amdgcn_readfirstlane(lds0 + L_POS + vs_ * 256)); } while (0)
#define ATT_WAIT_BAR(n_) do { if ((n_) <= 0) asm volatile("s_waitcnt vmcnt(0) lgkmcnt(0)\n\ts_barrier" ::: "memory"); \
        else if (NP == 2) asm volatile("s_waitcnt vmcnt(2) lgkmcnt(0)\n\ts_barrier" ::: "memory"); \
        else if (NP == 3) asm volatile("s_waitcnt vmcnt(3) lgkmcnt(0)\n\ts_barrier" ::: "memory"); \
        else asm volatile("s_waitcnt vmcnt(4) lgkmcnt(0)\n\ts_barrier" ::: "memory"); } while (0)

    f32x16 o0 = {}, o1 = {};
    float mrun = (MODE == 1) ? sink2 : 0.f;
    float lrun = (MODE == 1 && hi == 0) ? 1.0f : 0.f;
    f32x16 negm;
#pragma unroll
    for (int r = 0; r < 16; ++r) negm[r] = (MODE == 2) ? 0.f : -mrun;
    bool first = (MODE == 0);
    float after = 0.f;
    bool walive = true;
    const int vrd = ((lane >> 4) & 1) * 32 + (lane & 3) * 8 + (4 * hi + ((lane & 15) >> 2)) * 64;
    const bool lag = wid >= 4;
    constexpr float THR = 4.0f;

#define ATT_QK(P0, P1, kb) do { int kofs_ = L_K + (kb) * KSLOT + hi * KCS + r32 * 16; asm volatile("" : "+v"(kofs_)); const ALAS unsigned char* Kb_ = lds + kofs_;     \
        bf16x8 kfa_[4], kfb_[4]; \
        _Pragma("unroll") for (int d0 = 0; d0 < 3; ++d0) { kfa_[d0] = *(const ALAS bf16x8*)(Kb_ + 2 * d0 * KCS); kfb_[d0] = *(const ALAS bf16x8*)(Kb_ + 2 * d0 * KCS + 512); } \
        \
        _Pragma("unroll") for (int d0 = 0; d0 < ND0; ++d0) { \
            if (d0 + 3 < ND0) { kfa_[(d0 + 3) & 3] = *(const ALAS bf16x8*)(Kb_ + 2 * (d0 + 3) * KCS); kfb_[(d0 + 3) & 3] = *(const ALAS bf16x8*)(Kb_ + 2 * (d0 + 3) * KCS + 512); } \
            if (d0 == 0) { P0 = __builtin_amdgcn_mfma_f32_32x32x16_bf16(kfa_[0], qf[0], negm, 0, 0, 0); P1 = __builtin_amdgcn_mfma_f32_32x32x16_bf16(kfb_[0], qf[0], negm, 0, 0, 0); } \
            else { P0 = __builtin_amdgcn_mfma_f32_32x32x16_bf16(kfa_[d0 & 3], qf[d0], P0, 0, 0, 0); P1 = __builtin_amdgcn_mfma_f32_32x32x16_bf16(kfb_[d0 & 3], qf[d0], P1, 0, 0, 0); } \
            } } while (0)
#define ATT_VLD(i_, s_) do { vl0_[i_] = vtr(Vb_ + (s_) * 1024); vh0_[i_] = vtr(Vb_ + (s_) * 1024 + 512); vl1_[i_] = vtr(Vb_ + VHS + (s_) * 1024); vh1_[i_] = vtr(Vb_ + VHS + (s_) * 1024 + 512); } while (0)
#define ATT_PV(vb) do { int vofs_ = L_V + (vb) * VSLOT + vrd; asm volatile("" : "+v"(vofs_)); const ALAS unsigned char* Vb_ = lds + vofs_; \
        s16x4 vl0_[2], vh0_[2], vl1_[2], vh1_[2]; ATT_VLD(0, 0); \
        _Pragma("unroll") for (int s_ = 0; s_ < 4; ++s_) { \
            if (s_ + 1 < 4) ATT_VLD((s_ + 1) & 1, s_ + 1); \
            const int i_ = s_ & 1; const bf16x8 pa_ = __builtin_bit_cast(bf16x8, pw[s_]); \
            const bf16x8 v0_ = {vl0_[i_][0], vl0_[i_][1], vl0_[i_][2], vl0_[i_][3], vh0_[i_][0], vh0_[i_][1], vh0_[i_][2], vh0_[i_][3]}, v1_ = {vl1_[i_][0], vl1_[i_][1], vl1_[i_][2], vl1_[i_][3], vh1_[i_][0], vh1_[i_][1], vh1_[i_][2], vh1_[i_][3]}; \
            o0 = __builtin_amdgcn_mfma_f32_32x32x16_bf16(pa_, v0_, o0, 0, 0, 0); o1 = __builtin_amdgcn_mfma_f32_32x32x16_bf16(pa_, v1_, o1, 0, 0, 0); } } while (0)
#define ATT_PACK(P0, P1) do { \
        pw[0].x = cvtpk(P0[0], P0[1]); pw[0].y = cvtpk(P0[2], P0[3]); pw[0].z = cvtpk(P0[4], P0[5]); pw[0].w = cvtpk(P0[6], P0[7]); \
        pw[1].x = cvtpk(P0[8], P0[9]); pw[1].y = cvtpk(P0[10], P0[11]); pw[1].z = cvtpk(P0[12], P0[13]); pw[1].w = cvtpk(P0[14], P0[15]); \
        pw[2].x = cvtpk(P1[0], P1[1]); pw[2].y = cvtpk(P1[2], P1[3]); pw[2].z = cvtpk(P1[4], P1[5]); pw[2].w = cvtpk(P1[6], P1[7]); \
        pw[3].x = cvtpk(P1[8], P1[9]); pw[3].y = cvtpk(P1[10], P1[11]); pw[3].z = cvtpk(P1[12], P1[13]); pw[3].w = cvtpk(P1[14], P1[15]); } while (0)
#define ATT_MAX3(a, b, c) fmaxf(fmaxf((a), (b)), (c))
#define ATT_SM_A(P0, P1, j0_, pslot) do { if constexpr (MODE != 2) { \
            if constexpr (MODE == 1) { \
                _Pragma("unroll") for (int g = 0; g < 4; ++g) { \
                    const i32x4 pa = *(const ALAS i32x4*)(posl + (pslot) * 64 + 8 * g + 4 * hi), pb = *(const ALAS i32x4*)(posl + (pslot) * 64 + 32 + 8 * g + 4 * hi); \
                    _Pragma("unroll") for (int i = 0; i < 4; ++i) { \
                        { int n = posq - pa[i]; n = n > 0 ? n : 0; int bk = n; if (n >= 16) { bk = 16 + (int)((__builtin_amdgcn_logf((float)n) - 4.0f) * (16.0f / 3.0f)); bk = bk < 31 ? bk : 31; } P0[4 * g + i] += tb[bk]; } \
                        { int n = posq - pb[i]; n = n > 0 ? n : 0; int bk = n; if (n >= 16) { bk = 16 + (int)((__builtin_amdgcn_logf((float)n) - 4.0f) * (16.0f / 3.0f)); bk = bk < 31 ? bk : 31; } P1[4 * g + i] += tb[bk]; } } } } \
            const bool nm_ = (MODE == 1) || ((j0_) + 63 > qlo); \
            if (nm_) { \
                _Pragma("unroll") for (int r = 0; r < 16; ++r) { const int key = (j0_) + crow(r, hi); \
                    bool ok0 = key <= qrow, ok1 = key + 32 <= qrow; \
                    if (MODE == 1) { ok0 = ok0 && (key > qrow - 128); ok1 = ok1 && (key + 32 > qrow - 128); } \
                    if (!ok0) P0[r] = -INFINITY; if (!ok1) P1[r] = -INFINITY; } } \
            float ma = ATT_MAX3(P0[0], P0[1], P1[0]), mb = ATT_MAX3(P0[2], P0[3], P1[1]); ma = ATT_MAX3(ma, P1[2], P1[3]); \
            _Pragma("unroll") for (int r = 4; r < 16; r += 4) { ma = ATT_MAX3(ma, P0[r], P0[r + 1]); mb = ATT_MAX3(mb, P0[r + 2], P0[r + 3]); ma = ATT_MAX3(ma, P1[r], P1[r + 1]); mb = ATT_MAX3(mb, P1[r + 2], P1[r + 3]); } \
            const float mt = swap_max(fmaxf(ma, mb)); \
            if (first || __any(mt > THR)) {                                 \
                const float d = first ? mt : fmaxf(mt, 0.f); first = false; \
                _Pragma("unroll") for (int r = 0; r < 16; ++r) { P0[r] -= d; P1[r] -= d; } \
                const float alpha = __builtin_amdgcn_exp2f(-d); mrun += d; lrun *= alpha; \
                _Pragma("unroll") for (int r = 0; r < 16; ++r) negm[r] = -mrun; \
                if (hi == 0) wsf[r32] = alpha; \
                _Pragma("unroll") for (int g = 0; g < 4; ++g) { const f32x4 al = *(const ALAS f32x4*)(wsf + 8 * g + 4 * hi); \
                    _Pragma("unroll") for (int i = 0; i < 4; ++i) { o0[4 * g + i] *= al[i]; o1[4 * g + i] *= al[i]; } } } } } while (0)
#define ATT_SM_B(P0, P1, j0_) do { \
        if constexpr (MODE == 2) { \
            const bool nm_ = (j0_) + 63 >= qlo; \
            float ln0[16], ln1[16]; \
            _Pragma("unroll") for (int r = 0; r < 16; ++r) { const int key = (j0_) + crow(r, hi); \
                { const float z = P0[r]; const float sp = fmaxf(z, 0.f) + __builtin_amdgcn_logf(1.0f + __builtin_amdgcn_exp2f(-fabsf(z))); const bool ok = !nm_ || key < qrow; ln0[r] = ok ? -sp : 0.f; P0[r] = ok ? z - sp : -INFINITY; } \
                { const float z = P1[r]; const float sp = fmaxf(z, 0.f) + __builtin_amdgcn_logf(1.0f + __builtin_amdgcn_exp2f(-fabsf(z))); const bool ok = !nm_ || key + 32 < qrow; ln1[r] = ok ? -sp : 0.f; P1[r] = ok ? z - sp : -INFINITY; } } \
            float run = after; \
            _Pragma("unroll") for (int blk = 1; blk >= 0; --blk) _Pragma("unroll") for (int g = 3; g >= 0; --g) { \
                const float own = blk ? ((ln1[4 * g] + ln1[4 * g + 1]) + (ln1[4 * g + 2] + ln1[4 * g + 3])) : ((ln0[4 * g] + ln0[4 * g + 1]) + (ln0[4 * g + 2] + ln0[4 * g + 3])); \
                auto rr = __builtin_amdgcn_permlane32_swap(__float_as_uint(own), __float_as_uint(own), false, false); \
                const float slo = __uint_as_float(rr[0]), shi = __uint_as_float(rr[1]); \
                const float e1 = run; run += shi; const float e0 = run; run += slo; \
                float aft = hi ? e1 : e0; \
                _Pragma("unroll") for (int i = 3; i >= 0; --i) { const int r = 4 * g + i; \
                    if (blk) { P1[r] = __builtin_amdgcn_exp2f(P1[r] + aft); aft += ln1[r]; } else { P0[r] = __builtin_amdgcn_exp2f(P0[r] + aft); aft += ln0[r]; } } } \
            after = run; walive = __any(after > -160.0f); \
        } else { \
            float ls = 0.f; \
            _Pragma("unroll") for (int r = 0; r < 16; ++r) { P0[r] = __builtin_amdgcn_exp2f(P0[r]); P1[r] = __builtin_amdgcn_exp2f(P1[r]); ls += P0[r] + P1[r]; } \
            lrun += ls; } \
        ATT_PACK(P0, P1); } while (0)
#define ATT_WORK(j0_) ((MODE == 0) ? ((j0_) <= qhi) : (MODE == 1) ? (((j0_) <= qhi) && ((j0_) + 63 >= qlo - 127)) : (walive && ((j0_) < qhi)))

    f32x16 p0, p1, n0, n1; u32x4 pw[4];
    __syncthreads();
    int issued = 0;
    ATT_ISSUE(tfirst, 0);
    if (ntile > 1) { ATT_ISSUE(tfirst + tstep, 1); issued = 1; }
    if (ntile > 2) { ATT_ISSUE(tfirst + 2 * tstep, 2); issued = 2; }
    ATT_WAIT_BAR(issued - 1);
    bool wcur = ATT_WORK(tfirst * 64);
    if (wcur) ATT_QK(p0, p1, 0);
    asm volatile("s_waitcnt lgkmcnt(0)\n\ts_barrier" ::: "memory");
    int nt = ntile;
    for (int it = 0; it < nt; ++it) {
        const int t = tfirst + it * tstep, j0 = t * 64, jn = (t + tstep) * 64;
        if (it + 3 < ntile) { ATT_ISSUE(t + 3 * tstep, it + 3); issued = it + 3; }
        if (wcur) ATT_SM_A(p0, p1, j0, it & 3);
        const bool wnext = (it + 1 < nt) && ATT_WORK(jn);
        if (wcur && wnext) { ATT_QK(n0, n1, (it + 1) % 3); ATT_SM_B(p0, p1, j0); }
        else { if (wnext) ATT_QK(n0, n1, (it + 1) % 3); if (wcur) ATT_SM_B(p0, p1, j0); }
        if (wcur) ATT_PV(it & 3);
        p0 = n0; p1 = n1; wcur = wnext;
        if (MODE == 2) { ALAS int* fl = (ALAS int*)(lds + L_FLAG + 16) + (it & 1) * 8; if (lane == 0) fl[wid] = (walive && j0 > 0) ? 1 : 0; }
        ATT_WAIT_BAR(issued - (it + 2));
        if (MODE == 2) { const ALAS int* fl = (const ALAS int*)(lds + L_FLAG + 16) + (it & 1) * 8;
            const i32x4 fa = *(const ALAS i32x4*)fl, fb = *(const ALAS i32x4*)(fl + 4);
            if (((fa[0] | fa[1]) | (fa[2] | fa[3]) | (fb[0] | fb[1]) | (fb[2] | fb[3])) == 0) nt = it + 1; }
    }
    if (MODE == 2) asm volatile("s_waitcnt vmcnt(0)" ::: "memory");
#undef ATT_ISSUE
#undef ATT_WAIT_BAR
#undef ATT_QK
#undef ATT_PV
#undef ATT_PACK
#undef ATT_VLD
#undef ATT_SM_A
#undef ATT_SM_B
#undef ATT_WORK
#undef ATT_MAX3
    if (MODE != 2) {
        const float lt = swap_sum(lrun);
        if (hi == 0) wsf[32 + r32] = 1.0f / lt;
#pragma unroll
        for (int g = 0; g < 4; ++g) { const f32x4 il = *(const ALAS f32x4*)(wsf + 32 + 8 * g + 4 * hi);
#pragma unroll
            for (int i = 0; i < 4; ++i) { o0[4 * g + i] *= il[i]; o1[4 * g + i] *= il[i]; } }
    }
    {
        ALAS bf16_t* stg = (ALAS bf16_t*)ost;
#pragma unroll
        for (int r = 0; r < 16; ++r) { const int orow = crow(r, hi); stg[orow * 64 + r32] = (bf16_t)(cvtpk(o0[r], 0.f) & 0xffffu); stg[orow * 64 + 32 + r32] = (bf16_t)(cvtpk(o1[r], 0.f) & 0xffffu); }
        AGAS bf16_t* Ow = (AGAS bf16_t*)(P.ws + WS_OALL) + (rb + qlo) * 1024 + C::ocol0 + h * 64;
#pragma unroll
        for (int i = 0; i < 4; ++i) {
            const int row = i * 8 + (lane >> 3), ch = lane & 7;
            const u32x4 v = *(const ALAS u32x4*)(stg + row * 64 + ch * 8);
            float ss = 0.f;
#pragma unroll
            for (int k = 0; k < 4; ++k) { const unsigned w = v[k]; const float a = __uint_as_float(w << 16), c = __uint_as_float(w & 0xffff0000u); ss += a * a + c * c; }
            ss += __shfl_xor(ss, 1); ss += __shfl_xor(ss, 2); ss += __shfl_xor(ss, 4);
            *(AGAS u32x4*)(Ow + (size_t)row * 1024 + ch * 8) = v;
            if (ch == 0) ((AGAS float*)(P.ws + WS_SSQO))[(rb + qlo + row) * 16 + C::hidx0 + h] = ss;
        }
    }
#ifdef ATT_PROF
    if (MODE == 0 && blockIdx.x == 0 && wid == ATT_PROF_WAVE && lane == 0 && prof) { const long long tt = PROF_T() - pf_t0;
        atomicAdd(prof + 0, (unsigned long long)tt); atomicAdd(prof + 1, (unsigned long long)pf_qk); atomicAdd(prof + 2, (unsigned long long)pf_sm); atomicAdd(prof + 3, (unsigned long long)pf_pv); atomicAdd(prof + 4, (unsigned long long)pf_wait); atomicAdd(prof + 5, 1ull); }
#endif
}
#undef ALAS
#undef AGAS
}
struct Args { const void* in[23]; float* out; unsigned char* ws; int ph_lo, ph_hi, li, adapt; };

struct Frame { LAS unsigned char* lds; int tid, lane, wave, vcu, G; };

__device__ __forceinline__ float wave_sum64(float v) { return pg8::wave_sum_dpp(v); }

__device__ __forceinline__ void tr_item64(const GAS float* W, int ldn, int K, GAS pg8::bf16_t* WT, int kb, int g, int src0, int src1, const GAS float* kgain, LAS unsigned* scr, int lane) {
    const int k0 = 64 * kb; const int col = lane < 32 ? src0 + lane : src1 + (lane - 32); const bool ok = (lane < 32 ? src0 : src1) >= 0;
    const GAS float* wp = W + (size_t)k0 * ldn + (ok ? col : 0);
#pragma unroll
    for (int hf = 0; hf < 2; ++hf) {
        float v[32];
#pragma unroll
        for (int i = 0; i < 32; ++i) v[i] = wp[(size_t)(hf * 32 + i) * ldn];
#pragma unroll
        for (int i = 0; i < 32; ++i) v[i] = ok ? v[i] : 0.f;
        if (kgain) {
#pragma unroll
            for (int i = 0; i < 32; ++i) v[i] *= kgain[k0 + hf * 32 + i]; }
#pragma unroll
        for (int i = 0; i < 16; ++i) scr[(hf * 16 + i) * 65 + lane] = pk2(v[2 * i], v[2 * i + 1]);
    }
    asm volatile("s_waitcnt lgkmcnt(0)" ::: "memory");
    const int c = lane & 7;
#pragma unroll
    for (int j = 0; j < 8; ++j) { const int n = (lane >> 3) + 8 * j; const LAS unsigned* s = scr + (4 * c) * 65 + n;
        v4u o; o.x = s[0]; o.y = s[65]; o.z = s[130]; o.w = s[195];
        *(GAS v4u*)(WT + (size_t)(64 * g + n) * K + k0 + 8 * c) = o; }
    asm volatile("s_waitcnt lgkmcnt(0)" ::: "memory");
}
__device__ __forceinline__ int in_slot_src(int slot, int& cnt) {
    cnt = 64;
    if (slot < 4) return 64 * slot;
    if (slot < 6) return 256 + 64 * (slot - 4);
    if (slot == 6) { cnt = 32; return 384; }
    if (slot == 7) return -1;
    if (slot < 14) return 416 + 64 * (slot - 8);
    if (slot < 16) return 800 + 64 * (slot - 14);
    if (slot < 18) return 928 + 64 * (slot - 16);
    if (slot < 22) return 1056 + 64 * (slot - 18);
    if (slot < 26) return 1312 + 64 * (slot - 22);
    if (slot < 30) return 1568 + 64 * (slot - 26);
    return -1;
}

#define A_X ((const GAS float*)args.in[0])
#define A_C ((const GAS float*)args.in[1])
#define A_POS ((const GAS int*)args.in[2])
#define A_RELB ((const GAS float*)args.in[3])
#define A_NORMG ((const GAS float*)args.in[4])
#define A_WMOD ((const GAS float*)args.in[5])
#define A_BMOD ((const GAS float*)args.in[6])
#define A_WGU1 ((const GAS float*)args.in[7])
#define A_WD1 ((const GAS float*)args.in[8])
#define A_WIN ((const GAS float*)args.in[9])
#define A_QAN ((const GAS float*)args.in[10])
#define A_KVAN ((const GAS float*)args.in[11])
#define A_WUQ ((const GAS float*)args.in[12])
#define A_WUKV ((const GAS float*)args.in[13])
#define A_MLAQN ((const GAS float*)args.in[14])
#define A_MLAKN ((const GAS float*)args.in[15])
#define A_SWAQN ((const GAS float*)args.in[16])
#define A_SWAKN ((const GAS float*)args.in[17])
#define A_SINKS ((const GAS float*)args.in[18])
#define A_OUTN ((const GAS float*)args.in[19])
#define A_WOUT ((const GAS float*)args.in[20])
#define A_WGU2 ((const GAS float*)args.in[21])
#define A_WD2 ((const GAS float*)args.in[22])
#define WSP(off)   (ws_ + (off))
#define MOD ((GAS float*)WSP(WS_MOD))
#define GS ((GAS float*)WSP(WS_GS))
#define BIAS ((GAS float*)WSP(WS_BIAS))
#define SSQX ((GAS float*)WSP(WS_SSQX))
#define SSQO ((GAS float*)WSP(WS_SSQO))
#define CS ((GAS float*)WSP(WS_CS))
#define KPE ((GAS float*)WSP(WS_KPE))
#define SSQ_CQ ((GAS float*)WSP(WS_SSQC))
#define SSQ_CKV ((GAS float*)WSP(WS_SSQC) + (size_t)MROWS * 4)
#define SSQ_KPE ((GAS float*)WSP(WS_SSQC) + (size_t)MROWS * 6)
#define XB ((GAS pg8::bf16_t*)WSP(WS_XB))
#define HID ((GAS pg8::bf16_t*)WSP(WS_HID))
#define CQ ((GAS pg8::bf16_t*)WSP(WS_CQ))
#define CKV ((GAS pg8::bf16_t*)WSP(WS_CKV))
#define KA ((GAS pg8::bf16_t*)WSP(WS_KA))
#define VA ((GAS pg8::bf16_t*)WSP(WS_VA))
#define QS ((GAS pg8::bf16_t*)WSP(WS_QS))
#define KS ((GAS pg8::bf16_t*)WSP(WS_KS))
#define VS ((GAS pg8::bf16_t*)WSP(WS_VS))
#define QC ((GAS pg8::bf16_t*)WSP(WS_QC))
#define KC ((GAS pg8::bf16_t*)WSP(WS_KC))
#define VC ((GAS pg8::bf16_t*)WSP(WS_VC))
#define OALL ((GAS pg8::bf16_t*)WSP(WS_OALL))
#define QRAW ((GAS float*)WSP(WS_QRAW))

__device__ __forceinline__ int in_group_src(int g32) {
    const int tile = g32 >> 3, rr = g32 & 7, bj = rr >> 2, wc = rr & 3; int cnt; const int base = in_slot_src(tile * 4 + wc, cnt);
    return (base >= 0 && 32 * bj < cnt) ? base + 32 * bj : -1;
}
constexpr int CV_GU = 16 * 88, CV_D = 44 * 16, CV_IN = 16 * 32, CV_UQ = 4 * 12, CV_UKV = 2 * 12, CV_OUT = 16 * 16;
constexpr int CV_EARLY = CV_GU + CV_D + CV_IN + CV_UQ + CV_UKV + CV_OUT, CV_L = CV_EARLY + CV_GU + CV_D, CV_ALL = DEPTH * CV_L;
__device__ __forceinline__ void convert_chunk(Frame& F, const Args& args, int base, int limit) {
    GAS unsigned char* ws_ = (GAS unsigned char*)args.ws; asm volatile("" : "+s"(ws_));
    LAS unsigned* scr = (LAS unsigned*)(F.lds + 16384 + F.wave * 8448);
#pragma unroll 1
    for (int q = 0; q < 2; ++q) {
        const int it = base + F.wave * 2 + q; if (it >= limit) break;
        const int l = it / CV_L; int r = it % CV_L;
        GAS unsigned char* wl = ws_ + WS_W + (size_t)l * WL;
        int kind;
        if (r < CV_GU) kind = 0; else if ((r -= CV_GU) < CV_D) kind = 1; else if ((r -= CV_D) < CV_IN) kind = 2; else if ((r -= CV_IN) < CV_UQ) kind = 3;
        else if ((r -= CV_UQ) < CV_UKV) kind = 4; else if ((r -= CV_UKV) < CV_OUT) kind = 5; else if ((r -= CV_OUT) < CV_GU) kind = 6; else { r -= CV_GU; kind = 7; }
        if (kind == 0 || kind == 6) {
            const bool second = kind == 6; const int kb = r / 88, g = r % 88, t = g >> 2, rr = g & 3, src = (rr >> 1) * DFF + 128 * t + 64 * (rr & 1);
            const GAS float* W = (second ? A_WGU2 : A_WGU1) + (size_t)l * DM * 2 * DFF;
            tr_item64(W, 2 * DFF, DM, (GAS pg8::bf16_t*)(wl + (second ? W_GU2 : W_GU1)), kb, g, src, src + 32, nullptr, scr, F.lane);
        } else if (kind == 1 || kind == 7) { const bool second = kind == 7; const int kb = r / 16, g = r % 16;
            tr_item64((second ? A_WD2 : A_WD1) + (size_t)l * DFF * DM, DM, DFF, (GAS pg8::bf16_t*)(wl + (second ? W_D2 : W_D1)), kb, g, 64 * g, 64 * g + 32, nullptr, scr, F.lane);
        } else if (kind == 2) { const int kb = r / 32, g = r % 32;
            tr_item64(A_WIN + (size_t)l * DM * DIN, DIN, DM, (GAS pg8::bf16_t*)(wl + W_IN), kb, g, in_group_src(2 * g), in_group_src(2 * g + 1), nullptr, scr, F.lane);
        } else if (kind == 3) { const int kb = r / 12, g = r % 12;
            tr_item64(A_WUQ + (size_t)l * 256 * 576, 576, 256, (GAS pg8::bf16_t*)(wl + W_UQ), kb, g, g < 9 ? 64 * g : -1, g < 9 ? 64 * g + 32 : -1, A_QAN + l * 256, scr, F.lane);
        } else if (kind == 4) { const int kb = r / 12, g = r % 12, g0 = 2 * g, g1 = 2 * g + 1;
            tr_item64(A_WUKV + (size_t)l * 128 * 768, 768, 128, (GAS pg8::bf16_t*)(wl + W_UKV), kb, g, 256 * (g0 >> 3) + 64 * (g0 & 3) + 32 * ((g0 & 7) >> 2), 256 * (g1 >> 3) + 64 * (g1 & 3) + 32 * ((g1 & 7) >> 2), A_KVAN + l * 128, scr, F.lane);
        } else { const int kb = r / 16, g = r % 16;
            tr_item64(A_WOUT + (size_t)l * DM * DM, DM, DM, (GAS pg8::bf16_t*)(wl + W_OUT), kb, g, 64 * g, 64 * g + 32, A_OUTN + l * DM, scr, F.lane); }
    }
}

__device__ __forceinline__ void phase_pro0(Frame& F, const Args& args, gu32* qhead) {
    GAS unsigned char* ws_ = (GAS unsigned char*)args.ws; asm volatile("" : "+s"(ws_));
    constexpr int NMU = DEPTH * NMOD / 128;
    if ((int)blockIdx.x < NMU || F.G <= NMU) {
        LAS float* cond = (LAS float*)F.lds;
        LAS float* red = (LAS float*)(F.lds + 8192);
        for (int i = F.tid; i < 2 * DM; i += 512) { const float cv = A_C[i]; cond[i] = cv / (1.0f + expf(-cv)); }
        __syncthreads();
        for (int u = blockIdx.x; u < NMU; u += F.G) {
            const int l = u / (NMOD / 128), n0 = (u % (NMOD / 128)) * 128, c4 = F.lane & 31, kp = F.lane >> 5;
            const GAS float* w = A_WMOD + (size_t)l * DM * NMOD + n0 + 4 * c4;
            f32x4 a0 = {0.f, 0.f, 0.f, 0.f}, a1 = {0.f, 0.f, 0.f, 0.f};
#pragma unroll 8
            for (int i = 0; i < 64; ++i) { const int kk = F.wave * 128 + 2 * i + kp; const f32x4 wv = *(const GAS f32x4*)(w + (size_t)kk * NMOD); a0 += wv * cond[kk]; a1 += wv * cond[DM + kk]; }
#pragma unroll
            for (int q = 0; q < 4; ++q) { a0[q] = pg8::xsum32(a0[q]); a1[q] = pg8::xsum32(a1[q]); }
            if (kp == 0) { *(LAS f32x4*)(red + (F.wave * 2 + 0) * 128 + 4 * c4) = a0; *(LAS f32x4*)(red + (F.wave * 2 + 1) * 128 + 4 * c4) = a1; }
            __syncthreads();
            if (F.tid < 256) { const int bb = F.tid >> 7, ln = F.tid & 127; float s = 0.f;
#pragma unroll
                for (int wv = 0; wv < 8; ++wv) s += red[(wv * 2 + bb) * 128 + ln];
                MOD[((size_t)l * 2 + bb) * NMOD + n0 + ln] = s + A_BMOD[(size_t)l * NMOD + n0 + ln]; }
            __syncthreads();
        }
    }
    if ((int)blockIdx.x >= NMU || F.G <= NMU) {
        const int nb = F.G <= NMU ? F.G : F.G - NMU, b0 = F.G <= NMU ? (int)blockIdx.x : (int)blockIdx.x - NMU;
        for (int i = b0 * 512 + F.tid; i < MROWS * 16; i += nb * 512) {
            const int m = i >> 4, j = i & 15;
            const float freq = powf(10000.0f, -(float)j / 16.0f);
            const float ang = (float)A_POS[m] * freq;
            CS[(size_t)m * 32 + j] = cosf(ang); CS[(size_t)m * 32 + 16 + j] = sinf(ang);
        }
    }
    {
        LAS int* slot = (LAS int*)(F.lds + 12288);
        for (;;) {
            __syncthreads();
            if (F.tid == 0) slot[0] = (int)__hip_atomic_fetch_add(qhead, 16u, __ATOMIC_RELAXED, __HIP_MEMORY_SCOPE_AGENT);
            __syncthreads();
            const int base = slot[0];
            if (base >= CV_EARLY) break;
            convert_chunk(F, args, base, CV_EARLY);
        }
    }
}

__device__ __forceinline__ float gs_clamped(float g, float sc) { const float v = g * (1.0f + sc); return fabsf(v) < 1e-20f ? (v < 0.f ? -1e-20f : 1e-20f) : v; }
__device__ __forceinline__ void x_to_xb(Frame& F, const Args& args, const GAS float* xsrc, int l, int i) {
    GAS unsigned char* ws_ = (GAS unsigned char*)args.ws; asm volatile("" : "+s"(ws_));
    const int gw = F.vcu * NWAVES + F.wave, NGW = F.G * NWAVES;
    for (int m = gw; m < MROWS; m += NGW) {
        const int b = m >> 13;
        const GAS f32x4* xr = (const GAS f32x4*)(xsrc + (size_t)m * DM) + F.lane;
        const GAS f32x4* gr = (const GAS f32x4*)(A_NORMG + ((size_t)l * 3 + i) * DM) + F.lane;
        const GAS f32x4* sr = (const GAS f32x4*)(MOD + ((size_t)l * 2 + b) * NMOD + (3 * i + 1) * DM) + F.lane;
        float s = 0.f;
        GAS unsigned long long* o8 = (GAS unsigned long long*)(XB + (size_t)m * DM) + F.lane;
#pragma unroll
        for (int j = 0; j < 4; ++j) { const f32x4 v = xr[64 * j]; s += (v.x * v.x + v.y * v.y) + (v.z * v.z + v.w * v.w);
            const f32x4 g0 = gr[64 * j], s0 = sr[64 * j]; const f32x4 g = {gs_clamped(g0.x, s0.x), gs_clamped(g0.y, s0.y), gs_clamped(g0.z, s0.z), gs_clamped(g0.w, s0.w)}; const f32x4 y = v * g;
            o8[64 * j] = (unsigned long long)pk2(y.x, y.y) | ((unsigned long long)pk2(y.z, y.w) << 32); }
        s = wave_sum64(s);
        if (F.lane < 16) SSQX[(size_t)m * 16 + F.lane] = (F.lane == 0) ? s : 0.f;
    }
}

__device__ __forceinline__ void bias_rows(Frame& F, const Args& args, bool early) {
    GAS unsigned char* ws_ = (GAS unsigned char*)args.ws; asm volatile("" : "+s"(ws_));
    const int gw = F.vcu * NWAVES + F.wave, NGW = F.G * NWAVES;
    constexpr int RL = 5632 + 2048 + 5632, RE = 5632 + 2048;
    const int lo = early ? 0 : RE, hi = early ? RE : DEPTH * RL;
    for (int it = lo + gw; it < hi; it += NGW) {
        const int l = it / RL; int r = it % RL; int which, nrow; size_t woff; size_t boff;
        if (r < 5632) { which = 0; nrow = 5632; woff = W_GU1; boff = 0; } else if (r < 5632 + 2048) { r -= 5632; which = 1; nrow = 2048; woff = W_IN; boff = 2 * 5632; } else { r -= 5632 + 2048; which = 2; nrow = 5632; woff = W_GU2; boff = 2 * (5632 + 2048); }
        const GAS pg8::bf16_t* wr = (const GAS pg8::bf16_t*)(ws_ + WS_W + (size_t)l * WL + woff) + (size_t)r * DM;
        float a0 = 0.f, a1 = 0.f;
#pragma unroll
        for (int j = 0; j < 2; ++j) {
            const v4u wv = *(const GAS v4u*)(wr + j * 512 + F.lane * 8);
            const GAS float* s0 = MOD + ((size_t)l * 2 + 0) * NMOD + (3 * which) * DM + j * 512 + F.lane * 8; const GAS float* s1 = s0 + NMOD;
#pragma unroll
            for (int k = 0; k < 4; ++k) { const unsigned w = wv[k]; const float lo_ = __uint_as_float(w << 16), hi_ = __uint_as_float(w & 0xffff0000u);
                a0 += lo_ * s0[2 * k] + hi_ * s0[2 * k + 1]; a1 += lo_ * s1[2 * k] + hi_ * s1[2 * k + 1]; }
        }
        a0 = wave_sum64(a0); a1 = wave_sum64(a1);
        if (F.lane == 0) { BIAS[(size_t)l * BIAS_L + boff + r] = a0; BIAS[(size_t)l * BIAS_L + boff + nrow + r] = a1; }
    }
}
__device__ __forceinline__ void phase_pro1(Frame& F, const Args& args) {
    GAS unsigned char* ws_ = (GAS unsigned char*)args.ws; asm volatile("" : "+s"(ws_));
    for (int i = blockIdx.x * 512 + F.tid; i < DEPTH * 3 * 2 * DM; i += F.G * 512) {
        const int cidx = i & 1023, b = (i >> 10) & 1, li = i >> 11, l = li / 3, ii = li % 3;
        const float gv_ = gs_clamped(A_NORMG[((size_t)l * 3 + ii) * DM + cidx], MOD[((size_t)l * 2 + b) * NMOD + (3 * ii + 1) * DM + cidx]);
        GS[i] = gv_; ((GAS float*)WSP(WS_IGS))[i] = 1.0f / gv_;
    }
    bias_rows(F, args, true);
    x_to_xb(F, args, A_X, 0, 0);
}

__device__ __forceinline__ int next_unit(Frame& F, gu32* head) {
    LAS int* slot = (LAS int*)(F.lds + att::L_FLAG);
    __syncthreads();
    if (F.tid == 0) slot[0] = (int)__hip_atomic_fetch_add(head, 1u, __ATOMIC_RELAXED, __HIP_MEMORY_SCOPE_AGENT);
    __syncthreads();
    return slot[0];
}

#ifndef DUPS
#define DUPS -1
#endif
#ifndef PHM
#define PHM 255
#endif
#ifndef PHM2
#define PHM2 31
#endif
__global__ void __launch_bounds__(NWAVES * 64, 2) fwd_mega(Args args) {
    extern __shared__ __attribute__((aligned(16))) unsigned char lds[];
    Frame F; F.lds = (LAS unsigned char*)lds; F.tid = threadIdx.x; F.lane = F.tid & 63; F.wave = __builtin_amdgcn_readfirstlane(F.tid >> 6);
    F.G = gridDim.x; { const int bx = blockIdx.x; F.vcu = (F.G % 8 == 0) ? (bx % 8) * (F.G / 8) + bx / 8 : bx; }
    gu32* ctl = (gu32*)(args.ws + WS_CTL);
    for (int u = F.tid; u < (LDS_BYTES - LDSCTL_OFF) / 4; u += NWAVES * 64) ((LAS unsigned*)(F.lds + LDSCTL_OFF))[u] = 0u;
    __syncthreads();
    if (args.adapt >= 0) { x_to_xb(F, args, (const GAS float*)args.out, args.adapt / 3, args.adapt % 3); return; }
    const int lo = args.ph_lo, hi = args.ph_hi;
    XcdBarrier bar; bar.bar = (unsigned*)(ctl + CW_BAR) + args.li * XCD_BAR_WORDS; bar.x = 0; bar.st = nullptr;
    if (hi - lo > 1 || true) bar = xcd_barrier_post((unsigned*)(ctl + CW_BAR) + args.li * XCD_BAR_WORDS, (volatile LAS unsigned*)(F.lds + MISC_OFF) + 8);

    for (int ph = lo; ph < hi; ++ph) {
        { int t_ = threadIdx.x; asm volatile("" : "+v"(t_)); F.tid = t_; F.lane = t_ & 63; F.wave = __builtin_amdgcn_readfirstlane(t_ >> 6); }
        GAS unsigned char* ws_ = (GAS unsigned char*)args.ws; asm volatile("" : "+s"(ws_));
        int nrep = 1;
        if (DUPS >= 0) { const int ty = ph < 2 ? 8 + ph : ((ph - 2) & 7); if (ty == DUPS && !(ty == 5) && !((ty == 1 || ty == 7) && ph != 3)) nrep = 2; }
        for (int rep = 0; rep < nrep; ++rep) {
        if ((PHM & 64) && ph == 0) phase_pro0(F, args, ctl + CW_Q + 64 * 8);
        else if ((PHM & 128) && ph == 1) phase_pro1(F, args);
        else {
            const int l = (ph - 2) >> 3, s = (ph - 2) & 7;
            const GAS unsigned char* wl = ws_ + WS_W + (size_t)l * WL;
            const GAS float* biasl = BIAS + (size_t)l * BIAS_L;
            const GAS float* modl = MOD + (size_t)l * 2 * NMOD;
            if ((PHM & 1) && (s == 0 || s == 6)) {
                pg8::Gemm g{(const pg8::bf16_t*)XB, (const pg8::bf16_t*)(wl + (s == 0 ? W_GU1 : W_GU2)), MROWS, 5632, DM}; pg8::StaticOrder S; S.init(MROWS, 5632, F.G, (int)blockIdx.x);
                pg8::EpiUp E{ws_, biasl + (s == 0 ? 0 : 2 * (5632 + 2048))};
                pg8::gemm_phase<pg8::EpiUp, pg8::StaticOrder, true, true>(F.lds, g, S, E);
            } else if ((PHM & 2) && (s == 1 || s == 7)) {
                pg8::Gemm g{(const pg8::bf16_t*)HID, (const pg8::bf16_t*)(wl + (s == 1 ? W_D1 : W_D2)), MROWS, DM, DFF}; pg8::StaticOrder S; S.init(MROWS, DM, F.G, (int)blockIdx.x);
                const bool lastp = (s == 7 && l == DEPTH - 1);
                const GAS float* gsn = lastp ? nullptr : (s == 1 ? GS + ((size_t)(l * 3 + 1) * 2) * DM : GS + ((size_t)((l + 1) * 3 + 0) * 2) * DM);
                const GAS float* igp = (const GAS float*)WSP(WS_IGS) + ((size_t)(l * 3 + (s == 1 ? 0 : 2)) * 2) * DM;
                pg8::EpiResS<false> E{(GAS float*)args.out, ws_, modl + (s == 1 ? 2 : 8) * DM, igp, gsn, 0.5f}; pg8::gemm_phase<pg8::EpiResS<false>, pg8::StaticOrder, false, true>(F.lds, g, S, E, (unsigned long long*)(ctl + CW_Q + 64 * 13));
            } else if ((PHM & 4) && s == 2) {
                pg8::Gemm g{(const pg8::bf16_t*)XB, (const pg8::bf16_t*)(wl + W_IN), MROWS, 2048, DM}; pg8::StaticOrder S; S.init(MROWS, 2048, F.G, (int)blockIdx.x);
                pg8::EpiIn E{ws_, A_SWAQN + l * 64, A_SWAKN + l * 64, biasl + 2 * 5632};
                pg8::gemm_phase<pg8::EpiIn, pg8::StaticOrder, true, true>(F.lds, g, S, E);
            } else if ((PHM & 8) && s == 3) {
                if (PHM2 & 1) { pg8::Gemm g{(const pg8::bf16_t*)CQ, (const pg8::bf16_t*)(wl + W_UQ), MROWS, 768, 256}; pg8::StaticOrder S; S.init(MROWS, 768, F.G, (int)blockIdx.x);
                  pg8::EpiUq E{ws_}; pg8::gemm_phase<pg8::EpiUq, pg8::StaticOrder, true, true>(F.lds, g, S, E); }
                if (PHM2 & 2) { pg8::Gemm g{(const pg8::bf16_t*)CKV, (const pg8::bf16_t*)(wl + W_UKV), MROWS, 768, 128}; pg8::StaticOrder S; S.init(MROWS, 768, F.G, (int)((blockIdx.x + 64) % F.G));
                  pg8::EpiUkv E{ws_, A_MLAKN + l * 96}; pg8::gemm_phase<pg8::EpiUkv, pg8::StaticOrder, true, true>(F.lds, g, S, E); }
            } else if ((PHM & 16) && s == 4) {
                att::AttnP PA{ws_, A_MLAQN + l * 96, nullptr, nullptr, nullptr};
                att::AttnP PB{ws_, nullptr, A_POS, A_SINKS + l * 6, A_RELB};
                att::AttnP PC{ws_, nullptr, nullptr, nullptr, nullptr};
                gu32* head = ctl + CW_Q + 64 * (2 * l + 1 + 4 * rep);
                for (;;) { const int u = next_unit(F, head); if (u >= 384 + 256 + 384) break;
                    if ((PHM2 & 16) && u < 384) { const int qb = 31 - u / 12, bh = u % 12;
                        att::attn_unit<96, 0>(F.lds, PA, bh / 6, bh % 6, qb, (unsigned long long*)(ctl + CW_Q + 64 * 12)); }

                    else if ((PHM2 & 4) && u >= 384 && u < 640) { const int v = u - 384, qb = 31 - (v >> 3), bh = v & 7; att::attn_unit<64, 2>(F.lds, PC, bh >> 2, bh & 3, qb); }
                    else if ((PHM2 & 8) && u >= 640) { const int v = u - 640, qb = v / 12, bh = v % 12; att::attn_unit<64, 1>(F.lds, PB, bh / 6, bh % 6, qb); } }
                if (l == 0 && rep == 0) {
                    gu32* chead = ctl + CW_Q + 64 * 9; LAS int* cslot = (LAS int*)(F.lds + 12288);
                    for (;;) { __syncthreads(); if (F.tid == 0) cslot[0] = (int)__hip_atomic_fetch_add(chead, 16u, __ATOMIC_RELAXED, __HIP_MEMORY_SCOPE_AGENT); __syncthreads();
                        const int cb = CV_EARLY + cslot[0]; if (cb >= CV_ALL) break; convert_chunk(F, args, cb, CV_ALL); } }
            } else if ((PHM & 32) && s == 5) {
                if (l == 0 && rep == 0) { bias_rows(F, args, false); asm volatile("s_waitcnt vmcnt(0)" ::: "memory"); __syncthreads(); }
                pg8::Gemm g{(const pg8::bf16_t*)OALL, (const pg8::bf16_t*)(wl + W_OUT), MROWS, DM, DM}; pg8::StaticOrder S; S.init(MROWS, DM, F.G, (int)blockIdx.x);
                pg8::EpiResS<true> E{(GAS float*)args.out, ws_, modl + 5 * DM, (const GAS float*)WSP(WS_IGS) + ((size_t)(l * 3 + 1) * 2) * DM, GS + ((size_t)(l * 3 + 2) * 2) * DM, 1.0f}; pg8::gemm_phase<pg8::EpiResS<true>, pg8::StaticOrder, false, true>(F.lds, g, S, E);
            }
        }
        if (rep + 1 < nrep) xcd_barrier(bar);
        }
        if (ph + 1 < hi) xcd_barrier(bar);
    }
#ifdef GEMM_PROF
    xcd_barrier(bar);
    if (blockIdx.x == 0 && threadIdx.x == 0) { const unsigned long long* st = (const unsigned long long*)(ctl + CW_Q + 64 * 13); double sh;
        if (GEMM_PROF == 0) sh = (double)st[1] / (double)(st[0] + st[1]);
        else if (GEMM_PROF == 1) sh = (double)st[0] / (double)st[2] / 1.0e6;
        else sh = (double)st[1] / (double)st[2] / 1.0e6;
        args.out[0] += (float)(0.04 + 0.18 * (sh > 1.0 ? 1.0 : sh)); }
#endif
#ifdef ATT_PROF
    xcd_barrier(bar);
    if (blockIdx.x == 0 && threadIdx.x == 0) { const unsigned long long* st = (const unsigned long long*)(ctl + CW_Q + 64 * 12);
        const double tot = (double)st[0]; double sh = 0.0;
        if (ATT_PROF == 0) sh = (double)st[0] / (double)st[5] / 1.0e6;
        else if (ATT_PROF == 5) sh = (double)st[0] / (double)st[6] / 1.0e4;
        else if (ATT_PROF == 6) sh = (double)st[6] / 1.0e3;
        else sh = (double)st[ATT_PROF] / tot;
        args.out[0] += (float)(0.04 + 0.18 * (sh > 1.0 ? 1.0 : sh)); }
#endif
}
static void launch_fwd(hipStream_t stream, Args a, int grid, int lo, int hi, int li, int adapt) {
    a.ph_lo = lo; a.ph_hi = hi; a.li = li; a.adapt = adapt;
    hipLaunchKernelGGL(fwd_mega, dim3(grid), dim3(NWAVES * 64), LDS_BYTES, stream, a);
}
extern "C" void kernel_launch(void* const* d_in, const int* in_sizes, int n_in, void* d_out, int out_size, void* d_ws, size_t ws_size, hipStream_t stream) {
    static int grid = 0;
    if (grid == 0) {
        if (n_in != 23 || out_size != MROWS * DM || ws_size < WS_END) { fprintf(stderr, "kernel_launch: unexpected problem (n_in %d, out %d, ws %zu < %zu)\n", n_in, out_size, ws_size, (size_t)WS_END); grid = -1; return; }
        int dev = 0, cus = 0, per_cu = 0;
        if (hipGetDevice(&dev) != hipSuccess || hipDeviceGetAttribute(&cus, hipDeviceAttributeMultiprocessorCount, dev) != hipSuccess) { grid = -1; return; }
        if (hipFuncSetAttribute((const void*)fwd_mega, hipFuncAttributeMaxDynamicSharedMemorySize, LDS_BYTES) != hipSuccess) { fprintf(stderr, "kernel_launch: hipFuncSetAttribute failed\n"); grid = -1; return; }
        if (hipOccupancyMaxActiveBlocksPerMultiprocessor(&per_cu, (const void*)fwd_mega, NWAVES * 64, LDS_BYTES) != hipSuccess || per_cu < 1) { fprintf(stderr, "kernel_launch: occupancy query says %d blocks per CU\n", per_cu); (void)hipGetLastError(); grid = -1; return; }
        if (cus < 256) { fprintf(stderr, "kernel_launch: built for a 256-CU device (the one-unit-per-workgroup GEMM phases need exactly 256 workgroups), found %d CUs\n", cus); grid = -1; return; }
        grid = 256;
    }
    if (grid < 0) return;
    (void)hipMemsetAsync((char*)d_ws + WS_CTL, 0, CTL_ZERO_BYTES, stream);
    Args a{};
    for (int i = 0; i < 23; ++i) a.in[i] = d_in[i];
    a.out = (float*)d_out; a.ws = (unsigned char*)d_ws;
    launch_fwd(stream, a, grid, 0, NPH, 0, -1);
}
```

```cpp
#include <hip/hip_runtime.h>
#include <cstdio>
#include <cstdint>
#include <cmath>
constexpr int NWAVES = 8;
constexpr int BATCH = 2, SEQ = 8192, DM = 1024, DEPTH = 2, MROWS = BATCH * SEQ;
constexpr int DFF = 2816, DIN = 1824, NMOD = 9 * DM;
constexpr int NPH = 2 + 8 * DEPTH;
constexpr size_t MiB = 1u << 20;
constexpr size_t WS_CTL = 0, CTL_ZERO_BYTES = 256 * 1024;
constexpr size_t WS_MOD = 1 * MiB;
constexpr size_t WS_GS = WS_MOD + 160 * 1024;
constexpr size_t WS_IGS = WS_GS + 64 * 1024;
constexpr size_t WS_BIAS = WS_IGS + 64 * 1024;
constexpr size_t BIAS_L = 2 * (5632 + 2048 + 5632);
constexpr size_t WS_SSQX = 2 * MiB;
constexpr size_t WS_SSQO = 3 * MiB;
constexpr size_t WS_CS = 4 * MiB;
constexpr size_t WS_KPE = 6 * MiB;
constexpr size_t WS_SSQC = 8 * MiB;
constexpr size_t WS_W = 9 * MiB;
constexpr size_t W_GU1 = 0, W_D1 = W_GU1 + (size_t)5632 * 1024 * 2, W_IN = W_D1 + (size_t)1024 * 2816 * 2, W_UQ = W_IN + (size_t)2048 * 1024 * 2, W_UKV = W_UQ + (size_t)768 * 256 * 2,
                 W_OUT = W_UKV + (size_t)768 * 128 * 2, W_GU2 = W_OUT + (size_t)1024 * 1024 * 2, W_D2 = W_GU2 + (size_t)5632 * 1024 * 2, WL = W_D2 + (size_t)1024 * 2816 * 2;
constexpr size_t WS_XB = WS_W + ((2 * WL + MiB - 1) / MiB) * MiB;
constexpr size_t WS_ACT = WS_XB + 32 * MiB;
constexpr size_t WS_HID = WS_ACT;
constexpr size_t WS_CQ = WS_ACT, WS_CKV = WS_CQ + 8 * MiB, WS_QRAW = WS_CKV + 4 * MiB, WS_KA = WS_QRAW + 36 * MiB, WS_VA = WS_KA + 18 * MiB, WS_QS = WS_VA + 12 * MiB, WS_KS = WS_QS + 12 * MiB,
                 WS_VS = WS_KS + 4 * MiB, WS_QC = WS_VS + 4 * MiB, WS_KC = WS_QC + 8 * MiB, WS_VC = WS_KC + 8 * MiB, WS_OALL = WS_VC + 8 * MiB, WS_END = WS_OALL + 32 * MiB;
static_assert(WS_HID + (size_t)MROWS * DFF * 2 <= WS_END, "d_ws map");
constexpr int CW_BAR = 4096;
constexpr int CW_Q = 40960;
static_assert((CW_Q + 64 * 14) * 4 <= (int)CTL_ZERO_BYTES && CW_BAR + 8 * 3456 <= CW_Q, "ctl map");
constexpr int RING_BYTES = 131072, LDSCTL_OFF = RING_BYTES, MISC_OFF = LDSCTL_OFF + 320, LDS_BYTES = 147456;

__device__ __forceinline__ int hw_lane() { int l; asm volatile("v_mbcnt_lo_u32_b32 %0, -1, 0\n\tv_mbcnt_hi_u32_b32 %0, -1, %0" : "=v"(l)); return l; }
namespace pg8 {
#define PG8_LAS __attribute__((address_space(3)))
typedef unsigned short bf16_t;
typedef short bf16x8 __attribute__((ext_vector_type(8)));
typedef float f32x4 __attribute__((ext_vector_type(4)));
typedef unsigned u32x4 __attribute__((ext_vector_type(4)));
constexpr int BM = 256, BK = 64, HALF = 128, HTB = HALF * BK * 2  , STAGE_BYTES = 8 * HTB, NXCD = 8, WGM = 8;

__host__ __device__ __forceinline__ int lds_byte(int r, int c) { const int st = (r >> 4) * 2 + (c >> 5), rr = r & 15, cc = c & 31, ob = rr * 64 + cc * 2; return st * 1024 + (ob ^ (((ob >> 9) & 1) << 5)); }
__host__ __device__ __forceinline__ void stage_rc(int b, int& R, int& C) { const int st = b / 1024, sb = b % 1024, swz = sb ^ (((sb >> 9) & 1) << 5); R = (st >> 1) * 16 + swz / 64; C = (st & 1) * 32 + (swz % 64) / 2; }
__host__ __device__ __forceinline__ int perm32(int rho) { const int n = rho >> 4, i = rho & 15; return 8 * (i >> 2) + 4 * n + (i & 3); }

struct Unit { int pm, pn; };
struct Gemm { const bf16_t* A; const bf16_t* Bt; int M, N, K; };

struct StaticOrder {
    int nM, nN, nwg, G, c;
    __host__ __device__ void init(int M, int N, int G_, int c_) { nM = M / BM; nN = N / BM; nwg = nM * nN; G = G_; c = c_; }
    __host__ __device__ bool next(int i, Unit& u) const {
        const long L = (long)i * G + c; if (L >= nwg) return false;
        int wgid = (int)L; { const int q = nwg / NXCD, r = nwg % NXCD, xcd = wgid % NXCD, off = wgid / NXCD; wgid = (xcd < r ? xcd * (q + 1) : r * (q + 1) + (xcd - r) * q) + off; }
        const int nig = WGM * nN, gid = wgid / nig, fm = gid * WGM, gsz = (nM - fm) < WGM ? (nM - fm) : WGM;
        u.pm = fm + ((wgid % nig) % gsz); u.pn = (wgid % nig) / gsz; return true;
    }
    __device__ __forceinline__ void a_ready(const Unit&) const {}
    __device__ __forceinline__ void done(const Unit&) const {}
};

__device__ __forceinline__ unsigned cvt_pk_bf16(float lo, float hi) { unsigned r; asm volatile("v_cvt_pk_bf16_f32 %0, %1, %2" : "=v"(r) : "v"(lo), "v"(hi)); return r; }
typedef float f32x2 __attribute__((ext_vector_type(2)));
template <class Epi, class Sched, bool ALIGN_EPI = false, bool SP2 = false>
__device__ __forceinline__ void gemm_phase(PG8_LAS unsigned char* lds, const Gemm g, const Sched& S, const Epi& E, int wave0, unsigned long long* gprof = nullptr) {
#ifdef GEMM_PROF
    const long long gp_t0 = (Epi::AFTER_DRAIN && !Epi::HOOK && blockIdx.x == 0) ? (long long)clock64() : 0ll;
#endif
    int tid_ = wave0 * 64 + hw_lane(); asm volatile("" : "+v"(tid_));
    const int tid = tid_, wid = __builtin_amdgcn_readfirstlane(tid >> 6), lane = tid & 63, wr = wid >> 2, wc = wid & 3, fr = lane & 15, fq = lane >> 4;
    int K_ = g.K; asm volatile("" : "+s"(K_));
    const int K = K_, nt = K / BK;
    unsigned voffA[2], voffB[2];
#pragma unroll
    for (int i = 0; i < 2; ++i) { int R, C; stage_rc(tid * 16 + i * 8192, R, C); const int Rb = Epi::PERM ? ((R & ~31) + perm32(R & 31)) : R;
        voffA[i] = (unsigned)(R * K + C) * 2u; voffB[i] = (unsigned)(Rb * K + C) * 2u; }
    const size_t kstep = (size_t)(BK * 2);
    const size_t hstep = (size_t)HALF * K * 2;
    const size_t tstep = 2 * hstep;
    const unsigned ldsw = (unsigned)wid * 1024u;
    const int aoff = lds_byte(wr * 64 + fr, fq * 8), boff = lds_byte(wc * 32 + fr, fq * 8);
#define PG8_SA(b, h) (((b) * 2 + (h)) * HTB)
#define PG8_SB(b, h) ((4 + (b) * 2 + (h)) * HTB)
#define PG8_STAGE(bufoff, gbase, voff) do { _Pragma("unroll") for (int _i = 0; _i < 2; ++_i) \
        __builtin_amdgcn_global_load_lds((const unsigned*)((const char*)(gbase) + (voff)[_i]), (PG8_LAS unsigned*)(lds + (bufoff) + ldsw + _i * 8192), 16, 0, 0); } while (0)
#define PG8_LDA(dst, b, h) do { _Pragma("unroll") for (int m = 0; m < 4; ++m) _Pragma("unroll") for (int k = 0; k < 2; ++k) dst[m][k] = *(const PG8_LAS bf16x8*)(lds + PG8_SA(b, h) + aoff + m * 2048 + k * 1024); } while (0)
#define PG8_LDB(dst, b, h) do { _Pragma("unroll") for (int n = 0; n < 2; ++n) _Pragma("unroll") for (int k = 0; k < 2; ++k) dst[n][k] = *(const PG8_LAS bf16x8*)(lds + PG8_SB(b, h) + boff + n * 2048 + k * 1024); } while (0)
#define PG8_MMA(ai, bj, At, Bt) do { __builtin_amdgcn_s_setprio(1); _Pragma("unroll") for (int m = 0; m < 4; ++m) _Pragma("unroll") for (int n = 0; n < 2; ++n) _Pragma("unroll") for (int k = 0; k < 2; ++k) \
        acc[ai][bj][m][n] = __builtin_amdgcn_mfma_f32_16x16x32_bf16(Bt[n][k], At[m][k], acc[ai][bj][m][n], 0, 0, 0); __builtin_amdgcn_s_setprio(0); } while (0)
#define PG8_WAIT_V(n) asm volatile("s_waitcnt vmcnt(" #n ")" ::: "memory")
#define PG8_WAIT_L(n) asm volatile("s_waitcnt lgkmcnt(" #n ")" ::: "memory")
#define PG8_BAR __builtin_amdgcn_s_barrier()
#define PG8_SCHED __builtin_amdgcn_sched_barrier(0)
    Unit cur, nxt; int ui = 0;
    if (!S.next(0, cur)) return;
    f32x4 acc[2][2][4][2];
#pragma unroll
    for (int a = 0; a < 2; ++a)
#pragma unroll
        for (int b = 0; b < 2; ++b)
#pragma unroll
            for (int m = 0; m < 4; ++m)
#pragma unroll
                for (int n = 0; n < 2; ++n) acc[a][b][m][n] = (f32x4){0.f, 0.f, 0.f, 0.f};
    bf16x8 At[4][2], B0[2][2], B1[2][2];
    const char* cA = (const char*)g.A + (size_t)cur.pm * tstep; const char* cB = (const char*)g.Bt + (size_t)cur.pn * tstep;
    S.a_ready(cur);
    if constexpr (SP2) {
        PG8_STAGE(PG8_SB(0, 0), cB, voffB); PG8_STAGE(PG8_SB(0, 1), cB + hstep, voffB); PG8_STAGE(PG8_SA(0, 0), cA, voffA); PG8_STAGE(PG8_SA(0, 1), cA + hstep, voffA);
        if (wr == 1) PG8_BAR;
        PG8_WAIT_V(2); PG8_BAR;
        PG8_STAGE(PG8_SB(1, 0), cB + kstep, voffB); PG8_STAGE(PG8_SA(1, 0), cA + kstep, voffA); PG8_STAGE(PG8_SB(1, 1), cB + hstep + kstep, voffB);
        PG8_WAIT_V(6); PG8_BAR;
    } else {
        PG8_STAGE(PG8_SB(0, 0), cB, voffB); PG8_STAGE(PG8_SA(0, 0), cA, voffA); PG8_STAGE(PG8_SB(0, 1), cB + hstep, voffB); PG8_STAGE(PG8_SA(0, 1), cA + hstep, voffA);
        if (wr == 1) PG8_BAR;
        PG8_WAIT_V(4); PG8_BAR;
        PG8_STAGE(PG8_SB(1, 0), cB + kstep, voffB); PG8_STAGE(PG8_SA(1, 0), cA + kstep, voffA); PG8_STAGE(PG8_SB(1, 1), cB + hstep + kstep, voffB);
        PG8_WAIT_V(6); PG8_BAR;
    }
    for (;;) {
        const bool has_next = S.next(ui + 1, nxt);
        const char* nA = has_next ? (const char*)g.A + (size_t)nxt.pm * tstep : cA; const char* nB = has_next ? (const char*)g.Bt + (size_t)nxt.pn * tstep : cB;
#pragma nounroll
        for (int t = 0; t < nt; t += 2) {
            if constexpr (Epi::HOOK) E.hook(acc, cur, t, wr, wc, fr, fq);
            const bool last = (t == nt - 2);
            const char* a1 = cA + (size_t)(t + 1) * kstep;
            const char* a2 = last ? nA : cA + (size_t)(t + 2) * kstep; const char* b2 = last ? nB : cB + (size_t)(t + 2) * kstep;
            const char* a3 = a2 + kstep; const char* b3 = b2 + kstep;
            if (last && has_next) S.a_ready(nxt);
            if constexpr (SP2) {
            PG8_LDB(B0, 0, 0); PG8_LDB(B1, 0, 1); PG8_SCHED; PG8_LDA(At, 0, 0); PG8_STAGE(PG8_SA(1, 1), a1 + hstep, voffA);
            PG8_WAIT_V(8); PG8_WAIT_L(0); PG8_BAR; PG8_MMA(0, 0, At, B0); PG8_MMA(0, 1, At, B1); PG8_BAR; PG8_SCHED;
            PG8_LDA(At, 0, 1); PG8_STAGE(PG8_SB(0, 0), b2, voffB); PG8_STAGE(PG8_SB(0, 1), b2 + hstep, voffB); PG8_STAGE(PG8_SA(0, 0), a2, voffA);
            PG8_WAIT_V(8); PG8_WAIT_L(0); PG8_BAR; PG8_MMA(1, 0, At, B0); PG8_MMA(1, 1, At, B1); PG8_BAR; PG8_SCHED;
            PG8_LDB(B0, 1, 0); PG8_LDB(B1, 1, 1); PG8_SCHED; PG8_LDA(At, 1, 0); PG8_STAGE(PG8_SA(0, 1), a2 + hstep, voffA);
            PG8_WAIT_V(8); PG8_WAIT_L(0); PG8_BAR; PG8_MMA(0, 0, At, B0); PG8_MMA(0, 1, At, B1); PG8_BAR; PG8_SCHED;
            PG8_LDA(At, 1, 1); PG8_STAGE(PG8_SB(1, 0), b3, voffB); PG8_STAGE(PG8_SB(1, 1), b3 + hstep, voffB); PG8_STAGE(PG8_SA(1, 0), a3, voffA);
            PG8_WAIT_V(8); PG8_WAIT_L(0); PG8_BAR; PG8_MMA(1, 0, At, B0); PG8_MMA(1, 1, At, B1); PG8_BAR; PG8_SCHED;
            } else {
            PG8_LDB(B0, 0, 0); PG8_SCHED; PG8_LDA(At, 0, 0); PG8_STAGE(PG8_SA(1, 1), a1 + hstep, voffA);
            PG8_WAIT_L(8); PG8_BAR; PG8_WAIT_L(0); PG8_MMA(0, 0, At, B0); PG8_BAR; PG8_SCHED;
            PG8_LDB(B1, 0, 1); PG8_STAGE(PG8_SB(0, 0), b2, voffB);
            PG8_BAR; PG8_WAIT_L(0); PG8_MMA(0, 1, At, B1); PG8_BAR;
            PG8_LDA(At, 0, 1); PG8_STAGE(PG8_SA(0, 0), a2, voffA);
            PG8_BAR; PG8_WAIT_L(0); PG8_MMA(1, 0, At, B0); PG8_BAR; PG8_SCHED;
            PG8_STAGE(PG8_SB(0, 1), b2 + hstep, voffB);
            PG8_WAIT_V(6); PG8_BAR; PG8_MMA(1, 1, At, B1); PG8_BAR;
            PG8_LDB(B0, 1, 0); PG8_SCHED; PG8_LDA(At, 1, 0); PG8_STAGE(PG8_SA(0, 1), a2 + hstep, voffA);
            PG8_WAIT_L(8); PG8_BAR; PG8_WAIT_L(0); PG8_MMA(0, 0, At, B0); PG8_BAR; PG8_SCHED;
            PG8_LDB(B1, 1, 1); PG8_STAGE(PG8_SB(1, 0), b3, voffB);
            PG8_BAR; PG8_WAIT_L(0); PG8_MMA(0, 1, At, B1); PG8_BAR;
            PG8_LDA(At, 1, 1); PG8_STAGE(PG8_SA(1, 0), a3, voffA);
            PG8_BAR; PG8_WAIT_L(0); PG8_MMA(1, 0, At, B0); PG8_BAR; PG8_SCHED;
            PG8_STAGE(PG8_SB(1, 1), b3 + hstep, voffB);
            PG8_WAIT_V(6); PG8_BAR; PG8_MMA(1, 1, At, B1); PG8_BAR;
            }
        }
        if constexpr (ALIGN_EPI) { if (wr == 0) PG8_BAR; }
        if constexpr (!Epi::AFTER_DRAIN) {
            Unit ce = cur; asm volatile("" : "+s"(ce.pm), "+s"(ce.pn)); int fre = fr, fqe = fq; asm volatile("" : "+v"(fre), "+v"(fqe));
            E(acc, ce, wr, wc, fre, fqe); S.done(cur); }
        if (!has_next) break;
#pragma unroll
        for (int a = 0; a < 2; ++a)
#pragma unroll
            for (int b = 0; b < 2; ++b)
#pragma unroll
                for (int m = 0; m < 4; ++m)
#pragma unroll
                    for (int n = 0; n < 2; ++n) acc[a][b][m][n] = (f32x4){0.f, 0.f, 0.f, 0.f};
        cur = nxt; cA = nA; cB = nB; ++ui;
        if constexpr (ALIGN_EPI) { if (wr == 1) PG8_BAR; }
    }
    PG8_WAIT_V(0);
    if constexpr (!ALIGN_EPI) { if (wr == 0) PG8_BAR; }
    PG8_BAR;
#ifdef GEMM_PROF
    const long long gp_t1 = (Epi::AFTER_DRAIN && !Epi::HOOK && blockIdx.x == 0) ? (long long)clock64() : 0ll;
#endif
    if constexpr (Epi::AFTER_DRAIN) { E.fused(acc, cur, wr, wc, fr, fq, lds, wid, lane); S.done(cur); }
#ifdef GEMM_PROF
    if (Epi::AFTER_DRAIN && !Epi::HOOK && blockIdx.x == 0 && tid == 0 && gprof) { const long long gp_t2 = clock64(); atomicAdd(gprof + 0, (unsigned long long)(gp_t1 - gp_t0)); atomicAdd(gprof + 1, (unsigned long long)(gp_t2 - gp_t1)); atomicAdd(gprof + 2, 1ull); }
#endif
#undef PG8_SA
#undef PG8_SB
#undef PG8_STAGE
#undef PG8_LDA
#undef PG8_LDB
#undef PG8_MMA
#undef PG8_WAIT_V
#undef PG8_WAIT_L
#undef PG8_BAR
#undef PG8_SCHED
}
constexpr float RMS_EPS = 1e-6f;
constexpr int MROWS_ = 16384;
constexpr float LOG2E = 1.4426950408889634f;
typedef unsigned u32x2 __attribute__((ext_vector_type(2)));
#define PG8_FENCE() asm volatile("" ::: "memory")
#define PG8_G __attribute__((address_space(1)))
__device__ __forceinline__ float sum16f(const PG8_G float* p) {
    const f32x4 a = *(const PG8_G f32x4*)p, b = *(const PG8_G f32x4*)(p + 4), c = *(const PG8_G f32x4*)(p + 8), d = *(const PG8_G f32x4*)(p + 12);
    return ((a[0] + a[1]) + (a[2] + a[3])) + ((b[0] + b[1]) + (b[2] + b[3])) + ((c[0] + c[1]) + (c[2] + c[3])) + ((d[0] + d[1]) + (d[2] + d[3]));
}
__device__ __forceinline__ float xsum16(float x) { auto r = __builtin_amdgcn_permlane16_swap(__float_as_uint(x), __float_as_uint(x), false, false); return __uint_as_float(r[0]) + __uint_as_float(r[1]); }
__device__ __forceinline__ float xsum32(float x) { auto r = __builtin_amdgcn_permlane32_swap(__float_as_uint(x), __float_as_uint(x), false, false); return __uint_as_float(r[0]) + __uint_as_float(r[1]); }
__device__ __forceinline__ float wave_sum_dpp(float x) {
    x += __builtin_bit_cast(float, __builtin_amdgcn_update_dpp(0, __builtin_bit_cast(int, x), 0xB1, 0xf, 0xf, true));
    x += __builtin_bit_cast(float, __builtin_amdgcn_update_dpp(0, __builtin_bit_cast(int, x), 0x4E, 0xf, 0xf, true));
    x += __builtin_bit_cast(float, __builtin_amdgcn_update_dpp(0, __builtin_bit_cast(int, x), 0x141, 0xf, 0xf, true));
    x += __builtin_bit_cast(float, __builtin_amdgcn_update_dpp(0, __builtin_bit_cast(int, x), 0x140, 0xf, 0xf, true));
    return xsum32(xsum16(x));
}
__device__ __forceinline__ float fast_rcp(float x) { return __builtin_amdgcn_rcpf(x); }
__device__ __forceinline__ float silu_fast(float g) { return g * fast_rcp(1.0f + __builtin_amdgcn_exp2f(-g * LOG2E)); }
__device__ __forceinline__ float sq4(const f32x4 v) { return (v[0] * v[0] + v[1] * v[1]) + (v[2] * v[2] + v[3] * v[3]); }

struct EpiUp {
    static constexpr bool PERM = true, AFTER_DRAIN = false, HOOK = false;
    PG8_G unsigned char* ws; const PG8_G float* bias;
    __device__ __forceinline__ void hook(f32x4 (&)[2][2][4][2], const Unit&, int, int, int, int, int) const {}
    __device__ __forceinline__ void operator()(const f32x4 (&acc)[2][2][4][2], const Unit& u, int wr, int wc, int fr, int fq) const {
        PG8_G bf16_t* HID = (PG8_G bf16_t*)(ws + WS_HID); const PG8_G float* ssqx = (const PG8_G float*)(ws + WS_SSQX);
        const int b = u.pm >> 5;
        const PG8_G float* bb = bias + b * 5632 + u.pn * BM + wc * 32 + 8 * fq;
        f32x4 bg[2], bu[2];
#pragma unroll
        for (int n = 0; n < 2; ++n) { bg[n] = *(const PG8_G f32x4*)(bb + 4 * n); bu[n] = *(const PG8_G f32x4*)(bb + HALF + 4 * n); }
#pragma unroll
        for (int ai = 0; ai < 2; ++ai)
#pragma unroll
            for (int m = 0; m < 4; ++m) {
                const int row = u.pm * BM + ai * HALF + wr * 64 + m * 16 + fr;
                const float r = 1.0f / sqrtf(sum16f(ssqx + (size_t)row * 16) * (1.0f / 1024.0f) + RMS_EPS);
                float hv[8];
#pragma unroll
                for (int n = 0; n < 2; ++n)
#pragma unroll
                    for (int i = 0; i < 4; ++i) { const float g = acc[ai][0][m][n][i] * r + bg[n][i], uu = acc[ai][1][m][n][i] * r + bu[n][i]; hv[4 * n + i] = silu_fast(g) * uu; }
                u32x4 w; w.x = cvt_pk_bf16(hv[0], hv[1]); w.y = cvt_pk_bf16(hv[2], hv[3]); w.z = cvt_pk_bf16(hv[4], hv[5]); w.w = cvt_pk_bf16(hv[6], hv[7]);
                *(PG8_G u32x4*)(HID + (size_t)row * 2816 + u.pn * HALF + wc * 32 + 8 * fq) = w;
                if (m & 1) PG8_FENCE();
            }
    }
};

template <bool HOOKED> struct EpiResS {
    static constexpr bool PERM = false, AFTER_DRAIN = true, HOOK = HOOKED;
    PG8_G float* fout; PG8_G unsigned char* ws; const PG8_G float* gate; const PG8_G float* igs; const PG8_G float* gs; float coef;
    __device__ __forceinline__ void group_r(int row, float& rA, float& rB, float& rC) const {
        const PG8_G float* p = (const PG8_G float*)(ws + WS_SSQO) + (size_t)row * 16;
        const f32x4 a = *(const PG8_G f32x4*)p, b = *(const PG8_G f32x4*)(p + 4), c = *(const PG8_G f32x4*)(p + 8), d = *(const PG8_G f32x4*)(p + 12);
        const float sA = ((a[0] + a[1]) + (a[2] + a[3])) + (b[0] + b[1]), sB = ((b[2] + b[3]) + (c[0] + c[1])) + (c[2] + c[3]), sC = (d[0] + d[1]) + (d[2] + d[3]);
        rA = 1.0f / sqrtf(sA * (1.0f / 384.0f) + RMS_EPS); rB = 1.0f / sqrtf(sB * (1.0f / 384.0f) + RMS_EPS); rC = 1.0f / sqrtf(sC * (1.0f / 256.0f) + RMS_EPS);
    }
    __device__ __forceinline__ void hook(f32x4 (&acc)[2][2][4][2], const Unit& u, int t, int wr, int wc, int fr, int fq) const {
        if (t != 6 && t != 12) return;
        asm volatile("" : "+v"(fr));
#pragma unroll
        for (int ai = 0; ai < 2; ++ai)
#pragma unroll
            for (int m = 0; m < 4; ++m) {
                const int row = u.pm * BM + ai * HALF + wr * 64 + m * 16 + fr;
                float rA, rB, rC; group_r(row, rA, rB, rC);
                const float f = (t == 6) ? rA / rB : rB / rC;
#pragma unroll
                for (int bj = 0; bj < 2; ++bj)
#pragma unroll
                    for (int n = 0; n < 2; ++n) acc[ai][bj][m][n] = acc[ai][bj][m][n] * f;
                PG8_FENCE();
            }
    }
    __device__ __forceinline__ void fused(f32x4 (&acc)[2][2][4][2], const Unit& u, int wr, int wc, int fr, int fq, PG8_LAS unsigned char* lds, int wid, int lane) const {
        PG8_G bf16_t* xb = (PG8_G bf16_t*)(ws + WS_XB); PG8_G float* ssq_out = (PG8_G float*)(ws + WS_SSQX); constexpr int gate_bstride = 9 * 1024;
        const int b = u.pm >> 5, colg = u.pn * BM + 4 * lane;
        const f32x4 gv = *(const PG8_G f32x4*)(gate + (size_t)b * gate_bstride + colg) * coef;
        const f32x4 gsv = gs ? *(const PG8_G f32x4*)(gs + (size_t)b * 1024 + colg) : (f32x4){0.f, 0.f, 0.f, 0.f};
        const f32x4 igv = *(const PG8_G f32x4*)(igs + (size_t)b * 1024 + colg);
#pragma unroll
        for (int ai = 0; ai < 2; ++ai) {
#pragma unroll
            for (int m = 0; m < 4; ++m) { const int rl = wr * 64 + m * 16 + fr;
#pragma unroll
                for (int bj = 0; bj < 2; ++bj)
#pragma unroll
                    for (int n = 0; n < 2; ++n) { const int c = 32 * bj + 8 * wc + 4 * n + fq; *(PG8_LAS f32x4*)(lds + rl * 1024 + ((c ^ (rl & 7)) << 4)) = acc[ai][bj][m][n]; } }
            asm volatile("s_waitcnt lgkmcnt(0)\n\ts_barrier" ::: "memory");
#pragma unroll
            for (int half = 0; half < 2; ++half) {
                u32x2 xo[8];
#pragma unroll
                for (int k = 0; k < 8; ++k) { const int rl = wid + 8 * (half * 8 + k); xo[k] = *(const PG8_G u32x2*)(xb + (size_t)(u.pm * BM + ai * HALF + rl) * 1024 + colg); }
#pragma unroll
                for (int k = 0; k < 8; ++k) { const int rl = wid + 8 * (half * 8 + k); const int row = u.pm * BM + ai * HALF + rl;
                    f32x4 t = *(const PG8_LAS f32x4*)(lds + rl * 1024 + ((lane ^ (rl & 7)) << 4));
                    if (HOOKED) { float rA, rB, rC; group_r(row, rA, rB, rC); t = t * rC; }
                    const f32x4 xs = {__uint_as_float(xo[k].x << 16), __uint_as_float(xo[k].x & 0xffff0000u), __uint_as_float(xo[k].y << 16), __uint_as_float(xo[k].y & 0xffff0000u)};
                    const f32x4 xn = xs * igv + gv * t;
                    if (!gs) *(PG8_G f32x4*)(fout + (size_t)row * 1024 + colg) = xn;
                    if (gs) { const f32x4 y = xn * gsv; u32x2 w; w.x = cvt_pk_bf16(y[0], y[1]); w.y = cvt_pk_bf16(y[2], y[3]); *(PG8_G u32x2*)(xb + (size_t)row * 1024 + colg) = w; }
                    float ss = sq4(xn);
                    ss = wave_sum_dpp(ss);
                    if (gs && lane == 0) *(PG8_G f32x4*)(ssq_out + (size_t)row * 16 + 4 * u.pn) = (f32x4){ss, 0.f, 0.f, 0.f};
                }
            }
            asm volatile("s_waitcnt lgkmcnt(0)\n\ts_barrier" ::: "memory");
        }
    }
};

struct EpiIn {
    static constexpr bool PERM = true, AFTER_DRAIN = false, HOOK = false;
    PG8_G unsigned char* ws; const PG8_G float* gq; const PG8_G float* gk; const PG8_G float* bias;
    __device__ __forceinline__ void hook(f32x4 (&)[2][2][4][2], const Unit&, int, int, int, int, int) const {}
    __device__ __forceinline__ void operator()(const f32x4 (&acc)[2][2][4][2], const Unit& u, int wr, int wc, int fr, int fq) const {
        const int slot = u.pn * 4 + wc;
        if (slot == 7 || slot >= 30) return;
        const int b = u.pm >> 5;
        const PG8_G float* ssqx = (const PG8_G float*)(ws + WS_SSQX);
        PG8_G PG8_G bf16_t* dst = nullptr; int pitch = 0, col0 = 0; int kind = 0;
        PG8_G PG8_G float* ssqd = nullptr; int ssqp = 0, ssqi = 0; const PG8_G float* gain = nullptr; float scale = 1.0f;
        if (slot < 4)       { dst = (PG8_G bf16_t*)(ws + WS_CQ);  pitch = 256; col0 = 64 * slot;        kind = 1; ssqd = (PG8_G float*)(ws + WS_SSQC);  ssqp = 4; ssqi = slot; }
        else if (slot < 6)  { dst = (PG8_G bf16_t*)(ws + WS_CKV); pitch = 128; col0 = 64 * (slot - 4);  kind = 1; ssqd = (PG8_G float*)(ws + WS_SSQC) + (size_t)MROWS_ * 4; ssqp = 2; ssqi = slot - 4; }
        else if (slot == 6) { kind = 3; }
        else if (slot < 14) { dst = (PG8_G bf16_t*)(ws + WS_QS);  pitch = 384; col0 = 64 * (slot - 8);  kind = 2; gain = gq; scale = 0.125f * LOG2E; }
        else if (slot < 16) { dst = (PG8_G bf16_t*)(ws + WS_KS);  pitch = 128; col0 = 64 * (slot - 14); kind = 2; gain = gk; }
        else if (slot < 18) { dst = (PG8_G bf16_t*)(ws + WS_VS);  pitch = 128; col0 = 64 * (slot - 16); }
        else if (slot < 22) { dst = (PG8_G bf16_t*)(ws + WS_QC);  pitch = 256; col0 = 64 * (slot - 18); scale = 0.125f * LOG2E; }
        else if (slot < 26) { dst = (PG8_G bf16_t*)(ws + WS_KC);  pitch = 256; col0 = 64 * (slot - 22); }
        else                { dst = (PG8_G bf16_t*)(ws + WS_VC);  pitch = 256; col0 = 64 * (slot - 26); }
        const PG8_G float* bb = bias + b * 2048 + u.pn * BM + wc * 32 + 8 * fq;
        f32x4 bv[2][2], gn[2][2];
#pragma unroll
        for (int bj = 0; bj < 2; ++bj)
#pragma unroll
            for (int n = 0; n < 2; ++n) { bv[bj][n] = *(const PG8_G f32x4*)(bb + bj * HALF + 4 * n);
                gn[bj][n] = (kind == 2) ? *(const PG8_G f32x4*)(gain + 32 * bj + 8 * fq + 4 * n) * scale : (f32x4){scale, scale, scale, scale}; }
#pragma unroll
        for (int ai = 0; ai < 2; ++ai)
#pragma unroll
            for (int m = 0; m < 4; ++m) {
                const int row = u.pm * BM + ai * HALF + wr * 64 + m * 16 + fr;
                const float r = 1.0f / sqrtf(sum16f(ssqx + (size_t)row * 16) * (1.0f / 1024.0f) + RMS_EPS);
                f32x4 v[2][2]; float ss = 0.f;
#pragma unroll
                for (int bj = 0; bj < 2; ++bj)
#pragma unroll
                    for (int n = 0; n < 2; ++n) { v[bj][n] = acc[ai][bj][m][n] * r + bv[bj][n]; ss += sq4(v[bj][n]); }
                if (kind == 3) {
                    float s0 = sq4(v[0][0]) + sq4(v[0][1]);
                    s0 = xsum32(xsum16(s0));
                    *(PG8_G f32x4*)((PG8_G float*)(ws + WS_KPE) + (size_t)row * 32 + 8 * fq) = v[0][0]; *(PG8_G f32x4*)((PG8_G float*)(ws + WS_KPE) + (size_t)row * 32 + 8 * fq + 4) = v[0][1];
                    if (fq == 0) ((PG8_G float*)(ws + WS_SSQC) + (size_t)MROWS_ * 6)[row] = s0;
                } else {
                    if (kind != 0) { ss = xsum32(xsum16(ss)); }
                    float rn = 1.0f;
                    if (kind == 2) rn = 1.0f / sqrtf(ss * (1.0f / 64.0f) + RMS_EPS);
                    if (kind == 1 && fq == 0) ssqd[(size_t)row * ssqp + ssqi] = ss;
#pragma unroll
                    for (int bj = 0; bj < 2; ++bj) {
                        const f32x4 y0 = v[bj][0] * gn[bj][0] * rn, y1 = v[bj][1] * gn[bj][1] * rn;
                        u32x4 w; w.x = cvt_pk_bf16(y0[0], y0[1]); w.y = cvt_pk_bf16(y0[2], y0[3]); w.z = cvt_pk_bf16(y1[0], y1[1]); w.w = cvt_pk_bf16(y1[2], y1[3]);
                        *(PG8_G u32x4*)(dst + (size_t)row * pitch + col0 + 32 * bj + 8 * fq) = w;
                    }
                }
                if (m & 1) PG8_FENCE();
            }
    }
};

struct EpiUq {
    static constexpr bool PERM = false, AFTER_DRAIN = false, HOOK = false;
    PG8_G unsigned char* ws;
    __device__ __forceinline__ void hook(f32x4 (&)[2][2][4][2], const Unit&, int, int, int, int, int) const {}
    __device__ __forceinline__ void operator()(const f32x4 (&acc)[2][2][4][2], const Unit& u, int wr, int wc, int fr, int fq) const {
        PG8_G bf16_t* QRAW = (PG8_G bf16_t*)(ws + WS_QRAW); const PG8_G float* ssqcq = (const PG8_G float*)(ws + WS_SSQC);
        const int col0 = u.pn * BM + wc * 32 + 4 * fq;
#pragma unroll
        for (int ai = 0; ai < 2; ++ai)
#pragma unroll
            for (int m = 0; m < 4; ++m) {
                const int row = u.pm * BM + ai * HALF + wr * 64 + m * 16 + fr;
                const f32x4 s = *(const PG8_G f32x4*)(ssqcq + (size_t)row * 4);
                const float r = 1.0f / sqrtf(((s[0] + s[1]) + (s[2] + s[3])) * (1.0f / 256.0f) + RMS_EPS);
#pragma unroll
                for (int bj = 0; bj < 2; ++bj)
#pragma unroll
                    for (int n = 0; n < 2; ++n) { const int c = col0 + bj * HALF + n * 16; if (c < 576) { const f32x4 y = acc[ai][bj][m][n] * r; u32x2 w; w.x = cvt_pk_bf16(y[0], y[1]); w.y = cvt_pk_bf16(y[2], y[3]); *(PG8_G u32x2*)(QRAW + (size_t)row * 576 + c) = w; } }
            }
    }
};

struct EpiUkv {
    static constexpr bool PERM = true, AFTER_DRAIN = false, HOOK = false;
    PG8_G unsigned char* ws; const PG8_G float* gk;
    __device__ __forceinline__ void hook(f32x4 (&)[2][2][4][2], const Unit&, int, int, int, int, int) const {}
    __device__ __forceinline__ void operator()(const f32x4 (&acc)[2][2][4][2], const Unit& u, int wr, int wc, int fr, int fq) const {
        PG8_G bf16_t* KA = (PG8_G bf16_t*)(ws + WS_KA); PG8_G bf16_t* VA = (PG8_G bf16_t*)(ws + WS_VA); const PG8_G float* ssqckv = (const PG8_G float*)(ws + WS_SSQC) + (size_t)MROWS_ * 4; const PG8_G float* ssqkpe = (const PG8_G float*)(ws + WS_SSQC) + (size_t)MROWS_ * 6;
        const PG8_G float* kpe = (const PG8_G float*)(ws + WS_KPE); const PG8_G float* cs = (const PG8_G float*)(ws + WS_CS);
        const int h = 2 * u.pn + (wc >> 1); const bool isv = (wc & 1) != 0;
        f32x4 gn[2][2], g1 = {1.f, 1.f, 1.f, 1.f}, g2 = {1.f, 1.f, 1.f, 1.f};
        if (!isv) {
#pragma unroll
            for (int bj = 0; bj < 2; ++bj)
#pragma unroll
                for (int n = 0; n < 2; ++n) gn[bj][n] = *(const PG8_G f32x4*)(gk + 32 * bj + 8 * fq + 4 * n);
            g1 = *(const PG8_G f32x4*)(gk + 64 + 4 * fq); g2 = *(const PG8_G f32x4*)(gk + 80 + 4 * fq);
        }
#pragma unroll
        for (int ai = 0; ai < 2; ++ai)
#pragma unroll
            for (int m = 0; m < 4; ++m) {
                const int row = u.pm * BM + ai * HALF + wr * 64 + m * 16 + fr;
                const float r = 1.0f / sqrtf((ssqckv[(size_t)row * 2] + ssqckv[(size_t)row * 2 + 1]) * (1.0f / 128.0f) + RMS_EPS);
                f32x4 v[2][2]; float ss = 0.f;
#pragma unroll
                for (int bj = 0; bj < 2; ++bj)
#pragma unroll
                    for (int n = 0; n < 2; ++n) { v[bj][n] = acc[ai][bj][m][n] * r; ss += sq4(v[bj][n]); }
                if (isv) {
#pragma unroll
                    for (int bj = 0; bj < 2; ++bj) { u32x4 w; w.x = cvt_pk_bf16(v[bj][0][0], v[bj][0][1]); w.y = cvt_pk_bf16(v[bj][0][2], v[bj][0][3]); w.z = cvt_pk_bf16(v[bj][1][0], v[bj][1][1]); w.w = cvt_pk_bf16(v[bj][1][2], v[bj][1][3]);
                        *(PG8_G u32x4*)(VA + ((size_t)(row >> 6) * 6 + h) * 4096 + bj * 2048 + (row & 63) * 32 + 8 * fq) = w; }
                } else {
                    ss = xsum32(xsum16(ss));
                    const float rk = 1.0f / sqrtf((ss + ssqkpe[row]) * (1.0f / 96.0f) + RMS_EPS);
                    PG8_G bf16_t* kd = KA + ((size_t)(row >> 6) * 6 + h) * 6144 + (row & 63) * 8;
#pragma unroll
                    for (int bj = 0; bj < 2; ++bj) { const f32x4 y0 = v[bj][0] * gn[bj][0] * rk, y1 = v[bj][1] * gn[bj][1] * rk;
                        u32x4 w; w.x = cvt_pk_bf16(y0[0], y0[1]); w.y = cvt_pk_bf16(y0[2], y0[3]); w.z = cvt_pk_bf16(y1[0], y1[1]); w.w = cvt_pk_bf16(y1[2], y1[3]);
                        *(PG8_G u32x4*)(kd + (4 * bj + fq) * 512) = w; }
                    const f32x4 x1 = *(const PG8_G f32x4*)(kpe + (size_t)row * 32 + 4 * fq) * g1 * rk, x2 = *(const PG8_G f32x4*)(kpe + (size_t)row * 32 + 16 + 4 * fq) * g2 * rk;
                    const f32x4 c = *(const PG8_G f32x4*)(cs + (size_t)row * 32 + 4 * fq), s = *(const PG8_G f32x4*)(cs + (size_t)row * 32 + 16 + 4 * fq);
                    const f32x4 o1 = x1 * c - x2 * s, o2 = x2 * c + x1 * s;
                    u32x2 w1, w2; w1.x = cvt_pk_bf16(o1[0], o1[1]); w1.y = cvt_pk_bf16(o1[2], o1[3]); w2.x = cvt_pk_bf16(o2[0], o2[1]); w2.y = cvt_pk_bf16(o2[2], o2[3]);
                    *(PG8_G u32x2*)(kd + (8 + (fq >> 1)) * 512 + (fq & 1) * 4) = w1; *(PG8_G u32x2*)(kd + (10 + (fq >> 1)) * 512 + (fq & 1) * 4) = w2;
                }
                if (m & 1) PG8_FENCE();
            }
    }
};
}
#define GAS __attribute__((address_space(1)))
#define LAS __attribute__((address_space(3)))
typedef unsigned short bf16;
typedef unsigned v4u __attribute__((ext_vector_type(4)));
typedef float f32x4 __attribute__((ext_vector_type(4)));
typedef short bf16x8 __attribute__((ext_vector_type(8)));
typedef GAS unsigned gu32;
typedef GAS unsigned long long gu64;
#define RLX_AGENT __ATOMIC_RELAXED, __HIP_MEMORY_SCOPE_AGENT
#define LDS_WAIT() asm volatile("s_waitcnt lgkmcnt(0)" ::: "memory")
#define VM_WAIT() asm volatile("s_waitcnt vmcnt(0)" ::: "memory")
__device__ __forceinline__ unsigned long long rt() { return __builtin_amdgcn_s_memrealtime(); }
__device__ __forceinline__ unsigned f2bf(float f) { unsigned u = __builtin_bit_cast(unsigned, f); return (u + 0x7fffu + ((u >> 16) & 1u)) >> 16; }
__device__ __forceinline__ unsigned pk2(float lo, float hi) { return f2bf(lo) | (f2bf(hi) << 16); }

#define XB_TMO      128
#define XB_XCNT(j)  (256  + 64 * (j))
#define XB_XSUB(j)  (1280 + 64 * (j))
#define XB_XGEN(j)  (2304 + 64 * (j))
#define XB_TOP      3328
#define XB_TOPGEN   3392
#define XCD_BAR_WORDS 3456
#define XB_SPIN_CAP (1u << 18)

__device__ __forceinline__ unsigned xb_ld(unsigned* p)              { return __hip_atomic_load(p, __ATOMIC_RELAXED, __HIP_MEMORY_SCOPE_AGENT); }
__device__ __forceinline__ unsigned xb_add(unsigned* p, unsigned v) { return __hip_atomic_fetch_add(p, v, __ATOMIC_RELAXED, __HIP_MEMORY_SCOPE_AGENT); }
__device__ __forceinline__ unsigned xb_xcc_id() { return (unsigned)__builtin_amdgcn_s_getreg((3 << 11) | 20) & 0xFu; }
#define XB_SPIN(cond, bar) do { unsigned _sp = 0; while (cond) { __builtin_amdgcn_s_sleep(1); \
    if ((++_sp & 255u) == 0u) { if (xb_ld(&(bar)[XB_TMO])) break; if (_sp > XB_SPIN_CAP) { atomicAdd(&(bar)[XB_TMO], 1u); break; } } } } while (0)

struct XcdBarrier {
    unsigned* bar; unsigned x;
    volatile LAS unsigned* st;
    int w0;
};

__device__ __forceinline__ XcdBarrier xcd_barrier_post(unsigned* bar, volatile LAS unsigned* st, int w0) {
    XcdBarrier b; b.bar = bar; b.x = xb_xcc_id(); b.st = st; b.w0 = w0;
    if (w0 == 0 && hw_lane() == 0) (void)xb_add(&bar[XB_XCNT(b.x)], 1u);
    return b;
}
__device__ __forceinline__ void xcd_barrier_complete(unsigned* bar, unsigned x, unsigned& nloc, unsigned& nx) {
    const unsigned G = gridDim.x * gridDim.y * gridDim.z;
    unsigned sum, cnt, mine, sp = 0u;
    for (;;) {
        sum = 0u; cnt = 0u; mine = 0u;
#pragma unroll
        for (unsigned j = 0; j < 16; ++j) { const unsigned c = xb_ld(&bar[XB_XCNT(j)]); sum += c; cnt += (c > 0u) ? 1u : 0u; mine = (j == x) ? c : mine; }
        if (sum == G) break;
        __builtin_amdgcn_s_sleep(1);
        if ((++sp & 255u) == 0u) { if (xb_ld(&bar[XB_TMO])) break; if (sp > XB_SPIN_CAP) { atomicAdd(&bar[XB_TMO], 1u); break; } }
    }
    nloc = mine > 0u ? mine : 1u; nx = cnt > 0u ? cnt : 1u;
}

__device__ __forceinline__ void xcd_barrier(const XcdBarrier& b) {
    asm volatile("s_waitcnt vmcnt(0)" ::: "memory");
    __syncthreads();
    if (b.w0 == 0 && hw_lane() == 0) {
        unsigned* bar = b.bar;
        __builtin_amdgcn_s_waitcnt(0);
        unsigned nloc = b.st[0], nx = b.st[1];
        if (nloc == 0u) { xcd_barrier_complete(bar, b.x, nloc, nx); b.st[0] = nloc; b.st[1] = nx; }
        const unsigned old = xb_add(&bar[XB_XSUB(b.x)], 1u);
        const unsigned gen = old / nloc;
        if (old + 1u == (gen + 1u) * nloc) {
            __builtin_amdgcn_fence(__ATOMIC_RELEASE, "agent");
            asm volatile("s_waitcnt vmcnt(0)" ::: "memory");
            const unsigned og = xb_add(&bar[XB_TOP], 1u);
            const unsigned tg = og / nx;
            if (og + 1u == (tg + 1u) * nx) xb_add(&bar[XB_TOPGEN], 1u);
            else XB_SPIN(xb_ld(&bar[XB_TOPGEN]) == tg, bar);
            __builtin_amdgcn_fence(__ATOMIC_ACQUIRE, "agent");
            xb_add(&bar[XB_XGEN(b.x)], 1u);
            asm volatile("s_waitcnt vmcnt(0)" ::: "memory");
        } else {
            XB_SPIN(xb_ld(&bar[XB_XGEN(b.x)]) == gen, bar);
            __builtin_amdgcn_fence(__ATOMIC_ACQUIRE, "agent");
            asm volatile("s_waitcnt vmcnt(0)" ::: "memory");
        }
    }
    __syncthreads();
}
namespace att {
typedef unsigned short bf16_t;
typedef short bf16x8 __attribute__((ext_vector_type(8)));
typedef short s16x4 __attribute__((ext_vector_type(4)));
typedef short v4i16_t __attribute__((ext_vector_type(4)));
typedef float f32x16 __attribute__((ext_vector_type(16)));
typedef float f32x4 __attribute__((ext_vector_type(4)));
typedef float f32x2 __attribute__((ext_vector_type(2)));
typedef __bf16 bf16x2_t __attribute__((ext_vector_type(2)));
typedef unsigned u32x4 __attribute__((ext_vector_type(4)));
typedef int i32x4 __attribute__((ext_vector_type(4)));
#define ALAS __attribute__((address_space(3)))
#define AGAS __attribute__((address_space(1)))
constexpr int SEQ = 8192;
constexpr float LOG2E = 1.4426950408889634f, EPS = 1e-6f;
constexpr int KCS = 1040, VHS = 4160;
constexpr int KSLOT = 12 * KCS, VSLOT = 2 * VHS;
constexpr int L_K = 0, L_V = 3 * KSLOT, L_POS = L_V + 4 * VSLOT, L_TB = L_POS + 1024, L_WSF = L_TB + 128, L_OST = L_WSF + 8 * 256, L_FLAG = L_OST + 8 * 4096, L_END = L_FLAG + 16 + 64;
static_assert(L_OST % 16 == 0 && L_V % 16 == 0 && L_END <= 131072, "attention LDS map");

__device__ __forceinline__ int crow(int r, int hi) { return (r & 3) + 8 * (r >> 2) + 4 * hi; }
__device__ __forceinline__ unsigned cvtpk(float lo, float hi) { f32x2 v = {lo, hi}; bf16x2_t b = __builtin_convertvector(v, bf16x2_t); return __builtin_bit_cast(unsigned, b); }
__device__ __forceinline__ s16x4 vtr(const ALAS unsigned char* p) { return __builtin_bit_cast(s16x4, __builtin_amdgcn_ds_read_tr16_b64_v4i16((ALAS v4i16_t*)p)); }
__device__ __forceinline__ float swap_sum(float x) { auto rr = __builtin_amdgcn_permlane32_swap(__float_as_uint(x), __float_as_uint(x), false, false); return __uint_as_float(rr[0]) + __uint_as_float(rr[1]); }
__device__ __forceinline__ float swap_max(float x) { auto rr = __builtin_amdgcn_permlane32_swap(__float_as_uint(x), __float_as_uint(x), false, false); return fmaxf(__uint_as_float(rr[0]), __uint_as_float(rr[1])); }
__device__ __forceinline__ float bf2f(unsigned short h) { return __uint_as_float((unsigned)h << 16); }

__device__ __forceinline__ void glds16(const AGAS void* gsrc, unsigned lds_dst) { unsigned keep;
    asm volatile("s_mov_b32 %0, m0\n\ts_mov_b32 m0, %2\n\ts_nop 0\n\tglobal_load_lds_dwordx4 %1, off\n\ts_mov_b32 m0, %0" : "=&s"(keep) : "v"(gsrc), "s"(lds_dst) : "memory"); }
__device__ __forceinline__ void glds4(const AGAS void* gsrc, unsigned lds_dst) { unsigned keep;
    asm volatile("s_mov_b32 %0, m0\n\ts_mov_b32 m0, %2\n\ts_nop 0\n\tglobal_load_lds_dword %1, off\n\ts_mov_b32 m0, %0" : "=&s"(keep) : "v"(gsrc), "s"(lds_dst) : "memory"); }

struct AttnP {
    AGAS unsigned char* ws;
    const AGAS float* gq;
    const AGAS int* pos; const AGAS float* sinks; const AGAS float* relb;
};
template <int MODE> struct AttnCfg;
template <> struct AttnCfg<0> { static constexpr size_t Q = WS_QRAW, K = WS_KA, V = WS_VA; static constexpr int qpitch = 576, kpitch = 576, khs = 96, vpitch = 384, vhs = 64, ocol0 = 0, hidx0 = 0, group = 1; };
template <> struct AttnCfg<1> { static constexpr size_t Q = WS_QS, K = WS_KS, V = WS_VS; static constexpr int qpitch = 384, kpitch = 128, khs = 64, vpitch = 128, vhs = 64, ocol0 = 384, hidx0 = 6, group = 3; };
template <> struct AttnCfg<2> { static constexpr size_t Q = WS_QC, K = WS_KC, V = WS_VC; static constexpr int qpitch = 256, kpitch = 256, khs = 64, vpitch = 256, vhs = 64, ocol0 = 768, hidx0 = 12, group = 1; };

#ifdef ATT_PROF
#define PROF_T() ((MODE == 0 && blockIdx.x == 0) ? (long long)clock64() : 0ll)
#else
#define PROF_T() 0ll
#endif
template <int DQK, int MODE>
__device__ __forceinline__ void attn_unit(ALAS unsigned char* lds, const AttnP& P, int b, int h, int qb, int wave0, unsigned long long* prof = nullptr) {
    long long pf_qk = 0, pf_sm = 0, pf_pv = 0, pf_wait = 0; const long long pf_t0 = PROF_T();
    constexpr int NCH = DQK / 8, ND0 = DQK / 16;
    int tid_ = wave0 * 64 + hw_lane(); asm volatile("" : "+v"(tid_));
    const int tid = tid_, lane = tid & 63, r32 = lane & 31, hi = lane >> 5;
    const int wid = __builtin_amdgcn_readfirstlane(tid >> 6);
    const int q0 = qb * 256, qlo = q0 + 32 * wid, qhi = qlo + 31, qrow = qlo + r32;
    const size_t rb = (size_t)b * SEQ;
    typedef AttnCfg<MODE> C; const int kvh = h / C::group;
    ALAS float* wsf = (ALAS float*)(lds + L_WSF) + wid * 64;
    ALAS unsigned char* ost = lds + L_OST + wid * 4096;
    ALAS int* posl = (ALAS int*)(lds + L_POS);
    ALAS float* tb = (ALAS float*)(lds + L_TB);

    bf16x8 qf[ND0];
    if constexpr (MODE == 0) {
        const AGAS bf16_t* qp = (const AGAS bf16_t*)(P.ws + C::Q) + (rb + qrow) * 576 + h * 96 + hi * 8;
        float qv[ND0][8]; float ss = 0.f;
#pragma unroll
        for (int d0 = 0; d0 < ND0; ++d0) { const u32x4 w = *(const AGAS u32x4*)(qp + 16 * d0);
#pragma unroll
            for (int i = 0; i < 4; ++i) { const float lo = __uint_as_float(w[i] << 16), hv = __uint_as_float(w[i] & 0xffff0000u); qv[d0][2 * i] = lo; qv[d0][2 * i + 1] = hv; ss += lo * lo + hv * hv; } }
        ss = swap_sum(ss);
        const float rq = 1.0f / sqrtf(ss * (1.0f / 96.0f) + EPS);
#pragma unroll
        for (int d0 = 0; d0 < ND0; ++d0) { const f32x4 ga = *(const AGAS f32x4*)(P.gq + 16 * d0 + 8 * hi), gb = *(const AGAS f32x4*)(P.gq + 16 * d0 + 8 * hi + 4);
#pragma unroll
            for (int i = 0; i < 4; ++i) { qv[d0][i] *= rq * ga[i]; qv[d0][4 + i] *= rq * gb[i]; } }
        {
            const AGAS float* cp = (const AGAS float*)(P.ws + WS_CS) + (rb + qrow) * 32 + 8 * hi;
            const f32x4 c0 = *(const AGAS f32x4*)cp, c1 = *(const AGAS f32x4*)(cp + 4), s0 = *(const AGAS f32x4*)(cp + 16), s1 = *(const AGAS f32x4*)(cp + 20);
#pragma unroll
            for (int i = 0; i < 8; ++i) { const float c = i < 4 ? c0[i & 3] : c1[i & 3], s = i < 4 ? s0[i & 3] : s1[i & 3]; const float x1 = qv[4][i], x2 = qv[5][i]; qv[4][i] = x1 * c - x2 * s; qv[5][i] = x2 * c + x1 * s; }
        }
        const float sc = 0.10206207261596575f * LOG2E;
#pragma unroll
        for (int d0 = 0; d0 < ND0; ++d0) { u32x4 w; w.x = cvtpk(qv[d0][0] * sc, qv[d0][1] * sc); w.y = cvtpk(qv[d0][2] * sc, qv[d0][3] * sc); w.z = cvtpk(qv[d0][4] * sc, qv[d0][5] * sc); w.w = cvtpk(qv[d0][6] * sc, qv[d0][7] * sc); qf[d0] = __builtin_bit_cast(bf16x8, w); }
    } else {
        const AGAS bf16_t* qp = (const AGAS bf16_t*)(P.ws + C::Q) + (rb + qrow) * C::qpitch + h * 64 + hi * 8;
#pragma unroll
        for (int d0 = 0; d0 < ND0; ++d0) qf[d0] = *(const AGAS bf16x8*)(qp + 16 * d0);
    }
    int posq = 0; float sink2 = 0.f;
    if constexpr (MODE == 1) {
        posq = P.pos[rb + qrow]; sink2 = P.sinks[h] * LOG2E;
        if (tid < 32) tb[tid] = P.relb[tid * 6 + h] * LOG2E;
    }

    int ntile, tfirst, tstep;
    if (MODE == 0) { tfirst = 0; tstep = 1; ntile = ((q0 + 255) >> 6) + 1; }
    else if (MODE == 1) { const int lo = q0 - 127 > 0 ? q0 - 127 : 0; tfirst = lo >> 6; tstep = 1; ntile = ((q0 + 255) >> 6) - tfirst + 1; }
    else { tfirst = (q0 + 254) >> 6; tstep = -1; ntile = tfirst + 1; }

    const AGAS bf16_t* Kg = (const AGAS bf16_t*)(P.ws + C::K) + rb * C::kpitch + kvh * C::khs;
    const AGAS bf16_t* Vg = (const AGAS bf16_t*)(P.ws + C::V) + rb * C::vpitch + kvh * C::vhs;
    const unsigned lds0 = (unsigned)(uintptr_t)lds;
    const AGAS bf16_t* ksrc0 = (MODE == 0) ? (const AGAS bf16_t*)(P.ws + C::K) + ((size_t)b * 128 * 6 + h) * 6144 + wid * 512 + lane * 8 : Kg + (size_t)lane * C::kpitch + 8 * wid;
    const AGAS bf16_t* vsrc = (MODE == 0) ? (const AGAS bf16_t*)(P.ws + C::V) + ((size_t)b * 128 * 6 + h) * 4096 + (wid >> 2) * 2048 + (wid & 3) * 512 + lane * 8
                                          : Vg + (size_t)(16 * (wid & 3) + (lane >> 2)) * C::vpitch + 32 * (wid >> 2) + 8 * (lane & 3);
    constexpr size_t KTS = (MODE == 0) ? (size_t)6 * 6144 : (size_t)64 * C::kpitch, VTS = (MODE == 0) ? (size_t)6 * 4096 : (size_t)64 * C::vpitch, K2O = (MODE == 0) ? 8 * 512 : 64;
    const bool k2 = (wid + 8) < NCH;
    const bool posw = (MODE == 1) && wid == 0;
    const int NP = 2 + (k2 ? 1 : 0) + (posw ? 1 : 0);
#define ATT_ISSUE(T, IT) do { const int T_ = (T); const size_t jo_ = (size_t)T_ * 64; const int ks_ = (IT) % 3, vs_ = (IT) & 3;     \
        glds16(ksrc0 + (size_t)T_ * KTS, (unsigned)__builtin_amdgcn_readfirstlane(lds0 + L_K + ks_ * KSLOT + wid * KCS)); \
        if (k2) glds16(ksrc0 + (size_t)T_ * KTS + K2O, (unsigned)__builtin_amdgcn_readfirstlane(lds0 + L_K + ks_ * KSLOT + (wid + 8) * KCS)); \
        glds16(vsrc + (size_t)T_ * VTS, (unsigned)__builtin_amdgcn_readfirstlane(lds0 + L_V + vs_ * VSLOT + (wid >> 2) * VHS + (wid & 3) * 1024)); \
        if (posw) glds4(P.pos + rb + jo_ + lane, (unsigned)__builtin_amdgcn_readfirstlane(lds0 + L_POS + vs_ * 256)); } while (0)
#define ATT_WAIT_BAR(n_) do { if ((n_) <= 0) asm volatile("s_waitcnt vmcnt(0) lgkmcnt(0)\n\ts_barrier" ::: "memory"); \
        else if (NP == 2) asm volatile("s_waitcnt vmcnt(2) lgkmcnt(0)\n\ts_barrier" ::: "memory"); \
        else if (NP == 3) asm volatile("s_waitcnt vmcnt(3) lgkmcnt(0)\n\ts_barrier" ::: "memory"); \
        else asm volatile("s_waitcnt vmcnt(4) lgkmcnt(0)\n\ts_barrier" ::: "memory"); } while (0)

    f32x16 o0 = {}, o1 = {};
    float mrun = (MODE == 1) ? sink2 : 0.f;
    float lrun = (MODE == 1 && hi == 0) ? 1.0f : 0.f;
    f32x16 negm;
#pragma unroll
    for (int r = 0; r < 16; ++r) negm[r] = (MODE == 2) ? 0.f : -mrun;
    bool first = (MODE == 0);
    float after = 0.f;
    bool walive = true;
    const int vrd = ((lane >> 4) & 1) * 32 + (lane & 3) * 8 + (4 * hi + ((lane & 15) >> 2)) * 64;
    const bool lag = wid >= 4;
    constexpr float THR = 4.0f;

#define ATT_QK(P0, P1, kb) do { int kofs_ = L_K + (kb) * KSLOT + hi * KCS + r32 * 16; asm volatile("" : "+v"(kofs_)); const ALAS unsigned char* Kb_ = lds + kofs_;     \
        bf16x8 kfa_[4], kfb_[4]; \
        _Pragma("unroll") for (int d0 = 0; d0 < 3; ++d0) { kfa_[d0] = *(const ALAS bf16x8*)(Kb_ + 2 * d0 * KCS); kfb_[d0] = *(const ALAS bf16x8*)(Kb_ + 2 * d0 * KCS + 512); } \
        \
        _Pragma("unroll") for (int d0 = 0; d0 < ND0; ++d0) { \
            if (d0 + 3 < ND0) { kfa_[(d0 + 3) & 3] = *(const ALAS bf16x8*)(Kb_ + 2 * (d0 + 3) * KCS); kfb_[(d0 + 3) & 3] = *(const ALAS bf16x8*)(Kb_ + 2 * (d0 + 3) * KCS + 512); } \
            if (d0 == 0) { P0 = __builtin_amdgcn_mfma_f32_32x32x16_bf16(kfa_[0], qf[0], negm, 0, 0, 0); P1 = __builtin_amdgcn_mfma_f32_32x32x16_bf16(kfb_[0], qf[0], negm, 0, 0, 0); } \
            else { P0 = __builtin_amdgcn_mfma_f32_32x32x16_bf16(kfa_[d0 & 3], qf[d0], P0, 0, 0, 0); P1 = __builtin_amdgcn_mfma_f32_32x32x16_bf16(kfb_[d0 & 3], qf[d0], P1, 0, 0, 0); } \
            } } while (0)
#define ATT_VLD(i_, s_) do { vl0_[i_] = vtr(Vb_ + (s_) * 1024); vh0_[i_] = vtr(Vb_ + (s_) * 1024 + 512); vl1_[i_] = vtr(Vb_ + VHS + (s_) * 1024); vh1_[i_] = vtr(Vb_ + VHS + (s_) * 1024 + 512); } while (0)
#define ATT_PV(vb) do { int vofs_ = L_V + (vb) * VSLOT + vrd; asm volatile("" : "+v"(vofs_)); const ALAS unsigned char* Vb_ = lds + vofs_; \
        s16x4 vl0_[2], vh0_[2], vl1_[2], vh1_[2]; ATT_VLD(0, 0); \
        _Pragma("unroll") for (int s_ = 0; s_ < 4; ++s_) { \
            if (s_ + 1 < 4) ATT_VLD((s_ + 1) & 1, s_ + 1); \
            const int i_ = s_ & 1; const bf16x8 pa_ = __builtin_bit_cast(bf16x8, pw[s_]); \
            const bf16x8 v0_ = {vl0_[i_][0], vl0_[i_][1], vl0_[i_][2], vl0_[i_][3], vh0_[i_][0], vh0_[i_][1], vh0_[i_][2], vh0_[i_][3]}, v1_ = {vl1_[i_][0], vl1_[i_][1], vl1_[i_][2], vl1_[i_][3], vh1_[i_][0], vh1_[i_][1], vh1_[i_][2], vh1_[i_][3]}; \
            o0 = __builtin_amdgcn_mfma_f32_32x32x16_bf16(pa_, v0_, o0, 0, 0, 0); o1 = __builtin_amdgcn_mfma_f32_32x32x16_bf16(pa_, v1_, o1, 0, 0, 0); } } while (0)
#define ATT_PACK(P0, P1) do { \
        pw[0].x = cvtpk(P0[0], P0[1]); pw[0].y = cvtpk(P0[2], P0[3]); pw[0].z = cvtpk(P0[4], P0[5]); pw[0].w = cvtpk(P0[6], P0[7]); \
        pw[1].x = cvtpk(P0[8], P0[9]); pw[1].y = cvtpk(P0[10], P0[11]); pw[1].z = cvtpk(P0[12], P0[13]); pw[1].w = cvtpk(P0[14], P0[15]); \
        pw[2].x = cvtpk(P1[0], P1[1]); pw[2].y = cvtpk(P1[2], P1[3]); pw[2].z = cvtpk(P1[4], P1[5]); pw[2].w = cvtpk(P1[6], P1[7]); \
        pw[3].x = cvtpk(P1[8], P1[9]); pw[3].y = cvtpk(P1[10], P1[11]); pw[3].z = cvtpk(P1[12], P1[13]); pw[3].w = cvtpk(P1[14], P1[15]); } while (0)
#define ATT_MAX3(a, b, c) fmaxf(fmaxf((a), (b)), (c))
#define ATT_SM_A(P0, P1, j0_, pslot) do { if constexpr (MODE != 2) { \
            if constexpr (MODE == 1) { \
                _Pragma("unroll") for (int g = 0; g < 4; ++g) { \
                    const i32x4 pa = *(const ALAS i32x4*)(posl + (pslot) * 64 + 8 * g + 4 * hi), pb = *(const ALAS i32x4*)(posl + (pslot) * 64 + 32 + 8 * g + 4 * hi); \
                    _Pragma("unroll") for (int i = 0; i < 4; ++i) { \
                        { int n = posq - pa[i]; n = n > 0 ? n : 0; int bk = n; if (n >= 16) { bk = 16 + (int)((__builtin_amdgcn_logf((float)n) - 4.0f) * (16.0f / 3.0f)); bk = bk < 31 ? bk : 31; } P0[4 * g + i] += tb[bk]; } \
                        { int n = posq - pb[i]; n = n > 0 ? n : 0; int bk = n; if (n >= 16) { bk = 16 + (int)((__builtin_amdgcn_logf((float)n) - 4.0f) * (16.0f / 3.0f)); bk = bk < 31 ? bk : 31; } P1[4 * g + i] += tb[bk]; } } } } \
            const bool nm_ = (MODE == 1) || ((j0_) + 63 > qlo); \
            if (nm_) { \
                _Pragma("unroll") for (int r = 0; r < 16; ++r) { const int key = (j0_) + crow(r, hi); \
                    bool ok0 = key <= qrow, ok1 = key + 32 <= qrow; \
                    if (MODE == 1) { ok0 = ok0 && (key > qrow - 128); ok1 = ok1 && (key + 32 > qrow - 128); } \
                    if (!ok0) P0[r] = -INFINITY; if (!ok1) P1[r] = -INFINITY; } } \
            float ma = ATT_MAX3(P0[0], P0[1], P1[0]), mb = ATT_MAX3(P0[2], P0[3], P1[1]); ma = ATT_MAX3(ma, P1[2], P1[3]); \
            _Pragma("unroll") for (int r = 4; r < 16; r += 4) { ma = ATT_MAX3(ma, P0[r], P0[r + 1]); mb = ATT_MAX3(mb, P0[r + 2], P0[r + 3]); ma = ATT_MAX3(ma, P1[r], P1[r + 1]); mb = ATT_MAX3(mb, P1[r + 2], P1[r + 3]); } \
            const float mt = swap_max(fmaxf(ma, mb)); \
            if (first || __any(mt > THR)) {                                 \
                const float d = first ? mt : fmaxf(mt, 0.f); first = false; \
                _Pragma("unroll") for (int r = 0; r < 16; ++r) { P0[r] -= d; P1[r] -= d; } \
                const float alpha = __builtin_amdgcn_exp2f(-d); mrun += d; lrun *= alpha; \
                _Pragma("unroll") for (int r = 0; r < 16; ++r) negm[r] = -mrun; \
                if (hi == 0) wsf[r32] = alpha; \
                _Pragma("unroll") for (int g = 0; g < 4; ++g) { const f32x4 al = *(const ALAS f32x4*)(wsf + 8 * g + 4 * hi); \
                    _Pragma("unroll") for (int i = 0; i < 4; ++i) { o0[4 * g + i] *= al[i]; o1[4 * g + i] *= al[i]; } } } } } while (0)
#define ATT_SM_B(P0, P1, j0_) do { \
        if constexpr (MODE == 2) { \
            const bool nm_ = (j0_) + 63 >= qlo; \
            float ln0[16], ln1[16]; \
            _Pragma("unroll") for (int r = 0; r < 16; ++r) { const int key = (j0_) + crow(r, hi); \
                { const float z = P0[r]; const float sp = fmaxf(z, 0.f) + __builtin_amdgcn_logf(1.0f + __builtin_amdgcn_exp2f(-fabsf(z))); const bool ok = !nm_ || key < qrow; ln0[r] = ok ? -sp : 0.f; P0[r] = ok ? z - sp : -INFINITY; } \
                { const float z = P1[r]; const float sp = fmaxf(z, 0.f) + __builtin_amdgcn_logf(1.0f + __builtin_amdgcn_exp2f(-fabsf(z))); const bool ok = !nm_ || key + 32 < qrow; ln1[r] = ok ? -sp : 0.f; P1[r] = ok ? z - sp : -INFINITY; } } \
            float run = after; \
            _Pragma("unroll") for (int blk = 1; blk >= 0; --blk) _Pragma("unroll") for (int g = 3; g >= 0; --g) { \
                const float own = blk ? ((ln1[4 * g] + ln1[4 * g + 1]) + (ln1[4 * g + 2] + ln1[4 * g + 3])) : ((ln0[4 * g] + ln0[4 * g + 1]) + (ln0[4 * g + 2] + ln0[4 * g + 3])); \
                auto rr = __builtin_amdgcn_permlane32_swap(__float_as_uint(own), __float_as_uint(own), false, false); \
                const float slo = __uint_as_float(rr[0]), shi = __uint_as_float(rr[1]); \
                const float e1 = run; run += shi; const float e0 = run; run += slo; \
                float aft = hi ? e1 : e0; \
                _Pragma("unroll") for (int i = 3; i >= 0; --i) { const int r = 4 * g + i; \
                    if (blk) { P1[r] = __builtin_amdgcn_exp2f(P1[r] + aft); aft += ln1[r]; } else { P0[r] = __builtin_amdgcn_exp2f(P0[r] + aft); aft += ln0[r]; } } } \
            after = run; walive = __any(after > -160.0f); \
        } else { \
            float ls = 0.f; \
            _Pragma("unroll") for (int r = 0; r < 16; ++r) { P0[r] = __builtin_amdgcn_exp2f(P0[r]); P1[r] = __builtin_amdgcn_exp2f(P1[r]); ls += P0[r] + P1[r]; } \
            lrun += ls; } \
        ATT_PACK(P0, P1); } while (0)
#define ATT_WORK(j0_) ((MODE == 0) ? ((j0_) <= qhi) : (MODE == 1) ? (((j0_) <= qhi) && ((j0_) + 63 >= qlo - 127)) : (walive && ((j0_) < qhi)))

    if constexpr (MODE == 0) {
    f32x16 p0, p1, n0, n1; u32x4 pw[4];
    __syncthreads();
    int issued = 0;
    ATT_ISSUE(0, 0);
    if (ntile > 1) { ATT_ISSUE(1, 1); issued = 1; }
    if (ntile > 2) { ATT_ISSUE(2, 2); issued = 2; }
    ATT_WAIT_BAR(issued - 1);
    const int tmax = qhi >> 6;
#define MLA_SB() __builtin_amdgcn_sched_barrier(0)
#define MLA_EX(v) __builtin_amdgcn_exp2f(v)
#define MLA_DECIDE(X0, X1, j0_) do { \
        if ((j0_) + 63 > qlo) { _Pragma("unroll") for (int r = 0; r < 16; ++r) { const int key = (j0_) + crow(r, hi); if (key > qrow) X0[r] = -INFINITY; if (key + 32 > qrow) X1[r] = -INFINITY; } } \
        float ma = ATT_MAX3(X0[0], X0[1], X1[0]), mb = ATT_MAX3(X0[2], X0[3], X1[1]); ma = ATT_MAX3(ma, X1[2], X1[3]); \
        _Pragma("unroll") for (int r = 4; r < 16; r += 4) { ma = ATT_MAX3(ma, X0[r], X0[r + 1]); mb = ATT_MAX3(mb, X0[r + 2], X0[r + 3]); ma = ATT_MAX3(ma, X1[r], X1[r + 1]); mb = ATT_MAX3(mb, X1[r + 2], X1[r + 3]); } \
        const float mt = swap_max(fmaxf(ma, mb)); resc = false; \
        if (first || __any(mt > THR)) { const float d = first ? mt : fmaxf(mt, 0.f); first = false; \
            _Pragma("unroll") for (int r = 0; r < 16; ++r) { X0[r] -= d; X1[r] -= d; } \
            const float alpha = __builtin_amdgcn_exp2f(-d); lrun *= alpha; const float nm_ = negm[0] - d;     \
            _Pragma("unroll") for (int r = 0; r < 16; ++r) negm[r] = nm_; \
            if (hi == 0) wsf[r32] = alpha; resc = true; } } while (0)
#define MLA_RESC() do { if (resc) { _Pragma("unroll") for (int g = 0; g < 4; ++g) { const f32x4 al = *(const ALAS f32x4*)(wsf + 8 * g + 4 * hi); \
            _Pragma("unroll") for (int i = 0; i < 4; ++i) { o0[4 * g + i] *= al[i]; o1[4 * g + i] *= al[i]; } } } } while (0)
#define MLA_PV_(i) (i < 16 ? C0[(i) & 15] : C1[(i) & 15])
#define MLA_GA(MF, g, C0, C1) do { MF; \
        if (3 * (g) < 32) sacc += (3 * (g) < 16 ? C0[(3 * (g)) & 15] : C1[(3 * (g)) & 15]); \
        if (3 * (g) + 1 < 32) sacc += (3 * (g) + 1 < 16 ? C0[(3 * (g) + 1) & 15] : C1[(3 * (g) + 1) & 15]); \
        if (3 * (g) + 2 < 32) sacc += (3 * (g) + 2 < 16 ? C0[(3 * (g) + 2) & 15] : C1[(3 * (g) + 2) & 15]); \
        if ((g) < 4) { pw[((g) >> 1) & 3][2 * ((g) & 1)] = cvtpk(C0[4 * (g)], C0[4 * (g) + 1]); pw[((g) >> 1) & 3][2 * ((g) & 1) + 1] = cvtpk(C0[4 * (g) + 2], C0[4 * (g) + 3]); } \
        else if ((g) < 8) { pw[((g) >> 1) & 3][2 * ((g) & 1)] = cvtpk(C1[4 * ((g) - 4)], C1[4 * ((g) - 4) + 1]); pw[((g) >> 1) & 3][2 * ((g) & 1) + 1] = cvtpk(C1[4 * ((g) - 4) + 2], C1[4 * ((g) - 4) + 3]); } } while (0)
#define MLA_VF(lo_, hi_) (bf16x8){lo_[0], lo_[1], lo_[2], lo_[3], hi_[0], hi_[1], hi_[2], hi_[3]}
#define MLA_GB(MF, X, b_) do { MF; X[(b_)] = MLA_EX(X[(b_)]); X[(b_) + 1] = MLA_EX(X[(b_) + 1]); X[(b_) + 2] = MLA_EX(X[(b_) + 2]); X[(b_) + 3] = MLA_EX(X[(b_) + 3]); } while (0)
#define MLA_FULL(C0, C1, N0, N1, t_) do { \
        int kofs_ = L_K + (((t_) + 1) % 3) * KSLOT + hi * KCS + r32 * 16; asm volatile("" : "+v"(kofs_)); const ALAS unsigned char* Kb_ = lds + kofs_; \
        int vofs_ = L_V + ((t_) & 3) * VSLOT + vrd; asm volatile("" : "+v"(vofs_)); const ALAS unsigned char* Vb_ = lds + vofs_; \
        bf16x8 ka0 = *(const ALAS bf16x8*)(Kb_), kb0 = *(const ALAS bf16x8*)(Kb_ + 512), ka1 = *(const ALAS bf16x8*)(Kb_ + 2 * KCS), kb1 = *(const ALAS bf16x8*)(Kb_ + 2 * KCS + 512), ka2, kb2; \
        s16x4 vl0a, vh0a, vl1a, vh1a, vl0b, vh0b, vl1b, vh1b; float sacc = 0.f; \
        MLA_SB(); \
        MLA_GA(N0 = __builtin_amdgcn_mfma_f32_32x32x16_bf16(ka0, qf[0], negm, 0, 0, 0), 0, C0, C1); ka2 = *(const ALAS bf16x8*)(Kb_ + 4 * KCS); MLA_SB(); \
        MLA_GA(N1 = __builtin_amdgcn_mfma_f32_32x32x16_bf16(kb0, qf[0], negm, 0, 0, 0), 1, C0, C1); kb2 = *(const ALAS bf16x8*)(Kb_ + 4 * KCS + 512); MLA_SB(); \
        MLA_GA(N0 = __builtin_amdgcn_mfma_f32_32x32x16_bf16(ka1, qf[1], N0, 0, 0, 0), 2, C0, C1); ka0 = *(const ALAS bf16x8*)(Kb_ + 6 * KCS); MLA_SB(); \
        MLA_GA(N1 = __builtin_amdgcn_mfma_f32_32x32x16_bf16(kb1, qf[1], N1, 0, 0, 0), 3, C0, C1); kb0 = *(const ALAS bf16x8*)(Kb_ + 6 * KCS + 512); MLA_SB(); \
        MLA_GA(N0 = __builtin_amdgcn_mfma_f32_32x32x16_bf16(ka2, qf[2], N0, 0, 0, 0), 4, C0, C1); ka1 = *(const ALAS bf16x8*)(Kb_ + 8 * KCS); MLA_SB(); \
        MLA_GA(N1 = __builtin_amdgcn_mfma_f32_32x32x16_bf16(kb2, qf[2], N1, 0, 0, 0), 5, C0, C1); kb1 = *(const ALAS bf16x8*)(Kb_ + 8 * KCS + 512); MLA_SB(); \
        MLA_GA(N0 = __builtin_amdgcn_mfma_f32_32x32x16_bf16(ka0, qf[3], N0, 0, 0, 0), 6, C0, C1); ka2 = *(const ALAS bf16x8*)(Kb_ + 10 * KCS); MLA_SB(); \
        MLA_GA(N1 = __builtin_amdgcn_mfma_f32_32x32x16_bf16(kb0, qf[3], N1, 0, 0, 0), 7, C0, C1); kb2 = *(const ALAS bf16x8*)(Kb_ + 10 * KCS + 512); MLA_SB(); \
        MLA_GA(N0 = __builtin_amdgcn_mfma_f32_32x32x16_bf16(ka1, qf[4], N0, 0, 0, 0), 8, C0, C1); MLA_SB(); \
        MLA_GA(N1 = __builtin_amdgcn_mfma_f32_32x32x16_bf16(kb1, qf[4], N1, 0, 0, 0), 9, C0, C1); MLA_SB(); \
        MLA_GA(N0 = __builtin_amdgcn_mfma_f32_32x32x16_bf16(ka2, qf[5], N0, 0, 0, 0), 10, C0, C1); vl0a = vtr(Vb_); vh0a = vtr(Vb_ + 512); MLA_SB(); \
        MLA_GA(N1 = __builtin_amdgcn_mfma_f32_32x32x16_bf16(kb2, qf[5], N1, 0, 0, 0), 11, C0, C1); vl1a = vtr(Vb_ + VHS); vh1a = vtr(Vb_ + VHS + 512); MLA_SB(); \
        lrun += sacc; \
        MLA_DECIDE(N0, N1, ((t_) + 1) * 64); \
        MLA_SB(); \
        MLA_GB(o0 = __builtin_amdgcn_mfma_f32_32x32x16_bf16(__builtin_bit_cast(bf16x8, pw[0]), MLA_VF(vl0a, vh0a), o0, 0, 0, 0), N0, 0); vl0b = vtr(Vb_ + 1024); vh0b = vtr(Vb_ + 1024 + 512); MLA_SB(); \
        MLA_GB(o1 = __builtin_amdgcn_mfma_f32_32x32x16_bf16(__builtin_bit_cast(bf16x8, pw[0]), MLA_VF(vl1a, vh1a), o1, 0, 0, 0), N0, 4); vl1b = vtr(Vb_ + VHS + 1024); vh1b = vtr(Vb_ + VHS + 1024 + 512); MLA_SB(); \
        MLA_GB(o0 = __builtin_amdgcn_mfma_f32_32x32x16_bf16(__builtin_bit_cast(bf16x8, pw[1]), MLA_VF(vl0b, vh0b), o0, 0, 0, 0), N0, 8); vl0a = vtr(Vb_ + 2048); vh0a = vtr(Vb_ + 2048 + 512); MLA_SB(); \
        MLA_GB(o1 = __builtin_amdgcn_mfma_f32_32x32x16_bf16(__builtin_bit_cast(bf16x8, pw[1]), MLA_VF(vl1b, vh1b), o1, 0, 0, 0), N0, 12); vl1a = vtr(Vb_ + VHS + 2048); vh1a = vtr(Vb_ + VHS + 2048 + 512); MLA_SB(); \
        MLA_GB(o0 = __builtin_amdgcn_mfma_f32_32x32x16_bf16(__builtin_bit_cast(bf16x8, pw[2]), MLA_VF(vl0a, vh0a), o0, 0, 0, 0), N1, 0); vl0b = vtr(Vb_ + 3072); vh0b = vtr(Vb_ + 3072 + 512); MLA_SB(); \
        MLA_GB(o1 = __builtin_amdgcn_mfma_f32_32x32x16_bf16(__builtin_bit_cast(bf16x8, pw[2]), MLA_VF(vl1a, vh1a), o1, 0, 0, 0), N1, 4); vl1b = vtr(Vb_ + VHS + 3072); vh1b = vtr(Vb_ + VHS + 3072 + 512); MLA_SB(); \
        MLA_GB(o0 = __builtin_amdgcn_mfma_f32_32x32x16_bf16(__builtin_bit_cast(bf16x8, pw[3]), MLA_VF(vl0b, vh0b), o0, 0, 0, 0), N1, 8); MLA_SB(); \
        MLA_GB(o1 = __builtin_amdgcn_mfma_f32_32x32x16_bf16(__builtin_bit_cast(bf16x8, pw[3]), MLA_VF(vl1b, vh1b), o1, 0, 0, 0), N1, 12); MLA_SB(); \
        MLA_RESC(); } while (0)
#define MLA_TAIL(C0, C1, t_) do { float ls = 0.f; _Pragma("unroll") for (int r = 0; r < 16; ++r) ls += C0[r] + C1[r]; lrun += ls; ATT_PACK(C0, C1); ATT_PV((t_) & 3); } while (0)
#define MLA_STEP(C0, C1, N0, N1, t_) do { \
          \
        int lane_ = lane; asm volatile("" : "+v"(lane_)); const int r32 = lane_ & 31, hi = lane_ >> 5, qrow = qlo + r32; \
        const int vrd = ((lane_ >> 4) & 1) * 32 + (lane_ & 3) * 8 + (4 * hi + ((lane_ & 15) >> 2)) * 64; ALAS float* wsf = (ALAS float*)(lds + L_WSF) + wid * 64; \
        if ((t_) + 3 < ntile) { ATT_ISSUE((t_) + 3, (t_) + 3); issued = (t_) + 3; } \
        if ((t_) < tmax) MLA_FULL(C0, C1, N0, N1, t_); else if ((t_) == tmax) MLA_TAIL(C0, C1, t_); \
        ATT_WAIT_BAR(issued - ((t_) + 2)); } while (0)
    bool resc = false;
    ATT_QK(p0, p1, 0);
    MLA_DECIDE(p0, p1, 0);
#pragma unroll
    for (int r = 0; r < 16; ++r) { p0[r] = MLA_EX(p0[r]); p1[r] = MLA_EX(p1[r]); }
    asm volatile("s_waitcnt lgkmcnt(0)\n\ts_barrier" ::: "memory");
    for (int it = 0; it < ntile; it += 2) {
        MLA_STEP(p0, p1, n0, n1, it);
        if (it + 1 >= ntile) break;
        MLA_STEP(n0, n1, p0, p1, it + 1);
    }
#undef MLA_SB
#undef MLA_EX
#undef MLA_DECIDE
#undef MLA_RESC
#undef MLA_PV_
#undef MLA_GA
#undef MLA_VF
#undef MLA_GB
#undef MLA_FULL
#undef MLA_TAIL
#undef MLA_STEP
    } else {
    f32x16 p0, p1, n0, n1; u32x4 pw[4];
    __syncthreads();
    int issued = 0;
    ATT_ISSUE(tfirst, 0);
    if (ntile > 1) { ATT_ISSUE(tfirst + tstep, 1); issued = 1; }
    if (ntile > 2) { ATT_ISSUE(tfirst + 2 * tstep, 2); issued = 2; }
    ATT_WAIT_BAR(issued - 1);
    bool wcur = ATT_WORK(tfirst * 64);
    if (wcur) ATT_QK(p0, p1, 0);
    asm volatile("s_waitcnt lgkmcnt(0)\n\ts_barrier" ::: "memory");
    int nt = ntile;
    for (int it = 0; it < nt; ++it) {
        const int t = tfirst + it * tstep, j0 = t * 64, jn = (t + tstep) * 64;
        if (it + 3 < ntile) { ATT_ISSUE(t + 3 * tstep, it + 3); issued = it + 3; }
        if (wcur) ATT_SM_A(p0, p1, j0, it & 3);
        const bool wnext = (it + 1 < nt) && ATT_WORK(jn);
        if (wcur && wnext) { ATT_QK(n0, n1, (it + 1) % 3); ATT_SM_B(p0, p1, j0); }
        else { if (wnext) ATT_QK(n0, n1, (it + 1) % 3); if (wcur) ATT_SM_B(p0, p1, j0); }
        if (wcur) ATT_PV(it & 3);
        p0 = n0; p1 = n1; wcur = wnext;
        if (MODE == 2) { ALAS int* fl = (ALAS int*)(lds + L_FLAG + 16) + (it & 1) * 8; if (lane == 0) fl[wid] = (walive && j0 > 0) ? 1 : 0; }
        ATT_WAIT_BAR(issued - (it + 2));
        if (MODE == 2) { const ALAS int* fl = (const ALAS int*)(lds + L_FLAG + 16) + (it & 1) * 8;
            const i32x4 fa = *(const ALAS i32x4*)fl, fb = *(const ALAS i32x4*)(fl + 4);
            if (((fa[0] | fa[1]) | (fa[2] | fa[3]) | (fb[0] | fb[1]) | (fb[2] | fb[3])) == 0) nt = it + 1; }
    }
    }
    if (MODE == 2) asm volatile("s_waitcnt vmcnt(0)" ::: "memory");
#undef ATT_ISSUE
#undef ATT_WAIT_BAR
#undef ATT_QK
#undef ATT_PV
#undef ATT_PACK
#undef ATT_VLD
#undef ATT_SM_A
#undef ATT_SM_B
#undef ATT_WORK
#undef ATT_MAX3
    if (MODE != 2) {
        const float lt = swap_sum(lrun);
        if (hi == 0) wsf[32 + r32] = 1.0f / lt;
#pragma unroll
        for (int g = 0; g < 4; ++g) { const f32x4 il = *(const ALAS f32x4*)(wsf + 32 + 8 * g + 4 * hi);
#pragma unroll
            for (int i = 0; i < 4; ++i) { o0[4 * g + i] *= il[i]; o1[4 * g + i] *= il[i]; } }
    }
    {
        ALAS bf16_t* stg = (ALAS bf16_t*)ost;
#pragma unroll
        for (int r = 0; r < 16; ++r) { const int orow = crow(r, hi); stg[orow * 64 + r32] = (bf16_t)(cvtpk(o0[r], 0.f) & 0xffffu); stg[orow * 64 + 32 + r32] = (bf16_t)(cvtpk(o1[r], 0.f) & 0xffffu); }
        AGAS bf16_t* Ow = (AGAS bf16_t*)(P.ws + WS_OALL) + (rb + qlo) * 1024 + C::ocol0 + h * 64;
#pragma unroll
        for (int i = 0; i < 4; ++i) {
            const int row = i * 8 + (lane >> 3), ch = lane & 7;
            const u32x4 v = *(const ALAS u32x4*)(stg + row * 64 + ch * 8);
            float ss = 0.f;
#pragma unroll
            for (int k = 0; k < 4; ++k) { const unsigned w = v[k]; const float a = __uint_as_float(w << 16), c = __uint_as_float(w & 0xffff0000u); ss += a * a + c * c; }
            ss += __shfl_xor(ss, 1); ss += __shfl_xor(ss, 2); ss += __shfl_xor(ss, 4);
            *(AGAS u32x4*)(Ow + (size_t)row * 1024 + ch * 8) = v;
            if (ch == 0) ((AGAS float*)(P.ws + WS_SSQO))[(rb + qlo + row) * 16 + C::hidx0 + h] = ss;
        }
    }
#ifdef ATT_PROF
    if (MODE == 0 && blockIdx.x == 0 && wid == ATT_PROF_WAVE && lane == 0 && prof) { const long long tt = PROF_T() - pf_t0;
        atomicAdd(prof + 0, (unsigned long long)tt); atomicAdd(prof + 1, (unsigned long long)pf_qk); atomicAdd(prof + 2, (unsigned long long)pf_sm); atomicAdd(prof + 3, (unsigned long long)pf_pv); atomicAdd(prof + 4, (unsigned long long)pf_wait); atomicAdd(prof + 5, 1ull); }
#endif
}
#undef ALAS
#undef AGAS
}
struct Args { const void* in[23]; float* out; unsigned char* ws; int ph_lo, ph_hi, li, adapt; };

struct Frame { LAS unsigned char* lds; int tid, lane, wave, vcu, G; };

__device__ __forceinline__ float wave_sum64(float v) { return pg8::wave_sum_dpp(v); }

__device__ __forceinline__ void tr_item64(const GAS float* W, int ldn, int K, GAS pg8::bf16_t* WT, int kb, int g, int src0, int src1, const GAS float* kgain, LAS unsigned* scr, int lane) {
    const int k0 = 64 * kb; const int col = lane < 32 ? src0 + lane : src1 + (lane - 32); const bool ok = (lane < 32 ? src0 : src1) >= 0;
    const GAS float* wp = W + (size_t)k0 * ldn + (ok ? col : 0);
#pragma unroll
    for (int hf = 0; hf < 2; ++hf) {
        float v[32];
#pragma unroll
        for (int i = 0; i < 32; ++i) v[i] = wp[(size_t)(hf * 32 + i) * ldn];
#pragma unroll
        for (int i = 0; i < 32; ++i) v[i] = ok ? v[i] : 0.f;
        if (kgain) {
#pragma unroll
            for (int i = 0; i < 32; ++i) v[i] *= kgain[k0 + hf * 32 + i]; }
#pragma unroll
        for (int i = 0; i < 16; ++i) scr[(hf * 16 + i) * 65 + lane] = pk2(v[2 * i], v[2 * i + 1]);
    }
    asm volatile("s_waitcnt lgkmcnt(0)" ::: "memory");
    const int c = lane & 7;
#pragma unroll
    for (int j = 0; j < 8; ++j) { const int n = (lane >> 3) + 8 * j; const LAS unsigned* s = scr + (4 * c) * 65 + n;
        v4u o; o.x = s[0]; o.y = s[65]; o.z = s[130]; o.w = s[195];
        *(GAS v4u*)(WT + (size_t)(64 * g + n) * K + k0 + 8 * c) = o; }
    asm volatile("s_waitcnt lgkmcnt(0)" ::: "memory");
}
__device__ __forceinline__ int in_slot_src(int slot, int& cnt) {
    cnt = 64;
    if (slot < 4) return 64 * slot;
    if (slot < 6) return 256 + 64 * (slot - 4);
    if (slot == 6) { cnt = 32; return 384; }
    if (slot == 7) return -1;
    if (slot < 14) return 416 + 64 * (slot - 8);
    if (slot < 16) return 800 + 64 * (slot - 14);
    if (slot < 18) return 928 + 64 * (slot - 16);
    if (slot < 22) return 1056 + 64 * (slot - 18);
    if (slot < 26) return 1312 + 64 * (slot - 22);
    if (slot < 30) return 1568 + 64 * (slot - 26);
    return -1;
}

#define A_X ((const GAS float*)args.in[0])
#define A_C ((const GAS float*)args.in[1])
#define A_POS ((const GAS int*)args.in[2])
#define A_RELB ((const GAS float*)args.in[3])
#define A_NORMG ((const GAS float*)args.in[4])
#define A_WMOD ((const GAS float*)args.in[5])
#define A_BMOD ((const GAS float*)args.in[6])
#define A_WGU1 ((const GAS float*)args.in[7])
#define A_WD1 ((const GAS float*)args.in[8])
#define A_WIN ((const GAS float*)args.in[9])
#define A_QAN ((const GAS float*)args.in[10])
#define A_KVAN ((const GAS float*)args.in[11])
#define A_WUQ ((const GAS float*)args.in[12])
#define A_WUKV ((const GAS float*)args.in[13])
#define A_MLAQN ((const GAS float*)args.in[14])
#define A_MLAKN ((const GAS float*)args.in[15])
#define A_SWAQN ((const GAS float*)args.in[16])
#define A_SWAKN ((const GAS float*)args.in[17])
#define A_SINKS ((const GAS float*)args.in[18])
#define A_OUTN ((const GAS float*)args.in[19])
#define A_WOUT ((const GAS float*)args.in[20])
#define A_WGU2 ((const GAS float*)args.in[21])
#define A_WD2 ((const GAS float*)args.in[22])
#define WSP(off)   (ws_ + (off))
#define MOD ((GAS float*)WSP(WS_MOD))
#define GS ((GAS float*)WSP(WS_GS))
#define BIAS ((GAS float*)WSP(WS_BIAS))
#define SSQX ((GAS float*)WSP(WS_SSQX))
#define SSQO ((GAS float*)WSP(WS_SSQO))
#define CS ((GAS float*)WSP(WS_CS))
#define KPE ((GAS float*)WSP(WS_KPE))
#define SSQ_CQ ((GAS float*)WSP(WS_SSQC))
#define SSQ_CKV ((GAS float*)WSP(WS_SSQC) + (size_t)MROWS * 4)
#define SSQ_KPE ((GAS float*)WSP(WS_SSQC) + (size_t)MROWS * 6)
#define XB ((GAS pg8::bf16_t*)WSP(WS_XB))
#define HID ((GAS pg8::bf16_t*)WSP(WS_HID))
#define CQ ((GAS pg8::bf16_t*)WSP(WS_CQ))
#define CKV ((GAS pg8::bf16_t*)WSP(WS_CKV))
#define KA ((GAS pg8::bf16_t*)WSP(WS_KA))
#define VA ((GAS pg8::bf16_t*)WSP(WS_VA))
#define QS ((GAS pg8::bf16_t*)WSP(WS_QS))
#define KS ((GAS pg8::bf16_t*)WSP(WS_KS))
#define VS ((GAS pg8::bf16_t*)WSP(WS_VS))
#define QC ((GAS pg8::bf16_t*)WSP(WS_QC))
#define KC ((GAS pg8::bf16_t*)WSP(WS_KC))
#define VC ((GAS pg8::bf16_t*)WSP(WS_VC))
#define OALL ((GAS pg8::bf16_t*)WSP(WS_OALL))
#define QRAW ((GAS float*)WSP(WS_QRAW))

__device__ __forceinline__ int in_group_src(int g32) {
    const int tile = g32 >> 3, rr = g32 & 7, bj = rr >> 2, wc = rr & 3; int cnt; const int base = in_slot_src(tile * 4 + wc, cnt);
    return (base >= 0 && 32 * bj < cnt) ? base + 32 * bj : -1;
}
constexpr int CV_GU = 16 * 88, CV_D = 44 * 16, CV_IN = 16 * 32, CV_UQ = 4 * 12, CV_UKV = 2 * 12, CV_OUT = 16 * 16;
constexpr int CV_EARLY = CV_GU + CV_D + CV_IN + CV_UQ + CV_UKV + CV_OUT, CV_L = CV_EARLY + CV_GU + CV_D, CV_ALL = DEPTH * CV_L;
__device__ __forceinline__ void convert_chunk(Frame& F, const Args& args, int base, int limit) {
    GAS unsigned char* ws_ = (GAS unsigned char*)args.ws; asm volatile("" : "+s"(ws_));
    LAS unsigned* scr = (LAS unsigned*)(F.lds + 16384 + F.wave * 8448);
#pragma unroll 1
    for (int q = 0; q < 2; ++q) {
        const int it = base + F.wave * 2 + q; if (it >= limit) break;
        const int l = it / CV_L; int r = it % CV_L;
        GAS unsigned char* wl = ws_ + WS_W + (size_t)l * WL;
        int kind;
        if (r < CV_GU) kind = 0; else if ((r -= CV_GU) < CV_D) kind = 1; else if ((r -= CV_D) < CV_IN) kind = 2; else if ((r -= CV_IN) < CV_UQ) kind = 3;
        else if ((r -= CV_UQ) < CV_UKV) kind = 4; else if ((r -= CV_UKV) < CV_OUT) kind = 5; else if ((r -= CV_OUT) < CV_GU) kind = 6; else { r -= CV_GU; kind = 7; }
        if (kind == 0 || kind == 6) {
            const bool second = kind == 6; const int kb = r / 88, g = r % 88, t = g >> 2, rr = g & 3, src = (rr >> 1) * DFF + 128 * t + 64 * (rr & 1);
            const GAS float* W = (second ? A_WGU2 : A_WGU1) + (size_t)l * DM * 2 * DFF;
            tr_item64(W, 2 * DFF, DM, (GAS pg8::bf16_t*)(wl + (second ? W_GU2 : W_GU1)), kb, g, src, src + 32, nullptr, scr, F.lane);
        } else if (kind == 1 || kind == 7) { const bool second = kind == 7; const int kb = r / 16, g = r % 16;
            tr_item64((second ? A_WD2 : A_WD1) + (size_t)l * DFF * DM, DM, DFF, (GAS pg8::bf16_t*)(wl + (second ? W_D2 : W_D1)), kb, g, 64 * g, 64 * g + 32, nullptr, scr, F.lane);
        } else if (kind == 2) { const int kb = r / 32, g = r % 32;
            tr_item64(A_WIN + (size_t)l * DM * DIN, DIN, DM, (GAS pg8::bf16_t*)(wl + W_IN), kb, g, in_group_src(2 * g), in_group_src(2 * g + 1), nullptr, scr, F.lane);
        } else if (kind == 3) { const int kb = r / 12, g = r % 12;
            tr_item64(A_WUQ + (size_t)l * 256 * 576, 576, 256, (GAS pg8::bf16_t*)(wl + W_UQ), kb, g, g < 9 ? 64 * g : -1, g < 9 ? 64 * g + 32 : -1, A_QAN + l * 256, scr, F.lane);
        } else if (kind == 4) { const int kb = r / 12, g = r % 12, g0 = 2 * g, g1 = 2 * g + 1;
            tr_item64(A_WUKV + (size_t)l * 128 * 768, 768, 128, (GAS pg8::bf16_t*)(wl + W_UKV), kb, g, 256 * (g0 >> 3) + 64 * (g0 & 3) + 32 * ((g0 & 7) >> 2), 256 * (g1 >> 3) + 64 * (g1 & 3) + 32 * ((g1 & 7) >> 2), A_KVAN + l * 128, scr, F.lane);
        } else { const int kb = r / 16, g = r % 16;
            tr_item64(A_WOUT + (size_t)l * DM * DM, DM, DM, (GAS pg8::bf16_t*)(wl + W_OUT), kb, g, 64 * g, 64 * g + 32, A_OUTN + l * DM, scr, F.lane); }
    }
}

__device__ __forceinline__ void phase_pro0(Frame& F, const Args& args, gu32* qhead) {
    GAS unsigned char* ws_ = (GAS unsigned char*)args.ws; asm volatile("" : "+s"(ws_));
    constexpr int NMU = DEPTH * NMOD / 128;
    if ((int)blockIdx.x < NMU || F.G <= NMU) {
        LAS float* cond = (LAS float*)F.lds;
        LAS float* red = (LAS float*)(F.lds + 8192);
        for (int i = F.tid; i < 2 * DM; i += 512) { const float cv = A_C[i]; cond[i] = cv / (1.0f + expf(-cv)); }
        __syncthreads();
        for (int u = blockIdx.x; u < NMU; u += F.G) {
            const int l = u / (NMOD / 128), n0 = (u % (NMOD / 128)) * 128, c4 = F.lane & 31, kp = F.lane >> 5;
            const GAS float* w = A_WMOD + (size_t)l * DM * NMOD + n0 + 4 * c4;
            f32x4 a0 = {0.f, 0.f, 0.f, 0.f}, a1 = {0.f, 0.f, 0.f, 0.f};
#pragma unroll 8
            for (int i = 0; i < 64; ++i) { const int kk = F.wave * 128 + 2 * i + kp; const f32x4 wv = *(const GAS f32x4*)(w + (size_t)kk * NMOD); a0 += wv * cond[kk]; a1 += wv * cond[DM + kk]; }
#pragma unroll
            for (int q = 0; q < 4; ++q) { a0[q] = pg8::xsum32(a0[q]); a1[q] = pg8::xsum32(a1[q]); }
            if (kp == 0) { *(LAS f32x4*)(red + (F.wave * 2 + 0) * 128 + 4 * c4) = a0; *(LAS f32x4*)(red + (F.wave * 2 + 1) * 128 + 4 * c4) = a1; }
            __syncthreads();
            if (F.tid < 256) { const int bb = F.tid >> 7, ln = F.tid & 127; float s = 0.f;
#pragma unroll
                for (int wv = 0; wv < 8; ++wv) s += red[(wv * 2 + bb) * 128 + ln];
                MOD[((size_t)l * 2 + bb) * NMOD + n0 + ln] = s + A_BMOD[(size_t)l * NMOD + n0 + ln]; }
            __syncthreads();
        }
    }
    if ((int)blockIdx.x >= NMU || F.G <= NMU) {
        const int nb = F.G <= NMU ? F.G : F.G - NMU, b0 = F.G <= NMU ? (int)blockIdx.x : (int)blockIdx.x - NMU;
        for (int i = b0 * 512 + F.tid; i < MROWS * 16; i += nb * 512) {
            const int m = i >> 4, j = i & 15;
            const float freq = powf(10000.0f, -(float)j / 16.0f);
            const float ang = (float)A_POS[m] * freq;
            CS[(size_t)m * 32 + j] = cosf(ang); CS[(size_t)m * 32 + 16 + j] = sinf(ang);
        }
    }
    {
        LAS int* slot = (LAS int*)(F.lds + 12288);
        for (;;) {
            __syncthreads();
            if (F.tid == 0) slot[0] = (int)__hip_atomic_fetch_add(qhead, 16u, __ATOMIC_RELAXED, __HIP_MEMORY_SCOPE_AGENT);
            __syncthreads();
            const int base = slot[0];
            if (base >= CV_EARLY) break;
            convert_chunk(F, args, base, CV_EARLY);
        }
    }
}

__device__ __forceinline__ float gs_clamped(float g, float sc) { const float v = g * (1.0f + sc); return fabsf(v) < 1e-20f ? (v < 0.f ? -1e-20f : 1e-20f) : v; }
__device__ __forceinline__ void x_to_xb(Frame& F, const Args& args, const GAS float* xsrc, int l, int i) {
    GAS unsigned char* ws_ = (GAS unsigned char*)args.ws; asm volatile("" : "+s"(ws_));
    const int gw = F.vcu * NWAVES + F.wave, NGW = F.G * NWAVES;
    for (int m = gw; m < MROWS; m += NGW) {
        const int b = m >> 13;
        const GAS f32x4* xr = (const GAS f32x4*)(xsrc + (size_t)m * DM) + F.lane;
        const GAS f32x4* gr = (const GAS f32x4*)(A_NORMG + ((size_t)l * 3 + i) * DM) + F.lane;
        const GAS f32x4* sr = (const GAS f32x4*)(MOD + ((size_t)l * 2 + b) * NMOD + (3 * i + 1) * DM) + F.lane;
        float s = 0.f;
        GAS unsigned long long* o8 = (GAS unsigned long long*)(XB + (size_t)m * DM) + F.lane;
#pragma unroll
        for (int j = 0; j < 4; ++j) { const f32x4 v = xr[64 * j]; s += (v.x * v.x + v.y * v.y) + (v.z * v.z + v.w * v.w);
            const f32x4 g0 = gr[64 * j], s0 = sr[64 * j]; const f32x4 g = {gs_clamped(g0.x, s0.x), gs_clamped(g0.y, s0.y), gs_clamped(g0.z, s0.z), gs_clamped(g0.w, s0.w)}; const f32x4 y = v * g;
            o8[64 * j] = (unsigned long long)pk2(y.x, y.y) | ((unsigned long long)pk2(y.z, y.w) << 32); }
        s = wave_sum64(s);
        if (F.lane < 16) SSQX[(size_t)m * 16 + F.lane] = (F.lane == 0) ? s : 0.f;
    }
}

__device__ __forceinline__ void bias_rows(Frame& F, const Args& args, bool early) {
    GAS unsigned char* ws_ = (GAS unsigned char*)args.ws; asm volatile("" : "+s"(ws_));
    const int gw = F.vcu * NWAVES + F.wave, NGW = F.G * NWAVES;
    constexpr int RL = 5632 + 2048 + 5632, RE = 5632 + 2048;
    const int lo = early ? 0 : RE, hi = early ? RE : DEPTH * RL;
    for (int it = lo + gw; it < hi; it += NGW) {
        const int l = it / RL; int r = it % RL; int which, nrow; size_t woff; size_t boff;
        if (r < 5632) { which = 0; nrow = 5632; woff = W_GU1; boff = 0; } else if (r < 5632 + 2048) { r -= 5632; which = 1; nrow = 2048; woff = W_IN; boff = 2 * 5632; } else { r -= 5632 + 2048; which = 2; nrow = 5632; woff = W_GU2; boff = 2 * (5632 + 2048); }
        const GAS pg8::bf16_t* wr = (const GAS pg8::bf16_t*)(ws_ + WS_W + (size_t)l * WL + woff) + (size_t)r * DM;
        float a0 = 0.f, a1 = 0.f;
#pragma unroll
        for (int j = 0; j < 2; ++j) {
            const v4u wv = *(const GAS v4u*)(wr + j * 512 + F.lane * 8);
            const GAS float* s0 = MOD + ((size_t)l * 2 + 0) * NMOD + (3 * which) * DM + j * 512 + F.lane * 8; const GAS float* s1 = s0 + NMOD;
#pragma unroll
            for (int k = 0; k < 4; ++k) { const unsigned w = wv[k]; const float lo_ = __uint_as_float(w << 16), hi_ = __uint_as_float(w & 0xffff0000u);
                a0 += lo_ * s0[2 * k] + hi_ * s0[2 * k + 1]; a1 += lo_ * s1[2 * k] + hi_ * s1[2 * k + 1]; }
        }
        a0 = wave_sum64(a0); a1 = wave_sum64(a1);
        if (F.lane == 0) { BIAS[(size_t)l * BIAS_L + boff + r] = a0; BIAS[(size_t)l * BIAS_L + boff + nrow + r] = a1; }
    }
}
__device__ __forceinline__ void phase_pro1(Frame& F, const Args& args) {
    GAS unsigned char* ws_ = (GAS unsigned char*)args.ws; asm volatile("" : "+s"(ws_));
    for (int i = blockIdx.x * 512 + F.tid; i < DEPTH * 3 * 2 * DM; i += F.G * 512) {
        const int cidx = i & 1023, b = (i >> 10) & 1, li = i >> 11, l = li / 3, ii = li % 3;
        const float gv_ = gs_clamped(A_NORMG[((size_t)l * 3 + ii) * DM + cidx], MOD[((size_t)l * 2 + b) * NMOD + (3 * ii + 1) * DM + cidx]);
        GS[i] = gv_; ((GAS float*)WSP(WS_IGS))[i] = 1.0f / gv_;
    }
    bias_rows(F, args, true);
    x_to_xb(F, args, A_X, 0, 0);
}

__device__ __forceinline__ int next_unit(Frame& F, gu32* head) {
    LAS int* slot = (LAS int*)(F.lds + att::L_FLAG);
    __syncthreads();
    if (F.tid == 0) slot[0] = (int)__hip_atomic_fetch_add(head, 1u, __ATOMIC_RELAXED, __HIP_MEMORY_SCOPE_AGENT);
    __syncthreads();
    return slot[0];
}

#ifndef DUPS
#define DUPS -1
#endif
#ifndef PHM
#define PHM 255
#endif
#ifndef PHM2
#define PHM2 31
#endif
__global__ void __launch_bounds__(NWAVES * 64, 2) fwd_mega(Args args) {
    extern __shared__ __attribute__((aligned(16))) unsigned char lds[];
    const int wave0 = __builtin_amdgcn_readfirstlane((int)threadIdx.x >> 6);
    Frame F0; F0.lds = (LAS unsigned char*)lds; F0.wave = wave0; F0.lane = hw_lane(); F0.tid = wave0 * 64 + F0.lane;
    F0.G = gridDim.x; { const int bx = blockIdx.x; F0.vcu = (F0.G % 8 == 0) ? (bx % 8) * (F0.G / 8) + bx / 8 : bx; }
    gu32* ctl = (gu32*)(args.ws + WS_CTL);
    for (int u = F0.tid; u < (LDS_BYTES - LDSCTL_OFF) / 4; u += NWAVES * 64) ((LAS unsigned*)(F0.lds + LDSCTL_OFF))[u] = 0u;
    __syncthreads();
    const int lo = args.ph_lo, hi = args.ph_hi;
    XcdBarrier bar; bar.bar = (unsigned*)(ctl + CW_BAR) + args.li * XCD_BAR_WORDS; bar.x = 0; bar.st = nullptr; bar.w0 = wave0;
    if (hi - lo > 1 || true) bar = xcd_barrier_post((unsigned*)(ctl + CW_BAR) + args.li * XCD_BAR_WORDS, (volatile LAS unsigned*)(F0.lds + MISC_OFF) + 8, wave0);

    for (int ph = lo; ph < hi; ++ph) {
        Frame F; F.lds = F0.lds; F.G = F0.G; F.vcu = F0.vcu; { int t_ = wave0 * 64 + hw_lane(); asm volatile("" : "+v"(t_)); F.tid = t_; F.lane = t_ & 63; F.wave = wave0; }
        GAS unsigned char* ws_ = (GAS unsigned char*)args.ws; asm volatile("" : "+s"(ws_));
        int nrep = 1;
        if (DUPS >= 0) { const int ty = ph < 2 ? 8 + ph : ((ph - 2) & 7); if (ty == DUPS && !(ty == 5) && !((ty == 1 || ty == 7) && ph != 3)) nrep = 2; }
        for (int rep = 0; rep < nrep; ++rep) {
        if ((PHM & 64) && ph == 0) phase_pro0(F, args, ctl + CW_Q + 64 * 8);
        else if ((PHM & 128) && ph == 1) phase_pro1(F, args);
        else {
            const int l = (ph - 2) >> 3, s = (ph - 2) & 7;
            const GAS unsigned char* wl = ws_ + WS_W + (size_t)l * WL;
            const GAS float* biasl = BIAS + (size_t)l * BIAS_L;
            const GAS float* modl = MOD + (size_t)l * 2 * NMOD;
            if ((PHM & 1) && (s == 0 || s == 6)) {
                pg8::Gemm g{(const pg8::bf16_t*)XB, (const pg8::bf16_t*)(wl + (s == 0 ? W_GU1 : W_GU2)), MROWS, 5632, DM}; pg8::StaticOrder S; S.init(MROWS, 5632, F.G, (int)blockIdx.x);
                pg8::EpiUp E{ws_, biasl + (s == 0 ? 0 : 2 * (5632 + 2048))};
                pg8::gemm_phase<pg8::EpiUp, pg8::StaticOrder, true, true>(F.lds, g, S, E, F.wave);
            } else if ((PHM & 2) && (s == 1 || s == 7)) {
                pg8::Gemm g{(const pg8::bf16_t*)HID, (const pg8::bf16_t*)(wl + (s == 1 ? W_D1 : W_D2)), MROWS, DM, DFF}; pg8::StaticOrder S; S.init(MROWS, DM, F.G, (int)blockIdx.x);
                const bool lastp = (s == 7 && l == DEPTH - 1);
                const GAS float* gsn = lastp ? nullptr : (s == 1 ? GS + ((size_t)(l * 3 + 1) * 2) * DM : GS + ((size_t)((l + 1) * 3 + 0) * 2) * DM);
                const GAS float* igp = (const GAS float*)WSP(WS_IGS) + ((size_t)(l * 3 + (s == 1 ? 0 : 2)) * 2) * DM;
                pg8::EpiResS<false> E{(GAS float*)args.out, ws_, modl + (s == 1 ? 2 : 8) * DM, igp, gsn, 0.5f}; pg8::gemm_phase<pg8::EpiResS<false>, pg8::StaticOrder, false, true>(F.lds, g, S, E, F.wave, (unsigned long long*)(ctl + CW_Q + 64 * 13));
            } else if ((PHM & 4) && s == 2) {
                pg8::Gemm g{(const pg8::bf16_t*)XB, (const pg8::bf16_t*)(wl + W_IN), MROWS, 2048, DM}; pg8::StaticOrder S; S.init(MROWS, 2048, F.G, (int)blockIdx.x);
                pg8::EpiIn E{ws_, A_SWAQN + l * 64, A_SWAKN + l * 64, biasl + 2 * 5632};
                pg8::gemm_phase<pg8::EpiIn, pg8::StaticOrder, true, true>(F.lds, g, S, E, F.wave);
            } else if ((PHM & 8) && s == 3) {
                if (PHM2 & 1) { pg8::Gemm g{(const pg8::bf16_t*)CQ, (const pg8::bf16_t*)(wl + W_UQ), MROWS, 768, 256}; pg8::StaticOrder S; S.init(MROWS, 768, F.G, (int)blockIdx.x);
                  pg8::EpiUq E{ws_}; pg8::gemm_phase<pg8::EpiUq, pg8::StaticOrder, true, true>(F.lds, g, S, E, F.wave); }
                if (PHM2 & 2) { pg8::Gemm g{(const pg8::bf16_t*)CKV, (const pg8::bf16_t*)(wl + W_UKV), MROWS, 768, 128}; pg8::StaticOrder S; S.init(MROWS, 768, F.G, (int)((blockIdx.x + 64) % F.G));
                  pg8::EpiUkv E{ws_, A_MLAKN + l * 96}; pg8::gemm_phase<pg8::EpiUkv, pg8::StaticOrder, true, true>(F.lds, g, S, E, F.wave); }
            } else if ((PHM & 16) && s == 4) {
                att::AttnP PA{ws_, A_MLAQN + l * 96, nullptr, nullptr, nullptr};
                att::AttnP PB{ws_, nullptr, A_POS, A_SINKS + l * 6, A_RELB};
                att::AttnP PC{ws_, nullptr, nullptr, nullptr, nullptr};
                gu32* head = ctl + CW_Q + 64 * (2 * l + 1 + 4 * rep);
                for (;;) { const int u = next_unit(F, head); if (u >= 384 + 256 + 384) break;
                    if ((PHM2 & 16) && u < 384) { const int qb = 31 - u / 12, bh = u % 12;
                        att::attn_unit<96, 0>(F.lds, PA, bh / 6, bh % 6, qb, F.wave, (unsigned long long*)(ctl + CW_Q + 64 * 12)); }

                    else if ((PHM2 & 4) && u >= 384 && u < 640) { const int v = u - 384, qb = 31 - (v >> 3), bh = v & 7; att::attn_unit<64, 2>(F.lds, PC, bh >> 2, bh & 3, qb, F.wave); }
                    else if ((PHM2 & 8) && u >= 640) { const int v = u - 640, qb = v / 12, bh = v % 12; att::attn_unit<64, 1>(F.lds, PB, bh / 6, bh % 6, qb, F.wave); } }
                if (l == 0 && rep == 0) {
                    gu32* chead = ctl + CW_Q + 64 * 9; LAS int* cslot = (LAS int*)(F.lds + 12288);
                    for (;;) { __syncthreads(); if (F.tid == 0) cslot[0] = (int)__hip_atomic_fetch_add(chead, 16u, __ATOMIC_RELAXED, __HIP_MEMORY_SCOPE_AGENT); __syncthreads();
                        const int cb = CV_EARLY + cslot[0]; if (cb >= CV_ALL) break; convert_chunk(F, args, cb, CV_ALL); } }
            } else if ((PHM & 32) && s == 5) {
                if (l == 0 && rep == 0) { bias_rows(F, args, false); asm volatile("s_waitcnt vmcnt(0)" ::: "memory"); __syncthreads(); }
                pg8::Gemm g{(const pg8::bf16_t*)OALL, (const pg8::bf16_t*)(wl + W_OUT), MROWS, DM, DM}; pg8::StaticOrder S; S.init(MROWS, DM, F.G, (int)blockIdx.x);
                pg8::EpiResS<true> E{(GAS float*)args.out, ws_, modl + 5 * DM, (const GAS float*)WSP(WS_IGS) + ((size_t)(l * 3 + 1) * 2) * DM, GS + ((size_t)(l * 3 + 2) * 2) * DM, 1.0f}; pg8::gemm_phase<pg8::EpiResS<true>, pg8::StaticOrder, false, true>(F.lds, g, S, E, F.wave);
            }
        }
        if (rep + 1 < nrep) xcd_barrier(bar);
        }
        if (ph + 1 < hi) xcd_barrier(bar);
    }
#ifdef GEMM_PROF
    xcd_barrier(bar);
    if (blockIdx.x == 0 && threadIdx.x == 0) { const unsigned long long* st = (const unsigned long long*)(ctl + CW_Q + 64 * 13); double sh;
        if (GEMM_PROF == 0) sh = (double)st[1] / (double)(st[0] + st[1]);
        else if (GEMM_PROF == 1) sh = (double)st[0] / (double)st[2] / 1.0e6;
        else sh = (double)st[1] / (double)st[2] / 1.0e6;
        args.out[0] += (float)(0.04 + 0.18 * (sh > 1.0 ? 1.0 : sh)); }
#endif
#ifdef ATT_PROF
    xcd_barrier(bar);
    if (blockIdx.x == 0 && threadIdx.x == 0) { const unsigned long long* st = (const unsigned long long*)(ctl + CW_Q + 64 * 12);
        const double tot = (double)st[0]; double sh = 0.0;
        if (ATT_PROF == 0) sh = (double)st[0] / (double)st[5] / 1.0e6;
        else if (ATT_PROF == 5) sh = (double)st[0] / (double)st[6] / 1.0e4;
        else if (ATT_PROF == 6) sh = (double)st[6] / 1.0e3;
        else sh = (double)st[ATT_PROF] / tot;
        args.out[0] += (float)(0.04 + 0.18 * (sh > 1.0 ? 1.0 : sh)); }
#endif
}
static void launch_fwd(hipStream_t stream, Args a, int grid, int lo, int hi, int li, int adapt) {
    a.ph_lo = lo; a.ph_hi = hi; a.li = li; a.adapt = adapt;
    hipLaunchKernelGGL(fwd_mega, dim3(grid), dim3(NWAVES * 64), LDS_BYTES, stream, a);
}
extern "C" void kernel_launch(void* const* d_in, const int* in_sizes, int n_in, void* d_out, int out_size, void* d_ws, size_t ws_size, hipStream_t stream) {
    static int grid = 0;
    if (grid == 0) {
        if (n_in != 23 || out_size != MROWS * DM || ws_size < WS_END) { fprintf(stderr, "kernel_launch: unexpected problem (n_in %d, out %d, ws %zu < %zu)\n", n_in, out_size, ws_size, (size_t)WS_END); grid = -1; return; }
        int dev = 0, cus = 0, per_cu = 0;
        if (hipGetDevice(&dev) != hipSuccess || hipDeviceGetAttribute(&cus, hipDeviceAttributeMultiprocessorCount, dev) != hipSuccess) { grid = -1; return; }
        if (hipFuncSetAttribute((const void*)fwd_mega, hipFuncAttributeMaxDynamicSharedMemorySize, LDS_BYTES) != hipSuccess) { fprintf(stderr, "kernel_launch: hipFuncSetAttribute failed\n"); grid = -1; return; }
        if (hipOccupancyMaxActiveBlocksPerMultiprocessor(&per_cu, (const void*)fwd_mega, NWAVES * 64, LDS_BYTES) != hipSuccess || per_cu < 1) { fprintf(stderr, "kernel_launch: occupancy query says %d blocks per CU\n", per_cu); (void)hipGetLastError(); grid = -1; return; }
        if (cus < 256) { fprintf(stderr, "kernel_launch: built for a 256-CU device (the one-unit-per-workgroup GEMM phases need exactly 256 workgroups), found %d CUs\n", cus); grid = -1; return; }
        grid = 256;
    }
    if (grid < 0) return;
    (void)hipMemsetAsync((char*)d_ws + WS_CTL, 0, CTL_ZERO_BYTES, stream);
    Args a{};
    for (int i = 0; i < 23; ++i) a.in[i] = d_in[i];
    a.out = (float*)d_out; a.ws = (unsigned char*)d_ws;
    launch_fwd(stream, a, grid, 0, NPH, 0, -1);
}
```

```cpp
#include <hip/hip_runtime.h>
#include <cstdio>
#include <cstdint>
#include <cmath>
constexpr int NWAVES = 8;
constexpr int BATCH = 2, SEQ = 8192, DM = 1024, DEPTH = 2, MROWS = BATCH * SEQ;
constexpr int DFF = 2816, DIN = 1824, NMOD = 9 * DM;
constexpr int NPH = 2 + 8 * DEPTH;
constexpr size_t MiB = 1u << 20;
constexpr size_t WS_CTL = 0, CTL_ZERO_BYTES = 256 * 1024;
constexpr size_t WS_MOD = 1 * MiB;
constexpr size_t WS_GS = WS_MOD + 160 * 1024;
constexpr size_t WS_IGS = WS_GS + 64 * 1024;
constexpr size_t WS_BIAS = WS_IGS + 64 * 1024;
constexpr size_t BIAS_L = 2 * (5632 + 2048 + 5632);
constexpr size_t WS_SSQX = 2 * MiB;
constexpr size_t WS_SSQO = 3 * MiB;
constexpr size_t WS_CS = 4 * MiB;
constexpr size_t WS_KPE = 6 * MiB;
constexpr size_t WS_SSQC = 8 * MiB;
constexpr size_t WS_W = 9 * MiB;
constexpr size_t W_GU1 = 0, W_D1 = W_GU1 + (size_t)5632 * 1024 * 2, W_IN = W_D1 + (size_t)1024 * 2816 * 2, W_UQ = W_IN + (size_t)2048 * 1024 * 2, W_UKV = W_UQ + (size_t)768 * 256 * 2,
                 W_OUT = W_UKV + (size_t)768 * 128 * 2, W_GU2 = W_OUT + (size_t)1024 * 1024 * 2, W_D2 = W_GU2 + (size_t)5632 * 1024 * 2, WL = W_D2 + (size_t)1024 * 2816 * 2;
constexpr size_t WS_XB = WS_W + ((2 * WL + MiB - 1) / MiB) * MiB;
constexpr size_t WS_ACT = WS_XB + 32 * MiB;
constexpr size_t WS_HID = WS_ACT;
constexpr size_t WS_CQ = WS_ACT, WS_CKV = WS_CQ + 8 * MiB, WS_QRAW = WS_CKV + 4 * MiB, WS_KA = WS_QRAW + 36 * MiB, WS_VA = WS_KA + 18 * MiB, WS_QS = WS_VA + 12 * MiB, WS_KS = WS_QS + 12 * MiB,
                 WS_VS = WS_KS + 4 * MiB, WS_QC = WS_VS + 4 * MiB, WS_KC = WS_QC + 8 * MiB, WS_VC = WS_KC + 8 * MiB, WS_OALL = WS_VC + 8 * MiB, WS_END = WS_OALL + 32 * MiB;
static_assert(WS_HID + (size_t)MROWS * DFF * 2 <= WS_END, "d_ws map");
constexpr int CW_BAR = 4096;
constexpr int CW_Q = 40960;
static_assert((CW_Q + 64 * 14) * 4 <= (int)CTL_ZERO_BYTES && CW_BAR + 8 * 3456 <= CW_Q, "ctl map");
constexpr int RING_BYTES = 131072, LDSCTL_OFF = RING_BYTES, MISC_OFF = LDSCTL_OFF + 320, LDS_BYTES = 147456;

__device__ __forceinline__ int hw_lane() { int l; asm volatile("v_mbcnt_lo_u32_b32 %0, -1, 0\n\tv_mbcnt_hi_u32_b32 %0, -1, %0" : "=v"(l)); return l; }
namespace pg8 {
#define PG8_LAS __attribute__((address_space(3)))
typedef unsigned short bf16_t;
typedef short bf16x8 __attribute__((ext_vector_type(8)));
typedef float f32x4 __attribute__((ext_vector_type(4)));
typedef unsigned u32x4 __attribute__((ext_vector_type(4)));
constexpr int BM = 256, BK = 64, HALF = 128, HTB = HALF * BK * 2  , STAGE_BYTES = 8 * HTB, NXCD = 8, WGM = 8;

__host__ __device__ __forceinline__ int lds_byte(int r, int c) { const int st = (r >> 4) * 2 + (c >> 5), rr = r & 15, cc = c & 31, ob = rr * 64 + cc * 2; return st * 1024 + (ob ^ (((ob >> 9) & 1) << 5)); }
__host__ __device__ __forceinline__ void stage_rc(int b, int& R, int& C) { const int st = b / 1024, sb = b % 1024, swz = sb ^ (((sb >> 9) & 1) << 5); R = (st >> 1) * 16 + swz / 64; C = (st & 1) * 32 + (swz % 64) / 2; }
__host__ __device__ __forceinline__ int perm32(int rho) { const int n = rho >> 4, i = rho & 15; return 8 * (i >> 2) + 4 * n + (i & 3); }

struct Unit { int pm, pn; };
struct Gemm { const bf16_t* A; const bf16_t* Bt; int M, N, K; };

struct StaticOrder {
    int nM, nN, nwg, G, c;
    __host__ __device__ void init(int M, int N, int G_, int c_) { nM = M / BM; nN = N / BM; nwg = nM * nN; G = G_; c = c_; }
    __host__ __device__ bool next(int i, Unit& u) const {
        const long L = (long)i * G + c; if (L >= nwg) return false;
        int wgid = (int)L; { const int q = nwg / NXCD, r = nwg % NXCD, xcd = wgid % NXCD, off = wgid / NXCD; wgid = (xcd < r ? xcd * (q + 1) : r * (q + 1) + (xcd - r) * q) + off; }
        const int nig = WGM * nN, gid = wgid / nig, fm = gid * WGM, gsz = (nM - fm) < WGM ? (nM - fm) : WGM;
        u.pm = fm + ((wgid % nig) % gsz); u.pn = (wgid % nig) / gsz; return true;
    }
    __device__ __forceinline__ void a_ready(const Unit&) const {}
    __device__ __forceinline__ void done(const Unit&) const {}
};

__device__ __forceinline__ unsigned cvt_pk_bf16(float lo, float hi) { unsigned r; asm volatile("v_cvt_pk_bf16_f32 %0, %1, %2" : "=v"(r) : "v"(lo), "v"(hi)); return r; }
typedef float f32x2 __attribute__((ext_vector_type(2)));
template <class Epi, class Sched, bool ALIGN_EPI = false, bool SP2 = false>
__device__ __forceinline__ void gemm_phase(PG8_LAS unsigned char* lds, const Gemm g, const Sched& S, const Epi& E, int wave0, unsigned long long* gprof = nullptr) {
#ifdef GEMM_PROF
    const long long gp_t0 = (Epi::AFTER_DRAIN && !Epi::HOOK && blockIdx.x == 0) ? (long long)clock64() : 0ll;
#endif
    int tid_ = wave0 * 64 + hw_lane(); asm volatile("" : "+v"(tid_));
    const int tid = tid_, wid = __builtin_amdgcn_readfirstlane(tid >> 6), lane = tid & 63, wr = wid >> 2, wc = wid & 3, fr = lane & 15, fq = lane >> 4;
    int K_ = g.K; asm volatile("" : "+s"(K_));
    const int K = K_, nt = K / BK;
    unsigned voffA[2], voffB[2];
#pragma unroll
    for (int i = 0; i < 2; ++i) { int R, C; stage_rc(tid * 16 + i * 8192, R, C); const int Rb = Epi::PERM ? ((R & ~31) + perm32(R & 31)) : R;
        voffA[i] = (unsigned)(R * K + C) * 2u; voffB[i] = (unsigned)(Rb * K + C) * 2u; }
    const size_t kstep = (size_t)(BK * 2);
    const size_t hstep = (size_t)HALF * K * 2;
    const size_t tstep = 2 * hstep;
    const unsigned ldsw = (unsigned)wid * 1024u;
    const int aoff = lds_byte(wr * 64 + fr, fq * 8), boff = lds_byte(wc * 32 + fr, fq * 8);
#define PG8_SA(b, h) (((b) * 2 + (h)) * HTB)
#define PG8_SB(b, h) ((4 + (b) * 2 + (h)) * HTB)
#define PG8_STAGE(bufoff, gbase, voff) do { _Pragma("unroll") for (int _i = 0; _i < 2; ++_i) \
        __builtin_amdgcn_global_load_lds((const unsigned*)((const char*)(gbase) + (voff)[_i]), (PG8_LAS unsigned*)(lds + (bufoff) + ldsw + _i * 8192), 16, 0, 0); } while (0)
#define PG8_LDA(dst, b, h) do { _Pragma("unroll") for (int m = 0; m < 4; ++m) _Pragma("unroll") for (int k = 0; k < 2; ++k) dst[m][k] = *(const PG8_LAS bf16x8*)(lds + PG8_SA(b, h) + aoff + m * 2048 + k * 1024); } while (0)
#define PG8_LDB(dst, b, h) do { _Pragma("unroll") for (int n = 0; n < 2; ++n) _Pragma("unroll") for (int k = 0; k < 2; ++k) dst[n][k] = *(const PG8_LAS bf16x8*)(lds + PG8_SB(b, h) + boff + n * 2048 + k * 1024); } while (0)
#define PG8_MMA(ai, bj, At, Bt) do { __builtin_amdgcn_s_setprio(1); _Pragma("unroll") for (int m = 0; m < 4; ++m) _Pragma("unroll") for (int n = 0; n < 2; ++n) _Pragma("unroll") for (int k = 0; k < 2; ++k) \
        acc[ai][bj][m][n] = __builtin_amdgcn_mfma_f32_16x16x32_bf16(Bt[n][k], At[m][k], acc[ai][bj][m][n], 0, 0, 0); __builtin_amdgcn_s_setprio(0); } while (0)
#define PG8_WAIT_V(n) asm volatile("s_waitcnt vmcnt(" #n ")" ::: "memory")
#define PG8_WAIT_L(n) asm volatile("s_waitcnt lgkmcnt(" #n ")" ::: "memory")
#define PG8_BAR __builtin_amdgcn_s_barrier()
#define PG8_SCHED __builtin_amdgcn_sched_barrier(0)
    Unit cur, nxt; int ui = 0;
    if (!S.next(0, cur)) return;
    f32x4 acc[2][2][4][2];
#pragma unroll
    for (int a = 0; a < 2; ++a)
#pragma unroll
        for (int b = 0; b < 2; ++b)
#pragma unroll
            for (int m = 0; m < 4; ++m)
#pragma unroll
                for (int n = 0; n < 2; ++n) acc[a][b][m][n] = (f32x4){0.f, 0.f, 0.f, 0.f};
    bf16x8 At[4][2], B0[2][2], B1[2][2];
    const char* cA = (const char*)g.A + (size_t)cur.pm * tstep; const char* cB = (const char*)g.Bt + (size_t)cur.pn * tstep;
    S.a_ready(cur);
    if constexpr (SP2) {
        PG8_STAGE(PG8_SB(0, 0), cB, voffB); PG8_STAGE(PG8_SB(0, 1), cB + hstep, voffB); PG8_STAGE(PG8_SA(0, 0), cA, voffA); PG8_STAGE(PG8_SA(0, 1), cA + hstep, voffA);
        if (wr == 1) PG8_BAR;
        PG8_WAIT_V(2); PG8_BAR;
        PG8_STAGE(PG8_SB(1, 0), cB + kstep, voffB); PG8_STAGE(PG8_SA(1, 0), cA + kstep, voffA); PG8_STAGE(PG8_SB(1, 1), cB + hstep + kstep, voffB);
        PG8_WAIT_V(6); PG8_BAR;
    } else {
        PG8_STAGE(PG8_SB(0, 0), cB, voffB); PG8_STAGE(PG8_SA(0, 0), cA, voffA); PG8_STAGE(PG8_SB(0, 1), cB + hstep, voffB); PG8_STAGE(PG8_SA(0, 1), cA + hstep, voffA);
        if (wr == 1) PG8_BAR;
        PG8_WAIT_V(4); PG8_BAR;
        PG8_STAGE(PG8_SB(1, 0), cB + kstep, voffB); PG8_STAGE(PG8_SA(1, 0), cA + kstep, voffA); PG8_STAGE(PG8_SB(1, 1), cB + hstep + kstep, voffB);
        PG8_WAIT_V(6); PG8_BAR;
    }
    for (;;) {
        const bool has_next = S.next(ui + 1, nxt);
        const char* nA = has_next ? (const char*)g.A + (size_t)nxt.pm * tstep : cA; const char* nB = has_next ? (const char*)g.Bt + (size_t)nxt.pn * tstep : cB;
#pragma nounroll
        for (int t = 0; t < nt; t += 2) {
            if constexpr (Epi::HOOK) E.hook(acc, cur, t, wr, wc, fr, fq);
            const bool last = (t == nt - 2);
            const char* a1 = cA + (size_t)(t + 1) * kstep;
            const char* a2 = last ? nA : cA + (size_t)(t + 2) * kstep; const char* b2 = last ? nB : cB + (size_t)(t + 2) * kstep;
            const char* a3 = a2 + kstep; const char* b3 = b2 + kstep;
            if (last && has_next) S.a_ready(nxt);
            if constexpr (SP2) {
            PG8_LDB(B0, 0, 0); PG8_LDB(B1, 0, 1); PG8_SCHED; PG8_LDA(At, 0, 0); PG8_STAGE(PG8_SA(1, 1), a1 + hstep, voffA);
            PG8_WAIT_V(8); PG8_WAIT_L(0); PG8_BAR; PG8_MMA(0, 0, At, B0); PG8_MMA(0, 1, At, B1); PG8_BAR; PG8_SCHED;
            PG8_LDA(At, 0, 1); PG8_STAGE(PG8_SB(0, 0), b2, voffB); PG8_STAGE(PG8_SB(0, 1), b2 + hstep, voffB); PG8_STAGE(PG8_SA(0, 0), a2, voffA);
            PG8_WAIT_V(8); PG8_WAIT_L(0); PG8_BAR; PG8_MMA(1, 0, At, B0); PG8_MMA(1, 1, At, B1); PG8_BAR; PG8_SCHED;
            PG8_LDB(B0, 1, 0); PG8_LDB(B1, 1, 1); PG8_SCHED; PG8_LDA(At, 1, 0); PG8_STAGE(PG8_SA(0, 1), a2 + hstep, voffA);
            PG8_WAIT_V(8); PG8_WAIT_L(0); PG8_BAR; PG8_MMA(0, 0, At, B0); PG8_MMA(0, 1, At, B1); PG8_BAR; PG8_SCHED;
            PG8_LDA(At, 1, 1); PG8_STAGE(PG8_SB(1, 0), b3, voffB); PG8_STAGE(PG8_SB(1, 1), b3 + hstep, voffB); PG8_STAGE(PG8_SA(1, 0), a3, voffA);
            PG8_WAIT_V(8); PG8_WAIT_L(0); PG8_BAR; PG8_MMA(1, 0, At, B0); PG8_MMA(1, 1, At, B1); PG8_BAR; PG8_SCHED;
            } else {
            PG8_LDB(B0, 0, 0); PG8_SCHED; PG8_LDA(At, 0, 0); PG8_STAGE(PG8_SA(1, 1), a1 + hstep, voffA);
            PG8_WAIT_L(8); PG8_BAR; PG8_WAIT_L(0); PG8_MMA(0, 0, At, B0); PG8_BAR; PG8_SCHED;
            PG8_LDB(B1, 0, 1); PG8_STAGE(PG8_SB(0, 0), b2, voffB);
            PG8_BAR; PG8_WAIT_L(0); PG8_MMA(0, 1, At, B1); PG8_BAR;
            PG8_LDA(At, 0, 1); PG8_STAGE(PG8_SA(0, 0), a2, voffA);
            PG8_BAR; PG8_WAIT_L(0); PG8_MMA(1, 0, At, B0); PG8_BAR; PG8_SCHED;
            PG8_STAGE(PG8_SB(0, 1), b2 + hstep, voffB);
            PG8_WAIT_V(6); PG8_BAR; PG8_MMA(1, 1, At, B1); PG8_BAR;
            PG8_LDB(B0, 1, 0); PG8_SCHED; PG8_LDA(At, 1, 0); PG8_STAGE(PG8_SA(0, 1), a2 + hstep, voffA);
            PG8_WAIT_L(8); PG8_BAR; PG8_WAIT_L(0); PG8_MMA(0, 0, At, B0); PG8_BAR; PG8_SCHED;
            PG8_LDB(B1, 1, 1); PG8_STAGE(PG8_SB(1, 0), b3, voffB);
            PG8_BAR; PG8_WAIT_L(0); PG8_MMA(0, 1, At, B1); PG8_BAR;
            PG8_LDA(At, 1, 1); PG8_STAGE(PG8_SA(1, 0), a3, voffA);
            PG8_BAR; PG8_WAIT_L(0); PG8_MMA(1, 0, At, B0); PG8_BAR; PG8_SCHED;
            PG8_STAGE(PG8_SB(1, 1), b3 + hstep, voffB);
            PG8_WAIT_V(6); PG8_BAR; PG8_MMA(1, 1, At, B1); PG8_BAR;
            }
        }
        if constexpr (ALIGN_EPI) { if (wr == 0) PG8_BAR; }
        if constexpr (!Epi::AFTER_DRAIN) {
            Unit ce = cur; asm volatile("" : "+s"(ce.pm), "+s"(ce.pn)); int fre = fr, fqe = fq; asm volatile("" : "+v"(fre), "+v"(fqe));
            E(acc, ce, wr, wc, fre, fqe); S.done(cur); }
        if (!has_next) break;
#pragma unroll
        for (int a = 0; a < 2; ++a)
#pragma unroll
            for (int b = 0; b < 2; ++b)
#pragma unroll
                for (int m = 0; m < 4; ++m)
#pragma unroll
                    for (int n = 0; n < 2; ++n) acc[a][b][m][n] = (f32x4){0.f, 0.f, 0.f, 0.f};
        cur = nxt; cA = nA; cB = nB; ++ui;
        if constexpr (ALIGN_EPI) { if (wr == 1) PG8_BAR; }
    }
    PG8_WAIT_V(0);
    if constexpr (!ALIGN_EPI) { if (wr == 0) PG8_BAR; }
    PG8_BAR;
#ifdef GEMM_PROF
    const long long gp_t1 = (Epi::AFTER_DRAIN && !Epi::HOOK && blockIdx.x == 0) ? (long long)clock64() : 0ll;
#endif
    if constexpr (Epi::AFTER_DRAIN) { E.fused(acc, cur, wr, wc, fr, fq, lds, wid, lane); S.done(cur); }
#ifdef GEMM_PROF
    if (Epi::AFTER_DRAIN && !Epi::HOOK && blockIdx.x == 0 && tid == 0 && gprof) { const long long gp_t2 = clock64(); atomicAdd(gprof + 0, (unsigned long long)(gp_t1 - gp_t0)); atomicAdd(gprof + 1, (unsigned long long)(gp_t2 - gp_t1)); atomicAdd(gprof + 2, 1ull); }
#endif
#undef PG8_SA
#undef PG8_SB
#undef PG8_STAGE
#undef PG8_LDA
#undef PG8_LDB
#undef PG8_MMA
#undef PG8_WAIT_V
#undef PG8_WAIT_L
#undef PG8_BAR
#undef PG8_SCHED
}
constexpr float RMS_EPS = 1e-6f;
constexpr int MROWS_ = 16384;
constexpr float LOG2E = 1.4426950408889634f;
typedef unsigned u32x2 __attribute__((ext_vector_type(2)));
#define PG8_FENCE() asm volatile("" ::: "memory")
#define PG8_G __attribute__((address_space(1)))
__device__ __forceinline__ float sum16f(const PG8_G float* p) {
    const f32x4 a = *(const PG8_G f32x4*)p, b = *(const PG8_G f32x4*)(p + 4), c = *(const PG8_G f32x4*)(p + 8), d = *(const PG8_G f32x4*)(p + 12);
    return ((a[0] + a[1]) + (a[2] + a[3])) + ((b[0] + b[1]) + (b[2] + b[3])) + ((c[0] + c[1]) + (c[2] + c[3])) + ((d[0] + d[1]) + (d[2] + d[3]));
}
__device__ __forceinline__ float xsum16(float x) { auto r = __builtin_amdgcn_permlane16_swap(__float_as_uint(x), __float_as_uint(x), false, false); return __uint_as_float(r[0]) + __uint_as_float(r[1]); }
__device__ __forceinline__ float xsum32(float x) { auto r = __builtin_amdgcn_permlane32_swap(__float_as_uint(x), __float_as_uint(x), false, false); return __uint_as_float(r[0]) + __uint_as_float(r[1]); }
__device__ __forceinline__ float wave_sum_dpp(float x) {
    x += __builtin_bit_cast(float, __builtin_amdgcn_update_dpp(0, __builtin_bit_cast(int, x), 0xB1, 0xf, 0xf, true));
    x += __builtin_bit_cast(float, __builtin_amdgcn_update_dpp(0, __builtin_bit_cast(int, x), 0x4E, 0xf, 0xf, true));
    x += __builtin_bit_cast(float, __builtin_amdgcn_update_dpp(0, __builtin_bit_cast(int, x), 0x141, 0xf, 0xf, true));
    x += __builtin_bit_cast(float, __builtin_amdgcn_update_dpp(0, __builtin_bit_cast(int, x), 0x140, 0xf, 0xf, true));
    return xsum32(xsum16(x));
}
__device__ __forceinline__ float fast_rcp(float x) { return __builtin_amdgcn_rcpf(x); }
__device__ __forceinline__ float silu_fast(float g) { return g * fast_rcp(1.0f + __builtin_amdgcn_exp2f(-g * LOG2E)); }
__device__ __forceinline__ float sq4(const f32x4 v) { return (v[0] * v[0] + v[1] * v[1]) + (v[2] * v[2] + v[3] * v[3]); }

struct EpiUp {
    static constexpr bool PERM = true, AFTER_DRAIN = false, HOOK = false;
    PG8_G unsigned char* ws; const PG8_G float* bias;
    __device__ __forceinline__ void hook(f32x4 (&)[2][2][4][2], const Unit&, int, int, int, int, int) const {}
    __device__ __forceinline__ void operator()(const f32x4 (&acc)[2][2][4][2], const Unit& u, int wr, int wc, int fr, int fq) const {
        PG8_G bf16_t* HID = (PG8_G bf16_t*)(ws + WS_HID); const PG8_G float* ssqx = (const PG8_G float*)(ws + WS_SSQX);
        const int b = u.pm >> 5;
        const PG8_G float* bb = bias + b * 5632 + u.pn * BM + wc * 32 + 8 * fq;
        f32x4 bg[2], bu[2];
#pragma unroll
        for (int n = 0; n < 2; ++n) { bg[n] = *(const PG8_G f32x4*)(bb + 4 * n); bu[n] = *(const PG8_G f32x4*)(bb + HALF + 4 * n); }
#pragma unroll
        for (int ai = 0; ai < 2; ++ai)
#pragma unroll
            for (int m = 0; m < 4; ++m) {
                const int row = u.pm * BM + ai * HALF + wr * 64 + m * 16 + fr;
                const float r = 1.0f / sqrtf(sum16f(ssqx + (size_t)row * 16) * (1.0f / 1024.0f) + RMS_EPS);
                float hv[8];
#pragma unroll
                for (int n = 0; n < 2; ++n)
#pragma unroll
                    for (int i = 0; i < 4; ++i) { const float g = acc[ai][0][m][n][i] * r + bg[n][i], uu = acc[ai][1][m][n][i] * r + bu[n][i]; hv[4 * n + i] = silu_fast(g) * uu; }
                u32x4 w; w.x = cvt_pk_bf16(hv[0], hv[1]); w.y = cvt_pk_bf16(hv[2], hv[3]); w.z = cvt_pk_bf16(hv[4], hv[5]); w.w = cvt_pk_bf16(hv[6], hv[7]);
                *(PG8_G u32x4*)(HID + (size_t)row * 2816 + u.pn * HALF + wc * 32 + 8 * fq) = w;
                if (m & 1) PG8_FENCE();
            }
    }
};

template <bool HOOKED> struct EpiResS {
    static constexpr bool PERM = false, AFTER_DRAIN = true, HOOK = HOOKED;
    PG8_G float* fout; PG8_G unsigned char* ws; const PG8_G float* gate; const PG8_G float* igs; const PG8_G float* gs; float coef;
    __device__ __forceinline__ void group_r(int row, float& rA, float& rB, float& rC) const {
        const PG8_G float* p = (const PG8_G float*)(ws + WS_SSQO) + (size_t)row * 16;
        const f32x4 a = *(const PG8_G f32x4*)p, b = *(const PG8_G f32x4*)(p + 4), c = *(const PG8_G f32x4*)(p + 8), d = *(const PG8_G f32x4*)(p + 12);
        const float sA = ((a[0] + a[1]) + (a[2] + a[3])) + (b[0] + b[1]), sB = ((b[2] + b[3]) + (c[0] + c[1])) + (c[2] + c[3]), sC = (d[0] + d[1]) + (d[2] + d[3]);
        rA = 1.0f / sqrtf(sA * (1.0f / 384.0f) + RMS_EPS); rB = 1.0f / sqrtf(sB * (1.0f / 384.0f) + RMS_EPS); rC = 1.0f / sqrtf(sC * (1.0f / 256.0f) + RMS_EPS);
    }
    __device__ __forceinline__ void hook(f32x4 (&acc)[2][2][4][2], const Unit& u, int t, int wr, int wc, int fr, int fq) const {
        if (t != 6 && t != 12) return;
        asm volatile("" : "+v"(fr));
#pragma unroll
        for (int ai = 0; ai < 2; ++ai)
#pragma unroll
            for (int m = 0; m < 4; ++m) {
                const int row = u.pm * BM + ai * HALF + wr * 64 + m * 16 + fr;
                float rA, rB, rC; group_r(row, rA, rB, rC);
                const float f = (t == 6) ? rA / rB : rB / rC;
#pragma unroll
                for (int bj = 0; bj < 2; ++bj)
#pragma unroll
                    for (int n = 0; n < 2; ++n) acc[ai][bj][m][n] = acc[ai][bj][m][n] * f;
                PG8_FENCE();
            }
    }
    __device__ __forceinline__ void fused(f32x4 (&acc)[2][2][4][2], const Unit& u, int wr, int wc, int fr, int fq, PG8_LAS unsigned char* lds, int wid, int lane) const {
        PG8_G bf16_t* xb = (PG8_G bf16_t*)(ws + WS_XB); PG8_G float* ssq_out = (PG8_G float*)(ws + WS_SSQX); constexpr int gate_bstride = 9 * 1024;
        const int b = u.pm >> 5, colg = u.pn * BM + 4 * lane;
        const f32x4 gv = *(const PG8_G f32x4*)(gate + (size_t)b * gate_bstride + colg) * coef;
        const f32x4 gsv = gs ? *(const PG8_G f32x4*)(gs + (size_t)b * 1024 + colg) : (f32x4){0.f, 0.f, 0.f, 0.f};
        const f32x4 igv = *(const PG8_G f32x4*)(igs + (size_t)b * 1024 + colg);
#pragma unroll
        for (int ai = 0; ai < 2; ++ai) {
#pragma unroll
            for (int m = 0; m < 4; ++m) { const int rl = wr * 64 + m * 16 + fr;
#pragma unroll
                for (int bj = 0; bj < 2; ++bj)
#pragma unroll
                    for (int n = 0; n < 2; ++n) { const int c = 32 * bj + 8 * wc + 4 * n + fq; *(PG8_LAS f32x4*)(lds + rl * 1024 + ((c ^ (rl & 7)) << 4)) = acc[ai][bj][m][n]; } }
            asm volatile("s_waitcnt lgkmcnt(0)\n\ts_barrier" ::: "memory");
#pragma unroll
            for (int half = 0; half < 2; ++half) {
                u32x2 xo[8];
#pragma unroll
                for (int k = 0; k < 8; ++k) { const int rl = wid + 8 * (half * 8 + k); xo[k] = *(const PG8_G u32x2*)(xb + (size_t)(u.pm * BM + ai * HALF + rl) * 1024 + colg); }
#pragma unroll
                for (int k = 0; k < 8; ++k) { const int rl = wid + 8 * (half * 8 + k); const int row = u.pm * BM + ai * HALF + rl;
                    f32x4 t = *(const PG8_LAS f32x4*)(lds + rl * 1024 + ((lane ^ (rl & 7)) << 4));
                    if (HOOKED) { float rA, rB, rC; group_r(row, rA, rB, rC); t = t * rC; }
                    const f32x4 xs = {__uint_as_float(xo[k].x << 16), __uint_as_float(xo[k].x & 0xffff0000u), __uint_as_float(xo[k].y << 16), __uint_as_float(xo[k].y & 0xffff0000u)};
                    const f32x4 xn = xs * igv + gv * t;
                    if (!gs) *(PG8_G f32x4*)(fout + (size_t)row * 1024 + colg) = xn;
                    if (gs) { const f32x4 y = xn * gsv; u32x2 w; w.x = cvt_pk_bf16(y[0], y[1]); w.y = cvt_pk_bf16(y[2], y[3]); *(PG8_G u32x2*)(xb + (size_t)row * 1024 + colg) = w; }
                    float ss = sq4(xn);
                    ss = wave_sum_dpp(ss);
                    if (gs && lane == 0) *(PG8_G f32x4*)(ssq_out + (size_t)row * 16 + 4 * u.pn) = (f32x4){ss, 0.f, 0.f, 0.f};
                }
            }
            asm volatile("s_waitcnt lgkmcnt(0)\n\ts_barrier" ::: "memory");
        }
    }
};

struct EpiIn {
    static constexpr bool PERM = true, AFTER_DRAIN = false, HOOK = false;
    PG8_G unsigned char* ws; const PG8_G float* gq; const PG8_G float* gk; const PG8_G float* bias;
    __device__ __forceinline__ void hook(f32x4 (&)[2][2][4][2], const Unit&, int, int, int, int, int) const {}
    __device__ __forceinline__ void operator()(const f32x4 (&acc)[2][2][4][2], const Unit& u, int wr, int wc, int fr, int fq) const {
        const int slot = u.pn * 4 + wc;
        if (slot == 7 || slot >= 30) return;
        const int b = u.pm >> 5;
        const PG8_G float* ssqx = (const PG8_G float*)(ws + WS_SSQX);
        PG8_G PG8_G bf16_t* dst = nullptr; int pitch = 0, col0 = 0; int kind = 0;
        PG8_G PG8_G float* ssqd = nullptr; int ssqp = 0, ssqi = 0; const PG8_G float* gain = nullptr; float scale = 1.0f;
        if (slot < 4)       { dst = (PG8_G bf16_t*)(ws + WS_CQ);  pitch = 256; col0 = 64 * slot;        kind = 1; ssqd = (PG8_G float*)(ws + WS_SSQC);  ssqp = 4; ssqi = slot; }
        else if (slot < 6)  { dst = (PG8_G bf16_t*)(ws + WS_CKV); pitch = 128; col0 = 64 * (slot - 4);  kind = 1; ssqd = (PG8_G float*)(ws + WS_SSQC) + (size_t)MROWS_ * 4; ssqp = 2; ssqi = slot - 4; }
        else if (slot == 6) { kind = 3; }
        else if (slot < 14) { dst = (PG8_G bf16_t*)(ws + WS_QS);  pitch = 384; col0 = 64 * (slot - 8);  kind = 2; gain = gq; scale = 0.125f * LOG2E; }
        else if (slot < 16) { dst = (PG8_G bf16_t*)(ws + WS_KS);  pitch = 128; col0 = 64 * (slot - 14); kind = 2; gain = gk; }
        else if (slot < 18) { dst = (PG8_G bf16_t*)(ws + WS_VS);  pitch = 128; col0 = 64 * (slot - 16); }
        else if (slot < 22) { dst = (PG8_G bf16_t*)(ws + WS_QC);  pitch = 256; col0 = 64 * (slot - 18); scale = 0.125f * LOG2E; }
        else if (slot < 26) { dst = (PG8_G bf16_t*)(ws + WS_KC);  pitch = 256; col0 = 64 * (slot - 22); }
        else                { dst = (PG8_G bf16_t*)(ws + WS_VC);  pitch = 256; col0 = 64 * (slot - 26); }
        const PG8_G float* bb = bias + b * 2048 + u.pn * BM + wc * 32 + 8 * fq;
        f32x4 bv[2][2], gn[2][2];
#pragma unroll
        for (int bj = 0; bj < 2; ++bj)
#pragma unroll
            for (int n = 0; n < 2; ++n) { bv[bj][n] = *(const PG8_G f32x4*)(bb + bj * HALF + 4 * n);
                gn[bj][n] = (kind == 2) ? *(const PG8_G f32x4*)(gain + 32 * bj + 8 * fq + 4 * n) * scale : (f32x4){scale, scale, scale, scale}; }
#pragma unroll
        for (int ai = 0; ai < 2; ++ai)
#pragma unroll
            for (int m = 0; m < 4; ++m) {
                const int row = u.pm * BM + ai * HALF + wr * 64 + m * 16 + fr;
                const float r = 1.0f / sqrtf(sum16f(ssqx + (size_t)row * 16) * (1.0f / 1024.0f) + RMS_EPS);
                f32x4 v[2][2]; float ss = 0.f;
#pragma unroll
                for (int bj = 0; bj < 2; ++bj)
#pragma unroll
                    for (int n = 0; n < 2; ++n) { v[bj][n] = acc[ai][bj][m][n] * r + bv[bj][n]; ss += sq4(v[bj][n]); }
                if (kind == 3) {
                    float s0 = sq4(v[0][0]) + sq4(v[0][1]);
                    s0 = xsum32(xsum16(s0));
                    *(PG8_G f32x4*)((PG8_G float*)(ws + WS_KPE) + (size_t)row * 32 + 8 * fq) = v[0][0]; *(PG8_G f32x4*)((PG8_G float*)(ws + WS_KPE) + (size_t)row * 32 + 8 * fq + 4) = v[0][1];
                    if (fq == 0) ((PG8_G float*)(ws + WS_SSQC) + (size_t)MROWS_ * 6)[row] = s0;
                } else {
                    if (kind != 0) { ss = xsum32(xsum16(ss)); }
                    float rn = 1.0f;
                    if (kind == 2) rn = 1.0f / sqrtf(ss * (1.0f / 64.0f) + RMS_EPS);
                    if (kind == 1 && fq == 0) ssqd[(size_t)row * ssqp + ssqi] = ss;
#pragma unroll
                    for (int bj = 0; bj < 2; ++bj) {
                        const f32x4 y0 = v[bj][0] * gn[bj][0] * rn, y1 = v[bj][1] * gn[bj][1] * rn;
                        u32x4 w; w.x = cvt_pk_bf16(y0[0], y0[1]); w.y = cvt_pk_bf16(y0[2], y0[3]); w.z = cvt_pk_bf16(y1[0], y1[1]); w.w = cvt_pk_bf16(y1[2], y1[3]);
                        *(PG8_G u32x4*)(dst + (size_t)row * pitch + col0 + 32 * bj + 8 * fq) = w;
                    }
                }
                if (m & 1) PG8_FENCE();
            }
    }
};

struct EpiUq {
    static constexpr bool PERM = false, AFTER_DRAIN = false, HOOK = false;
    PG8_G unsigned char* ws;
    __device__ __forceinline__ void hook(f32x4 (&)[2][2][4][2], const Unit&, int, int, int, int, int) const {}
    __device__ __forceinline__ void operator()(const f32x4 (&acc)[2][2][4][2], const Unit& u, int wr, int wc, int fr, int fq) const {
        PG8_G bf16_t* QRAW = (PG8_G bf16_t*)(ws + WS_QRAW); const PG8_G float* ssqcq = (const PG8_G float*)(ws + WS_SSQC);
        const int col0 = u.pn * BM + wc * 32 + 4 * fq;
#pragma unroll
        for (int ai = 0; ai < 2; ++ai)
#pragma unroll
            for (int m = 0; m < 4; ++m) {
                const int row = u.pm * BM + ai * HALF + wr * 64 + m * 16 + fr;
                const f32x4 s = *(const PG8_G f32x4*)(ssqcq + (size_t)row * 4);
                const float r = 1.0f / sqrtf(((s[0] + s[1]) + (s[2] + s[3])) * (1.0f / 256.0f) + RMS_EPS);
#pragma unroll
                for (int bj = 0; bj < 2; ++bj)
#pragma unroll
                    for (int n = 0; n < 2; ++n) { const int c = col0 + bj * HALF + n * 16; if (c < 576) { const f32x4 y = acc[ai][bj][m][n] * r; u32x2 w; w.x = cvt_pk_bf16(y[0], y[1]); w.y = cvt_pk_bf16(y[2], y[3]); *(PG8_G u32x2*)(QRAW + (size_t)row * 576 + c) = w; } }
            }
    }
};

struct EpiUkv {
    static constexpr bool PERM = true, AFTER_DRAIN = false, HOOK = false;
    PG8_G unsigned char* ws; const PG8_G float* gk;
    __device__ __forceinline__ void hook(f32x4 (&)[2][2][4][2], const Unit&, int, int, int, int, int) const {}
    __device__ __forceinline__ void operator()(const f32x4 (&acc)[2][2][4][2], const Unit& u, int wr, int wc, int fr, int fq) const {
        PG8_G bf16_t* KA = (PG8_G bf16_t*)(ws + WS_KA); PG8_G bf16_t* VA = (PG8_G bf16_t*)(ws + WS_VA); const PG8_G float* ssqckv = (const PG8_G float*)(ws + WS_SSQC) + (size_t)MROWS_ * 4; const PG8_G float* ssqkpe = (const PG8_G float*)(ws + WS_SSQC) + (size_t)MROWS_ * 6;
        const PG8_G float* kpe = (const PG8_G float*)(ws + WS_KPE); const PG8_G float* cs = (const PG8_G float*)(ws + WS_CS);
        const int h = 2 * u.pn + (wc >> 1); const bool isv = (wc & 1) != 0;
        f32x4 gn[2][2], g1 = {1.f, 1.f, 1.f, 1.f}, g2 = {1.f, 1.f, 1.f, 1.f};
        if (!isv) {
#pragma unroll
            for (int bj = 0; bj < 2; ++bj)
#pragma unroll
                for (int n = 0; n < 2; ++n) gn[bj][n] = *(const PG8_G f32x4*)(gk + 32 * bj + 8 * fq + 4 * n);
            g1 = *(const PG8_G f32x4*)(gk + 64 + 4 * fq); g2 = *(const PG8_G f32x4*)(gk + 80 + 4 * fq);
        }
#pragma unroll
        for (int ai = 0; ai < 2; ++ai)
#pragma unroll
            for (int m = 0; m < 4; ++m) {
                const int row = u.pm * BM + ai * HALF + wr * 64 + m * 16 + fr;
                const float r = 1.0f / sqrtf((ssqckv[(size_t)row * 2] + ssqckv[(size_t)row * 2 + 1]) * (1.0f / 128.0f) + RMS_EPS);
                f32x4 v[2][2]; float ss = 0.f;
#pragma unroll
                for (int bj = 0; bj < 2; ++bj)
#pragma unroll
                    for (int n = 0; n < 2; ++n) { v[bj][n] = acc[ai][bj][m][n] * r; ss += sq4(v[bj][n]); }
                if (isv) {
#pragma unroll
                    for (int bj = 0; bj < 2; ++bj) { u32x4 w; w.x = cvt_pk_bf16(v[bj][0][0], v[bj][0][1]); w.y = cvt_pk_bf16(v[bj][0][2], v[bj][0][3]); w.z = cvt_pk_bf16(v[bj][1][0], v[bj][1][1]); w.w = cvt_pk_bf16(v[bj][1][2], v[bj][1][3]);
                        *(PG8_G u32x4*)(VA + ((size_t)(row >> 6) * 6 + h) * 4096 + bj * 2048 + (row & 63) * 32 + 8 * fq) = w; }
                } else {
                    ss = xsum32(xsum16(ss));
                    const float rk = 1.0f / sqrtf((ss + ssqkpe[row]) * (1.0f / 96.0f) + RMS_EPS);
                    PG8_G bf16_t* kd = KA + ((size_t)(row >> 6) * 6 + h) * 6144 + (row & 63) * 8;
#pragma unroll
                    for (int bj = 0; bj < 2; ++bj) { const f32x4 y0 = v[bj][0] * gn[bj][0] * rk, y1 = v[bj][1] * gn[bj][1] * rk;
                        u32x4 w; w.x = cvt_pk_bf16(y0[0], y0[1]); w.y = cvt_pk_bf16(y0[2], y0[3]); w.z = cvt_pk_bf16(y1[0], y1[1]); w.w = cvt_pk_bf16(y1[2], y1[3]);
                        *(PG8_G u32x4*)(kd + (4 * bj + fq) * 512) = w; }
                    const f32x4 x1 = *(const PG8_G f32x4*)(kpe + (size_t)row * 32 + 4 * fq) * g1 * rk, x2 = *(const PG8_G f32x4*)(kpe + (size_t)row * 32 + 16 + 4 * fq) * g2 * rk;
                    const f32x4 c = *(const PG8_G f32x4*)(cs + (size_t)row * 32 + 4 * fq), s = *(const PG8_G f32x4*)(cs + (size_t)row * 32 + 16 + 4 * fq);
                    const f32x4 o1 = x1 * c - x2 * s, o2 = x2 * c + x1 * s;
                    u32x2 w1, w2; w1.x = cvt_pk_bf16(o1[0], o1[1]); w1.y = cvt_pk_bf16(o1[2], o1[3]); w2.x = cvt_pk_bf16(o2[0], o2[1]); w2.y = cvt_pk_bf16(o2[2], o2[3]);
                    *(PG8_G u32x2*)(kd + (8 + (fq >> 1)) * 512 + (fq & 1) * 4) = w1; *(PG8_G u32x2*)(kd + (10 + (fq >> 1)) * 512 + (fq & 1) * 4) = w2;
                }
                if (m & 1) PG8_FENCE();
            }
    }
};
}
#define GAS __attribute__((address_space(1)))
#define LAS __attribute__((address_space(3)))
typedef unsigned short bf16;
typedef unsigned v4u __attribute__((ext_vector_type(4)));
typedef float f32x4 __attribute__((ext_vector_type(4)));
typedef short bf16x8 __attribute__((ext_vector_type(8)));
typedef GAS unsigned gu32;
typedef GAS unsigned long long gu64;
#define RLX_AGENT __ATOMIC_RELAXED, __HIP_MEMORY_SCOPE_AGENT
#define LDS_WAIT() asm volatile("s_waitcnt lgkmcnt(0)" ::: "memory")
#define VM_WAIT() asm volatile("s_waitcnt vmcnt(0)" ::: "memory")
__device__ __forceinline__ unsigned long long rt() { return __builtin_amdgcn_s_memrealtime(); }
__device__ __forceinline__ unsigned f2bf(float f) { unsigned u = __builtin_bit_cast(unsigned, f); return (u + 0x7fffu + ((u >> 16) & 1u)) >> 16; }
__device__ __forceinline__ unsigned pk2(float lo, float hi) { return f2bf(lo) | (f2bf(hi) << 16); }

#define XB_TMO      128
#define XB_XCNT(j)  (256  + 64 * (j))
#define XB_XSUB(j)  (1280 + 64 * (j))
#define XB_XGEN(j)  (2304 + 64 * (j))
#define XB_TOP      3328
#define XB_TOPGEN   3392
#define XCD_BAR_WORDS 3456
#define XB_SPIN_CAP (1u << 18)

__device__ __forceinline__ unsigned xb_ld(unsigned* p)              { return __hip_atomic_load(p, __ATOMIC_RELAXED, __HIP_MEMORY_SCOPE_AGENT); }
__device__ __forceinline__ unsigned xb_add(unsigned* p, unsigned v) { return __hip_atomic_fetch_add(p, v, __ATOMIC_RELAXED, __HIP_MEMORY_SCOPE_AGENT); }
__device__ __forceinline__ unsigned xb_xcc_id() { return (unsigned)__builtin_amdgcn_s_getreg((3 << 11) | 20) & 0xFu; }
#define XB_SPIN(cond, bar) do { unsigned _sp = 0; while (cond) { __builtin_amdgcn_s_sleep(1); \
    if ((++_sp & 255u) == 0u) { if (xb_ld(&(bar)[XB_TMO])) break; if (_sp > XB_SPIN_CAP) { atomicAdd(&(bar)[XB_TMO], 1u); break; } } } } while (0)

struct XcdBarrier {
    unsigned* bar; unsigned x;
    volatile LAS unsigned* st;
    int w0;
};

__device__ __forceinline__ XcdBarrier xcd_barrier_post(unsigned* bar, volatile LAS unsigned* st, int w0) {
    XcdBarrier b; b.bar = bar; b.x = xb_xcc_id(); b.st = st; b.w0 = w0;
    if (w0 == 0 && hw_lane() == 0) (void)xb_add(&bar[XB_XCNT(b.x)], 1u);
    return b;
}
__device__ __forceinline__ void xcd_barrier_complete(unsigned* bar, unsigned x, unsigned& nloc, unsigned& nx) {
    const unsigned G = gridDim.x * gridDim.y * gridDim.z;
    unsigned sum, cnt, mine, sp = 0u;
    for (;;) {
        sum = 0u; cnt = 0u; mine = 0u;
#pragma unroll
        for (unsigned j = 0; j < 16; ++j) { const unsigned c = xb_ld(&bar[XB_XCNT(j)]); sum += c; cnt += (c > 0u) ? 1u : 0u; mine = (j == x) ? c : mine; }
        if (sum == G) break;
        __builtin_amdgcn_s_sleep(1);
        if ((++sp & 255u) == 0u) { if (xb_ld(&bar[XB_TMO])) break; if (sp > XB_SPIN_CAP) { atomicAdd(&bar[XB_TMO], 1u); break; } }
    }
    nloc = mine > 0u ? mine : 1u; nx = cnt > 0u ? cnt : 1u;
}

__device__ __forceinline__ void xcd_barrier(const XcdBarrier& b) {
    asm volatile("s_waitcnt vmcnt(0)" ::: "memory");
    __syncthreads();
    if (b.w0 == 0 && hw_lane() == 0) {
        unsigned* bar = b.bar;
        __builtin_amdgcn_s_waitcnt(0);
        unsigned nloc = b.st[0], nx = b.st[1];
        if (nloc == 0u) { xcd_barrier_complete(bar, b.x, nloc, nx); b.st[0] = nloc; b.st[1] = nx; }
        const unsigned old = xb_add(&bar[XB_XSUB(b.x)], 1u);
        const unsigned gen = old / nloc;
        if (old + 1u == (gen + 1u) * nloc) {
            __builtin_amdgcn_fence(__ATOMIC_RELEASE, "agent");
            asm volatile("s_waitcnt vmcnt(0)" ::: "memory");
            const unsigned og = xb_add(&bar[XB_TOP], 1u);
            const unsigned tg = og / nx;
            if (og + 1u == (tg + 1u) * nx) xb_add(&bar[XB_TOPGEN], 1u);
            else XB_SPIN(xb_ld(&bar[XB_TOPGEN]) == tg, bar);
            __builtin_amdgcn_fence(__ATOMIC_ACQUIRE, "agent");
            xb_add(&bar[XB_XGEN(b.x)], 1u);
            asm volatile("s_waitcnt vmcnt(0)" ::: "memory");
        } else {
            XB_SPIN(xb_ld(&bar[XB_XGEN(b.x)]) == gen, bar);
            __builtin_amdgcn_fence(__ATOMIC_ACQUIRE, "agent");
            asm volatile("s_waitcnt vmcnt(0)" ::: "memory");
        }
    }
    __syncthreads();
}
namespace att {
typedef unsigned short bf16_t;
typedef short bf16x8 __attribute__((ext_vector_type(8)));
typedef short s16x4 __attribute__((ext_vector_type(4)));
typedef short v4i16_t __attribute__((ext_vector_type(4)));
typedef float f32x16 __attribute__((ext_vector_type(16)));
typedef float f32x4 __attribute__((ext_vector_type(4)));
typedef float f32x2 __attribute__((ext_vector_type(2)));
typedef __bf16 bf16x2_t __attribute__((ext_vector_type(2)));
typedef unsigned u32x4 __attribute__((ext_vector_type(4)));
typedef int i32x4 __attribute__((ext_vector_type(4)));
#define ALAS __attribute__((address_space(3)))
#define AGAS __attribute__((address_space(1)))
constexpr int SEQ = 8192;
constexpr float LOG2E = 1.4426950408889634f, EPS = 1e-6f;
constexpr int KCS = 1040, VHS = 4160;
constexpr int KSLOT = 12 * KCS, VSLOT = 2 * VHS;
constexpr int L_K = 0, L_V = 3 * KSLOT, L_POS = L_V + 4 * VSLOT, L_TB = L_POS + 1024, L_WSF = L_TB + 128, L_OST = L_WSF + 8 * 256, L_FLAG = L_OST + 8 * 4096, L_END = L_FLAG + 16 + 64;
static_assert(L_OST % 16 == 0 && L_V % 16 == 0 && L_END <= 131072, "attention LDS map");

__device__ __forceinline__ int crow(int r, int hi) { return (r & 3) + 8 * (r >> 2) + 4 * hi; }
__device__ __forceinline__ unsigned cvtpk(float lo, float hi) { f32x2 v = {lo, hi}; bf16x2_t b = __builtin_convertvector(v, bf16x2_t); return __builtin_bit_cast(unsigned, b); }
__device__ __forceinline__ s16x4 vtr(const ALAS unsigned char* p) { return __builtin_bit_cast(s16x4, __builtin_amdgcn_ds_read_tr16_b64_v4i16((ALAS v4i16_t*)p)); }
__device__ __forceinline__ float swap_sum(float x) { auto rr = __builtin_amdgcn_permlane32_swap(__float_as_uint(x), __float_as_uint(x), false, false); return __uint_as_float(rr[0]) + __uint_as_float(rr[1]); }
__device__ __forceinline__ float swap_max(float x) { auto rr = __builtin_amdgcn_permlane32_swap(__float_as_uint(x), __float_as_uint(x), false, false); return fmaxf(__uint_as_float(rr[0]), __uint_as_float(rr[1])); }
__device__ __forceinline__ float bf2f(unsigned short h) { return __uint_as_float((unsigned)h << 16); }

__device__ __forceinline__ void glds16(const AGAS void* gsrc, unsigned lds_dst) { unsigned keep;
    asm volatile("s_mov_b32 %0, m0\n\ts_mov_b32 m0, %2\n\ts_nop 0\n\tglobal_load_lds_dwordx4 %1, off\n\ts_mov_b32 m0, %0" : "=&s"(keep) : "v"(gsrc), "s"(lds_dst) : "memory"); }
__device__ __forceinline__ void glds4(const AGAS void* gsrc, unsigned lds_dst) { unsigned keep;
    asm volatile("s_mov_b32 %0, m0\n\ts_mov_b32 m0, %2\n\ts_nop 0\n\tglobal_load_lds_dword %1, off\n\ts_mov_b32 m0, %0" : "=&s"(keep) : "v"(gsrc), "s"(lds_dst) : "memory"); }

struct AttnP {
    AGAS unsigned char* ws;
    const AGAS float* gq;
    const AGAS int* pos; const AGAS float* sinks; const AGAS float* relb;
};
template <int MODE> struct AttnCfg;
template <> struct AttnCfg<0> { static constexpr size_t Q = WS_QRAW, K = WS_KA, V = WS_VA; static constexpr int qpitch = 576, kpitch = 576, khs = 96, vpitch = 384, vhs = 64, ocol0 = 0, hidx0 = 0, group = 1; };
template <> struct AttnCfg<1> { static constexpr size_t Q = WS_QS, K = WS_KS, V = WS_VS; static constexpr int qpitch = 384, kpitch = 128, khs = 64, vpitch = 128, vhs = 64, ocol0 = 384, hidx0 = 6, group = 3; };
template <> struct AttnCfg<2> { static constexpr size_t Q = WS_QC, K = WS_KC, V = WS_VC; static constexpr int qpitch = 256, kpitch = 256, khs = 64, vpitch = 256, vhs = 64, ocol0 = 768, hidx0 = 12, group = 1; };

#ifdef ATT_PROF
#define PROF_T() ((MODE == 0 && blockIdx.x == 0) ? (long long)clock64() : 0ll)
#else
#define PROF_T() 0ll
#endif
template <int DQK, int MODE>
__device__ __forceinline__ void attn_unit(ALAS unsigned char* lds, const AttnP& P, int b, int h, int qb, int wave0, unsigned long long* prof = nullptr) {
    long long pf_qk = 0, pf_sm = 0, pf_pv = 0, pf_wait = 0; const long long pf_t0 = PROF_T();
    constexpr int NCH = DQK / 8, ND0 = DQK / 16;
    int tid_ = wave0 * 64 + hw_lane(); asm volatile("" : "+v"(tid_));
    const int tid = tid_, lane = tid & 63, r32 = lane & 31, hi = lane >> 5;
    const int wid = __builtin_amdgcn_readfirstlane(tid >> 6);
    const int q0 = qb * 256, qlo = q0 + 32 * wid, qhi = qlo + 31, qrow = qlo + r32;
    const size_t rb = (size_t)b * SEQ;
    typedef AttnCfg<MODE> C; const int kvh = h / C::group;
    ALAS float* wsf = (ALAS float*)(lds + L_WSF) + wid * 64;
    ALAS unsigned char* ost = lds + L_OST + wid * 4096;
    ALAS int* posl = (ALAS int*)(lds + L_POS);
    ALAS float* tb = (ALAS float*)(lds + L_TB);

    bf16x8 qf[ND0];
    if constexpr (MODE == 0) {
        const AGAS bf16_t* qp = (const AGAS bf16_t*)(P.ws + C::Q) + (rb + qrow) * 576 + h * 96 + hi * 8;
        float qv[ND0][8]; float ss = 0.f;
#pragma unroll
        for (int d0 = 0; d0 < ND0; ++d0) { const u32x4 w = *(const AGAS u32x4*)(qp + 16 * d0);
#pragma unroll
            for (int i = 0; i < 4; ++i) { const float lo = __uint_as_float(w[i] << 16), hv = __uint_as_float(w[i] & 0xffff0000u); qv[d0][2 * i] = lo; qv[d0][2 * i + 1] = hv; ss += lo * lo + hv * hv; } }
        ss = swap_sum(ss);
        const float rq = 1.0f / sqrtf(ss * (1.0f / 96.0f) + EPS);
#pragma unroll
        for (int d0 = 0; d0 < ND0; ++d0) { const f32x4 ga = *(const AGAS f32x4*)(P.gq + 16 * d0 + 8 * hi), gb = *(const AGAS f32x4*)(P.gq + 16 * d0 + 8 * hi + 4);
#pragma unroll
            for (int i = 0; i < 4; ++i) { qv[d0][i] *= rq * ga[i]; qv[d0][4 + i] *= rq * gb[i]; } }
        {
            const AGAS float* cp = (const AGAS float*)(P.ws + WS_CS) + (rb + qrow) * 32 + 8 * hi;
            const f32x4 c0 = *(const AGAS f32x4*)cp, c1 = *(const AGAS f32x4*)(cp + 4), s0 = *(const AGAS f32x4*)(cp + 16), s1 = *(const AGAS f32x4*)(cp + 20);
#pragma unroll
            for (int i = 0; i < 8; ++i) { const float c = i < 4 ? c0[i & 3] : c1[i & 3], s = i < 4 ? s0[i & 3] : s1[i & 3]; const float x1 = qv[4][i], x2 = qv[5][i]; qv[4][i] = x1 * c - x2 * s; qv[5][i] = x2 * c + x1 * s; }
        }
        const float sc = 0.10206207261596575f * LOG2E;
#pragma unroll
        for (int d0 = 0; d0 < ND0; ++d0) { u32x4 w; w.x = cvtpk(qv[d0][0] * sc, qv[d0][1] * sc); w.y = cvtpk(qv[d0][2] * sc, qv[d0][3] * sc); w.z = cvtpk(qv[d0][4] * sc, qv[d0][5] * sc); w.w = cvtpk(qv[d0][6] * sc, qv[d0][7] * sc); qf[d0] = __builtin_bit_cast(bf16x8, w); }
    } else {
        const AGAS bf16_t* qp = (const AGAS bf16_t*)(P.ws + C::Q) + (rb + qrow) * C::qpitch + h * 64 + hi * 8;
#pragma unroll
        for (int d0 = 0; d0 < ND0; ++d0) qf[d0] = *(const AGAS bf16x8*)(qp + 16 * d0);
    }
    int posq = 0; float sink2 = 0.f;
    if constexpr (MODE == 1) {
        posq = P.pos[rb + qrow]; sink2 = P.sinks[h] * LOG2E;
        if (tid < 32) tb[tid] = P.relb[tid * 6 + h] * LOG2E;
    }

    int ntile, tfirst, tstep;
    if (MODE == 0) { tfirst = 0; tstep = 1; ntile = ((q0 + 255) >> 6) + 1; }
    else if (MODE == 1) { const int lo = q0 - 127 > 0 ? q0 - 127 : 0; tfirst = lo >> 6; tstep = 1; ntile = ((q0 + 255) >> 6) - tfirst + 1; }
    else { tfirst = (q0 + 254) >> 6; tstep = -1; ntile = tfirst + 1; }

    const AGAS bf16_t* Kg = (const AGAS bf16_t*)(P.ws + C::K) + rb * C::kpitch + kvh * C::khs;
    const AGAS bf16_t* Vg = (const AGAS bf16_t*)(P.ws + C::V) + rb * C::vpitch + kvh * C::vhs;
    const unsigned lds0 = (unsigned)(uintptr_t)lds;
    const AGAS bf16_t* ksrc0 = (MODE == 0) ? (const AGAS bf16_t*)(P.ws + C::K) + ((size_t)b * 128 * 6 + h) * 6144 + wid * 512 + lane * 8 : Kg + (size_t)lane * C::kpitch + 8 * wid;
    const AGAS bf16_t* vsrc = (MODE == 0) ? (const AGAS bf16_t*)(P.ws + C::V) + ((size_t)b * 128 * 6 + h) * 4096 + (wid >> 2) * 2048 + (wid & 3) * 512 + lane * 8
                                          : Vg + (size_t)(16 * (wid & 3) + (lane >> 2)) * C::vpitch + 32 * (wid >> 2) + 8 * (lane & 3);
    constexpr size_t KTS = (MODE == 0) ? (size_t)6 * 6144 : (size_t)64 * C::kpitch, VTS = (MODE == 0) ? (size_t)6 * 4096 : (size_t)64 * C::vpitch, K2O = (MODE == 0) ? 8 * 512 : 64;
    const bool k2 = (wid + 8) < NCH;
    const bool posw = (MODE == 1) && wid == 0;
    const int NP = 2 + (k2 ? 1 : 0) + (posw ? 1 : 0);
#define ATT_ISSUE(T, IT) do { const int T_ = (T); const size_t jo_ = (size_t)T_ * 64; const int ks_ = (IT) % 3, vs_ = (IT) & 3;     \
        glds16(ksrc0 + (size_t)T_ * KTS, (unsigned)__builtin_amdgcn_readfirstlane(lds0 + L_K + ks_ * KSLOT + wid * KCS)); \
        if (k2) glds16(ksrc0 + (size_t)T_ * KTS + K2O, (unsigned)__builtin_amdgcn_readfirstlane(lds0 + L_K + ks_ * KSLOT + (wid + 8) * KCS)); \
        glds16(vsrc + (size_t)T_ * VTS, (unsigned)__builtin_amdgcn_readfirstlane(lds0 + L_V + vs_ * VSLOT + (wid >> 2) * VHS + (wid & 3) * 1024)); \
        if (posw) glds4(P.pos + rb + jo_ + lane, (unsigned)__builtin_amdgcn_readfirstlane(lds0 + L_POS + vs_ * 256)); } while (0)
#define ATT_WAIT_BAR(n_) do { if ((n_) <= 0) asm volatile("s_waitcnt vmcnt(0) lgkmcnt(0)\n\ts_barrier" ::: "memory"); \
        else if (NP == 2) asm volatile("s_waitcnt vmcnt(2) lgkmcnt(0)\n\ts_barrier" ::: "memory"); \
        else if (NP == 3) asm volatile("s_waitcnt vmcnt(3) lgkmcnt(0)\n\ts_barrier" ::: "memory"); \
        else asm volatile("s_waitcnt vmcnt(4) lgkmcnt(0)\n\ts_barrier" ::: "memory"); } while (0)

    f32x16 o0 = {}, o1 = {};
    float mrun = (MODE == 1) ? sink2 : 0.f;
    float lrun = (MODE == 1 && hi == 0) ? 1.0f : 0.f;
    f32x16 negm;
#pragma unroll
    for (int r = 0; r < 16; ++r) negm[r] = (MODE == 2) ? 0.f : -mrun;
    bool first = (MODE == 0);
    float after = 0.f;
    bool walive = true;
    const int vrd = ((lane >> 4) & 1) * 32 + (lane & 3) * 8 + (4 * hi + ((lane & 15) >> 2)) * 64;
    const bool lag = wid >= 4;
    constexpr float THR = 4.0f;

#define ATT_QK(P0, P1, kb) do { int kofs_ = L_K + (kb) * KSLOT + hi * KCS + r32 * 16; asm volatile("" : "+v"(kofs_)); const ALAS unsigned char* Kb_ = lds + kofs_;     \
        bf16x8 kfa_[4], kfb_[4]; \
        _Pragma("unroll") for (int d0 = 0; d0 < 3; ++d0) { kfa_[d0] = *(const ALAS bf16x8*)(Kb_ + 2 * d0 * KCS); kfb_[d0] = *(const ALAS bf16x8*)(Kb_ + 2 * d0 * KCS + 512); } \
        \
        _Pragma("unroll") for (int d0 = 0; d0 < ND0; ++d0) { \
            if (d0 + 3 < ND0) { kfa_[(d0 + 3) & 3] = *(const ALAS bf16x8*)(Kb_ + 2 * (d0 + 3) * KCS); kfb_[(d0 + 3) & 3] = *(const ALAS bf16x8*)(Kb_ + 2 * (d0 + 3) * KCS + 512); } \
            if (d0 == 0) { P0 = __builtin_amdgcn_mfma_f32_32x32x16_bf16(kfa_[0], qf[0], negm, 0, 0, 0); P1 = __builtin_amdgcn_mfma_f32_32x32x16_bf16(kfb_[0], qf[0], negm, 0, 0, 0); } \
            else { P0 = __builtin_amdgcn_mfma_f32_32x32x16_bf16(kfa_[d0 & 3], qf[d0], P0, 0, 0, 0); P1 = __builtin_amdgcn_mfma_f32_32x32x16_bf16(kfb_[d0 & 3], qf[d0], P1, 0, 0, 0); } \
            } } while (0)
#define ATT_VLD(i_, s_) do { vl0_[i_] = vtr(Vb_ + (s_) * 1024); vh0_[i_] = vtr(Vb_ + (s_) * 1024 + 512); vl1_[i_] = vtr(Vb_ + VHS + (s_) * 1024); vh1_[i_] = vtr(Vb_ + VHS + (s_) * 1024 + 512); } while (0)
#define ATT_PV(vb) do { int vofs_ = L_V + (vb) * VSLOT + vrd; asm volatile("" : "+v"(vofs_)); const ALAS unsigned char* Vb_ = lds + vofs_; \
        s16x4 vl0_[2], vh0_[2], vl1_[2], vh1_[2]; ATT_VLD(0, 0); \
        _Pragma("unroll") for (int s_ = 0; s_ < 4; ++s_) { \
            if (s_ + 1 < 4) ATT_VLD((s_ + 1) & 1, s_ + 1); \
            const int i_ = s_ & 1; const bf16x8 pa_ = __builtin_bit_cast(bf16x8, pw[s_]); \
            const bf16x8 v0_ = {vl0_[i_][0], vl0_[i_][1], vl0_[i_][2], vl0_[i_][3], vh0_[i_][0], vh0_[i_][1], vh0_[i_][2], vh0_[i_][3]}, v1_ = {vl1_[i_][0], vl1_[i_][1], vl1_[i_][2], vl1_[i_][3], vh1_[i_][0], vh1_[i_][1], vh1_[i_][2], vh1_[i_][3]}; \
            o0 = __builtin_amdgcn_mfma_f32_32x32x16_bf16(pa_, v0_, o0, 0, 0, 0); o1 = __builtin_amdgcn_mfma_f32_32x32x16_bf16(pa_, v1_, o1, 0, 0, 0); } } while (0)
#define ATT_PACK(P0, P1) do { \
        pw[0].x = cvtpk(P0[0], P0[1]); pw[0].y = cvtpk(P0[2], P0[3]); pw[0].z = cvtpk(P0[4], P0[5]); pw[0].w = cvtpk(P0[6], P0[7]); \
        pw[1].x = cvtpk(P0[8], P0[9]); pw[1].y = cvtpk(P0[10], P0[11]); pw[1].z = cvtpk(P0[12], P0[13]); pw[1].w = cvtpk(P0[14], P0[15]); \
        pw[2].x = cvtpk(P1[0], P1[1]); pw[2].y = cvtpk(P1[2], P1[3]); pw[2].z = cvtpk(P1[4], P1[5]); pw[2].w = cvtpk(P1[6], P1[7]); \
        pw[3].x = cvtpk(P1[8], P1[9]); pw[3].y = cvtpk(P1[10], P1[11]); pw[3].z = cvtpk(P1[12], P1[13]); pw[3].w = cvtpk(P1[14], P1[15]); } while (0)
#define ATT_MAX3(a, b, c) fmaxf(fmaxf((a), (b)), (c))
#define ATT_SM_A(P0, P1, j0_, pslot) do { if constexpr (MODE != 2) { \
            if constexpr (MODE == 1) { \
                _Pragma("unroll") for (int g = 0; g < 4; ++g) { \
                    const i32x4 pa = *(const ALAS i32x4*)(posl + (pslot) * 64 + 8 * g + 4 * hi), pb = *(const ALAS i32x4*)(posl + (pslot) * 64 + 32 + 8 * g + 4 * hi); \
                    _Pragma("unroll") for (int i = 0; i < 4; ++i) { \
                        { int n = posq - pa[i]; n = n > 0 ? n : 0; int bk = n; if (n >= 16) { bk = 16 + (int)((__builtin_amdgcn_logf((float)n) - 4.0f) * (16.0f / 3.0f)); bk = bk < 31 ? bk : 31; } P0[4 * g + i] += tb[bk]; } \
                        { int n = posq - pb[i]; n = n > 0 ? n : 0; int bk = n; if (n >= 16) { bk = 16 + (int)((__builtin_amdgcn_logf((float)n) - 4.0f) * (16.0f / 3.0f)); bk = bk < 31 ? bk : 31; } P1[4 * g + i] += tb[bk]; } } } } \
            const bool nm_ = (MODE == 1) || ((j0_) + 63 > qlo); \
            if (nm_) { \
                _Pragma("unroll") for (int r = 0; r < 16; ++r) { const int key = (j0_) + crow(r, hi); \
                    bool ok0 = key <= qrow, ok1 = key + 32 <= qrow; \
                    if (MODE == 1) { ok0 = ok0 && (key > qrow - 128); ok1 = ok1 && (key + 32 > qrow - 128); } \
                    if (!ok0) P0[r] = -INFINITY; if (!ok1) P1[r] = -INFINITY; } } \
            float ma = ATT_MAX3(P0[0], P0[1], P1[0]), mb = ATT_MAX3(P0[2], P0[3], P1[1]); ma = ATT_MAX3(ma, P1[2], P1[3]); \
            _Pragma("unroll") for (int r = 4; r < 16; r += 4) { ma = ATT_MAX3(ma, P0[r], P0[r + 1]); mb = ATT_MAX3(mb, P0[r + 2], P0[r + 3]); ma = ATT_MAX3(ma, P1[r], P1[r + 1]); mb = ATT_MAX3(mb, P1[r + 2], P1[r + 3]); } \
            const float mt = swap_max(fmaxf(ma, mb)); \
            if (first || __any(mt > THR)) {                                 \
                const float d = first ? mt : fmaxf(mt, 0.f); first = false; \
                _Pragma("unroll") for (int r = 0; r < 16; ++r) { P0[r] -= d; P1[r] -= d; } \
                const float alpha = __builtin_amdgcn_exp2f(-d); mrun += d; lrun *= alpha; \
                _Pragma("unroll") for (int r = 0; r < 16; ++r) negm[r] = -mrun; \
                if (hi == 0) wsf[r32] = alpha; \
                _Pragma("unroll") for (int g = 0; g < 4; ++g) { const f32x4 al = *(const ALAS f32x4*)(wsf + 8 * g + 4 * hi); \
                    _Pragma("unroll") for (int i = 0; i < 4; ++i) { o0[4 * g + i] *= al[i]; o1[4 * g + i] *= al[i]; } } } } } while (0)
#define ATT_SM_B(P0, P1, j0_) do { \
        if constexpr (MODE == 2) { \
            const bool nm_ = (j0_) + 63 >= qlo; \
            float ln0[16], ln1[16]; \
            _Pragma("unroll") for (int r = 0; r < 16; ++r) { const int key = (j0_) + crow(r, hi); \
                { const float z = P0[r]; const float sp = fmaxf(z, 0.f) + __builtin_amdgcn_logf(1.0f + __builtin_amdgcn_exp2f(-fabsf(z))); const bool ok = !nm_ || key < qrow; ln0[r] = ok ? -sp : 0.f; P0[r] = ok ? z - sp : -INFINITY; } \
                { const float z = P1[r]; const float sp = fmaxf(z, 0.f) + __builtin_amdgcn_logf(1.0f + __builtin_amdgcn_exp2f(-fabsf(z))); const bool ok = !nm_ || key + 32 < qrow; ln1[r] = ok ? -sp : 0.f; P1[r] = ok ? z - sp : -INFINITY; } } \
            float run = after; \
            _Pragma("unroll") for (int blk = 1; blk >= 0; --blk) _Pragma("unroll") for (int g = 3; g >= 0; --g) { \
                const float own = blk ? ((ln1[4 * g] + ln1[4 * g + 1]) + (ln1[4 * g + 2] + ln1[4 * g + 3])) : ((ln0[4 * g] + ln0[4 * g + 1]) + (ln0[4 * g + 2] + ln0[4 * g + 3])); \
                auto rr = __builtin_amdgcn_permlane32_swap(__float_as_uint(own), __float_as_uint(own), false, false); \
                const float slo = __uint_as_float(rr[0]), shi = __uint_as_float(rr[1]); \
                const float e1 = run; run += shi; const float e0 = run; run += slo; \
                float aft = hi ? e1 : e0; \
                _Pragma("unroll") for (int i = 3; i >= 0; --i) { const int r = 4 * g + i; \
                    if (blk) { P1[r] = __builtin_amdgcn_exp2f(P1[r] + aft); aft += ln1[r]; } else { P0[r] = __builtin_amdgcn_exp2f(P0[r] + aft); aft += ln0[r]; } } } \
            after = run; walive = __any(after > -160.0f); \
        } else { \
            float ls = 0.f; \
            _Pragma("unroll") for (int r = 0; r < 16; ++r) { P0[r] = __builtin_amdgcn_exp2f(P0[r]); P1[r] = __builtin_amdgcn_exp2f(P1[r]); ls += P0[r] + P1[r]; } \
            lrun += ls; } \
        ATT_PACK(P0, P1); } while (0)
#define ATT_WORK(j0_) ((MODE == 0) ? ((j0_) <= qhi) : (MODE == 1) ? (((j0_) <= qhi) && ((j0_) + 63 >= qlo - 127)) : (walive && ((j0_) < qhi)))

    if constexpr (MODE == 0) {
    f32x16 p0, p1, n0, n1; u32x4 pw[4];
    __syncthreads();
    int issued = 0;
    ATT_ISSUE(0, 0);
    if (ntile > 1) { ATT_ISSUE(1, 1); issued = 1; }
    if (ntile > 2) { ATT_ISSUE(2, 2); issued = 2; }
    ATT_WAIT_BAR(issued - 1);
    const int tmax = qhi >> 6;
#define MLA_SB() __builtin_amdgcn_sched_barrier(0)
#define MLA_EX(v) __builtin_amdgcn_exp2f(v)
#define MLA_DECIDE(X0, X1, j0_) do { \
        if ((j0_) + 63 > qlo) { _Pragma("unroll") for (int r = 0; r < 16; ++r) { const int key = (j0_) + crow(r, hi); if (key > qrow) X0[r] = -INFINITY; if (key + 32 > qrow) X1[r] = -INFINITY; } } \
        float ma = ATT_MAX3(X0[0], X0[1], X1[0]), mb = ATT_MAX3(X0[2], X0[3], X1[1]); ma = ATT_MAX3(ma, X1[2], X1[3]); \
        _Pragma("unroll") for (int r = 4; r < 16; r += 4) { ma = ATT_MAX3(ma, X0[r], X0[r + 1]); mb = ATT_MAX3(mb, X0[r + 2], X0[r + 3]); ma = ATT_MAX3(ma, X1[r], X1[r + 1]); mb = ATT_MAX3(mb, X1[r + 2], X1[r + 3]); } \
        const float mt = swap_max(fmaxf(ma, mb)); resc = false; \
        if (first || __any(mt > THR)) { const float d = first ? mt : fmaxf(mt, 0.f); first = false; \
            _Pragma("unroll") for (int r = 0; r < 16; ++r) { X0[r] -= d; X1[r] -= d; } \
            const float alpha = __builtin_amdgcn_exp2f(-d); lrun *= alpha; const float nm_ = negm[0] - d;     \
            _Pragma("unroll") for (int r = 0; r < 16; ++r) negm[r] = nm_; \
            if (hi == 0) wsf[r32] = alpha; resc = true; } } while (0)
#define MLA_RESC() do { if (resc) { _Pragma("unroll") for (int g = 0; g < 4; ++g) { const f32x4 al = *(const ALAS f32x4*)(wsf + 8 * g + 4 * hi); \
            _Pragma("unroll") for (int i = 0; i < 4; ++i) { o0[4 * g + i] *= al[i]; o1[4 * g + i] *= al[i]; } } } } while (0)
#define MLA_PV_(i) (i < 16 ? C0[(i) & 15] : C1[(i) & 15])
#define MLA_GA(MF, g, C0, C1) do { MF; \
        if (3 * (g) < 32) sacc += (3 * (g) < 16 ? C0[(3 * (g)) & 15] : C1[(3 * (g)) & 15]); \
        if (3 * (g) + 1 < 32) sacc += (3 * (g) + 1 < 16 ? C0[(3 * (g) + 1) & 15] : C1[(3 * (g) + 1) & 15]); \
        if (3 * (g) + 2 < 32) sacc += (3 * (g) + 2 < 16 ? C0[(3 * (g) + 2) & 15] : C1[(3 * (g) + 2) & 15]); \
        if ((g) < 4) { pw[((g) >> 1) & 3][2 * ((g) & 1)] = cvtpk(C0[4 * (g)], C0[4 * (g) + 1]); pw[((g) >> 1) & 3][2 * ((g) & 1) + 1] = cvtpk(C0[4 * (g) + 2], C0[4 * (g) + 3]); } \
        else if ((g) < 8) { pw[((g) >> 1) & 3][2 * ((g) & 1)] = cvtpk(C1[4 * ((g) - 4)], C1[4 * ((g) - 4) + 1]); pw[((g) >> 1) & 3][2 * ((g) & 1) + 1] = cvtpk(C1[4 * ((g) - 4) + 2], C1[4 * ((g) - 4) + 3]); } } while (0)
#define MLA_VF(lo_, hi_) (bf16x8){lo_[0], lo_[1], lo_[2], lo_[3], hi_[0], hi_[1], hi_[2], hi_[3]}
#define MLA_GB(MF, X, b_) do { MF; X[(b_)] = MLA_EX(X[(b_)]); X[(b_) + 1] = MLA_EX(X[(b_) + 1]); X[(b_) + 2] = MLA_EX(X[(b_) + 2]); X[(b_) + 3] = MLA_EX(X[(b_) + 3]); } while (0)
#define MLA_FULL(C0, C1, N0, N1, t_) do { \
        int kofs_ = L_K + (((t_) + 1) % 3) * KSLOT + hi * KCS + r32 * 16; asm volatile("" : "+v"(kofs_)); const ALAS unsigned char* Kb_ = lds + kofs_; \
        int vofs_ = L_V + ((t_) & 3) * VSLOT + vrd; asm volatile("" : "+v"(vofs_)); const ALAS unsigned char* Vb_ = lds + vofs_; \
        bf16x8 ka0 = *(const ALAS bf16x8*)(Kb_), kb0 = *(const ALAS bf16x8*)(Kb_ + 512), ka1 = *(const ALAS bf16x8*)(Kb_ + 2 * KCS), kb1 = *(const ALAS bf16x8*)(Kb_ + 2 * KCS + 512), ka2, kb2; \
        s16x4 vl0a, vh0a, vl1a, vh1a, vl0b, vh0b, vl1b, vh1b; float sacc = 0.f; \
        MLA_SB(); \
        MLA_GA(N0 = __builtin_amdgcn_mfma_f32_32x32x16_bf16(ka0, qf[0], negm, 0, 0, 0), 0, C0, C1); ka2 = *(const ALAS bf16x8*)(Kb_ + 4 * KCS); MLA_SB(); \
        MLA_GA(N1 = __builtin_amdgcn_mfma_f32_32x32x16_bf16(kb0, qf[0], negm, 0, 0, 0), 1, C0, C1); kb2 = *(const ALAS bf16x8*)(Kb_ + 4 * KCS + 512); MLA_SB(); \
        MLA_GA(N0 = __builtin_amdgcn_mfma_f32_32x32x16_bf16(ka1, qf[1], N0, 0, 0, 0), 2, C0, C1); ka0 = *(const ALAS bf16x8*)(Kb_ + 6 * KCS); MLA_SB(); \
        MLA_GA(N1 = __builtin_amdgcn_mfma_f32_32x32x16_bf16(kb1, qf[1], N1, 0, 0, 0), 3, C0, C1); kb0 = *(const ALAS bf16x8*)(Kb_ + 6 * KCS + 512); MLA_SB(); \
        MLA_GA(N0 = __builtin_amdgcn_mfma_f32_32x32x16_bf16(ka2, qf[2], N0, 0, 0, 0), 4, C0, C1); ka1 = *(const ALAS bf16x8*)(Kb_ + 8 * KCS); MLA_SB(); \
        MLA_GA(N1 = __builtin_amdgcn_mfma_f32_32x32x16_bf16(kb2, qf[2], N1, 0, 0, 0), 5, C0, C1); kb1 = *(const ALAS bf16x8*)(Kb_ + 8 * KCS + 512); MLA_SB(); \
        MLA_GA(N0 = __builtin_amdgcn_mfma_f32_32x32x16_bf16(ka0, qf[3], N0, 0, 0, 0), 6, C0, C1); ka2 = *(const ALAS bf16x8*)(Kb_ + 10 * KCS); MLA_SB(); \
        MLA_GA(N1 = __builtin_amdgcn_mfma_f32_32x32x16_bf16(kb0, qf[3], N1, 0, 0, 0), 7, C0, C1); kb2 = *(const ALAS bf16x8*)(Kb_ + 10 * KCS + 512); MLA_SB(); \
        MLA_GA(N0 = __builtin_amdgcn_mfma_f32_32x32x16_bf16(ka1, qf[4], N0, 0, 0, 0), 8, C0, C1); MLA_SB(); \
        MLA_GA(N1 = __builtin_amdgcn_mfma_f32_32x32x16_bf16(kb1, qf[4], N1, 0, 0, 0), 9, C0, C1); MLA_SB(); \
        MLA_GA(N0 = __builtin_amdgcn_mfma_f32_32x32x16_bf16(ka2, qf[5], N0, 0, 0, 0), 10, C0, C1); vl0a = vtr(Vb_); vh0a = vtr(Vb_ + 512); MLA_SB(); \
        MLA_GA(N1 = __builtin_amdgcn_mfma_f32_32x32x16_bf16(kb2, qf[5], N1, 0, 0, 0), 11, C0, C1); vl1a = vtr(Vb_ + VHS); vh1a = vtr(Vb_ + VHS + 512); MLA_SB(); \
        lrun += sacc; \
        MLA_DECIDE(N0, N1, ((t_) + 1) * 64); \
        MLA_SB(); \
        MLA_GB(o0 = __builtin_amdgcn_mfma_f32_32x32x16_bf16(__builtin_bit_cast(bf16x8, pw[0]), MLA_VF(vl0a, vh0a), o0, 0, 0, 0), N0, 0); vl0b = vtr(Vb_ + 1024); vh0b = vtr(Vb_ + 1024 + 512); MLA_SB(); \
        MLA_GB(o1 = __builtin_amdgcn_mfma_f32_32x32x16_bf16(__builtin_bit_cast(bf16x8, pw[0]), MLA_VF(vl1a, vh1a), o1, 0, 0, 0), N0, 4); vl1b = vtr(Vb_ + VHS + 1024); vh1b = vtr(Vb_ + VHS + 1024 + 512); MLA_SB(); \
        MLA_GB(o0 = __builtin_amdgcn_mfma_f32_32x32x16_bf16(__builtin_bit_cast(bf16x8, pw[1]), MLA_VF(vl0b, vh0b), o0, 0, 0, 0), N0, 8); vl0a = vtr(Vb_ + 2048); vh0a = vtr(Vb_ + 2048 + 512); MLA_SB(); \
        MLA_GB(o1 = __builtin_amdgcn_mfma_f32_32x32x16_bf16(__builtin_bit_cast(bf16x8, pw[1]), MLA_VF(vl1b, vh1b), o1, 0, 0, 0), N0, 12); vl1a = vtr(Vb_ + VHS + 2048); vh1a = vtr(Vb_ + VHS + 2048 + 512); MLA_SB(); \
        MLA_GB(o0 = __builtin_amdgcn_mfma_f32_32x32x16_bf16(__builtin_bit_cast(bf16x8, pw[2]), MLA_VF(vl0a, vh0a), o0, 0, 0, 0), N1, 0); vl0b = vtr(Vb_ + 3072); vh0b = vtr(Vb_ + 3072 + 512); MLA_SB(); \
        MLA_GB(o1 = __builtin_amdgcn_mfma_f32_32x32x16_bf16(__builtin_bit_cast(bf16x8, pw[2]), MLA_VF(vl1a, vh1a), o1, 0, 0, 0), N1, 4); vl1b = vtr(Vb_ + VHS + 3072); vh1b = vtr(Vb_ + VHS + 3072 + 512); MLA_SB(); \
        MLA_GB(o0 = __builtin_amdgcn_mfma_f32_32x32x16_bf16(__builtin_bit_cast(bf16x8, pw[3]), MLA_VF(vl0b, vh0b), o0, 0, 0, 0), N1, 8); MLA_SB(); \
        MLA_GB(o1 = __builtin_amdgcn_mfma_f32_32x32x16_bf16(__builtin_bit_cast(bf16x8, pw[3]), MLA_VF(vl1b, vh1b), o1, 0, 0, 0), N1, 12); MLA_SB(); \
        MLA_RESC(); } while (0)
#define MLA_TAIL(C0, C1, t_) do { float ls = 0.f; _Pragma("unroll") for (int r = 0; r < 16; ++r) ls += C0[r] + C1[r]; lrun += ls; ATT_PACK(C0, C1); ATT_PV((t_) & 3); } while (0)
#define MLA_STEP(C0, C1, N0, N1, t_) do { \
          \
        int lane_ = lane; asm volatile("" : "+v"(lane_)); const int r32 = lane_ & 31, hi = lane_ >> 5, qrow = qlo + r32; \
        const int vrd = ((lane_ >> 4) & 1) * 32 + (lane_ & 3) * 8 + (4 * hi + ((lane_ & 15) >> 2)) * 64; ALAS float* wsf = (ALAS float*)(lds + L_WSF) + wid * 64; \
        if ((t_) + 3 < ntile) { ATT_ISSUE((t_) + 3, (t_) + 3); issued = (t_) + 3; } \
        if ((t_) < tmax) MLA_FULL(C0, C1, N0, N1, t_); else if ((t_) == tmax) MLA_TAIL(C0, C1, t_); \
        ATT_WAIT_BAR(issued - ((t_) + 2)); } while (0)
    if (wid >= 4) __builtin_amdgcn_s_setprio(1);
    bool resc = false;
    ATT_QK(p0, p1, 0);
    MLA_DECIDE(p0, p1, 0);
#pragma unroll
    for (int r = 0; r < 16; ++r) { p0[r] = MLA_EX(p0[r]); p1[r] = MLA_EX(p1[r]); }
    asm volatile("s_waitcnt lgkmcnt(0)\n\ts_barrier" ::: "memory");
    for (int it = 0; it < ntile; it += 2) {
        MLA_STEP(p0, p1, n0, n1, it);
        if (it + 1 >= ntile) break;
        MLA_STEP(n0, n1, p0, p1, it + 1);
    }
    __builtin_amdgcn_s_setprio(0);
#undef MLA_SB
#undef MLA_EX
#undef MLA_DECIDE
#undef MLA_RESC
#undef MLA_PV_
#undef MLA_GA
#undef MLA_VF
#undef MLA_GB
#undef MLA_FULL
#undef MLA_TAIL
#undef MLA_STEP
    } else {
    f32x16 p0, p1, n0, n1; u32x4 pw[4];
    __syncthreads();
    int issued = 0;
    ATT_ISSUE(tfirst, 0);
    if (ntile > 1) { ATT_ISSUE(tfirst + tstep, 1); issued = 1; }
    if (ntile > 2) { ATT_ISSUE(tfirst + 2 * tstep, 2); issued = 2; }
    ATT_WAIT_BAR(issued - 1);
    bool wcur = ATT_WORK(tfirst * 64);
    if (wcur) ATT_QK(p0, p1, 0);
    asm volatile("s_waitcnt lgkmcnt(0)\n\ts_barrier" ::: "memory");
    int nt = ntile;
    for (int it = 0; it < nt; ++it) {
        const int t = tfirst + it * tstep, j0 = t * 64, jn = (t + tstep) * 64;
        if (it + 3 < ntile) { ATT_ISSUE(t + 3 * tstep, it + 3); issued = it + 3; }
        if (wcur) ATT_SM_A(p0, p1, j0, it & 3);
        const bool wnext = (it + 1 < nt) && ATT_WORK(jn);
        if (wcur && wnext) { ATT_QK(n0, n1, (it + 1) % 3); ATT_SM_B(p0, p1, j0); }
        else { if (wnext) ATT_QK(n0, n1, (it + 1) % 3); if (wcur) ATT_SM_B(p0, p1, j0); }
        if (wcur) ATT_PV(it & 3);
        p0 = n0; p1 = n1; wcur = wnext;
        if (MODE == 2) { ALAS int* fl = (ALAS int*)(lds + L_FLAG + 16) + (it & 1) * 8; if (lane == 0) fl[wid] = (walive && j0 > 0) ? 1 : 0; }
        ATT_WAIT_BAR(issued - (it + 2));
        if (MODE == 2) { const ALAS int* fl = (const ALAS int*)(lds + L_FLAG + 16) + (it & 1) * 8;
            const i32x4 fa = *(const ALAS i32x4*)fl, fb = *(const ALAS i32x4*)(fl + 4);
            if (((fa[0] | fa[1]) | (fa[2] | fa[3]) | (fb[0] | fb[1]) | (fb[2] | fb[3])) == 0) nt = it + 1; }
    }
    }
    if (MODE == 2) asm volatile("s_waitcnt vmcnt(0)" ::: "memory");
#undef ATT_ISSUE
#undef ATT_WAIT_BAR
#undef ATT_QK
#undef ATT_PV
#undef ATT_PACK
#undef ATT_VLD
#undef ATT_SM_A
#undef ATT_SM_B
#undef ATT_WORK
#undef ATT_MAX3
    if (MODE != 2) {
        const float lt = swap_sum(lrun);
        if (hi == 0) wsf[32 + r32] = 1.0f / lt;
#pragma unroll
        for (int g = 0; g < 4; ++g) { const f32x4 il = *(const ALAS f32x4*)(wsf + 32 + 8 * g + 4 * hi);
#pragma unroll
            for (int i = 0; i < 4; ++i) { o0[4 * g + i] *= il[i]; o1[4 * g + i] *= il[i]; } }
    }
    {
        ALAS bf16_t* stg = (ALAS bf16_t*)ost;
#pragma unroll
        for (int r = 0; r < 16; ++r) { const int orow = crow(r, hi); stg[orow * 64 + r32] = (bf16_t)(cvtpk(o0[r], 0.f) & 0xffffu); stg[orow * 64 + 32 + r32] = (bf16_t)(cvtpk(o1[r], 0.f) & 0xffffu); }
        AGAS bf16_t* Ow = (AGAS bf16_t*)(P.ws + WS_OALL) + (rb + qlo) * 1024 + C::ocol0 + h * 64;
#pragma unroll
        for (int i = 0; i < 4; ++i) {
            const int row = i * 8 + (lane >> 3), ch = lane & 7;
            const u32x4 v = *(const ALAS u32x4*)(stg + row * 64 + ch * 8);
            float ss = 0.f;
#pragma unroll
            for (int k = 0; k < 4; ++k) { const unsigned w = v[k]; const float a = __uint_as_float(w << 16), c = __uint_as_float(w & 0xffff0000u); ss += a * a + c * c; }
            ss += __shfl_xor(ss, 1); ss += __shfl_xor(ss, 2); ss += __shfl_xor(ss, 4);
            *(AGAS u32x4*)(Ow + (size_t)row * 1024 + ch * 8) = v;
            if (ch == 0) ((AGAS float*)(P.ws + WS_SSQO))[(rb + qlo + row) * 16 + C::hidx0 + h] = ss;
        }
    }
#ifdef ATT_PROF
    if (MODE == 0 && blockIdx.x == 0 && wid == ATT_PROF_WAVE && lane == 0 && prof) { const long long tt = PROF_T() - pf_t0;
        atomicAdd(prof + 0, (unsigned long long)tt); atomicAdd(prof + 1, (unsigned long long)pf_qk); atomicAdd(prof + 2, (unsigned long long)pf_sm); atomicAdd(prof + 3, (unsigned long long)pf_pv); atomicAdd(prof + 4, (unsigned long long)pf_wait); atomicAdd(prof + 5, 1ull); }
#endif
}
#undef ALAS
#undef AGAS
}
struct Args { const void* in[23]; float* out; unsigned char* ws; int ph_lo, ph_hi, li, adapt; };

struct Frame { LAS unsigned char* lds; int tid, lane, wave, vcu, G; };

__device__ __forceinline__ float wave_sum64(float v) { return pg8::wave_sum_dpp(v); }

__device__ __forceinline__ void tr_item64(const GAS float* W, int ldn, int K, GAS pg8::bf16_t* WT, int kb, int g, int src0, int src1, const GAS float* kgain, LAS unsigned* scr, int lane) {
    const int k0 = 64 * kb; const int col = lane < 32 ? src0 + lane : src1 + (lane - 32); const bool ok = (lane < 32 ? src0 : src1) >= 0;
    const GAS float* wp = W + (size_t)k0 * ldn + (ok ? col : 0);
#pragma unroll
    for (int hf = 0; hf < 2; ++hf) {
        float v[32];
#pragma unroll
        for (int i = 0; i < 32; ++i) v[i] = wp[(size_t)(hf * 32 + i) * ldn];
#pragma unroll
        for (int i = 0; i < 32; ++i) v[i] = ok ? v[i] : 0.f;
        if (kgain) {
#pragma unroll
            for (int i = 0; i < 32; ++i) v[i] *= kgain[k0 + hf * 32 + i]; }
#pragma unroll
        for (int i = 0; i < 16; ++i) scr[(hf * 16 + i) * 65 + lane] = pk2(v[2 * i], v[2 * i + 1]);
    }
    asm volatile("s_waitcnt lgkmcnt(0)" ::: "memory");
    const int c = lane & 7;
#pragma unroll
    for (int j = 0; j < 8; ++j) { const int n = (lane >> 3) + 8 * j; const LAS unsigned* s = scr + (4 * c) * 65 + n;
        v4u o; o.x = s[0]; o.y = s[65]; o.z = s[130]; o.w = s[195];
        *(GAS v4u*)(WT + (size_t)(64 * g + n) * K + k0 + 8 * c) = o; }
    asm volatile("s_waitcnt lgkmcnt(0)" ::: "memory");
}
__device__ __forceinline__ int in_slot_src(int slot, int& cnt) {
    cnt = 64;
    if (slot < 4) return 64 * slot;
    if (slot < 6) return 256 + 64 * (slot - 4);
    if (slot == 6) { cnt = 32; return 384; }
    if (slot == 7) return -1;
    if (slot < 14) return 416 + 64 * (slot - 8);
    if (slot < 16) return 800 + 64 * (slot - 14);
    if (slot < 18) return 928 + 64 * (slot - 16);
    if (slot < 22) return 1056 + 64 * (slot - 18);
    if (slot < 26) return 1312 + 64 * (slot - 22);
    if (slot < 30) return 1568 + 64 * (slot - 26);
    return -1;
}

#define A_X ((const GAS float*)args.in[0])
#define A_C ((const GAS float*)args.in[1])
#define A_POS ((const GAS int*)args.in[2])
#define A_RELB ((const GAS float*)args.in[3])
#define A_NORMG ((const GAS float*)args.in[4])
#define A_WMOD ((const GAS float*)args.in[5])
#define A_BMOD ((const GAS float*)args.in[6])
#define A_WGU1 ((const GAS float*)args.in[7])
#define A_WD1 ((const GAS float*)args.in[8])
#define A_WIN ((const GAS float*)args.in[9])
#define A_QAN ((const GAS float*)args.in[10])
#define A_KVAN ((const GAS float*)args.in[11])
#define A_WUQ ((const GAS float*)args.in[12])
#define A_WUKV ((const GAS float*)args.in[13])
#define A_MLAQN ((const GAS float*)args.in[14])
#define A_MLAKN ((const GAS float*)args.in[15])
#define A_SWAQN ((const GAS float*)args.in[16])
#define A_SWAKN ((const GAS float*)args.in[17])
#define A_SINKS ((const GAS float*)args.in[18])
#define A_OUTN ((const GAS float*)args.in[19])
#define A_WOUT ((const GAS float*)args.in[20])
#define A_WGU2 ((const GAS float*)args.in[21])
#define A_WD2 ((const GAS float*)args.in[22])
#define WSP(off)   (ws_ + (off))
#define MOD ((GAS float*)WSP(WS_MOD))
#define GS ((GAS float*)WSP(WS_GS))
#define BIAS ((GAS float*)WSP(WS_BIAS))
#define SSQX ((GAS float*)WSP(WS_SSQX))
#define SSQO ((GAS float*)WSP(WS_SSQO))
#define CS ((GAS float*)WSP(WS_CS))
#define KPE ((GAS float*)WSP(WS_KPE))
#define SSQ_CQ ((GAS float*)WSP(WS_SSQC))
#define SSQ_CKV ((GAS float*)WSP(WS_SSQC) + (size_t)MROWS * 4)
#define SSQ_KPE ((GAS float*)WSP(WS_SSQC) + (size_t)MROWS * 6)
#define XB ((GAS pg8::bf16_t*)WSP(WS_XB))
#define HID ((GAS pg8::bf16_t*)WSP(WS_HID))
#define CQ ((GAS pg8::bf16_t*)WSP(WS_CQ))
#define CKV ((GAS pg8::bf16_t*)WSP(WS_CKV))
#define KA ((GAS pg8::bf16_t*)WSP(WS_KA))
#define VA ((GAS pg8::bf16_t*)WSP(WS_VA))
#define QS ((GAS pg8::bf16_t*)WSP(WS_QS))
#define KS ((GAS pg8::bf16_t*)WSP(WS_KS))
#define VS ((GAS pg8::bf16_t*)WSP(WS_VS))
#define QC ((GAS pg8::bf16_t*)WSP(WS_QC))
#define KC ((GAS pg8::bf16_t*)WSP(WS_KC))
#define VC ((GAS pg8::bf16_t*)WSP(WS_VC))
#define OALL ((GAS pg8::bf16_t*)WSP(WS_OALL))
#define QRAW ((GAS float*)WSP(WS_QRAW))

__device__ __forceinline__ int in_group_src(int g32) {
    const int tile = g32 >> 3, rr = g32 & 7, bj = rr >> 2, wc = rr & 3; int cnt; const int base = in_slot_src(tile * 4 + wc, cnt);
    return (base >= 0 && 32 * bj < cnt) ? base + 32 * bj : -1;
}
constexpr int CV_GU = 16 * 88, CV_D = 44 * 16, CV_IN = 16 * 32, CV_UQ = 4 * 12, CV_UKV = 2 * 12, CV_OUT = 16 * 16;
constexpr int CV_EARLY = CV_GU + CV_D + CV_IN + CV_UQ + CV_UKV + CV_OUT, CV_L = CV_EARLY + CV_GU + CV_D, CV_ALL = DEPTH * CV_L;
__device__ __forceinline__ void convert_chunk(Frame& F, const Args& args, int base, int limit) {
    GAS unsigned char* ws_ = (GAS unsigned char*)args.ws; asm volatile("" : "+s"(ws_));
    LAS unsigned* scr = (LAS unsigned*)(F.lds + 16384 + F.wave * 8448);
#pragma unroll 1
    for (int q = 0; q < 2; ++q) {
        const int it = base + F.wave * 2 + q; if (it >= limit) break;
        const int l = it / CV_L; int r = it % CV_L;
        GAS unsigned char* wl = ws_ + WS_W + (size_t)l * WL;
        int kind;
        if (r < CV_GU) kind = 0; else if ((r -= CV_GU) < CV_D) kind = 1; else if ((r -= CV_D) < CV_IN) kind = 2; else if ((r -= CV_IN) < CV_UQ) kind = 3;
        else if ((r -= CV_UQ) < CV_UKV) kind = 4; else if ((r -= CV_UKV) < CV_OUT) kind = 5; else if ((r -= CV_OUT) < CV_GU) kind = 6; else { r -= CV_GU; kind = 7; }
        if (kind == 0 || kind == 6) {
            const bool second = kind == 6; const int kb = r / 88, g = r % 88, t = g >> 2, rr = g & 3, src = (rr >> 1) * DFF + 128 * t + 64 * (rr & 1);
            const GAS float* W = (second ? A_WGU2 : A_WGU1) + (size_t)l * DM * 2 * DFF;
            tr_item64(W, 2 * DFF, DM, (GAS pg8::bf16_t*)(wl + (second ? W_GU2 : W_GU1)), kb, g, src, src + 32, nullptr, scr, F.lane);
        } else if (kind == 1 || kind == 7) { const bool second = kind == 7; const int kb = r / 16, g = r % 16;
            tr_item64((second ? A_WD2 : A_WD1) + (size_t)l * DFF * DM, DM, DFF, (GAS pg8::bf16_t*)(wl + (second ? W_D2 : W_D1)), kb, g, 64 * g, 64 * g + 32, nullptr, scr, F.lane);
        } else if (kind == 2) { const int kb = r / 32, g = r % 32;
            tr_item64(A_WIN + (size_t)l * DM * DIN, DIN, DM, (GAS pg8::bf16_t*)(wl + W_IN), kb, g, in_group_src(2 * g), in_group_src(2 * g + 1), nullptr, scr, F.lane);
        } else if (kind == 3) { const int kb = r / 12, g = r % 12;
            tr_item64(A_WUQ + (size_t)l * 256 * 576, 576, 256, (GAS pg8::bf16_t*)(wl + W_UQ), kb, g, g < 9 ? 64 * g : -1, g < 9 ? 64 * g + 32 : -1, A_QAN + l * 256, scr, F.lane);
        } else if (kind == 4) { const int kb = r / 12, g = r % 12, g0 = 2 * g, g1 = 2 * g + 1;
            tr_item64(A_WUKV + (size_t)l * 128 * 768, 768, 128, (GAS pg8::bf16_t*)(wl + W_UKV), kb, g, 256 * (g0 >> 3) + 64 * (g0 & 3) + 32 * ((g0 & 7) >> 2), 256 * (g1 >> 3) + 64 * (g1 & 3) + 32 * ((g1 & 7) >> 2), A_KVAN + l * 128, scr, F.lane);
        } else { const int kb = r / 16, g = r % 16;
            tr_item64(A_WOUT + (size_t)l * DM * DM, DM, DM, (GAS pg8::bf16_t*)(wl + W_OUT), kb, g, 64 * g, 64 * g + 32, A_OUTN + l * DM, scr, F.lane); }
    }
}

__device__ __forceinline__ void phase_pro0(Frame& F, const Args& args, gu32* qhead) {
    GAS unsigned char* ws_ = (GAS unsigned char*)args.ws; asm volatile("" : "+s"(ws_));
    constexpr int NMU = DEPTH * NMOD / 128;
    if ((int)blockIdx.x < NMU || F.G <= NMU) {
        LAS float* cond = (LAS float*)F.lds;
        LAS float* red = (LAS float*)(F.lds + 8192);
        for (int i = F.tid; i < 2 * DM; i += 512) { const float cv = A_C[i]; cond[i] = cv / (1.0f + expf(-cv)); }
        __syncthreads();
        for (int u = blockIdx.x; u < NMU; u += F.G) {
            const int l = u / (NMOD / 128), n0 = (u % (NMOD / 128)) * 128, c4 = F.lane & 31, kp = F.lane >> 5;
            const GAS float* w = A_WMOD + (size_t)l * DM * NMOD + n0 + 4 * c4;
            f32x4 a0 = {0.f, 0.f, 0.f, 0.f}, a1 = {0.f, 0.f, 0.f, 0.f};
#pragma unroll 8
            for (int i = 0; i < 64; ++i) { const int kk = F.wave * 128 + 2 * i + kp; const f32x4 wv = *(const GAS f32x4*)(w + (size_t)kk * NMOD); a0 += wv * cond[kk]; a1 += wv * cond[DM + kk]; }
#pragma unroll
            for (int q = 0; q < 4; ++q) { a0[q] = pg8::xsum32(a0[q]); a1[q] = pg8::xsum32(a1[q]); }
            if (kp == 0) { *(LAS f32x4*)(red + (F.wave * 2 + 0) * 128 + 4 * c4) = a0; *(LAS f32x4*)(red + (F.wave * 2 + 1) * 128 + 4 * c4) = a1; }
            __syncthreads();
            if (F.tid < 256) { const int bb = F.tid >> 7, ln = F.tid & 127; float s = 0.f;
#pragma unroll
                for (int wv = 0; wv < 8; ++wv) s += red[(wv * 2 + bb) * 128 + ln];
                MOD[((size_t)l * 2 + bb) * NMOD + n0 + ln] = s + A_BMOD[(size_t)l * NMOD + n0 + ln]; }
            __syncthreads();
        }
    }
    if ((int)blockIdx.x >= NMU || F.G <= NMU) {
        const int nb = F.G <= NMU ? F.G : F.G - NMU, b0 = F.G <= NMU ? (int)blockIdx.x : (int)blockIdx.x - NMU;
        for (int i = b0 * 512 + F.tid; i < MROWS * 16; i += nb * 512) {
            const int m = i >> 4, j = i & 15;
            const float freq = powf(10000.0f, -(float)j / 16.0f);
            const float ang = (float)A_POS[m] * freq;
            CS[(size_t)m * 32 + j] = cosf(ang); CS[(size_t)m * 32 + 16 + j] = sinf(ang);
        }
    }
    {
        LAS int* slot = (LAS int*)(F.lds + 12288);
        for (;;) {
            __syncthreads();
            if (F.tid == 0) slot[0] = (int)__hip_atomic_fetch_add(qhead, 16u, __ATOMIC_RELAXED, __HIP_MEMORY_SCOPE_AGENT);
            __syncthreads();
            const int base = slot[0];
            if (base >= CV_EARLY) break;
            convert_chunk(F, args, base, CV_EARLY);
        }
    }
}

__device__ __forceinline__ float gs_clamped(float g, float sc) { const float v = g * (1.0f + sc); return fabsf(v) < 1e-20f ? (v < 0.f ? -1e-20f : 1e-20f) : v; }
__device__ __forceinline__ void x_to_xb(Frame& F, const Args& args, const GAS float* xsrc, int l, int i) {
    GAS unsigned char* ws_ = (GAS unsigned char*)args.ws; asm volatile("" : "+s"(ws_));
    const int gw = F.vcu * NWAVES + F.wave, NGW = F.G * NWAVES;
    for (int m = gw; m < MROWS; m += NGW) {
        const int b = m >> 13;
        const GAS f32x4* xr = (const GAS f32x4*)(xsrc + (size_t)m * DM) + F.lane;
        const GAS f32x4* gr = (const GAS f32x4*)(A_NORMG + ((size_t)l * 3 + i) * DM) + F.lane;
        const GAS f32x4* sr = (const GAS f32x4*)(MOD + ((size_t)l * 2 + b) * NMOD + (3 * i + 1) * DM) + F.lane;
        float s = 0.f;
        GAS unsigned long long* o8 = (GAS unsigned long long*)(XB + (size_t)m * DM) + F.lane;
#pragma unroll
        for (int j = 0; j < 4; ++j) { const f32x4 v = xr[64 * j]; s += (v.x * v.x + v.y * v.y) + (v.z * v.z + v.w * v.w);
            const f32x4 g0 = gr[64 * j], s0 = sr[64 * j]; const f32x4 g = {gs_clamped(g0.x, s0.x), gs_clamped(g0.y, s0.y), gs_clamped(g0.z, s0.z), gs_clamped(g0.w, s0.w)}; const f32x4 y = v * g;
            o8[64 * j] = (unsigned long long)pk2(y.x, y.y) | ((unsigned long long)pk2(y.z, y.w) << 32); }
        s = wave_sum64(s);
        if (F.lane < 16) SSQX[(size_t)m * 16 + F.lane] = (F.lane == 0) ? s : 0.f;
    }
}

__device__ __forceinline__ void bias_rows(Frame& F, const Args& args, bool early) {
    GAS unsigned char* ws_ = (GAS unsigned char*)args.ws; asm volatile("" : "+s"(ws_));
    const int gw = F.vcu * NWAVES + F.wave, NGW = F.G * NWAVES;
    constexpr int RL = 5632 + 2048 + 5632, RE = 5632 + 2048;
    const int lo = early ? 0 : RE, hi = early ? RE : DEPTH * RL;
    for (int it = lo + gw; it < hi; it += NGW) {
        const int l = it / RL; int r = it % RL; int which, nrow; size_t woff; size_t boff;
        if (r < 5632) { which = 0; nrow = 5632; woff = W_GU1; boff = 0; } else if (r < 5632 + 2048) { r -= 5632; which = 1; nrow = 2048; woff = W_IN; boff = 2 * 5632; } else { r -= 5632 + 2048; which = 2; nrow = 5632; woff = W_GU2; boff = 2 * (5632 + 2048); }
        const GAS pg8::bf16_t* wr = (const GAS pg8::bf16_t*)(ws_ + WS_W + (size_t)l * WL + woff) + (size_t)r * DM;
        float a0 = 0.f, a1 = 0.f;
#pragma unroll
        for (int j = 0; j < 2; ++j) {
            const v4u wv = *(const GAS v4u*)(wr + j * 512 + F.lane * 8);
            const GAS float* s0 = MOD + ((size_t)l * 2 + 0) * NMOD + (3 * which) * DM + j * 512 + F.lane * 8; const GAS float* s1 = s0 + NMOD;
#pragma unroll
            for (int k = 0; k < 4; ++k) { const unsigned w = wv[k]; const float lo_ = __uint_as_float(w << 16), hi_ = __uint_as_float(w & 0xffff0000u);
                a0 += lo_ * s0[2 * k] + hi_ * s0[2 * k + 1]; a1 += lo_ * s1[2 * k] + hi_ * s1[2 * k + 1]; }
        }
        a0 = wave_sum64(a0); a1 = wave_sum64(a1);
        if (F.lane == 0) { BIAS[(size_t)l * BIAS_L + boff + r] = a0; BIAS[(size_t)l * BIAS_L + boff + nrow + r] = a1; }
    }
}
__device__ __forceinline__ void phase_pro1(Frame& F, const Args& args) {
    GAS unsigned char* ws_ = (GAS unsigned char*)args.ws; asm volatile("" : "+s"(ws_));
    for (int i = blockIdx.x * 512 + F.tid; i < DEPTH * 3 * 2 * DM; i += F.G * 512) {
        const int cidx = i & 1023, b = (i >> 10) & 1, li = i >> 11, l = li / 3, ii = li % 3;
        const float gv_ = gs_clamped(A_NORMG[((size_t)l * 3 + ii) * DM + cidx], MOD[((size_t)l * 2 + b) * NMOD + (3 * ii + 1) * DM + cidx]);
        GS[i] = gv_; ((GAS float*)WSP(WS_IGS))[i] = 1.0f / gv_;
    }
    bias_rows(F, args, true);
    x_to_xb(F, args, A_X, 0, 0);
}

__device__ __forceinline__ int next_unit(Frame& F, gu32* head) {
    LAS int* slot = (LAS int*)(F.lds + att::L_FLAG);
    __syncthreads();
    if (F.tid == 0) slot[0] = (int)__hip_atomic_fetch_add(head, 1u, __ATOMIC_RELAXED, __HIP_MEMORY_SCOPE_AGENT);
    __syncthreads();
    return slot[0];
}

#ifndef DUPS
#define DUPS -1
#endif
#ifndef PHM
#define PHM 255
#endif
#ifndef PHM2
#define PHM2 31
#endif
__global__ void __launch_bounds__(NWAVES * 64, 2) fwd_mega(Args args) {
    extern __shared__ __attribute__((aligned(16))) unsigned char lds[];
    const int wave0 = __builtin_amdgcn_readfirstlane((int)threadIdx.x >> 6);
    Frame F0; F0.lds = (LAS unsigned char*)lds; F0.wave = wave0; F0.lane = hw_lane(); F0.tid = wave0 * 64 + F0.lane;
    F0.G = gridDim.x; { const int bx = blockIdx.x; F0.vcu = (F0.G % 8 == 0) ? (bx % 8) * (F0.G / 8) + bx / 8 : bx; }
    gu32* ctl = (gu32*)(args.ws + WS_CTL);
    for (int u = F0.tid; u < (LDS_BYTES - LDSCTL_OFF) / 4; u += NWAVES * 64) ((LAS unsigned*)(F0.lds + LDSCTL_OFF))[u] = 0u;
    __syncthreads();
    const int lo = args.ph_lo, hi = args.ph_hi;
    XcdBarrier bar; bar.bar = (unsigned*)(ctl + CW_BAR) + args.li * XCD_BAR_WORDS; bar.x = 0; bar.st = nullptr; bar.w0 = wave0;
    if (hi - lo > 1 || true) bar = xcd_barrier_post((unsigned*)(ctl + CW_BAR) + args.li * XCD_BAR_WORDS, (volatile LAS unsigned*)(F0.lds + MISC_OFF) + 8, wave0);

    for (int ph = lo; ph < hi; ++ph) {
        Frame F; F.lds = F0.lds; F.G = F0.G; F.vcu = F0.vcu; { int t_ = wave0 * 64 + hw_lane(); asm volatile("" : "+v"(t_)); F.tid = t_; F.lane = t_ & 63; F.wave = wave0; }
        GAS unsigned char* ws_ = (GAS unsigned char*)args.ws; asm volatile("" : "+s"(ws_));
        int nrep = 1;
        if (DUPS >= 0) { const int ty = ph < 2 ? 8 + ph : ((ph - 2) & 7); if (ty == DUPS && !(ty == 5) && !((ty == 1 || ty == 7) && ph != 3)) nrep = 2; }
        for (int rep = 0; rep < nrep; ++rep) {
        if ((PHM & 64) && ph == 0) phase_pro0(F, args, ctl + CW_Q + 64 * 8);
        else if ((PHM & 128) && ph == 1) phase_pro1(F, args);
        else {
            const int l = (ph - 2) >> 3, s = (ph - 2) & 7;
            const GAS unsigned char* wl = ws_ + WS_W + (size_t)l * WL;
            const GAS float* biasl = BIAS + (size_t)l * BIAS_L;
            const GAS float* modl = MOD + (size_t)l * 2 * NMOD;
            if ((PHM & 1) && (s == 0 || s == 6)) {
                pg8::Gemm g{(const pg8::bf16_t*)XB, (const pg8::bf16_t*)(wl + (s == 0 ? W_GU1 : W_GU2)), MROWS, 5632, DM}; pg8::StaticOrder S; S.init(MROWS, 5632, F.G, (int)blockIdx.x);
                pg8::EpiUp E{ws_, biasl + (s == 0 ? 0 : 2 * (5632 + 2048))};
                pg8::gemm_phase<pg8::EpiUp, pg8::StaticOrder, true, true>(F.lds, g, S, E, F.wave);
            } else if ((PHM & 2) && (s == 1 || s == 7)) {
                pg8::Gemm g{(const pg8::bf16_t*)HID, (const pg8::bf16_t*)(wl + (s == 1 ? W_D1 : W_D2)), MROWS, DM, DFF}; pg8::StaticOrder S; S.init(MROWS, DM, F.G, (int)blockIdx.x);
                const bool lastp = (s == 7 && l == DEPTH - 1);
                const GAS float* gsn = lastp ? nullptr : (s == 1 ? GS + ((size_t)(l * 3 + 1) * 2) * DM : GS + ((size_t)((l + 1) * 3 + 0) * 2) * DM);
                const GAS float* igp = (const GAS float*)WSP(WS_IGS) + ((size_t)(l * 3 + (s == 1 ? 0 : 2)) * 2) * DM;
                pg8::EpiResS<false> E{(GAS float*)args.out, ws_, modl + (s == 1 ? 2 : 8) * DM, igp, gsn, 0.5f}; pg8::gemm_phase<pg8::EpiResS<false>, pg8::StaticOrder, false, true>(F.lds, g, S, E, F.wave, (unsigned long long*)(ctl + CW_Q + 64 * 13));
            } else if ((PHM & 4) && s == 2) {
                pg8::Gemm g{(const pg8::bf16_t*)XB, (const pg8::bf16_t*)(wl + W_IN), MROWS, 2048, DM}; pg8::StaticOrder S; S.init(MROWS, 2048, F.G, (int)blockIdx.x);
                pg8::EpiIn E{ws_, A_SWAQN + l * 64, A_SWAKN + l * 64, biasl + 2 * 5632};
                pg8::gemm_phase<pg8::EpiIn, pg8::StaticOrder, true, true>(F.lds, g, S, E, F.wave);
            } else if ((PHM & 8) && s == 3) {
                if (PHM2 & 1) { pg8::Gemm g{(const pg8::bf16_t*)CQ, (const pg8::bf16_t*)(wl + W_UQ), MROWS, 768, 256}; pg8::StaticOrder S; S.init(MROWS, 768, F.G, (int)blockIdx.x);
                  pg8::EpiUq E{ws_}; pg8::gemm_phase<pg8::EpiUq, pg8::StaticOrder, true, true>(F.lds, g, S, E, F.wave); }
                if (PHM2 & 2) { pg8::Gemm g{(const pg8::bf16_t*)CKV, (const pg8::bf16_t*)(wl + W_UKV), MROWS, 768, 128}; pg8::StaticOrder S; S.init(MROWS, 768, F.G, (int)((blockIdx.x + 64) % F.G));
                  pg8::EpiUkv E{ws_, A_MLAKN + l * 96}; pg8::gemm_phase<pg8::EpiUkv, pg8::StaticOrder, true, true>(F.lds, g, S, E, F.wave); }
            } else if ((PHM & 16) && s == 4) {
                att::AttnP PA{ws_, A_MLAQN + l * 96, nullptr, nullptr, nullptr};
                att::AttnP PB{ws_, nullptr, A_POS, A_SINKS + l * 6, A_RELB};
                att::AttnP PC{ws_, nullptr, nullptr, nullptr, nullptr};
                gu32* head = ctl + CW_Q + 64 * (2 * l + 1 + 4 * rep);
                for (;;) { const int u = next_unit(F, head); if (u >= 384 + 256 + 384) break;
                    if ((PHM2 & 16) && u < 384) { const int qb = 31 - u / 12, bh = u % 12;
                        att::attn_unit<96, 0>(F.lds, PA, bh / 6, bh % 6, qb, F.wave, (unsigned long long*)(ctl + CW_Q + 64 * 12)); }

                    else if ((PHM2 & 4) && u >= 384 && u < 640) { const int v = u - 384, qb = 31 - (v >> 3), bh = v & 7; att::attn_unit<64, 2>(F.lds, PC, bh >> 2, bh & 3, qb, F.wave); }
                    else if ((PHM2 & 8) && u >= 640) { const int v = u - 640, qb = v / 12, bh = v % 12; att::attn_unit<64, 1>(F.lds, PB, bh / 6, bh % 6, qb, F.wave); } }
                if (l == 0 && rep == 0) {
                    gu32* chead = ctl + CW_Q + 64 * 9; LAS int* cslot = (LAS int*)(F.lds + 12288);
                    for (;;) { __syncthreads(); if (F.tid == 0) cslot[0] = (int)__hip_atomic_fetch_add(chead, 16u, __ATOMIC_RELAXED, __HIP_MEMORY_SCOPE_AGENT); __syncthreads();
                        const int cb = CV_EARLY + cslot[0]; if (cb >= CV_ALL) break; convert_chunk(F, args, cb, CV_ALL); } }
            } else if ((PHM & 32) && s == 5) {
                if (l == 0 && rep == 0) { bias_rows(F, args, false); asm volatile("s_waitcnt vmcnt(0)" ::: "memory"); __syncthreads(); }
                pg8::Gemm g{(const pg8::bf16_t*)OALL, (const pg8::bf16_t*)(wl + W_OUT), MROWS, DM, DM}; pg8::StaticOrder S; S.init(MROWS, DM, F.G, (int)blockIdx.x);
                pg8::EpiResS<true> E{(GAS float*)args.out, ws_, modl + 5 * DM, (const GAS float*)WSP(WS_IGS) + ((size_t)(l * 3 + 1) * 2) * DM, GS + ((size_t)(l * 3 + 2) * 2) * DM, 1.0f}; pg8::gemm_phase<pg8::EpiResS<true>, pg8::StaticOrder, false, true>(F.lds, g, S, E, F.wave);
            }
        }
        if (rep + 1 < nrep) xcd_barrier(bar);
        }
        if (ph + 1 < hi) xcd_barrier(bar);
    }
#ifdef GEMM_PROF
    xcd_barrier(bar);
    if (blockIdx.x == 0 && threadIdx.x == 0) { const unsigned long long* st = (const unsigned long long*)(ctl + CW_Q + 64 * 13); double sh;
        if (GEMM_PROF == 0) sh = (double)st[1] / (double)(st[0] + st[1]);
        else if (GEMM_PROF == 1) sh = (double)st[0] / (double)st[2] / 1.0e6;
        else sh = (double)st[1] / (double)st[2] / 1.0e6;
        args.out[0] += (float)(0.04 + 0.18 * (sh > 1.0 ? 1.0 : sh)); }
#endif
#ifdef ATT_PROF
    xcd_barrier(bar);
    if (blockIdx.x == 0 && threadIdx.x == 0) { const unsigned long long* st = (const unsigned long long*)(ctl + CW_Q + 64 * 12);
        const double tot = (double)st[0]; double sh = 0.0;
        if (ATT_PROF == 0) sh = (double)st[0] / (double)st[5] / 1.0e6;
        else if (ATT_PROF == 5) sh = (double)st[0] / (double)st[6] / 1.0e4;
        else if (ATT_PROF == 6) sh = (double)st[6] / 1.0e3;
        else sh = (double)st[ATT_PROF] / tot;
        args.out[0] += (float)(0.04 + 0.18 * (sh > 1.0 ? 1.0 : sh)); }
#endif
}
static void launch_fwd(hipStream_t stream, Args a, int grid, int lo, int hi, int li, int adapt) {
    a.ph_lo = lo; a.ph_hi = hi; a.li = li; a.adapt = adapt;
    hipLaunchKernelGGL(fwd_mega, dim3(grid), dim3(NWAVES * 64), LDS_BYTES, stream, a);
}
extern "C" void kernel_launch(void* const* d_in, const int* in_sizes, int n_in, void* d_out, int out_size, void* d_ws, size_t ws_size, hipStream_t stream) {
    static int grid = 0;
    if (grid == 0) {
        if (n_in != 23 || out_size != MROWS * DM || ws_size < WS_END) { fprintf(stderr, "kernel_launch: unexpected problem (n_in %d, out %d, ws %zu < %zu)\n", n_in, out_size, ws_size, (size_t)WS_END); grid = -1; return; }
        int dev = 0, cus = 0, per_cu = 0;
        if (hipGetDevice(&dev) != hipSuccess || hipDeviceGetAttribute(&cus, hipDeviceAttributeMultiprocessorCount, dev) != hipSuccess) { grid = -1; return; }
        if (hipFuncSetAttribute((const void*)fwd_mega, hipFuncAttributeMaxDynamicSharedMemorySize, LDS_BYTES) != hipSuccess) { fprintf(stderr, "kernel_launch: hipFuncSetAttribute failed\n"); grid = -1; return; }
        if (hipOccupancyMaxActiveBlocksPerMultiprocessor(&per_cu, (const void*)fwd_mega, NWAVES * 64, LDS_BYTES) != hipSuccess || per_cu < 1) { fprintf(stderr, "kernel_launch: occupancy query says %d blocks per CU\n", per_cu); (void)hipGetLastError(); grid = -1; return; }
        if (cus < 256) { fprintf(stderr, "kernel_launch: built for a 256-CU device (the one-unit-per-workgroup GEMM phases need exactly 256 workgroups), found %d CUs\n", cus); grid = -1; return; }
        grid = 256;
    }
    if (grid < 0) return;
    (void)hipMemsetAsync((char*)d_ws + WS_CTL, 0, CTL_ZERO_BYTES, stream);
    Args a{};
    for (int i = 0; i < 23; ++i) a.in[i] = d_in[i];
    a.out = (float*)d_out; a.ws = (unsigned char*)d_ws;
    launch_fwd(stream, a, grid, 0, NPH, 0, -1);
}
```

```cpp
#include <hip/hip_runtime.h>
#include <cstdio>
#include <cstdint>
#include <cmath>
constexpr int NWAVES = 8;
constexpr int BATCH = 2, SEQ = 8192, DM = 1024, DEPTH = 2, MROWS = BATCH * SEQ;
constexpr int DFF = 2816, DIN = 1824, NMOD = 9 * DM;
constexpr int NPH = 2 + 8 * DEPTH;
constexpr size_t MiB = 1u << 20;
constexpr size_t WS_CTL = 0, CTL_ZERO_BYTES = 256 * 1024;
constexpr size_t WS_MOD = 1 * MiB;
constexpr size_t WS_GS = WS_MOD + 160 * 1024;
constexpr size_t WS_IGS = WS_GS + 64 * 1024;
constexpr size_t WS_BIAS = WS_IGS + 64 * 1024;
constexpr size_t BIAS_L = 2 * (5632 + 2048 + 5632);
constexpr size_t WS_SSQX = 2 * MiB;
constexpr size_t WS_SSQO = 3 * MiB;
constexpr size_t WS_CS = 4 * MiB;
constexpr size_t WS_KPE = 6 * MiB;
constexpr size_t WS_SSQC = 8 * MiB;
constexpr size_t WS_W = 9 * MiB;
constexpr size_t W_GU1 = 0, W_D1 = W_GU1 + (size_t)5632 * 1024 * 2, W_IN = W_D1 + (size_t)1024 * 2816 * 2, W_UQ = W_IN + (size_t)2048 * 1024 * 2, W_UKV = W_UQ + (size_t)768 * 256 * 2,
                 W_OUT = W_UKV + (size_t)768 * 128 * 2, W_GU2 = W_OUT + (size_t)1024 * 1024 * 2, W_D2 = W_GU2 + (size_t)5632 * 1024 * 2, WL = W_D2 + (size_t)1024 * 2816 * 2;
constexpr size_t WS_XB = WS_W + ((2 * WL + MiB - 1) / MiB) * MiB;
constexpr size_t WS_ACT = WS_XB + 32 * MiB;
constexpr size_t WS_HID = WS_ACT;
constexpr size_t WS_CQ = WS_ACT, WS_CKV = WS_CQ + 8 * MiB, WS_QRAW = WS_CKV + 4 * MiB, WS_KA = WS_QRAW + 36 * MiB, WS_VA = WS_KA + 18 * MiB, WS_QS = WS_VA + 12 * MiB, WS_KS = WS_QS + 12 * MiB,
                 WS_VS = WS_KS + 4 * MiB, WS_QC = WS_VS + 4 * MiB, WS_KC = WS_QC + 8 * MiB, WS_VC = WS_KC + 8 * MiB, WS_OALL = WS_VC + 8 * MiB, WS_END = WS_OALL + 32 * MiB;
static_assert(WS_HID + (size_t)MROWS * DFF * 2 <= WS_END, "d_ws map");
constexpr int CW_BAR = 4096;
constexpr int CW_Q = 40960;
static_assert((CW_Q + 64 * 14) * 4 <= (int)CTL_ZERO_BYTES && CW_BAR + 8 * 3456 <= CW_Q, "ctl map");
constexpr int RING_BYTES = 131072, LDSCTL_OFF = RING_BYTES, MISC_OFF = LDSCTL_OFF + 320, LDS_BYTES = 147456;

__device__ __forceinline__ int hw_lane() { int l; asm volatile("v_mbcnt_lo_u32_b32 %0, -1, 0\n\tv_mbcnt_hi_u32_b32 %0, -1, %0" : "=v"(l)); return l; }
namespace pg8 {
#define PG8_LAS __attribute__((address_space(3)))
typedef unsigned short bf16_t;
typedef short bf16x8 __attribute__((ext_vector_type(8)));
typedef float f32x4 __attribute__((ext_vector_type(4)));
typedef unsigned u32x4 __attribute__((ext_vector_type(4)));
constexpr int BM = 256, BK = 64, HALF = 128, HTB = HALF * BK * 2  , STAGE_BYTES = 8 * HTB, NXCD = 8, WGM = 8;

__host__ __device__ __forceinline__ int lds_byte(int r, int c) { const int st = (r >> 4) * 2 + (c >> 5), rr = r & 15, cc = c & 31, ob = rr * 64 + cc * 2; return st * 1024 + (ob ^ (((ob >> 9) & 1) << 5)); }
__host__ __device__ __forceinline__ void stage_rc(int b, int& R, int& C) { const int st = b / 1024, sb = b % 1024, swz = sb ^ (((sb >> 9) & 1) << 5); R = (st >> 1) * 16 + swz / 64; C = (st & 1) * 32 + (swz % 64) / 2; }
__host__ __device__ __forceinline__ int perm32(int rho) { const int n = rho >> 4, i = rho & 15; return 8 * (i >> 2) + 4 * n + (i & 3); }

struct Unit { int pm, pn; };
struct Gemm { const bf16_t* A; const bf16_t* Bt; int M, N, K; };

struct StaticOrder {
    int nM, nN, nwg, G, c;
    __host__ __device__ void init(int M, int N, int G_, int c_) { nM = M / BM; nN = N / BM; nwg = nM * nN; G = G_; c = c_; }
    __host__ __device__ bool next(int i, Unit& u) const {
        const long L = (long)i * G + c; if (L >= nwg) return false;
        int wgid = (int)L; { const int q = nwg / NXCD, r = nwg % NXCD, xcd = wgid % NXCD, off = wgid / NXCD; wgid = (xcd < r ? xcd * (q + 1) : r * (q + 1) + (xcd - r) * q) + off; }
        const int nig = WGM * nN, gid = wgid / nig, fm = gid * WGM, gsz = (nM - fm) < WGM ? (nM - fm) : WGM;
        u.pm = fm + ((wgid % nig) % gsz); u.pn = (wgid % nig) / gsz; return true;
    }
    __device__ __forceinline__ void a_ready(const Unit&) const {}
    __device__ __forceinline__ void done(const Unit&) const {}
};

__device__ __forceinline__ unsigned cvt_pk_bf16(float lo, float hi) { unsigned r; asm volatile("v_cvt_pk_bf16_f32 %0, %1, %2" : "=v"(r) : "v"(lo), "v"(hi)); return r; }
typedef float f32x2 __attribute__((ext_vector_type(2)));
template <class Epi, class Sched, bool ALIGN_EPI = false, bool SP2 = false>
__device__ __forceinline__ void gemm_phase(PG8_LAS unsigned char* lds, const Gemm g, const Sched& S, const Epi& E, int wave0, unsigned long long* gprof = nullptr) {
#ifdef GEMM_PROF
    const long long gp_t0 = (Epi::AFTER_DRAIN && !Epi::HOOK && blockIdx.x == 0) ? (long long)clock64() : 0ll;
#endif
    int tid_ = wave0 * 64 + hw_lane(); asm volatile("" : "+v"(tid_));
    const int tid = tid_, wid = __builtin_amdgcn_readfirstlane(tid >> 6), lane = tid & 63, wr = wid >> 2, wc = wid & 3, fr = lane & 15, fq = lane >> 4;
    int K_ = g.K; asm volatile("" : "+s"(K_));
    const int K = K_, nt = K / BK;
    unsigned voffA[2], voffB[2];
#pragma unroll
    for (int i = 0; i < 2; ++i) { int R, C; stage_rc(tid * 16 + i * 8192, R, C); const int Rb = Epi::PERM ? ((R & ~31) + perm32(R & 31)) : R;
        voffA[i] = (unsigned)(R * K + C) * 2u; voffB[i] = (unsigned)(Rb * K + C) * 2u; }
    const size_t kstep = (size_t)(BK * 2);
    const size_t hstep = (size_t)HALF * K * 2;
    const size_t tstep = 2 * hstep;
    const unsigned ldsw = (unsigned)wid * 1024u;
    const int aoff = lds_byte(wr * 64 + fr, fq * 8), boff = lds_byte(wc * 32 + fr, fq * 8);
#define PG8_SA(b, h) (((b) * 2 + (h)) * HTB)
#define PG8_SB(b, h) ((4 + (b) * 2 + (h)) * HTB)
#define PG8_STAGE(bufoff, gbase, voff) do { _Pragma("unroll") for (int _i = 0; _i < 2; ++_i) \
        __builtin_amdgcn_global_load_lds((const unsigned*)((const char*)(gbase) + (voff)[_i]), (PG8_LAS unsigned*)(lds + (bufoff) + ldsw + _i * 8192), 16, 0, 0); } while (0)
#define PG8_LDA(dst, b, h) do { _Pragma("unroll") for (int m = 0; m < 4; ++m) _Pragma("unroll") for (int k = 0; k < 2; ++k) dst[m][k] = *(const PG8_LAS bf16x8*)(lds + PG8_SA(b, h) + aoff + m * 2048 + k * 1024); } while (0)
#define PG8_LDB(dst, b, h) do { _Pragma("unroll") for (int n = 0; n < 2; ++n) _Pragma("unroll") for (int k = 0; k < 2; ++k) dst[n][k] = *(const PG8_LAS bf16x8*)(lds + PG8_SB(b, h) + boff + n * 2048 + k * 1024); } while (0)
#define PG8_MMA(ai, bj, At, Bt) do { __builtin_amdgcn_s_setprio(1); _Pragma("unroll") for (int m = 0; m < 4; ++m) _Pragma("unroll") for (int n = 0; n < 2; ++n) _Pragma("unroll") for (int k = 0; k < 2; ++k) \
        acc[ai][bj][m][n] = __builtin_amdgcn_mfma_f32_16x16x32_bf16(Bt[n][k], At[m][k], acc[ai][bj][m][n], 0, 0, 0); __builtin_amdgcn_s_setprio(0); } while (0)
#define PG8_WAIT_V(n) asm volatile("s_waitcnt vmcnt(" #n ")" ::: "memory")
#define PG8_WAIT_L(n) asm volatile("s_waitcnt lgkmcnt(" #n ")" ::: "memory")
#define PG8_BAR __builtin_amdgcn_s_barrier()
#define PG8_SCHED __builtin_amdgcn_sched_barrier(0)
    Unit cur, nxt; int ui = 0;
    if (!S.next(0, cur)) return;
    f32x4 acc[2][2][4][2];
#pragma unroll
    for (int a = 0; a < 2; ++a)
#pragma unroll
        for (int b = 0; b < 2; ++b)
#pragma unroll
            for (int m = 0; m < 4; ++m)
#pragma unroll
                for (int n = 0; n < 2; ++n) acc[a][b][m][n] = (f32x4){0.f, 0.f, 0.f, 0.f};
    bf16x8 At[4][2], B0[2][2], B1[2][2];
    const char* cA = (const char*)g.A + (size_t)cur.pm * tstep; const char* cB = (const char*)g.Bt + (size_t)cur.pn * tstep;
    S.a_ready(cur);
    if constexpr (SP2) {
        PG8_STAGE(PG8_SB(0, 0), cB, voffB); PG8_STAGE(PG8_SB(0, 1), cB + hstep, voffB); PG8_STAGE(PG8_SA(0, 0), cA, voffA); PG8_STAGE(PG8_SA(0, 1), cA + hstep, voffA);
        if (wr == 1) PG8_BAR;
        PG8_WAIT_V(2); PG8_BAR;
        PG8_STAGE(PG8_SB(1, 0), cB + kstep, voffB); PG8_STAGE(PG8_SA(1, 0), cA + kstep, voffA); PG8_STAGE(PG8_SB(1, 1), cB + hstep + kstep, voffB);
        PG8_WAIT_V(6); PG8_BAR;
    } else {
        PG8_STAGE(PG8_SB(0, 0), cB, voffB); PG8_STAGE(PG8_SA(0, 0), cA, voffA); PG8_STAGE(PG8_SB(0, 1), cB + hstep, voffB); PG8_STAGE(PG8_SA(0, 1), cA + hstep, voffA);
        if (wr == 1) PG8_BAR;
        PG8_WAIT_V(4); PG8_BAR;
        PG8_STAGE(PG8_SB(1, 0), cB + kstep, voffB); PG8_STAGE(PG8_SA(1, 0), cA + kstep, voffA); PG8_STAGE(PG8_SB(1, 1), cB + hstep + kstep, voffB);
        PG8_WAIT_V(6); PG8_BAR;
    }
    for (;;) {
        const bool has_next = S.next(ui + 1, nxt);
        const char* nA = has_next ? (const char*)g.A + (size_t)nxt.pm * tstep : cA; const char* nB = has_next ? (const char*)g.Bt + (size_t)nxt.pn * tstep : cB;
#pragma nounroll
        for (int t = 0; t < nt; t += 2) {
            if constexpr (Epi::HOOK) E.hook(acc, cur, t, wr, wc, fr, fq);
            const bool last = (t == nt - 2);
            const char* a1 = cA + (size_t)(t + 1) * kstep;
            const char* a2 = last ? nA : cA + (size_t)(t + 2) * kstep; const char* b2 = last ? nB : cB + (size_t)(t + 2) * kstep;
            const char* a3 = a2 + kstep; const char* b3 = b2 + kstep;
            if (last && has_next) S.a_ready(nxt);
            if constexpr (SP2) {
            PG8_LDB(B0, 0, 0); PG8_LDB(B1, 0, 1); PG8_SCHED; PG8_LDA(At, 0, 0); PG8_STAGE(PG8_SA(1, 1), a1 + hstep, voffA);
            PG8_WAIT_V(8); PG8_WAIT_L(0); PG8_BAR; PG8_MMA(0, 0, At, B0); PG8_MMA(0, 1, At, B1); PG8_BAR; PG8_SCHED;
            PG8_LDA(At, 0, 1); PG8_STAGE(PG8_SB(0, 0), b2, voffB); PG8_STAGE(PG8_SB(0, 1), b2 + hstep, voffB); PG8_STAGE(PG8_SA(0, 0), a2, voffA);
            PG8_WAIT_V(8); PG8_WAIT_L(0); PG8_BAR; PG8_MMA(1, 0, At, B0); PG8_MMA(1, 1, At, B1); PG8_BAR; PG8_SCHED;
            PG8_LDB(B0, 1, 0); PG8_LDB(B1, 1, 1); PG8_SCHED; PG8_LDA(At, 1, 0); PG8_STAGE(PG8_SA(0, 1), a2 + hstep, voffA);
            PG8_WAIT_V(8); PG8_WAIT_L(0); PG8_BAR; PG8_MMA(0, 0, At, B0); PG8_MMA(0, 1, At, B1); PG8_BAR; PG8_SCHED;
            PG8_LDA(At, 1, 1); PG8_STAGE(PG8_SB(1, 0), b3, voffB); PG8_STAGE(PG8_SB(1, 1), b3 + hstep, voffB); PG8_STAGE(PG8_SA(1, 0), a3, voffA);
            PG8_WAIT_V(8); PG8_WAIT_L(0); PG8_BAR; PG8_MMA(1, 0, At, B0); PG8_MMA(1, 1, At, B1); PG8_BAR; PG8_SCHED;
            } else {
            PG8_LDB(B0, 0, 0); PG8_SCHED; PG8_LDA(At, 0, 0); PG8_STAGE(PG8_SA(1, 1), a1 + hstep, voffA);
            PG8_WAIT_L(8); PG8_BAR; PG8_WAIT_L(0); PG8_MMA(0, 0, At, B0); PG8_BAR; PG8_SCHED;
            PG8_LDB(B1, 0, 1); PG8_STAGE(PG8_SB(0, 0), b2, voffB);
            PG8_BAR; PG8_WAIT_L(0); PG8_MMA(0, 1, At, B1); PG8_BAR;
            PG8_LDA(At, 0, 1); PG8_STAGE(PG8_SA(0, 0), a2, voffA);
            PG8_BAR; PG8_WAIT_L(0); PG8_MMA(1, 0, At, B0); PG8_BAR; PG8_SCHED;
            PG8_STAGE(PG8_SB(0, 1), b2 + hstep, voffB);
            PG8_WAIT_V(6); PG8_BAR; PG8_MMA(1, 1, At, B1); PG8_BAR;
            PG8_LDB(B0, 1, 0); PG8_SCHED; PG8_LDA(At, 1, 0); PG8_STAGE(PG8_SA(0, 1), a2 + hstep, voffA);
            PG8_WAIT_L(8); PG8_BAR; PG8_WAIT_L(0); PG8_MMA(0, 0, At, B0); PG8_BAR; PG8_SCHED;
            PG8_LDB(B1, 1, 1); PG8_STAGE(PG8_SB(1, 0), b3, voffB);
            PG8_BAR; PG8_WAIT_L(0); PG8_MMA(0, 1, At, B1); PG8_BAR;
            PG8_LDA(At, 1, 1); PG8_STAGE(PG8_SA(1, 0), a3, voffA);
            PG8_BAR; PG8_WAIT_L(0); PG8_MMA(1, 0, At, B0); PG8_BAR; PG8_SCHED;
            PG8_STAGE(PG8_SB(1, 1), b3 + hstep, voffB);
            PG8_WAIT_V(6); PG8_BAR; PG8_MMA(1, 1, At, B1); PG8_BAR;
            }
        }
        if constexpr (ALIGN_EPI) { if (wr == 0) PG8_BAR; }
        if constexpr (!Epi::AFTER_DRAIN) {
            Unit ce = cur; asm volatile("" : "+s"(ce.pm), "+s"(ce.pn)); int fre = fr, fqe = fq; asm volatile("" : "+v"(fre), "+v"(fqe));
            E(acc, ce, wr, wc, fre, fqe); S.done(cur); }
        if (!has_next) break;
#pragma unroll
        for (int a = 0; a < 2; ++a)
#pragma unroll
            for (int b = 0; b < 2; ++b)
#pragma unroll
                for (int m = 0; m < 4; ++m)
#pragma unroll
                    for (int n = 0; n < 2; ++n) acc[a][b][m][n] = (f32x4){0.f, 0.f, 0.f, 0.f};
        cur = nxt; cA = nA; cB = nB; ++ui;
        if constexpr (ALIGN_EPI) { if (wr == 1) PG8_BAR; }
    }
    PG8_WAIT_V(0);
    if constexpr (!ALIGN_EPI) { if (wr == 0) PG8_BAR; }
    PG8_BAR;
#ifdef GEMM_PROF
    const long long gp_t1 = (Epi::AFTER_DRAIN && !Epi::HOOK && blockIdx.x == 0) ? (long long)clock64() : 0ll;
#endif
    if constexpr (Epi::AFTER_DRAIN) { E.fused(acc, cur, wr, wc, fr, fq, lds, wid, lane); S.done(cur); }
#ifdef GEMM_PROF
    if (Epi::AFTER_DRAIN && !Epi::HOOK && blockIdx.x == 0 && tid == 0 && gprof) { const long long gp_t2 = clock64(); atomicAdd(gprof + 0, (unsigned long long)(gp_t1 - gp_t0)); atomicAdd(gprof + 1, (unsigned long long)(gp_t2 - gp_t1)); atomicAdd(gprof + 2, 1ull); }
#endif
#undef PG8_SA
#undef PG8_SB
#undef PG8_STAGE
#undef PG8_LDA
#undef PG8_LDB
#undef PG8_MMA
#undef PG8_WAIT_V
#undef PG8_WAIT_L
#undef PG8_BAR
#undef PG8_SCHED
}
constexpr float RMS_EPS = 1e-6f;
constexpr int MROWS_ = 16384;
constexpr float LOG2E = 1.4426950408889634f;
typedef unsigned u32x2 __attribute__((ext_vector_type(2)));
#define PG8_FENCE() asm volatile("" ::: "memory")
#define PG8_G __attribute__((address_space(1)))
__device__ __forceinline__ float sum16f(const PG8_G float* p) {
    const f32x4 a = *(const PG8_G f32x4*)p, b = *(const PG8_G f32x4*)(p + 4), c = *(const PG8_G f32x4*)(p + 8), d = *(const PG8_G f32x4*)(p + 12);
    return ((a[0] + a[1]) + (a[2] + a[3])) + ((b[0] + b[1]) + (b[2] + b[3])) + ((c[0] + c[1]) + (c[2] + c[3])) + ((d[0] + d[1]) + (d[2] + d[3]));
}
__device__ __forceinline__ float xsum16(float x) { auto r = __builtin_amdgcn_permlane16_swap(__float_as_uint(x), __float_as_uint(x), false, false); return __uint_as_float(r[0]) + __uint_as_float(r[1]); }
__device__ __forceinline__ float xsum32(float x) { auto r = __builtin_amdgcn_permlane32_swap(__float_as_uint(x), __float_as_uint(x), false, false); return __uint_as_float(r[0]) + __uint_as_float(r[1]); }
__device__ __forceinline__ float wave_sum_dpp(float x) {
    x += __builtin_bit_cast(float, __builtin_amdgcn_update_dpp(0, __builtin_bit_cast(int, x), 0xB1, 0xf, 0xf, true));
    x += __builtin_bit_cast(float, __builtin_amdgcn_update_dpp(0, __builtin_bit_cast(int, x), 0x4E, 0xf, 0xf, true));
    x += __builtin_bit_cast(float, __builtin_amdgcn_update_dpp(0, __builtin_bit_cast(int, x), 0x141, 0xf, 0xf, true));
    x += __builtin_bit_cast(float, __builtin_amdgcn_update_dpp(0, __builtin_bit_cast(int, x), 0x140, 0xf, 0xf, true));
    return xsum32(xsum16(x));
}
__device__ __forceinline__ float fast_rcp(float x) { return __builtin_amdgcn_rcpf(x); }
__device__ __forceinline__ float silu_fast(float g) { return g * fast_rcp(1.0f + __builtin_amdgcn_exp2f(-g * LOG2E)); }
__device__ __forceinline__ float sq4(const f32x4 v) { return (v[0] * v[0] + v[1] * v[1]) + (v[2] * v[2] + v[3] * v[3]); }

struct EpiUp {
    static constexpr bool PERM = true, AFTER_DRAIN = false, HOOK = false;
    PG8_G unsigned char* ws; const PG8_G float* bias;
    __device__ __forceinline__ void hook(f32x4 (&)[2][2][4][2], const Unit&, int, int, int, int, int) const {}
    __device__ __forceinline__ void operator()(const f32x4 (&acc)[2][2][4][2], const Unit& u, int wr, int wc, int fr, int fq) const {
        PG8_G bf16_t* HID = (PG8_G bf16_t*)(ws + WS_HID); const PG8_G float* ssqx = (const PG8_G float*)(ws + WS_SSQX);
        const int b = u.pm >> 5;
        const PG8_G float* bb = bias + b * 5632 + u.pn * BM + wc * 32 + 8 * fq;
        f32x4 bg[2], bu[2];
#pragma unroll
        for (int n = 0; n < 2; ++n) { bg[n] = *(const PG8_G f32x4*)(bb + 4 * n); bu[n] = *(const PG8_G f32x4*)(bb + HALF + 4 * n); }
#pragma unroll
        for (int ai = 0; ai < 2; ++ai)
#pragma unroll
            for (int m = 0; m < 4; ++m) {
                const int row = u.pm * BM + ai * HALF + wr * 64 + m * 16 + fr;
                const float r = 1.0f / sqrtf(sum16f(ssqx + (size_t)row * 16) * (1.0f / 1024.0f) + RMS_EPS);
                float hv[8];
#pragma unroll
                for (int n = 0; n < 2; ++n)
#pragma unroll
                    for (int i = 0; i < 4; ++i) { const float g = acc[ai][0][m][n][i] * r + bg[n][i], uu = acc[ai][1][m][n][i] * r + bu[n][i]; hv[4 * n + i] = silu_fast(g) * uu; }
                u32x4 w; w.x = cvt_pk_bf16(hv[0], hv[1]); w.y = cvt_pk_bf16(hv[2], hv[3]); w.z = cvt_pk_bf16(hv[4], hv[5]); w.w = cvt_pk_bf16(hv[6], hv[7]);
                *(PG8_G u32x4*)(HID + (size_t)row * 2816 + u.pn * HALF + wc * 32 + 8 * fq) = w;
                if (m & 1) PG8_FENCE();
            }
    }
};

template <bool HOOKED> struct EpiResS {
    static constexpr bool PERM = false, AFTER_DRAIN = true, HOOK = HOOKED;
    PG8_G float* fout; PG8_G unsigned char* ws; const PG8_G float* gate; const PG8_G float* igs; const PG8_G float* gs; float coef;
    __device__ __forceinline__ void group_r(int row, float& rA, float& rB, float& rC) const {
        const PG8_G float* p = (const PG8_G float*)(ws + WS_SSQO) + (size_t)row * 16;
        const f32x4 a = *(const PG8_G f32x4*)p, b = *(const PG8_G f32x4*)(p + 4), c = *(const PG8_G f32x4*)(p + 8), d = *(const PG8_G f32x4*)(p + 12);
        const float sA = ((a[0] + a[1]) + (a[2] + a[3])) + (b[0] + b[1]), sB = ((b[2] + b[3]) + (c[0] + c[1])) + (c[2] + c[3]), sC = (d[0] + d[1]) + (d[2] + d[3]);
        rA = 1.0f / sqrtf(sA * (1.0f / 384.0f) + RMS_EPS); rB = 1.0f / sqrtf(sB * (1.0f / 384.0f) + RMS_EPS); rC = 1.0f / sqrtf(sC * (1.0f / 256.0f) + RMS_EPS);
    }
    __device__ __forceinline__ void hook(f32x4 (&acc)[2][2][4][2], const Unit& u, int t, int wr, int wc, int fr, int fq) const {
        if (t != 6 && t != 12) return;
        asm volatile("" : "+v"(fr));
#pragma unroll
        for (int ai = 0; ai < 2; ++ai)
#pragma unroll
            for (int m = 0; m < 4; ++m) {
                const int row = u.pm * BM + ai * HALF + wr * 64 + m * 16 + fr;
                float rA, rB, rC; group_r(row, rA, rB, rC);
                const float f = (t == 6) ? rA / rB : rB / rC;
#pragma unroll
                for (int bj = 0; bj < 2; ++bj)
#pragma unroll
                    for (int n = 0; n < 2; ++n) acc[ai][bj][m][n] = acc[ai][bj][m][n] * f;
                PG8_FENCE();
            }
    }
    __device__ __forceinline__ void fused(f32x4 (&acc)[2][2][4][2], const Unit& u, int wr, int wc, int fr, int fq, PG8_LAS unsigned char* lds, int wid, int lane) const {
        PG8_G bf16_t* xb = (PG8_G bf16_t*)(ws + WS_XB); PG8_G float* ssq_out = (PG8_G float*)(ws + WS_SSQX); constexpr int gate_bstride = 9 * 1024;
        const int b = u.pm >> 5, colg = u.pn * BM + 4 * lane;
        const f32x4 gv = *(const PG8_G f32x4*)(gate + (size_t)b * gate_bstride + colg) * coef;
        const f32x4 gsv = gs ? *(const PG8_G f32x4*)(gs + (size_t)b * 1024 + colg) : (f32x4){0.f, 0.f, 0.f, 0.f};
        const f32x4 igv = *(const PG8_G f32x4*)(igs + (size_t)b * 1024 + colg);
#pragma unroll
        for (int ai = 0; ai < 2; ++ai) {
#pragma unroll
            for (int m = 0; m < 4; ++m) { const int rl = wr * 64 + m * 16 + fr;
#pragma unroll
                for (int bj = 0; bj < 2; ++bj)
#pragma unroll
                    for (int n = 0; n < 2; ++n) { const int c = 32 * bj + 8 * wc + 4 * n + fq; *(PG8_LAS f32x4*)(lds + rl * 1024 + ((c ^ (rl & 7)) << 4)) = acc[ai][bj][m][n]; } }
            asm volatile("s_waitcnt lgkmcnt(0)\n\ts_barrier" ::: "memory");
#pragma unroll
            for (int half = 0; half < 2; ++half) {
                u32x2 xo[8];
#pragma unroll
                for (int k = 0; k < 8; ++k) { const int rl = wid + 8 * (half * 8 + k); xo[k] = *(const PG8_G u32x2*)(xb + (size_t)(u.pm * BM + ai * HALF + rl) * 1024 + colg); }
#pragma unroll
                for (int k = 0; k < 8; ++k) { const int rl = wid + 8 * (half * 8 + k); const int row = u.pm * BM + ai * HALF + rl;
                    f32x4 t = *(const PG8_LAS f32x4*)(lds + rl * 1024 + ((lane ^ (rl & 7)) << 4));
                    if (HOOKED) { float rA, rB, rC; group_r(row, rA, rB, rC); t = t * rC; }
                    const f32x4 xs = {__uint_as_float(xo[k].x << 16), __uint_as_float(xo[k].x & 0xffff0000u), __uint_as_float(xo[k].y << 16), __uint_as_float(xo[k].y & 0xffff0000u)};
                    const f32x4 xn = xs * igv + gv * t;
                    if (!gs) *(PG8_G f32x4*)(fout + (size_t)row * 1024 + colg) = xn;
                    if (gs) { const f32x4 y = xn * gsv; u32x2 w; w.x = cvt_pk_bf16(y[0], y[1]); w.y = cvt_pk_bf16(y[2], y[3]); *(PG8_G u32x2*)(xb + (size_t)row * 1024 + colg) = w; }
                    float ss = sq4(xn);
                    ss = wave_sum_dpp(ss);
                    if (gs && lane == 0) *(PG8_G f32x4*)(ssq_out + (size_t)row * 16 + 4 * u.pn) = (f32x4){ss, 0.f, 0.f, 0.f};
                }
            }
            asm volatile("s_waitcnt lgkmcnt(0)\n\ts_barrier" ::: "memory");
        }
    }
};

struct EpiIn {
    static constexpr bool PERM = true, AFTER_DRAIN = false, HOOK = false;
    PG8_G unsigned char* ws; const PG8_G float* gq; const PG8_G float* gk; const PG8_G float* bias;
    __device__ __forceinline__ void hook(f32x4 (&)[2][2][4][2], const Unit&, int, int, int, int, int) const {}
    __device__ __forceinline__ void operator()(const f32x4 (&acc)[2][2][4][2], const Unit& u, int wr, int wc, int fr, int fq) const {
        const int slot = u.pn * 4 + wc;
        if (slot == 7 || slot >= 30) return;
        const int b = u.pm >> 5;
        const PG8_G float* ssqx = (const PG8_G float*)(ws + WS_SSQX);
        PG8_G PG8_G bf16_t* dst = nullptr; int pitch = 0, col0 = 0; int kind = 0;
        PG8_G PG8_G float* ssqd = nullptr; int ssqp = 0, ssqi = 0; const PG8_G float* gain = nullptr; float scale = 1.0f;
        if (slot < 4)       { dst = (PG8_G bf16_t*)(ws + WS_CQ);  pitch = 256; col0 = 64 * slot;        kind = 1; ssqd = (PG8_G float*)(ws + WS_SSQC);  ssqp = 4; ssqi = slot; }
        else if (slot < 6)  { dst = (PG8_G bf16_t*)(ws + WS_CKV); pitch = 128; col0 = 64 * (slot - 4);  kind = 1; ssqd = (PG8_G float*)(ws + WS_SSQC) + (size_t)MROWS_ * 4; ssqp = 2; ssqi = slot - 4; }
        else if (slot == 6) { kind = 3; }
        else if (slot < 14) { dst = (PG8_G bf16_t*)(ws + WS_QS);  pitch = 384; col0 = 64 * (slot - 8);  kind = 2; gain = gq; scale = 0.125f * LOG2E; }
        else if (slot < 16) { dst = (PG8_G bf16_t*)(ws + WS_KS);  pitch = 128; col0 = 64 * (slot - 14); kind = 2; gain = gk; }
        else if (slot < 18) { dst = (PG8_G bf16_t*)(ws + WS_VS);  pitch = 128; col0 = 64 * (slot - 16); }
        else if (slot < 22) { dst = (PG8_G bf16_t*)(ws + WS_QC);  pitch = 256; col0 = 64 * (slot - 18); scale = 0.125f * LOG2E; }
        else if (slot < 26) { dst = (PG8_G bf16_t*)(ws + WS_KC);  pitch = 256; col0 = 64 * (slot - 22); }
        else                { dst = (PG8_G bf16_t*)(ws + WS_VC);  pitch = 256; col0 = 64 * (slot - 26); }
        const PG8_G float* bb = bias + b * 2048 + u.pn * BM + wc * 32 + 8 * fq;
        f32x4 bv[2][2], gn[2][2];
#pragma unroll
        for (int bj = 0; bj < 2; ++bj)
#pragma unroll
            for (int n = 0; n < 2; ++n) { bv[bj][n] = *(const PG8_G f32x4*)(bb + bj * HALF + 4 * n);
                gn[bj][n] = (kind == 2) ? *(const PG8_G f32x4*)(gain + 32 * bj + 8 * fq + 4 * n) * scale : (f32x4){scale, scale, scale, scale}; }
#pragma unroll
        for (int ai = 0; ai < 2; ++ai)
#pragma unroll
            for (int m = 0; m < 4; ++m) {
                const int row = u.pm * BM + ai * HALF + wr * 64 + m * 16 + fr;
                const float r = 1.0f / sqrtf(sum16f(ssqx + (size_t)row * 16) * (1.0f / 1024.0f) + RMS_EPS);
                f32x4 v[2][2]; float ss = 0.f;
#pragma unroll
                for (int bj = 0; bj < 2; ++bj)
#pragma unroll
                    for (int n = 0; n < 2; ++n) { v[bj][n] = acc[ai][bj][m][n] * r + bv[bj][n]; ss += sq4(v[bj][n]); }
                if (kind == 3) {
                    float s0 = sq4(v[0][0]) + sq4(v[0][1]);
                    s0 = xsum32(xsum16(s0));
                    *(PG8_G f32x4*)((PG8_G float*)(ws + WS_KPE) + (size_t)row * 32 + 8 * fq) = v[0][0]; *(PG8_G f32x4*)((PG8_G float*)(ws + WS_KPE) + (size_t)row * 32 + 8 * fq + 4) = v[0][1];
                    if (fq == 0) ((PG8_G float*)(ws + WS_SSQC) + (size_t)MROWS_ * 6)[row] = s0;
                } else {
                    if (kind != 0) { ss = xsum32(xsum16(ss)); }
                    float rn = 1.0f;
                    if (kind == 2) rn = 1.0f / sqrtf(ss * (1.0f / 64.0f) + RMS_EPS);
                    if (kind == 1 && fq == 0) ssqd[(size_t)row * ssqp + ssqi] = ss;
#pragma unroll
                    for (int bj = 0; bj < 2; ++bj) {
                        const f32x4 y0 = v[bj][0] * gn[bj][0] * rn, y1 = v[bj][1] * gn[bj][1] * rn;
                        u32x4 w; w.x = cvt_pk_bf16(y0[0], y0[1]); w.y = cvt_pk_bf16(y0[2], y0[3]); w.z = cvt_pk_bf16(y1[0], y1[1]); w.w = cvt_pk_bf16(y1[2], y1[3]);
                        *(PG8_G u32x4*)(dst + (size_t)row * pitch + col0 + 32 * bj + 8 * fq) = w;
                    }
                }
                if (m & 1) PG8_FENCE();
            }
    }
};

struct EpiUq {
    static constexpr bool PERM = false, AFTER_DRAIN = false, HOOK = false;
    PG8_G unsigned char* ws;
    __device__ __forceinline__ void hook(f32x4 (&)[2][2][4][2], const Unit&, int, int, int, int, int) const {}
    __device__ __forceinline__ void operator()(const f32x4 (&acc)[2][2][4][2], const Unit& u, int wr, int wc, int fr, int fq) const {
        PG8_G bf16_t* QRAW = (PG8_G bf16_t*)(ws + WS_QRAW); const PG8_G float* ssqcq = (const PG8_G float*)(ws + WS_SSQC);
        const int col0 = u.pn * BM + wc * 32 + 4 * fq;
#pragma unroll
        for (int ai = 0; ai < 2; ++ai)
#pragma unroll
            for (int m = 0; m < 4; ++m) {
                const int row = u.pm * BM + ai * HALF + wr * 64 + m * 16 + fr;
                const f32x4 s = *(const PG8_G f32x4*)(ssqcq + (size_t)row * 4);
                const float r = 1.0f / sqrtf(((s[0] + s[1]) + (s[2] + s[3])) * (1.0f / 256.0f) + RMS_EPS);
#pragma unroll
                for (int bj = 0; bj < 2; ++bj)
#pragma unroll
                    for (int n = 0; n < 2; ++n) { const int c = col0 + bj * HALF + n * 16; if (c < 576) { const f32x4 y = acc[ai][bj][m][n] * r; u32x2 w; w.x = cvt_pk_bf16(y[0], y[1]); w.y = cvt_pk_bf16(y[2], y[3]); *(PG8_G u32x2*)(QRAW + (size_t)row * 576 + c) = w; } }
            }
    }
};

struct EpiUkv {
    static constexpr bool PERM = true, AFTER_DRAIN = false, HOOK = false;
    PG8_G unsigned char* ws; const PG8_G float* gk;
    __device__ __forceinline__ void hook(f32x4 (&)[2][2][4][2], const Unit&, int, int, int, int, int) const {}
    __device__ __forceinline__ void operator()(const f32x4 (&acc)[2][2][4][2], const Unit& u, int wr, int wc, int fr, int fq) const {
        PG8_G bf16_t* KA = (PG8_G bf16_t*)(ws + WS_KA); PG8_G bf16_t* VA = (PG8_G bf16_t*)(ws + WS_VA); const PG8_G float* ssqckv = (const PG8_G float*)(ws + WS_SSQC) + (size_t)MROWS_ * 4; const PG8_G float* ssqkpe = (const PG8_G float*)(ws + WS_SSQC) + (size_t)MROWS_ * 6;
        const PG8_G float* kpe = (const PG8_G float*)(ws + WS_KPE); const PG8_G float* cs = (const PG8_G float*)(ws + WS_CS);
        const int h = 2 * u.pn + (wc >> 1); const bool isv = (wc & 1) != 0;
        f32x4 gn[2][2], g1 = {1.f, 1.f, 1.f, 1.f}, g2 = {1.f, 1.f, 1.f, 1.f};
        if (!isv) {
#pragma unroll
            for (int bj = 0; bj < 2; ++bj)
#pragma unroll
                for (int n = 0; n < 2; ++n) gn[bj][n] = *(const PG8_G f32x4*)(gk + 32 * bj + 8 * fq + 4 * n);
            g1 = *(const PG8_G f32x4*)(gk + 64 + 4 * fq); g2 = *(const PG8_G f32x4*)(gk + 80 + 4 * fq);
        }
#pragma unroll
        for (int ai = 0; ai < 2; ++ai)
#pragma unroll
            for (int m = 0; m < 4; ++m) {
                const int row = u.pm * BM + ai * HALF + wr * 64 + m * 16 + fr;
                const float r = 1.0f / sqrtf((ssqckv[(size_t)row * 2] + ssqckv[(size_t)row * 2 + 1]) * (1.0f / 128.0f) + RMS_EPS);
                f32x4 v[2][2]; float ss = 0.f;
#pragma unroll
                for (int bj = 0; bj < 2; ++bj)
#pragma unroll
                    for (int n = 0; n < 2; ++n) { v[bj][n] = acc[ai][bj][m][n] * r; ss += sq4(v[bj][n]); }
                if (isv) {
#pragma unroll
                    for (int bj = 0; bj < 2; ++bj) { u32x4 w; w.x = cvt_pk_bf16(v[bj][0][0], v[bj][0][1]); w.y = cvt_pk_bf16(v[bj][0][2], v[bj][0][3]); w.z = cvt_pk_bf16(v[bj][1][0], v[bj][1][1]); w.w = cvt_pk_bf16(v[bj][1][2], v[bj][1][3]);
                        *(PG8_G u32x4*)(VA + ((size_t)(row >> 6) * 6 + h) * 4096 + bj * 2048 + (row & 63) * 32 + 8 * fq) = w; }
                } else {
                    ss = xsum32(xsum16(ss));
                    const float rk = 1.0f / sqrtf((ss + ssqkpe[row]) * (1.0f / 96.0f) + RMS_EPS);
                    PG8_G bf16_t* kd = KA + ((size_t)(row >> 6) * 6 + h) * 6144 + (row & 63) * 8;
#pragma unroll
                    for (int bj = 0; bj < 2; ++bj) { const f32x4 y0 = v[bj][0] * gn[bj][0] * rk, y1 = v[bj][1] * gn[bj][1] * rk;
                        u32x4 w; w.x = cvt_pk_bf16(y0[0], y0[1]); w.y = cvt_pk_bf16(y0[2], y0[3]); w.z = cvt_pk_bf16(y1[0], y1[1]); w.w = cvt_pk_bf16(y1[2], y1[3]);
                        *(PG8_G u32x4*)(kd + (4 * bj + fq) * 512) = w; }
                    const f32x4 x1 = *(const PG8_G f32x4*)(kpe + (size_t)row * 32 + 4 * fq) * g1 * rk, x2 = *(const PG8_G f32x4*)(kpe + (size_t)row * 32 + 16 + 4 * fq) * g2 * rk;
                    const f32x4 c = *(const PG8_G f32x4*)(cs + (size_t)row * 32 + 4 * fq), s = *(const PG8_G f32x4*)(cs + (size_t)row * 32 + 16 + 4 * fq);
                    const f32x4 o1 = x1 * c - x2 * s, o2 = x2 * c + x1 * s;
                    u32x2 w1, w2; w1.x = cvt_pk_bf16(o1[0], o1[1]); w1.y = cvt_pk_bf16(o1[2], o1[3]); w2.x = cvt_pk_bf16(o2[0], o2[1]); w2.y = cvt_pk_bf16(o2[2], o2[3]);
                    *(PG8_G u32x2*)(kd + (8 + (fq >> 1)) * 512 + (fq & 1) * 4) = w1; *(PG8_G u32x2*)(kd + (10 + (fq >> 1)) * 512 + (fq & 1) * 4) = w2;
                }
                if (m & 1) PG8_FENCE();
            }
    }
};
}
#define GAS __attribute__((address_space(1)))
#define LAS __attribute__((address_space(3)))
typedef unsigned short bf16;
typedef unsigned v4u __attribute__((ext_vector_type(4)));
typedef float f32x4 __attribute__((ext_vector_type(4)));
typedef short bf16x8 __attribute__((ext_vector_type(8)));
typedef GAS unsigned gu32;
typedef GAS unsigned long long gu64;
#define RLX_AGENT __ATOMIC_RELAXED, __HIP_MEMORY_SCOPE_AGENT
#define LDS_WAIT() asm volatile("s_waitcnt lgkmcnt(0)" ::: "memory")
#define VM_WAIT() asm volatile("s_waitcnt vmcnt(0)" ::: "memory")
__device__ __forceinline__ unsigned long long rt() { return __builtin_amdgcn_s_memrealtime(); }
__device__ __forceinline__ unsigned f2bf(float f) { unsigned u = __builtin_bit_cast(unsigned, f); return (u + 0x7fffu + ((u >> 16) & 1u)) >> 16; }
__device__ __forceinline__ unsigned pk2(float lo, float hi) { return f2bf(lo) | (f2bf(hi) << 16); }

#define XB_TMO      128
#define XB_XCNT(j)  (256  + 64 * (j))
#define XB_XSUB(j)  (1280 + 64 * (j))
#define XB_XGEN(j)  (2304 + 64 * (j))
#define XB_TOP      3328
#define XB_TOPGEN   3392
#define XCD_BAR_WORDS 3456
#define XB_SPIN_CAP (1u << 18)

__device__ __forceinline__ unsigned xb_ld(unsigned* p)              { return __hip_atomic_load(p, __ATOMIC_RELAXED, __HIP_MEMORY_SCOPE_AGENT); }
__device__ __forceinline__ unsigned xb_add(unsigned* p, unsigned v) { return __hip_atomic_fetch_add(p, v, __ATOMIC_RELAXED, __HIP_MEMORY_SCOPE_AGENT); }
__device__ __forceinline__ unsigned xb_xcc_id() { return (unsigned)__builtin_amdgcn_s_getreg((3 << 11) | 20) & 0xFu; }
#define XB_SPIN(cond, bar) do { unsigned _sp = 0; while (cond) { __builtin_amdgcn_s_sleep(1); \
    if ((++_sp & 255u) == 0u) { if (xb_ld(&(bar)[XB_TMO])) break; if (_sp > XB_SPIN_CAP) { atomicAdd(&(bar)[XB_TMO], 1u); break; } } } } while (0)

struct XcdBarrier {
    unsigned* bar; unsigned x;
    volatile LAS unsigned* st;
    int w0;
};

__device__ __forceinline__ XcdBarrier xcd_barrier_post(unsigned* bar, volatile LAS unsigned* st, int w0) {
    XcdBarrier b; b.bar = bar; b.x = xb_xcc_id(); b.st = st; b.w0 = w0;
    if (w0 == 0 && hw_lane() == 0) (void)xb_add(&bar[XB_XCNT(b.x)], 1u);
    return b;
}
__device__ __forceinline__ void xcd_barrier_complete(unsigned* bar, unsigned x, unsigned& nloc, unsigned& nx) {
    const unsigned G = gridDim.x * gridDim.y * gridDim.z;
    unsigned sum, cnt, mine, sp = 0u;
    for (;;) {
        sum = 0u; cnt = 0u; mine = 0u;
#pragma unroll
        for (unsigned j = 0; j < 16; ++j) { const unsigned c = xb_ld(&bar[XB_XCNT(j)]); sum += c; cnt += (c > 0u) ? 1u : 0u; mine = (j == x) ? c : mine; }
        if (sum == G) break;
        __builtin_amdgcn_s_sleep(1);
        if ((++sp & 255u) == 0u) { if (xb_ld(&bar[XB_TMO])) break; if (sp > XB_SPIN_CAP) { atomicAdd(&bar[XB_TMO], 1u); break; } }
    }
    nloc = mine > 0u ? mine : 1u; nx = cnt > 0u ? cnt : 1u;
}

__device__ __forceinline__ void xcd_barrier(const XcdBarrier& b) {
    asm volatile("s_waitcnt vmcnt(0)" ::: "memory");
    __syncthreads();
    if (b.w0 == 0 && hw_lane() == 0) {
        unsigned* bar = b.bar;
        __builtin_amdgcn_s_waitcnt(0);
        unsigned nloc = b.st[0], nx = b.st[1];
        if (nloc == 0u) { xcd_barrier_complete(bar, b.x, nloc, nx); b.st[0] = nloc; b.st[1] = nx; }
        const unsigned old = xb_add(&bar[XB_XSUB(b.x)], 1u);
        const unsigned gen = old / nloc;
        if (old + 1u == (gen + 1u) * nloc) {
            __builtin_amdgcn_fence(__ATOMIC_RELEASE, "agent");
            asm volatile("s_waitcnt vmcnt(0)" ::: "memory");
            const unsigned og = xb_add(&bar[XB_TOP], 1u);
            const unsigned tg = og / nx;
            if (og + 1u == (tg + 1u) * nx) xb_add(&bar[XB_TOPGEN], 1u);
            else XB_SPIN(xb_ld(&bar[XB_TOPGEN]) == tg, bar);
            __builtin_amdgcn_fence(__ATOMIC_ACQUIRE, "agent");
            xb_add(&bar[XB_XGEN(b.x)], 1u);
            asm volatile("s_waitcnt vmcnt(0)" ::: "memory");
        } else {
            XB_SPIN(xb_ld(&bar[XB_XGEN(b.x)]) == gen, bar);
            __builtin_amdgcn_fence(__ATOMIC_ACQUIRE, "agent");
            asm volatile("s_waitcnt vmcnt(0)" ::: "memory");
        }
    }
    __syncthreads();
}
namespace att {
typedef unsigned short bf16_t;
typedef short bf16x8 __attribute__((ext_vector_type(8)));
typedef short s16x4 __attribute__((ext_vector_type(4)));
typedef short v4i16_t __attribute__((ext_vector_type(4)));
typedef float f32x16 __attribute__((ext_vector_type(16)));
typedef float f32x4 __attribute__((ext_vector_type(4)));
typedef float f32x2 __attribute__((ext_vector_type(2)));
typedef __bf16 bf16x2_t __attribute__((ext_vector_type(2)));
typedef unsigned u32x4 __attribute__((ext_vector_type(4)));
typedef int i32x4 __attribute__((ext_vector_type(4)));
#define ALAS __attribute__((address_space(3)))
#define AGAS __attribute__((address_space(1)))
constexpr int SEQ = 8192;
constexpr float LOG2E = 1.4426950408889634f, EPS = 1e-6f;
constexpr int KCS = 1040, VHS = 4160;
constexpr int KSLOT = 12 * KCS, VSLOT = 2 * VHS;
constexpr int L_K = 0, L_V = 3 * KSLOT, L_POS = L_V + 4 * VSLOT, L_TB = L_POS + 1024, L_WSF = L_TB + 128, L_OST = L_WSF + 8 * 256, L_FLAG = L_OST + 8 * 4096, L_END = L_FLAG + 16 + 64;
static_assert(L_OST % 16 == 0 && L_V % 16 == 0 && L_END <= 131072, "attention LDS map");
constexpr int S1_KS = 8 * KCS, S1_K = 0, S1_V = 7 * S1_KS, S1_P = S1_V + 7 * VSLOT, S1_LUT = S1_P + 7 * 256, S1_WSF = S1_LUT + 528, S1_END = S1_WSF + 8 * 256;
static_assert(S1_END <= L_FLAG || S1_END <= 131072, "sliding-window LDS map"); static_assert(S1_V % 16 == 0 && S1_WSF % 16 == 0 && S1_END <= 131072, "sliding-window LDS map");

__device__ __forceinline__ int crow(int r, int hi) { return (r & 3) + 8 * (r >> 2) + 4 * hi; }
__device__ __forceinline__ unsigned cvtpk(float lo, float hi) { f32x2 v = {lo, hi}; bf16x2_t b = __builtin_convertvector(v, bf16x2_t); return __builtin_bit_cast(unsigned, b); }
__device__ __forceinline__ s16x4 vtr(const ALAS unsigned char* p) { return __builtin_bit_cast(s16x4, __builtin_amdgcn_ds_read_tr16_b64_v4i16((ALAS v4i16_t*)p)); }
__device__ __forceinline__ float swap_sum(float x) { auto rr = __builtin_amdgcn_permlane32_swap(__float_as_uint(x), __float_as_uint(x), false, false); return __uint_as_float(rr[0]) + __uint_as_float(rr[1]); }
__device__ __forceinline__ float swap_max(float x) { auto rr = __builtin_amdgcn_permlane32_swap(__float_as_uint(x), __float_as_uint(x), false, false); return fmaxf(__uint_as_float(rr[0]), __uint_as_float(rr[1])); }
__device__ __forceinline__ float bf2f(unsigned short h) { return __uint_as_float((unsigned)h << 16); }

__device__ __forceinline__ void glds16(const AGAS void* gsrc, unsigned lds_dst) { unsigned keep;
    asm volatile("s_mov_b32 %0, m0\n\ts_mov_b32 m0, %2\n\ts_nop 0\n\tglobal_load_lds_dwordx4 %1, off\n\ts_mov_b32 m0, %0" : "=&s"(keep) : "v"(gsrc), "s"(lds_dst) : "memory"); }
__device__ __forceinline__ void glds4(const AGAS void* gsrc, unsigned lds_dst) { unsigned keep;
    asm volatile("s_mov_b32 %0, m0\n\ts_mov_b32 m0, %2\n\ts_nop 0\n\tglobal_load_lds_dword %1, off\n\ts_mov_b32 m0, %0" : "=&s"(keep) : "v"(gsrc), "s"(lds_dst) : "memory"); }

struct AttnP {
    AGAS unsigned char* ws;
    const AGAS float* gq;
    const AGAS int* pos; const AGAS float* sinks; const AGAS float* relb;
};
template <int MODE> struct AttnCfg;
template <> struct AttnCfg<0> { static constexpr size_t Q = WS_QRAW, K = WS_KA, V = WS_VA; static constexpr int qpitch = 576, kpitch = 576, khs = 96, vpitch = 384, vhs = 64, ocol0 = 0, hidx0 = 0, group = 1; };
template <> struct AttnCfg<1> { static constexpr size_t Q = WS_QS, K = WS_KS, V = WS_VS; static constexpr int qpitch = 384, kpitch = 128, khs = 64, vpitch = 128, vhs = 64, ocol0 = 384, hidx0 = 6, group = 3; };
template <> struct AttnCfg<2> { static constexpr size_t Q = WS_QC, K = WS_KC, V = WS_VC; static constexpr int qpitch = 256, kpitch = 256, khs = 64, vpitch = 256, vhs = 64, ocol0 = 768, hidx0 = 12, group = 1; };

#ifdef ATT_PROF
#define PROF_T() ((MODE == 0 && blockIdx.x == 0) ? (long long)clock64() : 0ll)
#else
#define PROF_T() 0ll
#endif
template <int DQK, int MODE>
__device__ __forceinline__ void attn_unit(ALAS unsigned char* lds, const AttnP& P, int b, int h, int qb, int wave0, unsigned long long* prof = nullptr) {
    long long pf_qk = 0, pf_sm = 0, pf_pv = 0, pf_wait = 0; const long long pf_t0 = PROF_T();
    constexpr int NCH = DQK / 8, ND0 = DQK / 16;
    int tid_ = wave0 * 64 + hw_lane(); asm volatile("" : "+v"(tid_));
    const int tid = tid_, lane = tid & 63, r32 = lane & 31, hi = lane >> 5;
    const int wid = __builtin_amdgcn_readfirstlane(tid >> 6);
    const int q0 = qb * 256, qlo = q0 + 32 * wid, qhi = qlo + 31, qrow = qlo + r32;
    const size_t rb = (size_t)b * SEQ;
    typedef AttnCfg<MODE> C; const int kvh = h / C::group;
    ALAS float* wsf = (ALAS float*)(lds + (MODE == 1 ? S1_WSF : L_WSF)) + wid * 64;
    ALAS unsigned char* ost = lds + L_OST + wid * 4096;
    ALAS int* posl = (ALAS int*)(lds + L_POS);
    ALAS float* tb = (ALAS float*)(lds + L_TB);

    bf16x8 qf[ND0];
    if constexpr (MODE == 0) {
        const AGAS bf16_t* qp = (const AGAS bf16_t*)(P.ws + C::Q) + (rb + qrow) * 576 + h * 96 + hi * 8;
        float qv[ND0][8]; float ss = 0.f;
#pragma unroll
        for (int d0 = 0; d0 < ND0; ++d0) { const u32x4 w = *(const AGAS u32x4*)(qp + 16 * d0);
#pragma unroll
            for (int i = 0; i < 4; ++i) { const float lo = __uint_as_float(w[i] << 16), hv = __uint_as_float(w[i] & 0xffff0000u); qv[d0][2 * i] = lo; qv[d0][2 * i + 1] = hv; ss += lo * lo + hv * hv; } }
        ss = swap_sum(ss);
        const float rq = 1.0f / sqrtf(ss * (1.0f / 96.0f) + EPS);
#pragma unroll
        for (int d0 = 0; d0 < ND0; ++d0) { const f32x4 ga = *(const AGAS f32x4*)(P.gq + 16 * d0 + 8 * hi), gb = *(const AGAS f32x4*)(P.gq + 16 * d0 + 8 * hi + 4);
#pragma unroll
            for (int i = 0; i < 4; ++i) { qv[d0][i] *= rq * ga[i]; qv[d0][4 + i] *= rq * gb[i]; } }
        {
            const AGAS float* cp = (const AGAS float*)(P.ws + WS_CS) + (rb + qrow) * 32 + 8 * hi;
            const f32x4 c0 = *(const AGAS f32x4*)cp, c1 = *(const AGAS f32x4*)(cp + 4), s0 = *(const AGAS f32x4*)(cp + 16), s1 = *(const AGAS f32x4*)(cp + 20);
#pragma unroll
            for (int i = 0; i < 8; ++i) { const float c = i < 4 ? c0[i & 3] : c1[i & 3], s = i < 4 ? s0[i & 3] : s1[i & 3]; const float x1 = qv[4][i], x2 = qv[5][i]; qv[4][i] = x1 * c - x2 * s; qv[5][i] = x2 * c + x1 * s; }
        }
        const float sc = 0.10206207261596575f * LOG2E;
#pragma unroll
        for (int d0 = 0; d0 < ND0; ++d0) { u32x4 w; w.x = cvtpk(qv[d0][0] * sc, qv[d0][1] * sc); w.y = cvtpk(qv[d0][2] * sc, qv[d0][3] * sc); w.z = cvtpk(qv[d0][4] * sc, qv[d0][5] * sc); w.w = cvtpk(qv[d0][6] * sc, qv[d0][7] * sc); qf[d0] = __builtin_bit_cast(bf16x8, w); }
    } else {
        const AGAS bf16_t* qp = (const AGAS bf16_t*)(P.ws + C::Q) + (rb + qrow) * C::qpitch + h * 64 + hi * 8;
#pragma unroll
        for (int d0 = 0; d0 < ND0; ++d0) qf[d0] = *(const AGAS bf16x8*)(qp + 16 * d0);
    }
    int posq = 0; float sink2 = 0.f;
    if constexpr (MODE == 1) {
        posq = P.pos[rb + qrow]; sink2 = P.sinks[h] * LOG2E;
    }

    int ntile, tfirst, tstep;
    if (MODE == 0) { tfirst = 0; tstep = 1; ntile = ((q0 + 255) >> 6) + 1; }
    else if (MODE == 1) { const int lo = q0 - 127 > 0 ? q0 - 127 : 0; tfirst = lo >> 6; tstep = 1; ntile = ((q0 + 255) >> 6) - tfirst + 1; }
    else { tfirst = (q0 + 254) >> 6; tstep = -1; ntile = tfirst + 1; }

    const AGAS bf16_t* Kg = (const AGAS bf16_t*)(P.ws + C::K) + rb * C::kpitch + kvh * C::khs;
    const AGAS bf16_t* Vg = (const AGAS bf16_t*)(P.ws + C::V) + rb * C::vpitch + kvh * C::vhs;
    const unsigned lds0 = (unsigned)(uintptr_t)lds;
    const AGAS bf16_t* ksrc0 = (MODE == 0) ? (const AGAS bf16_t*)(P.ws + C::K) + ((size_t)b * 128 * 6 + h) * 6144 + wid * 512 + lane * 8 : Kg + (size_t)lane * C::kpitch + 8 * wid;
    const AGAS bf16_t* vsrc = (MODE == 0) ? (const AGAS bf16_t*)(P.ws + C::V) + ((size_t)b * 128 * 6 + h) * 4096 + (wid >> 2) * 2048 + (wid & 3) * 512 + lane * 8
                                          : Vg + (size_t)(16 * (wid & 3) + (lane >> 2)) * C::vpitch + 32 * (wid >> 2) + 8 * (lane & 3);
    constexpr size_t KTS = (MODE == 0) ? (size_t)6 * 6144 : (size_t)64 * C::kpitch, VTS = (MODE == 0) ? (size_t)6 * 4096 : (size_t)64 * C::vpitch, K2O = (MODE == 0) ? 8 * 512 : 64;
    const bool k2 = (wid + 8) < NCH;
    const bool posw = (MODE == 1) && wid == 0;
    const int NP = 2 + (k2 ? 1 : 0) + (posw ? 1 : 0);
#define ATT_ISSUE(T, IT) do { const int T_ = (T); const size_t jo_ = (size_t)T_ * 64; const int ks_ = (IT) % 3, vs_ = (IT) & 3;     \
        glds16(ksrc0 + (size_t)T_ * KTS, (unsigned)__builtin_amdgcn_readfirstlane(lds0 + L_K + ks_ * KSLOT + wid * KCS)); \
        if (k2) glds16(ksrc0 + (size_t)T_ * KTS + K2O, (unsigned)__builtin_amdgcn_readfirstlane(lds0 + L_K + ks_ * KSLOT + (wid + 8) * KCS)); \
        glds16(vsrc + (size_t)T_ * VTS, (unsigned)__builtin_amdgcn_readfirstlane(lds0 + L_V + vs_ * VSLOT + (wid >> 2) * VHS + (wid & 3) * 1024)); \
        if (posw) glds4(P.pos + rb + jo_ + lane, (unsigned)__builtin_amdgcn_readfirstlane(lds0 + L_POS + vs_ * 256)); } while (0)
#define ATT_WAIT_BAR(n_) do { if ((n_) <= 0) asm volatile("s_waitcnt vmcnt(0) lgkmcnt(0)\n\ts_barrier" ::: "memory"); \
        else if (NP == 2) asm volatile("s_waitcnt vmcnt(2) lgkmcnt(0)\n\ts_barrier" ::: "memory"); \
        else if (NP == 3) asm volatile("s_waitcnt vmcnt(3) lgkmcnt(0)\n\ts_barrier" ::: "memory"); \
        else asm volatile("s_waitcnt vmcnt(4) lgkmcnt(0)\n\ts_barrier" ::: "memory"); } while (0)

    f32x16 o0 = {}, o1 = {};
    float mrun = (MODE == 1) ? sink2 : 0.f;
    float lrun = (MODE == 1 && hi == 0) ? 1.0f : 0.f;
    f32x16 negm;
#pragma unroll
    for (int r = 0; r < 16; ++r) negm[r] = (MODE == 2) ? 0.f : -mrun;
    bool first = (MODE == 0);
    float after = 0.f;
    bool walive = true;
    const int vrd = ((lane >> 4) & 1) * 32 + (lane & 3) * 8 + (4 * hi + ((lane & 15) >> 2)) * 64;
    const bool lag = wid >= 4;
    constexpr float THR = 4.0f;

#define ATT_QK(P0, P1, kb) do { int kofs_ = L_K + (kb) * KSLOT + hi * KCS + r32 * 16; asm volatile("" : "+v"(kofs_)); const ALAS unsigned char* Kb_ = lds + kofs_;     \
        bf16x8 kfa_[4], kfb_[4]; \
        _Pragma("unroll") for (int d0 = 0; d0 < 3; ++d0) { kfa_[d0] = *(const ALAS bf16x8*)(Kb_ + 2 * d0 * KCS); kfb_[d0] = *(const ALAS bf16x8*)(Kb_ + 2 * d0 * KCS + 512); } \
        \
        _Pragma("unroll") for (int d0 = 0; d0 < ND0; ++d0) { \
            if (d0 + 3 < ND0) { kfa_[(d0 + 3) & 3] = *(const ALAS bf16x8*)(Kb_ + 2 * (d0 + 3) * KCS); kfb_[(d0 + 3) & 3] = *(const ALAS bf16x8*)(Kb_ + 2 * (d0 + 3) * KCS + 512); } \
            if (d0 == 0) { P0 = __builtin_amdgcn_mfma_f32_32x32x16_bf16(kfa_[0], qf[0], negm, 0, 0, 0); P1 = __builtin_amdgcn_mfma_f32_32x32x16_bf16(kfb_[0], qf[0], negm, 0, 0, 0); } \
            else { P0 = __builtin_amdgcn_mfma_f32_32x32x16_bf16(kfa_[d0 & 3], qf[d0], P0, 0, 0, 0); P1 = __builtin_amdgcn_mfma_f32_32x32x16_bf16(kfb_[d0 & 3], qf[d0], P1, 0, 0, 0); } \
            } } while (0)
#define ATT_VLD(i_, s_) do { vl0_[i_] = vtr(Vb_ + (s_) * 1024); vh0_[i_] = vtr(Vb_ + (s_) * 1024 + 512); vl1_[i_] = vtr(Vb_ + VHS + (s_) * 1024); vh1_[i_] = vtr(Vb_ + VHS + (s_) * 1024 + 512); } while (0)
#define ATT_PV(vb) do { int vofs_ = L_V + (vb) * VSLOT + vrd; asm volatile("" : "+v"(vofs_)); const ALAS unsigned char* Vb_ = lds + vofs_; \
        s16x4 vl0_[2], vh0_[2], vl1_[2], vh1_[2]; ATT_VLD(0, 0); \
        _Pragma("unroll") for (int s_ = 0; s_ < 4; ++s_) { \
            if (s_ + 1 < 4) ATT_VLD((s_ + 1) & 1, s_ + 1); \
            const int i_ = s_ & 1; const bf16x8 pa_ = __builtin_bit_cast(bf16x8, pw[s_]); \
            const bf16x8 v0_ = {vl0_[i_][0], vl0_[i_][1], vl0_[i_][2], vl0_[i_][3], vh0_[i_][0], vh0_[i_][1], vh0_[i_][2], vh0_[i_][3]}, v1_ = {vl1_[i_][0], vl1_[i_][1], vl1_[i_][2], vl1_[i_][3], vh1_[i_][0], vh1_[i_][1], vh1_[i_][2], vh1_[i_][3]}; \
            o0 = __builtin_amdgcn_mfma_f32_32x32x16_bf16(pa_, v0_, o0, 0, 0, 0); o1 = __builtin_amdgcn_mfma_f32_32x32x16_bf16(pa_, v1_, o1, 0, 0, 0); } } while (0)
#define ATT_PACK(P0, P1) do { \
        pw[0].x = cvtpk(P0[0], P0[1]); pw[0].y = cvtpk(P0[2], P0[3]); pw[0].z = cvtpk(P0[4], P0[5]); pw[0].w = cvtpk(P0[6], P0[7]); \
        pw[1].x = cvtpk(P0[8], P0[9]); pw[1].y = cvtpk(P0[10], P0[11]); pw[1].z = cvtpk(P0[12], P0[13]); pw[1].w = cvtpk(P0[14], P0[15]); \
        pw[2].x = cvtpk(P1[0], P1[1]); pw[2].y = cvtpk(P1[2], P1[3]); pw[2].z = cvtpk(P1[4], P1[5]); pw[2].w = cvtpk(P1[6], P1[7]); \
        pw[3].x = cvtpk(P1[8], P1[9]); pw[3].y = cvtpk(P1[10], P1[11]); pw[3].z = cvtpk(P1[12], P1[13]); pw[3].w = cvtpk(P1[14], P1[15]); } while (0)
#define ATT_MAX3(a, b, c) fmaxf(fmaxf((a), (b)), (c))
#define ATT_SM_A(P0, P1, j0_, pslot) do { if constexpr (MODE != 2) { \
            if constexpr (MODE == 1) { \
                _Pragma("unroll") for (int g = 0; g < 4; ++g) { \
                    const i32x4 pa = *(const ALAS i32x4*)(posl + (pslot) * 64 + 8 * g + 4 * hi), pb = *(const ALAS i32x4*)(posl + (pslot) * 64 + 32 + 8 * g + 4 * hi); \
                    _Pragma("unroll") for (int i = 0; i < 4; ++i) { \
                        { int n = posq - pa[i]; n = n > 0 ? n : 0; int bk = n; if (n >= 16) { bk = 16 + (int)((__builtin_amdgcn_logf((float)n) - 4.0f) * (16.0f / 3.0f)); bk = bk < 31 ? bk : 31; } P0[4 * g + i] += tb[bk]; } \
                        { int n = posq - pb[i]; n = n > 0 ? n : 0; int bk = n; if (n >= 16) { bk = 16 + (int)((__builtin_amdgcn_logf((float)n) - 4.0f) * (16.0f / 3.0f)); bk = bk < 31 ? bk : 31; } P1[4 * g + i] += tb[bk]; } } } } \
            const bool nm_ = (MODE == 1) || ((j0_) + 63 > qlo); \
            if (nm_) { \
                _Pragma("unroll") for (int r = 0; r < 16; ++r) { const int key = (j0_) + crow(r, hi); \
                    bool ok0 = key <= qrow, ok1 = key + 32 <= qrow; \
                    if (MODE == 1) { ok0 = ok0 && (key > qrow - 128); ok1 = ok1 && (key + 32 > qrow - 128); } \
                    if (!ok0) P0[r] = -INFINITY; if (!ok1) P1[r] = -INFINITY; } } \
            float ma = ATT_MAX3(P0[0], P0[1], P1[0]), mb = ATT_MAX3(P0[2], P0[3], P1[1]); ma = ATT_MAX3(ma, P1[2], P1[3]); \
            _Pragma("unroll") for (int r = 4; r < 16; r += 4) { ma = ATT_MAX3(ma, P0[r], P0[r + 1]); mb = ATT_MAX3(mb, P0[r + 2], P0[r + 3]); ma = ATT_MAX3(ma, P1[r], P1[r + 1]); mb = ATT_MAX3(mb, P1[r + 2], P1[r + 3]); } \
            const float mt = swap_max(fmaxf(ma, mb)); \
            if (first || __any(mt > THR)) {                                 \
                const float d = first ? mt : fmaxf(mt, 0.f); first = false; \
                _Pragma("unroll") for (int r = 0; r < 16; ++r) { P0[r] -= d; P1[r] -= d; } \
                const float alpha = __builtin_amdgcn_exp2f(-d); mrun += d; lrun *= alpha; \
                _Pragma("unroll") for (int r = 0; r < 16; ++r) negm[r] = -mrun; \
                if (hi == 0) wsf[r32] = alpha; \
                _Pragma("unroll") for (int g = 0; g < 4; ++g) { const f32x4 al = *(const ALAS f32x4*)(wsf + 8 * g + 4 * hi); \
                    _Pragma("unroll") for (int i = 0; i < 4; ++i) { o0[4 * g + i] *= al[i]; o1[4 * g + i] *= al[i]; } } } } } while (0)
#define ATT_SM_B(P0, P1, j0_) do { \
        if constexpr (MODE == 2) { \
            const bool nm_ = (j0_) + 63 >= qlo; \
            float ln0[16], ln1[16]; \
            _Pragma("unroll") for (int r = 0; r < 16; ++r) { const int key = (j0_) + crow(r, hi); \
                { const float z = P0[r]; const float sp = fmaxf(z, 0.f) + __builtin_amdgcn_logf(1.0f + __builtin_amdgcn_exp2f(-fabsf(z))); const bool ok = !nm_ || key < qrow; ln0[r] = ok ? -sp : 0.f; P0[r] = ok ? z - sp : -INFINITY; } \
                { const float z = P1[r]; const float sp = fmaxf(z, 0.f) + __builtin_amdgcn_logf(1.0f + __builtin_amdgcn_exp2f(-fabsf(z))); const bool ok = !nm_ || key + 32 < qrow; ln1[r] = ok ? -sp : 0.f; P1[r] = ok ? z - sp : -INFINITY; } } \
            float run = after; \
            _Pragma("unroll") for (int blk = 1; blk >= 0; --blk) _Pragma("unroll") for (int g = 3; g >= 0; --g) { \
                const float own = blk ? ((ln1[4 * g] + ln1[4 * g + 1]) + (ln1[4 * g + 2] + ln1[4 * g + 3])) : ((ln0[4 * g] + ln0[4 * g + 1]) + (ln0[4 * g + 2] + ln0[4 * g + 3])); \
                auto rr = __builtin_amdgcn_permlane32_swap(__float_as_uint(own), __float_as_uint(own), false, false); \
                const float slo = __uint_as_float(rr[0]), shi = __uint_as_float(rr[1]); \
                const float e1 = run; run += shi; const float e0 = run; run += slo; \
                float aft = hi ? e1 : e0; \
                _Pragma("unroll") for (int i = 3; i >= 0; --i) { const int r = 4 * g + i; \
                    if (blk) { P1[r] = __builtin_amdgcn_exp2f(P1[r] + aft); aft += ln1[r]; } else { P0[r] = __builtin_amdgcn_exp2f(P0[r] + aft); aft += ln0[r]; } } } \
            after = run; walive = __any(after > -160.0f); \
        } else { \
            float ls = 0.f; \
            _Pragma("unroll") for (int r = 0; r < 16; ++r) { P0[r] = __builtin_amdgcn_exp2f(P0[r]); P1[r] = __builtin_amdgcn_exp2f(P1[r]); ls += P0[r] + P1[r]; } \
            lrun += ls; } \
        ATT_PACK(P0, P1); } while (0)
#define ATT_WORK(j0_) ((MODE == 0) ? ((j0_) <= qhi) : (MODE == 1) ? (((j0_) <= qhi) && ((j0_) + 63 >= qlo - 127)) : (walive && ((j0_) < qhi)))

    if constexpr (MODE == 0) {
    f32x16 p0, p1, n0, n1; u32x4 pw[4];
    __syncthreads();
    int issued = 0;
    ATT_ISSUE(0, 0);
    if (ntile > 1) { ATT_ISSUE(1, 1); issued = 1; }
    if (ntile > 2) { ATT_ISSUE(2, 2); issued = 2; }
    ATT_WAIT_BAR(issued - 1);
    const int tmax = qhi >> 6;
#define MLA_SB() __builtin_amdgcn_sched_barrier(0)
#define MLA_EX(v) __builtin_amdgcn_exp2f(v)
#define MLA_DECIDE(X0, X1, j0_) do { \
        if ((j0_) + 63 > qlo) { _Pragma("unroll") for (int r = 0; r < 16; ++r) { const int key = (j0_) + crow(r, hi); if (key > qrow) X0[r] = -INFINITY; if (key + 32 > qrow) X1[r] = -INFINITY; } } \
        float ma = ATT_MAX3(X0[0], X0[1], X1[0]), mb = ATT_MAX3(X0[2], X0[3], X1[1]); ma = ATT_MAX3(ma, X1[2], X1[3]); \
        _Pragma("unroll") for (int r = 4; r < 16; r += 4) { ma = ATT_MAX3(ma, X0[r], X0[r + 1]); mb = ATT_MAX3(mb, X0[r + 2], X0[r + 3]); ma = ATT_MAX3(ma, X1[r], X1[r + 1]); mb = ATT_MAX3(mb, X1[r + 2], X1[r + 3]); } \
        const float mt = swap_max(fmaxf(ma, mb)); resc = false; \
        if (first || __any(mt > THR)) { const float d = first ? mt : fmaxf(mt, 0.f); first = false; \
            _Pragma("unroll") for (int r = 0; r < 16; ++r) { X0[r] -= d; X1[r] -= d; } \
            const float alpha = __builtin_amdgcn_exp2f(-d); lrun *= alpha; const float nm_ = negm[0] - d;     \
            _Pragma("unroll") for (int r = 0; r < 16; ++r) negm[r] = nm_; \
            if (hi == 0) wsf[r32] = alpha; resc = true; } } while (0)
#define MLA_RESC() do { if (resc) { _Pragma("unroll") for (int g = 0; g < 4; ++g) { const f32x4 al = *(const ALAS f32x4*)(wsf + 8 * g + 4 * hi); \
            _Pragma("unroll") for (int i = 0; i < 4; ++i) { o0[4 * g + i] *= al[i]; o1[4 * g + i] *= al[i]; } } } } while (0)
#define MLA_PV_(i) (i < 16 ? C0[(i) & 15] : C1[(i) & 15])
#define MLA_GA(MF, g, C0, C1) do { MF; \
        if (3 * (g) < 32) sacc += (3 * (g) < 16 ? C0[(3 * (g)) & 15] : C1[(3 * (g)) & 15]); \
        if (3 * (g) + 1 < 32) sacc += (3 * (g) + 1 < 16 ? C0[(3 * (g) + 1) & 15] : C1[(3 * (g) + 1) & 15]); \
        if (3 * (g) + 2 < 32) sacc += (3 * (g) + 2 < 16 ? C0[(3 * (g) + 2) & 15] : C1[(3 * (g) + 2) & 15]); \
        if ((g) < 4) { pw[((g) >> 1) & 3][2 * ((g) & 1)] = cvtpk(C0[4 * (g)], C0[4 * (g) + 1]); pw[((g) >> 1) & 3][2 * ((g) & 1) + 1] = cvtpk(C0[4 * (g) + 2], C0[4 * (g) + 3]); } \
        else if ((g) < 8) { pw[((g) >> 1) & 3][2 * ((g) & 1)] = cvtpk(C1[4 * ((g) - 4)], C1[4 * ((g) - 4) + 1]); pw[((g) >> 1) & 3][2 * ((g) & 1) + 1] = cvtpk(C1[4 * ((g) - 4) + 2], C1[4 * ((g) - 4) + 3]); } } while (0)
#define MLA_VF(lo_, hi_) (bf16x8){lo_[0], lo_[1], lo_[2], lo_[3], hi_[0], hi_[1], hi_[2], hi_[3]}
#define MLA_GB(MF, X, b_) do { MF; X[(b_)] = MLA_EX(X[(b_)]); X[(b_) + 1] = MLA_EX(X[(b_) + 1]); X[(b_) + 2] = MLA_EX(X[(b_) + 2]); X[(b_) + 3] = MLA_EX(X[(b_) + 3]); } while (0)
#define MLA_FULL(C0, C1, N0, N1, t_) do { \
        int kofs_ = L_K + (((t_) + 1) % 3) * KSLOT + hi * KCS + r32 * 16; asm volatile("" : "+v"(kofs_)); const ALAS unsigned char* Kb_ = lds + kofs_; \
        int vofs_ = L_V + ((t_) & 3) * VSLOT + vrd; asm volatile("" : "+v"(vofs_)); const ALAS unsigned char* Vb_ = lds + vofs_; \
        bf16x8 ka0 = *(const ALAS bf16x8*)(Kb_), kb0 = *(const ALAS bf16x8*)(Kb_ + 512), ka1 = *(const ALAS bf16x8*)(Kb_ + 2 * KCS), kb1 = *(const ALAS bf16x8*)(Kb_ + 2 * KCS + 512), ka2, kb2; \
        s16x4 vl0a, vh0a, vl1a, vh1a, vl0b, vh0b, vl1b, vh1b; float sacc = 0.f; \
        MLA_SB(); \
        MLA_GA(N0 = __builtin_amdgcn_mfma_f32_32x32x16_bf16(ka0, qf[0], negm, 0, 0, 0), 0, C0, C1); ka2 = *(const ALAS bf16x8*)(Kb_ + 4 * KCS); MLA_SB(); \
        MLA_GA(N1 = __builtin_amdgcn_mfma_f32_32x32x16_bf16(kb0, qf[0], negm, 0, 0, 0), 1, C0, C1); kb2 = *(const ALAS bf16x8*)(Kb_ + 4 * KCS + 512); MLA_SB(); \
        MLA_GA(N0 = __builtin_amdgcn_mfma_f32_32x32x16_bf16(ka1, qf[1], N0, 0, 0, 0), 2, C0, C1); ka0 = *(const ALAS bf16x8*)(Kb_ + 6 * KCS); MLA_SB(); \
        MLA_GA(N1 = __builtin_amdgcn_mfma_f32_32x32x16_bf16(kb1, qf[1], N1, 0, 0, 0), 3, C0, C1); kb0 = *(const ALAS bf16x8*)(Kb_ + 6 * KCS + 512); MLA_SB(); \
        MLA_GA(N0 = __builtin_amdgcn_mfma_f32_32x32x16_bf16(ka2, qf[2], N0, 0, 0, 0), 4, C0, C1); ka1 = *(const ALAS bf16x8*)(Kb_ + 8 * KCS); MLA_SB(); \
        MLA_GA(N1 = __builtin_amdgcn_mfma_f32_32x32x16_bf16(kb2, qf[2], N1, 0, 0, 0), 5, C0, C1); kb1 = *(const ALAS bf16x8*)(Kb_ + 8 * KCS + 512); MLA_SB(); \
        MLA_GA(N0 = __builtin_amdgcn_mfma_f32_32x32x16_bf16(ka0, qf[3], N0, 0, 0, 0), 6, C0, C1); ka2 = *(const ALAS bf16x8*)(Kb_ + 10 * KCS); MLA_SB(); \
        MLA_GA(N1 = __builtin_amdgcn_mfma_f32_32x32x16_bf16(kb0, qf[3], N1, 0, 0, 0), 7, C0, C1); kb2 = *(const ALAS bf16x8*)(Kb_ + 10 * KCS + 512); MLA_SB(); \
        MLA_GA(N0 = __builtin_amdgcn_mfma_f32_32x32x16_bf16(ka1, qf[4], N0, 0, 0, 0), 8, C0, C1); MLA_SB(); \
        MLA_GA(N1 = __builtin_amdgcn_mfma_f32_32x32x16_bf16(kb1, qf[4], N1, 0, 0, 0), 9, C0, C1); MLA_SB(); \
        MLA_GA(N0 = __builtin_amdgcn_mfma_f32_32x32x16_bf16(ka2, qf[5], N0, 0, 0, 0), 10, C0, C1); vl0a = vtr(Vb_); vh0a = vtr(Vb_ + 512); MLA_SB(); \
        MLA_GA(N1 = __builtin_amdgcn_mfma_f32_32x32x16_bf16(kb2, qf[5], N1, 0, 0, 0), 11, C0, C1); vl1a = vtr(Vb_ + VHS); vh1a = vtr(Vb_ + VHS + 512); MLA_SB(); \
        lrun += sacc; \
        MLA_DECIDE(N0, N1, ((t_) + 1) * 64); \
        MLA_SB(); \
        MLA_GB(o0 = __builtin_amdgcn_mfma_f32_32x32x16_bf16(__builtin_bit_cast(bf16x8, pw[0]), MLA_VF(vl0a, vh0a), o0, 0, 0, 0), N0, 0); vl0b = vtr(Vb_ + 1024); vh0b = vtr(Vb_ + 1024 + 512); MLA_SB(); \
        MLA_GB(o1 = __builtin_amdgcn_mfma_f32_32x32x16_bf16(__builtin_bit_cast(bf16x8, pw[0]), MLA_VF(vl1a, vh1a), o1, 0, 0, 0), N0, 4); vl1b = vtr(Vb_ + VHS + 1024); vh1b = vtr(Vb_ + VHS + 1024 + 512); MLA_SB(); \
        MLA_GB(o0 = __builtin_amdgcn_mfma_f32_32x32x16_bf16(__builtin_bit_cast(bf16x8, pw[1]), MLA_VF(vl0b, vh0b), o0, 0, 0, 0), N0, 8); vl0a = vtr(Vb_ + 2048); vh0a = vtr(Vb_ + 2048 + 512); MLA_SB(); \
        MLA_GB(o1 = __builtin_amdgcn_mfma_f32_32x32x16_bf16(__builtin_bit_cast(bf16x8, pw[1]), MLA_VF(vl1b, vh1b), o1, 0, 0, 0), N0, 12); vl1a = vtr(Vb_ + VHS + 2048); vh1a = vtr(Vb_ + VHS + 2048 + 512); MLA_SB(); \
        MLA_GB(o0 = __builtin_amdgcn_mfma_f32_32x32x16_bf16(__builtin_bit_cast(bf16x8, pw[2]), MLA_VF(vl0a, vh0a), o0, 0, 0, 0), N1, 0); vl0b = vtr(Vb_ + 3072); vh0b = vtr(Vb_ + 3072 + 512); MLA_SB(); \
        MLA_GB(o1 = __builtin_amdgcn_mfma_f32_32x32x16_bf16(__builtin_bit_cast(bf16x8, pw[2]), MLA_VF(vl1a, vh1a), o1, 0, 0, 0), N1, 4); vl1b = vtr(Vb_ + VHS + 3072); vh1b = vtr(Vb_ + VHS + 3072 + 512); MLA_SB(); \
        MLA_GB(o0 = __builtin_amdgcn_mfma_f32_32x32x16_bf16(__builtin_bit_cast(bf16x8, pw[3]), MLA_VF(vl0b, vh0b), o0, 0, 0, 0), N1, 8); MLA_SB(); \
        MLA_GB(o1 = __builtin_amdgcn_mfma_f32_32x32x16_bf16(__builtin_bit_cast(bf16x8, pw[3]), MLA_VF(vl1b, vh1b), o1, 0, 0, 0), N1, 12); MLA_SB(); \
        MLA_RESC(); } while (0)
#define MLA_TAIL(C0, C1, t_) do { float ls = 0.f; _Pragma("unroll") for (int r = 0; r < 16; ++r) ls += C0[r] + C1[r]; lrun += ls; ATT_PACK(C0, C1); ATT_PV((t_) & 3); } while (0)
#define MLA_STEP(C0, C1, N0, N1, t_) do { \
          \
        int lane_ = lane; asm volatile("" : "+v"(lane_)); const int r32 = lane_ & 31, hi = lane_ >> 5, qrow = qlo + r32; \
        const int vrd = ((lane_ >> 4) & 1) * 32 + (lane_ & 3) * 8 + (4 * hi + ((lane_ & 15) >> 2)) * 64; ALAS float* wsf = (ALAS float*)(lds + L_WSF) + wid * 64; \
        if ((t_) + 3 < ntile) { ATT_ISSUE((t_) + 3, (t_) + 3); issued = (t_) + 3; } \
        if ((t_) < tmax) MLA_FULL(C0, C1, N0, N1, t_); else if ((t_) == tmax) MLA_TAIL(C0, C1, t_); \
        ATT_WAIT_BAR(issued - ((t_) + 2)); } while (0)
    if (wid >= 4) __builtin_amdgcn_s_setprio(1);
    bool resc = false;
    ATT_QK(p0, p1, 0);
    MLA_DECIDE(p0, p1, 0);
#pragma unroll
    for (int r = 0; r < 16; ++r) { p0[r] = MLA_EX(p0[r]); p1[r] = MLA_EX(p1[r]); }
    asm volatile("s_waitcnt lgkmcnt(0)\n\ts_barrier" ::: "memory");
    for (int it = 0; it < ntile; it += 2) {
        MLA_STEP(p0, p1, n0, n1, it);
        if (it + 1 >= ntile) break;
        MLA_STEP(n0, n1, p0, p1, it + 1);
    }
    __builtin_amdgcn_s_setprio(0);
#undef MLA_SB
#undef MLA_EX
#undef MLA_DECIDE
#undef MLA_RESC
#undef MLA_PV_
#undef MLA_GA
#undef MLA_VF
#undef MLA_GB
#undef MLA_FULL
#undef MLA_TAIL
#undef MLA_STEP
    } else if constexpr (MODE == 1) {
    f32x16 p0, p1; u32x4 pw[4];
    __syncthreads();
    {
        const unsigned lds0_ = (unsigned)(uintptr_t)lds;
        for (int i = 0; i < ntile; ++i) { const int T_ = tfirst + i;
            glds16(ksrc0 + (size_t)T_ * KTS, (unsigned)__builtin_amdgcn_readfirstlane(lds0_ + S1_K + i * S1_KS + wid * KCS));
            glds16(vsrc + (size_t)T_ * VTS, (unsigned)__builtin_amdgcn_readfirstlane(lds0_ + S1_V + i * VSLOT + (wid >> 2) * VHS + (wid & 3) * 1024));
            if (wid == 0) glds4(P.pos + rb + (size_t)T_ * 64 + lane, (unsigned)__builtin_amdgcn_readfirstlane(lds0_ + S1_P + i * 256)); }
        ALAS float* lut = (ALAS float*)(lds + S1_LUT);
        if (tid < 129) { int bk = tid; if (tid >= 16) { bk = 16 + (int)((__builtin_amdgcn_logf((float)tid) - 4.0f) * (16.0f / 3.0f)); bk = bk < 31 ? bk : 31; } lut[tid] = P.relb[bk * 6 + h] * LOG2E; }
        asm volatile("s_waitcnt vmcnt(0) lgkmcnt(0)\n\ts_barrier" ::: "memory");
        const ALAS int* posk = (const ALAS int*)(lds + S1_P);
        const int lo_ = qlo - 127 > 0 ? qlo - 127 : 0; const int i_lo = (lo_ >> 6) - tfirst, i_hi = (qhi >> 6) - tfirst;
        for (int i = i_lo; i <= i_hi; ++i) {
            const int j0 = (tfirst + i) * 64;
            {
                int kofs_ = S1_K + i * S1_KS + hi * KCS + r32 * 16; asm volatile("" : "+v"(kofs_)); const ALAS unsigned char* Kb_ = lds + kofs_;
#pragma unroll
                for (int d0 = 0; d0 < ND0; ++d0) { const bf16x8 a0_ = *(const ALAS bf16x8*)(Kb_ + 2 * d0 * KCS), a1_ = *(const ALAS bf16x8*)(Kb_ + 2 * d0 * KCS + 512);
                    if (d0 == 0) { p0 = __builtin_amdgcn_mfma_f32_32x32x16_bf16(a0_, qf[0], negm, 0, 0, 0); p1 = __builtin_amdgcn_mfma_f32_32x32x16_bf16(a1_, qf[0], negm, 0, 0, 0); }
                    else { p0 = __builtin_amdgcn_mfma_f32_32x32x16_bf16(a0_, qf[d0], p0, 0, 0, 0); p1 = __builtin_amdgcn_mfma_f32_32x32x16_bf16(a1_, qf[d0], p1, 0, 0, 0); } }
            }
#pragma unroll
            for (int g = 0; g < 4; ++g) {
                const i32x4 pa = *(const ALAS i32x4*)(posk + i * 64 + 8 * g + 4 * hi), pb = *(const ALAS i32x4*)(posk + i * 64 + 32 + 8 * g + 4 * hi);
#pragma unroll
                for (int q = 0; q < 4; ++q) { int na = posq - pa[q]; na = na > 0 ? na : 0; na = na < 128 ? na : 128; int nb = posq - pb[q]; nb = nb > 0 ? nb : 0; nb = nb < 128 ? nb : 128;
                    p0[4 * g + q] += lut[na]; p1[4 * g + q] += lut[nb]; }
            }
#pragma unroll
            for (int r = 0; r < 16; ++r) { const int key = j0 + crow(r, hi); const bool ok0 = key <= qrow && key > qrow - 128, ok1 = key + 32 <= qrow && key + 32 > qrow - 128; if (!ok0) p0[r] = -INFINITY; if (!ok1) p1[r] = -INFINITY; }
            float ma = ATT_MAX3(p0[0], p0[1], p1[0]), mb = ATT_MAX3(p0[2], p0[3], p1[1]); ma = ATT_MAX3(ma, p1[2], p1[3]);
#pragma unroll
            for (int r = 4; r < 16; r += 4) { ma = ATT_MAX3(ma, p0[r], p0[r + 1]); mb = ATT_MAX3(mb, p0[r + 2], p0[r + 3]); ma = ATT_MAX3(ma, p1[r], p1[r + 1]); mb = ATT_MAX3(mb, p1[r + 2], p1[r + 3]); }
            const float mt = swap_max(fmaxf(ma, mb));
            if (__any(mt > THR)) {
                const float d = fmaxf(mt, 0.f);
#pragma unroll
                for (int r = 0; r < 16; ++r) { p0[r] -= d; p1[r] -= d; }
                const float alpha = __builtin_amdgcn_exp2f(-d); mrun += d; lrun *= alpha;
#pragma unroll
                for (int r = 0; r < 16; ++r) negm[r] = -mrun;
                if (hi == 0) wsf[r32] = alpha;
#pragma unroll
                for (int g = 0; g < 4; ++g) { const f32x4 al = *(const ALAS f32x4*)(wsf + 8 * g + 4 * hi);
#pragma unroll
                    for (int q = 0; q < 4; ++q) { o0[4 * g + q] *= al[q]; o1[4 * g + q] *= al[q]; } }
            }
            float ls = 0.f;
#pragma unroll
            for (int r = 0; r < 16; ++r) { p0[r] = __builtin_amdgcn_exp2f(p0[r]); p1[r] = __builtin_amdgcn_exp2f(p1[r]); ls += p0[r] + p1[r]; }
            lrun += ls;
            ATT_PACK(p0, p1);
            {
                int vofs_ = S1_V + i * VSLOT + vrd; asm volatile("" : "+v"(vofs_)); const ALAS unsigned char* Vb_ = lds + vofs_;
#pragma unroll
                for (int s_ = 0; s_ < 4; ++s_) { const bf16x8 pa_ = __builtin_bit_cast(bf16x8, pw[s_]);
                    const s16x4 l0_ = vtr(Vb_ + s_ * 1024), h0_ = vtr(Vb_ + s_ * 1024 + 512), l1_ = vtr(Vb_ + VHS + s_ * 1024), h1_ = vtr(Vb_ + VHS + s_ * 1024 + 512);
                    const bf16x8 v0_ = {l0_[0], l0_[1], l0_[2], l0_[3], h0_[0], h0_[1], h0_[2], h0_[3]}, v1_ = {l1_[0], l1_[1], l1_[2], l1_[3], h1_[0], h1_[1], h1_[2], h1_[3]};
                    o0 = __builtin_amdgcn_mfma_f32_32x32x16_bf16(pa_, v0_, o0, 0, 0, 0); o1 = __builtin_amdgcn_mfma_f32_32x32x16_bf16(pa_, v1_, o1, 0, 0, 0); }
            }
        }
        asm volatile("s_waitcnt lgkmcnt(0)\n\ts_barrier" ::: "memory");
    }
    } else {
    f32x16 p0, p1, n0, n1; u32x4 pw[4];
    __syncthreads();
    int issued = 0;
    ATT_ISSUE(tfirst, 0);
    if (ntile > 1) { ATT_ISSUE(tfirst + tstep, 1); issued = 1; }
    if (ntile > 2) { ATT_ISSUE(tfirst + 2 * tstep, 2); issued = 2; }
    ATT_WAIT_BAR(issued - 1);
    bool wcur = ATT_WORK(tfirst * 64);
    if (wcur) ATT_QK(p0, p1, 0);
    asm volatile("s_waitcnt lgkmcnt(0)\n\ts_barrier" ::: "memory");
    int nt = ntile;
    for (int it = 0; it < nt; ++it) {
        const int t = tfirst + it * tstep, j0 = t * 64, jn = (t + tstep) * 64;
        if (it + 3 < ntile) { ATT_ISSUE(t + 3 * tstep, it + 3); issued = it + 3; }
        if (wcur) ATT_SM_A(p0, p1, j0, it & 3);
        const bool wnext = (it + 1 < nt) && ATT_WORK(jn);
        if (wcur && wnext) { ATT_QK(n0, n1, (it + 1) % 3); ATT_SM_B(p0, p1, j0); }
        else { if (wnext) ATT_QK(n0, n1, (it + 1) % 3); if (wcur) ATT_SM_B(p0, p1, j0); }
        if (wcur) ATT_PV(it & 3);
        p0 = n0; p1 = n1; wcur = wnext;
        if (MODE == 2) { ALAS int* fl = (ALAS int*)(lds + L_FLAG + 16) + (it & 1) * 8; if (lane == 0) fl[wid] = (walive && j0 > 0) ? 1 : 0; }
        ATT_WAIT_BAR(issued - (it + 2));
        if (MODE == 2) { const ALAS int* fl = (const ALAS int*)(lds + L_FLAG + 16) + (it & 1) * 8;
            const i32x4 fa = *(const ALAS i32x4*)fl, fb = *(const ALAS i32x4*)(fl + 4);
            if (((fa[0] | fa[1]) | (fa[2] | fa[3]) | (fb[0] | fb[1]) | (fb[2] | fb[3])) == 0) nt = it + 1; }
    }
    }
    if (MODE == 2) asm volatile("s_waitcnt vmcnt(0)" ::: "memory");
#undef ATT_ISSUE
#undef ATT_WAIT_BAR
#undef ATT_QK
#undef ATT_PV
#undef ATT_PACK
#undef ATT_VLD
#undef ATT_SM_A
#undef ATT_SM_B
#undef ATT_WORK
#undef ATT_MAX3
    if (MODE != 2) {
        const float lt = swap_sum(lrun);
        if (hi == 0) wsf[32 + r32] = 1.0f / lt;
#pragma unroll
        for (int g = 0; g < 4; ++g) { const f32x4 il = *(const ALAS f32x4*)(wsf + 32 + 8 * g + 4 * hi);
#pragma unroll
            for (int i = 0; i < 4; ++i) { o0[4 * g + i] *= il[i]; o1[4 * g + i] *= il[i]; } }
    }
    {
        ALAS bf16_t* stg = (ALAS bf16_t*)ost;
#pragma unroll
        for (int r = 0; r < 16; ++r) { const int orow = crow(r, hi); stg[orow * 64 + r32] = (bf16_t)(cvtpk(o0[r], 0.f) & 0xffffu); stg[orow * 64 + 32 + r32] = (bf16_t)(cvtpk(o1[r], 0.f) & 0xffffu); }
        AGAS bf16_t* Ow = (AGAS bf16_t*)(P.ws + WS_OALL) + (rb + qlo) * 1024 + C::ocol0 + h * 64;
#pragma unroll
        for (int i = 0; i < 4; ++i) {
            const int row = i * 8 + (lane >> 3), ch = lane & 7;
            const u32x4 v = *(const ALAS u32x4*)(stg + row * 64 + ch * 8);
            float ss = 0.f;
#pragma unroll
            for (int k = 0; k < 4; ++k) { const unsigned w = v[k]; const float a = __uint_as_float(w << 16), c = __uint_as_float(w & 0xffff0000u); ss += a * a + c * c; }
            ss += __shfl_xor(ss, 1); ss += __shfl_xor(ss, 2); ss += __shfl_xor(ss, 4);
            *(AGAS u32x4*)(Ow + (size_t)row * 1024 + ch * 8) = v;
            if (ch == 0) ((AGAS float*)(P.ws + WS_SSQO))[(rb + qlo + row) * 16 + C::hidx0 + h] = ss;
        }
    }
#ifdef ATT_PROF
    if (MODE == 0 && blockIdx.x == 0 && wid == ATT_PROF_WAVE && lane == 0 && prof) { const long long tt = PROF_T() - pf_t0;
        atomicAdd(prof + 0, (unsigned long long)tt); atomicAdd(prof + 1, (unsigned long long)pf_qk); atomicAdd(prof + 2, (unsigned long long)pf_sm); atomicAdd(prof + 3, (unsigned long long)pf_pv); atomicAdd(prof + 4, (unsigned long long)pf_wait); atomicAdd(prof + 5, 1ull); }
#endif
}
#undef ALAS
#undef AGAS
}
struct Args { const void* in[23]; float* out; unsigned char* ws; int ph_lo, ph_hi, li, adapt; };

struct Frame { LAS unsigned char* lds; int wave, vcu, G; };
#define FLANE hw_lane()
#define FTID (F.wave * 64 + hw_lane())

__device__ __forceinline__ float wave_sum64(float v) { return pg8::wave_sum_dpp(v); }

__device__ __forceinline__ void tr_item64(const GAS float* W, int ldn, int K, GAS pg8::bf16_t* WT, int kb, int g, int src0, int src1, const GAS float* kgain, LAS unsigned* scr, int lane) {
    const int k0 = 64 * kb; const int col = lane < 32 ? src0 + lane : src1 + (lane - 32); const bool ok = (lane < 32 ? src0 : src1) >= 0;
    const GAS float* wp = W + (size_t)k0 * ldn + (ok ? col : 0);
#pragma unroll
    for (int hf = 0; hf < 4; ++hf) {
        float v[16];
#pragma unroll
        for (int i = 0; i < 16; ++i) v[i] = wp[(size_t)(hf * 16 + i) * ldn];
#pragma unroll
        for (int i = 0; i < 16; ++i) v[i] = ok ? v[i] : 0.f;
        if (kgain) {
#pragma unroll
            for (int i = 0; i < 16; ++i) v[i] *= kgain[k0 + hf * 16 + i]; }
#pragma unroll
        for (int i = 0; i < 8; ++i) scr[(hf * 8 + i) * 65 + lane] = pk2(v[2 * i], v[2 * i + 1]);
    }
    asm volatile("s_waitcnt lgkmcnt(0)" ::: "memory");
    const int c = lane & 7;
#pragma unroll
    for (int j = 0; j < 8; ++j) { const int n = (lane >> 3) + 8 * j; const LAS unsigned* s = scr + (4 * c) * 65 + n;
        v4u o; o.x = s[0]; o.y = s[65]; o.z = s[130]; o.w = s[195];
        *(GAS v4u*)(WT + (size_t)(64 * g + n) * K + k0 + 8 * c) = o; }
    asm volatile("s_waitcnt lgkmcnt(0)" ::: "memory");
}
__device__ __forceinline__ int in_slot_src(int slot, int& cnt) {
    cnt = 64;
    if (slot < 4) return 64 * slot;
    if (slot < 6) return 256 + 64 * (slot - 4);
    if (slot == 6) { cnt = 32; return 384; }
    if (slot == 7) return -1;
    if (slot < 14) return 416 + 64 * (slot - 8);
    if (slot < 16) return 800 + 64 * (slot - 14);
    if (slot < 18) return 928 + 64 * (slot - 16);
    if (slot < 22) return 1056 + 64 * (slot - 18);
    if (slot < 26) return 1312 + 64 * (slot - 22);
    if (slot < 30) return 1568 + 64 * (slot - 26);
    return -1;
}

#define A_X ((const GAS float*)args.in[0])
#define A_C ((const GAS float*)args.in[1])
#define A_POS ((const GAS int*)args.in[2])
#define A_RELB ((const GAS float*)args.in[3])
#define A_NORMG ((const GAS float*)args.in[4])
#define A_WMOD ((const GAS float*)args.in[5])
#define A_BMOD ((const GAS float*)args.in[6])
#define A_WGU1 ((const GAS float*)args.in[7])
#define A_WD1 ((const GAS float*)args.in[8])
#define A_WIN ((const GAS float*)args.in[9])
#define A_QAN ((const GAS float*)args.in[10])
#define A_KVAN ((const GAS float*)args.in[11])
#define A_WUQ ((const GAS float*)args.in[12])
#define A_WUKV ((const GAS float*)args.in[13])
#define A_MLAQN ((const GAS float*)args.in[14])
#define A_MLAKN ((const GAS float*)args.in[15])
#define A_SWAQN ((const GAS float*)args.in[16])
#define A_SWAKN ((const GAS float*)args.in[17])
#define A_SINKS ((const GAS float*)args.in[18])
#define A_OUTN ((const GAS float*)args.in[19])
#define A_WOUT ((const GAS float*)args.in[20])
#define A_WGU2 ((const GAS float*)args.in[21])
#define A_WD2 ((const GAS float*)args.in[22])
#define WSP(off)   (ws_ + (off))
#define MOD ((GAS float*)WSP(WS_MOD))
#define GS ((GAS float*)WSP(WS_GS))
#define BIAS ((GAS float*)WSP(WS_BIAS))
#define SSQX ((GAS float*)WSP(WS_SSQX))
#define SSQO ((GAS float*)WSP(WS_SSQO))
#define CS ((GAS float*)WSP(WS_CS))
#define KPE ((GAS float*)WSP(WS_KPE))
#define SSQ_CQ ((GAS float*)WSP(WS_SSQC))
#define SSQ_CKV ((GAS float*)WSP(WS_SSQC) + (size_t)MROWS * 4)
#define SSQ_KPE ((GAS float*)WSP(WS_SSQC) + (size_t)MROWS * 6)
#define XB ((GAS pg8::bf16_t*)WSP(WS_XB))
#define HID ((GAS pg8::bf16_t*)WSP(WS_HID))
#define CQ ((GAS pg8::bf16_t*)WSP(WS_CQ))
#define CKV ((GAS pg8::bf16_t*)WSP(WS_CKV))
#define KA ((GAS pg8::bf16_t*)WSP(WS_KA))
#define VA ((GAS pg8::bf16_t*)WSP(WS_VA))
#define QS ((GAS pg8::bf16_t*)WSP(WS_QS))
#define KS ((GAS pg8::bf16_t*)WSP(WS_KS))
#define VS ((GAS pg8::bf16_t*)WSP(WS_VS))
#define QC ((GAS pg8::bf16_t*)WSP(WS_QC))
#define KC ((GAS pg8::bf16_t*)WSP(WS_KC))
#define VC ((GAS pg8::bf16_t*)WSP(WS_VC))
#define OALL ((GAS pg8::bf16_t*)WSP(WS_OALL))
#define QRAW ((GAS float*)WSP(WS_QRAW))

__device__ __forceinline__ int in_group_src(int g32) {
    const int tile = g32 >> 3, rr = g32 & 7, bj = rr >> 2, wc = rr & 3; int cnt; const int base = in_slot_src(tile * 4 + wc, cnt);
    return (base >= 0 && 32 * bj < cnt) ? base + 32 * bj : -1;
}
constexpr int CV_GU = 16 * 88, CV_D = 44 * 16, CV_IN = 16 * 32, CV_UQ = 4 * 12, CV_UKV = 2 * 12, CV_OUT = 16 * 16;
constexpr int CV_EARLY = CV_GU + CV_D + CV_IN + CV_UQ + CV_UKV + CV_OUT, CV_L = CV_EARLY + CV_GU + CV_D, CV_ALL = DEPTH * CV_L;
__device__ __forceinline__ void convert_chunk(Frame& F, const Args& args, int base, int limit) {
    GAS unsigned char* ws_ = (GAS unsigned char*)args.ws; asm volatile("" : "+s"(ws_));
    LAS unsigned* scr = (LAS unsigned*)(F.lds + 16384 + F.wave * 8448);
#pragma unroll 1
    for (int q = 0; q < 2; ++q) {
        const int it = base + F.wave * 2 + q; if (it >= limit) break;
        const int l = it / CV_L; int r = it % CV_L;
        GAS unsigned char* wl = ws_ + WS_W + (size_t)l * WL;
        int kind;
        if (r < CV_GU) kind = 0; else if ((r -= CV_GU) < CV_D) kind = 1; else if ((r -= CV_D) < CV_IN) kind = 2; else if ((r -= CV_IN) < CV_UQ) kind = 3;
        else if ((r -= CV_UQ) < CV_UKV) kind = 4; else if ((r -= CV_UKV) < CV_OUT) kind = 5; else if ((r -= CV_OUT) < CV_GU) kind = 6; else { r -= CV_GU; kind = 7; }
        if (kind == 0 || kind == 6) {
            const bool second = kind == 6; const int kb = r / 88, g = r % 88, t = g >> 2, rr = g & 3, src = (rr >> 1) * DFF + 128 * t + 64 * (rr & 1);
            const GAS float* W = (second ? A_WGU2 : A_WGU1) + (size_t)l * DM * 2 * DFF;
            tr_item64(W, 2 * DFF, DM, (GAS pg8::bf16_t*)(wl + (second ? W_GU2 : W_GU1)), kb, g, src, src + 32, nullptr, scr, FLANE);
        } else if (kind == 1 || kind == 7) { const bool second = kind == 7; const int kb = r / 16, g = r % 16;
            tr_item64((second ? A_WD2 : A_WD1) + (size_t)l * DFF * DM, DM, DFF, (GAS pg8::bf16_t*)(wl + (second ? W_D2 : W_D1)), kb, g, 64 * g, 64 * g + 32, nullptr, scr, FLANE);
        } else if (kind == 2) { const int kb = r / 32, g = r % 32;
            tr_item64(A_WIN + (size_t)l * DM * DIN, DIN, DM, (GAS pg8::bf16_t*)(wl + W_IN), kb, g, in_group_src(2 * g), in_group_src(2 * g + 1), nullptr, scr, FLANE);
        } else if (kind == 3) { const int kb = r / 12, g = r % 12;
            tr_item64(A_WUQ + (size_t)l * 256 * 576, 576, 256, (GAS pg8::bf16_t*)(wl + W_UQ), kb, g, g < 9 ? 64 * g : -1, g < 9 ? 64 * g + 32 : -1, A_QAN + l * 256, scr, FLANE);
        } else if (kind == 4) { const int kb = r / 12, g = r % 12, g0 = 2 * g, g1 = 2 * g + 1;
            tr_item64(A_WUKV + (size_t)l * 128 * 768, 768, 128, (GAS pg8::bf16_t*)(wl + W_UKV), kb, g, 256 * (g0 >> 3) + 64 * (g0 & 3) + 32 * ((g0 & 7) >> 2), 256 * (g1 >> 3) + 64 * (g1 & 3) + 32 * ((g1 & 7) >> 2), A_KVAN + l * 128, scr, FLANE);
        } else { const int kb = r / 16, g = r % 16;
            tr_item64(A_WOUT + (size_t)l * DM * DM, DM, DM, (GAS pg8::bf16_t*)(wl + W_OUT), kb, g, 64 * g, 64 * g + 32, A_OUTN + l * DM, scr, FLANE); }
    }
}

__device__ __forceinline__ void phase_pro0(Frame& F, const Args& args, gu32* qhead) {
    GAS unsigned char* ws_ = (GAS unsigned char*)args.ws; asm volatile("" : "+s"(ws_));
    constexpr int NMU = DEPTH * NMOD / 128;
    if ((int)blockIdx.x < NMU || F.G <= NMU) {
        LAS float* cond = (LAS float*)F.lds;
        LAS float* red = (LAS float*)(F.lds + 8192);
        for (int i = FTID; i < 2 * DM; i += 512) { const float cv = A_C[i]; cond[i] = cv / (1.0f + expf(-cv)); }
        __syncthreads();
        for (int u = blockIdx.x; u < NMU; u += F.G) {
            const int l = u / (NMOD / 128), n0 = (u % (NMOD / 128)) * 128, c4 = FLANE & 31, kp = FLANE >> 5;
            const GAS float* w = A_WMOD + (size_t)l * DM * NMOD + n0 + 4 * c4;
            f32x4 a0 = {0.f, 0.f, 0.f, 0.f}, a1 = {0.f, 0.f, 0.f, 0.f};
#pragma unroll 8
            for (int i = 0; i < 64; ++i) { const int kk = F.wave * 128 + 2 * i + kp; const f32x4 wv = *(const GAS f32x4*)(w + (size_t)kk * NMOD); a0 += wv * cond[kk]; a1 += wv * cond[DM + kk]; }
#pragma unroll
            for (int q = 0; q < 4; ++q) { a0[q] = pg8::xsum32(a0[q]); a1[q] = pg8::xsum32(a1[q]); }
            if (kp == 0) { *(LAS f32x4*)(red + (F.wave * 2 + 0) * 128 + 4 * c4) = a0; *(LAS f32x4*)(red + (F.wave * 2 + 1) * 128 + 4 * c4) = a1; }
            __syncthreads();
            if (FTID < 256) { const int bb = FTID >> 7, ln = FTID & 127; float s = 0.f;
#pragma unroll
                for (int wv = 0; wv < 8; ++wv) s += red[(wv * 2 + bb) * 128 + ln];
                MOD[((size_t)l * 2 + bb) * NMOD + n0 + ln] = s + A_BMOD[(size_t)l * NMOD + n0 + ln]; }
            __syncthreads();
        }
    }
    if ((int)blockIdx.x >= NMU || F.G <= NMU) {
        const int nb = F.G <= NMU ? F.G : F.G - NMU, b0 = F.G <= NMU ? (int)blockIdx.x : (int)blockIdx.x - NMU;
        for (int i = b0 * 512 + FTID; i < MROWS * 16; i += nb * 512) {
            const int m = i >> 4, j = i & 15;
            const float freq = powf(10000.0f, -(float)j / 16.0f);
            const float ang = (float)A_POS[m] * freq;
            CS[(size_t)m * 32 + j] = cosf(ang); CS[(size_t)m * 32 + 16 + j] = sinf(ang);
        }
    }
    {
        LAS int* slot = (LAS int*)(F.lds + 12288);
        for (;;) {
            __syncthreads();
            if (FTID == 0) slot[0] = (int)__hip_atomic_fetch_add(qhead, 16u, __ATOMIC_RELAXED, __HIP_MEMORY_SCOPE_AGENT);
            __syncthreads();
            const int base = slot[0];
            if (base >= CV_EARLY) break;
            convert_chunk(F, args, base, CV_EARLY);
        }
    }
}

__device__ __forceinline__ float gs_clamped(float g, float sc) { const float v = g * (1.0f + sc); return fabsf(v) < 1e-20f ? (v < 0.f ? -1e-20f : 1e-20f) : v; }
__device__ __forceinline__ void x_to_xb(Frame& F, const Args& args, const GAS float* xsrc, int l, int i) {
    GAS unsigned char* ws_ = (GAS unsigned char*)args.ws; asm volatile("" : "+s"(ws_));
    const int gw = F.vcu * NWAVES + F.wave, NGW = F.G * NWAVES;
    for (int m = gw; m < MROWS; m += NGW) {
        const int b = m >> 13;
        const GAS f32x4* xr = (const GAS f32x4*)(xsrc + (size_t)m * DM) + FLANE;
        const GAS f32x4* gr = (const GAS f32x4*)(A_NORMG + ((size_t)l * 3 + i) * DM) + FLANE;
        const GAS f32x4* sr = (const GAS f32x4*)(MOD + ((size_t)l * 2 + b) * NMOD + (3 * i + 1) * DM) + FLANE;
        float s = 0.f;
        GAS unsigned long long* o8 = (GAS unsigned long long*)(XB + (size_t)m * DM) + FLANE;
#pragma unroll
        for (int j = 0; j < 4; ++j) { const f32x4 v = xr[64 * j]; s += (v.x * v.x + v.y * v.y) + (v.z * v.z + v.w * v.w);
            const f32x4 g0 = gr[64 * j], s0 = sr[64 * j]; const f32x4 g = {gs_clamped(g0.x, s0.x), gs_clamped(g0.y, s0.y), gs_clamped(g0.z, s0.z), gs_clamped(g0.w, s0.w)}; const f32x4 y = v * g;
            o8[64 * j] = (unsigned long long)pk2(y.x, y.y) | ((unsigned long long)pk2(y.z, y.w) << 32); }
        s = wave_sum64(s);
        if (FLANE < 16) SSQX[(size_t)m * 16 + FLANE] = (FLANE == 0) ? s : 0.f;
    }
}

__device__ __forceinline__ void bias_rows(Frame& F, const Args& args, bool early) {
    GAS unsigned char* ws_ = (GAS unsigned char*)args.ws; asm volatile("" : "+s"(ws_));
    const int gw = F.vcu * NWAVES + F.wave, NGW = F.G * NWAVES;
    constexpr int RL = 5632 + 2048 + 5632, RE = 5632 + 2048;
    const int lo = early ? 0 : RE, hi = early ? RE : DEPTH * RL;
    for (int it = lo + gw; it < hi; it += NGW) {
        const int l = it / RL; int r = it % RL; int which, nrow; size_t woff; size_t boff;
        if (r < 5632) { which = 0; nrow = 5632; woff = W_GU1; boff = 0; } else if (r < 5632 + 2048) { r -= 5632; which = 1; nrow = 2048; woff = W_IN; boff = 2 * 5632; } else { r -= 5632 + 2048; which = 2; nrow = 5632; woff = W_GU2; boff = 2 * (5632 + 2048); }
        const GAS pg8::bf16_t* wr = (const GAS pg8::bf16_t*)(ws_ + WS_W + (size_t)l * WL + woff) + (size_t)r * DM;
        float a0 = 0.f, a1 = 0.f;
#pragma unroll
        for (int j = 0; j < 2; ++j) {
            const v4u wv = *(const GAS v4u*)(wr + j * 512 + FLANE * 8);
            const GAS float* s0 = MOD + ((size_t)l * 2 + 0) * NMOD + (3 * which) * DM + j * 512 + FLANE * 8; const GAS float* s1 = s0 + NMOD;
#pragma unroll
            for (int k = 0; k < 4; ++k) { const unsigned w = wv[k]; const float lo_ = __uint_as_float(w << 16), hi_ = __uint_as_float(w & 0xffff0000u);
                a0 += lo_ * s0[2 * k] + hi_ * s0[2 * k + 1]; a1 += lo_ * s1[2 * k] + hi_ * s1[2 * k + 1]; }
        }
        a0 = wave_sum64(a0); a1 = wave_sum64(a1);
        if (FLANE == 0) { BIAS[(size_t)l * BIAS_L + boff + r] = a0; BIAS[(size_t)l * BIAS_L + boff + nrow + r] = a1; }
    }
}
__device__ __forceinline__ void phase_pro1(Frame& F, const Args& args) {
    GAS unsigned char* ws_ = (GAS unsigned char*)args.ws; asm volatile("" : "+s"(ws_));
    for (int i = blockIdx.x * 512 + FTID; i < DEPTH * 3 * 2 * DM; i += F.G * 512) {
        const int cidx = i & 1023, b = (i >> 10) & 1, li = i >> 11, l = li / 3, ii = li % 3;
        const float gv_ = gs_clamped(A_NORMG[((size_t)l * 3 + ii) * DM + cidx], MOD[((size_t)l * 2 + b) * NMOD + (3 * ii + 1) * DM + cidx]);
        GS[i] = gv_; ((GAS float*)WSP(WS_IGS))[i] = 1.0f / gv_;
    }
    bias_rows(F, args, true);
    x_to_xb(F, args, A_X, 0, 0);
}

__device__ __forceinline__ int next_unit(Frame& F, gu32* head) {
    LAS int* slot = (LAS int*)(F.lds + att::L_FLAG);
    __syncthreads();
    if (FTID == 0) slot[0] = (int)__hip_atomic_fetch_add(head, 1u, __ATOMIC_RELAXED, __HIP_MEMORY_SCOPE_AGENT);
    __syncthreads();
    return slot[0];
}

#ifndef DUPS
#define DUPS -1
#endif
#ifndef PHM
#define PHM 255
#endif
#ifndef PHM2
#define PHM2 31
#endif
__global__ void __launch_bounds__(NWAVES * 64, 2) fwd_mega(Args args) {
    extern __shared__ __attribute__((aligned(16))) unsigned char lds[];
    const int wave0 = __builtin_amdgcn_readfirstlane((int)threadIdx.x >> 6);
    Frame F0; F0.lds = (LAS unsigned char*)lds; F0.wave = wave0;
    F0.G = gridDim.x; { const int bx = blockIdx.x; F0.vcu = (F0.G % 8 == 0) ? (bx % 8) * (F0.G / 8) + bx / 8 : bx; }
    gu32* ctl = (gu32*)(args.ws + WS_CTL);
    for (int u = wave0 * 64 + hw_lane(); u < (LDS_BYTES - LDSCTL_OFF) / 4; u += NWAVES * 64) ((LAS unsigned*)(F0.lds + LDSCTL_OFF))[u] = 0u;
    __syncthreads();
    const int lo = args.ph_lo, hi = args.ph_hi;
    XcdBarrier bar; bar.bar = (unsigned*)(ctl + CW_BAR) + args.li * XCD_BAR_WORDS; bar.x = 0; bar.st = nullptr; bar.w0 = wave0;
    if (hi - lo > 1 || true) bar = xcd_barrier_post((unsigned*)(ctl + CW_BAR) + args.li * XCD_BAR_WORDS, (volatile LAS unsigned*)(F0.lds + MISC_OFF) + 8, wave0);

    for (int ph = lo; ph < hi; ++ph) {
        Frame F; F.lds = F0.lds; F.G = F0.G; F.vcu = F0.vcu; F.wave = wave0;
        GAS unsigned char* ws_ = (GAS unsigned char*)args.ws; asm volatile("" : "+s"(ws_));
        int nrep = 1;
        if (DUPS >= 0) { const int ty = ph < 2 ? 8 + ph : ((ph - 2) & 7); if (ty == DUPS && !(ty == 5) && !((ty == 1 || ty == 7) && ph != 3)) nrep = 2; }
        for (int rep = 0; rep < nrep; ++rep) {
        if ((PHM & 64) && ph == 0) phase_pro0(F, args, ctl + CW_Q + 64 * 8);
        else if ((PHM & 128) && ph == 1) phase_pro1(F, args);
        else {
            const int l = (ph - 2) >> 3, s = (ph - 2) & 7;
            const GAS unsigned char* wl = ws_ + WS_W + (size_t)l * WL;
            const GAS float* biasl = BIAS + (size_t)l * BIAS_L;
            const GAS float* modl = MOD + (size_t)l * 2 * NMOD;
            if ((PHM & 1) && (s == 0 || s == 6)) {
                pg8::Gemm g{(const pg8::bf16_t*)XB, (const pg8::bf16_t*)(wl + (s == 0 ? W_GU1 : W_GU2)), MROWS, 5632, DM}; pg8::StaticOrder S; S.init(MROWS, 5632, F.G, (int)blockIdx.x);
                pg8::EpiUp E{ws_, biasl + (s == 0 ? 0 : 2 * (5632 + 2048))};
                pg8::gemm_phase<pg8::EpiUp, pg8::StaticOrder, true, true>(F.lds, g, S, E, F.wave);
            } else if ((PHM & 2) && (s == 1 || s == 7)) {
                pg8::Gemm g{(const pg8::bf16_t*)HID, (const pg8::bf16_t*)(wl + (s == 1 ? W_D1 : W_D2)), MROWS, DM, DFF}; pg8::StaticOrder S; S.init(MROWS, DM, F.G, (int)blockIdx.x);
                const bool lastp = (s == 7 && l == DEPTH - 1);
                const GAS float* gsn = lastp ? nullptr : (s == 1 ? GS + ((size_t)(l * 3 + 1) * 2) * DM : GS + ((size_t)((l + 1) * 3 + 0) * 2) * DM);
                const GAS float* igp = (const GAS float*)WSP(WS_IGS) + ((size_t)(l * 3 + (s == 1 ? 0 : 2)) * 2) * DM;
                pg8::EpiResS<false> E{(GAS float*)args.out, ws_, modl + (s == 1 ? 2 : 8) * DM, igp, gsn, 0.5f}; pg8::gemm_phase<pg8::EpiResS<false>, pg8::StaticOrder, false, true>(F.lds, g, S, E, F.wave, (unsigned long long*)(ctl + CW_Q + 64 * 13));
            } else if ((PHM & 4) && s == 2) {
                pg8::Gemm g{(const pg8::bf16_t*)XB, (const pg8::bf16_t*)(wl + W_IN), MROWS, 2048, DM}; pg8::StaticOrder S; S.init(MROWS, 2048, F.G, (int)blockIdx.x);
                pg8::EpiIn E{ws_, A_SWAQN + l * 64, A_SWAKN + l * 64, biasl + 2 * 5632};
                pg8::gemm_phase<pg8::EpiIn, pg8::StaticOrder, true, true>(F.lds, g, S, E, F.wave);
            } else if ((PHM & 8) && s == 3) {
                if (PHM2 & 1) { pg8::Gemm g{(const pg8::bf16_t*)CQ, (const pg8::bf16_t*)(wl + W_UQ), MROWS, 768, 256}; pg8::StaticOrder S; S.init(MROWS, 768, F.G, (int)blockIdx.x);
                  pg8::EpiUq E{ws_}; pg8::gemm_phase<pg8::EpiUq, pg8::StaticOrder, true, true>(F.lds, g, S, E, F.wave); }
                if (PHM2 & 2) { pg8::Gemm g{(const pg8::bf16_t*)CKV, (const pg8::bf16_t*)(wl + W_UKV), MROWS, 768, 128}; pg8::StaticOrder S; S.init(MROWS, 768, F.G, (int)((blockIdx.x + 64) % F.G));
                  pg8::EpiUkv E{ws_, A_MLAKN + l * 96}; pg8::gemm_phase<pg8::EpiUkv, pg8::StaticOrder, true, true>(F.lds, g, S, E, F.wave); }
            } else if ((PHM & 16) && s == 4) {
                att::AttnP PA{ws_, A_MLAQN + l * 96, nullptr, nullptr, nullptr};
                att::AttnP PB{ws_, nullptr, A_POS, A_SINKS + l * 6, A_RELB};
                att::AttnP PC{ws_, nullptr, nullptr, nullptr, nullptr};
                gu32* head = ctl + CW_Q + 64 * (2 * l + 1 + 4 * rep);
                for (;;) { const int u = next_unit(F, head); if (u >= 384 + 256 + 384) break;
                    if ((PHM2 & 16) && u < 384) { const int qb = 31 - u / 12, bh = u % 12;
                        att::attn_unit<96, 0>(F.lds, PA, bh / 6, bh % 6, qb, F.wave, (unsigned long long*)(ctl + CW_Q + 64 * 12)); }

                    else if ((PHM2 & 4) && u >= 384 && u < 640) { const int v = u - 384, qb = 31 - (v >> 3), bh = v & 7; att::attn_unit<64, 2>(F.lds, PC, bh >> 2, bh & 3, qb, F.wave); }
                    else if ((PHM2 & 8) && u >= 640) { const int v = u - 640, qb = v / 12, bh = v % 12; att::attn_unit<64, 1>(F.lds, PB, bh / 6, bh % 6, qb, F.wave); } }
                if (l == 0 && rep == 0) {
                    gu32* chead = ctl + CW_Q + 64 * 9; LAS int* cslot = (LAS int*)(F.lds + 12288);
                    for (;;) { __syncthreads(); if (FTID == 0) cslot[0] = (int)__hip_atomic_fetch_add(chead, 16u, __ATOMIC_RELAXED, __HIP_MEMORY_SCOPE_AGENT); __syncthreads();
                        const int cb = CV_EARLY + cslot[0]; if (cb >= CV_ALL) break; convert_chunk(F, args, cb, CV_ALL); } }
            } else if ((PHM & 32) && s == 5) {
                if (l == 0 && rep == 0) { bias_rows(F, args, false); asm volatile("s_waitcnt vmcnt(0)" ::: "memory"); __syncthreads(); }
                pg8::Gemm g{(const pg8::bf16_t*)OALL, (const pg8::bf16_t*)(wl + W_OUT), MROWS, DM, DM}; pg8::StaticOrder S; S.init(MROWS, DM, F.G, (int)blockIdx.x);
                pg8::EpiResS<true> E{(GAS float*)args.out, ws_, modl + 5 * DM, (const GAS float*)WSP(WS_IGS) + ((size_t)(l * 3 + 1) * 2) * DM, GS + ((size_t)(l * 3 + 2) * 2) * DM, 1.0f}; pg8::gemm_phase<pg8::EpiResS<true>, pg8::StaticOrder, false, true>(F.lds, g, S, E, F.wave);
            }
        }
        if (rep + 1 < nrep) xcd_barrier(bar);
        }
        if (ph + 1 < hi) xcd_barrier(bar);
    }
#ifdef GEMM_PROF
    xcd_barrier(bar);
    if (blockIdx.x == 0 && threadIdx.x == 0) { const unsigned long long* st = (const unsigned long long*)(ctl + CW_Q + 64 * 13); double sh;
        if (GEMM_PROF == 0) sh = (double)st[1] / (double)(st[0] + st[1]);
        else if (GEMM_PROF == 1) sh = (double)st[0] / (double)st[2] / 1.0e6;
        else sh = (double)st[1] / (double)st[2] / 1.0e6;
        args.out[0] += (float)(0.04 + 0.18 * (sh > 1.0 ? 1.0 : sh)); }
#endif
#ifdef ATT_PROF
    xcd_barrier(bar);
    if (blockIdx.x == 0 && threadIdx.x == 0) { const unsigned long long* st = (const unsigned long long*)(ctl + CW_Q + 64 * 12);
        const double tot = (double)st[0]; double sh = 0.0;
        if (ATT_PROF == 0) sh = (double)st[0] / (double)st[5] / 1.0e6;
        else if (ATT_PROF == 5) sh = (double)st[0] / (double)st[6] / 1.0e4;
        else if (ATT_PROF == 6) sh = (double)st[6] / 1.0e3;
        else sh = (double)st[ATT_PROF] / tot;
        args.out[0] += (float)(0.04 + 0.18 * (sh > 1.0 ? 1.0 : sh)); }
#endif
}
static void launch_fwd(hipStream_t stream, Args a, int grid, int lo, int hi, int li, int adapt) {
    a.ph_lo = lo; a.ph_hi = hi; a.li = li; a.adapt = adapt;
    hipLaunchKernelGGL(fwd_mega, dim3(grid), dim3(NWAVES * 64), LDS_BYTES, stream, a);
}
extern "C" void kernel_launch(void* const* d_in, const int* in_sizes, int n_in, void* d_out, int out_size, void* d_ws, size_t ws_size, hipStream_t stream) {
    static int grid = 0;
    if (grid == 0) {
        if (n_in != 23 || out_size != MROWS * DM || ws_size < WS_END) { fprintf(stderr, "kernel_launch: unexpected problem (n_in %d, out %d, ws %zu < %zu)\n", n_in, out_size, ws_size, (size_t)WS_END); grid = -1; return; }
        int dev = 0, cus = 0, per_cu = 0;
        if (hipGetDevice(&dev) != hipSuccess || hipDeviceGetAttribute(&cus, hipDeviceAttributeMultiprocessorCount, dev) != hipSuccess) { grid = -1; return; }
        if (hipFuncSetAttribute((const void*)fwd_mega, hipFuncAttributeMaxDynamicSharedMemorySize, LDS_BYTES) != hipSuccess) { fprintf(stderr, "kernel_launch: hipFuncSetAttribute failed\n"); grid = -1; return; }
        if (hipOccupancyMaxActiveBlocksPerMultiprocessor(&per_cu, (const void*)fwd_mega, NWAVES * 64, LDS_BYTES) != hipSuccess || per_cu < 1) { fprintf(stderr, "kernel_launch: occupancy query says %d blocks per CU\n", per_cu); (void)hipGetLastError(); grid = -1; return; }
        if (cus < 256) { fprintf(stderr, "kernel_launch: built for a 256-CU device (the one-unit-per-workgroup GEMM phases need exactly 256 workgroups), found %d CUs\n", cus); grid = -1; return; }
        grid = 256;
    }
    if (grid < 0) return;
    (void)hipMemsetAsync((char*)d_ws + WS_CTL, 0, CTL_ZERO_BYTES, stream);
    Args a{};
    for (int i = 0; i < 23; ++i) a.in[i] = d_in[i];
    a.out = (float*)d_out; a.ws = (unsigned char*)d_ws;
    launch_fwd(stream, a, grid, 0, NPH, 0, -1);
}
```

```cpp
#include <hip/hip_runtime.h>
#include <cstdio>
#include <cstdint>
#include <cmath>
constexpr int NWAVES = 8;
constexpr int BATCH = 2, SEQ = 8192, DM = 1024, DEPTH = 2, MROWS = BATCH * SEQ;
constexpr int DFF = 2816, DIN = 1824, NMOD = 9 * DM;
constexpr int NPH = 2 + 8 * DEPTH;
constexpr size_t MiB = 1u << 20;
constexpr size_t WS_CTL = 0, CTL_ZERO_BYTES = 256 * 1024;
constexpr size_t WS_MOD = 1 * MiB;
constexpr size_t WS_GS = WS_MOD + 160 * 1024;
constexpr size_t WS_IGS = WS_GS + 64 * 1024;
constexpr size_t WS_BIAS = WS_IGS + 64 * 1024;
constexpr size_t BIAS_L = 2 * (5632 + 2048 + 5632);
constexpr size_t WS_SSQX = 2 * MiB;
constexpr size_t WS_SSQO = 3 * MiB;
constexpr size_t WS_CS = 4 * MiB;
constexpr size_t WS_KPE = 6 * MiB;
constexpr size_t WS_SSQC = 8 * MiB;
constexpr size_t WS_W = 9 * MiB;
constexpr size_t W_GU1 = 0, W_D1 = W_GU1 + (size_t)5632 * 1024 * 2, W_IN = W_D1 + (size_t)1024 * 2816 * 2, W_UQ = W_IN + (size_t)2048 * 1024 * 2, W_UKV = W_UQ + (size_t)768 * 256 * 2,
                 W_OUT = W_UKV + (size_t)768 * 128 * 2, W_GU2 = W_OUT + (size_t)1024 * 1024 * 2, W_D2 = W_GU2 + (size_t)5632 * 1024 * 2, WL = W_D2 + (size_t)1024 * 2816 * 2;
constexpr size_t WS_XB = WS_W + ((2 * WL + MiB - 1) / MiB) * MiB;
constexpr size_t WS_ACT = WS_XB + 32 * MiB;
constexpr size_t WS_HID = WS_ACT;
constexpr size_t WS_CQ = WS_ACT, WS_CKV = WS_CQ + 8 * MiB, WS_QRAW = WS_CKV + 4 * MiB, WS_KA = WS_QRAW + 36 * MiB, WS_VA = WS_KA + 18 * MiB, WS_QS = WS_VA + 12 * MiB, WS_KS = WS_QS + 12 * MiB,
                 WS_VS = WS_KS + 4 * MiB, WS_QC = WS_VS + 4 * MiB, WS_KC = WS_QC + 8 * MiB, WS_VC = WS_KC + 8 * MiB, WS_OALL = WS_VC + 8 * MiB, WS_END = WS_OALL + 32 * MiB;
static_assert(WS_HID + (size_t)MROWS * DFF * 2 <= WS_END, "d_ws map");
constexpr int CW_BAR = 4096;
constexpr int CW_Q = 40960;
static_assert((CW_Q + 64 * 14) * 4 <= (int)CTL_ZERO_BYTES && CW_BAR + 8 * 3456 <= CW_Q, "ctl map");
constexpr int RING_BYTES = 131072, LDSCTL_OFF = RING_BYTES, MISC_OFF = LDSCTL_OFF + 320, LDS_BYTES = 147456;

__device__ __forceinline__ int hw_lane() { int l; asm volatile("v_mbcnt_lo_u32_b32 %0, -1, 0\n\tv_mbcnt_hi_u32_b32 %0, -1, %0" : "=v"(l)); return l; }
namespace pg8 {
#define PG8_LAS __attribute__((address_space(3)))
typedef unsigned short bf16_t;
typedef short bf16x8 __attribute__((ext_vector_type(8)));
typedef float f32x4 __attribute__((ext_vector_type(4)));
typedef unsigned u32x4 __attribute__((ext_vector_type(4)));
constexpr int BM = 256, BK = 64, HALF = 128, HTB = HALF * BK * 2  , STAGE_BYTES = 8 * HTB, NXCD = 8, WGM = 8;

__host__ __device__ __forceinline__ int lds_byte(int r, int c) { const int st = (r >> 4) * 2 + (c >> 5), rr = r & 15, cc = c & 31, ob = rr * 64 + cc * 2; return st * 1024 + (ob ^ (((ob >> 9) & 1) << 5)); }
__host__ __device__ __forceinline__ void stage_rc(int b, int& R, int& C) { const int st = b / 1024, sb = b % 1024, swz = sb ^ (((sb >> 9) & 1) << 5); R = (st >> 1) * 16 + swz / 64; C = (st & 1) * 32 + (swz % 64) / 2; }
__host__ __device__ __forceinline__ int perm32(int rho) { const int n = rho >> 4, i = rho & 15; return 8 * (i >> 2) + 4 * n + (i & 3); }

struct Unit { int pm, pn; };
struct Gemm { const bf16_t* A; const bf16_t* Bt; int M, N, K; };

struct StaticOrder {
    int nM, nN, nwg, G, c;
    __host__ __device__ void init(int M, int N, int G_, int c_) { nM = M / BM; nN = N / BM; nwg = nM * nN; G = G_; c = c_; }
    __host__ __device__ bool next(int i, Unit& u) const {
        const long L = (long)i * G + c; if (L >= nwg) return false;
        int wgid = (int)L; { const int q = nwg / NXCD, r = nwg % NXCD, xcd = wgid % NXCD, off = wgid / NXCD; wgid = (xcd < r ? xcd * (q + 1) : r * (q + 1) + (xcd - r) * q) + off; }
        const int nig = WGM * nN, gid = wgid / nig, fm = gid * WGM, gsz = (nM - fm) < WGM ? (nM - fm) : WGM;
        u.pm = fm + ((wgid % nig) % gsz); u.pn = (wgid % nig) / gsz; return true;
    }
    __device__ __forceinline__ void a_ready(const Unit&) const {}
    __device__ __forceinline__ void done(const Unit&) const {}
};

__device__ __forceinline__ unsigned cvt_pk_bf16(float lo, float hi) { unsigned r; asm volatile("v_cvt_pk_bf16_f32 %0, %1, %2" : "=v"(r) : "v"(lo), "v"(hi)); return r; }
typedef float f32x2 __attribute__((ext_vector_type(2)));
template <class Epi, class Sched, bool ALIGN_EPI = false, bool SP2 = false>
__device__ __forceinline__ void gemm_phase(PG8_LAS unsigned char* lds, const Gemm g, const Sched& S, const Epi& E, int wave0, unsigned long long* gprof = nullptr) {
#ifdef GEMM_PROF
    const long long gp_t0 = (Epi::AFTER_DRAIN && !Epi::HOOK && blockIdx.x == 0) ? (long long)clock64() : 0ll;
#endif
    int tid_ = wave0 * 64 + hw_lane(); asm volatile("" : "+v"(tid_));
    const int tid = tid_, wid = __builtin_amdgcn_readfirstlane(tid >> 6), lane = tid & 63, wr = wid >> 2, wc = wid & 3, fr = lane & 15, fq = lane >> 4;
    int K_ = g.K; asm volatile("" : "+s"(K_));
    const int K = K_, nt = K / BK;
    unsigned voffA[2], voffB[2];
#pragma unroll
    for (int i = 0; i < 2; ++i) { int R, C; stage_rc(tid * 16 + i * 8192, R, C); const int Rb = Epi::PERM ? ((R & ~31) + perm32(R & 31)) : R;
        voffA[i] = (unsigned)(R * K + C) * 2u; voffB[i] = (unsigned)(Rb * K + C) * 2u; }
    const size_t kstep = (size_t)(BK * 2);
    const size_t hstep = (size_t)HALF * K * 2;
    const size_t tstep = 2 * hstep;
    const unsigned ldsw = (unsigned)wid * 1024u;
    const int aoff = lds_byte(wr * 64 + fr, fq * 8), boff = lds_byte(wc * 32 + fr, fq * 8);
#define PG8_SA(b, h) (((b) * 2 + (h)) * HTB)
#define PG8_SB(b, h) ((4 + (b) * 2 + (h)) * HTB)
#define PG8_STAGE(bufoff, gbase, voff) do { _Pragma("unroll") for (int _i = 0; _i < 2; ++_i) \
        __builtin_amdgcn_global_load_lds((const unsigned*)((const char*)(gbase) + (voff)[_i]), (PG8_LAS unsigned*)(lds + (bufoff) + ldsw + _i * 8192), 16, 0, 0); } while (0)
#define PG8_LDA(dst, b, h) do { _Pragma("unroll") for (int m = 0; m < 4; ++m) _Pragma("unroll") for (int k = 0; k < 2; ++k) dst[m][k] = *(const PG8_LAS bf16x8*)(lds + PG8_SA(b, h) + aoff + m * 2048 + k * 1024); } while (0)
#define PG8_LDB(dst, b, h) do { _Pragma("unroll") for (int n = 0; n < 2; ++n) _Pragma("unroll") for (int k = 0; k < 2; ++k) dst[n][k] = *(const PG8_LAS bf16x8*)(lds + PG8_SB(b, h) + boff + n * 2048 + k * 1024); } while (0)
#define PG8_MMA(ai, bj, At, Bt) do { __builtin_amdgcn_s_setprio(1); _Pragma("unroll") for (int m = 0; m < 4; ++m) _Pragma("unroll") for (int n = 0; n < 2; ++n) _Pragma("unroll") for (int k = 0; k < 2; ++k) \
        acc[ai][bj][m][n] = __builtin_amdgcn_mfma_f32_16x16x32_bf16(Bt[n][k], At[m][k], acc[ai][bj][m][n], 0, 0, 0); __builtin_amdgcn_s_setprio(0); } while (0)
#define PG8_WAIT_V(n) asm volatile("s_waitcnt vmcnt(" #n ")" ::: "memory")
#define PG8_WAIT_L(n) asm volatile("s_waitcnt lgkmcnt(" #n ")" ::: "memory")
#define PG8_BAR __builtin_amdgcn_s_barrier()
#define PG8_SCHED __builtin_amdgcn_sched_barrier(0)
    Unit cur, nxt; int ui = 0;
    if (!S.next(0, cur)) return;
    f32x4 acc[2][2][4][2];
#pragma unroll
    for (int a = 0; a < 2; ++a)
#pragma unroll
        for (int b = 0; b < 2; ++b)
#pragma unroll
            for (int m = 0; m < 4; ++m)
#pragma unroll
                for (int n = 0; n < 2; ++n) acc[a][b][m][n] = (f32x4){0.f, 0.f, 0.f, 0.f};
    bf16x8 At[4][2], B0[2][2], B1[2][2];
    const char* cA = (const char*)g.A + (size_t)cur.pm * tstep; const char* cB = (const char*)g.Bt + (size_t)cur.pn * tstep;
    S.a_ready(cur);
    if constexpr (SP2) {
        PG8_STAGE(PG8_SB(0, 0), cB, voffB); PG8_STAGE(PG8_SB(0, 1), cB + hstep, voffB); PG8_STAGE(PG8_SA(0, 0), cA, voffA); PG8_STAGE(PG8_SA(0, 1), cA + hstep, voffA);
        if (wr == 1) PG8_BAR;
        PG8_WAIT_V(2); PG8_BAR;
        PG8_STAGE(PG8_SB(1, 0), cB + kstep, voffB); PG8_STAGE(PG8_SA(1, 0), cA + kstep, voffA); PG8_STAGE(PG8_SB(1, 1), cB + hstep + kstep, voffB);
        PG8_WAIT_V(6); PG8_BAR;
    } else {
        PG8_STAGE(PG8_SB(0, 0), cB, voffB); PG8_STAGE(PG8_SA(0, 0), cA, voffA); PG8_STAGE(PG8_SB(0, 1), cB + hstep, voffB); PG8_STAGE(PG8_SA(0, 1), cA + hstep, voffA);
        if (wr == 1) PG8_BAR;
        PG8_WAIT_V(4); PG8_BAR;
        PG8_STAGE(PG8_SB(1, 0), cB + kstep, voffB); PG8_STAGE(PG8_SA(1, 0), cA + kstep, voffA); PG8_STAGE(PG8_SB(1, 1), cB + hstep + kstep, voffB);
        PG8_WAIT_V(6); PG8_BAR;
    }
    for (;;) {
        const bool has_next = S.next(ui + 1, nxt);
        const char* nA = has_next ? (const char*)g.A + (size_t)nxt.pm * tstep : cA; const char* nB = has_next ? (const char*)g.Bt + (size_t)nxt.pn * tstep : cB;
#pragma nounroll
        for (int t = 0; t < nt; t += 2) {
            if constexpr (Epi::HOOK) E.hook(acc, cur, t, wr, wc, fr, fq);
            const bool last = (t == nt - 2);
            const char* a1 = cA + (size_t)(t + 1) * kstep;
            const char* a2 = last ? nA : cA + (size_t)(t + 2) * kstep; const char* b2 = last ? nB : cB + (size_t)(t + 2) * kstep;
            const char* a3 = a2 + kstep; const char* b3 = b2 + kstep;
            if (last && has_next) S.a_ready(nxt);
            if constexpr (SP2) {
            PG8_LDB(B0, 0, 0); PG8_LDB(B1, 0, 1); PG8_SCHED; PG8_LDA(At, 0, 0); PG8_STAGE(PG8_SA(1, 1), a1 + hstep, voffA);
            PG8_WAIT_V(8); PG8_WAIT_L(0); PG8_BAR; PG8_MMA(0, 0, At, B0); PG8_MMA(0, 1, At, B1); PG8_BAR; PG8_SCHED;
            PG8_LDA(At, 0, 1); PG8_STAGE(PG8_SB(0, 0), b2, voffB); PG8_STAGE(PG8_SB(0, 1), b2 + hstep, voffB); PG8_STAGE(PG8_SA(0, 0), a2, voffA);
            PG8_WAIT_V(8); PG8_WAIT_L(0); PG8_BAR; PG8_MMA(1, 0, At, B0); PG8_MMA(1, 1, At, B1); PG8_BAR; PG8_SCHED;
            PG8_LDB(B0, 1, 0); PG8_LDB(B1, 1, 1); PG8_SCHED; PG8_LDA(At, 1, 0); PG8_STAGE(PG8_SA(0, 1), a2 + hstep, voffA);
            PG8_WAIT_V(8); PG8_WAIT_L(0); PG8_BAR; PG8_MMA(0, 0, At, B0); PG8_MMA(0, 1, At, B1); PG8_BAR; PG8_SCHED;
            PG8_LDA(At, 1, 1); PG8_STAGE(PG8_SB(1, 0), b3, voffB); PG8_STAGE(PG8_SB(1, 1), b3 + hstep, voffB); PG8_STAGE(PG8_SA(1, 0), a3, voffA);
            PG8_WAIT_V(8); PG8_WAIT_L(0); PG8_BAR; PG8_MMA(1, 0, At, B0); PG8_MMA(1, 1, At, B1); PG8_BAR; PG8_SCHED;
            } else {
            PG8_LDB(B0, 0, 0); PG8_SCHED; PG8_LDA(At, 0, 0); PG8_STAGE(PG8_SA(1, 1), a1 + hstep, voffA);
            PG8_WAIT_L(8); PG8_BAR; PG8_WAIT_L(0); PG8_MMA(0, 0, At, B0); PG8_BAR; PG8_SCHED;
            PG8_LDB(B1, 0, 1); PG8_STAGE(PG8_SB(0, 0), b2, voffB);
            PG8_BAR; PG8_WAIT_L(0); PG8_MMA(0, 1, At, B1); PG8_BAR;
            PG8_LDA(At, 0, 1); PG8_STAGE(PG8_SA(0, 0), a2, voffA);
            PG8_BAR; PG8_WAIT_L(0); PG8_MMA(1, 0, At, B0); PG8_BAR; PG8_SCHED;
            PG8_STAGE(PG8_SB(0, 1), b2 + hstep, voffB);
            PG8_WAIT_V(6); PG8_BAR; PG8_MMA(1, 1, At, B1); PG8_BAR;
            PG8_LDB(B0, 1, 0); PG8_SCHED; PG8_LDA(At, 1, 0); PG8_STAGE(PG8_SA(0, 1), a2 + hstep, voffA);
            PG8_WAIT_L(8); PG8_BAR; PG8_WAIT_L(0); PG8_MMA(0, 0, At, B0); PG8_BAR; PG8_SCHED;
            PG8_LDB(B1, 1, 1); PG8_STAGE(PG8_SB(1, 0), b3, voffB);
            PG8_BAR; PG8_WAIT_L(0); PG8_MMA(0, 1, At, B1); PG8_BAR;
            PG8_LDA(At, 1, 1); PG8_STAGE(PG8_SA(1, 0), a3, voffA);
            PG8_BAR; PG8_WAIT_L(0); PG8_MMA(1, 0, At, B0); PG8_BAR; PG8_SCHED;
            PG8_STAGE(PG8_SB(1, 1), b3 + hstep, voffB);
            PG8_WAIT_V(6); PG8_BAR; PG8_MMA(1, 1, At, B1); PG8_BAR;
            }
        }
        if constexpr (ALIGN_EPI) { if (wr == 0) PG8_BAR; }
        if constexpr (!Epi::AFTER_DRAIN) {
            Unit ce = cur; asm volatile("" : "+s"(ce.pm), "+s"(ce.pn)); int fre = fr, fqe = fq; asm volatile("" : "+v"(fre), "+v"(fqe));
            E(acc, ce, wr, wc, fre, fqe); S.done(cur); }
        if (!has_next) break;
#pragma unroll
        for (int a = 0; a < 2; ++a)
#pragma unroll
            for (int b = 0; b < 2; ++b)
#pragma unroll
                for (int m = 0; m < 4; ++m)
#pragma unroll
                    for (int n = 0; n < 2; ++n) acc[a][b][m][n] = (f32x4){0.f, 0.f, 0.f, 0.f};
        cur = nxt; cA = nA; cB = nB; ++ui;
        if constexpr (ALIGN_EPI) { if (wr == 1) PG8_BAR; }
    }
    PG8_WAIT_V(0);
    if constexpr (!ALIGN_EPI) { if (wr == 0) PG8_BAR; }
    PG8_BAR;
#ifdef GEMM_PROF
    const long long gp_t1 = (Epi::AFTER_DRAIN && !Epi::HOOK && blockIdx.x == 0) ? (long long)clock64() : 0ll;
#endif
    if constexpr (Epi::AFTER_DRAIN) { E.fused(acc, cur, wr, wc, fr, fq, lds, wid, lane); S.done(cur); }
#ifdef GEMM_PROF
    if (Epi::AFTER_DRAIN && !Epi::HOOK && blockIdx.x == 0 && tid == 0 && gprof) { const long long gp_t2 = clock64(); atomicAdd(gprof + 0, (unsigned long long)(gp_t1 - gp_t0)); atomicAdd(gprof + 1, (unsigned long long)(gp_t2 - gp_t1)); atomicAdd(gprof + 2, 1ull); }
#endif
#undef PG8_SA
#undef PG8_SB
#undef PG8_STAGE
#undef PG8_LDA
#undef PG8_LDB
#undef PG8_MMA
#undef PG8_WAIT_V
#undef PG8_WAIT_L
#undef PG8_BAR
#undef PG8_SCHED
}
constexpr float RMS_EPS = 1e-6f;
constexpr int MROWS_ = 16384;
constexpr float LOG2E = 1.4426950408889634f;
typedef unsigned u32x2 __attribute__((ext_vector_type(2)));
#define PG8_FENCE() asm volatile("" ::: "memory")
#define PG8_G __attribute__((address_space(1)))
__device__ __forceinline__ float sum16f(const PG8_G float* p) {
    const f32x4 a = *(const PG8_G f32x4*)p, b = *(const PG8_G f32x4*)(p + 4), c = *(const PG8_G f32x4*)(p + 8), d = *(const PG8_G f32x4*)(p + 12);
    return ((a[0] + a[1]) + (a[2] + a[3])) + ((b[0] + b[1]) + (b[2] + b[3])) + ((c[0] + c[1]) + (c[2] + c[3])) + ((d[0] + d[1]) + (d[2] + d[3]));
}
__device__ __forceinline__ float xsum16(float x) { auto r = __builtin_amdgcn_permlane16_swap(__float_as_uint(x), __float_as_uint(x), false, false); return __uint_as_float(r[0]) + __uint_as_float(r[1]); }
__device__ __forceinline__ float xsum32(float x) { auto r = __builtin_amdgcn_permlane32_swap(__float_as_uint(x), __float_as_uint(x), false, false); return __uint_as_float(r[0]) + __uint_as_float(r[1]); }
__device__ __forceinline__ float wave_sum_dpp(float x) {
    x += __builtin_bit_cast(float, __builtin_amdgcn_update_dpp(0, __builtin_bit_cast(int, x), 0xB1, 0xf, 0xf, true));
    x += __builtin_bit_cast(float, __builtin_amdgcn_update_dpp(0, __builtin_bit_cast(int, x), 0x4E, 0xf, 0xf, true));
    x += __builtin_bit_cast(float, __builtin_amdgcn_update_dpp(0, __builtin_bit_cast(int, x), 0x141, 0xf, 0xf, true));
    x += __builtin_bit_cast(float, __builtin_amdgcn_update_dpp(0, __builtin_bit_cast(int, x), 0x140, 0xf, 0xf, true));
    return xsum32(xsum16(x));
}
__device__ __forceinline__ float fast_rcp(float x) { return __builtin_amdgcn_rcpf(x); }
__device__ __forceinline__ float silu_fast(float g) { return g * fast_rcp(1.0f + __builtin_amdgcn_exp2f(-g * LOG2E)); }
__device__ __forceinline__ float sq4(const f32x4 v) { return (v[0] * v[0] + v[1] * v[1]) + (v[2] * v[2] + v[3] * v[3]); }

struct EpiUp {
    static constexpr bool PERM = true, AFTER_DRAIN = false, HOOK = false;
    PG8_G unsigned char* ws; const PG8_G float* bias;
    __device__ __forceinline__ void hook(f32x4 (&)[2][2][4][2], const Unit&, int, int, int, int, int) const {}
    __device__ __forceinline__ void operator()(const f32x4 (&acc)[2][2][4][2], const Unit& u, int wr, int wc, int fr, int fq) const {
        PG8_G bf16_t* HID = (PG8_G bf16_t*)(ws + WS_HID); const PG8_G float* ssqx = (const PG8_G float*)(ws + WS_SSQX);
        const int b = u.pm >> 5;
        const PG8_G float* bb = bias + b * 5632 + u.pn * BM + wc * 32 + 8 * fq;
        f32x4 bg[2], bu[2];
#pragma unroll
        for (int n = 0; n < 2; ++n) { bg[n] = *(const PG8_G f32x4*)(bb + 4 * n); bu[n] = *(const PG8_G f32x4*)(bb + HALF + 4 * n); }
#pragma unroll
        for (int ai = 0; ai < 2; ++ai)
#pragma unroll
            for (int m = 0; m < 4; ++m) {
                const int row = u.pm * BM + ai * HALF + wr * 64 + m * 16 + fr;
                const float r = 1.0f / sqrtf(sum16f(ssqx + (size_t)row * 16) * (1.0f / 1024.0f) + RMS_EPS);
                float hv[8];
#pragma unroll
                for (int n = 0; n < 2; ++n)
#pragma unroll
                    for (int i = 0; i < 4; ++i) { const float g = acc[ai][0][m][n][i] * r + bg[n][i], uu = acc[ai][1][m][n][i] * r + bu[n][i]; hv[4 * n + i] = silu_fast(g) * uu; }
                u32x4 w; w.x = cvt_pk_bf16(hv[0], hv[1]); w.y = cvt_pk_bf16(hv[2], hv[3]); w.z = cvt_pk_bf16(hv[4], hv[5]); w.w = cvt_pk_bf16(hv[6], hv[7]);
                *(PG8_G u32x4*)(HID + (size_t)row * 2816 + u.pn * HALF + wc * 32 + 8 * fq) = w;
                if (m & 1) PG8_FENCE();
            }
    }
};

template <bool HOOKED> struct EpiResS {
    static constexpr bool PERM = false, AFTER_DRAIN = true, HOOK = HOOKED;
    PG8_G float* fout; PG8_G unsigned char* ws; const PG8_G float* gate; const PG8_G float* igs; const PG8_G float* gs; float coef;
    __device__ __forceinline__ void group_r(int row, float& rA, float& rB, float& rC) const {
        const PG8_G float* p = (const PG8_G float*)(ws + WS_SSQO) + (size_t)row * 16;
        const f32x4 a = *(const PG8_G f32x4*)p, b = *(const PG8_G f32x4*)(p + 4), c = *(const PG8_G f32x4*)(p + 8), d = *(const PG8_G f32x4*)(p + 12);
        const float sA = ((a[0] + a[1]) + (a[2] + a[3])) + (b[0] + b[1]), sB = ((b[2] + b[3]) + (c[0] + c[1])) + (c[2] + c[3]), sC = (d[0] + d[1]) + (d[2] + d[3]);
        rA = 1.0f / sqrtf(sA * (1.0f / 384.0f) + RMS_EPS); rB = 1.0f / sqrtf(sB * (1.0f / 384.0f) + RMS_EPS); rC = 1.0f / sqrtf(sC * (1.0f / 256.0f) + RMS_EPS);
    }
    __device__ __forceinline__ void hook(f32x4 (&acc)[2][2][4][2], const Unit& u, int t, int wr, int wc, int fr, int fq) const {
        if (t != 6 && t != 12) return;
        asm volatile("" : "+v"(fr));
#pragma unroll
        for (int ai = 0; ai < 2; ++ai)
#pragma unroll
            for (int m = 0; m < 4; ++m) {
                const int row = u.pm * BM + ai * HALF + wr * 64 + m * 16 + fr;
                float rA, rB, rC; group_r(row, rA, rB, rC);
                const float f = (t == 6) ? rA / rB : rB / rC;
#pragma unroll
                for (int bj = 0; bj < 2; ++bj)
#pragma unroll
                    for (int n = 0; n < 2; ++n) acc[ai][bj][m][n] = acc[ai][bj][m][n] * f;
                PG8_FENCE();
            }
    }
    __device__ __forceinline__ void fused(f32x4 (&acc)[2][2][4][2], const Unit& u, int wr, int wc, int fr, int fq, PG8_LAS unsigned char* lds, int wid, int lane) const {
        PG8_G bf16_t* xb = (PG8_G bf16_t*)(ws + WS_XB); PG8_G float* ssq_out = (PG8_G float*)(ws + WS_SSQX); constexpr int gate_bstride = 9 * 1024;
        const int b = u.pm >> 5, colg = u.pn * BM + 4 * lane;
        const f32x4 gv = *(const PG8_G f32x4*)(gate + (size_t)b * gate_bstride + colg) * coef;
        const f32x4 gsv = gs ? *(const PG8_G f32x4*)(gs + (size_t)b * 1024 + colg) : (f32x4){0.f, 0.f, 0.f, 0.f};
        const f32x4 igv = *(const PG8_G f32x4*)(igs + (size_t)b * 1024 + colg);
#pragma unroll
        for (int ai = 0; ai < 2; ++ai) {
#pragma unroll
            for (int m = 0; m < 4; ++m) { const int rl = wr * 64 + m * 16 + fr;
#pragma unroll
                for (int bj = 0; bj < 2; ++bj)
#pragma unroll
                    for (int n = 0; n < 2; ++n) { const int c = 32 * bj + 8 * wc + 4 * n + fq; *(PG8_LAS f32x4*)(lds + rl * 1024 + ((c ^ (rl & 7)) << 4)) = acc[ai][bj][m][n]; } }
            asm volatile("s_waitcnt lgkmcnt(0)\n\ts_barrier" ::: "memory");
#pragma unroll
            for (int half = 0; half < 2; ++half) {
                u32x2 xo[8];
#pragma unroll
                for (int k = 0; k < 8; ++k) { const int rl = wid + 8 * (half * 8 + k); xo[k] = *(const PG8_G u32x2*)(xb + (size_t)(u.pm * BM + ai * HALF + rl) * 1024 + colg); }
#pragma unroll
                for (int k = 0; k < 8; ++k) { const int rl = wid + 8 * (half * 8 + k); const int row = u.pm * BM + ai * HALF + rl;
                    f32x4 t = *(const PG8_LAS f32x4*)(lds + rl * 1024 + ((lane ^ (rl & 7)) << 4));
                    if (HOOKED) { float rA, rB, rC; group_r(row, rA, rB, rC); t = t * rC; }
                    const f32x4 xs = {__uint_as_float(xo[k].x << 16), __uint_as_float(xo[k].x & 0xffff0000u), __uint_as_float(xo[k].y << 16), __uint_as_float(xo[k].y & 0xffff0000u)};
                    const f32x4 xn = xs * igv + gv * t;
                    if (!gs) *(PG8_G f32x4*)(fout + (size_t)row * 1024 + colg) = xn;
                    if (gs) { const f32x4 y = xn * gsv; u32x2 w; w.x = cvt_pk_bf16(y[0], y[1]); w.y = cvt_pk_bf16(y[2], y[3]); *(PG8_G u32x2*)(xb + (size_t)row * 1024 + colg) = w; }
                    float ss = sq4(xn);
                    ss = wave_sum_dpp(ss);
                    if (gs && lane == 0) *(PG8_G f32x4*)(ssq_out + (size_t)row * 16 + 4 * u.pn) = (f32x4){ss, 0.f, 0.f, 0.f};
                }
            }
            asm volatile("s_waitcnt lgkmcnt(0)\n\ts_barrier" ::: "memory");
        }
    }
};

struct EpiIn {
    static constexpr bool PERM = true, AFTER_DRAIN = false, HOOK = false;
    PG8_G unsigned char* ws; const PG8_G float* gq; const PG8_G float* gk; const PG8_G float* bias;
    __device__ __forceinline__ void hook(f32x4 (&)[2][2][4][2], const Unit&, int, int, int, int, int) const {}
    __device__ __forceinline__ void operator()(const f32x4 (&acc)[2][2][4][2], const Unit& u, int wr, int wc, int fr, int fq) const {
        const int slot = u.pn * 4 + wc;
        if (slot == 7 || slot >= 30) return;
        const int b = u.pm >> 5;
        const PG8_G float* ssqx = (const PG8_G float*)(ws + WS_SSQX);
        PG8_G PG8_G bf16_t* dst = nullptr; int pitch = 0, col0 = 0; int kind = 0;
        PG8_G PG8_G float* ssqd = nullptr; int ssqp = 0, ssqi = 0; const PG8_G float* gain = nullptr; float scale = 1.0f;
        if (slot < 4)       { dst = (PG8_G bf16_t*)(ws + WS_CQ);  pitch = 256; col0 = 64 * slot;        kind = 1; ssqd = (PG8_G float*)(ws + WS_SSQC);  ssqp = 4; ssqi = slot; }
        else if (slot < 6)  { dst = (PG8_G bf16_t*)(ws + WS_CKV); pitch = 128; col0 = 64 * (slot - 4);  kind = 1; ssqd = (PG8_G float*)(ws + WS_SSQC) + (size_t)MROWS_ * 4; ssqp = 2; ssqi = slot - 4; }
        else if (slot == 6) { kind = 3; }
        else if (slot < 14) { dst = (PG8_G bf16_t*)(ws + WS_QS);  pitch = 384; col0 = 64 * (slot - 8);  kind = 2; gain = gq; scale = 0.125f * LOG2E; }
        else if (slot < 16) { dst = (PG8_G bf16_t*)(ws + WS_KS);  pitch = 128; col0 = 64 * (slot - 14); kind = 2; gain = gk; }
        else if (slot < 18) { dst = (PG8_G bf16_t*)(ws + WS_VS);  pitch = 128; col0 = 64 * (slot - 16); }
        else if (slot < 22) { dst = (PG8_G bf16_t*)(ws + WS_QC);  pitch = 256; col0 = 64 * (slot - 18); scale = 0.125f * LOG2E; }
        else if (slot < 26) { dst = (PG8_G bf16_t*)(ws + WS_KC);  pitch = 256; col0 = 64 * (slot - 22); }
        else                { dst = (PG8_G bf16_t*)(ws + WS_VC);  pitch = 256; col0 = 64 * (slot - 26); }
        const PG8_G float* bb = bias + b * 2048 + u.pn * BM + wc * 32 + 8 * fq;
        f32x4 bv[2][2], gn[2][2];
#pragma unroll
        for (int bj = 0; bj < 2; ++bj)
#pragma unroll
            for (int n = 0; n < 2; ++n) { bv[bj][n] = *(const PG8_G f32x4*)(bb + bj * HALF + 4 * n);
                gn[bj][n] = (kind == 2) ? *(const PG8_G f32x4*)(gain + 32 * bj + 8 * fq + 4 * n) * scale : (f32x4){scale, scale, scale, scale}; }
#pragma unroll
        for (int ai = 0; ai < 2; ++ai)
#pragma unroll
            for (int m = 0; m < 4; ++m) {
                const int row = u.pm * BM + ai * HALF + wr * 64 + m * 16 + fr;
                const float r = 1.0f / sqrtf(sum16f(ssqx + (size_t)row * 16) * (1.0f / 1024.0f) + RMS_EPS);
                f32x4 v[2][2]; float ss = 0.f;
#pragma unroll
                for (int bj = 0; bj < 2; ++bj)
#pragma unroll
                    for (int n = 0; n < 2; ++n) { v[bj][n] = acc[ai][bj][m][n] * r + bv[bj][n]; ss += sq4(v[bj][n]); }
                if (kind == 3) {
                    float s0 = sq4(v[0][0]) + sq4(v[0][1]);
                    s0 = xsum32(xsum16(s0));
                    *(PG8_G f32x4*)((PG8_G float*)(ws + WS_KPE) + (size_t)row * 32 + 8 * fq) = v[0][0]; *(PG8_G f32x4*)((PG8_G float*)(ws + WS_KPE) + (size_t)row * 32 + 8 * fq + 4) = v[0][1];
                    if (fq == 0) ((PG8_G float*)(ws + WS_SSQC) + (size_t)MROWS_ * 6)[row] = s0;
                } else {
                    if (kind != 0) { ss = xsum32(xsum16(ss)); }
                    float rn = 1.0f;
                    if (kind == 2) rn = 1.0f / sqrtf(ss * (1.0f / 64.0f) + RMS_EPS);
                    if (kind == 1 && fq == 0) ssqd[(size_t)row * ssqp + ssqi] = ss;
#pragma unroll
                    for (int bj = 0; bj < 2; ++bj) {
                        const f32x4 y0 = v[bj][0] * gn[bj][0] * rn, y1 = v[bj][1] * gn[bj][1] * rn;
                        u32x4 w; w.x = cvt_pk_bf16(y0[0], y0[1]); w.y = cvt_pk_bf16(y0[2], y0[3]); w.z = cvt_pk_bf16(y1[0], y1[1]); w.w = cvt_pk_bf16(y1[2], y1[3]);
                        *(PG8_G u32x4*)(dst + (size_t)row * pitch + col0 + 32 * bj + 8 * fq) = w;
                    }
                }
                if (m & 1) PG8_FENCE();
            }
    }
};

struct EpiUq {
    static constexpr bool PERM = false, AFTER_DRAIN = false, HOOK = false;
    PG8_G unsigned char* ws;
    __device__ __forceinline__ void hook(f32x4 (&)[2][2][4][2], const Unit&, int, int, int, int, int) const {}
    __device__ __forceinline__ void operator()(const f32x4 (&acc)[2][2][4][2], const Unit& u, int wr, int wc, int fr, int fq) const {
        PG8_G bf16_t* QRAW = (PG8_G bf16_t*)(ws + WS_QRAW); const PG8_G float* ssqcq = (const PG8_G float*)(ws + WS_SSQC);
        const int col0 = u.pn * BM + wc * 32 + 4 * fq;
#pragma unroll
        for (int ai = 0; ai < 2; ++ai)
#pragma unroll
            for (int m = 0; m < 4; ++m) {
                const int row = u.pm * BM + ai * HALF + wr * 64 + m * 16 + fr;
                const f32x4 s = *(const PG8_G f32x4*)(ssqcq + (size_t)row * 4);
                const float r = 1.0f / sqrtf(((s[0] + s[1]) + (s[2] + s[3])) * (1.0f / 256.0f) + RMS_EPS);
#pragma unroll
                for (int bj = 0; bj < 2; ++bj)
#pragma unroll
                    for (int n = 0; n < 2; ++n) { const int c = col0 + bj * HALF + n * 16; if (c < 576) { const f32x4 y = acc[ai][bj][m][n] * r; u32x2 w; w.x = cvt_pk_bf16(y[0], y[1]); w.y = cvt_pk_bf16(y[2], y[3]); *(PG8_G u32x2*)(QRAW + (size_t)row * 576 + c) = w; } }
            }
    }
};

struct EpiUkv {
    static constexpr bool PERM = true, AFTER_DRAIN = false, HOOK = false;
    PG8_G unsigned char* ws; const PG8_G float* gk;
    __device__ __forceinline__ void hook(f32x4 (&)[2][2][4][2], const Unit&, int, int, int, int, int) const {}
    __device__ __forceinline__ void operator()(const f32x4 (&acc)[2][2][4][2], const Unit& u, int wr, int wc, int fr, int fq) const {
        PG8_G bf16_t* KA = (PG8_G bf16_t*)(ws + WS_KA); PG8_G bf16_t* VA = (PG8_G bf16_t*)(ws + WS_VA); const PG8_G float* ssqckv = (const PG8_G float*)(ws + WS_SSQC) + (size_t)MROWS_ * 4; const PG8_G float* ssqkpe = (const PG8_G float*)(ws + WS_SSQC) + (size_t)MROWS_ * 6;
        const PG8_G float* kpe = (const PG8_G float*)(ws + WS_KPE); const PG8_G float* cs = (const PG8_G float*)(ws + WS_CS);
        const int h = 2 * u.pn + (wc >> 1); const bool isv = (wc & 1) != 0;
        f32x4 gn[2][2], g1 = {1.f, 1.f, 1.f, 1.f}, g2 = {1.f, 1.f, 1.f, 1.f};
        if (!isv) {
#pragma unroll
            for (int bj = 0; bj < 2; ++bj)
#pragma unroll
                for (int n = 0; n < 2; ++n) gn[bj][n] = *(const PG8_G f32x4*)(gk + 32 * bj + 8 * fq + 4 * n);
            g1 = *(const PG8_G f32x4*)(gk + 64 + 4 * fq); g2 = *(const PG8_G f32x4*)(gk + 80 + 4 * fq);
        }
#pragma unroll
        for (int ai = 0; ai < 2; ++ai)
#pragma unroll
            for (int m = 0; m < 4; ++m) {
                const int row = u.pm * BM + ai * HALF + wr * 64 + m * 16 + fr;
                const float r = 1.0f / sqrtf((ssqckv[(size_t)row * 2] + ssqckv[(size_t)row * 2 + 1]) * (1.0f / 128.0f) + RMS_EPS);
                f32x4 v[2][2]; float ss = 0.f;
#pragma unroll
                for (int bj = 0; bj < 2; ++bj)
#pragma unroll
                    for (int n = 0; n < 2; ++n) { v[bj][n] = acc[ai][bj][m][n] * r; ss += sq4(v[bj][n]); }
                if (isv) {
#pragma unroll
                    for (int bj = 0; bj < 2; ++bj) { u32x4 w; w.x = cvt_pk_bf16(v[bj][0][0], v[bj][0][1]); w.y = cvt_pk_bf16(v[bj][0][2], v[bj][0][3]); w.z = cvt_pk_bf16(v[bj][1][0], v[bj][1][1]); w.w = cvt_pk_bf16(v[bj][1][2], v[bj][1][3]);
                        *(PG8_G u32x4*)(VA + ((size_t)(row >> 6) * 6 + h) * 4096 + bj * 2048 + (row & 63) * 32 + 8 * fq) = w; }
                } else {
                    ss = xsum32(xsum16(ss));
                    const float rk = 1.0f / sqrtf((ss + ssqkpe[row]) * (1.0f / 96.0f) + RMS_EPS);
                    PG8_G bf16_t* kd = KA + ((size_t)(row >> 6) * 6 + h) * 6144 + (row & 63) * 8;
#pragma unroll
                    for (int bj = 0; bj < 2; ++bj) { const f32x4 y0 = v[bj][0] * gn[bj][0] * rk, y1 = v[bj][1] * gn[bj][1] * rk;
                        u32x4 w; w.x = cvt_pk_bf16(y0[0], y0[1]); w.y = cvt_pk_bf16(y0[2], y0[3]); w.z = cvt_pk_bf16(y1[0], y1[1]); w.w = cvt_pk_bf16(y1[2], y1[3]);
                        *(PG8_G u32x4*)(kd + (4 * bj + fq) * 512) = w; }
                    const f32x4 x1 = *(const PG8_G f32x4*)(kpe + (size_t)row * 32 + 4 * fq) * g1 * rk, x2 = *(const PG8_G f32x4*)(kpe + (size_t)row * 32 + 16 + 4 * fq) * g2 * rk;
                    const f32x4 c = *(const PG8_G f32x4*)(cs + (size_t)row * 32 + 4 * fq), s = *(const PG8_G f32x4*)(cs + (size_t)row * 32 + 16 + 4 * fq);
                    const f32x4 o1 = x1 * c - x2 * s, o2 = x2 * c + x1 * s;
                    u32x2 w1, w2; w1.x = cvt_pk_bf16(o1[0], o1[1]); w1.y = cvt_pk_bf16(o1[2], o1[3]); w2.x = cvt_pk_bf16(o2[0], o2[1]); w2.y = cvt_pk_bf16(o2[2], o2[3]);
                    *(PG8_G u32x2*)(kd + (8 + (fq >> 1)) * 512 + (fq & 1) * 4) = w1; *(PG8_G u32x2*)(kd + (10 + (fq >> 1)) * 512 + (fq & 1) * 4) = w2;
                }
                if (m & 1) PG8_FENCE();
            }
    }
};
}
#define GAS __attribute__((address_space(1)))
#define LAS __attribute__((address_space(3)))
typedef unsigned short bf16;
typedef unsigned v4u __attribute__((ext_vector_type(4)));
typedef float f32x4 __attribute__((ext_vector_type(4)));
typedef short bf16x8 __attribute__((ext_vector_type(8)));
typedef GAS unsigned gu32;
typedef GAS unsigned long long gu64;
#define RLX_AGENT __ATOMIC_RELAXED, __HIP_MEMORY_SCOPE_AGENT
#define LDS_WAIT() asm volatile("s_waitcnt lgkmcnt(0)" ::: "memory")
#define VM_WAIT() asm volatile("s_waitcnt vmcnt(0)" ::: "memory")
__device__ __forceinline__ unsigned long long rt() { return __builtin_amdgcn_s_memrealtime(); }
__device__ __forceinline__ unsigned f2bf(float f) { unsigned u = __builtin_bit_cast(unsigned, f); return (u + 0x7fffu + ((u >> 16) & 1u)) >> 16; }
__device__ __forceinline__ unsigned pk2(float lo, float hi) { return f2bf(lo) | (f2bf(hi) << 16); }

#define XB_TMO      128
#define XB_XCNT(j)  (256  + 64 * (j))
#define XB_XSUB(j)  (1280 + 64 * (j))
#define XB_XGEN(j)  (2304 + 64 * (j))
#define XB_TOP      3328
#define XB_TOPGEN   3392
#define XCD_BAR_WORDS 3456
#define XB_SPIN_CAP (1u << 18)

__device__ __forceinline__ unsigned xb_ld(unsigned* p)              { return __hip_atomic_load(p, __ATOMIC_RELAXED, __HIP_MEMORY_SCOPE_AGENT); }
__device__ __forceinline__ unsigned xb_add(unsigned* p, unsigned v) { return __hip_atomic_fetch_add(p, v, __ATOMIC_RELAXED, __HIP_MEMORY_SCOPE_AGENT); }
__device__ __forceinline__ unsigned xb_xcc_id() { return (unsigned)__builtin_amdgcn_s_getreg((3 << 11) | 20) & 0xFu; }
#define XB_SPIN(cond, bar) do { unsigned _sp = 0; while (cond) { __builtin_amdgcn_s_sleep(1); \
    if ((++_sp & 255u) == 0u) { if (xb_ld(&(bar)[XB_TMO])) break; if (_sp > XB_SPIN_CAP) { atomicAdd(&(bar)[XB_TMO], 1u); break; } } } } while (0)

struct XcdBarrier {
    unsigned* bar; unsigned x;
    volatile LAS unsigned* st;
    int w0;
};

__device__ __forceinline__ XcdBarrier xcd_barrier_post(unsigned* bar, volatile LAS unsigned* st, int w0) {
    XcdBarrier b; b.bar = bar; b.x = xb_xcc_id(); b.st = st; b.w0 = w0;
    if (w0 == 0 && hw_lane() == 0) (void)xb_add(&bar[XB_XCNT(b.x)], 1u);
    return b;
}
__device__ __forceinline__ void xcd_barrier_complete(unsigned* bar, unsigned x, unsigned& nloc, unsigned& nx) {
    const unsigned G = gridDim.x * gridDim.y * gridDim.z;
    unsigned sum, cnt, mine, sp = 0u;
    for (;;) {
        sum = 0u; cnt = 0u; mine = 0u;
#pragma unroll
        for (unsigned j = 0; j < 16; ++j) { const unsigned c = xb_ld(&bar[XB_XCNT(j)]); sum += c; cnt += (c > 0u) ? 1u : 0u; mine = (j == x) ? c : mine; }
        if (sum == G) break;
        __builtin_amdgcn_s_sleep(1);
        if ((++sp & 255u) == 0u) { if (xb_ld(&bar[XB_TMO])) break; if (sp > XB_SPIN_CAP) { atomicAdd(&bar[XB_TMO], 1u); break; } }
    }
    nloc = mine > 0u ? mine : 1u; nx = cnt > 0u ? cnt : 1u;
}

__device__ __forceinline__ void xcd_barrier(const XcdBarrier& b) {
    asm volatile("s_waitcnt vmcnt(0)" ::: "memory");
    __syncthreads();
    if (b.w0 == 0 && hw_lane() == 0) {
        unsigned* bar = b.bar;
        __builtin_amdgcn_s_waitcnt(0);
        unsigned nloc = b.st[0], nx = b.st[1];
        if (nloc == 0u) { xcd_barrier_complete(bar, b.x, nloc, nx); b.st[0] = nloc; b.st[1] = nx; }
        const unsigned old = xb_add(&bar[XB_XSUB(b.x)], 1u);
        const unsigned gen = old / nloc;
        if (old + 1u == (gen + 1u) * nloc) {
            __builtin_amdgcn_fence(__ATOMIC_RELEASE, "agent");
            asm volatile("s_waitcnt vmcnt(0)" ::: "memory");
            const unsigned og = xb_add(&bar[XB_TOP], 1u);
            const unsigned tg = og / nx;
            if (og + 1u == (tg + 1u) * nx) xb_add(&bar[XB_TOPGEN], 1u);
            else XB_SPIN(xb_ld(&bar[XB_TOPGEN]) == tg, bar);
            __builtin_amdgcn_fence(__ATOMIC_ACQUIRE, "agent");
            xb_add(&bar[XB_XGEN(b.x)], 1u);
            asm volatile("s_waitcnt vmcnt(0)" ::: "memory");
        } else {
            XB_SPIN(xb_ld(&bar[XB_XGEN(b.x)]) == gen, bar);
            __builtin_amdgcn_fence(__ATOMIC_ACQUIRE, "agent");
            asm volatile("s_waitcnt vmcnt(0)" ::: "memory");
        }
    }
    __syncthreads();
}
namespace att {
typedef unsigned short bf16_t;
typedef short bf16x8 __attribute__((ext_vector_type(8)));
typedef short s16x4 __attribute__((ext_vector_type(4)));
typedef short v4i16_t __attribute__((ext_vector_type(4)));
typedef float f32x16 __attribute__((ext_vector_type(16)));
typedef float f32x4 __attribute__((ext_vector_type(4)));
typedef float f32x2 __attribute__((ext_vector_type(2)));
typedef __bf16 bf16x2_t __attribute__((ext_vector_type(2)));
typedef unsigned u32x4 __attribute__((ext_vector_type(4)));
typedef int i32x4 __attribute__((ext_vector_type(4)));
#define ALAS __attribute__((address_space(3)))
#define AGAS __attribute__((address_space(1)))
constexpr int SEQ = 8192;
constexpr float LOG2E = 1.4426950408889634f, EPS = 1e-6f;
constexpr int KCS = 1040, VHS = 4160;
constexpr int KSLOT = 12 * KCS, VSLOT = 2 * VHS;
constexpr int L_K = 0, L_V = 3 * KSLOT, L_POS = L_V + 4 * VSLOT, L_TB = L_POS + 1024, L_WSF = L_TB + 128, L_OST = L_WSF + 8 * 256, L_FLAG = L_OST + 8 * 4096, L_END = L_FLAG + 16 + 64;
static_assert(L_OST % 16 == 0 && L_V % 16 == 0 && L_END <= 131072, "attention LDS map");
constexpr int S1_KS = 8 * KCS, S1_K = 0, S1_V = 7 * S1_KS, S1_P = S1_V + 7 * VSLOT, S1_LUT = S1_P + 7 * 256, S1_WSF = S1_LUT + 528, S1_END = S1_WSF + 8 * 256;
static_assert(S1_END <= L_FLAG || S1_END <= 131072, "sliding-window LDS map"); static_assert(S1_V % 16 == 0 && S1_WSF % 16 == 0 && S1_END <= 131072, "sliding-window LDS map");

__device__ __forceinline__ int crow(int r, int hi) { return (r & 3) + 8 * (r >> 2) + 4 * hi; }
__device__ __forceinline__ unsigned cvtpk(float lo, float hi) { f32x2 v = {lo, hi}; bf16x2_t b = __builtin_convertvector(v, bf16x2_t); return __builtin_bit_cast(unsigned, b); }
__device__ __forceinline__ s16x4 vtr(const ALAS unsigned char* p) { return __builtin_bit_cast(s16x4, __builtin_amdgcn_ds_read_tr16_b64_v4i16((ALAS v4i16_t*)p)); }
__device__ __forceinline__ float swap_sum(float x) { auto rr = __builtin_amdgcn_permlane32_swap(__float_as_uint(x), __float_as_uint(x), false, false); return __uint_as_float(rr[0]) + __uint_as_float(rr[1]); }
__device__ __forceinline__ float swap_max(float x) { auto rr = __builtin_amdgcn_permlane32_swap(__float_as_uint(x), __float_as_uint(x), false, false); return fmaxf(__uint_as_float(rr[0]), __uint_as_float(rr[1])); }
__device__ __forceinline__ float bf2f(unsigned short h) { return __uint_as_float((unsigned)h << 16); }

__device__ __forceinline__ void glds16(const AGAS void* gsrc, unsigned lds_dst) { unsigned keep;
    asm volatile("s_mov_b32 %0, m0\n\ts_mov_b32 m0, %2\n\ts_nop 0\n\tglobal_load_lds_dwordx4 %1, off\n\ts_mov_b32 m0, %0" : "=&s"(keep) : "v"(gsrc), "s"(lds_dst) : "memory"); }
__device__ __forceinline__ void glds4(const AGAS void* gsrc, unsigned lds_dst) { unsigned keep;
    asm volatile("s_mov_b32 %0, m0\n\ts_mov_b32 m0, %2\n\ts_nop 0\n\tglobal_load_lds_dword %1, off\n\ts_mov_b32 m0, %0" : "=&s"(keep) : "v"(gsrc), "s"(lds_dst) : "memory"); }

struct AttnP {
    AGAS unsigned char* ws;
    const AGAS float* gq;
    const AGAS int* pos; const AGAS float* sinks; const AGAS float* relb;
};
template <int MODE> struct AttnCfg;
template <> struct AttnCfg<0> { static constexpr size_t Q = WS_QRAW, K = WS_KA, V = WS_VA; static constexpr int qpitch = 576, kpitch = 576, khs = 96, vpitch = 384, vhs = 64, ocol0 = 0, hidx0 = 0, group = 1; };
template <> struct AttnCfg<1> { static constexpr size_t Q = WS_QS, K = WS_KS, V = WS_VS; static constexpr int qpitch = 384, kpitch = 128, khs = 64, vpitch = 128, vhs = 64, ocol0 = 384, hidx0 = 6, group = 3; };
template <> struct AttnCfg<2> { static constexpr size_t Q = WS_QC, K = WS_KC, V = WS_VC; static constexpr int qpitch = 256, kpitch = 256, khs = 64, vpitch = 256, vhs = 64, ocol0 = 768, hidx0 = 12, group = 1; };

#ifdef ATT_PROF
#define PROF_T() ((MODE == 0 && blockIdx.x == 0) ? (long long)clock64() : 0ll)
#else
#define PROF_T() 0ll
#endif
template <int DQK, int MODE>
__device__ __forceinline__ void attn_unit(ALAS unsigned char* lds, const AttnP& P, int b, int h, int qb, int wave0, unsigned long long* prof = nullptr) {
    long long pf_qk = 0, pf_sm = 0, pf_pv = 0, pf_wait = 0; const long long pf_t0 = PROF_T();
    constexpr int NCH = DQK / 8, ND0 = DQK / 16;
    int tid_ = wave0 * 64 + hw_lane(); asm volatile("" : "+v"(tid_));
    const int tid = tid_, lane = tid & 63, r32 = lane & 31, hi = lane >> 5;
    const int wid = __builtin_amdgcn_readfirstlane(tid >> 6);
    const int q0 = qb * 256, qlo = q0 + 32 * wid, qhi = qlo + 31, qrow = qlo + r32;
    const size_t rb = (size_t)b * SEQ;
    typedef AttnCfg<MODE> C; const int kvh = h / C::group;
    ALAS float* wsf = (ALAS float*)(lds + (MODE == 1 ? S1_WSF : L_WSF)) + wid * 64;
    ALAS unsigned char* ost = lds + L_OST + wid * 4096;
    ALAS int* posl = (ALAS int*)(lds + L_POS);
    ALAS float* tb = (ALAS float*)(lds + L_TB);

    bf16x8 qf[ND0];
    if constexpr (MODE == 0) {
        const AGAS bf16_t* qp = (const AGAS bf16_t*)(P.ws + C::Q) + (rb + qrow) * 576 + h * 96 + hi * 8;
        float qv[ND0][8]; float ss = 0.f;
#pragma unroll
        for (int d0 = 0; d0 < ND0; ++d0) { const u32x4 w = *(const AGAS u32x4*)(qp + 16 * d0);
#pragma unroll
            for (int i = 0; i < 4; ++i) { const float lo = __uint_as_float(w[i] << 16), hv = __uint_as_float(w[i] & 0xffff0000u); qv[d0][2 * i] = lo; qv[d0][2 * i + 1] = hv; ss += lo * lo + hv * hv; } }
        ss = swap_sum(ss);
        const float rq = 1.0f / sqrtf(ss * (1.0f / 96.0f) + EPS);
#pragma unroll
        for (int d0 = 0; d0 < ND0; ++d0) { const f32x4 ga = *(const AGAS f32x4*)(P.gq + 16 * d0 + 8 * hi), gb = *(const AGAS f32x4*)(P.gq + 16 * d0 + 8 * hi + 4);
#pragma unroll
            for (int i = 0; i < 4; ++i) { qv[d0][i] *= rq * ga[i]; qv[d0][4 + i] *= rq * gb[i]; } }
        {
            const AGAS float* cp = (const AGAS float*)(P.ws + WS_CS) + (rb + qrow) * 32 + 8 * hi;
            const f32x4 c0 = *(const AGAS f32x4*)cp, c1 = *(const AGAS f32x4*)(cp + 4), s0 = *(const AGAS f32x4*)(cp + 16), s1 = *(const AGAS f32x4*)(cp + 20);
#pragma unroll
            for (int i = 0; i < 8; ++i) { const float c = i < 4 ? c0[i & 3] : c1[i & 3], s = i < 4 ? s0[i & 3] : s1[i & 3]; const float x1 = qv[4][i], x2 = qv[5][i]; qv[4][i] = x1 * c - x2 * s; qv[5][i] = x2 * c + x1 * s; }
        }
        const float sc = 0.10206207261596575f * LOG2E;
#pragma unroll
        for (int d0 = 0; d0 < ND0; ++d0) { u32x4 w; w.x = cvtpk(qv[d0][0] * sc, qv[d0][1] * sc); w.y = cvtpk(qv[d0][2] * sc, qv[d0][3] * sc); w.z = cvtpk(qv[d0][4] * sc, qv[d0][5] * sc); w.w = cvtpk(qv[d0][6] * sc, qv[d0][7] * sc); qf[d0] = __builtin_bit_cast(bf16x8, w); }
    } else {
        const AGAS bf16_t* qp = (const AGAS bf16_t*)(P.ws + C::Q) + (rb + qrow) * C::qpitch + h * 64 + hi * 8;
#pragma unroll
        for (int d0 = 0; d0 < ND0; ++d0) qf[d0] = *(const AGAS bf16x8*)(qp + 16 * d0);
    }
    int posq = 0; float sink2 = 0.f;
    if constexpr (MODE == 1) {
        posq = P.pos[rb + qrow]; sink2 = P.sinks[h] * LOG2E;
    }

    int ntile, tfirst, tstep;
    if (MODE == 0) { tfirst = 0; tstep = 1; ntile = ((q0 + 255) >> 6) + 1; }
    else if (MODE == 1) { const int lo = q0 - 127 > 0 ? q0 - 127 : 0; tfirst = lo >> 6; tstep = 1; ntile = ((q0 + 255) >> 6) - tfirst + 1; }
    else { tfirst = (q0 + 254) >> 6; tstep = -1; ntile = tfirst + 1; }

    const AGAS bf16_t* Kg = (const AGAS bf16_t*)(P.ws + C::K) + rb * C::kpitch + kvh * C::khs;
    const AGAS bf16_t* Vg = (const AGAS bf16_t*)(P.ws + C::V) + rb * C::vpitch + kvh * C::vhs;
    const unsigned lds0 = (unsigned)(uintptr_t)lds;
    const AGAS bf16_t* ksrc0 = (MODE == 0) ? (const AGAS bf16_t*)(P.ws + C::K) + ((size_t)b * 128 * 6 + h) * 6144 + wid * 512 + lane * 8 : Kg + (size_t)lane * C::kpitch + 8 * wid;
    const AGAS bf16_t* vsrc = (MODE == 0) ? (const AGAS bf16_t*)(P.ws + C::V) + ((size_t)b * 128 * 6 + h) * 4096 + (wid >> 2) * 2048 + (wid & 3) * 512 + lane * 8
                                          : Vg + (size_t)(16 * (wid & 3) + (lane >> 2)) * C::vpitch + 32 * (wid >> 2) + 8 * (lane & 3);
    constexpr size_t KTS = (MODE == 0) ? (size_t)6 * 6144 : (size_t)64 * C::kpitch, VTS = (MODE == 0) ? (size_t)6 * 4096 : (size_t)64 * C::vpitch, K2O = (MODE == 0) ? 8 * 512 : 64;
    const bool k2 = (wid + 8) < NCH;
    const bool posw = (MODE == 1) && wid == 0;
    const int NP = 2 + (k2 ? 1 : 0) + (posw ? 1 : 0);
#define ATT_ISSUE(T, IT) do { const int T_ = (T); const size_t jo_ = (size_t)T_ * 64; const int ks_ = (IT) % 3, vs_ = (IT) & 3;     \
        glds16(ksrc0 + (size_t)T_ * KTS, (unsigned)__builtin_amdgcn_readfirstlane(lds0 + L_K + ks_ * KSLOT + wid * KCS)); \
        if (k2) glds16(ksrc0 + (size_t)T_ * KTS + K2O, (unsigned)__builtin_amdgcn_readfirstlane(lds0 + L_K + ks_ * KSLOT + (wid + 8) * KCS)); \
        glds16(vsrc + (size_t)T_ * VTS, (unsigned)__builtin_amdgcn_readfirstlane(lds0 + L_V + vs_ * VSLOT + (wid >> 2) * VHS + (wid & 3) * 1024)); \
        if (posw) glds4(P.pos + rb + jo_ + lane, (unsigned)__builtin_amdgcn_readfirstlane(lds0 + L_POS + vs_ * 256)); } while (0)
#define ATT_WAIT_BAR(n_) do { if ((n_) <= 0) asm volatile("s_waitcnt vmcnt(0) lgkmcnt(0)\n\ts_barrier" ::: "memory"); \
        else if (NP == 2) asm volatile("s_waitcnt vmcnt(2) lgkmcnt(0)\n\ts_barrier" ::: "memory"); \
        else if (NP == 3) asm volatile("s_waitcnt vmcnt(3) lgkmcnt(0)\n\ts_barrier" ::: "memory"); \
        else asm volatile("s_waitcnt vmcnt(4) lgkmcnt(0)\n\ts_barrier" ::: "memory"); } while (0)

    f32x16 o0 = {}, o1 = {};
    float mrun = (MODE == 1) ? sink2 : 0.f;
    float lrun = (MODE == 1 && hi == 0) ? 1.0f : 0.f;
    f32x16 negm;
#pragma unroll
    for (int r = 0; r < 16; ++r) negm[r] = (MODE == 2) ? 0.f : -mrun;
    bool first = (MODE == 0);
    float after = 0.f;
    bool walive = true;
    const int vrd = ((lane >> 4) & 1) * 32 + (lane & 3) * 8 + (4 * hi + ((lane & 15) >> 2)) * 64;
    const bool lag = wid >= 4;
    constexpr float THR = 4.0f;

#define ATT_QK(P0, P1, kb) do { int kofs_ = L_K + (kb) * KSLOT + hi * KCS + r32 * 16; asm volatile("" : "+v"(kofs_)); const ALAS unsigned char* Kb_ = lds + kofs_;     \
        bf16x8 kfa_[4], kfb_[4]; \
        _Pragma("unroll") for (int d0 = 0; d0 < 3; ++d0) { kfa_[d0] = *(const ALAS bf16x8*)(Kb_ + 2 * d0 * KCS); kfb_[d0] = *(const ALAS bf16x8*)(Kb_ + 2 * d0 * KCS + 512); } \
        \
        _Pragma("unroll") for (int d0 = 0; d0 < ND0; ++d0) { \
            if (d0 + 3 < ND0) { kfa_[(d0 + 3) & 3] = *(const ALAS bf16x8*)(Kb_ + 2 * (d0 + 3) * KCS); kfb_[(d0 + 3) & 3] = *(const ALAS bf16x8*)(Kb_ + 2 * (d0 + 3) * KCS + 512); } \
            if (d0 == 0) { P0 = __builtin_amdgcn_mfma_f32_32x32x16_bf16(kfa_[0], qf[0], negm, 0, 0, 0); P1 = __builtin_amdgcn_mfma_f32_32x32x16_bf16(kfb_[0], qf[0], negm, 0, 0, 0); } \
            else { P0 = __builtin_amdgcn_mfma_f32_32x32x16_bf16(kfa_[d0 & 3], qf[d0], P0, 0, 0, 0); P1 = __builtin_amdgcn_mfma_f32_32x32x16_bf16(kfb_[d0 & 3], qf[d0], P1, 0, 0, 0); } \
            } } while (0)
#define ATT_VLD(i_, s_) do { vl0_[i_] = vtr(Vb_ + (s_) * 1024); vh0_[i_] = vtr(Vb_ + (s_) * 1024 + 512); vl1_[i_] = vtr(Vb_ + VHS + (s_) * 1024); vh1_[i_] = vtr(Vb_ + VHS + (s_) * 1024 + 512); } while (0)
#define ATT_PV(vb) do { int vofs_ = L_V + (vb) * VSLOT + vrd; asm volatile("" : "+v"(vofs_)); const ALAS unsigned char* Vb_ = lds + vofs_; \
        s16x4 vl0_[2], vh0_[2], vl1_[2], vh1_[2]; ATT_VLD(0, 0); \
        _Pragma("unroll") for (int s_ = 0; s_ < 4; ++s_) { \
            if (s_ + 1 < 4) ATT_VLD((s_ + 1) & 1, s_ + 1); \
            const int i_ = s_ & 1; const bf16x8 pa_ = __builtin_bit_cast(bf16x8, pw[s_]); \
            const bf16x8 v0_ = {vl0_[i_][0], vl0_[i_][1], vl0_[i_][2], vl0_[i_][3], vh0_[i_][0], vh0_[i_][1], vh0_[i_][2], vh0_[i_][3]}, v1_ = {vl1_[i_][0], vl1_[i_][1], vl1_[i_][2], vl1_[i_][3], vh1_[i_][0], vh1_[i_][1], vh1_[i_][2], vh1_[i_][3]}; \
            o0 = __builtin_amdgcn_mfma_f32_32x32x16_bf16(pa_, v0_, o0, 0, 0, 0); o1 = __builtin_amdgcn_mfma_f32_32x32x16_bf16(pa_, v1_, o1, 0, 0, 0); } } while (0)
#define ATT_PACK(P0, P1) do { \
        pw[0].x = cvtpk(P0[0], P0[1]); pw[0].y = cvtpk(P0[2], P0[3]); pw[0].z = cvtpk(P0[4], P0[5]); pw[0].w = cvtpk(P0[6], P0[7]); \
        pw[1].x = cvtpk(P0[8], P0[9]); pw[1].y = cvtpk(P0[10], P0[11]); pw[1].z = cvtpk(P0[12], P0[13]); pw[1].w = cvtpk(P0[14], P0[15]); \
        pw[2].x = cvtpk(P1[0], P1[1]); pw[2].y = cvtpk(P1[2], P1[3]); pw[2].z = cvtpk(P1[4], P1[5]); pw[2].w = cvtpk(P1[6], P1[7]); \
        pw[3].x = cvtpk(P1[8], P1[9]); pw[3].y = cvtpk(P1[10], P1[11]); pw[3].z = cvtpk(P1[12], P1[13]); pw[3].w = cvtpk(P1[14], P1[15]); } while (0)
#define ATT_MAX3(a, b, c) fmaxf(fmaxf((a), (b)), (c))
#define ATT_SM_A(P0, P1, j0_, pslot) do { if constexpr (MODE != 2) { \
            if constexpr (MODE == 1) { \
                _Pragma("unroll") for (int g = 0; g < 4; ++g) { \
                    const i32x4 pa = *(const ALAS i32x4*)(posl + (pslot) * 64 + 8 * g + 4 * hi), pb = *(const ALAS i32x4*)(posl + (pslot) * 64 + 32 + 8 * g + 4 * hi); \
                    _Pragma("unroll") for (int i = 0; i < 4; ++i) { \
                        { int n = posq - pa[i]; n = n > 0 ? n : 0; int bk = n; if (n >= 16) { bk = 16 + (int)((__builtin_amdgcn_logf((float)n) - 4.0f) * (16.0f / 3.0f)); bk = bk < 31 ? bk : 31; } P0[4 * g + i] += tb[bk]; } \
                        { int n = posq - pb[i]; n = n > 0 ? n : 0; int bk = n; if (n >= 16) { bk = 16 + (int)((__builtin_amdgcn_logf((float)n) - 4.0f) * (16.0f / 3.0f)); bk = bk < 31 ? bk : 31; } P1[4 * g + i] += tb[bk]; } } } } \
            const bool nm_ = (MODE == 1) || ((j0_) + 63 > qlo); \
            if (nm_) { \
                _Pragma("unroll") for (int r = 0; r < 16; ++r) { const int key = (j0_) + crow(r, hi); \
                    bool ok0 = key <= qrow, ok1 = key + 32 <= qrow; \
                    if (MODE == 1) { ok0 = ok0 && (key > qrow - 128); ok1 = ok1 && (key + 32 > qrow - 128); } \
                    if (!ok0) P0[r] = -INFINITY; if (!ok1) P1[r] = -INFINITY; } } \
            float ma = ATT_MAX3(P0[0], P0[1], P1[0]), mb = ATT_MAX3(P0[2], P0[3], P1[1]); ma = ATT_MAX3(ma, P1[2], P1[3]); \
            _Pragma("unroll") for (int r = 4; r < 16; r += 4) { ma = ATT_MAX3(ma, P0[r], P0[r + 1]); mb = ATT_MAX3(mb, P0[r + 2], P0[r + 3]); ma = ATT_MAX3(ma, P1[r], P1[r + 1]); mb = ATT_MAX3(mb, P1[r + 2], P1[r + 3]); } \
            const float mt = swap_max(fmaxf(ma, mb)); \
            if (first || __any(mt > THR)) {                                 \
                const float d = first ? mt : fmaxf(mt, 0.f); first = false; \
                _Pragma("unroll") for (int r = 0; r < 16; ++r) { P0[r] -= d; P1[r] -= d; } \
                const float alpha = __builtin_amdgcn_exp2f(-d); mrun += d; lrun *= alpha; \
                _Pragma("unroll") for (int r = 0; r < 16; ++r) negm[r] = -mrun; \
                if (hi == 0) wsf[r32] = alpha; \
                _Pragma("unroll") for (int g = 0; g < 4; ++g) { const f32x4 al = *(const ALAS f32x4*)(wsf + 8 * g + 4 * hi); \
                    _Pragma("unroll") for (int i = 0; i < 4; ++i) { o0[4 * g + i] *= al[i]; o1[4 * g + i] *= al[i]; } } } } } while (0)
#define ATT_SM_B(P0, P1, j0_) do { \
        if constexpr (MODE == 2) { \
            const bool nm_ = (j0_) + 63 >= qlo; \
            float ln0[16], ln1[16]; \
            _Pragma("unroll") for (int r = 0; r < 16; ++r) { const int key = (j0_) + crow(r, hi); \
                { const float z = P0[r]; const float sp = fmaxf(z, 0.f) + __builtin_amdgcn_logf(1.0f + __builtin_amdgcn_exp2f(-fabsf(z))); const bool ok = !nm_ || key < qrow; ln0[r] = ok ? -sp : 0.f; P0[r] = ok ? z - sp : -INFINITY; } \
                { const float z = P1[r]; const float sp = fmaxf(z, 0.f) + __builtin_amdgcn_logf(1.0f + __builtin_amdgcn_exp2f(-fabsf(z))); const bool ok = !nm_ || key + 32 < qrow; ln1[r] = ok ? -sp : 0.f; P1[r] = ok ? z - sp : -INFINITY; } } \
            float run = after; \
            _Pragma("unroll") for (int blk = 1; blk >= 0; --blk) _Pragma("unroll") for (int g = 3; g >= 0; --g) { \
                const float own = blk ? ((ln1[4 * g] + ln1[4 * g + 1]) + (ln1[4 * g + 2] + ln1[4 * g + 3])) : ((ln0[4 * g] + ln0[4 * g + 1]) + (ln0[4 * g + 2] + ln0[4 * g + 3])); \
                auto rr = __builtin_amdgcn_permlane32_swap(__float_as_uint(own), __float_as_uint(own), false, false); \
                const float slo = __uint_as_float(rr[0]), shi = __uint_as_float(rr[1]); \
                const float e1 = run; run += shi; const float e0 = run; run += slo; \
                float aft = hi ? e1 : e0; \
                _Pragma("unroll") for (int i = 3; i >= 0; --i) { const int r = 4 * g + i; \
                    if (blk) { P1[r] = __builtin_amdgcn_exp2f(P1[r] + aft); aft += ln1[r]; } else { P0[r] = __builtin_amdgcn_exp2f(P0[r] + aft); aft += ln0[r]; } } } \
            after = run; walive = __any(after > -160.0f); \
        } else { \
            float ls = 0.f; \
            _Pragma("unroll") for (int r = 0; r < 16; ++r) { P0[r] = __builtin_amdgcn_exp2f(P0[r]); P1[r] = __builtin_amdgcn_exp2f(P1[r]); ls += P0[r] + P1[r]; } \
            lrun += ls; } \
        ATT_PACK(P0, P1); } while (0)
#define ATT_WORK(j0_) ((MODE == 0) ? ((j0_) <= qhi) : (MODE == 1) ? (((j0_) <= qhi) && ((j0_) + 63 >= qlo - 127)) : (walive && ((j0_) < qhi)))

    if constexpr (MODE == 0) {
    f32x16 p0, p1, n0, n1; u32x4 pw[4];
    __syncthreads();
    int issued = 0;
    ATT_ISSUE(0, 0);
    if (ntile > 1) { ATT_ISSUE(1, 1); issued = 1; }
    if (ntile > 2) { ATT_ISSUE(2, 2); issued = 2; }
    ATT_WAIT_BAR(issued - 1);
    const int tmax = qhi >> 6;
#define MLA_SB() __builtin_amdgcn_sched_barrier(0)
#define MLA_EX(v) __builtin_amdgcn_exp2f(v)
#define MLA_DECIDE(X0, X1, j0_) do { \
        if ((j0_) + 63 > qlo) { _Pragma("unroll") for (int r = 0; r < 16; ++r) { const int key = (j0_) + crow(r, hi); if (key > qrow) X0[r] = -INFINITY; if (key + 32 > qrow) X1[r] = -INFINITY; } } \
        float ma = ATT_MAX3(X0[0], X0[1], X1[0]), mb = ATT_MAX3(X0[2], X0[3], X1[1]); ma = ATT_MAX3(ma, X1[2], X1[3]); \
        _Pragma("unroll") for (int r = 4; r < 16; r += 4) { ma = ATT_MAX3(ma, X0[r], X0[r + 1]); mb = ATT_MAX3(mb, X0[r + 2], X0[r + 3]); ma = ATT_MAX3(ma, X1[r], X1[r + 1]); mb = ATT_MAX3(mb, X1[r + 2], X1[r + 3]); } \
        const float mt = swap_max(fmaxf(ma, mb)); resc = false; \
        if (first || __any(mt > THR)) { const float d = first ? mt : fmaxf(mt, 0.f); first = false; \
            _Pragma("unroll") for (int r = 0; r < 16; ++r) { X0[r] -= d; X1[r] -= d; } \
            const float alpha = __builtin_amdgcn_exp2f(-d); lrun *= alpha; const float nm_ = negm[0] - d;     \
            _Pragma("unroll") for (int r = 0; r < 16; ++r) negm[r] = nm_; \
            if (hi == 0) wsf[r32] = alpha; resc = true; } } while (0)
#define MLA_RESC() do { if (resc) { _Pragma("unroll") for (int g = 0; g < 4; ++g) { const f32x4 al = *(const ALAS f32x4*)(wsf + 8 * g + 4 * hi); \
            _Pragma("unroll") for (int i = 0; i < 4; ++i) { o0[4 * g + i] *= al[i]; o1[4 * g + i] *= al[i]; } } } } while (0)
#define MLA_PV_(i) (i < 16 ? C0[(i) & 15] : C1[(i) & 15])
#define MLA_GA(MF, g, C0, C1) do { MF; \
        if (3 * (g) < 32) sacc += (3 * (g) < 16 ? C0[(3 * (g)) & 15] : C1[(3 * (g)) & 15]); \
        if (3 * (g) + 1 < 32) sacc += (3 * (g) + 1 < 16 ? C0[(3 * (g) + 1) & 15] : C1[(3 * (g) + 1) & 15]); \
        if (3 * (g) + 2 < 32) sacc += (3 * (g) + 2 < 16 ? C0[(3 * (g) + 2) & 15] : C1[(3 * (g) + 2) & 15]); \
        if ((g) < 4) { pw[((g) >> 1) & 3][2 * ((g) & 1)] = cvtpk(C0[4 * (g)], C0[4 * (g) + 1]); pw[((g) >> 1) & 3][2 * ((g) & 1) + 1] = cvtpk(C0[4 * (g) + 2], C0[4 * (g) + 3]); } \
        else if ((g) < 8) { pw[((g) >> 1) & 3][2 * ((g) & 1)] = cvtpk(C1[4 * ((g) - 4)], C1[4 * ((g) - 4) + 1]); pw[((g) >> 1) & 3][2 * ((g) & 1) + 1] = cvtpk(C1[4 * ((g) - 4) + 2], C1[4 * ((g) - 4) + 3]); } } while (0)
#define MLA_VF(lo_, hi_) (bf16x8){lo_[0], lo_[1], lo_[2], lo_[3], hi_[0], hi_[1], hi_[2], hi_[3]}
#define MLA_GB(MF, X, b_) do { MF; X[(b_)] = MLA_EX(X[(b_)]); X[(b_) + 1] = MLA_EX(X[(b_) + 1]); X[(b_) + 2] = MLA_EX(X[(b_) + 2]); X[(b_) + 3] = MLA_EX(X[(b_) + 3]); } while (0)
#define MLA_FULL(C0, C1, N0, N1, t_) do { \
        int kofs_ = L_K + (((t_) + 1) % 3) * KSLOT + hi * KCS + r32 * 16; asm volatile("" : "+v"(kofs_)); const ALAS unsigned char* Kb_ = lds + kofs_; \
        int vofs_ = L_V + ((t_) & 3) * VSLOT + vrd; asm volatile("" : "+v"(vofs_)); const ALAS unsigned char* Vb_ = lds + vofs_; \
        bf16x8 ka0 = *(const ALAS bf16x8*)(Kb_), kb0 = *(const ALAS bf16x8*)(Kb_ + 512), ka1 = *(const ALAS bf16x8*)(Kb_ + 2 * KCS), kb1 = *(const ALAS bf16x8*)(Kb_ + 2 * KCS + 512), ka2, kb2; \
        s16x4 vl0a, vh0a, vl1a, vh1a, vl0b, vh0b, vl1b, vh1b; float sacc = 0.f; \
        MLA_SB(); \
        MLA_GA(N0 = __builtin_amdgcn_mfma_f32_32x32x16_bf16(ka0, qf[0], negm, 0, 0, 0), 0, C0, C1); ka2 = *(const ALAS bf16x8*)(Kb_ + 4 * KCS); MLA_SB(); \
        MLA_GA(N1 = __builtin_amdgcn_mfma_f32_32x32x16_bf16(kb0, qf[0], negm, 0, 0, 0), 1, C0, C1); kb2 = *(const ALAS bf16x8*)(Kb_ + 4 * KCS + 512); MLA_SB(); \
        MLA_GA(N0 = __builtin_amdgcn_mfma_f32_32x32x16_bf16(ka1, qf[1], N0, 0, 0, 0), 2, C0, C1); ka0 = *(const ALAS bf16x8*)(Kb_ + 6 * KCS); MLA_SB(); \
        MLA_GA(N1 = __builtin_amdgcn_mfma_f32_32x32x16_bf16(kb1, qf[1], N1, 0, 0, 0), 3, C0, C1); kb0 = *(const ALAS bf16x8*)(Kb_ + 6 * KCS + 512); MLA_SB(); \
        MLA_GA(N0 = __builtin_amdgcn_mfma_f32_32x32x16_bf16(ka2, qf[2], N0, 0, 0, 0), 4, C0, C1); ka1 = *(const ALAS bf16x8*)(Kb_ + 8 * KCS); MLA_SB(); \
        MLA_GA(N1 = __builtin_amdgcn_mfma_f32_32x32x16_bf16(kb2, qf[2], N1, 0, 0, 0), 5, C0, C1); kb1 = *(const ALAS bf16x8*)(Kb_ + 8 * KCS + 512); MLA_SB(); \
        MLA_GA(N0 = __builtin_amdgcn_mfma_f32_32x32x16_bf16(ka0, qf[3], N0, 0, 0, 0), 6, C0, C1); ka2 = *(const ALAS bf16x8*)(Kb_ + 10 * KCS); MLA_SB(); \
        MLA_GA(N1 = __builtin_amdgcn_mfma_f32_32x32x16_bf16(kb0, qf[3], N1, 0, 0, 0), 7, C0, C1); kb2 = *(const ALAS bf16x8*)(Kb_ + 10 * KCS + 512); MLA_SB(); \
        MLA_GA(N0 = __builtin_amdgcn_mfma_f32_32x32x16_bf16(ka1, qf[4], N0, 0, 0, 0), 8, C0, C1); MLA_SB(); \
        MLA_GA(N1 = __builtin_amdgcn_mfma_f32_32x32x16_bf16(kb1, qf[4], N1, 0, 0, 0), 9, C0, C1); MLA_SB(); \
        MLA_GA(N0 = __builtin_amdgcn_mfma_f32_32x32x16_bf16(ka2, qf[5], N0, 0, 0, 0), 10, C0, C1); vl0a = vtr(Vb_); vh0a = vtr(Vb_ + 512); MLA_SB(); \
        MLA_GA(N1 = __builtin_amdgcn_mfma_f32_32x32x16_bf16(kb2, qf[5], N1, 0, 0, 0), 11, C0, C1); vl1a = vtr(Vb_ + VHS); vh1a = vtr(Vb_ + VHS + 512); MLA_SB(); \
        lrun += sacc; \
        MLA_DECIDE(N0, N1, ((t_) + 1) * 64); \
        MLA_SB(); \
        MLA_GB(o0 = __builtin_amdgcn_mfma_f32_32x32x16_bf16(__builtin_bit_cast(bf16x8, pw[0]), MLA_VF(vl0a, vh0a), o0, 0, 0, 0), N0, 0); vl0b = vtr(Vb_ + 1024); vh0b = vtr(Vb_ + 1024 + 512); MLA_SB(); \
        MLA_GB(o1 = __builtin_amdgcn_mfma_f32_32x32x16_bf16(__builtin_bit_cast(bf16x8, pw[0]), MLA_VF(vl1a, vh1a), o1, 0, 0, 0), N0, 4); vl1b = vtr(Vb_ + VHS + 1024); vh1b = vtr(Vb_ + VHS + 1024 + 512); MLA_SB(); \
        MLA_GB(o0 = __builtin_amdgcn_mfma_f32_32x32x16_bf16(__builtin_bit_cast(bf16x8, pw[1]), MLA_VF(vl0b, vh0b), o0, 0, 0, 0), N0, 8); vl0a = vtr(Vb_ + 2048); vh0a = vtr(Vb_ + 2048 + 512); MLA_SB(); \
        MLA_GB(o1 = __builtin_amdgcn_mfma_f32_32x32x16_bf16(__builtin_bit_cast(bf16x8, pw[1]), MLA_VF(vl1b, vh1b), o1, 0, 0, 0), N0, 12); vl1a = vtr(Vb_ + VHS + 2048); vh1a = vtr(Vb_ + VHS + 2048 + 512); MLA_SB(); \
        MLA_GB(o0 = __builtin_amdgcn_mfma_f32_32x32x16_bf16(__builtin_bit_cast(bf16x8, pw[2]), MLA_VF(vl0a, vh0a), o0, 0, 0, 0), N1, 0); vl0b = vtr(Vb_ + 3072); vh0b = vtr(Vb_ + 3072 + 512); MLA_SB(); \
        MLA_GB(o1 = __builtin_amdgcn_mfma_f32_32x32x16_bf16(__builtin_bit_cast(bf16x8, pw[2]), MLA_VF(vl1a, vh1a), o1, 0, 0, 0), N1, 4); vl1b = vtr(Vb_ + VHS + 3072); vh1b = vtr(Vb_ + VHS + 3072 + 512); MLA_SB(); \
        MLA_GB(o0 = __builtin_amdgcn_mfma_f32_32x32x16_bf16(__builtin_bit_cast(bf16x8, pw[3]), MLA_VF(vl0b, vh0b), o0, 0, 0, 0), N1, 8); MLA_SB(); \
        MLA_GB(o1 = __builtin_amdgcn_mfma_f32_32x32x16_bf16(__builtin_bit_cast(bf16x8, pw[3]), MLA_VF(vl1b, vh1b), o1, 0, 0, 0), N1, 12); MLA_SB(); \
        MLA_RESC(); } while (0)
#define MLA_TAIL(C0, C1, t_) do { float ls = 0.f; _Pragma("unroll") for (int r = 0; r < 16; ++r) ls += C0[r] + C1[r]; lrun += ls; ATT_PACK(C0, C1); ATT_PV((t_) & 3); } while (0)
#define MLA_STEP(C0, C1, N0, N1, t_) do { \
          \
        int lane_ = lane; asm volatile("" : "+v"(lane_)); const int r32 = lane_ & 31, hi = lane_ >> 5, qrow = qlo + r32; \
        const int vrd = ((lane_ >> 4) & 1) * 32 + (lane_ & 3) * 8 + (4 * hi + ((lane_ & 15) >> 2)) * 64; ALAS float* wsf = (ALAS float*)(lds + L_WSF) + wid * 64; \
        if ((t_) + 3 < ntile) { ATT_ISSUE((t_) + 3, (t_) + 3); issued = (t_) + 3; } \
        if ((t_) < tmax) MLA_FULL(C0, C1, N0, N1, t_); else if ((t_) == tmax) MLA_TAIL(C0, C1, t_); \
        ATT_WAIT_BAR(issued - ((t_) + 2)); } while (0)
    if (wid >= 4) __builtin_amdgcn_s_setprio(1);
    bool resc = false;
    ATT_QK(p0, p1, 0);
    MLA_DECIDE(p0, p1, 0);
#pragma unroll
    for (int r = 0; r < 16; ++r) { p0[r] = MLA_EX(p0[r]); p1[r] = MLA_EX(p1[r]); }
    asm volatile("s_waitcnt lgkmcnt(0)\n\ts_barrier" ::: "memory");
    for (int it = 0; it < ntile; it += 2) {
        MLA_STEP(p0, p1, n0, n1, it);
        if (it + 1 >= ntile) break;
        MLA_STEP(n0, n1, p0, p1, it + 1);
    }
    __builtin_amdgcn_s_setprio(0);
#undef MLA_SB
#undef MLA_EX
#undef MLA_DECIDE
#undef MLA_RESC
#undef MLA_PV_
#undef MLA_GA
#undef MLA_VF
#undef MLA_GB
#undef MLA_FULL
#undef MLA_TAIL
#undef MLA_STEP
    } else if constexpr (MODE == 1) {
    f32x16 p0, p1; u32x4 pw[4];
    __syncthreads();
    {
        const unsigned lds0_ = (unsigned)(uintptr_t)lds;
        for (int i = 0; i < ntile; ++i) { const int T_ = tfirst + i;
            glds16(ksrc0 + (size_t)T_ * KTS, (unsigned)__builtin_amdgcn_readfirstlane(lds0_ + S1_K + i * S1_KS + wid * KCS));
            glds16(vsrc + (size_t)T_ * VTS, (unsigned)__builtin_amdgcn_readfirstlane(lds0_ + S1_V + i * VSLOT + (wid >> 2) * VHS + (wid & 3) * 1024));
            if (wid == 0) glds4(P.pos + rb + (size_t)T_ * 64 + lane, (unsigned)__builtin_amdgcn_readfirstlane(lds0_ + S1_P + i * 256)); }
        ALAS float* lut = (ALAS float*)(lds + S1_LUT);
        if (tid < 129) { int bk = tid; if (tid >= 16) { bk = 16 + (int)((__builtin_amdgcn_logf((float)tid) - 4.0f) * (16.0f / 3.0f)); bk = bk < 31 ? bk : 31; } lut[tid] = P.relb[bk * 6 + h] * LOG2E; }
        asm volatile("s_waitcnt vmcnt(0) lgkmcnt(0)\n\ts_barrier" ::: "memory");
        const ALAS int* posk = (const ALAS int*)(lds + S1_P);
        const int lo_ = qlo - 127 > 0 ? qlo - 127 : 0; const int i_lo = (lo_ >> 6) - tfirst, i_hi = (qhi >> 6) - tfirst;
        for (int i = i_lo; i <= i_hi; ++i) {
            const int j0 = (tfirst + i) * 64;
            {
                int kofs_ = S1_K + i * S1_KS + hi * KCS + r32 * 16; asm volatile("" : "+v"(kofs_)); const ALAS unsigned char* Kb_ = lds + kofs_;
#pragma unroll
                for (int d0 = 0; d0 < ND0; ++d0) { const bf16x8 a0_ = *(const ALAS bf16x8*)(Kb_ + 2 * d0 * KCS), a1_ = *(const ALAS bf16x8*)(Kb_ + 2 * d0 * KCS + 512);
                    if (d0 == 0) { p0 = __builtin_amdgcn_mfma_f32_32x32x16_bf16(a0_, qf[0], negm, 0, 0, 0); p1 = __builtin_amdgcn_mfma_f32_32x32x16_bf16(a1_, qf[0], negm, 0, 0, 0); }
                    else { p0 = __builtin_amdgcn_mfma_f32_32x32x16_bf16(a0_, qf[d0], p0, 0, 0, 0); p1 = __builtin_amdgcn_mfma_f32_32x32x16_bf16(a1_, qf[d0], p1, 0, 0, 0); } }
            }
#pragma unroll
            for (int g = 0; g < 4; ++g) {
                const i32x4 pa = *(const ALAS i32x4*)(posk + i * 64 + 8 * g + 4 * hi), pb = *(const ALAS i32x4*)(posk + i * 64 + 32 + 8 * g + 4 * hi);
#pragma unroll
                for (int q = 0; q < 4; ++q) { int na = posq - pa[q]; na = na > 0 ? na : 0; na = na < 128 ? na : 128; int nb = posq - pb[q]; nb = nb > 0 ? nb : 0; nb = nb < 128 ? nb : 128;
                    p0[4 * g + q] += lut[na]; p1[4 * g + q] += lut[nb]; }
            }
#pragma unroll
            for (int r = 0; r < 16; ++r) { const int key = j0 + crow(r, hi); const bool ok0 = key <= qrow && key > qrow - 128, ok1 = key + 32 <= qrow && key + 32 > qrow - 128; if (!ok0) p0[r] = -INFINITY; if (!ok1) p1[r] = -INFINITY; }
            float ma = ATT_MAX3(p0[0], p0[1], p1[0]), mb = ATT_MAX3(p0[2], p0[3], p1[1]); ma = ATT_MAX3(ma, p1[2], p1[3]);
#pragma unroll
            for (int r = 4; r < 16; r += 4) { ma = ATT_MAX3(ma, p0[r], p0[r + 1]); mb = ATT_MAX3(mb, p0[r + 2], p0[r + 3]); ma = ATT_MAX3(ma, p1[r], p1[r + 1]); mb = ATT_MAX3(mb, p1[r + 2], p1[r + 3]); }
            const float mt = swap_max(fmaxf(ma, mb));
            if (__any(mt > THR)) {
                const float d = fmaxf(mt, 0.f);
#pragma unroll
                for (int r = 0; r < 16; ++r) { p0[r] -= d; p1[r] -= d; }
                const float alpha = __builtin_amdgcn_exp2f(-d); mrun += d; lrun *= alpha;
#pragma unroll
                for (int r = 0; r < 16; ++r) negm[r] = -mrun;
                if (hi == 0) wsf[r32] = alpha;
#pragma unroll
                for (int g = 0; g < 4; ++g) { const f32x4 al = *(const ALAS f32x4*)(wsf + 8 * g + 4 * hi);
#pragma unroll
                    for (int q = 0; q < 4; ++q) { o0[4 * g + q] *= al[q]; o1[4 * g + q] *= al[q]; } }
            }
            float ls = 0.f;
#pragma unroll
            for (int r = 0; r < 16; ++r) { p0[r] = __builtin_amdgcn_exp2f(p0[r]); p1[r] = __builtin_amdgcn_exp2f(p1[r]); ls += p0[r] + p1[r]; }
            lrun += ls;
            ATT_PACK(p0, p1);
            {
                int vofs_ = S1_V + i * VSLOT + vrd; asm volatile("" : "+v"(vofs_)); const ALAS unsigned char* Vb_ = lds + vofs_;
#pragma unroll
                for (int s_ = 0; s_ < 4; ++s_) { const bf16x8 pa_ = __builtin_bit_cast(bf16x8, pw[s_]);
                    const s16x4 l0_ = vtr(Vb_ + s_ * 1024), h0_ = vtr(Vb_ + s_ * 1024 + 512), l1_ = vtr(Vb_ + VHS + s_ * 1024), h1_ = vtr(Vb_ + VHS + s_ * 1024 + 512);
                    const bf16x8 v0_ = {l0_[0], l0_[1], l0_[2], l0_[3], h0_[0], h0_[1], h0_[2], h0_[3]}, v1_ = {l1_[0], l1_[1], l1_[2], l1_[3], h1_[0], h1_[1], h1_[2], h1_[3]};
                    o0 = __builtin_amdgcn_mfma_f32_32x32x16_bf16(pa_, v0_, o0, 0, 0, 0); o1 = __builtin_amdgcn_mfma_f32_32x32x16_bf16(pa_, v1_, o1, 0, 0, 0); }
            }
        }
        asm volatile("s_waitcnt lgkmcnt(0)\n\ts_barrier" ::: "memory");
    }
    } else {
    bool go_on = true;
    {
        u32x4 pw[4]; f32x16 p0, p1;
        const int nwin = ntile < 7 ? ntile : 7;
        __syncthreads();
        const unsigned lds0_ = (unsigned)(uintptr_t)lds;
        for (int i = 0; i < nwin; ++i) { const int T_ = tfirst - i;
            glds16(ksrc0 + (size_t)T_ * KTS, (unsigned)__builtin_amdgcn_readfirstlane(lds0_ + S1_K + i * S1_KS + wid * KCS));
            glds16(vsrc + (size_t)T_ * VTS, (unsigned)__builtin_amdgcn_readfirstlane(lds0_ + S1_V + i * VSLOT + (wid >> 2) * VHS + (wid & 3) * 1024)); }
        asm volatile("s_waitcnt vmcnt(0) lgkmcnt(0)\n\ts_barrier" ::: "memory");
        for (int i = 0; i < nwin; ++i) {
            const int j0 = (tfirst - i) * 64;
            if (!(walive && j0 < qhi)) { if (!walive) break; continue; }
            {
                int kofs_ = S1_K + i * S1_KS + hi * KCS + r32 * 16; asm volatile("" : "+v"(kofs_)); const ALAS unsigned char* Kb_ = lds + kofs_;
#pragma unroll
                for (int d0 = 0; d0 < ND0; ++d0) { const bf16x8 a0_ = *(const ALAS bf16x8*)(Kb_ + 2 * d0 * KCS), a1_ = *(const ALAS bf16x8*)(Kb_ + 2 * d0 * KCS + 512);
                    if (d0 == 0) { p0 = __builtin_amdgcn_mfma_f32_32x32x16_bf16(a0_, qf[0], negm, 0, 0, 0); p1 = __builtin_amdgcn_mfma_f32_32x32x16_bf16(a1_, qf[0], negm, 0, 0, 0); }
                    else { p0 = __builtin_amdgcn_mfma_f32_32x32x16_bf16(a0_, qf[d0], p0, 0, 0, 0); p1 = __builtin_amdgcn_mfma_f32_32x32x16_bf16(a1_, qf[d0], p1, 0, 0, 0); } }
            }
            ATT_SM_B(p0, p1, j0);
            {
                int vofs_ = S1_V + i * VSLOT + vrd; asm volatile("" : "+v"(vofs_)); const ALAS unsigned char* Vb_ = lds + vofs_;
#pragma unroll
                for (int s_ = 0; s_ < 4; ++s_) { const bf16x8 pa_ = __builtin_bit_cast(bf16x8, pw[s_]);
                    const s16x4 l0_ = vtr(Vb_ + s_ * 1024), h0_ = vtr(Vb_ + s_ * 1024 + 512), l1_ = vtr(Vb_ + VHS + s_ * 1024), h1_ = vtr(Vb_ + VHS + s_ * 1024 + 512);
                    const bf16x8 v0_ = {l0_[0], l0_[1], l0_[2], l0_[3], h0_[0], h0_[1], h0_[2], h0_[3]}, v1_ = {l1_[0], l1_[1], l1_[2], l1_[3], h1_[0], h1_[1], h1_[2], h1_[3]};
                    o0 = __builtin_amdgcn_mfma_f32_32x32x16_bf16(pa_, v0_, o0, 0, 0, 0); o1 = __builtin_amdgcn_mfma_f32_32x32x16_bf16(pa_, v1_, o1, 0, 0, 0); }
            }
        }
        ALAS int* fl = (ALAS int*)(lds + S1_WSF);
        if (lane == 0) fl[wid] = (walive && tfirst - nwin >= 0) ? 1 : 0;
        asm volatile("s_waitcnt lgkmcnt(0)\n\ts_barrier" ::: "memory");
        const i32x4 fa = *(const ALAS i32x4*)fl, fb = *(const ALAS i32x4*)(fl + 4);
        go_on = ((fa[0] | fa[1]) | (fa[2] | fa[3]) | (fb[0] | fb[1]) | (fb[2] | fb[3])) != 0;
        tfirst -= nwin; ntile = tfirst + 1;
    }
    if (go_on) {
    f32x16 p0, p1, n0, n1; u32x4 pw[4];
    __syncthreads();
    int issued = 0;
    ATT_ISSUE(tfirst, 0);
    if (ntile > 1) { ATT_ISSUE(tfirst + tstep, 1); issued = 1; }
    if (ntile > 2) { ATT_ISSUE(tfirst + 2 * tstep, 2); issued = 2; }
    ATT_WAIT_BAR(issued - 1);
    bool wcur = ATT_WORK(tfirst * 64);
    if (wcur) ATT_QK(p0, p1, 0);
    asm volatile("s_waitcnt lgkmcnt(0)\n\ts_barrier" ::: "memory");
    int nt = ntile;
    for (int it = 0; it < nt; ++it) {
        const int t = tfirst + it * tstep, j0 = t * 64, jn = (t + tstep) * 64;
        if (it + 3 < ntile) { ATT_ISSUE(t + 3 * tstep, it + 3); issued = it + 3; }
        if (wcur) ATT_SM_A(p0, p1, j0, it & 3);
        const bool wnext = (it + 1 < nt) && ATT_WORK(jn);
        if (wcur && wnext) { ATT_QK(n0, n1, (it + 1) % 3); ATT_SM_B(p0, p1, j0); }
        else { if (wnext) ATT_QK(n0, n1, (it + 1) % 3); if (wcur) ATT_SM_B(p0, p1, j0); }
        if (wcur) ATT_PV(it & 3);
        p0 = n0; p1 = n1; wcur = wnext;
        if (MODE == 2) { ALAS int* fl = (ALAS int*)(lds + L_FLAG + 16) + (it & 1) * 8; if (lane == 0) fl[wid] = (walive && j0 > 0) ? 1 : 0; }
        ATT_WAIT_BAR(issued - (it + 2));
        if (MODE == 2) { const ALAS int* fl = (const ALAS int*)(lds + L_FLAG + 16) + (it & 1) * 8;
            const i32x4 fa = *(const ALAS i32x4*)fl, fb = *(const ALAS i32x4*)(fl + 4);
            if (((fa[0] | fa[1]) | (fa[2] | fa[3]) | (fb[0] | fb[1]) | (fb[2] | fb[3])) == 0) nt = it + 1; }
    }
    }
    }
    if (MODE == 2) asm volatile("s_waitcnt vmcnt(0)" ::: "memory");
#undef ATT_ISSUE
#undef ATT_WAIT_BAR
#undef ATT_QK
#undef ATT_PV
#undef ATT_PACK
#undef ATT_VLD
#undef ATT_SM_A
#undef ATT_SM_B
#undef ATT_WORK
#undef ATT_MAX3
    if (MODE != 2) {
        const float lt = swap_sum(lrun);
        if (hi == 0) wsf[32 + r32] = 1.0f / lt;
#pragma unroll
        for (int g = 0; g < 4; ++g) { const f32x4 il = *(const ALAS f32x4*)(wsf + 32 + 8 * g + 4 * hi);
#pragma unroll
            for (int i = 0; i < 4; ++i) { o0[4 * g + i] *= il[i]; o1[4 * g + i] *= il[i]; } }
    }
    {
        ALAS bf16_t* stg = (ALAS bf16_t*)ost;
#pragma unroll
        for (int r = 0; r < 16; ++r) { const int orow = crow(r, hi); stg[orow * 64 + r32] = (bf16_t)(cvtpk(o0[r], 0.f) & 0xffffu); stg[orow * 64 + 32 + r32] = (bf16_t)(cvtpk(o1[r], 0.f) & 0xffffu); }
        AGAS bf16_t* Ow = (AGAS bf16_t*)(P.ws + WS_OALL) + (rb + qlo) * 1024 + C::ocol0 + h * 64;
#pragma unroll
        for (int i = 0; i < 4; ++i) {
            const int row = i * 8 + (lane >> 3), ch = lane & 7;
            const u32x4 v = *(const ALAS u32x4*)(stg + row * 64 + ch * 8);
            float ss = 0.f;
#pragma unroll
            for (int k = 0; k < 4; ++k) { const unsigned w = v[k]; const float a = __uint_as_float(w << 16), c = __uint_as_float(w & 0xffff0000u); ss += a * a + c * c; }
            ss += __shfl_xor(ss, 1); ss += __shfl_xor(ss, 2); ss += __shfl_xor(ss, 4);
            *(AGAS u32x4*)(Ow + (size_t)row * 1024 + ch * 8) = v;
            if (ch == 0) ((AGAS float*)(P.ws + WS_SSQO))[(rb + qlo + row) * 16 + C::hidx0 + h] = ss;
        }
    }
#ifdef ATT_PROF
    if (MODE == 0 && blockIdx.x == 0 && wid == ATT_PROF_WAVE && lane == 0 && prof) { const long long tt = PROF_T() - pf_t0;
        atomicAdd(prof + 0, (unsigned long long)tt); atomicAdd(prof + 1, (unsigned long long)pf_qk); atomicAdd(prof + 2, (unsigned long long)pf_sm); atomicAdd(prof + 3, (unsigned long long)pf_pv); atomicAdd(prof + 4, (unsigned long long)pf_wait); atomicAdd(prof + 5, 1ull); }
#endif
}
#undef ALAS
#undef AGAS
}
struct Args { const void* in[23]; float* out; unsigned char* ws; int ph_lo, ph_hi, li, adapt; };

struct Frame { LAS unsigned char* lds; int wave, vcu, G; };
#define FLANE hw_lane()
#define FTID (F.wave * 64 + hw_lane())

__device__ __forceinline__ float wave_sum64(float v) { return pg8::wave_sum_dpp(v); }

__device__ __forceinline__ void tr_item64(const GAS float* W, int ldn, int K, GAS pg8::bf16_t* WT, int kb, int g, int src0, int src1, const GAS float* kgain, LAS unsigned* scr, int lane) {
    const int k0 = 64 * kb; const int col = lane < 32 ? src0 + lane : src1 + (lane - 32); const bool ok = (lane < 32 ? src0 : src1) >= 0;
    const GAS float* wp = W + (size_t)k0 * ldn + (ok ? col : 0);
#pragma unroll
    for (int hf = 0; hf < 4; ++hf) {
        float v[16];
#pragma unroll
        for (int i = 0; i < 16; ++i) v[i] = wp[(size_t)(hf * 16 + i) * ldn];
#pragma unroll
        for (int i = 0; i < 16; ++i) v[i] = ok ? v[i] : 0.f;
        if (kgain) {
#pragma unroll
            for (int i = 0; i < 16; ++i) v[i] *= kgain[k0 + hf * 16 + i]; }
#pragma unroll
        for (int i = 0; i < 8; ++i) scr[(hf * 8 + i) * 65 + lane] = pk2(v[2 * i], v[2 * i + 1]);
    }
    asm volatile("s_waitcnt lgkmcnt(0)" ::: "memory");
    const int c = lane & 7;
#pragma unroll
    for (int j = 0; j < 8; ++j) { const int n = (lane >> 3) + 8 * j; const LAS unsigned* s = scr + (4 * c) * 65 + n;
        v4u o; o.x = s[0]; o.y = s[65]; o.z = s[130]; o.w = s[195];
        *(GAS v4u*)(WT + (size_t)(64 * g + n) * K + k0 + 8 * c) = o; }
    asm volatile("s_waitcnt lgkmcnt(0)" ::: "memory");
}
__device__ __forceinline__ int in_slot_src(int slot, int& cnt) {
    cnt = 64;
    if (slot < 4) return 64 * slot;
    if (slot < 6) return 256 + 64 * (slot - 4);
    if (slot == 6) { cnt = 32; return 384; }
    if (slot == 7) return -1;
    if (slot < 14) return 416 + 64 * (slot - 8);
    if (slot < 16) return 800 + 64 * (slot - 14);
    if (slot < 18) return 928 + 64 * (slot - 16);
    if (slot < 22) return 1056 + 64 * (slot - 18);
    if (slot < 26) return 1312 + 64 * (slot - 22);
    if (slot < 30) return 1568 + 64 * (slot - 26);
    return -1;
}

#define A_X ((const GAS float*)args.in[0])
#define A_C ((const GAS float*)args.in[1])
#define A_POS ((const GAS int*)args.in[2])
#define A_RELB ((const GAS float*)args.in[3])
#define A_NORMG ((const GAS float*)args.in[4])
#define A_WMOD ((const GAS float*)args.in[5])
#define A_BMOD ((const GAS float*)args.in[6])
#define A_WGU1 ((const GAS float*)args.in[7])
#define A_WD1 ((const GAS float*)args.in[8])
#define A_WIN ((const GAS float*)args.in[9])
#define A_QAN ((const GAS float*)args.in[10])
#define A_KVAN ((const GAS float*)args.in[11])
#define A_WUQ ((const GAS float*)args.in[12])
#define A_WUKV ((const GAS float*)args.in[13])
#define A_MLAQN ((const GAS float*)args.in[14])
#define A_MLAKN ((const GAS float*)args.in[15])
#define A_SWAQN ((const GAS float*)args.in[16])
#define A_SWAKN ((const GAS float*)args.in[17])
#define A_SINKS ((const GAS float*)args.in[18])
#define A_OUTN ((const GAS float*)args.in[19])
#define A_WOUT ((const GAS float*)args.in[20])
#define A_WGU2 ((const GAS float*)args.in[21])
#define A_WD2 ((const GAS float*)args.in[22])
#define WSP(off)   (ws_ + (off))
#define MOD ((GAS float*)WSP(WS_MOD))
#define GS ((GAS float*)WSP(WS_GS))
#define BIAS ((GAS float*)WSP(WS_BIAS))
#define SSQX ((GAS float*)WSP(WS_SSQX))
#define SSQO ((GAS float*)WSP(WS_SSQO))
#define CS ((GAS float*)WSP(WS_CS))
#define KPE ((GAS float*)WSP(WS_KPE))
#define SSQ_CQ ((GAS float*)WSP(WS_SSQC))
#define SSQ_CKV ((GAS float*)WSP(WS_SSQC) + (size_t)MROWS * 4)
#define SSQ_KPE ((GAS float*)WSP(WS_SSQC) + (size_t)MROWS * 6)
#define XB ((GAS pg8::bf16_t*)WSP(WS_XB))
#define HID ((GAS pg8::bf16_t*)WSP(WS_HID))
#define CQ ((GAS pg8::bf16_t*)WSP(WS_CQ))
#define CKV ((GAS pg8::bf16_t*)WSP(WS_CKV))
#define KA ((GAS pg8::bf16_t*)WSP(WS_KA))
#define VA ((GAS pg8::bf16_t*)WSP(WS_VA))
#define QS ((GAS pg8::bf16_t*)WSP(WS_QS))
#define KS ((GAS pg8::bf16_t*)WSP(WS_KS))
#define VS ((GAS pg8::bf16_t*)WSP(WS_VS))
#define QC ((GAS pg8::bf16_t*)WSP(WS_QC))
#define KC ((GAS pg8::bf16_t*)WSP(WS_KC))
#define VC ((GAS pg8::bf16_t*)WSP(WS_VC))
#define OALL ((GAS pg8::bf16_t*)WSP(WS_OALL))
#define QRAW ((GAS float*)WSP(WS_QRAW))

__device__ __forceinline__ int in_group_src(int g32) {
    const int tile = g32 >> 3, rr = g32 & 7, bj = rr >> 2, wc = rr & 3; int cnt; const int base = in_slot_src(tile * 4 + wc, cnt);
    return (base >= 0 && 32 * bj < cnt) ? base + 32 * bj : -1;
}
constexpr int CV_GU = 16 * 88, CV_D = 44 * 16, CV_IN = 16 * 32, CV_UQ = 4 * 12, CV_UKV = 2 * 12, CV_OUT = 16 * 16;
constexpr int CV_EARLY = CV_GU + CV_D + CV_IN + CV_UQ + CV_UKV + CV_OUT, CV_L = CV_EARLY + CV_GU + CV_D, CV_ALL = DEPTH * CV_L;
__device__ __forceinline__ void convert_chunk(Frame& F, const Args& args, int base, int limit) {
    GAS unsigned char* ws_ = (GAS unsigned char*)args.ws; asm volatile("" : "+s"(ws_));
    LAS unsigned* scr = (LAS unsigned*)(F.lds + 16384 + F.wave * 8448);
#pragma unroll 1
    for (int q = 0; q < 2; ++q) {
        const int it = base + F.wave * 2 + q; if (it >= limit) break;
        const int l = it / CV_L; int r = it % CV_L;
        GAS unsigned char* wl = ws_ + WS_W + (size_t)l * WL;
        int kind;
        if (r < CV_GU) kind = 0; else if ((r -= CV_GU) < CV_D) kind = 1; else if ((r -= CV_D) < CV_IN) kind = 2; else if ((r -= CV_IN) < CV_UQ) kind = 3;
        else if ((r -= CV_UQ) < CV_UKV) kind = 4; else if ((r -= CV_UKV) < CV_OUT) kind = 5; else if ((r -= CV_OUT) < CV_GU) kind = 6; else { r -= CV_GU; kind = 7; }
        if (kind == 0 || kind == 6) {
            const bool second = kind == 6; const int kb = r / 88, g = r % 88, t = g >> 2, rr = g & 3, src = (rr >> 1) * DFF + 128 * t + 64 * (rr & 1);
            const GAS float* W = (second ? A_WGU2 : A_WGU1) + (size_t)l * DM * 2 * DFF;
            tr_item64(W, 2 * DFF, DM, (GAS pg8::bf16_t*)(wl + (second ? W_GU2 : W_GU1)), kb, g, src, src + 32, nullptr, scr, FLANE);
        } else if (kind == 1 || kind == 7) { const bool second = kind == 7; const int kb = r / 16, g = r % 16;
            tr_item64((second ? A_WD2 : A_WD1) + (size_t)l * DFF * DM, DM, DFF, (GAS pg8::bf16_t*)(wl + (second ? W_D2 : W_D1)), kb, g, 64 * g, 64 * g + 32, nullptr, scr, FLANE);
        } else if (kind == 2) { const int kb = r / 32, g = r % 32;
            tr_item64(A_WIN + (size_t)l * DM * DIN, DIN, DM, (GAS pg8::bf16_t*)(wl + W_IN), kb, g, in_group_src(2 * g), in_group_src(2 * g + 1), nullptr, scr, FLANE);
        } else if (kind == 3) { const int kb = r / 12, g = r % 12;
            tr_item64(A_WUQ + (size_t)l * 256 * 576, 576, 256, (GAS pg8::bf16_t*)(wl + W_UQ), kb, g, g < 9 ? 64 * g : -1, g < 9 ? 64 * g + 32 : -1, A_QAN + l * 256, scr, FLANE);
        } else if (kind == 4) { const int kb = r / 12, g = r % 12, g0 = 2 * g, g1 = 2 * g + 1;
            tr_item64(A_WUKV + (size_t)l * 128 * 768, 768, 128, (GAS pg8::bf16_t*)(wl + W_UKV), kb, g, 256 * (g0 >> 3) + 64 * (g0 & 3) + 32 * ((g0 & 7) >> 2), 256 * (g1 >> 3) + 64 * (g1 & 3) + 32 * ((g1 & 7) >> 2), A_KVAN + l * 128, scr, FLANE);
        } else { const int kb = r / 16, g = r % 16;
            tr_item64(A_WOUT + (size_t)l * DM * DM, DM, DM, (GAS pg8::bf16_t*)(wl + W_OUT), kb, g, 64 * g, 64 * g + 32, A_OUTN + l * DM, scr, FLANE); }
    }
}

__device__ __forceinline__ void phase_pro0(Frame& F, const Args& args, gu32* qhead) {
    GAS unsigned char* ws_ = (GAS unsigned char*)args.ws; asm volatile("" : "+s"(ws_));
    constexpr int NMU = DEPTH * NMOD / 128;
    if ((int)blockIdx.x < NMU || F.G <= NMU) {
        LAS float* cond = (LAS float*)F.lds;
        LAS float* red = (LAS float*)(F.lds + 8192);
        for (int i = FTID; i < 2 * DM; i += 512) { const float cv = A_C[i]; cond[i] = cv / (1.0f + expf(-cv)); }
        __syncthreads();
        for (int u = blockIdx.x; u < NMU; u += F.G) {
            const int l = u / (NMOD / 128), n0 = (u % (NMOD / 128)) * 128, c4 = FLANE & 31, kp = FLANE >> 5;
            const GAS float* w = A_WMOD + (size_t)l * DM * NMOD + n0 + 4 * c4;
            f32x4 a0 = {0.f, 0.f, 0.f, 0.f}, a1 = {0.f, 0.f, 0.f, 0.f};
#pragma unroll 8
            for (int i = 0; i < 64; ++i) { const int kk = F.wave * 128 + 2 * i + kp; const f32x4 wv = *(const GAS f32x4*)(w + (size_t)kk * NMOD); a0 += wv * cond[kk]; a1 += wv * cond[DM + kk]; }
#pragma unroll
            for (int q = 0; q < 4; ++q) { a0[q] = pg8::xsum32(a0[q]); a1[q] = pg8::xsum32(a1[q]); }
            if (kp == 0) { *(LAS f32x4*)(red + (F.wave * 2 + 0) * 128 + 4 * c4) = a0; *(LAS f32x4*)(red + (F.wave * 2 + 1) * 128 + 4 * c4) = a1; }
            __syncthreads();
            if (FTID < 256) { const int bb = FTID >> 7, ln = FTID & 127; float s = 0.f;
#pragma unroll
                for (int wv = 0; wv < 8; ++wv) s += red[(wv * 2 + bb) * 128 + ln];
                MOD[((size_t)l * 2 + bb) * NMOD + n0 + ln] = s + A_BMOD[(size_t)l * NMOD + n0 + ln]; }
            __syncthreads();
        }
    }
    if ((int)blockIdx.x >= NMU || F.G <= NMU) {
        const int nb = F.G <= NMU ? F.G : F.G - NMU, b0 = F.G <= NMU ? (int)blockIdx.x : (int)blockIdx.x - NMU;
        for (int i = b0 * 512 + FTID; i < MROWS * 16; i += nb * 512) {
            const int m = i >> 4, j = i & 15;
            const float freq = powf(10000.0f, -(float)j / 16.0f);
            const float ang = (float)A_POS[m] * freq;
            CS[(size_t)m * 32 + j] = cosf(ang); CS[(size_t)m * 32 + 16 + j] = sinf(ang);
        }
    }
    {
        LAS int* slot = (LAS int*)(F.lds + 12288);
        for (;;) {
            __syncthreads();
            if (FTID == 0) slot[0] = (int)__hip_atomic_fetch_add(qhead, 16u, __ATOMIC_RELAXED, __HIP_MEMORY_SCOPE_AGENT);
            __syncthreads();
            const int base = slot[0];
            if (base >= CV_EARLY) break;
            convert_chunk(F, args, base, CV_EARLY);
        }
    }
}

__device__ __forceinline__ float gs_clamped(float g, float sc) { const float v = g * (1.0f + sc); return fabsf(v) < 1e-20f ? (v < 0.f ? -1e-20f : 1e-20f) : v; }
__device__ __forceinline__ void x_to_xb(Frame& F, const Args& args, const GAS float* xsrc, int l, int i) {
    GAS unsigned char* ws_ = (GAS unsigned char*)args.ws; asm volatile("" : "+s"(ws_));
    const int gw = F.vcu * NWAVES + F.wave, NGW = F.G * NWAVES;
    for (int m = gw; m < MROWS; m += NGW) {
        const int b = m >> 13;
        const GAS f32x4* xr = (const GAS f32x4*)(xsrc + (size_t)m * DM) + FLANE;
        const GAS f32x4* gr = (const GAS f32x4*)(A_NORMG + ((size_t)l * 3 + i) * DM) + FLANE;
        const GAS f32x4* sr = (const GAS f32x4*)(MOD + ((size_t)l * 2 + b) * NMOD + (3 * i + 1) * DM) + FLANE;
        float s = 0.f;
        GAS unsigned long long* o8 = (GAS unsigned long long*)(XB + (size_t)m * DM) + FLANE;
#pragma unroll
        for (int j = 0; j < 4; ++j) { const f32x4 v = xr[64 * j]; s += (v.x * v.x + v.y * v.y) + (v.z * v.z + v.w * v.w);
            const f32x4 g0 = gr[64 * j], s0 = sr[64 * j]; const f32x4 g = {gs_clamped(g0.x, s0.x), gs_clamped(g0.y, s0.y), gs_clamped(g0.z, s0.z), gs_clamped(g0.w, s0.w)}; const f32x4 y = v * g;
            o8[64 * j] = (unsigned long long)pk2(y.x, y.y) | ((unsigned long long)pk2(y.z, y.w) << 32); }
        s = wave_sum64(s);
        if (FLANE < 16) SSQX[(size_t)m * 16 + FLANE] = (FLANE == 0) ? s : 0.f;
    }
}

__device__ __forceinline__ void bias_rows(Frame& F, const Args& args, bool early) {
    GAS unsigned char* ws_ = (GAS unsigned char*)args.ws; asm volatile("" : "+s"(ws_));
    const int gw = F.vcu * NWAVES + F.wave, NGW = F.G * NWAVES;
    constexpr int RL = 5632 + 2048 + 5632, RE = 5632 + 2048;
    const int lo = early ? 0 : RE, hi = early ? RE : DEPTH * RL;
    for (int it = lo + gw; it < hi; it += NGW) {
        const int l = it / RL; int r = it % RL; int which, nrow; size_t woff; size_t boff;
        if (r < 5632) { which = 0; nrow = 5632; woff = W_GU1; boff = 0; } else if (r < 5632 + 2048) { r -= 5632; which = 1; nrow = 2048; woff = W_IN; boff = 2 * 5632; } else { r -= 5632 + 2048; which = 2; nrow = 5632; woff = W_GU2; boff = 2 * (5632 + 2048); }
        const GAS pg8::bf16_t* wr = (const GAS pg8::bf16_t*)(ws_ + WS_W + (size_t)l * WL + woff) + (size_t)r * DM;
        float a0 = 0.f, a1 = 0.f;
#pragma unroll
        for (int j = 0; j < 2; ++j) {
            const v4u wv = *(const GAS v4u*)(wr + j * 512 + FLANE * 8);
            const GAS float* s0 = MOD + ((size_t)l * 2 + 0) * NMOD + (3 * which) * DM + j * 512 + FLANE * 8; const GAS float* s1 = s0 + NMOD;
#pragma unroll
            for (int k = 0; k < 4; ++k) { const unsigned w = wv[k]; const float lo_ = __uint_as_float(w << 16), hi_ = __uint_as_float(w & 0xffff0000u);
                a0 += lo_ * s0[2 * k] + hi_ * s0[2 * k + 1]; a1 += lo_ * s1[2 * k] + hi_ * s1[2 * k + 1]; }
        }
        a0 = wave_sum64(a0); a1 = wave_sum64(a1);
        if (FLANE == 0) { BIAS[(size_t)l * BIAS_L + boff + r] = a0; BIAS[(size_t)l * BIAS_L + boff + nrow + r] = a1; }
    }
}
__device__ __forceinline__ void phase_pro1(Frame& F, const Args& args) {
    GAS unsigned char* ws_ = (GAS unsigned char*)args.ws; asm volatile("" : "+s"(ws_));
    for (int i = blockIdx.x * 512 + FTID; i < DEPTH * 3 * 2 * DM; i += F.G * 512) {
        const int cidx = i & 1023, b = (i >> 10) & 1, li = i >> 11, l = li / 3, ii = li % 3;
        const float gv_ = gs_clamped(A_NORMG[((size_t)l * 3 + ii) * DM + cidx], MOD[((size_t)l * 2 + b) * NMOD + (3 * ii + 1) * DM + cidx]);
        GS[i] = gv_; ((GAS float*)WSP(WS_IGS))[i] = 1.0f / gv_;
    }
    bias_rows(F, args, true);
    x_to_xb(F, args, A_X, 0, 0);
}

__device__ __forceinline__ int next_unit(Frame& F, gu32* head) {
    LAS int* slot = (LAS int*)(F.lds + att::L_FLAG);
    __syncthreads();
    if (FTID == 0) slot[0] = (int)__hip_atomic_fetch_add(head, 1u, __ATOMIC_RELAXED, __HIP_MEMORY_SCOPE_AGENT);
    __syncthreads();
    return slot[0];
}

#ifndef DUPS
#define DUPS -1
#endif
#ifndef PHM
#define PHM 255
#endif
#ifndef PHM2
#define PHM2 31
#endif
__global__ void __launch_bounds__(NWAVES * 64, 2) fwd_mega(Args args) {
    extern __shared__ __attribute__((aligned(16))) unsigned char lds[];
    const int wave0 = __builtin_amdgcn_readfirstlane((int)threadIdx.x >> 6);
    Frame F0; F0.lds = (LAS unsigned char*)lds; F0.wave = wave0;
    F0.G = gridDim.x; { const int bx = blockIdx.x; F0.vcu = (F0.G % 8 == 0) ? (bx % 8) * (F0.G / 8) + bx / 8 : bx; }
    gu32* ctl = (gu32*)(args.ws + WS_CTL);
    for (int u = wave0 * 64 + hw_lane(); u < (LDS_BYTES - LDSCTL_OFF) / 4; u += NWAVES * 64) ((LAS unsigned*)(F0.lds + LDSCTL_OFF))[u] = 0u;
    __syncthreads();
    const int lo = args.ph_lo, hi = args.ph_hi;
    XcdBarrier bar; bar.bar = (unsigned*)(ctl + CW_BAR) + args.li * XCD_BAR_WORDS; bar.x = 0; bar.st = nullptr; bar.w0 = wave0;
    if (hi - lo > 1 || true) bar = xcd_barrier_post((unsigned*)(ctl + CW_BAR) + args.li * XCD_BAR_WORDS, (volatile LAS unsigned*)(F0.lds + MISC_OFF) + 8, wave0);

    for (int ph = lo; ph < hi; ++ph) {
        Frame F; F.lds = F0.lds; F.G = F0.G; F.vcu = F0.vcu; F.wave = wave0;
        GAS unsigned char* ws_ = (GAS unsigned char*)args.ws; asm volatile("" : "+s"(ws_));
        int nrep = 1;
        if (DUPS >= 0) { const int ty = ph < 2 ? 8 + ph : ((ph - 2) & 7); if (ty == DUPS && !(ty == 5) && !((ty == 1 || ty == 7) && ph != 3)) nrep = 2; }
        for (int rep = 0; rep < nrep; ++rep) {
        if ((PHM & 64) && ph == 0) phase_pro0(F, args, ctl + CW_Q + 64 * 8);
        else if ((PHM & 128) && ph == 1) phase_pro1(F, args);
        else {
            const int l = (ph - 2) >> 3, s = (ph - 2) & 7;
            const GAS unsigned char* wl = ws_ + WS_W + (size_t)l * WL;
            const GAS float* biasl = BIAS + (size_t)l * BIAS_L;
            const GAS float* modl = MOD + (size_t)l * 2 * NMOD;
            if ((PHM & 1) && (s == 0 || s == 6)) {
                pg8::Gemm g{(const pg8::bf16_t*)XB, (const pg8::bf16_t*)(wl + (s == 0 ? W_GU1 : W_GU2)), MROWS, 5632, DM}; pg8::StaticOrder S; S.init(MROWS, 5632, F.G, (int)blockIdx.x);
                pg8::EpiUp E{ws_, biasl + (s == 0 ? 0 : 2 * (5632 + 2048))};
                pg8::gemm_phase<pg8::EpiUp, pg8::StaticOrder, true, true>(F.lds, g, S, E, F.wave);
            } else if ((PHM & 2) && (s == 1 || s == 7)) {
                pg8::Gemm g{(const pg8::bf16_t*)HID, (const pg8::bf16_t*)(wl + (s == 1 ? W_D1 : W_D2)), MROWS, DM, DFF}; pg8::StaticOrder S; S.init(MROWS, DM, F.G, (int)blockIdx.x);
                const bool lastp = (s == 7 && l == DEPTH - 1);
                const GAS float* gsn = lastp ? nullptr : (s == 1 ? GS + ((size_t)(l * 3 + 1) * 2) * DM : GS + ((size_t)((l + 1) * 3 + 0) * 2) * DM);
                const GAS float* igp = (const GAS float*)WSP(WS_IGS) + ((size_t)(l * 3 + (s == 1 ? 0 : 2)) * 2) * DM;
                pg8::EpiResS<false> E{(GAS float*)args.out, ws_, modl + (s == 1 ? 2 : 8) * DM, igp, gsn, 0.5f}; pg8::gemm_phase<pg8::EpiResS<false>, pg8::StaticOrder, false, true>(F.lds, g, S, E, F.wave, (unsigned long long*)(ctl + CW_Q + 64 * 13));
            } else if ((PHM & 4) && s == 2) {
                pg8::Gemm g{(const pg8::bf16_t*)XB, (const pg8::bf16_t*)(wl + W_IN), MROWS, 2048, DM}; pg8::StaticOrder S; S.init(MROWS, 2048, F.G, (int)blockIdx.x);
                pg8::EpiIn E{ws_, A_SWAQN + l * 64, A_SWAKN + l * 64, biasl + 2 * 5632};
                pg8::gemm_phase<pg8::EpiIn, pg8::StaticOrder, true, true>(F.lds, g, S, E, F.wave);
            } else if ((PHM & 8) && s == 3) {
                if (PHM2 & 1) { pg8::Gemm g{(const pg8::bf16_t*)CQ, (const pg8::bf16_t*)(wl + W_UQ), MROWS, 768, 256}; pg8::StaticOrder S; S.init(MROWS, 768, F.G, (int)blockIdx.x);
                  pg8::EpiUq E{ws_}; pg8::gemm_phase<pg8::EpiUq, pg8::StaticOrder, true, true>(F.lds, g, S, E, F.wave); }
                if (PHM2 & 2) { pg8::Gemm g{(const pg8::bf16_t*)CKV, (const pg8::bf16_t*)(wl + W_UKV), MROWS, 768, 128}; pg8::StaticOrder S; S.init(MROWS, 768, F.G, (int)((blockIdx.x + 64) % F.G));
                  pg8::EpiUkv E{ws_, A_MLAKN + l * 96}; pg8::gemm_phase<pg8::EpiUkv, pg8::StaticOrder, true, true>(F.lds, g, S, E, F.wave); }
            } else if ((PHM & 16) && s == 4) {
                att::AttnP PA{ws_, A_MLAQN + l * 96, nullptr, nullptr, nullptr};
                att::AttnP PB{ws_, nullptr, A_POS, A_SINKS + l * 6, A_RELB};
                att::AttnP PC{ws_, nullptr, nullptr, nullptr, nullptr};
                gu32* head = ctl + CW_Q + 64 * (2 * l + 1 + 4 * rep);
                for (;;) { const int u = next_unit(F, head); if (u >= 384 + 256 + 384) break;
                    if ((PHM2 & 16) && u < 384) { const int qb = 31 - u / 12, bh = u % 12;
                        att::attn_unit<96, 0>(F.lds, PA, bh / 6, bh % 6, qb, F.wave, (unsigned long long*)(ctl + CW_Q + 64 * 12)); }

                    else if ((PHM2 & 4) && u >= 384 && u < 640) { const int v = u - 384, qb = 31 - (v >> 3), bh = v & 7; att::attn_unit<64, 2>(F.lds, PC, bh >> 2, bh & 3, qb, F.wave); }
                    else if ((PHM2 & 8) && u >= 640) { const int v = u - 640, qb = v / 12, bh = v % 12; att::attn_unit<64, 1>(F.lds, PB, bh / 6, bh % 6, qb, F.wave); } }
                if (l == 0 && rep == 0) {
                    gu32* chead = ctl + CW_Q + 64 * 9; LAS int* cslot = (LAS int*)(F.lds + 12288);
                    for (;;) { __syncthreads(); if (FTID == 0) cslot[0] = (int)__hip_atomic_fetch_add(chead, 16u, __ATOMIC_RELAXED, __HIP_MEMORY_SCOPE_AGENT); __syncthreads();
                        const int cb = CV_EARLY + cslot[0]; if (cb >= CV_ALL) break; convert_chunk(F, args, cb, CV_ALL); } }
            } else if ((PHM & 32) && s == 5) {
                if (l == 0 && rep == 0) { bias_rows(F, args, false); asm volatile("s_waitcnt vmcnt(0)" ::: "memory"); __syncthreads(); }
                pg8::Gemm g{(const pg8::bf16_t*)OALL, (const pg8::bf16_t*)(wl + W_OUT), MROWS, DM, DM}; pg8::StaticOrder S; S.init(MROWS, DM, F.G, (int)blockIdx.x);
                pg8::EpiResS<true> E{(GAS float*)args.out, ws_, modl + 5 * DM, (const GAS float*)WSP(WS_IGS) + ((size_t)(l * 3 + 1) * 2) * DM, GS + ((size_t)(l * 3 + 2) * 2) * DM, 1.0f}; pg8::gemm_phase<pg8::EpiResS<true>, pg8::StaticOrder, false, true>(F.lds, g, S, E, F.wave);
            }
        }
        if (rep + 1 < nrep) xcd_barrier(bar);
        }
        if (ph + 1 < hi) xcd_barrier(bar);
    }
#ifdef GEMM_PROF
    xcd_barrier(bar);
    if (blockIdx.x == 0 && threadIdx.x == 0) { const unsigned long long* st = (const unsigned long long*)(ctl + CW_Q + 64 * 13); double sh;
        if (GEMM_PROF == 0) sh = (double)st[1] / (double)(st[0] + st[1]);
        else if (GEMM_PROF == 1) sh = (double)st[0] / (double)st[2] / 1.0e6;
        else sh = (double)st[1] / (double)st[2] / 1.0e6;
        args.out[0] += (float)(0.04 + 0.18 * (sh > 1.0 ? 1.0 : sh)); }
#endif
#ifdef ATT_PROF
    xcd_barrier(bar);
    if (blockIdx.x == 0 && threadIdx.x == 0) { const unsigned long long* st = (const unsigned long long*)(ctl + CW_Q + 64 * 12);
        const double tot = (double)st[0]; double sh = 0.0;
        if (ATT_PROF == 0) sh = (double)st[0] / (double)st[5] / 1.0e6;
        else if (ATT_PROF == 5) sh = (double)st[0] / (double)st[6] / 1.0e4;
        else if (ATT_PROF == 6) sh = (double)st[6] / 1.0e3;
        else sh = (double)st[ATT_PROF] / tot;
        args.out[0] += (float)(0.04 + 0.18 * (sh > 1.0 ? 1.0 : sh)); }
#endif
}
static void launch_fwd(hipStream_t stream, Args a, int grid, int lo, int hi, int li, int adapt) {
    a.ph_lo = lo; a.ph_hi = hi; a.li = li; a.adapt = adapt;
    hipLaunchKernelGGL(fwd_mega, dim3(grid), dim3(NWAVES * 64), LDS_BYTES, stream, a);
}
extern "C" void kernel_launch(void* const* d_in, const int* in_sizes, int n_in, void* d_out, int out_size, void* d_ws, size_t ws_size, hipStream_t stream) {
    static int grid = 0;
    if (grid == 0) {
        if (n_in != 23 || out_size != MROWS * DM || ws_size < WS_END) { fprintf(stderr, "kernel_launch: unexpected problem (n_in %d, out %d, ws %zu < %zu)\n", n_in, out_size, ws_size, (size_t)WS_END); grid = -1; return; }
        int dev = 0, cus = 0, per_cu = 0;
        if (hipGetDevice(&dev) != hipSuccess || hipDeviceGetAttribute(&cus, hipDeviceAttributeMultiprocessorCount, dev) != hipSuccess) { grid = -1; return; }
        if (hipFuncSetAttribute((const void*)fwd_mega, hipFuncAttributeMaxDynamicSharedMemorySize, LDS_BYTES) != hipSuccess) { fprintf(stderr, "kernel_launch: hipFuncSetAttribute failed\n"); grid = -1; return; }
        if (hipOccupancyMaxActiveBlocksPerMultiprocessor(&per_cu, (const void*)fwd_mega, NWAVES * 64, LDS_BYTES) != hipSuccess || per_cu < 1) { fprintf(stderr, "kernel_launch: occupancy query says %d blocks per CU\n", per_cu); (void)hipGetLastError(); grid = -1; return; }
        if (cus < 256) { fprintf(stderr, "kernel_launch: built for a 256-CU device (the one-unit-per-workgroup GEMM phases need exactly 256 workgroups), found %d CUs\n", cus); grid = -1; return; }
        grid = 256;
    }
    if (grid < 0) return;
    (void)hipMemsetAsync((char*)d_ws + WS_CTL, 0, CTL_ZERO_BYTES, stream);
    Args a{};
    for (int i = 0; i < 23; ++i) a.in[i] = d_in[i];
    a.out = (float*)d_out; a.ws = (unsigned char*)d_ws;
    launch_fwd(stream, a, grid, 0, NPH, 0, -1);
}
```

```cpp
#include <hip/hip_runtime.h>
#include <cstdio>
#include <cstdint>
#include <cmath>
constexpr int NWAVES = 8;
constexpr int BATCH = 2, SEQ = 8192, DM = 1024, DEPTH = 2, MROWS = BATCH * SEQ;
constexpr int DFF = 2816, DIN = 1824, NMOD = 9 * DM;
constexpr int NPH = 2 + 8 * DEPTH;
constexpr size_t MiB = 1u << 20;
constexpr size_t WS_CTL = 0, CTL_ZERO_BYTES = 256 * 1024;
constexpr size_t WS_MOD = 1 * MiB;
constexpr size_t WS_GS = WS_MOD + 160 * 1024;
constexpr size_t WS_IGS = WS_GS + 64 * 1024;
constexpr size_t WS_BIAS = WS_IGS + 64 * 1024;
constexpr size_t BIAS_L = 2 * (5632 + 2048 + 5632);
constexpr size_t WS_SSQX = 2 * MiB;
constexpr size_t WS_SSQO = 3 * MiB;
constexpr size_t WS_CS = 4 * MiB;
constexpr size_t WS_KPE = 6 * MiB;
constexpr size_t WS_SSQC = 8 * MiB;
constexpr size_t WS_W = 9 * MiB;
constexpr size_t W_GU1 = 0, W_D1 = W_GU1 + (size_t)5632 * 1024 * 2, W_IN = W_D1 + (size_t)1024 * 2816 * 2, W_UQ = W_IN + (size_t)2048 * 1024 * 2, W_UKV = W_UQ + (size_t)768 * 256 * 2,
                 W_OUT = W_UKV + (size_t)768 * 128 * 2, W_GU2 = W_OUT + (size_t)1024 * 1024 * 2, W_D2 = W_GU2 + (size_t)5632 * 1024 * 2, WL = W_D2 + (size_t)1024 * 2816 * 2;
constexpr size_t WS_XB = WS_W + ((2 * WL + MiB - 1) / MiB) * MiB;
constexpr size_t WS_ACT = WS_XB + 32 * MiB;
constexpr size_t WS_HID = WS_ACT;
constexpr size_t WS_CQ = WS_ACT, WS_CKV = WS_CQ + 8 * MiB, WS_QRAW = WS_CKV + 4 * MiB, WS_KA = WS_QRAW + 36 * MiB, WS_VA = WS_KA + 18 * MiB, WS_QS = WS_VA + 12 * MiB, WS_KS = WS_QS + 12 * MiB,
                 WS_VS = WS_KS + 4 * MiB, WS_QC = WS_VS + 4 * MiB, WS_KC = WS_QC + 8 * MiB, WS_VC = WS_KC + 8 * MiB, WS_OALL = WS_VC + 8 * MiB, WS_END = WS_OALL + 32 * MiB;
static_assert(WS_HID + (size_t)MROWS * DFF * 2 <= WS_END, "d_ws map");
constexpr int CW_BAR = 4096;
constexpr int CW_Q = 40960;
static_assert((CW_Q + 64 * 14) * 4 <= (int)CTL_ZERO_BYTES && CW_BAR + 8 * 3456 <= CW_Q, "ctl map");
constexpr int RING_BYTES = 131072, LDSCTL_OFF = RING_BYTES, MISC_OFF = LDSCTL_OFF + 320, LDS_BYTES = 147456;

__device__ __forceinline__ int hw_lane() { int l; asm volatile("v_mbcnt_lo_u32_b32 %0, -1, 0\n\tv_mbcnt_hi_u32_b32 %0, -1, %0" : "=v"(l)); return l; }
namespace pg8 {
#define PG8_LAS __attribute__((address_space(3)))
typedef unsigned short bf16_t;
typedef short bf16x8 __attribute__((ext_vector_type(8)));
typedef float f32x4 __attribute__((ext_vector_type(4)));
typedef unsigned u32x4 __attribute__((ext_vector_type(4)));
constexpr int BM = 256, BK = 64, HALF = 128, HTB = HALF * BK * 2  , STAGE_BYTES = 8 * HTB, NXCD = 8, WGM = 8;

__host__ __device__ __forceinline__ int lds_byte(int r, int c) { const int st = (r >> 4) * 2 + (c >> 5), rr = r & 15, cc = c & 31, ob = rr * 64 + cc * 2; return st * 1024 + (ob ^ (((ob >> 9) & 1) << 5)); }
__host__ __device__ __forceinline__ void stage_rc(int b, int& R, int& C) { const int st = b / 1024, sb = b % 1024, swz = sb ^ (((sb >> 9) & 1) << 5); R = (st >> 1) * 16 + swz / 64; C = (st & 1) * 32 + (swz % 64) / 2; }
__host__ __device__ __forceinline__ int perm32(int rho) { const int n = rho >> 4, i = rho & 15; return 8 * (i >> 2) + 4 * n + (i & 3); }

struct Unit { int pm, pn, ord; };
struct Gemm { const bf16_t* A; const bf16_t* Bt; int M, N, K; };

struct StaticOrder {
    int nM, nN, nwg, G, c;
    __host__ __device__ void init(int M, int N, int G_, int c_) { nM = M / BM; nN = N / BM; nwg = nM * nN; G = G_; c = c_; }
    __host__ __device__ bool next(int i, Unit& u) const {
        const long L = (long)i * G + c; if (L >= nwg) return false;
        int wgid = (int)L; { const int q = nwg / NXCD, r = nwg % NXCD, xcd = wgid % NXCD, off = wgid / NXCD; wgid = (xcd < r ? xcd * (q + 1) : r * (q + 1) + (xcd - r) * q) + off; }
        const int nig = WGM * nN, gid = wgid / nig, fm = gid * WGM, gsz = (nM - fm) < WGM ? (nM - fm) : WGM;
        u.pm = fm + ((wgid % nig) % gsz); u.pn = (wgid % nig) / gsz; u.ord = i; return true;
    }
    __device__ __forceinline__ void a_ready(const Unit&) const {}
    __device__ __forceinline__ void done(const Unit&) const {}
};

__device__ __forceinline__ unsigned cvt_pk_bf16(float lo, float hi) { unsigned r; asm volatile("v_cvt_pk_bf16_f32 %0, %1, %2" : "=v"(r) : "v"(lo), "v"(hi)); return r; }
typedef float f32x2 __attribute__((ext_vector_type(2)));
template <class Epi, class Sched, bool ALIGN_EPI = false, bool SP2 = false>
__device__ __forceinline__ void gemm_phase(PG8_LAS unsigned char* lds, const Gemm g, const Sched& S, const Epi& E, int wave0, unsigned long long* gprof = nullptr) {
#ifdef GEMM_PROF
    const long long gp_t0 = (Epi::AFTER_DRAIN && !Epi::HOOK && blockIdx.x == 0) ? (long long)clock64() : 0ll;
#endif
    int tid_ = wave0 * 64 + hw_lane(); asm volatile("" : "+v"(tid_));
    const int tid = tid_, wid = __builtin_amdgcn_readfirstlane(tid >> 6), lane = tid & 63, wr = wid >> 2, wc = wid & 3, fr = lane & 15, fq = lane >> 4;
    int K_ = g.K; asm volatile("" : "+s"(K_));
    const int K = K_, nt = K / BK;
    unsigned voffA[2], voffB[2];
#pragma unroll
    for (int i = 0; i < 2; ++i) { int R, C; stage_rc(tid * 16 + i * 8192, R, C); const int Rb = Epi::PERM ? ((R & ~31) + perm32(R & 31)) : R;
        voffA[i] = (unsigned)(R * K + C) * 2u; voffB[i] = (unsigned)(Rb * K + C) * 2u; }
    const size_t kstep = (size_t)(BK * 2);
    const size_t hstep = (size_t)HALF * K * 2;
    const size_t tstep = 2 * hstep;
    const unsigned ldsw = (unsigned)wid * 1024u;
    const int aoff = lds_byte(wr * 64 + fr, fq * 8), boff = lds_byte(wc * 32 + fr, fq * 8);
#define PG8_SA(b, h) (((b) * 2 + (h)) * HTB)
#define PG8_SB(b, h) ((4 + (b) * 2 + (h)) * HTB)
#define PG8_STAGE(bufoff, gbase, voff) do { _Pragma("unroll") for (int _i = 0; _i < 2; ++_i) \
        __builtin_amdgcn_global_load_lds((const unsigned*)((const char*)(gbase) + (voff)[_i]), (PG8_LAS unsigned*)(lds + (bufoff) + ldsw + _i * 8192), 16, 0, 0); } while (0)
#define PG8_LDA(dst, b, h) do { _Pragma("unroll") for (int m = 0; m < 4; ++m) _Pragma("unroll") for (int k = 0; k < 2; ++k) dst[m][k] = *(const PG8_LAS bf16x8*)(lds + PG8_SA(b, h) + aoff + m * 2048 + k * 1024); } while (0)
#define PG8_LDB(dst, b, h) do { _Pragma("unroll") for (int n = 0; n < 2; ++n) _Pragma("unroll") for (int k = 0; k < 2; ++k) dst[n][k] = *(const PG8_LAS bf16x8*)(lds + PG8_SB(b, h) + boff + n * 2048 + k * 1024); } while (0)
#define PG8_MMA(ai, bj, At, Bt) do { __builtin_amdgcn_s_setprio(1); _Pragma("unroll") for (int m = 0; m < 4; ++m) _Pragma("unroll") for (int n = 0; n < 2; ++n) _Pragma("unroll") for (int k = 0; k < 2; ++k) \
        acc[ai][bj][m][n] = __builtin_amdgcn_mfma_f32_16x16x32_bf16(Bt[n][k], At[m][k], acc[ai][bj][m][n], 0, 0, 0); __builtin_amdgcn_s_setprio(0); } while (0)
#define PG8_WAIT_V(n) asm volatile("s_waitcnt vmcnt(" #n ")" ::: "memory")
#define PG8_WAIT_L(n) asm volatile("s_waitcnt lgkmcnt(" #n ")" ::: "memory")
#define PG8_BAR __builtin_amdgcn_s_barrier()
#define PG8_SCHED __builtin_amdgcn_sched_barrier(0)
    Unit cur, nxt; int ui = 0;
    if (!S.next(0, cur)) return;
    f32x4 acc[2][2][4][2];
#pragma unroll
    for (int a = 0; a < 2; ++a)
#pragma unroll
        for (int b = 0; b < 2; ++b)
#pragma unroll
            for (int m = 0; m < 4; ++m)
#pragma unroll
                for (int n = 0; n < 2; ++n) acc[a][b][m][n] = (f32x4){0.f, 0.f, 0.f, 0.f};
    bf16x8 At[4][2], B0[2][2], B1[2][2];
    const char* cA = (const char*)g.A + (size_t)cur.pm * tstep; const char* cB = (const char*)g.Bt + (size_t)cur.pn * tstep;
    S.a_ready(cur);
    if constexpr (SP2) {
        PG8_STAGE(PG8_SB(0, 0), cB, voffB); PG8_STAGE(PG8_SB(0, 1), cB + hstep, voffB); PG8_STAGE(PG8_SA(0, 0), cA, voffA); PG8_STAGE(PG8_SA(0, 1), cA + hstep, voffA);
        if (wr == 1) PG8_BAR;
        PG8_WAIT_V(2); PG8_BAR;
        PG8_STAGE(PG8_SB(1, 0), cB + kstep, voffB); PG8_STAGE(PG8_SA(1, 0), cA + kstep, voffA); PG8_STAGE(PG8_SB(1, 1), cB + hstep + kstep, voffB);
        PG8_WAIT_V(6); PG8_BAR;
    } else {
        PG8_STAGE(PG8_SB(0, 0), cB, voffB); PG8_STAGE(PG8_SA(0, 0), cA, voffA); PG8_STAGE(PG8_SB(0, 1), cB + hstep, voffB); PG8_STAGE(PG8_SA(0, 1), cA + hstep, voffA);
        if (wr == 1) PG8_BAR;
        PG8_WAIT_V(4); PG8_BAR;
        PG8_STAGE(PG8_SB(1, 0), cB + kstep, voffB); PG8_STAGE(PG8_SA(1, 0), cA + kstep, voffA); PG8_STAGE(PG8_SB(1, 1), cB + hstep + kstep, voffB);
        PG8_WAIT_V(6); PG8_BAR;
    }
    for (;;) {
        const bool has_next = S.next(ui + 1, nxt);
        const char* nA = has_next ? (const char*)g.A + (size_t)nxt.pm * tstep : cA; const char* nB = has_next ? (const char*)g.Bt + (size_t)nxt.pn * tstep : cB;
#pragma nounroll
        for (int t = 0; t < nt; t += 2) {
            if constexpr (Epi::HOOK) E.hook(acc, cur, t, wr, wc, fr, fq);
            const bool last = (t == nt - 2);
            const char* a1 = cA + (size_t)(t + 1) * kstep;
            const char* a2 = last ? nA : cA + (size_t)(t + 2) * kstep; const char* b2 = last ? nB : cB + (size_t)(t + 2) * kstep;
            const char* a3 = a2 + kstep; const char* b3 = b2 + kstep;
            if (last && has_next) S.a_ready(nxt);
            if constexpr (SP2) {
            PG8_LDB(B0, 0, 0); PG8_LDB(B1, 0, 1); PG8_SCHED; PG8_LDA(At, 0, 0); PG8_STAGE(PG8_SA(1, 1), a1 + hstep, voffA);
            PG8_WAIT_V(8); PG8_WAIT_L(0); PG8_BAR; PG8_MMA(0, 0, At, B0); PG8_MMA(0, 1, At, B1); PG8_BAR; PG8_SCHED;
            PG8_LDA(At, 0, 1); PG8_STAGE(PG8_SB(0, 0), b2, voffB); PG8_STAGE(PG8_SB(0, 1), b2 + hstep, voffB); PG8_STAGE(PG8_SA(0, 0), a2, voffA);
            PG8_WAIT_V(8); PG8_WAIT_L(0); PG8_BAR; PG8_MMA(1, 0, At, B0); PG8_MMA(1, 1, At, B1); PG8_BAR; PG8_SCHED;
            PG8_LDB(B0, 1, 0); PG8_LDB(B1, 1, 1); PG8_SCHED; PG8_LDA(At, 1, 0); PG8_STAGE(PG8_SA(0, 1), a2 + hstep, voffA);
            PG8_WAIT_V(8); PG8_WAIT_L(0); PG8_BAR; PG8_MMA(0, 0, At, B0); PG8_MMA(0, 1, At, B1); PG8_BAR; PG8_SCHED;
            PG8_LDA(At, 1, 1); PG8_STAGE(PG8_SB(1, 0), b3, voffB); PG8_STAGE(PG8_SB(1, 1), b3 + hstep, voffB); PG8_STAGE(PG8_SA(1, 0), a3, voffA);
            PG8_WAIT_V(8); PG8_WAIT_L(0); PG8_BAR; PG8_MMA(1, 0, At, B0); PG8_MMA(1, 1, At, B1); PG8_BAR; PG8_SCHED;
            } else {
            PG8_LDB(B0, 0, 0); PG8_SCHED; PG8_LDA(At, 0, 0); PG8_STAGE(PG8_SA(1, 1), a1 + hstep, voffA);
            PG8_WAIT_L(8); PG8_BAR; PG8_WAIT_L(0); PG8_MMA(0, 0, At, B0); PG8_BAR; PG8_SCHED;
            PG8_LDB(B1, 0, 1); PG8_STAGE(PG8_SB(0, 0), b2, voffB);
            PG8_BAR; PG8_WAIT_L(0); PG8_MMA(0, 1, At, B1); PG8_BAR;
            PG8_LDA(At, 0, 1); PG8_STAGE(PG8_SA(0, 0), a2, voffA);
            PG8_BAR; PG8_WAIT_L(0); PG8_MMA(1, 0, At, B0); PG8_BAR; PG8_SCHED;
            PG8_STAGE(PG8_SB(0, 1), b2 + hstep, voffB);
            PG8_WAIT_V(6); PG8_BAR; PG8_MMA(1, 1, At, B1); PG8_BAR;
            PG8_LDB(B0, 1, 0); PG8_SCHED; PG8_LDA(At, 1, 0); PG8_STAGE(PG8_SA(0, 1), a2 + hstep, voffA);
            PG8_WAIT_L(8); PG8_BAR; PG8_WAIT_L(0); PG8_MMA(0, 0, At, B0); PG8_BAR; PG8_SCHED;
            PG8_LDB(B1, 1, 1); PG8_STAGE(PG8_SB(1, 0), b3, voffB);
            PG8_BAR; PG8_WAIT_L(0); PG8_MMA(0, 1, At, B1); PG8_BAR;
            PG8_LDA(At, 1, 1); PG8_STAGE(PG8_SA(1, 0), a3, voffA);
            PG8_BAR; PG8_WAIT_L(0); PG8_MMA(1, 0, At, B0); PG8_BAR; PG8_SCHED;
            PG8_STAGE(PG8_SB(1, 1), b3 + hstep, voffB);
            PG8_WAIT_V(6); PG8_BAR; PG8_MMA(1, 1, At, B1); PG8_BAR;
            }
        }
        if constexpr (ALIGN_EPI) { if (wr == 0) PG8_BAR; }
        if constexpr (!Epi::AFTER_DRAIN) {
            Unit ce = cur; asm volatile("" : "+s"(ce.pm), "+s"(ce.pn), "+s"(ce.ord)); int fre = fr, fqe = fq; asm volatile("" : "+v"(fre), "+v"(fqe));
            E(acc, ce, wr, wc, fre, fqe); S.done(cur); }
        if (!has_next) break;
#pragma unroll
        for (int a = 0; a < 2; ++a)
#pragma unroll
            for (int b = 0; b < 2; ++b)
#pragma unroll
                for (int m = 0; m < 4; ++m)
#pragma unroll
                    for (int n = 0; n < 2; ++n) acc[a][b][m][n] = (f32x4){0.f, 0.f, 0.f, 0.f};
        cur = nxt; cA = nA; cB = nB; ++ui;
        if constexpr (ALIGN_EPI) { if (wr == 1) PG8_BAR; }
    }
    PG8_WAIT_V(0);
    if constexpr (!ALIGN_EPI) { if (wr == 0) PG8_BAR; }
    PG8_BAR;
#ifdef GEMM_PROF
    const long long gp_t1 = (Epi::AFTER_DRAIN && !Epi::HOOK && blockIdx.x == 0) ? (long long)clock64() : 0ll;
#endif
    if constexpr (Epi::AFTER_DRAIN) { E.fused(acc, cur, wr, wc, fr, fq, lds, wid, lane); S.done(cur); }
#ifdef GEMM_PROF
    if (Epi::AFTER_DRAIN && !Epi::HOOK && blockIdx.x == 0 && tid == 0 && gprof) { const long long gp_t2 = clock64(); atomicAdd(gprof + 0, (unsigned long long)(gp_t1 - gp_t0)); atomicAdd(gprof + 1, (unsigned long long)(gp_t2 - gp_t1)); atomicAdd(gprof + 2, 1ull); }
#endif
#undef PG8_SA
#undef PG8_SB
#undef PG8_STAGE
#undef PG8_LDA
#undef PG8_LDB
#undef PG8_MMA
#undef PG8_WAIT_V
#undef PG8_WAIT_L
#undef PG8_BAR
#undef PG8_SCHED
}
constexpr float RMS_EPS = 1e-6f;
constexpr int MROWS_ = 16384;
constexpr float LOG2E = 1.4426950408889634f;
typedef unsigned u32x2 __attribute__((ext_vector_type(2)));
#define PG8_FENCE() asm volatile("" ::: "memory")
#define PG8_G __attribute__((address_space(1)))
__device__ __forceinline__ float sum16f(const PG8_G float* p) {
    const f32x4 a = *(const PG8_G f32x4*)p, b = *(const PG8_G f32x4*)(p + 4), c = *(const PG8_G f32x4*)(p + 8), d = *(const PG8_G f32x4*)(p + 12);
    return ((a[0] + a[1]) + (a[2] + a[3])) + ((b[0] + b[1]) + (b[2] + b[3])) + ((c[0] + c[1]) + (c[2] + c[3])) + ((d[0] + d[1]) + (d[2] + d[3]));
}
__device__ __forceinline__ float xsum16(float x) { auto r = __builtin_amdgcn_permlane16_swap(__float_as_uint(x), __float_as_uint(x), false, false); return __uint_as_float(r[0]) + __uint_as_float(r[1]); }
__device__ __forceinline__ float xsum32(float x) { auto r = __builtin_amdgcn_permlane32_swap(__float_as_uint(x), __float_as_uint(x), false, false); return __uint_as_float(r[0]) + __uint_as_float(r[1]); }
__device__ __forceinline__ float wave_sum_dpp(float x) {
    x += __builtin_bit_cast(float, __builtin_amdgcn_update_dpp(0, __builtin_bit_cast(int, x), 0xB1, 0xf, 0xf, true));
    x += __builtin_bit_cast(float, __builtin_amdgcn_update_dpp(0, __builtin_bit_cast(int, x), 0x4E, 0xf, 0xf, true));
    x += __builtin_bit_cast(float, __builtin_amdgcn_update_dpp(0, __builtin_bit_cast(int, x), 0x141, 0xf, 0xf, true));
    x += __builtin_bit_cast(float, __builtin_amdgcn_update_dpp(0, __builtin_bit_cast(int, x), 0x140, 0xf, 0xf, true));
    return xsum32(xsum16(x));
}
__device__ __forceinline__ float fast_rcp(float x) { return __builtin_amdgcn_rcpf(x); }
__device__ __forceinline__ float silu_fast(float g) { return g * fast_rcp(1.0f + __builtin_amdgcn_exp2f(-g * LOG2E)); }
__device__ __forceinline__ float sq4(const f32x4 v) { return (v[0] * v[0] + v[1] * v[1]) + (v[2] * v[2] + v[3] * v[3]); }

struct EpiUp {
    static constexpr bool PERM = true, AFTER_DRAIN = false, HOOK = false;
    PG8_G unsigned char* ws; const PG8_G float* bias; const PG8_LAS float* rr;
    __device__ __forceinline__ void hook(f32x4 (&)[2][2][4][2], const Unit&, int, int, int, int, int) const {}
    __device__ __forceinline__ void operator()(const f32x4 (&acc)[2][2][4][2], const Unit& u, int wr, int wc, int fr, int fq) const {
        PG8_G bf16_t* HID = (PG8_G bf16_t*)(ws + WS_HID); const PG8_LAS float* rt = rr + u.ord * BM + wr * 64 + fr;
        const int b = u.pm >> 5;
        const PG8_G float* bb = bias + b * 5632 + u.pn * BM + wc * 32 + 8 * fq;
        f32x4 bg[2], bu[2];
#pragma unroll
        for (int n = 0; n < 2; ++n) { bg[n] = *(const PG8_G f32x4*)(bb + 4 * n); bu[n] = *(const PG8_G f32x4*)(bb + HALF + 4 * n); }
#pragma unroll
        for (int ai = 0; ai < 2; ++ai)
#pragma unroll
            for (int m = 0; m < 4; ++m) {
                const int row = u.pm * BM + ai * HALF + wr * 64 + m * 16 + fr;
                const float r = rt[ai * HALF + m * 16];
                float hv[8];
#pragma unroll
                for (int n = 0; n < 2; ++n)
#pragma unroll
                    for (int i = 0; i < 4; ++i) { const float g = acc[ai][0][m][n][i] * r + bg[n][i], uu = acc[ai][1][m][n][i] * r + bu[n][i]; hv[4 * n + i] = silu_fast(g) * uu; }
                u32x4 w; w.x = cvt_pk_bf16(hv[0], hv[1]); w.y = cvt_pk_bf16(hv[2], hv[3]); w.z = cvt_pk_bf16(hv[4], hv[5]); w.w = cvt_pk_bf16(hv[6], hv[7]);
                *(PG8_G u32x4*)(HID + (size_t)row * 2816 + u.pn * HALF + wc * 32 + 8 * fq) = w;
            }
    }
};

template <bool HOOKED> struct EpiResS {
    static constexpr bool PERM = false, AFTER_DRAIN = true, HOOK = HOOKED;
    PG8_G float* fout; PG8_G unsigned char* ws; const PG8_G float* gate; const PG8_G float* igs; const PG8_G float* gs; float coef;
    __device__ __forceinline__ void group_r(int row, float& rA, float& rB, float& rC) const {
        const PG8_G float* p = (const PG8_G float*)(ws + WS_SSQO) + (size_t)row * 16;
        const f32x4 a = *(const PG8_G f32x4*)p, b = *(const PG8_G f32x4*)(p + 4), c = *(const PG8_G f32x4*)(p + 8), d = *(const PG8_G f32x4*)(p + 12);
        const float sA = ((a[0] + a[1]) + (a[2] + a[3])) + (b[0] + b[1]), sB = ((b[2] + b[3]) + (c[0] + c[1])) + (c[2] + c[3]), sC = (d[0] + d[1]) + (d[2] + d[3]);
        rA = 1.0f / sqrtf(sA * (1.0f / 384.0f) + RMS_EPS); rB = 1.0f / sqrtf(sB * (1.0f / 384.0f) + RMS_EPS); rC = 1.0f / sqrtf(sC * (1.0f / 256.0f) + RMS_EPS);
    }
    __device__ __forceinline__ void hook(f32x4 (&acc)[2][2][4][2], const Unit& u, int t, int wr, int wc, int fr, int fq) const {
        if (t != 6 && t != 12) return;
        asm volatile("" : "+v"(fr));
#pragma unroll
        for (int ai = 0; ai < 2; ++ai)
#pragma unroll
            for (int m = 0; m < 4; ++m) {
                const int row = u.pm * BM + ai * HALF + wr * 64 + m * 16 + fr;
                float rA, rB, rC; group_r(row, rA, rB, rC);
                const float f = (t == 6) ? rA / rB : rB / rC;
#pragma unroll
                for (int bj = 0; bj < 2; ++bj)
#pragma unroll
                    for (int n = 0; n < 2; ++n) acc[ai][bj][m][n] = acc[ai][bj][m][n] * f;
                PG8_FENCE();
            }
    }
    __device__ __forceinline__ void fused(f32x4 (&acc)[2][2][4][2], const Unit& u, int wr, int wc, int fr, int fq, PG8_LAS unsigned char* lds, int wid, int lane) const {
        PG8_G bf16_t* xb = (PG8_G bf16_t*)(ws + WS_XB); PG8_G float* ssq_out = (PG8_G float*)(ws + WS_SSQX); constexpr int gate_bstride = 9 * 1024;
        const int b = u.pm >> 5, colg = u.pn * BM + 4 * lane;
        const f32x4 gv = *(const PG8_G f32x4*)(gate + (size_t)b * gate_bstride + colg) * coef;
        const f32x4 gsv = gs ? *(const PG8_G f32x4*)(gs + (size_t)b * 1024 + colg) : (f32x4){0.f, 0.f, 0.f, 0.f};
        const f32x4 igv = *(const PG8_G f32x4*)(igs + (size_t)b * 1024 + colg);
#pragma unroll
        for (int ai = 0; ai < 2; ++ai) {
#pragma unroll
            for (int m = 0; m < 4; ++m) { const int rl = wr * 64 + m * 16 + fr;
#pragma unroll
                for (int bj = 0; bj < 2; ++bj)
#pragma unroll
                    for (int n = 0; n < 2; ++n) { const int c = 32 * bj + 8 * wc + 4 * n + fq; *(PG8_LAS f32x4*)(lds + rl * 1024 + ((c ^ (rl & 7)) << 4)) = acc[ai][bj][m][n]; } }
            asm volatile("s_waitcnt lgkmcnt(0)\n\ts_barrier" ::: "memory");
#pragma unroll
            for (int half = 0; half < 2; ++half) {
                u32x2 xo[8];
#pragma unroll
                for (int k = 0; k < 8; ++k) { const int rl = wid + 8 * (half * 8 + k); xo[k] = *(const PG8_G u32x2*)(xb + (size_t)(u.pm * BM + ai * HALF + rl) * 1024 + colg); }
#pragma unroll
                for (int k = 0; k < 8; ++k) { const int rl = wid + 8 * (half * 8 + k); const int row = u.pm * BM + ai * HALF + rl;
                    f32x4 t = *(const PG8_LAS f32x4*)(lds + rl * 1024 + ((lane ^ (rl & 7)) << 4));
                    if (HOOKED) { float rA, rB, rC; group_r(row, rA, rB, rC); t = t * rC; }
                    const f32x4 xs = {__uint_as_float(xo[k].x << 16), __uint_as_float(xo[k].x & 0xffff0000u), __uint_as_float(xo[k].y << 16), __uint_as_float(xo[k].y & 0xffff0000u)};
                    const f32x4 xn = xs * igv + gv * t;
                    if (!gs) *(PG8_G f32x4*)(fout + (size_t)row * 1024 + colg) = xn;
                    if (gs) { const f32x4 y = xn * gsv; u32x2 w; w.x = cvt_pk_bf16(y[0], y[1]); w.y = cvt_pk_bf16(y[2], y[3]); *(PG8_G u32x2*)(xb + (size_t)row * 1024 + colg) = w; }
                    float ss = sq4(xn);
                    ss = wave_sum_dpp(ss);
                    if (gs && lane == 0) *(PG8_G f32x4*)(ssq_out + (size_t)row * 16 + 4 * u.pn) = (f32x4){ss, 0.f, 0.f, 0.f};
                }
            }
            asm volatile("s_waitcnt lgkmcnt(0)\n\ts_barrier" ::: "memory");
        }
    }
};

struct EpiIn {
    static constexpr bool PERM = true, AFTER_DRAIN = false, HOOK = false;
    PG8_G unsigned char* ws; const PG8_G float* gq; const PG8_G float* gk; const PG8_G float* bias; const PG8_LAS float* rr;
    __device__ __forceinline__ void hook(f32x4 (&)[2][2][4][2], const Unit&, int, int, int, int, int) const {}
    __device__ __forceinline__ void operator()(const f32x4 (&acc)[2][2][4][2], const Unit& u, int wr, int wc, int fr, int fq) const {
        const int slot = u.pn * 4 + wc;
        if (slot == 7 || slot >= 30) return;
        const int b = u.pm >> 5;
        const PG8_LAS float* rt = rr + u.ord * BM + wr * 64 + fr;
        PG8_G PG8_G bf16_t* dst = nullptr; int pitch = 0, col0 = 0; int kind = 0;
        PG8_G PG8_G float* ssqd = nullptr; int ssqp = 0, ssqi = 0; const PG8_G float* gain = nullptr; float scale = 1.0f;
        if (slot < 4)       { dst = (PG8_G bf16_t*)(ws + WS_CQ);  pitch = 256; col0 = 64 * slot;        kind = 1; ssqd = (PG8_G float*)(ws + WS_SSQC);  ssqp = 4; ssqi = slot; }
        else if (slot < 6)  { dst = (PG8_G bf16_t*)(ws + WS_CKV); pitch = 128; col0 = 64 * (slot - 4);  kind = 1; ssqd = (PG8_G float*)(ws + WS_SSQC) + (size_t)MROWS_ * 4; ssqp = 2; ssqi = slot - 4; }
        else if (slot == 6) { kind = 3; }
        else if (slot < 14) { dst = (PG8_G bf16_t*)(ws + WS_QS);  pitch = 384; col0 = 64 * (slot - 8);  kind = 2; gain = gq; scale = 0.125f * LOG2E; }
        else if (slot < 16) { dst = (PG8_G bf16_t*)(ws + WS_KS);  pitch = 128; col0 = 64 * (slot - 14); kind = 2; gain = gk; }
        else if (slot < 18) { dst = (PG8_G bf16_t*)(ws + WS_VS);  pitch = 128; col0 = 64 * (slot - 16); }
        else if (slot < 22) { dst = (PG8_G bf16_t*)(ws + WS_QC);  pitch = 256; col0 = 64 * (slot - 18); scale = 0.125f * LOG2E; }
        else if (slot < 26) { dst = (PG8_G bf16_t*)(ws + WS_KC);  pitch = 256; col0 = 64 * (slot - 22); }
        else                { dst = (PG8_G bf16_t*)(ws + WS_VC);  pitch = 256; col0 = 64 * (slot - 26); }
        const PG8_G float* bb = bias + b * 2048 + u.pn * BM + wc * 32 + 8 * fq;
        f32x4 bv[2][2], gn[2][2];
#pragma unroll
        for (int bj = 0; bj < 2; ++bj)
#pragma unroll
            for (int n = 0; n < 2; ++n) { bv[bj][n] = *(const PG8_G f32x4*)(bb + bj * HALF + 4 * n);
                gn[bj][n] = (kind == 2) ? *(const PG8_G f32x4*)(gain + 32 * bj + 8 * fq + 4 * n) * scale : (f32x4){scale, scale, scale, scale}; }
#pragma unroll
        for (int ai = 0; ai < 2; ++ai)
#pragma unroll
            for (int m = 0; m < 4; ++m) {
                const int row = u.pm * BM + ai * HALF + wr * 64 + m * 16 + fr;
                const float r = rt[ai * HALF + m * 16];
                f32x4 v[2][2]; float ss = 0.f;
#pragma unroll
                for (int bj = 0; bj < 2; ++bj)
#pragma unroll
                    for (int n = 0; n < 2; ++n) { v[bj][n] = acc[ai][bj][m][n] * r + bv[bj][n]; ss += sq4(v[bj][n]); }
                if (kind == 3) {
                    float s0 = sq4(v[0][0]) + sq4(v[0][1]);
                    s0 = xsum32(xsum16(s0));
                    *(PG8_G f32x4*)((PG8_G float*)(ws + WS_KPE) + (size_t)row * 32 + 8 * fq) = v[0][0]; *(PG8_G f32x4*)((PG8_G float*)(ws + WS_KPE) + (size_t)row * 32 + 8 * fq + 4) = v[0][1];
                    if (fq == 0) ((PG8_G float*)(ws + WS_SSQC) + (size_t)MROWS_ * 6)[row] = s0;
                } else {
                    if (kind != 0) { ss = xsum32(xsum16(ss)); }
                    float rn = 1.0f;
                    if (kind == 2) rn = 1.0f / sqrtf(ss * (1.0f / 64.0f) + RMS_EPS);
                    if (kind == 1 && fq == 0) ssqd[(size_t)row * ssqp + ssqi] = ss;
#pragma unroll
                    for (int bj = 0; bj < 2; ++bj) {
                        const f32x4 y0 = v[bj][0] * gn[bj][0] * rn, y1 = v[bj][1] * gn[bj][1] * rn;
                        u32x4 w; w.x = cvt_pk_bf16(y0[0], y0[1]); w.y = cvt_pk_bf16(y0[2], y0[3]); w.z = cvt_pk_bf16(y1[0], y1[1]); w.w = cvt_pk_bf16(y1[2], y1[3]);
                        *(PG8_G u32x4*)(dst + (size_t)row * pitch + col0 + 32 * bj + 8 * fq) = w;
                    }
                }
            }
    }
};

struct EpiUq {
    static constexpr bool PERM = false, AFTER_DRAIN = false, HOOK = false;
    PG8_G unsigned char* ws;
    __device__ __forceinline__ void hook(f32x4 (&)[2][2][4][2], const Unit&, int, int, int, int, int) const {}
    __device__ __forceinline__ void operator()(const f32x4 (&acc)[2][2][4][2], const Unit& u, int wr, int wc, int fr, int fq) const {
        PG8_G bf16_t* QRAW = (PG8_G bf16_t*)(ws + WS_QRAW); const PG8_G float* ssqcq = (const PG8_G float*)(ws + WS_SSQC);
        const int col0 = u.pn * BM + wc * 32 + 4 * fq;
#pragma unroll
        for (int ai = 0; ai < 2; ++ai)
#pragma unroll
            for (int m = 0; m < 4; ++m) {
                const int row = u.pm * BM + ai * HALF + wr * 64 + m * 16 + fr;
                const f32x4 s = *(const PG8_G f32x4*)(ssqcq + (size_t)row * 4);
                const float r = 1.0f / sqrtf(((s[0] + s[1]) + (s[2] + s[3])) * (1.0f / 256.0f) + RMS_EPS);
#pragma unroll
                for (int bj = 0; bj < 2; ++bj)
#pragma unroll
                    for (int n = 0; n < 2; ++n) { const int c = col0 + bj * HALF + n * 16; if (c < 576) { const f32x4 y = acc[ai][bj][m][n] * r; u32x2 w; w.x = cvt_pk_bf16(y[0], y[1]); w.y = cvt_pk_bf16(y[2], y[3]); *(PG8_G u32x2*)(QRAW + (size_t)row * 576 + c) = w; } }
            }
    }
};

struct EpiUkv {
    static constexpr bool PERM = true, AFTER_DRAIN = false, HOOK = false;
    PG8_G unsigned char* ws; const PG8_G float* gk;
    __device__ __forceinline__ void hook(f32x4 (&)[2][2][4][2], const Unit&, int, int, int, int, int) const {}
    __device__ __forceinline__ void operator()(const f32x4 (&acc)[2][2][4][2], const Unit& u, int wr, int wc, int fr, int fq) const {
        PG8_G bf16_t* KA = (PG8_G bf16_t*)(ws + WS_KA); PG8_G bf16_t* VA = (PG8_G bf16_t*)(ws + WS_VA); const PG8_G float* ssqckv = (const PG8_G float*)(ws + WS_SSQC) + (size_t)MROWS_ * 4; const PG8_G float* ssqkpe = (const PG8_G float*)(ws + WS_SSQC) + (size_t)MROWS_ * 6;
        const PG8_G float* kpe = (const PG8_G float*)(ws + WS_KPE); const PG8_G float* cs = (const PG8_G float*)(ws + WS_CS);
        const int h = 2 * u.pn + (wc >> 1); const bool isv = (wc & 1) != 0;
        f32x4 gn[2][2], g1 = {1.f, 1.f, 1.f, 1.f}, g2 = {1.f, 1.f, 1.f, 1.f};
        if (!isv) {
#pragma unroll
            for (int bj = 0; bj < 2; ++bj)
#pragma unroll
                for (int n = 0; n < 2; ++n) gn[bj][n] = *(const PG8_G f32x4*)(gk + 32 * bj + 8 * fq + 4 * n);
            g1 = *(const PG8_G f32x4*)(gk + 64 + 4 * fq); g2 = *(const PG8_G f32x4*)(gk + 80 + 4 * fq);
        }
#pragma unroll
        for (int ai = 0; ai < 2; ++ai)
#pragma unroll
            for (int m = 0; m < 4; ++m) {
                const int row = u.pm * BM + ai * HALF + wr * 64 + m * 16 + fr;
                const float r = 1.0f / sqrtf((ssqckv[(size_t)row * 2] + ssqckv[(size_t)row * 2 + 1]) * (1.0f / 128.0f) + RMS_EPS);
                f32x4 v[2][2]; float ss = 0.f;
#pragma unroll
                for (int bj = 0; bj < 2; ++bj)
#pragma unroll
                    for (int n = 0; n < 2; ++n) { v[bj][n] = acc[ai][bj][m][n] * r; ss += sq4(v[bj][n]); }
                if (isv) {
#pragma unroll
                    for (int bj = 0; bj < 2; ++bj) { u32x4 w; w.x = cvt_pk_bf16(v[bj][0][0], v[bj][0][1]); w.y = cvt_pk_bf16(v[bj][0][2], v[bj][0][3]); w.z = cvt_pk_bf16(v[bj][1][0], v[bj][1][1]); w.w = cvt_pk_bf16(v[bj][1][2], v[bj][1][3]);
                        *(PG8_G u32x4*)(VA + ((size_t)(row >> 6) * 6 + h) * 4096 + bj * 2048 + (row & 63) * 32 + 8 * fq) = w; }
                } else {
                    ss = xsum32(xsum16(ss));
                    const float rk = 1.0f / sqrtf((ss + ssqkpe[row]) * (1.0f / 96.0f) + RMS_EPS);
                    PG8_G bf16_t* kd = KA + ((size_t)(row >> 6) * 6 + h) * 6144 + (row & 63) * 8;
#pragma unroll
                    for (int bj = 0; bj < 2; ++bj) { const f32x4 y0 = v[bj][0] * gn[bj][0] * rk, y1 = v[bj][1] * gn[bj][1] * rk;
                        u32x4 w; w.x = cvt_pk_bf16(y0[0], y0[1]); w.y = cvt_pk_bf16(y0[2], y0[3]); w.z = cvt_pk_bf16(y1[0], y1[1]); w.w = cvt_pk_bf16(y1[2], y1[3]);
                        *(PG8_G u32x4*)(kd + (4 * bj + fq) * 512) = w; }
                    const f32x4 x1 = *(const PG8_G f32x4*)(kpe + (size_t)row * 32 + 4 * fq) * g1 * rk, x2 = *(const PG8_G f32x4*)(kpe + (size_t)row * 32 + 16 + 4 * fq) * g2 * rk;
                    const f32x4 c = *(const PG8_G f32x4*)(cs + (size_t)row * 32 + 4 * fq), s = *(const PG8_G f32x4*)(cs + (size_t)row * 32 + 16 + 4 * fq);
                    const f32x4 o1 = x1 * c - x2 * s, o2 = x2 * c + x1 * s;
                    u32x2 w1, w2; w1.x = cvt_pk_bf16(o1[0], o1[1]); w1.y = cvt_pk_bf16(o1[2], o1[3]); w2.x = cvt_pk_bf16(o2[0], o2[1]); w2.y = cvt_pk_bf16(o2[2], o2[3]);
                    *(PG8_G u32x2*)(kd + (8 + (fq >> 1)) * 512 + (fq & 1) * 4) = w1; *(PG8_G u32x2*)(kd + (10 + (fq >> 1)) * 512 + (fq & 1) * 4) = w2;
                }
                if (m & 1) PG8_FENCE();
            }
    }
};
}
#define GAS __attribute__((address_space(1)))
#define LAS __attribute__((address_space(3)))
typedef unsigned short bf16;
typedef unsigned v4u __attribute__((ext_vector_type(4)));
typedef float f32x4 __attribute__((ext_vector_type(4)));
typedef short bf16x8 __attribute__((ext_vector_type(8)));
typedef GAS unsigned gu32;
typedef GAS unsigned long long gu64;
#define RLX_AGENT __ATOMIC_RELAXED, __HIP_MEMORY_SCOPE_AGENT
#define LDS_WAIT() asm volatile("s_waitcnt lgkmcnt(0)" ::: "memory")
#define VM_WAIT() asm volatile("s_waitcnt vmcnt(0)" ::: "memory")
__device__ __forceinline__ unsigned long long rt() { return __builtin_amdgcn_s_memrealtime(); }
__device__ __forceinline__ unsigned f2bf(float f) { unsigned u = __builtin_bit_cast(unsigned, f); return (u + 0x7fffu + ((u >> 16) & 1u)) >> 16; }
__device__ __forceinline__ unsigned pk2(float lo, float hi) { return f2bf(lo) | (f2bf(hi) << 16); }

#define XB_TMO      128
#define XB_XCNT(j)  (256  + 64 * (j))
#define XB_XSUB(j)  (1280 + 64 * (j))
#define XB_XGEN(j)  (2304 + 64 * (j))
#define XB_TOP      3328
#define XB_TOPGEN   3392
#define XCD_BAR_WORDS 3456
#define XB_SPIN_CAP (1u << 18)

__device__ __forceinline__ unsigned xb_ld(unsigned* p)              { return __hip_atomic_load(p, __ATOMIC_RELAXED, __HIP_MEMORY_SCOPE_AGENT); }
__device__ __forceinline__ unsigned xb_add(unsigned* p, unsigned v) { return __hip_atomic_fetch_add(p, v, __ATOMIC_RELAXED, __HIP_MEMORY_SCOPE_AGENT); }
__device__ __forceinline__ unsigned xb_xcc_id() { return (unsigned)__builtin_amdgcn_s_getreg((3 << 11) | 20) & 0xFu; }
#define XB_SPIN(cond, bar) do { unsigned _sp = 0; while (cond) { __builtin_amdgcn_s_sleep(1); \
    if ((++_sp & 255u) == 0u) { if (xb_ld(&(bar)[XB_TMO])) break; if (_sp > XB_SPIN_CAP) { atomicAdd(&(bar)[XB_TMO], 1u); break; } } } } while (0)

struct XcdBarrier {
    unsigned* bar; unsigned x;
    volatile LAS unsigned* st;
    int w0;
};

__device__ __forceinline__ XcdBarrier xcd_barrier_post(unsigned* bar, volatile LAS unsigned* st, int w0) {
    XcdBarrier b; b.bar = bar; b.x = xb_xcc_id(); b.st = st; b.w0 = w0;
    if (w0 == 0 && hw_lane() == 0) (void)xb_add(&bar[XB_XCNT(b.x)], 1u);
    return b;
}
__device__ __forceinline__ void xcd_barrier_complete(unsigned* bar, unsigned x, unsigned& nloc, unsigned& nx) {
    const unsigned G = gridDim.x * gridDim.y * gridDim.z;
    unsigned sum, cnt, mine, sp = 0u;
    for (;;) {
        sum = 0u; cnt = 0u; mine = 0u;
#pragma unroll
        for (unsigned j = 0; j < 16; ++j) { const unsigned c = xb_ld(&bar[XB_XCNT(j)]); sum += c; cnt += (c > 0u) ? 1u : 0u; mine = (j == x) ? c : mine; }
        if (sum == G) break;
        __builtin_amdgcn_s_sleep(1);
        if ((++sp & 255u) == 0u) { if (xb_ld(&bar[XB_TMO])) break; if (sp > XB_SPIN_CAP) { atomicAdd(&bar[XB_TMO], 1u); break; } }
    }
    nloc = mine > 0u ? mine : 1u; nx = cnt > 0u ? cnt : 1u;
}

__device__ __forceinline__ void xcd_barrier(const XcdBarrier& b) {
    asm volatile("s_waitcnt vmcnt(0)" ::: "memory");
    __syncthreads();
    if (b.w0 == 0 && hw_lane() == 0) {
        unsigned* bar = b.bar;
        __builtin_amdgcn_s_waitcnt(0);
        unsigned nloc = b.st[0], nx = b.st[1];
        if (nloc == 0u) { xcd_barrier_complete(bar, b.x, nloc, nx); b.st[0] = nloc; b.st[1] = nx; }
        const unsigned old = xb_add(&bar[XB_XSUB(b.x)], 1u);
        const unsigned gen = old / nloc;
        if (old + 1u == (gen + 1u) * nloc) {
            __builtin_amdgcn_fence(__ATOMIC_RELEASE, "agent");
            asm volatile("s_waitcnt vmcnt(0)" ::: "memory");
            const unsigned og = xb_add(&bar[XB_TOP], 1u);
            const unsigned tg = og / nx;
            if (og + 1u == (tg + 1u) * nx) xb_add(&bar[XB_TOPGEN], 1u);
            else XB_SPIN(xb_ld(&bar[XB_TOPGEN]) == tg, bar);
            __builtin_amdgcn_fence(__ATOMIC_ACQUIRE, "agent");
            xb_add(&bar[XB_XGEN(b.x)], 1u);
            asm volatile("s_waitcnt vmcnt(0)" ::: "memory");
        } else {
            XB_SPIN(xb_ld(&bar[XB_XGEN(b.x)]) == gen, bar);
            __builtin_amdgcn_fence(__ATOMIC_ACQUIRE, "agent");
            asm volatile("s_waitcnt vmcnt(0)" ::: "memory");
        }
    }
    __syncthreads();
}
namespace att {
typedef unsigned short bf16_t;
typedef short bf16x8 __attribute__((ext_vector_type(8)));
typedef short s16x4 __attribute__((ext_vector_type(4)));
typedef short v4i16_t __attribute__((ext_vector_type(4)));
typedef float f32x16 __attribute__((ext_vector_type(16)));
typedef float f32x4 __attribute__((ext_vector_type(4)));
typedef float f32x2 __attribute__((ext_vector_type(2)));
typedef __bf16 bf16x2_t __attribute__((ext_vector_type(2)));
typedef unsigned u32x4 __attribute__((ext_vector_type(4)));
typedef int i32x4 __attribute__((ext_vector_type(4)));
#define ALAS __attribute__((address_space(3)))
#define AGAS __attribute__((address_space(1)))
constexpr int SEQ = 8192;
constexpr float LOG2E = 1.4426950408889634f, EPS = 1e-6f;
constexpr int KCS = 1040, VHS = 4160;
constexpr int KSLOT = 12 * KCS, VSLOT = 2 * VHS;
constexpr int L_K = 0, L_V = 3 * KSLOT, L_POS = L_V + 4 * VSLOT, L_TB = L_POS + 1024, L_WSF = L_TB + 128, L_OST = L_WSF + 8 * 256, L_FLAG = L_OST + 8 * 4096, L_END = L_FLAG + 16 + 64;
static_assert(L_OST % 16 == 0 && L_V % 16 == 0 && L_END <= 131072, "attention LDS map");
constexpr int S1_KS = 8 * KCS, S1_K = 0, S1_V = 7 * S1_KS, S1_P = S1_V + 7 * VSLOT, S1_LUT = S1_P + 7 * 256, S1_WSF = S1_LUT + 528, S1_END = S1_WSF + 8 * 256;
static_assert(S1_END <= L_FLAG || S1_END <= 131072, "sliding-window LDS map"); static_assert(S1_V % 16 == 0 && S1_WSF % 16 == 0 && S1_END <= 131072, "sliding-window LDS map");

__device__ __forceinline__ int crow(int r, int hi) { return (r & 3) + 8 * (r >> 2) + 4 * hi; }
__device__ __forceinline__ unsigned cvtpk(float lo, float hi) { f32x2 v = {lo, hi}; bf16x2_t b = __builtin_convertvector(v, bf16x2_t); return __builtin_bit_cast(unsigned, b); }
__device__ __forceinline__ s16x4 vtr(const ALAS unsigned char* p) { return __builtin_bit_cast(s16x4, __builtin_amdgcn_ds_read_tr16_b64_v4i16((ALAS v4i16_t*)p)); }
__device__ __forceinline__ float swap_sum(float x) { auto rr = __builtin_amdgcn_permlane32_swap(__float_as_uint(x), __float_as_uint(x), false, false); return __uint_as_float(rr[0]) + __uint_as_float(rr[1]); }
__device__ __forceinline__ float swap_max(float x) { auto rr = __builtin_amdgcn_permlane32_swap(__float_as_uint(x), __float_as_uint(x), false, false); return fmaxf(__uint_as_float(rr[0]), __uint_as_float(rr[1])); }
__device__ __forceinline__ float bf2f(unsigned short h) { return __uint_as_float((unsigned)h << 16); }

__device__ __forceinline__ void glds16(const AGAS void* gsrc, unsigned lds_dst) { unsigned keep;
    asm volatile("s_mov_b32 %0, m0\n\ts_mov_b32 m0, %2\n\ts_nop 0\n\tglobal_load_lds_dwordx4 %1, off\n\ts_mov_b32 m0, %0" : "=&s"(keep) : "v"(gsrc), "s"(lds_dst) : "memory"); }
__device__ __forceinline__ void glds4(const AGAS void* gsrc, unsigned lds_dst) { unsigned keep;
    asm volatile("s_mov_b32 %0, m0\n\ts_mov_b32 m0, %2\n\ts_nop 0\n\tglobal_load_lds_dword %1, off\n\ts_mov_b32 m0, %0" : "=&s"(keep) : "v"(gsrc), "s"(lds_dst) : "memory"); }

struct AttnP {
    AGAS unsigned char* ws;
    const AGAS float* gq;
    const AGAS int* pos; const AGAS float* sinks; const AGAS float* relb;
};
template <int MODE> struct AttnCfg;
template <> struct AttnCfg<0> { static constexpr size_t Q = WS_QRAW, K = WS_KA, V = WS_VA; static constexpr int qpitch = 576, kpitch = 576, khs = 96, vpitch = 384, vhs = 64, ocol0 = 0, hidx0 = 0, group = 1; };
template <> struct AttnCfg<1> { static constexpr size_t Q = WS_QS, K = WS_KS, V = WS_VS; static constexpr int qpitch = 384, kpitch = 128, khs = 64, vpitch = 128, vhs = 64, ocol0 = 384, hidx0 = 6, group = 3; };
template <> struct AttnCfg<2> { static constexpr size_t Q = WS_QC, K = WS_KC, V = WS_VC; static constexpr int qpitch = 256, kpitch = 256, khs = 64, vpitch = 256, vhs = 64, ocol0 = 768, hidx0 = 12, group = 1; };

#ifdef ATT_PROF
#define PROF_T() ((MODE == 0 && blockIdx.x == 0) ? (long long)clock64() : 0ll)
#else
#define PROF_T() 0ll
#endif
template <int DQK, int MODE>
__device__ __forceinline__ void attn_unit(ALAS unsigned char* lds, const AttnP& P, int b, int h, int qb, int wave0, unsigned long long* prof = nullptr) {
    long long pf_qk = 0, pf_sm = 0, pf_pv = 0, pf_wait = 0; const long long pf_t0 = PROF_T();
    constexpr int NCH = DQK / 8, ND0 = DQK / 16;
    int tid_ = wave0 * 64 + hw_lane(); asm volatile("" : "+v"(tid_));
    const int tid = tid_, lane = tid & 63, r32 = lane & 31, hi = lane >> 5;
    const int wid = __builtin_amdgcn_readfirstlane(tid >> 6);
    const int q0 = qb * 256, qlo = q0 + 32 * wid, qhi = qlo + 31, qrow = qlo + r32;
    const size_t rb = (size_t)b * SEQ;
    typedef AttnCfg<MODE> C; const int kvh = h / C::group;
    ALAS float* wsf = (ALAS float*)(lds + (MODE == 1 ? S1_WSF : L_WSF)) + wid * 64;
    ALAS unsigned char* ost = lds + L_OST + wid * 4096;
    ALAS int* posl = (ALAS int*)(lds + L_POS);
    ALAS float* tb = (ALAS float*)(lds + L_TB);

    bf16x8 qf[ND0];
    if constexpr (MODE == 0) {
        const AGAS bf16_t* qp = (const AGAS bf16_t*)(P.ws + C::Q) + (rb + qrow) * 576 + h * 96 + hi * 8;
        float qv[ND0][8]; float ss = 0.f;
#pragma unroll
        for (int d0 = 0; d0 < ND0; ++d0) { const u32x4 w = *(const AGAS u32x4*)(qp + 16 * d0);
#pragma unroll
            for (int i = 0; i < 4; ++i) { const float lo = __uint_as_float(w[i] << 16), hv = __uint_as_float(w[i] & 0xffff0000u); qv[d0][2 * i] = lo; qv[d0][2 * i + 1] = hv; ss += lo * lo + hv * hv; } }
        ss = swap_sum(ss);
        const float rq = 1.0f / sqrtf(ss * (1.0f / 96.0f) + EPS);
#pragma unroll
        for (int d0 = 0; d0 < ND0; ++d0) { const f32x4 ga = *(const AGAS f32x4*)(P.gq + 16 * d0 + 8 * hi), gb = *(const AGAS f32x4*)(P.gq + 16 * d0 + 8 * hi + 4);
#pragma unroll
            for (int i = 0; i < 4; ++i) { qv[d0][i] *= rq * ga[i]; qv[d0][4 + i] *= rq * gb[i]; } }
        {
            const AGAS float* cp = (const AGAS float*)(P.ws + WS_CS) + (rb + qrow) * 32 + 8 * hi;
            const f32x4 c0 = *(const AGAS f32x4*)cp, c1 = *(const AGAS f32x4*)(cp + 4), s0 = *(const AGAS f32x4*)(cp + 16), s1 = *(const AGAS f32x4*)(cp + 20);
#pragma unroll
            for (int i = 0; i < 8; ++i) { const float c = i < 4 ? c0[i & 3] : c1[i & 3], s = i < 4 ? s0[i & 3] : s1[i & 3]; const float x1 = qv[4][i], x2 = qv[5][i]; qv[4][i] = x1 * c - x2 * s; qv[5][i] = x2 * c + x1 * s; }
        }
        const float sc = 0.10206207261596575f * LOG2E;
#pragma unroll
        for (int d0 = 0; d0 < ND0; ++d0) { u32x4 w; w.x = cvtpk(qv[d0][0] * sc, qv[d0][1] * sc); w.y = cvtpk(qv[d0][2] * sc, qv[d0][3] * sc); w.z = cvtpk(qv[d0][4] * sc, qv[d0][5] * sc); w.w = cvtpk(qv[d0][6] * sc, qv[d0][7] * sc); qf[d0] = __builtin_bit_cast(bf16x8, w); }
    } else {
        const AGAS bf16_t* qp = (const AGAS bf16_t*)(P.ws + C::Q) + (rb + qrow) * C::qpitch + h * 64 + hi * 8;
#pragma unroll
        for (int d0 = 0; d0 < ND0; ++d0) qf[d0] = *(const AGAS bf16x8*)(qp + 16 * d0);
    }
    int posq = 0; float sink2 = 0.f;
    if constexpr (MODE == 1) {
        posq = P.pos[rb + qrow]; sink2 = P.sinks[h] * LOG2E;
    }

    int ntile, tfirst, tstep;
    if (MODE == 0) { tfirst = 0; tstep = 1; ntile = ((q0 + 255) >> 6) + 1; }
    else if (MODE == 1) { const int lo = q0 - 127 > 0 ? q0 - 127 : 0; tfirst = lo >> 6; tstep = 1; ntile = ((q0 + 255) >> 6) - tfirst + 1; }
    else { tfirst = (q0 + 254) >> 6; tstep = -1; ntile = tfirst + 1; }

    const AGAS bf16_t* Kg = (const AGAS bf16_t*)(P.ws + C::K) + rb * C::kpitch + kvh * C::khs;
    const AGAS bf16_t* Vg = (const AGAS bf16_t*)(P.ws + C::V) + rb * C::vpitch + kvh * C::vhs;
    const unsigned lds0 = (unsigned)(uintptr_t)lds;
    const AGAS bf16_t* ksrc0 = (MODE == 0) ? (const AGAS bf16_t*)(P.ws + C::K) + ((size_t)b * 128 * 6 + h) * 6144 + wid * 512 + lane * 8 : Kg + (size_t)lane * C::kpitch + 8 * wid;
    const AGAS bf16_t* vsrc = (MODE == 0) ? (const AGAS bf16_t*)(P.ws + C::V) + ((size_t)b * 128 * 6 + h) * 4096 + (wid >> 2) * 2048 + (wid & 3) * 512 + lane * 8
                                          : Vg + (size_t)(16 * (wid & 3) + (lane >> 2)) * C::vpitch + 32 * (wid >> 2) + 8 * (lane & 3);
    constexpr size_t KTS = (MODE == 0) ? (size_t)6 * 6144 : (size_t)64 * C::kpitch, VTS = (MODE == 0) ? (size_t)6 * 4096 : (size_t)64 * C::vpitch, K2O = (MODE == 0) ? 8 * 512 : 64;
    const bool k2 = (wid + 8) < NCH;
    const bool posw = (MODE == 1) && wid == 0;
    const int NP = 2 + (k2 ? 1 : 0) + (posw ? 1 : 0);
#define ATT_ISSUE(T, IT) do { const int T_ = (T); const size_t jo_ = (size_t)T_ * 64; const int ks_ = (IT) % 3, vs_ = (IT) & 3;     \
        glds16(ksrc0 + (size_t)T_ * KTS, (unsigned)__builtin_amdgcn_readfirstlane(lds0 + L_K + ks_ * KSLOT + wid * KCS)); \
        if (k2) glds16(ksrc0 + (size_t)T_ * KTS + K2O, (unsigned)__builtin_amdgcn_readfirstlane(lds0 + L_K + ks_ * KSLOT + (wid + 8) * KCS)); \
        glds16(vsrc + (size_t)T_ * VTS, (unsigned)__builtin_amdgcn_readfirstlane(lds0 + L_V + vs_ * VSLOT + (wid >> 2) * VHS + (wid & 3) * 1024)); \
        if (posw) glds4(P.pos + rb + jo_ + lane, (unsigned)__builtin_amdgcn_readfirstlane(lds0 + L_POS + vs_ * 256)); } while (0)
#define ATT_WAIT_BAR(n_) do { if ((n_) <= 0) asm volatile("s_waitcnt vmcnt(0) lgkmcnt(0)\n\ts_barrier" ::: "memory"); \
        else if (NP == 2) asm volatile("s_waitcnt vmcnt(2) lgkmcnt(0)\n\ts_barrier" ::: "memory"); \
        else if (NP == 3) asm volatile("s_waitcnt vmcnt(3) lgkmcnt(0)\n\ts_barrier" ::: "memory"); \
        else asm volatile("s_waitcnt vmcnt(4) lgkmcnt(0)\n\ts_barrier" ::: "memory"); } while (0)

    f32x16 o0 = {}, o1 = {};
    float mrun = (MODE == 1) ? sink2 : 0.f;
    float lrun = (MODE == 1 && hi == 0) ? 1.0f : 0.f;
    f32x16 negm;
#pragma unroll
    for (int r = 0; r < 16; ++r) negm[r] = (MODE == 2) ? 0.f : -mrun;
    bool first = (MODE == 0);
    float after = 0.f;
    bool walive = true;
    const int vrd = ((lane >> 4) & 1) * 32 + (lane & 3) * 8 + (4 * hi + ((lane & 15) >> 2)) * 64;
    const bool lag = wid >= 4;
    constexpr float THR = 4.0f;

#define ATT_QK(P0, P1, kb) do { int kofs_ = L_K + (kb) * KSLOT + hi * KCS + r32 * 16; asm volatile("" : "+v"(kofs_)); const ALAS unsigned char* Kb_ = lds + kofs_;     \
        bf16x8 kfa_[4], kfb_[4]; \
        _Pragma("unroll") for (int d0 = 0; d0 < 3; ++d0) { kfa_[d0] = *(const ALAS bf16x8*)(Kb_ + 2 * d0 * KCS); kfb_[d0] = *(const ALAS bf16x8*)(Kb_ + 2 * d0 * KCS + 512); } \
        \
        _Pragma("unroll") for (int d0 = 0; d0 < ND0; ++d0) { \
            if (d0 + 3 < ND0) { kfa_[(d0 + 3) & 3] = *(const ALAS bf16x8*)(Kb_ + 2 * (d0 + 3) * KCS); kfb_[(d0 + 3) & 3] = *(const ALAS bf16x8*)(Kb_ + 2 * (d0 + 3) * KCS + 512); } \
            if (d0 == 0) { P0 = __builtin_amdgcn_mfma_f32_32x32x16_bf16(kfa_[0], qf[0], negm, 0, 0, 0); P1 = __builtin_amdgcn_mfma_f32_32x32x16_bf16(kfb_[0], qf[0], negm, 0, 0, 0); } \
            else { P0 = __builtin_amdgcn_mfma_f32_32x32x16_bf16(kfa_[d0 & 3], qf[d0], P0, 0, 0, 0); P1 = __builtin_amdgcn_mfma_f32_32x32x16_bf16(kfb_[d0 & 3], qf[d0], P1, 0, 0, 0); } \
            } } while (0)
#define ATT_VLD(i_, s_) do { vl0_[i_] = vtr(Vb_ + (s_) * 1024); vh0_[i_] = vtr(Vb_ + (s_) * 1024 + 512); vl1_[i_] = vtr(Vb_ + VHS + (s_) * 1024); vh1_[i_] = vtr(Vb_ + VHS + (s_) * 1024 + 512); } while (0)
#define ATT_PV(vb) do { int vofs_ = L_V + (vb) * VSLOT + vrd; asm volatile("" : "+v"(vofs_)); const ALAS unsigned char* Vb_ = lds + vofs_; \
        s16x4 vl0_[2], vh0_[2], vl1_[2], vh1_[2]; ATT_VLD(0, 0); \
        _Pragma("unroll") for (int s_ = 0; s_ < 4; ++s_) { \
            if (s_ + 1 < 4) ATT_VLD((s_ + 1) & 1, s_ + 1); \
            const int i_ = s_ & 1; const bf16x8 pa_ = __builtin_bit_cast(bf16x8, pw[s_]); \
            const bf16x8 v0_ = {vl0_[i_][0], vl0_[i_][1], vl0_[i_][2], vl0_[i_][3], vh0_[i_][0], vh0_[i_][1], vh0_[i_][2], vh0_[i_][3]}, v1_ = {vl1_[i_][0], vl1_[i_][1], vl1_[i_][2], vl1_[i_][3], vh1_[i_][0], vh1_[i_][1], vh1_[i_][2], vh1_[i_][3]}; \
            o0 = __builtin_amdgcn_mfma_f32_32x32x16_bf16(pa_, v0_, o0, 0, 0, 0); o1 = __builtin_amdgcn_mfma_f32_32x32x16_bf16(pa_, v1_, o1, 0, 0, 0); } } while (0)
#define ATT_PACK(P0, P1) do { \
        pw[0].x = cvtpk(P0[0], P0[1]); pw[0].y = cvtpk(P0[2], P0[3]); pw[0].z = cvtpk(P0[4], P0[5]); pw[0].w = cvtpk(P0[6], P0[7]); \
        pw[1].x = cvtpk(P0[8], P0[9]); pw[1].y = cvtpk(P0[10], P0[11]); pw[1].z = cvtpk(P0[12], P0[13]); pw[1].w = cvtpk(P0[14], P0[15]); \
        pw[2].x = cvtpk(P1[0], P1[1]); pw[2].y = cvtpk(P1[2], P1[3]); pw[2].z = cvtpk(P1[4], P1[5]); pw[2].w = cvtpk(P1[6], P1[7]); \
        pw[3].x = cvtpk(P1[8], P1[9]); pw[3].y = cvtpk(P1[10], P1[11]); pw[3].z = cvtpk(P1[12], P1[13]); pw[3].w = cvtpk(P1[14], P1[15]); } while (0)
#define ATT_MAX3(a, b, c) fmaxf(fmaxf((a), (b)), (c))
#define ATT_SM_A(P0, P1, j0_, pslot) do { if constexpr (MODE != 2) { \
            if constexpr (MODE == 1) { \
                _Pragma("unroll") for (int g = 0; g < 4; ++g) { \
                    const i32x4 pa = *(const ALAS i32x4*)(posl + (pslot) * 64 + 8 * g + 4 * hi), pb = *(const ALAS i32x4*)(posl + (pslot) * 64 + 32 + 8 * g + 4 * hi); \
                    _Pragma("unroll") for (int i = 0; i < 4; ++i) { \
                        { int n = posq - pa[i]; n = n > 0 ? n : 0; int bk = n; if (n >= 16) { bk = 16 + (int)((__builtin_amdgcn_logf((float)n) - 4.0f) * (16.0f / 3.0f)); bk = bk < 31 ? bk : 31; } P0[4 * g + i] += tb[bk]; } \
                        { int n = posq - pb[i]; n = n > 0 ? n : 0; int bk = n; if (n >= 16) { bk = 16 + (int)((__builtin_amdgcn_logf((float)n) - 4.0f) * (16.0f / 3.0f)); bk = bk < 31 ? bk : 31; } P1[4 * g + i] += tb[bk]; } } } } \
            const bool nm_ = (MODE == 1) || ((j0_) + 63 > qlo); \
            if (nm_) { \
                _Pragma("unroll") for (int r = 0; r < 16; ++r) { const int key = (j0_) + crow(r, hi); \
                    bool ok0 = key <= qrow, ok1 = key + 32 <= qrow; \
                    if (MODE == 1) { ok0 = ok0 && (key > qrow - 128); ok1 = ok1 && (key + 32 > qrow - 128); } \
                    if (!ok0) P0[r] = -INFINITY; if (!ok1) P1[r] = -INFINITY; } } \
            float ma = ATT_MAX3(P0[0], P0[1], P1[0]), mb = ATT_MAX3(P0[2], P0[3], P1[1]); ma = ATT_MAX3(ma, P1[2], P1[3]); \
            _Pragma("unroll") for (int r = 4; r < 16; r += 4) { ma = ATT_MAX3(ma, P0[r], P0[r + 1]); mb = ATT_MAX3(mb, P0[r + 2], P0[r + 3]); ma = ATT_MAX3(ma, P1[r], P1[r + 1]); mb = ATT_MAX3(mb, P1[r + 2], P1[r + 3]); } \
            const float mt = swap_max(fmaxf(ma, mb)); \
            if (first || __any(mt > THR)) {                                 \
                const float d = first ? mt : fmaxf(mt, 0.f); first = false; \
                _Pragma("unroll") for (int r = 0; r < 16; ++r) { P0[r] -= d; P1[r] -= d; } \
                const float alpha = __builtin_amdgcn_exp2f(-d); mrun += d; lrun *= alpha; \
                _Pragma("unroll") for (int r = 0; r < 16; ++r) negm[r] = -mrun; \
                if (hi == 0) wsf[r32] = alpha; \
                _Pragma("unroll") for (int g = 0; g < 4; ++g) { const f32x4 al = *(const ALAS f32x4*)(wsf + 8 * g + 4 * hi); \
                    _Pragma("unroll") for (int i = 0; i < 4; ++i) { o0[4 * g + i] *= al[i]; o1[4 * g + i] *= al[i]; } } } } } while (0)
#define ATT_SM_B(P0, P1, j0_) do { \
        if constexpr (MODE == 2) { \
            const bool nm_ = (j0_) + 63 >= qlo; \
            float ln0[16], ln1[16]; \
            _Pragma("unroll") for (int r = 0; r < 16; ++r) { const int key = (j0_) + crow(r, hi); \
                { const float z = P0[r]; const float sp = fmaxf(z, 0.f) + __builtin_amdgcn_logf(1.0f + __builtin_amdgcn_exp2f(-fabsf(z))); const bool ok = !nm_ || key < qrow; ln0[r] = ok ? -sp : 0.f; P0[r] = ok ? z - sp : -INFINITY; } \
                { const float z = P1[r]; const float sp = fmaxf(z, 0.f) + __builtin_amdgcn_logf(1.0f + __builtin_amdgcn_exp2f(-fabsf(z))); const bool ok = !nm_ || key + 32 < qrow; ln1[r] = ok ? -sp : 0.f; P1[r] = ok ? z - sp : -INFINITY; } } \
            float run = after; \
            _Pragma("unroll") for (int blk = 1; blk >= 0; --blk) _Pragma("unroll") for (int g = 3; g >= 0; --g) { \
                const float own = blk ? ((ln1[4 * g] + ln1[4 * g + 1]) + (ln1[4 * g + 2] + ln1[4 * g + 3])) : ((ln0[4 * g] + ln0[4 * g + 1]) + (ln0[4 * g + 2] + ln0[4 * g + 3])); \
                auto rr = __builtin_amdgcn_permlane32_swap(__float_as_uint(own), __float_as_uint(own), false, false); \
                const float slo = __uint_as_float(rr[0]), shi = __uint_as_float(rr[1]); \
                const float e1 = run; run += shi; const float e0 = run; run += slo; \
                float aft = hi ? e1 : e0; \
                _Pragma("unroll") for (int i = 3; i >= 0; --i) { const int r = 4 * g + i; \
                    if (blk) { P1[r] = __builtin_amdgcn_exp2f(P1[r] + aft); aft += ln1[r]; } else { P0[r] = __builtin_amdgcn_exp2f(P0[r] + aft); aft += ln0[r]; } } } \
            after = run; walive = __any(after > -160.0f); \
        } else { \
            float ls = 0.f; \
            _Pragma("unroll") for (int r = 0; r < 16; ++r) { P0[r] = __builtin_amdgcn_exp2f(P0[r]); P1[r] = __builtin_amdgcn_exp2f(P1[r]); ls += P0[r] + P1[r]; } \
            lrun += ls; } \
        ATT_PACK(P0, P1); } while (0)
#define ATT_WORK(j0_) ((MODE == 0) ? ((j0_) <= qhi) : (MODE == 1) ? (((j0_) <= qhi) && ((j0_) + 63 >= qlo - 127)) : (walive && ((j0_) < qhi)))

    if constexpr (MODE == 0) {
    f32x16 p0, p1, n0, n1; u32x4 pw[4];
    __syncthreads();
    int issued = 0;
    ATT_ISSUE(0, 0);
    if (ntile > 1) { ATT_ISSUE(1, 1); issued = 1; }
    if (ntile > 2) { ATT_ISSUE(2, 2); issued = 2; }
    ATT_WAIT_BAR(issued - 1);
    const int tmax = qhi >> 6;
#define MLA_SB() __builtin_amdgcn_sched_barrier(0)
#define MLA_EX(v) __builtin_amdgcn_exp2f(v)
#define MLA_DECIDE(X0, X1, j0_) do { \
        if ((j0_) + 63 > qlo) { _Pragma("unroll") for (int r = 0; r < 16; ++r) { const int key = (j0_) + crow(r, hi); if (key > qrow) X0[r] = -INFINITY; if (key + 32 > qrow) X1[r] = -INFINITY; } } \
        float ma = ATT_MAX3(X0[0], X0[1], X1[0]), mb = ATT_MAX3(X0[2], X0[3], X1[1]); ma = ATT_MAX3(ma, X1[2], X1[3]); \
        _Pragma("unroll") for (int r = 4; r < 16; r += 4) { ma = ATT_MAX3(ma, X0[r], X0[r + 1]); mb = ATT_MAX3(mb, X0[r + 2], X0[r + 3]); ma = ATT_MAX3(ma, X1[r], X1[r + 1]); mb = ATT_MAX3(mb, X1[r + 2], X1[r + 3]); } \
        const float mt = swap_max(fmaxf(ma, mb)); resc = false; \
        if (first || __any(mt > THR)) { const float d = first ? mt : fmaxf(mt, 0.f); first = false; \
            _Pragma("unroll") for (int r = 0; r < 16; ++r) { X0[r] -= d; X1[r] -= d; } \
            const float alpha = __builtin_amdgcn_exp2f(-d); lrun *= alpha; const float nm_ = negm[0] - d;     \
            _Pragma("unroll") for (int r = 0; r < 16; ++r) negm[r] = nm_; \
            if (hi == 0) wsf[r32] = alpha; resc = true; } } while (0)
#define MLA_RESC() do { if (resc) { _Pragma("unroll") for (int g = 0; g < 4; ++g) { const f32x4 al = *(const ALAS f32x4*)(wsf + 8 * g + 4 * hi); \
            _Pragma("unroll") for (int i = 0; i < 4; ++i) { o0[4 * g + i] *= al[i]; o1[4 * g + i] *= al[i]; } } } } while (0)
#define MLA_PV_(i) (i < 16 ? C0[(i) & 15] : C1[(i) & 15])
#define MLA_GA(MF, g, C0, C1) do { MF; \
        if (3 * (g) < 32) sacc += (3 * (g) < 16 ? C0[(3 * (g)) & 15] : C1[(3 * (g)) & 15]); \
        if (3 * (g) + 1 < 32) sacc += (3 * (g) + 1 < 16 ? C0[(3 * (g) + 1) & 15] : C1[(3 * (g) + 1) & 15]); \
        if (3 * (g) + 2 < 32) sacc += (3 * (g) + 2 < 16 ? C0[(3 * (g) + 2) & 15] : C1[(3 * (g) + 2) & 15]); \
        if ((g) < 4) { pw[((g) >> 1) & 3][2 * ((g) & 1)] = cvtpk(C0[4 * (g)], C0[4 * (g) + 1]); pw[((g) >> 1) & 3][2 * ((g) & 1) + 1] = cvtpk(C0[4 * (g) + 2], C0[4 * (g) + 3]); } \
        else if ((g) < 8) { pw[((g) >> 1) & 3][2 * ((g) & 1)] = cvtpk(C1[4 * ((g) - 4)], C1[4 * ((g) - 4) + 1]); pw[((g) >> 1) & 3][2 * ((g) & 1) + 1] = cvtpk(C1[4 * ((g) - 4) + 2], C1[4 * ((g) - 4) + 3]); } } while (0)
#define MLA_VF(lo_, hi_) (bf16x8){lo_[0], lo_[1], lo_[2], lo_[3], hi_[0], hi_[1], hi_[2], hi_[3]}
#define MLA_GB(MF, X, b_) do { MF; X[(b_)] = MLA_EX(X[(b_)]); X[(b_) + 1] = MLA_EX(X[(b_) + 1]); X[(b_) + 2] = MLA_EX(X[(b_) + 2]); X[(b_) + 3] = MLA_EX(X[(b_) + 3]); } while (0)
#define MLA_FULL(C0, C1, N0, N1, t_) do { \
        int kofs_ = L_K + (((t_) + 1) % 3) * KSLOT + hi * KCS + r32 * 16; asm volatile("" : "+v"(kofs_)); const ALAS unsigned char* Kb_ = lds + kofs_; \
        int vofs_ = L_V + ((t_) & 3) * VSLOT + vrd; asm volatile("" : "+v"(vofs_)); const ALAS unsigned char* Vb_ = lds + vofs_; \
        bf16x8 ka0 = *(const ALAS bf16x8*)(Kb_), kb0 = *(const ALAS bf16x8*)(Kb_ + 512), ka1 = *(const ALAS bf16x8*)(Kb_ + 2 * KCS), kb1 = *(const ALAS bf16x8*)(Kb_ + 2 * KCS + 512), ka2, kb2; \
        s16x4 vl0a, vh0a, vl1a, vh1a, vl0b, vh0b, vl1b, vh1b; float sacc = 0.f; \
        MLA_SB(); \
        MLA_GA(N0 = __builtin_amdgcn_mfma_f32_32x32x16_bf16(ka0, qf[0], negm, 0, 0, 0), 0, C0, C1); ka2 = *(const ALAS bf16x8*)(Kb_ + 4 * KCS); MLA_SB(); \
        MLA_GA(N1 = __builtin_amdgcn_mfma_f32_32x32x16_bf16(kb0, qf[0], negm, 0, 0, 0), 1, C0, C1); kb2 = *(const ALAS bf16x8*)(Kb_ + 4 * KCS + 512); MLA_SB(); \
        MLA_GA(N0 = __builtin_amdgcn_mfma_f32_32x32x16_bf16(ka1, qf[1], N0, 0, 0, 0), 2, C0, C1); ka0 = *(const ALAS bf16x8*)(Kb_ + 6 * KCS); MLA_SB(); \
        MLA_GA(N1 = __builtin_amdgcn_mfma_f32_32x32x16_bf16(kb1, qf[1], N1, 0, 0, 0), 3, C0, C1); kb0 = *(const ALAS bf16x8*)(Kb_ + 6 * KCS + 512); MLA_SB(); \
        MLA_GA(N0 = __builtin_amdgcn_mfma_f32_32x32x16_bf16(ka2, qf[2], N0, 0, 0, 0), 4, C0, C1); ka1 = *(const ALAS bf16x8*)(Kb_ + 8 * KCS); MLA_SB(); \
        MLA_GA(N1 = __builtin_amdgcn_mfma_f32_32x32x16_bf16(kb2, qf[2], N1, 0, 0, 0), 5, C0, C1); kb1 = *(const ALAS bf16x8*)(Kb_ + 8 * KCS + 512); MLA_SB(); \
        MLA_GA(N0 = __builtin_amdgcn_mfma_f32_32x32x16_bf16(ka0, qf[3], N0, 0, 0, 0), 6, C0, C1); ka2 = *(const ALAS bf16x8*)(Kb_ + 10 * KCS); MLA_SB(); \
        MLA_GA(N1 = __builtin_amdgcn_mfma_f32_32x32x16_bf16(kb0, qf[3], N1, 0, 0, 0), 7, C0, C1); kb2 = *(const ALAS bf16x8*)(Kb_ + 10 * KCS + 512); MLA_SB(); \
        MLA_GA(N0 = __builtin_amdgcn_mfma_f32_32x32x16_bf16(ka1, qf[4], N0, 0, 0, 0), 8, C0, C1); MLA_SB(); \
        MLA_GA(N1 = __builtin_amdgcn_mfma_f32_32x32x16_bf16(kb1, qf[4], N1, 0, 0, 0), 9, C0, C1); MLA_SB(); \
        MLA_GA(N0 = __builtin_amdgcn_mfma_f32_32x32x16_bf16(ka2, qf[5], N0, 0, 0, 0), 10, C0, C1); vl0a = vtr(Vb_); vh0a = vtr(Vb_ + 512); MLA_SB(); \
        MLA_GA(N1 = __builtin_amdgcn_mfma_f32_32x32x16_bf16(kb2, qf[5], N1, 0, 0, 0), 11, C0, C1); vl1a = vtr(Vb_ + VHS); vh1a = vtr(Vb_ + VHS + 512); MLA_SB(); \
        lrun += sacc; \
        MLA_DECIDE(N0, N1, ((t_) + 1) * 64); \
        MLA_SB(); \
        MLA_GB(o0 = __builtin_amdgcn_mfma_f32_32x32x16_bf16(__builtin_bit_cast(bf16x8, pw[0]), MLA_VF(vl0a, vh0a), o0, 0, 0, 0), N0, 0); vl0b = vtr(Vb_ + 1024); vh0b = vtr(Vb_ + 1024 + 512); MLA_SB(); \
        MLA_GB(o1 = __builtin_amdgcn_mfma_f32_32x32x16_bf16(__builtin_bit_cast(bf16x8, pw[0]), MLA_VF(vl1a, vh1a), o1, 0, 0, 0), N0, 4); vl1b = vtr(Vb_ + VHS + 1024); vh1b = vtr(Vb_ + VHS + 1024 + 512); MLA_SB(); \
        MLA_GB(o0 = __builtin_amdgcn_mfma_f32_32x32x16_bf16(__builtin_bit_cast(bf16x8, pw[1]), MLA_VF(vl0b, vh0b), o0, 0, 0, 0), N0, 8); vl0a = vtr(Vb_ + 2048); vh0a = vtr(Vb_ + 2048 + 512); MLA_SB(); \
        MLA_GB(o1 = __builtin_amdgcn_mfma_f32_32x32x16_bf16(__builtin_bit_cast(bf16x8, pw[1]), MLA_VF(vl1b, vh1b), o1, 0, 0, 0), N0, 12); vl1a = vtr(Vb_ + VHS + 2048); vh1a = vtr(Vb_ + VHS + 2048 + 512); MLA_SB(); \
        MLA_GB(o0 = __builtin_amdgcn_mfma_f32_32x32x16_bf16(__builtin_bit_cast(bf16x8, pw[2]), MLA_VF(vl0a, vh0a), o0, 0, 0, 0), N1, 0); vl0b = vtr(Vb_ + 3072); vh0b = vtr(Vb_ + 3072 + 512); MLA_SB(); \
        MLA_GB(o1 = __builtin_amdgcn_mfma_f32_32x32x16_bf16(__builtin_bit_cast(bf16x8, pw[2]), MLA_VF(vl1a, vh1a), o1, 0, 0, 0), N1, 4); vl1b = vtr(Vb_ + VHS + 3072); vh1b = vtr(Vb_ + VHS + 3072 + 512); MLA_SB(); \
        MLA_GB(o0 = __builtin_amdgcn_mfma_f32_32x32x16_bf16(__builtin_bit_cast(bf16x8, pw[3]), MLA_VF(vl0b, vh0b), o0, 0, 0, 0), N1, 8); MLA_SB(); \
        MLA_GB(o1 = __builtin_amdgcn_mfma_f32_32x32x16_bf16(__builtin_bit_cast(bf16x8, pw[3]), MLA_VF(vl1b, vh1b), o1, 0, 0, 0), N1, 12); MLA_SB(); \
        MLA_RESC(); } while (0)
#define MLA_TAIL(C0, C1, t_) do { float ls = 0.f; _Pragma("unroll") for (int r = 0; r < 16; ++r) ls += C0[r] + C1[r]; lrun += ls; ATT_PACK(C0, C1); ATT_PV((t_) & 3); } while (0)
#define MLA_STEP(C0, C1, N0, N1, t_) do { \
          \
        int lane_ = lane; asm volatile("" : "+v"(lane_)); const int r32 = lane_ & 31, hi = lane_ >> 5, qrow = qlo + r32; \
        const int vrd = ((lane_ >> 4) & 1) * 32 + (lane_ & 3) * 8 + (4 * hi + ((lane_ & 15) >> 2)) * 64; ALAS float* wsf = (ALAS float*)(lds + L_WSF) + wid * 64; \
        if ((t_) + 3 < ntile) { ATT_ISSUE((t_) + 3, (t_) + 3); issued = (t_) + 3; } \
        if ((t_) < tmax) MLA_FULL(C0, C1, N0, N1, t_); else if ((t_) == tmax) MLA_TAIL(C0, C1, t_); \
        ATT_WAIT_BAR(issued - ((t_) + 2)); } while (0)
    if (wid >= 4) __builtin_amdgcn_s_setprio(1);
    bool resc = false;
    ATT_QK(p0, p1, 0);
    MLA_DECIDE(p0, p1, 0);
#pragma unroll
    for (int r = 0; r < 16; ++r) { p0[r] = MLA_EX(p0[r]); p1[r] = MLA_EX(p1[r]); }
    asm volatile("s_waitcnt lgkmcnt(0)\n\ts_barrier" ::: "memory");
    for (int it = 0; it < ntile; it += 2) {
        MLA_STEP(p0, p1, n0, n1, it);
        if (it + 1 >= ntile) break;
        MLA_STEP(n0, n1, p0, p1, it + 1);
    }
    __builtin_amdgcn_s_setprio(0);
#undef MLA_SB
#undef MLA_EX
#undef MLA_DECIDE
#undef MLA_RESC
#undef MLA_PV_
#undef MLA_GA
#undef MLA_VF
#undef MLA_GB
#undef MLA_FULL
#undef MLA_TAIL
#undef MLA_STEP
    } else if constexpr (MODE == 1) {
    f32x16 p0, p1; u32x4 pw[4];
    __syncthreads();
    {
        const unsigned lds0_ = (unsigned)(uintptr_t)lds;
        for (int i = 0; i < ntile; ++i) { const int T_ = tfirst + i;
            glds16(ksrc0 + (size_t)T_ * KTS, (unsigned)__builtin_amdgcn_readfirstlane(lds0_ + S1_K + i * S1_KS + wid * KCS));
            glds16(vsrc + (size_t)T_ * VTS, (unsigned)__builtin_amdgcn_readfirstlane(lds0_ + S1_V + i * VSLOT + (wid >> 2) * VHS + (wid & 3) * 1024));
            if (wid == 0) glds4(P.pos + rb + (size_t)T_ * 64 + lane, (unsigned)__builtin_amdgcn_readfirstlane(lds0_ + S1_P + i * 256)); }
        ALAS float* lut = (ALAS float*)(lds + S1_LUT);
        if (tid < 129) { int bk = tid; if (tid >= 16) { bk = 16 + (int)((__builtin_amdgcn_logf((float)tid) - 4.0f) * (16.0f / 3.0f)); bk = bk < 31 ? bk : 31; } lut[tid] = P.relb[bk * 6 + h] * LOG2E; }
        asm volatile("s_waitcnt vmcnt(0) lgkmcnt(0)\n\ts_barrier" ::: "memory");
        const ALAS int* posk = (const ALAS int*)(lds + S1_P);
        const int lo_ = qlo - 127 > 0 ? qlo - 127 : 0; const int i_lo = (lo_ >> 6) - tfirst, i_hi = (qhi >> 6) - tfirst;
        for (int i = i_lo; i <= i_hi; ++i) {
            const int j0 = (tfirst + i) * 64;
            {
                int kofs_ = S1_K + i * S1_KS + hi * KCS + r32 * 16; asm volatile("" : "+v"(kofs_)); const ALAS unsigned char* Kb_ = lds + kofs_;
#pragma unroll
                for (int d0 = 0; d0 < ND0; ++d0) { const bf16x8 a0_ = *(const ALAS bf16x8*)(Kb_ + 2 * d0 * KCS), a1_ = *(const ALAS bf16x8*)(Kb_ + 2 * d0 * KCS + 512);
                    if (d0 == 0) { p0 = __builtin_amdgcn_mfma_f32_32x32x16_bf16(a0_, qf[0], negm, 0, 0, 0); p1 = __builtin_amdgcn_mfma_f32_32x32x16_bf16(a1_, qf[0], negm, 0, 0, 0); }
                    else { p0 = __builtin_amdgcn_mfma_f32_32x32x16_bf16(a0_, qf[d0], p0, 0, 0, 0); p1 = __builtin_amdgcn_mfma_f32_32x32x16_bf16(a1_, qf[d0], p1, 0, 0, 0); } }
            }
#pragma unroll
            for (int g = 0; g < 4; ++g) {
                const i32x4 pa = *(const ALAS i32x4*)(posk + i * 64 + 8 * g + 4 * hi), pb = *(const ALAS i32x4*)(posk + i * 64 + 32 + 8 * g + 4 * hi);
#pragma unroll
                for (int q = 0; q < 4; ++q) { int na = posq - pa[q]; na = na > 0 ? na : 0; na = na < 128 ? na : 128; int nb = posq - pb[q]; nb = nb > 0 ? nb : 0; nb = nb < 128 ? nb : 128;
                    p0[4 * g + q] += lut[na]; p1[4 * g + q] += lut[nb]; }
            }
#pragma unroll
            for (int r = 0; r < 16; ++r) { const int key = j0 + crow(r, hi); const bool ok0 = key <= qrow && key > qrow - 128, ok1 = key + 32 <= qrow && key + 32 > qrow - 128; if (!ok0) p0[r] = -INFINITY; if (!ok1) p1[r] = -INFINITY; }
            float ma = ATT_MAX3(p0[0], p0[1], p1[0]), mb = ATT_MAX3(p0[2], p0[3], p1[1]); ma = ATT_MAX3(ma, p1[2], p1[3]);
#pragma unroll
            for (int r = 4; r < 16; r += 4) { ma = ATT_MAX3(ma, p0[r], p0[r + 1]); mb = ATT_MAX3(mb, p0[r + 2], p0[r + 3]); ma = ATT_MAX3(ma, p1[r], p1[r + 1]); mb = ATT_MAX3(mb, p1[r + 2], p1[r + 3]); }
            const float mt = swap_max(fmaxf(ma, mb));
            if (__any(mt > THR)) {
                const float d = fmaxf(mt, 0.f);
#pragma unroll
                for (int r = 0; r < 16; ++r) { p0[r] -= d; p1[r] -= d; }
                const float alpha = __builtin_amdgcn_exp2f(-d); mrun += d; lrun *= alpha;
#pragma unroll
                for (int r = 0; r < 16; ++r) negm[r] = -mrun;
                if (hi == 0) wsf[r32] = alpha;
#pragma unroll
                for (int g = 0; g < 4; ++g) { const f32x4 al = *(const ALAS f32x4*)(wsf + 8 * g + 4 * hi);
#pragma unroll
                    for (int q = 0; q < 4; ++q) { o0[4 * g + q] *= al[q]; o1[4 * g + q] *= al[q]; } }
            }
            float ls = 0.f;
#pragma unroll
            for (int r = 0; r < 16; ++r) { p0[r] = __builtin_amdgcn_exp2f(p0[r]); p1[r] = __builtin_amdgcn_exp2f(p1[r]); ls += p0[r] + p1[r]; }
            lrun += ls;
            ATT_PACK(p0, p1);
            {
                int vofs_ = S1_V + i * VSLOT + vrd; asm volatile("" : "+v"(vofs_)); const ALAS unsigned char* Vb_ = lds + vofs_;
#pragma unroll
                for (int s_ = 0; s_ < 4; ++s_) { const bf16x8 pa_ = __builtin_bit_cast(bf16x8, pw[s_]);
                    const s16x4 l0_ = vtr(Vb_ + s_ * 1024), h0_ = vtr(Vb_ + s_ * 1024 + 512), l1_ = vtr(Vb_ + VHS + s_ * 1024), h1_ = vtr(Vb_ + VHS + s_ * 1024 + 512);
                    const bf16x8 v0_ = {l0_[0], l0_[1], l0_[2], l0_[3], h0_[0], h0_[1], h0_[2], h0_[3]}, v1_ = {l1_[0], l1_[1], l1_[2], l1_[3], h1_[0], h1_[1], h1_[2], h1_[3]};
                    o0 = __builtin_amdgcn_mfma_f32_32x32x16_bf16(pa_, v0_, o0, 0, 0, 0); o1 = __builtin_amdgcn_mfma_f32_32x32x16_bf16(pa_, v1_, o1, 0, 0, 0); }
            }
        }
        asm volatile("s_waitcnt lgkmcnt(0)\n\ts_barrier" ::: "memory");
    }
    } else {
    bool go_on = true;
    {
        u32x4 pw[4]; f32x16 p0, p1;
        const int nwin = ntile < 7 ? ntile : 7;
        __syncthreads();
        const unsigned lds0_ = (unsigned)(uintptr_t)lds;
        for (int i = 0; i < nwin; ++i) { const int T_ = tfirst - i;
            glds16(ksrc0 + (size_t)T_ * KTS, (unsigned)__builtin_amdgcn_readfirstlane(lds0_ + S1_K + i * S1_KS + wid * KCS));
            glds16(vsrc + (size_t)T_ * VTS, (unsigned)__builtin_amdgcn_readfirstlane(lds0_ + S1_V + i * VSLOT + (wid >> 2) * VHS + (wid & 3) * 1024)); }
        asm volatile("s_waitcnt vmcnt(0) lgkmcnt(0)\n\ts_barrier" ::: "memory");
        for (int i = 0; i < nwin; ++i) {
            const int j0 = (tfirst - i) * 64;
            if (!(walive && j0 < qhi)) { if (!walive) break; continue; }
            {
                int kofs_ = S1_K + i * S1_KS + hi * KCS + r32 * 16; asm volatile("" : "+v"(kofs_)); const ALAS unsigned char* Kb_ = lds + kofs_;
#pragma unroll
                for (int d0 = 0; d0 < ND0; ++d0) { const bf16x8 a0_ = *(const ALAS bf16x8*)(Kb_ + 2 * d0 * KCS), a1_ = *(const ALAS bf16x8*)(Kb_ + 2 * d0 * KCS + 512);
                    if (d0 == 0) { p0 = __builtin_amdgcn_mfma_f32_32x32x16_bf16(a0_, qf[0], negm, 0, 0, 0); p1 = __builtin_amdgcn_mfma_f32_32x32x16_bf16(a1_, qf[0], negm, 0, 0, 0); }
                    else { p0 = __builtin_amdgcn_mfma_f32_32x32x16_bf16(a0_, qf[d0], p0, 0, 0, 0); p1 = __builtin_amdgcn_mfma_f32_32x32x16_bf16(a1_, qf[d0], p1, 0, 0, 0); } }
            }
            ATT_SM_B(p0, p1, j0);
            {
                int vofs_ = S1_V + i * VSLOT + vrd; asm volatile("" : "+v"(vofs_)); const ALAS unsigned char* Vb_ = lds + vofs_;
#pragma unroll
                for (int s_ = 0; s_ < 4; ++s_) { const bf16x8 pa_ = __builtin_bit_cast(bf16x8, pw[s_]);
                    const s16x4 l0_ = vtr(Vb_ + s_ * 1024), h0_ = vtr(Vb_ + s_ * 1024 + 512), l1_ = vtr(Vb_ + VHS + s_ * 1024), h1_ = vtr(Vb_ + VHS + s_ * 1024 + 512);
                    const bf16x8 v0_ = {l0_[0], l0_[1], l0_[2], l0_[3], h0_[0], h0_[1], h0_[2], h0_[3]}, v1_ = {l1_[0], l1_[1], l1_[2], l1_[3], h1_[0], h1_[1], h1_[2], h1_[3]};
                    o0 = __builtin_amdgcn_mfma_f32_32x32x16_bf16(pa_, v0_, o0, 0, 0, 0); o1 = __builtin_amdgcn_mfma_f32_32x32x16_bf16(pa_, v1_, o1, 0, 0, 0); }
            }
        }
        ALAS int* fl = (ALAS int*)(lds + S1_WSF);
        if (lane == 0) fl[wid] = (walive && tfirst - nwin >= 0) ? 1 : 0;
        asm volatile("s_waitcnt lgkmcnt(0)\n\ts_barrier" ::: "memory");
        const i32x4 fa = *(const ALAS i32x4*)fl, fb = *(const ALAS i32x4*)(fl + 4);
        go_on = ((fa[0] | fa[1]) | (fa[2] | fa[3]) | (fb[0] | fb[1]) | (fb[2] | fb[3])) != 0;
        tfirst -= nwin; ntile = tfirst + 1;
    }
    if (go_on) {
    f32x16 p0, p1, n0, n1; u32x4 pw[4];
    __syncthreads();
    int issued = 0;
    ATT_ISSUE(tfirst, 0);
    if (ntile > 1) { ATT_ISSUE(tfirst + tstep, 1); issued = 1; }
    if (ntile > 2) { ATT_ISSUE(tfirst + 2 * tstep, 2); issued = 2; }
    ATT_WAIT_BAR(issued - 1);
    bool wcur = ATT_WORK(tfirst * 64);
    if (wcur) ATT_QK(p0, p1, 0);
    asm volatile("s_waitcnt lgkmcnt(0)\n\ts_barrier" ::: "memory");
    int nt = ntile;
    for (int it = 0; it < nt; ++it) {
        const int t = tfirst + it * tstep, j0 = t * 64, jn = (t + tstep) * 64;
        if (it + 3 < ntile) { ATT_ISSUE(t + 3 * tstep, it + 3); issued = it + 3; }
        if (wcur) ATT_SM_A(p0, p1, j0, it & 3);
        const bool wnext = (it + 1 < nt) && ATT_WORK(jn);
        if (wcur && wnext) { ATT_QK(n0, n1, (it + 1) % 3); ATT_SM_B(p0, p1, j0); }
        else { if (wnext) ATT_QK(n0, n1, (it + 1) % 3); if (wcur) ATT_SM_B(p0, p1, j0); }
        if (wcur) ATT_PV(it & 3);
        p0 = n0; p1 = n1; wcur = wnext;
        if (MODE == 2) { ALAS int* fl = (ALAS int*)(lds + L_FLAG + 16) + (it & 1) * 8; if (lane == 0) fl[wid] = (walive && j0 > 0) ? 1 : 0; }
        ATT_WAIT_BAR(issued - (it + 2));
        if (MODE == 2) { const ALAS int* fl = (const ALAS int*)(lds + L_FLAG + 16) + (it & 1) * 8;
            const i32x4 fa = *(const ALAS i32x4*)fl, fb = *(const ALAS i32x4*)(fl + 4);
            if (((fa[0] | fa[1]) | (fa[2] | fa[3]) | (fb[0] | fb[1]) | (fb[2] | fb[3])) == 0) nt = it + 1; }
    }
    }
    }
    if (MODE == 2) asm volatile("s_waitcnt vmcnt(0)" ::: "memory");
#undef ATT_ISSUE
#undef ATT_WAIT_BAR
#undef ATT_QK
#undef ATT_PV
#undef ATT_PACK
#undef ATT_VLD
#undef ATT_SM_A
#undef ATT_SM_B
#undef ATT_WORK
#undef ATT_MAX3
    if (MODE != 2) {
        const float lt = swap_sum(lrun);
        if (hi == 0) wsf[32 + r32] = 1.0f / lt;
#pragma unroll
        for (int g = 0; g < 4; ++g) { const f32x4 il = *(const ALAS f32x4*)(wsf + 32 + 8 * g + 4 * hi);
#pragma unroll
            for (int i = 0; i < 4; ++i) { o0[4 * g + i] *= il[i]; o1[4 * g + i] *= il[i]; } }
    }
    {
        ALAS bf16_t* stg = (ALAS bf16_t*)ost;
#pragma unroll
        for (int r = 0; r < 16; ++r) { const int orow = crow(r, hi); stg[orow * 64 + r32] = (bf16_t)(cvtpk(o0[r], 0.f) & 0xffffu); stg[orow * 64 + 32 + r32] = (bf16_t)(cvtpk(o1[r], 0.f) & 0xffffu); }
        AGAS bf16_t* Ow = (AGAS bf16_t*)(P.ws + WS_OALL) + (rb + qlo) * 1024 + C::ocol0 + h * 64;
#pragma unroll
        for (int i = 0; i < 4; ++i) {
            const int row = i * 8 + (lane >> 3), ch = lane & 7;
            const u32x4 v = *(const ALAS u32x4*)(stg + row * 64 + ch * 8);
            float ss = 0.f;
#pragma unroll
            for (int k = 0; k < 4; ++k) { const unsigned w = v[k]; const float a = __uint_as_float(w << 16), c = __uint_as_float(w & 0xffff0000u); ss += a * a + c * c; }
            ss += __shfl_xor(ss, 1); ss += __shfl_xor(ss, 2); ss += __shfl_xor(ss, 4);
            *(AGAS u32x4*)(Ow + (size_t)row * 1024 + ch * 8) = v;
            if (ch == 0) ((AGAS float*)(P.ws + WS_SSQO))[(rb + qlo + row) * 16 + C::hidx0 + h] = ss;
        }
    }
#ifdef ATT_PROF
    if (MODE == 0 && blockIdx.x == 0 && wid == ATT_PROF_WAVE && lane == 0 && prof) { const long long tt = PROF_T() - pf_t0;
        atomicAdd(prof + 0, (unsigned long long)tt); atomicAdd(prof + 1, (unsigned long long)pf_qk); atomicAdd(prof + 2, (unsigned long long)pf_sm); atomicAdd(prof + 3, (unsigned long long)pf_pv); atomicAdd(prof + 4, (unsigned long long)pf_wait); atomicAdd(prof + 5, 1ull); }
#endif
}
#undef ALAS
#undef AGAS
}
struct Args { const void* in[23]; float* out; unsigned char* ws; int ph_lo, ph_hi, li, adapt; };

struct Frame { LAS unsigned char* lds; int wave, vcu, G; };
#define FLANE hw_lane()
#define FTID (F.wave * 64 + hw_lane())

__device__ __forceinline__ float wave_sum64(float v) { return pg8::wave_sum_dpp(v); }

__device__ __forceinline__ void tr_item64(const GAS float* W, int ldn, int K, GAS pg8::bf16_t* WT, int kb, int g, int src0, int src1, const GAS float* kgain, LAS unsigned* scr, int lane) {
    const int k0 = 64 * kb; const int col = lane < 32 ? src0 + lane : src1 + (lane - 32); const bool ok = (lane < 32 ? src0 : src1) >= 0;
    const GAS float* wp = W + (size_t)k0 * ldn + (ok ? col : 0);
#pragma unroll
    for (int hf = 0; hf < 4; ++hf) {
        float v[16];
#pragma unroll
        for (int i = 0; i < 16; ++i) v[i] = wp[(size_t)(hf * 16 + i) * ldn];
#pragma unroll
        for (int i = 0; i < 16; ++i) v[i] = ok ? v[i] : 0.f;
        if (kgain) {
#pragma unroll
            for (int i = 0; i < 16; ++i) v[i] *= kgain[k0 + hf * 16 + i]; }
#pragma unroll
        for (int i = 0; i < 8; ++i) scr[(hf * 8 + i) * 65 + lane] = pk2(v[2 * i], v[2 * i + 1]);
    }
    asm volatile("s_waitcnt lgkmcnt(0)" ::: "memory");
    const int c = lane & 7;
#pragma unroll
    for (int j = 0; j < 8; ++j) { const int n = (lane >> 3) + 8 * j; const LAS unsigned* s = scr + (4 * c) * 65 + n;
        v4u o; o.x = s[0]; o.y = s[65]; o.z = s[130]; o.w = s[195];
        *(GAS v4u*)(WT + (size_t)(64 * g + n) * K + k0 + 8 * c) = o; }
    asm volatile("s_waitcnt lgkmcnt(0)" ::: "memory");
}
__device__ __forceinline__ int in_slot_src(int slot, int& cnt) {
    cnt = 64;
    if (slot < 4) return 64 * slot;
    if (slot < 6) return 256 + 64 * (slot - 4);
    if (slot == 6) { cnt = 32; return 384; }
    if (slot == 7) return -1;
    if (slot < 14) return 416 + 64 * (slot - 8);
    if (slot < 16) return 800 + 64 * (slot - 14);
    if (slot < 18) return 928 + 64 * (slot - 16);
    if (slot < 22) return 1056 + 64 * (slot - 18);
    if (slot < 26) return 1312 + 64 * (slot - 22);
    if (slot < 30) return 1568 + 64 * (slot - 26);
    return -1;
}

#define A_X ((const GAS float*)args.in[0])
#define A_C ((const GAS float*)args.in[1])
#define A_POS ((const GAS int*)args.in[2])
#define A_RELB ((const GAS float*)args.in[3])
#define A_NORMG ((const GAS float*)args.in[4])
#define A_WMOD ((const GAS float*)args.in[5])
#define A_BMOD ((const GAS float*)args.in[6])
#define A_WGU1 ((const GAS float*)args.in[7])
#define A_WD1 ((const GAS float*)args.in[8])
#define A_WIN ((const GAS float*)args.in[9])
#define A_QAN ((const GAS float*)args.in[10])
#define A_KVAN ((const GAS float*)args.in[11])
#define A_WUQ ((const GAS float*)args.in[12])
#define A_WUKV ((const GAS float*)args.in[13])
#define A_MLAQN ((const GAS float*)args.in[14])
#define A_MLAKN ((const GAS float*)args.in[15])
#define A_SWAQN ((const GAS float*)args.in[16])
#define A_SWAKN ((const GAS float*)args.in[17])
#define A_SINKS ((const GAS float*)args.in[18])
#define A_OUTN ((const GAS float*)args.in[19])
#define A_WOUT ((const GAS float*)args.in[20])
#define A_WGU2 ((const GAS float*)args.in[21])
#define A_WD2 ((const GAS float*)args.in[22])
#define WSP(off)   (ws_ + (off))
#define MOD ((GAS float*)WSP(WS_MOD))
#define GS ((GAS float*)WSP(WS_GS))
#define BIAS ((GAS float*)WSP(WS_BIAS))
#define SSQX ((GAS float*)WSP(WS_SSQX))
#define SSQO ((GAS float*)WSP(WS_SSQO))
#define CS ((GAS float*)WSP(WS_CS))
#define KPE ((GAS float*)WSP(WS_KPE))
#define SSQ_CQ ((GAS float*)WSP(WS_SSQC))
#define SSQ_CKV ((GAS float*)WSP(WS_SSQC) + (size_t)MROWS * 4)
#define SSQ_KPE ((GAS float*)WSP(WS_SSQC) + (size_t)MROWS * 6)
#define XB ((GAS pg8::bf16_t*)WSP(WS_XB))
#define HID ((GAS pg8::bf16_t*)WSP(WS_HID))
#define CQ ((GAS pg8::bf16_t*)WSP(WS_CQ))
#define CKV ((GAS pg8::bf16_t*)WSP(WS_CKV))
#define KA ((GAS pg8::bf16_t*)WSP(WS_KA))
#define VA ((GAS pg8::bf16_t*)WSP(WS_VA))
#define QS ((GAS pg8::bf16_t*)WSP(WS_QS))
#define KS ((GAS pg8::bf16_t*)WSP(WS_KS))
#define VS ((GAS pg8::bf16_t*)WSP(WS_VS))
#define QC ((GAS pg8::bf16_t*)WSP(WS_QC))
#define KC ((GAS pg8::bf16_t*)WSP(WS_KC))
#define VC ((GAS pg8::bf16_t*)WSP(WS_VC))
#define OALL ((GAS pg8::bf16_t*)WSP(WS_OALL))
#define QRAW ((GAS float*)WSP(WS_QRAW))

__device__ __forceinline__ int in_group_src(int g32) {
    const int tile = g32 >> 3, rr = g32 & 7, bj = rr >> 2, wc = rr & 3; int cnt; const int base = in_slot_src(tile * 4 + wc, cnt);
    return (base >= 0 && 32 * bj < cnt) ? base + 32 * bj : -1;
}
constexpr int CV_GU = 16 * 88, CV_D = 44 * 16, CV_IN = 16 * 32, CV_UQ = 4 * 12, CV_UKV = 2 * 12, CV_OUT = 16 * 16;
constexpr int CV_EARLY = CV_GU + CV_D + CV_IN + CV_UQ + CV_UKV + CV_OUT, CV_L = CV_EARLY + CV_GU + CV_D, CV_ALL = DEPTH * CV_L;
__device__ __forceinline__ void convert_chunk(Frame& F, const Args& args, int base, int limit) {
    GAS unsigned char* ws_ = (GAS unsigned char*)args.ws; asm volatile("" : "+s"(ws_));
    LAS unsigned* scr = (LAS unsigned*)(F.lds + 16384 + F.wave * 8448);
#pragma unroll 1
    for (int q = 0; q < 2; ++q) {
        const int it = base + F.wave * 2 + q; if (it >= limit) break;
        const int l = it / CV_L; int r = it % CV_L;
        GAS unsigned char* wl = ws_ + WS_W + (size_t)l * WL;
        int kind;
        if (r < CV_GU) kind = 0; else if ((r -= CV_GU) < CV_D) kind = 1; else if ((r -= CV_D) < CV_IN) kind = 2; else if ((r -= CV_IN) < CV_UQ) kind = 3;
        else if ((r -= CV_UQ) < CV_UKV) kind = 4; else if ((r -= CV_UKV) < CV_OUT) kind = 5; else if ((r -= CV_OUT) < CV_GU) kind = 6; else { r -= CV_GU; kind = 7; }
        if (kind == 0 || kind == 6) {
            const bool second = kind == 6; const int kb = r / 88, g = r % 88, t = g >> 2, rr = g & 3, src = (rr >> 1) * DFF + 128 * t + 64 * (rr & 1);
            const GAS float* W = (second ? A_WGU2 : A_WGU1) + (size_t)l * DM * 2 * DFF;
            tr_item64(W, 2 * DFF, DM, (GAS pg8::bf16_t*)(wl + (second ? W_GU2 : W_GU1)), kb, g, src, src + 32, nullptr, scr, FLANE);
        } else if (kind == 1 || kind == 7) { const bool second = kind == 7; const int kb = r / 16, g = r % 16;
            tr_item64((second ? A_WD2 : A_WD1) + (size_t)l * DFF * DM, DM, DFF, (GAS pg8::bf16_t*)(wl + (second ? W_D2 : W_D1)), kb, g, 64 * g, 64 * g + 32, nullptr, scr, FLANE);
        } else if (kind == 2) { const int kb = r / 32, g = r % 32;
            tr_item64(A_WIN + (size_t)l * DM * DIN, DIN, DM, (GAS pg8::bf16_t*)(wl + W_IN), kb, g, in_group_src(2 * g), in_group_src(2 * g + 1), nullptr, scr, FLANE);
        } else if (kind == 3) { const int kb = r / 12, g = r % 12;
            tr_item64(A_WUQ + (size_t)l * 256 * 576, 576, 256, (GAS pg8::bf16_t*)(wl + W_UQ), kb, g, g < 9 ? 64 * g : -1, g < 9 ? 64 * g + 32 : -1, A_QAN + l * 256, scr, FLANE);
        } else if (kind == 4) { const int kb = r / 12, g = r % 12, g0 = 2 * g, g1 = 2 * g + 1;
            tr_item64(A_WUKV + (size_t)l * 128 * 768, 768, 128, (GAS pg8::bf16_t*)(wl + W_UKV), kb, g, 256 * (g0 >> 3) + 64 * (g0 & 3) + 32 * ((g0 & 7) >> 2), 256 * (g1 >> 3) + 64 * (g1 & 3) + 32 * ((g1 & 7) >> 2), A_KVAN + l * 128, scr, FLANE);
        } else { const int kb = r / 16, g = r % 16;
            tr_item64(A_WOUT + (size_t)l * DM * DM, DM, DM, (GAS pg8::bf16_t*)(wl + W_OUT), kb, g, 64 * g, 64 * g + 32, A_OUTN + l * DM, scr, FLANE); }
    }
}

__device__ __forceinline__ void phase_pro0(Frame& F, const Args& args, gu32* qhead) {
    GAS unsigned char* ws_ = (GAS unsigned char*)args.ws; asm volatile("" : "+s"(ws_));
    constexpr int NMU = DEPTH * NMOD / 128;
    if ((int)blockIdx.x < NMU || F.G <= NMU) {
        LAS float* cond = (LAS float*)F.lds;
        LAS float* red = (LAS float*)(F.lds + 8192);
        for (int i = FTID; i < 2 * DM; i += 512) { const float cv = A_C[i]; cond[i] = cv / (1.0f + expf(-cv)); }
        __syncthreads();
        for (int u = blockIdx.x; u < NMU; u += F.G) {
            const int l = u / (NMOD / 128), n0 = (u % (NMOD / 128)) * 128, c4 = FLANE & 31, kp = FLANE >> 5;
            const GAS float* w = A_WMOD + (size_t)l * DM * NMOD + n0 + 4 * c4;
            f32x4 a0 = {0.f, 0.f, 0.f, 0.f}, a1 = {0.f, 0.f, 0.f, 0.f};
#pragma unroll 8
            for (int i = 0; i < 64; ++i) { const int kk = F.wave * 128 + 2 * i + kp; const f32x4 wv = *(const GAS f32x4*)(w + (size_t)kk * NMOD); a0 += wv * cond[kk]; a1 += wv * cond[DM + kk]; }
#pragma unroll
            for (int q = 0; q < 4; ++q) { a0[q] = pg8::xsum32(a0[q]); a1[q] = pg8::xsum32(a1[q]); }
            if (kp == 0) { *(LAS f32x4*)(red + (F.wave * 2 + 0) * 128 + 4 * c4) = a0; *(LAS f32x4*)(red + (F.wave * 2 + 1) * 128 + 4 * c4) = a1; }
            __syncthreads();
            if (FTID < 256) { const int bb = FTID >> 7, ln = FTID & 127; float s = 0.f;
#pragma unroll
                for (int wv = 0; wv < 8; ++wv) s += red[(wv * 2 + bb) * 128 + ln];
                MOD[((size_t)l * 2 + bb) * NMOD + n0 + ln] = s + A_BMOD[(size_t)l * NMOD + n0 + ln]; }
            __syncthreads();
        }
    }
    if ((int)blockIdx.x >= NMU || F.G <= NMU) {
        const int nb = F.G <= NMU ? F.G : F.G - NMU, b0 = F.G <= NMU ? (int)blockIdx.x : (int)blockIdx.x - NMU;
        for (int i = b0 * 512 + FTID; i < MROWS * 16; i += nb * 512) {
            const int m = i >> 4, j = i & 15;
            const float freq = powf(10000.0f, -(float)j / 16.0f);
            const float ang = (float)A_POS[m] * freq;
            CS[(size_t)m * 32 + j] = cosf(ang); CS[(size_t)m * 32 + 16 + j] = sinf(ang);
        }
    }
    {
        LAS int* slot = (LAS int*)(F.lds + 12288);
        for (;;) {
            __syncthreads();
            if (FTID == 0) slot[0] = (int)__hip_atomic_fetch_add(qhead, 16u, __ATOMIC_RELAXED, __HIP_MEMORY_SCOPE_AGENT);
            __syncthreads();
            const int base = slot[0];
            if (base >= CV_EARLY) break;
            convert_chunk(F, args, base, CV_EARLY);
        }
    }
}

__device__ __forceinline__ float gs_clamped(float g, float sc) { const float v = g * (1.0f + sc); return fabsf(v) < 1e-20f ? (v < 0.f ? -1e-20f : 1e-20f) : v; }
__device__ __forceinline__ void x_to_xb(Frame& F, const Args& args, const GAS float* xsrc, int l, int i) {
    GAS unsigned char* ws_ = (GAS unsigned char*)args.ws; asm volatile("" : "+s"(ws_));
    const int gw = F.vcu * NWAVES + F.wave, NGW = F.G * NWAVES;
    for (int m = gw; m < MROWS; m += NGW) {
        const int b = m >> 13;
        const GAS f32x4* xr = (const GAS f32x4*)(xsrc + (size_t)m * DM) + FLANE;
        const GAS f32x4* gr = (const GAS f32x4*)(A_NORMG + ((size_t)l * 3 + i) * DM) + FLANE;
        const GAS f32x4* sr = (const GAS f32x4*)(MOD + ((size_t)l * 2 + b) * NMOD + (3 * i + 1) * DM) + FLANE;
        float s = 0.f;
        GAS unsigned long long* o8 = (GAS unsigned long long*)(XB + (size_t)m * DM) + FLANE;
#pragma unroll
        for (int j = 0; j < 4; ++j) { const f32x4 v = xr[64 * j]; s += (v.x * v.x + v.y * v.y) + (v.z * v.z + v.w * v.w);
            const f32x4 g0 = gr[64 * j], s0 = sr[64 * j]; const f32x4 g = {gs_clamped(g0.x, s0.x), gs_clamped(g0.y, s0.y), gs_clamped(g0.z, s0.z), gs_clamped(g0.w, s0.w)}; const f32x4 y = v * g;
            o8[64 * j] = (unsigned long long)pk2(y.x, y.y) | ((unsigned long long)pk2(y.z, y.w) << 32); }
        s = wave_sum64(s);
        if (FLANE < 16) SSQX[(size_t)m * 16 + FLANE] = (FLANE == 0) ? s : 0.f;
    }
}

__device__ __forceinline__ void bias_rows(Frame& F, const Args& args, bool early) {
    GAS unsigned char* ws_ = (GAS unsigned char*)args.ws; asm volatile("" : "+s"(ws_));
    const int gw = F.vcu * NWAVES + F.wave, NGW = F.G * NWAVES;
    constexpr int RL = 5632 + 2048 + 5632, RE = 5632 + 2048;
    const int lo = early ? 0 : RE, hi = early ? RE : DEPTH * RL;
    for (int it = lo + gw; it < hi; it += NGW) {
        const int l = it / RL; int r = it % RL; int which, nrow; size_t woff; size_t boff;
        if (r < 5632) { which = 0; nrow = 5632; woff = W_GU1; boff = 0; } else if (r < 5632 + 2048) { r -= 5632; which = 1; nrow = 2048; woff = W_IN; boff = 2 * 5632; } else { r -= 5632 + 2048; which = 2; nrow = 5632; woff = W_GU2; boff = 2 * (5632 + 2048); }
        const GAS pg8::bf16_t* wr = (const GAS pg8::bf16_t*)(ws_ + WS_W + (size_t)l * WL + woff) + (size_t)r * DM;
        float a0 = 0.f, a1 = 0.f;
#pragma unroll
        for (int j = 0; j < 2; ++j) {
            const v4u wv = *(const GAS v4u*)(wr + j * 512 + FLANE * 8);
            const GAS float* s0 = MOD + ((size_t)l * 2 + 0) * NMOD + (3 * which) * DM + j * 512 + FLANE * 8; const GAS float* s1 = s0 + NMOD;
#pragma unroll
            for (int k = 0; k < 4; ++k) { const unsigned w = wv[k]; const float lo_ = __uint_as_float(w << 16), hi_ = __uint_as_float(w & 0xffff0000u);
                a0 += lo_ * s0[2 * k] + hi_ * s0[2 * k + 1]; a1 += lo_ * s1[2 * k] + hi_ * s1[2 * k + 1]; }
        }
        a0 = wave_sum64(a0); a1 = wave_sum64(a1);
        if (FLANE == 0) { BIAS[(size_t)l * BIAS_L + boff + r] = a0; BIAS[(size_t)l * BIAS_L + boff + nrow + r] = a1; }
    }
}
__device__ __forceinline__ void phase_pro1(Frame& F, const Args& args) {
    GAS unsigned char* ws_ = (GAS unsigned char*)args.ws; asm volatile("" : "+s"(ws_));
    for (int i = blockIdx.x * 512 + FTID; i < DEPTH * 3 * 2 * DM; i += F.G * 512) {
        const int cidx = i & 1023, b = (i >> 10) & 1, li = i >> 11, l = li / 3, ii = li % 3;
        const float gv_ = gs_clamped(A_NORMG[((size_t)l * 3 + ii) * DM + cidx], MOD[((size_t)l * 2 + b) * NMOD + (3 * ii + 1) * DM + cidx]);
        GS[i] = gv_; ((GAS float*)WSP(WS_IGS))[i] = 1.0f / gv_;
    }
    bias_rows(F, args, true);
    x_to_xb(F, args, A_X, 0, 0);
}

constexpr int RR_OFF = LDSCTL_OFF + 2048;
__device__ __forceinline__ void fill_rr(Frame& F, const Args& args, const pg8::StaticOrder& S) {
    GAS unsigned char* ws_ = (GAS unsigned char*)args.ws; asm volatile("" : "+s"(ws_));
    LAS float* rr = (LAS float*)(F.lds + RR_OFF);
    const GAS float* ssqx = (const GAS float*)(ws_ + WS_SSQX);
    for (int idx = FTID; idx < 6 * 256; idx += 512) {
        pg8::Unit u; if (!S.next(idx >> 8, u)) break;
        const int row = u.pm * 256 + (idx & 255);
        rr[idx] = 1.0f / sqrtf(pg8::sum16f(ssqx + (size_t)row * 16) * (1.0f / 1024.0f) + pg8::RMS_EPS);
    }
    __syncthreads();
}

__device__ __forceinline__ int next_unit(Frame& F, gu32* head) {
    LAS int* slot = (LAS int*)(F.lds + att::L_FLAG);
    __syncthreads();
    if (FTID == 0) slot[0] = (int)__hip_atomic_fetch_add(head, 1u, __ATOMIC_RELAXED, __HIP_MEMORY_SCOPE_AGENT);
    __syncthreads();
    return slot[0];
}

#ifndef DUPS
#define DUPS -1
#endif
#ifndef PHM
#define PHM 255
#endif
#ifndef PHM2
#define PHM2 31
#endif
__global__ void __launch_bounds__(NWAVES * 64, 2) fwd_mega(Args args) {
    extern __shared__ __attribute__((aligned(16))) unsigned char lds[];
    const int wave0 = __builtin_amdgcn_readfirstlane((int)threadIdx.x >> 6);
    Frame F0; F0.lds = (LAS unsigned char*)lds; F0.wave = wave0;
    F0.G = gridDim.x; { const int bx = blockIdx.x; F0.vcu = (F0.G % 8 == 0) ? (bx % 8) * (F0.G / 8) + bx / 8 : bx; }
    gu32* ctl = (gu32*)(args.ws + WS_CTL);
    for (int u = wave0 * 64 + hw_lane(); u < (LDS_BYTES - LDSCTL_OFF) / 4; u += NWAVES * 64) ((LAS unsigned*)(F0.lds + LDSCTL_OFF))[u] = 0u;
    __syncthreads();
    const int lo = args.ph_lo, hi = args.ph_hi;
    XcdBarrier bar; bar.bar = (unsigned*)(ctl + CW_BAR) + args.li * XCD_BAR_WORDS; bar.x = 0; bar.st = nullptr; bar.w0 = wave0;
    if (hi - lo > 1 || true) bar = xcd_barrier_post((unsigned*)(ctl + CW_BAR) + args.li * XCD_BAR_WORDS, (volatile LAS unsigned*)(F0.lds + MISC_OFF) + 8, wave0);

    for (int ph = lo; ph < hi; ++ph) {
        Frame F; F.lds = F0.lds; F.G = F0.G; F.vcu = F0.vcu; F.wave = wave0;
        GAS unsigned char* ws_ = (GAS unsigned char*)args.ws; asm volatile("" : "+s"(ws_));
        int nrep = 1;
        if (DUPS >= 0) { const int ty = ph < 2 ? 8 + ph : ((ph - 2) & 7); if (ty == DUPS && !(ty == 5) && !((ty == 1 || ty == 7) && ph != 3)) nrep = 2; }
        for (int rep = 0; rep < nrep; ++rep) {
        if ((PHM & 64) && ph == 0) phase_pro0(F, args, ctl + CW_Q + 64 * 8);
        else if ((PHM & 128) && ph == 1) phase_pro1(F, args);
        else {
            const int l = (ph - 2) >> 3, s = (ph - 2) & 7;
            const GAS unsigned char* wl = ws_ + WS_W + (size_t)l * WL;
            const GAS float* biasl = BIAS + (size_t)l * BIAS_L;
            const GAS float* modl = MOD + (size_t)l * 2 * NMOD;
            if ((PHM & 1) && (s == 0 || s == 6)) {
                pg8::Gemm g{(const pg8::bf16_t*)XB, (const pg8::bf16_t*)(wl + (s == 0 ? W_GU1 : W_GU2)), MROWS, 5632, DM}; pg8::StaticOrder S; S.init(MROWS, 5632, F.G, (int)blockIdx.x);
                fill_rr(F, args, S);
                pg8::EpiUp E{ws_, biasl + (s == 0 ? 0 : 2 * (5632 + 2048)), (const LAS float*)(F.lds + RR_OFF)};
                pg8::gemm_phase<pg8::EpiUp, pg8::StaticOrder, true, true>(F.lds, g, S, E, F.wave);
            } else if ((PHM & 2) && (s == 1 || s == 7)) {
                pg8::Gemm g{(const pg8::bf16_t*)HID, (const pg8::bf16_t*)(wl + (s == 1 ? W_D1 : W_D2)), MROWS, DM, DFF}; pg8::StaticOrder S; S.init(MROWS, DM, F.G, (int)blockIdx.x);
                const bool lastp = (s == 7 && l == DEPTH - 1);
                const GAS float* gsn = lastp ? nullptr : (s == 1 ? GS + ((size_t)(l * 3 + 1) * 2) * DM : GS + ((size_t)((l + 1) * 3 + 0) * 2) * DM);
                const GAS float* igp = (const GAS float*)WSP(WS_IGS) + ((size_t)(l * 3 + (s == 1 ? 0 : 2)) * 2) * DM;
                pg8::EpiResS<false> E{(GAS float*)args.out, ws_, modl + (s == 1 ? 2 : 8) * DM, igp, gsn, 0.5f}; pg8::gemm_phase<pg8::EpiResS<false>, pg8::StaticOrder, false, true>(F.lds, g, S, E, F.wave, (unsigned long long*)(ctl + CW_Q + 64 * 13));
            } else if ((PHM & 4) && s == 2) {
                pg8::Gemm g{(const pg8::bf16_t*)XB, (const pg8::bf16_t*)(wl + W_IN), MROWS, 2048, DM}; pg8::StaticOrder S; S.init(MROWS, 2048, F.G, (int)blockIdx.x);
                fill_rr(F, args, S);
                pg8::EpiIn E{ws_, A_SWAQN + l * 64, A_SWAKN + l * 64, biasl + 2 * 5632, (const LAS float*)(F.lds + RR_OFF)};
                pg8::gemm_phase<pg8::EpiIn, pg8::StaticOrder, true, true>(F.lds, g, S, E, F.wave);
            } else if ((PHM & 8) && s == 3) {
                if (PHM2 & 1) { pg8::Gemm g{(const pg8::bf16_t*)CQ, (const pg8::bf16_t*)(wl + W_UQ), MROWS, 768, 256}; pg8::StaticOrder S; S.init(MROWS, 768, F.G, (int)blockIdx.x);
                  pg8::EpiUq E{ws_}; pg8::gemm_phase<pg8::EpiUq, pg8::StaticOrder, true, true>(F.lds, g, S, E, F.wave); }
                if (PHM2 & 2) { pg8::Gemm g{(const pg8::bf16_t*)CKV, (const pg8::bf16_t*)(wl + W_UKV), MROWS, 768, 128}; pg8::StaticOrder S; S.init(MROWS, 768, F.G, (int)((blockIdx.x + 64) % F.G));
                  pg8::EpiUkv E{ws_, A_MLAKN + l * 96}; pg8::gemm_phase<pg8::EpiUkv, pg8::StaticOrder, true, true>(F.lds, g, S, E, F.wave); }
            } else if ((PHM & 16) && s == 4) {
                att::AttnP PA{ws_, A_MLAQN + l * 96, nullptr, nullptr, nullptr};
                att::AttnP PB{ws_, nullptr, A_POS, A_SINKS + l * 6, A_RELB};
                att::AttnP PC{ws_, nullptr, nullptr, nullptr, nullptr};
                gu32* head = ctl + CW_Q + 64 * (2 * l + 1 + 4 * rep);
                for (;;) { const int u = next_unit(F, head); if (u >= 384 + 256 + 384) break;
                    if ((PHM2 & 16) && u < 384) { const int qb = 31 - u / 12, bh = u % 12;
                        att::attn_unit<96, 0>(F.lds, PA, bh / 6, bh % 6, qb, F.wave, (unsigned long long*)(ctl + CW_Q + 64 * 12)); }

                    else if ((PHM2 & 4) && u >= 384 && u < 640) { const int v = u - 384, qb = 31 - (v >> 3), bh = v & 7; att::attn_unit<64, 2>(F.lds, PC, bh >> 2, bh & 3, qb, F.wave); }
                    else if ((PHM2 & 8) && u >= 640) { const int v = u - 640, qb = v / 12, bh = v % 12; att::attn_unit<64, 1>(F.lds, PB, bh / 6, bh % 6, qb, F.wave); } }
                if (l == 0 && rep == 0) {
                    gu32* chead = ctl + CW_Q + 64 * 9; LAS int* cslot = (LAS int*)(F.lds + 12288);
                    for (;;) { __syncthreads(); if (FTID == 0) cslot[0] = (int)__hip_atomic_fetch_add(chead, 16u, __ATOMIC_RELAXED, __HIP_MEMORY_SCOPE_AGENT); __syncthreads();
                        const int cb = CV_EARLY + cslot[0]; if (cb >= CV_ALL) break; convert_chunk(F, args, cb, CV_ALL); } }
            } else if ((PHM & 32) && s == 5) {
                if (l == 0 && rep == 0) { bias_rows(F, args, false); asm volatile("s_waitcnt vmcnt(0)" ::: "memory"); __syncthreads(); }
                pg8::Gemm g{(const pg8::bf16_t*)OALL, (const pg8::bf16_t*)(wl + W_OUT), MROWS, DM, DM}; pg8::StaticOrder S; S.init(MROWS, DM, F.G, (int)blockIdx.x);
                pg8::EpiResS<true> E{(GAS float*)args.out, ws_, modl + 5 * DM, (const GAS float*)WSP(WS_IGS) + ((size_t)(l * 3 + 1) * 2) * DM, GS + ((size_t)(l * 3 + 2) * 2) * DM, 1.0f}; pg8::gemm_phase<pg8::EpiResS<true>, pg8::StaticOrder, false, true>(F.lds, g, S, E, F.wave);
            }
        }
        if (rep + 1 < nrep) xcd_barrier(bar);
        }
        if (ph + 1 < hi) xcd_barrier(bar);
    }
#ifdef GEMM_PROF
    xcd_barrier(bar);
    if (blockIdx.x == 0 && threadIdx.x == 0) { const unsigned long long* st = (const unsigned long long*)(ctl + CW_Q + 64 * 13); double sh;
        if (GEMM_PROF == 0) sh = (double)st[1] / (double)(st[0] + st[1]);
        else if (GEMM_PROF == 1) sh = (double)st[0] / (double)st[2] / 1.0e6;
        else sh = (double)st[1] / (double)st[2] / 1.0e6;
        args.out[0] += (float)(0.04 + 0.18 * (sh > 1.0 ? 1.0 : sh)); }
#endif
#ifdef ATT_PROF
    xcd_barrier(bar);
    if (blockIdx.x == 0 && threadIdx.x == 0) { const unsigned long long* st = (const unsigned long long*)(ctl + CW_Q + 64 * 12);
        const double tot = (double)st[0]; double sh = 0.0;
        if (ATT_PROF == 0) sh = (double)st[0] / (double)st[5] / 1.0e6;
        else if (ATT_PROF == 5) sh = (double)st[0] / (double)st[6] / 1.0e4;
        else if (ATT_PROF == 6) sh = (double)st[6] / 1.0e3;
        else sh = (double)st[ATT_PROF] / tot;
        args.out[0] += (float)(0.04 + 0.18 * (sh > 1.0 ? 1.0 : sh)); }
#endif
}
static void launch_fwd(hipStream_t stream, Args a, int grid, int lo, int hi, int li, int adapt) {
    a.ph_lo = lo; a.ph_hi = hi; a.li = li; a.adapt = adapt;
    hipLaunchKernelGGL(fwd_mega, dim3(grid), dim3(NWAVES * 64), LDS_BYTES, stream, a);
}
extern "C" void kernel_launch(void* const* d_in, const int* in_sizes, int n_in, void* d_out, int out_size, void* d_ws, size_t ws_size, hipStream_t stream) {
    static int grid = 0;
    if (grid == 0) {
        if (n_in != 23 || out_size != MROWS * DM || ws_size < WS_END) { fprintf(stderr, "kernel_launch: unexpected problem (n_in %d, out %d, ws %zu < %zu)\n", n_in, out_size, ws_size, (size_t)WS_END); grid = -1; return; }
        int dev = 0, cus = 0, per_cu = 0;
        if (hipGetDevice(&dev) != hipSuccess || hipDeviceGetAttribute(&cus, hipDeviceAttributeMultiprocessorCount, dev) != hipSuccess) { grid = -1; return; }
        if (hipFuncSetAttribute((const void*)fwd_mega, hipFuncAttributeMaxDynamicSharedMemorySize, LDS_BYTES) != hipSuccess) { fprintf(stderr, "kernel_launch: hipFuncSetAttribute failed\n"); grid = -1; return; }
        if (hipOccupancyMaxActiveBlocksPerMultiprocessor(&per_cu, (const void*)fwd_mega, NWAVES * 64, LDS_BYTES) != hipSuccess || per_cu < 1) { fprintf(stderr, "kernel_launch: occupancy query says %d blocks per CU\n", per_cu); (void)hipGetLastError(); grid = -1; return; }
        if (cus < 256) { fprintf(stderr, "kernel_launch: built for a 256-CU device (the one-unit-per-workgroup GEMM phases need exactly 256 workgroups), found %d CUs\n", cus); grid = -1; return; }
        grid = 256;
    }
    if (grid < 0) return;
    (void)hipMemsetAsync((char*)d_ws + WS_CTL, 0, CTL_ZERO_BYTES, stream);
    Args a{};
    for (int i = 0; i < 23; ++i) a.in[i] = d_in[i];
    a.out = (float*)d_out; a.ws = (unsigned char*)d_ws;
#ifdef PFX
    launch_fwd(stream, a, grid, 0, PFX, 0, -1);
    (void)hipMemsetAsync((char*)d_ws + WS_CTL, 0, CTL_ZERO_BYTES, stream);
#endif
    launch_fwd(stream, a, grid, 0, NPH, 0, -1);
}
```

```cpp
#include <hip/hip_runtime.h>
#include <cstdio>
#include <cstdint>
#include <cmath>
constexpr int NWAVES = 8;
constexpr int BATCH = 2, SEQ = 8192, DM = 1024, DEPTH = 2, MROWS = BATCH * SEQ;
constexpr int DFF = 2816, DIN = 1824, NMOD = 9 * DM;
constexpr int NPH = 2 + 8 * DEPTH;
constexpr size_t MiB = 1u << 20;
constexpr size_t WS_CTL = 0, CTL_ZERO_BYTES = 256 * 1024;
constexpr size_t WS_MOD = 1 * MiB;
constexpr size_t WS_GS = WS_MOD + 160 * 1024;
constexpr size_t WS_IGS = WS_GS + 64 * 1024;
constexpr size_t WS_BIAS = WS_IGS + 64 * 1024;
constexpr size_t BIAS_L = 2 * (5632 + 2048 + 5632);
constexpr size_t WS_SSQX = 2 * MiB;
constexpr size_t WS_SSQO = 3 * MiB;
constexpr size_t WS_CS = 4 * MiB;
constexpr size_t WS_KPE = 6 * MiB;
constexpr size_t WS_SSQC = 8 * MiB;
constexpr size_t WS_W = 9 * MiB;
constexpr size_t W_GU1 = 0, W_D1 = W_GU1 + (size_t)5632 * 1024 * 2, W_IN = W_D1 + (size_t)1024 * 2816 * 2, W_UQ = W_IN + (size_t)2048 * 1024 * 2, W_UKV = W_UQ + (size_t)768 * 256 * 2,
                 W_OUT = W_UKV + (size_t)768 * 128 * 2, W_GU2 = W_OUT + (size_t)1024 * 1024 * 2, W_D2 = W_GU2 + (size_t)5632 * 1024 * 2, WL = W_D2 + (size_t)1024 * 2816 * 2;
constexpr size_t WS_XB = WS_W + ((2 * WL + MiB - 1) / MiB) * MiB;
constexpr size_t WS_ACT = WS_XB + 32 * MiB;
constexpr size_t WS_HID = WS_ACT;
constexpr size_t WS_CQ = WS_ACT, WS_CKV = WS_CQ + 8 * MiB, WS_QRAW = WS_CKV + 4 * MiB, WS_KA = WS_QRAW + 36 * MiB, WS_VA = WS_KA + 18 * MiB, WS_QS = WS_VA + 12 * MiB, WS_KS = WS_QS + 12 * MiB,
                 WS_VS = WS_KS + 4 * MiB, WS_QC = WS_VS + 4 * MiB, WS_KC = WS_QC + 8 * MiB, WS_VC = WS_KC + 8 * MiB, WS_OALL = WS_VC + 8 * MiB, WS_END = WS_OALL + 32 * MiB;
static_assert(WS_HID + (size_t)MROWS * DFF * 2 <= WS_END, "d_ws map");
constexpr int CW_BAR = 4096;
constexpr int CW_Q = 40960;
static_assert((CW_Q + 64 * 14) * 4 <= (int)CTL_ZERO_BYTES && CW_BAR + 8 * 3456 <= CW_Q, "ctl map");
constexpr int RING_BYTES = 131072, LDSCTL_OFF = RING_BYTES, MISC_OFF = LDSCTL_OFF + 320, LDS_BYTES = 147456;

__device__ __forceinline__ int hw_lane() { int l; asm volatile("v_mbcnt_lo_u32_b32 %0, -1, 0\n\tv_mbcnt_hi_u32_b32 %0, -1, %0" : "=v"(l)); return l; }
namespace pg8 {
#define PG8_LAS __attribute__((address_space(3)))
typedef unsigned short bf16_t;
typedef short bf16x8 __attribute__((ext_vector_type(8)));
typedef float f32x4 __attribute__((ext_vector_type(4)));
typedef unsigned u32x4 __attribute__((ext_vector_type(4)));
constexpr int BM = 256, BK = 64, HALF = 128, HTB = HALF * BK * 2  , STAGE_BYTES = 8 * HTB, NXCD = 8, WGM = 8;

__host__ __device__ __forceinline__ int lds_byte(int r, int c) { const int st = (r >> 4) * 2 + (c >> 5), rr = r & 15, cc = c & 31, ob = rr * 64 + cc * 2; return st * 1024 + (ob ^ (((ob >> 9) & 1) << 5)); }
__host__ __device__ __forceinline__ void stage_rc(int b, int& R, int& C) { const int st = b / 1024, sb = b % 1024, swz = sb ^ (((sb >> 9) & 1) << 5); R = (st >> 1) * 16 + swz / 64; C = (st & 1) * 32 + (swz % 64) / 2; }
__host__ __device__ __forceinline__ int perm32(int rho) { const int n = rho >> 4, i = rho & 15; return 8 * (i >> 2) + 4 * n + (i & 3); }

struct Unit { int pm, pn, ord; };
struct Gemm { const bf16_t* A; const bf16_t* Bt; int M, N, K; };

struct StaticOrder {
    int nM, nN, nwg, G, c;
    __host__ __device__ void init(int M, int N, int G_, int c_) { nM = M / BM; nN = N / BM; nwg = nM * nN; G = G_; c = c_; }
    __host__ __device__ bool next(int i, Unit& u) const {
        const long L = (long)i * G + c; if (L >= nwg) return false;
        int wgid = (int)L; { const int q = nwg / NXCD, r = nwg % NXCD, xcd = wgid % NXCD, off = wgid / NXCD; wgid = (xcd < r ? xcd * (q + 1) : r * (q + 1) + (xcd - r) * q) + off; }
        const int nig = WGM * nN, gid = wgid / nig, fm = gid * WGM, gsz = (nM - fm) < WGM ? (nM - fm) : WGM;
        u.pm = fm + ((wgid % nig) % gsz); u.pn = (wgid % nig) / gsz; u.ord = i; return true;
    }
    __device__ __forceinline__ void a_ready(const Unit&) const {}
    __device__ __forceinline__ void done(const Unit&) const {}
};

__device__ __forceinline__ unsigned cvt_pk_bf16(float lo, float hi) { unsigned r; asm volatile("v_cvt_pk_bf16_f32 %0, %1, %2" : "=v"(r) : "v"(lo), "v"(hi)); return r; }
typedef float f32x2 __attribute__((ext_vector_type(2)));
template <class Epi, class Sched, bool ALIGN_EPI = false, bool SP2 = false>
__device__ __forceinline__ void gemm_phase(PG8_LAS unsigned char* lds, const Gemm g, const Sched& S, const Epi& E, int wave0, unsigned long long* gprof = nullptr) {
#ifdef GEMM_PROF
    const long long gp_t0 = (Epi::AFTER_DRAIN && !Epi::HOOK && blockIdx.x == 0) ? (long long)clock64() : 0ll;
#endif
    int tid_ = wave0 * 64 + hw_lane(); asm volatile("" : "+v"(tid_));
    const int tid = tid_, wid = __builtin_amdgcn_readfirstlane(tid >> 6), lane = tid & 63, wr = wid >> 2, wc = wid & 3, fr = lane & 15, fq = lane >> 4;
    int K_ = g.K; asm volatile("" : "+s"(K_));
    const int K = K_, nt = K / BK;
    unsigned voffA[2], voffB[2];
#pragma unroll
    for (int i = 0; i < 2; ++i) { int R, C; stage_rc(tid * 16 + i * 8192, R, C); const int Rb = Epi::PERM ? ((R & ~31) + perm32(R & 31)) : R;
        voffA[i] = (unsigned)(R * K + C) * 2u; voffB[i] = (unsigned)(Rb * K + C) * 2u; }
    const size_t kstep = (size_t)(BK * 2);
    const size_t hstep = (size_t)HALF * K * 2;
    const size_t tstep = 2 * hstep;
    const unsigned ldsw = (unsigned)wid * 1024u;
    const int aoff = lds_byte(wr * 64 + fr, fq * 8), boff = lds_byte(wc * 32 + fr, fq * 8);
#define PG8_SA(b, h) (((b) * 2 + (h)) * HTB)
#define PG8_SB(b, h) ((4 + (b) * 2 + (h)) * HTB)
#define PG8_STAGE(bufoff, gbase, voff) do { _Pragma("unroll") for (int _i = 0; _i < 2; ++_i) \
        __builtin_amdgcn_global_load_lds((const unsigned*)((const char*)(gbase) + (voff)[_i]), (PG8_LAS unsigned*)(lds + (bufoff) + ldsw + _i * 8192), 16, 0, 0); } while (0)
#define PG8_LDA(dst, b, h) do { _Pragma("unroll") for (int m = 0; m < 4; ++m) _Pragma("unroll") for (int k = 0; k < 2; ++k) dst[m][k] = *(const PG8_LAS bf16x8*)(lds + PG8_SA(b, h) + aoff + m * 2048 + k * 1024); } while (0)
#define PG8_LDB(dst, b, h) do { _Pragma("unroll") for (int n = 0; n < 2; ++n) _Pragma("unroll") for (int k = 0; k < 2; ++k) dst[n][k] = *(const PG8_LAS bf16x8*)(lds + PG8_SB(b, h) + boff + n * 2048 + k * 1024); } while (0)
#define PG8_MMA(ai, bj, At, Bt) do { __builtin_amdgcn_s_setprio(1); _Pragma("unroll") for (int m = 0; m < 4; ++m) _Pragma("unroll") for (int n = 0; n < 2; ++n) _Pragma("unroll") for (int k = 0; k < 2; ++k) \
        acc[ai][bj][m][n] = __builtin_amdgcn_mfma_f32_16x16x32_bf16(Bt[n][k], At[m][k], acc[ai][bj][m][n], 0, 0, 0); __builtin_amdgcn_s_setprio(0); } while (0)
#define PG8_WAIT_V(n) asm volatile("s_waitcnt vmcnt(" #n ")" ::: "memory")
#define PG8_WAIT_L(n) asm volatile("s_waitcnt lgkmcnt(" #n ")" ::: "memory")
#define PG8_BAR __builtin_amdgcn_s_barrier()
#define PG8_SCHED __builtin_amdgcn_sched_barrier(0)
    Unit cur, nxt; int ui = 0;
    if (!S.next(0, cur)) return;
    f32x4 acc[2][2][4][2];
#pragma unroll
    for (int a = 0; a < 2; ++a)
#pragma unroll
        for (int b = 0; b < 2; ++b)
#pragma unroll
            for (int m = 0; m < 4; ++m)
#pragma unroll
                for (int n = 0; n < 2; ++n) acc[a][b][m][n] = (f32x4){0.f, 0.f, 0.f, 0.f};
    bf16x8 At[4][2], B0[2][2], B1[2][2];
    const char* cA = (const char*)g.A + (size_t)cur.pm * tstep; const char* cB = (const char*)g.Bt + (size_t)cur.pn * tstep;
    S.a_ready(cur);
    if constexpr (SP2) {
        PG8_STAGE(PG8_SB(0, 0), cB, voffB); PG8_STAGE(PG8_SB(0, 1), cB + hstep, voffB); PG8_STAGE(PG8_SA(0, 0), cA, voffA); PG8_STAGE(PG8_SA(0, 1), cA + hstep, voffA);
        if (wr == 1) PG8_BAR;
        PG8_WAIT_V(2); PG8_BAR;
        PG8_STAGE(PG8_SB(1, 0), cB + kstep, voffB); PG8_STAGE(PG8_SA(1, 0), cA + kstep, voffA); PG8_STAGE(PG8_SB(1, 1), cB + hstep + kstep, voffB);
        PG8_WAIT_V(6); PG8_BAR;
    } else {
        PG8_STAGE(PG8_SB(0, 0), cB, voffB); PG8_STAGE(PG8_SA(0, 0), cA, voffA); PG8_STAGE(PG8_SB(0, 1), cB + hstep, voffB); PG8_STAGE(PG8_SA(0, 1), cA + hstep, voffA);
        if (wr == 1) PG8_BAR;
        PG8_WAIT_V(4); PG8_BAR;
        PG8_STAGE(PG8_SB(1, 0), cB + kstep, voffB); PG8_STAGE(PG8_SA(1, 0), cA + kstep, voffA); PG8_STAGE(PG8_SB(1, 1), cB + hstep + kstep, voffB);
        PG8_WAIT_V(6); PG8_BAR;
    }
    for (;;) {
        const bool has_next = S.next(ui + 1, nxt);
        const char* nA = has_next ? (const char*)g.A + (size_t)nxt.pm * tstep : cA; const char* nB = has_next ? (const char*)g.Bt + (size_t)nxt.pn * tstep : cB;
#pragma nounroll
        for (int t = 0; t < nt; t += 2) {
            if constexpr (Epi::HOOK) E.hook(acc, cur, t, wr, wc, fr, fq);
            const bool last = (t == nt - 2);
            const char* a1 = cA + (size_t)(t + 1) * kstep;
            const char* a2 = last ? nA : cA + (size_t)(t + 2) * kstep; const char* b2 = last ? nB : cB + (size_t)(t + 2) * kstep;
            const char* a3 = a2 + kstep; const char* b3 = b2 + kstep;
            if (last && has_next) S.a_ready(nxt);
            if constexpr (SP2) {
            PG8_LDB(B0, 0, 0); PG8_LDB(B1, 0, 1); PG8_SCHED; PG8_LDA(At, 0, 0); PG8_STAGE(PG8_SA(1, 1), a1 + hstep, voffA);
            PG8_WAIT_V(8); PG8_WAIT_L(0); PG8_BAR; PG8_MMA(0, 0, At, B0); PG8_MMA(0, 1, At, B1); PG8_BAR; PG8_SCHED;
            PG8_LDA(At, 0, 1); PG8_STAGE(PG8_SB(0, 0), b2, voffB); PG8_STAGE(PG8_SB(0, 1), b2 + hstep, voffB); PG8_STAGE(PG8_SA(0, 0), a2, voffA);
            PG8_WAIT_V(8); PG8_WAIT_L(0); PG8_BAR; PG8_MMA(1, 0, At, B0); PG8_MMA(1, 1, At, B1); PG8_BAR; PG8_SCHED;
            PG8_LDB(B0, 1, 0); PG8_LDB(B1, 1, 1); PG8_SCHED; PG8_LDA(At, 1, 0); PG8_STAGE(PG8_SA(0, 1), a2 + hstep, voffA);
            PG8_WAIT_V(8); PG8_WAIT_L(0); PG8_BAR; PG8_MMA(0, 0, At, B0); PG8_MMA(0, 1, At, B1); PG8_BAR; PG8_SCHED;
            PG8_LDA(At, 1, 1); PG8_STAGE(PG8_SB(1, 0), b3, voffB); PG8_STAGE(PG8_SB(1, 1), b3 + hstep, voffB); PG8_STAGE(PG8_SA(1, 0), a3, voffA);
            PG8_WAIT_V(8); PG8_WAIT_L(0); PG8_BAR; PG8_MMA(1, 0, At, B0); PG8_MMA(1, 1, At, B1); PG8_BAR; PG8_SCHED;
            } else {
            PG8_LDB(B0, 0, 0); PG8_SCHED; PG8_LDA(At, 0, 0); PG8_STAGE(PG8_SA(1, 1), a1 + hstep, voffA);
            PG8_WAIT_L(8); PG8_BAR; PG8_WAIT_L(0); PG8_MMA(0, 0, At, B0); PG8_BAR; PG8_SCHED;
            PG8_LDB(B1, 0, 1); PG8_STAGE(PG8_SB(0, 0), b2, voffB);
            PG8_BAR; PG8_WAIT_L(0); PG8_MMA(0, 1, At, B1); PG8_BAR;
            PG8_LDA(At, 0, 1); PG8_STAGE(PG8_SA(0, 0), a2, voffA);
            PG8_BAR; PG8_WAIT_L(0); PG8_MMA(1, 0, At, B0); PG8_BAR; PG8_SCHED;
            PG8_STAGE(PG8_SB(0, 1), b2 + hstep, voffB);
            PG8_WAIT_V(6); PG8_BAR; PG8_MMA(1, 1, At, B1); PG8_BAR;
            PG8_LDB(B0, 1, 0); PG8_SCHED; PG8_LDA(At, 1, 0); PG8_STAGE(PG8_SA(0, 1), a2 + hstep, voffA);
            PG8_WAIT_L(8); PG8_BAR; PG8_WAIT_L(0); PG8_MMA(0, 0, At, B0); PG8_BAR; PG8_SCHED;
            PG8_LDB(B1, 1, 1); PG8_STAGE(PG8_SB(1, 0), b3, voffB);
            PG8_BAR; PG8_WAIT_L(0); PG8_MMA(0, 1, At, B1); PG8_BAR;
            PG8_LDA(At, 1, 1); PG8_STAGE(PG8_SA(1, 0), a3, voffA);
            PG8_BAR; PG8_WAIT_L(0); PG8_MMA(1, 0, At, B0); PG8_BAR; PG8_SCHED;
            PG8_STAGE(PG8_SB(1, 1), b3 + hstep, voffB);
            PG8_WAIT_V(6); PG8_BAR; PG8_MMA(1, 1, At, B1); PG8_BAR;
            }
        }
        if constexpr (ALIGN_EPI) { if (wr == 0) PG8_BAR; }
        if constexpr (!Epi::AFTER_DRAIN) {
            Unit ce = cur; asm volatile("" : "+s"(ce.pm), "+s"(ce.pn), "+s"(ce.ord)); int fre = fr, fqe = fq; asm volatile("" : "+v"(fre), "+v"(fqe));
            E(acc, ce, wr, wc, fre, fqe); S.done(cur); }
        if (!has_next) break;
#pragma unroll
        for (int a = 0; a < 2; ++a)
#pragma unroll
            for (int b = 0; b < 2; ++b)
#pragma unroll
                for (int m = 0; m < 4; ++m)
#pragma unroll
                    for (int n = 0; n < 2; ++n) acc[a][b][m][n] = (f32x4){0.f, 0.f, 0.f, 0.f};
        cur = nxt; cA = nA; cB = nB; ++ui;
        if constexpr (ALIGN_EPI) { if (wr == 1) PG8_BAR; }
    }
    PG8_WAIT_V(0);
    if constexpr (!ALIGN_EPI) { if (wr == 0) PG8_BAR; }
    PG8_BAR;
#ifdef GEMM_PROF
    const long long gp_t1 = (Epi::AFTER_DRAIN && !Epi::HOOK && blockIdx.x == 0) ? (long long)clock64() : 0ll;
#endif
    if constexpr (Epi::AFTER_DRAIN) { E.fused(acc, cur, wr, wc, fr, fq, lds, wid, lane); S.done(cur); }
#ifdef GEMM_PROF
    if (Epi::AFTER_DRAIN && !Epi::HOOK && blockIdx.x == 0 && tid == 0 && gprof) { const long long gp_t2 = clock64(); atomicAdd(gprof + 0, (unsigned long long)(gp_t1 - gp_t0)); atomicAdd(gprof + 1, (unsigned long long)(gp_t2 - gp_t1)); atomicAdd(gprof + 2, 1ull); }
#endif
#undef PG8_SA
#undef PG8_SB
#undef PG8_STAGE
#undef PG8_LDA
#undef PG8_LDB
#undef PG8_MMA
#undef PG8_WAIT_V
#undef PG8_WAIT_L
#undef PG8_BAR
#undef PG8_SCHED
}
constexpr float RMS_EPS = 1e-6f;
constexpr int MROWS_ = 16384;
constexpr float LOG2E = 1.4426950408889634f;
typedef unsigned u32x2 __attribute__((ext_vector_type(2)));
#define PG8_FENCE() asm volatile("" ::: "memory")
#define PG8_G __attribute__((address_space(1)))
__device__ __forceinline__ float sum16f(const PG8_G float* p) {
    const f32x4 a = *(const PG8_G f32x4*)p, b = *(const PG8_G f32x4*)(p + 4), c = *(const PG8_G f32x4*)(p + 8), d = *(const PG8_G f32x4*)(p + 12);
    return ((a[0] + a[1]) + (a[2] + a[3])) + ((b[0] + b[1]) + (b[2] + b[3])) + ((c[0] + c[1]) + (c[2] + c[3])) + ((d[0] + d[1]) + (d[2] + d[3]));
}
__device__ __forceinline__ float xsum16(float x) { auto r = __builtin_amdgcn_permlane16_swap(__float_as_uint(x), __float_as_uint(x), false, false); return __uint_as_float(r[0]) + __uint_as_float(r[1]); }
__device__ __forceinline__ float xsum32(float x) { auto r = __builtin_amdgcn_permlane32_swap(__float_as_uint(x), __float_as_uint(x), false, false); return __uint_as_float(r[0]) + __uint_as_float(r[1]); }
__device__ __forceinline__ float wave_sum_dpp(float x) {
    x += __builtin_bit_cast(float, __builtin_amdgcn_update_dpp(0, __builtin_bit_cast(int, x), 0xB1, 0xf, 0xf, true));
    x += __builtin_bit_cast(float, __builtin_amdgcn_update_dpp(0, __builtin_bit_cast(int, x), 0x4E, 0xf, 0xf, true));
    x += __builtin_bit_cast(float, __builtin_amdgcn_update_dpp(0, __builtin_bit_cast(int, x), 0x141, 0xf, 0xf, true));
    x += __builtin_bit_cast(float, __builtin_amdgcn_update_dpp(0, __builtin_bit_cast(int, x), 0x140, 0xf, 0xf, true));
    return xsum32(xsum16(x));
}
__device__ __forceinline__ float fast_rcp(float x) { return __builtin_amdgcn_rcpf(x); }
__device__ __forceinline__ float silu_fast(float g) { return g * fast_rcp(1.0f + __builtin_amdgcn_exp2f(-g * LOG2E)); }
__device__ __forceinline__ float sq4(const f32x4 v) { return (v[0] * v[0] + v[1] * v[1]) + (v[2] * v[2] + v[3] * v[3]); }

struct EpiUp {
    static constexpr bool PERM = true, AFTER_DRAIN = false, HOOK = false;
    PG8_G unsigned char* ws; const PG8_G float* bias; const PG8_LAS float* rr;
    __device__ __forceinline__ void hook(f32x4 (&)[2][2][4][2], const Unit&, int, int, int, int, int) const {}
    __device__ __forceinline__ void operator()(const f32x4 (&acc)[2][2][4][2], const Unit& u, int wr, int wc, int fr, int fq) const {
        PG8_G bf16_t* HID = (PG8_G bf16_t*)(ws + WS_HID); const PG8_LAS float* rt = rr + u.ord * BM + wr * 64 + fr;
        const int b = u.pm >> 5;
        const PG8_G float* bb = bias + b * 5632 + u.pn * BM + wc * 32 + 8 * fq;
        f32x4 bg[2], bu[2];
#pragma unroll
        for (int n = 0; n < 2; ++n) { bg[n] = *(const PG8_G f32x4*)(bb + 4 * n); bu[n] = *(const PG8_G f32x4*)(bb + HALF + 4 * n); }
#pragma unroll
        for (int ai = 0; ai < 2; ++ai)
#pragma unroll
            for (int m = 0; m < 4; ++m) {
                const int row = u.pm * BM + ai * HALF + wr * 64 + m * 16 + fr;
                const float r = rt[ai * HALF + m * 16];
                float hv[8];
#pragma unroll
                for (int n = 0; n < 2; ++n)
#pragma unroll
                    for (int i = 0; i < 4; ++i) { const float g = acc[ai][0][m][n][i] * r + bg[n][i], uu = acc[ai][1][m][n][i] * r + bu[n][i]; hv[4 * n + i] = silu_fast(g) * uu; }
                u32x4 w; w.x = cvt_pk_bf16(hv[0], hv[1]); w.y = cvt_pk_bf16(hv[2], hv[3]); w.z = cvt_pk_bf16(hv[4], hv[5]); w.w = cvt_pk_bf16(hv[6], hv[7]);
                *(PG8_G u32x4*)(HID + (size_t)row * 2816 + u.pn * HALF + wc * 32 + 8 * fq) = w;
            }
    }
};

template <bool HOOKED> struct EpiResS {
    static constexpr bool PERM = false, AFTER_DRAIN = true, HOOK = HOOKED;
    PG8_G float* fout; PG8_G unsigned char* ws; const PG8_G float* gate; const PG8_G float* igs; const PG8_G float* gs; float coef; const PG8_LAS float* gt;
    __device__ __forceinline__ void group_r(int row, float& rA, float& rB, float& rC) const {
        const PG8_G float* p = (const PG8_G float*)(ws + WS_SSQO) + (size_t)row * 16;
        const f32x4 a = *(const PG8_G f32x4*)p, b = *(const PG8_G f32x4*)(p + 4), c = *(const PG8_G f32x4*)(p + 8), d = *(const PG8_G f32x4*)(p + 12);
        const float sA = ((a[0] + a[1]) + (a[2] + a[3])) + (b[0] + b[1]), sB = ((b[2] + b[3]) + (c[0] + c[1])) + (c[2] + c[3]), sC = (d[0] + d[1]) + (d[2] + d[3]);
        rA = 1.0f / sqrtf(sA * (1.0f / 384.0f) + RMS_EPS); rB = 1.0f / sqrtf(sB * (1.0f / 384.0f) + RMS_EPS); rC = 1.0f / sqrtf(sC * (1.0f / 256.0f) + RMS_EPS);
    }
    __device__ __forceinline__ void hook(f32x4 (&acc)[2][2][4][2], const Unit& u, int t, int wr, int wc, int fr, int fq) const {
        if (t != 6 && t != 12) return;
        asm volatile("" : "+v"(fr));
#pragma unroll
        for (int ai = 0; ai < 2; ++ai)
#pragma unroll
            for (int m = 0; m < 4; ++m) {
                const float f = gt[(t == 6 ? 0 : BM) + ai * HALF + wr * 64 + m * 16 + fr];
#pragma unroll
                for (int bj = 0; bj < 2; ++bj)
#pragma unroll
                    for (int n = 0; n < 2; ++n) acc[ai][bj][m][n] = acc[ai][bj][m][n] * f;
            }
    }
    __device__ __forceinline__ void fused(f32x4 (&acc)[2][2][4][2], const Unit& u, int wr, int wc, int fr, int fq, PG8_LAS unsigned char* lds, int wid, int lane) const {
        PG8_G bf16_t* xb = (PG8_G bf16_t*)(ws + WS_XB); PG8_G float* ssq_out = (PG8_G float*)(ws + WS_SSQX); constexpr int gate_bstride = 9 * 1024;
        const int b = u.pm >> 5, colg = u.pn * BM + 4 * lane;
        const f32x4 gv = *(const PG8_G f32x4*)(gate + (size_t)b * gate_bstride + colg) * coef;
        const f32x4 gsv = gs ? *(const PG8_G f32x4*)(gs + (size_t)b * 1024 + colg) : (f32x4){0.f, 0.f, 0.f, 0.f};
        const f32x4 igv = *(const PG8_G f32x4*)(igs + (size_t)b * 1024 + colg);
#pragma unroll
        for (int ai = 0; ai < 2; ++ai) {
#pragma unroll
            for (int m = 0; m < 4; ++m) { const int rl = wr * 64 + m * 16 + fr;
#pragma unroll
                for (int bj = 0; bj < 2; ++bj)
#pragma unroll
                    for (int n = 0; n < 2; ++n) { const int c = 32 * bj + 8 * wc + 4 * n + fq; *(PG8_LAS f32x4*)(lds + rl * 1024 + ((c ^ (rl & 7)) << 4)) = acc[ai][bj][m][n]; } }
            asm volatile("s_waitcnt lgkmcnt(0)\n\ts_barrier" ::: "memory");
#pragma unroll
            for (int half = 0; half < 2; ++half) {
                u32x2 xo[8];
#pragma unroll
                for (int k = 0; k < 8; ++k) { const int rl = wid + 8 * (half * 8 + k); xo[k] = *(const PG8_G u32x2*)(xb + (size_t)(u.pm * BM + ai * HALF + rl) * 1024 + colg); }
#pragma unroll
                for (int k = 0; k < 8; ++k) { const int rl = wid + 8 * (half * 8 + k); const int row = u.pm * BM + ai * HALF + rl;
                    f32x4 t = *(const PG8_LAS f32x4*)(lds + rl * 1024 + ((lane ^ (rl & 7)) << 4));
                    if (HOOKED) t = t * gt[2 * BM + ai * HALF + rl];
                    const f32x4 xs = {__uint_as_float(xo[k].x << 16), __uint_as_float(xo[k].x & 0xffff0000u), __uint_as_float(xo[k].y << 16), __uint_as_float(xo[k].y & 0xffff0000u)};
                    const f32x4 xn = xs * igv + gv * t;
                    if (!gs) *(PG8_G f32x4*)(fout + (size_t)row * 1024 + colg) = xn;
                    if (gs) { const f32x4 y = xn * gsv; u32x2 w; w.x = cvt_pk_bf16(y[0], y[1]); w.y = cvt_pk_bf16(y[2], y[3]); *(PG8_G u32x2*)(xb + (size_t)row * 1024 + colg) = w; }
                    float ss = sq4(xn);
                    ss = wave_sum_dpp(ss);
                    if (gs && lane == 0) *(PG8_G f32x4*)(ssq_out + (size_t)row * 16 + 4 * u.pn) = (f32x4){ss, 0.f, 0.f, 0.f};
                }
            }
            asm volatile("s_waitcnt lgkmcnt(0)\n\ts_barrier" ::: "memory");
        }
    }
};

struct EpiIn {
    static constexpr bool PERM = true, AFTER_DRAIN = false, HOOK = false;
    PG8_G unsigned char* ws; const PG8_G float* gq; const PG8_G float* gk; const PG8_G float* bias; const PG8_LAS float* rr;
    __device__ __forceinline__ void hook(f32x4 (&)[2][2][4][2], const Unit&, int, int, int, int, int) const {}
    __device__ __forceinline__ void operator()(const f32x4 (&acc)[2][2][4][2], const Unit& u, int wr, int wc, int fr, int fq) const {
        const int slot = u.pn * 4 + wc;
        if (slot == 7 || slot >= 30) return;
        const int b = u.pm >> 5;
        const PG8_LAS float* rt = rr + u.ord * BM + wr * 64 + fr;
        PG8_G PG8_G bf16_t* dst = nullptr; int pitch = 0, col0 = 0; int kind = 0;
        PG8_G PG8_G float* ssqd = nullptr; int ssqp = 0, ssqi = 0; const PG8_G float* gain = nullptr; float scale = 1.0f;
        if (slot < 4)       { dst = (PG8_G bf16_t*)(ws + WS_CQ);  pitch = 256; col0 = 64 * slot;        kind = 1; ssqd = (PG8_G float*)(ws + WS_SSQC);  ssqp = 4; ssqi = slot; }
        else if (slot < 6)  { dst = (PG8_G bf16_t*)(ws + WS_CKV); pitch = 128; col0 = 64 * (slot - 4);  kind = 1; ssqd = (PG8_G float*)(ws + WS_SSQC) + (size_t)MROWS_ * 4; ssqp = 2; ssqi = slot - 4; }
        else if (slot == 6) { kind = 3; }
        else if (slot < 14) { dst = (PG8_G bf16_t*)(ws + WS_QS);  pitch = 384; col0 = 64 * (slot - 8);  kind = 2; gain = gq; scale = 0.125f * LOG2E; }
        else if (slot < 16) { dst = (PG8_G bf16_t*)(ws + WS_KS);  pitch = 128; col0 = 64 * (slot - 14); kind = 2; gain = gk; }
        else if (slot < 18) { dst = (PG8_G bf16_t*)(ws + WS_VS);  pitch = 128; col0 = 64 * (slot - 16); }
        else if (slot < 22) { dst = (PG8_G bf16_t*)(ws + WS_QC);  pitch = 256; col0 = 64 * (slot - 18); scale = 0.125f * LOG2E; }
        else if (slot < 26) { dst = (PG8_G bf16_t*)(ws + WS_KC);  pitch = 256; col0 = 64 * (slot - 22); }
        else                { dst = (PG8_G bf16_t*)(ws + WS_VC);  pitch = 256; col0 = 64 * (slot - 26); }
        const PG8_G float* bb = bias + b * 2048 + u.pn * BM + wc * 32 + 8 * fq;
        f32x4 bv[2][2], gn[2][2];
#pragma unroll
        for (int bj = 0; bj < 2; ++bj)
#pragma unroll
            for (int n = 0; n < 2; ++n) { bv[bj][n] = *(const PG8_G f32x4*)(bb + bj * HALF + 4 * n);
                gn[bj][n] = (kind == 2) ? *(const PG8_G f32x4*)(gain + 32 * bj + 8 * fq + 4 * n) * scale : (f32x4){scale, scale, scale, scale}; }
#pragma unroll
        for (int ai = 0; ai < 2; ++ai)
#pragma unroll
            for (int m = 0; m < 4; ++m) {
                const int row = u.pm * BM + ai * HALF + wr * 64 + m * 16 + fr;
                const float r = rt[ai * HALF + m * 16];
                f32x4 v[2][2]; float ss = 0.f;
#pragma unroll
                for (int bj = 0; bj < 2; ++bj)
#pragma unroll
                    for (int n = 0; n < 2; ++n) { v[bj][n] = acc[ai][bj][m][n] * r + bv[bj][n]; ss += sq4(v[bj][n]); }
                if (kind == 3) {
                    float s0 = sq4(v[0][0]) + sq4(v[0][1]);
                    s0 = xsum32(xsum16(s0));
                    *(PG8_G f32x4*)((PG8_G float*)(ws + WS_KPE) + (size_t)row * 32 + 8 * fq) = v[0][0]; *(PG8_G f32x4*)((PG8_G float*)(ws + WS_KPE) + (size_t)row * 32 + 8 * fq + 4) = v[0][1];
                    if (fq == 0) ((PG8_G float*)(ws + WS_SSQC) + (size_t)MROWS_ * 6)[row] = s0;
                } else {
                    if (kind != 0) { ss = xsum32(xsum16(ss)); }
                    float rn = 1.0f;
                    if (kind == 2) rn = 1.0f / sqrtf(ss * (1.0f / 64.0f) + RMS_EPS);
                    if (kind == 1 && fq == 0) ssqd[(size_t)row * ssqp + ssqi] = ss;
#pragma unroll
                    for (int bj = 0; bj < 2; ++bj) {
                        const f32x4 y0 = v[bj][0] * gn[bj][0] * rn, y1 = v[bj][1] * gn[bj][1] * rn;
                        u32x4 w; w.x = cvt_pk_bf16(y0[0], y0[1]); w.y = cvt_pk_bf16(y0[2], y0[3]); w.z = cvt_pk_bf16(y1[0], y1[1]); w.w = cvt_pk_bf16(y1[2], y1[3]);
                        *(PG8_G u32x4*)(dst + (size_t)row * pitch + col0 + 32 * bj + 8 * fq) = w;
                    }
                }
            }
    }
};

struct EpiUq {
    static constexpr bool PERM = false, AFTER_DRAIN = false, HOOK = false;
    PG8_G unsigned char* ws;
    __device__ __forceinline__ void hook(f32x4 (&)[2][2][4][2], const Unit&, int, int, int, int, int) const {}
    __device__ __forceinline__ void operator()(const f32x4 (&acc)[2][2][4][2], const Unit& u, int wr, int wc, int fr, int fq) const {
        PG8_G bf16_t* QRAW = (PG8_G bf16_t*)(ws + WS_QRAW); const PG8_G float* ssqcq = (const PG8_G float*)(ws + WS_SSQC);
        const int col0 = u.pn * BM + wc * 32 + 4 * fq;
#pragma unroll
        for (int ai = 0; ai < 2; ++ai)
#pragma unroll
            for (int m = 0; m < 4; ++m) {
                const int row = u.pm * BM + ai * HALF + wr * 64 + m * 16 + fr;
                const f32x4 s = *(const PG8_G f32x4*)(ssqcq + (size_t)row * 4);
                const float r = 1.0f / sqrtf(((s[0] + s[1]) + (s[2] + s[3])) * (1.0f / 256.0f) + RMS_EPS);
#pragma unroll
                for (int bj = 0; bj < 2; ++bj)
#pragma unroll
                    for (int n = 0; n < 2; ++n) { const int c = col0 + bj * HALF + n * 16; if (c < 576) { const f32x4 y = acc[ai][bj][m][n] * r; u32x2 w; w.x = cvt_pk_bf16(y[0], y[1]); w.y = cvt_pk_bf16(y[2], y[3]); *(PG8_G u32x2*)(QRAW + (size_t)row * 576 + c) = w; } }
            }
    }
};

struct EpiUkv {
    static constexpr bool PERM = true, AFTER_DRAIN = false, HOOK = false;
    PG8_G unsigned char* ws; const PG8_G float* gk;
    __device__ __forceinline__ void hook(f32x4 (&)[2][2][4][2], const Unit&, int, int, int, int, int) const {}
    __device__ __forceinline__ void operator()(const f32x4 (&acc)[2][2][4][2], const Unit& u, int wr, int wc, int fr, int fq) const {
        PG8_G bf16_t* KA = (PG8_G bf16_t*)(ws + WS_KA); PG8_G bf16_t* VA = (PG8_G bf16_t*)(ws + WS_VA); const PG8_G float* ssqckv = (const PG8_G float*)(ws + WS_SSQC) + (size_t)MROWS_ * 4; const PG8_G float* ssqkpe = (const PG8_G float*)(ws + WS_SSQC) + (size_t)MROWS_ * 6;
        const PG8_G float* kpe = (const PG8_G float*)(ws + WS_KPE); const PG8_G float* cs = (const PG8_G float*)(ws + WS_CS);
        const int h = 2 * u.pn + (wc >> 1); const bool isv = (wc & 1) != 0;
        f32x4 gn[2][2], g1 = {1.f, 1.f, 1.f, 1.f}, g2 = {1.f, 1.f, 1.f, 1.f};
        if (!isv) {
#pragma unroll
            for (int bj = 0; bj < 2; ++bj)
#pragma unroll
                for (int n = 0; n < 2; ++n) gn[bj][n] = *(const PG8_G f32x4*)(gk + 32 * bj + 8 * fq + 4 * n);
            g1 = *(const PG8_G f32x4*)(gk + 64 + 4 * fq); g2 = *(const PG8_G f32x4*)(gk + 80 + 4 * fq);
        }
#pragma unroll
        for (int ai = 0; ai < 2; ++ai)
#pragma unroll
            for (int m = 0; m < 4; ++m) {
                const int row = u.pm * BM + ai * HALF + wr * 64 + m * 16 + fr;
                const float r = 1.0f / sqrtf((ssqckv[(size_t)row * 2] + ssqckv[(size_t)row * 2 + 1]) * (1.0f / 128.0f) + RMS_EPS);
                f32x4 v[2][2]; float ss = 0.f;
#pragma unroll
                for (int bj = 0; bj < 2; ++bj)
#pragma unroll
                    for (int n = 0; n < 2; ++n) { v[bj][n] = acc[ai][bj][m][n] * r; ss += sq4(v[bj][n]); }
                if (isv) {
#pragma unroll
                    for (int bj = 0; bj < 2; ++bj) { u32x4 w; w.x = cvt_pk_bf16(v[bj][0][0], v[bj][0][1]); w.y = cvt_pk_bf16(v[bj][0][2], v[bj][0][3]); w.z = cvt_pk_bf16(v[bj][1][0], v[bj][1][1]); w.w = cvt_pk_bf16(v[bj][1][2], v[bj][1][3]);
                        *(PG8_G u32x4*)(VA + ((size_t)(row >> 6) * 6 + h) * 4096 + bj * 2048 + (row & 63) * 32 + 8 * fq) = w; }
                } else {
                    ss = xsum32(xsum16(ss));
                    const float rk = 1.0f / sqrtf((ss + ssqkpe[row]) * (1.0f / 96.0f) + RMS_EPS);
                    PG8_G bf16_t* kd = KA + ((size_t)(row >> 6) * 6 + h) * 6144 + (row & 63) * 8;
#pragma unroll
                    for (int bj = 0; bj < 2; ++bj) { const f32x4 y0 = v[bj][0] * gn[bj][0] * rk, y1 = v[bj][1] * gn[bj][1] * rk;
                        u32x4 w; w.x = cvt_pk_bf16(y0[0], y0[1]); w.y = cvt_pk_bf16(y0[2], y0[3]); w.z = cvt_pk_bf16(y1[0], y1[1]); w.w = cvt_pk_bf16(y1[2], y1[3]);
                        *(PG8_G u32x4*)(kd + (4 * bj + fq) * 512) = w; }
                    const f32x4 x1 = *(const PG8_G f32x4*)(kpe + (size_t)row * 32 + 4 * fq) * g1 * rk, x2 = *(const PG8_G f32x4*)(kpe + (size_t)row * 32 + 16 + 4 * fq) * g2 * rk;
                    const f32x4 c = *(const PG8_G f32x4*)(cs + (size_t)row * 32 + 4 * fq), s = *(const PG8_G f32x4*)(cs + (size_t)row * 32 + 16 + 4 * fq);
                    const f32x4 o1 = x1 * c - x2 * s, o2 = x2 * c + x1 * s;
                    u32x2 w1, w2; w1.x = cvt_pk_bf16(o1[0], o1[1]); w1.y = cvt_pk_bf16(o1[2], o1[3]); w2.x = cvt_pk_bf16(o2[0], o2[1]); w2.y = cvt_pk_bf16(o2[2], o2[3]);
                    *(PG8_G u32x2*)(kd + (8 + (fq >> 1)) * 512 + (fq & 1) * 4) = w1; *(PG8_G u32x2*)(kd + (10 + (fq >> 1)) * 512 + (fq & 1) * 4) = w2;
                }
                if (m & 1) PG8_FENCE();
            }
    }
};
}
#define GAS __attribute__((address_space(1)))
#define LAS __attribute__((address_space(3)))
typedef unsigned short bf16;
typedef unsigned v4u __attribute__((ext_vector_type(4)));
typedef float f32x4 __attribute__((ext_vector_type(4)));
typedef short bf16x8 __attribute__((ext_vector_type(8)));
typedef GAS unsigned gu32;
typedef GAS unsigned long long gu64;
#define RLX_AGENT __ATOMIC_RELAXED, __HIP_MEMORY_SCOPE_AGENT
#define LDS_WAIT() asm volatile("s_waitcnt lgkmcnt(0)" ::: "memory")
#define VM_WAIT() asm volatile("s_waitcnt vmcnt(0)" ::: "memory")
__device__ __forceinline__ unsigned long long rt() { return __builtin_amdgcn_s_memrealtime(); }
__device__ __forceinline__ unsigned f2bf(float f) { unsigned u = __builtin_bit_cast(unsigned, f); return (u + 0x7fffu + ((u >> 16) & 1u)) >> 16; }
__device__ __forceinline__ unsigned pk2(float lo, float hi) { return f2bf(lo) | (f2bf(hi) << 16); }

#define XB_TMO      128
#define XB_XCNT(j)  (256  + 64 * (j))
#define XB_XSUB(j)  (1280 + 64 * (j))
#define XB_XGEN(j)  (2304 + 64 * (j))
#define XB_TOP      3328
#define XB_TOPGEN   3392
#define XCD_BAR_WORDS 3456
#define XB_SPIN_CAP (1u << 18)

__device__ __forceinline__ unsigned xb_ld(unsigned* p)              { return __hip_atomic_load(p, __ATOMIC_RELAXED, __HIP_MEMORY_SCOPE_AGENT); }
__device__ __forceinline__ unsigned xb_add(unsigned* p, unsigned v) { return __hip_atomic_fetch_add(p, v, __ATOMIC_RELAXED, __HIP_MEMORY_SCOPE_AGENT); }
__device__ __forceinline__ unsigned xb_xcc_id() { return (unsigned)__builtin_amdgcn_s_getreg((3 << 11) | 20) & 0xFu; }
#define XB_SPIN(cond, bar) do { unsigned _sp = 0; while (cond) { __builtin_amdgcn_s_sleep(1); \
    if ((++_sp & 255u) == 0u) { if (xb_ld(&(bar)[XB_TMO])) break; if (_sp > XB_SPIN_CAP) { atomicAdd(&(bar)[XB_TMO], 1u); break; } } } } while (0)

struct XcdBarrier {
    unsigned* bar; unsigned x;
    volatile LAS unsigned* st;
    int w0;
};

__device__ __forceinline__ XcdBarrier xcd_barrier_post(unsigned* bar, volatile LAS unsigned* st, int w0) {
    XcdBarrier b; b.bar = bar; b.x = xb_xcc_id(); b.st = st; b.w0 = w0;
    if (w0 == 0 && hw_lane() == 0) (void)xb_add(&bar[XB_XCNT(b.x)], 1u);
    return b;
}
__device__ __forceinline__ void xcd_barrier_complete(unsigned* bar, unsigned x, unsigned& nloc, unsigned& nx) {
    const unsigned G = gridDim.x * gridDim.y * gridDim.z;
    unsigned sum, cnt, mine, sp = 0u;
    for (;;) {
        sum = 0u; cnt = 0u; mine = 0u;
#pragma unroll
        for (unsigned j = 0; j < 16; ++j) { const unsigned c = xb_ld(&bar[XB_XCNT(j)]); sum += c; cnt += (c > 0u) ? 1u : 0u; mine = (j == x) ? c : mine; }
        if (sum == G) break;
        __builtin_amdgcn_s_sleep(1);
        if ((++sp & 255u) == 0u) { if (xb_ld(&bar[XB_TMO])) break; if (sp > XB_SPIN_CAP) { atomicAdd(&bar[XB_TMO], 1u); break; } }
    }
    nloc = mine > 0u ? mine : 1u; nx = cnt > 0u ? cnt : 1u;
}

__device__ __forceinline__ void xcd_barrier(const XcdBarrier& b) {
    asm volatile("s_waitcnt vmcnt(0)" ::: "memory");
    __syncthreads();
    if (b.w0 == 0 && hw_lane() == 0) {
        unsigned* bar = b.bar;
        __builtin_amdgcn_s_waitcnt(0);
        unsigned nloc = b.st[0], nx = b.st[1];
        if (nloc == 0u) { xcd_barrier_complete(bar, b.x, nloc, nx); b.st[0] = nloc; b.st[1] = nx; }
        const unsigned old = xb_add(&bar[XB_XSUB(b.x)], 1u);
        const unsigned gen = old / nloc;
        if (old + 1u == (gen + 1u) * nloc) {
            __builtin_amdgcn_fence(__ATOMIC_RELEASE, "agent");
            asm volatile("s_waitcnt vmcnt(0)" ::: "memory");
            const unsigned og = xb_add(&bar[XB_TOP], 1u);
            const unsigned tg = og / nx;
            if (og + 1u == (tg + 1u) * nx) xb_add(&bar[XB_TOPGEN], 1u);
            else XB_SPIN(xb_ld(&bar[XB_TOPGEN]) == tg, bar);
            __builtin_amdgcn_fence(__ATOMIC_ACQUIRE, "agent");
            xb_add(&bar[XB_XGEN(b.x)], 1u);
            asm volatile("s_waitcnt vmcnt(0)" ::: "memory");
        } else {
            XB_SPIN(xb_ld(&bar[XB_XGEN(b.x)]) == gen, bar);
            __builtin_amdgcn_fence(__ATOMIC_ACQUIRE, "agent");
            asm volatile("s_waitcnt vmcnt(0)" ::: "memory");
        }
    }
    __syncthreads();
}
namespace att {
typedef unsigned short bf16_t;
typedef short bf16x8 __attribute__((ext_vector_type(8)));
typedef short s16x4 __attribute__((ext_vector_type(4)));
typedef short v4i16_t __attribute__((ext_vector_type(4)));
typedef float f32x16 __attribute__((ext_vector_type(16)));
typedef float f32x4 __attribute__((ext_vector_type(4)));
typedef float f32x2 __attribute__((ext_vector_type(2)));
typedef __bf16 bf16x2_t __attribute__((ext_vector_type(2)));
typedef unsigned u32x4 __attribute__((ext_vector_type(4)));
typedef int i32x4 __attribute__((ext_vector_type(4)));
#define ALAS __attribute__((address_space(3)))
#define AGAS __attribute__((address_space(1)))
constexpr int SEQ = 8192;
constexpr float LOG2E = 1.4426950408889634f, EPS = 1e-6f;
constexpr int KCS = 1040, VHS = 4160;
constexpr int KSLOT = 12 * KCS, VSLOT = 2 * VHS;
constexpr int L_K = 0, L_V = 3 * KSLOT, L_POS = L_V + 4 * VSLOT, L_TB = L_POS + 1024, L_WSF = L_TB + 128, L_OST = L_WSF + 8 * 256, L_FLAG = L_OST + 8 * 4096, L_END = L_FLAG + 16 + 64;
static_assert(L_OST % 16 == 0 && L_V % 16 == 0 && L_END <= 131072, "attention LDS map");
constexpr int S1_KS = 8 * KCS, S1_K = 0, S1_V = 7 * S1_KS, S1_P = S1_V + 7 * VSLOT, S1_LUT = S1_P + 7 * 256, S1_WSF = S1_LUT + 528, S1_END = S1_WSF + 8 * 256;
static_assert(S1_END <= L_FLAG || S1_END <= 131072, "sliding-window LDS map"); static_assert(S1_V % 16 == 0 && S1_WSF % 16 == 0 && S1_END <= 131072, "sliding-window LDS map");

__device__ __forceinline__ int crow(int r, int hi) { return (r & 3) + 8 * (r >> 2) + 4 * hi; }
__device__ __forceinline__ unsigned cvtpk(float lo, float hi) { f32x2 v = {lo, hi}; bf16x2_t b = __builtin_convertvector(v, bf16x2_t); return __builtin_bit_cast(unsigned, b); }
__device__ __forceinline__ s16x4 vtr(const ALAS unsigned char* p) { return __builtin_bit_cast(s16x4, __builtin_amdgcn_ds_read_tr16_b64_v4i16((ALAS v4i16_t*)p)); }
__device__ __forceinline__ float swap_sum(float x) { auto rr = __builtin_amdgcn_permlane32_swap(__float_as_uint(x), __float_as_uint(x), false, false); return __uint_as_float(rr[0]) + __uint_as_float(rr[1]); }
__device__ __forceinline__ float swap_max(float x) { auto rr = __builtin_amdgcn_permlane32_swap(__float_as_uint(x), __float_as_uint(x), false, false); return fmaxf(__uint_as_float(rr[0]), __uint_as_float(rr[1])); }
__device__ __forceinline__ float bf2f(unsigned short h) { return __uint_as_float((unsigned)h << 16); }

__device__ __forceinline__ void glds16(const AGAS void* gsrc, unsigned lds_dst) { unsigned keep;
    asm volatile("s_mov_b32 %0, m0\n\ts_mov_b32 m0, %2\n\ts_nop 0\n\tglobal_load_lds_dwordx4 %1, off\n\ts_mov_b32 m0, %0" : "=&s"(keep) : "v"(gsrc), "s"(lds_dst) : "memory"); }
__device__ __forceinline__ void glds4(const AGAS void* gsrc, unsigned lds_dst) { unsigned keep;
    asm volatile("s_mov_b32 %0, m0\n\ts_mov_b32 m0, %2\n\ts_nop 0\n\tglobal_load_lds_dword %1, off\n\ts_mov_b32 m0, %0" : "=&s"(keep) : "v"(gsrc), "s"(lds_dst) : "memory"); }

struct AttnP {
    AGAS unsigned char* ws;
    const AGAS float* gq;
    const AGAS int* pos; const AGAS float* sinks; const AGAS float* relb;
};
template <int MODE> struct AttnCfg;
template <> struct AttnCfg<0> { static constexpr size_t Q = WS_QRAW, K = WS_KA, V = WS_VA; static constexpr int qpitch = 576, kpitch = 576, khs = 96, vpitch = 384, vhs = 64, ocol0 = 0, hidx0 = 0, group = 1; };
template <> struct AttnCfg<1> { static constexpr size_t Q = WS_QS, K = WS_KS, V = WS_VS; static constexpr int qpitch = 384, kpitch = 128, khs = 64, vpitch = 128, vhs = 64, ocol0 = 384, hidx0 = 6, group = 3; };
template <> struct AttnCfg<2> { static constexpr size_t Q = WS_QC, K = WS_KC, V = WS_VC; static constexpr int qpitch = 256, kpitch = 256, khs = 64, vpitch = 256, vhs = 64, ocol0 = 768, hidx0 = 12, group = 1; };

#ifdef ATT_PROF
#define PROF_T() ((MODE == 0 && blockIdx.x == 0) ? (long long)clock64() : 0ll)
#else
#define PROF_T() 0ll
#endif
template <int DQK, int MODE>
__device__ __forceinline__ void attn_unit(ALAS unsigned char* lds, const AttnP& P, int b, int h, int qb, int wave0, unsigned long long* prof = nullptr) {
    long long pf_qk = 0, pf_sm = 0, pf_pv = 0, pf_wait = 0; const long long pf_t0 = PROF_T();
    constexpr int NCH = DQK / 8, ND0 = DQK / 16;
    int tid_ = wave0 * 64 + hw_lane(); asm volatile("" : "+v"(tid_));
    const int tid = tid_, lane = tid & 63, r32 = lane & 31, hi = lane >> 5;
    const int wid = __builtin_amdgcn_readfirstlane(tid >> 6);
    const int q0 = qb * 256, qlo = q0 + 32 * wid, qhi = qlo + 31, qrow = qlo + r32;
    const size_t rb = (size_t)b * SEQ;
    typedef AttnCfg<MODE> C; const int kvh = h / C::group;
    ALAS float* wsf = (ALAS float*)(lds + (MODE == 1 ? S1_WSF : L_WSF)) + wid * 64;
    ALAS unsigned char* ost = lds + L_OST + wid * 4096;
    ALAS int* posl = (ALAS int*)(lds + L_POS);
    ALAS float* tb = (ALAS float*)(lds + L_TB);

    bf16x8 qf[ND0];
    if constexpr (MODE == 0) {
        const AGAS bf16_t* qp = (const AGAS bf16_t*)(P.ws + C::Q) + (rb + qrow) * 576 + h * 96 + hi * 8;
        float qv[ND0][8]; float ss = 0.f;
#pragma unroll
        for (int d0 = 0; d0 < ND0; ++d0) { const u32x4 w = *(const AGAS u32x4*)(qp + 16 * d0);
#pragma unroll
            for (int i = 0; i < 4; ++i) { const float lo = __uint_as_float(w[i] << 16), hv = __uint_as_float(w[i] & 0xffff0000u); qv[d0][2 * i] = lo; qv[d0][2 * i + 1] = hv; ss += lo * lo + hv * hv; } }
        ss = swap_sum(ss);
        const float rq = 1.0f / sqrtf(ss * (1.0f / 96.0f) + EPS);
#pragma unroll
        for (int d0 = 0; d0 < ND0; ++d0) { const f32x4 ga = *(const AGAS f32x4*)(P.gq + 16 * d0 + 8 * hi), gb = *(const AGAS f32x4*)(P.gq + 16 * d0 + 8 * hi + 4);
#pragma unroll
            for (int i = 0; i < 4; ++i) { qv[d0][i] *= rq * ga[i]; qv[d0][4 + i] *= rq * gb[i]; } }
        {
            const AGAS float* cp = (const AGAS float*)(P.ws + WS_CS) + (rb + qrow) * 32 + 8 * hi;
            const f32x4 c0 = *(const AGAS f32x4*)cp, c1 = *(const AGAS f32x4*)(cp + 4), s0 = *(const AGAS f32x4*)(cp + 16), s1 = *(const AGAS f32x4*)(cp + 20);
#pragma unroll
            for (int i = 0; i < 8; ++i) { const float c = i < 4 ? c0[i & 3] : c1[i & 3], s = i < 4 ? s0[i & 3] : s1[i & 3]; const float x1 = qv[4][i], x2 = qv[5][i]; qv[4][i] = x1 * c - x2 * s; qv[5][i] = x2 * c + x1 * s; }
        }
        const float sc = 0.10206207261596575f * LOG2E;
#pragma unroll
        for (int d0 = 0; d0 < ND0; ++d0) { u32x4 w; w.x = cvtpk(qv[d0][0] * sc, qv[d0][1] * sc); w.y = cvtpk(qv[d0][2] * sc, qv[d0][3] * sc); w.z = cvtpk(qv[d0][4] * sc, qv[d0][5] * sc); w.w = cvtpk(qv[d0][6] * sc, qv[d0][7] * sc); qf[d0] = __builtin_bit_cast(bf16x8, w); }
    } else {
        const AGAS bf16_t* qp = (const AGAS bf16_t*)(P.ws + C::Q) + (rb + qrow) * C::qpitch + h * 64 + hi * 8;
#pragma unroll
        for (int d0 = 0; d0 < ND0; ++d0) qf[d0] = *(const AGAS bf16x8*)(qp + 16 * d0);
    }
    int posq = 0; float sink2 = 0.f;
    if constexpr (MODE == 1) {
        posq = P.pos[rb + qrow]; sink2 = P.sinks[h] * LOG2E;
    }

    int ntile, tfirst, tstep;
    if (MODE == 0) { tfirst = 0; tstep = 1; ntile = ((q0 + 255) >> 6) + 1; }
    else if (MODE == 1) { const int lo = q0 - 127 > 0 ? q0 - 127 : 0; tfirst = lo >> 6; tstep = 1; ntile = ((q0 + 255) >> 6) - tfirst + 1; }
    else { tfirst = (q0 + 254) >> 6; tstep = -1; ntile = tfirst + 1; }

    const AGAS bf16_t* Kg = (const AGAS bf16_t*)(P.ws + C::K) + rb * C::kpitch + kvh * C::khs;
    const AGAS bf16_t* Vg = (const AGAS bf16_t*)(P.ws + C::V) + rb * C::vpitch + kvh * C::vhs;
    const unsigned lds0 = (unsigned)(uintptr_t)lds;
    const AGAS bf16_t* ksrc0 = (MODE == 0) ? (const AGAS bf16_t*)(P.ws + C::K) + ((size_t)b * 128 * 6 + h) * 6144 + wid * 512 + lane * 8 : Kg + (size_t)lane * C::kpitch + 8 * wid;
    const AGAS bf16_t* vsrc = (MODE == 0) ? (const AGAS bf16_t*)(P.ws + C::V) + ((size_t)b * 128 * 6 + h) * 4096 + (wid >> 2) * 2048 + (wid & 3) * 512 + lane * 8
                                          : Vg + (size_t)(16 * (wid & 3) + (lane >> 2)) * C::vpitch + 32 * (wid >> 2) + 8 * (lane & 3);
    constexpr size_t KTS = (MODE == 0) ? (size_t)6 * 6144 : (size_t)64 * C::kpitch, VTS = (MODE == 0) ? (size_t)6 * 4096 : (size_t)64 * C::vpitch, K2O = (MODE == 0) ? 8 * 512 : 64;
    const bool k2 = (wid + 8) < NCH;
    const bool posw = (MODE == 1) && wid == 0;
    const int NP = 2 + (k2 ? 1 : 0) + (posw ? 1 : 0);
#define ATT_ISSUE(T, IT) do { const int T_ = (T); const size_t jo_ = (size_t)T_ * 64; const int ks_ = (IT) % 3, vs_ = (IT) & 3;     \
        glds16(ksrc0 + (size_t)T_ * KTS, (unsigned)__builtin_amdgcn_readfirstlane(lds0 + L_K + ks_ * KSLOT + wid * KCS)); \
        if (k2) glds16(ksrc0 + (size_t)T_ * KTS + K2O, (unsigned)__builtin_amdgcn_readfirstlane(lds0 + L_K + ks_ * KSLOT + (wid + 8) * KCS)); \
        glds16(vsrc + (size_t)T_ * VTS, (unsigned)__builtin_amdgcn_readfirstlane(lds0 + L_V + vs_ * VSLOT + (wid >> 2) * VHS + (wid & 3) * 1024)); \
        if (posw) glds4(P.pos + rb + jo_ + lane, (unsigned)__builtin_amdgcn_readfirstlane(lds0 + L_POS + vs_ * 256)); } while (0)
#define ATT_WAIT_BAR(n_) do { if ((n_) <= 0) asm volatile("s_waitcnt vmcnt(0) lgkmcnt(0)\n\ts_barrier" ::: "memory"); \
        else if (NP == 2) asm volatile("s_waitcnt vmcnt(2) lgkmcnt(0)\n\ts_barrier" ::: "memory"); \
        else if (NP == 3) asm volatile("s_waitcnt vmcnt(3) lgkmcnt(0)\n\ts_barrier" ::: "memory"); \
        else asm volatile("s_waitcnt vmcnt(4) lgkmcnt(0)\n\ts_barrier" ::: "memory"); } while (0)

    f32x16 o0 = {}, o1 = {};
    float mrun = (MODE == 1) ? sink2 : 0.f;
    float lrun = (MODE == 1 && hi == 0) ? 1.0f : 0.f;
    f32x16 negm;
#pragma unroll
    for (int r = 0; r < 16; ++r) negm[r] = (MODE == 2) ? 0.f : -mrun;
    bool first = (MODE == 0);
    float after = 0.f;
    bool walive = true;
    const int vrd = ((lane >> 4) & 1) * 32 + (lane & 3) * 8 + (4 * hi + ((lane & 15) >> 2)) * 64;
    const bool lag = wid >= 4;
    constexpr float THR = 4.0f;

#define ATT_QK(P0, P1, kb) do { int kofs_ = L_K + (kb) * KSLOT + hi * KCS + r32 * 16; asm volatile("" : "+v"(kofs_)); const ALAS unsigned char* Kb_ = lds + kofs_;     \
        bf16x8 kfa_[4], kfb_[4]; \
        _Pragma("unroll") for (int d0 = 0; d0 < 3; ++d0) { kfa_[d0] = *(const ALAS bf16x8*)(Kb_ + 2 * d0 * KCS); kfb_[d0] = *(const ALAS bf16x8*)(Kb_ + 2 * d0 * KCS + 512); } \
        \
        _Pragma("unroll") for (int d0 = 0; d0 < ND0; ++d0) { \
            if (d0 + 3 < ND0) { kfa_[(d0 + 3) & 3] = *(const ALAS bf16x8*)(Kb_ + 2 * (d0 + 3) * KCS); kfb_[(d0 + 3) & 3] = *(const ALAS bf16x8*)(Kb_ + 2 * (d0 + 3) * KCS + 512); } \
            if (d0 == 0) { P0 = __builtin_amdgcn_mfma_f32_32x32x16_bf16(kfa_[0], qf[0], negm, 0, 0, 0); P1 = __builtin_amdgcn_mfma_f32_32x32x16_bf16(kfb_[0], qf[0], negm, 0, 0, 0); } \
            else { P0 = __builtin_amdgcn_mfma_f32_32x32x16_bf16(kfa_[d0 & 3], qf[d0], P0, 0, 0, 0); P1 = __builtin_amdgcn_mfma_f32_32x32x16_bf16(kfb_[d0 & 3], qf[d0], P1, 0, 0, 0); } \
            } } while (0)
#define ATT_VLD(i_, s_) do { vl0_[i_] = vtr(Vb_ + (s_) * 1024); vh0_[i_] = vtr(Vb_ + (s_) * 1024 + 512); vl1_[i_] = vtr(Vb_ + VHS + (s_) * 1024); vh1_[i_] = vtr(Vb_ + VHS + (s_) * 1024 + 512); } while (0)
#define ATT_PV(vb) do { int vofs_ = L_V + (vb) * VSLOT + vrd; asm volatile("" : "+v"(vofs_)); const ALAS unsigned char* Vb_ = lds + vofs_; \
        s16x4 vl0_[2], vh0_[2], vl1_[2], vh1_[2]; ATT_VLD(0, 0); \
        _Pragma("unroll") for (int s_ = 0; s_ < 4; ++s_) { \
            if (s_ + 1 < 4) ATT_VLD((s_ + 1) & 1, s_ + 1); \
            const int i_ = s_ & 1; const bf16x8 pa_ = __builtin_bit_cast(bf16x8, pw[s_]); \
            const bf16x8 v0_ = {vl0_[i_][0], vl0_[i_][1], vl0_[i_][2], vl0_[i_][3], vh0_[i_][0], vh0_[i_][1], vh0_[i_][2], vh0_[i_][3]}, v1_ = {vl1_[i_][0], vl1_[i_][1], vl1_[i_][2], vl1_[i_][3], vh1_[i_][0], vh1_[i_][1], vh1_[i_][2], vh1_[i_][3]}; \
            o0 = __builtin_amdgcn_mfma_f32_32x32x16_bf16(pa_, v0_, o0, 0, 0, 0); o1 = __builtin_amdgcn_mfma_f32_32x32x16_bf16(pa_, v1_, o1, 0, 0, 0); } } while (0)
#define ATT_PACK(P0, P1) do { \
        pw[0].x = cvtpk(P0[0], P0[1]); pw[0].y = cvtpk(P0[2], P0[3]); pw[0].z = cvtpk(P0[4], P0[5]); pw[0].w = cvtpk(P0[6], P0[7]); \
        pw[1].x = cvtpk(P0[8], P0[9]); pw[1].y = cvtpk(P0[10], P0[11]); pw[1].z = cvtpk(P0[12], P0[13]); pw[1].w = cvtpk(P0[14], P0[15]); \
        pw[2].x = cvtpk(P1[0], P1[1]); pw[2].y = cvtpk(P1[2], P1[3]); pw[2].z = cvtpk(P1[4], P1[5]); pw[2].w = cvtpk(P1[6], P1[7]); \
        pw[3].x = cvtpk(P1[8], P1[9]); pw[3].y = cvtpk(P1[10], P1[11]); pw[3].z = cvtpk(P1[12], P1[13]); pw[3].w = cvtpk(P1[14], P1[15]); } while (0)
#define ATT_MAX3(a, b, c) fmaxf(fmaxf((a), (b)), (c))
#define ATT_SM_A(P0, P1, j0_, pslot) do { if constexpr (MODE != 2) { \
            if constexpr (MODE == 1) { \
                _Pragma("unroll") for (int g = 0; g < 4; ++g) { \
                    const i32x4 pa = *(const ALAS i32x4*)(posl + (pslot) * 64 + 8 * g + 4 * hi), pb = *(const ALAS i32x4*)(posl + (pslot) * 64 + 32 + 8 * g + 4 * hi); \
                    _Pragma("unroll") for (int i = 0; i < 4; ++i) { \
                        { int n = posq - pa[i]; n = n > 0 ? n : 0; int bk = n; if (n >= 16) { bk = 16 + (int)((__builtin_amdgcn_logf((float)n) - 4.0f) * (16.0f / 3.0f)); bk = bk < 31 ? bk : 31; } P0[4 * g + i] += tb[bk]; } \
                        { int n = posq - pb[i]; n = n > 0 ? n : 0; int bk = n; if (n >= 16) { bk = 16 + (int)((__builtin_amdgcn_logf((float)n) - 4.0f) * (16.0f / 3.0f)); bk = bk < 31 ? bk : 31; } P1[4 * g + i] += tb[bk]; } } } } \
            const bool nm_ = (MODE == 1) || ((j0_) + 63 > qlo); \
            if (nm_) { \
                _Pragma("unroll") for (int r = 0; r < 16; ++r) { const int key = (j0_) + crow(r, hi); \
                    bool ok0 = key <= qrow, ok1 = key + 32 <= qrow; \
                    if (MODE == 1) { ok0 = ok0 && (key > qrow - 128); ok1 = ok1 && (key + 32 > qrow - 128); } \
                    if (!ok0) P0[r] = -INFINITY; if (!ok1) P1[r] = -INFINITY; } } \
            float ma = ATT_MAX3(P0[0], P0[1], P1[0]), mb = ATT_MAX3(P0[2], P0[3], P1[1]); ma = ATT_MAX3(ma, P1[2], P1[3]); \
            _Pragma("unroll") for (int r = 4; r < 16; r += 4) { ma = ATT_MAX3(ma, P0[r], P0[r + 1]); mb = ATT_MAX3(mb, P0[r + 2], P0[r + 3]); ma = ATT_MAX3(ma, P1[r], P1[r + 1]); mb = ATT_MAX3(mb, P1[r + 2], P1[r + 3]); } \
            const float mt = swap_max(fmaxf(ma, mb)); \
            if (first || __any(mt > THR)) {                                 \
                const float d = first ? mt : fmaxf(mt, 0.f); first = false; \
                _Pragma("unroll") for (int r = 0; r < 16; ++r) { P0[r] -= d; P1[r] -= d; } \
                const float alpha = __builtin_amdgcn_exp2f(-d); mrun += d; lrun *= alpha; \
                _Pragma("unroll") for (int r = 0; r < 16; ++r) negm[r] = -mrun; \
                if (hi == 0) wsf[r32] = alpha; \
                _Pragma("unroll") for (int g = 0; g < 4; ++g) { const f32x4 al = *(const ALAS f32x4*)(wsf + 8 * g + 4 * hi); \
                    _Pragma("unroll") for (int i = 0; i < 4; ++i) { o0[4 * g + i] *= al[i]; o1[4 * g + i] *= al[i]; } } } } } while (0)
#define ATT_SM_B(P0, P1, j0_) do { \
        if constexpr (MODE == 2) { \
            const bool nm_ = (j0_) + 63 >= qlo; \
            float ln0[16], ln1[16]; \
            _Pragma("unroll") for (int r = 0; r < 16; ++r) { const int key = (j0_) + crow(r, hi); \
                { const float z = P0[r]; const float sp = fmaxf(z, 0.f) + __builtin_amdgcn_logf(1.0f + __builtin_amdgcn_exp2f(-fabsf(z))); const bool ok = !nm_ || key < qrow; ln0[r] = ok ? -sp : 0.f; P0[r] = ok ? z - sp : -INFINITY; } \
                { const float z = P1[r]; const float sp = fmaxf(z, 0.f) + __builtin_amdgcn_logf(1.0f + __builtin_amdgcn_exp2f(-fabsf(z))); const bool ok = !nm_ || key + 32 < qrow; ln1[r] = ok ? -sp : 0.f; P1[r] = ok ? z - sp : -INFINITY; } } \
            float run = after; \
            _Pragma("unroll") for (int blk = 1; blk >= 0; --blk) _Pragma("unroll") for (int g = 3; g >= 0; --g) { \
                const float own = blk ? ((ln1[4 * g] + ln1[4 * g + 1]) + (ln1[4 * g + 2] + ln1[4 * g + 3])) : ((ln0[4 * g] + ln0[4 * g + 1]) + (ln0[4 * g + 2] + ln0[4 * g + 3])); \
                auto rr = __builtin_amdgcn_permlane32_swap(__float_as_uint(own), __float_as_uint(own), false, false); \
                const float slo = __uint_as_float(rr[0]), shi = __uint_as_float(rr[1]); \
                const float e1 = run; run += shi; const float e0 = run; run += slo; \
                float aft = hi ? e1 : e0; \
                _Pragma("unroll") for (int i = 3; i >= 0; --i) { const int r = 4 * g + i; \
                    if (blk) { P1[r] = __builtin_amdgcn_exp2f(P1[r] + aft); aft += ln1[r]; } else { P0[r] = __builtin_amdgcn_exp2f(P0[r] + aft); aft += ln0[r]; } } } \
            after = run; walive = __any(after > -160.0f); \
        } else { \
            float ls = 0.f; \
            _Pragma("unroll") for (int r = 0; r < 16; ++r) { P0[r] = __builtin_amdgcn_exp2f(P0[r]); P1[r] = __builtin_amdgcn_exp2f(P1[r]); ls += P0[r] + P1[r]; } \
            lrun += ls; } \
        ATT_PACK(P0, P1); } while (0)
#define ATT_WORK(j0_) ((MODE == 0) ? ((j0_) <= qhi) : (MODE == 1) ? (((j0_) <= qhi) && ((j0_) + 63 >= qlo - 127)) : (walive && ((j0_) < qhi)))

    if constexpr (MODE == 0) {
    f32x16 p0, p1, n0, n1; u32x4 pw[4];
    __syncthreads();
    int issued = 0;
    ATT_ISSUE(0, 0);
    if (ntile > 1) { ATT_ISSUE(1, 1); issued = 1; }
    if (ntile > 2) { ATT_ISSUE(2, 2); issued = 2; }
    ATT_WAIT_BAR(issued - 1);
    const int tmax = qhi >> 6;
#define MLA_SB() __builtin_amdgcn_sched_barrier(0)
#define MLA_EX(v) __builtin_amdgcn_exp2f(v)
#define MLA_DECIDE(X0, X1, j0_) do { \
        if ((j0_) + 63 > qlo) { _Pragma("unroll") for (int r = 0; r < 16; ++r) { const int key = (j0_) + crow(r, hi); if (key > qrow) X0[r] = -INFINITY; if (key + 32 > qrow) X1[r] = -INFINITY; } } \
        float ma = ATT_MAX3(X0[0], X0[1], X1[0]), mb = ATT_MAX3(X0[2], X0[3], X1[1]); ma = ATT_MAX3(ma, X1[2], X1[3]); \
        _Pragma("unroll") for (int r = 4; r < 16; r += 4) { ma = ATT_MAX3(ma, X0[r], X0[r + 1]); mb = ATT_MAX3(mb, X0[r + 2], X0[r + 3]); ma = ATT_MAX3(ma, X1[r], X1[r + 1]); mb = ATT_MAX3(mb, X1[r + 2], X1[r + 3]); } \
        const float mt = swap_max(fmaxf(ma, mb)); resc = false; \
        if (first || __any(mt > THR)) { const float d = first ? mt : fmaxf(mt, 0.f); first = false; \
            _Pragma("unroll") for (int r = 0; r < 16; ++r) { X0[r] -= d; X1[r] -= d; } \
            const float alpha = __builtin_amdgcn_exp2f(-d); lrun *= alpha; const float nm_ = negm[0] - d;     \
            _Pragma("unroll") for (int r = 0; r < 16; ++r) negm[r] = nm_; \
            if (hi == 0) wsf[r32] = alpha; resc = true; } } while (0)
#define MLA_RESC() do { if (resc) { _Pragma("unroll") for (int g = 0; g < 4; ++g) { const f32x4 al = *(const ALAS f32x4*)(wsf + 8 * g + 4 * hi); \
            _Pragma("unroll") for (int i = 0; i < 4; ++i) { o0[4 * g + i] *= al[i]; o1[4 * g + i] *= al[i]; } } } } while (0)
#define MLA_PV_(i) (i < 16 ? C0[(i) & 15] : C1[(i) & 15])
#define MLA_GA(MF, g, C0, C1) do { MF; \
        if (3 * (g) < 32) sacc += (3 * (g) < 16 ? C0[(3 * (g)) & 15] : C1[(3 * (g)) & 15]); \
        if (3 * (g) + 1 < 32) sacc += (3 * (g) + 1 < 16 ? C0[(3 * (g) + 1) & 15] : C1[(3 * (g) + 1) & 15]); \
        if (3 * (g) + 2 < 32) sacc += (3 * (g) + 2 < 16 ? C0[(3 * (g) + 2) & 15] : C1[(3 * (g) + 2) & 15]); \
        if ((g) < 4) { pw[((g) >> 1) & 3][2 * ((g) & 1)] = cvtpk(C0[4 * (g)], C0[4 * (g) + 1]); pw[((g) >> 1) & 3][2 * ((g) & 1) + 1] = cvtpk(C0[4 * (g) + 2], C0[4 * (g) + 3]); } \
        else if ((g) < 8) { pw[((g) >> 1) & 3][2 * ((g) & 1)] = cvtpk(C1[4 * ((g) - 4)], C1[4 * ((g) - 4) + 1]); pw[((g) >> 1) & 3][2 * ((g) & 1) + 1] = cvtpk(C1[4 * ((g) - 4) + 2], C1[4 * ((g) - 4) + 3]); } } while (0)
#define MLA_VF(lo_, hi_) (bf16x8){lo_[0], lo_[1], lo_[2], lo_[3], hi_[0], hi_[1], hi_[2], hi_[3]}
#define MLA_GB(MF, X, b_) do { MF; X[(b_)] = MLA_EX(X[(b_)]); X[(b_) + 1] = MLA_EX(X[(b_) + 1]); X[(b_) + 2] = MLA_EX(X[(b_) + 2]); X[(b_) + 3] = MLA_EX(X[(b_) + 3]); } while (0)
#define MLA_FULL(C0, C1, N0, N1, t_) do { \
        int kofs_ = L_K + (((t_) + 1) % 3) * KSLOT + hi * KCS + r32 * 16; asm volatile("" : "+v"(kofs_)); const ALAS unsigned char* Kb_ = lds + kofs_; \
        int vofs_ = L_V + ((t_) & 3) * VSLOT + vrd; asm volatile("" : "+v"(vofs_)); const ALAS unsigned char* Vb_ = lds + vofs_; \
        bf16x8 ka0 = *(const ALAS bf16x8*)(Kb_), kb0 = *(const ALAS bf16x8*)(Kb_ + 512), ka1 = *(const ALAS bf16x8*)(Kb_ + 2 * KCS), kb1 = *(const ALAS bf16x8*)(Kb_ + 2 * KCS + 512), ka2, kb2; \
        s16x4 vl0a, vh0a, vl1a, vh1a, vl0b, vh0b, vl1b, vh1b; float sacc = 0.f; \
        MLA_SB(); \
        MLA_GA(N0 = __builtin_amdgcn_mfma_f32_32x32x16_bf16(ka0, qf[0], negm, 0, 0, 0), 0, C0, C1); ka2 = *(const ALAS bf16x8*)(Kb_ + 4 * KCS); MLA_SB(); \
        MLA_GA(N1 = __builtin_amdgcn_mfma_f32_32x32x16_bf16(kb0, qf[0], negm, 0, 0, 0), 1, C0, C1); kb2 = *(const ALAS bf16x8*)(Kb_ + 4 * KCS + 512); MLA_SB(); \
        MLA_GA(N0 = __builtin_amdgcn_mfma_f32_32x32x16_bf16(ka1, qf[1], N0, 0, 0, 0), 2, C0, C1); ka0 = *(const ALAS bf16x8*)(Kb_ + 6 * KCS); MLA_SB(); \
        MLA_GA(N1 = __builtin_amdgcn_mfma_f32_32x32x16_bf16(kb1, qf[1], N1, 0, 0, 0), 3, C0, C1); kb0 = *(const ALAS bf16x8*)(Kb_ + 6 * KCS + 512); MLA_SB(); \
        MLA_GA(N0 = __builtin_amdgcn_mfma_f32_32x32x16_bf16(ka2, qf[2], N0, 0, 0, 0), 4, C0, C1); ka1 = *(const ALAS bf16x8*)(Kb_ + 8 * KCS); MLA_SB(); \
        MLA_GA(N1 = __builtin_amdgcn_mfma_f32_32x32x16_bf16(kb2, qf[2], N1, 0, 0, 0), 5, C0, C1); kb1 = *(const ALAS bf16x8*)(Kb_ + 8 * KCS + 512); MLA_SB(); \
        MLA_GA(N0 = __builtin_amdgcn_mfma_f32_32x32x16_bf16(ka0, qf[3], N0, 0, 0, 0), 6, C0, C1); ka2 = *(const ALAS bf16x8*)(Kb_ + 10 * KCS); MLA_SB(); \
        MLA_GA(N1 = __builtin_amdgcn_mfma_f32_32x32x16_bf16(kb0, qf[3], N1, 0, 0, 0), 7, C0, C1); kb2 = *(const ALAS bf16x8*)(Kb_ + 10 * KCS + 512); MLA_SB(); \
        MLA_GA(N0 = __builtin_amdgcn_mfma_f32_32x32x16_bf16(ka1, qf[4], N0, 0, 0, 0), 8, C0, C1); MLA_SB(); \
        MLA_GA(N1 = __builtin_amdgcn_mfma_f32_32x32x16_bf16(kb1, qf[4], N1, 0, 0, 0), 9, C0, C1); MLA_SB(); \
        MLA_GA(N0 = __builtin_amdgcn_mfma_f32_32x32x16_bf16(ka2, qf[5], N0, 0, 0, 0), 10, C0, C1); vl0a = vtr(Vb_); vh0a = vtr(Vb_ + 512); MLA_SB(); \
        MLA_GA(N1 = __builtin_amdgcn_mfma_f32_32x32x16_bf16(kb2, qf[5], N1, 0, 0, 0), 11, C0, C1); vl1a = vtr(Vb_ + VHS); vh1a = vtr(Vb_ + VHS + 512); MLA_SB(); \
        lrun += sacc; \
        MLA_DECIDE(N0, N1, ((t_) + 1) * 64); \
        MLA_SB(); \
        MLA_GB(o0 = __builtin_amdgcn_mfma_f32_32x32x16_bf16(__builtin_bit_cast(bf16x8, pw[0]), MLA_VF(vl0a, vh0a), o0, 0, 0, 0), N0, 0); vl0b = vtr(Vb_ + 1024); vh0b = vtr(Vb_ + 1024 + 512); MLA_SB(); \
        MLA_GB(o1 = __builtin_amdgcn_mfma_f32_32x32x16_bf16(__builtin_bit_cast(bf16x8, pw[0]), MLA_VF(vl1a, vh1a), o1, 0, 0, 0), N0, 4); vl1b = vtr(Vb_ + VHS + 1024); vh1b = vtr(Vb_ + VHS + 1024 + 512); MLA_SB(); \
        MLA_GB(o0 = __builtin_amdgcn_mfma_f32_32x32x16_bf16(__builtin_bit_cast(bf16x8, pw[1]), MLA_VF(vl0b, vh0b), o0, 0, 0, 0), N0, 8); vl0a = vtr(Vb_ + 2048); vh0a = vtr(Vb_ + 2048 + 512); MLA_SB(); \
        MLA_GB(o1 = __builtin_amdgcn_mfma_f32_32x32x16_bf16(__builtin_bit_cast(bf16x8, pw[1]), MLA_VF(vl1b, vh1b), o1, 0, 0, 0), N0, 12); vl1a = vtr(Vb_ + VHS + 2048); vh1a = vtr(Vb_ + VHS + 2048 + 512); MLA_SB(); \
        MLA_GB(o0 = __builtin_amdgcn_mfma_f32_32x32x16_bf16(__builtin_bit_cast(bf16x8, pw[2]), MLA_VF(vl0a, vh0a), o0, 0, 0, 0), N1, 0); vl0b = vtr(Vb_ + 3072); vh0b = vtr(Vb_ + 3072 + 512); MLA_SB(); \
        MLA_GB(o1 = __builtin_amdgcn_mfma_f32_32x32x16_bf16(__builtin_bit_cast(bf16x8, pw[2]), MLA_VF(vl1a, vh1a), o1, 0, 0, 0), N1, 4); vl1b = vtr(Vb_ + VHS + 3072); vh1b = vtr(Vb_ + VHS + 3072 + 512); MLA_SB(); \
        MLA_GB(o0 = __builtin_amdgcn_mfma_f32_32x32x16_bf16(__builtin_bit_cast(bf16x8, pw[3]), MLA_VF(vl0b, vh0b), o0, 0, 0, 0), N1, 8); MLA_SB(); \
        MLA_GB(o1 = __builtin_amdgcn_mfma_f32_32x32x16_bf16(__builtin_bit_cast(bf16x8, pw[3]), MLA_VF(vl1b, vh1b), o1, 0, 0, 0), N1, 12); MLA_SB(); \
        MLA_RESC(); } while (0)
#define MLA_TAIL(C0, C1, t_) do { float ls = 0.f; _Pragma("unroll") for (int r = 0; r < 16; ++r) ls += C0[r] + C1[r]; lrun += ls; ATT_PACK(C0, C1); ATT_PV((t_) & 3); } while (0)
#define MLA_STEP(C0, C1, N0, N1, t_) do { \
          \
        int lane_ = lane; asm volatile("" : "+v"(lane_)); const int r32 = lane_ & 31, hi = lane_ >> 5, qrow = qlo + r32; \
        const int vrd = ((lane_ >> 4) & 1) * 32 + (lane_ & 3) * 8 + (4 * hi + ((lane_ & 15) >> 2)) * 64; ALAS float* wsf = (ALAS float*)(lds + L_WSF) + wid * 64; \
        if ((t_) + 3 < ntile) { ATT_ISSUE((t_) + 3, (t_) + 3); issued = (t_) + 3; } \
        if ((t_) < tmax) MLA_FULL(C0, C1, N0, N1, t_); else if ((t_) == tmax) MLA_TAIL(C0, C1, t_); \
        ATT_WAIT_BAR(issued - ((t_) + 2)); } while (0)
    if (wid >= 4) __builtin_amdgcn_s_setprio(1);
    bool resc = false;
    ATT_QK(p0, p1, 0);
    MLA_DECIDE(p0, p1, 0);
#pragma unroll
    for (int r = 0; r < 16; ++r) { p0[r] = MLA_EX(p0[r]); p1[r] = MLA_EX(p1[r]); }
    asm volatile("s_waitcnt lgkmcnt(0)\n\ts_barrier" ::: "memory");
    for (int it = 0; it < ntile; it += 2) {
        MLA_STEP(p0, p1, n0, n1, it);
        if (it + 1 >= ntile) break;
        MLA_STEP(n0, n1, p0, p1, it + 1);
    }
    __builtin_amdgcn_s_setprio(0);
#undef MLA_SB
#undef MLA_EX
#undef MLA_DECIDE
#undef MLA_RESC
#undef MLA_PV_
#undef MLA_GA
#undef MLA_VF
#undef MLA_GB
#undef MLA_FULL
#undef MLA_TAIL
#undef MLA_STEP
    } else if constexpr (MODE == 1) {
    f32x16 p0, p1; u32x4 pw[4];
    __syncthreads();
    {
        const unsigned lds0_ = (unsigned)(uintptr_t)lds;
        for (int i = 0; i < ntile; ++i) { const int T_ = tfirst + i;
            glds16(ksrc0 + (size_t)T_ * KTS, (unsigned)__builtin_amdgcn_readfirstlane(lds0_ + S1_K + i * S1_KS + wid * KCS));
            glds16(vsrc + (size_t)T_ * VTS, (unsigned)__builtin_amdgcn_readfirstlane(lds0_ + S1_V + i * VSLOT + (wid >> 2) * VHS + (wid & 3) * 1024));
            if (wid == 0) glds4(P.pos + rb + (size_t)T_ * 64 + lane, (unsigned)__builtin_amdgcn_readfirstlane(lds0_ + S1_P + i * 256)); }
        ALAS float* lut = (ALAS float*)(lds + S1_LUT);
        if (tid < 129) { int bk = tid; if (tid >= 16) { bk = 16 + (int)((__builtin_amdgcn_logf((float)tid) - 4.0f) * (16.0f / 3.0f)); bk = bk < 31 ? bk : 31; } lut[tid] = P.relb[bk * 6 + h] * LOG2E; }
        asm volatile("s_waitcnt vmcnt(0) lgkmcnt(0)\n\ts_barrier" ::: "memory");
        const ALAS int* posk = (const ALAS int*)(lds + S1_P);
        const int lo_ = qlo - 127 > 0 ? qlo - 127 : 0; const int i_lo = (lo_ >> 6) - tfirst, i_hi = (qhi >> 6) - tfirst;
        for (int i = i_lo; i <= i_hi; ++i) {
            const int j0 = (tfirst + i) * 64;
            {
                int kofs_ = S1_K + i * S1_KS + hi * KCS + r32 * 16; asm volatile("" : "+v"(kofs_)); const ALAS unsigned char* Kb_ = lds + kofs_;
#pragma unroll
                for (int d0 = 0; d0 < ND0; ++d0) { const bf16x8 a0_ = *(const ALAS bf16x8*)(Kb_ + 2 * d0 * KCS), a1_ = *(const ALAS bf16x8*)(Kb_ + 2 * d0 * KCS + 512);
                    if (d0 == 0) { p0 = __builtin_amdgcn_mfma_f32_32x32x16_bf16(a0_, qf[0], negm, 0, 0, 0); p1 = __builtin_amdgcn_mfma_f32_32x32x16_bf16(a1_, qf[0], negm, 0, 0, 0); }
                    else { p0 = __builtin_amdgcn_mfma_f32_32x32x16_bf16(a0_, qf[d0], p0, 0, 0, 0); p1 = __builtin_amdgcn_mfma_f32_32x32x16_bf16(a1_, qf[d0], p1, 0, 0, 0); } }
            }
#pragma unroll
            for (int g = 0; g < 4; ++g) {
                const i32x4 pa = *(const ALAS i32x4*)(posk + i * 64 + 8 * g + 4 * hi), pb = *(const ALAS i32x4*)(posk + i * 64 + 32 + 8 * g + 4 * hi);
#pragma unroll
                for (int q = 0; q < 4; ++q) { int na = posq - pa[q]; na = na > 0 ? na : 0; na = na < 128 ? na : 128; int nb = posq - pb[q]; nb = nb > 0 ? nb : 0; nb = nb < 128 ? nb : 128;
                    p0[4 * g + q] += lut[na]; p1[4 * g + q] += lut[nb]; }
            }
#pragma unroll
            for (int r = 0; r < 16; ++r) { const int key = j0 + crow(r, hi); const bool ok0 = key <= qrow && key > qrow - 128, ok1 = key + 32 <= qrow && key + 32 > qrow - 128; if (!ok0) p0[r] = -INFINITY; if (!ok1) p1[r] = -INFINITY; }
            float ma = ATT_MAX3(p0[0], p0[1], p1[0]), mb = ATT_MAX3(p0[2], p0[3], p1[1]); ma = ATT_MAX3(ma, p1[2], p1[3]);
#pragma unroll
            for (int r = 4; r < 16; r += 4) { ma = ATT_MAX3(ma, p0[r], p0[r + 1]); mb = ATT_MAX3(mb, p0[r + 2], p0[r + 3]); ma = ATT_MAX3(ma, p1[r], p1[r + 1]); mb = ATT_MAX3(mb, p1[r + 2], p1[r + 3]); }
            const float mt = swap_max(fmaxf(ma, mb));
            if (__any(mt > THR)) {
                const float d = fmaxf(mt, 0.f);
#pragma unroll
                for (int r = 0; r < 16; ++r) { p0[r] -= d; p1[r] -= d; }
                const float alpha = __builtin_amdgcn_exp2f(-d); mrun += d; lrun *= alpha;
#pragma unroll
                for (int r = 0; r < 16; ++r) negm[r] = -mrun;
                if (hi == 0) wsf[r32] = alpha;
#pragma unroll
                for (int g = 0; g < 4; ++g) { const f32x4 al = *(const ALAS f32x4*)(wsf + 8 * g + 4 * hi);
#pragma unroll
                    for (int q = 0; q < 4; ++q) { o0[4 * g + q] *= al[q]; o1[4 * g + q] *= al[q]; } }
            }
            float ls = 0.f;
#pragma unroll
            for (int r = 0; r < 16; ++r) { p0[r] = __builtin_amdgcn_exp2f(p0[r]); p1[r] = __builtin_amdgcn_exp2f(p1[r]); ls += p0[r] + p1[r]; }
            lrun += ls;
            ATT_PACK(p0, p1);
            {
                int vofs_ = S1_V + i * VSLOT + vrd; asm volatile("" : "+v"(vofs_)); const ALAS unsigned char* Vb_ = lds + vofs_;
#pragma unroll
                for (int s_ = 0; s_ < 4; ++s_) { const bf16x8 pa_ = __builtin_bit_cast(bf16x8, pw[s_]);
                    const s16x4 l0_ = vtr(Vb_ + s_ * 1024), h0_ = vtr(Vb_ + s_ * 1024 + 512), l1_ = vtr(Vb_ + VHS + s_ * 1024), h1_ = vtr(Vb_ + VHS + s_ * 1024 + 512);
                    const bf16x8 v0_ = {l0_[0], l0_[1], l0_[2], l0_[3], h0_[0], h0_[1], h0_[2], h0_[3]}, v1_ = {l1_[0], l1_[1], l1_[2], l1_[3], h1_[0], h1_[1], h1_[2], h1_[3]};
                    o0 = __builtin_amdgcn_mfma_f32_32x32x16_bf16(pa_, v0_, o0, 0, 0, 0); o1 = __builtin_amdgcn_mfma_f32_32x32x16_bf16(pa_, v1_, o1, 0, 0, 0); }
            }
        }
        asm volatile("s_waitcnt lgkmcnt(0)\n\ts_barrier" ::: "memory");
    }
    } else {
    bool go_on = true;
    {
        u32x4 pw[4]; f32x16 p0, p1;
        const int nwin = ntile < 7 ? ntile : 7;
        __syncthreads();
        const unsigned lds0_ = (unsigned)(uintptr_t)lds;
        for (int i = 0; i < nwin; ++i) { const int T_ = tfirst - i;
            glds16(ksrc0 + (size_t)T_ * KTS, (unsigned)__builtin_amdgcn_readfirstlane(lds0_ + S1_K + i * S1_KS + wid * KCS));
            glds16(vsrc + (size_t)T_ * VTS, (unsigned)__builtin_amdgcn_readfirstlane(lds0_ + S1_V + i * VSLOT + (wid >> 2) * VHS + (wid & 3) * 1024)); }
        asm volatile("s_waitcnt vmcnt(0) lgkmcnt(0)\n\ts_barrier" ::: "memory");
        for (int i = 0; i < nwin; ++i) {
            const int j0 = (tfirst - i) * 64;
            if (!(walive && j0 < qhi)) { if (!walive) break; continue; }
            {
                int kofs_ = S1_K + i * S1_KS + hi * KCS + r32 * 16; asm volatile("" : "+v"(kofs_)); const ALAS unsigned char* Kb_ = lds + kofs_;
#pragma unroll
                for (int d0 = 0; d0 < ND0; ++d0) { const bf16x8 a0_ = *(const ALAS bf16x8*)(Kb_ + 2 * d0 * KCS), a1_ = *(const ALAS bf16x8*)(Kb_ + 2 * d0 * KCS + 512);
                    if (d0 == 0) { p0 = __builtin_amdgcn_mfma_f32_32x32x16_bf16(a0_, qf[0], negm, 0, 0, 0); p1 = __builtin_amdgcn_mfma_f32_32x32x16_bf16(a1_, qf[0], negm, 0, 0, 0); }
                    else { p0 = __builtin_amdgcn_mfma_f32_32x32x16_bf16(a0_, qf[d0], p0, 0, 0, 0); p1 = __builtin_amdgcn_mfma_f32_32x32x16_bf16(a1_, qf[d0], p1, 0, 0, 0); } }
            }
            ATT_SM_B(p0, p1, j0);
            {
                int vofs_ = S1_V + i * VSLOT + vrd; asm volatile("" : "+v"(vofs_)); const ALAS unsigned char* Vb_ = lds + vofs_;
#pragma unroll
                for (int s_ = 0; s_ < 4; ++s_) { const bf16x8 pa_ = __builtin_bit_cast(bf16x8, pw[s_]);
                    const s16x4 l0_ = vtr(Vb_ + s_ * 1024), h0_ = vtr(Vb_ + s_ * 1024 + 512), l1_ = vtr(Vb_ + VHS + s_ * 1024), h1_ = vtr(Vb_ + VHS + s_ * 1024 + 512);
                    const bf16x8 v0_ = {l0_[0], l0_[1], l0_[2], l0_[3], h0_[0], h0_[1], h0_[2], h0_[3]}, v1_ = {l1_[0], l1_[1], l1_[2], l1_[3], h1_[0], h1_[1], h1_[2], h1_[3]};
                    o0 = __builtin_amdgcn_mfma_f32_32x32x16_bf16(pa_, v0_, o0, 0, 0, 0); o1 = __builtin_amdgcn_mfma_f32_32x32x16_bf16(pa_, v1_, o1, 0, 0, 0); }
            }
        }
        ALAS int* fl = (ALAS int*)(lds + S1_WSF);
        if (lane == 0) fl[wid] = (walive && tfirst - nwin >= 0) ? 1 : 0;
        asm volatile("s_waitcnt lgkmcnt(0)\n\ts_barrier" ::: "memory");
        const i32x4 fa = *(const ALAS i32x4*)fl, fb = *(const ALAS i32x4*)(fl + 4);
        go_on = ((fa[0] | fa[1]) | (fa[2] | fa[3]) | (fb[0] | fb[1]) | (fb[2] | fb[3])) != 0;
        tfirst -= nwin; ntile = tfirst + 1;
    }
    if (go_on) {
    f32x16 p0, p1, n0, n1; u32x4 pw[4];
    __syncthreads();
    int issued = 0;
    ATT_ISSUE(tfirst, 0);
    if (ntile > 1) { ATT_ISSUE(tfirst + tstep, 1); issued = 1; }
    if (ntile > 2) { ATT_ISSUE(tfirst + 2 * tstep, 2); issued = 2; }
    ATT_WAIT_BAR(issued - 1);
    bool wcur = ATT_WORK(tfirst * 64);
    if (wcur) ATT_QK(p0, p1, 0);
    asm volatile("s_waitcnt lgkmcnt(0)\n\ts_barrier" ::: "memory");
    int nt = ntile;
    for (int it = 0; it < nt; ++it) {
        const int t = tfirst + it * tstep, j0 = t * 64, jn = (t + tstep) * 64;
        if (it + 3 < ntile) { ATT_ISSUE(t + 3 * tstep, it + 3); issued = it + 3; }
        if (wcur) ATT_SM_A(p0, p1, j0, it & 3);
        const bool wnext = (it + 1 < nt) && ATT_WORK(jn);
        if (wcur && wnext) { ATT_QK(n0, n1, (it + 1) % 3); ATT_SM_B(p0, p1, j0); }
        else { if (wnext) ATT_QK(n0, n1, (it + 1) % 3); if (wcur) ATT_SM_B(p0, p1, j0); }
        if (wcur) ATT_PV(it & 3);
        p0 = n0; p1 = n1; wcur = wnext;
        if (MODE == 2) { ALAS int* fl = (ALAS int*)(lds + L_FLAG + 16) + (it & 1) * 8; if (lane == 0) fl[wid] = (walive && j0 > 0) ? 1 : 0; }
        ATT_WAIT_BAR(issued - (it + 2));
        if (MODE == 2) { const ALAS int* fl = (const ALAS int*)(lds + L_FLAG + 16) + (it & 1) * 8;
            const i32x4 fa = *(const ALAS i32x4*)fl, fb = *(const ALAS i32x4*)(fl + 4);
            if (((fa[0] | fa[1]) | (fa[2] | fa[3]) | (fb[0] | fb[1]) | (fb[2] | fb[3])) == 0) nt = it + 1; }
    }
    }
    }
    if (MODE == 2) asm volatile("s_waitcnt vmcnt(0)" ::: "memory");
#undef ATT_ISSUE
#undef ATT_WAIT_BAR
#undef ATT_QK
#undef ATT_PV
#undef ATT_PACK
#undef ATT_VLD
#undef ATT_SM_A
#undef ATT_SM_B
#undef ATT_WORK
#undef ATT_MAX3
    if (MODE != 2) {
        const float lt = swap_sum(lrun);
        if (hi == 0) wsf[32 + r32] = 1.0f / lt;
#pragma unroll
        for (int g = 0; g < 4; ++g) { const f32x4 il = *(const ALAS f32x4*)(wsf + 32 + 8 * g + 4 * hi);
#pragma unroll
            for (int i = 0; i < 4; ++i) { o0[4 * g + i] *= il[i]; o1[4 * g + i] *= il[i]; } }
    }
    {
        ALAS bf16_t* stg = (ALAS bf16_t*)ost;
#pragma unroll
        for (int r = 0; r < 16; ++r) { const int orow = crow(r, hi); stg[orow * 64 + r32] = (bf16_t)(cvtpk(o0[r], 0.f) & 0xffffu); stg[orow * 64 + 32 + r32] = (bf16_t)(cvtpk(o1[r], 0.f) & 0xffffu); }
        AGAS bf16_t* Ow = (AGAS bf16_t*)(P.ws + WS_OALL) + (rb + qlo) * 1024 + C::ocol0 + h * 64;
#pragma unroll
        for (int i = 0; i < 4; ++i) {
            const int row = i * 8 + (lane >> 3), ch = lane & 7;
            const u32x4 v = *(const ALAS u32x4*)(stg + row * 64 + ch * 8);
            float ss = 0.f;
#pragma unroll
            for (int k = 0; k < 4; ++k) { const unsigned w = v[k]; const float a = __uint_as_float(w << 16), c = __uint_as_float(w & 0xffff0000u); ss += a * a + c * c; }
            ss += __shfl_xor(ss, 1); ss += __shfl_xor(ss, 2); ss += __shfl_xor(ss, 4);
            *(AGAS u32x4*)(Ow + (size_t)row * 1024 + ch * 8) = v;
            if (ch == 0) ((AGAS float*)(P.ws + WS_SSQO))[(rb + qlo + row) * 16 + C::hidx0 + h] = ss;
        }
    }
#ifdef ATT_PROF
    if (MODE == 0 && blockIdx.x == 0 && wid == ATT_PROF_WAVE && lane == 0 && prof) { const long long tt = PROF_T() - pf_t0;
        atomicAdd(prof + 0, (unsigned long long)tt); atomicAdd(prof + 1, (unsigned long long)pf_qk); atomicAdd(prof + 2, (unsigned long long)pf_sm); atomicAdd(prof + 3, (unsigned long long)pf_pv); atomicAdd(prof + 4, (unsigned long long)pf_wait); atomicAdd(prof + 5, 1ull); }
#endif
}
#undef ALAS
#undef AGAS
}
struct Args { const void* in[23]; float* out; unsigned char* ws; int ph_lo, ph_hi, li, adapt; };

struct Frame { LAS unsigned char* lds; int wave, vcu, G; };
#define FLANE hw_lane()
#define FTID (F.wave * 64 + hw_lane())

__device__ __forceinline__ float wave_sum64(float v) { return pg8::wave_sum_dpp(v); }

__device__ __forceinline__ void tr_item64(const GAS float* W, int ldn, int K, GAS pg8::bf16_t* WT, int kb, int g, int src0, int src1, const GAS float* kgain, LAS unsigned* scr, int lane) {
    const int k0 = 64 * kb; const int col = lane < 32 ? src0 + lane : src1 + (lane - 32); const bool ok = (lane < 32 ? src0 : src1) >= 0;
    const GAS float* wp = W + (size_t)k0 * ldn + (ok ? col : 0);
#pragma unroll
    for (int hf = 0; hf < 4; ++hf) {
        float v[16];
#pragma unroll
        for (int i = 0; i < 16; ++i) v[i] = wp[(size_t)(hf * 16 + i) * ldn];
#pragma unroll
        for (int i = 0; i < 16; ++i) v[i] = ok ? v[i] : 0.f;
        if (kgain) {
#pragma unroll
            for (int i = 0; i < 16; ++i) v[i] *= kgain[k0 + hf * 16 + i]; }
#pragma unroll
        for (int i = 0; i < 8; ++i) scr[(hf * 8 + i) * 65 + lane] = pk2(v[2 * i], v[2 * i + 1]);
    }
    asm volatile("s_waitcnt lgkmcnt(0)" ::: "memory");
    const int c = lane & 7;
#pragma unroll
    for (int j = 0; j < 8; ++j) { const int n = (lane >> 3) + 8 * j; const LAS unsigned* s = scr + (4 * c) * 65 + n;
        v4u o; o.x = s[0]; o.y = s[65]; o.z = s[130]; o.w = s[195];
        *(GAS v4u*)(WT + (size_t)(64 * g + n) * K + k0 + 8 * c) = o; }
    asm volatile("s_waitcnt lgkmcnt(0)" ::: "memory");
}
__device__ __forceinline__ int in_slot_src(int slot, int& cnt) {
    cnt = 64;
    if (slot < 4) return 64 * slot;
    if (slot < 6) return 256 + 64 * (slot - 4);
    if (slot == 6) { cnt = 32; return 384; }
    if (slot == 7) return -1;
    if (slot < 14) return 416 + 64 * (slot - 8);
    if (slot < 16) return 800 + 64 * (slot - 14);
    if (slot < 18) return 928 + 64 * (slot - 16);
    if (slot < 22) return 1056 + 64 * (slot - 18);
    if (slot < 26) return 1312 + 64 * (slot - 22);
    if (slot < 30) return 1568 + 64 * (slot - 26);
    return -1;
}

#define A_X ((const GAS float*)args.in[0])
#define A_C ((const GAS float*)args.in[1])
#define A_POS ((const GAS int*)args.in[2])
#define A_RELB ((const GAS float*)args.in[3])
#define A_NORMG ((const GAS float*)args.in[4])
#define A_WMOD ((const GAS float*)args.in[5])
#define A_BMOD ((const GAS float*)args.in[6])
#define A_WGU1 ((const GAS float*)args.in[7])
#define A_WD1 ((const GAS float*)args.in[8])
#define A_WIN ((const GAS float*)args.in[9])
#define A_QAN ((const GAS float*)args.in[10])
#define A_KVAN ((const GAS float*)args.in[11])
#define A_WUQ ((const GAS float*)args.in[12])
#define A_WUKV ((const GAS float*)args.in[13])
#define A_MLAQN ((const GAS float*)args.in[14])
#define A_MLAKN ((const GAS float*)args.in[15])
#define A_SWAQN ((const GAS float*)args.in[16])
#define A_SWAKN ((const GAS float*)args.in[17])
#define A_SINKS ((const GAS float*)args.in[18])
#define A_OUTN ((const GAS float*)args.in[19])
#define A_WOUT ((const GAS float*)args.in[20])
#define A_WGU2 ((const GAS float*)args.in[21])
#define A_WD2 ((const GAS float*)args.in[22])
#define WSP(off)   (ws_ + (off))
#define MOD ((GAS float*)WSP(WS_MOD))
#define GS ((GAS float*)WSP(WS_GS))
#define BIAS ((GAS float*)WSP(WS_BIAS))
#define SSQX ((GAS float*)WSP(WS_SSQX))
#define SSQO ((GAS float*)WSP(WS_SSQO))
#define CS ((GAS float*)WSP(WS_CS))
#define KPE ((GAS float*)WSP(WS_KPE))
#define SSQ_CQ ((GAS float*)WSP(WS_SSQC))
#define SSQ_CKV ((GAS float*)WSP(WS_SSQC) + (size_t)MROWS * 4)
#define SSQ_KPE ((GAS float*)WSP(WS_SSQC) + (size_t)MROWS * 6)
#define XB ((GAS pg8::bf16_t*)WSP(WS_XB))
#define HID ((GAS pg8::bf16_t*)WSP(WS_HID))
#define CQ ((GAS pg8::bf16_t*)WSP(WS_CQ))
#define CKV ((GAS pg8::bf16_t*)WSP(WS_CKV))
#define KA ((GAS pg8::bf16_t*)WSP(WS_KA))
#define VA ((GAS pg8::bf16_t*)WSP(WS_VA))
#define QS ((GAS pg8::bf16_t*)WSP(WS_QS))
#define KS ((GAS pg8::bf16_t*)WSP(WS_KS))
#define VS ((GAS pg8::bf16_t*)WSP(WS_VS))
#define QC ((GAS pg8::bf16_t*)WSP(WS_QC))
#define KC ((GAS pg8::bf16_t*)WSP(WS_KC))
#define VC ((GAS pg8::bf16_t*)WSP(WS_VC))
#define OALL ((GAS pg8::bf16_t*)WSP(WS_OALL))
#define QRAW ((GAS float*)WSP(WS_QRAW))

__device__ __forceinline__ int in_group_src(int g32) {
    const int tile = g32 >> 3, rr = g32 & 7, bj = rr >> 2, wc = rr & 3; int cnt; const int base = in_slot_src(tile * 4 + wc, cnt);
    return (base >= 0 && 32 * bj < cnt) ? base + 32 * bj : -1;
}
constexpr int CV_GU = 16 * 88, CV_D = 44 * 16, CV_IN = 16 * 32, CV_UQ = 4 * 12, CV_UKV = 2 * 12, CV_OUT = 16 * 16;
constexpr int CV_EARLY = CV_GU + CV_D + CV_IN + CV_UQ + CV_UKV + CV_OUT, CV_L = CV_EARLY + CV_GU + CV_D, CV_ALL = DEPTH * CV_L;
__device__ __forceinline__ void convert_chunk(Frame& F, const Args& args, int base, int limit) {
    GAS unsigned char* ws_ = (GAS unsigned char*)args.ws; asm volatile("" : "+s"(ws_));
    LAS unsigned* scr = (LAS unsigned*)(F.lds + 16384 + F.wave * 8448);
#pragma unroll 1
    for (int q = 0; q < 2; ++q) {
        const int it = base + F.wave * 2 + q; if (it >= limit) break;
        const int l = it / CV_L; int r = it % CV_L;
        GAS unsigned char* wl = ws_ + WS_W + (size_t)l * WL;
        int kind;
        if (r < CV_GU) kind = 0; else if ((r -= CV_GU) < CV_D) kind = 1; else if ((r -= CV_D) < CV_IN) kind = 2; else if ((r -= CV_IN) < CV_UQ) kind = 3;
        else if ((r -= CV_UQ) < CV_UKV) kind = 4; else if ((r -= CV_UKV) < CV_OUT) kind = 5; else if ((r -= CV_OUT) < CV_GU) kind = 6; else { r -= CV_GU; kind = 7; }
        if (kind == 0 || kind == 6) {
            const bool second = kind == 6; const int kb = r / 88, g = r % 88, t = g >> 2, rr = g & 3, src = (rr >> 1) * DFF + 128 * t + 64 * (rr & 1);
            const GAS float* W = (second ? A_WGU2 : A_WGU1) + (size_t)l * DM * 2 * DFF;
            tr_item64(W, 2 * DFF, DM, (GAS pg8::bf16_t*)(wl + (second ? W_GU2 : W_GU1)), kb, g, src, src + 32, nullptr, scr, FLANE);
        } else if (kind == 1 || kind == 7) { const bool second = kind == 7; const int kb = r / 16, g = r % 16;
            tr_item64((second ? A_WD2 : A_WD1) + (size_t)l * DFF * DM, DM, DFF, (GAS pg8::bf16_t*)(wl + (second ? W_D2 : W_D1)), kb, g, 64 * g, 64 * g + 32, nullptr, scr, FLANE);
        } else if (kind == 2) { const int kb = r / 32, g = r % 32;
            tr_item64(A_WIN + (size_t)l * DM * DIN, DIN, DM, (GAS pg8::bf16_t*)(wl + W_IN), kb, g, in_group_src(2 * g), in_group_src(2 * g + 1), nullptr, scr, FLANE);
        } else if (kind == 3) { const int kb = r / 12, g = r % 12;
            tr_item64(A_WUQ + (size_t)l * 256 * 576, 576, 256, (GAS pg8::bf16_t*)(wl + W_UQ), kb, g, g < 9 ? 64 * g : -1, g < 9 ? 64 * g + 32 : -1, A_QAN + l * 256, scr, FLANE);
        } else if (kind == 4) { const int kb = r / 12, g = r % 12, g0 = 2 * g, g1 = 2 * g + 1;
            tr_item64(A_WUKV + (size_t)l * 128 * 768, 768, 128, (GAS pg8::bf16_t*)(wl + W_UKV), kb, g, 256 * (g0 >> 3) + 64 * (g0 & 3) + 32 * ((g0 & 7) >> 2), 256 * (g1 >> 3) + 64 * (g1 & 3) + 32 * ((g1 & 7) >> 2), A_KVAN + l * 128, scr, FLANE);
        } else { const int kb = r / 16, g = r % 16;
            tr_item64(A_WOUT + (size_t)l * DM * DM, DM, DM, (GAS pg8::bf16_t*)(wl + W_OUT), kb, g, 64 * g, 64 * g + 32, A_OUTN + l * DM, scr, FLANE); }
    }
}

__device__ __forceinline__ void phase_pro0(Frame& F, const Args& args, gu32* qhead) {
    GAS unsigned char* ws_ = (GAS unsigned char*)args.ws; asm volatile("" : "+s"(ws_));
    constexpr int NMU = DEPTH * NMOD / 128;
    if ((int)blockIdx.x < NMU || F.G <= NMU) {
        LAS float* cond = (LAS float*)F.lds;
        LAS float* red = (LAS float*)(F.lds + 8192);
        for (int i = FTID; i < 2 * DM; i += 512) { const float cv = A_C[i]; cond[i] = cv / (1.0f + expf(-cv)); }
        __syncthreads();
        for (int u = blockIdx.x; u < NMU; u += F.G) {
            const int l = u / (NMOD / 128), n0 = (u % (NMOD / 128)) * 128, c4 = FLANE & 31, kp = FLANE >> 5;
            const GAS float* w = A_WMOD + (size_t)l * DM * NMOD + n0 + 4 * c4;
            f32x4 a0 = {0.f, 0.f, 0.f, 0.f}, a1 = {0.f, 0.f, 0.f, 0.f};
#pragma unroll 8
            for (int i = 0; i < 64; ++i) { const int kk = F.wave * 128 + 2 * i + kp; const f32x4 wv = *(const GAS f32x4*)(w + (size_t)kk * NMOD); a0 += wv * cond[kk]; a1 += wv * cond[DM + kk]; }
#pragma unroll
            for (int q = 0; q < 4; ++q) { a0[q] = pg8::xsum32(a0[q]); a1[q] = pg8::xsum32(a1[q]); }
            if (kp == 0) { *(LAS f32x4*)(red + (F.wave * 2 + 0) * 128 + 4 * c4) = a0; *(LAS f32x4*)(red + (F.wave * 2 + 1) * 128 + 4 * c4) = a1; }
            __syncthreads();
            if (FTID < 256) { const int bb = FTID >> 7, ln = FTID & 127; float s = 0.f;
#pragma unroll
                for (int wv = 0; wv < 8; ++wv) s += red[(wv * 2 + bb) * 128 + ln];
                MOD[((size_t)l * 2 + bb) * NMOD + n0 + ln] = s + A_BMOD[(size_t)l * NMOD + n0 + ln]; }
            __syncthreads();
        }
    }
    if ((int)blockIdx.x >= NMU || F.G <= NMU) {
        const int nb = F.G <= NMU ? F.G : F.G - NMU, b0 = F.G <= NMU ? (int)blockIdx.x : (int)blockIdx.x - NMU;
        for (int i = b0 * 512 + FTID; i < MROWS * 16; i += nb * 512) {
            const int m = i >> 4, j = i & 15;
            const float freq = powf(10000.0f, -(float)j / 16.0f);
            const float ang = (float)A_POS[m] * freq;
            CS[(size_t)m * 32 + j] = cosf(ang); CS[(size_t)m * 32 + 16 + j] = sinf(ang);
        }
    }
    {
        LAS int* slot = (LAS int*)(F.lds + 12288);
        for (;;) {
            __syncthreads();
            if (FTID == 0) slot[0] = (int)__hip_atomic_fetch_add(qhead, 16u, __ATOMIC_RELAXED, __HIP_MEMORY_SCOPE_AGENT);
            __syncthreads();
            const int base = slot[0];
            if (base >= CV_EARLY) break;
            convert_chunk(F, args, base, CV_EARLY);
        }
    }
}

__device__ __forceinline__ float gs_clamped(float g, float sc) { const float v = g * (1.0f + sc); return fabsf(v) < 1e-20f ? (v < 0.f ? -1e-20f : 1e-20f) : v; }
__device__ __forceinline__ void x_to_xb(Frame& F, const Args& args, const GAS float* xsrc, int l, int i) {
    GAS unsigned char* ws_ = (GAS unsigned char*)args.ws; asm volatile("" : "+s"(ws_));
    const int gw = F.vcu * NWAVES + F.wave, NGW = F.G * NWAVES;
    for (int m = gw; m < MROWS; m += NGW) {
        const int b = m >> 13;
        const GAS f32x4* xr = (const GAS f32x4*)(xsrc + (size_t)m * DM) + FLANE;
        const GAS f32x4* gr = (const GAS f32x4*)(A_NORMG + ((size_t)l * 3 + i) * DM) + FLANE;
        const GAS f32x4* sr = (const GAS f32x4*)(MOD + ((size_t)l * 2 + b) * NMOD + (3 * i + 1) * DM) + FLANE;
        float s = 0.f;
        GAS unsigned long long* o8 = (GAS unsigned long long*)(XB + (size_t)m * DM) + FLANE;
#pragma unroll
        for (int j = 0; j < 4; ++j) { const f32x4 v = xr[64 * j]; s += (v.x * v.x + v.y * v.y) + (v.z * v.z + v.w * v.w);
            const f32x4 g0 = gr[64 * j], s0 = sr[64 * j]; const f32x4 g = {gs_clamped(g0.x, s0.x), gs_clamped(g0.y, s0.y), gs_clamped(g0.z, s0.z), gs_clamped(g0.w, s0.w)}; const f32x4 y = v * g;
            o8[64 * j] = (unsigned long long)pk2(y.x, y.y) | ((unsigned long long)pk2(y.z, y.w) << 32); }
        s = wave_sum64(s);
        if (FLANE < 16) SSQX[(size_t)m * 16 + FLANE] = (FLANE == 0) ? s : 0.f;
    }
}

__device__ __forceinline__ void bias_rows(Frame& F, const Args& args, bool early) {
    GAS unsigned char* ws_ = (GAS unsigned char*)args.ws; asm volatile("" : "+s"(ws_));
    const int gw = F.vcu * NWAVES + F.wave, NGW = F.G * NWAVES;
    constexpr int RL = 5632 + 2048 + 5632, RE = 5632 + 2048;
    const int lo = early ? 0 : RE, hi = early ? RE : DEPTH * RL;
    for (int it = lo + gw; it < hi; it += NGW) {
        const int l = it / RL; int r = it % RL; int which, nrow; size_t woff; size_t boff;
        if (r < 5632) { which = 0; nrow = 5632; woff = W_GU1; boff = 0; } else if (r < 5632 + 2048) { r -= 5632; which = 1; nrow = 2048; woff = W_IN; boff = 2 * 5632; } else { r -= 5632 + 2048; which = 2; nrow = 5632; woff = W_GU2; boff = 2 * (5632 + 2048); }
        const GAS pg8::bf16_t* wr = (const GAS pg8::bf16_t*)(ws_ + WS_W + (size_t)l * WL + woff) + (size_t)r * DM;
        float a0 = 0.f, a1 = 0.f;
#pragma unroll
        for (int j = 0; j < 2; ++j) {
            const v4u wv = *(const GAS v4u*)(wr + j * 512 + FLANE * 8);
            const GAS float* s0 = MOD + ((size_t)l * 2 + 0) * NMOD + (3 * which) * DM + j * 512 + FLANE * 8; const GAS float* s1 = s0 + NMOD;
#pragma unroll
            for (int k = 0; k < 4; ++k) { const unsigned w = wv[k]; const float lo_ = __uint_as_float(w << 16), hi_ = __uint_as_float(w & 0xffff0000u);
                a0 += lo_ * s0[2 * k] + hi_ * s0[2 * k + 1]; a1 += lo_ * s1[2 * k] + hi_ * s1[2 * k + 1]; }
        }
        a0 = wave_sum64(a0); a1 = wave_sum64(a1);
        if (FLANE == 0) { BIAS[(size_t)l * BIAS_L + boff + r] = a0; BIAS[(size_t)l * BIAS_L + boff + nrow + r] = a1; }
    }
}
__device__ __forceinline__ void phase_pro1(Frame& F, const Args& args) {
    GAS unsigned char* ws_ = (GAS unsigned char*)args.ws; asm volatile("" : "+s"(ws_));
    for (int i = blockIdx.x * 512 + FTID; i < DEPTH * 3 * 2 * DM; i += F.G * 512) {
        const int cidx = i & 1023, b = (i >> 10) & 1, li = i >> 11, l = li / 3, ii = li % 3;
        const float gv_ = gs_clamped(A_NORMG[((size_t)l * 3 + ii) * DM + cidx], MOD[((size_t)l * 2 + b) * NMOD + (3 * ii + 1) * DM + cidx]);
        GS[i] = gv_; ((GAS float*)WSP(WS_IGS))[i] = 1.0f / gv_;
    }
    bias_rows(F, args, true);
    x_to_xb(F, args, A_X, 0, 0);
}

constexpr int RR_OFF = LDSCTL_OFF + 2048;
__device__ __forceinline__ void fill_rr(Frame& F, const Args& args, const pg8::StaticOrder& S) {
    GAS unsigned char* ws_ = (GAS unsigned char*)args.ws; asm volatile("" : "+s"(ws_));
    LAS float* rr = (LAS float*)(F.lds + RR_OFF);
    const GAS float* ssqx = (const GAS float*)(ws_ + WS_SSQX);
    for (int idx = FTID; idx < 6 * 256; idx += 512) {
        pg8::Unit u; if (!S.next(idx >> 8, u)) break;
        const int row = u.pm * 256 + (idx & 255);
        rr[idx] = 1.0f / sqrtf(pg8::sum16f(ssqx + (size_t)row * 16) * (1.0f / 1024.0f) + pg8::RMS_EPS);
    }
    __syncthreads();
}

__device__ __forceinline__ void fill_grp(Frame& F, const pg8::EpiResS<true>& E, const pg8::StaticOrder& S) {
    LAS float* gt = (LAS float*)(F.lds + RR_OFF);
    pg8::Unit u;
    if (S.next(0, u) && FTID < 256) { const int t = FTID; float rA, rB, rC; E.group_r(u.pm * 256 + t, rA, rB, rC); gt[t] = rA / rB; gt[256 + t] = rB / rC; gt[512 + t] = rC; }
    __syncthreads();
}

__device__ __forceinline__ int next_unit(Frame& F, gu32* head) {
    LAS int* slot = (LAS int*)(F.lds + att::L_FLAG);
    __syncthreads();
    if (FTID == 0) slot[0] = (int)__hip_atomic_fetch_add(head, 1u, __ATOMIC_RELAXED, __HIP_MEMORY_SCOPE_AGENT);
    __syncthreads();
    return slot[0];
}

#ifndef DUPS
#define DUPS -1
#endif
#ifndef PHM
#define PHM 255
#endif
#ifndef PHM2
#define PHM2 31
#endif
__global__ void __launch_bounds__(NWAVES * 64, 2) fwd_mega(Args args) {
    extern __shared__ __attribute__((aligned(16))) unsigned char lds[];
    const int wave0 = __builtin_amdgcn_readfirstlane((int)threadIdx.x >> 6);
    Frame F0; F0.lds = (LAS unsigned char*)lds; F0.wave = wave0;
    F0.G = gridDim.x; { const int bx = blockIdx.x; F0.vcu = (F0.G % 8 == 0) ? (bx % 8) * (F0.G / 8) + bx / 8 : bx; }
    gu32* ctl = (gu32*)(args.ws + WS_CTL);
    for (int u = wave0 * 64 + hw_lane(); u < (LDS_BYTES - LDSCTL_OFF) / 4; u += NWAVES * 64) ((LAS unsigned*)(F0.lds + LDSCTL_OFF))[u] = 0u;
    __syncthreads();
    const int lo = args.ph_lo, hi = args.ph_hi;
    XcdBarrier bar; bar.bar = (unsigned*)(ctl + CW_BAR) + args.li * XCD_BAR_WORDS; bar.x = 0; bar.st = nullptr; bar.w0 = wave0;
    if (hi - lo > 1 || true) bar = xcd_barrier_post((unsigned*)(ctl + CW_BAR) + args.li * XCD_BAR_WORDS, (volatile LAS unsigned*)(F0.lds + MISC_OFF) + 8, wave0);

    for (int ph = lo; ph < hi; ++ph) {
        Frame F; F.lds = F0.lds; F.G = F0.G; F.vcu = F0.vcu; F.wave = wave0;
        GAS unsigned char* ws_ = (GAS unsigned char*)args.ws; asm volatile("" : "+s"(ws_));
        int nrep = 1;
        if (DUPS >= 0) { const int ty = ph < 2 ? 8 + ph : ((ph - 2) & 7); if (ty == DUPS && !(ty == 5) && !((ty == 1 || ty == 7) && ph != 3)) nrep = 2; }
        for (int rep = 0; rep < nrep; ++rep) {
        if ((PHM & 64) && ph == 0) phase_pro0(F, args, ctl + CW_Q + 64 * 8);
        else if ((PHM & 128) && ph == 1) phase_pro1(F, args);
        else {
            const int l = (ph - 2) >> 3, s = (ph - 2) & 7;
            const GAS unsigned char* wl = ws_ + WS_W + (size_t)l * WL;
            const GAS float* biasl = BIAS + (size_t)l * BIAS_L;
            const GAS float* modl = MOD + (size_t)l * 2 * NMOD;
            if ((PHM & 1) && (s == 0 || s == 6)) {
                pg8::Gemm g{(const pg8::bf16_t*)XB, (const pg8::bf16_t*)(wl + (s == 0 ? W_GU1 : W_GU2)), MROWS, 5632, DM}; pg8::StaticOrder S; S.init(MROWS, 5632, F.G, (int)blockIdx.x);
                fill_rr(F, args, S);
                pg8::EpiUp E{ws_, biasl + (s == 0 ? 0 : 2 * (5632 + 2048)), (const LAS float*)(F.lds + RR_OFF)};
                pg8::gemm_phase<pg8::EpiUp, pg8::StaticOrder, true, true>(F.lds, g, S, E, F.wave);
            } else if ((PHM & 2) && (s == 1 || s == 7)) {
                pg8::Gemm g{(const pg8::bf16_t*)HID, (const pg8::bf16_t*)(wl + (s == 1 ? W_D1 : W_D2)), MROWS, DM, DFF}; pg8::StaticOrder S; S.init(MROWS, DM, F.G, (int)blockIdx.x);
                const bool lastp = (s == 7 && l == DEPTH - 1);
                const GAS float* gsn = lastp ? nullptr : (s == 1 ? GS + ((size_t)(l * 3 + 1) * 2) * DM : GS + ((size_t)((l + 1) * 3 + 0) * 2) * DM);
                const GAS float* igp = (const GAS float*)WSP(WS_IGS) + ((size_t)(l * 3 + (s == 1 ? 0 : 2)) * 2) * DM;
                pg8::EpiResS<false> E{(GAS float*)args.out, ws_, modl + (s == 1 ? 2 : 8) * DM, igp, gsn, 0.5f, nullptr}; pg8::gemm_phase<pg8::EpiResS<false>, pg8::StaticOrder, false, true>(F.lds, g, S, E, F.wave, (unsigned long long*)(ctl + CW_Q + 64 * 13));
            } else if ((PHM & 4) && s == 2) {
                pg8::Gemm g{(const pg8::bf16_t*)XB, (const pg8::bf16_t*)(wl + W_IN), MROWS, 2048, DM}; pg8::StaticOrder S; S.init(MROWS, 2048, F.G, (int)blockIdx.x);
                fill_rr(F, args, S);
                pg8::EpiIn E{ws_, A_SWAQN + l * 64, A_SWAKN + l * 64, biasl + 2 * 5632, (const LAS float*)(F.lds + RR_OFF)};
                pg8::gemm_phase<pg8::EpiIn, pg8::StaticOrder, true, true>(F.lds, g, S, E, F.wave);
            } else if ((PHM & 8) && s == 3) {
                if (PHM2 & 1) { pg8::Gemm g{(const pg8::bf16_t*)CQ, (const pg8::bf16_t*)(wl + W_UQ), MROWS, 768, 256}; pg8::StaticOrder S; S.init(MROWS, 768, F.G, (int)blockIdx.x);
                  pg8::EpiUq E{ws_}; pg8::gemm_phase<pg8::EpiUq, pg8::StaticOrder, true, true>(F.lds, g, S, E, F.wave); }
                if (PHM2 & 2) { pg8::Gemm g{(const pg8::bf16_t*)CKV, (const pg8::bf16_t*)(wl + W_UKV), MROWS, 768, 128}; pg8::StaticOrder S; S.init(MROWS, 768, F.G, (int)((blockIdx.x + 64) % F.G));
                  pg8::EpiUkv E{ws_, A_MLAKN + l * 96}; pg8::gemm_phase<pg8::EpiUkv, pg8::StaticOrder, true, true>(F.lds, g, S, E, F.wave); }
            } else if ((PHM & 16) && s == 4) {
                att::AttnP PA{ws_, A_MLAQN + l * 96, nullptr, nullptr, nullptr};
                att::AttnP PB{ws_, nullptr, A_POS, A_SINKS + l * 6, A_RELB};
                att::AttnP PC{ws_, nullptr, nullptr, nullptr, nullptr};
                gu32* head = ctl + CW_Q + 64 * (2 * l + 1 + 4 * rep);
                for (;;) { const int u = next_unit(F, head); if (u >= 384 + 256 + 384) break;
                    if ((PHM2 & 16) && u < 384) { const int qb = 31 - u / 12, bh = u % 12;
                        att::attn_unit<96, 0>(F.lds, PA, bh / 6, bh % 6, qb, F.wave, (unsigned long long*)(ctl + CW_Q + 64 * 12)); }

                    else if ((PHM2 & 4) && u >= 384 && u < 640) { const int v = u - 384, qb = 31 - (v >> 3), bh = v & 7; att::attn_unit<64, 2>(F.lds, PC, bh >> 2, bh & 3, qb, F.wave); }
                    else if ((PHM2 & 8) && u >= 640) { const int v = u - 640, qb = v / 12, bh = v % 12; att::attn_unit<64, 1>(F.lds, PB, bh / 6, bh % 6, qb, F.wave); } }
                if (l == 0 && rep == 0) {
                    gu32* chead = ctl + CW_Q + 64 * 9; LAS int* cslot = (LAS int*)(F.lds + 12288);
                    for (;;) { __syncthreads(); if (FTID == 0) cslot[0] = (int)__hip_atomic_fetch_add(chead, 16u, __ATOMIC_RELAXED, __HIP_MEMORY_SCOPE_AGENT); __syncthreads();
                        const int cb = CV_EARLY + cslot[0]; if (cb >= CV_ALL) break; convert_chunk(F, args, cb, CV_ALL); } }
            } else if ((PHM & 32) && s == 5) {
                if (l == 0 && rep == 0) { bias_rows(F, args, false); asm volatile("s_waitcnt vmcnt(0)" ::: "memory"); __syncthreads(); }
                pg8::Gemm g{(const pg8::bf16_t*)OALL, (const pg8::bf16_t*)(wl + W_OUT), MROWS, DM, DM}; pg8::StaticOrder S; S.init(MROWS, DM, F.G, (int)blockIdx.x);
                pg8::EpiResS<true> E{(GAS float*)args.out, ws_, modl + 5 * DM, (const GAS float*)WSP(WS_IGS) + ((size_t)(l * 3 + 1) * 2) * DM, GS + ((size_t)(l * 3 + 2) * 2) * DM, 1.0f, (const LAS float*)(F.lds + RR_OFF)}; fill_grp(F, E, S); pg8::gemm_phase<pg8::EpiResS<true>, pg8::StaticOrder, false, true>(F.lds, g, S, E, F.wave);
            }
        }
        if (rep + 1 < nrep) xcd_barrier(bar);
        }
        if (ph + 1 < hi) xcd_barrier(bar);
    }
#ifdef GEMM_PROF
    xcd_barrier(bar);
    if (blockIdx.x == 0 && threadIdx.x == 0) { const unsigned long long* st = (const unsigned long long*)(ctl + CW_Q + 64 * 13); double sh;
        if (GEMM_PROF == 0) sh = (double)st[1] / (double)(st[0] + st[1]);
        else if (GEMM_PROF == 1) sh = (double)st[0] / (double)st[2] / 1.0e6;
        else sh = (double)st[1] / (double)st[2] / 1.0e6;
        args.out[0] += (float)(0.04 + 0.18 * (sh > 1.0 ? 1.0 : sh)); }
#endif
#ifdef ATT_PROF
    xcd_barrier(bar);
    if (blockIdx.x == 0 && threadIdx.x == 0) { const unsigned long long* st = (const unsigned long long*)(ctl + CW_Q + 64 * 12);
        const double tot = (double)st[0]; double sh = 0.0;
        if (ATT_PROF == 0) sh = (double)st[0] / (double)st[5] / 1.0e6;
        else if (ATT_PROF == 5) sh = (double)st[0] / (double)st[6] / 1.0e4;
        else if (ATT_PROF == 6) sh = (double)st[6] / 1.0e3;
        else sh = (double)st[ATT_PROF] / tot;
        args.out[0] += (float)(0.04 + 0.18 * (sh > 1.0 ? 1.0 : sh)); }
#endif
}
static void launch_fwd(hipStream_t stream, Args a, int grid, int lo, int hi, int li, int adapt) {
    a.ph_lo = lo; a.ph_hi = hi; a.li = li; a.adapt = adapt;
    hipLaunchKernelGGL(fwd_mega, dim3(grid), dim3(NWAVES * 64), LDS_BYTES, stream, a);
}
extern "C" void kernel_launch(void* const* d_in, const int* in_sizes, int n_in, void* d_out, int out_size, void* d_ws, size_t ws_size, hipStream_t stream) {
    static int grid = 0;
    if (grid == 0) {
        if (n_in != 23 || out_size != MROWS * DM || ws_size < WS_END) { fprintf(stderr, "kernel_launch: unexpected problem (n_in %d, out %d, ws %zu < %zu)\n", n_in, out_size, ws_size, (size_t)WS_END); grid = -1; return; }
        int dev = 0, cus = 0, per_cu = 0;
        if (hipGetDevice(&dev) != hipSuccess || hipDeviceGetAttribute(&cus, hipDeviceAttributeMultiprocessorCount, dev) != hipSuccess) { grid = -1; return; }
        if (hipFuncSetAttribute((const void*)fwd_mega, hipFuncAttributeMaxDynamicSharedMemorySize, LDS_BYTES) != hipSuccess) { fprintf(stderr, "kernel_launch: hipFuncSetAttribute failed\n"); grid = -1; return; }
        if (hipOccupancyMaxActiveBlocksPerMultiprocessor(&per_cu, (const void*)fwd_mega, NWAVES * 64, LDS_BYTES) != hipSuccess || per_cu < 1) { fprintf(stderr, "kernel_launch: occupancy query says %d blocks per CU\n", per_cu); (void)hipGetLastError(); grid = -1; return; }
        if (cus < 256) { fprintf(stderr, "kernel_launch: built for a 256-CU device (the one-unit-per-workgroup GEMM phases need exactly 256 workgroups), found %d CUs\n", cus); grid = -1; return; }
        grid = 256;
    }
    if (grid < 0) return;
    (void)hipMemsetAsync((char*)d_ws + WS_CTL, 0, CTL_ZERO_BYTES, stream);
    Args a{};
    for (int i = 0; i < 23; ++i) a.in[i] = d_in[i];
    a.out = (float*)d_out; a.ws = (unsigned char*)d_ws;
#ifdef PFX
    launch_fwd(stream, a, grid, 0, PFX, 0, -1);
    (void)hipMemsetAsync((char*)d_ws + WS_CTL, 0, CTL_ZERO_BYTES, stream);
#endif
    launch_fwd(stream, a, grid, 0, NPH, 0, -1);
}
```

```cpp
#include <hip/hip_runtime.h>
#include <cstdio>
#include <cstdint>
#include <cmath>
constexpr int NWAVES = 8;
constexpr int BATCH = 2, SEQ = 8192, DM = 1024, DEPTH = 2, MROWS = BATCH * SEQ;
constexpr int DFF = 2816, DIN = 1824, NMOD = 9 * DM;
constexpr int NPH = 2 + 8 * DEPTH;
constexpr size_t MiB = 1u << 20;
constexpr size_t WS_CTL = 0, CTL_ZERO_BYTES = 256 * 1024;
constexpr size_t WS_MOD = 1 * MiB;
constexpr size_t WS_GS = WS_MOD + 160 * 1024;
constexpr size_t WS_IGS = WS_GS + 64 * 1024;
constexpr size_t WS_BIAS = WS_IGS + 64 * 1024;
constexpr size_t BIAS_L = 2 * (5632 + 2048 + 5632);
constexpr size_t WS_SSQX = 2 * MiB;
constexpr size_t WS_SSQO = 3 * MiB;
constexpr size_t WS_CS = 4 * MiB;
constexpr size_t WS_KPE = 6 * MiB;
constexpr size_t WS_SSQC = 8 * MiB;
constexpr size_t WS_W = 9 * MiB;
constexpr size_t W_GU1 = 0, W_D1 = W_GU1 + (size_t)5632 * 1024 * 2, W_IN = W_D1 + (size_t)1024 * 2816 * 2, W_UQ = W_IN + (size_t)2048 * 1024 * 2, W_UKV = W_UQ + (size_t)768 * 256 * 2,
                 W_OUT = W_UKV + (size_t)768 * 128 * 2, W_GU2 = W_OUT + (size_t)1024 * 1024 * 2, W_D2 = W_GU2 + (size_t)5632 * 1024 * 2, WL = W_D2 + (size_t)1024 * 2816 * 2;
constexpr size_t WS_XB = WS_W + ((2 * WL + MiB - 1) / MiB) * MiB;
constexpr size_t WS_ACT = WS_XB + 32 * MiB;
constexpr size_t WS_HID = WS_ACT;
constexpr size_t WS_CQ = WS_ACT, WS_CKV = WS_CQ + 8 * MiB, WS_QRAW = WS_CKV + 4 * MiB, WS_KA = WS_QRAW + 36 * MiB, WS_VA = WS_KA + 18 * MiB, WS_QS = WS_VA + 12 * MiB, WS_KS = WS_QS + 12 * MiB,
                 WS_VS = WS_KS + 4 * MiB, WS_QC = WS_VS + 4 * MiB, WS_KC = WS_QC + 8 * MiB, WS_VC = WS_KC + 8 * MiB, WS_OALL = WS_VC + 8 * MiB, WS_END = WS_OALL + 32 * MiB;
static_assert(WS_HID + (size_t)MROWS * DFF * 2 <= WS_END, "d_ws map");
constexpr int CW_BAR = 4096;
constexpr int CW_Q = 40960;
static_assert((CW_Q + 64 * 14) * 4 <= (int)CTL_ZERO_BYTES && CW_BAR + 8 * 3456 <= CW_Q, "ctl map");
constexpr int RING_BYTES = 131072, LDSCTL_OFF = RING_BYTES, MISC_OFF = LDSCTL_OFF + 320, LDS_BYTES = 147456;

__device__ __forceinline__ int hw_lane() { int l; asm volatile("v_mbcnt_lo_u32_b32 %0, -1, 0\n\tv_mbcnt_hi_u32_b32 %0, -1, %0" : "=v"(l)); return l; }
namespace pg8 {
#define PG8_LAS __attribute__((address_space(3)))
typedef unsigned short bf16_t;
typedef short bf16x8 __attribute__((ext_vector_type(8)));
typedef float f32x4 __attribute__((ext_vector_type(4)));
typedef unsigned u32x4 __attribute__((ext_vector_type(4)));
constexpr int BM = 256, BK = 64, HALF = 128, HTB = HALF * BK * 2  , STAGE_BYTES = 8 * HTB, NXCD = 8, WGM = 8;

__host__ __device__ __forceinline__ int lds_byte(int r, int c) { const int st = (r >> 4) * 2 + (c >> 5), rr = r & 15, cc = c & 31, ob = rr * 64 + cc * 2; return st * 1024 + (ob ^ (((ob >> 9) & 1) << 5)); }
__host__ __device__ __forceinline__ void stage_rc(int b, int& R, int& C) { const int st = b / 1024, sb = b % 1024, swz = sb ^ (((sb >> 9) & 1) << 5); R = (st >> 1) * 16 + swz / 64; C = (st & 1) * 32 + (swz % 64) / 2; }
__host__ __device__ __forceinline__ int perm32(int rho) { const int n = rho >> 4, i = rho & 15; return 8 * (i >> 2) + 4 * n + (i & 3); }

struct Unit { int pm, pn, ord; };
struct Gemm { const bf16_t* A; const bf16_t* Bt; int M, N, K; };

struct StaticOrder {
    int nM, nN, nwg, G, c;
    __host__ __device__ void init(int M, int N, int G_, int c_) { nM = M / BM; nN = N / BM; nwg = nM * nN; G = G_; c = c_; }
    __host__ __device__ bool next(int i, Unit& u) const {
        const long L = (long)i * G + c; if (L >= nwg) return false;
        int wgid = (int)L; { const int q = nwg / NXCD, r = nwg % NXCD, xcd = wgid % NXCD, off = wgid / NXCD; wgid = (xcd < r ? xcd * (q + 1) : r * (q + 1) + (xcd - r) * q) + off; }
        const int nig = WGM * nN, gid = wgid / nig, fm = gid * WGM, gsz = (nM - fm) < WGM ? (nM - fm) : WGM;
        u.pm = fm + ((wgid % nig) % gsz); u.pn = (wgid % nig) / gsz; u.ord = i; return true;
    }
    __device__ __forceinline__ void a_ready(const Unit&) const {}
    __device__ __forceinline__ void done(const Unit&) const {}
};

__device__ __forceinline__ unsigned cvt_pk_bf16(float lo, float hi) { unsigned r; asm volatile("v_cvt_pk_bf16_f32 %0, %1, %2" : "=v"(r) : "v"(lo), "v"(hi)); return r; }
typedef float f32x2 __attribute__((ext_vector_type(2)));
template <class Epi, class Sched, bool ALIGN_EPI = false, bool SP2 = false>
__device__ __forceinline__ void gemm_phase(PG8_LAS unsigned char* lds, const Gemm g, const Sched& S, const Epi& E, int wave0, unsigned long long* gprof = nullptr) {
#ifdef GEMM_PROF
    const long long gp_t0 = (Epi::AFTER_DRAIN && !Epi::HOOK && blockIdx.x == 0) ? (long long)clock64() : 0ll;
#endif
    int tid_ = wave0 * 64 + hw_lane(); asm volatile("" : "+v"(tid_));
    const int tid = tid_, wid = __builtin_amdgcn_readfirstlane(tid >> 6), lane = tid & 63, wr = wid >> 2, wc = wid & 3, fr = lane & 15, fq = lane >> 4;
    int K_ = g.K; asm volatile("" : "+s"(K_));
    const int K = K_, nt = K / BK;
    unsigned voffA[2], voffB[2];
#pragma unroll
    for (int i = 0; i < 2; ++i) { int R, C; stage_rc(tid * 16 + i * 8192, R, C); const int Rb = Epi::PERM ? ((R & ~31) + perm32(R & 31)) : R;
        voffA[i] = (unsigned)(R * K + C) * 2u; voffB[i] = (unsigned)(Rb * K + C) * 2u; }
    const size_t kstep = (size_t)(BK * 2);
    const size_t hstep = (size_t)HALF * K * 2;
    const size_t tstep = 2 * hstep;
    const unsigned ldsw = (unsigned)wid * 1024u;
    const int aoff = lds_byte(wr * 64 + fr, fq * 8), boff = lds_byte(wc * 32 + fr, fq * 8);
#define PG8_SA(b, h) (((b) * 2 + (h)) * HTB)
#define PG8_SB(b, h) ((4 + (b) * 2 + (h)) * HTB)
#define PG8_STAGE(bufoff, gbase, voff) do { _Pragma("unroll") for (int _i = 0; _i < 2; ++_i) \
        __builtin_amdgcn_global_load_lds((const unsigned*)((const char*)(gbase) + (voff)[_i]), (PG8_LAS unsigned*)(lds + (bufoff) + ldsw + _i * 8192), 16, 0, 0); } while (0)
#define PG8_LDA(dst, b, h) do { _Pragma("unroll") for (int m = 0; m < 4; ++m) _Pragma("unroll") for (int k = 0; k < 2; ++k) dst[m][k] = *(const PG8_LAS bf16x8*)(lds + PG8_SA(b, h) + aoff + m * 2048 + k * 1024); } while (0)
#define PG8_LDB(dst, b, h) do { _Pragma("unroll") for (int n = 0; n < 2; ++n) _Pragma("unroll") for (int k = 0; k < 2; ++k) dst[n][k] = *(const PG8_LAS bf16x8*)(lds + PG8_SB(b, h) + boff + n * 2048 + k * 1024); } while (0)
#define PG8_MMA(ai, bj, At, Bt) do { __builtin_amdgcn_s_setprio(1); _Pragma("unroll") for (int m = 0; m < 4; ++m) _Pragma("unroll") for (int n = 0; n < 2; ++n) _Pragma("unroll") for (int k = 0; k < 2; ++k) \
        acc[ai][bj][m][n] = __builtin_amdgcn_mfma_f32_16x16x32_bf16(Bt[n][k], At[m][k], acc[ai][bj][m][n], 0, 0, 0); __builtin_amdgcn_s_setprio(0); } while (0)
#define PG8_WAIT_V(n) asm volatile("s_waitcnt vmcnt(" #n ")" ::: "memory")
#define PG8_WAIT_L(n) asm volatile("s_waitcnt lgkmcnt(" #n ")" ::: "memory")
#define PG8_BAR __builtin_amdgcn_s_barrier()
#define PG8_SCHED __builtin_amdgcn_sched_barrier(0)
    Unit cur, nxt; int ui = 0;
    if (!S.next(0, cur)) return;
    f32x4 acc[2][2][4][2];
#pragma unroll
    for (int a = 0; a < 2; ++a)
#pragma unroll
        for (int b = 0; b < 2; ++b)
#pragma unroll
            for (int m = 0; m < 4; ++m)
#pragma unroll
                for (int n = 0; n < 2; ++n) acc[a][b][m][n] = (f32x4){0.f, 0.f, 0.f, 0.f};
    bf16x8 At[4][2], B0[2][2], B1[2][2];
    const char* cA = (const char*)g.A + (size_t)cur.pm * tstep; const char* cB = (const char*)g.Bt + (size_t)cur.pn * tstep;
    S.a_ready(cur);
    if constexpr (SP2) {
        PG8_STAGE(PG8_SB(0, 0), cB, voffB); PG8_STAGE(PG8_SB(0, 1), cB + hstep, voffB); PG8_STAGE(PG8_SA(0, 0), cA, voffA); PG8_STAGE(PG8_SA(0, 1), cA + hstep, voffA);
        if (wr == 1) PG8_BAR;
        PG8_WAIT_V(2); PG8_BAR;
        PG8_STAGE(PG8_SB(1, 0), cB + kstep, voffB); PG8_STAGE(PG8_SA(1, 0), cA + kstep, voffA); PG8_STAGE(PG8_SB(1, 1), cB + hstep + kstep, voffB);
        PG8_WAIT_V(6); PG8_BAR;
    } else {
        PG8_STAGE(PG8_SB(0, 0), cB, voffB); PG8_STAGE(PG8_SA(0, 0), cA, voffA); PG8_STAGE(PG8_SB(0, 1), cB + hstep, voffB); PG8_STAGE(PG8_SA(0, 1), cA + hstep, voffA);
        if (wr == 1) PG8_BAR;
        PG8_WAIT_V(4); PG8_BAR;
        PG8_STAGE(PG8_SB(1, 0), cB + kstep, voffB); PG8_STAGE(PG8_SA(1, 0), cA + kstep, voffA); PG8_STAGE(PG8_SB(1, 1), cB + hstep + kstep, voffB);
        PG8_WAIT_V(6); PG8_BAR;
    }
    for (;;) {
        const bool has_next = S.next(ui + 1, nxt);
        const char* nA = has_next ? (const char*)g.A + (size_t)nxt.pm * tstep : cA; const char* nB = has_next ? (const char*)g.Bt + (size_t)nxt.pn * tstep : cB;
#pragma nounroll
        for (int t = 0; t < nt; t += 2) {
            if constexpr (Epi::HOOK) E.hook(acc, cur, t, wr, wc, fr, fq);
            const bool last = (t == nt - 2);
            const char* a1 = cA + (size_t)(t + 1) * kstep;
            const char* a2 = last ? nA : cA + (size_t)(t + 2) * kstep; const char* b2 = last ? nB : cB + (size_t)(t + 2) * kstep;
            const char* a3 = a2 + kstep; const char* b3 = b2 + kstep;
            if (last && has_next) S.a_ready(nxt);
            if constexpr (SP2) {
            PG8_LDB(B0, 0, 0); PG8_LDB(B1, 0, 1); PG8_SCHED; PG8_LDA(At, 0, 0); PG8_STAGE(PG8_SA(1, 1), a1 + hstep, voffA);
            PG8_WAIT_V(8); PG8_WAIT_L(0); PG8_BAR; PG8_MMA(0, 0, At, B0); PG8_MMA(0, 1, At, B1); PG8_BAR; PG8_SCHED;
            PG8_LDA(At, 0, 1); PG8_STAGE(PG8_SB(0, 0), b2, voffB); PG8_STAGE(PG8_SB(0, 1), b2 + hstep, voffB); PG8_STAGE(PG8_SA(0, 0), a2, voffA);
            PG8_WAIT_V(8); PG8_WAIT_L(0); PG8_BAR; PG8_MMA(1, 0, At, B0); PG8_MMA(1, 1, At, B1); PG8_BAR; PG8_SCHED;
            PG8_LDB(B0, 1, 0); PG8_LDB(B1, 1, 1); PG8_SCHED; PG8_LDA(At, 1, 0); PG8_STAGE(PG8_SA(0, 1), a2 + hstep, voffA);
            PG8_WAIT_V(8); PG8_WAIT_L(0); PG8_BAR; PG8_MMA(0, 0, At, B0); PG8_MMA(0, 1, At, B1); PG8_BAR; PG8_SCHED;
            PG8_LDA(At, 1, 1); PG8_STAGE(PG8_SB(1, 0), b3, voffB); PG8_STAGE(PG8_SB(1, 1), b3 + hstep, voffB); PG8_STAGE(PG8_SA(1, 0), a3, voffA);
            PG8_WAIT_V(8); PG8_WAIT_L(0); PG8_BAR; PG8_MMA(1, 0, At, B0); PG8_MMA(1, 1, At, B1); PG8_BAR; PG8_SCHED;
            } else {
            PG8_LDB(B0, 0, 0); PG8_SCHED; PG8_LDA(At, 0, 0); PG8_STAGE(PG8_SA(1, 1), a1 + hstep, voffA);
            PG8_WAIT_L(8); PG8_BAR; PG8_WAIT_L(0); PG8_MMA(0, 0, At, B0); PG8_BAR; PG8_SCHED;
            PG8_LDB(B1, 0, 1); PG8_STAGE(PG8_SB(0, 0), b2, voffB);
            PG8_BAR; PG8_WAIT_L(0); PG8_MMA(0, 1, At, B1); PG8_BAR;
            PG8_LDA(At, 0, 1); PG8_STAGE(PG8_SA(0, 0), a2, voffA);
            PG8_BAR; PG8_WAIT_L(0); PG8_MMA(1, 0, At, B0); PG8_BAR; PG8_SCHED;
            PG8_STAGE(PG8_SB(0, 1), b2 + hstep, voffB);
            PG8_WAIT_V(6); PG8_BAR; PG8_MMA(1, 1, At, B1); PG8_BAR;
            PG8_LDB(B0, 1, 0); PG8_SCHED; PG8_LDA(At, 1, 0); PG8_STAGE(PG8_SA(0, 1), a2 + hstep, voffA);
            PG8_WAIT_L(8); PG8_BAR; PG8_WAIT_L(0); PG8_MMA(0, 0, At, B0); PG8_BAR; PG8_SCHED;
            PG8_LDB(B1, 1, 1); PG8_STAGE(PG8_SB(1, 0), b3, voffB);
            PG8_BAR; PG8_WAIT_L(0); PG8_MMA(0, 1, At, B1); PG8_BAR;
            PG8_LDA(At, 1, 1); PG8_STAGE(PG8_SA(1, 0), a3, voffA);
            PG8_BAR; PG8_WAIT_L(0); PG8_MMA(1, 0, At, B0); PG8_BAR; PG8_SCHED;
            PG8_STAGE(PG8_SB(1, 1), b3 + hstep, voffB);
            PG8_WAIT_V(6); PG8_BAR; PG8_MMA(1, 1, At, B1); PG8_BAR;
            }
        }
        if constexpr (ALIGN_EPI) { if (wr == 0) PG8_BAR; }
        if constexpr (!Epi::AFTER_DRAIN) {
            Unit ce = cur; asm volatile("" : "+s"(ce.pm), "+s"(ce.pn), "+s"(ce.ord)); int fre = fr, fqe = fq; asm volatile("" : "+v"(fre), "+v"(fqe));
            E(acc, ce, wr, wc, fre, fqe); S.done(cur); }
        if (!has_next) break;
#pragma unroll
        for (int a = 0; a < 2; ++a)
#pragma unroll
            for (int b = 0; b < 2; ++b)
#pragma unroll
                for (int m = 0; m < 4; ++m)
#pragma unroll
                    for (int n = 0; n < 2; ++n) acc[a][b][m][n] = (f32x4){0.f, 0.f, 0.f, 0.f};
        cur = nxt; cA = nA; cB = nB; ++ui;
        if constexpr (ALIGN_EPI) { if (wr == 1) PG8_BAR; }
    }
    PG8_WAIT_V(0);
    if constexpr (!ALIGN_EPI) { if (wr == 0) PG8_BAR; }
    PG8_BAR;
#ifdef GEMM_PROF
    const long long gp_t1 = (Epi::AFTER_DRAIN && !Epi::HOOK && blockIdx.x == 0) ? (long long)clock64() : 0ll;
#endif
    if constexpr (Epi::AFTER_DRAIN) { E.fused(acc, cur, wr, wc, fr, fq, lds, wid, lane); S.done(cur); }
#ifdef GEMM_PROF
    if (Epi::AFTER_DRAIN && !Epi::HOOK && blockIdx.x == 0 && tid == 0 && gprof) { const long long gp_t2 = clock64(); atomicAdd(gprof + 0, (unsigned long long)(gp_t1 - gp_t0)); atomicAdd(gprof + 1, (unsigned long long)(gp_t2 - gp_t1)); atomicAdd(gprof + 2, 1ull); }
#endif
#undef PG8_SA
#undef PG8_SB
#undef PG8_STAGE
#undef PG8_LDA
#undef PG8_LDB
#undef PG8_MMA
#undef PG8_WAIT_V
#undef PG8_WAIT_L
#undef PG8_BAR
#undef PG8_SCHED
}
constexpr float RMS_EPS = 1e-6f;
constexpr int MROWS_ = 16384;
constexpr float LOG2E = 1.4426950408889634f;
typedef unsigned u32x2 __attribute__((ext_vector_type(2)));
#define PG8_FENCE() asm volatile("" ::: "memory")
#define PG8_G __attribute__((address_space(1)))
__device__ __forceinline__ float sum16f(const PG8_G float* p) {
    const f32x4 a = *(const PG8_G f32x4*)p, b = *(const PG8_G f32x4*)(p + 4), c = *(const PG8_G f32x4*)(p + 8), d = *(const PG8_G f32x4*)(p + 12);
    return ((a[0] + a[1]) + (a[2] + a[3])) + ((b[0] + b[1]) + (b[2] + b[3])) + ((c[0] + c[1]) + (c[2] + c[3])) + ((d[0] + d[1]) + (d[2] + d[3]));
}
__device__ __forceinline__ float xsum16(float x) { auto r = __builtin_amdgcn_permlane16_swap(__float_as_uint(x), __float_as_uint(x), false, false); return __uint_as_float(r[0]) + __uint_as_float(r[1]); }
__device__ __forceinline__ float xsum32(float x) { auto r = __builtin_amdgcn_permlane32_swap(__float_as_uint(x), __float_as_uint(x), false, false); return __uint_as_float(r[0]) + __uint_as_float(r[1]); }
__device__ __forceinline__ float wave_sum_dpp(float x) {
    x += __builtin_bit_cast(float, __builtin_amdgcn_update_dpp(0, __builtin_bit_cast(int, x), 0xB1, 0xf, 0xf, true));
    x += __builtin_bit_cast(float, __builtin_amdgcn_update_dpp(0, __builtin_bit_cast(int, x), 0x4E, 0xf, 0xf, true));
    x += __builtin_bit_cast(float, __builtin_amdgcn_update_dpp(0, __builtin_bit_cast(int, x), 0x141, 0xf, 0xf, true));
    x += __builtin_bit_cast(float, __builtin_amdgcn_update_dpp(0, __builtin_bit_cast(int, x), 0x140, 0xf, 0xf, true));
    return xsum32(xsum16(x));
}
__device__ __forceinline__ float fast_rcp(float x) { return __builtin_amdgcn_rcpf(x); }
__device__ __forceinline__ float silu_fast(float g) { return g * fast_rcp(1.0f + __builtin_amdgcn_exp2f(-g * LOG2E)); }
__device__ __forceinline__ float sq4(const f32x4 v) { return (v[0] * v[0] + v[1] * v[1]) + (v[2] * v[2] + v[3] * v[3]); }

struct EpiUp {
    static constexpr bool PERM = true, AFTER_DRAIN = false, HOOK = false;
    PG8_G unsigned char* ws; const PG8_G float* bias; const PG8_LAS float* rr;
    __device__ __forceinline__ void hook(f32x4 (&)[2][2][4][2], const Unit&, int, int, int, int, int) const {}
    __device__ __forceinline__ void operator()(const f32x4 (&acc)[2][2][4][2], const Unit& u, int wr, int wc, int fr, int fq) const {
        PG8_G bf16_t* HID = (PG8_G bf16_t*)(ws + WS_HID); const PG8_LAS float* rt = rr + u.ord * BM + wr * 64 + fr;
        const PG8_LAS float* bb = rr + 6 * BM + u.ord * BM + wc * 32 + 8 * fq;
        f32x4 bg[2], bu[2];
#pragma unroll
        for (int n = 0; n < 2; ++n) { bg[n] = *(const PG8_LAS f32x4*)(bb + 4 * n); bu[n] = *(const PG8_LAS f32x4*)(bb + HALF + 4 * n); }
#pragma unroll
        for (int ai = 0; ai < 2; ++ai)
#pragma unroll
            for (int m = 0; m < 4; ++m) {
                const int row = u.pm * BM + ai * HALF + wr * 64 + m * 16 + fr;
                const float r = rt[ai * HALF + m * 16];
                float hv[8];
#pragma unroll
                for (int n = 0; n < 2; ++n)
#pragma unroll
                    for (int i = 0; i < 4; ++i) { const float g = acc[ai][0][m][n][i] * r + bg[n][i], uu = acc[ai][1][m][n][i] * r + bu[n][i]; hv[4 * n + i] = silu_fast(g) * uu; }
                u32x4 w; w.x = cvt_pk_bf16(hv[0], hv[1]); w.y = cvt_pk_bf16(hv[2], hv[3]); w.z = cvt_pk_bf16(hv[4], hv[5]); w.w = cvt_pk_bf16(hv[6], hv[7]);
                *(PG8_G u32x4*)(HID + (size_t)row * 2816 + u.pn * HALF + wc * 32 + 8 * fq) = w;
            }
    }
};

template <bool HOOKED> struct EpiResS {
    static constexpr bool PERM = false, AFTER_DRAIN = true, HOOK = HOOKED;
    PG8_G float* fout; PG8_G unsigned char* ws; const PG8_G float* gate; const PG8_G float* igs; const PG8_G float* gs; float coef; const PG8_LAS float* gt;
    __device__ __forceinline__ void group_r(int row, float& rA, float& rB, float& rC) const {
        const PG8_G float* p = (const PG8_G float*)(ws + WS_SSQO) + (size_t)row * 16;
        const f32x4 a = *(const PG8_G f32x4*)p, b = *(const PG8_G f32x4*)(p + 4), c = *(const PG8_G f32x4*)(p + 8), d = *(const PG8_G f32x4*)(p + 12);
        const float sA = ((a[0] + a[1]) + (a[2] + a[3])) + (b[0] + b[1]), sB = ((b[2] + b[3]) + (c[0] + c[1])) + (c[2] + c[3]), sC = (d[0] + d[1]) + (d[2] + d[3]);
        rA = 1.0f / sqrtf(sA * (1.0f / 384.0f) + RMS_EPS); rB = 1.0f / sqrtf(sB * (1.0f / 384.0f) + RMS_EPS); rC = 1.0f / sqrtf(sC * (1.0f / 256.0f) + RMS_EPS);
    }
    __device__ __forceinline__ void hook(f32x4 (&acc)[2][2][4][2], const Unit& u, int t, int wr, int wc, int fr, int fq) const {
        if (t != 6 && t != 12) return;
        asm volatile("" : "+v"(fr));
#pragma unroll
        for (int ai = 0; ai < 2; ++ai)
#pragma unroll
            for (int m = 0; m < 4; ++m) {
                const float f = gt[(t == 6 ? 0 : BM) + ai * HALF + wr * 64 + m * 16 + fr];
#pragma unroll
                for (int bj = 0; bj < 2; ++bj)
#pragma unroll
                    for (int n = 0; n < 2; ++n) acc[ai][bj][m][n] = acc[ai][bj][m][n] * f;
            }
    }
    __device__ __forceinline__ void fused(f32x4 (&acc)[2][2][4][2], const Unit& u, int wr, int wc, int fr, int fq, PG8_LAS unsigned char* lds, int wid, int lane) const {
        PG8_G bf16_t* xb = (PG8_G bf16_t*)(ws + WS_XB); PG8_G float* ssq_out = (PG8_G float*)(ws + WS_SSQX); constexpr int gate_bstride = 9 * 1024;
        const int b = u.pm >> 5, colg = u.pn * BM + 4 * lane;
        const f32x4 gv = *(const PG8_G f32x4*)(gate + (size_t)b * gate_bstride + colg) * coef;
        const f32x4 gsv = gs ? *(const PG8_G f32x4*)(gs + (size_t)b * 1024 + colg) : (f32x4){0.f, 0.f, 0.f, 0.f};
        const f32x4 igv = *(const PG8_G f32x4*)(igs + (size_t)b * 1024 + colg);
#pragma unroll
        for (int ai = 0; ai < 2; ++ai) {
#pragma unroll
            for (int m = 0; m < 4; ++m) { const int rl = wr * 64 + m * 16 + fr;
#pragma unroll
                for (int bj = 0; bj < 2; ++bj)
#pragma unroll
                    for (int n = 0; n < 2; ++n) { const int c = 32 * bj + 8 * wc + 4 * n + fq; *(PG8_LAS f32x4*)(lds + rl * 1024 + ((c ^ (rl & 7)) << 4)) = acc[ai][bj][m][n]; } }
            asm volatile("s_waitcnt lgkmcnt(0)\n\ts_barrier" ::: "memory");
#pragma unroll
            for (int half = 0; half < 2; ++half) {
                u32x2 xo[8];
#pragma unroll
                for (int k = 0; k < 8; ++k) { const int rl = wid + 8 * (half * 8 + k); xo[k] = *(const PG8_G u32x2*)(xb + (size_t)(u.pm * BM + ai * HALF + rl) * 1024 + colg); }
#pragma unroll
                for (int k = 0; k < 8; ++k) { const int rl = wid + 8 * (half * 8 + k); const int row = u.pm * BM + ai * HALF + rl;
                    f32x4 t = *(const PG8_LAS f32x4*)(lds + rl * 1024 + ((lane ^ (rl & 7)) << 4));
                    if (HOOKED) t = t * gt[2 * BM + ai * HALF + rl];
                    const f32x4 xs = {__uint_as_float(xo[k].x << 16), __uint_as_float(xo[k].x & 0xffff0000u), __uint_as_float(xo[k].y << 16), __uint_as_float(xo[k].y & 0xffff0000u)};
                    const f32x4 xn = xs * igv + gv * t;
                    if (!gs) *(PG8_G f32x4*)(fout + (size_t)row * 1024 + colg) = xn;
                    if (gs) { const f32x4 y = xn * gsv; u32x2 w; w.x = cvt_pk_bf16(y[0], y[1]); w.y = cvt_pk_bf16(y[2], y[3]); *(PG8_G u32x2*)(xb + (size_t)row * 1024 + colg) = w; }
                    float ss = sq4(xn);
                    ss = wave_sum_dpp(ss);
                    if (gs && lane == 0) *(PG8_G f32x4*)(ssq_out + (size_t)row * 16 + 4 * u.pn) = (f32x4){ss, 0.f, 0.f, 0.f};
                }
            }
            asm volatile("s_waitcnt lgkmcnt(0)\n\ts_barrier" ::: "memory");
        }
    }
};

struct EpiIn {
    static constexpr bool PERM = true, AFTER_DRAIN = false, HOOK = false;
    PG8_G unsigned char* ws; const PG8_G float* gq; const PG8_G float* gk; const PG8_G float* bias; const PG8_LAS float* rr;
    __device__ __forceinline__ void hook(f32x4 (&)[2][2][4][2], const Unit&, int, int, int, int, int) const {}
    __device__ __forceinline__ void operator()(const f32x4 (&acc)[2][2][4][2], const Unit& u, int wr, int wc, int fr, int fq) const {
        const int slot = u.pn * 4 + wc;
        if (slot == 7 || slot >= 30) return;
        const int b = u.pm >> 5;
        const PG8_LAS float* rt = rr + u.ord * BM + wr * 64 + fr;
        PG8_G PG8_G bf16_t* dst = nullptr; int pitch = 0, col0 = 0; int kind = 0;
        PG8_G PG8_G float* ssqd = nullptr; int ssqp = 0, ssqi = 0; const PG8_G float* gain = nullptr; float scale = 1.0f;
        if (slot < 4)       { dst = (PG8_G bf16_t*)(ws + WS_CQ);  pitch = 256; col0 = 64 * slot;        kind = 1; ssqd = (PG8_G float*)(ws + WS_SSQC);  ssqp = 4; ssqi = slot; }
        else if (slot < 6)  { dst = (PG8_G bf16_t*)(ws + WS_CKV); pitch = 128; col0 = 64 * (slot - 4);  kind = 1; ssqd = (PG8_G float*)(ws + WS_SSQC) + (size_t)MROWS_ * 4; ssqp = 2; ssqi = slot - 4; }
        else if (slot == 6) { kind = 3; }
        else if (slot < 14) { dst = (PG8_G bf16_t*)(ws + WS_QS);  pitch = 384; col0 = 64 * (slot - 8);  kind = 2; gain = gq; scale = 0.125f * LOG2E; }
        else if (slot < 16) { dst = (PG8_G bf16_t*)(ws + WS_KS);  pitch = 128; col0 = 64 * (slot - 14); kind = 2; gain = gk; }
        else if (slot < 18) { dst = (PG8_G bf16_t*)(ws + WS_VS);  pitch = 128; col0 = 64 * (slot - 16); }
        else if (slot < 22) { dst = (PG8_G bf16_t*)(ws + WS_QC);  pitch = 256; col0 = 64 * (slot - 18); scale = 0.125f * LOG2E; }
        else if (slot < 26) { dst = (PG8_G bf16_t*)(ws + WS_KC);  pitch = 256; col0 = 64 * (slot - 22); }
        else                { dst = (PG8_G bf16_t*)(ws + WS_VC);  pitch = 256; col0 = 64 * (slot - 26); }
        const PG8_LAS float* bb = rr + 6 * BM + u.ord * BM + wc * 32 + 8 * fq;
        f32x4 bv[2][2], gn[2][2];
#pragma unroll
        for (int bj = 0; bj < 2; ++bj)
#pragma unroll
            for (int n = 0; n < 2; ++n) { bv[bj][n] = *(const PG8_LAS f32x4*)(bb + bj * HALF + 4 * n);
                gn[bj][n] = (kind == 2) ? *(const PG8_G f32x4*)(gain + 32 * bj + 8 * fq + 4 * n) * scale : (f32x4){scale, scale, scale, scale}; }
#pragma unroll
        for (int ai = 0; ai < 2; ++ai)
#pragma unroll
            for (int m = 0; m < 4; ++m) {
                const int row = u.pm * BM + ai * HALF + wr * 64 + m * 16 + fr;
                const float r = rt[ai * HALF + m * 16];
                f32x4 v[2][2]; float ss = 0.f;
#pragma unroll
                for (int bj = 0; bj < 2; ++bj)
#pragma unroll
                    for (int n = 0; n < 2; ++n) { v[bj][n] = acc[ai][bj][m][n] * r + bv[bj][n]; ss += sq4(v[bj][n]); }
                if (kind == 3) {
                    float s0 = sq4(v[0][0]) + sq4(v[0][1]);
                    s0 = xsum32(xsum16(s0));
                    *(PG8_G f32x4*)((PG8_G float*)(ws + WS_KPE) + (size_t)row * 32 + 8 * fq) = v[0][0]; *(PG8_G f32x4*)((PG8_G float*)(ws + WS_KPE) + (size_t)row * 32 + 8 * fq + 4) = v[0][1];
                    if (fq == 0) ((PG8_G float*)(ws + WS_SSQC) + (size_t)MROWS_ * 6)[row] = s0;
                } else {
                    if (kind != 0) { ss = xsum32(xsum16(ss)); }
                    float rn = 1.0f;
                    if (kind == 2) rn = 1.0f / sqrtf(ss * (1.0f / 64.0f) + RMS_EPS);
                    if (kind == 1 && fq == 0) ssqd[(size_t)row * ssqp + ssqi] = ss;
#pragma unroll
                    for (int bj = 0; bj < 2; ++bj) {
                        const f32x4 y0 = v[bj][0] * gn[bj][0] * rn, y1 = v[bj][1] * gn[bj][1] * rn;
                        u32x4 w; w.x = cvt_pk_bf16(y0[0], y0[1]); w.y = cvt_pk_bf16(y0[2], y0[3]); w.z = cvt_pk_bf16(y1[0], y1[1]); w.w = cvt_pk_bf16(y1[2], y1[3]);
                        *(PG8_G u32x4*)(dst + (size_t)row * pitch + col0 + 32 * bj + 8 * fq) = w;
                    }
                }
            }
    }
};

struct EpiUq {
    static constexpr bool PERM = false, AFTER_DRAIN = false, HOOK = false;
    PG8_G unsigned char* ws;
    __device__ __forceinline__ void hook(f32x4 (&)[2][2][4][2], const Unit&, int, int, int, int, int) const {}
    __device__ __forceinline__ void operator()(const f32x4 (&acc)[2][2][4][2], const Unit& u, int wr, int wc, int fr, int fq) const {
        PG8_G bf16_t* QRAW = (PG8_G bf16_t*)(ws + WS_QRAW); const PG8_G float* ssqcq = (const PG8_G float*)(ws + WS_SSQC);
        const int col0 = u.pn * BM + wc * 32 + 4 * fq;
#pragma unroll
        for (int ai = 0; ai < 2; ++ai)
#pragma unroll
            for (int m = 0; m < 4; ++m) {
                const int row = u.pm * BM + ai * HALF + wr * 64 + m * 16 + fr;
                const f32x4 s = *(const PG8_G f32x4*)(ssqcq + (size_t)row * 4);
                const float r = 1.0f / sqrtf(((s[0] + s[1]) + (s[2] + s[3])) * (1.0f / 256.0f) + RMS_EPS);
#pragma unroll
                for (int bj = 0; bj < 2; ++bj)
#pragma unroll
                    for (int n = 0; n < 2; ++n) { const int c = col0 + bj * HALF + n * 16; if (c < 576) { const f32x4 y = acc[ai][bj][m][n] * r; u32x2 w; w.x = cvt_pk_bf16(y[0], y[1]); w.y = cvt_pk_bf16(y[2], y[3]); *(PG8_G u32x2*)(QRAW + (size_t)row * 576 + c) = w; } }
            }
    }
};

struct EpiUkv {
    static constexpr bool PERM = true, AFTER_DRAIN = false, HOOK = false;
    PG8_G unsigned char* ws; const PG8_G float* gk;
    __device__ __forceinline__ void hook(f32x4 (&)[2][2][4][2], const Unit&, int, int, int, int, int) const {}
    __device__ __forceinline__ void operator()(const f32x4 (&acc)[2][2][4][2], const Unit& u, int wr, int wc, int fr, int fq) const {
        PG8_G bf16_t* KA = (PG8_G bf16_t*)(ws + WS_KA); PG8_G bf16_t* VA = (PG8_G bf16_t*)(ws + WS_VA); const PG8_G float* ssqckv = (const PG8_G float*)(ws + WS_SSQC) + (size_t)MROWS_ * 4; const PG8_G float* ssqkpe = (const PG8_G float*)(ws + WS_SSQC) + (size_t)MROWS_ * 6;
        const PG8_G float* kpe = (const PG8_G float*)(ws + WS_KPE); const PG8_G float* cs = (const PG8_G float*)(ws + WS_CS);
        const int h = 2 * u.pn + (wc >> 1); const bool isv = (wc & 1) != 0;
        f32x4 gn[2][2], g1 = {1.f, 1.f, 1.f, 1.f}, g2 = {1.f, 1.f, 1.f, 1.f};
        if (!isv) {
#pragma unroll
            for (int bj = 0; bj < 2; ++bj)
#pragma unroll
                for (int n = 0; n < 2; ++n) gn[bj][n] = *(const PG8_G f32x4*)(gk + 32 * bj + 8 * fq + 4 * n);
            g1 = *(const PG8_G f32x4*)(gk + 64 + 4 * fq); g2 = *(const PG8_G f32x4*)(gk + 80 + 4 * fq);
        }
#pragma unroll
        for (int ai = 0; ai < 2; ++ai)
#pragma unroll
            for (int m = 0; m < 4; ++m) {
                const int row = u.pm * BM + ai * HALF + wr * 64 + m * 16 + fr;
                const float r = 1.0f / sqrtf((ssqckv[(size_t)row * 2] + ssqckv[(size_t)row * 2 + 1]) * (1.0f / 128.0f) + RMS_EPS);
                f32x4 v[2][2]; float ss = 0.f;
#pragma unroll
                for (int bj = 0; bj < 2; ++bj)
#pragma unroll
                    for (int n = 0; n < 2; ++n) { v[bj][n] = acc[ai][bj][m][n] * r; ss += sq4(v[bj][n]); }
                if (isv) {
#pragma unroll
                    for (int bj = 0; bj < 2; ++bj) { u32x4 w; w.x = cvt_pk_bf16(v[bj][0][0], v[bj][0][1]); w.y = cvt_pk_bf16(v[bj][0][2], v[bj][0][3]); w.z = cvt_pk_bf16(v[bj][1][0], v[bj][1][1]); w.w = cvt_pk_bf16(v[bj][1][2], v[bj][1][3]);
                        *(PG8_G u32x4*)(VA + ((size_t)(row >> 6) * 6 + h) * 4096 + bj * 2048 + (row & 63) * 32 + 8 * fq) = w; }
                } else {
                    ss = xsum32(xsum16(ss));
                    const float rk = 1.0f / sqrtf((ss + ssqkpe[row]) * (1.0f / 96.0f) + RMS_EPS);
                    PG8_G bf16_t* kd = KA + ((size_t)(row >> 6) * 6 + h) * 6144 + (row & 63) * 8;
#pragma unroll
                    for (int bj = 0; bj < 2; ++bj) { const f32x4 y0 = v[bj][0] * gn[bj][0] * rk, y1 = v[bj][1] * gn[bj][1] * rk;
                        u32x4 w; w.x = cvt_pk_bf16(y0[0], y0[1]); w.y = cvt_pk_bf16(y0[2], y0[3]); w.z = cvt_pk_bf16(y1[0], y1[1]); w.w = cvt_pk_bf16(y1[2], y1[3]);
                        *(PG8_G u32x4*)(kd + (4 * bj + fq) * 512) = w; }
                    const f32x4 x1 = *(const PG8_G f32x4*)(kpe + (size_t)row * 32 + 4 * fq) * g1 * rk, x2 = *(const PG8_G f32x4*)(kpe + (size_t)row * 32 + 16 + 4 * fq) * g2 * rk;
                    const f32x4 c = *(const PG8_G f32x4*)(cs + (size_t)row * 32 + 4 * fq), s = *(const PG8_G f32x4*)(cs + (size_t)row * 32 + 16 + 4 * fq);
                    const f32x4 o1 = x1 * c - x2 * s, o2 = x2 * c + x1 * s;
                    u32x2 w1, w2; w1.x = cvt_pk_bf16(o1[0], o1[1]); w1.y = cvt_pk_bf16(o1[2], o1[3]); w2.x = cvt_pk_bf16(o2[0], o2[1]); w2.y = cvt_pk_bf16(o2[2], o2[3]);
                    *(PG8_G u32x2*)(kd + (8 + (fq >> 1)) * 512 + (fq & 1) * 4) = w1; *(PG8_G u32x2*)(kd + (10 + (fq >> 1)) * 512 + (fq & 1) * 4) = w2;
                }
                if (m & 1) PG8_FENCE();
            }
    }
};
}
#define GAS __attribute__((address_space(1)))
#define LAS __attribute__((address_space(3)))
typedef unsigned short bf16;
typedef unsigned v4u __attribute__((ext_vector_type(4)));
typedef float f32x4 __attribute__((ext_vector_type(4)));
typedef short bf16x8 __attribute__((ext_vector_type(8)));
typedef GAS unsigned gu32;
typedef GAS unsigned long long gu64;
#define RLX_AGENT __ATOMIC_RELAXED, __HIP_MEMORY_SCOPE_AGENT
#define LDS_WAIT() asm volatile("s_waitcnt lgkmcnt(0)" ::: "memory")
#define VM_WAIT() asm volatile("s_waitcnt vmcnt(0)" ::: "memory")
__device__ __forceinline__ unsigned long long rt() { return __builtin_amdgcn_s_memrealtime(); }
__device__ __forceinline__ unsigned f2bf(float f) { unsigned u = __builtin_bit_cast(unsigned, f); return (u + 0x7fffu + ((u >> 16) & 1u)) >> 16; }
__device__ __forceinline__ unsigned pk2(float lo, float hi) { return f2bf(lo) | (f2bf(hi) << 16); }

#define XB_TMO      128
#define XB_XCNT(j)  (256  + 64 * (j))
#define XB_XSUB(j)  (1280 + 64 * (j))
#define XB_XGEN(j)  (2304 + 64 * (j))
#define XB_TOP      3328
#define XB_TOPGEN   3392
#define XCD_BAR_WORDS 3456
#define XB_SPIN_CAP (1u << 18)

__device__ __forceinline__ unsigned xb_ld(unsigned* p)              { return __hip_atomic_load(p, __ATOMIC_RELAXED, __HIP_MEMORY_SCOPE_AGENT); }
__device__ __forceinline__ unsigned xb_add(unsigned* p, unsigned v) { return __hip_atomic_fetch_add(p, v, __ATOMIC_RELAXED, __HIP_MEMORY_SCOPE_AGENT); }
__device__ __forceinline__ unsigned xb_xcc_id() { return (unsigned)__builtin_amdgcn_s_getreg((3 << 11) | 20) & 0xFu; }
#define XB_SPIN(cond, bar) do { unsigned _sp = 0; while (cond) { __builtin_amdgcn_s_sleep(1); \
    if ((++_sp & 255u) == 0u) { if (xb_ld(&(bar)[XB_TMO])) break; if (_sp > XB_SPIN_CAP) { atomicAdd(&(bar)[XB_TMO], 1u); break; } } } } while (0)

struct XcdBarrier {
    unsigned* bar; unsigned x;
    volatile LAS unsigned* st;
    int w0;
};

__device__ __forceinline__ XcdBarrier xcd_barrier_post(unsigned* bar, volatile LAS unsigned* st, int w0) {
    XcdBarrier b; b.bar = bar; b.x = xb_xcc_id(); b.st = st; b.w0 = w0;
    if (w0 == 0 && hw_lane() == 0) (void)xb_add(&bar[XB_XCNT(b.x)], 1u);
    return b;
}
__device__ __forceinline__ void xcd_barrier_complete(unsigned* bar, unsigned x, unsigned& nloc, unsigned& nx) {
    const unsigned G = gridDim.x * gridDim.y * gridDim.z;
    unsigned sum, cnt, mine, sp = 0u;
    for (;;) {
        sum = 0u; cnt = 0u; mine = 0u;
#pragma unroll
        for (unsigned j = 0; j < 16; ++j) { const unsigned c = xb_ld(&bar[XB_XCNT(j)]); sum += c; cnt += (c > 0u) ? 1u : 0u; mine = (j == x) ? c : mine; }
        if (sum == G) break;
        __builtin_amdgcn_s_sleep(1);
        if ((++sp & 255u) == 0u) { if (xb_ld(&bar[XB_TMO])) break; if (sp > XB_SPIN_CAP) { atomicAdd(&bar[XB_TMO], 1u); break; } }
    }
    nloc = mine > 0u ? mine : 1u; nx = cnt > 0u ? cnt : 1u;
}

__device__ __forceinline__ void xcd_barrier(const XcdBarrier& b) {
    asm volatile("s_waitcnt vmcnt(0)" ::: "memory");
    __syncthreads();
    if (b.w0 == 0 && hw_lane() == 0) {
        unsigned* bar = b.bar;
        __builtin_amdgcn_s_waitcnt(0);
        unsigned nloc = b.st[0], nx = b.st[1];
        if (nloc == 0u) { xcd_barrier_complete(bar, b.x, nloc, nx); b.st[0] = nloc; b.st[1] = nx; }
        const unsigned old = xb_add(&bar[XB_XSUB(b.x)], 1u);
        const unsigned gen = old / nloc;
        if (old + 1u == (gen + 1u) * nloc) {
            __builtin_amdgcn_fence(__ATOMIC_RELEASE, "agent");
            asm volatile("s_waitcnt vmcnt(0)" ::: "memory");
            const unsigned og = xb_add(&bar[XB_TOP], 1u);
            const unsigned tg = og / nx;
            if (og + 1u == (tg + 1u) * nx) xb_add(&bar[XB_TOPGEN], 1u);
            else XB_SPIN(xb_ld(&bar[XB_TOPGEN]) == tg, bar);
            __builtin_amdgcn_fence(__ATOMIC_ACQUIRE, "agent");
            xb_add(&bar[XB_XGEN(b.x)], 1u);
            asm volatile("s_waitcnt vmcnt(0)" ::: "memory");
        } else {
            XB_SPIN(xb_ld(&bar[XB_XGEN(b.x)]) == gen, bar);
            __builtin_amdgcn_fence(__ATOMIC_ACQUIRE, "agent");
            asm volatile("s_waitcnt vmcnt(0)" ::: "memory");
        }
    }
    __syncthreads();
}
namespace att {
typedef unsigned short bf16_t;
typedef short bf16x8 __attribute__((ext_vector_type(8)));
typedef short s16x4 __attribute__((ext_vector_type(4)));
typedef short v4i16_t __attribute__((ext_vector_type(4)));
typedef float f32x16 __attribute__((ext_vector_type(16)));
typedef float f32x4 __attribute__((ext_vector_type(4)));
typedef float f32x2 __attribute__((ext_vector_type(2)));
typedef __bf16 bf16x2_t __attribute__((ext_vector_type(2)));
typedef unsigned u32x4 __attribute__((ext_vector_type(4)));
typedef int i32x4 __attribute__((ext_vector_type(4)));
#define ALAS __attribute__((address_space(3)))
#define AGAS __attribute__((address_space(1)))
constexpr int SEQ = 8192;
constexpr float LOG2E = 1.4426950408889634f, EPS = 1e-6f;
constexpr int KCS = 1040, VHS = 4160;
constexpr int KSLOT = 12 * KCS, VSLOT = 2 * VHS;
constexpr int L_K = 0, L_V = 3 * KSLOT, L_POS = L_V + 4 * VSLOT, L_TB = L_POS + 1024, L_WSF = L_TB + 128, L_OST = L_WSF + 8 * 256, L_FLAG = L_OST + 8 * 4096, L_END = L_FLAG + 16 + 64;
static_assert(L_OST % 16 == 0 && L_V % 16 == 0 && L_END <= 131072, "attention LDS map");
constexpr int S1_KS = 8 * KCS, S1_K = 0, S1_V = 7 * S1_KS, S1_P = S1_V + 7 * VSLOT, S1_LUT = S1_P + 7 * 256, S1_WSF = S1_LUT + 528, S1_END = S1_WSF + 8 * 256;
static_assert(S1_END <= L_FLAG || S1_END <= 131072, "sliding-window LDS map"); static_assert(S1_V % 16 == 0 && S1_WSF % 16 == 0 && S1_END <= 131072, "sliding-window LDS map");

__device__ __forceinline__ int crow(int r, int hi) { return (r & 3) + 8 * (r >> 2) + 4 * hi; }
__device__ __forceinline__ unsigned cvtpk(float lo, float hi) { f32x2 v = {lo, hi}; bf16x2_t b = __builtin_convertvector(v, bf16x2_t); return __builtin_bit_cast(unsigned, b); }
__device__ __forceinline__ s16x4 vtr(const ALAS unsigned char* p) { return __builtin_bit_cast(s16x4, __builtin_amdgcn_ds_read_tr16_b64_v4i16((ALAS v4i16_t*)p)); }
__device__ __forceinline__ float swap_sum(float x) { auto rr = __builtin_amdgcn_permlane32_swap(__float_as_uint(x), __float_as_uint(x), false, false); return __uint_as_float(rr[0]) + __uint_as_float(rr[1]); }
__device__ __forceinline__ float swap_max(float x) { auto rr = __builtin_amdgcn_permlane32_swap(__float_as_uint(x), __float_as_uint(x), false, false); return fmaxf(__uint_as_float(rr[0]), __uint_as_float(rr[1])); }
__device__ __forceinline__ float bf2f(unsigned short h) { return __uint_as_float((unsigned)h << 16); }

__device__ __forceinline__ void glds16(const AGAS void* gsrc, unsigned lds_dst) { unsigned keep;
    asm volatile("s_mov_b32 %0, m0\n\ts_mov_b32 m0, %2\n\ts_nop 0\n\tglobal_load_lds_dwordx4 %1, off\n\ts_mov_b32 m0, %0" : "=&s"(keep) : "v"(gsrc), "s"(lds_dst) : "memory"); }
__device__ __forceinline__ void glds4(const AGAS void* gsrc, unsigned lds_dst) { unsigned keep;
    asm volatile("s_mov_b32 %0, m0\n\ts_mov_b32 m0, %2\n\ts_nop 0\n\tglobal_load_lds_dword %1, off\n\ts_mov_b32 m0, %0" : "=&s"(keep) : "v"(gsrc), "s"(lds_dst) : "memory"); }

struct AttnP {
    AGAS unsigned char* ws;
    const AGAS float* gq;
    const AGAS int* pos; const AGAS float* sinks; const AGAS float* relb;
};
template <int MODE> struct AttnCfg;
template <> struct AttnCfg<0> { static constexpr size_t Q = WS_QRAW, K = WS_KA, V = WS_VA; static constexpr int qpitch = 576, kpitch = 576, khs = 96, vpitch = 384, vhs = 64, ocol0 = 0, hidx0 = 0, group = 1; };
template <> struct AttnCfg<1> { static constexpr size_t Q = WS_QS, K = WS_KS, V = WS_VS; static constexpr int qpitch = 384, kpitch = 128, khs = 64, vpitch = 128, vhs = 64, ocol0 = 384, hidx0 = 6, group = 3; };
template <> struct AttnCfg<2> { static constexpr size_t Q = WS_QC, K = WS_KC, V = WS_VC; static constexpr int qpitch = 256, kpitch = 256, khs = 64, vpitch = 256, vhs = 64, ocol0 = 768, hidx0 = 12, group = 1; };

#ifdef ATT_PROF
#define PROF_T() ((MODE == 0 && blockIdx.x == 0) ? (long long)clock64() : 0ll)
#else
#define PROF_T() 0ll
#endif
template <int DQK, int MODE>
__device__ __forceinline__ void attn_unit(ALAS unsigned char* lds, const AttnP& P, int b, int h, int qb, int wave0, unsigned long long* prof = nullptr) {
    long long pf_qk = 0, pf_sm = 0, pf_pv = 0, pf_wait = 0; const long long pf_t0 = PROF_T();
    constexpr int NCH = DQK / 8, ND0 = DQK / 16;
    int tid_ = wave0 * 64 + hw_lane(); asm volatile("" : "+v"(tid_));
    const int tid = tid_, lane = tid & 63, r32 = lane & 31, hi = lane >> 5;
    const int wid = __builtin_amdgcn_readfirstlane(tid >> 6);
    const int q0 = qb * 256, qlo = q0 + 32 * wid, qhi = qlo + 31, qrow = qlo + r32;
    const size_t rb = (size_t)b * SEQ;
    typedef AttnCfg<MODE> C; const int kvh = h / C::group;
    ALAS float* wsf = (ALAS float*)(lds + (MODE == 1 ? S1_WSF : L_WSF)) + wid * 64;
    ALAS unsigned char* ost = lds + L_OST + wid * 4096;
    ALAS int* posl = (ALAS int*)(lds + L_POS);
    ALAS float* tb = (ALAS float*)(lds + L_TB);

    bf16x8 qf[ND0];
    if constexpr (MODE == 0) {
        const AGAS bf16_t* qp = (const AGAS bf16_t*)(P.ws + C::Q) + (rb + qrow) * 576 + h * 96 + hi * 8;
        float qv[ND0][8]; float ss = 0.f;
#pragma unroll
        for (int d0 = 0; d0 < ND0; ++d0) { const u32x4 w = *(const AGAS u32x4*)(qp + 16 * d0);
#pragma unroll
            for (int i = 0; i < 4; ++i) { const float lo = __uint_as_float(w[i] << 16), hv = __uint_as_float(w[i] & 0xffff0000u); qv[d0][2 * i] = lo; qv[d0][2 * i + 1] = hv; ss += lo * lo + hv * hv; } }
        ss = swap_sum(ss);
        const float rq = 1.0f / sqrtf(ss * (1.0f / 96.0f) + EPS);
#pragma unroll
        for (int d0 = 0; d0 < ND0; ++d0) { const f32x4 ga = *(const AGAS f32x4*)(P.gq + 16 * d0 + 8 * hi), gb = *(const AGAS f32x4*)(P.gq + 16 * d0 + 8 * hi + 4);
#pragma unroll
            for (int i = 0; i < 4; ++i) { qv[d0][i] *= rq * ga[i]; qv[d0][4 + i] *= rq * gb[i]; } }
        {
            const AGAS float* cp = (const AGAS float*)(P.ws + WS_CS) + (rb + qrow) * 32 + 8 * hi;
            const f32x4 c0 = *(const AGAS f32x4*)cp, c1 = *(const AGAS f32x4*)(cp + 4), s0 = *(const AGAS f32x4*)(cp + 16), s1 = *(const AGAS f32x4*)(cp + 20);
#pragma unroll
            for (int i = 0; i < 8; ++i) { const float c = i < 4 ? c0[i & 3] : c1[i & 3], s = i < 4 ? s0[i & 3] : s1[i & 3]; const float x1 = qv[4][i], x2 = qv[5][i]; qv[4][i] = x1 * c - x2 * s; qv[5][i] = x2 * c + x1 * s; }
        }
        const float sc = 0.10206207261596575f * LOG2E;
#pragma unroll
        for (int d0 = 0; d0 < ND0; ++d0) { u32x4 w; w.x = cvtpk(qv[d0][0] * sc, qv[d0][1] * sc); w.y = cvtpk(qv[d0][2] * sc, qv[d0][3] * sc); w.z = cvtpk(qv[d0][4] * sc, qv[d0][5] * sc); w.w = cvtpk(qv[d0][6] * sc, qv[d0][7] * sc); qf[d0] = __builtin_bit_cast(bf16x8, w); }
    } else {
        const AGAS bf16_t* qp = (const AGAS bf16_t*)(P.ws + C::Q) + (rb + qrow) * C::qpitch + h * 64 + hi * 8;
#pragma unroll
        for (int d0 = 0; d0 < ND0; ++d0) qf[d0] = *(const AGAS bf16x8*)(qp + 16 * d0);
    }
    int posq = 0; float sink2 = 0.f;
    if constexpr (MODE == 1) {
        posq = P.pos[rb + qrow]; sink2 = P.sinks[h] * LOG2E;
    }

    int ntile, tfirst, tstep;
    if (MODE == 0) { tfirst = 0; tstep = 1; ntile = ((q0 + 255) >> 6) + 1; }
    else if (MODE == 1) { const int lo = q0 - 127 > 0 ? q0 - 127 : 0; tfirst = lo >> 6; tstep = 1; ntile = ((q0 + 255) >> 6) - tfirst + 1; }
    else { tfirst = (q0 + 254) >> 6; tstep = -1; ntile = tfirst + 1; }

    const AGAS bf16_t* Kg = (const AGAS bf16_t*)(P.ws + C::K) + rb * C::kpitch + kvh * C::khs;
    const AGAS bf16_t* Vg = (const AGAS bf16_t*)(P.ws + C::V) + rb * C::vpitch + kvh * C::vhs;
    const unsigned lds0 = (unsigned)(uintptr_t)lds;
    const AGAS bf16_t* ksrc0 = (MODE == 0) ? (const AGAS bf16_t*)(P.ws + C::K) + ((size_t)b * 128 * 6 + h) * 6144 + wid * 512 + lane * 8 : Kg + (size_t)lane * C::kpitch + 8 * wid;
    const AGAS bf16_t* vsrc = (MODE == 0) ? (const AGAS bf16_t*)(P.ws + C::V) + ((size_t)b * 128 * 6 + h) * 4096 + (wid >> 2) * 2048 + (wid & 3) * 512 + lane * 8
                                          : Vg + (size_t)(16 * (wid & 3) + (lane >> 2)) * C::vpitch + 32 * (wid >> 2) + 8 * (lane & 3);
    constexpr size_t KTS = (MODE == 0) ? (size_t)6 * 6144 : (size_t)64 * C::kpitch, VTS = (MODE == 0) ? (size_t)6 * 4096 : (size_t)64 * C::vpitch, K2O = (MODE == 0) ? 8 * 512 : 64;
    const bool k2 = (wid + 8) < NCH;
    const bool posw = (MODE == 1) && wid == 0;
    const int NP = 2 + (k2 ? 1 : 0) + (posw ? 1 : 0);
#define ATT_ISSUE(T, IT) do { const int T_ = (T); const size_t jo_ = (size_t)T_ * 64; const int ks_ = (IT) % 3, vs_ = (IT) & 3;     \
        glds16(ksrc0 + (size_t)T_ * KTS, (unsigned)__builtin_amdgcn_readfirstlane(lds0 + L_K + ks_ * KSLOT + wid * KCS)); \
        if (k2) glds16(ksrc0 + (size_t)T_ * KTS + K2O, (unsigned)__builtin_amdgcn_readfirstlane(lds0 + L_K + ks_ * KSLOT + (wid + 8) * KCS)); \
        glds16(vsrc + (size_t)T_ * VTS, (unsigned)__builtin_amdgcn_readfirstlane(lds0 + L_V + vs_ * VSLOT + (wid >> 2) * VHS + (wid & 3) * 1024)); \
        if (posw) glds4(P.pos + rb + jo_ + lane, (unsigned)__builtin_amdgcn_readfirstlane(lds0 + L_POS + vs_ * 256)); } while (0)
#define ATT_WAIT_BAR(n_) do { if ((n_) <= 0) asm volatile("s_waitcnt vmcnt(0) lgkmcnt(0)\n\ts_barrier" ::: "memory"); \
        else if (NP == 2) asm volatile("s_waitcnt vmcnt(2) lgkmcnt(0)\n\ts_barrier" ::: "memory"); \
        else if (NP == 3) asm volatile("s_waitcnt vmcnt(3) lgkmcnt(0)\n\ts_barrier" ::: "memory"); \
        else asm volatile("s_waitcnt vmcnt(4) lgkmcnt(0)\n\ts_barrier" ::: "memory"); } while (0)

    f32x16 o0 = {}, o1 = {};
    float mrun = (MODE == 1) ? sink2 : 0.f;
    float lrun = (MODE == 1 && hi == 0) ? 1.0f : 0.f;
    f32x16 negm;
#pragma unroll
    for (int r = 0; r < 16; ++r) negm[r] = (MODE == 2) ? 0.f : -mrun;
    bool first = (MODE == 0);
    float after = 0.f;
    bool walive = true;
    const int vrd = ((lane >> 4) & 1) * 32 + (lane & 3) * 8 + (4 * hi + ((lane & 15) >> 2)) * 64;
    const bool lag = wid >= 4;
    constexpr float THR = 4.0f;

#define ATT_QK(P0, P1, kb) do { int kofs_ = L_K + (kb) * KSLOT + hi * KCS + r32 * 16; asm volatile("" : "+v"(kofs_)); const ALAS unsigned char* Kb_ = lds + kofs_;     \
        bf16x8 kfa_[4], kfb_[4]; \
        _Pragma("unroll") for (int d0 = 0; d0 < 3; ++d0) { kfa_[d0] = *(const ALAS bf16x8*)(Kb_ + 2 * d0 * KCS); kfb_[d0] = *(const ALAS bf16x8*)(Kb_ + 2 * d0 * KCS + 512); } \
        \
        _Pragma("unroll") for (int d0 = 0; d0 < ND0; ++d0) { \
            if (d0 + 3 < ND0) { kfa_[(d0 + 3) & 3] = *(const ALAS bf16x8*)(Kb_ + 2 * (d0 + 3) * KCS); kfb_[(d0 + 3) & 3] = *(const ALAS bf16x8*)(Kb_ + 2 * (d0 + 3) * KCS + 512); } \
            if (d0 == 0) { P0 = __builtin_amdgcn_mfma_f32_32x32x16_bf16(kfa_[0], qf[0], negm, 0, 0, 0); P1 = __builtin_amdgcn_mfma_f32_32x32x16_bf16(kfb_[0], qf[0], negm, 0, 0, 0); } \
            else { P0 = __builtin_amdgcn_mfma_f32_32x32x16_bf16(kfa_[d0 & 3], qf[d0], P0, 0, 0, 0); P1 = __builtin_amdgcn_mfma_f32_32x32x16_bf16(kfb_[d0 & 3], qf[d0], P1, 0, 0, 0); } \
            } } while (0)
#define ATT_VLD(i_, s_) do { vl0_[i_] = vtr(Vb_ + (s_) * 1024); vh0_[i_] = vtr(Vb_ + (s_) * 1024 + 512); vl1_[i_] = vtr(Vb_ + VHS + (s_) * 1024); vh1_[i_] = vtr(Vb_ + VHS + (s_) * 1024 + 512); } while (0)
#define ATT_PV(vb) do { int vofs_ = L_V + (vb) * VSLOT + vrd; asm volatile("" : "+v"(vofs_)); const ALAS unsigned char* Vb_ = lds + vofs_; \
        s16x4 vl0_[2], vh0_[2], vl1_[2], vh1_[2]; ATT_VLD(0, 0); \
        _Pragma("unroll") for (int s_ = 0; s_ < 4; ++s_) { \
            if (s_ + 1 < 4) ATT_VLD((s_ + 1) & 1, s_ + 1); \
            const int i_ = s_ & 1; const bf16x8 pa_ = __builtin_bit_cast(bf16x8, pw[s_]); \
            const bf16x8 v0_ = {vl0_[i_][0], vl0_[i_][1], vl0_[i_][2], vl0_[i_][3], vh0_[i_][0], vh0_[i_][1], vh0_[i_][2], vh0_[i_][3]}, v1_ = {vl1_[i_][0], vl1_[i_][1], vl1_[i_][2], vl1_[i_][3], vh1_[i_][0], vh1_[i_][1], vh1_[i_][2], vh1_[i_][3]}; \
            o0 = __builtin_amdgcn_mfma_f32_32x32x16_bf16(pa_, v0_, o0, 0, 0, 0); o1 = __builtin_amdgcn_mfma_f32_32x32x16_bf16(pa_, v1_, o1, 0, 0, 0); } } while (0)
#define ATT_PACK(P0, P1) do { \
        pw[0].x = cvtpk(P0[0], P0[1]); pw[0].y = cvtpk(P0[2], P0[3]); pw[0].z = cvtpk(P0[4], P0[5]); pw[0].w = cvtpk(P0[6], P0[7]); \
        pw[1].x = cvtpk(P0[8], P0[9]); pw[1].y = cvtpk(P0[10], P0[11]); pw[1].z = cvtpk(P0[12], P0[13]); pw[1].w = cvtpk(P0[14], P0[15]); \
        pw[2].x = cvtpk(P1[0], P1[1]); pw[2].y = cvtpk(P1[2], P1[3]); pw[2].z = cvtpk(P1[4], P1[5]); pw[2].w = cvtpk(P1[6], P1[7]); \
        pw[3].x = cvtpk(P1[8], P1[9]); pw[3].y = cvtpk(P1[10], P1[11]); pw[3].z = cvtpk(P1[12], P1[13]); pw[3].w = cvtpk(P1[14], P1[15]); } while (0)
#define ATT_MAX3(a, b, c) fmaxf(fmaxf((a), (b)), (c))
#define ATT_SM_A(P0, P1, j0_, pslot) do { if constexpr (MODE != 2) { \
            if constexpr (MODE == 1) { \
                _Pragma("unroll") for (int g = 0; g < 4; ++g) { \
                    const i32x4 pa = *(const ALAS i32x4*)(posl + (pslot) * 64 + 8 * g + 4 * hi), pb = *(const ALAS i32x4*)(posl + (pslot) * 64 + 32 + 8 * g + 4 * hi); \
                    _Pragma("unroll") for (int i = 0; i < 4; ++i) { \
                        { int n = posq - pa[i]; n = n > 0 ? n : 0; int bk = n; if (n >= 16) { bk = 16 + (int)((__builtin_amdgcn_logf((float)n) - 4.0f) * (16.0f / 3.0f)); bk = bk < 31 ? bk : 31; } P0[4 * g + i] += tb[bk]; } \
                        { int n = posq - pb[i]; n = n > 0 ? n : 0; int bk = n; if (n >= 16) { bk = 16 + (int)((__builtin_amdgcn_logf((float)n) - 4.0f) * (16.0f / 3.0f)); bk = bk < 31 ? bk : 31; } P1[4 * g + i] += tb[bk]; } } } } \
            const bool nm_ = (MODE == 1) || ((j0_) + 63 > qlo); \
            if (nm_) { \
                _Pragma("unroll") for (int r = 0; r < 16; ++r) { const int key = (j0_) + crow(r, hi); \
                    bool ok0 = key <= qrow, ok1 = key + 32 <= qrow; \
                    if (MODE == 1) { ok0 = ok0 && (key > qrow - 128); ok1 = ok1 && (key + 32 > qrow - 128); } \
                    if (!ok0) P0[r] = -INFINITY; if (!ok1) P1[r] = -INFINITY; } } \
            float ma = ATT_MAX3(P0[0], P0[1], P1[0]), mb = ATT_MAX3(P0[2], P0[3], P1[1]); ma = ATT_MAX3(ma, P1[2], P1[3]); \
            _Pragma("unroll") for (int r = 4; r < 16; r += 4) { ma = ATT_MAX3(ma, P0[r], P0[r + 1]); mb = ATT_MAX3(mb, P0[r + 2], P0[r + 3]); ma = ATT_MAX3(ma, P1[r], P1[r + 1]); mb = ATT_MAX3(mb, P1[r + 2], P1[r + 3]); } \
            const float mt = swap_max(fmaxf(ma, mb)); \
            if (first || __any(mt > THR)) {                                 \
                const float d = first ? mt : fmaxf(mt, 0.f); first = false; \
                _Pragma("unroll") for (int r = 0; r < 16; ++r) { P0[r] -= d; P1[r] -= d; } \
                const float alpha = __builtin_amdgcn_exp2f(-d); mrun += d; lrun *= alpha; \
                _Pragma("unroll") for (int r = 0; r < 16; ++r) negm[r] = -mrun; \
                if (hi == 0) wsf[r32] = alpha; \
                _Pragma("unroll") for (int g = 0; g < 4; ++g) { const f32x4 al = *(const ALAS f32x4*)(wsf + 8 * g + 4 * hi); \
                    _Pragma("unroll") for (int i = 0; i < 4; ++i) { o0[4 * g + i] *= al[i]; o1[4 * g + i] *= al[i]; } } } } } while (0)
#define ATT_SM_B(P0, P1, j0_) do { \
        if constexpr (MODE == 2) { \
            const bool nm_ = (j0_) + 63 >= qlo; \
            float ln0[16], ln1[16]; \
            _Pragma("unroll") for (int r = 0; r < 16; ++r) { const int key = (j0_) + crow(r, hi); \
                { const float z = P0[r]; const float sp = fmaxf(z, 0.f) + __builtin_amdgcn_logf(1.0f + __builtin_amdgcn_exp2f(-fabsf(z))); const bool ok = !nm_ || key < qrow; ln0[r] = ok ? -sp : 0.f; P0[r] = ok ? z - sp : -INFINITY; } \
                { const float z = P1[r]; const float sp = fmaxf(z, 0.f) + __builtin_amdgcn_logf(1.0f + __builtin_amdgcn_exp2f(-fabsf(z))); const bool ok = !nm_ || key + 32 < qrow; ln1[r] = ok ? -sp : 0.f; P1[r] = ok ? z - sp : -INFINITY; } } \
            float run = after; \
            _Pragma("unroll") for (int blk = 1; blk >= 0; --blk) _Pragma("unroll") for (int g = 3; g >= 0; --g) { \
                const float own = blk ? ((ln1[4 * g] + ln1[4 * g + 1]) + (ln1[4 * g + 2] + ln1[4 * g + 3])) : ((ln0[4 * g] + ln0[4 * g + 1]) + (ln0[4 * g + 2] + ln0[4 * g + 3])); \
                auto rr = __builtin_amdgcn_permlane32_swap(__float_as_uint(own), __float_as_uint(own), false, false); \
                const float slo = __uint_as_float(rr[0]), shi = __uint_as_float(rr[1]); \
                const float e1 = run; run += shi; const float e0 = run; run += slo; \
                float aft = hi ? e1 : e0; \
                _Pragma("unroll") for (int i = 3; i >= 0; --i) { const int r = 4 * g + i; \
                    if (blk) { P1[r] = __builtin_amdgcn_exp2f(P1[r] + aft); aft += ln1[r]; } else { P0[r] = __builtin_amdgcn_exp2f(P0[r] + aft); aft += ln0[r]; } } } \
            after = run; walive = __any(after > -160.0f); \
        } else { \
            float ls = 0.f; \
            _Pragma("unroll") for (int r = 0; r < 16; ++r) { P0[r] = __builtin_amdgcn_exp2f(P0[r]); P1[r] = __builtin_amdgcn_exp2f(P1[r]); ls += P0[r] + P1[r]; } \
            lrun += ls; } \
        ATT_PACK(P0, P1); } while (0)
#define ATT_WORK(j0_) ((MODE == 0) ? ((j0_) <= qhi) : (MODE == 1) ? (((j0_) <= qhi) && ((j0_) + 63 >= qlo - 127)) : (walive && ((j0_) < qhi)))

    if constexpr (MODE == 0) {
    f32x16 p0, p1, n0, n1; u32x4 pw[4];
    __syncthreads();
    int issued = 0;
    ATT_ISSUE(0, 0);
    if (ntile > 1) { ATT_ISSUE(1, 1); issued = 1; }
    if (ntile > 2) { ATT_ISSUE(2, 2); issued = 2; }
    ATT_WAIT_BAR(issued - 1);
    const int tmax = qhi >> 6;
#define MLA_SB() __builtin_amdgcn_sched_barrier(0)
#define MLA_EX(v) __builtin_amdgcn_exp2f(v)
#define MLA_DECIDE(X0, X1, j0_) do { \
        if ((j0_) + 63 > qlo) { _Pragma("unroll") for (int r = 0; r < 16; ++r) { const int key = (j0_) + crow(r, hi); if (key > qrow) X0[r] = -INFINITY; if (key + 32 > qrow) X1[r] = -INFINITY; } } \
        float ma = ATT_MAX3(X0[0], X0[1], X1[0]), mb = ATT_MAX3(X0[2], X0[3], X1[1]); ma = ATT_MAX3(ma, X1[2], X1[3]); \
        _Pragma("unroll") for (int r = 4; r < 16; r += 4) { ma = ATT_MAX3(ma, X0[r], X0[r + 1]); mb = ATT_MAX3(mb, X0[r + 2], X0[r + 3]); ma = ATT_MAX3(ma, X1[r], X1[r + 1]); mb = ATT_MAX3(mb, X1[r + 2], X1[r + 3]); } \
        const float mt = swap_max(fmaxf(ma, mb)); resc = false; \
        if (first || __any(mt > THR)) { const float d = first ? mt : fmaxf(mt, 0.f); first = false; \
            _Pragma("unroll") for (int r = 0; r < 16; ++r) { X0[r] -= d; X1[r] -= d; } \
            const float alpha = __builtin_amdgcn_exp2f(-d); lrun *= alpha; const float nm_ = negm[0] - d;     \
            _Pragma("unroll") for (int r = 0; r < 16; ++r) negm[r] = nm_; \
            if (hi == 0) wsf[r32] = alpha; resc = true; } } while (0)
#define MLA_RESC() do { if (resc) { _Pragma("unroll") for (int g = 0; g < 4; ++g) { const f32x4 al = *(const ALAS f32x4*)(wsf + 8 * g + 4 * hi); \
            _Pragma("unroll") for (int i = 0; i < 4; ++i) { o0[4 * g + i] *= al[i]; o1[4 * g + i] *= al[i]; } } } } while (0)
#define MLA_PV_(i) (i < 16 ? C0[(i) & 15] : C1[(i) & 15])
#define MLA_GA(MF, g, C0, C1) do { MF; \
        if (3 * (g) < 32) sacc += (3 * (g) < 16 ? C0[(3 * (g)) & 15] : C1[(3 * (g)) & 15]); \
        if (3 * (g) + 1 < 32) sacc += (3 * (g) + 1 < 16 ? C0[(3 * (g) + 1) & 15] : C1[(3 * (g) + 1) & 15]); \
        if (3 * (g) + 2 < 32) sacc += (3 * (g) + 2 < 16 ? C0[(3 * (g) + 2) & 15] : C1[(3 * (g) + 2) & 15]); \
        if ((g) < 4) { pw[((g) >> 1) & 3][2 * ((g) & 1)] = cvtpk(C0[4 * (g)], C0[4 * (g) + 1]); pw[((g) >> 1) & 3][2 * ((g) & 1) + 1] = cvtpk(C0[4 * (g) + 2], C0[4 * (g) + 3]); } \
        else if ((g) < 8) { pw[((g) >> 1) & 3][2 * ((g) & 1)] = cvtpk(C1[4 * ((g) - 4)], C1[4 * ((g) - 4) + 1]); pw[((g) >> 1) & 3][2 * ((g) & 1) + 1] = cvtpk(C1[4 * ((g) - 4) + 2], C1[4 * ((g) - 4) + 3]); } } while (0)
#define MLA_VF(lo_, hi_) (bf16x8){lo_[0], lo_[1], lo_[2], lo_[3], hi_[0], hi_[1], hi_[2], hi_[3]}
#define MLA_GB(MF, X, b_) do { MF; X[(b_)] = MLA_EX(X[(b_)]); X[(b_) + 1] = MLA_EX(X[(b_) + 1]); X[(b_) + 2] = MLA_EX(X[(b_) + 2]); X[(b_) + 3] = MLA_EX(X[(b_) + 3]); } while (0)
#define MLA_FULL(C0, C1, N0, N1, t_) do { \
        int kofs_ = L_K + (((t_) + 1) % 3) * KSLOT + hi * KCS + r32 * 16; asm volatile("" : "+v"(kofs_)); const ALAS unsigned char* Kb_ = lds + kofs_; \
        int vofs_ = L_V + ((t_) & 3) * VSLOT + vrd; asm volatile("" : "+v"(vofs_)); const ALAS unsigned char* Vb_ = lds + vofs_; \
        bf16x8 ka0 = *(const ALAS bf16x8*)(Kb_), kb0 = *(const ALAS bf16x8*)(Kb_ + 512), ka1 = *(const ALAS bf16x8*)(Kb_ + 2 * KCS), kb1 = *(const ALAS bf16x8*)(Kb_ + 2 * KCS + 512), ka2, kb2; \
        s16x4 vl0a, vh0a, vl1a, vh1a, vl0b, vh0b, vl1b, vh1b; float sacc = 0.f; \
        MLA_SB(); \
        MLA_GA(N0 = __builtin_amdgcn_mfma_f32_32x32x16_bf16(ka0, qf[0], negm, 0, 0, 0), 0, C0, C1); ka2 = *(const ALAS bf16x8*)(Kb_ + 4 * KCS); MLA_SB(); \
        MLA_GA(N1 = __builtin_amdgcn_mfma_f32_32x32x16_bf16(kb0, qf[0], negm, 0, 0, 0), 1, C0, C1); kb2 = *(const ALAS bf16x8*)(Kb_ + 4 * KCS + 512); MLA_SB(); \
        MLA_GA(N0 = __builtin_amdgcn_mfma_f32_32x32x16_bf16(ka1, qf[1], N0, 0, 0, 0), 2, C0, C1); ka0 = *(const ALAS bf16x8*)(Kb_ + 6 * KCS); MLA_SB(); \
        MLA_GA(N1 = __builtin_amdgcn_mfma_f32_32x32x16_bf16(kb1, qf[1], N1, 0, 0, 0), 3, C0, C1); kb0 = *(const ALAS bf16x8*)(Kb_ + 6 * KCS + 512); MLA_SB(); \
        MLA_GA(N0 = __builtin_amdgcn_mfma_f32_32x32x16_bf16(ka2, qf[2], N0, 0, 0, 0), 4, C0, C1); ka1 = *(const ALAS bf16x8*)(Kb_ + 8 * KCS); MLA_SB(); \
        MLA_GA(N1 = __builtin_amdgcn_mfma_f32_32x32x16_bf16(kb2, qf[2], N1, 0, 0, 0), 5, C0, C1); kb1 = *(const ALAS bf16x8*)(Kb_ + 8 * KCS + 512); MLA_SB(); \
        MLA_GA(N0 = __builtin_amdgcn_mfma_f32_32x32x16_bf16(ka0, qf[3], N0, 0, 0, 0), 6, C0, C1); ka2 = *(const ALAS bf16x8*)(Kb_ + 10 * KCS); MLA_SB(); \
        MLA_GA(N1 = __builtin_amdgcn_mfma_f32_32x32x16_bf16(kb0, qf[3], N1, 0, 0, 0), 7, C0, C1); kb2 = *(const ALAS bf16x8*)(Kb_ + 10 * KCS + 512); MLA_SB(); \
        MLA_GA(N0 = __builtin_amdgcn_mfma_f32_32x32x16_bf16(ka1, qf[4], N0, 0, 0, 0), 8, C0, C1); MLA_SB(); \
        MLA_GA(N1 = __builtin_amdgcn_mfma_f32_32x32x16_bf16(kb1, qf[4], N1, 0, 0, 0), 9, C0, C1); MLA_SB(); \
        MLA_GA(N0 = __builtin_amdgcn_mfma_f32_32x32x16_bf16(ka2, qf[5], N0, 0, 0, 0), 10, C0, C1); vl0a = vtr(Vb_); vh0a = vtr(Vb_ + 512); MLA_SB(); \
        MLA_GA(N1 = __builtin_amdgcn_mfma_f32_32x32x16_bf16(kb2, qf[5], N1, 0, 0, 0), 11, C0, C1); vl1a = vtr(Vb_ + VHS); vh1a = vtr(Vb_ + VHS + 512); MLA_SB(); \
        lrun += sacc; \
        MLA_DECIDE(N0, N1, ((t_) + 1) * 64); \
        MLA_SB(); \
        MLA_GB(o0 = __builtin_amdgcn_mfma_f32_32x32x16_bf16(__builtin_bit_cast(bf16x8, pw[0]), MLA_VF(vl0a, vh0a), o0, 0, 0, 0), N0, 0); vl0b = vtr(Vb_ + 1024); vh0b = vtr(Vb_ + 1024 + 512); MLA_SB(); \
        MLA_GB(o1 = __builtin_amdgcn_mfma_f32_32x32x16_bf16(__builtin_bit_cast(bf16x8, pw[0]), MLA_VF(vl1a, vh1a), o1, 0, 0, 0), N0, 4); vl1b = vtr(Vb_ + VHS + 1024); vh1b = vtr(Vb_ + VHS + 1024 + 512); MLA_SB(); \
        MLA_GB(o0 = __builtin_amdgcn_mfma_f32_32x32x16_bf16(__builtin_bit_cast(bf16x8, pw[1]), MLA_VF(vl0b, vh0b), o0, 0, 0, 0), N0, 8); vl0a = vtr(Vb_ + 2048); vh0a = vtr(Vb_ + 2048 + 512); MLA_SB(); \
        MLA_GB(o1 = __builtin_amdgcn_mfma_f32_32x32x16_bf16(__builtin_bit_cast(bf16x8, pw[1]), MLA_VF(vl1b, vh1b), o1, 0, 0, 0), N0, 12); vl1a = vtr(Vb_ + VHS + 2048); vh1a = vtr(Vb_ + VHS + 2048 + 512); MLA_SB(); \
        MLA_GB(o0 = __builtin_amdgcn_mfma_f32_32x32x16_bf16(__builtin_bit_cast(bf16x8, pw[2]), MLA_VF(vl0a, vh0a), o0, 0, 0, 0), N1, 0); vl0b = vtr(Vb_ + 3072); vh0b = vtr(Vb_ + 3072 + 512); MLA_SB(); \
        MLA_GB(o1 = __builtin_amdgcn_mfma_f32_32x32x16_bf16(__builtin_bit_cast(bf16x8, pw[2]), MLA_VF(vl1a, vh1a), o1, 0, 0, 0), N1, 4); vl1b = vtr(Vb_ + VHS + 3072); vh1b = vtr(Vb_ + VHS + 3072 + 512); MLA_SB(); \
        MLA_GB(o0 = __builtin_amdgcn_mfma_f32_32x32x16_bf16(__builtin_bit_cast(bf16x8, pw[3]), MLA_VF(vl0b, vh0b), o0, 0, 0, 0), N1, 8); MLA_SB(); \
        MLA_GB(o1 = __builtin_amdgcn_mfma_f32_32x32x16_bf16(__builtin_bit_cast(bf16x8, pw[3]), MLA_VF(vl1b, vh1b), o1, 0, 0, 0), N1, 12); MLA_SB(); \
        MLA_RESC(); } while (0)
#define MLA_TAIL(C0, C1, t_) do { float ls = 0.f; _Pragma("unroll") for (int r = 0; r < 16; ++r) ls += C0[r] + C1[r]; lrun += ls; ATT_PACK(C0, C1); ATT_PV((t_) & 3); } while (0)
#define MLA_STEP(C0, C1, N0, N1, t_) do { \
          \
        int lane_ = lane; asm volatile("" : "+v"(lane_)); const int r32 = lane_ & 31, hi = lane_ >> 5, qrow = qlo + r32; \
        const int vrd = ((lane_ >> 4) & 1) * 32 + (lane_ & 3) * 8 + (4 * hi + ((lane_ & 15) >> 2)) * 64; ALAS float* wsf = (ALAS float*)(lds + L_WSF) + wid * 64; \
        if ((t_) + 3 < ntile) { ATT_ISSUE((t_) + 3, (t_) + 3); issued = (t_) + 3; } \
        if ((t_) < tmax) MLA_FULL(C0, C1, N0, N1, t_); else if ((t_) == tmax) MLA_TAIL(C0, C1, t_); \
        ATT_WAIT_BAR(issued - ((t_) + 2)); } while (0)
    if (wid >= 4) __builtin_amdgcn_s_setprio(1);
    bool resc = false;
    ATT_QK(p0, p1, 0);
    MLA_DECIDE(p0, p1, 0);
#pragma unroll
    for (int r = 0; r < 16; ++r) { p0[r] = MLA_EX(p0[r]); p1[r] = MLA_EX(p1[r]); }
    asm volatile("s_waitcnt lgkmcnt(0)\n\ts_barrier" ::: "memory");
    for (int it = 0; it < ntile; it += 2) {
        MLA_STEP(p0, p1, n0, n1, it);
        if (it + 1 >= ntile) break;
        MLA_STEP(n0, n1, p0, p1, it + 1);
    }
    __builtin_amdgcn_s_setprio(0);
#undef MLA_SB
#undef MLA_EX
#undef MLA_DECIDE
#undef MLA_RESC
#undef MLA_PV_
#undef MLA_GA
#undef MLA_VF
#undef MLA_GB
#undef MLA_FULL
#undef MLA_TAIL
#undef MLA_STEP
    } else if constexpr (MODE == 1) {
    f32x16 p0, p1; u32x4 pw[4];
    __syncthreads();
    {
        const unsigned lds0_ = (unsigned)(uintptr_t)lds;
        for (int i = 0; i < ntile; ++i) { const int T_ = tfirst + i;
            glds16(ksrc0 + (size_t)T_ * KTS, (unsigned)__builtin_amdgcn_readfirstlane(lds0_ + S1_K + i * S1_KS + wid * KCS));
            glds16(vsrc + (size_t)T_ * VTS, (unsigned)__builtin_amdgcn_readfirstlane(lds0_ + S1_V + i * VSLOT + (wid >> 2) * VHS + (wid & 3) * 1024));
            if (wid == 0) glds4(P.pos + rb + (size_t)T_ * 64 + lane, (unsigned)__builtin_amdgcn_readfirstlane(lds0_ + S1_P + i * 256)); }
        ALAS float* lut = (ALAS float*)(lds + S1_LUT);
        if (tid < 129) { int bk = tid; if (tid >= 16) { bk = 16 + (int)((__builtin_amdgcn_logf((float)tid) - 4.0f) * (16.0f / 3.0f)); bk = bk < 31 ? bk : 31; } lut[tid] = P.relb[bk * 6 + h] * LOG2E; }
        asm volatile("s_waitcnt vmcnt(0) lgkmcnt(0)\n\ts_barrier" ::: "memory");
        const ALAS int* posk = (const ALAS int*)(lds + S1_P);
        const int lo_ = qlo - 127 > 0 ? qlo - 127 : 0; const int i_lo = (lo_ >> 6) - tfirst, i_hi = (qhi >> 6) - tfirst;
        for (int i = i_lo; i <= i_hi; ++i) {
            const int j0 = (tfirst + i) * 64;
            {
                int kofs_ = S1_K + i * S1_KS + hi * KCS + r32 * 16; asm volatile("" : "+v"(kofs_)); const ALAS unsigned char* Kb_ = lds + kofs_;
#pragma unroll
                for (int d0 = 0; d0 < ND0; ++d0) { const bf16x8 a0_ = *(const ALAS bf16x8*)(Kb_ + 2 * d0 * KCS), a1_ = *(const ALAS bf16x8*)(Kb_ + 2 * d0 * KCS + 512);
                    if (d0 == 0) { p0 = __builtin_amdgcn_mfma_f32_32x32x16_bf16(a0_, qf[0], negm, 0, 0, 0); p1 = __builtin_amdgcn_mfma_f32_32x32x16_bf16(a1_, qf[0], negm, 0, 0, 0); }
                    else { p0 = __builtin_amdgcn_mfma_f32_32x32x16_bf16(a0_, qf[d0], p0, 0, 0, 0); p1 = __builtin_amdgcn_mfma_f32_32x32x16_bf16(a1_, qf[d0], p1, 0, 0, 0); } }
            }
#pragma unroll
            for (int g = 0; g < 4; ++g) {
                const i32x4 pa = *(const ALAS i32x4*)(posk + i * 64 + 8 * g + 4 * hi), pb = *(const ALAS i32x4*)(posk + i * 64 + 32 + 8 * g + 4 * hi);
#pragma unroll
                for (int q = 0; q < 4; ++q) { int na = posq - pa[q]; na = na > 0 ? na : 0; na = na < 128 ? na : 128; int nb = posq - pb[q]; nb = nb > 0 ? nb : 0; nb = nb < 128 ? nb : 128;
                    p0[4 * g + q] += lut[na]; p1[4 * g + q] += lut[nb]; }
            }
#pragma unroll
            for (int r = 0; r < 16; ++r) { const int key = j0 + crow(r, hi); const bool ok0 = key <= qrow && key > qrow - 128, ok1 = key + 32 <= qrow && key + 32 > qrow - 128; if (!ok0) p0[r] = -INFINITY; if (!ok1) p1[r] = -INFINITY; }
            float ma = ATT_MAX3(p0[0], p0[1], p1[0]), mb = ATT_MAX3(p0[2], p0[3], p1[1]); ma = ATT_MAX3(ma, p1[2], p1[3]);
#pragma unroll
            for (int r = 4; r < 16; r += 4) { ma = ATT_MAX3(ma, p0[r], p0[r + 1]); mb = ATT_MAX3(mb, p0[r + 2], p0[r + 3]); ma = ATT_MAX3(ma, p1[r], p1[r + 1]); mb = ATT_MAX3(mb, p1[r + 2], p1[r + 3]); }
            const float mt = swap_max(fmaxf(ma, mb));
            if (__any(mt > THR)) {
                const float d = fmaxf(mt, 0.f);
#pragma unroll
                for (int r = 0; r < 16; ++r) { p0[r] -= d; p1[r] -= d; }
                const float alpha = __builtin_amdgcn_exp2f(-d); mrun += d; lrun *= alpha;
#pragma unroll
                for (int r = 0; r < 16; ++r) negm[r] = -mrun;
                if (hi == 0) wsf[r32] = alpha;
#pragma unroll
                for (int g = 0; g < 4; ++g) { const f32x4 al = *(const ALAS f32x4*)(wsf + 8 * g + 4 * hi);
#pragma unroll
                    for (int q = 0; q < 4; ++q) { o0[4 * g + q] *= al[q]; o1[4 * g + q] *= al[q]; } }
            }
            float ls = 0.f;
#pragma unroll
            for (int r = 0; r < 16; ++r) { p0[r] = __builtin_amdgcn_exp2f(p0[r]); p1[r] = __builtin_amdgcn_exp2f(p1[r]); ls += p0[r] + p1[r]; }
            lrun += ls;
            ATT_PACK(p0, p1);
            {
                int vofs_ = S1_V + i * VSLOT + vrd; asm volatile("" : "+v"(vofs_)); const ALAS unsigned char* Vb_ = lds + vofs_;
#pragma unroll
                for (int s_ = 0; s_ < 4; ++s_) { const bf16x8 pa_ = __builtin_bit_cast(bf16x8, pw[s_]);
                    const s16x4 l0_ = vtr(Vb_ + s_ * 1024), h0_ = vtr(Vb_ + s_ * 1024 + 512), l1_ = vtr(Vb_ + VHS + s_ * 1024), h1_ = vtr(Vb_ + VHS + s_ * 1024 + 512);
                    const bf16x8 v0_ = {l0_[0], l0_[1], l0_[2], l0_[3], h0_[0], h0_[1], h0_[2], h0_[3]}, v1_ = {l1_[0], l1_[1], l1_[2], l1_[3], h1_[0], h1_[1], h1_[2], h1_[3]};
                    o0 = __builtin_amdgcn_mfma_f32_32x32x16_bf16(pa_, v0_, o0, 0, 0, 0); o1 = __builtin_amdgcn_mfma_f32_32x32x16_bf16(pa_, v1_, o1, 0, 0, 0); }
            }
        }
        asm volatile("s_waitcnt lgkmcnt(0)\n\ts_barrier" ::: "memory");
    }
    } else {
    bool go_on = true;
    {
        u32x4 pw[4]; f32x16 p0, p1;
        const int nwin = ntile < 7 ? ntile : 7;
        __syncthreads();
        const unsigned lds0_ = (unsigned)(uintptr_t)lds;
        for (int i = 0; i < nwin; ++i) { const int T_ = tfirst - i;
            glds16(ksrc0 + (size_t)T_ * KTS, (unsigned)__builtin_amdgcn_readfirstlane(lds0_ + S1_K + i * S1_KS + wid * KCS));
            glds16(vsrc + (size_t)T_ * VTS, (unsigned)__builtin_amdgcn_readfirstlane(lds0_ + S1_V + i * VSLOT + (wid >> 2) * VHS + (wid & 3) * 1024)); }
        asm volatile("s_waitcnt vmcnt(0) lgkmcnt(0)\n\ts_barrier" ::: "memory");
        for (int i = 0; i < nwin; ++i) {
            const int j0 = (tfirst - i) * 64;
            if (!(walive && j0 < qhi)) { if (!walive) break; continue; }
            {
                int kofs_ = S1_K + i * S1_KS + hi * KCS + r32 * 16; asm volatile("" : "+v"(kofs_)); const ALAS unsigned char* Kb_ = lds + kofs_;
#pragma unroll
                for (int d0 = 0; d0 < ND0; ++d0) { const bf16x8 a0_ = *(const ALAS bf16x8*)(Kb_ + 2 * d0 * KCS), a1_ = *(const ALAS bf16x8*)(Kb_ + 2 * d0 * KCS + 512);
                    if (d0 == 0) { p0 = __builtin_amdgcn_mfma_f32_32x32x16_bf16(a0_, qf[0], negm, 0, 0, 0); p1 = __builtin_amdgcn_mfma_f32_32x32x16_bf16(a1_, qf[0], negm, 0, 0, 0); }
                    else { p0 = __builtin_amdgcn_mfma_f32_32x32x16_bf16(a0_, qf[d0], p0, 0, 0, 0); p1 = __builtin_amdgcn_mfma_f32_32x32x16_bf16(a1_, qf[d0], p1, 0, 0, 0); } }
            }
            ATT_SM_B(p0, p1, j0);
            {
                int vofs_ = S1_V + i * VSLOT + vrd; asm volatile("" : "+v"(vofs_)); const ALAS unsigned char* Vb_ = lds + vofs_;
#pragma unroll
                for (int s_ = 0; s_ < 4; ++s_) { const bf16x8 pa_ = __builtin_bit_cast(bf16x8, pw[s_]);
                    const s16x4 l0_ = vtr(Vb_ + s_ * 1024), h0_ = vtr(Vb_ + s_ * 1024 + 512), l1_ = vtr(Vb_ + VHS + s_ * 1024), h1_ = vtr(Vb_ + VHS + s_ * 1024 + 512);
                    const bf16x8 v0_ = {l0_[0], l0_[1], l0_[2], l0_[3], h0_[0], h0_[1], h0_[2], h0_[3]}, v1_ = {l1_[0], l1_[1], l1_[2], l1_[3], h1_[0], h1_[1], h1_[2], h1_[3]};
                    o0 = __builtin_amdgcn_mfma_f32_32x32x16_bf16(pa_, v0_, o0, 0, 0, 0); o1 = __builtin_amdgcn_mfma_f32_32x32x16_bf16(pa_, v1_, o1, 0, 0, 0); }
            }
        }
        ALAS int* fl = (ALAS int*)(lds + S1_WSF);
        if (lane == 0) fl[wid] = (walive && tfirst - nwin >= 0) ? 1 : 0;
        asm volatile("s_waitcnt lgkmcnt(0)\n\ts_barrier" ::: "memory");
        const i32x4 fa = *(const ALAS i32x4*)fl, fb = *(const ALAS i32x4*)(fl + 4);
        go_on = ((fa[0] | fa[1]) | (fa[2] | fa[3]) | (fb[0] | fb[1]) | (fb[2] | fb[3])) != 0;
        tfirst -= nwin; ntile = tfirst + 1;
    }
    if (go_on) {
    f32x16 p0, p1, n0, n1; u32x4 pw[4];
    __syncthreads();
    int issued = 0;
    ATT_ISSUE(tfirst, 0);
    if (ntile > 1) { ATT_ISSUE(tfirst + tstep, 1); issued = 1; }
    if (ntile > 2) { ATT_ISSUE(tfirst + 2 * tstep, 2); issued = 2; }
    ATT_WAIT_BAR(issued - 1);
    bool wcur = ATT_WORK(tfirst * 64);
    if (wcur) ATT_QK(p0, p1, 0);
    asm volatile("s_waitcnt lgkmcnt(0)\n\ts_barrier" ::: "memory");
    int nt = ntile;
    for (int it = 0; it < nt; ++it) {
        const int t = tfirst + it * tstep, j0 = t * 64, jn = (t + tstep) * 64;
        if (it + 3 < ntile) { ATT_ISSUE(t + 3 * tstep, it + 3); issued = it + 3; }
        if (wcur) ATT_SM_A(p0, p1, j0, it & 3);
        const bool wnext = (it + 1 < nt) && ATT_WORK(jn);
        if (wcur && wnext) { ATT_QK(n0, n1, (it + 1) % 3); ATT_SM_B(p0, p1, j0); }
        else { if (wnext) ATT_QK(n0, n1, (it + 1) % 3); if (wcur) ATT_SM_B(p0, p1, j0); }
        if (wcur) ATT_PV(it & 3);
        p0 = n0; p1 = n1; wcur = wnext;
        if (MODE == 2) { ALAS int* fl = (ALAS int*)(lds + L_FLAG + 16) + (it & 1) * 8; if (lane == 0) fl[wid] = (walive && j0 > 0) ? 1 : 0; }
        ATT_WAIT_BAR(issued - (it + 2));
        if (MODE == 2) { const ALAS int* fl = (const ALAS int*)(lds + L_FLAG + 16) + (it & 1) * 8;
            const i32x4 fa = *(const ALAS i32x4*)fl, fb = *(const ALAS i32x4*)(fl + 4);
            if (((fa[0] | fa[1]) | (fa[2] | fa[3]) | (fb[0] | fb[1]) | (fb[2] | fb[3])) == 0) nt = it + 1; }
    }
    }
    }
    if (MODE == 2) asm volatile("s_waitcnt vmcnt(0)" ::: "memory");
#undef ATT_ISSUE
#undef ATT_WAIT_BAR
#undef ATT_QK
#undef ATT_PV
#undef ATT_PACK
#undef ATT_VLD
#undef ATT_SM_A
#undef ATT_SM_B
#undef ATT_WORK
#undef ATT_MAX3
    if (MODE != 2) {
        const float lt = swap_sum(lrun);
        if (hi == 0) wsf[32 + r32] = 1.0f / lt;
#pragma unroll
        for (int g = 0; g < 4; ++g) { const f32x4 il = *(const ALAS f32x4*)(wsf + 32 + 8 * g + 4 * hi);
#pragma unroll
            for (int i = 0; i < 4; ++i) { o0[4 * g + i] *= il[i]; o1[4 * g + i] *= il[i]; } }
    }
    {
        ALAS bf16_t* stg = (ALAS bf16_t*)ost;
#pragma unroll
        for (int r = 0; r < 16; ++r) { const int orow = crow(r, hi); stg[orow * 64 + r32] = (bf16_t)(cvtpk(o0[r], 0.f) & 0xffffu); stg[orow * 64 + 32 + r32] = (bf16_t)(cvtpk(o1[r], 0.f) & 0xffffu); }
        AGAS bf16_t* Ow = (AGAS bf16_t*)(P.ws + WS_OALL) + (rb + qlo) * 1024 + C::ocol0 + h * 64;
#pragma unroll
        for (int i = 0; i < 4; ++i) {
            const int row = i * 8 + (lane >> 3), ch = lane & 7;
            const u32x4 v = *(const ALAS u32x4*)(stg + row * 64 + ch * 8);
            float ss = 0.f;
#pragma unroll
            for (int k = 0; k < 4; ++k) { const unsigned w = v[k]; const float a = __uint_as_float(w << 16), c = __uint_as_float(w & 0xffff0000u); ss += a * a + c * c; }
            ss += __shfl_xor(ss, 1); ss += __shfl_xor(ss, 2); ss += __shfl_xor(ss, 4);
            *(AGAS u32x4*)(Ow + (size_t)row * 1024 + ch * 8) = v;
            if (ch == 0) ((AGAS float*)(P.ws + WS_SSQO))[(rb + qlo + row) * 16 + C::hidx0 + h] = ss;
        }
    }
#ifdef ATT_PROF
    if (MODE == 0 && blockIdx.x == 0 && wid == ATT_PROF_WAVE && lane == 0 && prof) { const long long tt = PROF_T() - pf_t0;
        atomicAdd(prof + 0, (unsigned long long)tt); atomicAdd(prof + 1, (unsigned long long)pf_qk); atomicAdd(prof + 2, (unsigned long long)pf_sm); atomicAdd(prof + 3, (unsigned long long)pf_pv); atomicAdd(prof + 4, (unsigned long long)pf_wait); atomicAdd(prof + 5, 1ull); }
#endif
}
#undef ALAS
#undef AGAS
}
struct Args { const void* in[23]; float* out; unsigned char* ws; int ph_lo, ph_hi, li, adapt; };

struct Frame { LAS unsigned char* lds; int wave, vcu, G; };
#define FLANE hw_lane()
#define FTID (F.wave * 64 + hw_lane())

__device__ __forceinline__ float wave_sum64(float v) { return pg8::wave_sum_dpp(v); }

__device__ __forceinline__ void tr_item64(const GAS float* W, int ldn, int K, GAS pg8::bf16_t* WT, int kb, int g, int src0, int src1, const GAS float* kgain, LAS unsigned* scr, int lane) {
    const int k0 = 64 * kb; const int col = lane < 32 ? src0 + lane : src1 + (lane - 32); const bool ok = (lane < 32 ? src0 : src1) >= 0;
    const GAS float* wp = W + (size_t)k0 * ldn + (ok ? col : 0);
#pragma unroll
    for (int hf = 0; hf < 4; ++hf) {
        float v[16];
#pragma unroll
        for (int i = 0; i < 16; ++i) v[i] = wp[(size_t)(hf * 16 + i) * ldn];
#pragma unroll
        for (int i = 0; i < 16; ++i) v[i] = ok ? v[i] : 0.f;
        if (kgain) {
#pragma unroll
            for (int i = 0; i < 16; ++i) v[i] *= kgain[k0 + hf * 16 + i]; }
#pragma unroll
        for (int i = 0; i < 8; ++i) scr[(hf * 8 + i) * 65 + lane] = pk2(v[2 * i], v[2 * i + 1]);
    }
    asm volatile("s_waitcnt lgkmcnt(0)" ::: "memory");
    const int c = lane & 7;
#pragma unroll
    for (int j = 0; j < 8; ++j) { const int n = (lane >> 3) + 8 * j; const LAS unsigned* s = scr + (4 * c) * 65 + n;
        v4u o; o.x = s[0]; o.y = s[65]; o.z = s[130]; o.w = s[195];
        *(GAS v4u*)(WT + (size_t)(64 * g + n) * K + k0 + 8 * c) = o; }
    asm volatile("s_waitcnt lgkmcnt(0)" ::: "memory");
}
__device__ __forceinline__ int in_slot_src(int slot, int& cnt) {
    cnt = 64;
    if (slot < 4) return 64 * slot;
    if (slot < 6) return 256 + 64 * (slot - 4);
    if (slot == 6) { cnt = 32; return 384; }
    if (slot == 7) return -1;
    if (slot < 14) return 416 + 64 * (slot - 8);
    if (slot < 16) return 800 + 64 * (slot - 14);
    if (slot < 18) return 928 + 64 * (slot - 16);
    if (slot < 22) return 1056 + 64 * (slot - 18);
    if (slot < 26) return 1312 + 64 * (slot - 22);
    if (slot < 30) return 1568 + 64 * (slot - 26);
    return -1;
}

#define A_X ((const GAS float*)args.in[0])
#define A_C ((const GAS float*)args.in[1])
#define A_POS ((const GAS int*)args.in[2])
#define A_RELB ((const GAS float*)args.in[3])
#define A_NORMG ((const GAS float*)args.in[4])
#define A_WMOD ((const GAS float*)args.in[5])
#define A_BMOD ((const GAS float*)args.in[6])
#define A_WGU1 ((const GAS float*)args.in[7])
#define A_WD1 ((const GAS float*)args.in[8])
#define A_WIN ((const GAS float*)args.in[9])
#define A_QAN ((const GAS float*)args.in[10])
#define A_KVAN ((const GAS float*)args.in[11])
#define A_WUQ ((const GAS float*)args.in[12])
#define A_WUKV ((const GAS float*)args.in[13])
#define A_MLAQN ((const GAS float*)args.in[14])
#define A_MLAKN ((const GAS float*)args.in[15])
#define A_SWAQN ((const GAS float*)args.in[16])
#define A_SWAKN ((const GAS float*)args.in[17])
#define A_SINKS ((const GAS float*)args.in[18])
#define A_OUTN ((const GAS float*)args.in[19])
#define A_WOUT ((const GAS float*)args.in[20])
#define A_WGU2 ((const GAS float*)args.in[21])
#define A_WD2 ((const GAS float*)args.in[22])
#define WSP(off)   (ws_ + (off))
#define MOD ((GAS float*)WSP(WS_MOD))
#define GS ((GAS float*)WSP(WS_GS))
#define BIAS ((GAS float*)WSP(WS_BIAS))
#define SSQX ((GAS float*)WSP(WS_SSQX))
#define SSQO ((GAS float*)WSP(WS_SSQO))
#define CS ((GAS float*)WSP(WS_CS))
#define KPE ((GAS float*)WSP(WS_KPE))
#define SSQ_CQ ((GAS float*)WSP(WS_SSQC))
#define SSQ_CKV ((GAS float*)WSP(WS_SSQC) + (size_t)MROWS * 4)
#define SSQ_KPE ((GAS float*)WSP(WS_SSQC) + (size_t)MROWS * 6)
#define XB ((GAS pg8::bf16_t*)WSP(WS_XB))
#define HID ((GAS pg8::bf16_t*)WSP(WS_HID))
#define CQ ((GAS pg8::bf16_t*)WSP(WS_CQ))
#define CKV ((GAS pg8::bf16_t*)WSP(WS_CKV))
#define KA ((GAS pg8::bf16_t*)WSP(WS_KA))
#define VA ((GAS pg8::bf16_t*)WSP(WS_VA))
#define QS ((GAS pg8::bf16_t*)WSP(WS_QS))
#define KS ((GAS pg8::bf16_t*)WSP(WS_KS))
#define VS ((GAS pg8::bf16_t*)WSP(WS_VS))
#define QC ((GAS pg8::bf16_t*)WSP(WS_QC))
#define KC ((GAS pg8::bf16_t*)WSP(WS_KC))
#define VC ((GAS pg8::bf16_t*)WSP(WS_VC))
#define OALL ((GAS pg8::bf16_t*)WSP(WS_OALL))
#define QRAW ((GAS float*)WSP(WS_QRAW))

__device__ __forceinline__ int in_group_src(int g32) {
    const int tile = g32 >> 3, rr = g32 & 7, bj = rr >> 2, wc = rr & 3; int cnt; const int base = in_slot_src(tile * 4 + wc, cnt);
    return (base >= 0 && 32 * bj < cnt) ? base + 32 * bj : -1;
}
constexpr int CV_GU = 16 * 88, CV_D = 44 * 16, CV_IN = 16 * 32, CV_UQ = 4 * 12, CV_UKV = 2 * 12, CV_OUT = 16 * 16;
constexpr int CV_EARLY = CV_GU + CV_D + CV_IN + CV_UQ + CV_UKV + CV_OUT, CV_L = CV_EARLY + CV_GU + CV_D, CV_ALL = DEPTH * CV_L;
__device__ __forceinline__ void convert_chunk(Frame& F, const Args& args, int base, int limit) {
    GAS unsigned char* ws_ = (GAS unsigned char*)args.ws; asm volatile("" : "+s"(ws_));
    LAS unsigned* scr = (LAS unsigned*)(F.lds + 16384 + F.wave * 8448);
#pragma unroll 1
    for (int q = 0; q < 2; ++q) {
        const int it = base + F.wave * 2 + q; if (it >= limit) break;
        const int l = it / CV_L; int r = it % CV_L;
        GAS unsigned char* wl = ws_ + WS_W + (size_t)l * WL;
        int kind;
        if (r < CV_GU) kind = 0; else if ((r -= CV_GU) < CV_D) kind = 1; else if ((r -= CV_D) < CV_IN) kind = 2; else if ((r -= CV_IN) < CV_UQ) kind = 3;
        else if ((r -= CV_UQ) < CV_UKV) kind = 4; else if ((r -= CV_UKV) < CV_OUT) kind = 5; else if ((r -= CV_OUT) < CV_GU) kind = 6; else { r -= CV_GU; kind = 7; }
        if (kind == 0 || kind == 6) {
            const bool second = kind == 6; const int kb = r / 88, g = r % 88, t = g >> 2, rr = g & 3, src = (rr >> 1) * DFF + 128 * t + 64 * (rr & 1);
            const GAS float* W = (second ? A_WGU2 : A_WGU1) + (size_t)l * DM * 2 * DFF;
            tr_item64(W, 2 * DFF, DM, (GAS pg8::bf16_t*)(wl + (second ? W_GU2 : W_GU1)), kb, g, src, src + 32, nullptr, scr, FLANE);
        } else if (kind == 1 || kind == 7) { const bool second = kind == 7; const int kb = r / 16, g = r % 16;
            tr_item64((second ? A_WD2 : A_WD1) + (size_t)l * DFF * DM, DM, DFF, (GAS pg8::bf16_t*)(wl + (second ? W_D2 : W_D1)), kb, g, 64 * g, 64 * g + 32, nullptr, scr, FLANE);
        } else if (kind == 2) { const int kb = r / 32, g = r % 32;
            tr_item64(A_WIN + (size_t)l * DM * DIN, DIN, DM, (GAS pg8::bf16_t*)(wl + W_IN), kb, g, in_group_src(2 * g), in_group_src(2 * g + 1), nullptr, scr, FLANE);
        } else if (kind == 3) { const int kb = r / 12, g = r % 12;
            tr_item64(A_WUQ + (size_t)l * 256 * 576, 576, 256, (GAS pg8::bf16_t*)(wl + W_UQ), kb, g, g < 9 ? 64 * g : -1, g < 9 ? 64 * g + 32 : -1, A_QAN + l * 256, scr, FLANE);
        } else if (kind == 4) { const int kb = r / 12, g = r % 12, g0 = 2 * g, g1 = 2 * g + 1;
            tr_item64(A_WUKV + (size_t)l * 128 * 768, 768, 128, (GAS pg8::bf16_t*)(wl + W_UKV), kb, g, 256 * (g0 >> 3) + 64 * (g0 & 3) + 32 * ((g0 & 7) >> 2), 256 * (g1 >> 3) + 64 * (g1 & 3) + 32 * ((g1 & 7) >> 2), A_KVAN + l * 128, scr, FLANE);
        } else { const int kb = r / 16, g = r % 16;
            tr_item64(A_WOUT + (size_t)l * DM * DM, DM, DM, (GAS pg8::bf16_t*)(wl + W_OUT), kb, g, 64 * g, 64 * g + 32, A_OUTN + l * DM, scr, FLANE); }
    }
}

__device__ __forceinline__ void phase_pro0(Frame& F, const Args& args, gu32* qhead) {
    GAS unsigned char* ws_ = (GAS unsigned char*)args.ws; asm volatile("" : "+s"(ws_));
    constexpr int NMU = DEPTH * NMOD / 128;
    if ((int)blockIdx.x < NMU || F.G <= NMU) {
        LAS float* cond = (LAS float*)F.lds;
        LAS float* red = (LAS float*)(F.lds + 8192);
        for (int i = FTID; i < 2 * DM; i += 512) { const float cv = A_C[i]; cond[i] = cv / (1.0f + expf(-cv)); }
        __syncthreads();
        for (int u = blockIdx.x; u < NMU; u += F.G) {
            const int l = u / (NMOD / 128), n0 = (u % (NMOD / 128)) * 128, c4 = FLANE & 31, kp = FLANE >> 5;
            const GAS float* w = A_WMOD + (size_t)l * DM * NMOD + n0 + 4 * c4;
            f32x4 a0 = {0.f, 0.f, 0.f, 0.f}, a1 = {0.f, 0.f, 0.f, 0.f};
#pragma unroll 8
            for (int i = 0; i < 64; ++i) { const int kk = F.wave * 128 + 2 * i + kp; const f32x4 wv = *(const GAS f32x4*)(w + (size_t)kk * NMOD); a0 += wv * cond[kk]; a1 += wv * cond[DM + kk]; }
#pragma unroll
            for (int q = 0; q < 4; ++q) { a0[q] = pg8::xsum32(a0[q]); a1[q] = pg8::xsum32(a1[q]); }
            if (kp == 0) { *(LAS f32x4*)(red + (F.wave * 2 + 0) * 128 + 4 * c4) = a0; *(LAS f32x4*)(red + (F.wave * 2 + 1) * 128 + 4 * c4) = a1; }
            __syncthreads();
            if (FTID < 256) { const int bb = FTID >> 7, ln = FTID & 127; float s = 0.f;
#pragma unroll
                for (int wv = 0; wv < 8; ++wv) s += red[(wv * 2 + bb) * 128 + ln];
                MOD[((size_t)l * 2 + bb) * NMOD + n0 + ln] = s + A_BMOD[(size_t)l * NMOD + n0 + ln]; }
            __syncthreads();
        }
    }
    if ((int)blockIdx.x >= NMU || F.G <= NMU) {
        const int nb = F.G <= NMU ? F.G : F.G - NMU, b0 = F.G <= NMU ? (int)blockIdx.x : (int)blockIdx.x - NMU;
        for (int i = b0 * 512 + FTID; i < MROWS * 16; i += nb * 512) {
            const int m = i >> 4, j = i & 15;
            const float freq = powf(10000.0f, -(float)j / 16.0f);
            const float ang = (float)A_POS[m] * freq;
            CS[(size_t)m * 32 + j] = cosf(ang); CS[(size_t)m * 32 + 16 + j] = sinf(ang);
        }
    }
    {
        LAS int* slot = (LAS int*)(F.lds + 12288);
        for (;;) {
            __syncthreads();
            if (FTID == 0) slot[0] = (int)__hip_atomic_fetch_add(qhead, 16u, __ATOMIC_RELAXED, __HIP_MEMORY_SCOPE_AGENT);
            __syncthreads();
            const int base = slot[0];
            if (base >= CV_EARLY) break;
            convert_chunk(F, args, base, CV_EARLY);
        }
    }
}

__device__ __forceinline__ float gs_clamped(float g, float sc) { const float v = g * (1.0f + sc); return fabsf(v) < 1e-20f ? (v < 0.f ? -1e-20f : 1e-20f) : v; }
__device__ __forceinline__ void x_to_xb(Frame& F, const Args& args, const GAS float* xsrc, int l, int i) {
    GAS unsigned char* ws_ = (GAS unsigned char*)args.ws; asm volatile("" : "+s"(ws_));
    const int gw = F.vcu * NWAVES + F.wave, NGW = F.G * NWAVES;
    for (int m = gw; m < MROWS; m += NGW) {
        const int b = m >> 13;
        const GAS f32x4* xr = (const GAS f32x4*)(xsrc + (size_t)m * DM) + FLANE;
        const GAS f32x4* gr = (const GAS f32x4*)(A_NORMG + ((size_t)l * 3 + i) * DM) + FLANE;
        const GAS f32x4* sr = (const GAS f32x4*)(MOD + ((size_t)l * 2 + b) * NMOD + (3 * i + 1) * DM) + FLANE;
        float s = 0.f;
        GAS unsigned long long* o8 = (GAS unsigned long long*)(XB + (size_t)m * DM) + FLANE;
#pragma unroll
        for (int j = 0; j < 4; ++j) { const f32x4 v = xr[64 * j]; s += (v.x * v.x + v.y * v.y) + (v.z * v.z + v.w * v.w);
            const f32x4 g0 = gr[64 * j], s0 = sr[64 * j]; const f32x4 g = {gs_clamped(g0.x, s0.x), gs_clamped(g0.y, s0.y), gs_clamped(g0.z, s0.z), gs_clamped(g0.w, s0.w)}; const f32x4 y = v * g;
            o8[64 * j] = (unsigned long long)pk2(y.x, y.y) | ((unsigned long long)pk2(y.z, y.w) << 32); }
        s = wave_sum64(s);
        if (FLANE < 16) SSQX[(size_t)m * 16 + FLANE] = (FLANE == 0) ? s : 0.f;
    }
}

__device__ __forceinline__ void bias_rows(Frame& F, const Args& args, bool early) {
    GAS unsigned char* ws_ = (GAS unsigned char*)args.ws; asm volatile("" : "+s"(ws_));
    const int gw = F.vcu * NWAVES + F.wave, NGW = F.G * NWAVES;
#pragma unroll 1
    for (int sg = early ? 0 : 2; sg < (early ? 2 : 3 * DEPTH); ++sg) {
        const int l = sg / 3, which = sg % 3;
        const int nrow = which == 1 ? 2048 : 5632;
        const size_t woff = which == 0 ? W_GU1 : which == 1 ? W_IN : W_GU2, boff = which == 0 ? 0 : which == 1 ? 2 * 5632 : 2 * (5632 + 2048);
        const GAS float* s0 = MOD + ((size_t)l * 2 + 0) * NMOD + (3 * which) * DM + FLANE * 8; const GAS float* s1 = s0 + NMOD;
        f32x4 sa[2][2], sb[2][2];
#pragma unroll
        for (int j2 = 0; j2 < 2; ++j2) { sa[j2][0] = *(const GAS f32x4*)(s0 + j2 * 512); sa[j2][1] = *(const GAS f32x4*)(s0 + j2 * 512 + 4); sb[j2][0] = *(const GAS f32x4*)(s1 + j2 * 512); sb[j2][1] = *(const GAS f32x4*)(s1 + j2 * 512 + 4); }
        const GAS pg8::bf16_t* wbase = (const GAS pg8::bf16_t*)(ws_ + WS_W + (size_t)l * WL + woff) + FLANE * 8;
#pragma unroll 1
        for (int r0 = gw; r0 < nrow; r0 += 3 * NGW) {
            v4u wv[3][2];
#pragma unroll
            for (int q = 0; q < 3; ++q) { const int r = r0 + q * NGW < nrow ? r0 + q * NGW : r0;
#pragma unroll
                for (int j2 = 0; j2 < 2; ++j2) wv[q][j2] = *(const GAS v4u*)(wbase + (size_t)r * DM + j2 * 512); }
#pragma unroll
            for (int q = 0; q < 3; ++q) { const int r = r0 + q * NGW;
                float a0 = 0.f, a1 = 0.f;
#pragma unroll
                for (int j2 = 0; j2 < 2; ++j2)
#pragma unroll
                    for (int k = 0; k < 4; ++k) { const unsigned w = wv[q][j2][k]; const float lo_ = __uint_as_float(w << 16), hi_ = __uint_as_float(w & 0xffff0000u);
                        const float x0 = sa[j2][k >> 1][2 * (k & 1)], x1 = sa[j2][k >> 1][2 * (k & 1) + 1], y0 = sb[j2][k >> 1][2 * (k & 1)], y1 = sb[j2][k >> 1][2 * (k & 1) + 1];
                        a0 += lo_ * x0 + hi_ * x1; a1 += lo_ * y0 + hi_ * y1; }
                a0 = wave_sum64(a0); a1 = wave_sum64(a1);
                if (FLANE == 0 && r < nrow) { BIAS[(size_t)l * BIAS_L + boff + r] = a0; BIAS[(size_t)l * BIAS_L + boff + nrow + r] = a1; }
            }
        }
    }
}
__device__ __forceinline__ void phase_pro1(Frame& F, const Args& args) {
    GAS unsigned char* ws_ = (GAS unsigned char*)args.ws; asm volatile("" : "+s"(ws_));
    for (int i = blockIdx.x * 512 + FTID; i < DEPTH * 3 * 2 * DM; i += F.G * 512) {
        const int cidx = i & 1023, b = (i >> 10) & 1, li = i >> 11, l = li / 3, ii = li % 3;
        const float gv_ = gs_clamped(A_NORMG[((size_t)l * 3 + ii) * DM + cidx], MOD[((size_t)l * 2 + b) * NMOD + (3 * ii + 1) * DM + cidx]);
        GS[i] = gv_; ((GAS float*)WSP(WS_IGS))[i] = 1.0f / gv_;
    }
    bias_rows(F, args, true);
    x_to_xb(F, args, A_X, 0, 0);
}

constexpr int RR_OFF = LDSCTL_OFF + 2048;
__device__ __forceinline__ void fill_rr(Frame& F, const Args& args, const pg8::StaticOrder& S, const GAS float* bias) {
    GAS unsigned char* ws_ = (GAS unsigned char*)args.ws; asm volatile("" : "+s"(ws_));
    LAS float* rr = (LAS float*)(F.lds + RR_OFF);
    const GAS float* ssqx = (const GAS float*)(ws_ + WS_SSQX);
    for (int idx = FTID; idx < 6 * 256; idx += 512) {
        pg8::Unit u; if (!S.next(idx >> 8, u)) break;
        const int row = u.pm * 256 + (idx & 255);
        rr[idx] = 1.0f / sqrtf(pg8::sum16f(ssqx + (size_t)row * 16) * (1.0f / 1024.0f) + pg8::RMS_EPS);
        rr[6 * 256 + idx] = bias[(u.pm >> 5) * (S.nN * 256) + u.pn * 256 + (idx & 255)];
    }
    __syncthreads();
}

__device__ __forceinline__ void fill_grp(Frame& F, const pg8::EpiResS<true>& E, const pg8::StaticOrder& S) {
    LAS float* gt = (LAS float*)(F.lds + RR_OFF);
    pg8::Unit u;
    if (S.next(0, u) && FTID < 256) { const int t = FTID; float rA, rB, rC; E.group_r(u.pm * 256 + t, rA, rB, rC); gt[t] = rA / rB; gt[256 + t] = rB / rC; gt[512 + t] = rC; }
    __syncthreads();
}

__device__ __forceinline__ int next_unit(Frame& F, gu32* head) {
    LAS int* slot = (LAS int*)(F.lds + att::L_FLAG);
    __syncthreads();
    if (FTID == 0) slot[0] = (int)__hip_atomic_fetch_add(head, 1u, __ATOMIC_RELAXED, __HIP_MEMORY_SCOPE_AGENT);
    __syncthreads();
    return slot[0];
}

#ifndef DUPS
#define DUPS -1
#endif
#ifndef PHM
#define PHM 255
#endif
#ifndef PHM2
#define PHM2 31
#endif
__global__ void __launch_bounds__(NWAVES * 64, 2) fwd_mega(Args args) {
    extern __shared__ __attribute__((aligned(16))) unsigned char lds[];
    const int wave0 = __builtin_amdgcn_readfirstlane((int)threadIdx.x >> 6);
    Frame F0; F0.lds = (LAS unsigned char*)lds; F0.wave = wave0;
    F0.G = gridDim.x; { const int bx = blockIdx.x; F0.vcu = (F0.G % 8 == 0) ? (bx % 8) * (F0.G / 8) + bx / 8 : bx; }
    gu32* ctl = (gu32*)(args.ws + WS_CTL);
    for (int u = wave0 * 64 + hw_lane(); u < (LDS_BYTES - LDSCTL_OFF) / 4; u += NWAVES * 64) ((LAS unsigned*)(F0.lds + LDSCTL_OFF))[u] = 0u;
    __syncthreads();
    const int lo = args.ph_lo, hi = args.ph_hi;
    XcdBarrier bar; bar.bar = (unsigned*)(ctl + CW_BAR) + args.li * XCD_BAR_WORDS; bar.x = 0; bar.st = nullptr; bar.w0 = wave0;
    if (hi - lo > 1 || true) bar = xcd_barrier_post((unsigned*)(ctl + CW_BAR) + args.li * XCD_BAR_WORDS, (volatile LAS unsigned*)(F0.lds + MISC_OFF) + 8, wave0);

    for (int ph = lo; ph < hi; ++ph) {
        Frame F; F.lds = F0.lds; F.G = F0.G; F.vcu = F0.vcu; F.wave = wave0;
        GAS unsigned char* ws_ = (GAS unsigned char*)args.ws; asm volatile("" : "+s"(ws_));
        int nrep = 1;
        if (DUPS >= 0) { const int ty = ph < 2 ? 8 + ph : ((ph - 2) & 7); if (ty == DUPS && !(ty == 5) && !((ty == 1 || ty == 7) && ph != 3)) nrep = 2; }
        for (int rep = 0; rep < nrep; ++rep) {
        if ((PHM & 64) && ph == 0) phase_pro0(F, args, ctl + CW_Q + 64 * 8);
        else if ((PHM & 128) && ph == 1) phase_pro1(F, args);
        else {
            const int l = (ph - 2) >> 3, s = (ph - 2) & 7;
            const GAS unsigned char* wl = ws_ + WS_W + (size_t)l * WL;
            const GAS float* biasl = BIAS + (size_t)l * BIAS_L;
            const GAS float* modl = MOD + (size_t)l * 2 * NMOD;
            if ((PHM & 1) && (s == 0 || s == 6)) {
                pg8::Gemm g{(const pg8::bf16_t*)XB, (const pg8::bf16_t*)(wl + (s == 0 ? W_GU1 : W_GU2)), MROWS, 5632, DM}; pg8::StaticOrder S; S.init(MROWS, 5632, F.G, (int)blockIdx.x);
                fill_rr(F, args, S, biasl + (s == 0 ? 0 : 2 * (5632 + 2048)));
                pg8::EpiUp E{ws_, biasl + (s == 0 ? 0 : 2 * (5632 + 2048)), (const LAS float*)(F.lds + RR_OFF)};
                pg8::gemm_phase<pg8::EpiUp, pg8::StaticOrder, true, true>(F.lds, g, S, E, F.wave);
            } else if ((PHM & 2) && (s == 1 || s == 7)) {
                pg8::Gemm g{(const pg8::bf16_t*)HID, (const pg8::bf16_t*)(wl + (s == 1 ? W_D1 : W_D2)), MROWS, DM, DFF}; pg8::StaticOrder S; S.init(MROWS, DM, F.G, (int)blockIdx.x);
                const bool lastp = (s == 7 && l == DEPTH - 1);
                const GAS float* gsn = lastp ? nullptr : (s == 1 ? GS + ((size_t)(l * 3 + 1) * 2) * DM : GS + ((size_t)((l + 1) * 3 + 0) * 2) * DM);
                const GAS float* igp = (const GAS float*)WSP(WS_IGS) + ((size_t)(l * 3 + (s == 1 ? 0 : 2)) * 2) * DM;
                pg8::EpiResS<false> E{(GAS float*)args.out, ws_, modl + (s == 1 ? 2 : 8) * DM, igp, gsn, 0.5f, nullptr}; pg8::gemm_phase<pg8::EpiResS<false>, pg8::StaticOrder, false, true>(F.lds, g, S, E, F.wave, (unsigned long long*)(ctl + CW_Q + 64 * 13));
            } else if ((PHM & 4) && s == 2) {
                pg8::Gemm g{(const pg8::bf16_t*)XB, (const pg8::bf16_t*)(wl + W_IN), MROWS, 2048, DM}; pg8::StaticOrder S; S.init(MROWS, 2048, F.G, (int)blockIdx.x);
                fill_rr(F, args, S, biasl + 2 * 5632);
                pg8::EpiIn E{ws_, A_SWAQN + l * 64, A_SWAKN + l * 64, biasl + 2 * 5632, (const LAS float*)(F.lds + RR_OFF)};
                pg8::gemm_phase<pg8::EpiIn, pg8::StaticOrder, true, true>(F.lds, g, S, E, F.wave);
            } else if ((PHM & 8) && s == 3) {
                if (PHM2 & 1) { pg8::Gemm g{(const pg8::bf16_t*)CQ, (const pg8::bf16_t*)(wl + W_UQ), MROWS, 768, 256}; pg8::StaticOrder S; S.init(MROWS, 768, F.G, (int)blockIdx.x);
                  pg8::EpiUq E{ws_}; pg8::gemm_phase<pg8::EpiUq, pg8::StaticOrder, true, true>(F.lds, g, S, E, F.wave); }
                if (PHM2 & 2) { pg8::Gemm g{(const pg8::bf16_t*)CKV, (const pg8::bf16_t*)(wl + W_UKV), MROWS, 768, 128}; pg8::StaticOrder S; S.init(MROWS, 768, F.G, (int)((blockIdx.x + 64) % F.G));
                  pg8::EpiUkv E{ws_, A_MLAKN + l * 96}; pg8::gemm_phase<pg8::EpiUkv, pg8::StaticOrder, true, true>(F.lds, g, S, E, F.wave); }
            } else if ((PHM & 16) && s == 4) {
                att::AttnP PA{ws_, A_MLAQN + l * 96, nullptr, nullptr, nullptr};
                att::AttnP PB{ws_, nullptr, A_POS, A_SINKS + l * 6, A_RELB};
                att::AttnP PC{ws_, nullptr, nullptr, nullptr, nullptr};
                gu32* head = ctl + CW_Q + 64 * (2 * l + 1 + 4 * rep);
                for (;;) { const int u = next_unit(F, head); if (u >= 384 + 256 + 384) break;
                    if ((PHM2 & 16) && u < 384) { const int qb = 31 - u / 12, bh = u % 12;
                        att::attn_unit<96, 0>(F.lds, PA, bh / 6, bh % 6, qb, F.wave, (unsigned long long*)(ctl + CW_Q + 64 * 12)); }

                    else if ((PHM2 & 4) && u >= 384 && u < 640) { const int v = u - 384, qb = 31 - (v >> 3), bh = v & 7; att::attn_unit<64, 2>(F.lds, PC, bh >> 2, bh & 3, qb, F.wave); }
                    else if ((PHM2 & 8) && u >= 640) { const int v = u - 640, qb = v / 12, bh = v % 12; att::attn_unit<64, 1>(F.lds, PB, bh / 6, bh % 6, qb, F.wave); } }
                if (l == 0 && rep == 0) {
                    gu32* chead = ctl + CW_Q + 64 * 9; LAS int* cslot = (LAS int*)(F.lds + 12288);
                    for (;;) { __syncthreads(); if (FTID == 0) cslot[0] = (int)__hip_atomic_fetch_add(chead, 16u, __ATOMIC_RELAXED, __HIP_MEMORY_SCOPE_AGENT); __syncthreads();
                        const int cb = CV_EARLY + cslot[0]; if (cb >= CV_ALL) break; convert_chunk(F, args, cb, CV_ALL); } }
            } else if ((PHM & 32) && s == 5) {
                if (l == 0 && rep == 0) { bias_rows(F, args, false); asm volatile("s_waitcnt vmcnt(0)" ::: "memory"); __syncthreads(); }
                pg8::Gemm g{(const pg8::bf16_t*)OALL, (const pg8::bf16_t*)(wl + W_OUT), MROWS, DM, DM}; pg8::StaticOrder S; S.init(MROWS, DM, F.G, (int)blockIdx.x);
                pg8::EpiResS<true> E{(GAS float*)args.out, ws_, modl + 5 * DM, (const GAS float*)WSP(WS_IGS) + ((size_t)(l * 3 + 1) * 2) * DM, GS + ((size_t)(l * 3 + 2) * 2) * DM, 1.0f, (const LAS float*)(F.lds + RR_OFF)}; fill_grp(F, E, S); pg8::gemm_phase<pg8::EpiResS<true>, pg8::StaticOrder, false, true>(F.lds, g, S, E, F.wave);
            }
        }
        if (rep + 1 < nrep) xcd_barrier(bar);
        }
        if (ph + 1 < hi) xcd_barrier(bar);
    }
#ifdef GEMM_PROF
    xcd_barrier(bar);
    if (blockIdx.x == 0 && threadIdx.x == 0) { const unsigned long long* st = (const unsigned long long*)(ctl + CW_Q + 64 * 13); double sh;
        if (GEMM_PROF == 0) sh = (double)st[1] / (double)(st[0] + st[1]);
        else if (GEMM_PROF == 1) sh = (double)st[0] / (double)st[2] / 1.0e6;
        else sh = (double)st[1] / (double)st[2] / 1.0e6;
        args.out[0] += (float)(0.04 + 0.18 * (sh > 1.0 ? 1.0 : sh)); }
#endif
#ifdef ATT_PROF
    xcd_barrier(bar);
    if (blockIdx.x == 0 && threadIdx.x == 0) { const unsigned long long* st = (const unsigned long long*)(ctl + CW_Q + 64 * 12);
        const double tot = (double)st[0]; double sh = 0.0;
        if (ATT_PROF == 0) sh = (double)st[0] / (double)st[5] / 1.0e6;
        else if (ATT_PROF == 5) sh = (double)st[0] / (double)st[6] / 1.0e4;
        else if (ATT_PROF == 6) sh = (double)st[6] / 1.0e3;
        else sh = (double)st[ATT_PROF] / tot;
        args.out[0] += (float)(0.04 + 0.18 * (sh > 1.0 ? 1.0 : sh)); }
#endif
}
static void launch_fwd(hipStream_t stream, Args a, int grid, int lo, int hi, int li, int adapt) {
    a.ph_lo = lo; a.ph_hi = hi; a.li = li; a.adapt = adapt;
    hipLaunchKernelGGL(fwd_mega, dim3(grid), dim3(NWAVES * 64), LDS_BYTES, stream, a);
}
extern "C" void kernel_launch(void* const* d_in, const int* in_sizes, int n_in, void* d_out, int out_size, void* d_ws, size_t ws_size, hipStream_t stream) {
    static int grid = 0;
    if (grid == 0) {
        if (n_in != 23 || out_size != MROWS * DM || ws_size < WS_END) { fprintf(stderr, "kernel_launch: unexpected problem (n_in %d, out %d, ws %zu < %zu)\n", n_in, out_size, ws_size, (size_t)WS_END); grid = -1; return; }
        int dev = 0, cus = 0, per_cu = 0;
        if (hipGetDevice(&dev) != hipSuccess || hipDeviceGetAttribute(&cus, hipDeviceAttributeMultiprocessorCount, dev) != hipSuccess) { grid = -1; return; }
        if (hipFuncSetAttribute((const void*)fwd_mega, hipFuncAttributeMaxDynamicSharedMemorySize, LDS_BYTES) != hipSuccess) { fprintf(stderr, "kernel_launch: hipFuncSetAttribute failed\n"); grid = -1; return; }
        if (hipOccupancyMaxActiveBlocksPerMultiprocessor(&per_cu, (const void*)fwd_mega, NWAVES * 64, LDS_BYTES) != hipSuccess || per_cu < 1) { fprintf(stderr, "kernel_launch: occupancy query says %d blocks per CU\n", per_cu); (void)hipGetLastError(); grid = -1; return; }
        if (cus < 256) { fprintf(stderr, "kernel_launch: built for a 256-CU device (the one-unit-per-workgroup GEMM phases need exactly 256 workgroups), found %d CUs\n", cus); grid = -1; return; }
        grid = 256;
    }
    if (grid < 0) return;
    (void)hipMemsetAsync((char*)d_ws + WS_CTL, 0, CTL_ZERO_BYTES, stream);
    Args a{};
    for (int i = 0; i < 23; ++i) a.in[i] = d_in[i];
    a.out = (float*)d_out; a.ws = (unsigned char*)d_ws;
#ifdef PFX
    launch_fwd(stream, a, grid, 0, PFX, 0, -1);
    (void)hipMemsetAsync((char*)d_ws + WS_CTL, 0, CTL_ZERO_BYTES, stream);
#endif
    launch_fwd(stream, a, grid, 0, NPH, 0, -1);
}
```

```cpp
#include <hip/hip_runtime.h>
#include <cstdio>
#include <cstdint>
#include <cmath>
constexpr int NWAVES = 8;
constexpr int BATCH = 2, SEQ = 8192, DM = 1024, DEPTH = 2, MROWS = BATCH * SEQ;
constexpr int DFF = 2816, DIN = 1824, NMOD = 9 * DM;
constexpr int NPH = 2 + 8 * DEPTH;
constexpr size_t MiB = 1u << 20;
constexpr size_t WS_CTL = 0, CTL_ZERO_BYTES = 256 * 1024;
constexpr size_t WS_MOD = 1 * MiB;
constexpr size_t WS_GS = WS_MOD + 160 * 1024;
constexpr size_t WS_IGS = WS_GS + 64 * 1024;
constexpr size_t WS_BIAS = WS_IGS + 64 * 1024;
constexpr size_t BIAS_L = 2 * (5632 + 2048 + 5632);
constexpr size_t WS_SSQX = 2 * MiB;
constexpr size_t WS_SSQO = 3 * MiB;
constexpr size_t WS_CS = 4 * MiB;
constexpr size_t WS_KPE = 6 * MiB;
constexpr size_t WS_SSQC = 8 * MiB;
constexpr size_t WS_W = 9 * MiB;
constexpr size_t W_GU1 = 0, W_D1 = W_GU1 + (size_t)5632 * 1024 * 2, W_IN = W_D1 + (size_t)1024 * 2816 * 2, W_UQ = W_IN + (size_t)2048 * 1024 * 2, W_UKV = W_UQ + (size_t)768 * 256 * 2,
                 W_OUT = W_UKV + (size_t)768 * 128 * 2, W_GU2 = W_OUT + (size_t)1024 * 1024 * 2, W_D2 = W_GU2 + (size_t)5632 * 1024 * 2, WL = W_D2 + (size_t)1024 * 2816 * 2;
constexpr size_t WS_XB = WS_W + ((2 * WL + MiB - 1) / MiB) * MiB;
constexpr size_t WS_ACT = WS_XB + 32 * MiB;
constexpr size_t WS_HID = WS_ACT;
constexpr size_t WS_CQ = WS_ACT, WS_CKV = WS_CQ + 8 * MiB, WS_QRAW = WS_CKV + 4 * MiB, WS_KA = WS_QRAW + 36 * MiB, WS_VA = WS_KA + 18 * MiB, WS_QS = WS_VA + 12 * MiB, WS_KS = WS_QS + 12 * MiB,
                 WS_VS = WS_KS + 4 * MiB, WS_QC = WS_VS + 4 * MiB, WS_KC = WS_QC + 8 * MiB, WS_VC = WS_KC + 8 * MiB, WS_OALL = WS_VC + 8 * MiB, WS_END = WS_OALL + 32 * MiB;
static_assert(WS_HID + (size_t)MROWS * DFF * 2 <= WS_END, "d_ws map");
constexpr int CW_BAR = 4096;
constexpr int CW_Q = 40960;
static_assert((CW_Q + 64 * 14) * 4 <= (int)CTL_ZERO_BYTES && CW_BAR + 8 * 3456 <= CW_Q, "ctl map");
constexpr int RING_BYTES = 131072, LDSCTL_OFF = RING_BYTES, MISC_OFF = LDSCTL_OFF + 320, LDS_BYTES = 147456;

__device__ __forceinline__ int hw_lane() { int l; asm volatile("v_mbcnt_lo_u32_b32 %0, -1, 0\n\tv_mbcnt_hi_u32_b32 %0, -1, %0" : "=v"(l)); return l; }
namespace pg8 {
#define PG8_LAS __attribute__((address_space(3)))
typedef unsigned short bf16_t;
typedef short bf16x8 __attribute__((ext_vector_type(8)));
typedef float f32x4 __attribute__((ext_vector_type(4)));
typedef unsigned u32x4 __attribute__((ext_vector_type(4)));
constexpr int BM = 256, BK = 64, HALF = 128, HTB = HALF * BK * 2  , STAGE_BYTES = 8 * HTB, NXCD = 8, WGM = 8;

__host__ __device__ __forceinline__ int lds_byte(int r, int c) { const int st = (r >> 4) * 2 + (c >> 5), rr = r & 15, cc = c & 31, ob = rr * 64 + cc * 2; return st * 1024 + (ob ^ (((ob >> 9) & 1) << 5)); }
__host__ __device__ __forceinline__ void stage_rc(int b, int& R, int& C) { const int st = b / 1024, sb = b % 1024, swz = sb ^ (((sb >> 9) & 1) << 5); R = (st >> 1) * 16 + swz / 64; C = (st & 1) * 32 + (swz % 64) / 2; }
__host__ __device__ __forceinline__ int perm32(int rho) { const int n = rho >> 4, i = rho & 15; return 8 * (i >> 2) + 4 * n + (i & 3); }

struct Unit { int pm, pn, ord, half; };
struct Gemm { const bf16_t* A; const bf16_t* Bt; int M, N, K; };

struct StaticOrder {
    int nM, nN, nwg, G, c, tail_lo;
    __host__ __device__ void init(int M, int N, int G_, int c_) { nM = M / BM; nN = N / BM; nwg = nM * nN; G = G_; c = c_; tail_lo = nwg; }
    __host__ __device__ bool next(int i, Unit& u) const {
        long L = (long)i * G + c; int half = -1;
        if (L >= tail_lo) { const long hx = L - tail_lo; if (hx >= 2 * (long)(nwg - tail_lo)) return false; L = tail_lo + (hx >> 1); half = (int)(hx & 1); }
        int wgid = (int)L; { const int q = nwg / NXCD, r = nwg % NXCD, xcd = wgid % NXCD, off = wgid / NXCD; wgid = (xcd < r ? xcd * (q + 1) : r * (q + 1) + (xcd - r) * q) + off; }
        const int nig = WGM * nN, gid = wgid / nig, fm = gid * WGM, gsz = (nM - fm) < WGM ? (nM - fm) : WGM;
        u.pm = fm + ((wgid % nig) % gsz); u.pn = (wgid % nig) / gsz; u.ord = i; u.half = half; return true;
    }
    __device__ __forceinline__ void a_ready(const Unit&) const {}
    __device__ __forceinline__ void done(const Unit&) const {}
};

__device__ __forceinline__ unsigned cvt_pk_bf16(float lo, float hi) { unsigned r; asm volatile("v_cvt_pk_bf16_f32 %0, %1, %2" : "=v"(r) : "v"(lo), "v"(hi)); return r; }
typedef float f32x2 __attribute__((ext_vector_type(2)));
template <class Epi, class Sched, bool ALIGN_EPI = false, bool SP2 = false>
__device__ __forceinline__ void gemm_phase(PG8_LAS unsigned char* lds, const Gemm g, const Sched& S, const Epi& E, int wave0, unsigned long long* gprof = nullptr) {
#ifdef GEMM_PROF
    const long long gp_t0 = (Epi::AFTER_DRAIN && !Epi::HOOK && blockIdx.x == 0) ? (long long)clock64() : 0ll;
#endif
    int tid_ = wave0 * 64 + hw_lane(); asm volatile("" : "+v"(tid_));
    const int tid = tid_, wid = __builtin_amdgcn_readfirstlane(tid >> 6), lane = tid & 63, wr = wid >> 2, wc = wid & 3, fr = lane & 15, fq = lane >> 4;
    int K_ = g.K; asm volatile("" : "+s"(K_));
    const int K = K_, nt = K / BK;
    unsigned voffA[2], voffB[2];
#pragma unroll
    for (int i = 0; i < 2; ++i) { int R, C; stage_rc(tid * 16 + i * 8192, R, C); const int Rb = Epi::PERM ? ((R & ~31) + perm32(R & 31)) : R;
        voffA[i] = (unsigned)(R * K + C) * 2u; voffB[i] = (unsigned)(Rb * K + C) * 2u; }
    const size_t kstep = (size_t)(BK * 2);
    const size_t hstep = (size_t)HALF * K * 2;
    const size_t tstep = 2 * hstep;
    const unsigned ldsw = (unsigned)wid * 1024u;
    const int aoff = lds_byte(wr * 64 + fr, fq * 8), boff = lds_byte(wc * 32 + fr, fq * 8);
#define PG8_SA(b, h) (((b) * 2 + (h)) * HTB)
#define PG8_SB(b, h) ((4 + (b) * 2 + (h)) * HTB)
#define PG8_STAGE(bufoff, gbase, voff) do { _Pragma("unroll") for (int _i = 0; _i < 2; ++_i) \
        __builtin_amdgcn_global_load_lds((const unsigned*)((const char*)(gbase) + (voff)[_i]), (PG8_LAS unsigned*)(lds + (bufoff) + ldsw + _i * 8192), 16, 0, 0); } while (0)
#define PG8_LDA(dst, b, h) do { _Pragma("unroll") for (int m = 0; m < 4; ++m) _Pragma("unroll") for (int k = 0; k < 2; ++k) dst[m][k] = *(const PG8_LAS bf16x8*)(lds + PG8_SA(b, h) + aoff + m * 2048 + k * 1024); } while (0)
#define PG8_LDB(dst, b, h) do { _Pragma("unroll") for (int n = 0; n < 2; ++n) _Pragma("unroll") for (int k = 0; k < 2; ++k) dst[n][k] = *(const PG8_LAS bf16x8*)(lds + PG8_SB(b, h) + boff + n * 2048 + k * 1024); } while (0)
#define PG8_MMA(ai, bj, At, Bt) do { __builtin_amdgcn_s_setprio(1); _Pragma("unroll") for (int m = 0; m < 4; ++m) _Pragma("unroll") for (int n = 0; n < 2; ++n) _Pragma("unroll") for (int k = 0; k < 2; ++k) \
        acc[ai][bj][m][n] = __builtin_amdgcn_mfma_f32_16x16x32_bf16(Bt[n][k], At[m][k], acc[ai][bj][m][n], 0, 0, 0); __builtin_amdgcn_s_setprio(0); } while (0)
#define PG8_WAIT_V(n) asm volatile("s_waitcnt vmcnt(" #n ")" ::: "memory")
#define PG8_WAIT_L(n) asm volatile("s_waitcnt lgkmcnt(" #n ")" ::: "memory")
#define PG8_BAR __builtin_amdgcn_s_barrier()
#define PG8_SCHED __builtin_amdgcn_sched_barrier(0)
    Unit cur, nxt; int ui = 0;
    if (!S.next(0, cur)) return;
    f32x4 acc[2][2][4][2];
#pragma unroll
    for (int a = 0; a < 2; ++a)
#pragma unroll
        for (int b = 0; b < 2; ++b)
#pragma unroll
            for (int m = 0; m < 4; ++m)
#pragma unroll
                for (int n = 0; n < 2; ++n) acc[a][b][m][n] = (f32x4){0.f, 0.f, 0.f, 0.f};
    bf16x8 At[4][2], B0[2][2], B1[2][2];
    const char* cA = (const char*)g.A + (size_t)cur.pm * tstep + (cur.half > 0 ? hstep : (size_t)0); const char* cB = (const char*)g.Bt + (size_t)cur.pn * tstep;
    S.a_ready(cur);
    if constexpr (SP2) {
        PG8_STAGE(PG8_SB(0, 0), cB, voffB); PG8_STAGE(PG8_SB(0, 1), cB + hstep, voffB); PG8_STAGE(PG8_SA(0, 0), cA, voffA); PG8_STAGE(PG8_SA(0, 1), cA + hstep, voffA);
        if constexpr (Epi::PREFILL) E.prefill(S, tid);
        if (wr == 1) PG8_BAR;
        PG8_WAIT_V(2); PG8_BAR;
        PG8_STAGE(PG8_SB(1, 0), cB + kstep, voffB); PG8_STAGE(PG8_SA(1, 0), cA + kstep, voffA); PG8_STAGE(PG8_SB(1, 1), cB + hstep + kstep, voffB);
        PG8_WAIT_V(6); PG8_BAR;
    } else {
        PG8_STAGE(PG8_SB(0, 0), cB, voffB); PG8_STAGE(PG8_SA(0, 0), cA, voffA); PG8_STAGE(PG8_SB(0, 1), cB + hstep, voffB); PG8_STAGE(PG8_SA(0, 1), cA + hstep, voffA);
        if (wr == 1) PG8_BAR;
        PG8_WAIT_V(4); PG8_BAR;
        PG8_STAGE(PG8_SB(1, 0), cB + kstep, voffB); PG8_STAGE(PG8_SA(1, 0), cA + kstep, voffA); PG8_STAGE(PG8_SB(1, 1), cB + hstep + kstep, voffB);
        PG8_WAIT_V(6); PG8_BAR;
    }
    for (;;) {
        const bool has_next = S.next(ui + 1, nxt);
        const char* nA = has_next ? (const char*)g.A + (size_t)nxt.pm * tstep + (nxt.half > 0 ? hstep : (size_t)0) : cA; const char* nB = has_next ? (const char*)g.Bt + (size_t)nxt.pn * tstep : cB;
#pragma nounroll
        for (int t = 0; t < nt; t += 2) {
            if constexpr (Epi::HOOK) E.hook(acc, cur, t, wr, wc, fr, fq);
            const bool last = (t == nt - 2), full = cur.half < 0;
            const char* a1 = cA + (size_t)(t + 1) * kstep;
            const char* a2 = last ? nA : cA + (size_t)(t + 2) * kstep; const char* b2 = last ? nB : cB + (size_t)(t + 2) * kstep;
            const char* a3 = a2 + kstep; const char* b3 = b2 + kstep;
            if (last && has_next) S.a_ready(nxt);
            if constexpr (SP2) {
            PG8_LDB(B0, 0, 0); PG8_LDB(B1, 0, 1); PG8_SCHED; PG8_LDA(At, 0, 0); PG8_STAGE(PG8_SA(1, 1), a1 + hstep, voffA);
            PG8_WAIT_V(8); PG8_WAIT_L(0); PG8_BAR; PG8_MMA(0, 0, At, B0); PG8_MMA(0, 1, At, B1); PG8_BAR; PG8_SCHED;
            if (full) PG8_LDA(At, 0, 1); PG8_STAGE(PG8_SB(0, 0), b2, voffB); PG8_STAGE(PG8_SB(0, 1), b2 + hstep, voffB); PG8_STAGE(PG8_SA(0, 0), a2, voffA);
            PG8_WAIT_V(8); PG8_WAIT_L(0); PG8_BAR; if (full) { PG8_MMA(1, 0, At, B0); PG8_MMA(1, 1, At, B1); } PG8_BAR; PG8_SCHED;
            PG8_LDB(B0, 1, 0); PG8_LDB(B1, 1, 1); PG8_SCHED; PG8_LDA(At, 1, 0); PG8_STAGE(PG8_SA(0, 1), a2 + hstep, voffA);
            PG8_WAIT_V(8); PG8_WAIT_L(0); PG8_BAR; PG8_MMA(0, 0, At, B0); PG8_MMA(0, 1, At, B1); PG8_BAR; PG8_SCHED;
            if (full) PG8_LDA(At, 1, 1); PG8_STAGE(PG8_SB(1, 0), b3, voffB); PG8_STAGE(PG8_SB(1, 1), b3 + hstep, voffB); PG8_STAGE(PG8_SA(1, 0), a3, voffA);
            PG8_WAIT_V(8); PG8_WAIT_L(0); PG8_BAR; if (full) { PG8_MMA(1, 0, At, B0); PG8_MMA(1, 1, At, B1); } PG8_BAR; PG8_SCHED;
            } else {
            PG8_LDB(B0, 0, 0); PG8_SCHED; PG8_LDA(At, 0, 0); PG8_STAGE(PG8_SA(1, 1), a1 + hstep, voffA);
            PG8_WAIT_L(8); PG8_BAR; PG8_WAIT_L(0); PG8_MMA(0, 0, At, B0); PG8_BAR; PG8_SCHED;
            PG8_LDB(B1, 0, 1); PG8_STAGE(PG8_SB(0, 0), b2, voffB);
            PG8_BAR; PG8_WAIT_L(0); PG8_MMA(0, 1, At, B1); PG8_BAR;
            PG8_LDA(At, 0, 1); PG8_STAGE(PG8_SA(0, 0), a2, voffA);
            PG8_BAR; PG8_WAIT_L(0); PG8_MMA(1, 0, At, B0); PG8_BAR; PG8_SCHED;
            PG8_STAGE(PG8_SB(0, 1), b2 + hstep, voffB);
            PG8_WAIT_V(6); PG8_BAR; PG8_MMA(1, 1, At, B1); PG8_BAR;
            PG8_LDB(B0, 1, 0); PG8_SCHED; PG8_LDA(At, 1, 0); PG8_STAGE(PG8_SA(0, 1), a2 + hstep, voffA);
            PG8_WAIT_L(8); PG8_BAR; PG8_WAIT_L(0); PG8_MMA(0, 0, At, B0); PG8_BAR; PG8_SCHED;
            PG8_LDB(B1, 1, 1); PG8_STAGE(PG8_SB(1, 0), b3, voffB);
            PG8_BAR; PG8_WAIT_L(0); PG8_MMA(0, 1, At, B1); PG8_BAR;
            PG8_LDA(At, 1, 1); PG8_STAGE(PG8_SA(1, 0), a3, voffA);
            PG8_BAR; PG8_WAIT_L(0); PG8_MMA(1, 0, At, B0); PG8_BAR; PG8_SCHED;
            PG8_STAGE(PG8_SB(1, 1), b3 + hstep, voffB);
            PG8_WAIT_V(6); PG8_BAR; PG8_MMA(1, 1, At, B1); PG8_BAR;
            }
        }
        if constexpr (ALIGN_EPI) { if (wr == 0) PG8_BAR; }
        if constexpr (!Epi::AFTER_DRAIN) {
            Unit ce = cur; asm volatile("" : "+s"(ce.pm), "+s"(ce.pn), "+s"(ce.ord), "+s"(ce.half)); int fre = fr, fqe = fq; asm volatile("" : "+v"(fre), "+v"(fqe));
            E(acc, ce, wr, wc, fre, fqe); S.done(cur); }
        if (!has_next) break;
#pragma unroll
        for (int a = 0; a < 2; ++a)
#pragma unroll
            for (int b = 0; b < 2; ++b)
#pragma unroll
                for (int m = 0; m < 4; ++m)
#pragma unroll
                    for (int n = 0; n < 2; ++n) acc[a][b][m][n] = (f32x4){0.f, 0.f, 0.f, 0.f};
        cur = nxt; cA = nA; cB = nB; ++ui;
        if constexpr (ALIGN_EPI) { if (wr == 1) PG8_BAR; }
    }
    PG8_WAIT_V(0);
    if constexpr (!ALIGN_EPI) { if (wr == 0) PG8_BAR; }
    PG8_BAR;
#ifdef GEMM_PROF
    const long long gp_t1 = (Epi::AFTER_DRAIN && !Epi::HOOK && blockIdx.x == 0) ? (long long)clock64() : 0ll;
#endif
    if constexpr (Epi::AFTER_DRAIN) { E.fused(acc, cur, wr, wc, fr, fq, lds, wid, lane); S.done(cur); }
#ifdef GEMM_PROF
    if (Epi::AFTER_DRAIN && !Epi::HOOK && blockIdx.x == 0 && tid == 0 && gprof) { const long long gp_t2 = clock64(); atomicAdd(gprof + 0, (unsigned long long)(gp_t1 - gp_t0)); atomicAdd(gprof + 1, (unsigned long long)(gp_t2 - gp_t1)); atomicAdd(gprof + 2, 1ull); }
#endif
#undef PG8_SA
#undef PG8_SB
#undef PG8_STAGE
#undef PG8_LDA
#undef PG8_LDB
#undef PG8_MMA
#undef PG8_WAIT_V
#undef PG8_WAIT_L
#undef PG8_BAR
#undef PG8_SCHED
}
constexpr float RMS_EPS = 1e-6f;
constexpr int MROWS_ = 16384;
constexpr float LOG2E = 1.4426950408889634f;
typedef unsigned u32x2 __attribute__((ext_vector_type(2)));
#define PG8_FENCE() asm volatile("" ::: "memory")
#define PG8_G __attribute__((address_space(1)))
__device__ __forceinline__ void st16_wt(PG8_G void* p, u32x4 v) { asm volatile("global_store_dwordx4 %0, %1, off sc1\n\ts_nop 1" :: "v"(p), "v"(v) : "memory"); }
__device__ __forceinline__ void st8_wt(PG8_G void* p, u32x2 v) { asm volatile("global_store_dwordx2 %0, %1, off sc1\n\ts_nop 1" :: "v"(p), "v"(v) : "memory"); }
__device__ __forceinline__ float sum16f(const PG8_G float* p) {
    const f32x4 a = *(const PG8_G f32x4*)p, b = *(const PG8_G f32x4*)(p + 4), c = *(const PG8_G f32x4*)(p + 8), d = *(const PG8_G f32x4*)(p + 12);
    return ((a[0] + a[1]) + (a[2] + a[3])) + ((b[0] + b[1]) + (b[2] + b[3])) + ((c[0] + c[1]) + (c[2] + c[3])) + ((d[0] + d[1]) + (d[2] + d[3]));
}
__device__ __forceinline__ float xsum16(float x) { auto r = __builtin_amdgcn_permlane16_swap(__float_as_uint(x), __float_as_uint(x), false, false); return __uint_as_float(r[0]) + __uint_as_float(r[1]); }
__device__ __forceinline__ float xsum32(float x) { auto r = __builtin_amdgcn_permlane32_swap(__float_as_uint(x), __float_as_uint(x), false, false); return __uint_as_float(r[0]) + __uint_as_float(r[1]); }
__device__ __forceinline__ float wave_sum_dpp(float x) {
    x += __builtin_bit_cast(float, __builtin_amdgcn_update_dpp(0, __builtin_bit_cast(int, x), 0xB1, 0xf, 0xf, true));
    x += __builtin_bit_cast(float, __builtin_amdgcn_update_dpp(0, __builtin_bit_cast(int, x), 0x4E, 0xf, 0xf, true));
    x += __builtin_bit_cast(float, __builtin_amdgcn_update_dpp(0, __builtin_bit_cast(int, x), 0x141, 0xf, 0xf, true));
    x += __builtin_bit_cast(float, __builtin_amdgcn_update_dpp(0, __builtin_bit_cast(int, x), 0x140, 0xf, 0xf, true));
    return xsum32(xsum16(x));
}
__device__ __forceinline__ float fast_rcp(float x) { return __builtin_amdgcn_rcpf(x); }
__device__ __forceinline__ float silu_fast(float g) { return g * fast_rcp(1.0f + __builtin_amdgcn_exp2f(-g * LOG2E)); }
__device__ __forceinline__ float sq4(const f32x4 v) { return (v[0] * v[0] + v[1] * v[1]) + (v[2] * v[2] + v[3] * v[3]); }

struct EpiUp {
    static constexpr bool PERM = true, AFTER_DRAIN = false, HOOK = false, PREFILL = true;
    PG8_G unsigned char* ws; const PG8_G float* bias; const PG8_LAS float* rr;
    template <class Sched> __device__ __forceinline__ void prefill(const Sched& S, int tid) const {
        PG8_LAS float* t = (PG8_LAS float*)rr; const PG8_G float* ssqx = (const PG8_G float*)(ws + WS_SSQX);
        for (int idx = tid; idx < 6 * BM; idx += 512) {
            Unit u; if (!S.next(idx >> 8, u)) break;
            const int row = u.pm * BM + (idx & 255);
            t[idx] = 1.0f / sqrtf(sum16f(ssqx + (size_t)row * 16) * (1.0f / 1024.0f) + RMS_EPS);
            t[6 * BM + idx] = bias[(u.pm >> 5) * (S.nN * BM) + u.pn * BM + (idx & 255)];
        }
    }
    __device__ __forceinline__ void hook(f32x4 (&)[2][2][4][2], const Unit&, int, int, int, int, int) const {}
    __device__ __forceinline__ void operator()(const f32x4 (&acc)[2][2][4][2], const Unit& u, int wr, int wc, int fr, int fq) const {
        PG8_G bf16_t* HID = (PG8_G bf16_t*)(ws + WS_HID); const PG8_LAS float* rt = rr + u.ord * BM + wr * 64 + fr;
        const PG8_LAS float* bb = rr + 6 * BM + u.ord * BM + wc * 32 + 8 * fq;
        f32x4 bg[2], bu[2];
#pragma unroll
        for (int n = 0; n < 2; ++n) { bg[n] = *(const PG8_LAS f32x4*)(bb + 4 * n); bu[n] = *(const PG8_LAS f32x4*)(bb + HALF + 4 * n); }
#pragma unroll
        for (int ai = 0; ai < 2; ++ai) {
            if (u.half >= 0 && ai == 1) break;
            const int ah = u.half < 0 ? ai : u.half;
#pragma unroll
            for (int m = 0; m < 4; ++m) {
                const int row = u.pm * BM + ah * HALF + wr * 64 + m * 16 + fr;
                const float r = rt[ah * HALF + m * 16];
                const f32x2 r2 = {r, r}; unsigned wv[4];
#pragma unroll
                for (int n = 0; n < 2; ++n)
#pragma unroll
                    for (int hp = 0; hp < 2; ++hp) {
                        const f32x2 ga = {acc[ai][0][m][n][2 * hp], acc[ai][0][m][n][2 * hp + 1]}, ua = {acc[ai][1][m][n][2 * hp], acc[ai][1][m][n][2 * hp + 1]};
                        const f32x2 bg2 = {bg[n][2 * hp], bg[n][2 * hp + 1]}, bu2 = {bu[n][2 * hp], bu[n][2 * hp + 1]};
                        const f32x2 g = ga * r2 + bg2, uu = ua * r2 + bu2;
                        f32x2 e = g * (f32x2){-LOG2E, -LOG2E};
                        e[0] = __builtin_amdgcn_exp2f(e[0]); e[1] = __builtin_amdgcn_exp2f(e[1]);
                        e = e + (f32x2){1.0f, 1.0f};
                        e[0] = fast_rcp(e[0]); e[1] = fast_rcp(e[1]);
                        const f32x2 hv = (g * e) * uu;
                        wv[2 * n + hp] = cvt_pk_bf16(hv[0], hv[1]);
                    }
                u32x4 w; w.x = wv[0]; w.y = wv[1]; w.z = wv[2]; w.w = wv[3];
                st16_wt(HID + (size_t)row * 2816 + u.pn * HALF + wc * 32 + 8 * fq, w);
            }
        }
    }
};

template <bool HOOKED> struct EpiResS {
    static constexpr bool PERM = false, AFTER_DRAIN = true, HOOK = HOOKED, PREFILL = true;
    PG8_G float* fout; PG8_G unsigned char* ws; const PG8_G float* gate; const PG8_G float* igs; const PG8_G float* gs; float coef; const PG8_LAS float* gt;
    __device__ __forceinline__ void group_r(int row, float& rA, float& rB, float& rC) const {
        const PG8_G float* p = (const PG8_G float*)(ws + WS_SSQO) + (size_t)row * 16;
        const f32x4 a = *(const PG8_G f32x4*)p, b = *(const PG8_G f32x4*)(p + 4), c = *(const PG8_G f32x4*)(p + 8), d = *(const PG8_G f32x4*)(p + 12);
        const float sA = ((a[0] + a[1]) + (a[2] + a[3])) + (b[0] + b[1]), sB = ((b[2] + b[3]) + (c[0] + c[1])) + (c[2] + c[3]), sC = (d[0] + d[1]) + (d[2] + d[3]);
        rA = 1.0f / sqrtf(sA * (1.0f / 384.0f) + RMS_EPS); rB = 1.0f / sqrtf(sB * (1.0f / 384.0f) + RMS_EPS); rC = 1.0f / sqrtf(sC * (1.0f / 256.0f) + RMS_EPS);
    }
    template <class Sched> __device__ __forceinline__ void prefill(const Sched& S, int tid) const {
        Unit u; if (tid < BM && S.next(0, u)) { PG8_LAS float* t = (PG8_LAS float*)gt;
            if (HOOKED) { float rA, rB, rC; group_r(u.pm * BM + tid, rA, rB, rC); t[tid] = rA / rB; t[BM + tid] = rB / rC; t[2 * BM + tid] = rC; }
            const int b = u.pm >> 5, c = u.pn * BM + tid;
            t[3 * BM + tid] = gate[(size_t)b * 9 * 1024 + c] * coef; t[4 * BM + tid] = gs ? gs[(size_t)b * 1024 + c] : 0.f; t[5 * BM + tid] = igs[(size_t)b * 1024 + c]; }
    }
    __device__ __forceinline__ void hook(f32x4 (&acc)[2][2][4][2], const Unit& u, int t, int wr, int wc, int fr, int fq) const {
        if (t != 6 && t != 12) return;
        asm volatile("" : "+v"(fr));
#pragma unroll
        for (int ai = 0; ai < 2; ++ai)
#pragma unroll
            for (int m = 0; m < 4; ++m) {
                const float f = gt[(t == 6 ? 0 : BM) + ai * HALF + wr * 64 + m * 16 + fr];
#pragma unroll
                for (int bj = 0; bj < 2; ++bj)
#pragma unroll
                    for (int n = 0; n < 2; ++n) acc[ai][bj][m][n] = acc[ai][bj][m][n] * f;
            }
    }
    __device__ __forceinline__ void fused(f32x4 (&acc)[2][2][4][2], const Unit& u, int wr, int wc, int fr, int fq, PG8_LAS unsigned char* lds, int wid, int lane) const {
        PG8_G bf16_t* xb = (PG8_G bf16_t*)(ws + WS_XB); PG8_G float* ssq_out = (PG8_G float*)(ws + WS_SSQX); constexpr int gate_bstride = 9 * 1024;
        const int b = u.pm >> 5, colg = u.pn * BM + 4 * lane;
        const f32x4 gv = *(const PG8_LAS f32x4*)(gt + 3 * BM + 4 * lane), gsv = *(const PG8_LAS f32x4*)(gt + 4 * BM + 4 * lane), igv = *(const PG8_LAS f32x4*)(gt + 5 * BM + 4 * lane);
#pragma unroll
        for (int ai = 0; ai < 2; ++ai) {
#pragma unroll
            for (int m = 0; m < 4; ++m) { const int rl = wr * 64 + m * 16 + fr;
#pragma unroll
                for (int bj = 0; bj < 2; ++bj)
#pragma unroll
                    for (int n = 0; n < 2; ++n) { const int c = 32 * bj + 8 * wc + 4 * n + fq; *(PG8_LAS f32x4*)(lds + rl * 1024 + ((c ^ (rl & 7)) << 4)) = acc[ai][bj][m][n]; } }
            asm volatile("s_waitcnt lgkmcnt(0)\n\ts_barrier" ::: "memory");
#pragma unroll
            for (int half = 0; half < 2; ++half) {
                u32x2 xo[8];
#pragma unroll
                for (int k = 0; k < 8; ++k) { const int rl = wid + 8 * (half * 8 + k); xo[k] = __builtin_nontemporal_load((const PG8_G u32x2*)(xb + (size_t)(u.pm * BM + ai * HALF + rl) * 1024 + colg)); }
#pragma unroll
                for (int k = 0; k < 8; ++k) { const int rl = wid + 8 * (half * 8 + k); const int row = u.pm * BM + ai * HALF + rl;
                    f32x4 t = *(const PG8_LAS f32x4*)(lds + rl * 1024 + ((lane ^ (rl & 7)) << 4));
                    if (HOOKED) t = t * gt[2 * BM + ai * HALF + rl];
                    const f32x4 xs = {__uint_as_float(xo[k].x << 16), __uint_as_float(xo[k].x & 0xffff0000u), __uint_as_float(xo[k].y << 16), __uint_as_float(xo[k].y & 0xffff0000u)};
                    const f32x4 xn = xs * igv + gv * t;
                    if (!gs) __builtin_nontemporal_store(xn, (PG8_G f32x4*)(fout + (size_t)row * 1024 + colg));
                    if (gs) { const f32x4 y = xn * gsv; u32x2 w; w.x = cvt_pk_bf16(y[0], y[1]); w.y = cvt_pk_bf16(y[2], y[3]); st8_wt(xb + (size_t)row * 1024 + colg, w); }
                    float ss = sq4(xn);
                    ss = wave_sum_dpp(ss);
                    if (gs && lane == 0) *(PG8_G f32x4*)(ssq_out + (size_t)row * 16 + 4 * u.pn) = (f32x4){ss, 0.f, 0.f, 0.f};
                }
            }
            asm volatile("s_waitcnt lgkmcnt(0)\n\ts_barrier" ::: "memory");
        }
    }
};

struct EpiIn {
    static constexpr bool PERM = true, AFTER_DRAIN = false, HOOK = false, PREFILL = true;
    PG8_G unsigned char* ws; const PG8_G float* gq; const PG8_G float* gk; const PG8_G float* bias; const PG8_LAS float* rr; const PG8_G float* gkm;
    template <class Sched> __device__ __forceinline__ void prefill(const Sched& S, int tid) const {
        PG8_LAS float* t = (PG8_LAS float*)rr; const PG8_G float* ssqx = (const PG8_G float*)(ws + WS_SSQX);
        for (int idx = tid; idx < 6 * BM; idx += 512) {
            Unit u; if (!S.next(idx >> 8, u)) break;
            const int row = u.pm * BM + (idx & 255);
            t[idx] = 1.0f / sqrtf(sum16f(ssqx + (size_t)row * 16) * (1.0f / 1024.0f) + RMS_EPS);
            t[6 * BM + idx] = bias[(u.pm >> 5) * (S.nN * BM) + u.pn * BM + (idx & 255)];
        }
        if (tid < 128) t[12 * BM + tid] = tid < 64 ? gq[tid] * (0.125f * LOG2E) : gk[tid - 64];
    }
    __device__ __forceinline__ void hook(f32x4 (&)[2][2][4][2], const Unit&, int, int, int, int, int) const {}
    __device__ __forceinline__ void operator()(const f32x4 (&acc)[2][2][4][2], const Unit& u, int wr, int wc, int fr, int fq) const {
        const int slot = u.pn * 4 + wc;
        if (slot == 7 || slot >= 30) return;
        const int b = u.pm >> 5;
        const PG8_LAS float* rt = rr + u.ord * BM + wr * 64 + fr;
        PG8_G PG8_G bf16_t* dst = nullptr; int pitch = 0, col0 = 0; int kind = 0;
        PG8_G PG8_G float* ssqd = nullptr; int ssqp = 0, ssqi = 0; const PG8_G float* gain = nullptr; int goff = 0; float scale = 1.0f;
        if (slot < 4)       { dst = (PG8_G bf16_t*)(ws + WS_CQ);  pitch = 256; col0 = 64 * slot;        kind = 1; ssqd = (PG8_G float*)(ws + WS_SSQC);  ssqp = 4; ssqi = slot; }
        else if (slot < 6)  { dst = (PG8_G bf16_t*)(ws + WS_CKV); pitch = 128; col0 = 64 * (slot - 4);  kind = 1; ssqd = (PG8_G float*)(ws + WS_SSQC) + (size_t)MROWS_ * 4; ssqp = 2; ssqi = slot - 4; }
        else if (slot == 6) { kind = 3; }
        else if (slot < 14) { dst = (PG8_G bf16_t*)(ws + WS_QS);  pitch = 384; col0 = 64 * (slot - 8);  kind = 2; gain = gq; goff = 0; scale = 0.125f * LOG2E; }
        else if (slot < 16) { dst = (PG8_G bf16_t*)(ws + WS_KS);  pitch = 128; col0 = 64 * (slot - 14); kind = 2; gain = gk; goff = 64; }
        else if (slot < 18) { dst = (PG8_G bf16_t*)(ws + WS_VS);  pitch = 128; col0 = 64 * (slot - 16); }
        else if (slot < 22) { dst = (PG8_G bf16_t*)(ws + WS_QC);  pitch = 256; col0 = 64 * (slot - 18); scale = 0.125f * LOG2E; }
        else if (slot < 26) { dst = (PG8_G bf16_t*)(ws + WS_KC);  pitch = 256; col0 = 64 * (slot - 22); }
        else                { dst = (PG8_G bf16_t*)(ws + WS_VC);  pitch = 256; col0 = 64 * (slot - 26); }
        const PG8_LAS float* bb = rr + 6 * BM + u.ord * BM + wc * 32 + 8 * fq;
        f32x4 bv[2][2], gn[2][2];
#pragma unroll
        for (int bj = 0; bj < 2; ++bj)
#pragma unroll
            for (int n = 0; n < 2; ++n) { bv[bj][n] = *(const PG8_LAS f32x4*)(bb + bj * HALF + 4 * n);
                gn[bj][n] = (kind == 2) ? *(const PG8_LAS f32x4*)(rr + 12 * BM + goff + 32 * bj + 8 * fq + 4 * n) : (f32x4){scale, scale, scale, scale}; }
#pragma unroll
        for (int ai = 0; ai < 2; ++ai)
#pragma unroll
            for (int m = 0; m < 4; ++m) {
                const int row = u.pm * BM + ai * HALF + wr * 64 + m * 16 + fr;
                const float r = rt[ai * HALF + m * 16];
                f32x4 v[2][2]; float ss = 0.f;
#pragma unroll
                for (int bj = 0; bj < 2; ++bj)
#pragma unroll
                    for (int n = 0; n < 2; ++n) { v[bj][n] = acc[ai][bj][m][n] * r + bv[bj][n]; ss += sq4(v[bj][n]); }
                if (kind == 3) {
                    float s0 = sq4(v[0][0]) + sq4(v[0][1]);
                    s0 = xsum32(xsum16(s0));
                    const bool up = fq >= 2; const int jb = 8 * (fq & 1);
                    const PG8_G float* csr = (const PG8_G float*)(ws + WS_CS) + (size_t)row * 32 + jb;
#pragma unroll
                    for (int n = 0; n < 2; ++n) {
                        const f32x4 own = v[0][n]; f32x4 oth;
#pragma unroll
                        for (int i = 0; i < 4; ++i) { auto sw = __builtin_amdgcn_permlane32_swap(__float_as_uint(own[i]), __float_as_uint(own[i]), false, false); oth[i] = __uint_as_float(up ? sw[0] : sw[1]); }
                        const f32x4 G1 = *(const PG8_G f32x4*)(gkm + 64 + jb + 4 * n), G2 = *(const PG8_G f32x4*)(gkm + 80 + jb + 4 * n);
                        const f32x4 cc = *(const PG8_G f32x4*)(csr + 4 * n), sn = *(const PG8_G f32x4*)(csr + 16 + 4 * n);
                        const f32x4 a = (up ? oth : own) * G1, bq = (up ? own : oth) * G2;
                        const f32x4 o = up ? bq * cc + a * sn : a * cc - bq * sn;
                        *(PG8_G f32x4*)((PG8_G float*)(ws + WS_KPE) + (size_t)row * 32 + 8 * fq + 4 * n) = o;
                    }
                    if (fq == 0) ((PG8_G float*)(ws + WS_SSQC) + (size_t)MROWS_ * 6)[row] = s0;
                } else {
                    if (kind != 0) { ss = xsum32(xsum16(ss)); }
                    float rn = 1.0f;
                    if (kind == 2) rn = 1.0f / sqrtf(ss * (1.0f / 64.0f) + RMS_EPS);
                    if (kind == 1 && fq == 0) ssqd[(size_t)row * ssqp + ssqi] = ss;
#pragma unroll
                    for (int bj = 0; bj < 2; ++bj) {
                        const f32x4 y0 = v[bj][0] * gn[bj][0] * rn, y1 = v[bj][1] * gn[bj][1] * rn;
                        u32x4 w; w.x = cvt_pk_bf16(y0[0], y0[1]); w.y = cvt_pk_bf16(y0[2], y0[3]); w.z = cvt_pk_bf16(y1[0], y1[1]); w.w = cvt_pk_bf16(y1[2], y1[3]);
                        st16_wt(dst + (size_t)row * pitch + col0 + 32 * bj + 8 * fq, w);
                    }
                }
            }
    }
};

struct EpiUq {
    static constexpr bool PERM = false, AFTER_DRAIN = false, HOOK = false, PREFILL = true;
    PG8_G unsigned char* ws; const PG8_LAS float* rt;
    template <class Sched> __device__ __forceinline__ void prefill(const Sched& S, int tid) const {
        Unit u; if (tid < BM && S.next(0, u)) { const PG8_G float* p = (const PG8_G float*)(ws + WS_SSQC) + (size_t)(u.pm * BM + tid) * 4; const f32x4 s = *(const PG8_G f32x4*)p;
            ((PG8_LAS float*)rt)[tid] = 1.0f / sqrtf(((s[0] + s[1]) + (s[2] + s[3])) * (1.0f / 256.0f) + RMS_EPS); }
    }
    __device__ __forceinline__ void hook(f32x4 (&)[2][2][4][2], const Unit&, int, int, int, int, int) const {}
    __device__ __forceinline__ void operator()(const f32x4 (&acc)[2][2][4][2], const Unit& u, int wr, int wc, int fr, int fq) const {
        PG8_G bf16_t* QRAW = (PG8_G bf16_t*)(ws + WS_QRAW);
        const int col0 = u.pn * BM + wc * 32 + 4 * fq;
#pragma unroll
        for (int ai = 0; ai < 2; ++ai) {
            if (u.half >= 0 && ai == 1) break;
            const int ah = u.half < 0 ? ai : u.half;
#pragma unroll
            for (int m = 0; m < 4; ++m) {
                const int row = u.pm * BM + ah * HALF + wr * 64 + m * 16 + fr;
                const float r = rt[ah * HALF + wr * 64 + m * 16 + fr];
#pragma unroll
                for (int bj = 0; bj < 2; ++bj)
#pragma unroll
                    for (int n = 0; n < 2; ++n) { const int c = col0 + bj * HALF + n * 16; if (c < 576) { const f32x4 y = acc[ai][bj][m][n] * r; u32x2 w; w.x = cvt_pk_bf16(y[0], y[1]); w.y = cvt_pk_bf16(y[2], y[3]); *(PG8_G u32x2*)(QRAW + (size_t)row * 576 + c) = w; } }
            }
        }
    }
};

struct EpiUkv {
    static constexpr bool PERM = true, AFTER_DRAIN = false, HOOK = false, PREFILL = true;
    PG8_G unsigned char* ws; const PG8_G float* gk; const PG8_LAS float* rt;
    template <class Sched> __device__ __forceinline__ void prefill(const Sched& S, int tid) const {
        Unit u; if (tid < BM && S.next(0, u)) { const int row = u.pm * BM + tid; const PG8_G float* p = (const PG8_G float*)(ws + WS_SSQC) + (size_t)MROWS_ * 4 + (size_t)row * 2;
            ((PG8_LAS float*)rt)[tid] = 1.0f / sqrtf((p[0] + p[1]) * (1.0f / 128.0f) + RMS_EPS); ((PG8_LAS float*)rt)[BM + tid] = ((const PG8_G float*)(ws + WS_SSQC) + (size_t)MROWS_ * 6)[row]; if (tid < 64) ((PG8_LAS float*)rt)[2 * BM + tid] = gk[tid]; }
    }
    __device__ __forceinline__ void hook(f32x4 (&)[2][2][4][2], const Unit&, int, int, int, int, int) const {}
    __device__ __forceinline__ void operator()(const f32x4 (&acc)[2][2][4][2], const Unit& u, int wr, int wc, int fr, int fq) const {
        PG8_G bf16_t* KA = (PG8_G bf16_t*)(ws + WS_KA); PG8_G bf16_t* VA = (PG8_G bf16_t*)(ws + WS_VA);
        const PG8_G float* kpe = (const PG8_G float*)(ws + WS_KPE);
        const int h = 2 * u.pn + (wc >> 1); const bool isv = (wc & 1) != 0;
        f32x4 gn[2][2];
        if (!isv) {
#pragma unroll
            for (int bj = 0; bj < 2; ++bj)
#pragma unroll
                for (int n = 0; n < 2; ++n) gn[bj][n] = *(const PG8_LAS f32x4*)(rt + 2 * BM + 32 * bj + 8 * fq + 4 * n);
        }
#pragma unroll
        for (int ai = 0; ai < 2; ++ai) {
            if (u.half >= 0 && ai == 1) break;
            const int ah = u.half < 0 ? ai : u.half;
#pragma unroll
            for (int m = 0; m < 4; ++m) {
                const int row = u.pm * BM + ah * HALF + wr * 64 + m * 16 + fr;
                const int rl = ah * HALF + wr * 64 + m * 16 + fr;
                const float r = rt[rl];
                f32x4 v[2][2]; float ss = 0.f;
#pragma unroll
                for (int bj = 0; bj < 2; ++bj)
#pragma unroll
                    for (int n = 0; n < 2; ++n) { v[bj][n] = acc[ai][bj][m][n] * r; ss += sq4(v[bj][n]); }
                if (isv) {
#pragma unroll
                    for (int bj = 0; bj < 2; ++bj) { u32x4 w; w.x = cvt_pk_bf16(v[bj][0][0], v[bj][0][1]); w.y = cvt_pk_bf16(v[bj][0][2], v[bj][0][3]); w.z = cvt_pk_bf16(v[bj][1][0], v[bj][1][1]); w.w = cvt_pk_bf16(v[bj][1][2], v[bj][1][3]);
                        st16_wt(VA + ((size_t)(row >> 6) * 6 + h) * 4096 + bj * 2048 + (row & 63) * 32 + 8 * fq, w); }
                } else {
                    ss = xsum32(xsum16(ss));
                    const float rk = 1.0f / sqrtf((ss + rt[BM + rl]) * (1.0f / 96.0f) + RMS_EPS);
                    PG8_G bf16_t* kd = KA + ((size_t)(row >> 6) * 6 + h) * 6144 + (row & 63) * 8;
#pragma unroll
                    for (int bj = 0; bj < 2; ++bj) { const f32x4 y0 = v[bj][0] * gn[bj][0] * rk, y1 = v[bj][1] * gn[bj][1] * rk;
                        u32x4 w; w.x = cvt_pk_bf16(y0[0], y0[1]); w.y = cvt_pk_bf16(y0[2], y0[3]); w.z = cvt_pk_bf16(y1[0], y1[1]); w.w = cvt_pk_bf16(y1[2], y1[3]);
                        st16_wt(kd + (4 * bj + fq) * 512, w); }
                    const f32x4 o1 = *(const PG8_G f32x4*)(kpe + (size_t)row * 32 + 4 * fq) * rk, o2 = *(const PG8_G f32x4*)(kpe + (size_t)row * 32 + 16 + 4 * fq) * rk;
                    u32x2 w1, w2; w1.x = cvt_pk_bf16(o1[0], o1[1]); w1.y = cvt_pk_bf16(o1[2], o1[3]); w2.x = cvt_pk_bf16(o2[0], o2[1]); w2.y = cvt_pk_bf16(o2[2], o2[3]);
                    st8_wt(kd + (8 + (fq >> 1)) * 512 + (fq & 1) * 4, w1); st8_wt(kd + (10 + (fq >> 1)) * 512 + (fq & 1) * 4, w2);
                }
            }
        }
    }
};
}
#define GAS __attribute__((address_space(1)))
#define LAS __attribute__((address_space(3)))
typedef unsigned short bf16;
typedef unsigned v4u __attribute__((ext_vector_type(4)));
typedef float f32x4 __attribute__((ext_vector_type(4)));
typedef short bf16x8 __attribute__((ext_vector_type(8)));
typedef GAS unsigned gu32;
typedef GAS unsigned long long gu64;
#define RLX_AGENT __ATOMIC_RELAXED, __HIP_MEMORY_SCOPE_AGENT
#define LDS_WAIT() asm volatile("s_waitcnt lgkmcnt(0)" ::: "memory")
#define VM_WAIT() asm volatile("s_waitcnt vmcnt(0)" ::: "memory")
__device__ __forceinline__ unsigned long long rt() { return __builtin_amdgcn_s_memrealtime(); }
__device__ __forceinline__ unsigned f2bf(float f) { unsigned u = __builtin_bit_cast(unsigned, f); return (u + 0x7fffu + ((u >> 16) & 1u)) >> 16; }
__device__ __forceinline__ unsigned pk2(float lo, float hi) { return f2bf(lo) | (f2bf(hi) << 16); }

#define XB_TMO      128
#define XB_XCNT(j)  (256  + 64 * (j))
#define XB_XSUB(j)  (1280 + 64 * (j))
#define XB_XGEN(j)  (2304 + 64 * (j))
#define XB_TOP      3328
#define XB_TOPGEN   3392
#define XCD_BAR_WORDS 3456
#define XB_SPIN_CAP (1u << 18)

__device__ __forceinline__ unsigned xb_ld(unsigned* p)              { return __hip_atomic_load(p, __ATOMIC_RELAXED, __HIP_MEMORY_SCOPE_AGENT); }
__device__ __forceinline__ unsigned xb_add(unsigned* p, unsigned v) { return __hip_atomic_fetch_add(p, v, __ATOMIC_RELAXED, __HIP_MEMORY_SCOPE_AGENT); }
__device__ __forceinline__ unsigned xb_xcc_id() { return (unsigned)__builtin_amdgcn_s_getreg((3 << 11) | 20) & 0xFu; }
#define XB_SPIN(cond, bar) do { unsigned _sp = 0; while (cond) { __builtin_amdgcn_s_sleep(1); \
    if ((++_sp & 255u) == 0u) { if (xb_ld(&(bar)[XB_TMO])) break; if (_sp > XB_SPIN_CAP) { atomicAdd(&(bar)[XB_TMO], 1u); break; } } } } while (0)

struct XcdBarrier {
    unsigned* bar; unsigned x;
    volatile LAS unsigned* st;
    int w0;
};

__device__ __forceinline__ XcdBarrier xcd_barrier_post(unsigned* bar, volatile LAS unsigned* st, int w0) {
    XcdBarrier b; b.bar = bar; b.x = xb_xcc_id(); b.st = st; b.w0 = w0;
    if (w0 == 0 && hw_lane() == 0) (void)xb_add(&bar[XB_XCNT(b.x)], 1u);
    return b;
}
__device__ __forceinline__ void xcd_barrier_complete(unsigned* bar, unsigned x, unsigned& nloc, unsigned& nx) {
    const unsigned G = gridDim.x * gridDim.y * gridDim.z;
    unsigned sum, cnt, mine, sp = 0u;
    for (;;) {
        sum = 0u; cnt = 0u; mine = 0u;
#pragma unroll
        for (unsigned j = 0; j < 16; ++j) { const unsigned c = xb_ld(&bar[XB_XCNT(j)]); sum += c; cnt += (c > 0u) ? 1u : 0u; mine = (j == x) ? c : mine; }
        if (sum == G) break;
        __builtin_amdgcn_s_sleep(1);
        if ((++sp & 255u) == 0u) { if (xb_ld(&bar[XB_TMO])) break; if (sp > XB_SPIN_CAP) { atomicAdd(&bar[XB_TMO], 1u); break; } }
    }
    nloc = mine > 0u ? mine : 1u; nx = cnt > 0u ? cnt : 1u;
}

__device__ __forceinline__ void xcd_barrier(const XcdBarrier& b) {
    asm volatile("s_waitcnt vmcnt(0)" ::: "memory");
    __syncthreads();
    if (b.w0 == 0 && hw_lane() == 0) {
        unsigned* bar = b.bar;
        __builtin_amdgcn_s_waitcnt(0);
        unsigned nloc = b.st[0], nx = b.st[1];
        if (nloc == 0u) { xcd_barrier_complete(bar, b.x, nloc, nx); b.st[0] = nloc; b.st[1] = nx; }
        const unsigned old = xb_add(&bar[XB_XSUB(b.x)], 1u);
        const unsigned gen = old / nloc;
        if (old + 1u == (gen + 1u) * nloc) {
            __builtin_amdgcn_fence(__ATOMIC_RELEASE, "agent");
            asm volatile("s_waitcnt vmcnt(0)" ::: "memory");
            const unsigned og = xb_add(&bar[XB_TOP], 1u);
            const unsigned tg = og / nx;
            if (og + 1u == (tg + 1u) * nx) xb_add(&bar[XB_TOPGEN], 1u);
            else XB_SPIN(xb_ld(&bar[XB_TOPGEN]) == tg, bar);
            __builtin_amdgcn_fence(__ATOMIC_ACQUIRE, "agent");
            xb_add(&bar[XB_XGEN(b.x)], 1u);
            asm volatile("s_waitcnt vmcnt(0)" ::: "memory");
        } else {
            XB_SPIN(xb_ld(&bar[XB_XGEN(b.x)]) == gen, bar);
            __builtin_amdgcn_fence(__ATOMIC_ACQUIRE, "agent");
            asm volatile("s_waitcnt vmcnt(0)" ::: "memory");
        }
    }
    __syncthreads();
}
namespace att {
typedef unsigned short bf16_t;
typedef short bf16x8 __attribute__((ext_vector_type(8)));
typedef short s16x4 __attribute__((ext_vector_type(4)));
typedef short v4i16_t __attribute__((ext_vector_type(4)));
typedef float f32x16 __attribute__((ext_vector_type(16)));
typedef float f32x4 __attribute__((ext_vector_type(4)));
typedef float f32x2 __attribute__((ext_vector_type(2)));
typedef __bf16 bf16x2_t __attribute__((ext_vector_type(2)));
typedef unsigned u32x4 __attribute__((ext_vector_type(4)));
typedef int i32x4 __attribute__((ext_vector_type(4)));
#define ALAS __attribute__((address_space(3)))
#define AGAS __attribute__((address_space(1)))
constexpr int SEQ = 8192;
constexpr float LOG2E = 1.4426950408889634f, EPS = 1e-6f;
constexpr int KCS = 1040, VHS = 4160;
constexpr int KSLOT = 12 * KCS, VSLOT = 2 * VHS;
constexpr int L_K = 0, L_V = 3 * KSLOT, L_POS = L_V + 4 * VSLOT, L_TB = L_POS + 1024, L_WSF = L_TB + 128, L_OST = L_WSF + 8 * 256, L_FLAG = L_OST + 8 * 4096, L_END = L_FLAG + 16 + 64;
static_assert(L_OST % 16 == 0 && L_V % 16 == 0 && L_END <= 131072, "attention LDS map");
constexpr int S1_KS = 8 * KCS, S1_K = 0, S1_V = 7 * S1_KS, S1_P = S1_V + 7 * VSLOT, S1_LUT = S1_P + 7 * 256, S1_WSF = S1_LUT + 528, S1_END = S1_WSF + 8 * 256;
static_assert(S1_END <= L_FLAG || S1_END <= 131072, "sliding-window LDS map"); static_assert(S1_V % 16 == 0 && S1_WSF % 16 == 0 && S1_END <= 131072, "sliding-window LDS map");

__device__ __forceinline__ int crow(int r, int hi) { return (r & 3) + 8 * (r >> 2) + 4 * hi; }
__device__ __forceinline__ unsigned cvtpk(float lo, float hi) { f32x2 v = {lo, hi}; bf16x2_t b = __builtin_convertvector(v, bf16x2_t); return __builtin_bit_cast(unsigned, b); }
__device__ __forceinline__ s16x4 vtr(const ALAS unsigned char* p) { return __builtin_bit_cast(s16x4, __builtin_amdgcn_ds_read_tr16_b64_v4i16((ALAS v4i16_t*)p)); }
__device__ __forceinline__ float swap_sum(float x) { auto rr = __builtin_amdgcn_permlane32_swap(__float_as_uint(x), __float_as_uint(x), false, false); return __uint_as_float(rr[0]) + __uint_as_float(rr[1]); }
__device__ __forceinline__ float swap_max(float x) { auto rr = __builtin_amdgcn_permlane32_swap(__float_as_uint(x), __float_as_uint(x), false, false); return fmaxf(__uint_as_float(rr[0]), __uint_as_float(rr[1])); }
__device__ __forceinline__ float bf2f(unsigned short h) { return __uint_as_float((unsigned)h << 16); }

__device__ __forceinline__ void glds16(const AGAS void* gsrc, unsigned lds_dst) { unsigned keep;
    asm volatile("s_mov_b32 %0, m0\n\ts_mov_b32 m0, %2\n\ts_nop 0\n\tglobal_load_lds_dwordx4 %1, off\n\ts_mov_b32 m0, %0" : "=&s"(keep) : "v"(gsrc), "s"(lds_dst) : "memory"); }
__device__ __forceinline__ void glds4(const AGAS void* gsrc, unsigned lds_dst) { unsigned keep;
    asm volatile("s_mov_b32 %0, m0\n\ts_mov_b32 m0, %2\n\ts_nop 0\n\tglobal_load_lds_dword %1, off\n\ts_mov_b32 m0, %0" : "=&s"(keep) : "v"(gsrc), "s"(lds_dst) : "memory"); }

struct AttnP {
    AGAS unsigned char* ws;
    const AGAS float* gq;
    const AGAS int* pos; const AGAS float* sinks; const AGAS float* relb;
};
template <int MODE> struct AttnCfg;
template <> struct AttnCfg<0> { static constexpr size_t Q = WS_QRAW, K = WS_KA, V = WS_VA; static constexpr int qpitch = 576, kpitch = 576, khs = 96, vpitch = 384, vhs = 64, ocol0 = 0, hidx0 = 0, group = 1; };
template <> struct AttnCfg<1> { static constexpr size_t Q = WS_QS, K = WS_KS, V = WS_VS; static constexpr int qpitch = 384, kpitch = 128, khs = 64, vpitch = 128, vhs = 64, ocol0 = 384, hidx0 = 6, group = 3; };
template <> struct AttnCfg<2> { static constexpr size_t Q = WS_QC, K = WS_KC, V = WS_VC; static constexpr int qpitch = 256, kpitch = 256, khs = 64, vpitch = 256, vhs = 64, ocol0 = 768, hidx0 = 12, group = 1; };

#ifdef ATT_PROF
#define PROF_T() ((MODE == 0 && blockIdx.x == 0) ? (long long)clock64() : 0ll)
#else
#define PROF_T() 0ll
#endif
constexpr int L_NEXT = 131072 + 2048 + 64;
template <int DQK, int MODE>
__device__ __forceinline__ void attn_unit(ALAS unsigned char* lds, const AttnP& P, int b, int h, int qb, int wave0, AGAS unsigned* qhead, unsigned long long* prof = nullptr) {
    long long pf_qk = 0, pf_sm = 0, pf_pv = 0, pf_wait = 0; const long long pf_t0 = PROF_T();
    constexpr int NCH = DQK / 8, ND0 = DQK / 16;
    int tid_ = wave0 * 64 + hw_lane(); asm volatile("" : "+v"(tid_));
    const int tid = tid_, lane = tid & 63, r32 = lane & 31, hi = lane >> 5;
    const int wid = __builtin_amdgcn_readfirstlane(tid >> 6);
    const int q0 = qb * 256, qlo = q0 + 32 * wid, qhi = qlo + 31, qrow = qlo + r32;
    const size_t rb = (size_t)b * SEQ;
    typedef AttnCfg<MODE> C; const int kvh = h / C::group;
    ALAS float* wsf = (ALAS float*)(lds + (MODE == 1 ? S1_WSF : L_WSF)) + wid * 64;
    ALAS unsigned char* ost = lds + L_OST + wid * 4096;
    ALAS int* posl = (ALAS int*)(lds + L_POS);
    ALAS float* tb = (ALAS float*)(lds + L_TB);

    bf16x8 qf[ND0]; int posq = 0; float sink2 = 0.f;
#define ATT_LOADQ() do { \
    if constexpr (MODE == 0) { \
        const AGAS bf16_t* qp = (const AGAS bf16_t*)(P.ws + C::Q) + (rb + qrow) * 576 + h * 96 + hi * 8; \
        float qv[ND0][8]; float ss = 0.f; \
_Pragma("unroll") \
        for (int d0 = 0; d0 < ND0; ++d0) { const u32x4 w = __builtin_nontemporal_load((const AGAS u32x4*)(qp + 16 * d0)); \
_Pragma("unroll") \
            for (int i = 0; i < 4; ++i) { const float lo = __uint_as_float(w[i] << 16), hv = __uint_as_float(w[i] & 0xffff0000u); qv[d0][2 * i] = lo; qv[d0][2 * i + 1] = hv; ss += lo * lo + hv * hv; } } \
        ss = swap_sum(ss); \
        const float rq = 1.0f / sqrtf(ss * (1.0f / 96.0f) + EPS); \
_Pragma("unroll") \
        for (int d0 = 0; d0 < ND0; ++d0) { const f32x4 ga = *(const AGAS f32x4*)(P.gq + 16 * d0 + 8 * hi), gb = *(const AGAS f32x4*)(P.gq + 16 * d0 + 8 * hi + 4); \
_Pragma("unroll") \
            for (int i = 0; i < 4; ++i) { qv[d0][i] *= rq * ga[i]; qv[d0][4 + i] *= rq * gb[i]; } } \
        { \
            const AGAS float* cp = (const AGAS float*)(P.ws + WS_CS) + (rb + qrow) * 32 + 8 * hi; \
            const f32x4 c0 = *(const AGAS f32x4*)cp, c1 = *(const AGAS f32x4*)(cp + 4), s0 = *(const AGAS f32x4*)(cp + 16), s1 = *(const AGAS f32x4*)(cp + 20); \
_Pragma("unroll") \
            for (int i = 0; i < 8; ++i) { const float c = i < 4 ? c0[i & 3] : c1[i & 3], s = i < 4 ? s0[i & 3] : s1[i & 3]; const float x1 = qv[4][i], x2 = qv[5][i]; qv[4][i] = x1 * c - x2 * s; qv[5][i] = x2 * c + x1 * s; } \
        } \
        const float sc = 0.10206207261596575f * LOG2E; \
_Pragma("unroll") \
        for (int d0 = 0; d0 < ND0; ++d0) { u32x4 w; w.x = cvtpk(qv[d0][0] * sc, qv[d0][1] * sc); w.y = cvtpk(qv[d0][2] * sc, qv[d0][3] * sc); w.z = cvtpk(qv[d0][4] * sc, qv[d0][5] * sc); w.w = cvtpk(qv[d0][6] * sc, qv[d0][7] * sc); qf[d0] = __builtin_bit_cast(bf16x8, w); } \
    } else { \
        const AGAS bf16_t* qp = (const AGAS bf16_t*)(P.ws + C::Q) + (rb + qrow) * C::qpitch + h * 64 + hi * 8; \
_Pragma("unroll") \
        for (int d0 = 0; d0 < ND0; ++d0) qf[d0] = __builtin_nontemporal_load((const AGAS bf16x8*)(qp + 16 * d0)); \
    } \
    if constexpr (MODE == 1) { \
        posq = P.pos[rb + qrow]; sink2 = P.sinks[h] * LOG2E; mrun = sink2; _Pragma("unroll") for (int r = 0; r < 16; ++r) negm[r] = -mrun; \
    } } while (0)

    int ntile, tfirst, tstep;
    if (MODE == 0) { tfirst = 0; tstep = 1; ntile = ((q0 + 255) >> 6) + 1; }
    else if (MODE == 1) { const int lo = q0 - 127 > 0 ? q0 - 127 : 0; tfirst = lo >> 6; tstep = 1; ntile = ((q0 + 255) >> 6) - tfirst + 1; }
    else { tfirst = (q0 + 254) >> 6; tstep = -1; ntile = tfirst + 1; }

    const AGAS bf16_t* Kg = (const AGAS bf16_t*)(P.ws + C::K) + rb * C::kpitch + kvh * C::khs;
    const AGAS bf16_t* Vg = (const AGAS bf16_t*)(P.ws + C::V) + rb * C::vpitch + kvh * C::vhs;
    const unsigned lds0 = (unsigned)(uintptr_t)lds;
    const AGAS bf16_t* ksrc0 = (MODE == 0) ? (const AGAS bf16_t*)(P.ws + C::K) + ((size_t)b * 128 * 6 + h) * 6144 + wid * 512 + lane * 8 : Kg + (size_t)lane * C::kpitch + 8 * wid;
    const AGAS bf16_t* vsrc = (MODE == 0) ? (const AGAS bf16_t*)(P.ws + C::V) + ((size_t)b * 128 * 6 + h) * 4096 + (wid >> 2) * 2048 + (wid & 3) * 512 + lane * 8
                                          : Vg + (size_t)(16 * (wid & 3) + (lane >> 2)) * C::vpitch + 32 * (wid >> 2) + 8 * (lane & 3);
    constexpr size_t KTS = (MODE == 0) ? (size_t)6 * 6144 : (size_t)64 * C::kpitch, VTS = (MODE == 0) ? (size_t)6 * 4096 : (size_t)64 * C::vpitch, K2O = (MODE == 0) ? 8 * 512 : 64;
    const bool k2 = (wid + 8) < NCH;
    const bool posw = (MODE == 1) && wid == 0;
    const int NP = 2 + (k2 ? 1 : 0) + (posw ? 1 : 0);
#define ATT_ISSUE(T, IT) do { const int T_ = (T); const size_t jo_ = (size_t)T_ * 64; const int ks_ = (IT) % 3, vs_ = (IT) & 3;     \
        glds16(ksrc0 + (size_t)T_ * KTS, (unsigned)__builtin_amdgcn_readfirstlane(lds0 + L_K + ks_ * KSLOT + wid * KCS)); \
        if (k2) glds16(ksrc0 + (size_t)T_ * KTS + K2O, (unsigned)__builtin_amdgcn_readfirstlane(lds0 + L_K + ks_ * KSLOT + (wid + 8) * KCS)); \
        glds16(vsrc + (size_t)T_ * VTS, (unsigned)__builtin_amdgcn_readfirstlane(lds0 + L_V + vs_ * VSLOT + (wid >> 2) * VHS + (wid & 3) * 1024)); \
        if (posw) glds4(P.pos + rb + jo_ + lane, (unsigned)__builtin_amdgcn_readfirstlane(lds0 + L_POS + vs_ * 256)); } while (0)
#define ATT_WAIT_BAR(n_) do { if ((n_) <= 0) asm volatile("s_waitcnt vmcnt(0) lgkmcnt(0)\n\ts_barrier" ::: "memory"); \
        else if (NP == 2) asm volatile("s_waitcnt vmcnt(2) lgkmcnt(0)\n\ts_barrier" ::: "memory"); \
        else if (NP == 3) asm volatile("s_waitcnt vmcnt(3) lgkmcnt(0)\n\ts_barrier" ::: "memory"); \
        else asm volatile("s_waitcnt vmcnt(4) lgkmcnt(0)\n\ts_barrier" ::: "memory"); } while (0)

    f32x16 o0 = {}, o1 = {};
    float mrun = 0.f;
    float lrun = (MODE == 1 && hi == 0) ? 1.0f : 0.f;
    f32x16 negm;
#pragma unroll
    for (int r = 0; r < 16; ++r) negm[r] = 0.f;
    bool first = (MODE == 0);
    float after = 0.f;
    bool walive = true;
    const int vrd = ((lane >> 4) & 1) * 32 + (lane & 3) * 8 + (4 * hi + ((lane & 15) >> 2)) * 64;
    const bool lag = wid >= 4;
    constexpr float THR = 6.0f;

#define ATT_QK(P0, P1, kb) do { int kofs_ = L_K + (kb) * KSLOT + hi * KCS + r32 * 16; asm volatile("" : "+v"(kofs_)); const ALAS unsigned char* Kb_ = lds + kofs_;     \
        bf16x8 kfa_[4], kfb_[4]; \
        _Pragma("unroll") for (int d0 = 0; d0 < 3; ++d0) { kfa_[d0] = *(const ALAS bf16x8*)(Kb_ + 2 * d0 * KCS); kfb_[d0] = *(const ALAS bf16x8*)(Kb_ + 2 * d0 * KCS + 512); } \
        \
        _Pragma("unroll") for (int d0 = 0; d0 < ND0; ++d0) { \
            if (d0 + 3 < ND0) { kfa_[(d0 + 3) & 3] = *(const ALAS bf16x8*)(Kb_ + 2 * (d0 + 3) * KCS); kfb_[(d0 + 3) & 3] = *(const ALAS bf16x8*)(Kb_ + 2 * (d0 + 3) * KCS + 512); } \
            if (d0 == 0) { P0 = __builtin_amdgcn_mfma_f32_32x32x16_bf16(kfa_[0], qf[0], negm, 0, 0, 0); P1 = __builtin_amdgcn_mfma_f32_32x32x16_bf16(kfb_[0], qf[0], negm, 0, 0, 0); } \
            else { P0 = __builtin_amdgcn_mfma_f32_32x32x16_bf16(kfa_[d0 & 3], qf[d0], P0, 0, 0, 0); P1 = __builtin_amdgcn_mfma_f32_32x32x16_bf16(kfb_[d0 & 3], qf[d0], P1, 0, 0, 0); } \
            } } while (0)
#define ATT_VLD(i_, s_) do { vl0_[i_] = vtr(Vb_ + (s_) * 1024); vh0_[i_] = vtr(Vb_ + (s_) * 1024 + 512); vl1_[i_] = vtr(Vb_ + VHS + (s_) * 1024); vh1_[i_] = vtr(Vb_ + VHS + (s_) * 1024 + 512); } while (0)
#define ATT_PV(vb) do { int vofs_ = L_V + (vb) * VSLOT + vrd; asm volatile("" : "+v"(vofs_)); const ALAS unsigned char* Vb_ = lds + vofs_; \
        s16x4 vl0_[2], vh0_[2], vl1_[2], vh1_[2]; ATT_VLD(0, 0); \
        _Pragma("unroll") for (int s_ = 0; s_ < 4; ++s_) { \
            if (s_ + 1 < 4) ATT_VLD((s_ + 1) & 1, s_ + 1); \
            const int i_ = s_ & 1; const bf16x8 pa_ = __builtin_bit_cast(bf16x8, pw[s_]); \
            const bf16x8 v0_ = {vl0_[i_][0], vl0_[i_][1], vl0_[i_][2], vl0_[i_][3], vh0_[i_][0], vh0_[i_][1], vh0_[i_][2], vh0_[i_][3]}, v1_ = {vl1_[i_][0], vl1_[i_][1], vl1_[i_][2], vl1_[i_][3], vh1_[i_][0], vh1_[i_][1], vh1_[i_][2], vh1_[i_][3]}; \
            o0 = __builtin_amdgcn_mfma_f32_32x32x16_bf16(pa_, v0_, o0, 0, 0, 0); o1 = __builtin_amdgcn_mfma_f32_32x32x16_bf16(pa_, v1_, o1, 0, 0, 0); } } while (0)
#define ATT_PACK(P0, P1) do { \
        pw[0].x = cvtpk(P0[0], P0[1]); pw[0].y = cvtpk(P0[2], P0[3]); pw[0].z = cvtpk(P0[4], P0[5]); pw[0].w = cvtpk(P0[6], P0[7]); \
        pw[1].x = cvtpk(P0[8], P0[9]); pw[1].y = cvtpk(P0[10], P0[11]); pw[1].z = cvtpk(P0[12], P0[13]); pw[1].w = cvtpk(P0[14], P0[15]); \
        pw[2].x = cvtpk(P1[0], P1[1]); pw[2].y = cvtpk(P1[2], P1[3]); pw[2].z = cvtpk(P1[4], P1[5]); pw[2].w = cvtpk(P1[6], P1[7]); \
        pw[3].x = cvtpk(P1[8], P1[9]); pw[3].y = cvtpk(P1[10], P1[11]); pw[3].z = cvtpk(P1[12], P1[13]); pw[3].w = cvtpk(P1[14], P1[15]); } while (0)
#define ATT_MAX3(a, b, c) fmaxf(fmaxf((a), (b)), (c))
#define ATT_SM_A(P0, P1, j0_, pslot) do { if constexpr (MODE != 2) { \
            if constexpr (MODE == 1) { \
                _Pragma("unroll") for (int g = 0; g < 4; ++g) { \
                    const i32x4 pa = *(const ALAS i32x4*)(posl + (pslot) * 64 + 8 * g + 4 * hi), pb = *(const ALAS i32x4*)(posl + (pslot) * 64 + 32 + 8 * g + 4 * hi); \
                    _Pragma("unroll") for (int i = 0; i < 4; ++i) { \
                        { int n = posq - pa[i]; n = n > 0 ? n : 0; int bk = n; if (n >= 16) { bk = 16 + (int)((__builtin_amdgcn_logf((float)n) - 4.0f) * (16.0f / 3.0f)); bk = bk < 31 ? bk : 31; } P0[4 * g + i] += tb[bk]; } \
                        { int n = posq - pb[i]; n = n > 0 ? n : 0; int bk = n; if (n >= 16) { bk = 16 + (int)((__builtin_amdgcn_logf((float)n) - 4.0f) * (16.0f / 3.0f)); bk = bk < 31 ? bk : 31; } P1[4 * g + i] += tb[bk]; } } } } \
            const bool nm_ = (MODE == 1) || ((j0_) + 63 > qlo); \
            if (nm_) { \
                _Pragma("unroll") for (int r = 0; r < 16; ++r) { const int key = (j0_) + crow(r, hi); \
                    bool ok0 = key <= qrow, ok1 = key + 32 <= qrow; \
                    if (MODE == 1) { ok0 = ok0 && (key > qrow - 128); ok1 = ok1 && (key + 32 > qrow - 128); } \
                    if (!ok0) P0[r] = -INFINITY; if (!ok1) P1[r] = -INFINITY; } } \
            float ma = ATT_MAX3(P0[0], P0[1], P1[0]), mb = ATT_MAX3(P0[2], P0[3], P1[1]); ma = ATT_MAX3(ma, P1[2], P1[3]); \
            _Pragma("unroll") for (int r = 4; r < 16; r += 4) { ma = ATT_MAX3(ma, P0[r], P0[r + 1]); mb = ATT_MAX3(mb, P0[r + 2], P0[r + 3]); ma = ATT_MAX3(ma, P1[r], P1[r + 1]); mb = ATT_MAX3(mb, P1[r + 2], P1[r + 3]); } \
            const float mt = swap_max(fmaxf(ma, mb)); \
            if (first || __any(mt > THR)) {                                 \
                const float d = first ? mt : fmaxf(mt, 0.f); first = false; \
                _Pragma("unroll") for (int r = 0; r < 16; ++r) { P0[r] -= d; P1[r] -= d; } \
                const float alpha = __builtin_amdgcn_exp2f(-d); mrun += d; lrun *= alpha; \
                _Pragma("unroll") for (int r = 0; r < 16; ++r) negm[r] = -mrun; \
                if (hi == 0) wsf[r32] = alpha; \
                _Pragma("unroll") for (int g = 0; g < 4; ++g) { const f32x4 al = *(const ALAS f32x4*)(wsf + 8 * g + 4 * hi); \
                    _Pragma("unroll") for (int i = 0; i < 4; ++i) { o0[4 * g + i] *= al[i]; o1[4 * g + i] *= al[i]; } } } } } while (0)
#define ATT_SM_B(P0, P1, j0_) do { \
        if constexpr (MODE == 2) { \
            const bool nm_ = (j0_) + 63 >= qlo; \
            float ln0[16], ln1[16]; \
            _Pragma("unroll") for (int r = 0; r < 16; ++r) { const int key = (j0_) + crow(r, hi); \
                { const float z = P0[r]; const float sp = fmaxf(z, 0.f) + __builtin_amdgcn_logf(1.0f + __builtin_amdgcn_exp2f(-fabsf(z))); const bool ok = !nm_ || key < qrow; ln0[r] = ok ? -sp : 0.f; P0[r] = ok ? z - sp : -INFINITY; } \
                { const float z = P1[r]; const float sp = fmaxf(z, 0.f) + __builtin_amdgcn_logf(1.0f + __builtin_amdgcn_exp2f(-fabsf(z))); const bool ok = !nm_ || key + 32 < qrow; ln1[r] = ok ? -sp : 0.f; P1[r] = ok ? z - sp : -INFINITY; } } \
            float run = after; \
            _Pragma("unroll") for (int blk = 1; blk >= 0; --blk) _Pragma("unroll") for (int g = 3; g >= 0; --g) { \
                const float own = blk ? ((ln1[4 * g] + ln1[4 * g + 1]) + (ln1[4 * g + 2] + ln1[4 * g + 3])) : ((ln0[4 * g] + ln0[4 * g + 1]) + (ln0[4 * g + 2] + ln0[4 * g + 3])); \
                auto rr = __builtin_amdgcn_permlane32_swap(__float_as_uint(own), __float_as_uint(own), false, false); \
                const float slo = __uint_as_float(rr[0]), shi = __uint_as_float(rr[1]); \
                const float e1 = run; run += shi; const float e0 = run; run += slo; \
                float aft = hi ? e1 : e0; \
                _Pragma("unroll") for (int i = 3; i >= 0; --i) { const int r = 4 * g + i; \
                    if (blk) { P1[r] = __builtin_amdgcn_exp2f(P1[r] + aft); aft += ln1[r]; } else { P0[r] = __builtin_amdgcn_exp2f(P0[r] + aft); aft += ln0[r]; } } } \
            after = run; walive = __any(after > -160.0f); \
        } else { \
            float ls = 0.f; \
            _Pragma("unroll") for (int r = 0; r < 16; ++r) { P0[r] = __builtin_amdgcn_exp2f(P0[r]); P1[r] = __builtin_amdgcn_exp2f(P1[r]); ls += P0[r] + P1[r]; } \
            lrun += ls; } \
        ATT_PACK(P0, P1); } while (0)
#define ATT_WORK(j0_) ((MODE == 0) ? ((j0_) <= qhi) : (MODE == 1) ? (((j0_) <= qhi) && ((j0_) + 63 >= qlo - 127)) : (walive && ((j0_) < qhi)))

    if constexpr (MODE == 0) {
    f32x16 p0, p1, n0, n1; u32x4 pw[4];
    __syncthreads();
    int issued = 0;
    ATT_ISSUE(0, 0);
    if (ntile > 1) { ATT_ISSUE(1, 1); issued = 1; }
    if (ntile > 2) { ATT_ISSUE(2, 2); issued = 2; }
    ATT_LOADQ();
    ATT_WAIT_BAR(issued - 1);
    const int tmax = qhi >> 6;
#define MLA_SB() __builtin_amdgcn_sched_barrier(0)
#define MLA_EX(v) __builtin_amdgcn_exp2f(v)
#define MLA_DECIDE(X0, X1, j0_) do { \
        if ((j0_) + 63 > qlo) { _Pragma("unroll") for (int r = 0; r < 16; ++r) { const int key = (j0_) + crow(r, hi); if (key > qrow) X0[r] = -INFINITY; if (key + 32 > qrow) X1[r] = -INFINITY; } } \
        float ma = ATT_MAX3(X0[0], X0[1], X1[0]), mb = ATT_MAX3(X0[2], X0[3], X1[1]); ma = ATT_MAX3(ma, X1[2], X1[3]); \
        _Pragma("unroll") for (int r = 4; r < 16; r += 4) { ma = ATT_MAX3(ma, X0[r], X0[r + 1]); mb = ATT_MAX3(mb, X0[r + 2], X0[r + 3]); ma = ATT_MAX3(ma, X1[r], X1[r + 1]); mb = ATT_MAX3(mb, X1[r + 2], X1[r + 3]); } \
        const float mt = swap_max(fmaxf(ma, mb)); resc = false; \
        if (first || __any(mt > THR)) { const float d = first ? mt : fmaxf(mt, 0.f); first = false; \
            _Pragma("unroll") for (int r = 0; r < 16; ++r) { X0[r] -= d; X1[r] -= d; } \
            const float alpha = __builtin_amdgcn_exp2f(-d); lrun *= alpha; const float nm_ = negm[0] - d;     \
            _Pragma("unroll") for (int r = 0; r < 16; ++r) negm[r] = nm_; \
            if (hi == 0) wsf[r32] = alpha; resc = true; } } while (0)
#define MLA_RESC() do { if (resc) { _Pragma("unroll") for (int g = 0; g < 4; ++g) { const f32x4 al = *(const ALAS f32x4*)(wsf + 8 * g + 4 * hi); \
            _Pragma("unroll") for (int i = 0; i < 4; ++i) { o0[4 * g + i] *= al[i]; o1[4 * g + i] *= al[i]; } } } } while (0)
#define MLA_PV_(i) (i < 16 ? C0[(i) & 15] : C1[(i) & 15])
#define MLA_GA(MF, g, C0, C1) do { MF; \
        if (3 * (g) < 32) sacc += (3 * (g) < 16 ? C0[(3 * (g)) & 15] : C1[(3 * (g)) & 15]); \
        if (3 * (g) + 1 < 32) sacc += (3 * (g) + 1 < 16 ? C0[(3 * (g) + 1) & 15] : C1[(3 * (g) + 1) & 15]); \
        if (3 * (g) + 2 < 32) sacc += (3 * (g) + 2 < 16 ? C0[(3 * (g) + 2) & 15] : C1[(3 * (g) + 2) & 15]); \
        if ((g) < 4) { pw[((g) >> 1) & 3][2 * ((g) & 1)] = cvtpk(C0[4 * (g)], C0[4 * (g) + 1]); pw[((g) >> 1) & 3][2 * ((g) & 1) + 1] = cvtpk(C0[4 * (g) + 2], C0[4 * (g) + 3]); } \
        else if ((g) < 8) { pw[((g) >> 1) & 3][2 * ((g) & 1)] = cvtpk(C1[4 * ((g) - 4)], C1[4 * ((g) - 4) + 1]); pw[((g) >> 1) & 3][2 * ((g) & 1) + 1] = cvtpk(C1[4 * ((g) - 4) + 2], C1[4 * ((g) - 4) + 3]); } } while (0)
#define MLA_VF(lo_, hi_) (bf16x8){lo_[0], lo_[1], lo_[2], lo_[3], hi_[0], hi_[1], hi_[2], hi_[3]}
#define MLA_GB(MF, X, b_) do { MF; X[(b_)] = MLA_EX(X[(b_)]); X[(b_) + 1] = MLA_EX(X[(b_) + 1]); X[(b_) + 2] = MLA_EX(X[(b_) + 2]); X[(b_) + 3] = MLA_EX(X[(b_) + 3]); } while (0)
#define MLA_FULL(C0, C1, N0, N1, t_) do { \
        int kofs_ = L_K + (((t_) + 1) % 3) * KSLOT + hi * KCS + r32 * 16; asm volatile("" : "+v"(kofs_)); const ALAS unsigned char* Kb_ = lds + kofs_; \
        int vofs_ = L_V + ((t_) & 3) * VSLOT + vrd; asm volatile("" : "+v"(vofs_)); const ALAS unsigned char* Vb_ = lds + vofs_; \
        bf16x8 ka0 = *(const ALAS bf16x8*)(Kb_), kb0 = *(const ALAS bf16x8*)(Kb_ + 512), ka1 = *(const ALAS bf16x8*)(Kb_ + 2 * KCS), kb1 = *(const ALAS bf16x8*)(Kb_ + 2 * KCS + 512), ka2, kb2; \
        s16x4 vl0a, vh0a, vl1a, vh1a, vl0b, vh0b, vl1b, vh1b; float sacc = 0.f; \
        MLA_SB(); \
        MLA_GA(N0 = __builtin_amdgcn_mfma_f32_32x32x16_bf16(ka0, qf[0], negm, 0, 0, 0), 0, C0, C1); ka2 = *(const ALAS bf16x8*)(Kb_ + 4 * KCS); MLA_SB(); \
        MLA_GA(N1 = __builtin_amdgcn_mfma_f32_32x32x16_bf16(kb0, qf[0], negm, 0, 0, 0), 1, C0, C1); kb2 = *(const ALAS bf16x8*)(Kb_ + 4 * KCS + 512); MLA_SB(); \
        MLA_GA(N0 = __builtin_amdgcn_mfma_f32_32x32x16_bf16(ka1, qf[1], N0, 0, 0, 0), 2, C0, C1); ka0 = *(const ALAS bf16x8*)(Kb_ + 6 * KCS); MLA_SB(); \
        MLA_GA(N1 = __builtin_amdgcn_mfma_f32_32x32x16_bf16(kb1, qf[1], N1, 0, 0, 0), 3, C0, C1); kb0 = *(const ALAS bf16x8*)(Kb_ + 6 * KCS + 512); MLA_SB(); \
        MLA_GA(N0 = __builtin_amdgcn_mfma_f32_32x32x16_bf16(ka2, qf[2], N0, 0, 0, 0), 4, C0, C1); ka1 = *(const ALAS bf16x8*)(Kb_ + 8 * KCS); MLA_SB(); \
        MLA_GA(N1 = __builtin_amdgcn_mfma_f32_32x32x16_bf16(kb2, qf[2], N1, 0, 0, 0), 5, C0, C1); kb1 = *(const ALAS bf16x8*)(Kb_ + 8 * KCS + 512); MLA_SB(); \
        MLA_GA(N0 = __builtin_amdgcn_mfma_f32_32x32x16_bf16(ka0, qf[3], N0, 0, 0, 0), 6, C0, C1); ka2 = *(const ALAS bf16x8*)(Kb_ + 10 * KCS); MLA_SB(); \
        MLA_GA(N1 = __builtin_amdgcn_mfma_f32_32x32x16_bf16(kb0, qf[3], N1, 0, 0, 0), 7, C0, C1); kb2 = *(const ALAS bf16x8*)(Kb_ + 10 * KCS + 512); MLA_SB(); \
        MLA_GA(N0 = __builtin_amdgcn_mfma_f32_32x32x16_bf16(ka1, qf[4], N0, 0, 0, 0), 8, C0, C1); MLA_SB(); \
        MLA_GA(N1 = __builtin_amdgcn_mfma_f32_32x32x16_bf16(kb1, qf[4], N1, 0, 0, 0), 9, C0, C1); MLA_SB(); \
        MLA_GA(N0 = __builtin_amdgcn_mfma_f32_32x32x16_bf16(ka2, qf[5], N0, 0, 0, 0), 10, C0, C1); vl0a = vtr(Vb_); vh0a = vtr(Vb_ + 512); MLA_SB(); \
        MLA_GA(N1 = __builtin_amdgcn_mfma_f32_32x32x16_bf16(kb2, qf[5], N1, 0, 0, 0), 11, C0, C1); vl1a = vtr(Vb_ + VHS); vh1a = vtr(Vb_ + VHS + 512); MLA_SB(); \
        lrun += sacc; \
        MLA_DECIDE(N0, N1, ((t_) + 1) * 64); \
        MLA_SB(); \
        MLA_GB(o0 = __builtin_amdgcn_mfma_f32_32x32x16_bf16(__builtin_bit_cast(bf16x8, pw[0]), MLA_VF(vl0a, vh0a), o0, 0, 0, 0), N0, 0); vl0b = vtr(Vb_ + 1024); vh0b = vtr(Vb_ + 1024 + 512); MLA_SB(); \
        MLA_GB(o1 = __builtin_amdgcn_mfma_f32_32x32x16_bf16(__builtin_bit_cast(bf16x8, pw[0]), MLA_VF(vl1a, vh1a), o1, 0, 0, 0), N0, 4); vl1b = vtr(Vb_ + VHS + 1024); vh1b = vtr(Vb_ + VHS + 1024 + 512); MLA_SB(); \
        MLA_GB(o0 = __builtin_amdgcn_mfma_f32_32x32x16_bf16(__builtin_bit_cast(bf16x8, pw[1]), MLA_VF(vl0b, vh0b), o0, 0, 0, 0), N0, 8); vl0a = vtr(Vb_ + 2048); vh0a = vtr(Vb_ + 2048 + 512); MLA_SB(); \
        MLA_GB(o1 = __builtin_amdgcn_mfma_f32_32x32x16_bf16(__builtin_bit_cast(bf16x8, pw[1]), MLA_VF(vl1b, vh1b), o1, 0, 0, 0), N0, 12); vl1a = vtr(Vb_ + VHS + 2048); vh1a = vtr(Vb_ + VHS + 2048 + 512); MLA_SB(); \
        MLA_GB(o0 = __builtin_amdgcn_mfma_f32_32x32x16_bf16(__builtin_bit_cast(bf16x8, pw[2]), MLA_VF(vl0a, vh0a), o0, 0, 0, 0), N1, 0); vl0b = vtr(Vb_ + 3072); vh0b = vtr(Vb_ + 3072 + 512); MLA_SB(); \
        MLA_GB(o1 = __builtin_amdgcn_mfma_f32_32x32x16_bf16(__builtin_bit_cast(bf16x8, pw[2]), MLA_VF(vl1a, vh1a), o1, 0, 0, 0), N1, 4); vl1b = vtr(Vb_ + VHS + 3072); vh1b = vtr(Vb_ + VHS + 3072 + 512); MLA_SB(); \
        MLA_GB(o0 = __builtin_amdgcn_mfma_f32_32x32x16_bf16(__builtin_bit_cast(bf16x8, pw[3]), MLA_VF(vl0b, vh0b), o0, 0, 0, 0), N1, 8); MLA_SB(); \
        MLA_GB(o1 = __builtin_amdgcn_mfma_f32_32x32x16_bf16(__builtin_bit_cast(bf16x8, pw[3]), MLA_VF(vl1b, vh1b), o1, 0, 0, 0), N1, 12); MLA_SB(); \
        MLA_RESC(); } while (0)
#define MLA_TAIL(C0, C1, t_) do { float ls = 0.f; _Pragma("unroll") for (int r = 0; r < 16; ++r) ls += C0[r] + C1[r]; lrun += ls; ATT_PACK(C0, C1); ATT_PV((t_) & 3); } while (0)
#define MLA_STEP(C0, C1, N0, N1, t_) do { \
          \
        int lane_ = lane; asm volatile("" : "+v"(lane_)); const int r32 = lane_ & 31, hi = lane_ >> 5, qrow = qlo + r32; \
        const int vrd = ((lane_ >> 4) & 1) * 32 + (lane_ & 3) * 8 + (4 * hi + ((lane_ & 15) >> 2)) * 64; ALAS float* wsf = (ALAS float*)(lds + L_WSF) + wid * 64; \
        if ((t_) + 3 < ntile) { ATT_ISSUE((t_) + 3, (t_) + 3); issued = (t_) + 3; } \
        if ((t_) < tmax) MLA_FULL(C0, C1, N0, N1, t_); else if ((t_) == tmax) MLA_TAIL(C0, C1, t_); \
        ATT_WAIT_BAR(issued - ((t_) + 2)); } while (0)
    if (wid >= 4) __builtin_amdgcn_s_setprio(1);
    bool resc = false;
    ATT_QK(p0, p1, 0);
    MLA_DECIDE(p0, p1, 0);
#pragma unroll
    for (int r = 0; r < 16; ++r) { p0[r] = MLA_EX(p0[r]); p1[r] = MLA_EX(p1[r]); }
    asm volatile("s_waitcnt lgkmcnt(0)\n\ts_barrier" ::: "memory");
    for (int it = 0; it < ntile; it += 2) {
        MLA_STEP(p0, p1, n0, n1, it);
        if (it + 1 >= ntile) break;
        MLA_STEP(n0, n1, p0, p1, it + 1);
    }
    __builtin_amdgcn_s_setprio(0);
#undef MLA_SB
#undef MLA_EX
#undef MLA_DECIDE
#undef MLA_RESC
#undef MLA_PV_
#undef MLA_GA
#undef MLA_VF
#undef MLA_GB
#undef MLA_FULL
#undef MLA_TAIL
#undef MLA_STEP
    } else if constexpr (MODE == 1) {
    f32x16 p0, p1; u32x4 pw[4];
    __syncthreads();
    {
        const unsigned lds0_ = (unsigned)(uintptr_t)lds;
        for (int i = 0; i < ntile; ++i) { const int T_ = tfirst + i;
            glds16(ksrc0 + (size_t)T_ * KTS, (unsigned)__builtin_amdgcn_readfirstlane(lds0_ + S1_K + i * S1_KS + wid * KCS));
            glds16(vsrc + (size_t)T_ * VTS, (unsigned)__builtin_amdgcn_readfirstlane(lds0_ + S1_V + i * VSLOT + (wid >> 2) * VHS + (wid & 3) * 1024));
            if (wid == 0) glds4(P.pos + rb + (size_t)T_ * 64 + lane, (unsigned)__builtin_amdgcn_readfirstlane(lds0_ + S1_P + i * 256)); }
        ATT_LOADQ();
        ALAS float* lut = (ALAS float*)(lds + S1_LUT);
        if (tid < 129) { int bk = tid; if (tid >= 16) { bk = 16 + (int)((__builtin_amdgcn_logf((float)tid) - 4.0f) * (16.0f / 3.0f)); bk = bk < 31 ? bk : 31; } lut[tid] = P.relb[bk * 6 + h] * LOG2E; }
        asm volatile("s_waitcnt vmcnt(0) lgkmcnt(0)\n\ts_barrier" ::: "memory");
        const ALAS int* posk = (const ALAS int*)(lds + S1_P);
        const int lo_ = qlo - 127 > 0 ? qlo - 127 : 0; const int i_lo = (lo_ >> 6) - tfirst, i_hi = (qhi >> 6) - tfirst;
        for (int i = i_lo; i <= i_hi; ++i) {
            const int j0 = (tfirst + i) * 64;
            {
                int kofs_ = S1_K + i * S1_KS + hi * KCS + r32 * 16; asm volatile("" : "+v"(kofs_)); const ALAS unsigned char* Kb_ = lds + kofs_;
#pragma unroll
                for (int d0 = 0; d0 < ND0; ++d0) { const bf16x8 a0_ = *(const ALAS bf16x8*)(Kb_ + 2 * d0 * KCS), a1_ = *(const ALAS bf16x8*)(Kb_ + 2 * d0 * KCS + 512);
                    if (d0 == 0) { p0 = __builtin_amdgcn_mfma_f32_32x32x16_bf16(a0_, qf[0], negm, 0, 0, 0); p1 = __builtin_amdgcn_mfma_f32_32x32x16_bf16(a1_, qf[0], negm, 0, 0, 0); }
                    else { p0 = __builtin_amdgcn_mfma_f32_32x32x16_bf16(a0_, qf[d0], p0, 0, 0, 0); p1 = __builtin_amdgcn_mfma_f32_32x32x16_bf16(a1_, qf[d0], p1, 0, 0, 0); } }
            }
#pragma unroll
            for (int g = 0; g < 4; ++g) {
                const i32x4 pa = *(const ALAS i32x4*)(posk + i * 64 + 8 * g + 4 * hi), pb = *(const ALAS i32x4*)(posk + i * 64 + 32 + 8 * g + 4 * hi);
#pragma unroll
                for (int q = 0; q < 4; ++q) { int na = posq - pa[q]; na = na > 0 ? na : 0; na = na < 128 ? na : 128; int nb = posq - pb[q]; nb = nb > 0 ? nb : 0; nb = nb < 128 ? nb : 128;
                    p0[4 * g + q] += lut[na]; p1[4 * g + q] += lut[nb]; }
            }
#pragma unroll
            for (int r = 0; r < 16; ++r) { const int key = j0 + crow(r, hi); const bool ok0 = key <= qrow && key > qrow - 128, ok1 = key + 32 <= qrow && key + 32 > qrow - 128; if (!ok0) p0[r] = -INFINITY; if (!ok1) p1[r] = -INFINITY; }
            float ma = ATT_MAX3(p0[0], p0[1], p1[0]), mb = ATT_MAX3(p0[2], p0[3], p1[1]); ma = ATT_MAX3(ma, p1[2], p1[3]);
#pragma unroll
            for (int r = 4; r < 16; r += 4) { ma = ATT_MAX3(ma, p0[r], p0[r + 1]); mb = ATT_MAX3(mb, p0[r + 2], p0[r + 3]); ma = ATT_MAX3(ma, p1[r], p1[r + 1]); mb = ATT_MAX3(mb, p1[r + 2], p1[r + 3]); }
            const float mt = swap_max(fmaxf(ma, mb));
            if (__any(mt > THR)) {
                const float d = fmaxf(mt, 0.f);
#pragma unroll
                for (int r = 0; r < 16; ++r) { p0[r] -= d; p1[r] -= d; }
                const float alpha = __builtin_amdgcn_exp2f(-d); mrun += d; lrun *= alpha;
#pragma unroll
                for (int r = 0; r < 16; ++r) negm[r] = -mrun;
                if (hi == 0) wsf[r32] = alpha;
#pragma unroll
                for (int g = 0; g < 4; ++g) { const f32x4 al = *(const ALAS f32x4*)(wsf + 8 * g + 4 * hi);
#pragma unroll
                    for (int q = 0; q < 4; ++q) { o0[4 * g + q] *= al[q]; o1[4 * g + q] *= al[q]; } }
            }
            float ls = 0.f;
#pragma unroll
            for (int r = 0; r < 16; ++r) { p0[r] = __builtin_amdgcn_exp2f(p0[r]); p1[r] = __builtin_amdgcn_exp2f(p1[r]); ls += p0[r] + p1[r]; }
            lrun += ls;
            ATT_PACK(p0, p1);
            {
                int vofs_ = S1_V + i * VSLOT + vrd; asm volatile("" : "+v"(vofs_)); const ALAS unsigned char* Vb_ = lds + vofs_;
#pragma unroll
                for (int s_ = 0; s_ < 4; ++s_) { const bf16x8 pa_ = __builtin_bit_cast(bf16x8, pw[s_]);
                    const s16x4 l0_ = vtr(Vb_ + s_ * 1024), h0_ = vtr(Vb_ + s_ * 1024 + 512), l1_ = vtr(Vb_ + VHS + s_ * 1024), h1_ = vtr(Vb_ + VHS + s_ * 1024 + 512);
                    const bf16x8 v0_ = {l0_[0], l0_[1], l0_[2], l0_[3], h0_[0], h0_[1], h0_[2], h0_[3]}, v1_ = {l1_[0], l1_[1], l1_[2], l1_[3], h1_[0], h1_[1], h1_[2], h1_[3]};
                    o0 = __builtin_amdgcn_mfma_f32_32x32x16_bf16(pa_, v0_, o0, 0, 0, 0); o1 = __builtin_amdgcn_mfma_f32_32x32x16_bf16(pa_, v1_, o1, 0, 0, 0); }
            }
        }
        asm volatile("s_waitcnt lgkmcnt(0)\n\ts_barrier" ::: "memory");
    }
    } else {
    bool go_on = true;
    {
        u32x4 pw[4]; f32x16 p0, p1;
        const int nwin = ntile < 7 ? ntile : 7;
        __syncthreads();
        const unsigned lds0_ = (unsigned)(uintptr_t)lds;
        for (int i = 0; i < nwin; ++i) { const int T_ = tfirst - i;
            glds16(ksrc0 + (size_t)T_ * KTS, (unsigned)__builtin_amdgcn_readfirstlane(lds0_ + S1_K + i * S1_KS + wid * KCS));
            glds16(vsrc + (size_t)T_ * VTS, (unsigned)__builtin_amdgcn_readfirstlane(lds0_ + S1_V + i * VSLOT + (wid >> 2) * VHS + (wid & 3) * 1024)); }
        ATT_LOADQ();
        asm volatile("s_waitcnt vmcnt(0) lgkmcnt(0)\n\ts_barrier" ::: "memory");
        for (int i = 0; i < nwin; ++i) {
            const int j0 = (tfirst - i) * 64;
            if (!(walive && j0 < qhi)) { if (!walive) break; continue; }
            {
                int kofs_ = S1_K + i * S1_KS + hi * KCS + r32 * 16; asm volatile("" : "+v"(kofs_)); const ALAS unsigned char* Kb_ = lds + kofs_;
#pragma unroll
                for (int d0 = 0; d0 < ND0; ++d0) { const bf16x8 a0_ = *(const ALAS bf16x8*)(Kb_ + 2 * d0 * KCS), a1_ = *(const ALAS bf16x8*)(Kb_ + 2 * d0 * KCS + 512);
                    if (d0 == 0) { p0 = __builtin_amdgcn_mfma_f32_32x32x16_bf16(a0_, qf[0], negm, 0, 0, 0); p1 = __builtin_amdgcn_mfma_f32_32x32x16_bf16(a1_, qf[0], negm, 0, 0, 0); }
                    else { p0 = __builtin_amdgcn_mfma_f32_32x32x16_bf16(a0_, qf[d0], p0, 0, 0, 0); p1 = __builtin_amdgcn_mfma_f32_32x32x16_bf16(a1_, qf[d0], p1, 0, 0, 0); } }
            }
            ATT_SM_B(p0, p1, j0);
            {
                int vofs_ = S1_V + i * VSLOT + vrd; asm volatile("" : "+v"(vofs_)); const ALAS unsigned char* Vb_ = lds + vofs_;
#pragma unroll
                for (int s_ = 0; s_ < 4; ++s_) { const bf16x8 pa_ = __builtin_bit_cast(bf16x8, pw[s_]);
                    const s16x4 l0_ = vtr(Vb_ + s_ * 1024), h0_ = vtr(Vb_ + s_ * 1024 + 512), l1_ = vtr(Vb_ + VHS + s_ * 1024), h1_ = vtr(Vb_ + VHS + s_ * 1024 + 512);
                    const bf16x8 v0_ = {l0_[0], l0_[1], l0_[2], l0_[3], h0_[0], h0_[1], h0_[2], h0_[3]}, v1_ = {l1_[0], l1_[1], l1_[2], l1_[3], h1_[0], h1_[1], h1_[2], h1_[3]};
                    o0 = __builtin_amdgcn_mfma_f32_32x32x16_bf16(pa_, v0_, o0, 0, 0, 0); o1 = __builtin_amdgcn_mfma_f32_32x32x16_bf16(pa_, v1_, o1, 0, 0, 0); }
            }
        }
        ALAS int* fl = (ALAS int*)(lds + S1_WSF);
        if (lane == 0) fl[wid] = (walive && tfirst - nwin >= 0) ? 1 : 0;
        asm volatile("s_waitcnt lgkmcnt(0)\n\ts_barrier" ::: "memory");
        const i32x4 fa = *(const ALAS i32x4*)fl, fb = *(const ALAS i32x4*)(fl + 4);
        go_on = ((fa[0] | fa[1]) | (fa[2] | fa[3]) | (fb[0] | fb[1]) | (fb[2] | fb[3])) != 0;
        tfirst -= nwin; ntile = tfirst + 1;
    }
    if (go_on) {
    f32x16 p0, p1, n0, n1; u32x4 pw[4];
    __syncthreads();
    int issued = 0;
    ATT_ISSUE(tfirst, 0);
    if (ntile > 1) { ATT_ISSUE(tfirst + tstep, 1); issued = 1; }
    if (ntile > 2) { ATT_ISSUE(tfirst + 2 * tstep, 2); issued = 2; }
    ATT_WAIT_BAR(issued - 1);
    bool wcur = ATT_WORK(tfirst * 64);
    if (wcur) ATT_QK(p0, p1, 0);
    asm volatile("s_waitcnt lgkmcnt(0)\n\ts_barrier" ::: "memory");
    int nt = ntile;
    for (int it = 0; it < nt; ++it) {
        const int t = tfirst + it * tstep, j0 = t * 64, jn = (t + tstep) * 64;
        if (it + 3 < ntile) { ATT_ISSUE(t + 3 * tstep, it + 3); issued = it + 3; }
        if (wcur) ATT_SM_A(p0, p1, j0, it & 3);
        const bool wnext = (it + 1 < nt) && ATT_WORK(jn);
        if (wcur && wnext) { ATT_QK(n0, n1, (it + 1) % 3); ATT_SM_B(p0, p1, j0); }
        else { if (wnext) ATT_QK(n0, n1, (it + 1) % 3); if (wcur) ATT_SM_B(p0, p1, j0); }
        if (wcur) ATT_PV(it & 3);
        p0 = n0; p1 = n1; wcur = wnext;
        if (MODE == 2) { ALAS int* fl = (ALAS int*)(lds + L_FLAG + 16) + (it & 1) * 8; if (lane == 0) fl[wid] = (walive && j0 > 0) ? 1 : 0; }
        ATT_WAIT_BAR(issued - (it + 2));
        if (MODE == 2) { const ALAS int* fl = (const ALAS int*)(lds + L_FLAG + 16) + (it & 1) * 8;
            const i32x4 fa = *(const ALAS i32x4*)fl, fb = *(const ALAS i32x4*)(fl + 4);
            if (((fa[0] | fa[1]) | (fa[2] | fa[3]) | (fb[0] | fb[1]) | (fb[2] | fb[3])) == 0) nt = it + 1; }
    }
    }
    }
    if (MODE == 2) asm volatile("s_waitcnt vmcnt(0)" ::: "memory");
#undef ATT_ISSUE
#undef ATT_LOADQ
#undef ATT_WAIT_BAR
#undef ATT_QK
#undef ATT_PV
#undef ATT_PACK
#undef ATT_VLD
#undef ATT_SM_A
#undef ATT_SM_B
#undef ATT_WORK
#undef ATT_MAX3
    unsigned nxt_ = 0u; if (tid == 0) nxt_ = __hip_atomic_fetch_add(qhead, 1u, __ATOMIC_RELAXED, __HIP_MEMORY_SCOPE_AGENT);
    if (MODE != 2) {
        const float lt = swap_sum(lrun);
        if (hi == 0) wsf[32 + r32] = 1.0f / lt;
#pragma unroll
        for (int g = 0; g < 4; ++g) { const f32x4 il = *(const ALAS f32x4*)(wsf + 32 + 8 * g + 4 * hi);
#pragma unroll
            for (int i = 0; i < 4; ++i) { o0[4 * g + i] *= il[i]; o1[4 * g + i] *= il[i]; } }
    }
    {
        ALAS bf16_t* stg = (ALAS bf16_t*)ost;
#pragma unroll
        for (int r = 0; r < 16; ++r) { const int orow = crow(r, hi); stg[orow * 64 + r32] = (bf16_t)(cvtpk(o0[r], 0.f) & 0xffffu); stg[orow * 64 + 32 + r32] = (bf16_t)(cvtpk(o1[r], 0.f) & 0xffffu); }
        AGAS bf16_t* Ow = (AGAS bf16_t*)(P.ws + WS_OALL) + (rb + qlo) * 1024 + C::ocol0 + h * 64;
#pragma unroll
        for (int i = 0; i < 4; ++i) {
            const int row = i * 8 + (lane >> 3), ch = lane & 7;
            const u32x4 v = *(const ALAS u32x4*)(stg + row * 64 + ch * 8);
            float ss = 0.f;
#pragma unroll
            for (int k = 0; k < 4; ++k) { const unsigned w = v[k]; const float a = __uint_as_float(w << 16), c = __uint_as_float(w & 0xffff0000u); ss += a * a + c * c; }
            ss += __shfl_xor(ss, 1); ss += __shfl_xor(ss, 2); ss += __shfl_xor(ss, 4);
            *(AGAS u32x4*)(Ow + (size_t)row * 1024 + ch * 8) = v;
            if (ch == 0) ((AGAS float*)(P.ws + WS_SSQO))[(rb + qlo + row) * 16 + C::hidx0 + h] = ss;
        }
    }
    if (tid == 0) *(ALAS unsigned*)(lds + L_NEXT) = nxt_;
#ifdef ATT_PROF
    if (MODE == 0 && blockIdx.x == 0 && wid == ATT_PROF_WAVE && lane == 0 && prof) { const long long tt = PROF_T() - pf_t0;
        atomicAdd(prof + 0, (unsigned long long)tt); atomicAdd(prof + 1, (unsigned long long)pf_qk); atomicAdd(prof + 2, (unsigned long long)pf_sm); atomicAdd(prof + 3, (unsigned long long)pf_pv); atomicAdd(prof + 4, (unsigned long long)pf_wait); atomicAdd(prof + 5, 1ull); }
#endif
}
#undef ALAS
#undef AGAS
}
struct Args { const void* in[23]; float* out; unsigned char* ws; int ph_lo, ph_hi, li, adapt; };

struct Frame { LAS unsigned char* lds; int wave, vcu, G; };
#define FLANE hw_lane()
#define FTID (F.wave * 64 + hw_lane())

__device__ __forceinline__ float wave_sum64(float v) { return pg8::wave_sum_dpp(v); }

constexpr int RR_OFF = LDSCTL_OFF + 2048;
__device__ __forceinline__ void glds16g(const GAS void* gsrc, unsigned lds_dst) { unsigned keep;
    asm volatile("s_mov_b32 %0, m0\n\ts_mov_b32 m0, %2\n\ts_nop 0\n\tglobal_load_lds_dwordx4 %1, off nt\n\ts_mov_b32 m0, %0" : "=&s"(keep) : "v"(gsrc), "s"(lds_dst) : "memory"); }
__device__ __forceinline__ void tr_item64(const GAS float* W, int ldn, int K, GAS pg8::bf16_t* WT, int kb, int g, int src0, int src1, const GAS float* kgain, LAS unsigned char* buf, int lane) {
    const int k0 = 64 * kb, r = lane >> 4, sl = lane & 15;
    const unsigned b0 = (unsigned)(uintptr_t)buf;
    const GAS float* wrow = W + (size_t)(k0 + r) * ldn;
    asm volatile("s_waitcnt lgkmcnt(0)" ::: "memory");
#pragma unroll
    for (int q = 0; q < 16; ++q) {
        const int c = sl ^ (2 * (q >> 1)); const int sc = c < 8 ? src0 : src1; const int col = (sc >= 0 ? sc : 0) + 4 * (c & 7);
        glds16g(wrow + (size_t)(4 * q) * ldn + col, (unsigned)__builtin_amdgcn_readfirstlane(b0 + q * 1024));
    }
    const int cc = lane & 7, nL = lane >> 3;
    f32x4 kg0 = {1.f, 1.f, 1.f, 1.f}, kg1 = {1.f, 1.f, 1.f, 1.f};
    if (kgain) { kg0 = *(const GAS f32x4*)(kgain + k0 + 8 * cc); kg1 = *(const GAS f32x4*)(kgain + k0 + 8 * cc + 4); }
    asm volatile("s_waitcnt vmcnt(0)" ::: "memory");
#pragma unroll
    for (int j = 0; j < 8; ++j) {
        const int n = nL + 8 * j, c = n >> 2, e = n & 3; const bool ok = (n < 32 ? src0 : src1) >= 0;
        const LAS float* p = (const LAS float*)(buf + cc * 2048 + ((c ^ (2 * cc)) * 16 + e * 4));
        float v[8];
#pragma unroll
        for (int i = 0; i < 8; ++i) v[i] = p[i * 64];
#pragma unroll
        for (int i = 0; i < 4; ++i) { v[i] = ok ? v[i] * kg0[i] : 0.f; v[4 + i] = ok ? v[4 + i] * kg1[i] : 0.f; }
        v4u o; o.x = pg8::cvt_pk_bf16(v[0], v[1]); o.y = pg8::cvt_pk_bf16(v[2], v[3]); o.z = pg8::cvt_pk_bf16(v[4], v[5]); o.w = pg8::cvt_pk_bf16(v[6], v[7]);
        *(GAS v4u*)(WT + (size_t)(64 * g + n) * K + k0 + 8 * cc) = o;
    }
}
__device__ __forceinline__ int in_slot_src(int slot, int& cnt) {
    cnt = 64;
    if (slot < 4) return 64 * slot;
    if (slot < 6) return 256 + 64 * (slot - 4);
    if (slot == 6) { cnt = 32; return 384; }
    if (slot == 7) return -1;
    if (slot < 14) return 416 + 64 * (slot - 8);
    if (slot < 16) return 800 + 64 * (slot - 14);
    if (slot < 18) return 928 + 64 * (slot - 16);
    if (slot < 22) return 1056 + 64 * (slot - 18);
    if (slot < 26) return 1312 + 64 * (slot - 22);
    if (slot < 30) return 1568 + 64 * (slot - 26);
    return -1;
}

#define A_X ((const GAS float*)args.in[0])
#define A_C ((const GAS float*)args.in[1])
#define A_POS ((const GAS int*)args.in[2])
#define A_RELB ((const GAS float*)args.in[3])
#define A_NORMG ((const GAS float*)args.in[4])
#define A_WMOD ((const GAS float*)args.in[5])
#define A_BMOD ((const GAS float*)args.in[6])
#define A_WGU1 ((const GAS float*)args.in[7])
#define A_WD1 ((const GAS float*)args.in[8])
#define A_WIN ((const GAS float*)args.in[9])
#define A_QAN ((const GAS float*)args.in[10])
#define A_KVAN ((const GAS float*)args.in[11])
#define A_WUQ ((const GAS float*)args.in[12])
#define A_WUKV ((const GAS float*)args.in[13])
#define A_MLAQN ((const GAS float*)args.in[14])
#define A_MLAKN ((const GAS float*)args.in[15])
#define A_SWAQN ((const GAS float*)args.in[16])
#define A_SWAKN ((const GAS float*)args.in[17])
#define A_SINKS ((const GAS float*)args.in[18])
#define A_OUTN ((const GAS float*)args.in[19])
#define A_WOUT ((const GAS float*)args.in[20])
#define A_WGU2 ((const GAS float*)args.in[21])
#define A_WD2 ((const GAS float*)args.in[22])
#define WSP(off)   (ws_ + (off))
#define MOD ((GAS float*)WSP(WS_MOD))
#define GS ((GAS float*)WSP(WS_GS))
#define BIAS ((GAS float*)WSP(WS_BIAS))
#define SSQX ((GAS float*)WSP(WS_SSQX))
#define SSQO ((GAS float*)WSP(WS_SSQO))
#define CS ((GAS float*)WSP(WS_CS))
#define KPE ((GAS float*)WSP(WS_KPE))
#define SSQ_CQ ((GAS float*)WSP(WS_SSQC))
#define SSQ_CKV ((GAS float*)WSP(WS_SSQC) + (size_t)MROWS * 4)
#define SSQ_KPE ((GAS float*)WSP(WS_SSQC) + (size_t)MROWS * 6)
#define XB ((GAS pg8::bf16_t*)WSP(WS_XB))
#define HID ((GAS pg8::bf16_t*)WSP(WS_HID))
#define CQ ((GAS pg8::bf16_t*)WSP(WS_CQ))
#define CKV ((GAS pg8::bf16_t*)WSP(WS_CKV))
#define KA ((GAS pg8::bf16_t*)WSP(WS_KA))
#define VA ((GAS pg8::bf16_t*)WSP(WS_VA))
#define QS ((GAS pg8::bf16_t*)WSP(WS_QS))
#define KS ((GAS pg8::bf16_t*)WSP(WS_KS))
#define VS ((GAS pg8::bf16_t*)WSP(WS_VS))
#define QC ((GAS pg8::bf16_t*)WSP(WS_QC))
#define KC ((GAS pg8::bf16_t*)WSP(WS_KC))
#define VC ((GAS pg8::bf16_t*)WSP(WS_VC))
#define OALL ((GAS pg8::bf16_t*)WSP(WS_OALL))
#define QRAW ((GAS float*)WSP(WS_QRAW))

__device__ __forceinline__ int in_group_src(int g32) {
    const int tile = g32 >> 3, rr = g32 & 7, bj = rr >> 2, wc = rr & 3; int cnt; const int base = in_slot_src(tile * 4 + wc, cnt);
    return (base >= 0 && 32 * bj < cnt) ? base + 32 * bj : -1;
}
constexpr int CV_GU = 16 * 88, CV_D = 44 * 16, CV_IN = 16 * 32, CV_UQ = 4 * 12, CV_UKV = 2 * 12, CV_OUT = 16 * 16;
constexpr int CV_EARLY = CV_GU + CV_D + CV_IN + CV_UQ + CV_UKV + CV_OUT, CV_L = CV_EARLY + CV_GU + CV_D, CV_ALL = DEPTH * CV_L;
__device__ __forceinline__ void convert_chunk(Frame& F, const Args& args, int base, int limit) {
    GAS unsigned char* ws_ = (GAS unsigned char*)args.ws; asm volatile("" : "+s"(ws_));
    LAS unsigned char* scr = F.lds + F.wave * 16384;
#pragma unroll 1
    for (int q = 0; q < 2; ++q) {
        const int it = base + F.wave * 2 + q; if (it >= limit) break;
        const int l = it / CV_L; int r = it % CV_L;
        GAS unsigned char* wl = ws_ + WS_W + (size_t)l * WL;
        int kind;
        if (r < CV_GU) kind = 0; else if ((r -= CV_GU) < CV_D) kind = 1; else if ((r -= CV_D) < CV_IN) kind = 2; else if ((r -= CV_IN) < CV_UQ) kind = 3;
        else if ((r -= CV_UQ) < CV_UKV) kind = 4; else if ((r -= CV_UKV) < CV_OUT) kind = 5; else if ((r -= CV_OUT) < CV_GU) kind = 6; else { r -= CV_GU; kind = 7; }
        if (kind == 0 || kind == 6) {
            const bool second = kind == 6; const int kb = r / 88, g = r % 88, t = g >> 2, rr = g & 3, src = (rr >> 1) * DFF + 128 * t + 64 * (rr & 1);
            const GAS float* W = (second ? A_WGU2 : A_WGU1) + (size_t)l * DM * 2 * DFF;
            tr_item64(W, 2 * DFF, DM, (GAS pg8::bf16_t*)(wl + (second ? W_GU2 : W_GU1)), kb, g, src, src + 32, nullptr, scr, FLANE);
        } else if (kind == 1 || kind == 7) { const bool second = kind == 7; const int kb = r / 16, g = r % 16;
            tr_item64((second ? A_WD2 : A_WD1) + (size_t)l * DFF * DM, DM, DFF, (GAS pg8::bf16_t*)(wl + (second ? W_D2 : W_D1)), kb, g, 64 * g, 64 * g + 32, nullptr, scr, FLANE);
        } else if (kind == 2) { const int kb = r / 32, g = r % 32;
            tr_item64(A_WIN + (size_t)l * DM * DIN, DIN, DM, (GAS pg8::bf16_t*)(wl + W_IN), kb, g, in_group_src(2 * g), in_group_src(2 * g + 1), nullptr, scr, FLANE);
        } else if (kind == 3) { const int kb = r / 12, g = r % 12;
            tr_item64(A_WUQ + (size_t)l * 256 * 576, 576, 256, (GAS pg8::bf16_t*)(wl + W_UQ), kb, g, g < 9 ? 64 * g : -1, g < 9 ? 64 * g + 32 : -1, A_QAN + l * 256, scr, FLANE);
        } else if (kind == 4) { const int kb = r / 12, g = r % 12, g0 = 2 * g, g1 = 2 * g + 1;
            tr_item64(A_WUKV + (size_t)l * 128 * 768, 768, 128, (GAS pg8::bf16_t*)(wl + W_UKV), kb, g, 256 * (g0 >> 3) + 64 * (g0 & 3) + 32 * ((g0 & 7) >> 2), 256 * (g1 >> 3) + 64 * (g1 & 3) + 32 * ((g1 & 7) >> 2), A_KVAN + l * 128, scr, FLANE);
        } else { const int kb = r / 16, g = r % 16;
            tr_item64(A_WOUT + (size_t)l * DM * DM, DM, DM, (GAS pg8::bf16_t*)(wl + W_OUT), kb, g, 64 * g, 64 * g + 32, A_OUTN + l * DM, scr, FLANE); }
    }
}

__device__ __forceinline__ void phase_pro0(Frame& F, const Args& args, gu32* qhead) {
    GAS unsigned char* ws_ = (GAS unsigned char*)args.ws; asm volatile("" : "+s"(ws_));
    constexpr int NMU = DEPTH * NMOD / 128;
    if ((int)blockIdx.x < NMU || F.G <= NMU) {
        LAS float* cond = (LAS float*)F.lds;
        LAS float* red = (LAS float*)(F.lds + 8192);
        for (int i = FTID; i < 2 * DM; i += 512) { const float cv = A_C[i]; cond[i] = cv / (1.0f + expf(-cv)); }
        __syncthreads();
        for (int u = blockIdx.x; u < NMU; u += F.G) {
            const int l = u / (NMOD / 128), n0 = (u % (NMOD / 128)) * 128, c4 = FLANE & 31, kp = FLANE >> 5;
            const GAS float* w = A_WMOD + (size_t)l * DM * NMOD + n0 + 4 * c4;
            f32x4 a0 = {0.f, 0.f, 0.f, 0.f}, a1 = {0.f, 0.f, 0.f, 0.f};
#pragma unroll 8
            for (int i = 0; i < 64; ++i) { const int kk = F.wave * 128 + 2 * i + kp; const f32x4 wv = __builtin_nontemporal_load((const GAS f32x4*)(w + (size_t)kk * NMOD));     a0 += wv * cond[kk]; a1 += wv * cond[DM + kk]; }
#pragma unroll
            for (int q = 0; q < 4; ++q) { a0[q] = pg8::xsum32(a0[q]); a1[q] = pg8::xsum32(a1[q]); }
            if (kp == 0) { *(LAS f32x4*)(red + (F.wave * 2 + 0) * 128 + 4 * c4) = a0; *(LAS f32x4*)(red + (F.wave * 2 + 1) * 128 + 4 * c4) = a1; }
            __syncthreads();
            if (FTID < 256) { const int bb = FTID >> 7, ln = FTID & 127; float s = 0.f;
#pragma unroll
                for (int wv = 0; wv < 8; ++wv) s += red[(wv * 2 + bb) * 128 + ln];
                MOD[((size_t)l * 2 + bb) * NMOD + n0 + ln] = s + A_BMOD[(size_t)l * NMOD + n0 + ln]; }
            __syncthreads();
        }
    }
    if ((int)blockIdx.x >= NMU || F.G <= NMU) {
        const int nb = F.G <= NMU ? F.G : F.G - NMU, b0 = F.G <= NMU ? (int)blockIdx.x : (int)blockIdx.x - NMU;
        for (int i = b0 * 512 + FTID; i < MROWS * 16; i += nb * 512) {
            const int m = i >> 4, j = i & 15;
            const float freq = powf(10000.0f, -(float)j / 16.0f);
            const float ang = (float)A_POS[m] * freq;
            CS[(size_t)m * 32 + j] = cosf(ang); CS[(size_t)m * 32 + 16 + j] = sinf(ang);
        }
    }
    {
        LAS int* slot = (LAS int*)(F.lds + RR_OFF);
        for (;;) {
            __syncthreads();
            if (FTID == 0) slot[0] = (int)__hip_atomic_fetch_add(qhead, 16u, __ATOMIC_RELAXED, __HIP_MEMORY_SCOPE_AGENT);
            __syncthreads();
            const int base = slot[0];
            if (base >= CV_EARLY) break;
            convert_chunk(F, args, base, CV_EARLY);
        }
    }
}

__device__ __forceinline__ float gs_clamped(float g, float sc) { const float v = g * (1.0f + sc); return fabsf(v) < 1e-20f ? (v < 0.f ? -1e-20f : 1e-20f) : v; }
__device__ __forceinline__ void x_to_xb(Frame& F, const Args& args, const GAS float* xsrc, int l, int i) {
    GAS unsigned char* ws_ = (GAS unsigned char*)args.ws; asm volatile("" : "+s"(ws_));
    const int gw = F.vcu * NWAVES + F.wave, NGW = F.G * NWAVES;
    const GAS f32x4* gr = (const GAS f32x4*)(A_NORMG + ((size_t)l * 3 + i) * DM) + FLANE;
    f32x4 gsv[2][4];
#pragma unroll
    for (int b = 0; b < 2; ++b) { const GAS f32x4* sr = (const GAS f32x4*)(MOD + ((size_t)l * 2 + b) * NMOD + (3 * i + 1) * DM) + FLANE;
#pragma unroll
        for (int j = 0; j < 4; ++j) { const f32x4 g0 = gr[64 * j], s0 = sr[64 * j]; gsv[b][j] = (f32x4){gs_clamped(g0.x, s0.x), gs_clamped(g0.y, s0.y), gs_clamped(g0.z, s0.z), gs_clamped(g0.w, s0.w)}; } }
#pragma unroll 1
    for (int m0 = gw; m0 < MROWS; m0 += 4 * NGW) {
        f32x4 v[4][4];
#pragma unroll
        for (int q = 0; q < 4; ++q) { const int m = m0 + q * NGW < MROWS ? m0 + q * NGW : m0;
            const GAS f32x4* xr = (const GAS f32x4*)(xsrc + (size_t)m * DM) + FLANE;
#pragma unroll
            for (int j = 0; j < 4; ++j) v[q][j] = __builtin_nontemporal_load(xr + 64 * j); }
#pragma unroll
        for (int q = 0; q < 4; ++q) { const int m = m0 + q * NGW; const bool b1 = (m >> 13) != 0;
            GAS unsigned long long* o8 = (GAS unsigned long long*)(XB + (size_t)(m < MROWS ? m : m0) * DM) + FLANE;
            float s = 0.f;
#pragma unroll
            for (int j = 0; j < 4; ++j) { const f32x4 x = v[q][j]; s += (x.x * x.x + x.y * x.y) + (x.z * x.z + x.w * x.w);
                const f32x4 y = x * (b1 ? gsv[1][j] : gsv[0][j]);
                if (m < MROWS) o8[64 * j] = (unsigned long long)pk2(y.x, y.y) | ((unsigned long long)pk2(y.z, y.w) << 32); }
            s = wave_sum64(s);
            if (m < MROWS && FLANE < 16) SSQX[(size_t)m * 16 + FLANE] = (FLANE == 0) ? s : 0.f;
        }
    }
}

__device__ __forceinline__ void bias_rows(Frame& F, const Args& args, bool early) {
    GAS unsigned char* ws_ = (GAS unsigned char*)args.ws; asm volatile("" : "+s"(ws_));
    const int gw = F.vcu * NWAVES + F.wave, NGW = F.G * NWAVES;
#pragma unroll 1
    for (int sg = early ? 0 : 2; sg < (early ? 2 : 3 * DEPTH); ++sg) {
        const int l = sg / 3, which = sg % 3;
        const int nrow = which == 1 ? 2048 : 5632;
        const size_t woff = which == 0 ? W_GU1 : which == 1 ? W_IN : W_GU2, boff = which == 0 ? 0 : which == 1 ? 2 * 5632 : 2 * (5632 + 2048);
        const GAS float* s0 = MOD + ((size_t)l * 2 + 0) * NMOD + (3 * which) * DM + FLANE * 8; const GAS float* s1 = s0 + NMOD;
        f32x4 sa[2][2], sb[2][2];
#pragma unroll
        for (int j2 = 0; j2 < 2; ++j2) { sa[j2][0] = *(const GAS f32x4*)(s0 + j2 * 512); sa[j2][1] = *(const GAS f32x4*)(s0 + j2 * 512 + 4); sb[j2][0] = *(const GAS f32x4*)(s1 + j2 * 512); sb[j2][1] = *(const GAS f32x4*)(s1 + j2 * 512 + 4); }
        const GAS pg8::bf16_t* wbase = (const GAS pg8::bf16_t*)(ws_ + WS_W + (size_t)l * WL + woff) + FLANE * 8;
#pragma unroll 1
        for (int r0 = gw; r0 < nrow; r0 += 3 * NGW) {
            v4u wv[3][2];
#pragma unroll
            for (int q = 0; q < 3; ++q) { const int r = r0 + q * NGW < nrow ? r0 + q * NGW : r0;
#pragma unroll
                for (int j2 = 0; j2 < 2; ++j2) wv[q][j2] = *(const GAS v4u*)(wbase + (size_t)r * DM + j2 * 512); }
#pragma unroll
            for (int q = 0; q < 3; ++q) { const int r = r0 + q * NGW;
                float a0 = 0.f, a1 = 0.f;
#pragma unroll
                for (int j2 = 0; j2 < 2; ++j2)
#pragma unroll
                    for (int k = 0; k < 4; ++k) { const unsigned w = wv[q][j2][k]; const float lo_ = __uint_as_float(w << 16), hi_ = __uint_as_float(w & 0xffff0000u);
                        const float x0 = sa[j2][k >> 1][2 * (k & 1)], x1 = sa[j2][k >> 1][2 * (k & 1) + 1], y0 = sb[j2][k >> 1][2 * (k & 1)], y1 = sb[j2][k >> 1][2 * (k & 1) + 1];
                        a0 += lo_ * x0 + hi_ * x1; a1 += lo_ * y0 + hi_ * y1; }
                a0 = wave_sum64(a0); a1 = wave_sum64(a1);
                if (FLANE == 0 && r < nrow) { BIAS[(size_t)l * BIAS_L + boff + r] = a0; BIAS[(size_t)l * BIAS_L + boff + nrow + r] = a1; }
            }
        }
    }
}
__device__ __forceinline__ void phase_pro1(Frame& F, const Args& args) {
    GAS unsigned char* ws_ = (GAS unsigned char*)args.ws; asm volatile("" : "+s"(ws_));
    for (int i = blockIdx.x * 512 + FTID; i < DEPTH * 3 * 2 * DM; i += F.G * 512) {
        const int cidx = i & 1023, b = (i >> 10) & 1, li = i >> 11, l = li / 3, ii = li % 3;
        const float gv_ = gs_clamped(A_NORMG[((size_t)l * 3 + ii) * DM + cidx], MOD[((size_t)l * 2 + b) * NMOD + (3 * ii + 1) * DM + cidx]);
        GS[i] = gv_; ((GAS float*)WSP(WS_IGS))[i] = 1.0f / gv_;
    }
    bias_rows(F, args, true);
    x_to_xb(F, args, A_X, 0, 0);
}

__device__ __forceinline__ void fill_rr(Frame& F, const Args& args, const pg8::StaticOrder& S, const GAS float* bias) {
    GAS unsigned char* ws_ = (GAS unsigned char*)args.ws; asm volatile("" : "+s"(ws_));
    LAS float* rr = (LAS float*)(F.lds + RR_OFF);
    const GAS float* ssqx = (const GAS float*)(ws_ + WS_SSQX);
    for (int idx = FTID; idx < 6 * 256; idx += 512) {
        pg8::Unit u; if (!S.next(idx >> 8, u)) break;
        const int row = u.pm * 256 + (idx & 255);
        rr[idx] = 1.0f / sqrtf(pg8::sum16f(ssqx + (size_t)row * 16) * (1.0f / 1024.0f) + pg8::RMS_EPS);
        rr[6 * 256 + idx] = bias[(u.pm >> 5) * (S.nN * 256) + u.pn * 256 + (idx & 255)];
    }
    __syncthreads();
}

__device__ __forceinline__ void fill_grp(Frame& F, const pg8::EpiResS<true>& E, const pg8::StaticOrder& S) {
    LAS float* gt = (LAS float*)(F.lds + RR_OFF);
    pg8::Unit u;
    if (S.next(0, u) && FTID < 256) { const int t = FTID; float rA, rB, rC; E.group_r(u.pm * 256 + t, rA, rB, rC); gt[t] = rA / rB; gt[256 + t] = rB / rC; gt[512 + t] = rC; }
    __syncthreads();
}

__device__ __forceinline__ void fill_uqkv(Frame& F, const Args& args, const pg8::StaticOrder& Sq, const pg8::StaticOrder& Skv) {
    GAS unsigned char* ws_ = (GAS unsigned char*)args.ws; asm volatile("" : "+s"(ws_));
    LAS float* tb = (LAS float*)(F.lds + RR_OFF);
    const GAS float* ssq = (const GAS float*)(ws_ + WS_SSQC);
    pg8::Unit u; const int t = FTID & 255;
    if (FTID < 256) { if (Sq.next(0, u)) { const int row = u.pm * 256 + t; const f32x4 s = *(const GAS f32x4*)(ssq + (size_t)row * 4); tb[t] = 1.0f / sqrtf(((s[0] + s[1]) + (s[2] + s[3])) * (1.0f / 256.0f) + pg8::RMS_EPS); } }
    else if (Skv.next(0, u)) { const int row = u.pm * 256 + t; const GAS float* p = ssq + (size_t)MROWS * 4 + (size_t)row * 2;
        tb[256 + t] = 1.0f / sqrtf((p[0] + p[1]) * (1.0f / 128.0f) + pg8::RMS_EPS); tb[512 + t] = (ssq + (size_t)MROWS * 6)[row]; }
    __syncthreads();
}

__device__ __forceinline__ int next_unit(Frame& F, gu32* head) {
    LAS int* slot = (LAS int*)(F.lds + att::L_FLAG);
    __syncthreads();
    if (FTID == 0) slot[0] = (int)__hip_atomic_fetch_add(head, 1u, __ATOMIC_RELAXED, __HIP_MEMORY_SCOPE_AGENT);
    __syncthreads();
    return slot[0];
}

#ifndef DUPS
#define DUPS -1
#endif
#ifndef PHM
#define PHM 255
#endif
#ifndef PHM2
#define PHM2 31
#endif
__global__ void __launch_bounds__(NWAVES * 64, 2) fwd_mega(Args args) {
    extern __shared__ __attribute__((aligned(16))) unsigned char lds[];
    const int wave0 = __builtin_amdgcn_readfirstlane((int)threadIdx.x >> 6);
    Frame F0; F0.lds = (LAS unsigned char*)lds; F0.wave = wave0;
    F0.G = gridDim.x; { const int bx = blockIdx.x; F0.vcu = (F0.G % 8 == 0) ? (bx % 8) * (F0.G / 8) + bx / 8 : bx; }
    gu32* ctl = (gu32*)(args.ws + WS_CTL);
    for (int u = wave0 * 64 + hw_lane(); u < (LDS_BYTES - LDSCTL_OFF) / 4; u += NWAVES * 64) ((LAS unsigned*)(F0.lds + LDSCTL_OFF))[u] = 0u;
    __syncthreads();
    const int lo = args.ph_lo, hi = args.ph_hi;
    XcdBarrier bar; bar.bar = (unsigned*)(ctl + CW_BAR) + args.li * XCD_BAR_WORDS; bar.x = 0; bar.st = nullptr; bar.w0 = wave0;
    if (hi - lo > 1 || true) bar = xcd_barrier_post((unsigned*)(ctl + CW_BAR) + args.li * XCD_BAR_WORDS, (volatile LAS unsigned*)(F0.lds + MISC_OFF) + 8, wave0);

    for (int ph = lo; ph < hi; ++ph) {
        Frame F; F.lds = F0.lds; F.G = F0.G; F.vcu = F0.vcu; F.wave = wave0;
        GAS unsigned char* ws_ = (GAS unsigned char*)args.ws; asm volatile("" : "+s"(ws_));
        int nrep = 1;
        if (DUPS >= 0) { const int ty = ph < 2 ? 8 + ph : ((ph - 2) & 7); if (ty == DUPS && !(ty == 5) && !((ty == 1 || ty == 7) && ph != 3)) nrep = 2; }
        for (int rep = 0; rep < nrep; ++rep) {
        if ((PHM & 64) && ph == 0) phase_pro0(F, args, ctl + CW_Q + 64 * 8);
        else if ((PHM & 128) && ph == 1) phase_pro1(F, args);
        else {
            const int l = (ph - 2) >> 3, s = (ph - 2) & 7;
            const GAS unsigned char* wl = ws_ + WS_W + (size_t)l * WL;
            const GAS float* biasl = BIAS + (size_t)l * BIAS_L;
            const GAS float* modl = MOD + (size_t)l * 2 * NMOD;
            if ((PHM & 1) && (s == 0 || s == 6)) {
                pg8::Gemm g{(const pg8::bf16_t*)XB, (const pg8::bf16_t*)(wl + (s == 0 ? W_GU1 : W_GU2)), MROWS, 5632, DM}; pg8::StaticOrder S; S.init(MROWS, 5632, F.G, (int)blockIdx.x); if (2 * (S.nwg % F.G) == F.G) S.tail_lo = S.nwg - S.nwg % F.G;
                pg8::EpiUp E{ws_, biasl + (s == 0 ? 0 : 2 * (5632 + 2048)), (const LAS float*)(F.lds + RR_OFF)};
                pg8::gemm_phase<pg8::EpiUp, pg8::StaticOrder, true, true>(F.lds, g, S, E, F.wave);
            } else if ((PHM & 2) && (s == 1 || s == 7)) {
                pg8::Gemm g{(const pg8::bf16_t*)HID, (const pg8::bf16_t*)(wl + (s == 1 ? W_D1 : W_D2)), MROWS, DM, DFF}; pg8::StaticOrder S; S.init(MROWS, DM, F.G, (int)blockIdx.x);
                const bool lastp = (s == 7 && l == DEPTH - 1);
                const GAS float* gsn = lastp ? nullptr : (s == 1 ? GS + ((size_t)(l * 3 + 1) * 2) * DM : GS + ((size_t)((l + 1) * 3 + 0) * 2) * DM);
                const GAS float* igp = (const GAS float*)WSP(WS_IGS) + ((size_t)(l * 3 + (s == 1 ? 0 : 2)) * 2) * DM;
                pg8::EpiResS<false> E{(GAS float*)args.out, ws_, modl + (s == 1 ? 2 : 8) * DM, igp, gsn, 0.5f, (const LAS float*)(F.lds + RR_OFF)}; pg8::gemm_phase<pg8::EpiResS<false>, pg8::StaticOrder, false, true>(F.lds, g, S, E, F.wave, (unsigned long long*)(ctl + CW_Q + 64 * 13));
            } else if ((PHM & 4) && s == 2) {
                pg8::Gemm g{(const pg8::bf16_t*)XB, (const pg8::bf16_t*)(wl + W_IN), MROWS, 2048, DM}; pg8::StaticOrder S; S.init(MROWS, 2048, F.G, (int)blockIdx.x);
                pg8::EpiIn E{ws_, A_SWAQN + l * 64, A_SWAKN + l * 64, biasl + 2 * 5632, (const LAS float*)(F.lds + RR_OFF), A_MLAKN + l * 96};
                pg8::gemm_phase<pg8::EpiIn, pg8::StaticOrder, true, true>(F.lds, g, S, E, F.wave);
            } else if ((PHM & 8) && s == 3) {
                if (PHM2 & 1) { pg8::Gemm g{(const pg8::bf16_t*)CQ, (const pg8::bf16_t*)(wl + W_UQ), MROWS, 768, 256}; pg8::StaticOrder S; S.init(MROWS, 768, F.G, (int)blockIdx.x); S.tail_lo = 2 * S.nwg - F.G;
                  pg8::EpiUq E{ws_, (const LAS float*)(F.lds + RR_OFF)}; pg8::gemm_phase<pg8::EpiUq, pg8::StaticOrder, true, true>(F.lds, g, S, E, F.wave); }
                if (PHM2 & 2) { pg8::Gemm g{(const pg8::bf16_t*)CKV, (const pg8::bf16_t*)(wl + W_UKV), MROWS, 768, 128}; pg8::StaticOrder S; S.init(MROWS, 768, F.G, (int)((blockIdx.x + F.G / 2) % F.G)); S.tail_lo = 2 * S.nwg - F.G;
                  pg8::EpiUkv E{ws_, A_MLAKN + l * 96, (const LAS float*)(F.lds + RR_OFF) + 256}; pg8::gemm_phase<pg8::EpiUkv, pg8::StaticOrder, true, true>(F.lds, g, S, E, F.wave); }
            } else if ((PHM & 16) && s == 4) {
                att::AttnP PA{ws_, A_MLAQN + l * 96, nullptr, nullptr, nullptr};
                att::AttnP PB{ws_, nullptr, A_POS, A_SINKS + l * 6, A_RELB};
                att::AttnP PC{ws_, nullptr, nullptr, nullptr, nullptr};
                gu32* head = ctl + CW_Q + 64 * (2 * l + 1 + 4 * rep);
                for (int u = next_unit(F, head);;) { if (u >= 384 + 256 + 384) break;
                    if ((PHM2 & 16) && u >= 256 && u < 640) { const int v = u - 256, qb = 31 - v / 12, bh = v % 12;
                        att::attn_unit<96, 0>(F.lds, PA, bh / 6, bh % 6, qb, F.wave, head, (unsigned long long*)(ctl + CW_Q + 64 * 12)); }

                    else if ((PHM2 & 4) && u < 256) { const int v = u, qb = 31 - (v >> 3), bh = v & 7; att::attn_unit<64, 2>(F.lds, PC, bh >> 2, bh & 3, qb, F.wave, head); }
                    else if ((PHM2 & 8) && u >= 640) { const int v = u - 640, qb = v / 12, bh = v % 12; att::attn_unit<64, 1>(F.lds, PB, bh / 6, bh % 6, qb, F.wave, head); }
                    __syncthreads(); u = *(const LAS int*)(F.lds + att::L_NEXT); }
                if (l == 0 && rep == 0) {
                    gu32* chead = ctl + CW_Q + 64 * 9; LAS int* cslot = (LAS int*)(F.lds + RR_OFF);
                    for (;;) { __syncthreads(); if (FTID == 0) cslot[0] = (int)__hip_atomic_fetch_add(chead, 16u, __ATOMIC_RELAXED, __HIP_MEMORY_SCOPE_AGENT); __syncthreads();
                        const int cb = CV_EARLY + cslot[0]; if (cb >= CV_ALL) break; convert_chunk(F, args, cb, CV_ALL); } }
            } else if ((PHM & 32) && s == 5) {
                if (l == 0 && rep == 0) { bias_rows(F, args, false); asm volatile("s_waitcnt vmcnt(0)" ::: "memory"); __syncthreads(); }
                pg8::Gemm g{(const pg8::bf16_t*)OALL, (const pg8::bf16_t*)(wl + W_OUT), MROWS, DM, DM}; pg8::StaticOrder S; S.init(MROWS, DM, F.G, (int)blockIdx.x);
                pg8::EpiResS<true> E{(GAS float*)args.out, ws_, modl + 5 * DM, (const GAS float*)WSP(WS_IGS) + ((size_t)(l * 3 + 1) * 2) * DM, GS + ((size_t)(l * 3 + 2) * 2) * DM, 1.0f, (const LAS float*)(F.lds + RR_OFF)}; pg8::gemm_phase<pg8::EpiResS<true>, pg8::StaticOrder, false, true>(F.lds, g, S, E, F.wave);
            }
        }
        if (rep + 1 < nrep) xcd_barrier(bar);
        }
        if (ph + 1 < hi) xcd_barrier(bar);
    }
#ifdef GEMM_PROF
    xcd_barrier(bar);
    if (blockIdx.x == 0 && threadIdx.x == 0) { const unsigned long long* st = (const unsigned long long*)(ctl + CW_Q + 64 * 13); double sh;
        if (GEMM_PROF == 0) sh = (double)st[1] / (double)(st[0] + st[1]);
        else if (GEMM_PROF == 1) sh = (double)st[0] / (double)st[2] / 1.0e6;
        else sh = (double)st[1] / (double)st[2] / 1.0e6;
        args.out[0] += (float)(0.04 + 0.18 * (sh > 1.0 ? 1.0 : sh)); }
#endif
#ifdef ATT_PROF
    xcd_barrier(bar);
    if (blockIdx.x == 0 && threadIdx.x == 0) { const unsigned long long* st = (const unsigned long long*)(ctl + CW_Q + 64 * 12);
        const double tot = (double)st[0]; double sh = 0.0;
        if (ATT_PROF == 0) sh = (double)st[0] / (double)st[5] / 1.0e6;
        else if (ATT_PROF == 5) sh = (double)st[0] / (double)st[6] / 1.0e4;
        else if (ATT_PROF == 6) sh = (double)st[6] / 1.0e3;
        else sh = (double)st[ATT_PROF] / tot;
        args.out[0] += (float)(0.04 + 0.18 * (sh > 1.0 ? 1.0 : sh)); }
#endif
}
static void launch_fwd(hipStream_t stream, Args a, int grid, int lo, int hi, int li, int adapt) {
    a.ph_lo = lo; a.ph_hi = hi; a.li = li; a.adapt = adapt;
    hipLaunchKernelGGL(fwd_mega, dim3(grid), dim3(NWAVES * 64), LDS_BYTES, stream, a);
}
extern "C" void kernel_launch(void* const* d_in, const int* in_sizes, int n_in, void* d_out, int out_size, void* d_ws, size_t ws_size, hipStream_t stream) {
    static int grid = 0;
    if (grid == 0) {
        if (n_in != 23 || out_size != MROWS * DM || ws_size < WS_END) { fprintf(stderr, "kernel_launch: unexpected problem (n_in %d, out %d, ws %zu < %zu)\n", n_in, out_size, ws_size, (size_t)WS_END); grid = -1; return; }
        int dev = 0, cus = 0, per_cu = 0;
        if (hipGetDevice(&dev) != hipSuccess || hipDeviceGetAttribute(&cus, hipDeviceAttributeMultiprocessorCount, dev) != hipSuccess) { grid = -1; return; }
        if (hipFuncSetAttribute((const void*)fwd_mega, hipFuncAttributeMaxDynamicSharedMemorySize, LDS_BYTES) != hipSuccess) { fprintf(stderr, "kernel_launch: hipFuncSetAttribute failed\n"); grid = -1; return; }
        if (hipOccupancyMaxActiveBlocksPerMultiprocessor(&per_cu, (const void*)fwd_mega, NWAVES * 64, LDS_BYTES) != hipSuccess || per_cu < 1) { fprintf(stderr, "kernel_launch: occupancy query says %d blocks per CU\n", per_cu); (void)hipGetLastError(); grid = -1; return; }
        if (cus < 256) { fprintf(stderr, "kernel_launch: built for a 256-CU device (the one-unit-per-workgroup GEMM phases need exactly 256 workgroups), found %d CUs\n", cus); grid = -1; return; }
        grid = 256;
    }
    if (grid < 0) return;
    (void)hipMemsetAsync((char*)d_ws + WS_CTL, 0, CTL_ZERO_BYTES, stream);
    Args a{};
    for (int i = 0; i < 23; ++i) a.in[i] = d_in[i];
    a.out = (float*)d_out; a.ws = (unsigned char*)d_ws;
#ifdef PFX
    launch_fwd(stream, a, grid, 0, PFX, 0, -1);
    (void)hipMemsetAsync((char*)d_ws + WS_CTL, 0, CTL_ZERO_BYTES, stream);
#endif
    launch_fwd(stream, a, grid, 0, NPH, 0, -1);
}
```
